# Optimizing an MI355X kernel written in HIP

```python
import math
import jax, jax.numpy as jnp
from jax import lax
import numpy as np

D_MODEL = 1024
BATCH = 2
SEQ = 16384
DEPTH = 2

S5_WIDTH = D_MODEL // 2
S5_GROUP_CH = 16
S5_GROUPS = S5_WIDTH // S5_GROUP_CH
S5_STATE = 64
S5_DT_MIN = 0.001
S5_DT_MAX = 0.1
GLA_WIDTH = D_MODEL - S5_WIDTH
GLA_HEADS = 4
GLA_DV = GLA_WIDTH // GLA_HEADS
GLA_DK = GLA_DV // 2
GLA_KEY = GLA_HEADS * GLA_DK
GLA_GATE_RANK = 16
GLA_TAU = 16.0
GLA_CHUNK = 64
AB_SPLITS = [S5_WIDTH, S5_WIDTH + GLA_KEY, S5_WIDTH + 2 * GLA_KEY,
             S5_WIDTH + 2 * GLA_KEY + GLA_WIDTH, S5_WIDTH + 2 * GLA_KEY + 2 * GLA_WIDTH]
AB_IN = S5_WIDTH + 2 * GLA_KEY + 2 * GLA_WIDTH + 2 * GLA_GATE_RANK
HEAD_DIM = 64
N_HEADS = D_MODEL // HEAD_DIM
N_KV_HEADS = 4
GQA_GROUP = N_HEADS // N_KV_HEADS
ATT_DIM = N_HEADS * HEAD_DIM
KV_DIM = N_KV_HEADS * HEAD_DIM
WINDOW = 128
ATT_BLOCK = 128
ATT_SCALE = HEAD_DIM ** -0.5
REL_BUCKETS = 32
REL_MAX_DIST = 128
NEG_INF = -1e30
N_GROUPS = 4
EXPERTS_PER_GROUP = 8
N_EXPERTS = N_GROUPS * EXPERTS_PER_GROUP
TOP_K = 2
D_EXPERT = 512
MOE_BLOCK = 128
LN_EPS = 1e-5
RMS_EPS = 1e-6
DEEPNORM_ALPHA = (2 * DEPTH) ** 0.25
DEEPNORM_BETA = (8 * DEPTH) ** -0.25
N_EVEN = (DEPTH + 1) // 2
N_ODD = DEPTH // 2

kernel_name = "hybrid_s5_gla_swa_hmoe_deepnorm"


def layer_norm(x, g, b):
    xf = x.astype(jnp.float32)
    mu = jnp.mean(xf, -1, keepdims=True)
    var = jnp.mean(jnp.square(xf - mu), -1, keepdims=True)
    y = (xf - mu) * lax.rsqrt(var + LN_EPS) * g.astype(jnp.float32) + b.astype(jnp.float32)
    return y.astype(x.dtype)


def _complex_linear_combine(e1, e2):
    a1r, a1i, b1r, b1i = e1
    a2r, a2i, b2r, b2i = e2
    ar = a2r * a1r - a2i * a1i
    ai = a2r * a1i + a2i * a1r
    br = a2r * b1r - a2i * b1i + b2r
    bi = a2r * b1i + a2i * b1r + b2i
    return ar, ai, br, bi


def s5_bidir(u, lam_re, lam_im, log_dt, b_re, b_im, c_re, c_im, d, glu_w, glu_b):
    bsz, L, _ = u.shape
    uf = u.astype(jnp.float32).reshape(bsz, L, S5_GROUPS, S5_GROUP_CH)
    y = uf * d.astype(jnp.float32).reshape(S5_GROUPS, S5_GROUP_CH)
    for direction in range(2):
        lr = jnp.minimum(lam_re[direction].astype(jnp.float32), -1e-4)
        li = lam_im[direction].astype(jnp.float32)
        dt = jnp.exp(log_dt[direction].astype(jnp.float32))[:, None]
        mag = jnp.exp(lr * dt)
        ar = mag * jnp.cos(li * dt)
        ai = mag * jnp.sin(li * dt)
        den = lr * lr + li * li
        nr = ar - 1.0
        coef_r = (nr * lr + ai * li) / den
        coef_i = (ai * lr - nr * li) / den
        br_ = b_re[direction].astype(jnp.float32)
        bi_ = b_im[direction].astype(jnp.float32)
        bbr = coef_r[..., None] * br_ - coef_i[..., None] * bi_
        bbi = coef_r[..., None] * bi_ + coef_i[..., None] * br_
        xr = jnp.einsum('blgc,gpc->blgp', uf, bbr)
        xi = jnp.einsum('blgc,gpc->blgp', uf, bbi)
        a_r = jnp.broadcast_to(ar[None, None], (1, L, S5_GROUPS, S5_STATE))
        a_i = jnp.broadcast_to(ai[None, None], (1, L, S5_GROUPS, S5_STATE))
        _, _, hr, hi = lax.associative_scan(_complex_linear_combine, (a_r, a_i, xr, xi),
                                            reverse=(direction == 1), axis=1)
        y = y + (jnp.einsum('blgp,gcp->blgc', hr, c_re[direction].astype(jnp.float32))
                 - jnp.einsum('blgp,gcp->blgc', hi, c_im[direction].astype(jnp.float32)))
    y = jax.nn.gelu(y.reshape(bsz, L, S5_WIDTH))
    y = y * jax.nn.sigmoid(y @ glu_w.astype(jnp.float32) + glu_b.astype(jnp.float32))
    return y.astype(u.dtype)


def gla_chunked(q, k, v, log_a, strict):
    bsz, L, H, dk = q.shape
    dv = v.shape[-1]
    n = L // GLA_CHUNK
    r = lambda t: t.reshape(bsz, n, GLA_CHUNK, H, t.shape[-1])
    q, k, v, log_a = r(q), r(k), r(v), r(log_a)
    bc = jnp.cumsum(log_a, axis=2)
    b_last = bc[:, :, -1]
    qd = q * jnp.exp(bc)
    kd = k * jnp.exp(-bc)
    mask = jnp.tril(jnp.ones((GLA_CHUNK, GLA_CHUNK), bool), k=-1 if strict else 0)
    s = jnp.where(mask, jnp.einsum('bnihd,bnjhd->bnhij', qd, kd), 0.0)
    o_intra = jnp.einsum('bnhij,bnjhe->bnihe', s, v)
    kc = k * jnp.exp(b_last[:, :, None] - bc)
    chunk_kv = jnp.einsum('bnjhd,bnjhe->bnhde', kc, v)
    decay = jnp.exp(b_last)

    def step(state, inp):
        dec, kv = inp
        return state * dec[..., None] + kv, state

    s0 = jnp.zeros((bsz, H, dk, dv), q.dtype)
    _, s_prev = lax.scan(step, s0, (jnp.moveaxis(decay, 1, 0), jnp.moveaxis(chunk_kv, 1, 0)))
    s_prev = jnp.moveaxis(s_prev, 0, 1)
    o_inter = jnp.einsum('bnihd,bnhde->bnihe', qd, s_prev)
    return (o_intra + o_inter).reshape(bsz, L, H, dv)


def gla_bidir(q, k, v, go, lr, gate_w, gate_b, norm_g):
    bsz, L, _ = q.shape
    f32 = jnp.float32
    qf = q.astype(f32).reshape(bsz, L, GLA_HEADS, GLA_DK) * (GLA_DK ** -0.5)
    kf = k.astype(f32).reshape(bsz, L, GLA_HEADS, GLA_DK)
    vf = v.astype(f32).reshape(bsz, L, GLA_HEADS, GLA_DV)
    lrf = lr.astype(f32).reshape(bsz, L, 2, GLA_GATE_RANK)
    z = jnp.einsum('blsr,srk->blsk', lrf, gate_w.astype(f32)) + gate_b.astype(f32)
    log_a = (jax.nn.log_sigmoid(z) / GLA_TAU).reshape(bsz, L, 2, GLA_HEADS, GLA_DK)
    o = gla_chunked(qf, kf, vf, log_a[:, :, 0], strict=False)
    flip = lambda t: jnp.flip(t, axis=1)
    o = o + flip(gla_chunked(flip(qf), flip(kf), flip(vf), flip(log_a[:, :, 1]), strict=True))
    o = o * lax.rsqrt(jnp.mean(o * o, -1, keepdims=True) + RMS_EPS) * norm_g.astype(f32)
    o = o.reshape(bsz, L, GLA_WIDTH) * jax.nn.silu(go.astype(f32))
    return o.astype(q.dtype)


def ssm_gla_mixer(x, w_in, lam_re, lam_im, log_dt, b_re, b_im, c_re, c_im, d, glu_w, glu_b,
                  gate_w, gate_b, norm_g, w_out):
    h = x @ w_in
    u, q, k, v, go, lr = jnp.split(h, AB_SPLITS, axis=-1)
    ya = s5_bidir(u, lam_re, lam_im, log_dt, b_re, b_im, c_re, c_im, d, glu_w, glu_b)
    yb = gla_bidir(q, k, v, go, lr, gate_w, gate_b, norm_g)
    return jnp.concatenate([ya, yb], axis=-1) @ w_out


def t5_bucket(rel):
    nb = REL_BUCKETS // 2
    max_exact = nb // 2
    ret = (rel > 0).astype(jnp.int32) * nb
    n = jnp.abs(rel)
    large = max_exact + (jnp.log(jnp.maximum(n, 1).astype(jnp.float32) / max_exact)
                         / math.log(REL_MAX_DIST / max_exact) * (nb - max_exact)).astype(jnp.int32)
    large = jnp.minimum(large, nb - 1)
    return ret + jnp.where(n < max_exact, n, large)


def window_gqa_mixer(x, w_in, sink, w_out, rel_bias):
    bsz, L, _ = x.shape
    h = x @ w_in
    q, k, v = jnp.split(h, [ATT_DIM, ATT_DIM + KV_DIM], axis=-1)
    k = k.reshape(bsz, L, N_KV_HEADS, HEAD_DIM)
    v = v.reshape(bsz, L, N_KV_HEADS, HEAD_DIM)
    nb = L // ATT_BLOCK
    kw = ATT_BLOCK + 2 * WINDOW
    pad = ((0, 0), (WINDOW, WINDOW), (0, 0), (0, 0))
    kp, vp = jnp.pad(k, pad), jnp.pad(v, pad)
    rel = jnp.arange(kw)[None, :] - WINDOW - jnp.arange(ATT_BLOCK)[:, None]
    band = jnp.abs(rel) <= WINDOW
    bias = rel_bias.astype(jnp.float32)[t5_bucket(rel)]
    bias = jnp.transpose(bias, (2, 0, 1)).reshape(N_KV_HEADS, GQA_GROUP, ATT_BLOCK, kw)
    sink_f = sink.astype(jnp.float32).reshape(N_KV_HEADS, GQA_GROUP)[..., None]
    qb = jnp.moveaxis(q.reshape(bsz, nb, ATT_BLOCK, N_KV_HEADS, GQA_GROUP, HEAD_DIM), 1, 0)

    def attend(args):
        n, qblk = args
        start = n * ATT_BLOCK
        kb = lax.dynamic_slice_in_dim(kp, start, kw, axis=1)
        vb = lax.dynamic_slice_in_dim(vp, start, kw, axis=1)
        kpos = start - WINDOW + jnp.arange(kw)
        valid = band & ((kpos >= 0) & (kpos < L))[None, :]
        s = jnp.einsum('bikgd,bjkd->bkgij', qblk, kb).astype(jnp.float32) * ATT_SCALE + bias
        s = jnp.where(valid, s, NEG_INF)
        m = jnp.maximum(jnp.max(s, -1), sink_f)
        p = jnp.exp(s - m[..., None])
        den = jnp.sum(p, -1) + jnp.exp(sink_f - m)
        o = jnp.einsum('bkgij,bjkd->bkgid', p, vb.astype(jnp.float32)) / den[..., None]
        return jnp.transpose(o, (0, 3, 1, 2, 4)).astype(x.dtype)

    o = lax.map(attend, (jnp.arange(nb), qb))
    o = jnp.moveaxis(o, 0, 1).reshape(bsz, L, ATT_DIM)
    return o @ w_out


def hier_moe(x, w_group, b_group, w_router, b_router, w1, w3, w2):
    bsz, L, D = x.shape
    xt = x.reshape(-1, D)
    T = xt.shape[0]
    tok = jnp.arange(T)
    gp = jax.nn.softmax((xt @ w_group + b_group).astype(jnp.float32), axis=-1)
    grp = jnp.argmax(gp, axis=-1)
    p_grp = gp[tok, grp][:, None]
    el = (xt @ w_router + b_router).astype(jnp.float32).reshape(T, N_GROUPS, EXPERTS_PER_GROUP)
    el = el[tok, grp]
    top_l, top_i = lax.top_k(el, TOP_K)
    gate = jax.nn.softmax(top_l, axis=-1) * p_grp
    eid = grp[:, None] * EXPERTS_PER_GROUP + top_i

    n_assign = T * TOP_K
    fe = eid.reshape(-1)
    ft = jnp.repeat(tok, TOP_K)
    fw = gate.reshape(-1).astype(x.dtype)
    order = jnp.argsort(fe)
    se = fe[order]
    counts = jnp.bincount(fe, length=N_EXPERTS)
    padded = (counts + MOE_BLOCK - 1) // MOE_BLOCK * MOE_BLOCK
    pad_end = jnp.cumsum(padded)
    pad_start = pad_end - padded
    start = jnp.cumsum(counts) - counts
    dest = pad_start[se] + jnp.arange(n_assign) - start[se]
    cap = n_assign + N_EXPERTS * MOE_BLOCK
    nblk = cap // MOE_BLOCK
    buf_tok = jnp.zeros((cap,), jnp.int32).at[dest].set(ft[order].astype(jnp.int32))
    buf_w = jnp.zeros((cap,), x.dtype).at[dest].set(fw[order])
    blk_e = jnp.minimum(jnp.searchsorted(pad_end, jnp.arange(nblk) * MOE_BLOCK, side='right'),
                        N_EXPERTS - 1)

    def expert_block(args):
        t_idx, wt, e = args
        xb = xt[t_idx]
        hdn = jax.nn.silu(xb @ w1[e]) * (xb @ w3[e])
        return (hdn @ w2[e]) * wt[:, None]

    yb = lax.map(expert_block, (buf_tok.reshape(nblk, MOE_BLOCK), buf_w.reshape(nblk, MOE_BLOCK), blk_e))
    y = jnp.zeros_like(xt).at[buf_tok].add(yb.reshape(cap, D))
    return y.reshape(bsz, L, D)


def setup_inputs(seed: int = 0) -> dict:
    key = jax.random.key(seed)
    keys = iter(jax.random.split(key, 48))

    def nrm(shape, scale):
        return jax.random.normal(next(keys), shape, jnp.float32) * scale

    ne, no, nl = N_EVEN, N_ODD, DEPTH
    s5 = (ne, 2, S5_GROUPS, S5_STATE)
    return {
        "x": nrm((BATCH, SEQ, D_MODEL), 1.0),
        "ln_mix_g": 1.0 + nrm((nl, D_MODEL), 0.02),
        "ln_mix_b": nrm((nl, D_MODEL), 0.02),
        "ln_ffn_g": 1.0 + nrm((nl, D_MODEL), 0.02),
        "ln_ffn_b": nrm((nl, D_MODEL), 0.02),
        "ab_w_in": nrm((ne, D_MODEL, AB_IN), D_MODEL ** -0.5),
        "s5_lam_re": -0.5 * jnp.exp(nrm(s5, 0.02)),
        "s5_lam_im": jnp.pi * jnp.arange(S5_STATE, dtype=jnp.float32) + nrm(s5, 0.02),
        "s5_log_dt": jax.random.uniform(next(keys), (ne, 2, S5_GROUPS), jnp.float32,
                                        math.log(S5_DT_MIN), math.log(S5_DT_MAX)),
        "s5_b_re": nrm((ne, 2, S5_GROUPS, S5_STATE, S5_GROUP_CH), (2 * S5_GROUP_CH) ** -0.5),
        "s5_b_im": nrm((ne, 2, S5_GROUPS, S5_STATE, S5_GROUP_CH), (2 * S5_GROUP_CH) ** -0.5),
        "s5_c_re": nrm((ne, 2, S5_GROUPS, S5_GROUP_CH, S5_STATE), (2 * S5_STATE) ** -0.5),
        "s5_c_im": nrm((ne, 2, S5_GROUPS, S5_GROUP_CH, S5_STATE), (2 * S5_STATE) ** -0.5),
        "s5_d": nrm((ne, S5_WIDTH), 1.0),
        "s5_glu_w": nrm((ne, S5_WIDTH, S5_WIDTH), S5_WIDTH ** -0.5),
        "s5_glu_b": nrm((ne, S5_WIDTH), 0.02),
        "gla_gate_w": nrm((ne, 2, GLA_GATE_RANK, GLA_KEY), GLA_GATE_RANK ** -0.5),
        "gla_gate_b": nrm((ne, 2, GLA_KEY), 0.1),
        "gla_norm_g": 1.0 + nrm((ne, GLA_HEADS, GLA_DV), 0.02),
        "ab_w_out": nrm((ne, D_MODEL, D_MODEL), D_MODEL ** -0.5 * DEEPNORM_BETA),
        "c_w_in": nrm((no, D_MODEL, ATT_DIM + 2 * KV_DIM), D_MODEL ** -0.5),
        "c_sink": nrm((no, N_HEADS), 0.5),
        "c_w_out": nrm((no, ATT_DIM, D_MODEL), ATT_DIM ** -0.5 * DEEPNORM_BETA),
        "rel_bias": nrm((REL_BUCKETS, N_HEADS), 0.1),
        "moe_w_group": nrm((nl, D_MODEL, N_GROUPS), D_MODEL ** -0.5),
        "moe_b_group": nrm((nl, N_GROUPS), 0.01),
        "moe_w_router": nrm((nl, D_MODEL, N_EXPERTS), D_MODEL ** -0.5),
        "moe_b_router": nrm((nl, N_EXPERTS), 0.01),
        "moe_w1": nrm((nl, N_EXPERTS, D_MODEL, D_EXPERT), D_MODEL ** -0.5),
        "moe_w3": nrm((nl, N_EXPERTS, D_MODEL, D_EXPERT), D_MODEL ** -0.5),
        "moe_w2": nrm((nl, N_EXPERTS, D_EXPERT, D_MODEL), D_EXPERT ** -0.5 * DEEPNORM_BETA),
    }


def reference(x, ln_mix_g, ln_mix_b, ln_ffn_g, ln_ffn_b, ab_w_in, s5_lam_re, s5_lam_im,
              s5_log_dt, s5_b_re, s5_b_im, s5_c_re, s5_c_im, s5_d, s5_glu_w, s5_glu_b,
              gla_gate_w, gla_gate_b, gla_norm_g, ab_w_out, c_w_in, c_sink, c_w_out, rel_bias,
              moe_w_group, moe_b_group, moe_w_router, moe_b_router, moe_w1, moe_w3, moe_w2):
    h = x
    for layer in range(DEPTH):
        i = layer // 2
        if layer % 2 == 0:
            y = ssm_gla_mixer(h, ab_w_in[i], s5_lam_re[i], s5_lam_im[i], s5_log_dt[i],
                              s5_b_re[i], s5_b_im[i], s5_c_re[i], s5_c_im[i], s5_d[i],
                              s5_glu_w[i], s5_glu_b[i], gla_gate_w[i], gla_gate_b[i],
                              gla_norm_g[i], ab_w_out[i])
        else:
            y = window_gqa_mixer(h, c_w_in[i], c_sink[i], c_w_out[i], rel_bias)
        h = layer_norm(DEEPNORM_ALPHA * h + y, ln_mix_g[layer], ln_mix_b[layer])
        y = hier_moe(h, moe_w_group[layer], moe_b_group[layer], moe_w_router[layer],
                     moe_b_router[layer], moe_w1[layer], moe_w3[layer], moe_w2[layer])
        h = layer_norm(DEEPNORM_ALPHA * h + y, ln_ffn_g[layer], ln_ffn_b[layer])
    return h
```

```cpp
#include <hip/hip_runtime.h>
#include <cstdio>
#include <cstdint>
#include <cmath>
namespace pg8 {
#define PG8_LAS __attribute__((address_space(3)))
typedef unsigned short bf16_t;
typedef short bf16x8 __attribute__((ext_vector_type(8)));
typedef float f32x4 __attribute__((ext_vector_type(4)));
typedef float f32x2 __attribute__((ext_vector_type(2)));
typedef unsigned u32x4 __attribute__((ext_vector_type(4)));
typedef unsigned u32x2 __attribute__((ext_vector_type(2)));
constexpr int BM = 256, BK = 64, HALF = 128, HTB = HALF * BK * 2  , STAGE_BYTES = 8 * HTB, NXCD = 8, WGM = 8;

__host__ __device__ __forceinline__ int lds_byte(int r, int c) { const int st = (r >> 4) * 2 + (c >> 5), rr = r & 15, cc = c & 31, ob = rr * 64 + cc * 2; return st * 1024 + (ob ^ (((ob >> 9) & 1) << 5)); }
__host__ __device__ __forceinline__ void stage_rc(int b, int& R, int& C) { const int st = b / 1024, sb = b % 1024, swz = sb ^ (((sb >> 9) & 1) << 5); R = (st >> 1) * 16 + swz / 64; C = (st & 1) * 32 + (swz % 64) / 2; }
__host__ __device__ __forceinline__ int perm32(int rho) { const int n = rho >> 4, i = rho & 15; return 8 * (i >> 2) + 4 * n + (i & 3); }

struct Unit { int pm, pn, e; };
struct Gemm { const bf16_t* A; const bf16_t* Bt; int M, N, K; size_t bstride; const int* rowmap; };

struct StaticOrder {
    int nM, nN, nwg, G, c;
    __host__ __device__ void init(int M, int N, int G_, int c_) { nM = M / BM; nN = N / BM; nwg = nM * nN; G = G_; c = c_; }
    __host__ __device__ bool next(int i, Unit& u) const {
        const long L = (long)i * G + c; if (L >= nwg) return false;
        int wgid = (int)L; { const int q = nwg / NXCD, r = nwg % NXCD, xcd = wgid % NXCD, off = wgid / NXCD; wgid = (xcd < r ? xcd * (q + 1) : r * (q + 1) + (xcd - r) * q) + off; }
        const int nig = WGM * nN, gid = wgid / nig, fm = gid * WGM, gsz = (nM - fm) < WGM ? (nM - fm) : WGM;
        u.pm = fm + ((wgid % nig) % gsz); u.pn = (wgid % nig) / gsz; u.e = 0; return true;
    }
};
struct GroupOrder {
    const int* tile_e; int ntiles, nN, G, c;
    __device__ bool next(int i, Unit& u) const {
        const int L = i * G + c; if (L >= ntiles * nN) return false;
        u.pm = L / nN; u.pn = L % nN; u.e = __builtin_amdgcn_readfirstlane(tile_e[u.pm]); return true;
    }
};

typedef __bf16 bf16x2_t __attribute__((ext_vector_type(2)));
__device__ __forceinline__ unsigned cvt_pk_bf16(float lo, float hi) { f32x2 v = {lo, hi}; return __builtin_bit_cast(unsigned, __builtin_convertvector(v, bf16x2_t)); }
__device__ __forceinline__ float bf_lo(unsigned w) { return __uint_as_float(w << 16); }
__device__ __forceinline__ float bf_hi(unsigned w) { return __uint_as_float(w & 0xffff0000u); }

struct EpiBf16 {
    static constexpr bool PERM = true;
    bf16_t* O; int ldc;
    __device__ __forceinline__ void operator()(const f32x4 (&acc)[2][2][4][2], const Unit& u, int wr, int wc, int fr, int fq) const {
        const int row0 = u.pm * BM + wr * 64 + fr; const int col0 = u.pn * BM + wc * 32 + 8 * fq;
#pragma unroll
        for (int ai = 0; ai < 2; ++ai)
#pragma unroll
            for (int m = 0; m < 4; ++m) { bf16_t* rowp = O + (size_t)(row0 + ai * HALF + m * 16) * ldc + col0;
#pragma unroll
                for (int bj = 0; bj < 2; ++bj) { const f32x4 v0 = acc[ai][bj][m][0], v1 = acc[ai][bj][m][1];
                    u32x4 w; w.x = cvt_pk_bf16(v0[0], v0[1]); w.y = cvt_pk_bf16(v0[2], v0[3]); w.z = cvt_pk_bf16(v1[0], v1[1]); w.w = cvt_pk_bf16(v1[2], v1[3]);
                    *(u32x4*)(rowp + bj * HALF) = w; } }
    }
};
struct EpiGlu {
    static constexpr bool PERM = true;
    const bf16_t* Y; int ldy; bf16_t* O; int ldc; const float* bias;
    __device__ __forceinline__ void operator()(const f32x4 (&acc)[2][2][4][2], const Unit& u, int wr, int wc, int fr, int fq) const {
        const int row0 = u.pm * BM + wr * 64 + fr; const int col0 = u.pn * BM + wc * 32 + 8 * fq;
        f32x4 bv[2][2];
#pragma unroll
        for (int bj = 0; bj < 2; ++bj)
#pragma unroll
            for (int n = 0; n < 2; ++n) bv[bj][n] = *(const f32x4*)(bias + col0 + bj * HALF + 4 * n);
#pragma unroll
        for (int ai = 0; ai < 2; ++ai)
#pragma unroll
            for (int m = 0; m < 4; ++m) { const size_t r = (size_t)(row0 + ai * HALF + m * 16);
#pragma unroll
                for (int bj = 0; bj < 2; ++bj) { const f32x4 v0 = acc[ai][bj][m][0] + bv[bj][0], v1 = acc[ai][bj][m][1] + bv[bj][1];
                    const u32x4 y = *(const u32x4*)(Y + r * ldy + col0 + bj * HALF);
                    float o[8]; const float yv[8] = {bf_lo(y.x), bf_hi(y.x), bf_lo(y.y), bf_hi(y.y), bf_lo(y.z), bf_hi(y.z), bf_lo(y.w), bf_hi(y.w)};
#pragma unroll
                    for (int i = 0; i < 4; ++i) { o[i] = yv[i] / (1.f + __expf(-v0[i])); o[4 + i] = yv[4 + i] / (1.f + __expf(-v1[i])); }
                    u32x4 w; w.x = cvt_pk_bf16(o[0], o[1]); w.y = cvt_pk_bf16(o[2], o[3]); w.z = cvt_pk_bf16(o[4], o[5]); w.w = cvt_pk_bf16(o[6], o[7]);
                    *(u32x4*)(O + r * ldc + col0 + bj * HALF) = w; } }
    }
};
struct EpiResid {
    static constexpr bool PERM = false;
    const float* resid; float* out; int ldc; float alpha;
    __device__ __forceinline__ void operator()(const f32x4 (&acc)[2][2][4][2], const Unit& u, int wr, int wc, int fr, int fq) const {
        const int col0 = u.pn * BM + wc * 32 + 4 * fq;
#pragma unroll
        for (int ai = 0; ai < 2; ++ai)
#pragma unroll
            for (int m = 0; m < 4; ++m) { const size_t off = (size_t)(u.pm * BM + ai * HALF + wr * 64 + m * 16 + fr) * ldc + col0;
#pragma unroll
                for (int bj = 0; bj < 2; ++bj)
#pragma unroll
                    for (int n = 0; n < 2; ++n) { const f32x4 bs = *(const f32x4*)(resid + off + bj * HALF + n * 16);
                        *(f32x4*)(out + off + bj * HALF + n * 16) = bs * alpha + acc[ai][bj][m][n]; } }
    }
};
struct EpiSwiglu {
    static constexpr bool PERM = true;
    bf16_t* O; int ldc;
    __device__ __forceinline__ void operator()(const f32x4 (&acc)[2][2][4][2], const Unit& u, int wr, int wc, int fr, int fq) const {
        const int row0 = u.pm * BM + wr * 64 + fr; const int col0 = (u.pn * BM + wc * 32 + 8 * fq) >> 1;
#pragma unroll
        for (int ai = 0; ai < 2; ++ai)
#pragma unroll
            for (int m = 0; m < 4; ++m) { bf16_t* rowp = O + (size_t)(row0 + ai * HALF + m * 16) * ldc + col0;
#pragma unroll
                for (int bj = 0; bj < 2; ++bj) { const f32x4 g = acc[ai][bj][m][0], up = acc[ai][bj][m][1]; float o[4];
#pragma unroll
                    for (int i = 0; i < 4; ++i) o[i] = g[i] / (1.f + __expf(-g[i])) * up[i];
                    u32x2 w; w.x = cvt_pk_bf16(o[0], o[1]); w.y = cvt_pk_bf16(o[2], o[3]);
                    *(u32x2*)(rowp + bj * (HALF / 2)) = w; } }
    }
};
struct EpiScale {
    static constexpr bool PERM = true;
    bf16_t* O; int ldc; const float* rw;
    __device__ __forceinline__ void operator()(const f32x4 (&acc)[2][2][4][2], const Unit& u, int wr, int wc, int fr, int fq) const {
        const int row0 = u.pm * BM + wr * 64 + fr; const int col0 = u.pn * BM + wc * 32 + 8 * fq;
#pragma unroll
        for (int ai = 0; ai < 2; ++ai)
#pragma unroll
            for (int m = 0; m < 4; ++m) { const int r = row0 + ai * HALF + m * 16; const float s = rw[r]; bf16_t* rowp = O + (size_t)r * ldc + col0;
#pragma unroll
                for (int bj = 0; bj < 2; ++bj) { const f32x4 v0 = acc[ai][bj][m][0] * s, v1 = acc[ai][bj][m][1] * s;
                    u32x4 w; w.x = cvt_pk_bf16(v0[0], v0[1]); w.y = cvt_pk_bf16(v0[2], v0[3]); w.z = cvt_pk_bf16(v1[0], v1[1]); w.w = cvt_pk_bf16(v1[2], v1[3]);
                    *(u32x4*)(rowp + bj * HALF) = w; } }
    }
};

template <class Epi, class Sched, bool GATHER>
__device__ __forceinline__ void gemm_phase(PG8_LAS unsigned char* lds, const Gemm g, const Sched& S, const Epi& E) {
    const int tid = threadIdx.x, wid = __builtin_amdgcn_readfirstlane(tid >> 6), lane = tid & 63, wr = wid >> 2, wc = wid & 3, fr = lane & 15, fq = lane >> 4;
    const int K = g.K, nt = K / BK;
    unsigned voffA[2], voffB[2]; int RA[2], CA[2];
#pragma unroll
    for (int i = 0; i < 2; ++i) { int R, C; stage_rc(tid * 16 + i * 8192, R, C); const int Rb = Epi::PERM ? ((R & ~31) + perm32(R & 31)) : R;
        voffA[i] = (unsigned)(R * K + C) * 2u; voffB[i] = (unsigned)(Rb * K + C) * 2u; RA[i] = R; CA[i] = C; }
    const size_t kstep = (size_t)(BK * 2);
    const size_t hstep = (size_t)HALF * K * 2;
    const size_t tstep = 2 * hstep;
    const unsigned ldsw = (unsigned)wid * 1024u;
    const int aoff = lds_byte(wr * 64 + fr, fq * 8), boff = lds_byte(wc * 32 + fr, fq * 8);
#define PG8_SA(b, h) (((b) * 2 + (h)) * HTB)
#define PG8_SB(b, h) ((4 + (b) * 2 + (h)) * HTB)
#define PG8_STAGE(bufoff, gbase, voff) do { _Pragma("unroll") for (int _i = 0; _i < 2; ++_i) \
        __builtin_amdgcn_global_load_lds((const unsigned*)((const char*)(gbase) + (voff)[_i]), (PG8_LAS unsigned*)(lds + (bufoff) + ldsw + _i * 8192), 16, 0, 0); } while (0)
#define PG8_LDA(dst, b, h) do { _Pragma("unroll") for (int m = 0; m < 4; ++m) _Pragma("unroll") for (int k = 0; k < 2; ++k) dst[m][k] = *(const PG8_LAS bf16x8*)(lds + PG8_SA(b, h) + aoff + m * 2048 + k * 1024); } while (0)
#define PG8_LDB(dst, b, h) do { _Pragma("unroll") for (int n = 0; n < 2; ++n) _Pragma("unroll") for (int k = 0; k < 2; ++k) dst[n][k] = *(const PG8_LAS bf16x8*)(lds + PG8_SB(b, h) + boff + n * 2048 + k * 1024); } while (0)
#define PG8_MMA(ai, bj, At, Bt) do { __builtin_amdgcn_s_setprio(1); _Pragma("unroll") for (int m = 0; m < 4; ++m) _Pragma("unroll") for (int n = 0; n < 2; ++n) _Pragma("unroll") for (int k = 0; k < 2; ++k) \
        acc[ai][bj][m][n] = __builtin_amdgcn_mfma_f32_16x16x32_bf16(Bt[n][k], At[m][k], acc[ai][bj][m][n], 0, 0, 0); __builtin_amdgcn_s_setprio(0); } while (0)
#define PG8_WAIT_V(n) asm volatile("s_waitcnt vmcnt(" #n ")" ::: "memory")
#define PG8_WAIT_L(n) asm volatile("s_waitcnt lgkmcnt(" #n ")" ::: "memory")
#define PG8_BAR __builtin_amdgcn_s_barrier()
#define PG8_SCHED __builtin_amdgcn_sched_barrier(0)
    Unit cur, nxt; int ui = 0;
    if (!S.next(0, cur)) return;
    f32x4 acc[2][2][4][2];
#pragma unroll
    for (int a = 0; a < 2; ++a)
#pragma unroll
        for (int b = 0; b < 2; ++b)
#pragma unroll
            for (int m = 0; m < 4; ++m)
#pragma unroll
                for (int n = 0; n < 2; ++n) acc[a][b][m][n] = (f32x4){0.f, 0.f, 0.f, 0.f};
    bf16x8 At[4][2], B0[2][2], B1[2][2];
    unsigned cG[2][2], nG[2][2];
#define PG8_LOAD_ROWS(u_, G2_) do { _Pragma("unroll") for (int h_ = 0; h_ < 2; ++h_) _Pragma("unroll") for (int i_ = 0; i_ < 2; ++i_) \
        G2_[h_][i_] = GATHER ? ((unsigned)g.rowmap[(u_).pm * BM + h_ * HALF + RA[i_]] * (unsigned)K + (unsigned)CA[i_]) * 2u : voffA[i_]; } while (0)
    const char* cA = GATHER ? (const char*)g.A : (const char*)g.A + (size_t)cur.pm * tstep;
    const size_t hA = GATHER ? 0 : hstep;
    const char* cB = (const char*)g.Bt + (size_t)cur.e * g.bstride + (size_t)cur.pn * tstep;
    PG8_LOAD_ROWS(cur, cG);
    PG8_STAGE(PG8_SB(0, 0), cB, voffB); PG8_STAGE(PG8_SB(0, 1), cB + hstep, voffB); PG8_STAGE(PG8_SA(0, 0), cA, cG[0]); PG8_STAGE(PG8_SA(0, 1), cA + hA, cG[1]);
    if (wr == 1) PG8_BAR;
    PG8_WAIT_V(2); PG8_BAR;
    PG8_STAGE(PG8_SB(1, 0), cB + kstep, voffB); PG8_STAGE(PG8_SA(1, 0), cA + kstep, cG[0]); PG8_STAGE(PG8_SB(1, 1), cB + hstep + kstep, voffB);
    PG8_WAIT_V(6); PG8_BAR;
    for (;;) {
        const bool has_next = S.next(ui + 1, nxt);
        const char* nA = GATHER ? (const char*)g.A : (has_next ? (const char*)g.A + (size_t)nxt.pm * tstep : cA);
        const char* nB = has_next ? (const char*)g.Bt + (size_t)nxt.e * g.bstride + (size_t)nxt.pn * tstep : cB;
        if (has_next) PG8_LOAD_ROWS(nxt, nG); else {
#pragma unroll
            for (int h = 0; h < 2; ++h) { nG[h][0] = cG[h][0]; nG[h][1] = cG[h][1]; } }
        for (int t = 0; t < nt; t += 2) {
            const bool last = (t == nt - 2);
            const char* a1 = cA + (size_t)(t + 1) * kstep;
            const char* a2 = last ? nA : cA + (size_t)(t + 2) * kstep; const char* b2 = last ? nB : cB + (size_t)(t + 2) * kstep;
            const char* a3 = a2 + kstep; const char* b3 = b2 + kstep;
            unsigned sG[2][2];
#pragma unroll
            for (int h = 0; h < 2; ++h) { sG[h][0] = (GATHER && last) ? nG[h][0] : cG[h][0]; sG[h][1] = (GATHER && last) ? nG[h][1] : cG[h][1]; }
            PG8_LDB(B0, 0, 0); PG8_LDB(B1, 0, 1); PG8_SCHED; PG8_LDA(At, 0, 0); PG8_STAGE(PG8_SA(1, 1), a1 + hA, cG[1]);
            PG8_WAIT_V(8); PG8_WAIT_L(0); PG8_BAR; PG8_MMA(0, 0, At, B0); PG8_MMA(0, 1, At, B1); PG8_BAR; PG8_SCHED;
            PG8_LDA(At, 0, 1); PG8_STAGE(PG8_SB(0, 0), b2, voffB); PG8_STAGE(PG8_SB(0, 1), b2 + hstep, voffB); PG8_STAGE(PG8_SA(0, 0), a2, sG[0]);
            PG8_WAIT_V(8); PG8_WAIT_L(0); PG8_BAR; PG8_MMA(1, 0, At, B0); PG8_MMA(1, 1, At, B1); PG8_BAR; PG8_SCHED;
            PG8_LDB(B0, 1, 0); PG8_LDB(B1, 1, 1); PG8_SCHED; PG8_LDA(At, 1, 0); PG8_STAGE(PG8_SA(0, 1), a2 + hA, sG[1]);
            PG8_WAIT_V(8); PG8_WAIT_L(0); PG8_BAR; PG8_MMA(0, 0, At, B0); PG8_MMA(0, 1, At, B1); PG8_BAR; PG8_SCHED;
            PG8_LDA(At, 1, 1); PG8_STAGE(PG8_SB(1, 0), b3, voffB); PG8_STAGE(PG8_SB(1, 1), b3 + hstep, voffB); PG8_STAGE(PG8_SA(1, 0), a3, sG[0]);
            PG8_WAIT_V(8); PG8_WAIT_L(0); PG8_BAR; PG8_MMA(1, 0, At, B0); PG8_MMA(1, 1, At, B1); PG8_BAR; PG8_SCHED;
        }
        if (wr == 0) PG8_BAR;
        E(acc, cur, wr, wc, fr, fq);
        if (!has_next) break;
#pragma unroll
        for (int a = 0; a < 2; ++a)
#pragma unroll
            for (int b = 0; b < 2; ++b)
#pragma unroll
                for (int m = 0; m < 4; ++m)
#pragma unroll
                    for (int n = 0; n < 2; ++n) acc[a][b][m][n] = (f32x4){0.f, 0.f, 0.f, 0.f};
        cur = nxt; cA = nA; cB = nB; ++ui;
#pragma unroll
        for (int h = 0; h < 2; ++h) { cG[h][0] = nG[h][0]; cG[h][1] = nG[h][1]; }
        if (wr == 1) PG8_BAR;
    }
    PG8_WAIT_V(0);
    PG8_BAR;
#undef PG8_LOAD_ROWS
#undef PG8_SA
#undef PG8_SB
#undef PG8_STAGE
#undef PG8_LDA
#undef PG8_LDB
#undef PG8_MMA
#undef PG8_WAIT_V
#undef PG8_WAIT_L
#undef PG8_BAR
#undef PG8_SCHED
}
}
constexpr int NB = 2, SEQ = 16384, T = NB * SEQ, D = 1024;
constexpr int ABN = 2048, OFF_U = 0, OFF_Q = 512, OFF_K = 768, OFF_V = 1024, OFF_GO = 1536, AB_IN = 2080;
constexpr int CN = 1536;
constexpr int NEXP = 32, DEXP = 512, CAP = 2 * T + NEXP * 256, MAXTILES = CAP / 256;
constexpr int S5CH = 256, S5NCH = SEQ / S5CH;
constexpr int GSC = 16, GCH = 64, GNSC = SEQ / (GSC * GCH);
constexpr float ALPHA = 1.41421356237309515f;
constexpr float LN_EPS = 1e-5f, RMS_EPS = 1e-6f, LOG2E = 1.44269504088896341f;
constexpr int NWAVES = 8, NTHR = 512;

constexpr size_t MiB = 1u << 20, KiB = 1u << 10;
constexpr size_t WS_CTL = 0, CTL_ZERO_BYTES = 64 * KiB;
constexpr int CW_BAR = 4096;
constexpr size_t WS_LR = 1 * MiB;
constexpr size_t WS_S5E = 5 * MiB;
constexpr size_t WS_GS = 9 * MiB;
constexpr size_t WS_GD = 17 * MiB;
constexpr size_t WS_S5L = WS_GD + 64 * KiB;
constexpr size_t WS_S5B = WS_S5L + 64 * KiB;
constexpr size_t WS_S5C = WS_S5B + 256 * KiB;
constexpr size_t WS_BTAB = WS_S5C + 256 * KiB;
constexpr size_t WS_WR = WS_BTAB + 32 * KiB;
constexpr size_t WS_TOKE = WS_WR + 384 * KiB;
constexpr size_t WS_TOKW = WS_TOKE + 256 * KiB;
constexpr size_t WS_TOKS = WS_TOKW + 256 * KiB;
constexpr size_t WS_SLOTT = WS_TOKS + 256 * KiB;
constexpr size_t WS_SLOTW = WS_SLOTT + 288 * KiB;
constexpr size_t WS_BLKC = WS_SLOTW + 288 * KiB;
constexpr size_t WS_TILE = WS_BLKC + 32 * KiB;
static_assert(WS_TILE + 4 * KiB <= 32 * MiB, "param region");
constexpr size_t WS_WIN = 32 * MiB, WS_WLR = 36 * MiB, WS_WGLU = 37 * MiB, WS_WOUT = 38 * MiB, WS_CIN = 40 * MiB, WS_COUT = 43 * MiB;
constexpr size_t WS_W13 = 48 * MiB, WS_W2 = 112 * MiB;
constexpr size_t A0 = 144 * MiB;
constexpr size_t WS_H1 = A0, WS_H0 = A0;
constexpr size_t WS_Z = A0 + 128 * MiB;
constexpr size_t WS_YG = A0 + 128 * MiB, WS_OF = A0 + 160 * MiB, WS_OB = A0 + 320 * MiB;
constexpr size_t WS_YSCR = A0 + 224 * MiB;
constexpr size_t WS_X64 = A0 + 256 * MiB;
constexpr size_t WS_HID = A0 + 128 * MiB;
constexpr size_t WS_Y2 = A0 + 200 * MiB;
constexpr size_t WS_H2B = A0 + 128 * MiB;
constexpr size_t WS_QKV = A0 + 192 * MiB;
constexpr size_t WS_AO = A0 + 288 * MiB;
constexpr size_t WS_END = A0 + 384 * MiB;
static_assert(WS_Y2 + (size_t)CAP * D * 2 <= WS_END && WS_OB + (size_t)T * 512 * 4 <= WS_END && WS_HID + (size_t)CAP * 512 * 2 <= WS_Y2, "act map");

constexpr int RING_BYTES = 131072;
constexpr int MISC_OFF = RING_BYTES;
constexpr int PTR_OFF = MISC_OFF + 256;
constexpr int LDS_BYTES = 147456;

#define GAS __attribute__((address_space(1)))
#define LAS __attribute__((address_space(3)))
typedef unsigned short bf16;
typedef float f32x4 __attribute__((ext_vector_type(4)));
typedef float f32x2 __attribute__((ext_vector_type(2)));
typedef float f32x16 __attribute__((ext_vector_type(16)));
typedef short bf16x8 __attribute__((ext_vector_type(8)));
typedef short bf16x4 __attribute__((ext_vector_type(4)));
typedef unsigned u32x4 __attribute__((ext_vector_type(4)));
typedef unsigned u32x2 __attribute__((ext_vector_type(2)));
#define LDS_WAIT() asm volatile("s_waitcnt lgkmcnt(0)" ::: "memory")
#define VM_WAIT() asm volatile("s_waitcnt vmcnt(0)" ::: "memory")
__device__ __forceinline__ unsigned f2bf(float f) { unsigned u = __builtin_bit_cast(unsigned, f); return (u + 0x7fffu + ((u >> 16) & 1u)) >> 16; }
typedef __bf16 bf16x2_t __attribute__((ext_vector_type(2)));
__device__ __forceinline__ unsigned pk2(float lo, float hi) { f32x2 v = {lo, hi}; return __builtin_bit_cast(unsigned, __builtin_convertvector(v, bf16x2_t)); }
__device__ __forceinline__ float bf2f(unsigned short b) { return __uint_as_float((unsigned)b << 16); }
__device__ __forceinline__ float bflo(unsigned w) { return __uint_as_float(w << 16); }
__device__ __forceinline__ float bfhi(unsigned w) { return __uint_as_float(w & 0xffff0000u); }
__device__ __forceinline__ float wave_sum(float v) {
#pragma unroll
    for (int o = 1; o < 64; o <<= 1) v += __shfl_xor(v, o);
    return v;
}
__device__ __forceinline__ int crow(int r, int hi) { return (r & 3) + 8 * (r >> 2) + 4 * hi; }

#define XB_TMO      128
#define XB_XCNT(j)  (256  + 64 * (j))
#define XB_XSUB(j)  (1280 + 64 * (j))
#define XB_XGEN(j)  (2304 + 64 * (j))
#define XB_TOP      3328
#define XB_TOPGEN   3392
#define XCD_BAR_WORDS 3456
#define XB_SPIN_CAP (1u << 18)
__device__ __forceinline__ unsigned xb_ld(unsigned* p)              { return __hip_atomic_load(p, __ATOMIC_RELAXED, __HIP_MEMORY_SCOPE_AGENT); }
__device__ __forceinline__ unsigned xb_add(unsigned* p, unsigned v) { return __hip_atomic_fetch_add(p, v, __ATOMIC_RELAXED, __HIP_MEMORY_SCOPE_AGENT); }
__device__ __forceinline__ unsigned xb_xcc_id() { return (unsigned)__builtin_amdgcn_s_getreg((3 << 11) | 20) & 0xFu; }
#define XB_SPIN(cond, bar) do { unsigned _sp = 0; while (cond) { __builtin_amdgcn_s_sleep(1); \
    if ((++_sp & 255u) == 0u) { if (xb_ld(&(bar)[XB_TMO])) break; if (_sp > XB_SPIN_CAP) { atomicAdd(&(bar)[XB_TMO], 1u); break; } } } } while (0)
struct XcdBarrier { unsigned* bar; unsigned x; volatile LAS unsigned* st; };
__device__ __forceinline__ XcdBarrier xcd_barrier_post(unsigned* bar, volatile LAS unsigned* st) {
    XcdBarrier b; b.bar = bar; b.x = xb_xcc_id(); b.st = st;
    if (threadIdx.x == 0) (void)xb_add(&bar[XB_XCNT(b.x)], 1u);
    return b;
}
__device__ __forceinline__ void xcd_barrier_complete(unsigned* bar, unsigned x, unsigned& nloc, unsigned& nx) {
    const unsigned G = gridDim.x * gridDim.y * gridDim.z;
    unsigned sum, cnt, mine, sp = 0u;
    for (;;) {
        sum = 0u; cnt = 0u; mine = 0u;
#pragma unroll
        for (unsigned j = 0; j < 16; ++j) { const unsigned c = xb_ld(&bar[XB_XCNT(j)]); sum += c; cnt += (c > 0u) ? 1u : 0u; mine = (j == x) ? c : mine; }
        if (sum == G) break;
        __builtin_amdgcn_s_sleep(1);
        if ((++sp & 255u) == 0u) { if (xb_ld(&bar[XB_TMO])) break; if (sp > XB_SPIN_CAP) { atomicAdd(&bar[XB_TMO], 1u); break; } }
    }
    nloc = mine > 0u ? mine : 1u; nx = cnt > 0u ? cnt : 1u;
}
__device__ __forceinline__ void xcd_barrier(const XcdBarrier& b) {
    asm volatile("s_waitcnt vmcnt(0)" ::: "memory");
    __syncthreads();
    if (threadIdx.x == 0) {
        unsigned* bar = b.bar;
        __builtin_amdgcn_s_waitcnt(0);
        unsigned nloc = b.st[0], nx = b.st[1];
        if (nloc == 0u) { xcd_barrier_complete(bar, b.x, nloc, nx); b.st[0] = nloc; b.st[1] = nx; }
        const unsigned old = xb_add(&bar[XB_XSUB(b.x)], 1u);
        const unsigned gen = old / nloc;
        if (old + 1u == (gen + 1u) * nloc) {
            __builtin_amdgcn_fence(__ATOMIC_RELEASE, "agent");
            asm volatile("s_waitcnt vmcnt(0)" ::: "memory");
            const unsigned og = xb_add(&bar[XB_TOP], 1u);
            const unsigned tg = og / nx;
            if (og + 1u == (tg + 1u) * nx) xb_add(&bar[XB_TOPGEN], 1u);
            else XB_SPIN(xb_ld(&bar[XB_TOPGEN]) == tg, bar);
            __builtin_amdgcn_fence(__ATOMIC_ACQUIRE, "agent");
            xb_add(&bar[XB_XGEN(b.x)], 1u);
            asm volatile("s_waitcnt vmcnt(0)" ::: "memory");
        } else {
            XB_SPIN(xb_ld(&bar[XB_XGEN(b.x)]) == gen, bar);
            __builtin_amdgcn_fence(__ATOMIC_ACQUIRE, "agent");
            asm volatile("s_waitcnt vmcnt(0)" ::: "memory");
        }
    }
    __syncthreads();
}

struct Frame {
    LAS unsigned char* lds;
    int tid, lane, wave, G, bid;
    unsigned char* ws;
    const float* const* in;
};
enum InIdx { I_X = 0, I_LNMG, I_LNMB, I_LNFG, I_LNFB, I_ABWIN, I_LAMRE, I_LAMIM, I_LOGDT, I_BRE, I_BIM, I_CRE, I_CIM, I_S5D, I_GLUW, I_GLUB,
             I_GATEW, I_GATEB, I_NORMG, I_ABWOUT, I_CWIN, I_SINK, I_CWOUT, I_RELB, I_WGRP, I_BGRP, I_WRT, I_BRT, I_W1, I_W3, I_W2, N_IN };

__device__ __forceinline__ const float* inp(LAS unsigned char* lds, int k) {
    const LAS unsigned* p = (const LAS unsigned*)(lds + PTR_OFF) + 2 * k;
    const unsigned lo = __builtin_amdgcn_readfirstlane(p[0]), hi = __builtin_amdgcn_readfirstlane(p[1]);
    return (const float*)(((unsigned long long)hi << 32) | (unsigned long long)lo);
}
__device__ __forceinline__ void tr_item(const float* W, int ldw, bf16* WT, int ldt, int rowmode, LAS float* scr, int item, int nblk, int lane) {
    const int kb = item / nblk, nb = item % nblk, k0 = 64 * kb, n0 = 32 * nb;
#pragma unroll 8
    for (int i = 0; i < 32; ++i) { const int kk = 2 * i + (lane >> 5); scr[kk * 33 + (lane & 31)] = W[(size_t)(k0 + kk) * ldw + n0 + (lane & 31)]; }
    LDS_WAIT(); asm volatile("" ::: "memory");
    const int c = lane & 7;
#pragma unroll
    for (int j = 0; j < 4; ++j) { const int n = (lane >> 3) + 8 * j; const LAS float* s = scr + (8 * c) * 33 + n;
        u32x4 o; o.x = pk2(s[0 * 33], s[1 * 33]); o.y = pk2(s[2 * 33], s[3 * 33]); o.z = pk2(s[4 * 33], s[5 * 33]); o.w = pk2(s[6 * 33], s[7 * 33]);
        const int ng = n0 + n; const int dr = rowmode == 0 ? ng : (8 * (ng >> 2) + (ng & 3) + (rowmode == 2 ? 4 : 0));
        *(GAS u32x4*)(WT + (size_t)dr * ldt + k0 + 8 * c) = o; }
    LDS_WAIT(); asm volatile("" ::: "memory");
}
__device__ __forceinline__ void moe_convert(const float* w1, const float* w3, const float* w2, bf16* W13, bf16* W2T, LAS float* scr, int gw, int NGW, int lane) {
    constexpr int PER_E = 768;
    for (int it = gw; it < NEXP * PER_E; it += NGW) {
        const int e = it / PER_E; int r = it % PER_E;
        if (r < 256) tr_item(w1 + (size_t)e * D * DEXP, DEXP, W13 + (size_t)e * D * D, D, 1, scr, r, DEXP / 32, lane);
        else if (r < 512) tr_item(w3 + (size_t)e * D * DEXP, DEXP, W13 + (size_t)e * D * D, D, 2, scr, r - 256, DEXP / 32, lane);
        else tr_item(w2 + (size_t)e * DEXP * D, D, W2T + (size_t)e * D * DEXP, DEXP, 0, scr, r - 512, D / 32, lane);
    }
}
__device__ __forceinline__ int t5_bucket(int rel) {
    const int nb = 16, max_exact = 8; int ret = rel > 0 ? nb : 0; const int n = rel < 0 ? -rel : rel;
    const float lg = logf((float)(n < 1 ? 1 : n) / 8.0f) / 2.7725887f * 8.0f;
    int large = max_exact + (int)lg; large = large < nb - 1 ? large : nb - 1;
    return ret + (n < max_exact ? n : large);
}
__device__ __forceinline__ void p0_prologue(unsigned char* ws, LAS unsigned char* lds, int bid, int G, int tid, int wave, int lane) {
    LAS float* scr = (LAS float*)(lds + wave * 16384);
    const int gw = bid * NWAVES + wave, NGW = G * NWAVES;
    constexpr int I0 = 16 * 64, I1 = 16, I2 = 8 * 16, I3 = 16 * 32, I4 = 16 * 48, I5 = 16 * 32, NIT = I0 + I1 + I2 + I3 + I4 + I5;
    for (int it = gw; it < NIT; it += NGW) {
        int r = it;
        if (r < I0) { tr_item(inp(lds, I_ABWIN), AB_IN, (bf16*)(ws + WS_WIN), D, 0, scr, r, 64, lane); continue; } r -= I0;
        if (r < I1) { tr_item(inp(lds, I_ABWIN) + 2048, AB_IN, (bf16*)(ws + WS_WLR), D, 0, scr, r, 1, lane); continue; } r -= I1;
        if (r < I2) { tr_item(inp(lds, I_GLUW), 512, (bf16*)(ws + WS_WGLU), 512, 0, scr, r, 16, lane); continue; } r -= I2;
        if (r < I3) { tr_item(inp(lds, I_ABWOUT), D, (bf16*)(ws + WS_WOUT), D, 0, scr, r, 32, lane); continue; } r -= I3;
        if (r < I4) { tr_item(inp(lds, I_CWIN), CN, (bf16*)(ws + WS_CIN), D, 0, scr, r, 48, lane); continue; } r -= I4;
        tr_item(inp(lds, I_CWOUT), D, (bf16*)(ws + WS_COUT), D, 0, scr, r, 32, lane);
    }
    moe_convert(inp(lds, I_W1), inp(lds, I_W3), inp(lds, I_W2), (bf16*)(ws + WS_W13), (bf16*)(ws + WS_W2), scr, gw, NGW, lane);
    { const float* x = inp(lds, I_X); bf16* xb = (bf16*)(ws + WS_X64);
      for (int m = gw; m < T; m += NGW) { const GAS f32x4* xr = (const GAS f32x4*)(x + (size_t)m * D) + lane; GAS u32x2* o = (GAS u32x2*)(xb + (size_t)m * D) + lane;
#pragma unroll
          for (int j = 0; j < 4; ++j) { const f32x4 v = xr[64 * j]; u32x2 w; w.x = pk2(v.x, v.y); w.y = pk2(v.z, v.w); o[64 * j] = w; } } }
    const int gt = bid * NTHR + tid, NGT = G * NTHR;
    { const float* lamre = inp(lds, I_LAMRE); const float* lamim = inp(lds, I_LAMIM); const float* logdt = inp(lds, I_LOGDT); const float* bre = inp(lds, I_BRE); const float* bim = inp(lds, I_BIM);
    for (int i = gt; i < 2 * 32 * 64; i += NGT) {
        const int p = i & 63, g = (i >> 6) & 31, dir = i >> 11;
        const double lr = fmin((double)lamre[i], -1e-4), li = (double)lamim[i], dt = exp((double)logdt[dir * 32 + g]);
        const double mag = exp(lr * dt), ar = mag * cos(li * dt), ai = mag * sin(li * dt), den = lr * lr + li * li, nr = ar - 1.0;
        const double cr = (nr * lr + ai * li) / den, ci = (ai * lr - nr * li) / den;
        double qr = ar, qi = ai;
#pragma unroll 1
        for (int s = 1; s < S5CH; s <<= 1) { const double t = qr * qr - qi * qi; qi = 2.0 * qr * qi; qr = t; }
        float* L4 = (float*)(ws + WS_S5L) + (size_t)i * 4; L4[0] = (float)ar; L4[1] = (float)ai; L4[2] = (float)qr; L4[3] = (float)qi;
        bf16* Bb = (bf16*)(ws + WS_S5B) + (size_t)(dir * 32 + g) * 2048;
#pragma unroll 4
        for (int c = 0; c < 16; ++c) { const double br = bre[(size_t)i * 16 + c], bi = bim[(size_t)i * 16 + c];
            Bb[p * 16 + c] = (bf16)f2bf((float)(cr * br - ci * bi)); Bb[1024 + p * 16 + c] = (bf16)f2bf((float)(cr * bi + ci * br)); }
    } }
    { const float* cre = inp(lds, I_CRE); const float* cim = inp(lds, I_CIM);
    for (int i = gt; i < 2 * 32 * 16 * 64; i += NGT) {
        const int p = i & 63, c = (i >> 6) & 15, dg = i >> 10;
        bf16* Cm = (bf16*)(ws + WS_S5C) + (size_t)dg * 2048 + c * 128 + 2 * p;
        Cm[0] = (bf16)f2bf(cre[i]); Cm[1] = (bf16)f2bf(-cim[i]);
    } }
    { const float* relb = inp(lds, I_RELB);
    for (int i = gt; i < 16 * 257; i += NGT) { const int h = i / 257, r = i % 257; ((float*)(ws + WS_BTAB))[h * 260 + r] = relb[t5_bucket(r - 128) * 16 + h] * LOG2E; } }
    { const float* wgrp = inp(lds, I_WGRP); const float* wrt = inp(lds, I_WRT);
    for (int i = gt; i < 2 * 48 * 1024; i += NGT) {
        const int k = i & 1023, n = (i >> 10) % 48, l = i / (48 * 1024);
        const float w = n < 4 ? wgrp[(size_t)l * D * 4 + k * 4 + n] : (n < 36 ? wrt[(size_t)l * D * 32 + k * 32 + (n - 4)] : 0.f);
        const unsigned hi = f2bf(w); const float lo = w - __uint_as_float(hi << 16);
        bf16* Wr = (bf16*)(ws + WS_WR) + (size_t)l * 2 * 48 * 1024; Wr[n * 1024 + k] = (bf16)hi; Wr[48 * 1024 + n * 1024 + k] = (bf16)f2bf(lo);
    } }
}

__device__ __forceinline__ void lr_tail(unsigned char* ws, int bid, int G, int wave, int lane) {
    const bf16* xb = (const bf16*)(ws + WS_X64); const bf16* wl = (const bf16*)(ws + WS_WLR); float* lr = (float*)(ws + WS_LR);
    for (int rt = bid; rt < T / 128; rt += G) {
        const int r0 = rt * 128 + wave * 16;
        f32x4 acc0 = {0.f, 0.f, 0.f, 0.f}, acc1 = {0.f, 0.f, 0.f, 0.f};
        const bf16* ap = xb + (size_t)(r0 + (lane & 15)) * D + 8 * (lane >> 4);
        const bf16* bp = wl + (size_t)(lane & 15) * D + 8 * (lane >> 4);
#pragma unroll 8
        for (int ks = 0; ks < 32; ++ks) {
            const bf16x8 a = *(const bf16x8*)(ap + ks * 32), b0 = *(const bf16x8*)(bp + ks * 32), b1 = *(const bf16x8*)(bp + 16 * D + ks * 32);
            acc0 = __builtin_amdgcn_mfma_f32_16x16x32_bf16(a, b0, acc0, 0, 0, 0); acc1 = __builtin_amdgcn_mfma_f32_16x16x32_bf16(a, b1, acc1, 0, 0, 0);
        }
#pragma unroll
        for (int r = 0; r < 4; ++r) { float* o = lr + (size_t)(r0 + 4 * (lane >> 4) + r) * 32 + (lane & 15); o[0] = acc0[r]; o[16] = acc1[r]; }
    }
}

__device__ __forceinline__ void gla_finalize(unsigned char* ws, const float* norm_g, int gw, int NGW, int lane) {
    const float* of = (const float*)(ws + WS_OF); const float* ob = (const float*)(ws + WS_OB); const bf16* h0 = (const bf16*)(ws + WS_H0); bf16* cc = (bf16*)(ws + WS_X64);
    f32x4 g0 = *(const f32x4*)(norm_g + 8 * lane), g1 = *(const f32x4*)(norm_g + 8 * lane + 4);
    for (int m = gw; m < T; m += NGW) {
        const float* a = of + (size_t)m * 512 + 8 * lane; const float* b = ob + (size_t)m * 512 + 8 * lane;
        f32x4 v0 = *(const f32x4*)a + *(const f32x4*)b, v1 = *(const f32x4*)(a + 4) + *(const f32x4*)(b + 4);
        const u32x4 gq = *(const u32x4*)(h0 + (size_t)m * ABN + OFF_GO + 8 * lane);
        float ss = (v0.x * v0.x + v0.y * v0.y) + (v0.z * v0.z + v0.w * v0.w) + (v1.x * v1.x + v1.y * v1.y) + (v1.z * v1.z + v1.w * v1.w);
        ss += __shfl_xor(ss, 1); ss += __shfl_xor(ss, 2); ss += __shfl_xor(ss, 4); ss += __shfl_xor(ss, 8);
        const float rs = 1.0f / sqrtf(ss * (1.0f / 128.0f) + RMS_EPS);
        const float gv[8] = {bflo(gq.x), bfhi(gq.x), bflo(gq.y), bfhi(gq.y), bflo(gq.z), bfhi(gq.z), bflo(gq.w), bfhi(gq.w)};
        const float ov[8] = {v0.x * g0.x, v0.y * g0.y, v0.z * g0.z, v0.w * g0.w, v1.x * g1.x, v1.y * g1.y, v1.z * g1.z, v1.w * g1.w};
        float r[8];
#pragma unroll
        for (int i = 0; i < 8; ++i) r[i] = ov[i] * rs * (gv[i] / (1.f + __expf(-gv[i])));
        u32x4 w; w.x = pk2(r[0], r[1]); w.y = pk2(r[2], r[3]); w.z = pk2(r[4], r[5]); w.w = pk2(r[6], r[7]);
        *(u32x4*)(cc + (size_t)m * D + 512 + 8 * lane) = w;
    }
}

constexpr int RT_AST = 2064;
__device__ __forceinline__ void ln_router(unsigned char* ws, const float* lng, const float* lnb, const float* bgrp, const float* brt, int layer, LAS unsigned char* lds, int bid, int G, int tid, int wave, int lane) {
    const float* z = (const float*)(ws + WS_Z); float* h1 = (float*)(ws + WS_H1); bf16* hb = (bf16*)(ws + WS_X64);
    int* tok_e = (int*)(ws + WS_TOKE); float* tok_w = (float*)(ws + WS_TOKW);
    LAS unsigned char* Ahi = lds; LAS unsigned char* Alo = lds + 16 * RT_AST; LAS float* part = (LAS float*)(lds + 32 * RT_AST);
    LAS int* hist = (LAS int*)(lds + 32 * RT_AST + 8 * 16 * 48 * 4); LAS float* lgt = (LAS float*)(lds + 32 * RT_AST + 8 * 16 * 48 * 4 + 256);
    if (tid < 32) hist[tid] = 0;
    const bf16* Wr = (const bf16*)(ws + WS_WR) + (size_t)layer * 2 * 48 * 1024;
    bf16x8 Bh[3][4], Bl[3][4];
#pragma unroll
    for (int nt = 0; nt < 3; ++nt)
#pragma unroll
        for (int ks = 0; ks < 4; ++ks) { const size_t o = (size_t)(nt * 16 + (lane & 15)) * 1024 + wave * 128 + ks * 32 + 8 * (lane >> 4);
            Bh[nt][ks] = *(const bf16x8*)(Wr + o); Bl[nt][ks] = *(const bf16x8*)(Wr + 48 * 1024 + o); }
    f32x4 gv[4], bv[4];
#pragma unroll
    for (int j = 0; j < 4; ++j) { gv[j] = *(const f32x4*)(lng + 4 * lane + 256 * j); bv[j] = *(const f32x4*)(lnb + 4 * lane + 256 * j); }
    __syncthreads();
    for (int grp = bid; grp < T / 16; grp += G) {
#pragma unroll
        for (int rr = 0; rr < 2; ++rr) {
            const int row = 2 * wave + rr; const size_t m = (size_t)grp * 16 + row;
            const GAS f32x4* zr = (const GAS f32x4*)(z + m * D) + lane;
            f32x4 v[4]; float s = 0.f;
#pragma unroll
            for (int j = 0; j < 4; ++j) { v[j] = zr[64 * j]; s += (v[j].x + v[j].y) + (v[j].z + v[j].w); }
            const float mean = wave_sum(s) * (1.f / D); float s2 = 0.f;
#pragma unroll
            for (int j = 0; j < 4; ++j) { v[j] = v[j] - mean; s2 += (v[j].x * v[j].x + v[j].y * v[j].y) + (v[j].z * v[j].z + v[j].w * v[j].w); }
            const float rstd = 1.f / sqrtf(wave_sum(s2) * (1.f / D) + LN_EPS);
#pragma unroll
            for (int j = 0; j < 4; ++j) {
                const f32x4 h = v[j] * rstd * gv[j] + bv[j];
                ((GAS f32x4*)(h1 + m * D) + lane)[64 * j] = h;
                const unsigned h0 = pk2(h.x, h.y), h1w = pk2(h.z, h.w);
                u32x2 w; w.x = h0; w.y = h1w; ((GAS u32x2*)(hb + m * D) + lane)[64 * j] = w;
                u32x2 lo; lo.x = pk2(h.x - bflo(h0), h.y - bfhi(h0)); lo.y = pk2(h.z - bflo(h1w), h.w - bfhi(h1w));
                *(LAS u32x2*)(Ahi + row * RT_AST + (4 * lane + 256 * j) * 2) = w; *(LAS u32x2*)(Alo + row * RT_AST + (4 * lane + 256 * j) * 2) = lo;
            }
        }
        __syncthreads();
        f32x4 acc[3] = {{0.f, 0.f, 0.f, 0.f}, {0.f, 0.f, 0.f, 0.f}, {0.f, 0.f, 0.f, 0.f}};
#pragma unroll
        for (int ks = 0; ks < 4; ++ks) {
            const int bo = (lane & 15) * RT_AST + (wave * 128 + ks * 32 + 8 * (lane >> 4)) * 2;
            const bf16x8 ah = *(const LAS bf16x8*)(Ahi + bo), al = *(const LAS bf16x8*)(Alo + bo);
#pragma unroll
            for (int nt = 0; nt < 3; ++nt) {
                acc[nt] = __builtin_amdgcn_mfma_f32_16x16x32_bf16(ah, Bh[nt][ks], acc[nt], 0, 0, 0);
                acc[nt] = __builtin_amdgcn_mfma_f32_16x16x32_bf16(ah, Bl[nt][ks], acc[nt], 0, 0, 0);
                acc[nt] = __builtin_amdgcn_mfma_f32_16x16x32_bf16(al, Bh[nt][ks], acc[nt], 0, 0, 0);
            }
        }
#pragma unroll
        for (int nt = 0; nt < 3; ++nt)
#pragma unroll
            for (int r = 0; r < 4; ++r) part[(wave * 16 + 4 * (lane >> 4) + r) * 48 + nt * 16 + (lane & 15)] = acc[nt][r];
        __syncthreads();
        for (int idx = tid; idx < 16 * 36; idx += NTHR) { const int tk = idx / 36, n = idx % 36; float s = 0.f;
#pragma unroll
            for (int w = 0; w < 8; ++w) s += part[(w * 16 + tk) * 48 + n];
            lgt[tk * 36 + n] = s + (n < 4 ? bgrp[n] : brt[n - 4]); }
        __syncthreads();
        if (tid < 16) {
            const size_t m = (size_t)grp * 16 + tid;
            const LAS float* lg = lgt + tid * 36;
            int gi = 0; float gm = lg[0];
#pragma unroll
            for (int n = 1; n < 4; ++n) if (lg[n] > gm) { gm = lg[n]; gi = n; }
            float gs = 0.f;
#pragma unroll
            for (int n = 0; n < 4; ++n) gs += __expf(lg[n] - gm);
            const float pg = 1.f / gs;
            float el[8];
#pragma unroll
            for (int i = 0; i < 8; ++i) el[i] = lg[4 + gi * 8 + i];
            int i1 = 0; float m1 = el[0];
#pragma unroll
            for (int i = 1; i < 8; ++i) if (el[i] > m1) { m1 = el[i]; i1 = i; }
            int i2 = -1; float m2 = -3.0e38f;
#pragma unroll
            for (int i = 0; i < 8; ++i) if (i != i1 && el[i] > m2) { m2 = el[i]; i2 = i; }
            const float e2 = __expf(m2 - m1), inv = 1.f / (1.f + e2);
            const int ea = gi * 8 + i1, eb = gi * 8 + i2;
            tok_e[m * 2] = ea; tok_e[m * 2 + 1] = eb; tok_w[m * 2] = pg * inv; tok_w[m * 2 + 1] = pg * e2 * inv;
            atomicAdd((int*)&hist[ea], 1); atomicAdd((int*)&hist[eb], 1);
        }
        __syncthreads();
    }
    if (tid < 32) ((int*)(ws + WS_BLKC))[bid * 32 + tid] = hist[tid];
}

__device__ __forceinline__ void moe_sort(unsigned char* ws, LAS unsigned char* lds, int bid, int G, int tid) {
    const int* blkc = (const int*)(ws + WS_BLKC); const int* tok_e = (const int*)(ws + WS_TOKE); const float* tok_w = (const float*)(ws + WS_TOKW);
    int* tok_s = (int*)(ws + WS_TOKS); int* slot_t = (int*)(ws + WS_SLOTT); float* slot_w = (float*)(ws + WS_SLOTW); int* tile = (int*)(ws + WS_TILE);
    LAS int* ptot = (LAS int*)lds; LAS int* pbase = ptot + 512; LAS int* tot = pbase + 512; LAS int* base = tot + 32; LAS int* pstart = base + 32; LAS int* lcur = pstart + 33;
    { const int e = tid & 31, part = tid >> 5; int st = 0, sb = 0;
      for (int b = part; b < G; b += 16) { const int c = blkc[b * 32 + e]; st += c; sb += (b < bid) ? c : 0; }
      ptot[part * 32 + e] = st; pbase[part * 32 + e] = sb; }
    __syncthreads();
    if (tid < 32) { int st = 0, sb = 0;
#pragma unroll
        for (int p = 0; p < 16; ++p) { st += ptot[p * 32 + tid]; sb += pbase[p * 32 + tid]; }
        tot[tid] = st; base[tid] = sb; lcur[tid] = 0; }
    __syncthreads();
    if (tid == 0) { int acc = 0; for (int e = 0; e < 32; ++e) { pstart[e] = acc; acc += (tot[e] + 255) & ~255; } pstart[32] = acc; }
    __syncthreads();
    if (bid == 0) {
        const int nt = pstart[32] >> 8;
        if (tid == 0) tile[511] = nt;
        for (int t = tid; t < nt; t += NTHR) { int e = 0; for (int q = 1; q < 32; ++q) if ((t << 8) >= pstart[q]) e = q; tile[t] = e; }
    }
    for (int e = bid; e < 32; e += G)
        for (int s = pstart[e] + tot[e] + tid; s < pstart[e + 1]; s += NTHR) { slot_t[s] = 0; slot_w[s] = 0.f; }
    for (int grp = bid; grp < T / 16; grp += G) {
        if (tid < 32) { const size_t a = (size_t)grp * 32 + tid; const int e = tok_e[a]; const int rank = atomicAdd((int*)&lcur[e], 1);
            const int s = pstart[e] + base[e] + rank; slot_t[s] = (int)(a >> 1); slot_w[s] = tok_w[a]; tok_s[a] = s; }
    }
}

template <bool FINAL>
__device__ __forceinline__ void combine_ln(unsigned char* ws, const float* lng, const float* lnb, float* dout, int gw, int NGW, int lane) {
    float* h1 = (float*)(ws + WS_H1); const bf16* y2 = (const bf16*)(ws + WS_Y2); const int* tok_s = (const int*)(ws + WS_TOKS); bf16* h2b = (bf16*)(ws + WS_H2B);
    f32x4 gv[4], bv[4];
#pragma unroll
    for (int j = 0; j < 4; ++j) { gv[j] = *(const f32x4*)(lng + 4 * lane + 256 * j); bv[j] = *(const f32x4*)(lnb + 4 * lane + 256 * j); }
    for (int m = gw; m < T; m += NGW) {
        const int s0 = tok_s[(size_t)m * 2], s1 = tok_s[(size_t)m * 2 + 1];
        const GAS f32x4* hr = (const GAS f32x4*)(h1 + (size_t)m * D) + lane;
        const GAS u32x2* ya = (const GAS u32x2*)(y2 + (size_t)s0 * D) + lane; const GAS u32x2* yb = (const GAS u32x2*)(y2 + (size_t)s1 * D) + lane;
        f32x4 v[4]; float s = 0.f;
#pragma unroll
        for (int j = 0; j < 4; ++j) { const f32x4 h = hr[64 * j]; const u32x2 a = ya[64 * j], b = yb[64 * j];
            v[j].x = h.x * ALPHA + (bflo(a.x) + bflo(b.x)); v[j].y = h.y * ALPHA + (bfhi(a.x) + bfhi(b.x)); v[j].z = h.z * ALPHA + (bflo(a.y) + bflo(b.y)); v[j].w = h.w * ALPHA + (bfhi(a.y) + bfhi(b.y));
            s += (v[j].x + v[j].y) + (v[j].z + v[j].w); }
        const float mean = wave_sum(s) * (1.f / D); float s2 = 0.f;
#pragma unroll
        for (int j = 0; j < 4; ++j) { v[j] = v[j] - mean; s2 += (v[j].x * v[j].x + v[j].y * v[j].y) + (v[j].z * v[j].z + v[j].w * v[j].w); }
        const float rstd = 1.f / sqrtf(wave_sum(s2) * (1.f / D) + LN_EPS);
#pragma unroll
        for (int j = 0; j < 4; ++j) { const f32x4 h = v[j] * rstd * gv[j] + bv[j];
            if (FINAL) ((GAS f32x4*)(dout + (size_t)m * D) + lane)[64 * j] = h;
            else { ((GAS f32x4*)(h1 + (size_t)m * D) + lane)[64 * j] = h; u32x2 w; w.x = pk2(h.x, h.y); w.y = pk2(h.z, h.w); ((GAS u32x2*)(h2b + (size_t)m * D) + lane)[64 * j] = w; } }
    }
}
constexpr int S5_HST = 272;
#define MFMA32(a, b, c) __builtin_amdgcn_mfma_f32_32x32x16_bf16((a), (b), (c), 0, 0, 0)
#define MFMA16(a, b, c) __builtin_amdgcn_mfma_f32_16x16x32_bf16((a), (b), (c), 0, 0, 0)
__device__ __forceinline__ float gelu_tanh(float x) {
    const float u = 0.7978845608028654f * (x + 0.044715f * x * x * x);
    const float e = __expf(2.f * u); const float th = 1.f - 2.f / (e + 1.f);
    return 0.5f * x * (1.f + th);
}
template <int PASS, int DIR>
__device__ __forceinline__ void s5_dir(unsigned char* ws, const float* s5d, int b, int g, int c, LAS unsigned char* hl, float* yscr, int lane) {
    const bf16* h0 = (const bf16*)(ws + WS_H0);
    const int dg = DIR * 32 + g;
    const f32x4 L4 = *(const f32x4*)((const float*)(ws + WS_S5L) + (size_t)(dg * 64 + lane) * 4);
    const float ar = L4.x, ai = L4.y, qr = L4.z, qi = L4.w;
    const bf16* Bb = (const bf16*)(ws + WS_S5B) + (size_t)dg * 2048 + (lane & 31) * 16 + 8 * (lane >> 5);
    const bf16x8 bre0 = *(const bf16x8*)Bb, bre1 = *(const bf16x8*)(Bb + 512), bim0 = *(const bf16x8*)(Bb + 1024), bim1 = *(const bf16x8*)(Bb + 1536);
    bf16x8 cf[4]; bf16x8 dfrag;
    if (PASS == 2) {
        const bf16* Cm = (const bf16*)(ws + WS_S5C) + (size_t)dg * 2048 + (lane & 15) * 128 + 8 * (lane >> 4);
#pragma unroll
        for (int ks = 0; ks < 4; ++ks) cf[ks] = *(const bf16x8*)(Cm + 32 * ks);
        if (DIR == 1) {
            const int cc = lane & 15, kq = lane >> 4; const float d = s5d[g * 16 + cc]; const unsigned dh = f2bf(d); const unsigned dl = f2bf(d - __uint_as_float(dh << 16));
#pragma unroll
            for (int j = 0; j < 8; ++j) { const int k = 8 * (kq & 1) + j; dfrag[j] = (short)((k == cc) ? (kq < 2 ? dh : dl) : 0u); }
        }
    }
    float hr = 0.f, hi = 0.f;
    float* Ec = (float*)(ws + WS_S5E) + ((size_t)((DIR * NB + b) * 32 + g) * S5NCH) * 128 + 2 * lane;
    if (PASS == 2) {
        if (DIR == 0) { for (int j = 0; j < c; ++j) { const f32x2 e = *(const f32x2*)(Ec + (size_t)j * 128); const float nr = qr * hr - qi * hi + e.x; hi = qr * hi + qi * hr + e.y; hr = nr; } }
        else { for (int j = S5NCH - 1; j > c; --j) { const f32x2 e = *(const f32x2*)(Ec + (size_t)j * 128); const float nr = qr * hr - qi * hi + e.x; hi = qr * hi + qi * hr + e.y; hr = nr; } }
    }
    const size_t rowbase = (size_t)b * SEQ + (size_t)c * S5CH;
    const bf16* up = h0 + (rowbase + (lane & 31)) * ABN + OFF_U + g * 16 + 8 * (lane >> 5);
    const f32x16 zero16 = {0.f, 0.f, 0.f, 0.f, 0.f, 0.f, 0.f, 0.f, 0.f, 0.f, 0.f, 0.f, 0.f, 0.f, 0.f, 0.f};
#pragma unroll 1
    for (int ti = 0; ti < S5CH / 32; ++ti) {
        const int tile = DIR == 0 ? ti : (S5CH / 32 - 1 - ti);
        const bf16x8 a = *(const bf16x8*)(up + (size_t)tile * 32 * ABN);
        f32x16 xr0 = MFMA32(a, bre0, zero16), xr1 = MFMA32(a, bre1, zero16), xi0 = MFMA32(a, bim0, zero16), xi1 = MFMA32(a, bim1, zero16);
        float xr[32], xi[32];
#pragma unroll
        for (int r = 0; r < 16; ++r) {
            auto s = __builtin_amdgcn_permlane32_swap(__float_as_uint(xr0[r]), __float_as_uint(xr1[r]), false, false);
            xr[crow(r, 0)] = __uint_as_float(s[0]); xr[crow(r, 1)] = __uint_as_float(s[1]);
            auto q = __builtin_amdgcn_permlane32_swap(__float_as_uint(xi0[r]), __float_as_uint(xi1[r]), false, false);
            xi[crow(r, 0)] = __uint_as_float(q[0]); xi[crow(r, 1)] = __uint_as_float(q[1]);
        }
#pragma unroll
        for (int tt = 0; tt < 32; ++tt) {
            const int t = DIR == 0 ? tt : 31 - tt;
            const float nr = ar * hr - ai * hi + xr[t]; hi = ar * hi + ai * hr + xi[t]; hr = nr;
            if (PASS == 2) *(LAS unsigned*)(hl + t * S5_HST + 4 * lane) = pk2(hr, hi);
        }
        if (PASS == 2) {
#pragma unroll
            for (int sub = 0; sub < 2; ++sub) {
                float* ys = yscr + (size_t)(tile * 2 + sub) * 256 + 4 * lane;
                f32x4 y = {0.f, 0.f, 0.f, 0.f};
                if (DIR == 1) y = *(const f32x4*)ys;
#pragma unroll
                for (int ks = 0; ks < 4; ++ks) { const bf16x8 hf = *(const LAS bf16x8*)(hl + (sub * 16 + (lane & 15)) * S5_HST + 64 * ks + 16 * (lane >> 4)); y = MFMA16(hf, cf[ks], y); }
                if (DIR == 0) *(f32x4*)ys = y;
                else {
                    const bf16x8 uf = *(const bf16x8*)(h0 + (rowbase + tile * 32 + sub * 16 + (lane & 15)) * ABN + OFF_U + g * 16 + 8 * ((lane >> 4) & 1));
                    y = MFMA16(uf, dfrag, y);
                    bf16* yo = (bf16*)(ws + WS_YG) + (rowbase + tile * 32 + sub * 16 + 4 * (lane >> 4)) * 512 + g * 16 + (lane & 15);
#pragma unroll
                    for (int r = 0; r < 4; ++r) yo[(size_t)r * 512] = (bf16)f2bf(gelu_tanh(y[r]));
                }
            }
        }
    }
    if (PASS == 1) { f32x2 e; e.x = hr; e.y = hi; *(f32x2*)(Ec + (size_t)c * 128) = e; }
}
template <int PASS>
__device__ __forceinline__ void s5_phase(unsigned char* ws, const float* s5d, LAS unsigned char* lds, int bid, int G, int wave, int lane) {
    LAS unsigned char* hl = lds + wave * (32 * S5_HST);
    float* yscr = (float*)(ws + WS_YSCR) + (size_t)(bid * NWAVES + wave) * 4096;
    for (int it = bid; it < NB * S5NCH * 4; it += G) {
        const int go = it & 3, c = (it >> 2) % S5NCH, b = it / (4 * S5NCH), g = go * 8 + wave;
        s5_dir<PASS, 0>(ws, s5d, b, g, c, hl, yscr, lane);
        s5_dir<PASS, 1>(ws, s5d, b, g, c, hl, yscr, lane);
    }
}
constexpr int G_ST = 144;
constexpr int GL_LRS = 0, GL_GSUM = 4096, GL_BC = 6144, GL_QD = 22784, GL_KD = GL_QD + 64 * G_ST, GL_KCT = GL_KD + 64 * G_ST, GL_VT = GL_KCT + 64 * G_ST,
              GL_S = GL_VT + 128 * G_ST, GL_ST = GL_S + 64 * G_ST, GL_END = GL_ST + 128 * G_ST;
static_assert(GL_END <= RING_BYTES, "GLA LDS");
__device__ __forceinline__ bf16x8 ldfrag32(const LAS unsigned char* base, int row0, int ks, int lane) {
    return *(const LAS bf16x8*)(base + (row0 + (lane & 31)) * G_ST + 32 * ks + 16 * (lane >> 5));
}
template <int PASS>
__device__ __forceinline__ void gla_item(unsigned char* ws, const float* gate_w, const float* gate_b, int item, LAS unsigned char* lds, int tid, int wave, int lane) {
    const int sc = item % GNSC, dir = (item / GNSC) & 1, h = (item / (GNSC * 2)) & 3, b = item / (GNSC * 8);
    const bf16* h0 = (const bf16*)(ws + WS_H0); const float* lrp = (const float*)(ws + WS_LR);
    LAS float* lrs = (LAS float*)(lds + GL_LRS); LAS float* gsum = (LAS float*)(lds + GL_GSUM); LAS float* bcs = (LAS float*)(lds + GL_BC);
    LAS unsigned char* QD = lds + GL_QD; LAS unsigned char* KD = lds + GL_KD; LAS unsigned char* KCT = lds + GL_KCT; LAS unsigned char* VT = lds + GL_VT; LAS unsigned char* SS = lds + GL_S; LAS unsigned char* STT = lds + GL_ST;
    float gw[16];
#pragma unroll
    for (int r = 0; r < 16; ++r) gw[r] = gate_w[(size_t)(dir * 16 + r) * 256 + h * 64 + lane];
    const float gb = gate_b[dir * 256 + h * 64 + lane];
    const int me = wave >> 1, nd = wave & 1;
    f32x16 st;
#pragma unroll
    for (int r = 0; r < 16; ++r) st[r] = 0.f;
    float dtot = 1.f;
    float* GS = (float*)(ws + WS_GS); float* GD = (float*)(ws + WS_GD);
    const int ibase = item - sc;
    if (PASS == 2) {
        for (int j = 0; j < sc; ++j) {
            const float dj = GD[(size_t)(ibase + j) * 64 + nd * 32 + (lane & 31)];
            const float* gs = GS + (size_t)(ibase + j) * 8192 + nd * 32 + (lane & 31);
#pragma unroll
            for (int r = 0; r < 16; ++r) st[r] = st[r] * dj + gs[(size_t)(me * 32 + crow(r, lane >> 5)) * 64];
        }
#pragma unroll
        for (int r = 0; r < 16; ++r) *(LAS bf16*)(STT + (me * 32 + crow(r, lane >> 5)) * G_ST + (nd * 32 + (lane & 31)) * 2) = (bf16)f2bf(st[r]);
    }
    const float qscale = 0.125f;
    const int s_l = lane;
    u32x4 pq, pk, pv0, pv1; f32x2 plr;
    auto tok_of = [&](int n, int s) { const int pos = (sc * GSC + n) * GCH + s; return (size_t)b * SEQ + (dir ? (SEQ - 1 - pos) : pos); };
#define GLA_LOAD(n) do { const size_t tk = tok_of((n), s_l); const bf16* rp = h0 + tk * ABN; \
        if (PASS == 2) pq = *(const u32x4*)(rp + OFF_Q + h * 64 + 8 * wave); \
        pk = *(const u32x4*)(rp + OFF_K + h * 64 + 8 * wave); pv0 = *(const u32x4*)(rp + OFF_V + h * 128 + 16 * wave); pv1 = *(const u32x4*)(rp + OFF_V + h * 128 + 16 * wave + 8); \
        plr = *(const f32x2*)(lrp + tk * 32 + dir * 16 + 2 * wave); } while (0)
    GLA_LOAD(0);
#pragma unroll 1
    for (int n = 0; n < GSC; ++n) {
        lrs[s_l * 16 + 2 * wave] = plr.x; lrs[s_l * 16 + 2 * wave + 1] = plr.y;
        __syncthreads();
        float la[8];
        { float run = 0.f;
#pragma unroll
          for (int i = 0; i < 8; ++i) { const int s = 8 * wave + i; float z = gb;
#pragma unroll
              for (int r = 0; r < 16; ++r) z += lrs[s * 16 + r] * gw[r];
              const float ls = fminf(z, 0.f) - log1pf(__expf(-fabsf(z)));
              run += ls * (1.0f / 16.0f); la[i] = run; }
          gsum[wave * 64 + lane] = run; }
        __syncthreads();
        { float off = 0.f;
#pragma unroll
          for (int w = 0; w < 8; ++w) off += (w < wave) ? gsum[w * 64 + lane] : 0.f;
#pragma unroll
          for (int i = 0; i < 8; ++i) bcs[(8 * wave + i) * 65 + lane] = la[i] + off; }
        __syncthreads();
        { float bc[8], bl[8];
#pragma unroll
          for (int i = 0; i < 8; ++i) { bc[i] = bcs[s_l * 65 + 8 * wave + i]; bl[i] = bcs[63 * 65 + 8 * wave + i]; }
          const float kv[8] = {bflo(pk.x), bfhi(pk.x), bflo(pk.y), bfhi(pk.y), bflo(pk.z), bfhi(pk.z), bflo(pk.w), bfhi(pk.w)};
          if (PASS == 2) {
              const float qv[8] = {bflo(pq.x), bfhi(pq.x), bflo(pq.y), bfhi(pq.y), bflo(pq.z), bfhi(pq.z), bflo(pq.w), bfhi(pq.w)};
              float qd[8], kd[8];
#pragma unroll
              for (int i = 0; i < 8; ++i) { qd[i] = qv[i] * qscale * __expf(bc[i]); kd[i] = kv[i] * __expf(-bc[i]); }
              u32x4 w; w.x = pk2(qd[0], qd[1]); w.y = pk2(qd[2], qd[3]); w.z = pk2(qd[4], qd[5]); w.w = pk2(qd[6], qd[7]);
              *(LAS u32x4*)(QD + s_l * G_ST + 16 * wave) = w;
              w.x = pk2(kd[0], kd[1]); w.y = pk2(kd[2], kd[3]); w.z = pk2(kd[4], kd[5]); w.w = pk2(kd[6], kd[7]);
              *(LAS u32x4*)(KD + s_l * G_ST + 16 * wave) = w;
          }
#pragma unroll
          for (int i = 0; i < 8; ++i) *(LAS bf16*)(KCT + (8 * wave + i) * G_ST + 2 * s_l) = (bf16)f2bf(kv[i] * __expf(bl[i] - bc[i]));
          const unsigned vv[8] = {pv0.x, pv0.y, pv0.z, pv0.w, pv1.x, pv1.y, pv1.z, pv1.w};
#pragma unroll
          for (int i = 0; i < 8; ++i) { *(LAS bf16*)(VT + (16 * wave + 2 * i) * G_ST + 2 * s_l) = (bf16)(vv[i] & 0xffffu); *(LAS bf16*)(VT + (16 * wave + 2 * i + 1) * G_ST + 2 * s_l) = (bf16)(vv[i] >> 16); }
        }
        const float dec = __expf(bcs[63 * 65 + nd * 32 + (lane & 31)]);
        if (n + 1 < GSC) GLA_LOAD(n + 1);
        __syncthreads();
        if (PASS == 2) {
            if (wave < 4) {
                const int ms = wave >> 1, ns = wave & 1;
                f32x16 sa;
#pragma unroll
                for (int r = 0; r < 16; ++r) sa[r] = 0.f;
                if (ns <= ms) {
#pragma unroll
                    for (int ks = 0; ks < 4; ++ks) sa = MFMA32(ldfrag32(QD, ms * 32, ks, lane), ldfrag32(KD, ns * 32, ks, lane), sa);
                }
#pragma unroll
                for (int r = 0; r < 16; ++r) { const int s = ms * 32 + crow(r, lane >> 5), s2 = ns * 32 + (lane & 31);
                    const bool keep = dir ? (s2 < s) : (s2 <= s);
                    *(LAS bf16*)(SS + s * G_ST + 2 * s2) = (bf16)f2bf(keep ? sa[r] : 0.f); }
            }
            __syncthreads();
            { const int ms = wave >> 2, ne = wave & 3;
              f32x16 oa;
#pragma unroll
              for (int r = 0; r < 16; ++r) oa[r] = 0.f;
#pragma unroll
              for (int ks = 0; ks < 4; ++ks) oa = MFMA32(ldfrag32(SS, ms * 32, ks, lane), ldfrag32(VT, ne * 32, ks, lane), oa);
#pragma unroll
              for (int ks = 0; ks < 4; ++ks) oa = MFMA32(ldfrag32(QD, ms * 32, ks, lane), ldfrag32(STT, ne * 32, ks, lane), oa);
              float* op = (float*)(ws + (dir ? WS_OB : WS_OF));
#pragma unroll
              for (int r = 0; r < 16; ++r) { const size_t tk = tok_of(n, ms * 32 + crow(r, lane >> 5)); op[tk * 512 + h * 128 + ne * 32 + (lane & 31)] = oa[r]; }
            }
            __syncthreads();
        }
#pragma unroll
        for (int r = 0; r < 16; ++r) st[r] *= dec;
        dtot *= dec;
#pragma unroll
        for (int ks = 0; ks < 4; ++ks) st = MFMA32(ldfrag32(VT, me * 32, ks, lane), ldfrag32(KCT, nd * 32, ks, lane), st);
        if (PASS == 2 && n + 1 < GSC) {
#pragma unroll
            for (int r = 0; r < 16; ++r) *(LAS bf16*)(STT + (me * 32 + crow(r, lane >> 5)) * G_ST + (nd * 32 + (lane & 31)) * 2) = (bf16)f2bf(st[r]);
        }
    }
    if (PASS == 1) {
        float* gs = GS + (size_t)item * 8192 + nd * 32 + (lane & 31);
#pragma unroll
        for (int r = 0; r < 16; ++r) gs[(size_t)(me * 32 + crow(r, lane >> 5)) * 64] = st[r];
        if (me == 0 && lane < 32) GD[(size_t)item * 64 + nd * 32 + lane] = dtot;
    }
    __syncthreads();
#undef GLA_LOAD
}
constexpr int AT_KST = 144, AT_VST = 656, AT_K = 0, AT_V = 320 * AT_KST, AT_BT = AT_V + 64 * AT_VST, AT_END = AT_BT + 4 * 260 * 4;
static_assert(AT_END <= RING_BYTES && AT_V % 16 == 0 && AT_BT % 16 == 0, "attention LDS");
__device__ __forceinline__ void attn_phase(unsigned char* ws, const float* sink, LAS unsigned char* lds, int bid, int G, int tid, int wave, int lane) {
    const bf16* qkv = (const bf16*)(ws + WS_QKV); bf16* ao = (bf16*)(ws + WS_AO); const float* btab = (const float*)(ws + WS_BTAB);
    LAS unsigned char* KS = lds + AT_K; LAS unsigned char* VT = lds + AT_V; LAS float* BT = (LAS float*)(lds + AT_BT);
    const float sc2 = 0.125f * LOG2E;
    for (int u = bid; u < NB * 4 * (SEQ / 64); u += G) {
        const int qb = u % (SEQ / 64), kvh = (u / (SEQ / 64)) & 3, b = u / (4 * (SEQ / 64)), q0 = qb * 64, kbase = q0 - 128;
        for (int p = tid; p < 320 * 8; p += NTHR) {
            const int i = p >> 3, ch = p & 7; int key = kbase + i; key = key < 0 ? 0 : (key > SEQ - 1 ? SEQ - 1 : key);
            const u32x4 kq = *(const u32x4*)(qkv + ((size_t)b * SEQ + key) * CN + 1024 + kvh * 64 + 8 * ch);
            *(LAS u32x4*)(KS + i * AT_KST + 16 * ch) = kq;
        }
        for (int p = tid; p < 320 * 8; p += NTHR) {
            const int i = p % 320, ch = p / 320; int key = kbase + i; key = key < 0 ? 0 : (key > SEQ - 1 ? SEQ - 1 : key);
            const u32x4 vq = *(const u32x4*)(qkv + ((size_t)b * SEQ + key) * CN + 1280 + kvh * 64 + 8 * ch);
            const unsigned vv[4] = {vq.x, vq.y, vq.z, vq.w};
#pragma unroll
            for (int j = 0; j < 4; ++j) { *(LAS bf16*)(VT + (8 * ch + 2 * j) * AT_VST + 2 * i) = (bf16)(vv[j] & 0xffffu); *(LAS bf16*)(VT + (8 * ch + 2 * j + 1) * AT_VST + 2 * i) = (bf16)(vv[j] >> 16); }
        }
        for (int p = tid; p < 4 * 260; p += NTHR) BT[p] = btab[(kvh * 4) * 260 + p];
        __syncthreads();
        const int hl = wave >> 1, hq = kvh * 4 + hl, qw = q0 + 32 * (wave & 1), qi = qw + (lane & 31), hh = lane >> 5;
        bf16x8 qf[4];
        { const bf16* qp = qkv + ((size_t)b * SEQ + qi) * CN + hq * 64 + 8 * hh;
#pragma unroll
          for (int ks = 0; ks < 4; ++ks) qf[ks] = *(const bf16x8*)(qp + 16 * ks); }
        float m = sink[hq] * LOG2E, l = hh == 0 ? 1.f : 0.f;
        f32x16 o0, o1;
#pragma unroll
        for (int r = 0; r < 16; ++r) { o0[r] = 0.f; o1[r] = 0.f; }
        const LAS float* btr = BT + hl * 260 + 128 - (lane & 31);
#pragma unroll 1
        for (int j = 0; j < 9; ++j) {
            const int i0 = 32 * (wave & 1) + 32 * j;
            f32x16 sa;
#pragma unroll
            for (int r = 0; r < 16; ++r) sa[r] = 0.f;
#pragma unroll
            for (int ks = 0; ks < 4; ++ks) { const bf16x8 kf = *(const LAS bf16x8*)(KS + (i0 + (lane & 31)) * AT_KST + 32 * ks + 16 * hh); sa = MFMA32(kf, qf[ks], sa); }
            float mx = -3.0e38f;
#pragma unroll
            for (int r = 0; r < 16; ++r) {
                const int kk = 32 * j - 128 + crow(r, hh);
                const int rel = kk - (lane & 31), key = qw + kk;
                const bool ok = (rel >= -128) && (rel <= 128) && (key >= 0) && (key < SEQ);
                const float s = ok ? (sa[r] * sc2 + btr[kk]) : -3.0e38f;
                sa[r] = s; mx = fmaxf(mx, s);
            }
            mx = fmaxf(mx, __shfl_xor(mx, 32));
            const float mn = fmaxf(m, mx), alpha = exp2f(m - mn); m = mn;
            float ps = 0.f;
#pragma unroll
            for (int r = 0; r < 16; ++r) { const float p = exp2f(sa[r] - mn); sa[r] = p; ps += p; }
            l = l * alpha + ps;
#pragma unroll
            for (int r = 0; r < 16; ++r) { o0[r] *= alpha; o1[r] *= alpha; }
#pragma unroll
            for (int s = 0; s < 2; ++s) {
                u32x4 pw; pw.x = pk2(sa[8 * s], sa[8 * s + 1]); pw.y = pk2(sa[8 * s + 2], sa[8 * s + 3]); pw.z = pk2(sa[8 * s + 4], sa[8 * s + 5]); pw.w = pk2(sa[8 * s + 6], sa[8 * s + 7]);
                const bf16x8 pf = __builtin_bit_cast(bf16x8, pw);
#pragma unroll
                for (int dt = 0; dt < 2; ++dt) {
                    const LAS unsigned char* vp = VT + (dt * 32 + (lane & 31)) * AT_VST + 2 * (i0 + 16 * s + 4 * hh);
                    const bf16x4 va = *(const LAS bf16x4*)vp, vb = *(const LAS bf16x4*)(vp + 16);
                    const bf16x8 vf = __builtin_shufflevector(va, vb, 0, 1, 2, 3, 4, 5, 6, 7);
                    if (dt == 0) o0 = MFMA32(vf, pf, o0); else o1 = MFMA32(vf, pf, o1);
                }
            }
        }
        l += __shfl_xor(l, 32);
        const float inv = 1.f / l;
        bf16* op = ao + ((size_t)b * SEQ + qi) * D + hq * 64 + 4 * hh;
#pragma unroll
        for (int g = 0; g < 4; ++g) {
            u32x2 w0, w1; w0.x = pk2(o0[4 * g] * inv, o0[4 * g + 1] * inv); w0.y = pk2(o0[4 * g + 2] * inv, o0[4 * g + 3] * inv);
            w1.x = pk2(o1[4 * g] * inv, o1[4 * g + 1] * inv); w1.y = pk2(o1[4 * g + 2] * inv, o1[4 * g + 3] * inv);
            *(u32x2*)(op + 8 * g) = w0; *(u32x2*)(op + 32 + 8 * g) = w1;
        }
        __syncthreads();
    }
}
#ifndef MK_N_LAUNCHES
#define MK_N_LAUNCHES 1
#endif
constexpr int N_PHASES = 19;
#ifndef PH_MASK
#define PH_MASK 0xFFFFFFFFu
#endif
#define ON(k) (((PH_MASK) >> (k)) & 1u)

template <int LAYER>
__device__ __forceinline__ void common_phases(unsigned char* ws, LAS unsigned char* lds, float* dout, const XcdBarrier& bar, int lo, int hi, int bid, int G, int tid, int wave, int lane) {
    constexpr int pb = LAYER == 0 ? 5 : 13;
    const int gw = bid * NWAVES + wave, NGW = G * NWAVES;
#define IN(k) (lo <= (k) && (k) < hi)
#define SEAM(k) do { if (IN(k) && IN((k) + 1)) xcd_barrier(bar); } while (0)
    if (ON(5) && IN(pb)) {
        pg8::Gemm g{(const bf16*)(ws + (LAYER == 0 ? WS_X64 : WS_AO)), (const bf16*)(ws + (LAYER == 0 ? WS_WOUT : WS_COUT)), T, D, D, 0, nullptr}; pg8::StaticOrder S; S.init(T, D, G, bid);
        pg8::EpiResid E{LAYER == 0 ? inp(lds, I_X) : (const float*)(ws + WS_H1), (float*)(ws + WS_Z), D, ALPHA};
        pg8::gemm_phase<pg8::EpiResid, pg8::StaticOrder, false>(lds, g, S, E);
    }
    SEAM(pb);
    if (ON(6) && IN(pb + 1)) { ln_router(ws, inp(lds, I_LNMG) + LAYER * D, inp(lds, I_LNMB) + LAYER * D, inp(lds, I_BGRP) + LAYER * 4, inp(lds, I_BRT) + LAYER * 32, LAYER, lds, bid, G, tid, wave, lane); __syncthreads(); }
    SEAM(pb + 1);
    if (ON(7) && IN(pb + 2)) { moe_sort(ws, lds, bid, G, tid); __syncthreads(); }
    SEAM(pb + 2);
    if (ON(8) && IN(pb + 3)) {
        const int* tile = (const int*)(ws + WS_TILE); const int ntiles = __builtin_amdgcn_readfirstlane(tile[511]);
        pg8::Gemm g{(const bf16*)(ws + WS_X64), (const bf16*)(ws + WS_W13), 0, D, D, (size_t)D * D * 2, (const int*)(ws + WS_SLOTT)};
        pg8::GroupOrder S{tile, ntiles, D / 256, G, bid};
        pg8::EpiSwiglu E{(bf16*)(ws + WS_HID), DEXP};
        pg8::gemm_phase<pg8::EpiSwiglu, pg8::GroupOrder, true>(lds, g, S, E);
    }
    SEAM(pb + 3);
    if (ON(9) && IN(pb + 4)) {
        const int* tile = (const int*)(ws + WS_TILE); const int ntiles = __builtin_amdgcn_readfirstlane(tile[511]);
        pg8::Gemm g{(const bf16*)(ws + WS_HID), (const bf16*)(ws + WS_W2), 0, D, DEXP, (size_t)D * DEXP * 2, nullptr};
        pg8::GroupOrder S{tile, ntiles, D / 256, G, bid};
        pg8::EpiScale E{(bf16*)(ws + WS_Y2), D, (const float*)(ws + WS_SLOTW)};
        pg8::gemm_phase<pg8::EpiScale, pg8::GroupOrder, false>(lds, g, S, E);
    }
    SEAM(pb + 4);
    if (ON(10) && IN(pb + 5)) {
        if (LAYER == 0) {
            combine_ln<false>(ws, inp(lds, I_LNFG), inp(lds, I_LNFB), nullptr, gw, NGW, lane);
            moe_convert(inp(lds, I_W1) + (size_t)NEXP * D * DEXP, inp(lds, I_W3) + (size_t)NEXP * D * DEXP, inp(lds, I_W2) + (size_t)NEXP * DEXP * D, (bf16*)(ws + WS_W13), (bf16*)(ws + WS_W2), (LAS float*)(lds + wave * 16384), gw, NGW, lane);
            __syncthreads();
        } else combine_ln<true>(ws, inp(lds, I_LNFG) + D, inp(lds, I_LNFB) + D, dout, gw, NGW, lane);
    }
    if (LAYER == 0) SEAM(10);
#undef IN
#undef SEAM
}

struct Args { const float* in[N_IN]; float* out; unsigned char* ws; int ph_lo, ph_hi; };
static_assert(sizeof(Args) == N_IN * 8 + 8 + 8 + 8, "no padding holes in Args");

__global__ void __launch_bounds__(NTHR, 2) fwd_kernel(Args args) {
    extern __shared__ __attribute__((aligned(16))) unsigned char lds_raw[];
    LAS unsigned char* lds = (LAS unsigned char*)lds_raw;
    volatile LAS unsigned* MISC = (volatile LAS unsigned*)(lds + MISC_OFF);
    const int tid = threadIdx.x, lane = tid & 63, wave = __builtin_amdgcn_readfirstlane(tid >> 6), G = gridDim.x, bid = blockIdx.x;
    unsigned char* ws = args.ws;
    for (int u = tid; u < 64; u += NTHR) MISC[u] = 0u;
    if (tid < N_IN) *(LAS unsigned long long*)(lds + PTR_OFF + 8 * tid) = (unsigned long long)args.in[tid];
    __syncthreads();
    const int lo = args.ph_lo, hi = args.ph_hi;
    const bool use_bar = (hi - lo) > 1;
    XcdBarrier bar; bar.bar = (unsigned*)(ws + WS_CTL) + CW_BAR; bar.x = 0; bar.st = nullptr;
    if (use_bar) bar = xcd_barrier_post((unsigned*)(ws + WS_CTL) + CW_BAR, MISC + 8);
#define IN(k) (lo <= (k) && (k) < hi)
#define SEAM(k) do { if (IN(k) && IN((k) + 1)) xcd_barrier(bar); } while (0)
    const int gw = bid * NWAVES + wave, NGW = G * NWAVES;

    if (ON(0) && IN(0)) { p0_prologue(ws, lds, bid, G, tid, wave, lane); __syncthreads(); }
    SEAM(0);
    if (ON(1) && IN(1)) {
        pg8::Gemm g{(const bf16*)(ws + WS_X64), (const bf16*)(ws + WS_WIN), T, ABN, D, 0, nullptr}; pg8::StaticOrder S; S.init(T, ABN, G, bid);
        pg8::EpiBf16 E{(bf16*)(ws + WS_H0), ABN};
        pg8::gemm_phase<pg8::EpiBf16, pg8::StaticOrder, false>(lds, g, S, E);
        lr_tail(ws, bid, G, wave, lane);
    }
    SEAM(1);
    if (ON(2) && IN(2)) {
        s5_phase<1>(ws, inp(lds, I_S5D), lds, bid, G, wave, lane);
        __syncthreads();
        for (int it = bid; it < 256; it += G) gla_item<1>(ws, inp(lds, I_GATEW), inp(lds, I_GATEB), it, lds, tid, wave, lane);
    }
    SEAM(2);
    if (ON(3) && IN(3)) {
        s5_phase<2>(ws, inp(lds, I_S5D), lds, bid, G, wave, lane);
        __syncthreads();
        for (int it = bid; it < 256; it += G) gla_item<2>(ws, inp(lds, I_GATEW), inp(lds, I_GATEB), it, lds, tid, wave, lane);
    }
    SEAM(3);
    if (ON(4) && IN(4)) {
        gla_finalize(ws, inp(lds, I_NORMG), gw, NGW, lane);
        pg8::Gemm g{(const bf16*)(ws + WS_YG), (const bf16*)(ws + WS_WGLU), T, 512, 512, 0, nullptr}; pg8::StaticOrder S; S.init(T, 512, G, bid);
        pg8::EpiGlu E{(const bf16*)(ws + WS_YG), 512, (bf16*)(ws + WS_X64), D, inp(lds, I_GLUB)};
        pg8::gemm_phase<pg8::EpiGlu, pg8::StaticOrder, false>(lds, g, S, E);
    }
    SEAM(4);
    common_phases<0>(ws, lds, args.out, bar, lo, hi, bid, G, tid, wave, lane);
    if (ON(11) && IN(11)) {
        pg8::Gemm g{(const bf16*)(ws + WS_H2B), (const bf16*)(ws + WS_CIN), T, CN, D, 0, nullptr}; pg8::StaticOrder S; S.init(T, CN, G, bid);
        pg8::EpiBf16 E{(bf16*)(ws + WS_QKV), CN};
        pg8::gemm_phase<pg8::EpiBf16, pg8::StaticOrder, false>(lds, g, S, E);
    }
    SEAM(11);
    if (ON(12) && IN(12)) attn_phase(ws, inp(lds, I_SINK), lds, bid, G, tid, wave, lane);
    SEAM(12);
    common_phases<1>(ws, lds, args.out, bar, lo, hi, bid, G, tid, wave, lane);
#undef IN
#undef SEAM
}

extern "C" void kernel_launch(void* const* d_in, const int* in_sizes, int n_in, void* d_out, int out_size, void* d_ws, size_t ws_size, hipStream_t stream) {
    static int grid = 0;
    if (grid == 0) {
        if (n_in != N_IN || in_sizes[0] != T * D || out_size != T * D || ws_size < WS_END) { fprintf(stderr, "kernel_launch: unexpected shapes (n_in %d, in0 %d, out %d, ws %zu < %zu)\n", n_in, n_in > 0 ? in_sizes[0] : -1, out_size, ws_size, (size_t)WS_END); grid = -1; return; }
        int dev = 0, cus = 0, per_cu = 0;
        if (hipGetDevice(&dev) != hipSuccess || hipDeviceGetAttribute(&cus, hipDeviceAttributeMultiprocessorCount, dev) != hipSuccess) { grid = -1; return; }
        if (hipFuncSetAttribute((const void*)fwd_kernel, hipFuncAttributeMaxDynamicSharedMemorySize, LDS_BYTES) != hipSuccess) { fprintf(stderr, "kernel_launch: hipFuncSetAttribute failed\n"); grid = -1; return; }
        if (hipOccupancyMaxActiveBlocksPerMultiprocessor(&per_cu, (const void*)fwd_kernel, NTHR, LDS_BYTES) != hipSuccess || per_cu < 1) fprintf(stderr, "kernel_launch: occupancy query reports %d\n", per_cu);
        (void)hipGetLastError();
        grid = cus;
    }
    if (grid < 0) return;
    if (hipMemsetAsync((char*)d_ws + WS_CTL, 0, CTL_ZERO_BYTES, stream) != hipSuccess) return;
    Args a{};
    for (int i = 0; i < N_IN; ++i) a.in[i] = (const float*)d_in[i];
    a.out = (float*)d_out; a.ws = (unsigned char*)d_ws;
    for (int li = 0; li < MK_N_LAUNCHES; ++li) {
        a.ph_lo = (MK_N_LAUNCHES == 1) ? 0 : li; a.ph_hi = (MK_N_LAUNCHES == 1) ? N_PHASES : li + 1;
        hipLaunchKernelGGL(fwd_kernel, dim3(grid), dim3(NTHR), LDS_BYTES, stream, a);
    }
}
```

```cpp
#include <hip/hip_runtime.h>
#include <cstdio>
#include <cstdint>
#include <cmath>
namespace pg8 {
#define PG8_LAS __attribute__((address_space(3)))
typedef unsigned short bf16_t;
typedef short bf16x8 __attribute__((ext_vector_type(8)));
typedef float f32x4 __attribute__((ext_vector_type(4)));
typedef float f32x2 __attribute__((ext_vector_type(2)));
typedef unsigned u32x4 __attribute__((ext_vector_type(4)));
typedef unsigned u32x2 __attribute__((ext_vector_type(2)));
constexpr int BM = 256, BK = 64, HALF = 128, HTB = HALF * BK * 2  , STAGE_BYTES = 8 * HTB, NXCD = 8, WGM = 8;

__host__ __device__ __forceinline__ int lds_byte(int r, int c) { const int st = (r >> 4) * 2 + (c >> 5), rr = r & 15, cc = c & 31, ob = rr * 64 + cc * 2; return st * 1024 + (ob ^ (((ob >> 9) & 1) << 5)); }
__host__ __device__ __forceinline__ void stage_rc(int b, int& R, int& C) { const int st = b / 1024, sb = b % 1024, swz = sb ^ (((sb >> 9) & 1) << 5); R = (st >> 1) * 16 + swz / 64; C = (st & 1) * 32 + (swz % 64) / 2; }
__host__ __device__ __forceinline__ int perm32(int rho) { const int n = rho >> 4, i = rho & 15; return 8 * (i >> 2) + 4 * n + (i & 3); }

struct Unit { int pm, pn, e; };
struct Gemm { const bf16_t* A; const bf16_t* Bt; int M, N, K; size_t bstride; const int* rowmap; };

struct StaticOrder {
    int nM, nN, nwg, G, c;
    __host__ __device__ void init(int M, int N, int G_, int c_) { nM = M / BM; nN = N / BM; nwg = nM * nN; G = G_; c = c_; }
    __host__ __device__ bool next(int i, Unit& u) const {
        const long L = (long)i * G + c; if (L >= nwg) return false;
        int wgid = (int)L; { const int q = nwg / NXCD, r = nwg % NXCD, xcd = wgid % NXCD, off = wgid / NXCD; wgid = (xcd < r ? xcd * (q + 1) : r * (q + 1) + (xcd - r) * q) + off; }
        const int nig = WGM * nN, gid = wgid / nig, fm = gid * WGM, gsz = (nM - fm) < WGM ? (nM - fm) : WGM;
        u.pm = fm + ((wgid % nig) % gsz); u.pn = (wgid % nig) / gsz; u.e = 0; return true;
    }
};
struct GroupOrder {
    const int* tile_e; int ntiles, nN, G, c;
    __device__ bool next(int i, Unit& u) const {
        const int L = i * G + c; if (L >= ntiles * nN) return false;
        u.pm = L / nN; u.pn = L % nN; u.e = __builtin_amdgcn_readfirstlane(tile_e[u.pm]); return true;
    }
};

typedef __bf16 bf16x2_t __attribute__((ext_vector_type(2)));
__device__ __forceinline__ unsigned cvt_pk_bf16(float lo, float hi) { f32x2 v = {lo, hi}; return __builtin_bit_cast(unsigned, __builtin_convertvector(v, bf16x2_t)); }
__device__ __forceinline__ float bf_lo(unsigned w) { return __uint_as_float(w << 16); }
__device__ __forceinline__ float bf_hi(unsigned w) { return __uint_as_float(w & 0xffff0000u); }

struct EpiBf16 {
    static constexpr bool PERM = true;
    bf16_t* O; int ldc;
    __device__ __forceinline__ void operator()(const f32x4 (&acc)[2][2][4][2], const Unit& u, int wr, int wc, int fr, int fq) const {
        const int row0 = u.pm * BM + wr * 64 + fr; const int col0 = u.pn * BM + wc * 32 + 8 * fq;
#pragma unroll
        for (int ai = 0; ai < 2; ++ai)
#pragma unroll
            for (int m = 0; m < 4; ++m) { bf16_t* rowp = O + (size_t)(row0 + ai * HALF + m * 16) * ldc + col0;
#pragma unroll
                for (int bj = 0; bj < 2; ++bj) { const f32x4 v0 = acc[ai][bj][m][0], v1 = acc[ai][bj][m][1];
                    u32x4 w; w.x = cvt_pk_bf16(v0[0], v0[1]); w.y = cvt_pk_bf16(v0[2], v0[3]); w.z = cvt_pk_bf16(v1[0], v1[1]); w.w = cvt_pk_bf16(v1[2], v1[3]);
                    *(u32x4*)(rowp + bj * HALF) = w; } }
    }
};
struct EpiGlu {
    static constexpr bool PERM = true;
    const bf16_t* Y; int ldy; bf16_t* O; int ldc; const float* bias;
    __device__ __forceinline__ void operator()(const f32x4 (&acc)[2][2][4][2], const Unit& u, int wr, int wc, int fr, int fq) const {
        const int row0 = u.pm * BM + wr * 64 + fr; const int col0 = u.pn * BM + wc * 32 + 8 * fq;
        f32x4 bv[2][2];
#pragma unroll
        for (int bj = 0; bj < 2; ++bj)
#pragma unroll
            for (int n = 0; n < 2; ++n) bv[bj][n] = *(const f32x4*)(bias + col0 + bj * HALF + 4 * n);
#pragma unroll
        for (int ai = 0; ai < 2; ++ai)
#pragma unroll
            for (int m = 0; m < 4; ++m) { const size_t r = (size_t)(row0 + ai * HALF + m * 16);
#pragma unroll
                for (int bj = 0; bj < 2; ++bj) { const f32x4 v0 = acc[ai][bj][m][0] + bv[bj][0], v1 = acc[ai][bj][m][1] + bv[bj][1];
                    const u32x4 y = *(const u32x4*)(Y + r * ldy + col0 + bj * HALF);
                    float o[8]; const float yv[8] = {bf_lo(y.x), bf_hi(y.x), bf_lo(y.y), bf_hi(y.y), bf_lo(y.z), bf_hi(y.z), bf_lo(y.w), bf_hi(y.w)};
#pragma unroll
                    for (int i = 0; i < 4; ++i) { o[i] = yv[i] / (1.f + __expf(-v0[i])); o[4 + i] = yv[4 + i] / (1.f + __expf(-v1[i])); }
                    u32x4 w; w.x = cvt_pk_bf16(o[0], o[1]); w.y = cvt_pk_bf16(o[2], o[3]); w.z = cvt_pk_bf16(o[4], o[5]); w.w = cvt_pk_bf16(o[6], o[7]);
                    *(u32x4*)(O + r * ldc + col0 + bj * HALF) = w; } }
    }
};
struct EpiResid {
    static constexpr bool PERM = false;
    const float* resid; float* out; int ldc; float alpha;
    __device__ __forceinline__ void operator()(const f32x4 (&acc)[2][2][4][2], const Unit& u, int wr, int wc, int fr, int fq) const {
        const int col0 = u.pn * BM + wc * 32 + 4 * fq;
#pragma unroll
        for (int ai = 0; ai < 2; ++ai)
#pragma unroll
            for (int m = 0; m < 4; ++m) { const size_t off = (size_t)(u.pm * BM + ai * HALF + wr * 64 + m * 16 + fr) * ldc + col0;
#pragma unroll
                for (int bj = 0; bj < 2; ++bj)
#pragma unroll
                    for (int n = 0; n < 2; ++n) { const f32x4 bs = *(const f32x4*)(resid + off + bj * HALF + n * 16);
                        *(f32x4*)(out + off + bj * HALF + n * 16) = bs * alpha + acc[ai][bj][m][n]; } }
    }
};
struct EpiSwiglu {
    static constexpr bool PERM = true;
    bf16_t* O; int ldc;
    __device__ __forceinline__ void operator()(const f32x4 (&acc)[2][2][4][2], const Unit& u, int wr, int wc, int fr, int fq) const {
        const int row0 = u.pm * BM + wr * 64 + fr; const int col0 = (u.pn * BM + wc * 32 + 8 * fq) >> 1;
#pragma unroll
        for (int ai = 0; ai < 2; ++ai)
#pragma unroll
            for (int m = 0; m < 4; ++m) { bf16_t* rowp = O + (size_t)(row0 + ai * HALF + m * 16) * ldc + col0;
#pragma unroll
                for (int bj = 0; bj < 2; ++bj) { const f32x4 g = acc[ai][bj][m][0], up = acc[ai][bj][m][1]; float o[4];
#pragma unroll
                    for (int i = 0; i < 4; ++i) o[i] = g[i] / (1.f + __expf(-g[i])) * up[i];
                    u32x2 w; w.x = cvt_pk_bf16(o[0], o[1]); w.y = cvt_pk_bf16(o[2], o[3]);
                    *(u32x2*)(rowp + bj * (HALF / 2)) = w; } }
    }
};
struct EpiScale {
    static constexpr bool PERM = true;
    bf16_t* O; int ldc; const float* rw;
    __device__ __forceinline__ void operator()(const f32x4 (&acc)[2][2][4][2], const Unit& u, int wr, int wc, int fr, int fq) const {
        const int row0 = u.pm * BM + wr * 64 + fr; const int col0 = u.pn * BM + wc * 32 + 8 * fq;
#pragma unroll
        for (int ai = 0; ai < 2; ++ai)
#pragma unroll
            for (int m = 0; m < 4; ++m) { const int r = row0 + ai * HALF + m * 16; const float s = rw[r]; bf16_t* rowp = O + (size_t)r * ldc + col0;
#pragma unroll
                for (int bj = 0; bj < 2; ++bj) { const f32x4 v0 = acc[ai][bj][m][0] * s, v1 = acc[ai][bj][m][1] * s;
                    u32x4 w; w.x = cvt_pk_bf16(v0[0], v0[1]); w.y = cvt_pk_bf16(v0[2], v0[3]); w.z = cvt_pk_bf16(v1[0], v1[1]); w.w = cvt_pk_bf16(v1[2], v1[3]);
                    *(u32x4*)(rowp + bj * HALF) = w; } }
    }
};

template <class Epi, class Sched, bool GATHER>
__device__ __forceinline__ void gemm_phase(PG8_LAS unsigned char* lds, const Gemm g, const Sched& S, const Epi& E) {
    const int tid = threadIdx.x, wid = __builtin_amdgcn_readfirstlane(tid >> 6), lane = tid & 63, wr = wid >> 2, wc = wid & 3, fr = lane & 15, fq = lane >> 4;
    const int K = g.K, nt = K / BK;
    unsigned voffA[2], voffB[2]; int RA[2], CA[2];
#pragma unroll
    for (int i = 0; i < 2; ++i) { int R, C; stage_rc(tid * 16 + i * 8192, R, C); const int Rb = Epi::PERM ? ((R & ~31) + perm32(R & 31)) : R;
        voffA[i] = (unsigned)(R * K + C) * 2u; voffB[i] = (unsigned)(Rb * K + C) * 2u; RA[i] = R; CA[i] = C; }
    const size_t kstep = (size_t)(BK * 2);
    const size_t hstep = (size_t)HALF * K * 2;
    const size_t tstep = 2 * hstep;
    const unsigned ldsw = (unsigned)wid * 1024u;
    const int aoff = lds_byte(wr * 64 + fr, fq * 8), boff = lds_byte(wc * 32 + fr, fq * 8);
#define PG8_SA(b, h) (((b) * 2 + (h)) * HTB)
#define PG8_SB(b, h) ((4 + (b) * 2 + (h)) * HTB)
#define PG8_STAGE(bufoff, gbase, voff) do { _Pragma("unroll") for (int _i = 0; _i < 2; ++_i) \
        __builtin_amdgcn_global_load_lds((const unsigned*)((const char*)(gbase) + (voff)[_i]), (PG8_LAS unsigned*)(lds + (bufoff) + ldsw + _i * 8192), 16, 0, 0); } while (0)
#define PG8_LDA(dst, b, h) do { _Pragma("unroll") for (int m = 0; m < 4; ++m) _Pragma("unroll") for (int k = 0; k < 2; ++k) dst[m][k] = *(const PG8_LAS bf16x8*)(lds + PG8_SA(b, h) + aoff + m * 2048 + k * 1024); } while (0)
#define PG8_LDB(dst, b, h) do { _Pragma("unroll") for (int n = 0; n < 2; ++n) _Pragma("unroll") for (int k = 0; k < 2; ++k) dst[n][k] = *(const PG8_LAS bf16x8*)(lds + PG8_SB(b, h) + boff + n * 2048 + k * 1024); } while (0)
#define PG8_MMA(ai, bj, At, Bt) do { __builtin_amdgcn_s_setprio(1); _Pragma("unroll") for (int m = 0; m < 4; ++m) _Pragma("unroll") for (int n = 0; n < 2; ++n) _Pragma("unroll") for (int k = 0; k < 2; ++k) \
        acc[ai][bj][m][n] = __builtin_amdgcn_mfma_f32_16x16x32_bf16(Bt[n][k], At[m][k], acc[ai][bj][m][n], 0, 0, 0); __builtin_amdgcn_s_setprio(0); } while (0)
#define PG8_WAIT_V(n) asm volatile("s_waitcnt vmcnt(" #n ")" ::: "memory")
#define PG8_WAIT_L(n) asm volatile("s_waitcnt lgkmcnt(" #n ")" ::: "memory")
#define PG8_BAR __builtin_amdgcn_s_barrier()
#define PG8_SCHED __builtin_amdgcn_sched_barrier(0)
    Unit cur, nxt; int ui = 0;
    if (!S.next(0, cur)) return;
    f32x4 acc[2][2][4][2];
#pragma unroll
    for (int a = 0; a < 2; ++a)
#pragma unroll
        for (int b = 0; b < 2; ++b)
#pragma unroll
            for (int m = 0; m < 4; ++m)
#pragma unroll
                for (int n = 0; n < 2; ++n) acc[a][b][m][n] = (f32x4){0.f, 0.f, 0.f, 0.f};
    bf16x8 At[4][2], B0[2][2], B1[2][2];
    unsigned cG[2][2], nG[2][2];
#define PG8_LOAD_ROWS(u_, G2_) do { _Pragma("unroll") for (int h_ = 0; h_ < 2; ++h_) _Pragma("unroll") for (int i_ = 0; i_ < 2; ++i_) \
        G2_[h_][i_] = GATHER ? ((unsigned)g.rowmap[(u_).pm * BM + h_ * HALF + RA[i_]] * (unsigned)K + (unsigned)CA[i_]) * 2u : voffA[i_]; } while (0)
    const char* cA = GATHER ? (const char*)g.A : (const char*)g.A + (size_t)cur.pm * tstep;
    const size_t hA = GATHER ? 0 : hstep;
    const char* cB = (const char*)g.Bt + (size_t)cur.e * g.bstride + (size_t)cur.pn * tstep;
    PG8_LOAD_ROWS(cur, cG);
    PG8_STAGE(PG8_SB(0, 0), cB, voffB); PG8_STAGE(PG8_SB(0, 1), cB + hstep, voffB); PG8_STAGE(PG8_SA(0, 0), cA, cG[0]); PG8_STAGE(PG8_SA(0, 1), cA + hA, cG[1]);
    if (wr == 1) PG8_BAR;
    PG8_WAIT_V(2); PG8_BAR;
    PG8_STAGE(PG8_SB(1, 0), cB + kstep, voffB); PG8_STAGE(PG8_SA(1, 0), cA + kstep, cG[0]); PG8_STAGE(PG8_SB(1, 1), cB + hstep + kstep, voffB);
    PG8_WAIT_V(6); PG8_BAR;
    for (;;) {
        const bool has_next = S.next(ui + 1, nxt);
        const char* nA = GATHER ? (const char*)g.A : (has_next ? (const char*)g.A + (size_t)nxt.pm * tstep : cA);
        const char* nB = has_next ? (const char*)g.Bt + (size_t)nxt.e * g.bstride + (size_t)nxt.pn * tstep : cB;
        if (has_next) PG8_LOAD_ROWS(nxt, nG); else {
#pragma unroll
            for (int h = 0; h < 2; ++h) { nG[h][0] = cG[h][0]; nG[h][1] = cG[h][1]; } }
        for (int t = 0; t < nt; t += 2) {
            const bool last = (t == nt - 2);
            const char* a1 = cA + (size_t)(t + 1) * kstep;
            const char* a2 = last ? nA : cA + (size_t)(t + 2) * kstep; const char* b2 = last ? nB : cB + (size_t)(t + 2) * kstep;
            const char* a3 = a2 + kstep; const char* b3 = b2 + kstep;
            unsigned sG[2][2];
#pragma unroll
            for (int h = 0; h < 2; ++h) { sG[h][0] = (GATHER && last) ? nG[h][0] : cG[h][0]; sG[h][1] = (GATHER && last) ? nG[h][1] : cG[h][1]; }
            PG8_LDB(B0, 0, 0); PG8_LDB(B1, 0, 1); PG8_SCHED; PG8_LDA(At, 0, 0); PG8_STAGE(PG8_SA(1, 1), a1 + hA, cG[1]);
            PG8_WAIT_V(8); PG8_WAIT_L(0); PG8_BAR; PG8_MMA(0, 0, At, B0); PG8_MMA(0, 1, At, B1); PG8_BAR; PG8_SCHED;
            PG8_LDA(At, 0, 1); PG8_STAGE(PG8_SB(0, 0), b2, voffB); PG8_STAGE(PG8_SB(0, 1), b2 + hstep, voffB); PG8_STAGE(PG8_SA(0, 0), a2, sG[0]);
            PG8_WAIT_V(8); PG8_WAIT_L(0); PG8_BAR; PG8_MMA(1, 0, At, B0); PG8_MMA(1, 1, At, B1); PG8_BAR; PG8_SCHED;
            PG8_LDB(B0, 1, 0); PG8_LDB(B1, 1, 1); PG8_SCHED; PG8_LDA(At, 1, 0); PG8_STAGE(PG8_SA(0, 1), a2 + hA, sG[1]);
            PG8_WAIT_V(8); PG8_WAIT_L(0); PG8_BAR; PG8_MMA(0, 0, At, B0); PG8_MMA(0, 1, At, B1); PG8_BAR; PG8_SCHED;
            PG8_LDA(At, 1, 1); PG8_STAGE(PG8_SB(1, 0), b3, voffB); PG8_STAGE(PG8_SB(1, 1), b3 + hstep, voffB); PG8_STAGE(PG8_SA(1, 0), a3, sG[0]);
            PG8_WAIT_V(8); PG8_WAIT_L(0); PG8_BAR; PG8_MMA(1, 0, At, B0); PG8_MMA(1, 1, At, B1); PG8_BAR; PG8_SCHED;
        }
        if (wr == 0) PG8_BAR;
        E(acc, cur, wr, wc, fr, fq);
        if (!has_next) break;
#pragma unroll
        for (int a = 0; a < 2; ++a)
#pragma unroll
            for (int b = 0; b < 2; ++b)
#pragma unroll
                for (int m = 0; m < 4; ++m)
#pragma unroll
                    for (int n = 0; n < 2; ++n) acc[a][b][m][n] = (f32x4){0.f, 0.f, 0.f, 0.f};
        cur = nxt; cA = nA; cB = nB; ++ui;
#pragma unroll
        for (int h = 0; h < 2; ++h) { cG[h][0] = nG[h][0]; cG[h][1] = nG[h][1]; }
        if (wr == 1) PG8_BAR;
    }
    PG8_WAIT_V(0);
    PG8_BAR;
#undef PG8_LOAD_ROWS
#undef PG8_SA
#undef PG8_SB
#undef PG8_STAGE
#undef PG8_LDA
#undef PG8_LDB
#undef PG8_MMA
#undef PG8_WAIT_V
#undef PG8_WAIT_L
#undef PG8_BAR
#undef PG8_SCHED
}
}
constexpr int NB = 2, SEQ = 16384, T = NB * SEQ, D = 1024;
constexpr int ABN = 2048, OFF_U = 0, OFF_Q = 512, OFF_K = 768, OFF_V = 1024, OFF_GO = 1536, AB_IN = 2080;
constexpr int CN = 1536;
constexpr int NEXP = 32, DEXP = 512, CAP = 2 * T + NEXP * 256, MAXTILES = CAP / 256;
constexpr int S5CH = 256, S5NCH = SEQ / S5CH;
constexpr int GSC = 16, GCH = 64, GNSC = SEQ / (GSC * GCH);
constexpr float ALPHA = 1.41421356237309515f;
constexpr float LN_EPS = 1e-5f, RMS_EPS = 1e-6f, LOG2E = 1.44269504088896341f;
constexpr int NWAVES = 8, NTHR = 512;

constexpr size_t MiB = 1u << 20, KiB = 1u << 10;
constexpr size_t WS_CTL = 0, CTL_ZERO_BYTES = 64 * KiB;
constexpr int CW_BAR = 4096;
constexpr size_t WS_LR = 1 * MiB;
constexpr size_t WS_S5E = 5 * MiB;
constexpr size_t WS_GS = 9 * MiB;
constexpr size_t WS_GD = 17 * MiB;
constexpr size_t WS_S5L = WS_GD + 64 * KiB;
constexpr size_t WS_S5B = WS_S5L + 64 * KiB;
constexpr size_t WS_S5C = WS_S5B + 256 * KiB;
constexpr size_t WS_BTAB = WS_S5C + 256 * KiB;
constexpr size_t WS_WR = WS_BTAB + 32 * KiB;
constexpr size_t WS_TOKE = WS_WR + 384 * KiB;
constexpr size_t WS_TOKW = WS_TOKE + 256 * KiB;
constexpr size_t WS_TOKS = WS_TOKW + 256 * KiB;
constexpr size_t WS_SLOTT = WS_TOKS + 256 * KiB;
constexpr size_t WS_SLOTW = WS_SLOTT + 288 * KiB;
constexpr size_t WS_BLKC = WS_SLOTW + 288 * KiB;
constexpr size_t WS_TILE = WS_BLKC + 32 * KiB;
static_assert(WS_TILE + 4 * KiB <= 32 * MiB, "param region");
constexpr size_t WS_WIN = 32 * MiB, WS_WLR = 36 * MiB, WS_WGLU = 37 * MiB, WS_WOUT = 38 * MiB, WS_CIN = 40 * MiB, WS_COUT = 43 * MiB;
constexpr size_t WS_W13 = 48 * MiB, WS_W2 = 112 * MiB;
constexpr size_t A0 = 144 * MiB;
constexpr size_t WS_H1 = A0, WS_H0 = A0;
constexpr size_t WS_Z = A0 + 128 * MiB;
constexpr size_t WS_YG = A0 + 128 * MiB, WS_OF = A0 + 160 * MiB, WS_OB = A0 + 320 * MiB;
constexpr size_t WS_YSCR = A0 + 224 * MiB;
constexpr size_t WS_X64 = A0 + 256 * MiB;
constexpr size_t WS_HID = A0 + 128 * MiB;
constexpr size_t WS_Y2 = A0 + 200 * MiB;
constexpr size_t WS_H2B = A0 + 128 * MiB;
constexpr size_t WS_QKV = A0 + 192 * MiB;
constexpr size_t WS_AO = A0 + 288 * MiB;
constexpr size_t WS_END = A0 + 384 * MiB;
static_assert(WS_Y2 + (size_t)CAP * D * 2 <= WS_END && WS_OB + (size_t)T * 512 * 4 <= WS_END && WS_HID + (size_t)CAP * 512 * 2 <= WS_Y2, "act map");

constexpr int RING_BYTES = 131072;
constexpr int MISC_OFF = 163840 - 1024;
constexpr int PTR_OFF = MISC_OFF + 256;
constexpr int LDS_BYTES = 163840;

#define GAS __attribute__((address_space(1)))
#define LAS __attribute__((address_space(3)))
typedef unsigned short bf16;
typedef float f32x4 __attribute__((ext_vector_type(4)));
typedef float f32x2 __attribute__((ext_vector_type(2)));
typedef float f32x16 __attribute__((ext_vector_type(16)));
typedef short bf16x8 __attribute__((ext_vector_type(8)));
typedef short bf16x4 __attribute__((ext_vector_type(4)));
typedef unsigned u32x4 __attribute__((ext_vector_type(4)));
typedef unsigned u32x2 __attribute__((ext_vector_type(2)));
#define LDS_WAIT() asm volatile("s_waitcnt lgkmcnt(0)" ::: "memory")
#define VM_WAIT() asm volatile("s_waitcnt vmcnt(0)" ::: "memory")
__device__ __forceinline__ unsigned f2bf(float f) { unsigned u = __builtin_bit_cast(unsigned, f); return (u + 0x7fffu + ((u >> 16) & 1u)) >> 16; }
typedef __bf16 bf16x2_t __attribute__((ext_vector_type(2)));
__device__ __forceinline__ unsigned pk2(float lo, float hi) { f32x2 v = {lo, hi}; return __builtin_bit_cast(unsigned, __builtin_convertvector(v, bf16x2_t)); }
__device__ __forceinline__ float bf2f(unsigned short b) { return __uint_as_float((unsigned)b << 16); }
__device__ __forceinline__ float bflo(unsigned w) { return __uint_as_float(w << 16); }
__device__ __forceinline__ float bfhi(unsigned w) { return __uint_as_float(w & 0xffff0000u); }
__device__ __forceinline__ float wave_sum(float v) {
#pragma unroll
    for (int o = 1; o < 64; o <<= 1) v += __shfl_xor(v, o);
    return v;
}
__device__ __forceinline__ int crow(int r, int hi) { return (r & 3) + 8 * (r >> 2) + 4 * hi; }

#define XB_TMO      128
#define XB_XCNT(j)  (256  + 64 * (j))
#define XB_XSUB(j)  (1280 + 64 * (j))
#define XB_XGEN(j)  (2304 + 64 * (j))
#define XB_TOP      3328
#define XB_TOPGEN   3392
#define XCD_BAR_WORDS 3456
#define XB_SPIN_CAP (1u << 18)
__device__ __forceinline__ unsigned xb_ld(unsigned* p)              { return __hip_atomic_load(p, __ATOMIC_RELAXED, __HIP_MEMORY_SCOPE_AGENT); }
__device__ __forceinline__ unsigned xb_add(unsigned* p, unsigned v) { return __hip_atomic_fetch_add(p, v, __ATOMIC_RELAXED, __HIP_MEMORY_SCOPE_AGENT); }
__device__ __forceinline__ unsigned xb_xcc_id() { return (unsigned)__builtin_amdgcn_s_getreg((3 << 11) | 20) & 0xFu; }
#define XB_SPIN(cond, bar) do { unsigned _sp = 0; while (cond) { __builtin_amdgcn_s_sleep(1); \
    if ((++_sp & 255u) == 0u) { if (xb_ld(&(bar)[XB_TMO])) break; if (_sp > XB_SPIN_CAP) { atomicAdd(&(bar)[XB_TMO], 1u); break; } } } } while (0)
struct XcdBarrier { unsigned* bar; unsigned x; volatile LAS unsigned* st; };
__device__ __forceinline__ XcdBarrier xcd_barrier_post(unsigned* bar, volatile LAS unsigned* st) {
    XcdBarrier b; b.bar = bar; b.x = xb_xcc_id(); b.st = st;
    if (threadIdx.x == 0) (void)xb_add(&bar[XB_XCNT(b.x)], 1u);
    return b;
}
__device__ __forceinline__ void xcd_barrier_complete(unsigned* bar, unsigned x, unsigned& nloc, unsigned& nx) {
    const unsigned G = gridDim.x * gridDim.y * gridDim.z;
    unsigned sum, cnt, mine, sp = 0u;
    for (;;) {
        sum = 0u; cnt = 0u; mine = 0u;
#pragma unroll
        for (unsigned j = 0; j < 16; ++j) { const unsigned c = xb_ld(&bar[XB_XCNT(j)]); sum += c; cnt += (c > 0u) ? 1u : 0u; mine = (j == x) ? c : mine; }
        if (sum == G) break;
        __builtin_amdgcn_s_sleep(1);
        if ((++sp & 255u) == 0u) { if (xb_ld(&bar[XB_TMO])) break; if (sp > XB_SPIN_CAP) { atomicAdd(&bar[XB_TMO], 1u); break; } }
    }
    nloc = mine > 0u ? mine : 1u; nx = cnt > 0u ? cnt : 1u;
}
__device__ __forceinline__ void xcd_barrier(const XcdBarrier& b) {
    asm volatile("s_waitcnt vmcnt(0)" ::: "memory");
    __syncthreads();
    if (threadIdx.x == 0) {
        unsigned* bar = b.bar;
        __builtin_amdgcn_s_waitcnt(0);
        unsigned nloc = b.st[0], nx = b.st[1];
        if (nloc == 0u) { xcd_barrier_complete(bar, b.x, nloc, nx); b.st[0] = nloc; b.st[1] = nx; }
        const unsigned old = xb_add(&bar[XB_XSUB(b.x)], 1u);
        const unsigned gen = old / nloc;
        if (old + 1u == (gen + 1u) * nloc) {
            __builtin_amdgcn_fence(__ATOMIC_RELEASE, "agent");
            asm volatile("s_waitcnt vmcnt(0)" ::: "memory");
            const unsigned og = xb_add(&bar[XB_TOP], 1u);
            const unsigned tg = og / nx;
            if (og + 1u == (tg + 1u) * nx) xb_add(&bar[XB_TOPGEN], 1u);
            else XB_SPIN(xb_ld(&bar[XB_TOPGEN]) == tg, bar);
            __builtin_amdgcn_fence(__ATOMIC_ACQUIRE, "agent");
            xb_add(&bar[XB_XGEN(b.x)], 1u);
            asm volatile("s_waitcnt vmcnt(0)" ::: "memory");
        } else {
            XB_SPIN(xb_ld(&bar[XB_XGEN(b.x)]) == gen, bar);
            __builtin_amdgcn_fence(__ATOMIC_ACQUIRE, "agent");
            asm volatile("s_waitcnt vmcnt(0)" ::: "memory");
        }
    }
    __syncthreads();
}

struct Frame {
    LAS unsigned char* lds;
    int tid, lane, wave, G, bid;
    unsigned char* ws;
    const float* const* in;
};
enum InIdx { I_X = 0, I_LNMG, I_LNMB, I_LNFG, I_LNFB, I_ABWIN, I_LAMRE, I_LAMIM, I_LOGDT, I_BRE, I_BIM, I_CRE, I_CIM, I_S5D, I_GLUW, I_GLUB,
             I_GATEW, I_GATEB, I_NORMG, I_ABWOUT, I_CWIN, I_SINK, I_CWOUT, I_RELB, I_WGRP, I_BGRP, I_WRT, I_BRT, I_W1, I_W3, I_W2, N_IN };

__device__ __forceinline__ const float* inp(LAS unsigned char* lds, int k) {
    const LAS unsigned* p = (const LAS unsigned*)(lds + PTR_OFF) + 2 * k;
    const unsigned lo = __builtin_amdgcn_readfirstlane(p[0]), hi = __builtin_amdgcn_readfirstlane(p[1]);
    return (const float*)(((unsigned long long)hi << 32) | (unsigned long long)lo);
}
__device__ __forceinline__ void tr_item(const float* W, int ldw, bf16* WT, int ldt, int rowmode, LAS float* scr, int item, int nblk, int lane) {
    const int kb = item / nblk, nb = item % nblk, k0 = 64 * kb, n0 = 32 * nb;
    float tv[32];
    const float* wp = W + (size_t)(k0 + (lane >> 5)) * ldw + n0 + (lane & 31);
#pragma unroll
    for (int i = 0; i < 32; ++i) tv[i] = wp[(size_t)(2 * i) * ldw];
#pragma unroll
    for (int i = 0; i < 32; ++i) scr[(2 * i + (lane >> 5)) * 33 + (lane & 31)] = tv[i];
    LDS_WAIT(); asm volatile("" ::: "memory");
    const int c = lane & 7;
#pragma unroll
    for (int j = 0; j < 4; ++j) { const int n = (lane >> 3) + 8 * j; const LAS float* s = scr + (8 * c) * 33 + n;
        u32x4 o; o.x = pk2(s[0 * 33], s[1 * 33]); o.y = pk2(s[2 * 33], s[3 * 33]); o.z = pk2(s[4 * 33], s[5 * 33]); o.w = pk2(s[6 * 33], s[7 * 33]);
        const int ng = n0 + n; const int dr = rowmode == 0 ? ng : (8 * (ng >> 2) + (ng & 3) + (rowmode == 2 ? 4 : 0));
        *(GAS u32x4*)(WT + (size_t)dr * ldt + k0 + 8 * c) = o; }
    LDS_WAIT(); asm volatile("" ::: "memory");
}
__device__ __forceinline__ void moe_convert(const float* w1, const float* w3, const float* w2, bf16* W13, bf16* W2T, LAS float* scr, int gw, int NGW, int lane) {
    constexpr int PER_E = 768;
    for (int it = gw; it < NEXP * PER_E; it += NGW) {
        const int e = it / PER_E; int r = it % PER_E;
        if (r < 256) tr_item(w1 + (size_t)e * D * DEXP, DEXP, W13 + (size_t)e * D * D, D, 1, scr, r, DEXP / 32, lane);
        else if (r < 512) tr_item(w3 + (size_t)e * D * DEXP, DEXP, W13 + (size_t)e * D * D, D, 2, scr, r - 256, DEXP / 32, lane);
        else tr_item(w2 + (size_t)e * DEXP * D, D, W2T + (size_t)e * D * DEXP, DEXP, 0, scr, r - 512, D / 32, lane);
    }
}
__device__ __forceinline__ int t5_bucket(int rel) {
    const int nb = 16, max_exact = 8; int ret = rel > 0 ? nb : 0; const int n = rel < 0 ? -rel : rel;
    const float lg = logf((float)(n < 1 ? 1 : n) / 8.0f) / 2.7725887f * 8.0f;
    int large = max_exact + (int)lg; large = large < nb - 1 ? large : nb - 1;
    return ret + (n < max_exact ? n : large);
}
__device__ __forceinline__ void p0_prologue(unsigned char* ws, LAS unsigned char* lds, int bid, int G, int tid, int wave, int lane) {
    LAS float* scr = (LAS float*)(lds + wave * 16384);
    const int gw = bid * NWAVES + wave, NGW = G * NWAVES;
    constexpr int I0 = 16 * 64, I1 = 16, I2 = 8 * 16, I3 = 16 * 32, I4 = 16 * 48, I5 = 16 * 32, NIT = I0 + I1 + I2 + I3 + I4 + I5;
    for (int it = gw; it < NIT; it += NGW) {
        int r = it;
        if (r < I0) { tr_item(inp(lds, I_ABWIN), AB_IN, (bf16*)(ws + WS_WIN), D, 0, scr, r, 64, lane); continue; } r -= I0;
        if (r < I1) { tr_item(inp(lds, I_ABWIN) + 2048, AB_IN, (bf16*)(ws + WS_WLR), D, 0, scr, r, 1, lane); continue; } r -= I1;
        if (r < I2) { tr_item(inp(lds, I_GLUW), 512, (bf16*)(ws + WS_WGLU), 512, 0, scr, r, 16, lane); continue; } r -= I2;
        if (r < I3) { tr_item(inp(lds, I_ABWOUT), D, (bf16*)(ws + WS_WOUT), D, 0, scr, r, 32, lane); continue; } r -= I3;
        if (r < I4) { tr_item(inp(lds, I_CWIN), CN, (bf16*)(ws + WS_CIN), D, 0, scr, r, 48, lane); continue; } r -= I4;
        tr_item(inp(lds, I_CWOUT), D, (bf16*)(ws + WS_COUT), D, 0, scr, r, 32, lane);
    }
    moe_convert(inp(lds, I_W1), inp(lds, I_W3), inp(lds, I_W2), (bf16*)(ws + WS_W13), (bf16*)(ws + WS_W2), scr, gw, NGW, lane);
    { const float* x = inp(lds, I_X); bf16* xb = (bf16*)(ws + WS_X64);
      for (int m = gw; m < T; m += 2 * NGW) { const int m2 = m + NGW;
          const GAS f32x4* xr = (const GAS f32x4*)(x + (size_t)m * D) + lane; GAS u32x2* o = (GAS u32x2*)(xb + (size_t)m * D) + lane;
          const GAS f32x4* xr2 = (const GAS f32x4*)(x + (size_t)m2 * D) + lane; GAS u32x2* o2 = (GAS u32x2*)(xb + (size_t)m2 * D) + lane;
          f32x4 v[4], v2[4];
#pragma unroll
          for (int j = 0; j < 4; ++j) { v[j] = xr[64 * j]; if (m2 < T) v2[j] = xr2[64 * j]; }
#pragma unroll
          for (int j = 0; j < 4; ++j) { u32x2 w; w.x = pk2(v[j].x, v[j].y); w.y = pk2(v[j].z, v[j].w); o[64 * j] = w;
              if (m2 < T) { u32x2 w2; w2.x = pk2(v2[j].x, v2[j].y); w2.y = pk2(v2[j].z, v2[j].w); o2[64 * j] = w2; } } } }
    const int gt = bid * NTHR + tid, NGT = G * NTHR;
    { const float* lamre = inp(lds, I_LAMRE); const float* lamim = inp(lds, I_LAMIM); const float* logdt = inp(lds, I_LOGDT); const float* bre = inp(lds, I_BRE); const float* bim = inp(lds, I_BIM);
    for (int i = gt; i < 2 * 32 * 64; i += NGT) {
        const int p = i & 63, g = (i >> 6) & 31, dir = i >> 11;
        const double lr = fmin((double)lamre[i], -1e-4), li = (double)lamim[i], dt = exp((double)logdt[dir * 32 + g]);
        const double mag = exp(lr * dt), ar = mag * cos(li * dt), ai = mag * sin(li * dt), den = lr * lr + li * li, nr = ar - 1.0;
        const double cr = (nr * lr + ai * li) / den, ci = (ai * lr - nr * li) / den;
        double qr = ar, qi = ai;
#pragma unroll 1
        for (int s = 1; s < S5CH; s <<= 1) { const double t = qr * qr - qi * qi; qi = 2.0 * qr * qi; qr = t; }
        float* L4 = (float*)(ws + WS_S5L) + (size_t)i * 4; L4[0] = (float)ar; L4[1] = (float)ai; L4[2] = (float)qr; L4[3] = (float)qi;
        bf16* Bb = (bf16*)(ws + WS_S5B) + (size_t)(dir * 32 + g) * 2048;
#pragma unroll 4
        for (int c = 0; c < 16; ++c) { const double br = bre[(size_t)i * 16 + c], bi = bim[(size_t)i * 16 + c];
            Bb[p * 16 + c] = (bf16)f2bf((float)(cr * br - ci * bi)); Bb[1024 + p * 16 + c] = (bf16)f2bf((float)(cr * bi + ci * br)); }
    } }
    { const float* cre = inp(lds, I_CRE); const float* cim = inp(lds, I_CIM);
    for (int i = gt; i < 2 * 32 * 16 * 64; i += NGT) {
        const int p = i & 63, c = (i >> 6) & 15, dg = i >> 10;
        bf16* Cm = (bf16*)(ws + WS_S5C) + (size_t)dg * 2048 + c * 128 + 2 * p;
        Cm[0] = (bf16)f2bf(cre[i]); Cm[1] = (bf16)f2bf(-cim[i]);
    } }
    { const float* relb = inp(lds, I_RELB);
    for (int i = gt; i < 16 * 257; i += NGT) { const int h = i / 257, r = i % 257; ((float*)(ws + WS_BTAB))[h * 260 + r] = relb[t5_bucket(r - 128) * 16 + h] * LOG2E; } }
    { const float* wgrp = inp(lds, I_WGRP); const float* wrt = inp(lds, I_WRT);
    for (int i = gt; i < 2 * 48 * 1024; i += NGT) {
        const int k = i & 1023, n = (i >> 10) % 48, l = i / (48 * 1024);
        const float w = n < 4 ? wgrp[(size_t)l * D * 4 + k * 4 + n] : (n < 36 ? wrt[(size_t)l * D * 32 + k * 32 + (n - 4)] : 0.f);
        const unsigned hi = f2bf(w); const float lo = w - __uint_as_float(hi << 16);
        bf16* Wr = (bf16*)(ws + WS_WR) + (size_t)l * 2 * 48 * 1024; Wr[n * 1024 + k] = (bf16)hi; Wr[48 * 1024 + n * 1024 + k] = (bf16)f2bf(lo);
    } }
}

__device__ __forceinline__ void lr_tail(unsigned char* ws, int bid, int G, int wave, int lane) {
    const bf16* xb = (const bf16*)(ws + WS_X64); const bf16* wl = (const bf16*)(ws + WS_WLR); float* lr = (float*)(ws + WS_LR);
    for (int rt = bid; rt < T / 128; rt += G) {
        const int r0 = rt * 128 + wave * 16;
        f32x4 acc0 = {0.f, 0.f, 0.f, 0.f}, acc1 = {0.f, 0.f, 0.f, 0.f};
        const bf16* ap = xb + (size_t)(r0 + (lane & 15)) * D + 8 * (lane >> 4);
        const bf16* bp = wl + (size_t)(lane & 15) * D + 8 * (lane >> 4);
#pragma unroll 8
        for (int ks = 0; ks < 32; ++ks) {
            const bf16x8 a = *(const bf16x8*)(ap + ks * 32), b0 = *(const bf16x8*)(bp + ks * 32), b1 = *(const bf16x8*)(bp + 16 * D + ks * 32);
            acc0 = __builtin_amdgcn_mfma_f32_16x16x32_bf16(a, b0, acc0, 0, 0, 0); acc1 = __builtin_amdgcn_mfma_f32_16x16x32_bf16(a, b1, acc1, 0, 0, 0);
        }
#pragma unroll
        for (int r = 0; r < 4; ++r) { float* o = lr + (size_t)(r0 + 4 * (lane >> 4) + r) * 32 + (lane & 15); o[0] = acc0[r]; o[16] = acc1[r]; }
    }
}

__device__ __forceinline__ void gla_finalize(unsigned char* ws, const float* norm_g, int gw, int NGW, int lane) {
    const float* of = (const float*)(ws + WS_OF); const float* ob = (const float*)(ws + WS_OB); const bf16* h0 = (const bf16*)(ws + WS_H0); bf16* cc = (bf16*)(ws + WS_X64);
    f32x4 g0 = *(const f32x4*)(norm_g + 8 * lane), g1 = *(const f32x4*)(norm_g + 8 * lane + 4);
    for (int m = gw; m < T; m += NGW) {
        const float* a = of + (size_t)m * 512 + 8 * lane; const float* b = ob + (size_t)m * 512 + 8 * lane;
        f32x4 v0 = *(const f32x4*)a + *(const f32x4*)b, v1 = *(const f32x4*)(a + 4) + *(const f32x4*)(b + 4);
        const u32x4 gq = *(const u32x4*)(h0 + (size_t)m * ABN + OFF_GO + 8 * lane);
        float ss = (v0.x * v0.x + v0.y * v0.y) + (v0.z * v0.z + v0.w * v0.w) + (v1.x * v1.x + v1.y * v1.y) + (v1.z * v1.z + v1.w * v1.w);
        ss += __shfl_xor(ss, 1); ss += __shfl_xor(ss, 2); ss += __shfl_xor(ss, 4); ss += __shfl_xor(ss, 8);
        const float rs = 1.0f / sqrtf(ss * (1.0f / 128.0f) + RMS_EPS);
        const float gv[8] = {bflo(gq.x), bfhi(gq.x), bflo(gq.y), bfhi(gq.y), bflo(gq.z), bfhi(gq.z), bflo(gq.w), bfhi(gq.w)};
        const float ov[8] = {v0.x * g0.x, v0.y * g0.y, v0.z * g0.z, v0.w * g0.w, v1.x * g1.x, v1.y * g1.y, v1.z * g1.z, v1.w * g1.w};
        float r[8];
#pragma unroll
        for (int i = 0; i < 8; ++i) r[i] = ov[i] * rs * (gv[i] / (1.f + __expf(-gv[i])));
        u32x4 w; w.x = pk2(r[0], r[1]); w.y = pk2(r[2], r[3]); w.z = pk2(r[4], r[5]); w.w = pk2(r[6], r[7]);
        *(u32x4*)(cc + (size_t)m * D + 512 + 8 * lane) = w;
    }
}

constexpr int RT_AST = 2064;
__device__ __forceinline__ void ln_router(unsigned char* ws, const float* lng, const float* lnb, const float* bgrp, const float* brt, int layer, LAS unsigned char* lds, int bid, int G, int tid, int wave, int lane) {
    const float* z = (const float*)(ws + WS_Z); float* h1 = (float*)(ws + WS_H1); bf16* hb = (bf16*)(ws + WS_X64);
    int* tok_e = (int*)(ws + WS_TOKE); float* tok_w = (float*)(ws + WS_TOKW);
    LAS unsigned char* Ahi = lds; LAS unsigned char* Alo = lds + 16 * RT_AST; LAS float* part = (LAS float*)(lds + 32 * RT_AST);
    LAS int* hist = (LAS int*)(lds + 32 * RT_AST + 8 * 16 * 48 * 4); LAS float* lgt = (LAS float*)(lds + 32 * RT_AST + 8 * 16 * 48 * 4 + 256);
    if (tid < 32) hist[tid] = 0;
    const bf16* Wr = (const bf16*)(ws + WS_WR) + (size_t)layer * 2 * 48 * 1024;
    bf16x8 Bh[3][4], Bl[3][4];
#pragma unroll
    for (int nt = 0; nt < 3; ++nt)
#pragma unroll
        for (int ks = 0; ks < 4; ++ks) { const size_t o = (size_t)(nt * 16 + (lane & 15)) * 1024 + wave * 128 + ks * 32 + 8 * (lane >> 4);
            Bh[nt][ks] = *(const bf16x8*)(Wr + o); Bl[nt][ks] = *(const bf16x8*)(Wr + 48 * 1024 + o); }
    f32x4 gv[4], bv[4];
#pragma unroll
    for (int j = 0; j < 4; ++j) { gv[j] = *(const f32x4*)(lng + 4 * lane + 256 * j); bv[j] = *(const f32x4*)(lnb + 4 * lane + 256 * j); }
    __syncthreads();
    for (int grp = bid; grp < T / 16; grp += G) {
#pragma unroll
        for (int rr = 0; rr < 2; ++rr) {
            const int row = 2 * wave + rr; const size_t m = (size_t)grp * 16 + row;
            const GAS f32x4* zr = (const GAS f32x4*)(z + m * D) + lane;
            f32x4 v[4]; float s = 0.f;
#pragma unroll
            for (int j = 0; j < 4; ++j) { v[j] = zr[64 * j]; s += (v[j].x + v[j].y) + (v[j].z + v[j].w); }
            const float mean = wave_sum(s) * (1.f / D); float s2 = 0.f;
#pragma unroll
            for (int j = 0; j < 4; ++j) { v[j] = v[j] - mean; s2 += (v[j].x * v[j].x + v[j].y * v[j].y) + (v[j].z * v[j].z + v[j].w * v[j].w); }
            const float rstd = 1.f / sqrtf(wave_sum(s2) * (1.f / D) + LN_EPS);
#pragma unroll
            for (int j = 0; j < 4; ++j) {
                const f32x4 h = v[j] * rstd * gv[j] + bv[j];
                ((GAS f32x4*)(h1 + m * D) + lane)[64 * j] = h;
                const unsigned h0 = pk2(h.x, h.y), h1w = pk2(h.z, h.w);
                u32x2 w; w.x = h0; w.y = h1w; ((GAS u32x2*)(hb + m * D) + lane)[64 * j] = w;
                u32x2 lo; lo.x = pk2(h.x - bflo(h0), h.y - bfhi(h0)); lo.y = pk2(h.z - bflo(h1w), h.w - bfhi(h1w));
                *(LAS u32x2*)(Ahi + row * RT_AST + (4 * lane + 256 * j) * 2) = w; *(LAS u32x2*)(Alo + row * RT_AST + (4 * lane + 256 * j) * 2) = lo;
            }
        }
        __syncthreads();
        f32x4 acc[3] = {{0.f, 0.f, 0.f, 0.f}, {0.f, 0.f, 0.f, 0.f}, {0.f, 0.f, 0.f, 0.f}};
#pragma unroll
        for (int ks = 0; ks < 4; ++ks) {
            const int bo = (lane & 15) * RT_AST + (wave * 128 + ks * 32 + 8 * (lane >> 4)) * 2;
            const bf16x8 ah = *(const LAS bf16x8*)(Ahi + bo), al = *(const LAS bf16x8*)(Alo + bo);
#pragma unroll
            for (int nt = 0; nt < 3; ++nt) {
                acc[nt] = __builtin_amdgcn_mfma_f32_16x16x32_bf16(ah, Bh[nt][ks], acc[nt], 0, 0, 0);
                acc[nt] = __builtin_amdgcn_mfma_f32_16x16x32_bf16(ah, Bl[nt][ks], acc[nt], 0, 0, 0);
                acc[nt] = __builtin_amdgcn_mfma_f32_16x16x32_bf16(al, Bh[nt][ks], acc[nt], 0, 0, 0);
            }
        }
#pragma unroll
        for (int nt = 0; nt < 3; ++nt)
#pragma unroll
            for (int r = 0; r < 4; ++r) part[(wave * 16 + 4 * (lane >> 4) + r) * 48 + nt * 16 + (lane & 15)] = acc[nt][r];
        __syncthreads();
        for (int idx = tid; idx < 16 * 36; idx += NTHR) { const int tk = idx / 36, n = idx % 36; float s = 0.f;
#pragma unroll
            for (int w = 0; w < 8; ++w) s += part[(w * 16 + tk) * 48 + n];
            lgt[tk * 36 + n] = s + (n < 4 ? bgrp[n] : brt[n - 4]); }
        __syncthreads();
        if (tid < 16) {
            const size_t m = (size_t)grp * 16 + tid;
            const LAS float* lg = lgt + tid * 36;
            int gi = 0; float gm = lg[0];
#pragma unroll
            for (int n = 1; n < 4; ++n) if (lg[n] > gm) { gm = lg[n]; gi = n; }
            float gs = 0.f;
#pragma unroll
            for (int n = 0; n < 4; ++n) gs += __expf(lg[n] - gm);
            const float pg = 1.f / gs;
            float el[8];
#pragma unroll
            for (int i = 0; i < 8; ++i) el[i] = lg[4 + gi * 8 + i];
            int i1 = 0; float m1 = el[0];
#pragma unroll
            for (int i = 1; i < 8; ++i) if (el[i] > m1) { m1 = el[i]; i1 = i; }
            int i2 = -1; float m2 = -3.0e38f;
#pragma unroll
            for (int i = 0; i < 8; ++i) if (i != i1 && el[i] > m2) { m2 = el[i]; i2 = i; }
            const float e2 = __expf(m2 - m1), inv = 1.f / (1.f + e2);
            const int ea = gi * 8 + i1, eb = gi * 8 + i2;
            tok_e[m * 2] = ea; tok_e[m * 2 + 1] = eb; tok_w[m * 2] = pg * inv; tok_w[m * 2 + 1] = pg * e2 * inv;
            atomicAdd((int*)&hist[ea], 1); atomicAdd((int*)&hist[eb], 1);
        }
        __syncthreads();
    }
    if (tid < 32) ((int*)(ws + WS_BLKC))[bid * 32 + tid] = hist[tid];
}

__device__ __forceinline__ void moe_sort(unsigned char* ws, LAS unsigned char* lds, int bid, int G, int tid) {
    const int* blkc = (const int*)(ws + WS_BLKC); const int* tok_e = (const int*)(ws + WS_TOKE); const float* tok_w = (const float*)(ws + WS_TOKW);
    int* tok_s = (int*)(ws + WS_TOKS); int* slot_t = (int*)(ws + WS_SLOTT); float* slot_w = (float*)(ws + WS_SLOTW); int* tile = (int*)(ws + WS_TILE);
    LAS int* ptot = (LAS int*)lds; LAS int* pbase = ptot + 512; LAS int* tot = pbase + 512; LAS int* base = tot + 32; LAS int* pstart = base + 32; LAS int* lcur = pstart + 33;
    { const int e = tid & 31, part = tid >> 5; int st = 0, sb = 0;
      for (int b = part; b < G; b += 16) { const int c = blkc[b * 32 + e]; st += c; sb += (b < bid) ? c : 0; }
      ptot[part * 32 + e] = st; pbase[part * 32 + e] = sb; }
    __syncthreads();
    if (tid < 32) { int st = 0, sb = 0;
#pragma unroll
        for (int p = 0; p < 16; ++p) { st += ptot[p * 32 + tid]; sb += pbase[p * 32 + tid]; }
        tot[tid] = st; base[tid] = sb; lcur[tid] = 0; }
    __syncthreads();
    if (tid == 0) { int acc = 0; for (int e = 0; e < 32; ++e) { pstart[e] = acc; acc += (tot[e] + 255) & ~255; } pstart[32] = acc; }
    __syncthreads();
    if (bid == 0) {
        const int nt = pstart[32] >> 8;
        if (tid == 0) tile[511] = nt;
        for (int t = tid; t < nt; t += NTHR) { int e = 0; for (int q = 1; q < 32; ++q) if ((t << 8) >= pstart[q]) e = q; tile[t] = e; }
    }
    for (int e = bid; e < 32; e += G)
        for (int s = pstart[e] + tot[e] + tid; s < pstart[e + 1]; s += NTHR) { slot_t[s] = 0; slot_w[s] = 0.f; }
    for (int grp = bid; grp < T / 16; grp += G) {
        if (tid < 32) { const size_t a = (size_t)grp * 32 + tid; const int e = tok_e[a]; const int rank = atomicAdd((int*)&lcur[e], 1);
            const int s = pstart[e] + base[e] + rank; slot_t[s] = (int)(a >> 1); slot_w[s] = tok_w[a]; tok_s[a] = s; }
    }
}

template <bool FINAL>
__device__ __forceinline__ void combine_ln(unsigned char* ws, const float* lng, const float* lnb, float* dout, int gw, int NGW, int lane) {
    float* h1 = (float*)(ws + WS_H1); const bf16* y2 = (const bf16*)(ws + WS_Y2); const int* tok_s = (const int*)(ws + WS_TOKS); bf16* h2b = (bf16*)(ws + WS_H2B);
    f32x4 gv[4], bv[4];
#pragma unroll
    for (int j = 0; j < 4; ++j) { gv[j] = *(const f32x4*)(lng + 4 * lane + 256 * j); bv[j] = *(const f32x4*)(lnb + 4 * lane + 256 * j); }
    for (int m = gw; m < T; m += NGW) {
        const int s0 = tok_s[(size_t)m * 2], s1 = tok_s[(size_t)m * 2 + 1];
        const GAS f32x4* hr = (const GAS f32x4*)(h1 + (size_t)m * D) + lane;
        const GAS u32x2* ya = (const GAS u32x2*)(y2 + (size_t)s0 * D) + lane; const GAS u32x2* yb = (const GAS u32x2*)(y2 + (size_t)s1 * D) + lane;
        f32x4 v[4]; float s = 0.f;
#pragma unroll
        for (int j = 0; j < 4; ++j) { const f32x4 h = hr[64 * j]; const u32x2 a = ya[64 * j], b = yb[64 * j];
            v[j].x = h.x * ALPHA + (bflo(a.x) + bflo(b.x)); v[j].y = h.y * ALPHA + (bfhi(a.x) + bfhi(b.x)); v[j].z = h.z * ALPHA + (bflo(a.y) + bflo(b.y)); v[j].w = h.w * ALPHA + (bfhi(a.y) + bfhi(b.y));
            s += (v[j].x + v[j].y) + (v[j].z + v[j].w); }
        const float mean = wave_sum(s) * (1.f / D); float s2 = 0.f;
#pragma unroll
        for (int j = 0; j < 4; ++j) { v[j] = v[j] - mean; s2 += (v[j].x * v[j].x + v[j].y * v[j].y) + (v[j].z * v[j].z + v[j].w * v[j].w); }
        const float rstd = 1.f / sqrtf(wave_sum(s2) * (1.f / D) + LN_EPS);
#pragma unroll
        for (int j = 0; j < 4; ++j) { const f32x4 h = v[j] * rstd * gv[j] + bv[j];
            if (FINAL) ((GAS f32x4*)(dout + (size_t)m * D) + lane)[64 * j] = h;
            else { ((GAS f32x4*)(h1 + (size_t)m * D) + lane)[64 * j] = h; u32x2 w; w.x = pk2(h.x, h.y); w.y = pk2(h.z, h.w); ((GAS u32x2*)(h2b + (size_t)m * D) + lane)[64 * j] = w; } }
    }
}
constexpr int S5_HST = 272, S5_UST = 272, S5_UOFF = 8 * 32 * S5_HST;
#define MFMA32(a, b, c) __builtin_amdgcn_mfma_f32_32x32x16_bf16((a), (b), (c), 0, 0, 0)
#define MFMA16(a, b, c) __builtin_amdgcn_mfma_f32_16x16x32_bf16((a), (b), (c), 0, 0, 0)
__device__ __forceinline__ float gelu_tanh(float x) {
    const float u = 0.7978845608028654f * (x + 0.044715f * x * x * x);
    const float e = __expf(2.f * u); const float th = 1.f - 2.f / (e + 1.f);
    return 0.5f * x * (1.f + th);
}
__device__ __forceinline__ f32x4 ld_ys(const float* p) {
    f32x4 v;
    v.x = __hip_atomic_load(p, __ATOMIC_RELAXED, __HIP_MEMORY_SCOPE_AGENT); v.y = __hip_atomic_load(p + 1, __ATOMIC_RELAXED, __HIP_MEMORY_SCOPE_AGENT);
    v.z = __hip_atomic_load(p + 2, __ATOMIC_RELAXED, __HIP_MEMORY_SCOPE_AGENT); v.w = __hip_atomic_load(p + 3, __ATOMIC_RELAXED, __HIP_MEMORY_SCOPE_AGENT);
    return v;
}
template <int PASS, int DIR>
__device__ __forceinline__ void s5_dir(unsigned char* ws, const float* s5d, int b, int g, int c, LAS unsigned char* hl, const LAS unsigned char* ul, float* yscr, int lane) {
    const bf16* h0 = (const bf16*)(ws + WS_H0);
    const int dg = DIR * 32 + g;
    const f32x4 L4 = *(const f32x4*)((const float*)(ws + WS_S5L) + (size_t)(dg * 64 + lane) * 4);
    const float ar = L4.x, ai = L4.y, qr = L4.z, qi = L4.w;
    const bf16* Bb = (const bf16*)(ws + WS_S5B) + (size_t)dg * 2048 + (lane & 31) * 16 + 8 * (lane >> 5);
    const bf16x8 bre0 = *(const bf16x8*)Bb, bre1 = *(const bf16x8*)(Bb + 512), bim0 = *(const bf16x8*)(Bb + 1024), bim1 = *(const bf16x8*)(Bb + 1536);
    bf16x8 cf[4]; bf16x8 dfrag;
    if (PASS == 2) {
        const bf16* Cm = (const bf16*)(ws + WS_S5C) + (size_t)dg * 2048 + (lane & 15) * 128 + 8 * (lane >> 4);
#pragma unroll
        for (int ks = 0; ks < 4; ++ks) cf[ks] = *(const bf16x8*)(Cm + 32 * ks);
        if (DIR == 1) {
            const int cc = lane & 15, kq = lane >> 4; const float d = s5d[g * 16 + cc]; const unsigned dh = f2bf(d); const unsigned dl = f2bf(d - __uint_as_float(dh << 16));
#pragma unroll
            for (int j = 0; j < 8; ++j) { const int k = 8 * (kq & 1) + j; dfrag[j] = (short)((k == cc) ? (kq < 2 ? dh : dl) : 0u); }
        }
    }
    float hr = 0.f, hi = 0.f;
    float* Ec = (float*)(ws + WS_S5E) + ((size_t)((DIR * NB + b) * 32 + g) * S5NCH) * 128 + 2 * lane;
    if (PASS == 2) {
        const int nj = DIR == 0 ? c : (S5NCH - 1 - c);
        for (int j0 = 0; j0 < nj; j0 += 8) {
            f32x2 e[8];
#pragma unroll
            for (int q = 0; q < 8; ++q) { const int j = j0 + q; const int jj = DIR == 0 ? j : (S5NCH - 1 - j); e[q] = (j < nj) ? *(const f32x2*)(Ec + (size_t)jj * 128) : (f32x2){0.f, 0.f}; }
#pragma unroll
            for (int q = 0; q < 8; ++q) if (j0 + q < nj) { const float nr = qr * hr - qi * hi + e[q].x; hi = qr * hi + qi * hr + e[q].y; hr = nr; }
        }
    }
    const size_t rowbase = (size_t)b * SEQ + (size_t)c * S5CH;
    const LAS unsigned char* up = ul + (lane & 31) * S5_UST + (g & 7) * 32 + 16 * (lane >> 5);
    const f32x16 zero16 = {0.f, 0.f, 0.f, 0.f, 0.f, 0.f, 0.f, 0.f, 0.f, 0.f, 0.f, 0.f, 0.f, 0.f, 0.f, 0.f};
#pragma unroll 1
    for (int ti = 0; ti < S5CH / 32; ++ti) {
        const int tile = DIR == 0 ? ti : (S5CH / 32 - 1 - ti);
        const bf16x8 a = *(const LAS bf16x8*)(up + tile * 32 * S5_UST);
        f32x4 ysv[2] = {{0.f, 0.f, 0.f, 0.f}, {0.f, 0.f, 0.f, 0.f}};
        if (PASS == 2 && DIR == 1) { ysv[0] = ld_ys(yscr + (size_t)(tile * 2) * 256 + 4 * lane); ysv[1] = ld_ys(yscr + (size_t)(tile * 2 + 1) * 256 + 4 * lane); }
        f32x16 xr0 = MFMA32(a, bre0, zero16), xr1 = MFMA32(a, bre1, zero16), xi0 = MFMA32(a, bim0, zero16), xi1 = MFMA32(a, bim1, zero16);
        __builtin_amdgcn_sched_barrier(0);
        asm volatile("s_nop 15\n\ts_nop 15\n\ts_nop 15\n\ts_nop 15" ::: "memory");
        __builtin_amdgcn_sched_barrier(0);
        float xr[32], xi[32];
#pragma unroll
        for (int r = 0; r < 16; ++r) {
            auto s = __builtin_amdgcn_permlane32_swap(__float_as_uint(xr0[r]), __float_as_uint(xr1[r]), false, false);
            xr[crow(r, 0)] = __uint_as_float(s[0]); xr[crow(r, 1)] = __uint_as_float(s[1]);
            auto q = __builtin_amdgcn_permlane32_swap(__float_as_uint(xi0[r]), __float_as_uint(xi1[r]), false, false);
            xi[crow(r, 0)] = __uint_as_float(q[0]); xi[crow(r, 1)] = __uint_as_float(q[1]);
        }
#pragma unroll
        for (int tt = 0; tt < 32; ++tt) {
            const int t = DIR == 0 ? tt : 31 - tt;
            const float nr = ar * hr - ai * hi + xr[t]; hi = ar * hi + ai * hr + xi[t]; hr = nr;
            if (PASS == 2) *(LAS unsigned*)(hl + t * S5_HST + 4 * lane) = pk2(hr, hi);
        }
        if (PASS == 2) {
#pragma unroll
            for (int sub = 0; sub < 2; ++sub) {
                float* ys = yscr + (size_t)(tile * 2 + sub) * 256 + 4 * lane;
                f32x4 y = {0.f, 0.f, 0.f, 0.f};
                if (DIR == 1) y = ysv[sub];
#pragma unroll
                for (int ks = 0; ks < 4; ++ks) { const bf16x8 hf = *(const LAS bf16x8*)(hl + (sub * 16 + (lane & 15)) * S5_HST + 64 * ks + 16 * (lane >> 4)); y = MFMA16(hf, cf[ks], y); }
                if (DIR == 0) *(f32x4*)ys = y;
                else {
                    const bf16x8 uf = *(const LAS bf16x8*)(ul + (tile * 32 + sub * 16 + (lane & 15)) * S5_UST + (g & 7) * 32 + 16 * ((lane >> 4) & 1));
                    y = MFMA16(uf, dfrag, y);
                    bf16* yo = (bf16*)(ws + WS_YG) + (rowbase + tile * 32 + sub * 16 + 4 * (lane >> 4)) * 512 + g * 16 + (lane & 15);
#pragma unroll
                    for (int r = 0; r < 4; ++r) yo[(size_t)r * 512] = (bf16)f2bf(gelu_tanh(y[r]));
                }
            }
        }
    }
    if (PASS == 1) { f32x2 e; e.x = hr; e.y = hi; *(f32x2*)(Ec + (size_t)c * 128) = e; }
}
template <int PASS>
__device__ __forceinline__ void s5_phase(unsigned char* ws, const float* s5d, LAS unsigned char* lds, int bid, int G, int tid, int wave, int lane) {
    LAS unsigned char* hl = lds + wave * (32 * S5_HST); LAS unsigned char* ul = lds + S5_UOFF;
    float* yscr = (float*)(ws + WS_YSCR) + (size_t)(bid * NWAVES + wave) * 4096;
    const bf16* h0 = (const bf16*)(ws + WS_H0);
    for (int it = bid; it < NB * S5NCH * 4; it += G) {
        const int go = it & 3, c = (it >> 2) % S5NCH, b = it / (4 * S5NCH), g = go * 8 + wave;
        { const bf16* src = h0 + ((size_t)b * SEQ + (size_t)c * S5CH) * ABN + OFF_U + go * 128;
          u32x4 v[8];
#pragma unroll
          for (int i = 0; i < 8; ++i) { const int p = i * NTHR + tid; v[i] = *(const u32x4*)(src + (size_t)(p >> 4) * ABN + 8 * (p & 15)); }
          __syncthreads();
#pragma unroll
          for (int i = 0; i < 8; ++i) { const int p = i * NTHR + tid; *(LAS u32x4*)(ul + (p >> 4) * S5_UST + 16 * (p & 15)) = v[i]; }
          __syncthreads(); }
        s5_dir<PASS, 0>(ws, s5d, b, g, c, hl, ul, yscr, lane);
        s5_dir<PASS, 1>(ws, s5d, b, g, c, hl, ul, yscr, lane);
    }
}
constexpr int G_ST = 144;
constexpr int GL_LRS = 0, GL_GSUM = 4096, GL_BC = 6144, GL_QD = 22784, GL_KD = GL_QD + 64 * G_ST, GL_KCT = GL_KD + 64 * G_ST, GL_VT = GL_KCT + 64 * G_ST,
              GL_S = GL_VT + 128 * G_ST, GL_ST = GL_S + 64 * G_ST, GL_END = GL_ST + 128 * G_ST;
static_assert(GL_END <= RING_BYTES, "GLA LDS");
__device__ __forceinline__ bf16x8 ldfrag32(const LAS unsigned char* base, int row0, int ks, int lane) {
    return *(const LAS bf16x8*)(base + (row0 + (lane & 31)) * G_ST + 32 * ks + 16 * (lane >> 5));
}
template <int PASS>
__device__ __forceinline__ void gla_item(unsigned char* ws, const float* gate_w, const float* gate_b, int item, LAS unsigned char* lds, int tid, int wave, int lane) {
    const int sc = item % GNSC, dir = (item / GNSC) & 1, h = (item / (GNSC * 2)) & 3, b = item / (GNSC * 8);
    const bf16* h0 = (const bf16*)(ws + WS_H0); const float* lrp = (const float*)(ws + WS_LR);
    LAS float* lrs = (LAS float*)(lds + GL_LRS); LAS float* gsum = (LAS float*)(lds + GL_GSUM); LAS float* bcs = (LAS float*)(lds + GL_BC);
    LAS unsigned char* QD = lds + GL_QD; LAS unsigned char* KD = lds + GL_KD; LAS unsigned char* KCT = lds + GL_KCT; LAS unsigned char* VT = lds + GL_VT; LAS unsigned char* SS = lds + GL_S; LAS unsigned char* STT = lds + GL_ST;
    float gw[16];
#pragma unroll
    for (int r = 0; r < 16; ++r) gw[r] = gate_w[(size_t)(dir * 16 + r) * 256 + h * 64 + lane];
    const float gb = gate_b[dir * 256 + h * 64 + lane];
    const int me = wave >> 1, nd = wave & 1;
    f32x16 st;
#pragma unroll
    for (int r = 0; r < 16; ++r) st[r] = 0.f;
    float dtot = 1.f;
    float* GS = (float*)(ws + WS_GS); float* GD = (float*)(ws + WS_GD);
    const int ibase = item - sc;
    if (PASS == 2) {
        for (int j = 0; j < sc; ++j) {
            const float dj = GD[(size_t)(ibase + j) * 64 + nd * 32 + (lane & 31)];
            const float* gs = GS + (size_t)(ibase + j) * 8192 + nd * 32 + (lane & 31);
#pragma unroll
            for (int r = 0; r < 16; ++r) st[r] = st[r] * dj + gs[(size_t)(me * 32 + crow(r, lane >> 5)) * 64];
        }
#pragma unroll
        for (int r = 0; r < 16; ++r) *(LAS bf16*)(STT + (me * 32 + crow(r, lane >> 5)) * G_ST + (nd * 32 + (lane & 31)) * 2) = (bf16)f2bf(st[r]);
    }
    const float qscale = 0.125f;
    const int s_l = lane;
    u32x4 pq, pk, pv0, pv1; f32x2 plr;
    auto tok_of = [&](int n, int s) { const int pos = (sc * GSC + n) * GCH + s; return (size_t)b * SEQ + (dir ? (SEQ - 1 - pos) : pos); };
#define GLA_LOAD(n) do { const size_t tk = tok_of((n), s_l); const bf16* rp = h0 + tk * ABN; \
        if (PASS == 2) pq = *(const u32x4*)(rp + OFF_Q + h * 64 + 8 * wave); \
        pk = *(const u32x4*)(rp + OFF_K + h * 64 + 8 * wave); pv0 = *(const u32x4*)(rp + OFF_V + h * 128 + 16 * wave); pv1 = *(const u32x4*)(rp + OFF_V + h * 128 + 16 * wave + 8); \
        plr = *(const f32x2*)(lrp + tk * 32 + dir * 16 + 2 * wave); } while (0)
    GLA_LOAD(0);
#pragma unroll 1
    for (int n = 0; n < GSC; ++n) {
        lrs[s_l * 16 + 2 * wave] = plr.x; lrs[s_l * 16 + 2 * wave + 1] = plr.y;
        __syncthreads();
        float la[8];
        { float run = 0.f;
#pragma unroll
          for (int i = 0; i < 8; ++i) { const int s = 8 * wave + i; float z = gb;
#pragma unroll
              for (int r = 0; r < 16; ++r) z += lrs[s * 16 + r] * gw[r];
              const float ls = fminf(z, 0.f) - __logf(1.f + __expf(-fabsf(z)));
              run += ls * (1.0f / 16.0f); la[i] = run; }
          gsum[wave * 64 + lane] = run; }
        __syncthreads();
        { float off = 0.f;
#pragma unroll
          for (int w = 0; w < 8; ++w) off += (w < wave) ? gsum[w * 64 + lane] : 0.f;
#pragma unroll
          for (int i = 0; i < 8; ++i) bcs[(8 * wave + i) * 65 + lane] = la[i] + off; }
        __syncthreads();
        { float bc[8], bl[8];
#pragma unroll
          for (int i = 0; i < 8; ++i) { bc[i] = bcs[s_l * 65 + 8 * wave + i]; bl[i] = bcs[63 * 65 + 8 * wave + i]; }
          const float kv[8] = {bflo(pk.x), bfhi(pk.x), bflo(pk.y), bfhi(pk.y), bflo(pk.z), bfhi(pk.z), bflo(pk.w), bfhi(pk.w)};
          if (PASS == 2) {
              const float qv[8] = {bflo(pq.x), bfhi(pq.x), bflo(pq.y), bfhi(pq.y), bflo(pq.z), bfhi(pq.z), bflo(pq.w), bfhi(pq.w)};
              float qd[8], kd[8];
#pragma unroll
              for (int i = 0; i < 8; ++i) { qd[i] = qv[i] * qscale * __expf(bc[i]); kd[i] = kv[i] * __expf(-bc[i]); }
              u32x4 w; w.x = pk2(qd[0], qd[1]); w.y = pk2(qd[2], qd[3]); w.z = pk2(qd[4], qd[5]); w.w = pk2(qd[6], qd[7]);
              *(LAS u32x4*)(QD + s_l * G_ST + 16 * wave) = w;
              w.x = pk2(kd[0], kd[1]); w.y = pk2(kd[2], kd[3]); w.z = pk2(kd[4], kd[5]); w.w = pk2(kd[6], kd[7]);
              *(LAS u32x4*)(KD + s_l * G_ST + 16 * wave) = w;
          }
#pragma unroll
          for (int i = 0; i < 8; ++i) *(LAS bf16*)(KCT + (8 * wave + i) * G_ST + 2 * s_l) = (bf16)f2bf(kv[i] * __expf(bl[i] - bc[i]));
          const unsigned vv[8] = {pv0.x, pv0.y, pv0.z, pv0.w, pv1.x, pv1.y, pv1.z, pv1.w};
#pragma unroll
          for (int i = 0; i < 8; ++i) { *(LAS bf16*)(VT + (16 * wave + 2 * i) * G_ST + 2 * s_l) = (bf16)(vv[i] & 0xffffu); *(LAS bf16*)(VT + (16 * wave + 2 * i + 1) * G_ST + 2 * s_l) = (bf16)(vv[i] >> 16); }
        }
        const float dec = __expf(bcs[63 * 65 + nd * 32 + (lane & 31)]);
        if (n + 1 < GSC) GLA_LOAD(n + 1);
        __syncthreads();
        if (PASS == 2) {
            if (wave < 4) {
                const int ms = wave >> 1, ns = wave & 1;
                f32x16 sa;
#pragma unroll
                for (int r = 0; r < 16; ++r) sa[r] = 0.f;
                if (ns <= ms) {
#pragma unroll
                    for (int ks = 0; ks < 4; ++ks) sa = MFMA32(ldfrag32(QD, ms * 32, ks, lane), ldfrag32(KD, ns * 32, ks, lane), sa);
                }
#pragma unroll
                for (int r = 0; r < 16; ++r) { const int s = ms * 32 + crow(r, lane >> 5), s2 = ns * 32 + (lane & 31);
                    const bool keep = dir ? (s2 < s) : (s2 <= s);
                    *(LAS bf16*)(SS + s * G_ST + 2 * s2) = (bf16)f2bf(keep ? sa[r] : 0.f); }
            }
            __syncthreads();
            { const int ms = wave >> 2, ne = wave & 3;
              f32x16 oa;
#pragma unroll
              for (int r = 0; r < 16; ++r) oa[r] = 0.f;
#pragma unroll
              for (int ks = 0; ks < 4; ++ks) oa = MFMA32(ldfrag32(SS, ms * 32, ks, lane), ldfrag32(VT, ne * 32, ks, lane), oa);
#pragma unroll
              for (int ks = 0; ks < 4; ++ks) oa = MFMA32(ldfrag32(QD, ms * 32, ks, lane), ldfrag32(STT, ne * 32, ks, lane), oa);
              float* op = (float*)(ws + (dir ? WS_OB : WS_OF));
#pragma unroll
              for (int r = 0; r < 16; ++r) { const size_t tk = tok_of(n, ms * 32 + crow(r, lane >> 5)); op[tk * 512 + h * 128 + ne * 32 + (lane & 31)] = oa[r]; }
            }
            __syncthreads();
        }
#pragma unroll
        for (int r = 0; r < 16; ++r) st[r] *= dec;
        dtot *= dec;
#pragma unroll
        for (int ks = 0; ks < 4; ++ks) st = MFMA32(ldfrag32(VT, me * 32, ks, lane), ldfrag32(KCT, nd * 32, ks, lane), st);
        if (PASS == 2 && n + 1 < GSC) {
#pragma unroll
            for (int r = 0; r < 16; ++r) *(LAS bf16*)(STT + (me * 32 + crow(r, lane >> 5)) * G_ST + (nd * 32 + (lane & 31)) * 2) = (bf16)f2bf(st[r]);
        }
    }
    if (PASS == 1) {
        float* gs = GS + (size_t)item * 8192 + nd * 32 + (lane & 31);
#pragma unroll
        for (int r = 0; r < 16; ++r) gs[(size_t)(me * 32 + crow(r, lane >> 5)) * 64] = st[r];
        if (me == 0 && lane < 32) GD[(size_t)item * 64 + nd * 32 + lane] = dtot;
    }
    __syncthreads();
#undef GLA_LOAD
}
constexpr int AT_KST = 144, AT_VST = 656, AT_K = 0, AT_V = 320 * AT_KST, AT_BT = AT_V + 64 * AT_VST, AT_END = AT_BT + 4 * 260 * 4;
static_assert(AT_END <= RING_BYTES && AT_V % 16 == 0 && AT_BT % 16 == 0, "attention LDS");
__device__ __forceinline__ void attn_phase(unsigned char* ws, const float* sink, LAS unsigned char* lds, int bid, int G, int tid, int wave, int lane) {
    const bf16* qkv = (const bf16*)(ws + WS_QKV); bf16* ao = (bf16*)(ws + WS_AO); const float* btab = (const float*)(ws + WS_BTAB);
    LAS unsigned char* KS = lds + AT_K; LAS unsigned char* VT = lds + AT_V; LAS float* BT = (LAS float*)(lds + AT_BT);
    const float sc2 = 0.125f * LOG2E;
    for (int u = bid; u < NB * 4 * (SEQ / 64); u += G) {
        const int qb = u % (SEQ / 64), kvh = (u / (SEQ / 64)) & 3, b = u / (4 * (SEQ / 64)), q0 = qb * 64, kbase = q0 - 128;
        for (int p = tid; p < 320 * 8; p += NTHR) {
            const int i = p >> 3, ch = p & 7; int key = kbase + i; key = key < 0 ? 0 : (key > SEQ - 1 ? SEQ - 1 : key);
            const u32x4 kq = *(const u32x4*)(qkv + ((size_t)b * SEQ + key) * CN + 1024 + kvh * 64 + 8 * ch);
            *(LAS u32x4*)(KS + i * AT_KST + 16 * ch) = kq;
        }
        for (int p = tid; p < 320 * 8; p += NTHR) {
            const int i = p % 320, ch = p / 320; int key = kbase + i; key = key < 0 ? 0 : (key > SEQ - 1 ? SEQ - 1 : key);
            const u32x4 vq = *(const u32x4*)(qkv + ((size_t)b * SEQ + key) * CN + 1280 + kvh * 64 + 8 * ch);
            const unsigned vv[4] = {vq.x, vq.y, vq.z, vq.w};
#pragma unroll
            for (int j = 0; j < 4; ++j) { *(LAS bf16*)(VT + (8 * ch + 2 * j) * AT_VST + 2 * i) = (bf16)(vv[j] & 0xffffu); *(LAS bf16*)(VT + (8 * ch + 2 * j + 1) * AT_VST + 2 * i) = (bf16)(vv[j] >> 16); }
        }
        for (int p = tid; p < 4 * 260; p += NTHR) BT[p] = btab[(kvh * 4) * 260 + p];
        __syncthreads();
        const int hl = wave >> 1, hq = kvh * 4 + hl, qw = q0 + 32 * (wave & 1), qi = qw + (lane & 31), hh = lane >> 5;
        bf16x8 qf[4];
        { const bf16* qp = qkv + ((size_t)b * SEQ + qi) * CN + hq * 64 + 8 * hh;
#pragma unroll
          for (int ks = 0; ks < 4; ++ks) qf[ks] = *(const bf16x8*)(qp + 16 * ks); }
        float m = sink[hq] * LOG2E, l = hh == 0 ? 1.f : 0.f;
        f32x16 o0, o1;
#pragma unroll
        for (int r = 0; r < 16; ++r) { o0[r] = 0.f; o1[r] = 0.f; }
        const LAS float* btr = BT + hl * 260 + 128 - (lane & 31);
#pragma unroll 1
        for (int j = 0; j < 9; ++j) {
            const int i0 = 32 * (wave & 1) + 32 * j;
            f32x16 sa;
#pragma unroll
            for (int r = 0; r < 16; ++r) sa[r] = 0.f;
#pragma unroll
            for (int ks = 0; ks < 4; ++ks) { const bf16x8 kf = *(const LAS bf16x8*)(KS + (i0 + (lane & 31)) * AT_KST + 32 * ks + 16 * hh); sa = MFMA32(kf, qf[ks], sa); }
            float mx = -3.0e38f;
#pragma unroll
            for (int r = 0; r < 16; ++r) {
                const int kk = 32 * j - 128 + crow(r, hh);
                const int rel = kk - (lane & 31), key = qw + kk;
                const bool ok = (rel >= -128) && (rel <= 128) && (key >= 0) && (key < SEQ);
                const float s = ok ? (sa[r] * sc2 + btr[kk]) : -3.0e38f;
                sa[r] = s; mx = fmaxf(mx, s);
            }
            mx = fmaxf(mx, __shfl_xor(mx, 32));
            const float mn = fmaxf(m, mx), alpha = exp2f(m - mn); m = mn;
            float ps = 0.f;
#pragma unroll
            for (int r = 0; r < 16; ++r) { const float p = exp2f(sa[r] - mn); sa[r] = p; ps += p; }
            l = l * alpha + ps;
#pragma unroll
            for (int r = 0; r < 16; ++r) { o0[r] *= alpha; o1[r] *= alpha; }
#pragma unroll
            for (int s = 0; s < 2; ++s) {
                u32x4 pw; pw.x = pk2(sa[8 * s], sa[8 * s + 1]); pw.y = pk2(sa[8 * s + 2], sa[8 * s + 3]); pw.z = pk2(sa[8 * s + 4], sa[8 * s + 5]); pw.w = pk2(sa[8 * s + 6], sa[8 * s + 7]);
                const bf16x8 pf = __builtin_bit_cast(bf16x8, pw);
#pragma unroll
                for (int dt = 0; dt < 2; ++dt) {
                    const LAS unsigned char* vp = VT + (dt * 32 + (lane & 31)) * AT_VST + 2 * (i0 + 16 * s + 4 * hh);
                    const bf16x4 va = *(const LAS bf16x4*)vp, vb = *(const LAS bf16x4*)(vp + 16);
                    const bf16x8 vf = __builtin_shufflevector(va, vb, 0, 1, 2, 3, 4, 5, 6, 7);
                    if (dt == 0) o0 = MFMA32(vf, pf, o0); else o1 = MFMA32(vf, pf, o1);
                }
            }
        }
        l += __shfl_xor(l, 32);
        const float inv = 1.f / l;
        bf16* op = ao + ((size_t)b * SEQ + qi) * D + hq * 64 + 4 * hh;
#pragma unroll
        for (int g = 0; g < 4; ++g) {
            u32x2 w0, w1; w0.x = pk2(o0[4 * g] * inv, o0[4 * g + 1] * inv); w0.y = pk2(o0[4 * g + 2] * inv, o0[4 * g + 3] * inv);
            w1.x = pk2(o1[4 * g] * inv, o1[4 * g + 1] * inv); w1.y = pk2(o1[4 * g + 2] * inv, o1[4 * g + 3] * inv);
            *(u32x2*)(op + 8 * g) = w0; *(u32x2*)(op + 32 + 8 * g) = w1;
        }
        __syncthreads();
    }
}
#ifndef MK_N_LAUNCHES
#define MK_N_LAUNCHES 1
#endif
constexpr int N_PHASES = 19;
#ifndef PH_MASK
#define PH_MASK 0xFFFFFFFFu
#endif
#define ON(k) (((PH_MASK) >> (k)) & 1u)
#ifndef REP_MASK
#define REP_MASK 0u
#endif
#define NREP(k) ((((REP_MASK) >> (k)) & 1u) ? 2 : 1)

template <int LAYER>
__device__ __forceinline__ void common_phases(unsigned char* ws, LAS unsigned char* lds, float* dout, const XcdBarrier& bar, int lo, int hi, int bid, int G, int tid, int wave, int lane) {
    constexpr int pb = LAYER == 0 ? 5 : 13;
    const int gw = bid * NWAVES + wave, NGW = G * NWAVES;
#define IN(k) (lo <= (k) && (k) < hi)
#define SEAM(k) do { if (IN(k) && IN((k) + 1)) xcd_barrier(bar); } while (0)
    if (ON(5) && IN(pb)) {
        pg8::Gemm g{(const bf16*)(ws + (LAYER == 0 ? WS_X64 : WS_AO)), (const bf16*)(ws + (LAYER == 0 ? WS_WOUT : WS_COUT)), T, D, D, 0, nullptr}; pg8::StaticOrder S; S.init(T, D, G, bid);
        pg8::EpiResid E{LAYER == 0 ? inp(lds, I_X) : (const float*)(ws + WS_H1), (float*)(ws + WS_Z), D, ALPHA};
        pg8::gemm_phase<pg8::EpiResid, pg8::StaticOrder, false>(lds, g, S, E);
    }
    SEAM(pb);
    if (ON(6) && IN(pb + 1)) { ln_router(ws, inp(lds, I_LNMG) + LAYER * D, inp(lds, I_LNMB) + LAYER * D, inp(lds, I_BGRP) + LAYER * 4, inp(lds, I_BRT) + LAYER * 32, LAYER, lds, bid, G, tid, wave, lane); __syncthreads(); }
    SEAM(pb + 1);
    if (ON(7) && IN(pb + 2)) { moe_sort(ws, lds, bid, G, tid); __syncthreads(); }
    SEAM(pb + 2);
    if (ON(8) && IN(pb + 3)) {
        const int* tile = (const int*)(ws + WS_TILE); const int ntiles = __builtin_amdgcn_readfirstlane(tile[511]);
        pg8::Gemm g{(const bf16*)(ws + WS_X64), (const bf16*)(ws + WS_W13), 0, D, D, (size_t)D * D * 2, (const int*)(ws + WS_SLOTT)};
        pg8::GroupOrder S{tile, ntiles, D / 256, G, bid};
        pg8::EpiSwiglu E{(bf16*)(ws + WS_HID), DEXP};
        pg8::gemm_phase<pg8::EpiSwiglu, pg8::GroupOrder, true>(lds, g, S, E);
    }
    SEAM(pb + 3);
    if (ON(9) && IN(pb + 4)) {
        const int* tile = (const int*)(ws + WS_TILE); const int ntiles = __builtin_amdgcn_readfirstlane(tile[511]);
        pg8::Gemm g{(const bf16*)(ws + WS_HID), (const bf16*)(ws + WS_W2), 0, D, DEXP, (size_t)D * DEXP * 2, nullptr};
        pg8::GroupOrder S{tile, ntiles, D / 256, G, bid};
        pg8::EpiScale E{(bf16*)(ws + WS_Y2), D, (const float*)(ws + WS_SLOTW)};
        pg8::gemm_phase<pg8::EpiScale, pg8::GroupOrder, false>(lds, g, S, E);
    }
    SEAM(pb + 4);
    if (ON(10) && IN(pb + 5)) {
        if (LAYER == 0) {
            combine_ln<false>(ws, inp(lds, I_LNFG), inp(lds, I_LNFB), nullptr, gw, NGW, lane);
            moe_convert(inp(lds, I_W1) + (size_t)NEXP * D * DEXP, inp(lds, I_W3) + (size_t)NEXP * D * DEXP, inp(lds, I_W2) + (size_t)NEXP * DEXP * D, (bf16*)(ws + WS_W13), (bf16*)(ws + WS_W2), (LAS float*)(lds + wave * 16384), gw, NGW, lane);
            __syncthreads();
        } else combine_ln<true>(ws, inp(lds, I_LNFG) + D, inp(lds, I_LNFB) + D, dout, gw, NGW, lane);
    }
    if (LAYER == 0) SEAM(10);
#undef IN
#undef SEAM
}

struct Args { const float* in[N_IN]; float* out; unsigned char* ws; int ph_lo, ph_hi; };
static_assert(sizeof(Args) == N_IN * 8 + 8 + 8 + 8, "no padding holes in Args");

__global__ void __launch_bounds__(NTHR, 2) fwd_kernel(Args args) {
    extern __shared__ __attribute__((aligned(16))) unsigned char lds_raw[];
    LAS unsigned char* lds = (LAS unsigned char*)lds_raw;
    volatile LAS unsigned* MISC = (volatile LAS unsigned*)(lds + MISC_OFF);
    const int tid = threadIdx.x, lane = tid & 63, wave = __builtin_amdgcn_readfirstlane(tid >> 6), G = gridDim.x, bid = blockIdx.x;
    unsigned char* ws = args.ws;
    for (int u = tid; u < 64; u += NTHR) MISC[u] = 0u;
    if (tid < N_IN) *(LAS unsigned long long*)(lds + PTR_OFF + 8 * tid) = (unsigned long long)args.in[tid];
    __syncthreads();
    const int lo = args.ph_lo, hi = args.ph_hi;
    const bool use_bar = (hi - lo) > 1;
    XcdBarrier bar; bar.bar = (unsigned*)(ws + WS_CTL) + CW_BAR; bar.x = 0; bar.st = nullptr;
    if (use_bar) bar = xcd_barrier_post((unsigned*)(ws + WS_CTL) + CW_BAR, MISC + 8);
#define IN(k) (lo <= (k) && (k) < hi)
#define SEAM(k) do { if (IN(k) && IN((k) + 1)) xcd_barrier(bar); } while (0)
    const int gw = bid * NWAVES + wave, NGW = G * NWAVES;

    if (ON(0) && IN(0)) { p0_prologue(ws, lds, bid, G, tid, wave, lane); __syncthreads(); }
    SEAM(0);
    if (ON(1) && IN(1)) {
        pg8::Gemm g{(const bf16*)(ws + WS_X64), (const bf16*)(ws + WS_WIN), T, ABN, D, 0, nullptr}; pg8::StaticOrder S; S.init(T, ABN, G, bid);
        pg8::EpiBf16 E{(bf16*)(ws + WS_H0), ABN};
        pg8::gemm_phase<pg8::EpiBf16, pg8::StaticOrder, false>(lds, g, S, E);
        lr_tail(ws, bid, G, wave, lane);
    }
    SEAM(1);
    if (ON(2) && IN(2)) {
        s5_phase<1>(ws, inp(lds, I_S5D), lds, bid, G, tid, wave, lane);
        __syncthreads();
        for (int it = bid; it < 256; it += G) gla_item<1>(ws, inp(lds, I_GATEW), inp(lds, I_GATEB), it, lds, tid, wave, lane);
    }
    SEAM(2);
    if (ON(3) && IN(3)) {
        s5_phase<2>(ws, inp(lds, I_S5D), lds, bid, G, tid, wave, lane);
        __syncthreads();
        for (int it = bid; it < 256; it += G) gla_item<2>(ws, inp(lds, I_GATEW), inp(lds, I_GATEB), it, lds, tid, wave, lane);
    }
    SEAM(3);
    if (ON(4) && IN(4)) {
        gla_finalize(ws, inp(lds, I_NORMG), gw, NGW, lane);
        pg8::Gemm g{(const bf16*)(ws + WS_YG), (const bf16*)(ws + WS_WGLU), T, 512, 512, 0, nullptr}; pg8::StaticOrder S; S.init(T, 512, G, bid);
        pg8::EpiGlu E{(const bf16*)(ws + WS_YG), 512, (bf16*)(ws + WS_X64), D, inp(lds, I_GLUB)};
        pg8::gemm_phase<pg8::EpiGlu, pg8::StaticOrder, false>(lds, g, S, E);
    }
    SEAM(4);
    common_phases<0>(ws, lds, args.out, bar, lo, hi, bid, G, tid, wave, lane);
    if (ON(11) && IN(11)) {
        pg8::Gemm g{(const bf16*)(ws + WS_H2B), (const bf16*)(ws + WS_CIN), T, CN, D, 0, nullptr}; pg8::StaticOrder S; S.init(T, CN, G, bid);
        pg8::EpiBf16 E{(bf16*)(ws + WS_QKV), CN};
        pg8::gemm_phase<pg8::EpiBf16, pg8::StaticOrder, false>(lds, g, S, E);
    }
    SEAM(11);
    if (ON(12) && IN(12)) attn_phase(ws, inp(lds, I_SINK), lds, bid, G, tid, wave, lane);
    SEAM(12);
    common_phases<1>(ws, lds, args.out, bar, lo, hi, bid, G, tid, wave, lane);
#undef IN
#undef SEAM
}

extern "C" void kernel_launch(void* const* d_in, const int* in_sizes, int n_in, void* d_out, int out_size, void* d_ws, size_t ws_size, hipStream_t stream) {
    static int grid = 0;
    if (grid == 0) {
        if (n_in != N_IN || in_sizes[0] != T * D || out_size != T * D || ws_size < WS_END) { fprintf(stderr, "kernel_launch: unexpected shapes (n_in %d, in0 %d, out %d, ws %zu < %zu)\n", n_in, n_in > 0 ? in_sizes[0] : -1, out_size, ws_size, (size_t)WS_END); grid = -1; return; }
        int dev = 0, cus = 0, per_cu = 0;
        if (hipGetDevice(&dev) != hipSuccess || hipDeviceGetAttribute(&cus, hipDeviceAttributeMultiprocessorCount, dev) != hipSuccess) { grid = -1; return; }
        if (hipFuncSetAttribute((const void*)fwd_kernel, hipFuncAttributeMaxDynamicSharedMemorySize, LDS_BYTES) != hipSuccess) { fprintf(stderr, "kernel_launch: hipFuncSetAttribute failed\n"); grid = -1; return; }
        if (hipOccupancyMaxActiveBlocksPerMultiprocessor(&per_cu, (const void*)fwd_kernel, NTHR, LDS_BYTES) != hipSuccess || per_cu < 1) fprintf(stderr, "kernel_launch: occupancy query reports %d\n", per_cu);
        (void)hipGetLastError();
        grid = cus;
    }
    if (grid < 0) return;
    if (hipMemsetAsync((char*)d_ws + WS_CTL, 0, CTL_ZERO_BYTES, stream) != hipSuccess) return;
    Args a{};
    for (int i = 0; i < N_IN; ++i) a.in[i] = (const float*)d_in[i];
    a.out = (float*)d_out; a.ws = (unsigned char*)d_ws;
    for (int li = 0; li < MK_N_LAUNCHES; ++li) {
        a.ph_lo = (MK_N_LAUNCHES == 1) ? 0 : li; a.ph_hi = (MK_N_LAUNCHES == 1) ? N_PHASES : li + 1;
        for (int rep = 0; rep < ((MK_N_LAUNCHES > 1 && ((REP_MASK >> li) & 1u)) ? 2 : 1); ++rep)
            hipLaunchKernelGGL(fwd_kernel, dim3(grid), dim3(NTHR), LDS_BYTES, stream, a);
    }
}
```

```cpp
#include <hip/hip_runtime.h>
#include <cstdio>
#include <cstdint>
#include <cmath>
namespace pg8 {
#define PG8_LAS __attribute__((address_space(3)))
typedef unsigned short bf16_t;
typedef short bf16x8 __attribute__((ext_vector_type(8)));
typedef float f32x4 __attribute__((ext_vector_type(4)));
typedef float f32x2 __attribute__((ext_vector_type(2)));
typedef unsigned u32x4 __attribute__((ext_vector_type(4)));
typedef unsigned u32x2 __attribute__((ext_vector_type(2)));
constexpr int BM = 256, BK = 64, HALF = 128, HTB = HALF * BK * 2  , STAGE_BYTES = 8 * HTB, NXCD = 8, WGM = 8;

__host__ __device__ __forceinline__ int lds_byte(int r, int c) { const int st = (r >> 4) * 2 + (c >> 5), rr = r & 15, cc = c & 31, ob = rr * 64 + cc * 2; return st * 1024 + (ob ^ (((ob >> 9) & 1) << 5)); }
__host__ __device__ __forceinline__ void stage_rc(int b, int& R, int& C) { const int st = b / 1024, sb = b % 1024, swz = sb ^ (((sb >> 9) & 1) << 5); R = (st >> 1) * 16 + swz / 64; C = (st & 1) * 32 + (swz % 64) / 2; }
__host__ __device__ __forceinline__ int perm32(int rho) { const int n = rho >> 4, i = rho & 15; return 8 * (i >> 2) + 4 * n + (i & 3); }

struct Unit { int pm, pn, e; };
struct Gemm { const bf16_t* A; const bf16_t* Bt; int M, N, K; size_t bstride; const int* rowmap; };

struct StaticOrder {
    int nM, nN, nwg, G, c;
    __host__ __device__ void init(int M, int N, int G_, int c_) { nM = M / BM; nN = N / BM; nwg = nM * nN; G = G_; c = c_; }
    __host__ __device__ bool next(int i, Unit& u) const {
        const long L = (long)i * G + c; if (L >= nwg) return false;
        int wgid = (int)L; { const int q = nwg / NXCD, r = nwg % NXCD, xcd = wgid % NXCD, off = wgid / NXCD; wgid = (xcd < r ? xcd * (q + 1) : r * (q + 1) + (xcd - r) * q) + off; }
        const int nig = WGM * nN, gid = wgid / nig, fm = gid * WGM, gsz = (nM - fm) < WGM ? (nM - fm) : WGM;
        u.pm = fm + ((wgid % nig) % gsz); u.pn = (wgid % nig) / gsz; u.e = 0; return true;
    }
};
struct GroupOrder {
    const int* tile_e; int ntiles, nN, G, c;
    __device__ bool next(int i, Unit& u) const {
        const int L = i * G + c; if (L >= ntiles * nN) return false;
        u.pm = L / nN; u.pn = L % nN; u.e = __builtin_amdgcn_readfirstlane(tile_e[u.pm]); return true;
    }
};

typedef __bf16 bf16x2_t __attribute__((ext_vector_type(2)));
__device__ __forceinline__ unsigned cvt_pk_bf16(float lo, float hi) { f32x2 v = {lo, hi}; return __builtin_bit_cast(unsigned, __builtin_convertvector(v, bf16x2_t)); }
__device__ __forceinline__ float bf_lo(unsigned w) { return __uint_as_float(w << 16); }
__device__ __forceinline__ float bf_hi(unsigned w) { return __uint_as_float(w & 0xffff0000u); }

struct EpiBf16 {
    static constexpr bool PERM = true;
    bf16_t* O; int ldc;
    __device__ __forceinline__ void operator()(const f32x4 (&acc)[2][2][4][2], const Unit& u, int wr, int wc, int fr, int fq) const {
        const int row0 = u.pm * BM + wr * 64 + fr; const int col0 = u.pn * BM + wc * 32 + 8 * fq;
#pragma unroll
        for (int ai = 0; ai < 2; ++ai)
#pragma unroll
            for (int m = 0; m < 4; ++m) { bf16_t* rowp = O + (size_t)(row0 + ai * HALF + m * 16) * ldc + col0;
#pragma unroll
                for (int bj = 0; bj < 2; ++bj) { const f32x4 v0 = acc[ai][bj][m][0], v1 = acc[ai][bj][m][1];
                    u32x4 w; w.x = cvt_pk_bf16(v0[0], v0[1]); w.y = cvt_pk_bf16(v0[2], v0[3]); w.z = cvt_pk_bf16(v1[0], v1[1]); w.w = cvt_pk_bf16(v1[2], v1[3]);
                    *(u32x4*)(rowp + bj * HALF) = w; } }
    }
};
struct EpiGlu {
    static constexpr bool PERM = true;
    const bf16_t* Y; int ldy; bf16_t* O; int ldc; const float* bias;
    __device__ __forceinline__ void operator()(const f32x4 (&acc)[2][2][4][2], const Unit& u, int wr, int wc, int fr, int fq) const {
        const int row0 = u.pm * BM + wr * 64 + fr; const int col0 = u.pn * BM + wc * 32 + 8 * fq;
        f32x4 bv[2][2];
#pragma unroll
        for (int bj = 0; bj < 2; ++bj)
#pragma unroll
            for (int n = 0; n < 2; ++n) bv[bj][n] = *(const f32x4*)(bias + col0 + bj * HALF + 4 * n);
#pragma unroll
        for (int ai = 0; ai < 2; ++ai) {
            u32x4 yq[4][2];
#pragma unroll
            for (int m = 0; m < 4; ++m)
#pragma unroll
                for (int bj = 0; bj < 2; ++bj) yq[m][bj] = *(const u32x4*)(Y + (size_t)(row0 + ai * HALF + m * 16) * ldy + col0 + bj * HALF);
            asm volatile("" ::: "memory");
#pragma unroll
            for (int m = 0; m < 4; ++m) { const size_t r = (size_t)(row0 + ai * HALF + m * 16);
#pragma unroll
                for (int bj = 0; bj < 2; ++bj) { const f32x4 v0 = acc[ai][bj][m][0] + bv[bj][0], v1 = acc[ai][bj][m][1] + bv[bj][1];
                    const u32x4 y = yq[m][bj];
                    float o[8]; const float yv[8] = {bf_lo(y.x), bf_hi(y.x), bf_lo(y.y), bf_hi(y.y), bf_lo(y.z), bf_hi(y.z), bf_lo(y.w), bf_hi(y.w)};
#pragma unroll
                    for (int i = 0; i < 4; ++i) { o[i] = yv[i] / (1.f + __expf(-v0[i])); o[4 + i] = yv[4 + i] / (1.f + __expf(-v1[i])); }
                    u32x4 w; w.x = cvt_pk_bf16(o[0], o[1]); w.y = cvt_pk_bf16(o[2], o[3]); w.z = cvt_pk_bf16(o[4], o[5]); w.w = cvt_pk_bf16(o[6], o[7]);
                    *(u32x4*)(O + r * ldc + col0 + bj * HALF) = w; } }
            asm volatile("" ::: "memory");
        }
    }
};
struct EpiResid {
    static constexpr bool PERM = false;
    const float* resid; float* out; int ldc; float alpha;
    __device__ __forceinline__ void operator()(const f32x4 (&acc)[2][2][4][2], const Unit& u, int wr, int wc, int fr, int fq) const {
        const int col0 = u.pn * BM + wc * 32 + 4 * fq;
#pragma unroll
        for (int ai = 0; ai < 2; ++ai) {
            f32x4 bs[4][2][2];
#pragma unroll
            for (int m = 0; m < 4; ++m) { const size_t off = (size_t)(u.pm * BM + ai * HALF + wr * 64 + m * 16 + fr) * ldc + col0;
#pragma unroll
                for (int bj = 0; bj < 2; ++bj)
#pragma unroll
                    for (int n = 0; n < 2; ++n) bs[m][bj][n] = *(const f32x4*)(resid + off + bj * HALF + n * 16); }
            asm volatile("" ::: "memory");
#pragma unroll
            for (int m = 0; m < 4; ++m) { const size_t off = (size_t)(u.pm * BM + ai * HALF + wr * 64 + m * 16 + fr) * ldc + col0;
#pragma unroll
                for (int bj = 0; bj < 2; ++bj)
#pragma unroll
                    for (int n = 0; n < 2; ++n) *(f32x4*)(out + off + bj * HALF + n * 16) = bs[m][bj][n] * alpha + acc[ai][bj][m][n]; }
            asm volatile("" ::: "memory");
        }
    }
};
struct EpiSwiglu {
    static constexpr bool PERM = true;
    bf16_t* O; int ldc;
    __device__ __forceinline__ void operator()(const f32x4 (&acc)[2][2][4][2], const Unit& u, int wr, int wc, int fr, int fq) const {
        const int row0 = u.pm * BM + wr * 64 + fr; const int col0 = (u.pn * BM + wc * 32 + 8 * fq) >> 1;
#pragma unroll
        for (int ai = 0; ai < 2; ++ai)
#pragma unroll
            for (int m = 0; m < 4; ++m) { bf16_t* rowp = O + (size_t)(row0 + ai * HALF + m * 16) * ldc + col0;
#pragma unroll
                for (int bj = 0; bj < 2; ++bj) { const f32x4 g = acc[ai][bj][m][0], up = acc[ai][bj][m][1]; float o[4];
#pragma unroll
                    for (int i = 0; i < 4; ++i) o[i] = g[i] / (1.f + __expf(-g[i])) * up[i];
                    u32x2 w; w.x = cvt_pk_bf16(o[0], o[1]); w.y = cvt_pk_bf16(o[2], o[3]);
                    *(u32x2*)(rowp + bj * (HALF / 2)) = w; } }
    }
};
struct EpiScale {
    static constexpr bool PERM = true;
    bf16_t* O; int ldc; const float* rw;
    __device__ __forceinline__ void operator()(const f32x4 (&acc)[2][2][4][2], const Unit& u, int wr, int wc, int fr, int fq) const {
        const int row0 = u.pm * BM + wr * 64 + fr; const int col0 = u.pn * BM + wc * 32 + 8 * fq;
        float sw[2][4];
#pragma unroll
        for (int ai = 0; ai < 2; ++ai)
#pragma unroll
            for (int m = 0; m < 4; ++m) sw[ai][m] = rw[row0 + ai * HALF + m * 16];
        asm volatile("" ::: "memory");
#pragma unroll
        for (int ai = 0; ai < 2; ++ai)
#pragma unroll
            for (int m = 0; m < 4; ++m) { const int r = row0 + ai * HALF + m * 16; const float s = sw[ai][m]; bf16_t* rowp = O + (size_t)r * ldc + col0;
#pragma unroll
                for (int bj = 0; bj < 2; ++bj) { const f32x4 v0 = acc[ai][bj][m][0] * s, v1 = acc[ai][bj][m][1] * s;
                    u32x4 w; w.x = cvt_pk_bf16(v0[0], v0[1]); w.y = cvt_pk_bf16(v0[2], v0[3]); w.z = cvt_pk_bf16(v1[0], v1[1]); w.w = cvt_pk_bf16(v1[2], v1[3]);
                    *(u32x4*)(rowp + bj * HALF) = w; } }
    }
};

template <class Epi, class Sched, bool GATHER>
__device__ __forceinline__ void gemm_phase(PG8_LAS unsigned char* lds, const Gemm g, const Sched& S, const Epi& E) {
    const int tid = threadIdx.x, wid = __builtin_amdgcn_readfirstlane(tid >> 6), lane = tid & 63, wr = wid >> 2, wc = wid & 3, fr = lane & 15, fq = lane >> 4;
    const int K = g.K, nt = K / BK;
    unsigned voffA[2], voffB[2]; int RA[2], CA[2];
#pragma unroll
    for (int i = 0; i < 2; ++i) { int R, C; stage_rc(tid * 16 + i * 8192, R, C); const int Rb = Epi::PERM ? ((R & ~31) + perm32(R & 31)) : R;
        voffA[i] = (unsigned)(R * K + C) * 2u; voffB[i] = (unsigned)(Rb * K + C) * 2u; RA[i] = R; CA[i] = C; }
    const size_t kstep = (size_t)(BK * 2);
    const size_t hstep = (size_t)HALF * K * 2;
    const size_t tstep = 2 * hstep;
    const unsigned ldsw = (unsigned)wid * 1024u;
    const int aoff = lds_byte(wr * 64 + fr, fq * 8), boff = lds_byte(wc * 32 + fr, fq * 8);
#define PG8_SA(b, h) (((b) * 2 + (h)) * HTB)
#define PG8_SB(b, h) ((4 + (b) * 2 + (h)) * HTB)
#define PG8_STAGE(bufoff, gbase, voff) do { _Pragma("unroll") for (int _i = 0; _i < 2; ++_i) \
        __builtin_amdgcn_global_load_lds((const unsigned*)((const char*)(gbase) + (voff)[_i]), (PG8_LAS unsigned*)(lds + (bufoff) + ldsw + _i * 8192), 16, 0, 0); } while (0)
#define PG8_LDA(dst, b, h) do { _Pragma("unroll") for (int m = 0; m < 4; ++m) _Pragma("unroll") for (int k = 0; k < 2; ++k) dst[m][k] = *(const PG8_LAS bf16x8*)(lds + PG8_SA(b, h) + aoff + m * 2048 + k * 1024); } while (0)
#define PG8_LDB(dst, b, h) do { _Pragma("unroll") for (int n = 0; n < 2; ++n) _Pragma("unroll") for (int k = 0; k < 2; ++k) dst[n][k] = *(const PG8_LAS bf16x8*)(lds + PG8_SB(b, h) + boff + n * 2048 + k * 1024); } while (0)
#define PG8_MMA(ai, bj, At, Bt) do { __builtin_amdgcn_s_setprio(1); _Pragma("unroll") for (int m = 0; m < 4; ++m) _Pragma("unroll") for (int n = 0; n < 2; ++n) _Pragma("unroll") for (int k = 0; k < 2; ++k) \
        acc[ai][bj][m][n] = __builtin_amdgcn_mfma_f32_16x16x32_bf16(Bt[n][k], At[m][k], acc[ai][bj][m][n], 0, 0, 0); __builtin_amdgcn_s_setprio(0); } while (0)
#define PG8_WAIT_V(n) asm volatile("s_waitcnt vmcnt(" #n ")" ::: "memory")
#define PG8_WAIT_L(n) asm volatile("s_waitcnt lgkmcnt(" #n ")" ::: "memory")
#define PG8_BAR __builtin_amdgcn_s_barrier()
#define PG8_SCHED __builtin_amdgcn_sched_barrier(0)
    Unit cur, nxt; int ui = 0;
    if (!S.next(0, cur)) return;
    f32x4 acc[2][2][4][2];
#pragma unroll
    for (int a = 0; a < 2; ++a)
#pragma unroll
        for (int b = 0; b < 2; ++b)
#pragma unroll
            for (int m = 0; m < 4; ++m)
#pragma unroll
                for (int n = 0; n < 2; ++n) acc[a][b][m][n] = (f32x4){0.f, 0.f, 0.f, 0.f};
    bf16x8 At[4][2], B0[2][2], B1[2][2];
    unsigned cG[2][2], nG[2][2];
#define PG8_LOAD_ROWS(u_, G2_) do { _Pragma("unroll") for (int h_ = 0; h_ < 2; ++h_) _Pragma("unroll") for (int i_ = 0; i_ < 2; ++i_) \
        G2_[h_][i_] = GATHER ? ((unsigned)g.rowmap[(u_).pm * BM + h_ * HALF + RA[i_]] * (unsigned)K + (unsigned)CA[i_]) * 2u : voffA[i_]; } while (0)
    const char* cA = GATHER ? (const char*)g.A : (const char*)g.A + (size_t)cur.pm * tstep;
    const size_t hA = GATHER ? 0 : hstep;
    const char* cB = (const char*)g.Bt + (size_t)cur.e * g.bstride + (size_t)cur.pn * tstep;
    PG8_LOAD_ROWS(cur, cG);
    PG8_STAGE(PG8_SB(0, 0), cB, voffB); PG8_STAGE(PG8_SB(0, 1), cB + hstep, voffB); PG8_STAGE(PG8_SA(0, 0), cA, cG[0]); PG8_STAGE(PG8_SA(0, 1), cA + hA, cG[1]);
    if (wr == 1) PG8_BAR;
    PG8_WAIT_V(2); PG8_BAR;
    PG8_STAGE(PG8_SB(1, 0), cB + kstep, voffB); PG8_STAGE(PG8_SA(1, 0), cA + kstep, cG[0]); PG8_STAGE(PG8_SB(1, 1), cB + hstep + kstep, voffB);
    PG8_WAIT_V(6); PG8_BAR;
    for (;;) {
        const bool has_next = S.next(ui + 1, nxt);
        const char* nA = GATHER ? (const char*)g.A : (has_next ? (const char*)g.A + (size_t)nxt.pm * tstep : cA);
        const char* nB = has_next ? (const char*)g.Bt + (size_t)nxt.e * g.bstride + (size_t)nxt.pn * tstep : cB;
        if (has_next) PG8_LOAD_ROWS(nxt, nG); else {
#pragma unroll
            for (int h = 0; h < 2; ++h) { nG[h][0] = cG[h][0]; nG[h][1] = cG[h][1]; } }
        for (int t = 0; t < nt; t += 2) {
            const bool last = (t == nt - 2);
            const char* a1 = cA + (size_t)(t + 1) * kstep;
            const char* a2 = last ? nA : cA + (size_t)(t + 2) * kstep; const char* b2 = last ? nB : cB + (size_t)(t + 2) * kstep;
            const char* a3 = a2 + kstep; const char* b3 = b2 + kstep;
            unsigned sG[2][2];
#pragma unroll
            for (int h = 0; h < 2; ++h) { sG[h][0] = (GATHER && last) ? nG[h][0] : cG[h][0]; sG[h][1] = (GATHER && last) ? nG[h][1] : cG[h][1]; }
            PG8_LDB(B0, 0, 0); PG8_LDB(B1, 0, 1); PG8_SCHED; PG8_LDA(At, 0, 0); PG8_STAGE(PG8_SA(1, 1), a1 + hA, cG[1]);
            PG8_WAIT_V(8); PG8_WAIT_L(0); PG8_BAR; PG8_MMA(0, 0, At, B0); PG8_MMA(0, 1, At, B1); PG8_BAR; PG8_SCHED;
            PG8_LDA(At, 0, 1); PG8_STAGE(PG8_SB(0, 0), b2, voffB); PG8_STAGE(PG8_SB(0, 1), b2 + hstep, voffB); PG8_STAGE(PG8_SA(0, 0), a2, sG[0]);
            PG8_WAIT_V(8); PG8_WAIT_L(0); PG8_BAR; PG8_MMA(1, 0, At, B0); PG8_MMA(1, 1, At, B1); PG8_BAR; PG8_SCHED;
            PG8_LDB(B0, 1, 0); PG8_LDB(B1, 1, 1); PG8_SCHED; PG8_LDA(At, 1, 0); PG8_STAGE(PG8_SA(0, 1), a2 + hA, sG[1]);
            PG8_WAIT_V(8); PG8_WAIT_L(0); PG8_BAR; PG8_MMA(0, 0, At, B0); PG8_MMA(0, 1, At, B1); PG8_BAR; PG8_SCHED;
            PG8_LDA(At, 1, 1); PG8_STAGE(PG8_SB(1, 0), b3, voffB); PG8_STAGE(PG8_SB(1, 1), b3 + hstep, voffB); PG8_STAGE(PG8_SA(1, 0), a3, sG[0]);
            PG8_WAIT_V(8); PG8_WAIT_L(0); PG8_BAR; PG8_MMA(1, 0, At, B0); PG8_MMA(1, 1, At, B1); PG8_BAR; PG8_SCHED;
        }
        if (wr == 0) PG8_BAR;
        E(acc, cur, wr, wc, fr, fq);
        if (!has_next) break;
#pragma unroll
        for (int a = 0; a < 2; ++a)
#pragma unroll
            for (int b = 0; b < 2; ++b)
#pragma unroll
                for (int m = 0; m < 4; ++m)
#pragma unroll
                    for (int n = 0; n < 2; ++n) acc[a][b][m][n] = (f32x4){0.f, 0.f, 0.f, 0.f};
        cur = nxt; cA = nA; cB = nB; ++ui;
#pragma unroll
        for (int h = 0; h < 2; ++h) { cG[h][0] = nG[h][0]; cG[h][1] = nG[h][1]; }
        if (wr == 1) PG8_BAR;
    }
    PG8_WAIT_V(0);
    PG8_BAR;
#undef PG8_LOAD_ROWS
#undef PG8_SA
#undef PG8_SB
#undef PG8_STAGE
#undef PG8_LDA
#undef PG8_LDB
#undef PG8_MMA
#undef PG8_WAIT_V
#undef PG8_WAIT_L
#undef PG8_BAR
#undef PG8_SCHED
}
}
constexpr int NB = 2, SEQ = 16384, T = NB * SEQ, D = 1024;
constexpr int H0P = 2112;
constexpr int ABN = 2048, OFF_U = 0, OFF_Q = 512, OFF_K = 768, OFF_V = 1024, OFF_GO = 1536, AB_IN = 2080;
constexpr int CN = 1536;
constexpr int NEXP = 32, DEXP = 512, CAP = 2 * T + NEXP * 256, MAXTILES = CAP / 256;
constexpr int S5CH = 256, S5NCH = SEQ / S5CH;
constexpr int GSC = 16, GCH = 64, GNSC = SEQ / (GSC * GCH);
constexpr float ALPHA = 1.41421356237309515f;
constexpr float LN_EPS = 1e-5f, RMS_EPS = 1e-6f, LOG2E = 1.44269504088896341f;
constexpr int NWAVES = 8, NTHR = 512;

constexpr size_t MiB = 1u << 20, KiB = 1u << 10;
constexpr size_t WS_CTL = 0, CTL_ZERO_BYTES = 64 * KiB;
constexpr int CW_BAR = 4096;
constexpr size_t WS_LR = 1 * MiB;
constexpr size_t WS_S5E = 5 * MiB;
constexpr size_t WS_GS = 9 * MiB;
constexpr size_t WS_GD = 17 * MiB;
constexpr size_t WS_S5L = WS_GD + 64 * KiB;
constexpr size_t WS_S5B = WS_S5L + 64 * KiB;
constexpr size_t WS_S5C = WS_S5B + 256 * KiB;
constexpr size_t WS_BTAB = WS_S5C + 256 * KiB;
constexpr size_t WS_WR = WS_BTAB + 32 * KiB;
constexpr size_t WS_TOKE = WS_WR + 384 * KiB;
constexpr size_t WS_TOKW = WS_TOKE + 256 * KiB;
constexpr size_t WS_TOKS = WS_TOKW + 256 * KiB;
constexpr size_t WS_SLOTT = WS_TOKS + 256 * KiB;
constexpr size_t WS_SLOTW = WS_SLOTT + 288 * KiB;
constexpr size_t WS_BLKC = WS_SLOTW + 288 * KiB;
constexpr size_t WS_TILE = WS_BLKC + 32 * KiB;
static_assert(WS_TILE + 4 * KiB <= 32 * MiB, "param region");
constexpr size_t WS_WIN = 32 * MiB, WS_WLR = 36 * MiB, WS_WGLU = 37 * MiB, WS_WOUT = 38 * MiB, WS_CIN = 40 * MiB, WS_COUT = 43 * MiB;
constexpr size_t WS_W13 = 48 * MiB, WS_W2 = 112 * MiB;
constexpr size_t A0 = 144 * MiB;
constexpr size_t WS_H1 = A0, WS_H0 = A0;
constexpr size_t WS_Z = A0 + 128 * MiB;
constexpr size_t WS_YG = A0 + 136 * MiB, WS_OF = A0 + 168 * MiB, WS_OB = A0 + 320 * MiB;
constexpr size_t WS_YSCR = A0 + 232 * MiB;
constexpr size_t WS_X64 = A0 + 256 * MiB;
constexpr size_t WS_HID = A0 + 128 * MiB;
constexpr size_t WS_Y2 = A0 + 200 * MiB;
constexpr size_t WS_H2B = A0 + 128 * MiB;
constexpr size_t WS_QKV = A0 + 192 * MiB;
constexpr size_t WS_AO = A0 + 288 * MiB;
constexpr size_t WS_END = A0 + 384 * MiB;
static_assert((size_t)T * H0P * 2 <= 136 * MiB && WS_Y2 + (size_t)CAP * D * 2 <= WS_END && WS_OB + (size_t)T * 512 * 4 <= WS_END && WS_HID + (size_t)CAP * 512 * 2 <= WS_Y2, "act map");

constexpr int RING_BYTES = 131072;
constexpr int MISC_OFF = 163840 - 1024;
constexpr int PTR_OFF = MISC_OFF + 256;
constexpr int LDS_BYTES = 163840;

#define GAS __attribute__((address_space(1)))
#define LAS __attribute__((address_space(3)))
typedef unsigned short bf16;
typedef float f32x4 __attribute__((ext_vector_type(4)));
typedef float f32x2 __attribute__((ext_vector_type(2)));
typedef float f32x16 __attribute__((ext_vector_type(16)));
typedef short bf16x8 __attribute__((ext_vector_type(8)));
typedef short bf16x4 __attribute__((ext_vector_type(4)));
typedef unsigned u32x4 __attribute__((ext_vector_type(4)));
typedef unsigned u32x2 __attribute__((ext_vector_type(2)));
#define LDS_WAIT() asm volatile("s_waitcnt lgkmcnt(0)" ::: "memory")
#define VM_WAIT() asm volatile("s_waitcnt vmcnt(0)" ::: "memory")
#define LDS_BARRIER() do { asm volatile("s_waitcnt lgkmcnt(0)" ::: "memory"); __builtin_amdgcn_s_barrier(); asm volatile("" ::: "memory"); } while (0)
__device__ __forceinline__ unsigned f2bf(float f) { unsigned u = __builtin_bit_cast(unsigned, f); return (u + 0x7fffu + ((u >> 16) & 1u)) >> 16; }
typedef __bf16 bf16x2_t __attribute__((ext_vector_type(2)));
__device__ __forceinline__ unsigned pk2(float lo, float hi) { f32x2 v = {lo, hi}; return __builtin_bit_cast(unsigned, __builtin_convertvector(v, bf16x2_t)); }
__device__ __forceinline__ float bf2f(unsigned short b) { return __uint_as_float((unsigned)b << 16); }
__device__ __forceinline__ float bflo(unsigned w) { return __uint_as_float(w << 16); }
__device__ __forceinline__ float bfhi(unsigned w) { return __uint_as_float(w & 0xffff0000u); }
__device__ __forceinline__ float wave_sum(float v) {
#pragma unroll
    for (int o = 1; o < 64; o <<= 1) v += __shfl_xor(v, o);
    return v;
}
__device__ __forceinline__ int crow(int r, int hi) { return (r & 3) + 8 * (r >> 2) + 4 * hi; }

#define XB_TMO      128
#define XB_XCNT(j)  (256  + 64 * (j))
#define XB_XSUB(j)  (1280 + 64 * (j))
#define XB_XGEN(j)  (2304 + 64 * (j))
#define XB_TOP      3328
#define XB_TOPGEN   3392
#define XCD_BAR_WORDS 3456
#define XB_SPIN_CAP (1u << 18)
__device__ __forceinline__ unsigned xb_ld(unsigned* p)              { return __hip_atomic_load(p, __ATOMIC_RELAXED, __HIP_MEMORY_SCOPE_AGENT); }
__device__ __forceinline__ unsigned xb_add(unsigned* p, unsigned v) { return __hip_atomic_fetch_add(p, v, __ATOMIC_RELAXED, __HIP_MEMORY_SCOPE_AGENT); }
__device__ __forceinline__ unsigned xb_xcc_id() { return (unsigned)__builtin_amdgcn_s_getreg((3 << 11) | 20) & 0xFu; }
#define XB_SPIN(cond, bar) do { unsigned _sp = 0; while (cond) { __builtin_amdgcn_s_sleep(1); \
    if ((++_sp & 255u) == 0u) { if (xb_ld(&(bar)[XB_TMO])) break; if (_sp > XB_SPIN_CAP) { atomicAdd(&(bar)[XB_TMO], 1u); break; } } } } while (0)
struct XcdBarrier { unsigned* bar; unsigned x; volatile LAS unsigned* st; };
__device__ __forceinline__ XcdBarrier xcd_barrier_post(unsigned* bar, volatile LAS unsigned* st) {
    XcdBarrier b; b.bar = bar; b.x = xb_xcc_id(); b.st = st;
    if (threadIdx.x == 0) (void)xb_add(&bar[XB_XCNT(b.x)], 1u);
    return b;
}
__device__ __forceinline__ void xcd_barrier_complete(unsigned* bar, unsigned x, unsigned& nloc, unsigned& nx) {
    const unsigned G = gridDim.x * gridDim.y * gridDim.z;
    unsigned sum, cnt, mine, sp = 0u;
    for (;;) {
        sum = 0u; cnt = 0u; mine = 0u;
#pragma unroll
        for (unsigned j = 0; j < 16; ++j) { const unsigned c = xb_ld(&bar[XB_XCNT(j)]); sum += c; cnt += (c > 0u) ? 1u : 0u; mine = (j == x) ? c : mine; }
        if (sum == G) break;
        __builtin_amdgcn_s_sleep(1);
        if ((++sp & 255u) == 0u) { if (xb_ld(&bar[XB_TMO])) break; if (sp > XB_SPIN_CAP) { atomicAdd(&bar[XB_TMO], 1u); break; } }
    }
    nloc = mine > 0u ? mine : 1u; nx = cnt > 0u ? cnt : 1u;
}
__device__ __forceinline__ void xcd_barrier(const XcdBarrier& b) {
    asm volatile("s_waitcnt vmcnt(0)" ::: "memory");
    __syncthreads();
    if (threadIdx.x == 0) {
        unsigned* bar = b.bar;
        __builtin_amdgcn_s_waitcnt(0);
        unsigned nloc = b.st[0], nx = b.st[1];
        if (nloc == 0u) { xcd_barrier_complete(bar, b.x, nloc, nx); b.st[0] = nloc; b.st[1] = nx; }
        const unsigned old = xb_add(&bar[XB_XSUB(b.x)], 1u);
        const unsigned gen = old / nloc;
        if (old + 1u == (gen + 1u) * nloc) {
            __builtin_amdgcn_fence(__ATOMIC_RELEASE, "agent");
            asm volatile("s_waitcnt vmcnt(0)" ::: "memory");
            const unsigned og = xb_add(&bar[XB_TOP], 1u);
            const unsigned tg = og / nx;
            if (og + 1u == (tg + 1u) * nx) xb_add(&bar[XB_TOPGEN], 1u);
            else XB_SPIN(xb_ld(&bar[XB_TOPGEN]) == tg, bar);
            __builtin_amdgcn_fence(__ATOMIC_ACQUIRE, "agent");
            xb_add(&bar[XB_XGEN(b.x)], 1u);
            asm volatile("s_waitcnt vmcnt(0)" ::: "memory");
        } else {
            XB_SPIN(xb_ld(&bar[XB_XGEN(b.x)]) == gen, bar);
            __builtin_amdgcn_fence(__ATOMIC_ACQUIRE, "agent");
            asm volatile("s_waitcnt vmcnt(0)" ::: "memory");
        }
    }
    __syncthreads();
}

struct Frame {
    LAS unsigned char* lds;
    int tid, lane, wave, G, bid;
    unsigned char* ws;
    const float* const* in;
};
enum InIdx { I_X = 0, I_LNMG, I_LNMB, I_LNFG, I_LNFB, I_ABWIN, I_LAMRE, I_LAMIM, I_LOGDT, I_BRE, I_BIM, I_CRE, I_CIM, I_S5D, I_GLUW, I_GLUB,
             I_GATEW, I_GATEB, I_NORMG, I_ABWOUT, I_CWIN, I_SINK, I_CWOUT, I_RELB, I_WGRP, I_BGRP, I_WRT, I_BRT, I_W1, I_W3, I_W2, N_IN };

__device__ __forceinline__ const float* inp(LAS unsigned char* lds, int k) {
    const LAS unsigned* p = (const LAS unsigned*)(lds + PTR_OFF) + 2 * k;
    const unsigned lo = __builtin_amdgcn_readfirstlane(p[0]), hi = __builtin_amdgcn_readfirstlane(p[1]);
    return (const float*)(((unsigned long long)hi << 32) | (unsigned long long)lo);
}
__device__ __forceinline__ void tr_item(const float* W, int ldw, bf16* WT, int ldt, int rowmode, LAS float* scr, int item, int nblk, int lane) {
    const int kb = item / nblk, nb = item % nblk, k0 = 64 * kb, n0 = 32 * nb;
    float tv[32];
    const float* wp = W + (size_t)(k0 + (lane >> 5)) * ldw + n0 + (lane & 31);
#pragma unroll
    for (int i = 0; i < 32; ++i) tv[i] = wp[(size_t)(2 * i) * ldw];
#pragma unroll
    for (int i = 0; i < 32; ++i) scr[(2 * i + (lane >> 5)) * 33 + (lane & 31)] = tv[i];
    LDS_WAIT(); asm volatile("" ::: "memory");
    const int c = lane & 7;
#pragma unroll
    for (int j = 0; j < 4; ++j) { const int n = (lane >> 3) + 8 * j; const LAS float* s = scr + (8 * c) * 33 + n;
        u32x4 o; o.x = pk2(s[0 * 33], s[1 * 33]); o.y = pk2(s[2 * 33], s[3 * 33]); o.z = pk2(s[4 * 33], s[5 * 33]); o.w = pk2(s[6 * 33], s[7 * 33]);
        const int ng = n0 + n; const int dr = rowmode == 0 ? ng : (8 * (ng >> 2) + (ng & 3) + (rowmode == 2 ? 4 : 0));
        *(GAS u32x4*)(WT + (size_t)dr * ldt + k0 + 8 * c) = o; }
    LDS_WAIT(); asm volatile("" ::: "memory");
}
__device__ __forceinline__ void moe_convert(const float* w1, const float* w3, const float* w2, bf16* W13, bf16* W2T, LAS float* scr, int gw, int NGW, int lane) {
    constexpr int PER_E = 768;
    for (int it = gw; it < NEXP * PER_E; it += NGW) {
        const int e = it / PER_E; int r = it % PER_E;
        if (r < 256) tr_item(w1 + (size_t)e * D * DEXP, DEXP, W13 + (size_t)e * D * D, D, 1, scr, r, DEXP / 32, lane);
        else if (r < 512) tr_item(w3 + (size_t)e * D * DEXP, DEXP, W13 + (size_t)e * D * D, D, 2, scr, r - 256, DEXP / 32, lane);
        else tr_item(w2 + (size_t)e * DEXP * D, D, W2T + (size_t)e * D * DEXP, DEXP, 0, scr, r - 512, D / 32, lane);
    }
}
__device__ __forceinline__ int t5_bucket(int rel) {
    const int nb = 16, max_exact = 8; int ret = rel > 0 ? nb : 0; const int n = rel < 0 ? -rel : rel;
    const float lg = logf((float)(n < 1 ? 1 : n) / 8.0f) / 2.7725887f * 8.0f;
    int large = max_exact + (int)lg; large = large < nb - 1 ? large : nb - 1;
    return ret + (n < max_exact ? n : large);
}
__device__ __forceinline__ void p0_prologue(unsigned char* ws, LAS unsigned char* lds, int bid, int G, int tid, int wave, int lane) {
    LAS float* scr = (LAS float*)(lds + wave * 16384);
    const int gw = bid * NWAVES + wave, NGW = G * NWAVES;
    constexpr int I0 = 16 * 64, I1 = 16, I2 = 8 * 16, I3 = 16 * 32, I4 = 16 * 48, I5 = 16 * 32, NIT = I0 + I1 + I2 + I3 + I4 + I5;
    for (int it = gw; it < NIT; it += NGW) {
        int r = it;
        if (r < I0) { tr_item(inp(lds, I_ABWIN), AB_IN, (bf16*)(ws + WS_WIN), D, 0, scr, r, 64, lane); continue; } r -= I0;
        if (r < I1) { tr_item(inp(lds, I_ABWIN) + 2048, AB_IN, (bf16*)(ws + WS_WLR), D, 0, scr, r, 1, lane); continue; } r -= I1;
        if (r < I2) { tr_item(inp(lds, I_GLUW), 512, (bf16*)(ws + WS_WGLU), 512, 0, scr, r, 16, lane); continue; } r -= I2;
        if (r < I3) { tr_item(inp(lds, I_ABWOUT), D, (bf16*)(ws + WS_WOUT), D, 0, scr, r, 32, lane); continue; } r -= I3;
        if (r < I4) { tr_item(inp(lds, I_CWIN), CN, (bf16*)(ws + WS_CIN), D, 0, scr, r, 48, lane); continue; } r -= I4;
        tr_item(inp(lds, I_CWOUT), D, (bf16*)(ws + WS_COUT), D, 0, scr, r, 32, lane);
    }
    moe_convert(inp(lds, I_W1), inp(lds, I_W3), inp(lds, I_W2), (bf16*)(ws + WS_W13), (bf16*)(ws + WS_W2), scr, gw, NGW, lane);
    { const float* x = inp(lds, I_X); bf16* xb = (bf16*)(ws + WS_X64);
      for (int m = gw; m < T; m += 2 * NGW) { const int m2 = m + NGW;
          const GAS f32x4* xr = (const GAS f32x4*)(x + (size_t)m * D) + lane; GAS u32x2* o = (GAS u32x2*)(xb + (size_t)m * D) + lane;
          const GAS f32x4* xr2 = (const GAS f32x4*)(x + (size_t)m2 * D) + lane; GAS u32x2* o2 = (GAS u32x2*)(xb + (size_t)m2 * D) + lane;
          f32x4 v[4], v2[4];
#pragma unroll
          for (int j = 0; j < 4; ++j) { v[j] = xr[64 * j]; if (m2 < T) v2[j] = xr2[64 * j]; }
#pragma unroll
          for (int j = 0; j < 4; ++j) { u32x2 w; w.x = pk2(v[j].x, v[j].y); w.y = pk2(v[j].z, v[j].w); o[64 * j] = w;
              if (m2 < T) { u32x2 w2; w2.x = pk2(v2[j].x, v2[j].y); w2.y = pk2(v2[j].z, v2[j].w); o2[64 * j] = w2; } } } }
    const int gt = bid * NTHR + tid, NGT = G * NTHR;
    { const float* lamre = inp(lds, I_LAMRE); const float* lamim = inp(lds, I_LAMIM); const float* logdt = inp(lds, I_LOGDT); const float* bre = inp(lds, I_BRE); const float* bim = inp(lds, I_BIM);
    for (int i = gt; i < 2 * 32 * 64; i += NGT) {
        const int p = i & 63, g = (i >> 6) & 31, dir = i >> 11;
        const double lr = fmin((double)lamre[i], -1e-4), li = (double)lamim[i], dt = exp((double)logdt[dir * 32 + g]);
        const double mag = exp(lr * dt), ar = mag * cos(li * dt), ai = mag * sin(li * dt), den = lr * lr + li * li, nr = ar - 1.0;
        const double cr = (nr * lr + ai * li) / den, ci = (ai * lr - nr * li) / den;
        double qr = ar, qi = ai;
#pragma unroll 1
        for (int s = 1; s < S5CH; s <<= 1) { const double t = qr * qr - qi * qi; qi = 2.0 * qr * qi; qr = t; }
        float* L4 = (float*)(ws + WS_S5L) + (size_t)i * 4; L4[0] = (float)ar; L4[1] = (float)ai; L4[2] = (float)qr; L4[3] = (float)qi;
        bf16* Bb = (bf16*)(ws + WS_S5B) + (size_t)(dir * 32 + g) * 2048;
#pragma unroll 4
        for (int c = 0; c < 16; ++c) { const double br = bre[(size_t)i * 16 + c], bi = bim[(size_t)i * 16 + c];
            Bb[p * 16 + c] = (bf16)f2bf((float)(cr * br - ci * bi)); Bb[1024 + p * 16 + c] = (bf16)f2bf((float)(cr * bi + ci * br)); }
    } }
    { const float* cre = inp(lds, I_CRE); const float* cim = inp(lds, I_CIM);
    for (int i = gt; i < 2 * 32 * 16 * 64; i += NGT) {
        const int p = i & 63, c = (i >> 6) & 15, dg = i >> 10;
        bf16* Cm = (bf16*)(ws + WS_S5C) + (size_t)dg * 2048 + c * 128 + 2 * p;
        Cm[0] = (bf16)f2bf(cre[i]); Cm[1] = (bf16)f2bf(-cim[i]);
    } }
    { const float* relb = inp(lds, I_RELB);
    for (int i = gt; i < 16 * 257; i += NGT) { const int h = i / 257, r = i % 257; ((float*)(ws + WS_BTAB))[h * 260 + r] = relb[t5_bucket(r - 128) * 16 + h] * LOG2E; } }
    { const float* wgrp = inp(lds, I_WGRP); const float* wrt = inp(lds, I_WRT);
    for (int i = gt; i < 2 * 48 * 1024; i += NGT) {
        const int k = i & 1023, n = (i >> 10) % 48, l = i / (48 * 1024);
        const float w = n < 4 ? wgrp[(size_t)l * D * 4 + k * 4 + n] : (n < 36 ? wrt[(size_t)l * D * 32 + k * 32 + (n - 4)] : 0.f);
        const unsigned hi = f2bf(w); const float lo = w - __uint_as_float(hi << 16);
        bf16* Wr = (bf16*)(ws + WS_WR) + (size_t)l * 2 * 48 * 1024; Wr[n * 1024 + k] = (bf16)hi; Wr[48 * 1024 + n * 1024 + k] = (bf16)f2bf(lo);
    } }
}

__device__ __forceinline__ void gate_tail(float* bcg, const float* gate_w, const float* gate_b, const LAS float* lrs, size_t row0, int tid);
__device__ __forceinline__ void lr_tail(unsigned char* ws, float* bcg, const float* gate_w, const float* gate_b, LAS unsigned char* lds, int bid, int G, int tid, int wave, int lane) {
    const bf16* xb = (const bf16*)(ws + WS_X64); const bf16* wl = (const bf16*)(ws + WS_WLR); LAS float* lrs = (LAS float*)lds;
    for (int rt = bid; rt < T / 128; rt += G) {
        const int r0 = rt * 128 + wave * 16;
        f32x4 acc0 = {0.f, 0.f, 0.f, 0.f}, acc1 = {0.f, 0.f, 0.f, 0.f};
        const bf16* ap = xb + (size_t)(r0 + (lane & 15)) * D + 8 * (lane >> 4);
        const bf16* bp = wl + (size_t)(lane & 15) * D + 8 * (lane >> 4);
#pragma unroll 8
        for (int ks = 0; ks < 32; ++ks) {
            const bf16x8 a = *(const bf16x8*)(ap + ks * 32), b0 = *(const bf16x8*)(bp + ks * 32), b1 = *(const bf16x8*)(bp + 16 * D + ks * 32);
            acc0 = __builtin_amdgcn_mfma_f32_16x16x32_bf16(a, b0, acc0, 0, 0, 0); acc1 = __builtin_amdgcn_mfma_f32_16x16x32_bf16(a, b1, acc1, 0, 0, 0);
        }
        __syncthreads();
#pragma unroll
        for (int r = 0; r < 4; ++r) { LAS float* o = lrs + (wave * 16 + 4 * (lane >> 4) + r) * 32 + (lane & 15); o[0] = acc0[r]; o[16] = acc1[r]; }
        __syncthreads();
        gate_tail(bcg, gate_w, gate_b, lrs, (size_t)rt * 128, tid);
    }
    __syncthreads();
}

__device__ __forceinline__ void gla_finalize(unsigned char* ws, const float* norm_g, int gw, int NGW, int lane) {
    const float* of = (const float*)(ws + WS_OF); const float* ob = (const float*)(ws + WS_OB); const bf16* h0 = (const bf16*)(ws + WS_H0); bf16* cc = (bf16*)(ws + WS_X64);
    f32x4 g0 = *(const f32x4*)(norm_g + 8 * lane), g1 = *(const f32x4*)(norm_g + 8 * lane + 4);
    for (int m = gw; m < T; m += NGW) {
        const float* a = of + (size_t)m * 512 + 8 * lane; const float* b = ob + (size_t)m * 512 + 8 * lane;
        f32x4 v0 = *(const f32x4*)a + *(const f32x4*)b, v1 = *(const f32x4*)(a + 4) + *(const f32x4*)(b + 4);
        const u32x4 gq = *(const u32x4*)(h0 + (size_t)m * H0P + OFF_GO + 8 * lane);
        float ss = (v0.x * v0.x + v0.y * v0.y) + (v0.z * v0.z + v0.w * v0.w) + (v1.x * v1.x + v1.y * v1.y) + (v1.z * v1.z + v1.w * v1.w);
        ss += __shfl_xor(ss, 1); ss += __shfl_xor(ss, 2); ss += __shfl_xor(ss, 4); ss += __shfl_xor(ss, 8);
        const float rs = 1.0f / sqrtf(ss * (1.0f / 128.0f) + RMS_EPS);
        const float gv[8] = {bflo(gq.x), bfhi(gq.x), bflo(gq.y), bfhi(gq.y), bflo(gq.z), bfhi(gq.z), bflo(gq.w), bfhi(gq.w)};
        const float ov[8] = {v0.x * g0.x, v0.y * g0.y, v0.z * g0.z, v0.w * g0.w, v1.x * g1.x, v1.y * g1.y, v1.z * g1.z, v1.w * g1.w};
        float r[8];
#pragma unroll
        for (int i = 0; i < 8; ++i) r[i] = ov[i] * rs * (gv[i] / (1.f + __expf(-gv[i])));
        u32x4 w; w.x = pk2(r[0], r[1]); w.y = pk2(r[2], r[3]); w.z = pk2(r[4], r[5]); w.w = pk2(r[6], r[7]);
        *(u32x4*)(cc + (size_t)m * D + 512 + 8 * lane) = w;
    }
}

constexpr int RT_AST = 2064;
__device__ __forceinline__ void ln_router(unsigned char* ws, const float* lng, const float* lnb, const float* bgrp, const float* brt, int layer, LAS unsigned char* lds, int bid, int G, int tid, int wave, int lane) {
    const float* z = (const float*)(ws + WS_Z); float* h1 = (float*)(ws + WS_H1); bf16* hb = (bf16*)(ws + WS_X64);
    int* tok_e = (int*)(ws + WS_TOKE); float* tok_w = (float*)(ws + WS_TOKW);
    LAS unsigned char* Ahi = lds; LAS unsigned char* Alo = lds + 16 * RT_AST; LAS float* part = (LAS float*)(lds + 32 * RT_AST);
    LAS int* hist = (LAS int*)(lds + 32 * RT_AST + 8 * 16 * 48 * 4); LAS float* lgt = (LAS float*)(lds + 32 * RT_AST + 8 * 16 * 48 * 4 + 256);
    if (tid < 32) hist[tid] = 0;
    const bf16* Wr = (const bf16*)(ws + WS_WR) + (size_t)layer * 2 * 48 * 1024;
    bf16x8 Bh[3][4], Bl[3][4];
#pragma unroll
    for (int nt = 0; nt < 3; ++nt)
#pragma unroll
        for (int ks = 0; ks < 4; ++ks) { const size_t o = (size_t)(nt * 16 + (lane & 15)) * 1024 + wave * 128 + ks * 32 + 8 * (lane >> 4);
            Bh[nt][ks] = *(const bf16x8*)(Wr + o); Bl[nt][ks] = *(const bf16x8*)(Wr + 48 * 1024 + o); }
    f32x4 gv[4], bv[4];
#pragma unroll
    for (int j = 0; j < 4; ++j) { gv[j] = *(const f32x4*)(lng + 4 * lane + 256 * j); bv[j] = *(const f32x4*)(lnb + 4 * lane + 256 * j); }
    __syncthreads();
    for (int grp = bid; grp < T / 16; grp += G) {
#pragma unroll
        for (int rr = 0; rr < 2; ++rr) {
            const int row = 2 * wave + rr; const size_t m = (size_t)grp * 16 + row;
            const GAS f32x4* zr = (const GAS f32x4*)(z + m * D) + lane;
            f32x4 v[4]; float s = 0.f;
#pragma unroll
            for (int j = 0; j < 4; ++j) { v[j] = zr[64 * j]; s += (v[j].x + v[j].y) + (v[j].z + v[j].w); }
            const float mean = wave_sum(s) * (1.f / D); float s2 = 0.f;
#pragma unroll
            for (int j = 0; j < 4; ++j) { v[j] = v[j] - mean; s2 += (v[j].x * v[j].x + v[j].y * v[j].y) + (v[j].z * v[j].z + v[j].w * v[j].w); }
            const float rstd = 1.f / sqrtf(wave_sum(s2) * (1.f / D) + LN_EPS);
#pragma unroll
            for (int j = 0; j < 4; ++j) {
                const f32x4 h = v[j] * rstd * gv[j] + bv[j];
                ((GAS f32x4*)(h1 + m * D) + lane)[64 * j] = h;
                const unsigned h0 = pk2(h.x, h.y), h1w = pk2(h.z, h.w);
                u32x2 w; w.x = h0; w.y = h1w; ((GAS u32x2*)(hb + m * D) + lane)[64 * j] = w;
                u32x2 lo; lo.x = pk2(h.x - bflo(h0), h.y - bfhi(h0)); lo.y = pk2(h.z - bflo(h1w), h.w - bfhi(h1w));
                *(LAS u32x2*)(Ahi + row * RT_AST + (4 * lane + 256 * j) * 2) = w; *(LAS u32x2*)(Alo + row * RT_AST + (4 * lane + 256 * j) * 2) = lo;
            }
        }
        LDS_BARRIER();
        f32x4 acc[3] = {{0.f, 0.f, 0.f, 0.f}, {0.f, 0.f, 0.f, 0.f}, {0.f, 0.f, 0.f, 0.f}};
#pragma unroll
        for (int ks = 0; ks < 4; ++ks) {
            const int bo = (lane & 15) * RT_AST + (wave * 128 + ks * 32 + 8 * (lane >> 4)) * 2;
            const bf16x8 ah = *(const LAS bf16x8*)(Ahi + bo), al = *(const LAS bf16x8*)(Alo + bo);
#pragma unroll
            for (int nt = 0; nt < 3; ++nt) {
                acc[nt] = __builtin_amdgcn_mfma_f32_16x16x32_bf16(ah, Bh[nt][ks], acc[nt], 0, 0, 0);
                acc[nt] = __builtin_amdgcn_mfma_f32_16x16x32_bf16(ah, Bl[nt][ks], acc[nt], 0, 0, 0);
                acc[nt] = __builtin_amdgcn_mfma_f32_16x16x32_bf16(al, Bh[nt][ks], acc[nt], 0, 0, 0);
            }
        }
#pragma unroll
        for (int nt = 0; nt < 3; ++nt)
#pragma unroll
            for (int r = 0; r < 4; ++r) part[(wave * 16 + 4 * (lane >> 4) + r) * 48 + nt * 16 + (lane & 15)] = acc[nt][r];
        LDS_BARRIER();
        for (int idx = tid; idx < 16 * 36; idx += NTHR) { const int tk = idx / 36, n = idx % 36; float s = 0.f;
#pragma unroll
            for (int w = 0; w < 8; ++w) s += part[(w * 16 + tk) * 48 + n];
            lgt[tk * 36 + n] = s + (n < 4 ? bgrp[n] : brt[n - 4]); }
        LDS_BARRIER();
        if (tid < 16) {
            const size_t m = (size_t)grp * 16 + tid;
            const LAS float* lg = lgt + tid * 36;
            int gi = 0; float gm = lg[0];
#pragma unroll
            for (int n = 1; n < 4; ++n) if (lg[n] > gm) { gm = lg[n]; gi = n; }
            float gs = 0.f;
#pragma unroll
            for (int n = 0; n < 4; ++n) gs += __expf(lg[n] - gm);
            const float pg = 1.f / gs;
            float el[8];
#pragma unroll
            for (int i = 0; i < 8; ++i) el[i] = lg[4 + gi * 8 + i];
            int i1 = 0; float m1 = el[0];
#pragma unroll
            for (int i = 1; i < 8; ++i) if (el[i] > m1) { m1 = el[i]; i1 = i; }
            int i2 = -1; float m2 = -3.0e38f;
#pragma unroll
            for (int i = 0; i < 8; ++i) if (i != i1 && el[i] > m2) { m2 = el[i]; i2 = i; }
            const float e2 = __expf(m2 - m1), inv = 1.f / (1.f + e2);
            const int ea = gi * 8 + i1, eb = gi * 8 + i2;
            tok_e[m * 2] = ea; tok_e[m * 2 + 1] = eb; tok_w[m * 2] = pg * inv; tok_w[m * 2 + 1] = pg * e2 * inv;
            atomicAdd((int*)&hist[ea], 1); atomicAdd((int*)&hist[eb], 1);
        }
        LDS_BARRIER();
    }
    if (tid < 32) ((int*)(ws + WS_BLKC))[bid * 32 + tid] = hist[tid];
}

__device__ __forceinline__ void moe_sort(unsigned char* ws, LAS unsigned char* lds, int bid, int G, int tid) {
    const int* blkc = (const int*)(ws + WS_BLKC); const int* tok_e = (const int*)(ws + WS_TOKE); const float* tok_w = (const float*)(ws + WS_TOKW);
    int* tok_s = (int*)(ws + WS_TOKS); int* slot_t = (int*)(ws + WS_SLOTT); float* slot_w = (float*)(ws + WS_SLOTW); int* tile = (int*)(ws + WS_TILE);
    LAS int* ptot = (LAS int*)lds; LAS int* pbase = ptot + 512; LAS int* tot = pbase + 512; LAS int* base = tot + 32; LAS int* pstart = base + 32; LAS int* lcur = pstart + 33;
    { const int e = tid & 31, part = tid >> 5; int st = 0, sb = 0;
      for (int b = part; b < G; b += 16) { const int c = blkc[b * 32 + e]; st += c; sb += (b < bid) ? c : 0; }
      ptot[part * 32 + e] = st; pbase[part * 32 + e] = sb; }
    __syncthreads();
    if (tid < 32) { int st = 0, sb = 0;
#pragma unroll
        for (int p = 0; p < 16; ++p) { st += ptot[p * 32 + tid]; sb += pbase[p * 32 + tid]; }
        tot[tid] = st; base[tid] = sb; lcur[tid] = 0; }
    __syncthreads();
    if (tid == 0) { int acc = 0; for (int e = 0; e < 32; ++e) { pstart[e] = acc; acc += (tot[e] + 255) & ~255; } pstart[32] = acc; }
    __syncthreads();
    if (bid == 0) {
        const int nt = pstart[32] >> 8;
        if (tid == 0) tile[511] = nt;
        for (int t = tid; t < nt; t += NTHR) { int e = 0; for (int q = 1; q < 32; ++q) if ((t << 8) >= pstart[q]) e = q; tile[t] = e; }
    }
    for (int e = bid; e < 32; e += G)
        for (int s = pstart[e] + tot[e] + tid; s < pstart[e + 1]; s += NTHR) { slot_t[s] = 0; slot_w[s] = 0.f; }
    for (int grp = bid; grp < T / 16; grp += G) {
        if (tid < 32) { const size_t a = (size_t)grp * 32 + tid; const int e = tok_e[a]; const int rank = atomicAdd((int*)&lcur[e], 1);
            const int s = pstart[e] + base[e] + rank; slot_t[s] = (int)(a >> 1); slot_w[s] = tok_w[a]; tok_s[a] = s; }
    }
}

template <bool FINAL>
__device__ __forceinline__ void combine_ln(unsigned char* ws, const float* lng, const float* lnb, float* dout, int gw, int NGW, int lane) {
    float* h1 = (float*)(ws + WS_H1); const bf16* y2 = (const bf16*)(ws + WS_Y2); const int* tok_s = (const int*)(ws + WS_TOKS); bf16* h2b = (bf16*)(ws + WS_H2B);
    f32x4 gv[4], bv[4];
#pragma unroll
    for (int j = 0; j < 4; ++j) { gv[j] = *(const f32x4*)(lng + 4 * lane + 256 * j); bv[j] = *(const f32x4*)(lnb + 4 * lane + 256 * j); }
    for (int m = gw; m < T; m += NGW) {
        const int s0 = tok_s[(size_t)m * 2], s1 = tok_s[(size_t)m * 2 + 1];
        const GAS f32x4* hr = (const GAS f32x4*)(h1 + (size_t)m * D) + lane;
        const GAS u32x2* ya = (const GAS u32x2*)(y2 + (size_t)s0 * D) + lane; const GAS u32x2* yb = (const GAS u32x2*)(y2 + (size_t)s1 * D) + lane;
        f32x4 v[4]; float s = 0.f;
#pragma unroll
        for (int j = 0; j < 4; ++j) { const f32x4 h = hr[64 * j]; const u32x2 a = ya[64 * j], b = yb[64 * j];
            v[j].x = h.x * ALPHA + (bflo(a.x) + bflo(b.x)); v[j].y = h.y * ALPHA + (bfhi(a.x) + bfhi(b.x)); v[j].z = h.z * ALPHA + (bflo(a.y) + bflo(b.y)); v[j].w = h.w * ALPHA + (bfhi(a.y) + bfhi(b.y));
            s += (v[j].x + v[j].y) + (v[j].z + v[j].w); }
        const float mean = wave_sum(s) * (1.f / D); float s2 = 0.f;
#pragma unroll
        for (int j = 0; j < 4; ++j) { v[j] = v[j] - mean; s2 += (v[j].x * v[j].x + v[j].y * v[j].y) + (v[j].z * v[j].z + v[j].w * v[j].w); }
        const float rstd = 1.f / sqrtf(wave_sum(s2) * (1.f / D) + LN_EPS);
#pragma unroll
        for (int j = 0; j < 4; ++j) { const f32x4 h = v[j] * rstd * gv[j] + bv[j];
            if (FINAL) ((GAS f32x4*)(dout + (size_t)m * D) + lane)[64 * j] = h;
            else { ((GAS f32x4*)(h1 + (size_t)m * D) + lane)[64 * j] = h; u32x2 w; w.x = pk2(h.x, h.y); w.y = pk2(h.z, h.w); ((GAS u32x2*)(h2b + (size_t)m * D) + lane)[64 * j] = w; } }
    }
}
constexpr int S5_HST = 272, S5_UST = 272, S5_UOFF = 8 * 32 * S5_HST;
#define MFMA32(a, b, c) __builtin_amdgcn_mfma_f32_32x32x16_bf16((a), (b), (c), 0, 0, 0)
#define MFMA16(a, b, c) __builtin_amdgcn_mfma_f32_16x16x32_bf16((a), (b), (c), 0, 0, 0)
__device__ __forceinline__ float gelu_tanh(float x) {
    const float u = 0.7978845608028654f * (x + 0.044715f * x * x * x);
    const float e = __expf(2.f * u); const float th = 1.f - 2.f / (e + 1.f);
    return 0.5f * x * (1.f + th);
}
__device__ __forceinline__ f32x4 ld_ys(const float* p) {
    f32x4 v;
    v.x = __hip_atomic_load(p, __ATOMIC_RELAXED, __HIP_MEMORY_SCOPE_AGENT); v.y = __hip_atomic_load(p + 1, __ATOMIC_RELAXED, __HIP_MEMORY_SCOPE_AGENT);
    v.z = __hip_atomic_load(p + 2, __ATOMIC_RELAXED, __HIP_MEMORY_SCOPE_AGENT); v.w = __hip_atomic_load(p + 3, __ATOMIC_RELAXED, __HIP_MEMORY_SCOPE_AGENT);
    return v;
}
template <int PASS, int DIR>
__device__ __forceinline__ void s5_dir(unsigned char* ws, const float* s5d, int b, int g, int c, LAS unsigned char* hl, const LAS unsigned char* ul, float* yscr, int lane) {
    const bf16* h0 = (const bf16*)(ws + WS_H0);
    const int dg = DIR * 32 + g;
    const f32x4 L4 = *(const f32x4*)((const float*)(ws + WS_S5L) + (size_t)(dg * 64 + lane) * 4);
    const float ar = L4.x, ai = L4.y, qr = L4.z, qi = L4.w;
    const float l2r = ar * ar - ai * ai, l2i = 2.f * ar * ai, l4r = l2r * l2r - l2i * l2i, l4i = 2.f * l2r * l2i, l8r = l4r * l4r - l4i * l4i, l8i = 2.f * l4r * l4i;
    const float l16r = l8r * l8r - l8i * l8i, l16i = 2.f * l8r * l8i, l32r = l16r * l16r - l16i * l16i, l32i = 2.f * l16r * l16i;
    const bf16* Bb = (const bf16*)(ws + WS_S5B) + (size_t)dg * 2048 + (lane & 31) * 16 + 8 * (lane >> 5);
    const bf16x8 bre0 = *(const bf16x8*)Bb, bre1 = *(const bf16x8*)(Bb + 512), bim0 = *(const bf16x8*)(Bb + 1024), bim1 = *(const bf16x8*)(Bb + 1536);
    bf16x8 cf[4]; bf16x8 dfrag;
    if (PASS == 2) {
        const bf16* Cm = (const bf16*)(ws + WS_S5C) + (size_t)dg * 2048 + (lane & 15) * 128 + 8 * (lane >> 4);
#pragma unroll
        for (int ks = 0; ks < 4; ++ks) cf[ks] = *(const bf16x8*)(Cm + 32 * ks);
        if (DIR == 1) {
            const int cc = lane & 15, kq = lane >> 4; const float d = s5d[g * 16 + cc]; const unsigned dh = f2bf(d); const unsigned dl = f2bf(d - __uint_as_float(dh << 16));
#pragma unroll
            for (int j = 0; j < 8; ++j) { const int k = 8 * (kq & 1) + j; dfrag[j] = (short)((k == cc) ? (kq < 2 ? dh : dl) : 0u); }
        }
    }
    float hr = 0.f, hi = 0.f;
    float* Ec = (float*)(ws + WS_S5E) + ((size_t)((DIR * NB + b) * 32 + g) * S5NCH) * 128 + 2 * lane;
    if (PASS == 2) {
        const int nj = DIR == 0 ? c : (S5NCH - 1 - c);
        for (int j0 = 0; j0 < nj; j0 += 8) {
            f32x2 e[8];
#pragma unroll
            for (int q = 0; q < 8; ++q) { const int j = j0 + q; const int jj = DIR == 0 ? j : (S5NCH - 1 - j); e[q] = (j < nj) ? *(const f32x2*)(Ec + (size_t)jj * 128) : (f32x2){0.f, 0.f}; }
#pragma unroll
            for (int q = 0; q < 8; ++q) if (j0 + q < nj) { const float nr = qr * hr - qi * hi + e[q].x; hi = qr * hi + qi * hr + e[q].y; hr = nr; }
        }
    }
    const size_t rowbase = (size_t)b * SEQ + (size_t)c * S5CH;
    const LAS unsigned char* up = ul + (lane & 31) * S5_UST + (g & 7) * 32 + 16 * (lane >> 5);
    const f32x16 zero16 = {0.f, 0.f, 0.f, 0.f, 0.f, 0.f, 0.f, 0.f, 0.f, 0.f, 0.f, 0.f, 0.f, 0.f, 0.f, 0.f};
#pragma unroll 1
    for (int ti = 0; ti < S5CH / 32; ++ti) {
        const int tile = DIR == 0 ? ti : (S5CH / 32 - 1 - ti);
        const bf16x8 a = *(const LAS bf16x8*)(up + tile * 32 * S5_UST);
        f32x4 ysv[2] = {{0.f, 0.f, 0.f, 0.f}, {0.f, 0.f, 0.f, 0.f}};
        if (PASS == 2 && DIR == 1) { ysv[0] = ld_ys(yscr + (size_t)(tile * 2) * 256 + 4 * lane); ysv[1] = ld_ys(yscr + (size_t)(tile * 2 + 1) * 256 + 4 * lane); }
        f32x16 xr0 = MFMA32(a, bre0, zero16), xr1 = MFMA32(a, bre1, zero16), xi0 = MFMA32(a, bim0, zero16), xi1 = MFMA32(a, bim1, zero16);
        __builtin_amdgcn_sched_barrier(0);
        asm volatile("s_nop 15\n\ts_nop 15\n\ts_nop 15\n\ts_nop 15" ::: "memory");
        __builtin_amdgcn_sched_barrier(0);
        float xr[32], xi[32];
#pragma unroll
        for (int r = 0; r < 16; ++r) {
            auto s = __builtin_amdgcn_permlane32_swap(__float_as_uint(xr0[r]), __float_as_uint(xr1[r]), false, false);
            xr[crow(r, 0)] = __uint_as_float(s[0]); xr[crow(r, 1)] = __uint_as_float(s[1]);
            auto q = __builtin_amdgcn_permlane32_swap(__float_as_uint(xi0[r]), __float_as_uint(xi1[r]), false, false);
            xi[crow(r, 0)] = __uint_as_float(q[0]); xi[crow(r, 1)] = __uint_as_float(q[1]);
        }
        if (PASS == 1) {
#pragma unroll
            for (int lv = 0; lv < 5; ++lv) {
                const float pr = lv == 0 ? ar : lv == 1 ? l2r : lv == 2 ? l4r : lv == 3 ? l8r : l16r, pi = lv == 0 ? ai : lv == 1 ? l2i : lv == 2 ? l4i : lv == 3 ? l8i : l16i;
#pragma unroll
                for (int i = 0; i < (16 >> lv); ++i) {
                    const int e = DIR == 0 ? 2 * i : 2 * i + 1, l = DIR == 0 ? 2 * i + 1 : 2 * i;
                    const float er = xr[e << lv], ei = xi[e << lv], lr_ = xr[l << lv], li_ = xi[l << lv];
                    const float wr = fmaf(pr, er, fmaf(-pi, ei, lr_)), wi = fmaf(pr, ei, fmaf(pi, er, li_));
                    xr[(2 * i) << lv] = wr; xi[(2 * i) << lv] = wi;
                }
            }
            { const float nr = fmaf(l32r, hr, fmaf(-l32i, hi, xr[0])), ni = fmaf(l32r, hi, fmaf(l32i, hr, xi[0])); hr = nr; hi = ni; }
        } else {
#pragma unroll
        for (int tt = 0; tt < 32; ++tt) {
            const int t = DIR == 0 ? tt : 31 - tt;
            const float tr_ = fmaf(-ai, hi, xr[t]), ti_ = fmaf(ai, hr, xi[t]);
            hr = fmaf(ar, hr, tr_); hi = fmaf(ar, hi, ti_);
            *(LAS unsigned*)(hl + t * S5_HST + 4 * lane) = pk2(hr, hi);
        }
        }
        if (PASS == 2) {
#pragma unroll
            for (int sub = 0; sub < 2; ++sub) {
                float* ys = yscr + (size_t)(tile * 2 + sub) * 256 + 4 * lane;
                f32x4 y = {0.f, 0.f, 0.f, 0.f};
                if (DIR == 1) y = ysv[sub];
#pragma unroll
                for (int ks = 0; ks < 4; ++ks) { const bf16x8 hf = *(const LAS bf16x8*)(hl + (sub * 16 + (lane & 15)) * S5_HST + 64 * ks + 16 * (lane >> 4)); y = MFMA16(hf, cf[ks], y); }
                if (DIR == 0) *(f32x4*)ys = y;
                else {
                    const bf16x8 uf = *(const LAS bf16x8*)(ul + (tile * 32 + sub * 16 + (lane & 15)) * S5_UST + (g & 7) * 32 + 16 * ((lane >> 4) & 1));
                    y = MFMA16(uf, dfrag, y);
                    bf16* yo = (bf16*)(ws + WS_YG) + (rowbase + tile * 32 + sub * 16 + 4 * (lane >> 4)) * 512 + g * 16 + (lane & 15);
#pragma unroll
                    for (int r = 0; r < 4; ++r) yo[(size_t)r * 512] = (bf16)f2bf(gelu_tanh(y[r]));
                }
            }
        }
    }
    if (PASS == 1) { f32x2 e; e.x = hr; e.y = hi; *(f32x2*)(Ec + (size_t)c * 128) = e; }
}
template <int PASS>
__device__ __forceinline__ void s5_phase(unsigned char* ws, const float* s5d, LAS unsigned char* lds, int bid, int G, int tid, int wave, int lane) {
    LAS unsigned char* hl = lds + wave * (32 * S5_HST); LAS unsigned char* ul = lds + S5_UOFF;
    float* yscr = (float*)(ws + WS_YSCR) + (size_t)(bid * NWAVES + wave) * 4096;
    const bf16* h0 = (const bf16*)(ws + WS_H0);
    for (int it = bid; it < NB * S5NCH * 4; it += G) {
        const int go = it & 3, c = (it >> 2) % S5NCH, b = it / (4 * S5NCH), g = go * 8 + wave;
        { const bf16* src = h0 + ((size_t)b * SEQ + (size_t)c * S5CH) * H0P + OFF_U + go * 128;
          u32x4 v[8];
#pragma unroll
          for (int i = 0; i < 8; ++i) { const int p = i * NTHR + tid; v[i] = *(const u32x4*)(src + (size_t)(p >> 4) * H0P + 8 * (p & 15)); }
          __syncthreads();
#pragma unroll
          for (int i = 0; i < 8; ++i) { const int p = i * NTHR + tid; *(LAS u32x4*)(ul + (p >> 4) * S5_UST + 16 * (p & 15)) = v[i]; }
          __syncthreads(); }
        s5_dir<PASS, 0>(ws, s5d, b, g, c, hl, ul, yscr, lane);
        s5_dir<PASS, 1>(ws, s5d, b, g, c, hl, ul, yscr, lane);
    }
}
constexpr int G_ST = 144;
constexpr int GL_QD = 0, GL_KD = GL_QD + 64 * G_ST, GL_KCT = GL_KD + 64 * G_ST, GL_VT = GL_KCT + 64 * G_ST,
              GL_S = GL_VT + 128 * G_ST, GL_ST = GL_S + 64 * G_ST, GL_END = GL_ST + 2 * 128 * G_ST;
static_assert(GL_END <= RING_BYTES, "GLA LDS");
__device__ __forceinline__ bf16x8 ldfrag32(const LAS unsigned char* base, int row0, int ks, int lane) {
    return *(const LAS bf16x8*)(base + (row0 + (lane & 31)) * G_ST + 32 * ks + 16 * (lane >> 5));
}
__device__ __forceinline__ void gate_tail(float* bcg, const float* gate_w, const float* gate_b, const LAS float* lrs, size_t row0, int tid) {
    const int dir = tid >> 8;
    float gw[16];
#pragma unroll
    for (int r = 0; r < 16; ++r) gw[r] = gate_w[(size_t)(dir * 16 + r) * 256 + (tid & 255)];
    const float gb = gate_b[tid];
    float run = 0.f;
#pragma unroll 4
    for (int i = 0; i < 128; ++i) {
        const int t = dir ? 127 - i : i;
        if ((i & 63) == 0) run = 0.f;
        const LAS f32x4* lp = (const LAS f32x4*)(lrs + t * 32 + dir * 16);
        const f32x4 l0 = lp[0], l1 = lp[1], l2 = lp[2], l3 = lp[3];
        float z = gb + l0.x * gw[0] + l0.y * gw[1] + l0.z * gw[2] + l0.w * gw[3] + l1.x * gw[4] + l1.y * gw[5] + l1.z * gw[6] + l1.w * gw[7]
                     + l2.x * gw[8] + l2.y * gw[9] + l2.z * gw[10] + l2.w * gw[11] + l3.x * gw[12] + l3.y * gw[13] + l3.z * gw[14] + l3.w * gw[15];
        const float ls = fminf(z, 0.f) - __logf(1.f + __expf(-fabsf(z)));
        run += ls * (1.0f / 16.0f);
        bcg[(row0 + t) * 512 + tid] = run;
    }
}
__device__ __forceinline__ size_t gla_tok(int b, int dir, int chunk, int s) { const int pos = chunk * GCH + s; return (size_t)b * SEQ + (dir ? (SEQ - 1 - pos) : pos); }
template <int PASS>
__device__ __forceinline__ void gla_item(unsigned char* ws, const float* bcg, int item, LAS unsigned char* lds, int tid, int wave, int lane) {
    const int sc = item % GNSC, dir = (item / GNSC) & 1, h = (item / (GNSC * 2)) & 3, b = item / (GNSC * 8);
    const bf16* h0 = (const bf16*)(ws + WS_H0);
    LAS unsigned char* QD = lds + GL_QD; LAS unsigned char* KD = lds + GL_KD; LAS unsigned char* KCT = lds + GL_KCT; LAS unsigned char* VT = lds + GL_VT; LAS unsigned char* SS = lds + GL_S; LAS unsigned char* STT = lds + GL_ST;
    const int me = wave >> 1, nd = wave & 1;
    f32x16 st;
#pragma unroll
    for (int r = 0; r < 16; ++r) st[r] = 0.f;
    float dtot = 1.f;
    float* GS = (float*)(ws + WS_GS); float* GD = (float*)(ws + WS_GD);
    const int ibase = item - sc;
    if (PASS == 2) {
        for (int j = 0; j < sc; ++j) {
            const float dj = GD[(size_t)(ibase + j) * 64 + nd * 32 + (lane & 31)];
            const float* gs = GS + (size_t)(ibase + j) * 8192 + nd * 32 + (lane & 31);
#pragma unroll
            for (int r = 0; r < 16; ++r) st[r] = st[r] * dj + gs[(size_t)(me * 32 + crow(r, lane >> 5)) * 64];
        }
#pragma unroll
        for (int r = 0; r < 16; ++r) *(LAS bf16*)(STT + (me * 32 + crow(r, lane >> 5)) * G_ST + (nd * 32 + (lane & 31)) * 2) = (bf16)f2bf(st[r]);
    }
    const float qscale = 0.125f;
    const int s_l = lane;
    const int gcol = dir * 256 + h * 64;
    u32x4 pq, pk, pv0, pv1; f32x4 pb0, pb1, pl0, pl1; float pdec;
#define GLA_LOAD(n) do { const int ch_ = sc * GSC + (n); const size_t tk = gla_tok(b, dir, ch_, s_l), tl = gla_tok(b, dir, ch_, 63); const bf16* rp = h0 + tk * H0P; \
        if (PASS == 2) pq = *(const u32x4*)(rp + OFF_Q + h * 64 + 8 * wave); \
        pk = *(const u32x4*)(rp + OFF_K + h * 64 + 8 * wave); pv0 = *(const u32x4*)(rp + OFF_V + h * 128 + 16 * wave); pv1 = *(const u32x4*)(rp + OFF_V + h * 128 + 16 * wave + 8); \
        pb0 = *(const f32x4*)(bcg + tk * 512 + gcol + 8 * wave); pb1 = *(const f32x4*)(bcg + tk * 512 + gcol + 8 * wave + 4); \
        pl0 = *(const f32x4*)(bcg + tl * 512 + gcol + 8 * wave); pl1 = *(const f32x4*)(bcg + tl * 512 + gcol + 8 * wave + 4); \
        pdec = bcg[tl * 512 + gcol + nd * 32 + (lane & 31)]; } while (0)
    GLA_LOAD(0);
    __syncthreads();
#pragma unroll 1
    for (int n = 0; n < GSC; ++n) {
        LAS unsigned char* STc = STT + (n & 1) * (128 * G_ST); LAS unsigned char* STn = STT + ((n + 1) & 1) * (128 * G_ST);
        { const float bc[8] = {pb0.x, pb0.y, pb0.z, pb0.w, pb1.x, pb1.y, pb1.z, pb1.w}, bl[8] = {pl0.x, pl0.y, pl0.z, pl0.w, pl1.x, pl1.y, pl1.z, pl1.w};
          const float kv[8] = {bflo(pk.x), bfhi(pk.x), bflo(pk.y), bfhi(pk.y), bflo(pk.z), bfhi(pk.z), bflo(pk.w), bfhi(pk.w)};
          if (PASS == 2) {
              const float qv[8] = {bflo(pq.x), bfhi(pq.x), bflo(pq.y), bfhi(pq.y), bflo(pq.z), bfhi(pq.z), bflo(pq.w), bfhi(pq.w)};
              float qd[8], kd[8];
#pragma unroll
              for (int i = 0; i < 8; ++i) { qd[i] = qv[i] * qscale * __expf(bc[i]); kd[i] = kv[i] * __expf(-bc[i]); }
              u32x4 w; w.x = pk2(qd[0], qd[1]); w.y = pk2(qd[2], qd[3]); w.z = pk2(qd[4], qd[5]); w.w = pk2(qd[6], qd[7]);
              *(LAS u32x4*)(QD + s_l * G_ST + 16 * wave) = w;
              w.x = pk2(kd[0], kd[1]); w.y = pk2(kd[2], kd[3]); w.z = pk2(kd[4], kd[5]); w.w = pk2(kd[6], kd[7]);
              *(LAS u32x4*)(KD + s_l * G_ST + 16 * wave) = w;
          }
#pragma unroll
          for (int i = 0; i < 8; ++i) *(LAS bf16*)(KCT + (8 * wave + i) * G_ST + 2 * s_l) = (bf16)f2bf(kv[i] * __expf(bl[i] - bc[i]));
          const unsigned vv[8] = {pv0.x, pv0.y, pv0.z, pv0.w, pv1.x, pv1.y, pv1.z, pv1.w};
#pragma unroll
          for (int i = 0; i < 8; ++i) { *(LAS bf16*)(VT + (16 * wave + 2 * i) * G_ST + 2 * s_l) = (bf16)(vv[i] & 0xffffu); *(LAS bf16*)(VT + (16 * wave + 2 * i + 1) * G_ST + 2 * s_l) = (bf16)(vv[i] >> 16); }
        }
        const float dec = __expf(pdec);
        if (n + 1 < GSC) GLA_LOAD(n + 1);
        LDS_BARRIER();
        if (PASS == 2 && wave < 4) {
            const int ms = wave >> 1, ns = wave & 1;
            f32x16 sa;
#pragma unroll
            for (int r = 0; r < 16; ++r) sa[r] = 0.f;
            if (ns <= ms) {
#pragma unroll
                for (int ks = 0; ks < 4; ++ks) sa = MFMA32(ldfrag32(QD, ms * 32, ks, lane), ldfrag32(KD, ns * 32, ks, lane), sa);
            }
#pragma unroll
            for (int r = 0; r < 16; ++r) { const int s = ms * 32 + crow(r, lane >> 5), s2 = ns * 32 + (lane & 31);
                const bool keep = dir ? (s2 < s) : (s2 <= s);
                *(LAS bf16*)(SS + s * G_ST + 2 * s2) = (bf16)f2bf(keep ? sa[r] : 0.f); }
        }
#pragma unroll
        for (int r = 0; r < 16; ++r) st[r] *= dec;
        dtot *= dec;
#pragma unroll
        for (int ks = 0; ks < 4; ++ks) st = MFMA32(ldfrag32(VT, me * 32, ks, lane), ldfrag32(KCT, nd * 32, ks, lane), st);
        if (PASS == 2 && n + 1 < GSC) {
#pragma unroll
            for (int r = 0; r < 16; ++r) *(LAS bf16*)(STn + (me * 32 + crow(r, lane >> 5)) * G_ST + (nd * 32 + (lane & 31)) * 2) = (bf16)f2bf(st[r]);
        }
        LDS_BARRIER();
        if (PASS == 2) {
            const int ms = wave >> 2, ne = wave & 3;
            f32x16 oa;
#pragma unroll
            for (int r = 0; r < 16; ++r) oa[r] = 0.f;
#pragma unroll
            for (int ks = 0; ks < 4; ++ks) oa = MFMA32(ldfrag32(SS, ms * 32, ks, lane), ldfrag32(VT, ne * 32, ks, lane), oa);
#pragma unroll
            for (int ks = 0; ks < 4; ++ks) oa = MFMA32(ldfrag32(QD, ms * 32, ks, lane), ldfrag32(STc, ne * 32, ks, lane), oa);
            float* op = (float*)(ws + (dir ? WS_OB : WS_OF)) + h * 128 + ne * 32 + (lane & 31);
#pragma unroll
            for (int r = 0; r < 16; ++r) op[gla_tok(b, dir, sc * GSC + n, ms * 32 + crow(r, lane >> 5)) * 512] = oa[r];
            LDS_BARRIER();
        }
    }
    if (PASS == 1) {
        float* gs = GS + (size_t)item * 8192 + nd * 32 + (lane & 31);
#pragma unroll
        for (int r = 0; r < 16; ++r) gs[(size_t)(me * 32 + crow(r, lane >> 5)) * 64] = st[r];
        if (me == 0 && lane < 32) GD[(size_t)item * 64 + nd * 32 + lane] = dtot;
    }
    __syncthreads();
#undef GLA_LOAD
}
constexpr int AT_KST = 144, AT_VST = 664, AT_K = 0, AT_V = 320 * AT_KST, AT_BT = AT_V + 64 * AT_VST, AT_END = AT_BT + 4 * 260 * 4;
static_assert(AT_END <= RING_BYTES && AT_V % 16 == 0 && AT_BT % 16 == 0, "attention LDS");
__device__ __forceinline__ void attn_phase(unsigned char* ws, const float* sink, LAS unsigned char* lds, int bid, int G, int tid, int wave, int lane) {
    const bf16* qkv = (const bf16*)(ws + WS_QKV); bf16* ao = (bf16*)(ws + WS_AO); const float* btab = (const float*)(ws + WS_BTAB);
    LAS unsigned char* KS = lds + AT_K; LAS unsigned char* VT = lds + AT_V; LAS float* BT = (LAS float*)(lds + AT_BT);
    const float sc2 = 0.125f * LOG2E;
    u32x4 kreg[5], vreg[5];
#define AT_LOAD(u_) do { const int qb_ = (u_) % (SEQ / 64), kvh_ = ((u_) / (SEQ / 64)) & 3, b_ = (u_) / (4 * (SEQ / 64)), kb_ = qb_ * 64 - 128; \
        _Pragma("unroll") for (int it = 0; it < 5; ++it) { const int p = it * NTHR + tid; int key = kb_ + (p >> 3); key = key < 0 ? 0 : (key > SEQ - 1 ? SEQ - 1 : key); \
            const bf16* rp = qkv + ((size_t)b_ * SEQ + key) * CN + kvh_ * 64 + 8 * (p & 7); kreg[it] = *(const u32x4*)(rp + 1024); vreg[it] = *(const u32x4*)(rp + 1280); } } while (0)
    if (bid < NB * 4 * (SEQ / 64)) AT_LOAD(bid);
    for (int u = bid; u < NB * 4 * (SEQ / 64); u += G) {
        const int qb = u % (SEQ / 64), kvh = (u / (SEQ / 64)) & 3, b = u / (4 * (SEQ / 64)), q0 = qb * 64;
#pragma unroll
        for (int it = 0; it < 5; ++it) { const int p = it * NTHR + tid, i = p >> 3, ch = p & 7;
            *(LAS u32x4*)(KS + i * AT_KST + 16 * ch) = kreg[it];
            const unsigned vv[4] = {vreg[it].x, vreg[it].y, vreg[it].z, vreg[it].w};
#pragma unroll
            for (int j = 0; j < 4; ++j) { *(LAS bf16*)(VT + (8 * ch + 2 * j) * AT_VST + 2 * i) = (bf16)(vv[j] & 0xffffu); *(LAS bf16*)(VT + (8 * ch + 2 * j + 1) * AT_VST + 2 * i) = (bf16)(vv[j] >> 16); } }
        for (int p = tid; p < 4 * 260; p += NTHR) BT[p] = btab[(kvh * 4) * 260 + p];
        if (u + G < NB * 4 * (SEQ / 64)) AT_LOAD(u + G);
        LDS_BARRIER();
        const int hl = wave >> 1, hq = kvh * 4 + hl, qw = q0 + 32 * (wave & 1), qi = qw + (lane & 31), hh = lane >> 5;
        bf16x8 qf[4];
        { const bf16* qp = qkv + ((size_t)b * SEQ + qi) * CN + hq * 64 + 8 * hh;
#pragma unroll
          for (int ks = 0; ks < 4; ++ks) qf[ks] = *(const bf16x8*)(qp + 16 * ks); }
        float m = sink[hq] * LOG2E, l = hh == 0 ? 1.f : 0.f;
        f32x16 o0, o1;
#pragma unroll
        for (int r = 0; r < 16; ++r) { o0[r] = 0.f; o1[r] = 0.f; }
        const LAS float* btr = BT + hl * 260 + 128 - (lane & 31);
#pragma unroll 1
        for (int j = 0; j < 9; ++j) {
            const int i0 = 32 * (wave & 1) + 32 * j;
            f32x16 sa;
#pragma unroll
            for (int r = 0; r < 16; ++r) sa[r] = 0.f;
#pragma unroll
            for (int ks = 0; ks < 4; ++ks) { const bf16x8 kf = *(const LAS bf16x8*)(KS + (i0 + (lane & 31)) * AT_KST + 32 * ks + 16 * hh); sa = MFMA32(kf, qf[ks], sa); }
            float mx = -3.0e38f;
#pragma unroll
            for (int r = 0; r < 16; ++r) {
                const int kk = 32 * j - 128 + crow(r, hh);
                const int rel = kk - (lane & 31), key = qw + kk;
                const bool ok = (rel >= -128) && (rel <= 128) && (key >= 0) && (key < SEQ);
                const float s = ok ? (sa[r] * sc2 + btr[kk]) : -3.0e38f;
                sa[r] = s; mx = fmaxf(mx, s);
            }
            mx = fmaxf(mx, __shfl_xor(mx, 32));
            const float mn = fmaxf(m, mx), alpha = __builtin_amdgcn_exp2f(m - mn); m = mn;
            float ps = 0.f;
#pragma unroll
            for (int r = 0; r < 16; ++r) { const float p = __builtin_amdgcn_exp2f(sa[r] - mn); sa[r] = p; ps += p; }
            l = l * alpha + ps;
#pragma unroll
            for (int r = 0; r < 16; ++r) { o0[r] *= alpha; o1[r] *= alpha; }
#pragma unroll
            for (int s = 0; s < 2; ++s) {
                u32x4 pw; pw.x = pk2(sa[8 * s], sa[8 * s + 1]); pw.y = pk2(sa[8 * s + 2], sa[8 * s + 3]); pw.z = pk2(sa[8 * s + 4], sa[8 * s + 5]); pw.w = pk2(sa[8 * s + 6], sa[8 * s + 7]);
                const bf16x8 pf = __builtin_bit_cast(bf16x8, pw);
#pragma unroll
                for (int dt = 0; dt < 2; ++dt) {
                    const LAS unsigned char* vp = VT + (dt * 32 + (lane & 31)) * AT_VST + 2 * (i0 + 16 * s + 4 * hh);
                    const bf16x4 va = *(const LAS bf16x4*)vp, vb = *(const LAS bf16x4*)(vp + 16);
                    const bf16x8 vf = __builtin_shufflevector(va, vb, 0, 1, 2, 3, 4, 5, 6, 7);
                    if (dt == 0) o0 = MFMA32(vf, pf, o0); else o1 = MFMA32(vf, pf, o1);
                }
            }
        }
        l += __shfl_xor(l, 32);
        const float inv = 1.f / l;
        bf16* op = ao + ((size_t)b * SEQ + qi) * D + hq * 64 + 4 * hh;
#pragma unroll
        for (int g = 0; g < 4; ++g) {
            u32x2 w0, w1; w0.x = pk2(o0[4 * g] * inv, o0[4 * g + 1] * inv); w0.y = pk2(o0[4 * g + 2] * inv, o0[4 * g + 3] * inv);
            w1.x = pk2(o1[4 * g] * inv, o1[4 * g + 1] * inv); w1.y = pk2(o1[4 * g + 2] * inv, o1[4 * g + 3] * inv);
            *(u32x2*)(op + 8 * g) = w0; *(u32x2*)(op + 32 + 8 * g) = w1;
        }
        LDS_BARRIER();
    }
#undef AT_LOAD
}
#ifndef MK_N_LAUNCHES
#define MK_N_LAUNCHES 1
#endif
constexpr int N_PHASES = 19;
#ifndef PH_MASK
#define PH_MASK 0xFFFFFFFFu
#endif
#define ON(k) (((PH_MASK) >> (k)) & 1u)
#ifndef REP_MASK
#define REP_MASK 0u
#endif
#define NREP(k) ((((REP_MASK) >> (k)) & 1u) ? 2 : 1)

template <int LAYER>
__device__ __forceinline__ void common_phases(unsigned char* ws, LAS unsigned char* lds, float* dout, const XcdBarrier& bar, int lo, int hi, int bid, int G, int tid, int wave, int lane) {
    constexpr int pb = LAYER == 0 ? 5 : 13;
    const int gw = bid * NWAVES + wave, NGW = G * NWAVES;
#define IN(k) (lo <= (k) && (k) < hi)
#define SEAM(k) do { if (IN(k) && IN((k) + 1)) xcd_barrier(bar); } while (0)
    if (ON(5) && IN(pb)) {
        pg8::Gemm g{(const bf16*)(ws + (LAYER == 0 ? WS_X64 : WS_AO)), (const bf16*)(ws + (LAYER == 0 ? WS_WOUT : WS_COUT)), T, D, D, 0, nullptr}; pg8::StaticOrder S; S.init(T, D, G, bid);
        pg8::EpiResid E{LAYER == 0 ? inp(lds, I_X) : (const float*)(ws + WS_H1), (float*)(ws + WS_Z), D, ALPHA};
        pg8::gemm_phase<pg8::EpiResid, pg8::StaticOrder, false>(lds, g, S, E);
    }
    SEAM(pb);
    if (ON(6) && IN(pb + 1)) { ln_router(ws, inp(lds, I_LNMG) + LAYER * D, inp(lds, I_LNMB) + LAYER * D, inp(lds, I_BGRP) + LAYER * 4, inp(lds, I_BRT) + LAYER * 32, LAYER, lds, bid, G, tid, wave, lane); __syncthreads(); }
    SEAM(pb + 1);
    if (ON(7) && IN(pb + 2)) { moe_sort(ws, lds, bid, G, tid); __syncthreads(); }
    SEAM(pb + 2);
    if (ON(8) && IN(pb + 3)) {
        const int* tile = (const int*)(ws + WS_TILE); const int ntiles = __builtin_amdgcn_readfirstlane(tile[511]);
        pg8::Gemm g{(const bf16*)(ws + WS_X64), (const bf16*)(ws + WS_W13), 0, D, D, (size_t)D * D * 2, (const int*)(ws + WS_SLOTT)};
        pg8::GroupOrder S{tile, ntiles, D / 256, G, bid};
        pg8::EpiSwiglu E{(bf16*)(ws + WS_HID), DEXP};
        pg8::gemm_phase<pg8::EpiSwiglu, pg8::GroupOrder, true>(lds, g, S, E);
    }
    SEAM(pb + 3);
    if (ON(9) && IN(pb + 4)) {
        const int* tile = (const int*)(ws + WS_TILE); const int ntiles = __builtin_amdgcn_readfirstlane(tile[511]);
        pg8::Gemm g{(const bf16*)(ws + WS_HID), (const bf16*)(ws + WS_W2), 0, D, DEXP, (size_t)D * DEXP * 2, nullptr};
        pg8::GroupOrder S{tile, ntiles, D / 256, G, bid};
        pg8::EpiScale E{(bf16*)(ws + WS_Y2), D, (const float*)(ws + WS_SLOTW)};
        pg8::gemm_phase<pg8::EpiScale, pg8::GroupOrder, false>(lds, g, S, E);
    }
    SEAM(pb + 4);
    if (ON(10) && IN(pb + 5)) {
        if (LAYER == 0) {
            combine_ln<false>(ws, inp(lds, I_LNFG), inp(lds, I_LNFB), nullptr, gw, NGW, lane);
            moe_convert(inp(lds, I_W1) + (size_t)NEXP * D * DEXP, inp(lds, I_W3) + (size_t)NEXP * D * DEXP, inp(lds, I_W2) + (size_t)NEXP * DEXP * D, (bf16*)(ws + WS_W13), (bf16*)(ws + WS_W2), (LAS float*)(lds + wave * 16384), gw, NGW, lane);
            __syncthreads();
        } else combine_ln<true>(ws, inp(lds, I_LNFG) + D, inp(lds, I_LNFB) + D, dout, gw, NGW, lane);
    }
    if (LAYER == 0) SEAM(10);
#undef IN
#undef SEAM
}

struct Args { const float* in[N_IN]; float* out; unsigned char* ws; int ph_lo, ph_hi; };
static_assert(sizeof(Args) == N_IN * 8 + 8 + 8 + 8, "no padding holes in Args");

__global__ void __launch_bounds__(NTHR, 2) fwd_kernel(Args args) {
    extern __shared__ __attribute__((aligned(16))) unsigned char lds_raw[];
    LAS unsigned char* lds = (LAS unsigned char*)lds_raw;
    volatile LAS unsigned* MISC = (volatile LAS unsigned*)(lds + MISC_OFF);
    const int tid = threadIdx.x, lane = tid & 63, wave = __builtin_amdgcn_readfirstlane(tid >> 6), G = gridDim.x, bid = blockIdx.x;
    unsigned char* ws = args.ws;
    for (int u = tid; u < 64; u += NTHR) MISC[u] = 0u;
    if (tid < N_IN) *(LAS unsigned long long*)(lds + PTR_OFF + 8 * tid) = (unsigned long long)args.in[tid];
    __syncthreads();
    const int lo = args.ph_lo, hi = args.ph_hi;
    const bool use_bar = (hi - lo) > 1;
    XcdBarrier bar; bar.bar = (unsigned*)(ws + WS_CTL) + CW_BAR; bar.x = 0; bar.st = nullptr;
    if (use_bar) bar = xcd_barrier_post((unsigned*)(ws + WS_CTL) + CW_BAR, MISC + 8);
#define IN(k) (lo <= (k) && (k) < hi)
#define SEAM(k) do { if (IN(k) && IN((k) + 1)) xcd_barrier(bar); } while (0)
    const int gw = bid * NWAVES + wave, NGW = G * NWAVES;

    if (ON(0) && IN(0)) { p0_prologue(ws, lds, bid, G, tid, wave, lane); __syncthreads(); }
    SEAM(0);
    if (ON(1) && IN(1)) {
        pg8::Gemm g{(const bf16*)(ws + WS_X64), (const bf16*)(ws + WS_WIN), T, ABN, D, 0, nullptr}; pg8::StaticOrder S; S.init(T, ABN, G, bid);
        pg8::EpiBf16 E{(bf16*)(ws + WS_H0), H0P};
        pg8::gemm_phase<pg8::EpiBf16, pg8::StaticOrder, false>(lds, g, S, E);
        lr_tail(ws, args.out, inp(lds, I_GATEW), inp(lds, I_GATEB), lds, bid, G, tid, wave, lane);
#ifdef TAIL_TWICE
        lr_tail(ws, args.out, inp(lds, I_GATEW), inp(lds, I_GATEB), lds, bid, G, tid, wave, lane);
#endif
    }
    SEAM(1);
    if (ON(2) && IN(2)) {
        s5_phase<1>(ws, inp(lds, I_S5D), lds, bid, G, tid, wave, lane);
#ifdef S5_TWICE
        __syncthreads(); s5_phase<1>(ws, inp(lds, I_S5D), lds, bid, G, tid, wave, lane);
#endif
        __syncthreads();
        for (int it = bid; it < 256; it += G) gla_item<1>(ws, args.out, it, lds, tid, wave, lane);
    }
    SEAM(2);
    if (ON(3) && IN(3)) {
        s5_phase<2>(ws, inp(lds, I_S5D), lds, bid, G, tid, wave, lane);
#ifdef S5_TWICE
        __syncthreads(); s5_phase<2>(ws, inp(lds, I_S5D), lds, bid, G, tid, wave, lane);
#endif
        __syncthreads();
        for (int it = bid; it < 256; it += G) gla_item<2>(ws, args.out, it, lds, tid, wave, lane);
    }
    SEAM(3);
    if (ON(4) && IN(4)) {
        gla_finalize(ws, inp(lds, I_NORMG), gw, NGW, lane);
        pg8::Gemm g{(const bf16*)(ws + WS_YG), (const bf16*)(ws + WS_WGLU), T, 512, 512, 0, nullptr}; pg8::StaticOrder S; S.init(T, 512, G, bid);
        pg8::EpiGlu E{(const bf16*)(ws + WS_YG), 512, (bf16*)(ws + WS_X64), D, inp(lds, I_GLUB)};
        pg8::gemm_phase<pg8::EpiGlu, pg8::StaticOrder, false>(lds, g, S, E);
    }
    SEAM(4);
    common_phases<0>(ws, lds, args.out, bar, lo, hi, bid, G, tid, wave, lane);
    if (ON(11) && IN(11)) {
        pg8::Gemm g{(const bf16*)(ws + WS_H2B), (const bf16*)(ws + WS_CIN), T, CN, D, 0, nullptr}; pg8::StaticOrder S; S.init(T, CN, G, bid);
        pg8::EpiBf16 E{(bf16*)(ws + WS_QKV), CN};
        pg8::gemm_phase<pg8::EpiBf16, pg8::StaticOrder, false>(lds, g, S, E);
    }
    SEAM(11);
    if (ON(12) && IN(12)) attn_phase(ws, inp(lds, I_SINK), lds, bid, G, tid, wave, lane);
    SEAM(12);
    common_phases<1>(ws, lds, args.out, bar, lo, hi, bid, G, tid, wave, lane);
#undef IN
#undef SEAM
}

extern "C" void kernel_launch(void* const* d_in, const int* in_sizes, int n_in, void* d_out, int out_size, void* d_ws, size_t ws_size, hipStream_t stream) {
    static int grid = 0;
    if (grid == 0) {
        if (n_in != N_IN || in_sizes[0] != T * D || out_size != T * D || ws_size < WS_END) { fprintf(stderr, "kernel_launch: unexpected shapes (n_in %d, in0 %d, out %d, ws %zu < %zu)\n", n_in, n_in > 0 ? in_sizes[0] : -1, out_size, ws_size, (size_t)WS_END); grid = -1; return; }
        int dev = 0, cus = 0, per_cu = 0;
        if (hipGetDevice(&dev) != hipSuccess || hipDeviceGetAttribute(&cus, hipDeviceAttributeMultiprocessorCount, dev) != hipSuccess) { grid = -1; return; }
        if (hipFuncSetAttribute((const void*)fwd_kernel, hipFuncAttributeMaxDynamicSharedMemorySize, LDS_BYTES) != hipSuccess) { fprintf(stderr, "kernel_launch: hipFuncSetAttribute failed\n"); grid = -1; return; }
        if (hipOccupancyMaxActiveBlocksPerMultiprocessor(&per_cu, (const void*)fwd_kernel, NTHR, LDS_BYTES) != hipSuccess || per_cu < 1) fprintf(stderr, "kernel_launch: occupancy query reports %d\n", per_cu);
        (void)hipGetLastError();
        grid = cus;
    }
    if (grid < 0) return;
    if (hipMemsetAsync((char*)d_ws + WS_CTL, 0, CTL_ZERO_BYTES, stream) != hipSuccess) return;
    Args a{};
    for (int i = 0; i < N_IN; ++i) a.in[i] = (const float*)d_in[i];
    a.out = (float*)d_out; a.ws = (unsigned char*)d_ws;
    for (int li = 0; li < MK_N_LAUNCHES; ++li) {
        a.ph_lo = (MK_N_LAUNCHES == 1) ? 0 : li; a.ph_hi = (MK_N_LAUNCHES == 1) ? N_PHASES : li + 1;
        for (int rep = 0; rep < ((MK_N_LAUNCHES > 1 && ((REP_MASK >> li) & 1u)) ? 2 : 1); ++rep)
            hipLaunchKernelGGL(fwd_kernel, dim3(grid), dim3(NTHR), LDS_BYTES, stream, a);
    }
}
```

```cpp
#include <hip/hip_runtime.h>
#include <cstdio>
#include <cstdint>
#include <cmath>
namespace pg8 {
#define PG8_LAS __attribute__((address_space(3)))
typedef unsigned short bf16_t;
typedef short bf16x8 __attribute__((ext_vector_type(8)));
typedef float f32x4 __attribute__((ext_vector_type(4)));
typedef float f32x2 __attribute__((ext_vector_type(2)));
typedef unsigned u32x4 __attribute__((ext_vector_type(4)));
typedef unsigned u32x2 __attribute__((ext_vector_type(2)));
constexpr int BM = 256, BK = 64, HALF = 128, HTB = HALF * BK * 2  , STAGE_BYTES = 8 * HTB, NXCD = 8, WGM = 8;

__host__ __device__ __forceinline__ int lds_byte(int r, int c) { const int st = (r >> 4) * 2 + (c >> 5), rr = r & 15, cc = c & 31, ob = rr * 64 + cc * 2; return st * 1024 + (ob ^ (((ob >> 9) & 1) << 5)); }
__host__ __device__ __forceinline__ void stage_rc(int b, int& R, int& C) { const int st = b / 1024, sb = b % 1024, swz = sb ^ (((sb >> 9) & 1) << 5); R = (st >> 1) * 16 + swz / 64; C = (st & 1) * 32 + (swz % 64) / 2; }
__host__ __device__ __forceinline__ int perm32(int rho) { const int n = rho >> 4, i = rho & 15; return 8 * (i >> 2) + 4 * n + (i & 3); }

struct Unit { int pm, pn, e; };
struct Gemm { const bf16_t* A; const bf16_t* Bt; int M, N, K; size_t bstride; const int* rowmap; };

struct StaticOrder {
    int nM, nN, nwg, G, c;
    __host__ __device__ void init(int M, int N, int G_, int c_) { nM = M / BM; nN = N / BM; nwg = nM * nN; G = G_; c = c_; }
    __host__ __device__ bool next(int i, Unit& u) const {
        const long L = (long)i * G + c; if (L >= nwg) return false;
        int wgid = (int)L; { const int q = nwg / NXCD, r = nwg % NXCD, xcd = wgid % NXCD, off = wgid / NXCD; wgid = (xcd < r ? xcd * (q + 1) : r * (q + 1) + (xcd - r) * q) + off; }
        const int nig = WGM * nN, gid = wgid / nig, fm = gid * WGM, gsz = (nM - fm) < WGM ? (nM - fm) : WGM;
        u.pm = fm + ((wgid % nig) % gsz); u.pn = (wgid % nig) / gsz; u.e = 0; return true;
    }
};
struct SplitOrder {
    int nM, nNs, nwgs, nsp, G, c;
    __host__ __device__ void init(int M, int N, int nsp_, int G_, int c_) { nM = M / BM; nNs = N / BM / nsp_; nwgs = nM * nNs; nsp = nsp_; G = G_; c = c_; }
    __host__ __device__ bool next(int i, Unit& u) const {
        const long L = (long)i * G + c; if (L >= (long)nwgs * nsp) return false;
        const int slab = (int)(L / nwgs); int wgid = (int)(L % nwgs);
        { const int q = nwgs / NXCD, r = nwgs % NXCD, xcd = wgid % NXCD, off = wgid / NXCD; wgid = (xcd < r ? xcd * (q + 1) : r * (q + 1) + (xcd - r) * q) + off; }
        const int nig = WGM * nNs, gid = wgid / nig, fm = gid * WGM, gsz = (nM - fm) < WGM ? (nM - fm) : WGM;
        u.pm = fm + ((wgid % nig) % gsz); u.pn = slab * nNs + (wgid % nig) / gsz; u.e = 0; return true;
    }
};
struct GroupOrder {
    const int* tile_e; int ntiles, nN, G, c;
    __device__ bool next(int i, Unit& u) const {
        const int L = i * G + c; if (L >= ntiles * nN) return false;
        u.pm = L / nN; u.pn = L % nN; u.e = __builtin_amdgcn_readfirstlane(tile_e[u.pm]); return true;
    }
};

typedef __bf16 bf16x2_t __attribute__((ext_vector_type(2)));
__device__ __forceinline__ unsigned cvt_pk_bf16(float lo, float hi) { f32x2 v = {lo, hi}; return __builtin_bit_cast(unsigned, __builtin_convertvector(v, bf16x2_t)); }
__device__ __forceinline__ float bf_lo(unsigned w) { return __uint_as_float(w << 16); }
__device__ __forceinline__ float bf_hi(unsigned w) { return __uint_as_float(w & 0xffff0000u); }

struct EpiBf16 {
    static constexpr bool PERM = true;
    bf16_t* O; int ldc;
    __device__ __forceinline__ void operator()(const f32x4 (&acc)[2][2][4][2], const Unit& u, int wr, int wc, int fr, int fq) const {
        const int row0 = u.pm * BM + wr * 64 + fr; const int col0 = u.pn * BM + wc * 32 + 8 * fq;
#pragma unroll
        for (int ai = 0; ai < 2; ++ai)
#pragma unroll
            for (int m = 0; m < 4; ++m) { bf16_t* rowp = O + (size_t)(row0 + ai * HALF + m * 16) * ldc + col0;
#pragma unroll
                for (int bj = 0; bj < 2; ++bj) { const f32x4 v0 = acc[ai][bj][m][0], v1 = acc[ai][bj][m][1];
                    u32x4 w; w.x = cvt_pk_bf16(v0[0], v0[1]); w.y = cvt_pk_bf16(v0[2], v0[3]); w.z = cvt_pk_bf16(v1[0], v1[1]); w.w = cvt_pk_bf16(v1[2], v1[3]);
                    *(u32x4*)(rowp + bj * HALF) = w; } }
    }
};
struct EpiGlu {
    static constexpr bool PERM = true;
    const bf16_t* Y; int ldy; bf16_t* O; int ldc; const float* bias;
    __device__ __forceinline__ void operator()(const f32x4 (&acc)[2][2][4][2], const Unit& u, int wr, int wc, int fr, int fq) const {
        const int row0 = u.pm * BM + wr * 64 + fr; const int col0 = u.pn * BM + wc * 32 + 8 * fq;
        f32x4 bv[2][2];
#pragma unroll
        for (int bj = 0; bj < 2; ++bj)
#pragma unroll
            for (int n = 0; n < 2; ++n) bv[bj][n] = *(const f32x4*)(bias + col0 + bj * HALF + 4 * n);
#pragma unroll
        for (int ai = 0; ai < 2; ++ai) {
            u32x4 yq[4][2];
#pragma unroll
            for (int m = 0; m < 4; ++m)
#pragma unroll
                for (int bj = 0; bj < 2; ++bj) yq[m][bj] = *(const u32x4*)(Y + (size_t)(row0 + ai * HALF + m * 16) * ldy + col0 + bj * HALF);
            asm volatile("" ::: "memory");
#pragma unroll
            for (int m = 0; m < 4; ++m) { const size_t r = (size_t)(row0 + ai * HALF + m * 16);
#pragma unroll
                for (int bj = 0; bj < 2; ++bj) { const f32x4 v0 = acc[ai][bj][m][0] + bv[bj][0], v1 = acc[ai][bj][m][1] + bv[bj][1];
                    const u32x4 y = yq[m][bj];
                    float o[8]; const float yv[8] = {bf_lo(y.x), bf_hi(y.x), bf_lo(y.y), bf_hi(y.y), bf_lo(y.z), bf_hi(y.z), bf_lo(y.w), bf_hi(y.w)};
#pragma unroll
                    for (int i = 0; i < 4; ++i) { o[i] = yv[i] / (1.f + __expf(-v0[i])); o[4 + i] = yv[4 + i] / (1.f + __expf(-v1[i])); }
                    u32x4 w; w.x = cvt_pk_bf16(o[0], o[1]); w.y = cvt_pk_bf16(o[2], o[3]); w.z = cvt_pk_bf16(o[4], o[5]); w.w = cvt_pk_bf16(o[6], o[7]);
                    *(u32x4*)(O + r * ldc + col0 + bj * HALF) = w; } }
            asm volatile("" ::: "memory");
        }
    }
};
struct EpiResid {
    static constexpr bool PERM = false;
    const float* resid; float* out; int ldc; float alpha;
    __device__ __forceinline__ void operator()(const f32x4 (&acc)[2][2][4][2], const Unit& u, int wr, int wc, int fr, int fq) const {
        const int col0 = u.pn * BM + wc * 32 + 4 * fq;
#pragma unroll
        for (int ai = 0; ai < 2; ++ai) {
            f32x4 bs[4][2][2];
#pragma unroll
            for (int m = 0; m < 4; ++m) { const size_t off = (size_t)(u.pm * BM + ai * HALF + wr * 64 + m * 16 + fr) * ldc + col0;
#pragma unroll
                for (int bj = 0; bj < 2; ++bj)
#pragma unroll
                    for (int n = 0; n < 2; ++n) bs[m][bj][n] = *(const f32x4*)(resid + off + bj * HALF + n * 16); }
            asm volatile("" ::: "memory");
#pragma unroll
            for (int m = 0; m < 4; ++m) { const size_t off = (size_t)(u.pm * BM + ai * HALF + wr * 64 + m * 16 + fr) * ldc + col0;
#pragma unroll
                for (int bj = 0; bj < 2; ++bj)
#pragma unroll
                    for (int n = 0; n < 2; ++n) *(f32x4*)(out + off + bj * HALF + n * 16) = bs[m][bj][n] * alpha + acc[ai][bj][m][n]; }
            asm volatile("" ::: "memory");
        }
    }
};
struct EpiSwiglu {
    static constexpr bool PERM = true;
    bf16_t* O; int ldc;
    __device__ __forceinline__ void operator()(const f32x4 (&acc)[2][2][4][2], const Unit& u, int wr, int wc, int fr, int fq) const {
        const int row0 = u.pm * BM + wr * 64 + fr; const int col0 = (u.pn * BM + wc * 32 + 8 * fq) >> 1;
#pragma unroll
        for (int ai = 0; ai < 2; ++ai)
#pragma unroll
            for (int m = 0; m < 4; ++m) { bf16_t* rowp = O + (size_t)(row0 + ai * HALF + m * 16) * ldc + col0;
#pragma unroll
                for (int bj = 0; bj < 2; ++bj) { const f32x4 g = acc[ai][bj][m][0], up = acc[ai][bj][m][1]; float o[4];
#pragma unroll
                    for (int i = 0; i < 4; ++i) o[i] = g[i] / (1.f + __expf(-g[i])) * up[i];
                    u32x2 w; w.x = cvt_pk_bf16(o[0], o[1]); w.y = cvt_pk_bf16(o[2], o[3]);
                    *(u32x2*)(rowp + bj * (HALF / 2)) = w; } }
    }
};
struct EpiScale {
    static constexpr bool PERM = true;
    bf16_t* O; int ldc; const float* rw;
    __device__ __forceinline__ void operator()(const f32x4 (&acc)[2][2][4][2], const Unit& u, int wr, int wc, int fr, int fq) const {
        const int row0 = u.pm * BM + wr * 64 + fr; const int col0 = u.pn * BM + wc * 32 + 8 * fq;
        float sw[2][4];
#pragma unroll
        for (int ai = 0; ai < 2; ++ai)
#pragma unroll
            for (int m = 0; m < 4; ++m) sw[ai][m] = rw[row0 + ai * HALF + m * 16];
        asm volatile("" ::: "memory");
#pragma unroll
        for (int ai = 0; ai < 2; ++ai)
#pragma unroll
            for (int m = 0; m < 4; ++m) { const int r = row0 + ai * HALF + m * 16; const float s = sw[ai][m]; bf16_t* rowp = O + (size_t)r * ldc + col0;
#pragma unroll
                for (int bj = 0; bj < 2; ++bj) { const f32x4 v0 = acc[ai][bj][m][0] * s, v1 = acc[ai][bj][m][1] * s;
                    u32x4 w; w.x = cvt_pk_bf16(v0[0], v0[1]); w.y = cvt_pk_bf16(v0[2], v0[3]); w.z = cvt_pk_bf16(v1[0], v1[1]); w.w = cvt_pk_bf16(v1[2], v1[3]);
                    *(u32x4*)(rowp + bj * HALF) = w; } }
    }
};

template <class Epi, class Sched, bool GATHER>
__device__ __forceinline__ void gemm_phase(PG8_LAS unsigned char* lds, const Gemm g, const Sched& S, const Epi& E) {
    const int tid = threadIdx.x, wid = __builtin_amdgcn_readfirstlane(tid >> 6), lane = tid & 63, wr = wid >> 2, wc = wid & 3, fr = lane & 15, fq = lane >> 4;
    const int K = g.K, nt = K / BK;
    unsigned voffA[2], voffB[2]; int RA[2], CA[2];
#pragma unroll
    for (int i = 0; i < 2; ++i) { int R, C; stage_rc(tid * 16 + i * 8192, R, C); const int Rb = Epi::PERM ? ((R & ~31) + perm32(R & 31)) : R;
        voffA[i] = (unsigned)(R * K + C) * 2u; voffB[i] = (unsigned)(Rb * K + C) * 2u; RA[i] = R; CA[i] = C; }
    const size_t kstep = (size_t)(BK * 2);
    const size_t hstep = (size_t)HALF * K * 2;
    const size_t tstep = 2 * hstep;
    const unsigned ldsw = (unsigned)wid * 1024u;
    const int aoff = lds_byte(wr * 64 + fr, fq * 8), boff = lds_byte(wc * 32 + fr, fq * 8);
#define PG8_SA(b, h) (((b) * 2 + (h)) * HTB)
#define PG8_SB(b, h) ((4 + (b) * 2 + (h)) * HTB)
#define PG8_STAGE(bufoff, gbase, voff) do { _Pragma("unroll") for (int _i = 0; _i < 2; ++_i) \
        __builtin_amdgcn_global_load_lds((const unsigned*)((const char*)(gbase) + (voff)[_i]), (PG8_LAS unsigned*)(lds + (bufoff) + ldsw + _i * 8192), 16, 0, 0); } while (0)
#define PG8_LDA(dst, b, h) do { _Pragma("unroll") for (int m = 0; m < 4; ++m) _Pragma("unroll") for (int k = 0; k < 2; ++k) dst[m][k] = *(const PG8_LAS bf16x8*)(lds + PG8_SA(b, h) + aoff + m * 2048 + k * 1024); } while (0)
#define PG8_LDB(dst, b, h) do { _Pragma("unroll") for (int n = 0; n < 2; ++n) _Pragma("unroll") for (int k = 0; k < 2; ++k) dst[n][k] = *(const PG8_LAS bf16x8*)(lds + PG8_SB(b, h) + boff + n * 2048 + k * 1024); } while (0)
#define PG8_MMA(ai, bj, At, Bt) do { __builtin_amdgcn_s_setprio(1); _Pragma("unroll") for (int m = 0; m < 4; ++m) _Pragma("unroll") for (int n = 0; n < 2; ++n) _Pragma("unroll") for (int k = 0; k < 2; ++k) \
        acc[ai][bj][m][n] = __builtin_amdgcn_mfma_f32_16x16x32_bf16(Bt[n][k], At[m][k], acc[ai][bj][m][n], 0, 0, 0); __builtin_amdgcn_s_setprio(0); } while (0)
#define PG8_WAIT_V(n) asm volatile("s_waitcnt vmcnt(" #n ")" ::: "memory")
#define PG8_WAIT_L(n) asm volatile("s_waitcnt lgkmcnt(" #n ")" ::: "memory")
#define PG8_BAR __builtin_amdgcn_s_barrier()
#define PG8_SCHED __builtin_amdgcn_sched_barrier(0)
    Unit cur, nxt; int ui = 0;
    if (!S.next(0, cur)) return;
    f32x4 acc[2][2][4][2];
#pragma unroll
    for (int a = 0; a < 2; ++a)
#pragma unroll
        for (int b = 0; b < 2; ++b)
#pragma unroll
            for (int m = 0; m < 4; ++m)
#pragma unroll
                for (int n = 0; n < 2; ++n) acc[a][b][m][n] = (f32x4){0.f, 0.f, 0.f, 0.f};
    bf16x8 At[4][2], B0[2][2], B1[2][2];
    unsigned cG[2][2], nG[2][2];
#define PG8_LOAD_ROWS(u_, G2_) do { _Pragma("unroll") for (int h_ = 0; h_ < 2; ++h_) _Pragma("unroll") for (int i_ = 0; i_ < 2; ++i_) \
        G2_[h_][i_] = GATHER ? ((unsigned)g.rowmap[(u_).pm * BM + h_ * HALF + RA[i_]] * (unsigned)K + (unsigned)CA[i_]) * 2u : voffA[i_]; } while (0)
    const char* cA = GATHER ? (const char*)g.A : (const char*)g.A + (size_t)cur.pm * tstep;
    const size_t hA = GATHER ? 0 : hstep;
    const char* cB = (const char*)g.Bt + (size_t)cur.e * g.bstride + (size_t)cur.pn * tstep;
    PG8_LOAD_ROWS(cur, cG);
    PG8_STAGE(PG8_SB(0, 0), cB, voffB); PG8_STAGE(PG8_SB(0, 1), cB + hstep, voffB); PG8_STAGE(PG8_SA(0, 0), cA, cG[0]); PG8_STAGE(PG8_SA(0, 1), cA + hA, cG[1]);
    if (wr == 1) PG8_BAR;
    PG8_WAIT_V(2); PG8_BAR;
    PG8_STAGE(PG8_SB(1, 0), cB + kstep, voffB); PG8_STAGE(PG8_SA(1, 0), cA + kstep, cG[0]); PG8_STAGE(PG8_SB(1, 1), cB + hstep + kstep, voffB);
    PG8_WAIT_V(6); PG8_BAR;
    for (;;) {
        const bool has_next = S.next(ui + 1, nxt);
        const char* nA = GATHER ? (const char*)g.A : (has_next ? (const char*)g.A + (size_t)nxt.pm * tstep : cA);
        const char* nB = has_next ? (const char*)g.Bt + (size_t)nxt.e * g.bstride + (size_t)nxt.pn * tstep : cB;
        if (has_next) PG8_LOAD_ROWS(nxt, nG); else {
#pragma unroll
            for (int h = 0; h < 2; ++h) { nG[h][0] = cG[h][0]; nG[h][1] = cG[h][1]; } }
        for (int t = 0; t < nt; t += 2) {
            const bool last = (t == nt - 2);
            const char* a1 = cA + (size_t)(t + 1) * kstep;
            const char* a2 = last ? nA : cA + (size_t)(t + 2) * kstep; const char* b2 = last ? nB : cB + (size_t)(t + 2) * kstep;
            const char* a3 = a2 + kstep; const char* b3 = b2 + kstep;
            unsigned sG[2][2];
#pragma unroll
            for (int h = 0; h < 2; ++h) { sG[h][0] = (GATHER && last) ? nG[h][0] : cG[h][0]; sG[h][1] = (GATHER && last) ? nG[h][1] : cG[h][1]; }
            PG8_LDB(B0, 0, 0); PG8_LDB(B1, 0, 1); PG8_SCHED; PG8_LDA(At, 0, 0); PG8_STAGE(PG8_SA(1, 1), a1 + hA, cG[1]);
            PG8_WAIT_V(8); PG8_WAIT_L(0); PG8_BAR; PG8_MMA(0, 0, At, B0); PG8_MMA(0, 1, At, B1); PG8_BAR; PG8_SCHED;
            PG8_LDA(At, 0, 1); PG8_STAGE(PG8_SB(0, 0), b2, voffB); PG8_STAGE(PG8_SB(0, 1), b2 + hstep, voffB); PG8_STAGE(PG8_SA(0, 0), a2, sG[0]);
            PG8_WAIT_V(8); PG8_WAIT_L(0); PG8_BAR; PG8_MMA(1, 0, At, B0); PG8_MMA(1, 1, At, B1); PG8_BAR; PG8_SCHED;
            PG8_LDB(B0, 1, 0); PG8_LDB(B1, 1, 1); PG8_SCHED; PG8_LDA(At, 1, 0); PG8_STAGE(PG8_SA(0, 1), a2 + hA, sG[1]);
            PG8_WAIT_V(8); PG8_WAIT_L(0); PG8_BAR; PG8_MMA(0, 0, At, B0); PG8_MMA(0, 1, At, B1); PG8_BAR; PG8_SCHED;
            PG8_LDA(At, 1, 1); PG8_STAGE(PG8_SB(1, 0), b3, voffB); PG8_STAGE(PG8_SB(1, 1), b3 + hstep, voffB); PG8_STAGE(PG8_SA(1, 0), a3, sG[0]);
            PG8_WAIT_V(8); PG8_WAIT_L(0); PG8_BAR; PG8_MMA(1, 0, At, B0); PG8_MMA(1, 1, At, B1); PG8_BAR; PG8_SCHED;
        }
        if (wr == 0) PG8_BAR;
        E(acc, cur, wr, wc, fr, fq);
        if (!has_next) break;
#pragma unroll
        for (int a = 0; a < 2; ++a)
#pragma unroll
            for (int b = 0; b < 2; ++b)
#pragma unroll
                for (int m = 0; m < 4; ++m)
#pragma unroll
                    for (int n = 0; n < 2; ++n) acc[a][b][m][n] = (f32x4){0.f, 0.f, 0.f, 0.f};
        cur = nxt; cA = nA; cB = nB; ++ui;
#pragma unroll
        for (int h = 0; h < 2; ++h) { cG[h][0] = nG[h][0]; cG[h][1] = nG[h][1]; }
        if (wr == 1) PG8_BAR;
    }
    PG8_WAIT_V(0);
    PG8_BAR;
#undef PG8_LOAD_ROWS
#undef PG8_SA
#undef PG8_SB
#undef PG8_STAGE
#undef PG8_LDA
#undef PG8_LDB
#undef PG8_MMA
#undef PG8_WAIT_V
#undef PG8_WAIT_L
#undef PG8_BAR
#undef PG8_SCHED
}
}
constexpr int NB = 2, SEQ = 16384, T = NB * SEQ, D = 1024;
constexpr int H0P = 2112;
constexpr int ABN = 2048, OFF_U = 0, OFF_Q = 512, OFF_K = 768, OFF_V = 1024, OFF_GO = 1536, AB_IN = 2080;
constexpr int CN = 1536;
constexpr int NEXP = 32, DEXP = 512, CAP = 2 * T + NEXP * 256, MAXTILES = CAP / 256;
constexpr int S5CH = 256, S5NCH = SEQ / S5CH;
constexpr int GSC = 16, GCH = 64, GNSC = SEQ / (GSC * GCH);
constexpr float ALPHA = 1.41421356237309515f;
constexpr float LN_EPS = 1e-5f, RMS_EPS = 1e-6f, LOG2E = 1.44269504088896341f;
constexpr int NWAVES = 8, NTHR = 512;

constexpr size_t MiB = 1u << 20, KiB = 1u << 10;
constexpr size_t WS_CTL = 0, CTL_ZERO_BYTES = 64 * KiB;
constexpr int CW_BAR = 4096;
constexpr size_t WS_LR = 1 * MiB;
constexpr size_t WS_S5E = 5 * MiB;
constexpr size_t WS_GS = 9 * MiB;
constexpr size_t WS_GD = 17 * MiB;
constexpr size_t WS_S5L = WS_GD + 64 * KiB;
constexpr size_t WS_S5B = WS_S5L + 64 * KiB;
constexpr size_t WS_S5C = WS_S5B + 256 * KiB;
constexpr size_t WS_BTAB = WS_S5C + 256 * KiB;
constexpr size_t WS_WR = WS_BTAB + 32 * KiB;
constexpr size_t WS_TOKE = WS_WR + 384 * KiB;
constexpr size_t WS_TOKW = WS_TOKE + 256 * KiB;
constexpr size_t WS_TOKS = WS_TOKW + 256 * KiB;
constexpr size_t WS_SLOTT = WS_TOKS + 256 * KiB;
constexpr size_t WS_SLOTW = WS_SLOTT + 288 * KiB;
constexpr size_t WS_BLKC = WS_SLOTW + 288 * KiB;
constexpr size_t WS_TILE = WS_BLKC + 32 * KiB;
static_assert(WS_TILE + 4 * KiB <= 32 * MiB, "param region");
constexpr size_t WS_WIN = 32 * MiB, WS_WLR = 36 * MiB, WS_WGLU = 37 * MiB, WS_WOUT = 38 * MiB, WS_CIN = 40 * MiB, WS_COUT = 43 * MiB;
constexpr size_t WS_W13 = 48 * MiB, WS_W2 = 112 * MiB;
constexpr size_t A0 = 144 * MiB;
constexpr size_t WS_H1 = A0, WS_H0 = A0;
constexpr size_t WS_Z = A0 + 128 * MiB;
constexpr size_t WS_YG = A0 + 136 * MiB, WS_OF = A0 + 168 * MiB, WS_OB = A0 + 320 * MiB;
constexpr size_t WS_YSCR = A0 + 232 * MiB;
constexpr size_t WS_X64 = A0 + 256 * MiB;
constexpr size_t WS_HID = A0 + 128 * MiB;
constexpr size_t WS_Y2 = A0 + 200 * MiB;
constexpr size_t WS_H2B = A0 + 128 * MiB;
constexpr size_t WS_QKV = A0 + 192 * MiB;
constexpr size_t WS_AO = A0 + 288 * MiB;
constexpr size_t WS_END = A0 + 384 * MiB;
static_assert((size_t)T * H0P * 2 <= 136 * MiB && WS_Y2 + (size_t)CAP * D * 2 <= WS_END && WS_OB + (size_t)T * 512 * 4 <= WS_END && WS_HID + (size_t)CAP * 512 * 2 <= WS_Y2, "act map");

constexpr int RING_BYTES = 131072;
constexpr int MISC_OFF = 163840 - 1024;
constexpr int PTR_OFF = MISC_OFF + 256;
constexpr int LDS_BYTES = 163840;

#define GAS __attribute__((address_space(1)))
#define LAS __attribute__((address_space(3)))
typedef unsigned short bf16;
typedef float f32x4 __attribute__((ext_vector_type(4)));
typedef float f32x2 __attribute__((ext_vector_type(2)));
typedef float f32x16 __attribute__((ext_vector_type(16)));
typedef short bf16x8 __attribute__((ext_vector_type(8)));
typedef short bf16x4 __attribute__((ext_vector_type(4)));
typedef unsigned u32x4 __attribute__((ext_vector_type(4)));
typedef unsigned u32x2 __attribute__((ext_vector_type(2)));
#define LDS_WAIT() asm volatile("s_waitcnt lgkmcnt(0)" ::: "memory")
#define VM_WAIT() asm volatile("s_waitcnt vmcnt(0)" ::: "memory")
#define LDS_BARRIER() do { asm volatile("s_waitcnt lgkmcnt(0)" ::: "memory"); __builtin_amdgcn_s_barrier(); asm volatile("" ::: "memory"); } while (0)
__device__ __forceinline__ unsigned f2bf(float f) { unsigned u = __builtin_bit_cast(unsigned, f); return (u + 0x7fffu + ((u >> 16) & 1u)) >> 16; }
typedef __bf16 bf16x2_t __attribute__((ext_vector_type(2)));
__device__ __forceinline__ unsigned pk2(float lo, float hi) { f32x2 v = {lo, hi}; return __builtin_bit_cast(unsigned, __builtin_convertvector(v, bf16x2_t)); }
__device__ __forceinline__ float bf2f(unsigned short b) { return __uint_as_float((unsigned)b << 16); }
__device__ __forceinline__ float bflo(unsigned w) { return __uint_as_float(w << 16); }
__device__ __forceinline__ float bfhi(unsigned w) { return __uint_as_float(w & 0xffff0000u); }
__device__ __forceinline__ float wave_sum(float v) {
#pragma unroll
    for (int o = 1; o < 64; o <<= 1) v += __shfl_xor(v, o);
    return v;
}
__device__ __forceinline__ int crow(int r, int hi) { return (r & 3) + 8 * (r >> 2) + 4 * hi; }

#define XB_TMO      128
#define XB_XCNT(j)  (256  + 64 * (j))
#define XB_XSUB(j)  (1280 + 64 * (j))
#define XB_XGEN(j)  (2304 + 64 * (j))
#define XB_TOP      3328
#define XB_TOPGEN   3392
#define XCD_BAR_WORDS 3456
#define XB_SPIN_CAP (1u << 18)
__device__ __forceinline__ unsigned xb_ld(unsigned* p)              { return __hip_atomic_load(p, __ATOMIC_RELAXED, __HIP_MEMORY_SCOPE_AGENT); }
__device__ __forceinline__ unsigned xb_add(unsigned* p, unsigned v) { return __hip_atomic_fetch_add(p, v, __ATOMIC_RELAXED, __HIP_MEMORY_SCOPE_AGENT); }
__device__ __forceinline__ unsigned xb_xcc_id() { return (unsigned)__builtin_amdgcn_s_getreg((3 << 11) | 20) & 0xFu; }
#define XB_SPIN(cond, bar) do { unsigned _sp = 0; while (cond) { __builtin_amdgcn_s_sleep(1); \
    if ((++_sp & 255u) == 0u) { if (xb_ld(&(bar)[XB_TMO])) break; if (_sp > XB_SPIN_CAP) { atomicAdd(&(bar)[XB_TMO], 1u); break; } } } } while (0)
struct XcdBarrier { unsigned* bar; unsigned x; volatile LAS unsigned* st; };
__device__ __forceinline__ XcdBarrier xcd_barrier_post(unsigned* bar, volatile LAS unsigned* st) {
    XcdBarrier b; b.bar = bar; b.x = xb_xcc_id(); b.st = st;
    if (threadIdx.x == 0) (void)xb_add(&bar[XB_XCNT(b.x)], 1u);
    return b;
}
__device__ __forceinline__ void xcd_barrier_complete(unsigned* bar, unsigned x, unsigned& nloc, unsigned& nx) {
    const unsigned G = gridDim.x * gridDim.y * gridDim.z;
    unsigned sum, cnt, mine, sp = 0u;
    for (;;) {
        sum = 0u; cnt = 0u; mine = 0u;
#pragma unroll
        for (unsigned j = 0; j < 16; ++j) { const unsigned c = xb_ld(&bar[XB_XCNT(j)]); sum += c; cnt += (c > 0u) ? 1u : 0u; mine = (j == x) ? c : mine; }
        if (sum == G) break;
        __builtin_amdgcn_s_sleep(1);
        if ((++sp & 255u) == 0u) { if (xb_ld(&bar[XB_TMO])) break; if (sp > XB_SPIN_CAP) { atomicAdd(&bar[XB_TMO], 1u); break; } }
    }
    nloc = mine > 0u ? mine : 1u; nx = cnt > 0u ? cnt : 1u;
}
__device__ __forceinline__ void xcd_barrier(const XcdBarrier& b) {
    asm volatile("s_waitcnt vmcnt(0)" ::: "memory");
    __syncthreads();
    if (threadIdx.x == 0) {
        unsigned* bar = b.bar;
        __builtin_amdgcn_s_waitcnt(0);
        unsigned nloc = b.st[0], nx = b.st[1];
        if (nloc == 0u) { xcd_barrier_complete(bar, b.x, nloc, nx); b.st[0] = nloc; b.st[1] = nx; }
        const unsigned old = xb_add(&bar[XB_XSUB(b.x)], 1u);
        const unsigned gen = old / nloc;
        if (old + 1u == (gen + 1u) * nloc) {
            __builtin_amdgcn_fence(__ATOMIC_RELEASE, "agent");
            asm volatile("s_waitcnt vmcnt(0)" ::: "memory");
            const unsigned og = xb_add(&bar[XB_TOP], 1u);
            const unsigned tg = og / nx;
            if (og + 1u == (tg + 1u) * nx) xb_add(&bar[XB_TOPGEN], 1u);
            else XB_SPIN(xb_ld(&bar[XB_TOPGEN]) == tg, bar);
            __builtin_amdgcn_fence(__ATOMIC_ACQUIRE, "agent");
            xb_add(&bar[XB_XGEN(b.x)], 1u);
            asm volatile("s_waitcnt vmcnt(0)" ::: "memory");
        } else {
            XB_SPIN(xb_ld(&bar[XB_XGEN(b.x)]) == gen, bar);
            __builtin_amdgcn_fence(__ATOMIC_ACQUIRE, "agent");
            asm volatile("s_waitcnt vmcnt(0)" ::: "memory");
        }
    }
    __syncthreads();
}

struct Frame {
    LAS unsigned char* lds;
    int tid, lane, wave, G, bid;
    unsigned char* ws;
    const float* const* in;
};
enum InIdx { I_X = 0, I_LNMG, I_LNMB, I_LNFG, I_LNFB, I_ABWIN, I_LAMRE, I_LAMIM, I_LOGDT, I_BRE, I_BIM, I_CRE, I_CIM, I_S5D, I_GLUW, I_GLUB,
             I_GATEW, I_GATEB, I_NORMG, I_ABWOUT, I_CWIN, I_SINK, I_CWOUT, I_RELB, I_WGRP, I_BGRP, I_WRT, I_BRT, I_W1, I_W3, I_W2, N_IN };

__device__ __forceinline__ const float* inp(LAS unsigned char* lds, int k) {
    const LAS unsigned* p = (const LAS unsigned*)(lds + PTR_OFF) + 2 * k;
    const unsigned lo = __builtin_amdgcn_readfirstlane(p[0]), hi = __builtin_amdgcn_readfirstlane(p[1]);
    return (const float*)(((unsigned long long)hi << 32) | (unsigned long long)lo);
}
__device__ __forceinline__ void tr_item(const float* W, int ldw, bf16* WT, int ldt, int rowmode, LAS float* scr, int item, int nblk, int lane) {
    const int kb = item / nblk, nb = item % nblk, k0 = 64 * kb, n0 = 32 * nb;
    float tv[32];
    const float* wp = W + (size_t)(k0 + (lane >> 5)) * ldw + n0 + (lane & 31);
#pragma unroll
    for (int i = 0; i < 32; ++i) tv[i] = wp[(size_t)(2 * i) * ldw];
#pragma unroll
    for (int i = 0; i < 32; ++i) scr[(2 * i + (lane >> 5)) * 33 + (lane & 31)] = tv[i];
    LDS_WAIT(); asm volatile("" ::: "memory");
    const int c = lane & 7;
#pragma unroll
    for (int j = 0; j < 4; ++j) { const int n = (lane >> 3) + 8 * j; const LAS float* s = scr + (8 * c) * 33 + n;
        u32x4 o; o.x = pk2(s[0 * 33], s[1 * 33]); o.y = pk2(s[2 * 33], s[3 * 33]); o.z = pk2(s[4 * 33], s[5 * 33]); o.w = pk2(s[6 * 33], s[7 * 33]);
        const int ng = n0 + n; const int dr = rowmode == 0 ? ng : (8 * (ng >> 2) + (ng & 3) + (rowmode == 2 ? 4 : 0));
        *(GAS u32x4*)(WT + (size_t)dr * ldt + k0 + 8 * c) = o; }
    LDS_WAIT(); asm volatile("" ::: "memory");
}
__device__ __forceinline__ void moe_convert(const float* w1, const float* w3, const float* w2, bf16* W13, bf16* W2T, LAS float* scr, int gw, int NGW, int lane) {
    constexpr int PER_E = 768;
    for (int it = gw; it < NEXP * PER_E; it += NGW) {
        const int e = it / PER_E; int r = it % PER_E;
        if (r < 256) tr_item(w1 + (size_t)e * D * DEXP, DEXP, W13 + (size_t)e * D * D, D, 1, scr, r, DEXP / 32, lane);
        else if (r < 512) tr_item(w3 + (size_t)e * D * DEXP, DEXP, W13 + (size_t)e * D * D, D, 2, scr, r - 256, DEXP / 32, lane);
        else tr_item(w2 + (size_t)e * DEXP * D, D, W2T + (size_t)e * D * DEXP, DEXP, 0, scr, r - 512, D / 32, lane);
    }
}
__device__ __forceinline__ int t5_bucket(int rel) {
    const int nb = 16, max_exact = 8; int ret = rel > 0 ? nb : 0; const int n = rel < 0 ? -rel : rel;
    const float lg = logf((float)(n < 1 ? 1 : n) / 8.0f) / 2.7725887f * 8.0f;
    int large = max_exact + (int)lg; large = large < nb - 1 ? large : nb - 1;
    return ret + (n < max_exact ? n : large);
}
__device__ __forceinline__ void p0_prologue(unsigned char* ws, LAS unsigned char* lds, int bid, int G, int tid, int wave, int lane) {
    LAS float* scr = (LAS float*)(lds + wave * 16384);
    const int gw = bid * NWAVES + wave, NGW = G * NWAVES;
    constexpr int I0 = 16 * 64, I1 = 16, I2 = 8 * 16, I3 = 16 * 32, I4 = 16 * 48, I5 = 16 * 32, NIT = I0 + I1 + I2 + I3 + I4 + I5;
    for (int it = gw; it < NIT; it += NGW) {
        int r = it;
        if (r < I0) { tr_item(inp(lds, I_ABWIN), AB_IN, (bf16*)(ws + WS_WIN), D, 0, scr, r, 64, lane); continue; } r -= I0;
        if (r < I1) { tr_item(inp(lds, I_ABWIN) + 2048, AB_IN, (bf16*)(ws + WS_WLR), D, 0, scr, r, 1, lane); continue; } r -= I1;
        if (r < I2) { tr_item(inp(lds, I_GLUW), 512, (bf16*)(ws + WS_WGLU), 512, 0, scr, r, 16, lane); continue; } r -= I2;
        if (r < I3) { tr_item(inp(lds, I_ABWOUT), D, (bf16*)(ws + WS_WOUT), D, 0, scr, r, 32, lane); continue; } r -= I3;
        if (r < I4) { tr_item(inp(lds, I_CWIN), CN, (bf16*)(ws + WS_CIN), D, 0, scr, r, 48, lane); continue; } r -= I4;
        tr_item(inp(lds, I_CWOUT), D, (bf16*)(ws + WS_COUT), D, 0, scr, r, 32, lane);
    }
    moe_convert(inp(lds, I_W1), inp(lds, I_W3), inp(lds, I_W2), (bf16*)(ws + WS_W13), (bf16*)(ws + WS_W2), scr, gw, NGW, lane);
    { const float* x = inp(lds, I_X); bf16* xb = (bf16*)(ws + WS_X64);
      for (int m = gw; m < T; m += 2 * NGW) { const int m2 = m + NGW;
          const GAS f32x4* xr = (const GAS f32x4*)(x + (size_t)m * D) + lane; GAS u32x2* o = (GAS u32x2*)(xb + (size_t)m * D) + lane;
          const GAS f32x4* xr2 = (const GAS f32x4*)(x + (size_t)m2 * D) + lane; GAS u32x2* o2 = (GAS u32x2*)(xb + (size_t)m2 * D) + lane;
          f32x4 v[4], v2[4];
#pragma unroll
          for (int j = 0; j < 4; ++j) { v[j] = xr[64 * j]; if (m2 < T) v2[j] = xr2[64 * j]; }
#pragma unroll
          for (int j = 0; j < 4; ++j) { u32x2 w; w.x = pk2(v[j].x, v[j].y); w.y = pk2(v[j].z, v[j].w); o[64 * j] = w;
              if (m2 < T) { u32x2 w2; w2.x = pk2(v2[j].x, v2[j].y); w2.y = pk2(v2[j].z, v2[j].w); o2[64 * j] = w2; } } } }
    const int gt = bid * NTHR + tid, NGT = G * NTHR;
    { const float* lamre = inp(lds, I_LAMRE); const float* lamim = inp(lds, I_LAMIM); const float* logdt = inp(lds, I_LOGDT); const float* bre = inp(lds, I_BRE); const float* bim = inp(lds, I_BIM);
    for (int i = gt; i < 2 * 32 * 64; i += NGT) {
        const int p = i & 63, g = (i >> 6) & 31, dir = i >> 11;
        const double lr = fmin((double)lamre[i], -1e-4), li = (double)lamim[i], dt = exp((double)logdt[dir * 32 + g]);
        const double mag = exp(lr * dt), ar = mag * cos(li * dt), ai = mag * sin(li * dt), den = lr * lr + li * li, nr = ar - 1.0;
        const double cr = (nr * lr + ai * li) / den, ci = (ai * lr - nr * li) / den;
        double qr = ar, qi = ai;
#pragma unroll 1
        for (int s = 1; s < S5CH; s <<= 1) { const double t = qr * qr - qi * qi; qi = 2.0 * qr * qi; qr = t; }
        float* L4 = (float*)(ws + WS_S5L) + (size_t)i * 4; L4[0] = (float)ar; L4[1] = (float)ai; L4[2] = (float)qr; L4[3] = (float)qi;
        bf16* Bb = (bf16*)(ws + WS_S5B) + (size_t)(dir * 32 + g) * 2048;
#pragma unroll 4
        for (int c = 0; c < 16; ++c) { const double br = bre[(size_t)i * 16 + c], bi = bim[(size_t)i * 16 + c];
            Bb[p * 16 + c] = (bf16)f2bf((float)(cr * br - ci * bi)); Bb[1024 + p * 16 + c] = (bf16)f2bf((float)(cr * bi + ci * br)); }
    } }
    { const float* cre = inp(lds, I_CRE); const float* cim = inp(lds, I_CIM);
    for (int i = gt; i < 2 * 32 * 16 * 64; i += NGT) {
        const int p = i & 63, c = (i >> 6) & 15, dg = i >> 10;
        bf16* Cm = (bf16*)(ws + WS_S5C) + (size_t)dg * 2048 + c * 128 + 2 * p;
        Cm[0] = (bf16)f2bf(cre[i]); Cm[1] = (bf16)f2bf(-cim[i]);
    } }
    { const float* relb = inp(lds, I_RELB);
    for (int i = gt; i < 16 * 257; i += NGT) { const int h = i / 257, r = i % 257; ((float*)(ws + WS_BTAB))[h * 260 + r] = relb[t5_bucket(r - 128) * 16 + h] * LOG2E; } }
    { const float* wgrp = inp(lds, I_WGRP); const float* wrt = inp(lds, I_WRT);
    for (int i = gt; i < 2 * 48 * 1024; i += NGT) {
        const int k = i & 1023, n = (i >> 10) % 48, l = i / (48 * 1024);
        const float w = n < 4 ? wgrp[(size_t)l * D * 4 + k * 4 + n] : (n < 36 ? wrt[(size_t)l * D * 32 + k * 32 + (n - 4)] : 0.f);
        const unsigned hi = f2bf(w); const float lo = w - __uint_as_float(hi << 16);
        bf16* Wr = (bf16*)(ws + WS_WR) + (size_t)l * 2 * 48 * 1024; Wr[n * 1024 + k] = (bf16)hi; Wr[48 * 1024 + n * 1024 + k] = (bf16)f2bf(lo);
    } }
}

__device__ __forceinline__ void gate_tail(float* bcg, const float* gate_w, const float* gate_b, const LAS float* lrs, size_t row0, int tid);
__device__ __forceinline__ void lr_tail(unsigned char* ws, float* bcg, const float* gate_w, const float* gate_b, LAS unsigned char* lds, int bid, int G, int tid, int wave, int lane) {
    const bf16* xb = (const bf16*)(ws + WS_X64); const bf16* wl = (const bf16*)(ws + WS_WLR); LAS float* lrs = (LAS float*)lds;
    for (int rt = bid; rt < T / 128; rt += G) {
        const int r0 = rt * 128 + wave * 16;
        f32x4 acc0 = {0.f, 0.f, 0.f, 0.f}, acc1 = {0.f, 0.f, 0.f, 0.f};
        const bf16* ap = xb + (size_t)(r0 + (lane & 15)) * D + 8 * (lane >> 4);
        const bf16* bp = wl + (size_t)(lane & 15) * D + 8 * (lane >> 4);
#pragma unroll 8
        for (int ks = 0; ks < 32; ++ks) {
            const bf16x8 a = *(const bf16x8*)(ap + ks * 32), b0 = *(const bf16x8*)(bp + ks * 32), b1 = *(const bf16x8*)(bp + 16 * D + ks * 32);
            acc0 = __builtin_amdgcn_mfma_f32_16x16x32_bf16(a, b0, acc0, 0, 0, 0); acc1 = __builtin_amdgcn_mfma_f32_16x16x32_bf16(a, b1, acc1, 0, 0, 0);
        }
        __syncthreads();
#pragma unroll
        for (int r = 0; r < 4; ++r) { LAS float* o = lrs + (wave * 16 + 4 * (lane >> 4) + r) * 32 + (lane & 15); o[0] = acc0[r]; o[16] = acc1[r]; }
        __syncthreads();
        gate_tail(bcg, gate_w, gate_b, lrs, (size_t)rt * 128, tid);
    }
    __syncthreads();
}

__device__ __forceinline__ void gla_finalize(unsigned char* ws, const float* norm_g, int gw, int NGW, int lane) {
    const bf16* of = (const bf16*)(ws + WS_OF); const bf16* ob = (const bf16*)(ws + WS_OB); const bf16* h0 = (const bf16*)(ws + WS_H0); bf16* cc = (bf16*)(ws + WS_X64);
    const f32x4 g0 = *(const f32x4*)(norm_g + 8 * lane), g1 = *(const f32x4*)(norm_g + 8 * lane + 4);
    for (int m0 = gw; m0 < T; m0 += 4 * NGW) {
        u32x4 a[4], b[4], gq[4];
#pragma unroll
        for (int q = 0; q < 4; ++q) { const size_t m = (size_t)m0 + (size_t)q * NGW;
            a[q] = *(const u32x4*)(of + m * 512 + 8 * lane); b[q] = *(const u32x4*)(ob + m * 512 + 8 * lane); gq[q] = *(const u32x4*)(h0 + m * H0P + OFF_GO + 8 * lane); }
#pragma unroll
        for (int q = 0; q < 4; ++q) { const size_t m = (size_t)m0 + (size_t)q * NGW;
            f32x4 v0, v1;
            v0.x = bflo(a[q].x) + bflo(b[q].x); v0.y = bfhi(a[q].x) + bfhi(b[q].x); v0.z = bflo(a[q].y) + bflo(b[q].y); v0.w = bfhi(a[q].y) + bfhi(b[q].y);
            v1.x = bflo(a[q].z) + bflo(b[q].z); v1.y = bfhi(a[q].z) + bfhi(b[q].z); v1.z = bflo(a[q].w) + bflo(b[q].w); v1.w = bfhi(a[q].w) + bfhi(b[q].w);
            float ss = (v0.x * v0.x + v0.y * v0.y) + (v0.z * v0.z + v0.w * v0.w) + (v1.x * v1.x + v1.y * v1.y) + (v1.z * v1.z + v1.w * v1.w);
            ss += __shfl_xor(ss, 1); ss += __shfl_xor(ss, 2); ss += __shfl_xor(ss, 4); ss += __shfl_xor(ss, 8);
            const float rs = 1.0f / sqrtf(ss * (1.0f / 128.0f) + RMS_EPS);
            const float gv[8] = {bflo(gq[q].x), bfhi(gq[q].x), bflo(gq[q].y), bfhi(gq[q].y), bflo(gq[q].z), bfhi(gq[q].z), bflo(gq[q].w), bfhi(gq[q].w)};
            const float ov[8] = {v0.x * g0.x, v0.y * g0.y, v0.z * g0.z, v0.w * g0.w, v1.x * g1.x, v1.y * g1.y, v1.z * g1.z, v1.w * g1.w};
            float r[8];
#pragma unroll
            for (int i = 0; i < 8; ++i) r[i] = ov[i] * rs * (gv[i] / (1.f + __expf(-gv[i])));
            u32x4 w; w.x = pk2(r[0], r[1]); w.y = pk2(r[2], r[3]); w.z = pk2(r[4], r[5]); w.w = pk2(r[6], r[7]);
            *(u32x4*)(cc + m * D + 512 + 8 * lane) = w; }
    }
}

constexpr int RT_AST = 2064;
__device__ __forceinline__ void ln_router(unsigned char* ws, const float* resid, const float* lng, const float* lnb, const float* bgrp, const float* brt, int layer, LAS unsigned char* lds, int bid, int G, int tid, int wave, int lane) {
    const bf16* yb = (const bf16*)(ws + WS_Z); float* h1 = (float*)(ws + WS_H1); bf16* hb = (bf16*)(ws + WS_X64);
    int* tok_e = (int*)(ws + WS_TOKE); float* tok_w = (float*)(ws + WS_TOKW);
    LAS unsigned char* Ahi = lds; LAS unsigned char* Alo = lds + 16 * RT_AST; LAS float* part = (LAS float*)(lds + 32 * RT_AST);
    LAS int* hist = (LAS int*)(lds + 32 * RT_AST + 8 * 16 * 48 * 4); LAS float* lgt = (LAS float*)(lds + 32 * RT_AST + 8 * 16 * 48 * 4 + 256);
    if (tid < 32) hist[tid] = 0;
    const bf16* Wr = (const bf16*)(ws + WS_WR) + (size_t)layer * 2 * 48 * 1024;
    bf16x8 Bh[3][4], Bl[3][4];
#pragma unroll
    for (int nt = 0; nt < 3; ++nt)
#pragma unroll
        for (int ks = 0; ks < 4; ++ks) { const size_t o = (size_t)(nt * 16 + (lane & 15)) * 1024 + wave * 128 + ks * 32 + 8 * (lane >> 4);
            Bh[nt][ks] = *(const bf16x8*)(Wr + o); Bl[nt][ks] = *(const bf16x8*)(Wr + 48 * 1024 + o); }
    f32x4 gv[4], bv[4];
#pragma unroll
    for (int j = 0; j < 4; ++j) { gv[j] = *(const f32x4*)(lng + 4 * lane + 256 * j); bv[j] = *(const f32x4*)(lnb + 4 * lane + 256 * j); }
    __syncthreads();
    for (int grp = bid; grp < T / 16; grp += G) {
#pragma unroll
        for (int rr = 0; rr < 2; ++rr) {
            const int row = 2 * wave + rr; const size_t m = (size_t)grp * 16 + row;
            const GAS f32x4* xr = (const GAS f32x4*)(resid + m * D) + lane; const GAS u32x2* yr = (const GAS u32x2*)(yb + m * D) + lane;
            f32x4 v[4]; float s = 0.f;
#pragma unroll
            for (int j = 0; j < 4; ++j) { const f32x4 x4 = xr[64 * j]; const u32x2 y2 = yr[64 * j];
                v[j].x = x4.x * ALPHA + bflo(y2.x); v[j].y = x4.y * ALPHA + bfhi(y2.x); v[j].z = x4.z * ALPHA + bflo(y2.y); v[j].w = x4.w * ALPHA + bfhi(y2.y);
                s += (v[j].x + v[j].y) + (v[j].z + v[j].w); }
            const float mean = wave_sum(s) * (1.f / D); float s2 = 0.f;
#pragma unroll
            for (int j = 0; j < 4; ++j) { v[j] = v[j] - mean; s2 += (v[j].x * v[j].x + v[j].y * v[j].y) + (v[j].z * v[j].z + v[j].w * v[j].w); }
            const float rstd = 1.f / sqrtf(wave_sum(s2) * (1.f / D) + LN_EPS);
#pragma unroll
            for (int j = 0; j < 4; ++j) {
                const f32x4 h = v[j] * rstd * gv[j] + bv[j];
                ((GAS f32x4*)(h1 + m * D) + lane)[64 * j] = h;
                const unsigned h0 = pk2(h.x, h.y), h1w = pk2(h.z, h.w);
                u32x2 w; w.x = h0; w.y = h1w; ((GAS u32x2*)(hb + m * D) + lane)[64 * j] = w;
                u32x2 lo; lo.x = pk2(h.x - bflo(h0), h.y - bfhi(h0)); lo.y = pk2(h.z - bflo(h1w), h.w - bfhi(h1w));
                *(LAS u32x2*)(Ahi + row * RT_AST + (4 * lane + 256 * j) * 2) = w; *(LAS u32x2*)(Alo + row * RT_AST + (4 * lane + 256 * j) * 2) = lo;
            }
        }
        LDS_BARRIER();
        f32x4 acc[3] = {{0.f, 0.f, 0.f, 0.f}, {0.f, 0.f, 0.f, 0.f}, {0.f, 0.f, 0.f, 0.f}};
#pragma unroll
        for (int ks = 0; ks < 4; ++ks) {
            const int bo = (lane & 15) * RT_AST + (wave * 128 + ks * 32 + 8 * (lane >> 4)) * 2;
            const bf16x8 ah = *(const LAS bf16x8*)(Ahi + bo), al = *(const LAS bf16x8*)(Alo + bo);
#pragma unroll
            for (int nt = 0; nt < 3; ++nt) {
                acc[nt] = __builtin_amdgcn_mfma_f32_16x16x32_bf16(ah, Bh[nt][ks], acc[nt], 0, 0, 0);
                acc[nt] = __builtin_amdgcn_mfma_f32_16x16x32_bf16(ah, Bl[nt][ks], acc[nt], 0, 0, 0);
                acc[nt] = __builtin_amdgcn_mfma_f32_16x16x32_bf16(al, Bh[nt][ks], acc[nt], 0, 0, 0);
            }
        }
#pragma unroll
        for (int nt = 0; nt < 3; ++nt)
#pragma unroll
            for (int r = 0; r < 4; ++r) part[(wave * 16 + 4 * (lane >> 4) + r) * 48 + nt * 16 + (lane & 15)] = acc[nt][r];
        LDS_BARRIER();
        for (int idx = tid; idx < 16 * 36; idx += NTHR) { const int tk = idx / 36, n = idx % 36; float s = 0.f;
#pragma unroll
            for (int w = 0; w < 8; ++w) s += part[(w * 16 + tk) * 48 + n];
            lgt[tk * 36 + n] = s + (n < 4 ? bgrp[n] : brt[n - 4]); }
        LDS_BARRIER();
        if (tid < 16) {
            const size_t m = (size_t)grp * 16 + tid;
            const LAS float* lg = lgt + tid * 36;
            int gi = 0; float gm = lg[0];
#pragma unroll
            for (int n = 1; n < 4; ++n) if (lg[n] > gm) { gm = lg[n]; gi = n; }
            float gs = 0.f;
#pragma unroll
            for (int n = 0; n < 4; ++n) gs += __expf(lg[n] - gm);
            const float pg = 1.f / gs;
            float el[8];
#pragma unroll
            for (int i = 0; i < 8; ++i) el[i] = lg[4 + gi * 8 + i];
            int i1 = 0; float m1 = el[0];
#pragma unroll
            for (int i = 1; i < 8; ++i) if (el[i] > m1) { m1 = el[i]; i1 = i; }
            int i2 = -1; float m2 = -3.0e38f;
#pragma unroll
            for (int i = 0; i < 8; ++i) if (i != i1 && el[i] > m2) { m2 = el[i]; i2 = i; }
            const float e2 = __expf(m2 - m1), inv = 1.f / (1.f + e2);
            const int ea = gi * 8 + i1, eb = gi * 8 + i2;
            tok_e[m * 2] = ea; tok_e[m * 2 + 1] = eb; tok_w[m * 2] = pg * inv; tok_w[m * 2 + 1] = pg * e2 * inv;
            atomicAdd((int*)&hist[ea], 1); atomicAdd((int*)&hist[eb], 1);
        }
        LDS_BARRIER();
    }
    if (tid < 32) ((int*)(ws + WS_BLKC))[bid * 32 + tid] = hist[tid];
}

__device__ __forceinline__ void moe_sort(unsigned char* ws, LAS unsigned char* lds, int bid, int G, int tid) {
    const int* blkc = (const int*)(ws + WS_BLKC); const int* tok_e = (const int*)(ws + WS_TOKE); const float* tok_w = (const float*)(ws + WS_TOKW);
    int* tok_s = (int*)(ws + WS_TOKS); int* slot_t = (int*)(ws + WS_SLOTT); float* slot_w = (float*)(ws + WS_SLOTW); int* tile = (int*)(ws + WS_TILE);
    LAS int* ptot = (LAS int*)lds; LAS int* pbase = ptot + 512; LAS int* tot = pbase + 512; LAS int* base = tot + 32; LAS int* pstart = base + 32; LAS int* lcur = pstart + 33;
    { const int e = tid & 31, part = tid >> 5; int st = 0, sb = 0;
      for (int b = part; b < G; b += 16) { const int c = blkc[b * 32 + e]; st += c; sb += (b < bid) ? c : 0; }
      ptot[part * 32 + e] = st; pbase[part * 32 + e] = sb; }
    __syncthreads();
    if (tid < 32) { int st = 0, sb = 0;
#pragma unroll
        for (int p = 0; p < 16; ++p) { st += ptot[p * 32 + tid]; sb += pbase[p * 32 + tid]; }
        tot[tid] = st; base[tid] = sb; lcur[tid] = 0; }
    __syncthreads();
    if (tid == 0) { int acc = 0; for (int e = 0; e < 32; ++e) { pstart[e] = acc; acc += (tot[e] + 255) & ~255; } pstart[32] = acc; }
    __syncthreads();
    if (bid == 0) {
        const int nt = pstart[32] >> 8;
        if (tid == 0) tile[511] = nt;
        for (int t = tid; t < nt; t += NTHR) { int e = 0; for (int q = 1; q < 32; ++q) if ((t << 8) >= pstart[q]) e = q; tile[t] = e; }
    }
    for (int e = bid; e < 32; e += G)
        for (int s = pstart[e] + tot[e] + tid; s < pstart[e + 1]; s += NTHR) { slot_t[s] = 0; slot_w[s] = 0.f; }
    for (int grp = bid; grp < T / 16; grp += G) {
        if (tid < 32) { const size_t a = (size_t)grp * 32 + tid; const int e = tok_e[a]; const int rank = atomicAdd((int*)&lcur[e], 1);
            const int s = pstart[e] + base[e] + rank; slot_t[s] = (int)(a >> 1); slot_w[s] = tok_w[a]; tok_s[a] = s; }
    }
}

template <bool FINAL>
__device__ __forceinline__ void combine_ln(unsigned char* ws, const float* lng, const float* lnb, float* dout, int gw, int NGW, int lane) {
    float* h1 = (float*)(ws + WS_H1); const bf16* y2 = (const bf16*)(ws + WS_Y2); const int* tok_s = (const int*)(ws + WS_TOKS); bf16* h2b = (bf16*)(ws + WS_H2B);
    f32x4 gv[4], bv[4];
#pragma unroll
    for (int j = 0; j < 4; ++j) { gv[j] = *(const f32x4*)(lng + 4 * lane + 256 * j); bv[j] = *(const f32x4*)(lnb + 4 * lane + 256 * j); }
    for (int m = gw; m < T; m += NGW) {
        const int s0 = tok_s[(size_t)m * 2], s1 = tok_s[(size_t)m * 2 + 1];
        const GAS f32x4* hr = (const GAS f32x4*)(h1 + (size_t)m * D) + lane;
        const GAS u32x2* ya = (const GAS u32x2*)(y2 + (size_t)s0 * D) + lane; const GAS u32x2* yb = (const GAS u32x2*)(y2 + (size_t)s1 * D) + lane;
        f32x4 v[4]; float s = 0.f;
#pragma unroll
        for (int j = 0; j < 4; ++j) { const f32x4 h = hr[64 * j]; const u32x2 a = ya[64 * j], b = yb[64 * j];
            v[j].x = h.x * ALPHA + (bflo(a.x) + bflo(b.x)); v[j].y = h.y * ALPHA + (bfhi(a.x) + bfhi(b.x)); v[j].z = h.z * ALPHA + (bflo(a.y) + bflo(b.y)); v[j].w = h.w * ALPHA + (bfhi(a.y) + bfhi(b.y));
            s += (v[j].x + v[j].y) + (v[j].z + v[j].w); }
        const float mean = wave_sum(s) * (1.f / D); float s2 = 0.f;
#pragma unroll
        for (int j = 0; j < 4; ++j) { v[j] = v[j] - mean; s2 += (v[j].x * v[j].x + v[j].y * v[j].y) + (v[j].z * v[j].z + v[j].w * v[j].w); }
        const float rstd = 1.f / sqrtf(wave_sum(s2) * (1.f / D) + LN_EPS);
#pragma unroll
        for (int j = 0; j < 4; ++j) { const f32x4 h = v[j] * rstd * gv[j] + bv[j];
            if (FINAL) ((GAS f32x4*)(dout + (size_t)m * D) + lane)[64 * j] = h;
            else { ((GAS f32x4*)(h1 + (size_t)m * D) + lane)[64 * j] = h; u32x2 w; w.x = pk2(h.x, h.y); w.y = pk2(h.z, h.w); ((GAS u32x2*)(h2b + (size_t)m * D) + lane)[64 * j] = w; } }
    }
}
constexpr int S5_HST = 272, S5_UST = 272, S5_UOFF = 8 * 32 * S5_HST;
#define MFMA32(a, b, c) __builtin_amdgcn_mfma_f32_32x32x16_bf16((a), (b), (c), 0, 0, 0)
#define MFMA16(a, b, c) __builtin_amdgcn_mfma_f32_16x16x32_bf16((a), (b), (c), 0, 0, 0)
__device__ __forceinline__ float gelu_tanh(float x) {
    const float u = 0.7978845608028654f * (x + 0.044715f * x * x * x);
    const float e = __expf(2.f * u); const float th = 1.f - 2.f / (e + 1.f);
    return 0.5f * x * (1.f + th);
}
__device__ __forceinline__ f32x4 ld_ys(const float* p) {
    f32x4 v;
    v.x = __hip_atomic_load(p, __ATOMIC_RELAXED, __HIP_MEMORY_SCOPE_AGENT); v.y = __hip_atomic_load(p + 1, __ATOMIC_RELAXED, __HIP_MEMORY_SCOPE_AGENT);
    v.z = __hip_atomic_load(p + 2, __ATOMIC_RELAXED, __HIP_MEMORY_SCOPE_AGENT); v.w = __hip_atomic_load(p + 3, __ATOMIC_RELAXED, __HIP_MEMORY_SCOPE_AGENT);
    return v;
}
template <int PASS, int DIR>
__device__ __forceinline__ void s5_dir(unsigned char* ws, const float* s5d, int b, int g, int c, LAS unsigned char* hl, const LAS unsigned char* ul, float* yscr, int lane) {
    const bf16* h0 = (const bf16*)(ws + WS_H0);
    const int dg = DIR * 32 + g;
    const f32x4 L4 = *(const f32x4*)((const float*)(ws + WS_S5L) + (size_t)(dg * 64 + lane) * 4);
    const float ar = L4.x, ai = L4.y, qr = L4.z, qi = L4.w;
    const float l2r = ar * ar - ai * ai, l2i = 2.f * ar * ai, l4r = l2r * l2r - l2i * l2i, l4i = 2.f * l2r * l2i, l8r = l4r * l4r - l4i * l4i, l8i = 2.f * l4r * l4i;
    const float l16r = l8r * l8r - l8i * l8i, l16i = 2.f * l8r * l8i, l32r = l16r * l16r - l16i * l16i, l32i = 2.f * l16r * l16i;
    const bf16* Bb = (const bf16*)(ws + WS_S5B) + (size_t)dg * 2048 + (lane & 31) * 16 + 8 * (lane >> 5);
    const bf16x8 bre0 = *(const bf16x8*)Bb, bre1 = *(const bf16x8*)(Bb + 512), bim0 = *(const bf16x8*)(Bb + 1024), bim1 = *(const bf16x8*)(Bb + 1536);
    bf16x8 cf[4]; bf16x8 dfrag;
    if (PASS == 2) {
        const bf16* Cm = (const bf16*)(ws + WS_S5C) + (size_t)dg * 2048 + (lane & 15) * 128 + 8 * (lane >> 4);
#pragma unroll
        for (int ks = 0; ks < 4; ++ks) cf[ks] = *(const bf16x8*)(Cm + 32 * ks);
        if (DIR == 1) {
            const int cc = lane & 15, kq = lane >> 4; const float d = s5d[g * 16 + cc]; const unsigned dh = f2bf(d); const unsigned dl = f2bf(d - __uint_as_float(dh << 16));
#pragma unroll
            for (int j = 0; j < 8; ++j) { const int k = 8 * (kq & 1) + j; dfrag[j] = (short)((k == cc) ? (kq < 2 ? dh : dl) : 0u); }
        }
    }
    float hr = 0.f, hi = 0.f;
    float* Ec = (float*)(ws + WS_S5E) + ((size_t)((DIR * NB + b) * 32 + g) * S5NCH) * 128 + 2 * lane;
    if (PASS == 2) {
        const int nj = DIR == 0 ? c : (S5NCH - 1 - c);
        for (int j0 = 0; j0 < nj; j0 += 8) {
            f32x2 e[8];
#pragma unroll
            for (int q = 0; q < 8; ++q) { const int j = j0 + q; const int jj = DIR == 0 ? j : (S5NCH - 1 - j); e[q] = (j < nj) ? *(const f32x2*)(Ec + (size_t)jj * 128) : (f32x2){0.f, 0.f}; }
#pragma unroll
            for (int q = 0; q < 8; ++q) if (j0 + q < nj) { const float nr = qr * hr - qi * hi + e[q].x; hi = qr * hi + qi * hr + e[q].y; hr = nr; }
        }
    }
    const size_t rowbase = (size_t)b * SEQ + (size_t)c * S5CH;
    const LAS unsigned char* up = ul + (lane & 31) * S5_UST + (g & 7) * 32 + 16 * (lane >> 5);
    const f32x16 zero16 = {0.f, 0.f, 0.f, 0.f, 0.f, 0.f, 0.f, 0.f, 0.f, 0.f, 0.f, 0.f, 0.f, 0.f, 0.f, 0.f};
#pragma unroll 1
    for (int ti = 0; ti < S5CH / 32; ++ti) {
        const int tile = DIR == 0 ? ti : (S5CH / 32 - 1 - ti);
        const bf16x8 a = *(const LAS bf16x8*)(up + tile * 32 * S5_UST);
        f32x4 ysv[2] = {{0.f, 0.f, 0.f, 0.f}, {0.f, 0.f, 0.f, 0.f}};
        if (PASS == 2 && DIR == 1) { ysv[0] = ld_ys(yscr + (size_t)(tile * 2) * 256 + 4 * lane); ysv[1] = ld_ys(yscr + (size_t)(tile * 2 + 1) * 256 + 4 * lane); }
        f32x16 xr0 = MFMA32(a, bre0, zero16), xr1 = MFMA32(a, bre1, zero16), xi0 = MFMA32(a, bim0, zero16), xi1 = MFMA32(a, bim1, zero16);
        __builtin_amdgcn_sched_barrier(0);
        asm volatile("s_nop 15\n\ts_nop 15\n\ts_nop 15\n\ts_nop 15" ::: "memory");
        __builtin_amdgcn_sched_barrier(0);
        float xr[32], xi[32];
#pragma unroll
        for (int r = 0; r < 16; ++r) {
            auto s = __builtin_amdgcn_permlane32_swap(__float_as_uint(xr0[r]), __float_as_uint(xr1[r]), false, false);
            xr[crow(r, 0)] = __uint_as_float(s[0]); xr[crow(r, 1)] = __uint_as_float(s[1]);
            auto q = __builtin_amdgcn_permlane32_swap(__float_as_uint(xi0[r]), __float_as_uint(xi1[r]), false, false);
            xi[crow(r, 0)] = __uint_as_float(q[0]); xi[crow(r, 1)] = __uint_as_float(q[1]);
        }
        if (PASS == 1) {
#pragma unroll
            for (int lv = 0; lv < 5; ++lv) {
                const float pr = lv == 0 ? ar : lv == 1 ? l2r : lv == 2 ? l4r : lv == 3 ? l8r : l16r, pi = lv == 0 ? ai : lv == 1 ? l2i : lv == 2 ? l4i : lv == 3 ? l8i : l16i;
#pragma unroll
                for (int i = 0; i < (16 >> lv); ++i) {
                    const int e = DIR == 0 ? 2 * i : 2 * i + 1, l = DIR == 0 ? 2 * i + 1 : 2 * i;
                    const float er = xr[e << lv], ei = xi[e << lv], lr_ = xr[l << lv], li_ = xi[l << lv];
                    const float wr = fmaf(pr, er, fmaf(-pi, ei, lr_)), wi = fmaf(pr, ei, fmaf(pi, er, li_));
                    xr[(2 * i) << lv] = wr; xi[(2 * i) << lv] = wi;
                }
            }
            { const float nr = fmaf(l32r, hr, fmaf(-l32i, hi, xr[0])), ni = fmaf(l32r, hi, fmaf(l32i, hr, xi[0])); hr = nr; hi = ni; }
        } else {
#pragma unroll
        for (int tt = 0; tt < 32; ++tt) {
            const int t = DIR == 0 ? tt : 31 - tt;
            const float tr_ = fmaf(-ai, hi, xr[t]), ti_ = fmaf(ai, hr, xi[t]);
            hr = fmaf(ar, hr, tr_); hi = fmaf(ar, hi, ti_);
            *(LAS unsigned*)(hl + t * S5_HST + 4 * lane) = pk2(hr, hi);
        }
        }
        if (PASS == 2) {
#pragma unroll
            for (int sub = 0; sub < 2; ++sub) {
                float* ys = yscr + (size_t)(tile * 2 + sub) * 256 + 4 * lane;
                f32x4 y = {0.f, 0.f, 0.f, 0.f};
                if (DIR == 1) y = ysv[sub];
#pragma unroll
                for (int ks = 0; ks < 4; ++ks) { const bf16x8 hf = *(const LAS bf16x8*)(hl + (sub * 16 + (lane & 15)) * S5_HST + 64 * ks + 16 * (lane >> 4)); y = MFMA16(hf, cf[ks], y); }
                if (DIR == 0) *(f32x4*)ys = y;
                else {
                    const bf16x8 uf = *(const LAS bf16x8*)(ul + (tile * 32 + sub * 16 + (lane & 15)) * S5_UST + (g & 7) * 32 + 16 * ((lane >> 4) & 1));
                    y = MFMA16(uf, dfrag, y);
                    bf16* yo = (bf16*)(ws + WS_YG) + (rowbase + tile * 32 + sub * 16 + 4 * (lane >> 4)) * 512 + g * 16 + (lane & 15);
#pragma unroll
                    for (int r = 0; r < 4; ++r) yo[(size_t)r * 512] = (bf16)f2bf(gelu_tanh(y[r]));
                }
            }
        }
    }
    if (PASS == 1) { f32x2 e; e.x = hr; e.y = hi; *(f32x2*)(Ec + (size_t)c * 128) = e; }
}
template <int PASS>
__device__ __forceinline__ void s5_phase(unsigned char* ws, const float* s5d, LAS unsigned char* lds, int bid, int G, int tid, int wave, int lane) {
    LAS unsigned char* hl = lds + wave * (32 * S5_HST); LAS unsigned char* ul = lds + S5_UOFF;
    float* yscr = (float*)(ws + WS_YSCR) + (size_t)(bid * NWAVES + wave) * 4096;
    const bf16* h0 = (const bf16*)(ws + WS_H0);
    for (int it = bid; it < NB * S5NCH * 4; it += G) {
        const int go = it & 3, c = (it >> 2) % S5NCH, b = it / (4 * S5NCH), g = go * 8 + wave;
        { const bf16* src = h0 + ((size_t)b * SEQ + (size_t)c * S5CH) * H0P + OFF_U + go * 128;
          u32x4 v[8];
#pragma unroll
          for (int i = 0; i < 8; ++i) { const int p = i * NTHR + tid; v[i] = *(const u32x4*)(src + (size_t)(p >> 4) * H0P + 8 * (p & 15)); }
          __syncthreads();
#pragma unroll
          for (int i = 0; i < 8; ++i) { const int p = i * NTHR + tid; *(LAS u32x4*)(ul + (p >> 4) * S5_UST + 16 * (p & 15)) = v[i]; }
          __syncthreads(); }
        s5_dir<PASS, 0>(ws, s5d, b, g, c, hl, ul, yscr, lane);
        s5_dir<PASS, 1>(ws, s5d, b, g, c, hl, ul, yscr, lane);
    }
}
constexpr int G_ST = 144;
constexpr int GL_QD = 0, GL_KD = GL_QD + 64 * G_ST, GL_KCT = GL_KD + 64 * G_ST, GL_VT = GL_KCT + 64 * G_ST,
              GL_S = GL_VT + 128 * G_ST, GL_ST = GL_S + 64 * G_ST, GL_END = GL_ST + 2 * 128 * G_ST;
static_assert(GL_END <= RING_BYTES, "GLA LDS");
__device__ __forceinline__ bf16x8 ldfrag32(const LAS unsigned char* base, int row0, int ks, int lane) {
    return *(const LAS bf16x8*)(base + (row0 + (lane & 31)) * G_ST + 32 * ks + 16 * (lane >> 5));
}
__device__ __forceinline__ void gate_tail(float* bcg, const float* gate_w, const float* gate_b, const LAS float* lrs, size_t row0, int tid) {
    const int dir = tid >> 8;
    float gw[16];
#pragma unroll
    for (int r = 0; r < 16; ++r) gw[r] = gate_w[(size_t)(dir * 16 + r) * 256 + (tid & 255)];
    const float gb = gate_b[tid];
    float run = 0.f;
#pragma unroll 4
    for (int i = 0; i < 128; ++i) {
        const int t = dir ? 127 - i : i;
        if ((i & 63) == 0) run = 0.f;
        const LAS f32x4* lp = (const LAS f32x4*)(lrs + t * 32 + dir * 16);
        const f32x4 l0 = lp[0], l1 = lp[1], l2 = lp[2], l3 = lp[3];
        float z = gb + l0.x * gw[0] + l0.y * gw[1] + l0.z * gw[2] + l0.w * gw[3] + l1.x * gw[4] + l1.y * gw[5] + l1.z * gw[6] + l1.w * gw[7]
                     + l2.x * gw[8] + l2.y * gw[9] + l2.z * gw[10] + l2.w * gw[11] + l3.x * gw[12] + l3.y * gw[13] + l3.z * gw[14] + l3.w * gw[15];
        const float ls = fminf(z, 0.f) - __logf(1.f + __expf(-fabsf(z)));
        run += ls * (1.0f / 16.0f);
        bcg[(row0 + t) * 512 + tid] = run;
    }
}
__device__ __forceinline__ size_t gla_tok(int b, int dir, int chunk, int s) { const int pos = chunk * GCH + s; return (size_t)b * SEQ + (dir ? (SEQ - 1 - pos) : pos); }
template <int PASS>
__device__ __forceinline__ void gla_item(unsigned char* ws, const float* bcg, int item, LAS unsigned char* lds, int tid, int wave, int lane) {
    const int sc = item % GNSC, dir = (item / GNSC) & 1, h = (item / (GNSC * 2)) & 3, b = item / (GNSC * 8);
    const bf16* h0 = (const bf16*)(ws + WS_H0);
    LAS unsigned char* QD = lds + GL_QD; LAS unsigned char* KD = lds + GL_KD; LAS unsigned char* KCT = lds + GL_KCT; LAS unsigned char* VT = lds + GL_VT; LAS unsigned char* SS = lds + GL_S; LAS unsigned char* STT = lds + GL_ST;
    const int me = wave >> 1, nd = wave & 1;
    f32x16 st;
#pragma unroll
    for (int r = 0; r < 16; ++r) st[r] = 0.f;
    float dtot = 1.f;
    float* GS = (float*)(ws + WS_GS); float* GD = (float*)(ws + WS_GD);
    const int ibase = item - sc;
    if (PASS == 2) {
        for (int j = 0; j < sc; ++j) {
            const float dj = GD[(size_t)(ibase + j) * 64 + nd * 32 + (lane & 31)];
            const float* gs = GS + (size_t)(ibase + j) * 8192 + nd * 32 + (lane & 31);
#pragma unroll
            for (int r = 0; r < 16; ++r) st[r] = st[r] * dj + gs[(size_t)(me * 32 + crow(r, lane >> 5)) * 64];
        }
#pragma unroll
        for (int r = 0; r < 16; ++r) *(LAS bf16*)(STT + (me * 32 + crow(r, lane >> 5)) * G_ST + (nd * 32 + (lane & 31)) * 2) = (bf16)f2bf(st[r]);
    }
    const float qscale = 0.125f;
    const int s_l = lane;
    const int gcol = dir * 256 + h * 64;
    u32x4 pq, pk, pv0, pv1; f32x4 pb0, pb1, pl0, pl1; float pdec;
#define GLA_LOAD(n) do { const int ch_ = sc * GSC + (n); const size_t tk = gla_tok(b, dir, ch_, s_l), tl = gla_tok(b, dir, ch_, 63); const bf16* rp = h0 + tk * H0P; \
        if (PASS == 2) pq = *(const u32x4*)(rp + OFF_Q + h * 64 + 8 * wave); \
        pk = *(const u32x4*)(rp + OFF_K + h * 64 + 8 * wave); pv0 = *(const u32x4*)(rp + OFF_V + h * 128 + 16 * wave); pv1 = *(const u32x4*)(rp + OFF_V + h * 128 + 16 * wave + 8); \
        pb0 = *(const f32x4*)(bcg + tk * 512 + gcol + 8 * wave); pb1 = *(const f32x4*)(bcg + tk * 512 + gcol + 8 * wave + 4); \
        pl0 = *(const f32x4*)(bcg + tl * 512 + gcol + 8 * wave); pl1 = *(const f32x4*)(bcg + tl * 512 + gcol + 8 * wave + 4); \
        pdec = bcg[tl * 512 + gcol + nd * 32 + (lane & 31)]; } while (0)
    GLA_LOAD(0);
    __syncthreads();
#pragma unroll 1
    for (int n = 0; n < GSC; ++n) {
        LAS unsigned char* STc = STT + (n & 1) * (128 * G_ST); LAS unsigned char* STn = STT + ((n + 1) & 1) * (128 * G_ST);
        { const float bc[8] = {pb0.x, pb0.y, pb0.z, pb0.w, pb1.x, pb1.y, pb1.z, pb1.w}, bl[8] = {pl0.x, pl0.y, pl0.z, pl0.w, pl1.x, pl1.y, pl1.z, pl1.w};
          const float kv[8] = {bflo(pk.x), bfhi(pk.x), bflo(pk.y), bfhi(pk.y), bflo(pk.z), bfhi(pk.z), bflo(pk.w), bfhi(pk.w)};
          if (PASS == 2) {
              const float qv[8] = {bflo(pq.x), bfhi(pq.x), bflo(pq.y), bfhi(pq.y), bflo(pq.z), bfhi(pq.z), bflo(pq.w), bfhi(pq.w)};
              float qd[8], kd[8];
#pragma unroll
              for (int i = 0; i < 8; ++i) { qd[i] = qv[i] * qscale * __expf(bc[i]); kd[i] = kv[i] * __expf(-bc[i]); }
              u32x4 w; w.x = pk2(qd[0], qd[1]); w.y = pk2(qd[2], qd[3]); w.z = pk2(qd[4], qd[5]); w.w = pk2(qd[6], qd[7]);
              *(LAS u32x4*)(QD + s_l * G_ST + 16 * wave) = w;
              w.x = pk2(kd[0], kd[1]); w.y = pk2(kd[2], kd[3]); w.z = pk2(kd[4], kd[5]); w.w = pk2(kd[6], kd[7]);
              *(LAS u32x4*)(KD + s_l * G_ST + 16 * wave) = w;
          }
#pragma unroll
          for (int i = 0; i < 8; ++i) *(LAS bf16*)(KCT + (8 * wave + i) * G_ST + 2 * s_l) = (bf16)f2bf(kv[i] * __expf(bl[i] - bc[i]));
          const unsigned vv[8] = {pv0.x, pv0.y, pv0.z, pv0.w, pv1.x, pv1.y, pv1.z, pv1.w};
#pragma unroll
          for (int i = 0; i < 8; ++i) { *(LAS bf16*)(VT + (16 * wave + 2 * i) * G_ST + 2 * s_l) = (bf16)(vv[i] & 0xffffu); *(LAS bf16*)(VT + (16 * wave + 2 * i + 1) * G_ST + 2 * s_l) = (bf16)(vv[i] >> 16); }
        }
        const float dec = __expf(pdec);
        if (n + 1 < GSC) GLA_LOAD(n + 1);
        LDS_BARRIER();
        if (PASS == 2 && wave < 4) {
            const int ms = wave >> 1, ns = wave & 1;
            f32x16 sa;
#pragma unroll
            for (int r = 0; r < 16; ++r) sa[r] = 0.f;
            if (ns <= ms) {
#pragma unroll
                for (int ks = 0; ks < 4; ++ks) sa = MFMA32(ldfrag32(QD, ms * 32, ks, lane), ldfrag32(KD, ns * 32, ks, lane), sa);
            }
#pragma unroll
            for (int r = 0; r < 16; ++r) { const int s = ms * 32 + crow(r, lane >> 5), s2 = ns * 32 + (lane & 31);
                const bool keep = dir ? (s2 < s) : (s2 <= s);
                *(LAS bf16*)(SS + s * G_ST + 2 * s2) = (bf16)f2bf(keep ? sa[r] : 0.f); }
        }
#pragma unroll
        for (int r = 0; r < 16; ++r) st[r] *= dec;
        dtot *= dec;
#pragma unroll
        for (int ks = 0; ks < 4; ++ks) st = MFMA32(ldfrag32(VT, me * 32, ks, lane), ldfrag32(KCT, nd * 32, ks, lane), st);
        if (PASS == 2 && n + 1 < GSC) {
#pragma unroll
            for (int r = 0; r < 16; ++r) *(LAS bf16*)(STn + (me * 32 + crow(r, lane >> 5)) * G_ST + (nd * 32 + (lane & 31)) * 2) = (bf16)f2bf(st[r]);
        }
        LDS_BARRIER();
        if (PASS == 2) {
            const int ms = wave >> 2, ne = wave & 3;
            f32x16 oa;
#pragma unroll
            for (int r = 0; r < 16; ++r) oa[r] = 0.f;
#pragma unroll
            for (int ks = 0; ks < 4; ++ks) oa = MFMA32(ldfrag32(SS, ms * 32, ks, lane), ldfrag32(VT, ne * 32, ks, lane), oa);
#pragma unroll
            for (int ks = 0; ks < 4; ++ks) oa = MFMA32(ldfrag32(QD, ms * 32, ks, lane), ldfrag32(STc, ne * 32, ks, lane), oa);
            bf16* op = (bf16*)(ws + (dir ? WS_OB : WS_OF)) + h * 128 + ne * 32 + (lane & 31);
#pragma unroll
            for (int r = 0; r < 16; ++r) op[gla_tok(b, dir, sc * GSC + n, ms * 32 + crow(r, lane >> 5)) * 512] = (bf16)f2bf(oa[r]);
            LDS_BARRIER();
        }
    }
    if (PASS == 1) {
        float* gs = GS + (size_t)item * 8192 + nd * 32 + (lane & 31);
#pragma unroll
        for (int r = 0; r < 16; ++r) gs[(size_t)(me * 32 + crow(r, lane >> 5)) * 64] = st[r];
        if (me == 0 && lane < 32) GD[(size_t)item * 64 + nd * 32 + lane] = dtot;
    }
    __syncthreads();
#undef GLA_LOAD
}
constexpr int AT_KST = 144, AT_VST = 664, AT_K = 0, AT_V = 320 * AT_KST, AT_BT = AT_V + 64 * AT_VST, AT_END = AT_BT + 4 * 260 * 4;
static_assert(AT_END <= RING_BYTES && AT_V % 16 == 0 && AT_BT % 16 == 0, "attention LDS");
__device__ __forceinline__ void attn_phase(unsigned char* ws, const float* sink, LAS unsigned char* lds, int bid, int G, int tid, int wave, int lane) {
    const bf16* qkv = (const bf16*)(ws + WS_QKV); bf16* ao = (bf16*)(ws + WS_AO); const float* btab = (const float*)(ws + WS_BTAB);
    LAS unsigned char* KS = lds + AT_K; LAS unsigned char* VT = lds + AT_V; LAS float* BT = (LAS float*)(lds + AT_BT);
    const float sc2 = 0.125f * LOG2E;
    u32x4 kreg[5], vreg[5];
#define AT_LOAD(u_) do { const int qb_ = (u_) % (SEQ / 64), kvh_ = ((u_) / (SEQ / 64)) & 3, b_ = (u_) / (4 * (SEQ / 64)), kb_ = qb_ * 64 - 128; \
        _Pragma("unroll") for (int it = 0; it < 5; ++it) { const int p = it * NTHR + tid; int key = kb_ + (p >> 3); key = key < 0 ? 0 : (key > SEQ - 1 ? SEQ - 1 : key); \
            const bf16* rp = qkv + ((size_t)b_ * SEQ + key) * CN + kvh_ * 64 + 8 * (p & 7); kreg[it] = *(const u32x4*)(rp + 1024); vreg[it] = *(const u32x4*)(rp + 1280); } } while (0)
    if (bid < NB * 4 * (SEQ / 64)) AT_LOAD(bid);
    for (int u = bid; u < NB * 4 * (SEQ / 64); u += G) {
        const int qb = u % (SEQ / 64), kvh = (u / (SEQ / 64)) & 3, b = u / (4 * (SEQ / 64)), q0 = qb * 64;
#pragma unroll
        for (int it = 0; it < 5; ++it) { const int p = it * NTHR + tid, i = p >> 3, ch = p & 7;
            *(LAS u32x4*)(KS + i * AT_KST + 16 * ch) = kreg[it];
            const unsigned vv[4] = {vreg[it].x, vreg[it].y, vreg[it].z, vreg[it].w};
#pragma unroll
            for (int j = 0; j < 4; ++j) { *(LAS bf16*)(VT + (8 * ch + 2 * j) * AT_VST + 2 * i) = (bf16)(vv[j] & 0xffffu); *(LAS bf16*)(VT + (8 * ch + 2 * j + 1) * AT_VST + 2 * i) = (bf16)(vv[j] >> 16); } }
        for (int p = tid; p < 4 * 260; p += NTHR) BT[p] = btab[(kvh * 4) * 260 + p];
        if (u + G < NB * 4 * (SEQ / 64)) AT_LOAD(u + G);
        LDS_BARRIER();
        const int hl = wave >> 1, hq = kvh * 4 + hl, qw = q0 + 32 * (wave & 1), qi = qw + (lane & 31), hh = lane >> 5;
        bf16x8 qf[4];
        { const bf16* qp = qkv + ((size_t)b * SEQ + qi) * CN + hq * 64 + 8 * hh;
#pragma unroll
          for (int ks = 0; ks < 4; ++ks) qf[ks] = *(const bf16x8*)(qp + 16 * ks); }
        float m = sink[hq] * LOG2E, l = hh == 0 ? 1.f : 0.f;
        f32x16 o0, o1;
#pragma unroll
        for (int r = 0; r < 16; ++r) { o0[r] = 0.f; o1[r] = 0.f; }
        const LAS float* btr = BT + hl * 260 + 128 - (lane & 31);
#pragma unroll 1
        for (int j = 0; j < 9; ++j) {
            const int i0 = 32 * (wave & 1) + 32 * j;
            f32x16 sa;
#pragma unroll
            for (int r = 0; r < 16; ++r) sa[r] = 0.f;
#pragma unroll
            for (int ks = 0; ks < 4; ++ks) { const bf16x8 kf = *(const LAS bf16x8*)(KS + (i0 + (lane & 31)) * AT_KST + 32 * ks + 16 * hh); sa = MFMA32(kf, qf[ks], sa); }
            float mx = -3.0e38f;
#pragma unroll
            for (int r = 0; r < 16; ++r) {
                const int kk = 32 * j - 128 + crow(r, hh);
                const int rel = kk - (lane & 31), key = qw + kk;
                const bool ok = ((unsigned)(rel + 128) <= 256u) && ((unsigned)key < (unsigned)SEQ);
                const float s = ok ? (sa[r] * sc2 + btr[kk]) : -3.0e38f;
                sa[r] = s; mx = fmaxf(mx, s);
            }
            mx = fmaxf(mx, __shfl_xor(mx, 32));
            if (!__all(mx <= m)) {
                const float mn = fmaxf(m, mx), alpha = __builtin_amdgcn_exp2f(m - mn); m = mn; l *= alpha;
#pragma unroll
                for (int r = 0; r < 16; ++r) { o0[r] *= alpha; o1[r] *= alpha; }
            }
            float ps = 0.f;
#pragma unroll
            for (int r = 0; r < 16; ++r) { const float p = __builtin_amdgcn_exp2f(sa[r] - m); sa[r] = p; ps += p; }
            l += ps;
#pragma unroll
            for (int s = 0; s < 2; ++s) {
                u32x4 pw; pw.x = pk2(sa[8 * s], sa[8 * s + 1]); pw.y = pk2(sa[8 * s + 2], sa[8 * s + 3]); pw.z = pk2(sa[8 * s + 4], sa[8 * s + 5]); pw.w = pk2(sa[8 * s + 6], sa[8 * s + 7]);
                const bf16x8 pf = __builtin_bit_cast(bf16x8, pw);
#pragma unroll
                for (int dt = 0; dt < 2; ++dt) {
                    const LAS unsigned char* vp = VT + (dt * 32 + (lane & 31)) * AT_VST + 2 * (i0 + 16 * s + 4 * hh);
                    const bf16x4 va = *(const LAS bf16x4*)vp, vb = *(const LAS bf16x4*)(vp + 16);
                    const bf16x8 vf = __builtin_shufflevector(va, vb, 0, 1, 2, 3, 4, 5, 6, 7);
                    if (dt == 0) o0 = MFMA32(vf, pf, o0); else o1 = MFMA32(vf, pf, o1);
                }
            }
        }
        l += __shfl_xor(l, 32);
        const float inv = 1.f / l;
        bf16* op = ao + ((size_t)b * SEQ + qi) * D + hq * 64 + 4 * hh;
#pragma unroll
        for (int g = 0; g < 4; ++g) {
            u32x2 w0, w1; w0.x = pk2(o0[4 * g] * inv, o0[4 * g + 1] * inv); w0.y = pk2(o0[4 * g + 2] * inv, o0[4 * g + 3] * inv);
            w1.x = pk2(o1[4 * g] * inv, o1[4 * g + 1] * inv); w1.y = pk2(o1[4 * g + 2] * inv, o1[4 * g + 3] * inv);
            *(u32x2*)(op + 8 * g) = w0; *(u32x2*)(op + 32 + 8 * g) = w1;
        }
        LDS_BARRIER();
    }
#undef AT_LOAD
}
#ifndef MK_N_LAUNCHES
#define MK_N_LAUNCHES 1
#endif
constexpr int N_PHASES = 19;
#ifndef PH_MASK
#define PH_MASK 0xFFFFFFFFu
#endif
#define ON(k) (((PH_MASK) >> (k)) & 1u)
#ifndef REP_MASK
#define REP_MASK 0u
#endif
#define NREP(k) ((((REP_MASK) >> (k)) & 1u) ? 2 : 1)

template <int LAYER>
__device__ __forceinline__ void common_phases(unsigned char* ws, LAS unsigned char* lds, float* dout, const XcdBarrier& bar, int lo, int hi, int bid, int G, int tid, int wave, int lane) {
    constexpr int pb = LAYER == 0 ? 5 : 13;
    const int gw = bid * NWAVES + wave, NGW = G * NWAVES;
#define IN(k) (lo <= (k) && (k) < hi)
#define SEAM(k) do { if (IN(k) && IN((k) + 1)) xcd_barrier(bar); } while (0)
    if (ON(5) && IN(pb)) {
        pg8::Gemm g{(const bf16*)(ws + (LAYER == 0 ? WS_X64 : WS_AO)), (const bf16*)(ws + (LAYER == 0 ? WS_WOUT : WS_COUT)), T, D, D, 0, nullptr}; pg8::StaticOrder S; S.init(T, D, G, bid);
        pg8::EpiBf16 E{(bf16*)(ws + WS_Z), D};
        pg8::gemm_phase<pg8::EpiBf16, pg8::StaticOrder, false>(lds, g, S, E);
    }
    SEAM(pb);
    if (ON(6) && IN(pb + 1)) { ln_router(ws, LAYER == 0 ? inp(lds, I_X) : (const float*)(ws + WS_H1), inp(lds, I_LNMG) + LAYER * D, inp(lds, I_LNMB) + LAYER * D, inp(lds, I_BGRP) + LAYER * 4, inp(lds, I_BRT) + LAYER * 32, LAYER, lds, bid, G, tid, wave, lane); __syncthreads(); }
    SEAM(pb + 1);
    if (ON(7) && IN(pb + 2)) { moe_sort(ws, lds, bid, G, tid); __syncthreads(); }
    SEAM(pb + 2);
    if (ON(8) && IN(pb + 3)) {
        const int* tile = (const int*)(ws + WS_TILE); const int ntiles = __builtin_amdgcn_readfirstlane(tile[511]);
        pg8::Gemm g{(const bf16*)(ws + WS_X64), (const bf16*)(ws + WS_W13), 0, D, D, (size_t)D * D * 2, (const int*)(ws + WS_SLOTT)};
        pg8::GroupOrder S{tile, ntiles, D / 256, G, bid};
        pg8::EpiSwiglu E{(bf16*)(ws + WS_HID), DEXP};
        pg8::gemm_phase<pg8::EpiSwiglu, pg8::GroupOrder, true>(lds, g, S, E);
    }
    SEAM(pb + 3);
    if (ON(9) && IN(pb + 4)) {
        const int* tile = (const int*)(ws + WS_TILE); const int ntiles = __builtin_amdgcn_readfirstlane(tile[511]);
        pg8::Gemm g{(const bf16*)(ws + WS_HID), (const bf16*)(ws + WS_W2), 0, D, DEXP, (size_t)D * DEXP * 2, nullptr};
        pg8::GroupOrder S{tile, ntiles, D / 256, G, bid};
        pg8::EpiScale E{(bf16*)(ws + WS_Y2), D, (const float*)(ws + WS_SLOTW)};
        pg8::gemm_phase<pg8::EpiScale, pg8::GroupOrder, false>(lds, g, S, E);
    }
    SEAM(pb + 4);
    if (ON(10) && IN(pb + 5)) {
        if (LAYER == 0) {
            combine_ln<false>(ws, inp(lds, I_LNFG), inp(lds, I_LNFB), nullptr, gw, NGW, lane);
            moe_convert(inp(lds, I_W1) + (size_t)NEXP * D * DEXP, inp(lds, I_W3) + (size_t)NEXP * D * DEXP, inp(lds, I_W2) + (size_t)NEXP * DEXP * D, (bf16*)(ws + WS_W13), (bf16*)(ws + WS_W2), (LAS float*)(lds + wave * 16384), gw, NGW, lane);
            __syncthreads();
        } else combine_ln<true>(ws, inp(lds, I_LNFG) + D, inp(lds, I_LNFB) + D, dout, gw, NGW, lane);
    }
    if (LAYER == 0) SEAM(10);
#undef IN
#undef SEAM
}

struct Args { const float* in[N_IN]; float* out; unsigned char* ws; int ph_lo, ph_hi; };
static_assert(sizeof(Args) == N_IN * 8 + 8 + 8 + 8, "no padding holes in Args");

__global__ void __launch_bounds__(NTHR, 2) fwd_kernel(Args args) {
    extern __shared__ __attribute__((aligned(16))) unsigned char lds_raw[];
    LAS unsigned char* lds = (LAS unsigned char*)lds_raw;
    volatile LAS unsigned* MISC = (volatile LAS unsigned*)(lds + MISC_OFF);
    const int tid = threadIdx.x, lane = tid & 63, wave = __builtin_amdgcn_readfirstlane(tid >> 6), G = gridDim.x, bid = blockIdx.x;
    unsigned char* ws = args.ws;
    for (int u = tid; u < 64; u += NTHR) MISC[u] = 0u;
    if (tid < N_IN) *(LAS unsigned long long*)(lds + PTR_OFF + 8 * tid) = (unsigned long long)args.in[tid];
    __syncthreads();
    const int lo = args.ph_lo, hi = args.ph_hi;
    const bool use_bar = (hi - lo) > 1;
    XcdBarrier bar; bar.bar = (unsigned*)(ws + WS_CTL) + CW_BAR; bar.x = 0; bar.st = nullptr;
    if (use_bar) bar = xcd_barrier_post((unsigned*)(ws + WS_CTL) + CW_BAR, MISC + 8);
#define IN(k) (lo <= (k) && (k) < hi)
#define SEAM(k) do { if (IN(k) && IN((k) + 1)) xcd_barrier(bar); } while (0)
    const int gw = bid * NWAVES + wave, NGW = G * NWAVES;

    if (ON(0) && IN(0)) { p0_prologue(ws, lds, bid, G, tid, wave, lane); __syncthreads(); }
    SEAM(0);
    if (ON(1) && IN(1)) {
        pg8::Gemm g{(const bf16*)(ws + WS_X64), (const bf16*)(ws + WS_WIN), T, ABN, D, 0, nullptr}; pg8::SplitOrder S; S.init(T, ABN, 2, G, bid);
        pg8::EpiBf16 E{(bf16*)(ws + WS_H0), H0P};
        pg8::gemm_phase<pg8::EpiBf16, pg8::SplitOrder, false>(lds, g, S, E);
        lr_tail(ws, args.out, inp(lds, I_GATEW), inp(lds, I_GATEB), lds, bid, G, tid, wave, lane);
#ifdef TAIL_TWICE
        lr_tail(ws, args.out, inp(lds, I_GATEW), inp(lds, I_GATEB), lds, bid, G, tid, wave, lane);
#endif
    }
    SEAM(1);
    if (ON(2) && IN(2)) {
        s5_phase<1>(ws, inp(lds, I_S5D), lds, bid, G, tid, wave, lane);
#ifdef S5_TWICE
        __syncthreads(); s5_phase<1>(ws, inp(lds, I_S5D), lds, bid, G, tid, wave, lane);
#endif
        __syncthreads();
        for (int it = bid; it < 256; it += G) gla_item<1>(ws, args.out, it, lds, tid, wave, lane);
#ifdef GLA_TWICE
        for (int it = bid; it < 256; it += G) gla_item<1>(ws, args.out, it, lds, tid, wave, lane);
#endif
    }
    SEAM(2);
    if (ON(3) && IN(3)) {
        s5_phase<2>(ws, inp(lds, I_S5D), lds, bid, G, tid, wave, lane);
#ifdef S5_TWICE
        __syncthreads(); s5_phase<2>(ws, inp(lds, I_S5D), lds, bid, G, tid, wave, lane);
#endif
        __syncthreads();
        for (int it = bid; it < 256; it += G) gla_item<2>(ws, args.out, it, lds, tid, wave, lane);
#ifdef GLA_TWICE
        for (int it = bid; it < 256; it += G) gla_item<2>(ws, args.out, it, lds, tid, wave, lane);
#endif
    }
    SEAM(3);
    if (ON(4) && IN(4)) {
        gla_finalize(ws, inp(lds, I_NORMG), gw, NGW, lane);
        pg8::Gemm g{(const bf16*)(ws + WS_YG), (const bf16*)(ws + WS_WGLU), T, 512, 512, 0, nullptr}; pg8::StaticOrder S; S.init(T, 512, G, bid);
        pg8::EpiGlu E{(const bf16*)(ws + WS_YG), 512, (bf16*)(ws + WS_X64), D, inp(lds, I_GLUB)};
        pg8::gemm_phase<pg8::EpiGlu, pg8::StaticOrder, false>(lds, g, S, E);
    }
    SEAM(4);
    common_phases<0>(ws, lds, args.out, bar, lo, hi, bid, G, tid, wave, lane);
    if (ON(11) && IN(11)) {
        pg8::Gemm g{(const bf16*)(ws + WS_H2B), (const bf16*)(ws + WS_CIN), T, CN, D, 0, nullptr}; pg8::StaticOrder S; S.init(T, CN, G, bid);
        pg8::EpiBf16 E{(bf16*)(ws + WS_QKV), CN};
        pg8::gemm_phase<pg8::EpiBf16, pg8::StaticOrder, false>(lds, g, S, E);
    }
    SEAM(11);
    if (ON(12) && IN(12)) attn_phase(ws, inp(lds, I_SINK), lds, bid, G, tid, wave, lane);
    SEAM(12);
    common_phases<1>(ws, lds, args.out, bar, lo, hi, bid, G, tid, wave, lane);
#undef IN
#undef SEAM
}

extern "C" void kernel_launch(void* const* d_in, const int* in_sizes, int n_in, void* d_out, int out_size, void* d_ws, size_t ws_size, hipStream_t stream) {
    static int grid = 0;
    if (grid == 0) {
        if (n_in != N_IN || in_sizes[0] != T * D || out_size != T * D || ws_size < WS_END) { fprintf(stderr, "kernel_launch: unexpected shapes (n_in %d, in0 %d, out %d, ws %zu < %zu)\n", n_in, n_in > 0 ? in_sizes[0] : -1, out_size, ws_size, (size_t)WS_END); grid = -1; return; }
        int dev = 0, cus = 0, per_cu = 0;
        if (hipGetDevice(&dev) != hipSuccess || hipDeviceGetAttribute(&cus, hipDeviceAttributeMultiprocessorCount, dev) != hipSuccess) { grid = -1; return; }
        if (hipFuncSetAttribute((const void*)fwd_kernel, hipFuncAttributeMaxDynamicSharedMemorySize, LDS_BYTES) != hipSuccess) { fprintf(stderr, "kernel_launch: hipFuncSetAttribute failed\n"); grid = -1; return; }
        if (hipOccupancyMaxActiveBlocksPerMultiprocessor(&per_cu, (const void*)fwd_kernel, NTHR, LDS_BYTES) != hipSuccess || per_cu < 1) fprintf(stderr, "kernel_launch: occupancy query reports %d\n", per_cu);
        (void)hipGetLastError();
        grid = cus;
    }
    if (grid < 0) return;
    if (hipMemsetAsync((char*)d_ws + WS_CTL, 0, CTL_ZERO_BYTES, stream) != hipSuccess) return;
    Args a{};
    for (int i = 0; i < N_IN; ++i) a.in[i] = (const float*)d_in[i];
    a.out = (float*)d_out; a.ws = (unsigned char*)d_ws;
    for (int li = 0; li < MK_N_LAUNCHES; ++li) {
        a.ph_lo = (MK_N_LAUNCHES == 1) ? 0 : li; a.ph_hi = (MK_N_LAUNCHES == 1) ? N_PHASES : li + 1;
        for (int rep = 0; rep < ((MK_N_LAUNCHES > 1 && ((REP_MASK >> li) & 1u)) ? 2 : 1); ++rep)
            hipLaunchKernelGGL(fwd_kernel, dim3(grid), dim3(NTHR), LDS_BYTES, stream, a);
    }
}
```

```cpp
#include <hip/hip_runtime.h>
#include <cstdio>
#include <cstdint>
#include <cmath>
namespace pg8 {
#define PG8_LAS __attribute__((address_space(3)))
typedef unsigned short bf16_t;
typedef short bf16x8 __attribute__((ext_vector_type(8)));
typedef float f32x4 __attribute__((ext_vector_type(4)));
typedef float f32x2 __attribute__((ext_vector_type(2)));
typedef unsigned u32x4 __attribute__((ext_vector_type(4)));
typedef unsigned u32x2 __attribute__((ext_vector_type(2)));
constexpr int BM = 256, BK = 64, HALF = 128, HTB = HALF * BK * 2  , STAGE_BYTES = 8 * HTB, NXCD = 8, WGM = 8;

__host__ __device__ __forceinline__ int lds_byte(int r, int c) { const int st = (r >> 4) * 2 + (c >> 5), rr = r & 15, cc = c & 31, ob = rr * 64 + cc * 2; return st * 1024 + (ob ^ (((ob >> 9) & 1) << 5)); }
__host__ __device__ __forceinline__ void stage_rc(int b, int& R, int& C) { const int st = b / 1024, sb = b % 1024, swz = sb ^ (((sb >> 9) & 1) << 5); R = (st >> 1) * 16 + swz / 64; C = (st & 1) * 32 + (swz % 64) / 2; }
__host__ __device__ __forceinline__ int perm32(int rho) { const int n = rho >> 4, i = rho & 15; return 8 * (i >> 2) + 4 * n + (i & 3); }

struct Unit { int pm, pn, e; };
struct Gemm { const bf16_t* A; const bf16_t* Bt; int M, N, K; size_t bstride; const int* rowmap; };

struct StaticOrder {
    int nM, nN, nwg, G, c;
    __host__ __device__ void init(int M, int N, int G_, int c_) { nM = M / BM; nN = N / BM; nwg = nM * nN; G = G_; c = c_; }
    __host__ __device__ bool next(int i, Unit& u) const {
        const long L = (long)i * G + c; if (L >= nwg) return false;
        int wgid = (int)L; { const int q = nwg / NXCD, r = nwg % NXCD, xcd = wgid % NXCD, off = wgid / NXCD; wgid = (xcd < r ? xcd * (q + 1) : r * (q + 1) + (xcd - r) * q) + off; }
        const int nig = WGM * nN, gid = wgid / nig, fm = gid * WGM, gsz = (nM - fm) < WGM ? (nM - fm) : WGM;
        u.pm = fm + ((wgid % nig) % gsz); u.pn = (wgid % nig) / gsz; u.e = 0; return true;
    }
};
struct SplitOrder {
    int nM, nNs, nwgs, nsp, G, c;
    __host__ __device__ void init(int M, int N, int nsp_, int G_, int c_) { nM = M / BM; nNs = N / BM / nsp_; nwgs = nM * nNs; nsp = nsp_; G = G_; c = c_; }
    __host__ __device__ bool next(int i, Unit& u) const {
        const long L = (long)i * G + c; if (L >= (long)nwgs * nsp) return false;
        const int slab = (int)(L / nwgs); int wgid = (int)(L % nwgs);
        { const int q = nwgs / NXCD, r = nwgs % NXCD, xcd = wgid % NXCD, off = wgid / NXCD; wgid = (xcd < r ? xcd * (q + 1) : r * (q + 1) + (xcd - r) * q) + off; }
        const int nig = WGM * nNs, gid = wgid / nig, fm = gid * WGM, gsz = (nM - fm) < WGM ? (nM - fm) : WGM;
        u.pm = fm + ((wgid % nig) % gsz); u.pn = slab * nNs + (wgid % nig) / gsz; u.e = 0; return true;
    }
};
struct GroupOrder {
    const int* tile_e; int ntiles, nN, G, c;
    __device__ bool next(int i, Unit& u) const {
        const int L = i * G + c; if (L >= ntiles * nN) return false;
        u.pm = L / nN; u.pn = L % nN; u.e = __builtin_amdgcn_readfirstlane(tile_e[u.pm]); return true;
    }
};

typedef __bf16 bf16x2_t __attribute__((ext_vector_type(2)));
__device__ __forceinline__ unsigned cvt_pk_bf16(float lo, float hi) { f32x2 v = {lo, hi}; return __builtin_bit_cast(unsigned, __builtin_convertvector(v, bf16x2_t)); }
__device__ __forceinline__ float bf_lo(unsigned w) { return __uint_as_float(w << 16); }
__device__ __forceinline__ float bf_hi(unsigned w) { return __uint_as_float(w & 0xffff0000u); }

struct EpiBf16 {
    static constexpr bool PERM = true;
    bf16_t* O; int ldc;
    __device__ __forceinline__ void operator()(const f32x4 (&acc)[2][2][4][2], const Unit& u, int wr, int wc, int fr, int fq) const {
        const int row0 = u.pm * BM + wr * 64 + fr; const int col0 = u.pn * BM + wc * 32 + 8 * fq;
#pragma unroll
        for (int ai = 0; ai < 2; ++ai)
#pragma unroll
            for (int m = 0; m < 4; ++m) { bf16_t* rowp = O + (size_t)(row0 + ai * HALF + m * 16) * ldc + col0;
#pragma unroll
                for (int bj = 0; bj < 2; ++bj) { const f32x4 v0 = acc[ai][bj][m][0], v1 = acc[ai][bj][m][1];
                    u32x4 w; w.x = cvt_pk_bf16(v0[0], v0[1]); w.y = cvt_pk_bf16(v0[2], v0[3]); w.z = cvt_pk_bf16(v1[0], v1[1]); w.w = cvt_pk_bf16(v1[2], v1[3]);
                    *(u32x4*)(rowp + bj * HALF) = w; } }
    }
};
struct EpiGlu {
    static constexpr bool PERM = true;
    const bf16_t* Y; int ldy; bf16_t* O; int ldc; const float* bias;
    __device__ __forceinline__ void operator()(const f32x4 (&acc)[2][2][4][2], const Unit& u, int wr, int wc, int fr, int fq) const {
        const int row0 = u.pm * BM + wr * 64 + fr; const int col0 = u.pn * BM + wc * 32 + 8 * fq;
        f32x4 bv[2][2];
#pragma unroll
        for (int bj = 0; bj < 2; ++bj)
#pragma unroll
            for (int n = 0; n < 2; ++n) bv[bj][n] = *(const f32x4*)(bias + col0 + bj * HALF + 4 * n);
#pragma unroll
        for (int ai = 0; ai < 2; ++ai) {
            u32x4 yq[4][2];
#pragma unroll
            for (int m = 0; m < 4; ++m)
#pragma unroll
                for (int bj = 0; bj < 2; ++bj) yq[m][bj] = *(const u32x4*)(Y + (size_t)(row0 + ai * HALF + m * 16) * ldy + col0 + bj * HALF);
            asm volatile("" ::: "memory");
#pragma unroll
            for (int m = 0; m < 4; ++m) { const size_t r = (size_t)(row0 + ai * HALF + m * 16);
#pragma unroll
                for (int bj = 0; bj < 2; ++bj) { const f32x4 v0 = acc[ai][bj][m][0] + bv[bj][0], v1 = acc[ai][bj][m][1] + bv[bj][1];
                    const u32x4 y = yq[m][bj];
                    float o[8]; const float yv[8] = {bf_lo(y.x), bf_hi(y.x), bf_lo(y.y), bf_hi(y.y), bf_lo(y.z), bf_hi(y.z), bf_lo(y.w), bf_hi(y.w)};
#pragma unroll
                    for (int i = 0; i < 4; ++i) { o[i] = yv[i] / (1.f + __expf(-v0[i])); o[4 + i] = yv[4 + i] / (1.f + __expf(-v1[i])); }
                    u32x4 w; w.x = cvt_pk_bf16(o[0], o[1]); w.y = cvt_pk_bf16(o[2], o[3]); w.z = cvt_pk_bf16(o[4], o[5]); w.w = cvt_pk_bf16(o[6], o[7]);
                    *(u32x4*)(O + r * ldc + col0 + bj * HALF) = w; } }
            asm volatile("" ::: "memory");
        }
    }
};
struct EpiResid {
    static constexpr bool PERM = false;
    const float* resid; float* out; int ldc; float alpha;
    __device__ __forceinline__ void operator()(const f32x4 (&acc)[2][2][4][2], const Unit& u, int wr, int wc, int fr, int fq) const {
        const int col0 = u.pn * BM + wc * 32 + 4 * fq;
#pragma unroll
        for (int ai = 0; ai < 2; ++ai) {
            f32x4 bs[4][2][2];
#pragma unroll
            for (int m = 0; m < 4; ++m) { const size_t off = (size_t)(u.pm * BM + ai * HALF + wr * 64 + m * 16 + fr) * ldc + col0;
#pragma unroll
                for (int bj = 0; bj < 2; ++bj)
#pragma unroll
                    for (int n = 0; n < 2; ++n) bs[m][bj][n] = *(const f32x4*)(resid + off + bj * HALF + n * 16); }
            asm volatile("" ::: "memory");
#pragma unroll
            for (int m = 0; m < 4; ++m) { const size_t off = (size_t)(u.pm * BM + ai * HALF + wr * 64 + m * 16 + fr) * ldc + col0;
#pragma unroll
                for (int bj = 0; bj < 2; ++bj)
#pragma unroll
                    for (int n = 0; n < 2; ++n) *(f32x4*)(out + off + bj * HALF + n * 16) = bs[m][bj][n] * alpha + acc[ai][bj][m][n]; }
            asm volatile("" ::: "memory");
        }
    }
};
struct EpiSwiglu {
    static constexpr bool PERM = true;
    bf16_t* O; int ldc;
    __device__ __forceinline__ void operator()(const f32x4 (&acc)[2][2][4][2], const Unit& u, int wr, int wc, int fr, int fq) const {
        const int row0 = u.pm * BM + wr * 64 + fr; const int col0 = (u.pn * BM + wc * 32 + 8 * fq) >> 1;
#pragma unroll
        for (int ai = 0; ai < 2; ++ai)
#pragma unroll
            for (int m = 0; m < 4; ++m) { bf16_t* rowp = O + (size_t)(row0 + ai * HALF + m * 16) * ldc + col0;
#pragma unroll
                for (int bj = 0; bj < 2; ++bj) { const f32x4 g = acc[ai][bj][m][0], up = acc[ai][bj][m][1]; float o[4];
#pragma unroll
                    for (int i = 0; i < 4; ++i) o[i] = g[i] / (1.f + __expf(-g[i])) * up[i];
                    u32x2 w; w.x = cvt_pk_bf16(o[0], o[1]); w.y = cvt_pk_bf16(o[2], o[3]);
                    *(u32x2*)(rowp + bj * (HALF / 2)) = w; } }
    }
};
struct EpiScale {
    static constexpr bool PERM = true;
    bf16_t* O; int ldc; const float* rw;
    __device__ __forceinline__ void operator()(const f32x4 (&acc)[2][2][4][2], const Unit& u, int wr, int wc, int fr, int fq) const {
        const int row0 = u.pm * BM + wr * 64 + fr; const int col0 = u.pn * BM + wc * 32 + 8 * fq;
        float sw[2][4];
#pragma unroll
        for (int ai = 0; ai < 2; ++ai)
#pragma unroll
            for (int m = 0; m < 4; ++m) sw[ai][m] = rw[row0 + ai * HALF + m * 16];
        asm volatile("" ::: "memory");
#pragma unroll
        for (int ai = 0; ai < 2; ++ai)
#pragma unroll
            for (int m = 0; m < 4; ++m) { const int r = row0 + ai * HALF + m * 16; const float s = sw[ai][m]; bf16_t* rowp = O + (size_t)r * ldc + col0;
#pragma unroll
                for (int bj = 0; bj < 2; ++bj) { const f32x4 v0 = acc[ai][bj][m][0] * s, v1 = acc[ai][bj][m][1] * s;
                    u32x4 w; w.x = cvt_pk_bf16(v0[0], v0[1]); w.y = cvt_pk_bf16(v0[2], v0[3]); w.z = cvt_pk_bf16(v1[0], v1[1]); w.w = cvt_pk_bf16(v1[2], v1[3]);
                    *(u32x4*)(rowp + bj * HALF) = w; } }
    }
};

template <class Epi, class Sched, bool GATHER>
__device__ __forceinline__ void gemm_phase(PG8_LAS unsigned char* lds, const Gemm g, const Sched& S, const Epi& E) {
    const int tid = threadIdx.x, wid = __builtin_amdgcn_readfirstlane(tid >> 6), lane = tid & 63, wr = wid >> 2, wc = wid & 3, fr = lane & 15, fq = lane >> 4;
    const int K = g.K, nt = K / BK;
    unsigned voffA[2], voffB[2]; int RA[2], CA[2];
#pragma unroll
    for (int i = 0; i < 2; ++i) { int R, C; stage_rc(tid * 16 + i * 8192, R, C); const int Rb = Epi::PERM ? ((R & ~31) + perm32(R & 31)) : R;
        voffA[i] = (unsigned)(R * K + C) * 2u; voffB[i] = (unsigned)(Rb * K + C) * 2u; RA[i] = R; CA[i] = C; }
    const size_t kstep = (size_t)(BK * 2);
    const size_t hstep = (size_t)HALF * K * 2;
    const size_t tstep = 2 * hstep;
    const unsigned ldsw = (unsigned)wid * 1024u;
    const int aoff = lds_byte(wr * 64 + fr, fq * 8), boff = lds_byte(wc * 32 + fr, fq * 8);
#define PG8_SA(b, h) (((b) * 2 + (h)) * HTB)
#define PG8_SB(b, h) ((4 + (b) * 2 + (h)) * HTB)
#define PG8_STAGE(bufoff, gbase, voff) do { _Pragma("unroll") for (int _i = 0; _i < 2; ++_i) \
        __builtin_amdgcn_global_load_lds((const unsigned*)((const char*)(gbase) + (voff)[_i]), (PG8_LAS unsigned*)(lds + (bufoff) + ldsw + _i * 8192), 16, 0, 0); } while (0)
#define PG8_LDA(dst, b, h) do { _Pragma("unroll") for (int m = 0; m < 4; ++m) _Pragma("unroll") for (int k = 0; k < 2; ++k) dst[m][k] = *(const PG8_LAS bf16x8*)(lds + PG8_SA(b, h) + aoff + m * 2048 + k * 1024); } while (0)
#define PG8_LDB(dst, b, h) do { _Pragma("unroll") for (int n = 0; n < 2; ++n) _Pragma("unroll") for (int k = 0; k < 2; ++k) dst[n][k] = *(const PG8_LAS bf16x8*)(lds + PG8_SB(b, h) + boff + n * 2048 + k * 1024); } while (0)
#define PG8_MMA(ai, bj, At, Bt) do { __builtin_amdgcn_s_setprio(1); _Pragma("unroll") for (int m = 0; m < 4; ++m) _Pragma("unroll") for (int n = 0; n < 2; ++n) _Pragma("unroll") for (int k = 0; k < 2; ++k) \
        acc[ai][bj][m][n] = __builtin_amdgcn_mfma_f32_16x16x32_bf16(Bt[n][k], At[m][k], acc[ai][bj][m][n], 0, 0, 0); __builtin_amdgcn_s_setprio(0); } while (0)
#define PG8_WAIT_V(n) asm volatile("s_waitcnt vmcnt(" #n ")" ::: "memory")
#define PG8_WAIT_L(n) asm volatile("s_waitcnt lgkmcnt(" #n ")" ::: "memory")
#define PG8_BAR __builtin_amdgcn_s_barrier()
#define PG8_SCHED __builtin_amdgcn_sched_barrier(0)
    Unit cur, nxt; int ui = 0;
    if (!S.next(0, cur)) return;
    f32x4 acc[2][2][4][2];
#pragma unroll
    for (int a = 0; a < 2; ++a)
#pragma unroll
        for (int b = 0; b < 2; ++b)
#pragma unroll
            for (int m = 0; m < 4; ++m)
#pragma unroll
                for (int n = 0; n < 2; ++n) acc[a][b][m][n] = (f32x4){0.f, 0.f, 0.f, 0.f};
    bf16x8 At[4][2], B0[2][2], B1[2][2];
    unsigned cG[2][2], nG[2][2];
#define PG8_LOAD_ROWS(u_, G2_) do { _Pragma("unroll") for (int h_ = 0; h_ < 2; ++h_) _Pragma("unroll") for (int i_ = 0; i_ < 2; ++i_) \
        G2_[h_][i_] = GATHER ? ((unsigned)g.rowmap[(u_).pm * BM + h_ * HALF + RA[i_]] * (unsigned)K + (unsigned)CA[i_]) * 2u : voffA[i_]; } while (0)
    const char* cA = GATHER ? (const char*)g.A : (const char*)g.A + (size_t)cur.pm * tstep;
    const size_t hA = GATHER ? 0 : hstep;
    const char* cB = (const char*)g.Bt + (size_t)cur.e * g.bstride + (size_t)cur.pn * tstep;
    PG8_LOAD_ROWS(cur, cG);
    PG8_STAGE(PG8_SB(0, 0), cB, voffB); PG8_STAGE(PG8_SB(0, 1), cB + hstep, voffB); PG8_STAGE(PG8_SA(0, 0), cA, cG[0]); PG8_STAGE(PG8_SA(0, 1), cA + hA, cG[1]);
    if (wr == 1) PG8_BAR;
    PG8_WAIT_V(2); PG8_BAR;
    PG8_STAGE(PG8_SB(1, 0), cB + kstep, voffB); PG8_STAGE(PG8_SA(1, 0), cA + kstep, cG[0]); PG8_STAGE(PG8_SB(1, 1), cB + hstep + kstep, voffB);
    PG8_WAIT_V(6); PG8_BAR;
    for (;;) {
        const bool has_next = S.next(ui + 1, nxt);
        const char* nA = GATHER ? (const char*)g.A : (has_next ? (const char*)g.A + (size_t)nxt.pm * tstep : cA);
        const char* nB = has_next ? (const char*)g.Bt + (size_t)nxt.e * g.bstride + (size_t)nxt.pn * tstep : cB;
        if (has_next) PG8_LOAD_ROWS(nxt, nG); else {
#pragma unroll
            for (int h = 0; h < 2; ++h) { nG[h][0] = cG[h][0]; nG[h][1] = cG[h][1]; } }
        for (int t = 0; t < nt; t += 2) {
            const bool last = (t == nt - 2);
            const char* a1 = cA + (size_t)(t + 1) * kstep;
            const char* a2 = last ? nA : cA + (size_t)(t + 2) * kstep; const char* b2 = last ? nB : cB + (size_t)(t + 2) * kstep;
            const char* a3 = a2 + kstep; const char* b3 = b2 + kstep;
            unsigned sG[2][2];
#pragma unroll
            for (int h = 0; h < 2; ++h) { sG[h][0] = (GATHER && last) ? nG[h][0] : cG[h][0]; sG[h][1] = (GATHER && last) ? nG[h][1] : cG[h][1]; }
            PG8_LDB(B0, 0, 0); PG8_LDB(B1, 0, 1); PG8_SCHED; PG8_LDA(At, 0, 0); PG8_STAGE(PG8_SA(1, 1), a1 + hA, cG[1]);
            PG8_WAIT_V(8); PG8_WAIT_L(0); PG8_BAR; PG8_MMA(0, 0, At, B0); PG8_MMA(0, 1, At, B1); PG8_BAR; PG8_SCHED;
            PG8_LDA(At, 0, 1); PG8_STAGE(PG8_SB(0, 0), b2, voffB); PG8_STAGE(PG8_SB(0, 1), b2 + hstep, voffB); PG8_STAGE(PG8_SA(0, 0), a2, sG[0]);
            PG8_WAIT_V(8); PG8_WAIT_L(0); PG8_BAR; PG8_MMA(1, 0, At, B0); PG8_MMA(1, 1, At, B1); PG8_BAR; PG8_SCHED;
            PG8_LDB(B0, 1, 0); PG8_LDB(B1, 1, 1); PG8_SCHED; PG8_LDA(At, 1, 0); PG8_STAGE(PG8_SA(0, 1), a2 + hA, sG[1]);
            PG8_WAIT_V(8); PG8_WAIT_L(0); PG8_BAR; PG8_MMA(0, 0, At, B0); PG8_MMA(0, 1, At, B1); PG8_BAR; PG8_SCHED;
            PG8_LDA(At, 1, 1); PG8_STAGE(PG8_SB(1, 0), b3, voffB); PG8_STAGE(PG8_SB(1, 1), b3 + hstep, voffB); PG8_STAGE(PG8_SA(1, 0), a3, sG[0]);
            PG8_WAIT_V(8); PG8_WAIT_L(0); PG8_BAR; PG8_MMA(1, 0, At, B0); PG8_MMA(1, 1, At, B1); PG8_BAR; PG8_SCHED;
        }
        if (wr == 0) PG8_BAR;
        E(acc, cur, wr, wc, fr, fq);
        if (!has_next) break;
#pragma unroll
        for (int a = 0; a < 2; ++a)
#pragma unroll
            for (int b = 0; b < 2; ++b)
#pragma unroll
                for (int m = 0; m < 4; ++m)
#pragma unroll
                    for (int n = 0; n < 2; ++n) acc[a][b][m][n] = (f32x4){0.f, 0.f, 0.f, 0.f};
        cur = nxt; cA = nA; cB = nB; ++ui;
#pragma unroll
        for (int h = 0; h < 2; ++h) { cG[h][0] = nG[h][0]; cG[h][1] = nG[h][1]; }
        if (wr == 1) PG8_BAR;
    }
    PG8_WAIT_V(0);
    PG8_BAR;
#undef PG8_LOAD_ROWS
#undef PG8_SA
#undef PG8_SB
#undef PG8_STAGE
#undef PG8_LDA
#undef PG8_LDB
#undef PG8_MMA
#undef PG8_WAIT_V
#undef PG8_WAIT_L
#undef PG8_BAR
#undef PG8_SCHED
}
}
constexpr int NB = 2, SEQ = 16384, T = NB * SEQ, D = 1024;
constexpr int H0P = 2112;
constexpr int ABN = 2048, OFF_U = 0, OFF_Q = 512, OFF_K = 768, OFF_V = 1024, OFF_GO = 1536, AB_IN = 2080;
constexpr int CN = 1536;
constexpr int NEXP = 32, DEXP = 512, CAP = 2 * T + NEXP * 256, MAXTILES = CAP / 256;
constexpr int S5CH = 256, S5NCH = SEQ / S5CH;
constexpr int GSC = 16, GCH = 64, GNSC = SEQ / (GSC * GCH);
constexpr float ALPHA = 1.41421356237309515f;
constexpr float LN_EPS = 1e-5f, RMS_EPS = 1e-6f, LOG2E = 1.44269504088896341f;
constexpr int NWAVES = 8, NTHR = 512;

constexpr size_t MiB = 1u << 20, KiB = 1u << 10;
constexpr size_t WS_CTL = 0, CTL_ZERO_BYTES = 64 * KiB;
constexpr int CW_BAR = 4096;
constexpr size_t WS_LR = 1 * MiB;
constexpr size_t WS_S5E = 5 * MiB;
constexpr size_t WS_GS = 9 * MiB;
constexpr size_t WS_GD = 17 * MiB;
constexpr size_t WS_S5L = WS_GD + 64 * KiB;
constexpr size_t WS_S5B = WS_S5L + 64 * KiB;
constexpr size_t WS_S5C = WS_S5B + 256 * KiB;
constexpr size_t WS_BTAB = WS_S5C + 256 * KiB;
constexpr size_t WS_WR = WS_BTAB + 32 * KiB;
constexpr size_t WS_TOKE = WS_WR + 384 * KiB;
constexpr size_t WS_TOKW = WS_TOKE + 256 * KiB;
constexpr size_t WS_TOKS = WS_TOKW + 256 * KiB;
constexpr size_t WS_SLOTT = WS_TOKS + 256 * KiB;
constexpr size_t WS_SLOTW = WS_SLOTT + 288 * KiB;
constexpr size_t WS_BLKC = WS_SLOTW + 288 * KiB;
constexpr size_t WS_TILE = WS_BLKC + 32 * KiB;
static_assert(WS_TILE + 4 * KiB <= 32 * MiB, "param region");
constexpr size_t WS_WIN = 32 * MiB, WS_WLR = 36 * MiB, WS_WGLU = 37 * MiB, WS_WOUT = 38 * MiB, WS_CIN = 40 * MiB, WS_COUT = 43 * MiB;
constexpr size_t WS_W13 = 48 * MiB, WS_W2 = 112 * MiB;
constexpr size_t A0 = 144 * MiB;
constexpr size_t WS_H1 = A0, WS_H0 = A0;
constexpr size_t WS_Z = A0 + 128 * MiB;
constexpr size_t WS_YG = A0 + 136 * MiB, WS_OF = A0 + 168 * MiB, WS_OB = A0 + 320 * MiB;
constexpr size_t WS_YSCR = A0 + 232 * MiB;
constexpr size_t WS_X64 = A0 + 256 * MiB;
constexpr size_t WS_HID = A0 + 128 * MiB;
constexpr size_t WS_Y2 = A0 + 200 * MiB;
constexpr size_t WS_H2B = A0 + 128 * MiB;
constexpr size_t WS_QKV = A0 + 192 * MiB;
constexpr size_t WS_AO = A0 + 288 * MiB;
constexpr size_t WS_END = A0 + 384 * MiB;
static_assert((size_t)T * H0P * 2 <= 136 * MiB && WS_Y2 + (size_t)CAP * D * 2 <= WS_END && WS_OB + (size_t)T * 512 * 4 <= WS_END && WS_HID + (size_t)CAP * 512 * 2 <= WS_Y2, "act map");

constexpr int RING_BYTES = 131072;
constexpr int MISC_OFF = 163840 - 1024;
constexpr int PTR_OFF = MISC_OFF + 256;
constexpr int LDS_BYTES = 163840;

#define GAS __attribute__((address_space(1)))
#define LAS __attribute__((address_space(3)))
typedef unsigned short bf16;
typedef float f32x4 __attribute__((ext_vector_type(4)));
typedef float f32x2 __attribute__((ext_vector_type(2)));
typedef float f32x16 __attribute__((ext_vector_type(16)));
typedef short bf16x8 __attribute__((ext_vector_type(8)));
typedef short bf16x4 __attribute__((ext_vector_type(4)));
typedef unsigned u32x4 __attribute__((ext_vector_type(4)));
typedef unsigned u32x2 __attribute__((ext_vector_type(2)));
#define LDS_WAIT() asm volatile("s_waitcnt lgkmcnt(0)" ::: "memory")
#define VM_WAIT() asm volatile("s_waitcnt vmcnt(0)" ::: "memory")
#define LDS_BARRIER() do { asm volatile("s_waitcnt lgkmcnt(0)" ::: "memory"); __builtin_amdgcn_s_barrier(); asm volatile("" ::: "memory"); } while (0)
__device__ __forceinline__ unsigned f2bf(float f) { unsigned u = __builtin_bit_cast(unsigned, f); return (u + 0x7fffu + ((u >> 16) & 1u)) >> 16; }
typedef __bf16 bf16x2_t __attribute__((ext_vector_type(2)));
__device__ __forceinline__ unsigned pk2(float lo, float hi) { f32x2 v = {lo, hi}; return __builtin_bit_cast(unsigned, __builtin_convertvector(v, bf16x2_t)); }
__device__ __forceinline__ float bf2f(unsigned short b) { return __uint_as_float((unsigned)b << 16); }
__device__ __forceinline__ float bflo(unsigned w) { return __uint_as_float(w << 16); }
__device__ __forceinline__ float bfhi(unsigned w) { return __uint_as_float(w & 0xffff0000u); }
__device__ __forceinline__ float wave_sum(float v) {
#pragma unroll
    for (int o = 1; o < 64; o <<= 1) v += __shfl_xor(v, o);
    return v;
}
__device__ __forceinline__ int crow(int r, int hi) { return (r & 3) + 8 * (r >> 2) + 4 * hi; }

#define XB_TMO      128
#define XB_XCNT(j)  (256  + 64 * (j))
#define XB_XSUB(j)  (1280 + 64 * (j))
#define XB_XGEN(j)  (2304 + 64 * (j))
#define XB_TOP      3328
#define XB_TOPGEN   3392
#define XCD_BAR_WORDS 3456
#define XB_SPIN_CAP (1u << 18)
__device__ __forceinline__ unsigned xb_ld(unsigned* p)              { return __hip_atomic_load(p, __ATOMIC_RELAXED, __HIP_MEMORY_SCOPE_AGENT); }
__device__ __forceinline__ unsigned xb_add(unsigned* p, unsigned v) { return __hip_atomic_fetch_add(p, v, __ATOMIC_RELAXED, __HIP_MEMORY_SCOPE_AGENT); }
__device__ __forceinline__ unsigned xb_xcc_id() { return (unsigned)__builtin_amdgcn_s_getreg((3 << 11) | 20) & 0xFu; }
#define XB_SPIN(cond, bar) do { unsigned _sp = 0; while (cond) { __builtin_amdgcn_s_sleep(1); \
    if ((++_sp & 255u) == 0u) { if (xb_ld(&(bar)[XB_TMO])) break; if (_sp > XB_SPIN_CAP) { atomicAdd(&(bar)[XB_TMO], 1u); break; } } } } while (0)
struct XcdBarrier { unsigned* bar; unsigned x; volatile LAS unsigned* st; };
__device__ __forceinline__ XcdBarrier xcd_barrier_post(unsigned* bar, volatile LAS unsigned* st) {
    XcdBarrier b; b.bar = bar; b.x = xb_xcc_id(); b.st = st;
    if (threadIdx.x == 0) (void)xb_add(&bar[XB_XCNT(b.x)], 1u);
    return b;
}
__device__ __forceinline__ void xcd_barrier_complete(unsigned* bar, unsigned x, unsigned& nloc, unsigned& nx) {
    const unsigned G = gridDim.x * gridDim.y * gridDim.z;
    unsigned sum, cnt, mine, sp = 0u;
    for (;;) {
        sum = 0u; cnt = 0u; mine = 0u;
#pragma unroll
        for (unsigned j = 0; j < 16; ++j) { const unsigned c = xb_ld(&bar[XB_XCNT(j)]); sum += c; cnt += (c > 0u) ? 1u : 0u; mine = (j == x) ? c : mine; }
        if (sum == G) break;
        __builtin_amdgcn_s_sleep(1);
        if ((++sp & 255u) == 0u) { if (xb_ld(&bar[XB_TMO])) break; if (sp > XB_SPIN_CAP) { atomicAdd(&bar[XB_TMO], 1u); break; } }
    }
    nloc = mine > 0u ? mine : 1u; nx = cnt > 0u ? cnt : 1u;
}
__device__ __forceinline__ void xcd_barrier(const XcdBarrier& b) {
    asm volatile("s_waitcnt vmcnt(0)" ::: "memory");
    __syncthreads();
    if (threadIdx.x == 0) {
        unsigned* bar = b.bar;
        __builtin_amdgcn_s_waitcnt(0);
        unsigned nloc = b.st[0], nx = b.st[1];
        if (nloc == 0u) { xcd_barrier_complete(bar, b.x, nloc, nx); b.st[0] = nloc; b.st[1] = nx; }
        const unsigned old = xb_add(&bar[XB_XSUB(b.x)], 1u);
        const unsigned gen = old / nloc;
        if (old + 1u == (gen + 1u) * nloc) {
            __builtin_amdgcn_fence(__ATOMIC_RELEASE, "agent");
            asm volatile("s_waitcnt vmcnt(0)" ::: "memory");
            const unsigned og = xb_add(&bar[XB_TOP], 1u);
            const unsigned tg = og / nx;
            if (og + 1u == (tg + 1u) * nx) xb_add(&bar[XB_TOPGEN], 1u);
            else XB_SPIN(xb_ld(&bar[XB_TOPGEN]) == tg, bar);
            __builtin_amdgcn_fence(__ATOMIC_ACQUIRE, "agent");
            xb_add(&bar[XB_XGEN(b.x)], 1u);
            asm volatile("s_waitcnt vmcnt(0)" ::: "memory");
        } else {
            XB_SPIN(xb_ld(&bar[XB_XGEN(b.x)]) == gen, bar);
            __builtin_amdgcn_fence(__ATOMIC_ACQUIRE, "agent");
            asm volatile("s_waitcnt vmcnt(0)" ::: "memory");
        }
    }
    __syncthreads();
}

struct Frame {
    LAS unsigned char* lds;
    int tid, lane, wave, G, bid;
    unsigned char* ws;
    const float* const* in;
};
enum InIdx { I_X = 0, I_LNMG, I_LNMB, I_LNFG, I_LNFB, I_ABWIN, I_LAMRE, I_LAMIM, I_LOGDT, I_BRE, I_BIM, I_CRE, I_CIM, I_S5D, I_GLUW, I_GLUB,
             I_GATEW, I_GATEB, I_NORMG, I_ABWOUT, I_CWIN, I_SINK, I_CWOUT, I_RELB, I_WGRP, I_BGRP, I_WRT, I_BRT, I_W1, I_W3, I_W2, N_IN };

__device__ __forceinline__ const float* inp(LAS unsigned char* lds, int k) {
    const LAS unsigned* p = (const LAS unsigned*)(lds + PTR_OFF) + 2 * k;
    const unsigned lo = __builtin_amdgcn_readfirstlane(p[0]), hi = __builtin_amdgcn_readfirstlane(p[1]);
    return (const float*)(((unsigned long long)hi << 32) | (unsigned long long)lo);
}
__device__ __forceinline__ void tr_item(const float* W, int ldw, bf16* WT, int ldt, int rowmode, LAS float* scr, int item, int nblk, int lane) {
    const int kb = item / nblk, nb = item % nblk, k0 = 64 * kb, n0 = 32 * nb;
    float tv[32];
    const float* wp = W + (size_t)(k0 + (lane >> 5)) * ldw + n0 + (lane & 31);
#pragma unroll
    for (int i = 0; i < 32; ++i) tv[i] = wp[(size_t)(2 * i) * ldw];
#pragma unroll
    for (int i = 0; i < 32; ++i) scr[(2 * i + (lane >> 5)) * 33 + (lane & 31)] = tv[i];
    LDS_WAIT(); asm volatile("" ::: "memory");
    const int c = lane & 7;
#pragma unroll
    for (int j = 0; j < 4; ++j) { const int n = (lane >> 3) + 8 * j; const LAS float* s = scr + (8 * c) * 33 + n;
        u32x4 o; o.x = pk2(s[0 * 33], s[1 * 33]); o.y = pk2(s[2 * 33], s[3 * 33]); o.z = pk2(s[4 * 33], s[5 * 33]); o.w = pk2(s[6 * 33], s[7 * 33]);
        const int ng = n0 + n; const int dr = rowmode == 0 ? ng : (8 * (ng >> 2) + (ng & 3) + (rowmode == 2 ? 4 : 0));
        *(GAS u32x4*)(WT + (size_t)dr * ldt + k0 + 8 * c) = o; }
    LDS_WAIT(); asm volatile("" ::: "memory");
}
__device__ __forceinline__ void moe_convert(const float* w1, const float* w3, const float* w2, bf16* W13, bf16* W2T, LAS float* scr, int it0, int it1, int gw, int NGW, int lane) {
    constexpr int PER_E = 768;
    for (int it = it0 + gw; it < it1; it += NGW) {
        const int e = it / PER_E; int r = it % PER_E;
        if (r < 256) tr_item(w1 + (size_t)e * D * DEXP, DEXP, W13 + (size_t)e * D * D, D, 1, scr, r, DEXP / 32, lane);
        else if (r < 512) tr_item(w3 + (size_t)e * D * DEXP, DEXP, W13 + (size_t)e * D * D, D, 2, scr, r - 256, DEXP / 32, lane);
        else tr_item(w2 + (size_t)e * DEXP * D, D, W2T + (size_t)e * D * DEXP, DEXP, 0, scr, r - 512, D / 32, lane);
    }
}
constexpr int MOE_ITEMS = NEXP * 768, IDLE_Q8 = 88, IDLE_Q9 = 56;
__device__ __forceinline__ void idle_convert(int which, unsigned char* ws, LAS unsigned char* lds, float* dout, int ntiles, int bid, int G, int wave, int lane) {
    const int U = ntiles * (D / 256), rem = U % G; if (rem == 0 || bid < rem) return;
    const int n_idle = G - rem, rank = bid - rem;
    int q8 = n_idle * IDLE_Q8; q8 = q8 < MOE_ITEMS ? q8 : MOE_ITEMS; int q9 = n_idle * IDLE_Q9; q9 = (q8 + q9) < MOE_ITEMS ? q9 : (MOE_ITEMS - q8);
    const int per = which == 0 ? IDLE_Q8 : IDLE_Q9, base = which == 0 ? 0 : q8, lim = which == 0 ? q8 : q8 + q9;
    int lo = base + rank * per, hi = lo + per; hi = hi < lim ? hi : lim;
    moe_convert(inp(lds, I_W1) + (size_t)NEXP * D * DEXP, inp(lds, I_W3) + (size_t)NEXP * D * DEXP, inp(lds, I_W2) + (size_t)NEXP * DEXP * D,
                (bf16*)dout, (bf16*)dout + (size_t)NEXP * D * D, (LAS float*)(lds + wave * 16384), lo, hi, wave, NWAVES, lane);
}
__device__ __forceinline__ int idle_done(int ntiles, int G) {
    const int U = ntiles * (D / 256), rem = U % G; if (rem == 0) return 0;
    const int n_idle = G - rem; int q = n_idle * (IDLE_Q8 + IDLE_Q9); return q < MOE_ITEMS ? q : MOE_ITEMS;
}
__device__ __forceinline__ int t5_bucket(int rel) {
    const int nb = 16, max_exact = 8; int ret = rel > 0 ? nb : 0; const int n = rel < 0 ? -rel : rel;
    const float lg = logf((float)(n < 1 ? 1 : n) / 8.0f) / 2.7725887f * 8.0f;
    int large = max_exact + (int)lg; large = large < nb - 1 ? large : nb - 1;
    return ret + (n < max_exact ? n : large);
}
__device__ __forceinline__ void p0_prologue(unsigned char* ws, LAS unsigned char* lds, int bid, int G, int tid, int wave, int lane) {
    LAS float* scr = (LAS float*)(lds + wave * 16384);
    const int gw = bid * NWAVES + wave, NGW = G * NWAVES;
    constexpr int I0 = 16 * 64, I1 = 16, I2 = 8 * 16, I3 = 16 * 32, I4 = 16 * 48, I5 = 16 * 32, NIT = I0 + I1 + I2 + I3 + I4 + I5;
    for (int it = gw; it < NIT; it += NGW) {
        int r = it;
        if (r < I0) { tr_item(inp(lds, I_ABWIN), AB_IN, (bf16*)(ws + WS_WIN), D, 0, scr, r, 64, lane); continue; } r -= I0;
        if (r < I1) { tr_item(inp(lds, I_ABWIN) + 2048, AB_IN, (bf16*)(ws + WS_WLR), D, 0, scr, r, 1, lane); continue; } r -= I1;
        if (r < I2) { tr_item(inp(lds, I_GLUW), 512, (bf16*)(ws + WS_WGLU), 512, 0, scr, r, 16, lane); continue; } r -= I2;
        if (r < I3) { tr_item(inp(lds, I_ABWOUT), D, (bf16*)(ws + WS_WOUT), D, 0, scr, r, 32, lane); continue; } r -= I3;
        if (r < I4) { tr_item(inp(lds, I_CWIN), CN, (bf16*)(ws + WS_CIN), D, 0, scr, r, 48, lane); continue; } r -= I4;
        tr_item(inp(lds, I_CWOUT), D, (bf16*)(ws + WS_COUT), D, 0, scr, r, 32, lane);
    }
    moe_convert(inp(lds, I_W1), inp(lds, I_W3), inp(lds, I_W2), (bf16*)(ws + WS_W13), (bf16*)(ws + WS_W2), scr, 0, MOE_ITEMS, gw, NGW, lane);
    { const float* x = inp(lds, I_X); bf16* xb = (bf16*)(ws + WS_X64);
      for (int m = gw; m < T; m += 2 * NGW) { const int m2 = m + NGW;
          const GAS f32x4* xr = (const GAS f32x4*)(x + (size_t)m * D) + lane; GAS u32x2* o = (GAS u32x2*)(xb + (size_t)m * D) + lane;
          const GAS f32x4* xr2 = (const GAS f32x4*)(x + (size_t)m2 * D) + lane; GAS u32x2* o2 = (GAS u32x2*)(xb + (size_t)m2 * D) + lane;
          f32x4 v[4], v2[4];
#pragma unroll
          for (int j = 0; j < 4; ++j) { v[j] = xr[64 * j]; if (m2 < T) v2[j] = xr2[64 * j]; }
#pragma unroll
          for (int j = 0; j < 4; ++j) { u32x2 w; w.x = pk2(v[j].x, v[j].y); w.y = pk2(v[j].z, v[j].w); o[64 * j] = w;
              if (m2 < T) { u32x2 w2; w2.x = pk2(v2[j].x, v2[j].y); w2.y = pk2(v2[j].z, v2[j].w); o2[64 * j] = w2; } } } }
    const int gt = bid * NTHR + tid, NGT = G * NTHR;
    { const float* lamre = inp(lds, I_LAMRE); const float* lamim = inp(lds, I_LAMIM); const float* logdt = inp(lds, I_LOGDT); const float* bre = inp(lds, I_BRE); const float* bim = inp(lds, I_BIM);
    for (int i = gt; i < 2 * 32 * 64; i += NGT) {
        const int p = i & 63, g = (i >> 6) & 31, dir = i >> 11;
        const double lr = fmin((double)lamre[i], -1e-4), li = (double)lamim[i], dt = exp((double)logdt[dir * 32 + g]);
        const double mag = exp(lr * dt), ar = mag * cos(li * dt), ai = mag * sin(li * dt), den = lr * lr + li * li, nr = ar - 1.0;
        const double cr = (nr * lr + ai * li) / den, ci = (ai * lr - nr * li) / den;
        double qr = ar, qi = ai;
#pragma unroll 1
        for (int s = 1; s < S5CH; s <<= 1) { const double t = qr * qr - qi * qi; qi = 2.0 * qr * qi; qr = t; }
        float* L4 = (float*)(ws + WS_S5L) + (size_t)i * 4; L4[0] = (float)ar; L4[1] = (float)ai; L4[2] = (float)qr; L4[3] = (float)qi;
        bf16* Bb = (bf16*)(ws + WS_S5B) + (size_t)(dir * 32 + g) * 2048;
#pragma unroll 4
        for (int c = 0; c < 16; ++c) { const double br = bre[(size_t)i * 16 + c], bi = bim[(size_t)i * 16 + c];
            Bb[p * 16 + c] = (bf16)f2bf((float)(cr * br - ci * bi)); Bb[1024 + p * 16 + c] = (bf16)f2bf((float)(cr * bi + ci * br)); }
    } }
    { const float* cre = inp(lds, I_CRE); const float* cim = inp(lds, I_CIM);
    for (int i = gt; i < 2 * 32 * 16 * 64; i += NGT) {
        const int p = i & 63, c = (i >> 6) & 15, dg = i >> 10;
        bf16* Cm = (bf16*)(ws + WS_S5C) + (size_t)dg * 2048 + c * 128 + 2 * p;
        Cm[0] = (bf16)f2bf(cre[i]); Cm[1] = (bf16)f2bf(-cim[i]);
    } }
    { const float* relb = inp(lds, I_RELB);
    for (int i = gt; i < 16 * 257; i += NGT) { const int h = i / 257, r = i % 257; ((float*)(ws + WS_BTAB))[h * 260 + r] = relb[t5_bucket(r - 128) * 16 + h] * LOG2E; } }
    { const float* wgrp = inp(lds, I_WGRP); const float* wrt = inp(lds, I_WRT);
    for (int i = gt; i < 2 * 48 * 1024; i += NGT) {
        const int k = i & 1023, n = (i >> 10) % 48, l = i / (48 * 1024);
        const float w = n < 4 ? wgrp[(size_t)l * D * 4 + k * 4 + n] : (n < 36 ? wrt[(size_t)l * D * 32 + k * 32 + (n - 4)] : 0.f);
        const unsigned hi = f2bf(w); const float lo = w - __uint_as_float(hi << 16);
        bf16* Wr = (bf16*)(ws + WS_WR) + (size_t)l * 2 * 48 * 1024; Wr[n * 1024 + k] = (bf16)hi; Wr[48 * 1024 + n * 1024 + k] = (bf16)f2bf(lo);
    } }
}

__device__ __forceinline__ void gate_tail(float* bcg, const float* gate_w, const float* gate_b, const LAS float* lrs, size_t row0, int tid);
__device__ __forceinline__ void lr_tail(unsigned char* ws, float* bcg, const float* gate_w, const float* gate_b, LAS unsigned char* lds, int bid, int G, int tid, int wave, int lane) {
    const bf16* xb = (const bf16*)(ws + WS_X64); const bf16* wl = (const bf16*)(ws + WS_WLR); LAS float* lrs = (LAS float*)lds;
    for (int rt = bid; rt < T / 128; rt += G) {
        const int r0 = rt * 128 + wave * 16;
        f32x4 acc0 = {0.f, 0.f, 0.f, 0.f}, acc1 = {0.f, 0.f, 0.f, 0.f};
        const bf16* ap = xb + (size_t)(r0 + (lane & 15)) * D + 8 * (lane >> 4);
        const bf16* bp = wl + (size_t)(lane & 15) * D + 8 * (lane >> 4);
#pragma unroll 8
        for (int ks = 0; ks < 32; ++ks) {
            const bf16x8 a = *(const bf16x8*)(ap + ks * 32), b0 = *(const bf16x8*)(bp + ks * 32), b1 = *(const bf16x8*)(bp + 16 * D + ks * 32);
            acc0 = __builtin_amdgcn_mfma_f32_16x16x32_bf16(a, b0, acc0, 0, 0, 0); acc1 = __builtin_amdgcn_mfma_f32_16x16x32_bf16(a, b1, acc1, 0, 0, 0);
        }
        __syncthreads();
#pragma unroll
        for (int r = 0; r < 4; ++r) { LAS float* o = lrs + (wave * 16 + 4 * (lane >> 4) + r) * 32 + (lane & 15); o[0] = acc0[r]; o[16] = acc1[r]; }
        __syncthreads();
        gate_tail(bcg, gate_w, gate_b, lrs, (size_t)rt * 128, tid);
    }
    __syncthreads();
}

__device__ __forceinline__ void gla_finalize(unsigned char* ws, const float* norm_g, int gw, int NGW, int lane) {
    const bf16* of = (const bf16*)(ws + WS_OF); const bf16* ob = (const bf16*)(ws + WS_OB); const bf16* h0 = (const bf16*)(ws + WS_H0); bf16* cc = (bf16*)(ws + WS_X64);
    const f32x4 g0 = *(const f32x4*)(norm_g + 8 * lane), g1 = *(const f32x4*)(norm_g + 8 * lane + 4);
    for (int m0 = gw; m0 < T; m0 += 4 * NGW) {
        u32x4 a[4], b[4], gq[4];
#pragma unroll
        for (int q = 0; q < 4; ++q) { const size_t m = (size_t)m0 + (size_t)q * NGW;
            a[q] = *(const u32x4*)(of + m * 512 + 8 * lane); b[q] = *(const u32x4*)(ob + m * 512 + 8 * lane); gq[q] = *(const u32x4*)(h0 + m * H0P + OFF_GO + 8 * lane); }
#pragma unroll
        for (int q = 0; q < 4; ++q) { const size_t m = (size_t)m0 + (size_t)q * NGW;
            f32x4 v0, v1;
            v0.x = bflo(a[q].x) + bflo(b[q].x); v0.y = bfhi(a[q].x) + bfhi(b[q].x); v0.z = bflo(a[q].y) + bflo(b[q].y); v0.w = bfhi(a[q].y) + bfhi(b[q].y);
            v1.x = bflo(a[q].z) + bflo(b[q].z); v1.y = bfhi(a[q].z) + bfhi(b[q].z); v1.z = bflo(a[q].w) + bflo(b[q].w); v1.w = bfhi(a[q].w) + bfhi(b[q].w);
            float ss = (v0.x * v0.x + v0.y * v0.y) + (v0.z * v0.z + v0.w * v0.w) + (v1.x * v1.x + v1.y * v1.y) + (v1.z * v1.z + v1.w * v1.w);
            ss += __shfl_xor(ss, 1); ss += __shfl_xor(ss, 2); ss += __shfl_xor(ss, 4); ss += __shfl_xor(ss, 8);
            const float rs = 1.0f / sqrtf(ss * (1.0f / 128.0f) + RMS_EPS);
            const float gv[8] = {bflo(gq[q].x), bfhi(gq[q].x), bflo(gq[q].y), bfhi(gq[q].y), bflo(gq[q].z), bfhi(gq[q].z), bflo(gq[q].w), bfhi(gq[q].w)};
            const float ov[8] = {v0.x * g0.x, v0.y * g0.y, v0.z * g0.z, v0.w * g0.w, v1.x * g1.x, v1.y * g1.y, v1.z * g1.z, v1.w * g1.w};
            float r[8];
#pragma unroll
            for (int i = 0; i < 8; ++i) r[i] = ov[i] * rs * (gv[i] / (1.f + __expf(-gv[i])));
            u32x4 w; w.x = pk2(r[0], r[1]); w.y = pk2(r[2], r[3]); w.z = pk2(r[4], r[5]); w.w = pk2(r[6], r[7]);
            *(u32x4*)(cc + m * D + 512 + 8 * lane) = w; }
    }
}

constexpr int RT_AST = 2064;
__device__ __forceinline__ void ln_router(unsigned char* ws, const float* resid, const float* lng, const float* lnb, const float* bgrp, const float* brt, int layer, LAS unsigned char* lds, int bid, int G, int tid, int wave, int lane) {
    const bf16* yb = (const bf16*)(ws + WS_Z); float* h1 = (float*)(ws + WS_H1); bf16* hb = (bf16*)(ws + WS_X64);
    int* tok_e = (int*)(ws + WS_TOKE); float* tok_w = (float*)(ws + WS_TOKW);
    LAS unsigned char* Ahi = lds; LAS unsigned char* Alo = lds + 16 * RT_AST; LAS float* part = (LAS float*)(lds + 32 * RT_AST);
    LAS int* hist = (LAS int*)(lds + 32 * RT_AST + 8 * 16 * 48 * 4); LAS float* lgt = (LAS float*)(lds + 32 * RT_AST + 8 * 16 * 48 * 4 + 256);
    if (tid < 32) hist[tid] = 0;
    const bf16* Wr = (const bf16*)(ws + WS_WR) + (size_t)layer * 2 * 48 * 1024;
    bf16x8 Bh[3][4], Bl[3][4];
#pragma unroll
    for (int nt = 0; nt < 3; ++nt)
#pragma unroll
        for (int ks = 0; ks < 4; ++ks) { const size_t o = (size_t)(nt * 16 + (lane & 15)) * 1024 + wave * 128 + ks * 32 + 8 * (lane >> 4);
            Bh[nt][ks] = *(const bf16x8*)(Wr + o); Bl[nt][ks] = *(const bf16x8*)(Wr + 48 * 1024 + o); }
    f32x4 gv[4], bv[4];
#pragma unroll
    for (int j = 0; j < 4; ++j) { gv[j] = *(const f32x4*)(lng + 4 * lane + 256 * j); bv[j] = *(const f32x4*)(lnb + 4 * lane + 256 * j); }
    __syncthreads();
    for (int grp = bid; grp < T / 16; grp += G) {
#pragma unroll
        for (int rr = 0; rr < 2; ++rr) {
            const int row = 2 * wave + rr; const size_t m = (size_t)grp * 16 + row;
            const GAS f32x4* xr = (const GAS f32x4*)(resid + m * D) + lane; const GAS u32x2* yr = (const GAS u32x2*)(yb + m * D) + lane;
            f32x4 v[4]; float s = 0.f;
#pragma unroll
            for (int j = 0; j < 4; ++j) { const f32x4 x4 = xr[64 * j]; const u32x2 y2 = yr[64 * j];
                v[j].x = x4.x * ALPHA + bflo(y2.x); v[j].y = x4.y * ALPHA + bfhi(y2.x); v[j].z = x4.z * ALPHA + bflo(y2.y); v[j].w = x4.w * ALPHA + bfhi(y2.y);
                s += (v[j].x + v[j].y) + (v[j].z + v[j].w); }
            const float mean = wave_sum(s) * (1.f / D); float s2 = 0.f;
#pragma unroll
            for (int j = 0; j < 4; ++j) { v[j] = v[j] - mean; s2 += (v[j].x * v[j].x + v[j].y * v[j].y) + (v[j].z * v[j].z + v[j].w * v[j].w); }
            const float rstd = 1.f / sqrtf(wave_sum(s2) * (1.f / D) + LN_EPS);
#pragma unroll
            for (int j = 0; j < 4; ++j) {
                const f32x4 h = v[j] * rstd * gv[j] + bv[j];
                ((GAS f32x4*)(h1 + m * D) + lane)[64 * j] = h;
                const unsigned h0 = pk2(h.x, h.y), h1w = pk2(h.z, h.w);
                u32x2 w; w.x = h0; w.y = h1w; ((GAS u32x2*)(hb + m * D) + lane)[64 * j] = w;
                u32x2 lo; lo.x = pk2(h.x - bflo(h0), h.y - bfhi(h0)); lo.y = pk2(h.z - bflo(h1w), h.w - bfhi(h1w));
                *(LAS u32x2*)(Ahi + row * RT_AST + (4 * lane + 256 * j) * 2) = w; *(LAS u32x2*)(Alo + row * RT_AST + (4 * lane + 256 * j) * 2) = lo;
            }
        }
        LDS_BARRIER();
        f32x4 acc[3] = {{0.f, 0.f, 0.f, 0.f}, {0.f, 0.f, 0.f, 0.f}, {0.f, 0.f, 0.f, 0.f}};
#pragma unroll
        for (int ks = 0; ks < 4; ++ks) {
            const int bo = (lane & 15) * RT_AST + (wave * 128 + ks * 32 + 8 * (lane >> 4)) * 2;
            const bf16x8 ah = *(const LAS bf16x8*)(Ahi + bo), al = *(const LAS bf16x8*)(Alo + bo);
#pragma unroll
            for (int nt = 0; nt < 3; ++nt) {
                acc[nt] = __builtin_amdgcn_mfma_f32_16x16x32_bf16(ah, Bh[nt][ks], acc[nt], 0, 0, 0);
                acc[nt] = __builtin_amdgcn_mfma_f32_16x16x32_bf16(ah, Bl[nt][ks], acc[nt], 0, 0, 0);
                acc[nt] = __builtin_amdgcn_mfma_f32_16x16x32_bf16(al, Bh[nt][ks], acc[nt], 0, 0, 0);
            }
        }
#pragma unroll
        for (int nt = 0; nt < 3; ++nt)
#pragma unroll
            for (int r = 0; r < 4; ++r) part[(wave * 16 + 4 * (lane >> 4) + r) * 48 + nt * 16 + (lane & 15)] = acc[nt][r];
        LDS_BARRIER();
        for (int idx = tid; idx < 16 * 36; idx += NTHR) { const int tk = idx / 36, n = idx % 36; float s = 0.f;
#pragma unroll
            for (int w = 0; w < 8; ++w) s += part[(w * 16 + tk) * 48 + n];
            lgt[tk * 36 + n] = s + (n < 4 ? bgrp[n] : brt[n - 4]); }
        LDS_BARRIER();
        if (tid < 16) {
            const size_t m = (size_t)grp * 16 + tid;
            const LAS float* lg = lgt + tid * 36;
            int gi = 0; float gm = lg[0];
#pragma unroll
            for (int n = 1; n < 4; ++n) if (lg[n] > gm) { gm = lg[n]; gi = n; }
            float gs = 0.f;
#pragma unroll
            for (int n = 0; n < 4; ++n) gs += __expf(lg[n] - gm);
            const float pg = 1.f / gs;
            float el[8];
#pragma unroll
            for (int i = 0; i < 8; ++i) el[i] = lg[4 + gi * 8 + i];
            int i1 = 0; float m1 = el[0];
#pragma unroll
            for (int i = 1; i < 8; ++i) if (el[i] > m1) { m1 = el[i]; i1 = i; }
            int i2 = -1; float m2 = -3.0e38f;
#pragma unroll
            for (int i = 0; i < 8; ++i) if (i != i1 && el[i] > m2) { m2 = el[i]; i2 = i; }
            const float e2 = __expf(m2 - m1), inv = 1.f / (1.f + e2);
            const int ea = gi * 8 + i1, eb = gi * 8 + i2;
            tok_e[m * 2] = ea; tok_e[m * 2 + 1] = eb; tok_w[m * 2] = pg * inv; tok_w[m * 2 + 1] = pg * e2 * inv;
            atomicAdd((int*)&hist[ea], 1); atomicAdd((int*)&hist[eb], 1);
        }
        LDS_BARRIER();
    }
    if (tid < 32) ((int*)(ws + WS_BLKC))[bid * 32 + tid] = hist[tid];
}

__device__ __forceinline__ void moe_sort(unsigned char* ws, LAS unsigned char* lds, int bid, int G, int tid) {
    const int* blkc = (const int*)(ws + WS_BLKC); const int* tok_e = (const int*)(ws + WS_TOKE); const float* tok_w = (const float*)(ws + WS_TOKW);
    int* tok_s = (int*)(ws + WS_TOKS); int* slot_t = (int*)(ws + WS_SLOTT); float* slot_w = (float*)(ws + WS_SLOTW); int* tile = (int*)(ws + WS_TILE);
    LAS int* ptot = (LAS int*)lds; LAS int* pbase = ptot + 512; LAS int* tot = pbase + 512; LAS int* base = tot + 32; LAS int* pstart = base + 32; LAS int* lcur = pstart + 33;
    { const int e = tid & 31, part = tid >> 5; int st = 0, sb = 0;
      for (int b = part; b < G; b += 16) { const int c = blkc[b * 32 + e]; st += c; sb += (b < bid) ? c : 0; }
      ptot[part * 32 + e] = st; pbase[part * 32 + e] = sb; }
    __syncthreads();
    if (tid < 32) { int st = 0, sb = 0;
#pragma unroll
        for (int p = 0; p < 16; ++p) { st += ptot[p * 32 + tid]; sb += pbase[p * 32 + tid]; }
        tot[tid] = st; base[tid] = sb; lcur[tid] = 0; }
    __syncthreads();
    if (tid == 0) { int acc = 0; for (int e = 0; e < 32; ++e) { pstart[e] = acc; acc += (tot[e] + 255) & ~255; } pstart[32] = acc; }
    __syncthreads();
    if (bid == 0) {
        const int nt = pstart[32] >> 8;
        if (tid == 0) tile[511] = nt;
        for (int t = tid; t < nt; t += NTHR) { int e = 0; for (int q = 1; q < 32; ++q) if ((t << 8) >= pstart[q]) e = q; tile[t] = e; }
    }
    for (int e = bid; e < 32; e += G)
        for (int s = pstart[e] + tot[e] + tid; s < pstart[e + 1]; s += NTHR) { slot_t[s] = 0; slot_w[s] = 0.f; }
    for (int grp = bid; grp < T / 16; grp += G) {
        if (tid < 32) { const size_t a = (size_t)grp * 32 + tid; const int e = tok_e[a]; const int rank = atomicAdd((int*)&lcur[e], 1);
            const int s = pstart[e] + base[e] + rank; slot_t[s] = (int)(a >> 1); slot_w[s] = tok_w[a]; tok_s[a] = s; }
    }
}

template <bool FINAL>
__device__ __forceinline__ void combine_ln(unsigned char* ws, const float* lng, const float* lnb, float* dout, int gw, int NGW, int lane) {
    float* h1 = (float*)(ws + WS_H1); const bf16* y2 = (const bf16*)(ws + WS_Y2); const int* tok_s = (const int*)(ws + WS_TOKS); bf16* h2b = (bf16*)(ws + WS_H2B);
    f32x4 gv[4], bv[4];
#pragma unroll
    for (int j = 0; j < 4; ++j) { gv[j] = *(const f32x4*)(lng + 4 * lane + 256 * j); bv[j] = *(const f32x4*)(lnb + 4 * lane + 256 * j); }
    for (int m = gw; m < T; m += NGW) {
        const int s0 = tok_s[(size_t)m * 2], s1 = tok_s[(size_t)m * 2 + 1];
        const GAS f32x4* hr = (const GAS f32x4*)(h1 + (size_t)m * D) + lane;
        const GAS u32x2* ya = (const GAS u32x2*)(y2 + (size_t)s0 * D) + lane; const GAS u32x2* yb = (const GAS u32x2*)(y2 + (size_t)s1 * D) + lane;
        f32x4 v[4]; float s = 0.f;
#pragma unroll
        for (int j = 0; j < 4; ++j) { const f32x4 h = hr[64 * j]; const u32x2 a = ya[64 * j], b = yb[64 * j];
            v[j].x = h.x * ALPHA + (bflo(a.x) + bflo(b.x)); v[j].y = h.y * ALPHA + (bfhi(a.x) + bfhi(b.x)); v[j].z = h.z * ALPHA + (bflo(a.y) + bflo(b.y)); v[j].w = h.w * ALPHA + (bfhi(a.y) + bfhi(b.y));
            s += (v[j].x + v[j].y) + (v[j].z + v[j].w); }
        const float mean = wave_sum(s) * (1.f / D); float s2 = 0.f;
#pragma unroll
        for (int j = 0; j < 4; ++j) { v[j] = v[j] - mean; s2 += (v[j].x * v[j].x + v[j].y * v[j].y) + (v[j].z * v[j].z + v[j].w * v[j].w); }
        const float rstd = 1.f / sqrtf(wave_sum(s2) * (1.f / D) + LN_EPS);
#pragma unroll
        for (int j = 0; j < 4; ++j) { const f32x4 h = v[j] * rstd * gv[j] + bv[j];
            if (FINAL) ((GAS f32x4*)(dout + (size_t)m * D) + lane)[64 * j] = h;
            else { ((GAS f32x4*)(h1 + (size_t)m * D) + lane)[64 * j] = h; u32x2 w; w.x = pk2(h.x, h.y); w.y = pk2(h.z, h.w); ((GAS u32x2*)(h2b + (size_t)m * D) + lane)[64 * j] = w; } }
    }
}
constexpr int S5_HST = 272, S5_UST = 272, S5_UOFF = 8 * 32 * S5_HST;
#define MFMA32(a, b, c) __builtin_amdgcn_mfma_f32_32x32x16_bf16((a), (b), (c), 0, 0, 0)
#define MFMA16(a, b, c) __builtin_amdgcn_mfma_f32_16x16x32_bf16((a), (b), (c), 0, 0, 0)
__device__ __forceinline__ float gelu_tanh(float x) {
    const float u = 0.7978845608028654f * (x + 0.044715f * x * x * x);
    const float e = __expf(2.f * u); const float th = 1.f - 2.f / (e + 1.f);
    return 0.5f * x * (1.f + th);
}
__device__ __forceinline__ f32x4 ld_ys(const float* p) {
    f32x4 v;
    v.x = __hip_atomic_load(p, __ATOMIC_RELAXED, __HIP_MEMORY_SCOPE_AGENT); v.y = __hip_atomic_load(p + 1, __ATOMIC_RELAXED, __HIP_MEMORY_SCOPE_AGENT);
    v.z = __hip_atomic_load(p + 2, __ATOMIC_RELAXED, __HIP_MEMORY_SCOPE_AGENT); v.w = __hip_atomic_load(p + 3, __ATOMIC_RELAXED, __HIP_MEMORY_SCOPE_AGENT);
    return v;
}
template <int PASS, int DIR>
__device__ __forceinline__ void s5_dir(unsigned char* ws, const float* s5d, int b, int g, int c, LAS unsigned char* hl, const LAS unsigned char* ul, float* yscr, int lane) {
    const bf16* h0 = (const bf16*)(ws + WS_H0);
    const int dg = DIR * 32 + g;
    const f32x4 L4 = *(const f32x4*)((const float*)(ws + WS_S5L) + (size_t)(dg * 64 + lane) * 4);
    const float ar = L4.x, ai = L4.y, qr = L4.z, qi = L4.w;
    const float l2r = ar * ar - ai * ai, l2i = 2.f * ar * ai, l4r = l2r * l2r - l2i * l2i, l4i = 2.f * l2r * l2i, l8r = l4r * l4r - l4i * l4i, l8i = 2.f * l4r * l4i;
    const float l16r = l8r * l8r - l8i * l8i, l16i = 2.f * l8r * l8i, l32r = l16r * l16r - l16i * l16i, l32i = 2.f * l16r * l16i;
    const bf16* Bb = (const bf16*)(ws + WS_S5B) + (size_t)dg * 2048 + (lane & 31) * 16 + 8 * (lane >> 5);
    const bf16x8 bre0 = *(const bf16x8*)Bb, bre1 = *(const bf16x8*)(Bb + 512), bim0 = *(const bf16x8*)(Bb + 1024), bim1 = *(const bf16x8*)(Bb + 1536);
    bf16x8 cf[4]; bf16x8 dfrag;
    if (PASS == 2) {
        const bf16* Cm = (const bf16*)(ws + WS_S5C) + (size_t)dg * 2048 + (lane & 15) * 128 + 8 * (lane >> 4);
#pragma unroll
        for (int ks = 0; ks < 4; ++ks) cf[ks] = *(const bf16x8*)(Cm + 32 * ks);
        if (DIR == 1) {
            const int cc = lane & 15, kq = lane >> 4; const float d = s5d[g * 16 + cc]; const unsigned dh = f2bf(d); const unsigned dl = f2bf(d - __uint_as_float(dh << 16));
#pragma unroll
            for (int j = 0; j < 8; ++j) { const int k = 8 * (kq & 1) + j; dfrag[j] = (short)((k == cc) ? (kq < 2 ? dh : dl) : 0u); }
        }
    }
    float hr = 0.f, hi = 0.f;
    float* Ec = (float*)(ws + WS_S5E) + ((size_t)((DIR * NB + b) * 32 + g) * S5NCH) * 128 + 2 * lane;
    if (PASS == 2) {
        const int nj = DIR == 0 ? c : (S5NCH - 1 - c);
        for (int j0 = 0; j0 < nj; j0 += 8) {
            f32x2 e[8];
#pragma unroll
            for (int q = 0; q < 8; ++q) { const int j = j0 + q; const int jj = DIR == 0 ? j : (S5NCH - 1 - j); e[q] = (j < nj) ? *(const f32x2*)(Ec + (size_t)jj * 128) : (f32x2){0.f, 0.f}; }
#pragma unroll
            for (int q = 0; q < 8; ++q) if (j0 + q < nj) { const float nr = qr * hr - qi * hi + e[q].x; hi = qr * hi + qi * hr + e[q].y; hr = nr; }
        }
    }
    const size_t rowbase = (size_t)b * SEQ + (size_t)c * S5CH;
    const LAS unsigned char* up = ul + (lane & 31) * S5_UST + (g & 7) * 32 + 16 * (lane >> 5);
    const f32x16 zero16 = {0.f, 0.f, 0.f, 0.f, 0.f, 0.f, 0.f, 0.f, 0.f, 0.f, 0.f, 0.f, 0.f, 0.f, 0.f, 0.f};
#pragma unroll 1
    for (int ti = 0; ti < S5CH / 32; ++ti) {
        const int tile = DIR == 0 ? ti : (S5CH / 32 - 1 - ti);
        const bf16x8 a = *(const LAS bf16x8*)(up + tile * 32 * S5_UST);
        f32x4 ysv[2] = {{0.f, 0.f, 0.f, 0.f}, {0.f, 0.f, 0.f, 0.f}};
        if (PASS == 2 && DIR == 1) { ysv[0] = ld_ys(yscr + (size_t)(tile * 2) * 256 + 4 * lane); ysv[1] = ld_ys(yscr + (size_t)(tile * 2 + 1) * 256 + 4 * lane); }
        f32x16 xr0 = MFMA32(a, bre0, zero16), xr1 = MFMA32(a, bre1, zero16), xi0 = MFMA32(a, bim0, zero16), xi1 = MFMA32(a, bim1, zero16);
        __builtin_amdgcn_sched_barrier(0);
        asm volatile("s_nop 15\n\ts_nop 15\n\ts_nop 15\n\ts_nop 15" ::: "memory");
        __builtin_amdgcn_sched_barrier(0);
        float xr[32], xi[32];
#pragma unroll
        for (int r = 0; r < 16; ++r) {
            auto s = __builtin_amdgcn_permlane32_swap(__float_as_uint(xr0[r]), __float_as_uint(xr1[r]), false, false);
            xr[crow(r, 0)] = __uint_as_float(s[0]); xr[crow(r, 1)] = __uint_as_float(s[1]);
            auto q = __builtin_amdgcn_permlane32_swap(__float_as_uint(xi0[r]), __float_as_uint(xi1[r]), false, false);
            xi[crow(r, 0)] = __uint_as_float(q[0]); xi[crow(r, 1)] = __uint_as_float(q[1]);
        }
        if (PASS == 1) {
#pragma unroll
            for (int lv = 0; lv < 5; ++lv) {
                const float pr = lv == 0 ? ar : lv == 1 ? l2r : lv == 2 ? l4r : lv == 3 ? l8r : l16r, pi = lv == 0 ? ai : lv == 1 ? l2i : lv == 2 ? l4i : lv == 3 ? l8i : l16i;
#pragma unroll
                for (int i = 0; i < (16 >> lv); ++i) {
                    const int e = DIR == 0 ? 2 * i : 2 * i + 1, l = DIR == 0 ? 2 * i + 1 : 2 * i;
                    const float er = xr[e << lv], ei = xi[e << lv], lr_ = xr[l << lv], li_ = xi[l << lv];
                    const float wr = fmaf(pr, er, fmaf(-pi, ei, lr_)), wi = fmaf(pr, ei, fmaf(pi, er, li_));
                    xr[(2 * i) << lv] = wr; xi[(2 * i) << lv] = wi;
                }
            }
            { const float nr = fmaf(l32r, hr, fmaf(-l32i, hi, xr[0])), ni = fmaf(l32r, hi, fmaf(l32i, hr, xi[0])); hr = nr; hi = ni; }
        } else {
#pragma unroll
        for (int tt = 0; tt < 32; ++tt) {
            const int t = DIR == 0 ? tt : 31 - tt;
            const float tr_ = fmaf(-ai, hi, xr[t]), ti_ = fmaf(ai, hr, xi[t]);
            hr = fmaf(ar, hr, tr_); hi = fmaf(ar, hi, ti_);
            *(LAS unsigned*)(hl + t * S5_HST + 4 * lane) = pk2(hr, hi);
        }
        }
        if (PASS == 2) {
#pragma unroll
            for (int sub = 0; sub < 2; ++sub) {
                float* ys = yscr + (size_t)(tile * 2 + sub) * 256 + 4 * lane;
                f32x4 y = {0.f, 0.f, 0.f, 0.f};
                if (DIR == 1) y = ysv[sub];
#pragma unroll
                for (int ks = 0; ks < 4; ++ks) { const bf16x8 hf = *(const LAS bf16x8*)(hl + (sub * 16 + (lane & 15)) * S5_HST + 64 * ks + 16 * (lane >> 4)); y = MFMA16(hf, cf[ks], y); }
                if (DIR == 0) *(f32x4*)ys = y;
                else {
                    const bf16x8 uf = *(const LAS bf16x8*)(ul + (tile * 32 + sub * 16 + (lane & 15)) * S5_UST + (g & 7) * 32 + 16 * ((lane >> 4) & 1));
                    y = MFMA16(uf, dfrag, y);
                    bf16* yo = (bf16*)(ws + WS_YG) + (rowbase + tile * 32 + sub * 16 + 4 * (lane >> 4)) * 512 + g * 16 + (lane & 15);
#pragma unroll
                    for (int r = 0; r < 4; ++r) yo[(size_t)r * 512] = (bf16)f2bf(gelu_tanh(y[r]));
                }
            }
        }
    }
    if (PASS == 1) { f32x2 e; e.x = hr; e.y = hi; *(f32x2*)(Ec + (size_t)c * 128) = e; }
}
template <int PASS>
__device__ __forceinline__ void s5_phase(unsigned char* ws, const float* s5d, LAS unsigned char* lds, int bid, int G, int tid, int wave, int lane) {
    LAS unsigned char* hl = lds + wave * (32 * S5_HST); LAS unsigned char* ul = lds + S5_UOFF;
    float* yscr = (float*)(ws + WS_YSCR) + (size_t)(bid * NWAVES + wave) * 4096;
    const bf16* h0 = (const bf16*)(ws + WS_H0);
    for (int it = bid; it < NB * S5NCH * 4; it += G) {
        const int go = it & 3, c = (it >> 2) % S5NCH, b = it / (4 * S5NCH), g = go * 8 + wave;
        { const bf16* src = h0 + ((size_t)b * SEQ + (size_t)c * S5CH) * H0P + OFF_U + go * 128;
          u32x4 v[8];
#pragma unroll
          for (int i = 0; i < 8; ++i) { const int p = i * NTHR + tid; v[i] = *(const u32x4*)(src + (size_t)(p >> 4) * H0P + 8 * (p & 15)); }
          __syncthreads();
#pragma unroll
          for (int i = 0; i < 8; ++i) { const int p = i * NTHR + tid; *(LAS u32x4*)(ul + (p >> 4) * S5_UST + 16 * (p & 15)) = v[i]; }
          __syncthreads(); }
        s5_dir<PASS, 0>(ws, s5d, b, g, c, hl, ul, yscr, lane);
        s5_dir<PASS, 1>(ws, s5d, b, g, c, hl, ul, yscr, lane);
    }
}
constexpr int G_ST = 144;
constexpr int GL_QD = 0, GL_KD = GL_QD + 64 * G_ST, GL_KCT = GL_KD + 64 * G_ST, GL_VT = GL_KCT + 64 * G_ST,
              GL_S = GL_VT + 128 * G_ST, GL_ST = GL_S + 64 * G_ST, GL_END = GL_ST + 2 * 128 * G_ST;
static_assert(GL_END <= RING_BYTES, "GLA LDS");
__device__ __forceinline__ bf16x8 ldfrag32(const LAS unsigned char* base, int row0, int ks, int lane) {
    return *(const LAS bf16x8*)(base + (row0 + (lane & 31)) * G_ST + 32 * ks + 16 * (lane >> 5));
}
__device__ __forceinline__ void gate_tail(float* bcg, const float* gate_w, const float* gate_b, const LAS float* lrs, size_t row0, int tid) {
    const int dir = tid >> 8;
    float gw[16];
#pragma unroll
    for (int r = 0; r < 16; ++r) gw[r] = gate_w[(size_t)(dir * 16 + r) * 256 + (tid & 255)];
    const float gb = gate_b[tid];
    float run = 0.f;
#pragma unroll 4
    for (int i = 0; i < 128; ++i) {
        const int t = dir ? 127 - i : i;
        if ((i & 63) == 0) run = 0.f;
        const LAS f32x4* lp = (const LAS f32x4*)(lrs + t * 32 + dir * 16);
        const f32x4 l0 = lp[0], l1 = lp[1], l2 = lp[2], l3 = lp[3];
        float z = gb + l0.x * gw[0] + l0.y * gw[1] + l0.z * gw[2] + l0.w * gw[3] + l1.x * gw[4] + l1.y * gw[5] + l1.z * gw[6] + l1.w * gw[7]
                     + l2.x * gw[8] + l2.y * gw[9] + l2.z * gw[10] + l2.w * gw[11] + l3.x * gw[12] + l3.y * gw[13] + l3.z * gw[14] + l3.w * gw[15];
        const float ls = fminf(z, 0.f) - __logf(1.f + __expf(-fabsf(z)));
        run += ls * (1.0f / 16.0f);
        bcg[(row0 + t) * 512 + tid] = run;
    }
}
__device__ __forceinline__ size_t gla_tok(int b, int dir, int chunk, int s) { const int pos = chunk * GCH + s; return (size_t)b * SEQ + (dir ? (SEQ - 1 - pos) : pos); }
template <int PASS>
__device__ __forceinline__ void gla_item(unsigned char* ws, const float* bcg, int item, LAS unsigned char* lds, int tid, int wave, int lane) {
    const int sc = item % GNSC, dir = (item / GNSC) & 1, h = (item / (GNSC * 2)) & 3, b = item / (GNSC * 8);
    const bf16* h0 = (const bf16*)(ws + WS_H0);
    LAS unsigned char* QD = lds + GL_QD; LAS unsigned char* KD = lds + GL_KD; LAS unsigned char* KCT = lds + GL_KCT; LAS unsigned char* VT = lds + GL_VT; LAS unsigned char* SS = lds + GL_S; LAS unsigned char* STT = lds + GL_ST;
    const int me = wave >> 1, nd = wave & 1;
    f32x16 st;
#pragma unroll
    for (int r = 0; r < 16; ++r) st[r] = 0.f;
    float dtot = 1.f;
    float* GS = (float*)(ws + WS_GS); float* GD = (float*)(ws + WS_GD);
    const int ibase = item - sc;
    if (PASS == 2) {
        for (int j = 0; j < sc; ++j) {
            const float dj = GD[(size_t)(ibase + j) * 64 + nd * 32 + (lane & 31)];
            const float* gs = GS + (size_t)(ibase + j) * 8192 + nd * 32 + (lane & 31);
#pragma unroll
            for (int r = 0; r < 16; ++r) st[r] = st[r] * dj + gs[(size_t)(me * 32 + crow(r, lane >> 5)) * 64];
        }
#pragma unroll
        for (int r = 0; r < 16; ++r) *(LAS bf16*)(STT + (me * 32 + crow(r, lane >> 5)) * G_ST + (nd * 32 + (lane & 31)) * 2) = (bf16)f2bf(st[r]);
    }
    const float qscale = 0.125f;
    const int s_l = lane;
    const int gcol = dir * 256 + h * 64;
    u32x4 pq, pk, pv0, pv1; f32x4 pb0, pb1, pl0, pl1; float pdec;
#define GLA_LOAD(n) do { const int ch_ = sc * GSC + (n); const size_t tk = gla_tok(b, dir, ch_, s_l), tl = gla_tok(b, dir, ch_, 63); const bf16* rp = h0 + tk * H0P; \
        if (PASS == 2) pq = *(const u32x4*)(rp + OFF_Q + h * 64 + 8 * wave); \
        pk = *(const u32x4*)(rp + OFF_K + h * 64 + 8 * wave); pv0 = *(const u32x4*)(rp + OFF_V + h * 128 + 16 * wave); pv1 = *(const u32x4*)(rp + OFF_V + h * 128 + 16 * wave + 8); \
        pb0 = *(const f32x4*)(bcg + tk * 512 + gcol + 8 * wave); pb1 = *(const f32x4*)(bcg + tk * 512 + gcol + 8 * wave + 4); \
        pl0 = *(const f32x4*)(bcg + tl * 512 + gcol + 8 * wave); pl1 = *(const f32x4*)(bcg + tl * 512 + gcol + 8 * wave + 4); \
        pdec = bcg[tl * 512 + gcol + nd * 32 + (lane & 31)]; } while (0)
    GLA_LOAD(0);
    __syncthreads();
#pragma unroll 1
    for (int n = 0; n < GSC; ++n) {
        LAS unsigned char* STc = STT + (n & 1) * (128 * G_ST); LAS unsigned char* STn = STT + ((n + 1) & 1) * (128 * G_ST);
        { const float bc[8] = {pb0.x, pb0.y, pb0.z, pb0.w, pb1.x, pb1.y, pb1.z, pb1.w}, bl[8] = {pl0.x, pl0.y, pl0.z, pl0.w, pl1.x, pl1.y, pl1.z, pl1.w};
          const float kv[8] = {bflo(pk.x), bfhi(pk.x), bflo(pk.y), bfhi(pk.y), bflo(pk.z), bfhi(pk.z), bflo(pk.w), bfhi(pk.w)};
          if (PASS == 2) {
              const float qv[8] = {bflo(pq.x), bfhi(pq.x), bflo(pq.y), bfhi(pq.y), bflo(pq.z), bfhi(pq.z), bflo(pq.w), bfhi(pq.w)};
              float qd[8], kd[8];
#pragma unroll
              for (int i = 0; i < 8; ++i) { qd[i] = qv[i] * qscale * __expf(bc[i]); kd[i] = kv[i] * __expf(-bc[i]); }
              u32x4 w; w.x = pk2(qd[0], qd[1]); w.y = pk2(qd[2], qd[3]); w.z = pk2(qd[4], qd[5]); w.w = pk2(qd[6], qd[7]);
              *(LAS u32x4*)(QD + s_l * G_ST + 16 * wave) = w;
              w.x = pk2(kd[0], kd[1]); w.y = pk2(kd[2], kd[3]); w.z = pk2(kd[4], kd[5]); w.w = pk2(kd[6], kd[7]);
              *(LAS u32x4*)(KD + s_l * G_ST + 16 * wave) = w;
          }
#pragma unroll
          for (int i = 0; i < 8; ++i) *(LAS bf16*)(KCT + (8 * wave + i) * G_ST + 2 * s_l) = (bf16)f2bf(kv[i] * __expf(bl[i] - bc[i]));
          const unsigned vv[8] = {pv0.x, pv0.y, pv0.z, pv0.w, pv1.x, pv1.y, pv1.z, pv1.w};
#pragma unroll
          for (int i = 0; i < 8; ++i) { *(LAS bf16*)(VT + (16 * wave + 2 * i) * G_ST + 2 * s_l) = (bf16)(vv[i] & 0xffffu); *(LAS bf16*)(VT + (16 * wave + 2 * i + 1) * G_ST + 2 * s_l) = (bf16)(vv[i] >> 16); }
        }
        const float dec = __expf(pdec);
        if (n + 1 < GSC) GLA_LOAD(n + 1);
        LDS_BARRIER();
        if (PASS == 2 && wave < 4) {
            const int ms = wave >> 1, ns = wave & 1;
            f32x16 sa;
#pragma unroll
            for (int r = 0; r < 16; ++r) sa[r] = 0.f;
            if (ns <= ms) {
#pragma unroll
                for (int ks = 0; ks < 4; ++ks) sa = MFMA32(ldfrag32(QD, ms * 32, ks, lane), ldfrag32(KD, ns * 32, ks, lane), sa);
            }
#pragma unroll
            for (int r = 0; r < 16; ++r) { const int s = ms * 32 + crow(r, lane >> 5), s2 = ns * 32 + (lane & 31);
                const bool keep = dir ? (s2 < s) : (s2 <= s);
                *(LAS bf16*)(SS + s * G_ST + 2 * s2) = (bf16)f2bf(keep ? sa[r] : 0.f); }
        }
#pragma unroll
        for (int r = 0; r < 16; ++r) st[r] *= dec;
        dtot *= dec;
#pragma unroll
        for (int ks = 0; ks < 4; ++ks) st = MFMA32(ldfrag32(VT, me * 32, ks, lane), ldfrag32(KCT, nd * 32, ks, lane), st);
        if (PASS == 2 && n + 1 < GSC) {
#pragma unroll
            for (int r = 0; r < 16; ++r) *(LAS bf16*)(STn + (me * 32 + crow(r, lane >> 5)) * G_ST + (nd * 32 + (lane & 31)) * 2) = (bf16)f2bf(st[r]);
        }
        LDS_BARRIER();
        if (PASS == 2) {
            const int ms = wave >> 2, ne = wave & 3;
            f32x16 oa;
#pragma unroll
            for (int r = 0; r < 16; ++r) oa[r] = 0.f;
#pragma unroll
            for (int ks = 0; ks < 4; ++ks) oa = MFMA32(ldfrag32(SS, ms * 32, ks, lane), ldfrag32(VT, ne * 32, ks, lane), oa);
#pragma unroll
            for (int ks = 0; ks < 4; ++ks) oa = MFMA32(ldfrag32(QD, ms * 32, ks, lane), ldfrag32(STc, ne * 32, ks, lane), oa);
            bf16* op = (bf16*)(ws + (dir ? WS_OB : WS_OF)) + h * 128 + ne * 32 + (lane & 31);
#pragma unroll
            for (int r = 0; r < 16; ++r) op[gla_tok(b, dir, sc * GSC + n, ms * 32 + crow(r, lane >> 5)) * 512] = (bf16)f2bf(oa[r]);
            LDS_BARRIER();
        }
    }
    if (PASS == 1) {
        float* gs = GS + (size_t)item * 8192 + nd * 32 + (lane & 31);
#pragma unroll
        for (int r = 0; r < 16; ++r) gs[(size_t)(me * 32 + crow(r, lane >> 5)) * 64] = st[r];
        if (me == 0 && lane < 32) GD[(size_t)item * 64 + nd * 32 + lane] = dtot;
    }
    __syncthreads();
#undef GLA_LOAD
}
constexpr int AT_KST = 144, AT_VST = 664, AT_K = 0, AT_V = 320 * AT_KST, AT_BT = AT_V + 64 * AT_VST, AT_END = AT_BT + 4 * 260 * 4;
static_assert(AT_END <= RING_BYTES && AT_V % 16 == 0 && AT_BT % 16 == 0, "attention LDS");
__device__ __forceinline__ void attn_phase(unsigned char* ws, const float* sink, LAS unsigned char* lds, int bid, int G, int tid, int wave, int lane) {
    const bf16* qkv = (const bf16*)(ws + WS_QKV); bf16* ao = (bf16*)(ws + WS_AO); const float* btab = (const float*)(ws + WS_BTAB);
    LAS unsigned char* KS = lds + AT_K; LAS unsigned char* VT = lds + AT_V; LAS float* BT = (LAS float*)(lds + AT_BT);
    const float sc2 = 0.125f * LOG2E;
    u32x4 kreg[5], vreg[5];
#define AT_LOAD(u_) do { const int qb_ = (u_) % (SEQ / 64), kvh_ = ((u_) / (SEQ / 64)) & 3, b_ = (u_) / (4 * (SEQ / 64)), kb_ = qb_ * 64 - 128; \
        _Pragma("unroll") for (int it = 0; it < 5; ++it) { const int p = it * NTHR + tid; int key = kb_ + (p >> 3); key = key < 0 ? 0 : (key > SEQ - 1 ? SEQ - 1 : key); \
            const bf16* rp = qkv + ((size_t)b_ * SEQ + key) * CN + kvh_ * 64 + 8 * (p & 7); kreg[it] = *(const u32x4*)(rp + 1024); vreg[it] = *(const u32x4*)(rp + 1280); } } while (0)
    if (bid < NB * 4 * (SEQ / 64)) AT_LOAD(bid);
    for (int u = bid; u < NB * 4 * (SEQ / 64); u += G) {
        const int qb = u % (SEQ / 64), kvh = (u / (SEQ / 64)) & 3, b = u / (4 * (SEQ / 64)), q0 = qb * 64;
#pragma unroll
        for (int it = 0; it < 5; ++it) { const int p = it * NTHR + tid, i = p >> 3, ch = p & 7;
            *(LAS u32x4*)(KS + i * AT_KST + 16 * ch) = kreg[it];
            const unsigned vv[4] = {vreg[it].x, vreg[it].y, vreg[it].z, vreg[it].w};
#pragma unroll
            for (int j = 0; j < 4; ++j) { *(LAS bf16*)(VT + (8 * ch + 2 * j) * AT_VST + 2 * i) = (bf16)(vv[j] & 0xffffu); *(LAS bf16*)(VT + (8 * ch + 2 * j + 1) * AT_VST + 2 * i) = (bf16)(vv[j] >> 16); } }
        for (int p = tid; p < 4 * 260; p += NTHR) BT[p] = btab[(kvh * 4) * 260 + p];
        if (u + G < NB * 4 * (SEQ / 64)) AT_LOAD(u + G);
        LDS_BARRIER();
        const int hl = wave >> 1, hq = kvh * 4 + hl, qw = q0 + 32 * (wave & 1), qi = qw + (lane & 31), hh = lane >> 5;
        bf16x8 qf[4];
        { const bf16* qp = qkv + ((size_t)b * SEQ + qi) * CN + hq * 64 + 8 * hh;
#pragma unroll
          for (int ks = 0; ks < 4; ++ks) qf[ks] = *(const bf16x8*)(qp + 16 * ks); }
        float m = sink[hq] * LOG2E, l = hh == 0 ? 1.f : 0.f;
        f32x16 o0, o1;
#pragma unroll
        for (int r = 0; r < 16; ++r) { o0[r] = 0.f; o1[r] = 0.f; }
        const LAS float* btr = BT + hl * 260 + 128 - (lane & 31);
#pragma unroll 1
        for (int j = 0; j < 9; ++j) {
            const int i0 = 32 * (wave & 1) + 32 * j;
            f32x16 sa;
#pragma unroll
            for (int r = 0; r < 16; ++r) sa[r] = 0.f;
#pragma unroll
            for (int ks = 0; ks < 4; ++ks) { const bf16x8 kf = *(const LAS bf16x8*)(KS + (i0 + (lane & 31)) * AT_KST + 32 * ks + 16 * hh); sa = MFMA32(kf, qf[ks], sa); }
            float mx = -3.0e38f;
#pragma unroll
            for (int r = 0; r < 16; ++r) {
                const int kk = 32 * j - 128 + crow(r, hh);
                const int rel = kk - (lane & 31), key = qw + kk;
                const bool ok = ((unsigned)(rel + 128) <= 256u) && ((unsigned)key < (unsigned)SEQ);
                const float s = ok ? (sa[r] * sc2 + btr[kk]) : -3.0e38f;
                sa[r] = s; mx = fmaxf(mx, s);
            }
            mx = fmaxf(mx, __shfl_xor(mx, 32));
            if (!__all(mx <= m)) {
                const float mn = fmaxf(m, mx), alpha = __builtin_amdgcn_exp2f(m - mn); m = mn; l *= alpha;
#pragma unroll
                for (int r = 0; r < 16; ++r) { o0[r] *= alpha; o1[r] *= alpha; }
            }
            float ps = 0.f;
#pragma unroll
            for (int r = 0; r < 16; ++r) { const float p = __builtin_amdgcn_exp2f(sa[r] - m); sa[r] = p; ps += p; }
            l += ps;
#pragma unroll
            for (int s = 0; s < 2; ++s) {
                u32x4 pw; pw.x = pk2(sa[8 * s], sa[8 * s + 1]); pw.y = pk2(sa[8 * s + 2], sa[8 * s + 3]); pw.z = pk2(sa[8 * s + 4], sa[8 * s + 5]); pw.w = pk2(sa[8 * s + 6], sa[8 * s + 7]);
                const bf16x8 pf = __builtin_bit_cast(bf16x8, pw);
#pragma unroll
                for (int dt = 0; dt < 2; ++dt) {
                    const LAS unsigned char* vp = VT + (dt * 32 + (lane & 31)) * AT_VST + 2 * (i0 + 16 * s + 4 * hh);
                    const bf16x4 va = *(const LAS bf16x4*)vp, vb = *(const LAS bf16x4*)(vp + 16);
                    const bf16x8 vf = __builtin_shufflevector(va, vb, 0, 1, 2, 3, 4, 5, 6, 7);
                    if (dt == 0) o0 = MFMA32(vf, pf, o0); else o1 = MFMA32(vf, pf, o1);
                }
            }
        }
        l += __shfl_xor(l, 32);
        const float inv = 1.f / l;
        bf16* op = ao + ((size_t)b * SEQ + qi) * D + hq * 64 + 4 * hh;
#pragma unroll
        for (int g = 0; g < 4; ++g) {
            u32x2 w0, w1; w0.x = pk2(o0[4 * g] * inv, o0[4 * g + 1] * inv); w0.y = pk2(o0[4 * g + 2] * inv, o0[4 * g + 3] * inv);
            w1.x = pk2(o1[4 * g] * inv, o1[4 * g + 1] * inv); w1.y = pk2(o1[4 * g + 2] * inv, o1[4 * g + 3] * inv);
            *(u32x2*)(op + 8 * g) = w0; *(u32x2*)(op + 32 + 8 * g) = w1;
        }
        LDS_BARRIER();
    }
#undef AT_LOAD
}
#ifndef MK_N_LAUNCHES
#define MK_N_LAUNCHES 1
#endif
constexpr int N_PHASES = 19;
#ifndef PH_MASK
#define PH_MASK 0xFFFFFFFFu
#endif
#define ON(k) (((PH_MASK) >> (k)) & 1u)
#ifndef REP_MASK
#define REP_MASK 0u
#endif
#define NREP(k) ((((REP_MASK) >> (k)) & 1u) ? 2 : 1)

template <int LAYER>
__device__ __forceinline__ void common_phases(unsigned char* ws, LAS unsigned char* lds, float* dout, const XcdBarrier& bar, int lo, int hi, int bid, int G, int tid, int wave, int lane) {
    constexpr int pb = LAYER == 0 ? 5 : 13;
    const int gw = bid * NWAVES + wave, NGW = G * NWAVES;
#define IN(k) (lo <= (k) && (k) < hi)
#define SEAM(k) do { if (IN(k) && IN((k) + 1)) xcd_barrier(bar); } while (0)
    if (ON(5) && IN(pb)) {
        pg8::Gemm g{(const bf16*)(ws + (LAYER == 0 ? WS_X64 : WS_AO)), (const bf16*)(ws + (LAYER == 0 ? WS_WOUT : WS_COUT)), T, D, D, 0, nullptr}; pg8::StaticOrder S; S.init(T, D, G, bid);
        pg8::EpiBf16 E{(bf16*)(ws + WS_Z), D};
        pg8::gemm_phase<pg8::EpiBf16, pg8::StaticOrder, false>(lds, g, S, E);
    }
    SEAM(pb);
    if (ON(6) && IN(pb + 1)) { ln_router(ws, LAYER == 0 ? inp(lds, I_X) : (const float*)(ws + WS_H1), inp(lds, I_LNMG) + LAYER * D, inp(lds, I_LNMB) + LAYER * D, inp(lds, I_BGRP) + LAYER * 4, inp(lds, I_BRT) + LAYER * 32, LAYER, lds, bid, G, tid, wave, lane); __syncthreads(); }
    SEAM(pb + 1);
    if (ON(7) && IN(pb + 2)) { moe_sort(ws, lds, bid, G, tid); __syncthreads(); }
    SEAM(pb + 2);
    if (ON(8) && IN(pb + 3)) {
        const int* tile = (const int*)(ws + WS_TILE); const int ntiles = __builtin_amdgcn_readfirstlane(tile[511]);
        pg8::Gemm g{(const bf16*)(ws + WS_X64), LAYER == 0 ? (const bf16*)(ws + WS_W13) : (const bf16*)dout, 0, D, D, (size_t)D * D * 2, (const int*)(ws + WS_SLOTT)};
        pg8::GroupOrder S{tile, ntiles, D / 256, G, bid};
        pg8::EpiSwiglu E{(bf16*)(ws + WS_HID), DEXP};
        pg8::gemm_phase<pg8::EpiSwiglu, pg8::GroupOrder, true>(lds, g, S, E);
        if (LAYER == 0) idle_convert(0, ws, lds, dout, ntiles, bid, G, wave, lane);
    }
    SEAM(pb + 3);
    if (ON(9) && IN(pb + 4)) {
        const int* tile = (const int*)(ws + WS_TILE); const int ntiles = __builtin_amdgcn_readfirstlane(tile[511]);
        pg8::Gemm g{(const bf16*)(ws + WS_HID), LAYER == 0 ? (const bf16*)(ws + WS_W2) : (const bf16*)dout + (size_t)NEXP * D * D, 0, D, DEXP, (size_t)D * DEXP * 2, nullptr};
        pg8::GroupOrder S{tile, ntiles, D / 256, G, bid};
        pg8::EpiScale E{(bf16*)(ws + WS_Y2), D, (const float*)(ws + WS_SLOTW)};
        pg8::gemm_phase<pg8::EpiScale, pg8::GroupOrder, false>(lds, g, S, E);
        if (LAYER == 0) idle_convert(1, ws, lds, dout, ntiles, bid, G, wave, lane);
    }
    SEAM(pb + 4);
    if (ON(10) && IN(pb + 5)) {
        if (LAYER == 0) {
            combine_ln<false>(ws, inp(lds, I_LNFG), inp(lds, I_LNFB), nullptr, gw, NGW, lane);
            { const int done = idle_done(__builtin_amdgcn_readfirstlane(((const int*)(ws + WS_TILE))[511]), G);
              moe_convert(inp(lds, I_W1) + (size_t)NEXP * D * DEXP, inp(lds, I_W3) + (size_t)NEXP * D * DEXP, inp(lds, I_W2) + (size_t)NEXP * DEXP * D, (bf16*)dout, (bf16*)dout + (size_t)NEXP * D * D, (LAS float*)(lds + wave * 16384), done, MOE_ITEMS, gw, NGW, lane); }
            __syncthreads();
        } else combine_ln<true>(ws, inp(lds, I_LNFG) + D, inp(lds, I_LNFB) + D, dout, gw, NGW, lane);
    }
    if (LAYER == 0) SEAM(10);
#undef IN
#undef SEAM
}

struct Args { const float* in[N_IN]; float* out; unsigned char* ws; int ph_lo, ph_hi; };
static_assert(sizeof(Args) == N_IN * 8 + 8 + 8 + 8, "no padding holes in Args");

__global__ void __launch_bounds__(NTHR, 2) fwd_kernel(Args args) {
    extern __shared__ __attribute__((aligned(16))) unsigned char lds_raw[];
    LAS unsigned char* lds = (LAS unsigned char*)lds_raw;
    volatile LAS unsigned* MISC = (volatile LAS unsigned*)(lds + MISC_OFF);
    const int tid = threadIdx.x, lane = tid & 63, wave = __builtin_amdgcn_readfirstlane(tid >> 6), G = gridDim.x, bid = blockIdx.x;
    unsigned char* ws = args.ws;
    for (int u = tid; u < 64; u += NTHR) MISC[u] = 0u;
    if (tid < N_IN) *(LAS unsigned long long*)(lds + PTR_OFF + 8 * tid) = (unsigned long long)args.in[tid];
    __syncthreads();
    const int lo = args.ph_lo, hi = args.ph_hi;
    const bool use_bar = (hi - lo) > 1;
    XcdBarrier bar; bar.bar = (unsigned*)(ws + WS_CTL) + CW_BAR; bar.x = 0; bar.st = nullptr;
    if (use_bar) bar = xcd_barrier_post((unsigned*)(ws + WS_CTL) + CW_BAR, MISC + 8);
#define IN(k) (lo <= (k) && (k) < hi)
#define SEAM(k) do { if (IN(k) && IN((k) + 1)) xcd_barrier(bar); } while (0)
    const int gw = bid * NWAVES + wave, NGW = G * NWAVES;

    if (ON(0) && IN(0)) { p0_prologue(ws, lds, bid, G, tid, wave, lane); __syncthreads(); }
    SEAM(0);
    if (ON(1) && IN(1)) {
        pg8::Gemm g{(const bf16*)(ws + WS_X64), (const bf16*)(ws + WS_WIN), T, ABN, D, 0, nullptr}; pg8::SplitOrder S; S.init(T, ABN, 2, G, bid);
        pg8::EpiBf16 E{(bf16*)(ws + WS_H0), H0P};
        pg8::gemm_phase<pg8::EpiBf16, pg8::SplitOrder, false>(lds, g, S, E);
        lr_tail(ws, args.out, inp(lds, I_GATEW), inp(lds, I_GATEB), lds, bid, G, tid, wave, lane);
#ifdef TAIL_TWICE
        lr_tail(ws, args.out, inp(lds, I_GATEW), inp(lds, I_GATEB), lds, bid, G, tid, wave, lane);
#endif
    }
    SEAM(1);
    if (ON(2) && IN(2)) {
        s5_phase<1>(ws, inp(lds, I_S5D), lds, bid, G, tid, wave, lane);
#ifdef S5_TWICE
        __syncthreads(); s5_phase<1>(ws, inp(lds, I_S5D), lds, bid, G, tid, wave, lane);
#endif
        __syncthreads();
        for (int it = bid; it < 256; it += G) gla_item<1>(ws, args.out, it, lds, tid, wave, lane);
#ifdef GLA_TWICE
        for (int it = bid; it < 256; it += G) gla_item<1>(ws, args.out, it, lds, tid, wave, lane);
#endif
    }
    SEAM(2);
    if (ON(3) && IN(3)) {
        s5_phase<2>(ws, inp(lds, I_S5D), lds, bid, G, tid, wave, lane);
#ifdef S5_TWICE
        __syncthreads(); s5_phase<2>(ws, inp(lds, I_S5D), lds, bid, G, tid, wave, lane);
#endif
        __syncthreads();
        for (int it = bid; it < 256; it += G) gla_item<2>(ws, args.out, it, lds, tid, wave, lane);
#ifdef GLA_TWICE
        for (int it = bid; it < 256; it += G) gla_item<2>(ws, args.out, it, lds, tid, wave, lane);
#endif
    }
    SEAM(3);
    if (ON(4) && IN(4)) {
        gla_finalize(ws, inp(lds, I_NORMG), gw, NGW, lane);
        pg8::Gemm g{(const bf16*)(ws + WS_YG), (const bf16*)(ws + WS_WGLU), T, 512, 512, 0, nullptr}; pg8::StaticOrder S; S.init(T, 512, G, bid);
        pg8::EpiGlu E{(const bf16*)(ws + WS_YG), 512, (bf16*)(ws + WS_X64), D, inp(lds, I_GLUB)};
        pg8::gemm_phase<pg8::EpiGlu, pg8::StaticOrder, false>(lds, g, S, E);
    }
    SEAM(4);
    common_phases<0>(ws, lds, args.out, bar, lo, hi, bid, G, tid, wave, lane);
    if (ON(11) && IN(11)) {
        pg8::Gemm g{(const bf16*)(ws + WS_H2B), (const bf16*)(ws + WS_CIN), T, CN, D, 0, nullptr}; pg8::StaticOrder S; S.init(T, CN, G, bid);
        pg8::EpiBf16 E{(bf16*)(ws + WS_QKV), CN};
        pg8::gemm_phase<pg8::EpiBf16, pg8::StaticOrder, false>(lds, g, S, E);
    }
    SEAM(11);
    if (ON(12) && IN(12)) attn_phase(ws, inp(lds, I_SINK), lds, bid, G, tid, wave, lane);
    SEAM(12);
    common_phases<1>(ws, lds, args.out, bar, lo, hi, bid, G, tid, wave, lane);
#undef IN
#undef SEAM
}

extern "C" void kernel_launch(void* const* d_in, const int* in_sizes, int n_in, void* d_out, int out_size, void* d_ws, size_t ws_size, hipStream_t stream) {
    static int grid = 0;
    if (grid == 0) {
        if (n_in != N_IN || in_sizes[0] != T * D || out_size != T * D || ws_size < WS_END) { fprintf(stderr, "kernel_launch: unexpected shapes (n_in %d, in0 %d, out %d, ws %zu < %zu)\n", n_in, n_in > 0 ? in_sizes[0] : -1, out_size, ws_size, (size_t)WS_END); grid = -1; return; }
        int dev = 0, cus = 0, per_cu = 0;
        if (hipGetDevice(&dev) != hipSuccess || hipDeviceGetAttribute(&cus, hipDeviceAttributeMultiprocessorCount, dev) != hipSuccess) { grid = -1; return; }
        if (hipFuncSetAttribute((const void*)fwd_kernel, hipFuncAttributeMaxDynamicSharedMemorySize, LDS_BYTES) != hipSuccess) { fprintf(stderr, "kernel_launch: hipFuncSetAttribute failed\n"); grid = -1; return; }
        if (hipOccupancyMaxActiveBlocksPerMultiprocessor(&per_cu, (const void*)fwd_kernel, NTHR, LDS_BYTES) != hipSuccess || per_cu < 1) fprintf(stderr, "kernel_launch: occupancy query reports %d\n", per_cu);
        (void)hipGetLastError();
        grid = cus;
    }
    if (grid < 0) return;
    if (hipMemsetAsync((char*)d_ws + WS_CTL, 0, CTL_ZERO_BYTES, stream) != hipSuccess) return;
    Args a{};
    for (int i = 0; i < N_IN; ++i) a.in[i] = (const float*)d_in[i];
    a.out = (float*)d_out; a.ws = (unsigned char*)d_ws;
    for (int li = 0; li < MK_N_LAUNCHES; ++li) {
        a.ph_lo = (MK_N_LAUNCHES == 1) ? 0 : li; a.ph_hi = (MK_N_LAUNCHES == 1) ? N_PHASES : li + 1;
        for (int rep = 0; rep < ((MK_N_LAUNCHES > 1 && ((REP_MASK >> li) & 1u)) ? 2 : 1); ++rep)
            hipLaunchKernelGGL(fwd_kernel, dim3(grid), dim3(NTHR), LDS_BYTES, stream, a);
    }
}
```

```cpp
#include <hip/hip_runtime.h>
#include <cstdio>
#include <cstdint>
#include <cmath>
namespace pg8 {
#define PG8_LAS __attribute__((address_space(3)))
typedef unsigned short bf16_t;
typedef short bf16x8 __attribute__((ext_vector_type(8)));
typedef float f32x4 __attribute__((ext_vector_type(4)));
typedef float f32x2 __attribute__((ext_vector_type(2)));
typedef unsigned u32x4 __attribute__((ext_vector_type(4)));
typedef unsigned u32x2 __attribute__((ext_vector_type(2)));
constexpr int BM = 256, BK = 64, HALF = 128, HTB = HALF * BK * 2  , STAGE_BYTES = 8 * HTB, NXCD = 8, WGM = 8;

__host__ __device__ __forceinline__ int lds_byte(int r, int c) { const int st = (r >> 4) * 2 + (c >> 5), rr = r & 15, cc = c & 31, ob = rr * 64 + cc * 2; return st * 1024 + (ob ^ (((ob >> 9) & 1) << 5)); }
__host__ __device__ __forceinline__ void stage_rc(int b, int& R, int& C) { const int st = b / 1024, sb = b % 1024, swz = sb ^ (((sb >> 9) & 1) << 5); R = (st >> 1) * 16 + swz / 64; C = (st & 1) * 32 + (swz % 64) / 2; }
__host__ __device__ __forceinline__ int perm32(int rho) { const int n = rho >> 4, i = rho & 15; return 8 * (i >> 2) + 4 * n + (i & 3); }

struct Unit { int pm, pn, e; };
struct Gemm { const bf16_t* A; const bf16_t* Bt; int M, N, K; size_t bstride; const int* rowmap; };

struct StaticOrder {
    int nM, nN, nwg, G, c;
    __host__ __device__ void init(int M, int N, int G_, int c_) { nM = M / BM; nN = N / BM; nwg = nM * nN; G = G_; c = c_; }
    __host__ __device__ bool next(int i, Unit& u) const {
        const long L = (long)i * G + c; if (L >= nwg) return false;
        int wgid = (int)L; { const int q = nwg / NXCD, r = nwg % NXCD, xcd = wgid % NXCD, off = wgid / NXCD; wgid = (xcd < r ? xcd * (q + 1) : r * (q + 1) + (xcd - r) * q) + off; }
        const int nig = WGM * nN, gid = wgid / nig, fm = gid * WGM, gsz = (nM - fm) < WGM ? (nM - fm) : WGM;
        u.pm = fm + ((wgid % nig) % gsz); u.pn = (wgid % nig) / gsz; u.e = 0; return true;
    }
};
struct SplitOrder {
    int nM, nNs, nwgs, nsp, G, c;
    __host__ __device__ void init(int M, int N, int nsp_, int G_, int c_) { nM = M / BM; nNs = N / BM / nsp_; nwgs = nM * nNs; nsp = nsp_; G = G_; c = c_; }
    __host__ __device__ bool next(int i, Unit& u) const {
        const long L = (long)i * G + c; if (L >= (long)nwgs * nsp) return false;
        const int slab = (int)(L / nwgs); int wgid = (int)(L % nwgs);
        { const int q = nwgs / NXCD, r = nwgs % NXCD, xcd = wgid % NXCD, off = wgid / NXCD; wgid = (xcd < r ? xcd * (q + 1) : r * (q + 1) + (xcd - r) * q) + off; }
        const int nig = WGM * nNs, gid = wgid / nig, fm = gid * WGM, gsz = (nM - fm) < WGM ? (nM - fm) : WGM;
        u.pm = fm + ((wgid % nig) % gsz); u.pn = slab * nNs + (wgid % nig) / gsz; u.e = 0; return true;
    }
};
struct GroupOrder {
    const int* tile_e; int ntiles, nN, G, c;
    __device__ bool next(int i, Unit& u) const {
        const int L = i * G + c; if (L >= ntiles * nN) return false;
        u.pm = L / nN; u.pn = L % nN; u.e = __builtin_amdgcn_readfirstlane(tile_e[u.pm]); return true;
    }
};

typedef __bf16 bf16x2_t __attribute__((ext_vector_type(2)));
__device__ __forceinline__ unsigned cvt_pk_bf16(float lo, float hi) { f32x2 v = {lo, hi}; return __builtin_bit_cast(unsigned, __builtin_convertvector(v, bf16x2_t)); }
__device__ __forceinline__ float bf_lo(unsigned w) { return __uint_as_float(w << 16); }
__device__ __forceinline__ float bf_hi(unsigned w) { return __uint_as_float(w & 0xffff0000u); }

struct EpiBf16 {
    static constexpr bool PERM = true;
    bf16_t* O; int ldc;
    __device__ __forceinline__ void operator()(const f32x4 (&acc)[2][2][4][2], const Unit& u, int wr, int wc, int fr, int fq) const {
        const int row0 = u.pm * BM + wr * 64 + fr; const int col0 = u.pn * BM + wc * 32 + 8 * fq;
#pragma unroll
        for (int ai = 0; ai < 2; ++ai)
#pragma unroll
            for (int m = 0; m < 4; ++m) { bf16_t* rowp = O + (size_t)(row0 + ai * HALF + m * 16) * ldc + col0;
#pragma unroll
                for (int bj = 0; bj < 2; ++bj) { const f32x4 v0 = acc[ai][bj][m][0], v1 = acc[ai][bj][m][1];
                    u32x4 w; w.x = cvt_pk_bf16(v0[0], v0[1]); w.y = cvt_pk_bf16(v0[2], v0[3]); w.z = cvt_pk_bf16(v1[0], v1[1]); w.w = cvt_pk_bf16(v1[2], v1[3]);
                    *(u32x4*)(rowp + bj * HALF) = w; } }
    }
};
struct EpiGlu {
    static constexpr bool PERM = true;
    const bf16_t* Y; int ldy; bf16_t* O; int ldc; const float* bias;
    __device__ __forceinline__ void operator()(const f32x4 (&acc)[2][2][4][2], const Unit& u, int wr, int wc, int fr, int fq) const {
        const int row0 = u.pm * BM + wr * 64 + fr; const int col0 = u.pn * BM + wc * 32 + 8 * fq;
        f32x4 bv[2][2];
#pragma unroll
        for (int bj = 0; bj < 2; ++bj)
#pragma unroll
            for (int n = 0; n < 2; ++n) bv[bj][n] = *(const f32x4*)(bias + col0 + bj * HALF + 4 * n);
#pragma unroll
        for (int ai = 0; ai < 2; ++ai) {
            u32x4 yq[4][2];
#pragma unroll
            for (int m = 0; m < 4; ++m)
#pragma unroll
                for (int bj = 0; bj < 2; ++bj) yq[m][bj] = *(const u32x4*)(Y + (size_t)(row0 + ai * HALF + m * 16) * ldy + col0 + bj * HALF);
            asm volatile("" ::: "memory");
#pragma unroll
            for (int m = 0; m < 4; ++m) { const size_t r = (size_t)(row0 + ai * HALF + m * 16);
#pragma unroll
                for (int bj = 0; bj < 2; ++bj) { const f32x4 v0 = acc[ai][bj][m][0] + bv[bj][0], v1 = acc[ai][bj][m][1] + bv[bj][1];
                    const u32x4 y = yq[m][bj];
                    float o[8]; const float yv[8] = {bf_lo(y.x), bf_hi(y.x), bf_lo(y.y), bf_hi(y.y), bf_lo(y.z), bf_hi(y.z), bf_lo(y.w), bf_hi(y.w)};
#pragma unroll
                    for (int i = 0; i < 4; ++i) { o[i] = yv[i] * __builtin_amdgcn_rcpf(1.f + __expf(-v0[i])); o[4 + i] = yv[4 + i] * __builtin_amdgcn_rcpf(1.f + __expf(-v1[i])); }
                    u32x4 w; w.x = cvt_pk_bf16(o[0], o[1]); w.y = cvt_pk_bf16(o[2], o[3]); w.z = cvt_pk_bf16(o[4], o[5]); w.w = cvt_pk_bf16(o[6], o[7]);
                    *(u32x4*)(O + r * ldc + col0 + bj * HALF) = w; } }
            asm volatile("" ::: "memory");
        }
    }
};
struct EpiResid {
    static constexpr bool PERM = false;
    const float* resid; float* out; int ldc; float alpha;
    __device__ __forceinline__ void operator()(const f32x4 (&acc)[2][2][4][2], const Unit& u, int wr, int wc, int fr, int fq) const {
        const int col0 = u.pn * BM + wc * 32 + 4 * fq;
#pragma unroll
        for (int ai = 0; ai < 2; ++ai) {
            f32x4 bs[4][2][2];
#pragma unroll
            for (int m = 0; m < 4; ++m) { const size_t off = (size_t)(u.pm * BM + ai * HALF + wr * 64 + m * 16 + fr) * ldc + col0;
#pragma unroll
                for (int bj = 0; bj < 2; ++bj)
#pragma unroll
                    for (int n = 0; n < 2; ++n) bs[m][bj][n] = *(const f32x4*)(resid + off + bj * HALF + n * 16); }
            asm volatile("" ::: "memory");
#pragma unroll
            for (int m = 0; m < 4; ++m) { const size_t off = (size_t)(u.pm * BM + ai * HALF + wr * 64 + m * 16 + fr) * ldc + col0;
#pragma unroll
                for (int bj = 0; bj < 2; ++bj)
#pragma unroll
                    for (int n = 0; n < 2; ++n) *(f32x4*)(out + off + bj * HALF + n * 16) = bs[m][bj][n] * alpha + acc[ai][bj][m][n]; }
            asm volatile("" ::: "memory");
        }
    }
};
struct EpiSwiglu {
    static constexpr bool PERM = true;
    bf16_t* O; int ldc;
    __device__ __forceinline__ void operator()(const f32x4 (&acc)[2][2][4][2], const Unit& u, int wr, int wc, int fr, int fq) const {
        const int row0 = u.pm * BM + wr * 64 + fr; const int col0 = (u.pn * BM + wc * 32 + 8 * fq) >> 1;
#pragma unroll
        for (int ai = 0; ai < 2; ++ai)
#pragma unroll
            for (int m = 0; m < 4; ++m) { bf16_t* rowp = O + (size_t)(row0 + ai * HALF + m * 16) * ldc + col0;
#pragma unroll
                for (int bj = 0; bj < 2; ++bj) { const f32x4 g = acc[ai][bj][m][0], up = acc[ai][bj][m][1]; float o[4];
#pragma unroll
                    for (int i = 0; i < 4; ++i) o[i] = g[i] * __builtin_amdgcn_rcpf(1.f + __expf(-g[i])) * up[i];
                    u32x2 w; w.x = cvt_pk_bf16(o[0], o[1]); w.y = cvt_pk_bf16(o[2], o[3]);
                    *(u32x2*)(rowp + bj * (HALF / 2)) = w; } }
    }
};
struct EpiScale {
    static constexpr bool PERM = true;
    bf16_t* O; int ldc; const float* rw;
    __device__ __forceinline__ void operator()(const f32x4 (&acc)[2][2][4][2], const Unit& u, int wr, int wc, int fr, int fq) const {
        const int row0 = u.pm * BM + wr * 64 + fr; const int col0 = u.pn * BM + wc * 32 + 8 * fq;
        float sw[2][4];
#pragma unroll
        for (int ai = 0; ai < 2; ++ai)
#pragma unroll
            for (int m = 0; m < 4; ++m) sw[ai][m] = rw[row0 + ai * HALF + m * 16];
        asm volatile("" ::: "memory");
#pragma unroll
        for (int ai = 0; ai < 2; ++ai)
#pragma unroll
            for (int m = 0; m < 4; ++m) { const int r = row0 + ai * HALF + m * 16; const float s = sw[ai][m]; bf16_t* rowp = O + (size_t)r * ldc + col0;
#pragma unroll
                for (int bj = 0; bj < 2; ++bj) { const f32x4 v0 = acc[ai][bj][m][0] * s, v1 = acc[ai][bj][m][1] * s;
                    u32x4 w; w.x = cvt_pk_bf16(v0[0], v0[1]); w.y = cvt_pk_bf16(v0[2], v0[3]); w.z = cvt_pk_bf16(v1[0], v1[1]); w.w = cvt_pk_bf16(v1[2], v1[3]);
                    *(u32x4*)(rowp + bj * HALF) = w; } }
    }
};

template <class Epi, class Sched, bool GATHER>
__device__ __forceinline__ void gemm_phase(PG8_LAS unsigned char* lds, const Gemm g, const Sched& S, const Epi& E) {
    const int tid = threadIdx.x, wid = __builtin_amdgcn_readfirstlane(tid >> 6), lane = tid & 63, wr = wid >> 2, wc = wid & 3, fr = lane & 15, fq = lane >> 4;
    const int K = g.K, nt = K / BK;
    unsigned voffA[2], voffB[2]; int RA[2], CA[2];
#pragma unroll
    for (int i = 0; i < 2; ++i) { int R, C; stage_rc(tid * 16 + i * 8192, R, C); const int Rb = Epi::PERM ? ((R & ~31) + perm32(R & 31)) : R;
        voffA[i] = (unsigned)(R * K + C) * 2u; voffB[i] = (unsigned)(Rb * K + C) * 2u; RA[i] = R; CA[i] = C; }
    const size_t kstep = (size_t)(BK * 2);
    const size_t hstep = (size_t)HALF * K * 2;
    const size_t tstep = 2 * hstep;
    const unsigned ldsw = (unsigned)wid * 1024u;
    const int aoff = lds_byte(wr * 64 + fr, fq * 8), boff = lds_byte(wc * 32 + fr, fq * 8);
#define PG8_SA(b, h) (((b) * 2 + (h)) * HTB)
#define PG8_SB(b, h) ((4 + (b) * 2 + (h)) * HTB)
#define PG8_STAGE(bufoff, gbase, voff) do { _Pragma("unroll") for (int _i = 0; _i < 2; ++_i) \
        __builtin_amdgcn_global_load_lds((const unsigned*)((const char*)(gbase) + (voff)[_i]), (PG8_LAS unsigned*)(lds + (bufoff) + ldsw + _i * 8192), 16, 0, 0); } while (0)
#define PG8_LDA(dst, b, h) do { _Pragma("unroll") for (int m = 0; m < 4; ++m) _Pragma("unroll") for (int k = 0; k < 2; ++k) dst[m][k] = *(const PG8_LAS bf16x8*)(lds + PG8_SA(b, h) + aoff + m * 2048 + k * 1024); } while (0)
#define PG8_LDB(dst, b, h) do { _Pragma("unroll") for (int n = 0; n < 2; ++n) _Pragma("unroll") for (int k = 0; k < 2; ++k) dst[n][k] = *(const PG8_LAS bf16x8*)(lds + PG8_SB(b, h) + boff + n * 2048 + k * 1024); } while (0)
#define PG8_MMA(ai, bj, At, Bt) do { __builtin_amdgcn_s_setprio(1); _Pragma("unroll") for (int m = 0; m < 4; ++m) _Pragma("unroll") for (int n = 0; n < 2; ++n) _Pragma("unroll") for (int k = 0; k < 2; ++k) \
        acc[ai][bj][m][n] = __builtin_amdgcn_mfma_f32_16x16x32_bf16(Bt[n][k], At[m][k], acc[ai][bj][m][n], 0, 0, 0); __builtin_amdgcn_s_setprio(0); } while (0)
#define PG8_WAIT_V(n) asm volatile("s_waitcnt vmcnt(" #n ")" ::: "memory")
#define PG8_WAIT_L(n) asm volatile("s_waitcnt lgkmcnt(" #n ")" ::: "memory")
#define PG8_BAR __builtin_amdgcn_s_barrier()
#define PG8_SCHED __builtin_amdgcn_sched_barrier(0)
    Unit cur, nxt; int ui = 0;
    if (!S.next(0, cur)) return;
    f32x4 acc[2][2][4][2];
#pragma unroll
    for (int a = 0; a < 2; ++a)
#pragma unroll
        for (int b = 0; b < 2; ++b)
#pragma unroll
            for (int m = 0; m < 4; ++m)
#pragma unroll
                for (int n = 0; n < 2; ++n) acc[a][b][m][n] = (f32x4){0.f, 0.f, 0.f, 0.f};
    bf16x8 At[4][2], B0[2][2], B1[2][2];
    unsigned cG[2][2], nG[2][2];
#define PG8_LOAD_ROWS(u_, G2_) do { _Pragma("unroll") for (int h_ = 0; h_ < 2; ++h_) _Pragma("unroll") for (int i_ = 0; i_ < 2; ++i_) \
        G2_[h_][i_] = GATHER ? ((unsigned)g.rowmap[(u_).pm * BM + h_ * HALF + RA[i_]] * (unsigned)K + (unsigned)CA[i_]) * 2u : voffA[i_]; } while (0)
    const char* cA = GATHER ? (const char*)g.A : (const char*)g.A + (size_t)cur.pm * tstep;
    const size_t hA = GATHER ? 0 : hstep;
    const char* cB = (const char*)g.Bt + (size_t)cur.e * g.bstride + (size_t)cur.pn * tstep;
    PG8_LOAD_ROWS(cur, cG);
    PG8_STAGE(PG8_SB(0, 0), cB, voffB); PG8_STAGE(PG8_SB(0, 1), cB + hstep, voffB); PG8_STAGE(PG8_SA(0, 0), cA, cG[0]); PG8_STAGE(PG8_SA(0, 1), cA + hA, cG[1]);
    if (wr == 1) PG8_BAR;
    PG8_WAIT_V(2); PG8_BAR;
    PG8_STAGE(PG8_SB(1, 0), cB + kstep, voffB); PG8_STAGE(PG8_SA(1, 0), cA + kstep, cG[0]); PG8_STAGE(PG8_SB(1, 1), cB + hstep + kstep, voffB);
    PG8_WAIT_V(6); PG8_BAR;
    for (;;) {
        const bool has_next = S.next(ui + 1, nxt);
        const char* nA = GATHER ? (const char*)g.A : (has_next ? (const char*)g.A + (size_t)nxt.pm * tstep : cA);
        const char* nB = has_next ? (const char*)g.Bt + (size_t)nxt.e * g.bstride + (size_t)nxt.pn * tstep : cB;
        if (has_next) PG8_LOAD_ROWS(nxt, nG); else {
#pragma unroll
            for (int h = 0; h < 2; ++h) { nG[h][0] = cG[h][0]; nG[h][1] = cG[h][1]; } }
        for (int t = 0; t < nt; t += 2) {
            const bool last = (t == nt - 2);
            const char* a1 = cA + (size_t)(t + 1) * kstep;
            const char* a2 = last ? nA : cA + (size_t)(t + 2) * kstep; const char* b2 = last ? nB : cB + (size_t)(t + 2) * kstep;
            const char* a3 = a2 + kstep; const char* b3 = b2 + kstep;
            unsigned sG[2][2];
#pragma unroll
            for (int h = 0; h < 2; ++h) { sG[h][0] = (GATHER && last) ? nG[h][0] : cG[h][0]; sG[h][1] = (GATHER && last) ? nG[h][1] : cG[h][1]; }
            PG8_LDB(B0, 0, 0); PG8_LDB(B1, 0, 1); PG8_SCHED; PG8_LDA(At, 0, 0); PG8_STAGE(PG8_SA(1, 1), a1 + hA, cG[1]);
            PG8_WAIT_V(8); PG8_WAIT_L(0); PG8_BAR; PG8_MMA(0, 0, At, B0); PG8_MMA(0, 1, At, B1); PG8_BAR; PG8_SCHED;
            PG8_LDA(At, 0, 1); PG8_STAGE(PG8_SB(0, 0), b2, voffB); PG8_STAGE(PG8_SB(0, 1), b2 + hstep, voffB); PG8_STAGE(PG8_SA(0, 0), a2, sG[0]);
            PG8_WAIT_V(8); PG8_WAIT_L(0); PG8_BAR; PG8_MMA(1, 0, At, B0); PG8_MMA(1, 1, At, B1); PG8_BAR; PG8_SCHED;
            PG8_LDB(B0, 1, 0); PG8_LDB(B1, 1, 1); PG8_SCHED; PG8_LDA(At, 1, 0); PG8_STAGE(PG8_SA(0, 1), a2 + hA, sG[1]);
            PG8_WAIT_V(8); PG8_WAIT_L(0); PG8_BAR; PG8_MMA(0, 0, At, B0); PG8_MMA(0, 1, At, B1); PG8_BAR; PG8_SCHED;
            PG8_LDA(At, 1, 1); PG8_STAGE(PG8_SB(1, 0), b3, voffB); PG8_STAGE(PG8_SB(1, 1), b3 + hstep, voffB); PG8_STAGE(PG8_SA(1, 0), a3, sG[0]);
            PG8_WAIT_V(8); PG8_WAIT_L(0); PG8_BAR; PG8_MMA(1, 0, At, B0); PG8_MMA(1, 1, At, B1); PG8_BAR; PG8_SCHED;
        }
        if (wr == 0) PG8_BAR;
        E(acc, cur, wr, wc, fr, fq);
        if (!has_next) break;
#pragma unroll
        for (int a = 0; a < 2; ++a)
#pragma unroll
            for (int b = 0; b < 2; ++b)
#pragma unroll
                for (int m = 0; m < 4; ++m)
#pragma unroll
                    for (int n = 0; n < 2; ++n) acc[a][b][m][n] = (f32x4){0.f, 0.f, 0.f, 0.f};
        cur = nxt; cA = nA; cB = nB; ++ui;
#pragma unroll
        for (int h = 0; h < 2; ++h) { cG[h][0] = nG[h][0]; cG[h][1] = nG[h][1]; }
        if (wr == 1) PG8_BAR;
    }
    PG8_WAIT_V(0);
    PG8_BAR;
#undef PG8_LOAD_ROWS
#undef PG8_SA
#undef PG8_SB
#undef PG8_STAGE
#undef PG8_LDA
#undef PG8_LDB
#undef PG8_MMA
#undef PG8_WAIT_V
#undef PG8_WAIT_L
#undef PG8_BAR
#undef PG8_SCHED
}
}
constexpr int NB = 2, SEQ = 16384, T = NB * SEQ, D = 1024;
constexpr int H0P = 2112;
constexpr int ABN = 2048, OFF_U = 0, OFF_Q = 512, OFF_K = 768, OFF_V = 1024, OFF_GO = 1536, AB_IN = 2080;
constexpr int CN = 1536;
constexpr int NEXP = 32, DEXP = 512, CAP = 2 * T + NEXP * 256, MAXTILES = CAP / 256;
constexpr int S5CH = 256, S5NCH = SEQ / S5CH;
constexpr int GSC = 16, GCH = 64, GNSC = SEQ / (GSC * GCH);
constexpr float ALPHA = 1.41421356237309515f;
constexpr float LN_EPS = 1e-5f, RMS_EPS = 1e-6f, LOG2E = 1.44269504088896341f;
constexpr int NWAVES = 8, NTHR = 512;

constexpr size_t MiB = 1u << 20, KiB = 1u << 10;
constexpr size_t WS_CTL = 0, CTL_ZERO_BYTES = 64 * KiB;
constexpr int CW_BAR = 4096;
constexpr size_t WS_LR = 1 * MiB;
constexpr size_t WS_S5E = 5 * MiB;
constexpr size_t WS_GS = 9 * MiB;
constexpr size_t WS_GD = 17 * MiB;
constexpr size_t WS_S5L = WS_GD + 64 * KiB;
constexpr size_t WS_S5B = WS_S5L + 64 * KiB;
constexpr size_t WS_S5C = WS_S5B + 256 * KiB;
constexpr size_t WS_BTAB = WS_S5C + 256 * KiB;
constexpr size_t WS_WR = WS_BTAB + 32 * KiB;
constexpr size_t WS_TOKE = WS_WR + 384 * KiB;
constexpr size_t WS_TOKW = WS_TOKE + 256 * KiB;
constexpr size_t WS_TOKS = WS_TOKW + 256 * KiB;
constexpr size_t WS_SLOTT = WS_TOKS + 256 * KiB;
constexpr size_t WS_SLOTW = WS_SLOTT + 288 * KiB;
constexpr size_t WS_BLKC = WS_SLOTW + 288 * KiB;
constexpr size_t WS_TILE = WS_BLKC + 32 * KiB;
static_assert(WS_TILE + 4 * KiB <= 32 * MiB, "param region");
constexpr size_t WS_WIN = 32 * MiB, WS_WLR = 36 * MiB, WS_WGLU = 37 * MiB, WS_WOUT = 38 * MiB, WS_CIN = 40 * MiB, WS_COUT = 43 * MiB;
constexpr size_t WS_W13 = 48 * MiB, WS_W2 = 112 * MiB;
constexpr size_t A0 = 144 * MiB;
constexpr size_t WS_H1 = A0, WS_H0 = A0;
constexpr size_t WS_Z = A0 + 128 * MiB;
constexpr size_t WS_YG = A0 + 136 * MiB, WS_OF = A0 + 168 * MiB, WS_OB = A0 + 320 * MiB;
constexpr size_t WS_YSCR = A0 + 232 * MiB;
constexpr size_t WS_X64 = A0 + 256 * MiB;
constexpr size_t WS_HID = A0 + 128 * MiB;
constexpr size_t WS_Y2 = A0 + 200 * MiB;
constexpr size_t WS_H2B = A0 + 128 * MiB;
constexpr size_t WS_QKV = A0 + 192 * MiB;
constexpr size_t WS_AO = A0 + 288 * MiB;
constexpr size_t WS_END = A0 + 384 * MiB;
static_assert((size_t)T * H0P * 2 <= 136 * MiB && WS_Y2 + (size_t)CAP * D * 2 <= WS_END && WS_OB + (size_t)T * 512 * 4 <= WS_END && WS_HID + (size_t)CAP * 512 * 2 <= WS_Y2, "act map");

constexpr int RING_BYTES = 131072;
constexpr int MISC_OFF = 163840 - 1024;
constexpr int PTR_OFF = MISC_OFF + 256;
constexpr int LDS_BYTES = 163840;

#define GAS __attribute__((address_space(1)))
#define LAS __attribute__((address_space(3)))
typedef unsigned short bf16;
typedef float f32x4 __attribute__((ext_vector_type(4)));
typedef float f32x2 __attribute__((ext_vector_type(2)));
typedef float f32x16 __attribute__((ext_vector_type(16)));
typedef short bf16x8 __attribute__((ext_vector_type(8)));
typedef short bf16x4 __attribute__((ext_vector_type(4)));
typedef unsigned u32x4 __attribute__((ext_vector_type(4)));
typedef unsigned u32x2 __attribute__((ext_vector_type(2)));
#define LDS_WAIT() asm volatile("s_waitcnt lgkmcnt(0)" ::: "memory")
#define VM_WAIT() asm volatile("s_waitcnt vmcnt(0)" ::: "memory")
#define LDS_BARRIER() do { asm volatile("s_waitcnt lgkmcnt(0)" ::: "memory"); __builtin_amdgcn_s_barrier(); asm volatile("" ::: "memory"); } while (0)
typedef __bf16 bf16x2_t __attribute__((ext_vector_type(2)));
__device__ __forceinline__ unsigned pk2(float lo, float hi) { f32x2 v = {lo, hi}; return __builtin_bit_cast(unsigned, __builtin_convertvector(v, bf16x2_t)); }
__device__ __forceinline__ unsigned f2bf(float f) { return pk2(f, 0.f) & 0xffffu; }
__device__ __forceinline__ float bf2f(unsigned short b) { return __uint_as_float((unsigned)b << 16); }
__device__ __forceinline__ float bflo(unsigned w) { return __uint_as_float(w << 16); }
__device__ __forceinline__ float bfhi(unsigned w) { return __uint_as_float(w & 0xffff0000u); }
__device__ __forceinline__ float wave_sum(float v) {
#pragma unroll
    for (int o = 1; o < 64; o <<= 1) v += __shfl_xor(v, o);
    return v;
}
__device__ __forceinline__ int crow(int r, int hi) { return (r & 3) + 8 * (r >> 2) + 4 * hi; }

#define XB_TMO      128
#define XB_XCNT(j)  (256  + 64 * (j))
#define XB_XSUB(j)  (1280 + 64 * (j))
#define XB_XGEN(j)  (2304 + 64 * (j))
#define XB_TOP      3328
#define XB_TOPGEN   3392
#define XCD_BAR_WORDS 3456
#define XB_SPIN_CAP (1u << 18)
__device__ __forceinline__ unsigned xb_ld(unsigned* p)              { return __hip_atomic_load(p, __ATOMIC_RELAXED, __HIP_MEMORY_SCOPE_AGENT); }
__device__ __forceinline__ unsigned xb_add(unsigned* p, unsigned v) { return __hip_atomic_fetch_add(p, v, __ATOMIC_RELAXED, __HIP_MEMORY_SCOPE_AGENT); }
__device__ __forceinline__ unsigned xb_xcc_id() { return (unsigned)__builtin_amdgcn_s_getreg((3 << 11) | 20) & 0xFu; }
#define XB_SPIN(cond, bar) do { unsigned _sp = 0; while (cond) { __builtin_amdgcn_s_sleep(1); \
    if ((++_sp & 255u) == 0u) { if (xb_ld(&(bar)[XB_TMO])) break; if (_sp > XB_SPIN_CAP) { atomicAdd(&(bar)[XB_TMO], 1u); break; } } } } while (0)
struct XcdBarrier { unsigned* bar; unsigned x; volatile LAS unsigned* st; };
__device__ __forceinline__ XcdBarrier xcd_barrier_post(unsigned* bar, volatile LAS unsigned* st) {
    XcdBarrier b; b.bar = bar; b.x = xb_xcc_id(); b.st = st;
    if (threadIdx.x == 0) (void)xb_add(&bar[XB_XCNT(b.x)], 1u);
    return b;
}
__device__ __forceinline__ void xcd_barrier_complete(unsigned* bar, unsigned x, unsigned& nloc, unsigned& nx) {
    const unsigned G = gridDim.x * gridDim.y * gridDim.z;
    unsigned sum, cnt, mine, sp = 0u;
    for (;;) {
        sum = 0u; cnt = 0u; mine = 0u;
#pragma unroll
        for (unsigned j = 0; j < 16; ++j) { const unsigned c = xb_ld(&bar[XB_XCNT(j)]); sum += c; cnt += (c > 0u) ? 1u : 0u; mine = (j == x) ? c : mine; }
        if (sum == G) break;
        __builtin_amdgcn_s_sleep(1);
        if ((++sp & 255u) == 0u) { if (xb_ld(&bar[XB_TMO])) break; if (sp > XB_SPIN_CAP) { atomicAdd(&bar[XB_TMO], 1u); break; } }
    }
    nloc = mine > 0u ? mine : 1u; nx = cnt > 0u ? cnt : 1u;
}
__device__ __forceinline__ void xcd_barrier(const XcdBarrier& b) {
    asm volatile("s_waitcnt vmcnt(0)" ::: "memory");
    __syncthreads();
    if (threadIdx.x == 0) {
        unsigned* bar = b.bar;
        __builtin_amdgcn_s_waitcnt(0);
        unsigned nloc = b.st[0], nx = b.st[1];
        if (nloc == 0u) { xcd_barrier_complete(bar, b.x, nloc, nx); b.st[0] = nloc; b.st[1] = nx; }
        const unsigned old = xb_add(&bar[XB_XSUB(b.x)], 1u);
        const unsigned gen = old / nloc;
        if (old + 1u == (gen + 1u) * nloc) {
            __builtin_amdgcn_fence(__ATOMIC_RELEASE, "agent");
            asm volatile("s_waitcnt vmcnt(0)" ::: "memory");
            const unsigned og = xb_add(&bar[XB_TOP], 1u);
            const unsigned tg = og / nx;
            if (og + 1u == (tg + 1u) * nx) xb_add(&bar[XB_TOPGEN], 1u);
            else XB_SPIN(xb_ld(&bar[XB_TOPGEN]) == tg, bar);
            __builtin_amdgcn_fence(__ATOMIC_ACQUIRE, "agent");
            xb_add(&bar[XB_XGEN(b.x)], 1u);
            asm volatile("s_waitcnt vmcnt(0)" ::: "memory");
        } else {
            XB_SPIN(xb_ld(&bar[XB_XGEN(b.x)]) == gen, bar);
            __builtin_amdgcn_fence(__ATOMIC_ACQUIRE, "agent");
            asm volatile("s_waitcnt vmcnt(0)" ::: "memory");
        }
    }
    __syncthreads();
}

struct Frame {
    LAS unsigned char* lds;
    int tid, lane, wave, G, bid;
    unsigned char* ws;
    const float* const* in;
};
enum InIdx { I_X = 0, I_LNMG, I_LNMB, I_LNFG, I_LNFB, I_ABWIN, I_LAMRE, I_LAMIM, I_LOGDT, I_BRE, I_BIM, I_CRE, I_CIM, I_S5D, I_GLUW, I_GLUB,
             I_GATEW, I_GATEB, I_NORMG, I_ABWOUT, I_CWIN, I_SINK, I_CWOUT, I_RELB, I_WGRP, I_BGRP, I_WRT, I_BRT, I_W1, I_W3, I_W2, N_IN };

__device__ __forceinline__ const float* inp(LAS unsigned char* lds, int k) {
    const LAS unsigned* p = (const LAS unsigned*)(lds + PTR_OFF) + 2 * k;
    const unsigned lo = __builtin_amdgcn_readfirstlane(p[0]), hi = __builtin_amdgcn_readfirstlane(p[1]);
    return (const float*)(const GAS float*)(((unsigned long long)hi << 32) | (unsigned long long)lo);
}
__device__ __forceinline__ void tr_item(const float* W, int ldw, bf16* WT, int ldt, int rowmode, LAS float* scr, int item, int nblk, int lane) {
    const int kb = item / nblk, nb = item % nblk, k0 = 64 * kb, n0 = 32 * nb;
    float tv[32];
    const float* wp = W + (size_t)(k0 + (lane >> 5)) * ldw + n0 + (lane & 31);
#pragma unroll
    for (int i = 0; i < 32; ++i) tv[i] = wp[(size_t)(2 * i) * ldw];
#pragma unroll
    for (int i = 0; i < 32; ++i) scr[(2 * i + (lane >> 5)) * 33 + (lane & 31)] = tv[i];
    LDS_WAIT(); asm volatile("" ::: "memory");
    const int c = lane & 7;
#pragma unroll
    for (int j = 0; j < 4; ++j) { const int n = (lane >> 3) + 8 * j; const LAS float* s = scr + (8 * c) * 33 + n;
        u32x4 o; o.x = pk2(s[0 * 33], s[1 * 33]); o.y = pk2(s[2 * 33], s[3 * 33]); o.z = pk2(s[4 * 33], s[5 * 33]); o.w = pk2(s[6 * 33], s[7 * 33]);
        const int ng = n0 + n; const int dr = rowmode == 0 ? ng : (8 * (ng >> 2) + (ng & 3) + (rowmode == 2 ? 4 : 0));
        *(GAS u32x4*)(WT + (size_t)dr * ldt + k0 + 8 * c) = o; }
    LDS_WAIT(); asm volatile("" ::: "memory");
}
__device__ __forceinline__ void moe_convert(const float* w1, const float* w3, const float* w2, bf16* W13, bf16* W2T, LAS float* scr, int it0, int it1, int gw, int NGW, int lane) {
    constexpr int PER_E = 768;
    for (int it = it0 + gw; it < it1; it += NGW) {
        const int e = it / PER_E; int r = it % PER_E;
        if (r < 256) tr_item(w1 + (size_t)e * D * DEXP, DEXP, W13 + (size_t)e * D * D, D, 1, scr, r, DEXP / 32, lane);
        else if (r < 512) tr_item(w3 + (size_t)e * D * DEXP, DEXP, W13 + (size_t)e * D * D, D, 2, scr, r - 256, DEXP / 32, lane);
        else tr_item(w2 + (size_t)e * DEXP * D, D, W2T + (size_t)e * D * DEXP, DEXP, 0, scr, r - 512, D / 32, lane);
    }
}
constexpr int MOE_ITEMS = NEXP * 768, IDLE_Q8 = 88, IDLE_Q9 = 56;
__device__ __forceinline__ void idle_convert(int which, unsigned char* ws, LAS unsigned char* lds, float* dout, int ntiles, int bid, int G, int wave, int lane) {
    const int U = ntiles * (D / 256), rem = U % G; if (rem == 0 || bid < rem) return;
    const int n_idle = G - rem, rank = bid - rem;
    int q8 = n_idle * IDLE_Q8; q8 = q8 < MOE_ITEMS ? q8 : MOE_ITEMS; int q9 = n_idle * IDLE_Q9; q9 = (q8 + q9) < MOE_ITEMS ? q9 : (MOE_ITEMS - q8);
    const int per = which == 0 ? IDLE_Q8 : IDLE_Q9, base = which == 0 ? 0 : q8, lim = which == 0 ? q8 : q8 + q9;
    int lo = base + rank * per, hi = lo + per; hi = hi < lim ? hi : lim;
    moe_convert(inp(lds, I_W1) + (size_t)NEXP * D * DEXP, inp(lds, I_W3) + (size_t)NEXP * D * DEXP, inp(lds, I_W2) + (size_t)NEXP * DEXP * D,
                (bf16*)dout, (bf16*)dout + (size_t)NEXP * D * D, (LAS float*)(lds + wave * 16384), lo, hi, wave, NWAVES, lane);
}
__device__ __forceinline__ int idle_done(int ntiles, int G) {
    const int U = ntiles * (D / 256), rem = U % G; if (rem == 0) return 0;
    const int n_idle = G - rem; int q = n_idle * (IDLE_Q8 + IDLE_Q9); return q < MOE_ITEMS ? q : MOE_ITEMS;
}
__device__ __forceinline__ int t5_bucket(int rel) {
    const int nb = 16, max_exact = 8; int ret = rel > 0 ? nb : 0; const int n = rel < 0 ? -rel : rel;
    const float lg = logf((float)(n < 1 ? 1 : n) / 8.0f) / 2.7725887f * 8.0f;
    int large = max_exact + (int)lg; large = large < nb - 1 ? large : nb - 1;
    return ret + (n < max_exact ? n : large);
}
__device__ __forceinline__ void p0_prologue(unsigned char* ws, LAS unsigned char* lds, int bid, int G, int tid, int wave, int lane) {
    LAS float* scr = (LAS float*)(lds + wave * 16384);
    const int gw = bid * NWAVES + wave, NGW = G * NWAVES;
    constexpr int I0 = 16 * 64, I1 = 16, I2 = 8 * 16, I3 = 16 * 32, I4 = 16 * 48, I5 = 16 * 32, NIT = I0 + I1 + I2 + I3 + I4 + I5;
    for (int it = gw; it < NIT; it += NGW) {
        int r = it;
        if (r < I0) { tr_item(inp(lds, I_ABWIN), AB_IN, (bf16*)(ws + WS_WIN), D, 0, scr, r, 64, lane); continue; } r -= I0;
        if (r < I1) { tr_item(inp(lds, I_ABWIN) + 2048, AB_IN, (bf16*)(ws + WS_WLR), D, 0, scr, r, 1, lane); continue; } r -= I1;
        if (r < I2) { tr_item(inp(lds, I_GLUW), 512, (bf16*)(ws + WS_WGLU), 512, 0, scr, r, 16, lane); continue; } r -= I2;
        if (r < I3) { tr_item(inp(lds, I_ABWOUT), D, (bf16*)(ws + WS_WOUT), D, 0, scr, r, 32, lane); continue; } r -= I3;
        if (r < I4) { tr_item(inp(lds, I_CWIN), CN, (bf16*)(ws + WS_CIN), D, 0, scr, r, 48, lane); continue; } r -= I4;
        tr_item(inp(lds, I_CWOUT), D, (bf16*)(ws + WS_COUT), D, 0, scr, r, 32, lane);
    }
    moe_convert(inp(lds, I_W1), inp(lds, I_W3), inp(lds, I_W2), (bf16*)(ws + WS_W13), (bf16*)(ws + WS_W2), scr, 0, MOE_ITEMS, gw, NGW, lane);
    { const float* x = inp(lds, I_X); bf16* xb = (bf16*)(ws + WS_X64);
      for (int m = gw; m < T; m += 2 * NGW) { const int m2 = m + NGW;
          const GAS f32x4* xr = (const GAS f32x4*)(x + (size_t)m * D) + lane; GAS u32x2* o = (GAS u32x2*)(xb + (size_t)m * D) + lane;
          const GAS f32x4* xr2 = (const GAS f32x4*)(x + (size_t)m2 * D) + lane; GAS u32x2* o2 = (GAS u32x2*)(xb + (size_t)m2 * D) + lane;
          f32x4 v[4], v2[4];
#pragma unroll
          for (int j = 0; j < 4; ++j) { v[j] = xr[64 * j]; if (m2 < T) v2[j] = xr2[64 * j]; }
#pragma unroll
          for (int j = 0; j < 4; ++j) { u32x2 w; w.x = pk2(v[j].x, v[j].y); w.y = pk2(v[j].z, v[j].w); o[64 * j] = w;
              if (m2 < T) { u32x2 w2; w2.x = pk2(v2[j].x, v2[j].y); w2.y = pk2(v2[j].z, v2[j].w); o2[64 * j] = w2; } } } }
    const int gt = bid * NTHR + tid, NGT = G * NTHR;
    { const float* lamre = inp(lds, I_LAMRE); const float* lamim = inp(lds, I_LAMIM); const float* logdt = inp(lds, I_LOGDT); const float* bre = inp(lds, I_BRE); const float* bim = inp(lds, I_BIM);
    for (int i = gt; i < 2 * 32 * 64; i += NGT) {
        const int p = i & 63, g = (i >> 6) & 31, dir = i >> 11;
        const double lr = fmin((double)lamre[i], -1e-4), li = (double)lamim[i], dt = exp((double)logdt[dir * 32 + g]);
        const double mag = exp(lr * dt), ar = mag * cos(li * dt), ai = mag * sin(li * dt), den = lr * lr + li * li, nr = ar - 1.0;
        const double cr = (nr * lr + ai * li) / den, ci = (ai * lr - nr * li) / den;
        double qr = ar, qi = ai;
#pragma unroll 1
        for (int s = 1; s < S5CH; s <<= 1) { const double t = qr * qr - qi * qi; qi = 2.0 * qr * qi; qr = t; }
        float* L4 = (float*)(ws + WS_S5L) + (size_t)i * 4; L4[0] = (float)ar; L4[1] = (float)ai; L4[2] = (float)qr; L4[3] = (float)qi;
        bf16* Bb = (bf16*)(ws + WS_S5B) + (size_t)(dir * 32 + g) * 2048;
#pragma unroll 4
        for (int c = 0; c < 16; ++c) { const double br = bre[(size_t)i * 16 + c], bi = bim[(size_t)i * 16 + c];
            Bb[p * 16 + c] = (bf16)f2bf((float)(cr * br - ci * bi)); Bb[1024 + p * 16 + c] = (bf16)f2bf((float)(cr * bi + ci * br)); }
    } }
    { const float* cre = inp(lds, I_CRE); const float* cim = inp(lds, I_CIM);
    for (int i = gt; i < 2 * 32 * 16 * 64; i += NGT) {
        const int p = i & 63, c = (i >> 6) & 15, dg = i >> 10;
        bf16* Cm = (bf16*)(ws + WS_S5C) + (size_t)dg * 2048 + c * 128 + 2 * p;
        Cm[0] = (bf16)f2bf(cre[i]); Cm[1] = (bf16)f2bf(-cim[i]);
    } }
    { const float* relb = inp(lds, I_RELB);
    for (int i = gt; i < 16 * 257; i += NGT) { const int h = i / 257, r = i % 257; ((float*)(ws + WS_BTAB))[h * 260 + r] = relb[t5_bucket(r - 128) * 16 + h] * LOG2E; } }
    { const float* wgrp = inp(lds, I_WGRP); const float* wrt = inp(lds, I_WRT);
    for (int i = gt; i < 2 * 48 * 1024; i += NGT) {
        const int k = i & 1023, n = (i >> 10) % 48, l = i / (48 * 1024);
        const float w = n < 4 ? wgrp[(size_t)l * D * 4 + k * 4 + n] : (n < 36 ? wrt[(size_t)l * D * 32 + k * 32 + (n - 4)] : 0.f);
        const unsigned hi = f2bf(w); const float lo = w - __uint_as_float(hi << 16);
        bf16* Wr = (bf16*)(ws + WS_WR) + (size_t)l * 2 * 48 * 1024; Wr[n * 1024 + k] = (bf16)hi; Wr[48 * 1024 + n * 1024 + k] = (bf16)f2bf(lo);
    } }
}

__device__ __forceinline__ void gate_tail(float* bcg, const float* gate_w, const float* gate_b, const LAS float* lrs, size_t row0, int tid);
__device__ __forceinline__ void lr_tail(unsigned char* ws, float* bcg, const float* gate_w, const float* gate_b, LAS unsigned char* lds, int bid, int G, int tid, int wave, int lane) {
    const bf16* xb = (const bf16*)(ws + WS_X64); const bf16* wl = (const bf16*)(ws + WS_WLR); LAS float* lrs = (LAS float*)lds;
    for (int rt = bid; rt < T / 128; rt += G) {
        const int r0 = rt * 128 + wave * 16;
        f32x4 acc0 = {0.f, 0.f, 0.f, 0.f}, acc1 = {0.f, 0.f, 0.f, 0.f};
        const bf16* ap = xb + (size_t)(r0 + (lane & 15)) * D + 8 * (lane >> 4);
        const bf16* bp = wl + (size_t)(lane & 15) * D + 8 * (lane >> 4);
#pragma unroll 8
        for (int ks = 0; ks < 32; ++ks) {
            const bf16x8 a = *(const bf16x8*)(ap + ks * 32), b0 = *(const bf16x8*)(bp + ks * 32), b1 = *(const bf16x8*)(bp + 16 * D + ks * 32);
            acc0 = __builtin_amdgcn_mfma_f32_16x16x32_bf16(a, b0, acc0, 0, 0, 0); acc1 = __builtin_amdgcn_mfma_f32_16x16x32_bf16(a, b1, acc1, 0, 0, 0);
        }
        __syncthreads();
#pragma unroll
        for (int r = 0; r < 4; ++r) { LAS float* o = lrs + (wave * 16 + 4 * (lane >> 4) + r) * 32 + (lane & 15); o[0] = acc0[r]; o[16] = acc1[r]; }
        __syncthreads();
        gate_tail(bcg, gate_w, gate_b, lrs, (size_t)rt * 128, tid);
    }
    __syncthreads();
}

__device__ __forceinline__ void gla_finalize(unsigned char* ws, const float* norm_g, int gw, int NGW, int lane) {
    const bf16* of = (const bf16*)(ws + WS_OF); const bf16* ob = (const bf16*)(ws + WS_OB); const bf16* h0 = (const bf16*)(ws + WS_H0); bf16* cc = (bf16*)(ws + WS_X64);
    const f32x4 g0 = *(const f32x4*)(norm_g + 8 * lane), g1 = *(const f32x4*)(norm_g + 8 * lane + 4);
    for (int m0 = gw; m0 < T; m0 += 4 * NGW) {
        u32x4 a[4], b[4], gq[4];
#pragma unroll
        for (int q = 0; q < 4; ++q) { const size_t m = (size_t)m0 + (size_t)q * NGW;
            a[q] = *(const u32x4*)(of + m * 512 + 8 * lane); b[q] = *(const u32x4*)(ob + m * 512 + 8 * lane); gq[q] = *(const u32x4*)(h0 + m * H0P + OFF_GO + 8 * lane); }
#pragma unroll
        for (int q = 0; q < 4; ++q) { const size_t m = (size_t)m0 + (size_t)q * NGW;
            f32x4 v0, v1;
            v0.x = bflo(a[q].x) + bflo(b[q].x); v0.y = bfhi(a[q].x) + bfhi(b[q].x); v0.z = bflo(a[q].y) + bflo(b[q].y); v0.w = bfhi(a[q].y) + bfhi(b[q].y);
            v1.x = bflo(a[q].z) + bflo(b[q].z); v1.y = bfhi(a[q].z) + bfhi(b[q].z); v1.z = bflo(a[q].w) + bflo(b[q].w); v1.w = bfhi(a[q].w) + bfhi(b[q].w);
            float ss = (v0.x * v0.x + v0.y * v0.y) + (v0.z * v0.z + v0.w * v0.w) + (v1.x * v1.x + v1.y * v1.y) + (v1.z * v1.z + v1.w * v1.w);
            ss += __shfl_xor(ss, 1); ss += __shfl_xor(ss, 2); ss += __shfl_xor(ss, 4); ss += __shfl_xor(ss, 8);
            const float rs = __builtin_amdgcn_rsqf(ss * (1.0f / 128.0f) + RMS_EPS);
            const float gv[8] = {bflo(gq[q].x), bfhi(gq[q].x), bflo(gq[q].y), bfhi(gq[q].y), bflo(gq[q].z), bfhi(gq[q].z), bflo(gq[q].w), bfhi(gq[q].w)};
            const float ov[8] = {v0.x * g0.x, v0.y * g0.y, v0.z * g0.z, v0.w * g0.w, v1.x * g1.x, v1.y * g1.y, v1.z * g1.z, v1.w * g1.w};
            float r[8];
#pragma unroll
            for (int i = 0; i < 8; ++i) r[i] = ov[i] * rs * (gv[i] * __builtin_amdgcn_rcpf(1.f + __expf(-gv[i])));
            u32x4 w; w.x = pk2(r[0], r[1]); w.y = pk2(r[2], r[3]); w.z = pk2(r[4], r[5]); w.w = pk2(r[6], r[7]);
            *(u32x4*)(cc + m * D + 512 + 8 * lane) = w; }
    }
}

constexpr int RT_AST = 2064;
__device__ __forceinline__ void ln_router(unsigned char* ws, const float* resid, const float* lng, const float* lnb, const float* bgrp, const float* brt, int layer, LAS unsigned char* lds, int bid, int G, int tid, int wave, int lane) {
    const bf16* yb = (const bf16*)(ws + WS_Z); float* h1 = (float*)(ws + WS_H1); bf16* hb = (bf16*)(ws + WS_X64);
    int* tok_e = (int*)(ws + WS_TOKE); float* tok_w = (float*)(ws + WS_TOKW);
    LAS unsigned char* Ahi = lds; LAS unsigned char* Alo = lds + 16 * RT_AST; LAS float* part = (LAS float*)(lds + 32 * RT_AST);
    LAS int* hist = (LAS int*)(lds + 32 * RT_AST + 8 * 16 * 48 * 4); LAS float* lgt = (LAS float*)(lds + 32 * RT_AST + 8 * 16 * 48 * 4 + 256);
    if (tid < 32) hist[tid] = 0;
    const bf16* Wr = (const bf16*)(ws + WS_WR) + (size_t)layer * 2 * 48 * 1024;
    bf16x8 Bh[3][4], Bl[3][4];
#pragma unroll
    for (int nt = 0; nt < 3; ++nt)
#pragma unroll
        for (int ks = 0; ks < 4; ++ks) { const size_t o = (size_t)(nt * 16 + (lane & 15)) * 1024 + wave * 128 + ks * 32 + 8 * (lane >> 4);
            Bh[nt][ks] = *(const bf16x8*)(Wr + o); Bl[nt][ks] = *(const bf16x8*)(Wr + 48 * 1024 + o); }
    f32x4 gv[4], bv[4];
#pragma unroll
    for (int j = 0; j < 4; ++j) { gv[j] = *(const f32x4*)(lng + 4 * lane + 256 * j); bv[j] = *(const f32x4*)(lnb + 4 * lane + 256 * j); }
    __syncthreads();
    for (int grp = bid; grp < T / 16; grp += G) {
#pragma unroll
        for (int rr = 0; rr < 2; ++rr) {
            const int row = 2 * wave + rr; const size_t m = (size_t)grp * 16 + row;
            const GAS f32x4* xr = (const GAS f32x4*)(resid + m * D) + lane; const GAS u32x2* yr = (const GAS u32x2*)(yb + m * D) + lane;
            f32x4 v[4]; float s = 0.f;
#pragma unroll
            for (int j = 0; j < 4; ++j) { const f32x4 x4 = xr[64 * j]; const u32x2 y2 = yr[64 * j];
                v[j].x = x4.x * ALPHA + bflo(y2.x); v[j].y = x4.y * ALPHA + bfhi(y2.x); v[j].z = x4.z * ALPHA + bflo(y2.y); v[j].w = x4.w * ALPHA + bfhi(y2.y);
                s += (v[j].x + v[j].y) + (v[j].z + v[j].w); }
            const float mean = wave_sum(s) * (1.f / D); float s2 = 0.f;
#pragma unroll
            for (int j = 0; j < 4; ++j) { v[j] = v[j] - mean; s2 += (v[j].x * v[j].x + v[j].y * v[j].y) + (v[j].z * v[j].z + v[j].w * v[j].w); }
            const float rstd = 1.f / sqrtf(wave_sum(s2) * (1.f / D) + LN_EPS);
#pragma unroll
            for (int j = 0; j < 4; ++j) {
                const f32x4 h = v[j] * rstd * gv[j] + bv[j];
                ((GAS f32x4*)(h1 + m * D) + lane)[64 * j] = h;
                const unsigned h0 = pk2(h.x, h.y), h1w = pk2(h.z, h.w);
                u32x2 w; w.x = h0; w.y = h1w; ((GAS u32x2*)(hb + m * D) + lane)[64 * j] = w;
                u32x2 lo; lo.x = pk2(h.x - bflo(h0), h.y - bfhi(h0)); lo.y = pk2(h.z - bflo(h1w), h.w - bfhi(h1w));
                *(LAS u32x2*)(Ahi + row * RT_AST + (4 * lane + 256 * j) * 2) = w; *(LAS u32x2*)(Alo + row * RT_AST + (4 * lane + 256 * j) * 2) = lo;
            }
        }
        LDS_BARRIER();
        f32x4 acc[3] = {{0.f, 0.f, 0.f, 0.f}, {0.f, 0.f, 0.f, 0.f}, {0.f, 0.f, 0.f, 0.f}};
#pragma unroll
        for (int ks = 0; ks < 4; ++ks) {
            const int bo = (lane & 15) * RT_AST + (wave * 128 + ks * 32 + 8 * (lane >> 4)) * 2;
            const bf16x8 ah = *(const LAS bf16x8*)(Ahi + bo), al = *(const LAS bf16x8*)(Alo + bo);
#pragma unroll
            for (int nt = 0; nt < 3; ++nt) {
                acc[nt] = __builtin_amdgcn_mfma_f32_16x16x32_bf16(ah, Bh[nt][ks], acc[nt], 0, 0, 0);
                acc[nt] = __builtin_amdgcn_mfma_f32_16x16x32_bf16(ah, Bl[nt][ks], acc[nt], 0, 0, 0);
                acc[nt] = __builtin_amdgcn_mfma_f32_16x16x32_bf16(al, Bh[nt][ks], acc[nt], 0, 0, 0);
            }
        }
#pragma unroll
        for (int nt = 0; nt < 3; ++nt)
#pragma unroll
            for (int r = 0; r < 4; ++r) part[(wave * 16 + 4 * (lane >> 4) + r) * 48 + nt * 16 + (lane & 15)] = acc[nt][r];
        LDS_BARRIER();
        for (int idx = tid; idx < 16 * 36; idx += NTHR) { const int tk = idx / 36, n = idx % 36; float s = 0.f;
#pragma unroll
            for (int w = 0; w < 8; ++w) s += part[(w * 16 + tk) * 48 + n];
            lgt[tk * 36 + n] = s + (n < 4 ? bgrp[n] : brt[n - 4]); }
        LDS_BARRIER();
        if (tid < 16) {
            const size_t m = (size_t)grp * 16 + tid;
            const LAS float* lg = lgt + tid * 36;
            int gi = 0; float gm = lg[0];
#pragma unroll
            for (int n = 1; n < 4; ++n) if (lg[n] > gm) { gm = lg[n]; gi = n; }
            float gs = 0.f;
#pragma unroll
            for (int n = 0; n < 4; ++n) gs += __expf(lg[n] - gm);
            const float pg = 1.f / gs;
            float el[8];
#pragma unroll
            for (int i = 0; i < 8; ++i) el[i] = lg[4 + gi * 8 + i];
            int i1 = 0; float m1 = el[0];
#pragma unroll
            for (int i = 1; i < 8; ++i) if (el[i] > m1) { m1 = el[i]; i1 = i; }
            int i2 = -1; float m2 = -3.0e38f;
#pragma unroll
            for (int i = 0; i < 8; ++i) if (i != i1 && el[i] > m2) { m2 = el[i]; i2 = i; }
            const float e2 = __expf(m2 - m1), inv = 1.f / (1.f + e2);
            const int ea = gi * 8 + i1, eb = gi * 8 + i2;
            tok_e[m * 2] = ea; tok_e[m * 2 + 1] = eb; tok_w[m * 2] = pg * inv; tok_w[m * 2 + 1] = pg * e2 * inv;
            atomicAdd((int*)&hist[ea], 1); atomicAdd((int*)&hist[eb], 1);
        }
        LDS_BARRIER();
    }
    if (tid < 32) ((int*)(ws + WS_BLKC))[bid * 32 + tid] = hist[tid];
}

__device__ __forceinline__ void moe_sort(unsigned char* ws, LAS unsigned char* lds, int bid, int G, int tid) {
    const int* blkc = (const int*)(ws + WS_BLKC); const int* tok_e = (const int*)(ws + WS_TOKE); const float* tok_w = (const float*)(ws + WS_TOKW);
    int* tok_s = (int*)(ws + WS_TOKS); int* slot_t = (int*)(ws + WS_SLOTT); float* slot_w = (float*)(ws + WS_SLOTW); int* tile = (int*)(ws + WS_TILE);
    LAS int* ptot = (LAS int*)lds; LAS int* pbase = ptot + 512; LAS int* tot = pbase + 512; LAS int* base = tot + 32; LAS int* pstart = base + 32; LAS int* lcur = pstart + 33;
    { const int e = tid & 31, part = tid >> 5; int st = 0, sb = 0;
      for (int b = part; b < G; b += 16) { const int c = blkc[b * 32 + e]; st += c; sb += (b < bid) ? c : 0; }
      ptot[part * 32 + e] = st; pbase[part * 32 + e] = sb; }
    __syncthreads();
    if (tid < 32) { int st = 0, sb = 0;
#pragma unroll
        for (int p = 0; p < 16; ++p) { st += ptot[p * 32 + tid]; sb += pbase[p * 32 + tid]; }
        tot[tid] = st; base[tid] = sb; lcur[tid] = 0; }
    __syncthreads();
    if (tid == 0) { int acc = 0; for (int e = 0; e < 32; ++e) { pstart[e] = acc; acc += (tot[e] + 255) & ~255; } pstart[32] = acc; }
    __syncthreads();
    if (bid == 0) {
        const int nt = pstart[32] >> 8;
        if (tid == 0) tile[511] = nt;
        for (int t = tid; t < nt; t += NTHR) { int e = 0; for (int q = 1; q < 32; ++q) if ((t << 8) >= pstart[q]) e = q; tile[t] = e; }
    }
    for (int e = bid; e < 32; e += G)
        for (int s = pstart[e] + tot[e] + tid; s < pstart[e + 1]; s += NTHR) { slot_t[s] = 0; slot_w[s] = 0.f; }
    for (int grp = bid; grp < T / 16; grp += G) {
        if (tid < 32) { const size_t a = (size_t)grp * 32 + tid; const int e = tok_e[a]; const int rank = atomicAdd((int*)&lcur[e], 1);
            const int s = pstart[e] + base[e] + rank; slot_t[s] = (int)(a >> 1); slot_w[s] = tok_w[a]; tok_s[a] = s; }
    }
}

template <bool FINAL>
__device__ __forceinline__ void combine_ln(unsigned char* ws, const float* lng, const float* lnb, float* dout, int gw, int NGW, int lane) {
    float* h1 = (float*)(ws + WS_H1); const bf16* y2 = (const bf16*)(ws + WS_Y2); const int* tok_s = (const int*)(ws + WS_TOKS); bf16* h2b = (bf16*)(ws + WS_H2B);
    f32x4 gv[4], bv[4];
#pragma unroll
    for (int j = 0; j < 4; ++j) { gv[j] = *(const f32x4*)(lng + 4 * lane + 256 * j); bv[j] = *(const f32x4*)(lnb + 4 * lane + 256 * j); }
    for (int m = gw; m < T; m += NGW) {
        const int s0 = tok_s[(size_t)m * 2], s1 = tok_s[(size_t)m * 2 + 1];
        const GAS f32x4* hr = (const GAS f32x4*)(h1 + (size_t)m * D) + lane;
        const GAS u32x2* ya = (const GAS u32x2*)(y2 + (size_t)s0 * D) + lane; const GAS u32x2* yb = (const GAS u32x2*)(y2 + (size_t)s1 * D) + lane;
        f32x4 v[4]; float s = 0.f;
#pragma unroll
        for (int j = 0; j < 4; ++j) { const f32x4 h = hr[64 * j]; const u32x2 a = ya[64 * j], b = yb[64 * j];
            v[j].x = h.x * ALPHA + (bflo(a.x) + bflo(b.x)); v[j].y = h.y * ALPHA + (bfhi(a.x) + bfhi(b.x)); v[j].z = h.z * ALPHA + (bflo(a.y) + bflo(b.y)); v[j].w = h.w * ALPHA + (bfhi(a.y) + bfhi(b.y));
            s += (v[j].x + v[j].y) + (v[j].z + v[j].w); }
        const float mean = wave_sum(s) * (1.f / D); float s2 = 0.f;
#pragma unroll
        for (int j = 0; j < 4; ++j) { v[j] = v[j] - mean; s2 += (v[j].x * v[j].x + v[j].y * v[j].y) + (v[j].z * v[j].z + v[j].w * v[j].w); }
        const float rstd = 1.f / sqrtf(wave_sum(s2) * (1.f / D) + LN_EPS);
#pragma unroll
        for (int j = 0; j < 4; ++j) { const f32x4 h = v[j] * rstd * gv[j] + bv[j];
            if (FINAL) ((GAS f32x4*)(dout + (size_t)m * D) + lane)[64 * j] = h;
            else { ((GAS f32x4*)(h1 + (size_t)m * D) + lane)[64 * j] = h; u32x2 w; w.x = pk2(h.x, h.y); w.y = pk2(h.z, h.w); ((GAS u32x2*)(h2b + (size_t)m * D) + lane)[64 * j] = w; } }
    }
}
constexpr int S5_HST = 272, S5_UST = 272, S5_UOFF = 8 * 32 * S5_HST;
#define MFMA32(a, b, c) __builtin_amdgcn_mfma_f32_32x32x16_bf16((a), (b), (c), 0, 0, 0)
#define MFMA16(a, b, c) __builtin_amdgcn_mfma_f32_16x16x32_bf16((a), (b), (c), 0, 0, 0)
__device__ __forceinline__ float gelu_tanh(float x) {
    const float u = 0.7978845608028654f * (x + 0.044715f * x * x * x);
    const float e = __expf(2.f * u); const float th = 1.f - 2.f * __builtin_amdgcn_rcpf(e + 1.f);
    return 0.5f * x * (1.f + th);
}
__device__ __forceinline__ f32x4 ld_ys(const float* p) {
    f32x4 v;
    v.x = __hip_atomic_load(p, __ATOMIC_RELAXED, __HIP_MEMORY_SCOPE_AGENT); v.y = __hip_atomic_load(p + 1, __ATOMIC_RELAXED, __HIP_MEMORY_SCOPE_AGENT);
    v.z = __hip_atomic_load(p + 2, __ATOMIC_RELAXED, __HIP_MEMORY_SCOPE_AGENT); v.w = __hip_atomic_load(p + 3, __ATOMIC_RELAXED, __HIP_MEMORY_SCOPE_AGENT);
    return v;
}
template <int PASS, int DIR>
__device__ __forceinline__ void s5_dir(unsigned char* ws, const float* s5d, int b, int g, int c, LAS unsigned char* hl, const LAS unsigned char* ul, float* yscr, int lane) {
    const bf16* h0 = (const bf16*)(ws + WS_H0);
    const int dg = DIR * 32 + g;
    const f32x4 L4 = *(const f32x4*)((const float*)(ws + WS_S5L) + (size_t)(dg * 64 + lane) * 4);
    const float ar = L4.x, ai = L4.y, qr = L4.z, qi = L4.w;
    const float l2r = ar * ar - ai * ai, l2i = 2.f * ar * ai, l4r = l2r * l2r - l2i * l2i, l4i = 2.f * l2r * l2i, l8r = l4r * l4r - l4i * l4i, l8i = 2.f * l4r * l4i;
    const float l16r = l8r * l8r - l8i * l8i, l16i = 2.f * l8r * l8i, l32r = l16r * l16r - l16i * l16i, l32i = 2.f * l16r * l16i;
    const bf16* Bb = (const bf16*)(ws + WS_S5B) + (size_t)dg * 2048 + (lane & 31) * 16 + 8 * (lane >> 5);
    const bf16x8 bre0 = *(const bf16x8*)Bb, bre1 = *(const bf16x8*)(Bb + 512), bim0 = *(const bf16x8*)(Bb + 1024), bim1 = *(const bf16x8*)(Bb + 1536);
    bf16x8 cf[4]; bf16x8 dfrag;
    if (PASS == 2) {
        const bf16* Cm = (const bf16*)(ws + WS_S5C) + (size_t)dg * 2048 + (lane & 15) * 128 + 8 * (lane >> 4);
#pragma unroll
        for (int ks = 0; ks < 4; ++ks) cf[ks] = *(const bf16x8*)(Cm + 32 * ks);
        if (DIR == 1) {
            const int cc = lane & 15, kq = lane >> 4; const float d = s5d[g * 16 + cc]; const unsigned dh = f2bf(d); const unsigned dl = f2bf(d - __uint_as_float(dh << 16));
#pragma unroll
            for (int j = 0; j < 8; ++j) { const int k = 8 * (kq & 1) + j; dfrag[j] = (short)((k == cc) ? (kq < 2 ? dh : dl) : 0u); }
        }
    }
    float hr = 0.f, hi = 0.f;
    float* Ec = (float*)(ws + WS_S5E) + ((size_t)((DIR * NB + b) * 32 + g) * S5NCH) * 128 + 2 * lane;
    if (PASS == 2) {
        const int nj = DIR == 0 ? c : (S5NCH - 1 - c);
        for (int j0 = 0; j0 < nj; j0 += 8) {
            f32x2 e[8];
#pragma unroll
            for (int q = 0; q < 8; ++q) { const int j = j0 + q; const int jj = DIR == 0 ? j : (S5NCH - 1 - j); e[q] = (j < nj) ? *(const f32x2*)(Ec + (size_t)jj * 128) : (f32x2){0.f, 0.f}; }
#pragma unroll
            for (int q = 0; q < 8; ++q) if (j0 + q < nj) { const float nr = qr * hr - qi * hi + e[q].x; hi = qr * hi + qi * hr + e[q].y; hr = nr; }
        }
    }
    const size_t rowbase = (size_t)b * SEQ + (size_t)c * S5CH;
    const LAS unsigned char* up = ul + (lane & 31) * S5_UST + (g & 7) * 32 + 16 * (lane >> 5);
    const f32x16 zero16 = {0.f, 0.f, 0.f, 0.f, 0.f, 0.f, 0.f, 0.f, 0.f, 0.f, 0.f, 0.f, 0.f, 0.f, 0.f, 0.f};
#pragma unroll 1
    for (int ti = 0; ti < S5CH / 32; ++ti) {
        const int tile = DIR == 0 ? ti : (S5CH / 32 - 1 - ti);
        const bf16x8 a = *(const LAS bf16x8*)(up + tile * 32 * S5_UST);
        f32x4 ysv[2] = {{0.f, 0.f, 0.f, 0.f}, {0.f, 0.f, 0.f, 0.f}};
        if (PASS == 2 && DIR == 1) { ysv[0] = ld_ys(yscr + (size_t)(tile * 2) * 256 + 4 * lane); ysv[1] = ld_ys(yscr + (size_t)(tile * 2 + 1) * 256 + 4 * lane); }
        f32x16 xr0 = MFMA32(a, bre0, zero16), xr1 = MFMA32(a, bre1, zero16), xi0 = MFMA32(a, bim0, zero16), xi1 = MFMA32(a, bim1, zero16);
        __builtin_amdgcn_sched_barrier(0);
        asm volatile("s_nop 15\n\ts_nop 15\n\ts_nop 15\n\ts_nop 15" ::: "memory");
        __builtin_amdgcn_sched_barrier(0);
        float xr[32], xi[32];
#pragma unroll
        for (int r = 0; r < 16; ++r) {
            auto s = __builtin_amdgcn_permlane32_swap(__float_as_uint(xr0[r]), __float_as_uint(xr1[r]), false, false);
            xr[crow(r, 0)] = __uint_as_float(s[0]); xr[crow(r, 1)] = __uint_as_float(s[1]);
            auto q = __builtin_amdgcn_permlane32_swap(__float_as_uint(xi0[r]), __float_as_uint(xi1[r]), false, false);
            xi[crow(r, 0)] = __uint_as_float(q[0]); xi[crow(r, 1)] = __uint_as_float(q[1]);
        }
        if (PASS == 1) {
#pragma unroll
            for (int lv = 0; lv < 5; ++lv) {
                const float pr = lv == 0 ? ar : lv == 1 ? l2r : lv == 2 ? l4r : lv == 3 ? l8r : l16r, pi = lv == 0 ? ai : lv == 1 ? l2i : lv == 2 ? l4i : lv == 3 ? l8i : l16i;
#pragma unroll
                for (int i = 0; i < (16 >> lv); ++i) {
                    const int e = DIR == 0 ? 2 * i : 2 * i + 1, l = DIR == 0 ? 2 * i + 1 : 2 * i;
                    const float er = xr[e << lv], ei = xi[e << lv], lr_ = xr[l << lv], li_ = xi[l << lv];
                    const float wr = fmaf(pr, er, fmaf(-pi, ei, lr_)), wi = fmaf(pr, ei, fmaf(pi, er, li_));
                    xr[(2 * i) << lv] = wr; xi[(2 * i) << lv] = wi;
                }
            }
            { const float nr = fmaf(l32r, hr, fmaf(-l32i, hi, xr[0])), ni = fmaf(l32r, hi, fmaf(l32i, hr, xi[0])); hr = nr; hi = ni; }
        } else {
#pragma unroll
        for (int tt = 0; tt < 32; ++tt) {
            const int t = DIR == 0 ? tt : 31 - tt;
            const float tr_ = fmaf(-ai, hi, xr[t]), ti_ = fmaf(ai, hr, xi[t]);
            hr = fmaf(ar, hr, tr_); hi = fmaf(ar, hi, ti_);
            *(LAS unsigned*)(hl + t * S5_HST + 4 * lane) = pk2(hr, hi);
        }
        }
        if (PASS == 2) {
#pragma unroll
            for (int sub = 0; sub < 2; ++sub) {
                float* ys = yscr + (size_t)(tile * 2 + sub) * 256 + 4 * lane;
                f32x4 y = {0.f, 0.f, 0.f, 0.f};
                if (DIR == 1) y = ysv[sub];
#pragma unroll
                for (int ks = 0; ks < 4; ++ks) { const bf16x8 hf = *(const LAS bf16x8*)(hl + (sub * 16 + (lane & 15)) * S5_HST + 64 * ks + 16 * (lane >> 4)); y = MFMA16(hf, cf[ks], y); }
                if (DIR == 0) *(f32x4*)ys = y;
                else {
                    const bf16x8 uf = *(const LAS bf16x8*)(ul + (tile * 32 + sub * 16 + (lane & 15)) * S5_UST + (g & 7) * 32 + 16 * ((lane >> 4) & 1));
                    y = MFMA16(uf, dfrag, y);
                    bf16* yo = (bf16*)(ws + WS_YG) + (rowbase + tile * 32 + sub * 16 + 4 * (lane >> 4)) * 512 + g * 16 + (lane & 15);
#pragma unroll
                    for (int r = 0; r < 4; ++r) yo[(size_t)r * 512] = (bf16)f2bf(gelu_tanh(y[r]));
                }
            }
        }
    }
    if (PASS == 1) { f32x2 e; e.x = hr; e.y = hi; *(f32x2*)(Ec + (size_t)c * 128) = e; }
}
template <int PASS>
__device__ __forceinline__ void s5_phase(unsigned char* ws, const float* s5d, LAS unsigned char* lds, int bid, int G, int tid, int wave, int lane) {
    LAS unsigned char* hl = lds + wave * (32 * S5_HST); LAS unsigned char* ul = lds + S5_UOFF;
    float* yscr = (float*)(ws + WS_YSCR) + (size_t)(bid * NWAVES + wave) * 4096;
    const bf16* h0 = (const bf16*)(ws + WS_H0);
    for (int it = bid; it < NB * S5NCH * 4; it += G) {
        const int go = it & 3, c = (it >> 2) % S5NCH, b = it / (4 * S5NCH), g = go * 8 + wave;
        { const bf16* src = h0 + ((size_t)b * SEQ + (size_t)c * S5CH) * H0P + OFF_U + go * 128;
          u32x4 v[8];
#pragma unroll
          for (int i = 0; i < 8; ++i) { const int p = i * NTHR + tid; v[i] = *(const u32x4*)(src + (size_t)(p >> 4) * H0P + 8 * (p & 15)); }
          __syncthreads();
#pragma unroll
          for (int i = 0; i < 8; ++i) { const int p = i * NTHR + tid; *(LAS u32x4*)(ul + (p >> 4) * S5_UST + 16 * (p & 15)) = v[i]; }
          __syncthreads(); }
        s5_dir<PASS, 0>(ws, s5d, b, g, c, hl, ul, yscr, lane);
        s5_dir<PASS, 1>(ws, s5d, b, g, c, hl, ul, yscr, lane);
    }
}
constexpr int G_ST = 144;
constexpr int GL_QD = 0, GL_KD = GL_QD + 64 * G_ST, GL_KCT = GL_KD + 64 * G_ST, GL_VT = GL_KCT + 64 * G_ST,
              GL_S = GL_VT + 128 * G_ST, GL_ST = GL_S + 64 * G_ST, GL_END = GL_ST + 2 * 128 * G_ST;
static_assert(GL_END <= RING_BYTES, "GLA LDS");
__device__ __forceinline__ bf16x8 ldfrag32(const LAS unsigned char* base, int row0, int ks, int lane) {
    return *(const LAS bf16x8*)(base + (row0 + (lane & 31)) * G_ST + 32 * ks + 16 * (lane >> 5));
}
__device__ __forceinline__ void gate_tail(float* bcg, const float* gate_w, const float* gate_b, const LAS float* lrs, size_t row0, int tid) {
    const int dir = tid >> 8;
    float gw[16];
#pragma unroll
    for (int r = 0; r < 16; ++r) gw[r] = gate_w[(size_t)(dir * 16 + r) * 256 + (tid & 255)];
    const float gb = gate_b[tid];
    float run = 0.f;
#pragma unroll 4
    for (int i = 0; i < 128; ++i) {
        const int t = dir ? 127 - i : i;
        if ((i & 63) == 0) run = 0.f;
        const LAS f32x4* lp = (const LAS f32x4*)(lrs + t * 32 + dir * 16);
        const f32x4 l0 = lp[0], l1 = lp[1], l2 = lp[2], l3 = lp[3];
        float z = gb + l0.x * gw[0] + l0.y * gw[1] + l0.z * gw[2] + l0.w * gw[3] + l1.x * gw[4] + l1.y * gw[5] + l1.z * gw[6] + l1.w * gw[7]
                     + l2.x * gw[8] + l2.y * gw[9] + l2.z * gw[10] + l2.w * gw[11] + l3.x * gw[12] + l3.y * gw[13] + l3.z * gw[14] + l3.w * gw[15];
        const float ls = fminf(z, 0.f) - __logf(1.f + __expf(-fabsf(z)));
        run += ls * (1.0f / 16.0f);
        bcg[(row0 + t) * 512 + tid] = run;
    }
}
__device__ __forceinline__ size_t gla_tok(int b, int dir, int chunk, int s) { const int pos = chunk * GCH + s; return (size_t)b * SEQ + (dir ? (SEQ - 1 - pos) : pos); }
template <int PASS>
__device__ __forceinline__ void gla_item(unsigned char* ws, const float* bcg, int item, LAS unsigned char* lds, int tid, int wave, int lane) {
    const int sc = item % GNSC, dir = (item / GNSC) & 1, h = (item / (GNSC * 2)) & 3, b = item / (GNSC * 8);
    const bf16* h0 = (const bf16*)(ws + WS_H0);
    LAS unsigned char* QD = lds + GL_QD; LAS unsigned char* KD = lds + GL_KD; LAS unsigned char* KCT = lds + GL_KCT; LAS unsigned char* VT = lds + GL_VT; LAS unsigned char* SS = lds + GL_S; LAS unsigned char* STT = lds + GL_ST;
    const int me = wave >> 1, nd = wave & 1;
    f32x16 st;
#pragma unroll
    for (int r = 0; r < 16; ++r) st[r] = 0.f;
    float dtot = 1.f;
    float* GS = (float*)(ws + WS_GS); float* GD = (float*)(ws + WS_GD);
    const int ibase = item - sc;
    if (PASS == 2) {
        for (int j = 0; j < sc; ++j) {
            const float dj = GD[(size_t)(ibase + j) * 64 + nd * 32 + (lane & 31)];
            const float* gs = GS + (size_t)(ibase + j) * 8192 + nd * 32 + (lane & 31);
#pragma unroll
            for (int r = 0; r < 16; ++r) st[r] = st[r] * dj + gs[(size_t)(me * 32 + crow(r, lane >> 5)) * 64];
        }
#pragma unroll
        for (int r = 0; r < 16; ++r) *(LAS bf16*)(STT + (me * 32 + crow(r, lane >> 5)) * G_ST + (nd * 32 + (lane & 31)) * 2) = (bf16)f2bf(st[r]);
    }
    const float qscale = 0.125f;
    const int s_l = lane;
    const int gcol = dir * 256 + h * 64;
    u32x4 pq, pk, pv0, pv1; f32x4 pb0, pb1, pl0, pl1; float pdec;
#define GLA_LOAD(n) do { const int ch_ = sc * GSC + (n); const size_t tk = gla_tok(b, dir, ch_, s_l), tl = gla_tok(b, dir, ch_, 63); const bf16* rp = h0 + tk * H0P; \
        if (PASS == 2) pq = *(const u32x4*)(rp + OFF_Q + h * 64 + 8 * wave); \
        pk = *(const u32x4*)(rp + OFF_K + h * 64 + 8 * wave); pv0 = *(const u32x4*)(rp + OFF_V + h * 128 + 16 * wave); pv1 = *(const u32x4*)(rp + OFF_V + h * 128 + 16 * wave + 8); \
        pb0 = *(const f32x4*)(bcg + tk * 512 + gcol + 8 * wave); pb1 = *(const f32x4*)(bcg + tk * 512 + gcol + 8 * wave + 4); \
        pl0 = *(const f32x4*)(bcg + tl * 512 + gcol + 8 * wave); pl1 = *(const f32x4*)(bcg + tl * 512 + gcol + 8 * wave + 4); \
        pdec = bcg[tl * 512 + gcol + nd * 32 + (lane & 31)]; } while (0)
    GLA_LOAD(0);
    __syncthreads();
#pragma unroll 1
    for (int n = 0; n < GSC; ++n) {
        LAS unsigned char* STc = STT + (n & 1) * (128 * G_ST); LAS unsigned char* STn = STT + ((n + 1) & 1) * (128 * G_ST);
        { const float bc[8] = {pb0.x, pb0.y, pb0.z, pb0.w, pb1.x, pb1.y, pb1.z, pb1.w}, bl[8] = {pl0.x, pl0.y, pl0.z, pl0.w, pl1.x, pl1.y, pl1.z, pl1.w};
          const float kv[8] = {bflo(pk.x), bfhi(pk.x), bflo(pk.y), bfhi(pk.y), bflo(pk.z), bfhi(pk.z), bflo(pk.w), bfhi(pk.w)};
          if (PASS == 2) {
              const float qv[8] = {bflo(pq.x), bfhi(pq.x), bflo(pq.y), bfhi(pq.y), bflo(pq.z), bfhi(pq.z), bflo(pq.w), bfhi(pq.w)};
              float qd[8], kd[8];
#pragma unroll
              for (int i = 0; i < 8; ++i) { qd[i] = qv[i] * qscale * __expf(bc[i]); kd[i] = kv[i] * __expf(-bc[i]); }
              u32x4 w; w.x = pk2(qd[0], qd[1]); w.y = pk2(qd[2], qd[3]); w.z = pk2(qd[4], qd[5]); w.w = pk2(qd[6], qd[7]);
              *(LAS u32x4*)(QD + s_l * G_ST + 16 * wave) = w;
              w.x = pk2(kd[0], kd[1]); w.y = pk2(kd[2], kd[3]); w.z = pk2(kd[4], kd[5]); w.w = pk2(kd[6], kd[7]);
              *(LAS u32x4*)(KD + s_l * G_ST + 16 * wave) = w;
          }
#pragma unroll
          for (int i = 0; i < 8; ++i) *(LAS bf16*)(KCT + (8 * wave + i) * G_ST + 2 * s_l) = (bf16)f2bf(kv[i] * __expf(bl[i] - bc[i]));
          const unsigned vv[8] = {pv0.x, pv0.y, pv0.z, pv0.w, pv1.x, pv1.y, pv1.z, pv1.w};
#pragma unroll
          for (int i = 0; i < 8; ++i) { *(LAS bf16*)(VT + (16 * wave + 2 * i) * G_ST + 2 * s_l) = (bf16)(vv[i] & 0xffffu); *(LAS bf16*)(VT + (16 * wave + 2 * i + 1) * G_ST + 2 * s_l) = (bf16)(vv[i] >> 16); }
        }
        const float dec = __expf(pdec);
        if (n + 1 < GSC) GLA_LOAD(n + 1);
        LDS_BARRIER();
        if (PASS == 2 && wave < 4) {
            const int ms = wave >> 1, ns = wave & 1;
            f32x16 sa;
#pragma unroll
            for (int r = 0; r < 16; ++r) sa[r] = 0.f;
            if (ns <= ms) {
#pragma unroll
                for (int ks = 0; ks < 4; ++ks) sa = MFMA32(ldfrag32(QD, ms * 32, ks, lane), ldfrag32(KD, ns * 32, ks, lane), sa);
            }
#pragma unroll
            for (int r = 0; r < 16; ++r) { const int s = ms * 32 + crow(r, lane >> 5), s2 = ns * 32 + (lane & 31);
                const bool keep = dir ? (s2 < s) : (s2 <= s);
                *(LAS bf16*)(SS + s * G_ST + 2 * s2) = (bf16)f2bf(keep ? sa[r] : 0.f); }
        }
#pragma unroll
        for (int r = 0; r < 16; ++r) st[r] *= dec;
        dtot *= dec;
#pragma unroll
        for (int ks = 0; ks < 4; ++ks) st = MFMA32(ldfrag32(VT, me * 32, ks, lane), ldfrag32(KCT, nd * 32, ks, lane), st);
        if (PASS == 2 && n + 1 < GSC) {
#pragma unroll
            for (int r = 0; r < 16; ++r) *(LAS bf16*)(STn + (me * 32 + crow(r, lane >> 5)) * G_ST + (nd * 32 + (lane & 31)) * 2) = (bf16)f2bf(st[r]);
        }
        LDS_BARRIER();
        if (PASS == 2) {
            const int ms = wave >> 2, ne = wave & 3;
            f32x16 oa;
#pragma unroll
            for (int r = 0; r < 16; ++r) oa[r] = 0.f;
#pragma unroll
            for (int ks = 0; ks < 4; ++ks) oa = MFMA32(ldfrag32(SS, ms * 32, ks, lane), ldfrag32(VT, ne * 32, ks, lane), oa);
#pragma unroll
            for (int ks = 0; ks < 4; ++ks) oa = MFMA32(ldfrag32(QD, ms * 32, ks, lane), ldfrag32(STc, ne * 32, ks, lane), oa);
            bf16* op = (bf16*)(ws + (dir ? WS_OB : WS_OF)) + h * 128 + ne * 32 + (lane & 31);
#pragma unroll
            for (int r = 0; r < 16; ++r) op[gla_tok(b, dir, sc * GSC + n, ms * 32 + crow(r, lane >> 5)) * 512] = (bf16)f2bf(oa[r]);
            LDS_BARRIER();
        }
    }
    if (PASS == 1) {
        float* gs = GS + (size_t)item * 8192 + nd * 32 + (lane & 31);
#pragma unroll
        for (int r = 0; r < 16; ++r) gs[(size_t)(me * 32 + crow(r, lane >> 5)) * 64] = st[r];
        if (me == 0 && lane < 32) GD[(size_t)item * 64 + nd * 32 + lane] = dtot;
    }
    __syncthreads();
#undef GLA_LOAD
}
constexpr int AT_KST = 144, AT_VST = 664, AT_K = 0, AT_V = 320 * AT_KST, AT_BT = AT_V + 64 * AT_VST, AT_END = AT_BT + 4 * 260 * 4;
static_assert(AT_END <= RING_BYTES && AT_V % 16 == 0 && AT_BT % 16 == 0, "attention LDS");
__device__ __forceinline__ void attn_phase(unsigned char* ws, const float* sink, LAS unsigned char* lds, int bid, int G, int tid, int wave, int lane) {
    const bf16* qkv = (const bf16*)(ws + WS_QKV); bf16* ao = (bf16*)(ws + WS_AO); const float* btab = (const float*)(ws + WS_BTAB);
    LAS unsigned char* KS = lds + AT_K; LAS unsigned char* VT = lds + AT_V; LAS float* BT = (LAS float*)(lds + AT_BT);
    const float sc2 = 0.125f * LOG2E;
    u32x4 kreg[5], vreg[5];
#define AT_LOAD(u_) do { const int qb_ = (u_) % (SEQ / 64), kvh_ = ((u_) / (SEQ / 64)) & 3, b_ = (u_) / (4 * (SEQ / 64)), kb_ = qb_ * 64 - 128; \
        _Pragma("unroll") for (int it = 0; it < 5; ++it) { const int p = it * NTHR + tid; int key = kb_ + (p >> 3); key = key < 0 ? 0 : (key > SEQ - 1 ? SEQ - 1 : key); \
            const bf16* rp = qkv + ((size_t)b_ * SEQ + key) * CN + kvh_ * 64 + 8 * (p & 7); kreg[it] = *(const u32x4*)(rp + 1024); vreg[it] = *(const u32x4*)(rp + 1280); } } while (0)
    if (bid < NB * 4 * (SEQ / 64)) AT_LOAD(bid);
    for (int u = bid; u < NB * 4 * (SEQ / 64); u += G) {
        const int qb = u % (SEQ / 64), kvh = (u / (SEQ / 64)) & 3, b = u / (4 * (SEQ / 64)), q0 = qb * 64;
#pragma unroll
        for (int it = 0; it < 5; ++it) { const int p = it * NTHR + tid, i = p >> 3, ch = p & 7;
            *(LAS u32x4*)(KS + i * AT_KST + 16 * ch) = kreg[it];
            const unsigned vv[4] = {vreg[it].x, vreg[it].y, vreg[it].z, vreg[it].w};
#pragma unroll
            for (int j = 0; j < 4; ++j) { *(LAS bf16*)(VT + (8 * ch + 2 * j) * AT_VST + 2 * i) = (bf16)(vv[j] & 0xffffu); *(LAS bf16*)(VT + (8 * ch + 2 * j + 1) * AT_VST + 2 * i) = (bf16)(vv[j] >> 16); } }
        for (int p = tid; p < 4 * 260; p += NTHR) BT[p] = btab[(kvh * 4) * 260 + p];
        if (u + G < NB * 4 * (SEQ / 64)) AT_LOAD(u + G);
        LDS_BARRIER();
        const int hl = wave >> 1, hq = kvh * 4 + hl, qw = q0 + 32 * (wave & 1), qi = qw + (lane & 31), hh = lane >> 5;
        bf16x8 qf[4];
        { const bf16* qp = qkv + ((size_t)b * SEQ + qi) * CN + hq * 64 + 8 * hh;
#pragma unroll
          for (int ks = 0; ks < 4; ++ks) qf[ks] = *(const bf16x8*)(qp + 16 * ks); }
        float m = sink[hq] * LOG2E, l = hh == 0 ? 1.f : 0.f;
        f32x16 o0, o1;
#pragma unroll
        for (int r = 0; r < 16; ++r) { o0[r] = 0.f; o1[r] = 0.f; }
        const LAS float* btr = BT + hl * 260 + 128 - (lane & 31);
#pragma unroll 1
        for (int j = 0; j < 9; ++j) {
            const int i0 = 32 * (wave & 1) + 32 * j;
            f32x16 sa;
#pragma unroll
            for (int r = 0; r < 16; ++r) sa[r] = 0.f;
#pragma unroll
            for (int ks = 0; ks < 4; ++ks) { const bf16x8 kf = *(const LAS bf16x8*)(KS + (i0 + (lane & 31)) * AT_KST + 32 * ks + 16 * hh); sa = MFMA32(kf, qf[ks], sa); }
            float mx = -3.0e38f;
#pragma unroll
            for (int r = 0; r < 16; ++r) {
                const int kk = 32 * j - 128 + crow(r, hh);
                const int rel = kk - (lane & 31), key = qw + kk;
                const bool ok = ((unsigned)(rel + 128) <= 256u) && ((unsigned)key < (unsigned)SEQ);
                const float s = ok ? (sa[r] * sc2 + btr[kk]) : -3.0e38f;
                sa[r] = s; mx = fmaxf(mx, s);
            }
            mx = fmaxf(mx, __shfl_xor(mx, 32));
            if (!__all(mx <= m)) {
                const float mn = fmaxf(m, mx), alpha = __builtin_amdgcn_exp2f(m - mn); m = mn; l *= alpha;
#pragma unroll
                for (int r = 0; r < 16; ++r) { o0[r] *= alpha; o1[r] *= alpha; }
            }
            float ps = 0.f;
#pragma unroll
            for (int r = 0; r < 16; ++r) { const float p = __builtin_amdgcn_exp2f(sa[r] - m); sa[r] = p; ps += p; }
            l += ps;
#pragma unroll
            for (int s = 0; s < 2; ++s) {
                u32x4 pw; pw.x = pk2(sa[8 * s], sa[8 * s + 1]); pw.y = pk2(sa[8 * s + 2], sa[8 * s + 3]); pw.z = pk2(sa[8 * s + 4], sa[8 * s + 5]); pw.w = pk2(sa[8 * s + 6], sa[8 * s + 7]);
                const bf16x8 pf = __builtin_bit_cast(bf16x8, pw);
#pragma unroll
                for (int dt = 0; dt < 2; ++dt) {
                    const LAS unsigned char* vp = VT + (dt * 32 + (lane & 31)) * AT_VST + 2 * (i0 + 16 * s + 4 * hh);
                    const bf16x4 va = *(const LAS bf16x4*)vp, vb = *(const LAS bf16x4*)(vp + 16);
                    const bf16x8 vf = __builtin_shufflevector(va, vb, 0, 1, 2, 3, 4, 5, 6, 7);
                    if (dt == 0) o0 = MFMA32(vf, pf, o0); else o1 = MFMA32(vf, pf, o1);
                }
            }
        }
        l += __shfl_xor(l, 32);
        const float inv = __builtin_amdgcn_rcpf(l);
        bf16* op = ao + ((size_t)b * SEQ + qi) * D + hq * 64 + 4 * hh;
#pragma unroll
        for (int g = 0; g < 4; ++g) {
            u32x2 w0, w1; w0.x = pk2(o0[4 * g] * inv, o0[4 * g + 1] * inv); w0.y = pk2(o0[4 * g + 2] * inv, o0[4 * g + 3] * inv);
            w1.x = pk2(o1[4 * g] * inv, o1[4 * g + 1] * inv); w1.y = pk2(o1[4 * g + 2] * inv, o1[4 * g + 3] * inv);
            *(u32x2*)(op + 8 * g) = w0; *(u32x2*)(op + 32 + 8 * g) = w1;
        }
        LDS_BARRIER();
    }
#undef AT_LOAD
}
#ifndef MK_N_LAUNCHES
#define MK_N_LAUNCHES 1
#endif
constexpr int N_PHASES = 19;
#ifndef PH_MASK
#define PH_MASK 0xFFFFFFFFu
#endif
#define ON(k) (((PH_MASK) >> (k)) & 1u)
#ifndef REP_MASK
#define REP_MASK 0u
#endif
#define NREP(k) ((((REP_MASK) >> (k)) & 1u) ? 2 : 1)

template <int LAYER>
__device__ __forceinline__ void common_phases(unsigned char* ws, LAS unsigned char* lds, float* dout, const XcdBarrier& bar, int lo, int hi, int bid, int G, int tid, int wave, int lane) {
    constexpr int pb = LAYER == 0 ? 5 : 13;
    const int gw = bid * NWAVES + wave, NGW = G * NWAVES;
#define IN(k) (lo <= (k) && (k) < hi)
#define SEAM(k) do { if (IN(k) && IN((k) + 1)) xcd_barrier(bar); } while (0)
    if (ON(5) && IN(pb)) {
        pg8::Gemm g{(const bf16*)(ws + (LAYER == 0 ? WS_X64 : WS_AO)), (const bf16*)(ws + (LAYER == 0 ? WS_WOUT : WS_COUT)), T, D, D, 0, nullptr}; pg8::StaticOrder S; S.init(T, D, G, bid);
        pg8::EpiBf16 E{(bf16*)(ws + WS_Z), D};
        pg8::gemm_phase<pg8::EpiBf16, pg8::StaticOrder, false>(lds, g, S, E);
    }
    SEAM(pb);
    if (ON(6) && IN(pb + 1)) { ln_router(ws, LAYER == 0 ? inp(lds, I_X) : (const float*)(ws + WS_H1), inp(lds, I_LNMG) + LAYER * D, inp(lds, I_LNMB) + LAYER * D, inp(lds, I_BGRP) + LAYER * 4, inp(lds, I_BRT) + LAYER * 32, LAYER, lds, bid, G, tid, wave, lane); __syncthreads(); }
    SEAM(pb + 1);
    if (ON(7) && IN(pb + 2)) { moe_sort(ws, lds, bid, G, tid); __syncthreads(); }
    SEAM(pb + 2);
    if (ON(8) && IN(pb + 3)) {
        const int* tile = (const int*)(ws + WS_TILE); const int ntiles = __builtin_amdgcn_readfirstlane(tile[511]);
        pg8::Gemm g{(const bf16*)(ws + WS_X64), LAYER == 0 ? (const bf16*)(ws + WS_W13) : (const bf16*)dout, 0, D, D, (size_t)D * D * 2, (const int*)(ws + WS_SLOTT)};
        pg8::GroupOrder S{tile, ntiles, D / 256, G, bid};
        pg8::EpiSwiglu E{(bf16*)(ws + WS_HID), DEXP};
        pg8::gemm_phase<pg8::EpiSwiglu, pg8::GroupOrder, true>(lds, g, S, E);
        if (LAYER == 0) idle_convert(0, ws, lds, dout, ntiles, bid, G, wave, lane);
    }
    SEAM(pb + 3);
    if (ON(9) && IN(pb + 4)) {
        const int* tile = (const int*)(ws + WS_TILE); const int ntiles = __builtin_amdgcn_readfirstlane(tile[511]);
        pg8::Gemm g{(const bf16*)(ws + WS_HID), LAYER == 0 ? (const bf16*)(ws + WS_W2) : (const bf16*)dout + (size_t)NEXP * D * D, 0, D, DEXP, (size_t)D * DEXP * 2, nullptr};
        pg8::GroupOrder S{tile, ntiles, D / 256, G, bid};
        pg8::EpiScale E{(bf16*)(ws + WS_Y2), D, (const float*)(ws + WS_SLOTW)};
        pg8::gemm_phase<pg8::EpiScale, pg8::GroupOrder, false>(lds, g, S, E);
        if (LAYER == 0) idle_convert(1, ws, lds, dout, ntiles, bid, G, wave, lane);
    }
    SEAM(pb + 4);
    if (ON(10) && IN(pb + 5)) {
        if (LAYER == 0) {
            combine_ln<false>(ws, inp(lds, I_LNFG), inp(lds, I_LNFB), nullptr, gw, NGW, lane);
            { const int done = idle_done(__builtin_amdgcn_readfirstlane(((const int*)(ws + WS_TILE))[511]), G);
              moe_convert(inp(lds, I_W1) + (size_t)NEXP * D * DEXP, inp(lds, I_W3) + (size_t)NEXP * D * DEXP, inp(lds, I_W2) + (size_t)NEXP * DEXP * D, (bf16*)dout, (bf16*)dout + (size_t)NEXP * D * D, (LAS float*)(lds + wave * 16384), done, MOE_ITEMS, gw, NGW, lane); }
            __syncthreads();
        } else combine_ln<true>(ws, inp(lds, I_LNFG) + D, inp(lds, I_LNFB) + D, dout, gw, NGW, lane);
    }
    if (LAYER == 0) SEAM(10);
#undef IN
#undef SEAM
}

struct Args { const float* in[N_IN]; float* out; unsigned char* ws; int ph_lo, ph_hi; };
static_assert(sizeof(Args) == N_IN * 8 + 8 + 8 + 8, "no padding holes in Args");

__global__ void __launch_bounds__(NTHR, 2) fwd_kernel(Args args) {
    extern __shared__ __attribute__((aligned(16))) unsigned char lds_raw[];
    LAS unsigned char* lds = (LAS unsigned char*)lds_raw;
    volatile LAS unsigned* MISC = (volatile LAS unsigned*)(lds + MISC_OFF);
    const int tid = threadIdx.x, lane = tid & 63, wave = __builtin_amdgcn_readfirstlane(tid >> 6), G = gridDim.x, bid = blockIdx.x;
    unsigned char* ws = args.ws;
    for (int u = tid; u < 64; u += NTHR) MISC[u] = 0u;
    if (tid < N_IN) *(LAS unsigned long long*)(lds + PTR_OFF + 8 * tid) = (unsigned long long)args.in[tid];
    __syncthreads();
    const int lo = args.ph_lo, hi = args.ph_hi;
    const bool use_bar = (hi - lo) > 1;
    XcdBarrier bar; bar.bar = (unsigned*)(ws + WS_CTL) + CW_BAR; bar.x = 0; bar.st = nullptr;
    if (use_bar) bar = xcd_barrier_post((unsigned*)(ws + WS_CTL) + CW_BAR, MISC + 8);
#define IN(k) (lo <= (k) && (k) < hi)
#define SEAM(k) do { if (IN(k) && IN((k) + 1)) xcd_barrier(bar); } while (0)
    const int gw = bid * NWAVES + wave, NGW = G * NWAVES;

    if (ON(0) && IN(0)) { p0_prologue(ws, lds, bid, G, tid, wave, lane); __syncthreads(); }
    SEAM(0);
    if (ON(1) && IN(1)) {
        pg8::Gemm g{(const bf16*)(ws + WS_X64), (const bf16*)(ws + WS_WIN), T, ABN, D, 0, nullptr}; pg8::SplitOrder S; S.init(T, ABN, 2, G, bid);
        pg8::EpiBf16 E{(bf16*)(ws + WS_H0), H0P};
        pg8::gemm_phase<pg8::EpiBf16, pg8::SplitOrder, false>(lds, g, S, E);
        lr_tail(ws, args.out, inp(lds, I_GATEW), inp(lds, I_GATEB), lds, bid, G, tid, wave, lane);
#ifdef TAIL_TWICE
        lr_tail(ws, args.out, inp(lds, I_GATEW), inp(lds, I_GATEB), lds, bid, G, tid, wave, lane);
#endif
    }
    SEAM(1);
    if (ON(2) && IN(2)) {
        s5_phase<1>(ws, inp(lds, I_S5D), lds, bid, G, tid, wave, lane);
#ifdef S5_TWICE
        __syncthreads(); s5_phase<1>(ws, inp(lds, I_S5D), lds, bid, G, tid, wave, lane);
#endif
        __syncthreads();
        for (int it = bid; it < 256; it += G) gla_item<1>(ws, args.out, it, lds, tid, wave, lane);
#ifdef GLA_TWICE
        for (int it = bid; it < 256; it += G) gla_item<1>(ws, args.out, it, lds, tid, wave, lane);
#endif
    }
    SEAM(2);
    if (ON(3) && IN(3)) {
        s5_phase<2>(ws, inp(lds, I_S5D), lds, bid, G, tid, wave, lane);
#ifdef S5_TWICE
        __syncthreads(); s5_phase<2>(ws, inp(lds, I_S5D), lds, bid, G, tid, wave, lane);
#endif
        __syncthreads();
        for (int it = bid; it < 256; it += G) gla_item<2>(ws, args.out, it, lds, tid, wave, lane);
#ifdef GLA_TWICE
        for (int it = bid; it < 256; it += G) gla_item<2>(ws, args.out, it, lds, tid, wave, lane);
#endif
    }
    SEAM(3);
    if (ON(4) && IN(4)) {
        gla_finalize(ws, inp(lds, I_NORMG), gw, NGW, lane);
        pg8::Gemm g{(const bf16*)(ws + WS_YG), (const bf16*)(ws + WS_WGLU), T, 512, 512, 0, nullptr}; pg8::StaticOrder S; S.init(T, 512, G, bid);
        pg8::EpiGlu E{(const bf16*)(ws + WS_YG), 512, (bf16*)(ws + WS_X64), D, inp(lds, I_GLUB)};
        pg8::gemm_phase<pg8::EpiGlu, pg8::StaticOrder, false>(lds, g, S, E);
    }
    SEAM(4);
    common_phases<0>(ws, lds, args.out, bar, lo, hi, bid, G, tid, wave, lane);
    if (ON(11) && IN(11)) {
        pg8::Gemm g{(const bf16*)(ws + WS_H2B), (const bf16*)(ws + WS_CIN), T, CN, D, 0, nullptr}; pg8::StaticOrder S; S.init(T, CN, G, bid);
        pg8::EpiBf16 E{(bf16*)(ws + WS_QKV), CN};
        pg8::gemm_phase<pg8::EpiBf16, pg8::StaticOrder, false>(lds, g, S, E);
    }
    SEAM(11);
    if (ON(12) && IN(12)) attn_phase(ws, inp(lds, I_SINK), lds, bid, G, tid, wave, lane);
    SEAM(12);
    common_phases<1>(ws, lds, args.out, bar, lo, hi, bid, G, tid, wave, lane);
#undef IN
#undef SEAM
}

extern "C" void kernel_launch(void* const* d_in, const int* in_sizes, int n_in, void* d_out, int out_size, void* d_ws, size_t ws_size, hipStream_t stream) {
    static int grid = 0;
    if (grid == 0) {
        if (n_in != N_IN || in_sizes[0] != T * D || out_size != T * D || ws_size < WS_END) { fprintf(stderr, "kernel_launch: unexpected shapes (n_in %d, in0 %d, out %d, ws %zu < %zu)\n", n_in, n_in > 0 ? in_sizes[0] : -1, out_size, ws_size, (size_t)WS_END); grid = -1; return; }
        int dev = 0, cus = 0, per_cu = 0;
        if (hipGetDevice(&dev) != hipSuccess || hipDeviceGetAttribute(&cus, hipDeviceAttributeMultiprocessorCount, dev) != hipSuccess) { grid = -1; return; }
        if (hipFuncSetAttribute((const void*)fwd_kernel, hipFuncAttributeMaxDynamicSharedMemorySize, LDS_BYTES) != hipSuccess) { fprintf(stderr, "kernel_launch: hipFuncSetAttribute failed\n"); grid = -1; return; }
        if (hipOccupancyMaxActiveBlocksPerMultiprocessor(&per_cu, (const void*)fwd_kernel, NTHR, LDS_BYTES) != hipSuccess || per_cu < 1) fprintf(stderr, "kernel_launch: occupancy query reports %d\n", per_cu);
        (void)hipGetLastError();
        grid = cus;
    }
    if (grid < 0) return;
    if (hipMemsetAsync((char*)d_ws + WS_CTL, 0, CTL_ZERO_BYTES, stream) != hipSuccess) return;
    Args a{};
    for (int i = 0; i < N_IN; ++i) a.in[i] = (const float*)d_in[i];
    a.out = (float*)d_out; a.ws = (unsigned char*)d_ws;
    for (int li = 0; li < MK_N_LAUNCHES; ++li) {
        a.ph_lo = (MK_N_LAUNCHES == 1) ? 0 : li; a.ph_hi = (MK_N_LAUNCHES == 1) ? N_PHASES : li + 1;
        for (int rep = 0; rep < ((MK_N_LAUNCHES > 1 && ((REP_MASK >> li) & 1u)) ? 2 : 1); ++rep)
            hipLaunchKernelGGL(fwd_kernel, dim3(grid), dim3(NTHR), LDS_BYTES, stream, a);
    }
}
```

```cpp
#include <hip/hip_runtime.h>
#include <cstdio>
#include <cstdint>
#include <cmath>
namespace pg8 {
#define PG8_LAS __attribute__((address_space(3)))
typedef unsigned short bf16_t;
typedef short bf16x8 __attribute__((ext_vector_type(8)));
typedef float f32x4 __attribute__((ext_vector_type(4)));
typedef float f32x2 __attribute__((ext_vector_type(2)));
typedef unsigned u32x4 __attribute__((ext_vector_type(4)));
typedef unsigned u32x2 __attribute__((ext_vector_type(2)));
constexpr int BM = 256, BK = 64, HALF = 128, HTB = HALF * BK * 2  , STAGE_BYTES = 8 * HTB, NXCD = 8, WGM = 8;

__host__ __device__ __forceinline__ int lds_byte(int r, int c) { const int st = (r >> 4) * 2 + (c >> 5), rr = r & 15, cc = c & 31, ob = rr * 64 + cc * 2; return st * 1024 + (ob ^ (((ob >> 9) & 1) << 5)); }
__host__ __device__ __forceinline__ void stage_rc(int b, int& R, int& C) { const int st = b / 1024, sb = b % 1024, swz = sb ^ (((sb >> 9) & 1) << 5); R = (st >> 1) * 16 + swz / 64; C = (st & 1) * 32 + (swz % 64) / 2; }
__host__ __device__ __forceinline__ int perm32(int rho) { const int n = rho >> 4, i = rho & 15; return 8 * (i >> 2) + 4 * n + (i & 3); }

struct Unit { int pm, pn, e, ui; };
struct Gemm { const bf16_t* A; const bf16_t* Bt; int M, N, K; size_t bstride; const int* rowmap; };

struct StaticOrder {
    int nM, nN, nwg, G, c;
    __host__ __device__ void init(int M, int N, int G_, int c_) { nM = M / BM; nN = N / BM; nwg = nM * nN; G = G_; c = c_; }
    __host__ __device__ bool next(int i, Unit& u) const {
        const long L = (long)i * G + c; if (L >= nwg) return false;
        int wgid = (int)L; { const int q = nwg / NXCD, r = nwg % NXCD, xcd = wgid % NXCD, off = wgid / NXCD; wgid = (xcd < r ? xcd * (q + 1) : r * (q + 1) + (xcd - r) * q) + off; }
        const int nig = WGM * nN, gid = wgid / nig, fm = gid * WGM, gsz = (nM - fm) < WGM ? (nM - fm) : WGM;
        u.pm = fm + ((wgid % nig) % gsz); u.pn = (wgid % nig) / gsz; u.e = 0; u.ui = i; return true;
    }
};
struct SplitOrder {
    int nM, nNs, nwgs, nsp, G, c;
    __host__ __device__ void init(int M, int N, int nsp_, int G_, int c_) { nM = M / BM; nNs = N / BM / nsp_; nwgs = nM * nNs; nsp = nsp_; G = G_; c = c_; }
    __host__ __device__ bool next(int i, Unit& u) const {
        const long L = (long)i * G + c; if (L >= (long)nwgs * nsp) return false;
        const int slab = (int)(L / nwgs); int wgid = (int)(L % nwgs);
        { const int q = nwgs / NXCD, r = nwgs % NXCD, xcd = wgid % NXCD, off = wgid / NXCD; wgid = (xcd < r ? xcd * (q + 1) : r * (q + 1) + (xcd - r) * q) + off; }
        const int nig = WGM * nNs, gid = wgid / nig, fm = gid * WGM, gsz = (nM - fm) < WGM ? (nM - fm) : WGM;
        u.pm = fm + ((wgid % nig) % gsz); u.pn = slab * nNs + (wgid % nig) / gsz; u.e = 0; u.ui = i; return true;
    }
};
struct GroupOrder {
    const int* tile_e; int ntiles, nN, G, c;
    __device__ bool next(int i, Unit& u) const {
        const int L = i * G + c; if (L >= ntiles * nN) return false;
        u.pm = L / nN; u.pn = L % nN; u.e = __builtin_amdgcn_readfirstlane(tile_e[u.pm]); u.ui = i; return true;
    }
};

typedef __bf16 bf16x2_t __attribute__((ext_vector_type(2)));
__device__ __forceinline__ unsigned cvt_pk_bf16(float lo, float hi) { f32x2 v = {lo, hi}; return __builtin_bit_cast(unsigned, __builtin_convertvector(v, bf16x2_t)); }
__device__ __forceinline__ float bf_lo(unsigned w) { return __uint_as_float(w << 16); }
__device__ __forceinline__ float bf_hi(unsigned w) { return __uint_as_float(w & 0xffff0000u); }

struct EpiBf16 {
    static constexpr bool PERM = true;
    bf16_t* O; int ldc;
    __device__ __forceinline__ void operator()(const f32x4 (&acc)[2][2][4][2], const Unit& u, int wr, int wc, int fr, int fq) const {
        const int row0 = u.pm * BM + wr * 64 + fr; const int col0 = u.pn * BM + wc * 32 + 8 * fq;
#pragma unroll
        for (int ai = 0; ai < 2; ++ai)
#pragma unroll
            for (int m = 0; m < 4; ++m) { bf16_t* rowp = O + (size_t)(row0 + ai * HALF + m * 16) * ldc + col0;
#pragma unroll
                for (int bj = 0; bj < 2; ++bj) { const f32x4 v0 = acc[ai][bj][m][0], v1 = acc[ai][bj][m][1];
                    u32x4 w; w.x = cvt_pk_bf16(v0[0], v0[1]); w.y = cvt_pk_bf16(v0[2], v0[3]); w.z = cvt_pk_bf16(v1[0], v1[1]); w.w = cvt_pk_bf16(v1[2], v1[3]);
                    *(u32x4*)(rowp + bj * HALF) = w; } }
    }
};
struct EpiGlu {
    static constexpr bool PERM = true;
    const bf16_t* Y; int ldy; bf16_t* O; int ldc; const float* bias;
    __device__ __forceinline__ void operator()(const f32x4 (&acc)[2][2][4][2], const Unit& u, int wr, int wc, int fr, int fq) const {
        const int row0 = u.pm * BM + wr * 64 + fr; const int col0 = u.pn * BM + wc * 32 + 8 * fq;
        f32x4 bv[2][2];
#pragma unroll
        for (int bj = 0; bj < 2; ++bj)
#pragma unroll
            for (int n = 0; n < 2; ++n) bv[bj][n] = *(const f32x4*)(bias + col0 + bj * HALF + 4 * n);
#pragma unroll
        for (int ai = 0; ai < 2; ++ai) {
            u32x4 yq[4][2];
#pragma unroll
            for (int m = 0; m < 4; ++m)
#pragma unroll
                for (int bj = 0; bj < 2; ++bj) yq[m][bj] = *(const u32x4*)(Y + (size_t)(row0 + ai * HALF + m * 16) * ldy + col0 + bj * HALF);
            asm volatile("" ::: "memory");
#pragma unroll
            for (int m = 0; m < 4; ++m) { const size_t r = (size_t)(row0 + ai * HALF + m * 16);
#pragma unroll
                for (int bj = 0; bj < 2; ++bj) { const f32x4 v0 = acc[ai][bj][m][0] + bv[bj][0], v1 = acc[ai][bj][m][1] + bv[bj][1];
                    const u32x4 y = yq[m][bj];
                    float o[8]; const float yv[8] = {bf_lo(y.x), bf_hi(y.x), bf_lo(y.y), bf_hi(y.y), bf_lo(y.z), bf_hi(y.z), bf_lo(y.w), bf_hi(y.w)};
#pragma unroll
                    for (int i = 0; i < 4; ++i) { o[i] = yv[i] * __builtin_amdgcn_rcpf(1.f + __expf(-v0[i])); o[4 + i] = yv[4 + i] * __builtin_amdgcn_rcpf(1.f + __expf(-v1[i])); }
                    u32x4 w; w.x = cvt_pk_bf16(o[0], o[1]); w.y = cvt_pk_bf16(o[2], o[3]); w.z = cvt_pk_bf16(o[4], o[5]); w.w = cvt_pk_bf16(o[6], o[7]);
                    *(u32x4*)(O + r * ldc + col0 + bj * HALF) = w; } }
            asm volatile("" ::: "memory");
        }
    }
};
struct EpiResid {
    static constexpr bool PERM = false;
    const float* resid; float* out; int ldc; float alpha;
    __device__ __forceinline__ void operator()(const f32x4 (&acc)[2][2][4][2], const Unit& u, int wr, int wc, int fr, int fq) const {
        const int col0 = u.pn * BM + wc * 32 + 4 * fq;
#pragma unroll
        for (int ai = 0; ai < 2; ++ai) {
            f32x4 bs[4][2][2];
#pragma unroll
            for (int m = 0; m < 4; ++m) { const size_t off = (size_t)(u.pm * BM + ai * HALF + wr * 64 + m * 16 + fr) * ldc + col0;
#pragma unroll
                for (int bj = 0; bj < 2; ++bj)
#pragma unroll
                    for (int n = 0; n < 2; ++n) bs[m][bj][n] = *(const f32x4*)(resid + off + bj * HALF + n * 16); }
            asm volatile("" ::: "memory");
#pragma unroll
            for (int m = 0; m < 4; ++m) { const size_t off = (size_t)(u.pm * BM + ai * HALF + wr * 64 + m * 16 + fr) * ldc + col0;
#pragma unroll
                for (int bj = 0; bj < 2; ++bj)
#pragma unroll
                    for (int n = 0; n < 2; ++n) *(f32x4*)(out + off + bj * HALF + n * 16) = bs[m][bj][n] * alpha + acc[ai][bj][m][n]; }
            asm volatile("" ::: "memory");
        }
    }
};
struct EpiSwiglu {
    static constexpr bool PERM = true;
    bf16_t* O; int ldc;
    __device__ __forceinline__ void operator()(const f32x4 (&acc)[2][2][4][2], const Unit& u, int wr, int wc, int fr, int fq) const {
        const int row0 = u.pm * BM + wr * 64 + fr; const int col0 = (u.pn * BM + wc * 32 + 8 * fq) >> 1;
#pragma unroll
        for (int ai = 0; ai < 2; ++ai)
#pragma unroll
            for (int m = 0; m < 4; ++m) { bf16_t* rowp = O + (size_t)(row0 + ai * HALF + m * 16) * ldc + col0;
#pragma unroll
                for (int bj = 0; bj < 2; ++bj) { const f32x4 g = acc[ai][bj][m][0], up = acc[ai][bj][m][1]; float o[4];
#pragma unroll
                    for (int i = 0; i < 4; ++i) o[i] = g[i] * __builtin_amdgcn_rcpf(1.f + __expf(-g[i])) * up[i];
                    u32x2 w; w.x = cvt_pk_bf16(o[0], o[1]); w.y = cvt_pk_bf16(o[2], o[3]);
                    *(u32x2*)(rowp + bj * (HALF / 2)) = w; } }
    }
};
struct EpiScale {
    static constexpr bool PERM = true;
    bf16_t* O; int ldc; const float* rw;
    __device__ __forceinline__ void operator()(const f32x4 (&acc)[2][2][4][2], const Unit& u, int wr, int wc, int fr, int fq) const {
        const int row0 = u.pm * BM + wr * 64 + fr; const int col0 = u.pn * BM + wc * 32 + 8 * fq;
        float sw[2][4];
#pragma unroll
        for (int ai = 0; ai < 2; ++ai)
#pragma unroll
            for (int m = 0; m < 4; ++m) sw[ai][m] = rw[row0 + ai * HALF + m * 16];
        asm volatile("" ::: "memory");
#pragma unroll
        for (int ai = 0; ai < 2; ++ai)
#pragma unroll
            for (int m = 0; m < 4; ++m) { const int r = row0 + ai * HALF + m * 16; const float s = sw[ai][m]; bf16_t* rowp = O + (size_t)r * ldc + col0;
#pragma unroll
                for (int bj = 0; bj < 2; ++bj) { const f32x4 v0 = acc[ai][bj][m][0] * s, v1 = acc[ai][bj][m][1] * s;
                    u32x4 w; w.x = cvt_pk_bf16(v0[0], v0[1]); w.y = cvt_pk_bf16(v0[2], v0[3]); w.z = cvt_pk_bf16(v1[0], v1[1]); w.w = cvt_pk_bf16(v1[2], v1[3]);
                    *(u32x4*)(rowp + bj * HALF) = w; } }
    }
};

template <class Epi, class Sched, bool GATHER>
__device__ __forceinline__ void gemm_phase(PG8_LAS unsigned char* lds, const Gemm g, const Sched& S, const Epi& E) {
    const int tid = threadIdx.x, wid = __builtin_amdgcn_readfirstlane(tid >> 6), lane = tid & 63, wr = wid >> 2, wc = wid & 3, fr = lane & 15, fq = lane >> 4;
    const int K = g.K, nt = K / BK;
    unsigned voffA[2], voffB[2]; int RA[2], CA[2];
#pragma unroll
    for (int i = 0; i < 2; ++i) { int R, C; stage_rc(tid * 16 + i * 8192, R, C); const int Rb = Epi::PERM ? ((R & ~31) + perm32(R & 31)) : R;
        voffA[i] = (unsigned)(R * K + C) * 2u; voffB[i] = (unsigned)(Rb * K + C) * 2u; RA[i] = R; CA[i] = C; }
    const size_t kstep = (size_t)(BK * 2);
    const size_t hstep = (size_t)HALF * K * 2;
    const size_t tstep = 2 * hstep;
    const unsigned ldsw = (unsigned)wid * 1024u;
    const int aoff = lds_byte(wr * 64 + fr, fq * 8), boff = lds_byte(wc * 32 + fr, fq * 8);
#define PG8_SA(b, h) (((b) * 2 + (h)) * HTB)
#define PG8_SB(b, h) ((4 + (b) * 2 + (h)) * HTB)
#define PG8_STAGE(bufoff, gbase, voff) do { _Pragma("unroll") for (int _i = 0; _i < 2; ++_i) \
        __builtin_amdgcn_global_load_lds((const unsigned*)((const char*)(gbase) + (voff)[_i]), (PG8_LAS unsigned*)(lds + (bufoff) + ldsw + _i * 8192), 16, 0, 0); } while (0)
#define PG8_LDA(dst, b, h) do { _Pragma("unroll") for (int m = 0; m < 4; ++m) _Pragma("unroll") for (int k = 0; k < 2; ++k) dst[m][k] = *(const PG8_LAS bf16x8*)(lds + PG8_SA(b, h) + aoff + m * 2048 + k * 1024); } while (0)
#define PG8_LDB(dst, b, h) do { _Pragma("unroll") for (int n = 0; n < 2; ++n) _Pragma("unroll") for (int k = 0; k < 2; ++k) dst[n][k] = *(const PG8_LAS bf16x8*)(lds + PG8_SB(b, h) + boff + n * 2048 + k * 1024); } while (0)
#define PG8_MMA(ai, bj, At, Bt) do { __builtin_amdgcn_s_setprio(1); _Pragma("unroll") for (int m = 0; m < 4; ++m) _Pragma("unroll") for (int n = 0; n < 2; ++n) _Pragma("unroll") for (int k = 0; k < 2; ++k) \
        acc[ai][bj][m][n] = __builtin_amdgcn_mfma_f32_16x16x32_bf16(Bt[n][k], At[m][k], acc[ai][bj][m][n], 0, 0, 0); __builtin_amdgcn_s_setprio(0); } while (0)
#define PG8_WAIT_V(n) asm volatile("s_waitcnt vmcnt(" #n ")" ::: "memory")
#define PG8_WAIT_L(n) asm volatile("s_waitcnt lgkmcnt(" #n ")" ::: "memory")
#define PG8_BAR __builtin_amdgcn_s_barrier()
#define PG8_SCHED __builtin_amdgcn_sched_barrier(0)
    Unit cur, nxt; int ui = 0;
    const PG8_LAS int* rmap = (const PG8_LAS int*)(lds + STAGE_BYTES);
    if (GATHER) { Unit t_; for (int i_ = 0; S.next(i_, t_) && i_ < 16; ++i_) { if (tid < BM) ((PG8_LAS int*)(lds + STAGE_BYTES))[i_ * BM + tid] = g.rowmap[t_.pm * BM + tid]; }
        asm volatile("s_waitcnt vmcnt(0) lgkmcnt(0)" ::: "memory"); __builtin_amdgcn_s_barrier(); asm volatile("" ::: "memory"); }
    if (!S.next(0, cur)) return;
    f32x4 acc[2][2][4][2];
#pragma unroll
    for (int a = 0; a < 2; ++a)
#pragma unroll
        for (int b = 0; b < 2; ++b)
#pragma unroll
            for (int m = 0; m < 4; ++m)
#pragma unroll
                for (int n = 0; n < 2; ++n) acc[a][b][m][n] = (f32x4){0.f, 0.f, 0.f, 0.f};
    bf16x8 At[4][2], B0[2][2], B1[2][2];
    unsigned cG[2][2], nG[2][2];
#define PG8_LOAD_ROWS(u_, G2_) do { _Pragma("unroll") for (int h_ = 0; h_ < 2; ++h_) _Pragma("unroll") for (int i_ = 0; i_ < 2; ++i_) \
        G2_[h_][i_] = GATHER ? ((unsigned)rmap[(u_).ui * BM + h_ * HALF + RA[i_]] * (unsigned)K + (unsigned)CA[i_]) * 2u : voffA[i_]; } while (0)
    const char* cA = GATHER ? (const char*)g.A : (const char*)g.A + (size_t)cur.pm * tstep;
    const size_t hA = GATHER ? 0 : hstep;
    const char* cB = (const char*)g.Bt + (size_t)cur.e * g.bstride + (size_t)cur.pn * tstep;
    PG8_LOAD_ROWS(cur, cG);
    PG8_STAGE(PG8_SB(0, 0), cB, voffB); PG8_STAGE(PG8_SB(0, 1), cB + hstep, voffB); PG8_STAGE(PG8_SA(0, 0), cA, cG[0]); PG8_STAGE(PG8_SA(0, 1), cA + hA, cG[1]);
    if (wr == 1) PG8_BAR;
    PG8_WAIT_V(2); PG8_BAR;
    PG8_STAGE(PG8_SB(1, 0), cB + kstep, voffB); PG8_STAGE(PG8_SA(1, 0), cA + kstep, cG[0]); PG8_STAGE(PG8_SB(1, 1), cB + hstep + kstep, voffB);
    PG8_WAIT_V(6); PG8_BAR;
    for (;;) {
        const bool has_next = S.next(ui + 1, nxt);
        const char* nA = GATHER ? (const char*)g.A : (has_next ? (const char*)g.A + (size_t)nxt.pm * tstep : cA);
        const char* nB = has_next ? (const char*)g.Bt + (size_t)nxt.e * g.bstride + (size_t)nxt.pn * tstep : cB;
        if (has_next) PG8_LOAD_ROWS(nxt, nG); else {
#pragma unroll
            for (int h = 0; h < 2; ++h) { nG[h][0] = cG[h][0]; nG[h][1] = cG[h][1]; } }
        for (int t = 0; t < nt; t += 2) {
            const bool last = (t == nt - 2);
            const char* a1 = cA + (size_t)(t + 1) * kstep;
            const char* a2 = last ? nA : cA + (size_t)(t + 2) * kstep; const char* b2 = last ? nB : cB + (size_t)(t + 2) * kstep;
            const char* a3 = a2 + kstep; const char* b3 = b2 + kstep;
            unsigned sG[2][2];
#pragma unroll
            for (int h = 0; h < 2; ++h) { sG[h][0] = (GATHER && last) ? nG[h][0] : cG[h][0]; sG[h][1] = (GATHER && last) ? nG[h][1] : cG[h][1]; }
            PG8_LDB(B0, 0, 0); PG8_LDB(B1, 0, 1); PG8_SCHED; PG8_LDA(At, 0, 0); PG8_STAGE(PG8_SA(1, 1), a1 + hA, cG[1]);
            PG8_WAIT_V(8); PG8_WAIT_L(0); PG8_BAR; PG8_MMA(0, 0, At, B0); PG8_MMA(0, 1, At, B1); PG8_BAR; PG8_SCHED;
            PG8_LDA(At, 0, 1); PG8_STAGE(PG8_SB(0, 0), b2, voffB); PG8_STAGE(PG8_SB(0, 1), b2 + hstep, voffB); PG8_STAGE(PG8_SA(0, 0), a2, sG[0]);
            PG8_WAIT_V(8); PG8_WAIT_L(0); PG8_BAR; PG8_MMA(1, 0, At, B0); PG8_MMA(1, 1, At, B1); PG8_BAR; PG8_SCHED;
            PG8_LDB(B0, 1, 0); PG8_LDB(B1, 1, 1); PG8_SCHED; PG8_LDA(At, 1, 0); PG8_STAGE(PG8_SA(0, 1), a2 + hA, sG[1]);
            PG8_WAIT_V(8); PG8_WAIT_L(0); PG8_BAR; PG8_MMA(0, 0, At, B0); PG8_MMA(0, 1, At, B1); PG8_BAR; PG8_SCHED;
            PG8_LDA(At, 1, 1); PG8_STAGE(PG8_SB(1, 0), b3, voffB); PG8_STAGE(PG8_SB(1, 1), b3 + hstep, voffB); PG8_STAGE(PG8_SA(1, 0), a3, sG[0]);
            PG8_WAIT_V(8); PG8_WAIT_L(0); PG8_BAR; PG8_MMA(1, 0, At, B0); PG8_MMA(1, 1, At, B1); PG8_BAR; PG8_SCHED;
        }
        if (wr == 0) PG8_BAR;
        E(acc, cur, wr, wc, fr, fq);
        if (!has_next) break;
#pragma unroll
        for (int a = 0; a < 2; ++a)
#pragma unroll
            for (int b = 0; b < 2; ++b)
#pragma unroll
                for (int m = 0; m < 4; ++m)
#pragma unroll
                    for (int n = 0; n < 2; ++n) acc[a][b][m][n] = (f32x4){0.f, 0.f, 0.f, 0.f};
        cur = nxt; cA = nA; cB = nB; ++ui;
#pragma unroll
        for (int h = 0; h < 2; ++h) { cG[h][0] = nG[h][0]; cG[h][1] = nG[h][1]; }
        if (wr == 1) PG8_BAR;
    }
    PG8_WAIT_V(0);
    PG8_BAR;
#undef PG8_LOAD_ROWS
#undef PG8_SA
#undef PG8_SB
#undef PG8_STAGE
#undef PG8_LDA
#undef PG8_LDB
#undef PG8_MMA
#undef PG8_WAIT_V
#undef PG8_WAIT_L
#undef PG8_BAR
#undef PG8_SCHED
}
}
constexpr int NB = 2, SEQ = 16384, T = NB * SEQ, D = 1024;
constexpr int H0P = 2112;
constexpr int ABN = 2048, OFF_U = 0, OFF_Q = 512, OFF_K = 768, OFF_V = 1024, OFF_GO = 1536, AB_IN = 2080;
constexpr int CN = 1536;
constexpr int NEXP = 32, DEXP = 512, CAP = 2 * T + NEXP * 256, MAXTILES = CAP / 256;
constexpr int S5CH = 256, S5NCH = SEQ / S5CH;
constexpr int GSC = 16, GCH = 64, GNSC = SEQ / (GSC * GCH);
constexpr float ALPHA = 1.41421356237309515f;
constexpr float LN_EPS = 1e-5f, RMS_EPS = 1e-6f, LOG2E = 1.44269504088896341f;
constexpr int NWAVES = 8, NTHR = 512;

constexpr size_t MiB = 1u << 20, KiB = 1u << 10;
constexpr size_t WS_CTL = 0, CTL_ZERO_BYTES = 64 * KiB;
constexpr int CW_BAR = 4096;
constexpr size_t WS_LR = 1 * MiB;
constexpr size_t WS_S5E = 5 * MiB;
constexpr size_t WS_GS = 9 * MiB;
constexpr size_t WS_GD = 17 * MiB;
constexpr size_t WS_S5L = WS_GD + 64 * KiB;
constexpr size_t WS_S5B = WS_S5L + 64 * KiB;
constexpr size_t WS_S5C = WS_S5B + 256 * KiB;
constexpr size_t WS_BTAB = WS_S5C + 256 * KiB;
constexpr size_t WS_WR = WS_BTAB + 32 * KiB;
constexpr size_t WS_TOKE = WS_WR + 384 * KiB;
constexpr size_t WS_TOKW = WS_TOKE + 256 * KiB;
constexpr size_t WS_TOKS = WS_TOKW + 256 * KiB;
constexpr size_t WS_SLOTT = WS_TOKS + 256 * KiB;
constexpr size_t WS_SLOTW = WS_SLOTT + 288 * KiB;
constexpr size_t WS_BLKC = WS_SLOTW + 288 * KiB;
constexpr size_t WS_TILE = WS_BLKC + 32 * KiB;
static_assert(WS_TILE + 4 * KiB <= 32 * MiB, "param region");
constexpr size_t WS_WIN = 32 * MiB, WS_WLR = 36 * MiB, WS_WGLU = 37 * MiB, WS_WOUT = 38 * MiB, WS_CIN = 40 * MiB, WS_COUT = 43 * MiB;
constexpr size_t WS_W13 = 48 * MiB, WS_W2 = 112 * MiB;
constexpr size_t A0 = 144 * MiB;
constexpr size_t WS_H1 = A0, WS_H0 = A0;
constexpr size_t WS_Z = A0 + 128 * MiB;
constexpr size_t WS_YG = A0 + 136 * MiB, WS_OF = A0 + 168 * MiB, WS_OB = A0 + 320 * MiB;
constexpr size_t WS_YSCR = A0 + 232 * MiB;
constexpr size_t WS_X64 = A0 + 256 * MiB;
constexpr size_t WS_HID = A0 + 128 * MiB;
constexpr size_t WS_Y2 = A0 + 200 * MiB;
constexpr size_t WS_H2B = A0 + 128 * MiB;
constexpr size_t WS_QKV = A0 + 192 * MiB;
constexpr size_t WS_AO = A0 + 288 * MiB;
constexpr size_t WS_END = A0 + 384 * MiB;
static_assert((size_t)T * H0P * 2 <= 136 * MiB && WS_Y2 + (size_t)CAP * D * 2 <= WS_END && WS_OB + (size_t)T * 512 * 4 <= WS_END && WS_HID + (size_t)CAP * 512 * 2 <= WS_Y2, "act map");

constexpr int RING_BYTES = 131072;
constexpr int MISC_OFF = 163840 - 1024;
constexpr int PTR_OFF = MISC_OFF + 256;
constexpr int LDS_BYTES = 163840;

#define GAS __attribute__((address_space(1)))
#define LAS __attribute__((address_space(3)))
typedef unsigned short bf16;
typedef float f32x4 __attribute__((ext_vector_type(4)));
typedef float f32x2 __attribute__((ext_vector_type(2)));
typedef float f32x16 __attribute__((ext_vector_type(16)));
typedef short bf16x8 __attribute__((ext_vector_type(8)));
typedef short bf16x4 __attribute__((ext_vector_type(4)));
typedef unsigned u32x4 __attribute__((ext_vector_type(4)));
typedef unsigned u32x2 __attribute__((ext_vector_type(2)));
#define LDS_WAIT() asm volatile("s_waitcnt lgkmcnt(0)" ::: "memory")
#define VM_WAIT() asm volatile("s_waitcnt vmcnt(0)" ::: "memory")
#define LDS_BARRIER() do { asm volatile("s_waitcnt lgkmcnt(0)" ::: "memory"); __builtin_amdgcn_s_barrier(); asm volatile("" ::: "memory"); } while (0)
typedef __bf16 bf16x2_t __attribute__((ext_vector_type(2)));
__device__ __forceinline__ unsigned pk2(float lo, float hi) { f32x2 v = {lo, hi}; return __builtin_bit_cast(unsigned, __builtin_convertvector(v, bf16x2_t)); }
__device__ __forceinline__ unsigned f2bf(float f) { return pk2(f, 0.f) & 0xffffu; }
__device__ __forceinline__ float bf2f(unsigned short b) { return __uint_as_float((unsigned)b << 16); }
__device__ __forceinline__ float bflo(unsigned w) { return __uint_as_float(w << 16); }
__device__ __forceinline__ float bfhi(unsigned w) { return __uint_as_float(w & 0xffff0000u); }
__device__ __forceinline__ float wave_sum(float v) {
#pragma unroll
    for (int o = 1; o < 64; o <<= 1) v += __shfl_xor(v, o);
    return v;
}
__device__ __forceinline__ int crow(int r, int hi) { return (r & 3) + 8 * (r >> 2) + 4 * hi; }

#define XB_TMO      128
#define XB_XCNT(j)  (256  + 64 * (j))
#define XB_XSUB(j)  (1280 + 64 * (j))
#define XB_XGEN(j)  (2304 + 64 * (j))
#define XB_TOP      3328
#define XB_TOPGEN   3392
#define XCD_BAR_WORDS 3456
#define XB_SPIN_CAP (1u << 18)
__device__ __forceinline__ unsigned xb_ld(unsigned* p)              { return __hip_atomic_load(p, __ATOMIC_RELAXED, __HIP_MEMORY_SCOPE_AGENT); }
__device__ __forceinline__ unsigned xb_add(unsigned* p, unsigned v) { return __hip_atomic_fetch_add(p, v, __ATOMIC_RELAXED, __HIP_MEMORY_SCOPE_AGENT); }
__device__ __forceinline__ unsigned xb_xcc_id() { return (unsigned)__builtin_amdgcn_s_getreg((3 << 11) | 20) & 0xFu; }
#define XB_SPIN(cond, bar) do { unsigned _sp = 0; while (cond) { __builtin_amdgcn_s_sleep(1); \
    if ((++_sp & 255u) == 0u) { if (xb_ld(&(bar)[XB_TMO])) break; if (_sp > XB_SPIN_CAP) { atomicAdd(&(bar)[XB_TMO], 1u); break; } } } } while (0)
struct XcdBarrier { unsigned* bar; unsigned x; volatile LAS unsigned* st; };
__device__ __forceinline__ XcdBarrier xcd_barrier_post(unsigned* bar, volatile LAS unsigned* st) {
    XcdBarrier b; b.bar = bar; b.x = xb_xcc_id(); b.st = st;
    if (threadIdx.x == 0) (void)xb_add(&bar[XB_XCNT(b.x)], 1u);
    return b;
}
__device__ __forceinline__ void xcd_barrier_complete(unsigned* bar, unsigned x, unsigned& nloc, unsigned& nx) {
    const unsigned G = gridDim.x * gridDim.y * gridDim.z;
    unsigned sum, cnt, mine, sp = 0u;
    for (;;) {
        sum = 0u; cnt = 0u; mine = 0u;
#pragma unroll
        for (unsigned j = 0; j < 16; ++j) { const unsigned c = xb_ld(&bar[XB_XCNT(j)]); sum += c; cnt += (c > 0u) ? 1u : 0u; mine = (j == x) ? c : mine; }
        if (sum == G) break;
        __builtin_amdgcn_s_sleep(1);
        if ((++sp & 255u) == 0u) { if (xb_ld(&bar[XB_TMO])) break; if (sp > XB_SPIN_CAP) { atomicAdd(&bar[XB_TMO], 1u); break; } }
    }
    nloc = mine > 0u ? mine : 1u; nx = cnt > 0u ? cnt : 1u;
}
__device__ __forceinline__ void xcd_barrier(const XcdBarrier& b) {
    asm volatile("s_waitcnt vmcnt(0)" ::: "memory");
    __syncthreads();
    if (threadIdx.x == 0) {
        unsigned* bar = b.bar;
        __builtin_amdgcn_s_waitcnt(0);
        unsigned nloc = b.st[0], nx = b.st[1];
        if (nloc == 0u) { xcd_barrier_complete(bar, b.x, nloc, nx); b.st[0] = nloc; b.st[1] = nx; }
        const unsigned old = xb_add(&bar[XB_XSUB(b.x)], 1u);
        const unsigned gen = old / nloc;
        if (old + 1u == (gen + 1u) * nloc) {
            __builtin_amdgcn_fence(__ATOMIC_RELEASE, "agent");
            asm volatile("s_waitcnt vmcnt(0)" ::: "memory");
            const unsigned og = xb_add(&bar[XB_TOP], 1u);
            const unsigned tg = og / nx;
            if (og + 1u == (tg + 1u) * nx) xb_add(&bar[XB_TOPGEN], 1u);
            else XB_SPIN(xb_ld(&bar[XB_TOPGEN]) == tg, bar);
            __builtin_amdgcn_fence(__ATOMIC_ACQUIRE, "agent");
            xb_add(&bar[XB_XGEN(b.x)], 1u);
            asm volatile("s_waitcnt vmcnt(0)" ::: "memory");
        } else {
            XB_SPIN(xb_ld(&bar[XB_XGEN(b.x)]) == gen, bar);
            __builtin_amdgcn_fence(__ATOMIC_ACQUIRE, "agent");
            asm volatile("s_waitcnt vmcnt(0)" ::: "memory");
        }
    }
    __syncthreads();
}

struct Frame {
    LAS unsigned char* lds;
    int tid, lane, wave, G, bid;
    unsigned char* ws;
    const float* const* in;
};
enum InIdx { I_X = 0, I_LNMG, I_LNMB, I_LNFG, I_LNFB, I_ABWIN, I_LAMRE, I_LAMIM, I_LOGDT, I_BRE, I_BIM, I_CRE, I_CIM, I_S5D, I_GLUW, I_GLUB,
             I_GATEW, I_GATEB, I_NORMG, I_ABWOUT, I_CWIN, I_SINK, I_CWOUT, I_RELB, I_WGRP, I_BGRP, I_WRT, I_BRT, I_W1, I_W3, I_W2, N_IN };

__device__ __forceinline__ const float* inp(LAS unsigned char* lds, int k) {
    const LAS unsigned* p = (const LAS unsigned*)(lds + PTR_OFF) + 2 * k;
    const unsigned lo = __builtin_amdgcn_readfirstlane(p[0]), hi = __builtin_amdgcn_readfirstlane(p[1]);
    return (const float*)(const GAS float*)(((unsigned long long)hi << 32) | (unsigned long long)lo);
}
__device__ __forceinline__ void tr_item(const float* W, int ldw, bf16* WT, int ldt, int rowmode, LAS float* scr, int item, int nblk, int lane) {
    const int kb = item / nblk, nb = item % nblk, k0 = 64 * kb, n0 = 32 * nb;
    float tv[32];
    const float* wp = W + (size_t)(k0 + (lane >> 5)) * ldw + n0 + (lane & 31);
#pragma unroll
    for (int i = 0; i < 32; ++i) tv[i] = wp[(size_t)(2 * i) * ldw];
#pragma unroll
    for (int i = 0; i < 32; ++i) scr[(2 * i + (lane >> 5)) * 33 + (lane & 31)] = tv[i];
    LDS_WAIT(); asm volatile("" ::: "memory");
    const int c = lane & 7;
#pragma unroll
    for (int j = 0; j < 4; ++j) { const int n = (lane >> 3) + 8 * j; const LAS float* s = scr + (8 * c) * 33 + n;
        u32x4 o; o.x = pk2(s[0 * 33], s[1 * 33]); o.y = pk2(s[2 * 33], s[3 * 33]); o.z = pk2(s[4 * 33], s[5 * 33]); o.w = pk2(s[6 * 33], s[7 * 33]);
        const int ng = n0 + n; const int dr = rowmode == 0 ? ng : (8 * (ng >> 2) + (ng & 3) + (rowmode == 2 ? 4 : 0));
        *(GAS u32x4*)(WT + (size_t)dr * ldt + k0 + 8 * c) = o; }
    LDS_WAIT(); asm volatile("" ::: "memory");
}
__device__ __forceinline__ void moe_convert(const float* w1, const float* w3, const float* w2, bf16* W13, bf16* W2T, LAS float* scr, int it0, int it1, int gw, int NGW, int lane) {
    constexpr int PER_E = 768;
    for (int it = it0 + gw; it < it1; it += NGW) {
        const int e = it / PER_E; int r = it % PER_E;
        if (r < 256) tr_item(w1 + (size_t)e * D * DEXP, DEXP, W13 + (size_t)e * D * D, D, 1, scr, r, DEXP / 32, lane);
        else if (r < 512) tr_item(w3 + (size_t)e * D * DEXP, DEXP, W13 + (size_t)e * D * D, D, 2, scr, r - 256, DEXP / 32, lane);
        else tr_item(w2 + (size_t)e * DEXP * D, D, W2T + (size_t)e * D * DEXP, DEXP, 0, scr, r - 512, D / 32, lane);
    }
}
constexpr int MOE_ITEMS = NEXP * 768, IDLE_Q8 = 88, IDLE_Q9 = 56;
__device__ __forceinline__ void idle_convert(int which, unsigned char* ws, LAS unsigned char* lds, float* dout, int ntiles, int bid, int G, int wave, int lane) {
    const int U = ntiles * (D / 256), rem = U % G; if (rem == 0 || bid < rem) return;
    const int n_idle = G - rem, rank = bid - rem;
    int q8 = n_idle * IDLE_Q8; q8 = q8 < MOE_ITEMS ? q8 : MOE_ITEMS; int q9 = n_idle * IDLE_Q9; q9 = (q8 + q9) < MOE_ITEMS ? q9 : (MOE_ITEMS - q8);
    const int per = which == 0 ? IDLE_Q8 : IDLE_Q9, base = which == 0 ? 0 : q8, lim = which == 0 ? q8 : q8 + q9;
    int lo = base + rank * per, hi = lo + per; hi = hi < lim ? hi : lim;
    moe_convert(inp(lds, I_W1) + (size_t)NEXP * D * DEXP, inp(lds, I_W3) + (size_t)NEXP * D * DEXP, inp(lds, I_W2) + (size_t)NEXP * DEXP * D,
                (bf16*)dout, (bf16*)dout + (size_t)NEXP * D * D, (LAS float*)(lds + wave * 16384), lo, hi, wave, NWAVES, lane);
}
__device__ __forceinline__ int idle_done(int ntiles, int G) {
    const int U = ntiles * (D / 256), rem = U % G; if (rem == 0) return 0;
    const int n_idle = G - rem; int q = n_idle * (IDLE_Q8 + IDLE_Q9); return q < MOE_ITEMS ? q : MOE_ITEMS;
}
__device__ __forceinline__ int t5_bucket(int rel) {
    const int nb = 16, max_exact = 8; int ret = rel > 0 ? nb : 0; const int n = rel < 0 ? -rel : rel;
    const float lg = logf((float)(n < 1 ? 1 : n) / 8.0f) / 2.7725887f * 8.0f;
    int large = max_exact + (int)lg; large = large < nb - 1 ? large : nb - 1;
    return ret + (n < max_exact ? n : large);
}
__device__ __forceinline__ void p0_prologue(unsigned char* ws, LAS unsigned char* lds, int bid, int G, int tid, int wave, int lane) {
    LAS float* scr = (LAS float*)(lds + wave * 16384);
    const int gw = bid * NWAVES + wave, NGW = G * NWAVES;
    constexpr int I0 = 16 * 64, I1 = 16, I2 = 8 * 16, I3 = 16 * 32, I4 = 16 * 48, I5 = 16 * 32, NIT = I0 + I1 + I2 + I3 + I4 + I5;
    for (int it = gw; it < NIT; it += NGW) {
        int r = it;
        if (r < I0) { tr_item(inp(lds, I_ABWIN), AB_IN, (bf16*)(ws + WS_WIN), D, 0, scr, r, 64, lane); continue; } r -= I0;
        if (r < I1) { tr_item(inp(lds, I_ABWIN) + 2048, AB_IN, (bf16*)(ws + WS_WLR), D, 0, scr, r, 1, lane); continue; } r -= I1;
        if (r < I2) { tr_item(inp(lds, I_GLUW), 512, (bf16*)(ws + WS_WGLU), 512, 0, scr, r, 16, lane); continue; } r -= I2;
        if (r < I3) { tr_item(inp(lds, I_ABWOUT), D, (bf16*)(ws + WS_WOUT), D, 0, scr, r, 32, lane); continue; } r -= I3;
        if (r < I4) { tr_item(inp(lds, I_CWIN), CN, (bf16*)(ws + WS_CIN), D, 0, scr, r, 48, lane); continue; } r -= I4;
        tr_item(inp(lds, I_CWOUT), D, (bf16*)(ws + WS_COUT), D, 0, scr, r, 32, lane);
    }
    moe_convert(inp(lds, I_W1), inp(lds, I_W3), inp(lds, I_W2), (bf16*)(ws + WS_W13), (bf16*)(ws + WS_W2), scr, 0, MOE_ITEMS, gw, NGW, lane);
    { const float* x = inp(lds, I_X); bf16* xb = (bf16*)(ws + WS_X64);
      for (int m = gw; m < T; m += 2 * NGW) { const int m2 = m + NGW;
          const GAS f32x4* xr = (const GAS f32x4*)(x + (size_t)m * D) + lane; GAS u32x2* o = (GAS u32x2*)(xb + (size_t)m * D) + lane;
          const GAS f32x4* xr2 = (const GAS f32x4*)(x + (size_t)m2 * D) + lane; GAS u32x2* o2 = (GAS u32x2*)(xb + (size_t)m2 * D) + lane;
          f32x4 v[4], v2[4];
#pragma unroll
          for (int j = 0; j < 4; ++j) { v[j] = xr[64 * j]; if (m2 < T) v2[j] = xr2[64 * j]; }
#pragma unroll
          for (int j = 0; j < 4; ++j) { u32x2 w; w.x = pk2(v[j].x, v[j].y); w.y = pk2(v[j].z, v[j].w); o[64 * j] = w;
              if (m2 < T) { u32x2 w2; w2.x = pk2(v2[j].x, v2[j].y); w2.y = pk2(v2[j].z, v2[j].w); o2[64 * j] = w2; } } } }
    const int gt = bid * NTHR + tid, NGT = G * NTHR;
    { const float* lamre = inp(lds, I_LAMRE); const float* lamim = inp(lds, I_LAMIM); const float* logdt = inp(lds, I_LOGDT); const float* bre = inp(lds, I_BRE); const float* bim = inp(lds, I_BIM);
    for (int i = tid * G + bid; i < 2 * 32 * 64; i += NTHR * G) {
        const int p = i & 63, g = (i >> 6) & 31, dir = i >> 11;
        const double lr = fmin((double)lamre[i], -1e-4), li = (double)lamim[i], dt = exp((double)logdt[dir * 32 + g]);
        const double mag = exp(lr * dt), ar = mag * cos(li * dt), ai = mag * sin(li * dt), den = lr * lr + li * li, nr = ar - 1.0;
        const double cr = (nr * lr + ai * li) / den, ci = (ai * lr - nr * li) / den;
        double qr = ar, qi = ai;
#pragma unroll 1
        for (int s = 1; s < S5CH; s <<= 1) { const double t = qr * qr - qi * qi; qi = 2.0 * qr * qi; qr = t; }
        float* L4 = (float*)(ws + WS_S5L) + (size_t)i * 4; L4[0] = (float)ar; L4[1] = (float)ai; L4[2] = (float)qr; L4[3] = (float)qi;
        bf16* Bb = (bf16*)(ws + WS_S5B) + (size_t)(dir * 32 + g) * 2048;
#pragma unroll 4
        for (int c = 0; c < 16; ++c) { const double br = bre[(size_t)i * 16 + c], bi = bim[(size_t)i * 16 + c];
            Bb[p * 16 + c] = (bf16)f2bf((float)(cr * br - ci * bi)); Bb[1024 + p * 16 + c] = (bf16)f2bf((float)(cr * bi + ci * br)); }
    } }
    { const float* cre = inp(lds, I_CRE); const float* cim = inp(lds, I_CIM);
    for (int i = gt; i < 2 * 32 * 16 * 64; i += NGT) {
        const int p = i & 63, c = (i >> 6) & 15, dg = i >> 10;
        bf16* Cm = (bf16*)(ws + WS_S5C) + (size_t)dg * 2048 + c * 128 + 2 * p;
        Cm[0] = (bf16)f2bf(cre[i]); Cm[1] = (bf16)f2bf(-cim[i]);
    } }
    { const float* relb = inp(lds, I_RELB);
    for (int i = gt; i < 16 * 257; i += NGT) { const int h = i / 257, r = i % 257; ((float*)(ws + WS_BTAB))[h * 260 + r] = relb[t5_bucket(r - 128) * 16 + h] * LOG2E; } }
    { const float* wgrp = inp(lds, I_WGRP); const float* wrt = inp(lds, I_WRT);
    for (int i = gt; i < 2 * 48 * 1024; i += NGT) {
        const int k = i & 1023, n = (i >> 10) % 48, l = i / (48 * 1024);
        const float w = n < 4 ? wgrp[(size_t)l * D * 4 + k * 4 + n] : (n < 36 ? wrt[(size_t)l * D * 32 + k * 32 + (n - 4)] : 0.f);
        const unsigned hi = f2bf(w); const float lo = w - __uint_as_float(hi << 16);
        bf16* Wr = (bf16*)(ws + WS_WR) + (size_t)l * 2 * 48 * 1024; Wr[n * 1024 + k] = (bf16)hi; Wr[48 * 1024 + n * 1024 + k] = (bf16)f2bf(lo);
    } }
}

__device__ __forceinline__ void gate_tail(float* bcg, const float* gate_w, const float* gate_b, const LAS float* lrs, size_t row0, int tid);
__device__ __forceinline__ void lr_tail(unsigned char* ws, float* bcg, const float* gate_w, const float* gate_b, LAS unsigned char* lds, int bid, int G, int tid, int wave, int lane) {
    const bf16* xb = (const bf16*)(ws + WS_X64); const bf16* wl = (const bf16*)(ws + WS_WLR); LAS float* lrs = (LAS float*)lds;
    for (int rt = bid; rt < T / 128; rt += G) {
        const int r0 = rt * 128 + wave * 16;
        f32x4 acc0 = {0.f, 0.f, 0.f, 0.f}, acc1 = {0.f, 0.f, 0.f, 0.f};
        const bf16* ap = xb + (size_t)(r0 + (lane & 15)) * D + 8 * (lane >> 4);
        const bf16* bp = wl + (size_t)(lane & 15) * D + 8 * (lane >> 4);
#pragma unroll 8
        for (int ks = 0; ks < 32; ++ks) {
            const bf16x8 a = *(const bf16x8*)(ap + ks * 32), b0 = *(const bf16x8*)(bp + ks * 32), b1 = *(const bf16x8*)(bp + 16 * D + ks * 32);
            acc0 = __builtin_amdgcn_mfma_f32_16x16x32_bf16(a, b0, acc0, 0, 0, 0); acc1 = __builtin_amdgcn_mfma_f32_16x16x32_bf16(a, b1, acc1, 0, 0, 0);
        }
        __syncthreads();
#pragma unroll
        for (int r = 0; r < 4; ++r) { LAS float* o = lrs + (wave * 16 + 4 * (lane >> 4) + r) * 32 + (lane & 15); o[0] = acc0[r]; o[16] = acc1[r]; }
        __syncthreads();
        gate_tail(bcg, gate_w, gate_b, lrs, (size_t)rt * 128, tid);
    }
    __syncthreads();
}

__device__ __forceinline__ void gla_finalize(unsigned char* ws, const float* norm_g, int gw, int NGW, int lane) {
    const bf16* of = (const bf16*)(ws + WS_OF); const bf16* ob = (const bf16*)(ws + WS_OB); const bf16* h0 = (const bf16*)(ws + WS_H0); bf16* cc = (bf16*)(ws + WS_X64);
    const f32x4 g0 = *(const f32x4*)(norm_g + 8 * lane), g1 = *(const f32x4*)(norm_g + 8 * lane + 4);
    for (int m0 = gw; m0 < T; m0 += 4 * NGW) {
        u32x4 a[4], b[4], gq[4];
#pragma unroll
        for (int q = 0; q < 4; ++q) { const size_t m = (size_t)m0 + (size_t)q * NGW;
            a[q] = *(const u32x4*)(of + m * 512 + 8 * lane); b[q] = *(const u32x4*)(ob + m * 512 + 8 * lane); gq[q] = *(const u32x4*)(h0 + m * H0P + OFF_GO + 8 * lane); }
#pragma unroll
        for (int q = 0; q < 4; ++q) { const size_t m = (size_t)m0 + (size_t)q * NGW;
            f32x4 v0, v1;
            v0.x = bflo(a[q].x) + bflo(b[q].x); v0.y = bfhi(a[q].x) + bfhi(b[q].x); v0.z = bflo(a[q].y) + bflo(b[q].y); v0.w = bfhi(a[q].y) + bfhi(b[q].y);
            v1.x = bflo(a[q].z) + bflo(b[q].z); v1.y = bfhi(a[q].z) + bfhi(b[q].z); v1.z = bflo(a[q].w) + bflo(b[q].w); v1.w = bfhi(a[q].w) + bfhi(b[q].w);
            float ss = (v0.x * v0.x + v0.y * v0.y) + (v0.z * v0.z + v0.w * v0.w) + (v1.x * v1.x + v1.y * v1.y) + (v1.z * v1.z + v1.w * v1.w);
            ss += __shfl_xor(ss, 1); ss += __shfl_xor(ss, 2); ss += __shfl_xor(ss, 4); ss += __shfl_xor(ss, 8);
            const float rs = __builtin_amdgcn_rsqf(ss * (1.0f / 128.0f) + RMS_EPS);
            const float gv[8] = {bflo(gq[q].x), bfhi(gq[q].x), bflo(gq[q].y), bfhi(gq[q].y), bflo(gq[q].z), bfhi(gq[q].z), bflo(gq[q].w), bfhi(gq[q].w)};
            const float ov[8] = {v0.x * g0.x, v0.y * g0.y, v0.z * g0.z, v0.w * g0.w, v1.x * g1.x, v1.y * g1.y, v1.z * g1.z, v1.w * g1.w};
            float r[8];
#pragma unroll
            for (int i = 0; i < 8; ++i) r[i] = ov[i] * rs * (gv[i] * __builtin_amdgcn_rcpf(1.f + __expf(-gv[i])));
            u32x4 w; w.x = pk2(r[0], r[1]); w.y = pk2(r[2], r[3]); w.z = pk2(r[4], r[5]); w.w = pk2(r[6], r[7]);
            *(u32x4*)(cc + m * D + 512 + 8 * lane) = w; }
    }
}

constexpr int RT_AST = 2064;
__device__ __forceinline__ void ln_router(unsigned char* ws, const float* resid, const float* lng, const float* lnb, const float* bgrp, const float* brt, int layer, LAS unsigned char* lds, int bid, int G, int tid, int wave, int lane) {
    const bf16* yb = (const bf16*)(ws + WS_Z); float* h1 = (float*)(ws + WS_H1); bf16* hb = (bf16*)(ws + WS_X64);
    int* tok_e = (int*)(ws + WS_TOKE); float* tok_w = (float*)(ws + WS_TOKW);
    LAS unsigned char* Ahi = lds; LAS unsigned char* Alo = lds + 16 * RT_AST; LAS float* part = (LAS float*)(lds + 32 * RT_AST);
    LAS int* hist = (LAS int*)(lds + 32 * RT_AST + 8 * 16 * 48 * 4); LAS float* lgt = (LAS float*)(lds + 32 * RT_AST + 8 * 16 * 48 * 4 + 256);
    if (tid < 32) hist[tid] = 0;
    const bf16* Wr = (const bf16*)(ws + WS_WR) + (size_t)layer * 2 * 48 * 1024;
    bf16x8 Bh[3][4], Bl[3][4];
#pragma unroll
    for (int nt = 0; nt < 3; ++nt)
#pragma unroll
        for (int ks = 0; ks < 4; ++ks) { const size_t o = (size_t)(nt * 16 + (lane & 15)) * 1024 + wave * 128 + ks * 32 + 8 * (lane >> 4);
            Bh[nt][ks] = *(const bf16x8*)(Wr + o); Bl[nt][ks] = *(const bf16x8*)(Wr + 48 * 1024 + o); }
    f32x4 gv[4], bv[4];
#pragma unroll
    for (int j = 0; j < 4; ++j) { gv[j] = *(const f32x4*)(lng + 4 * lane + 256 * j); bv[j] = *(const f32x4*)(lnb + 4 * lane + 256 * j); }
    __syncthreads();
    for (int grp = bid; grp < T / 16; grp += G) {
#pragma unroll
        for (int rr = 0; rr < 2; ++rr) {
            const int row = 2 * wave + rr; const size_t m = (size_t)grp * 16 + row;
            const GAS f32x4* xr = (const GAS f32x4*)(resid + m * D) + lane; const GAS u32x2* yr = (const GAS u32x2*)(yb + m * D) + lane;
            f32x4 v[4]; float s = 0.f;
#pragma unroll
            for (int j = 0; j < 4; ++j) { const f32x4 x4 = xr[64 * j]; const u32x2 y2 = yr[64 * j];
                v[j].x = x4.x * ALPHA + bflo(y2.x); v[j].y = x4.y * ALPHA + bfhi(y2.x); v[j].z = x4.z * ALPHA + bflo(y2.y); v[j].w = x4.w * ALPHA + bfhi(y2.y);
                s += (v[j].x + v[j].y) + (v[j].z + v[j].w); }
            const float mean = wave_sum(s) * (1.f / D); float s2 = 0.f;
#pragma unroll
            for (int j = 0; j < 4; ++j) { v[j] = v[j] - mean; s2 += (v[j].x * v[j].x + v[j].y * v[j].y) + (v[j].z * v[j].z + v[j].w * v[j].w); }
            const float rstd = 1.f / sqrtf(wave_sum(s2) * (1.f / D) + LN_EPS);
#pragma unroll
            for (int j = 0; j < 4; ++j) {
                const f32x4 h = v[j] * rstd * gv[j] + bv[j];
                ((GAS f32x4*)(h1 + m * D) + lane)[64 * j] = h;
                const unsigned h0 = pk2(h.x, h.y), h1w = pk2(h.z, h.w);
                u32x2 w; w.x = h0; w.y = h1w; ((GAS u32x2*)(hb + m * D) + lane)[64 * j] = w;
                u32x2 lo; lo.x = pk2(h.x - bflo(h0), h.y - bfhi(h0)); lo.y = pk2(h.z - bflo(h1w), h.w - bfhi(h1w));
                *(LAS u32x2*)(Ahi + row * RT_AST + (4 * lane + 256 * j) * 2) = w; *(LAS u32x2*)(Alo + row * RT_AST + (4 * lane + 256 * j) * 2) = lo;
            }
        }
        LDS_BARRIER();
        f32x4 acc[3] = {{0.f, 0.f, 0.f, 0.f}, {0.f, 0.f, 0.f, 0.f}, {0.f, 0.f, 0.f, 0.f}};
#pragma unroll
        for (int ks = 0; ks < 4; ++ks) {
            const int bo = (lane & 15) * RT_AST + (wave * 128 + ks * 32 + 8 * (lane >> 4)) * 2;
            const bf16x8 ah = *(const LAS bf16x8*)(Ahi + bo), al = *(const LAS bf16x8*)(Alo + bo);
#pragma unroll
            for (int nt = 0; nt < 3; ++nt) {
                acc[nt] = __builtin_amdgcn_mfma_f32_16x16x32_bf16(ah, Bh[nt][ks], acc[nt], 0, 0, 0);
                acc[nt] = __builtin_amdgcn_mfma_f32_16x16x32_bf16(ah, Bl[nt][ks], acc[nt], 0, 0, 0);
                acc[nt] = __builtin_amdgcn_mfma_f32_16x16x32_bf16(al, Bh[nt][ks], acc[nt], 0, 0, 0);
            }
        }
#pragma unroll
        for (int nt = 0; nt < 3; ++nt)
#pragma unroll
            for (int r = 0; r < 4; ++r) part[(wave * 16 + 4 * (lane >> 4) + r) * 48 + nt * 16 + (lane & 15)] = acc[nt][r];
        LDS_BARRIER();
        { const int itn = (grp - bid) / G;
          for (int idx = tid; idx < 16 * 36; idx += NTHR) { const int tk = idx / 36, n = idx % 36; float s = 0.f;
#pragma unroll
            for (int w = 0; w < 8; ++w) s += part[(w * 16 + tk) * 48 + n];
            lgt[(itn * 16 + tk) * 36 + n] = s + (n < 4 ? bgrp[n] : brt[n - 4]); } }
    }
    LDS_BARRIER();
    for (int tk = tid; tk < 16 * ((T / 16 - bid + G - 1) / G); tk += NTHR) {
        const size_t m = ((size_t)bid + (size_t)(tk >> 4) * G) * 16 + (tk & 15);
        const LAS float* lg = lgt + tk * 36;
        int gi = 0; float gm = lg[0];
#pragma unroll
        for (int n = 1; n < 4; ++n) if (lg[n] > gm) { gm = lg[n]; gi = n; }
        float gs = 0.f;
#pragma unroll
        for (int n = 0; n < 4; ++n) gs += __expf(lg[n] - gm);
        const float pg = 1.f / gs;
        float el[8];
#pragma unroll
        for (int i = 0; i < 8; ++i) el[i] = lg[4 + gi * 8 + i];
        int i1 = 0; float m1 = el[0];
#pragma unroll
        for (int i = 1; i < 8; ++i) if (el[i] > m1) { m1 = el[i]; i1 = i; }
        int i2 = -1; float m2 = -3.0e38f;
#pragma unroll
        for (int i = 0; i < 8; ++i) if (i != i1 && el[i] > m2) { m2 = el[i]; i2 = i; }
        const float e2 = __expf(m2 - m1), inv = 1.f / (1.f + e2);
        const int ea = gi * 8 + i1, eb = gi * 8 + i2;
        tok_e[m * 2] = ea; tok_e[m * 2 + 1] = eb; tok_w[m * 2] = pg * inv; tok_w[m * 2 + 1] = pg * e2 * inv;
        atomicAdd((int*)&hist[ea], 1); atomicAdd((int*)&hist[eb], 1);
    }
    LDS_BARRIER();
    if (tid < 32) ((int*)(ws + WS_BLKC))[bid * 32 + tid] = hist[tid];
}

__device__ __forceinline__ void moe_sort(unsigned char* ws, LAS unsigned char* lds, int bid, int G, int tid) {
    const int* blkc = (const int*)(ws + WS_BLKC); const int* tok_e = (const int*)(ws + WS_TOKE); const float* tok_w = (const float*)(ws + WS_TOKW);
    int* tok_s = (int*)(ws + WS_TOKS); int* slot_t = (int*)(ws + WS_SLOTT); float* slot_w = (float*)(ws + WS_SLOTW); int* tile = (int*)(ws + WS_TILE);
    LAS int* ptot = (LAS int*)lds; LAS int* pbase = ptot + 512; LAS int* tot = pbase + 512; LAS int* base = tot + 32; LAS int* pstart = base + 32; LAS int* lcur = pstart + 33;
    { const int e = tid & 31, part = tid >> 5; int st = 0, sb = 0;
      for (int b = part; b < G; b += 16) { const int c = blkc[b * 32 + e]; st += c; sb += (b < bid) ? c : 0; }
      ptot[part * 32 + e] = st; pbase[part * 32 + e] = sb; }
    __syncthreads();
    if (tid < 32) { int st = 0, sb = 0;
#pragma unroll
        for (int p = 0; p < 16; ++p) { st += ptot[p * 32 + tid]; sb += pbase[p * 32 + tid]; }
        tot[tid] = st; base[tid] = sb; lcur[tid] = 0; }
    __syncthreads();
    if (tid == 0) { int acc = 0; for (int e = 0; e < 32; ++e) { pstart[e] = acc; acc += (tot[e] + 255) & ~255; } pstart[32] = acc; }
    __syncthreads();
    if (bid == 0) {
        const int nt = pstart[32] >> 8;
        if (tid == 0) tile[511] = nt;
        for (int t = tid; t < nt; t += NTHR) { int e = 0; for (int q = 1; q < 32; ++q) if ((t << 8) >= pstart[q]) e = q; tile[t] = e; }
    }
    for (int e = bid; e < 32; e += G)
        for (int s = pstart[e] + tot[e] + tid; s < pstart[e + 1]; s += NTHR) { slot_t[s] = 0; slot_w[s] = 0.f; }
    for (int grp = bid; grp < T / 16; grp += G) {
        if (tid < 32) { const size_t a = (size_t)grp * 32 + tid; const int e = tok_e[a]; const int rank = atomicAdd((int*)&lcur[e], 1);
            const int s = pstart[e] + base[e] + rank; slot_t[s] = (int)(a >> 1); slot_w[s] = tok_w[a]; tok_s[a] = s; }
    }
}

template <bool FINAL>
__device__ __forceinline__ void combine_ln(unsigned char* ws, const float* lng, const float* lnb, float* dout, int gw, int NGW, int lane) {
    float* h1 = (float*)(ws + WS_H1); const bf16* y2 = (const bf16*)(ws + WS_Y2); const int* tok_s = (const int*)(ws + WS_TOKS); const float* tok_w = (const float*)(ws + WS_TOKW); bf16* h2b = (bf16*)(ws + WS_H2B);
    f32x4 gv[4], bv[4];
#pragma unroll
    for (int j = 0; j < 4; ++j) { gv[j] = *(const f32x4*)(lng + 4 * lane + 256 * j); bv[j] = *(const f32x4*)(lnb + 4 * lane + 256 * j); }
    for (int m = gw; m < T; m += NGW) {
        const int s0 = tok_s[(size_t)m * 2], s1 = tok_s[(size_t)m * 2 + 1]; const float w0 = tok_w[(size_t)m * 2], w1 = tok_w[(size_t)m * 2 + 1];
        const GAS f32x4* hr = (const GAS f32x4*)(h1 + (size_t)m * D) + lane;
        const GAS u32x2* ya = (const GAS u32x2*)(y2 + (size_t)s0 * D) + lane; const GAS u32x2* yb = (const GAS u32x2*)(y2 + (size_t)s1 * D) + lane;
        f32x4 v[4]; float s = 0.f;
#pragma unroll
        for (int j = 0; j < 4; ++j) { const f32x4 h = hr[64 * j]; const u32x2 a = ya[64 * j], b = yb[64 * j];
            v[j].x = h.x * ALPHA + (w0 * bflo(a.x) + w1 * bflo(b.x)); v[j].y = h.y * ALPHA + (w0 * bfhi(a.x) + w1 * bfhi(b.x)); v[j].z = h.z * ALPHA + (w0 * bflo(a.y) + w1 * bflo(b.y)); v[j].w = h.w * ALPHA + (w0 * bfhi(a.y) + w1 * bfhi(b.y));
            s += (v[j].x + v[j].y) + (v[j].z + v[j].w); }
        const float mean = wave_sum(s) * (1.f / D); float s2 = 0.f;
#pragma unroll
        for (int j = 0; j < 4; ++j) { v[j] = v[j] - mean; s2 += (v[j].x * v[j].x + v[j].y * v[j].y) + (v[j].z * v[j].z + v[j].w * v[j].w); }
        const float rstd = 1.f / sqrtf(wave_sum(s2) * (1.f / D) + LN_EPS);
#pragma unroll
        for (int j = 0; j < 4; ++j) { const f32x4 h = v[j] * rstd * gv[j] + bv[j];
            if (FINAL) ((GAS f32x4*)(dout + (size_t)m * D) + lane)[64 * j] = h;
            else { ((GAS f32x4*)(h1 + (size_t)m * D) + lane)[64 * j] = h; u32x2 w; w.x = pk2(h.x, h.y); w.y = pk2(h.z, h.w); ((GAS u32x2*)(h2b + (size_t)m * D) + lane)[64 * j] = w; } }
    }
}
constexpr int S5_HST = 272, S5_UST = 272, S5_UOFF = 8 * 32 * S5_HST;
#define MFMA32(a, b, c) __builtin_amdgcn_mfma_f32_32x32x16_bf16((a), (b), (c), 0, 0, 0)
#define MFMA16(a, b, c) __builtin_amdgcn_mfma_f32_16x16x32_bf16((a), (b), (c), 0, 0, 0)
__device__ __forceinline__ float gelu_tanh(float x) {
    const float u = 0.7978845608028654f * (x + 0.044715f * x * x * x);
    const float e = __expf(2.f * u); const float th = 1.f - 2.f * __builtin_amdgcn_rcpf(e + 1.f);
    return 0.5f * x * (1.f + th);
}
__device__ __forceinline__ f32x4 ld_ys(const float* p) {
    f32x4 v;
    v.x = __hip_atomic_load(p, __ATOMIC_RELAXED, __HIP_MEMORY_SCOPE_AGENT); v.y = __hip_atomic_load(p + 1, __ATOMIC_RELAXED, __HIP_MEMORY_SCOPE_AGENT);
    v.z = __hip_atomic_load(p + 2, __ATOMIC_RELAXED, __HIP_MEMORY_SCOPE_AGENT); v.w = __hip_atomic_load(p + 3, __ATOMIC_RELAXED, __HIP_MEMORY_SCOPE_AGENT);
    return v;
}
template <int PASS, int DIR>
__device__ __forceinline__ void s5_dir(unsigned char* ws, const float* s5d, int b, int g, int c, LAS unsigned char* hl, const LAS unsigned char* ul, float* yscr, int lane) {
    const bf16* h0 = (const bf16*)(ws + WS_H0);
    const int dg = DIR * 32 + g;
    const f32x4 L4 = *(const f32x4*)((const float*)(ws + WS_S5L) + (size_t)(dg * 64 + lane) * 4);
    const float ar = L4.x, ai = L4.y, qr = L4.z, qi = L4.w;
    const float l2r = ar * ar - ai * ai, l2i = 2.f * ar * ai, l4r = l2r * l2r - l2i * l2i, l4i = 2.f * l2r * l2i, l8r = l4r * l4r - l4i * l4i, l8i = 2.f * l4r * l4i;
    const float l16r = l8r * l8r - l8i * l8i, l16i = 2.f * l8r * l8i, l32r = l16r * l16r - l16i * l16i, l32i = 2.f * l16r * l16i;
    const bf16* Bb = (const bf16*)(ws + WS_S5B) + (size_t)dg * 2048 + (lane & 31) * 16 + 8 * (lane >> 5);
    const bf16x8 bre0 = *(const bf16x8*)Bb, bre1 = *(const bf16x8*)(Bb + 512), bim0 = *(const bf16x8*)(Bb + 1024), bim1 = *(const bf16x8*)(Bb + 1536);
    bf16x8 cf[4]; bf16x8 dfrag;
    if (PASS == 2) {
        const bf16* Cm = (const bf16*)(ws + WS_S5C) + (size_t)dg * 2048 + (lane & 15) * 128 + 8 * (lane >> 4);
#pragma unroll
        for (int ks = 0; ks < 4; ++ks) cf[ks] = *(const bf16x8*)(Cm + 32 * ks);
        if (DIR == 1) {
            const int cc = lane & 15, kq = lane >> 4; const float d = s5d[g * 16 + cc]; const unsigned dh = f2bf(d); const unsigned dl = f2bf(d - __uint_as_float(dh << 16));
#pragma unroll
            for (int j = 0; j < 8; ++j) { const int k = 8 * (kq & 1) + j; dfrag[j] = (short)((k == cc) ? (kq < 2 ? dh : dl) : 0u); }
        }
    }
    float hr = 0.f, hi = 0.f;
    float* Ec = (float*)(ws + WS_S5E) + ((size_t)((DIR * NB + b) * 32 + g) * S5NCH) * 128 + 2 * lane;
    if (PASS == 2) {
        const int nj = DIR == 0 ? c : (S5NCH - 1 - c);
        for (int j0 = 0; j0 < nj; j0 += 32) {
            f32x2 e[32];
#pragma unroll
            for (int q = 0; q < 32; ++q) { const int j = (j0 + q) < nj ? (j0 + q) : (nj - 1); const int jj = DIR == 0 ? j : (S5NCH - 1 - j); e[q] = *(const f32x2*)(Ec + (size_t)jj * 128); }
#pragma unroll
            for (int q = 0; q < 32; ++q) if (j0 + q < nj) { const float nr = qr * hr - qi * hi + e[q].x; hi = qr * hi + qi * hr + e[q].y; hr = nr; }
        }
    }
    const size_t rowbase = (size_t)b * SEQ + (size_t)c * S5CH;
    const LAS unsigned char* up = ul + (lane & 31) * S5_UST + (g & 7) * 32 + 16 * (lane >> 5);
    const f32x16 zero16 = {0.f, 0.f, 0.f, 0.f, 0.f, 0.f, 0.f, 0.f, 0.f, 0.f, 0.f, 0.f, 0.f, 0.f, 0.f, 0.f};
#pragma unroll 1
    for (int ti = 0; ti < S5CH / 32; ++ti) {
        const int tile = DIR == 0 ? ti : (S5CH / 32 - 1 - ti);
        const bf16x8 a = *(const LAS bf16x8*)(up + tile * 32 * S5_UST);
        f32x4 ysv[2] = {{0.f, 0.f, 0.f, 0.f}, {0.f, 0.f, 0.f, 0.f}};
        if (PASS == 2 && DIR == 1) { ysv[0] = ld_ys(yscr + (size_t)(tile * 2) * 256 + 4 * lane); ysv[1] = ld_ys(yscr + (size_t)(tile * 2 + 1) * 256 + 4 * lane); }
        f32x16 xr0 = MFMA32(a, bre0, zero16), xr1 = MFMA32(a, bre1, zero16), xi0 = MFMA32(a, bim0, zero16), xi1 = MFMA32(a, bim1, zero16);
        __builtin_amdgcn_sched_barrier(0);
        asm volatile("s_nop 15\n\ts_nop 15\n\ts_nop 15\n\ts_nop 15" ::: "memory");
        __builtin_amdgcn_sched_barrier(0);
        float xr[32], xi[32];
#pragma unroll
        for (int r = 0; r < 16; ++r) {
            auto s = __builtin_amdgcn_permlane32_swap(__float_as_uint(xr0[r]), __float_as_uint(xr1[r]), false, false);
            xr[crow(r, 0)] = __uint_as_float(s[0]); xr[crow(r, 1)] = __uint_as_float(s[1]);
            auto q = __builtin_amdgcn_permlane32_swap(__float_as_uint(xi0[r]), __float_as_uint(xi1[r]), false, false);
            xi[crow(r, 0)] = __uint_as_float(q[0]); xi[crow(r, 1)] = __uint_as_float(q[1]);
        }
        if (PASS == 1) {
#pragma unroll
            for (int lv = 0; lv < 5; ++lv) {
                const float pr = lv == 0 ? ar : lv == 1 ? l2r : lv == 2 ? l4r : lv == 3 ? l8r : l16r, pi = lv == 0 ? ai : lv == 1 ? l2i : lv == 2 ? l4i : lv == 3 ? l8i : l16i;
#pragma unroll
                for (int i = 0; i < (16 >> lv); ++i) {
                    const int e = DIR == 0 ? 2 * i : 2 * i + 1, l = DIR == 0 ? 2 * i + 1 : 2 * i;
                    const float er = xr[e << lv], ei = xi[e << lv], lr_ = xr[l << lv], li_ = xi[l << lv];
                    const float wr = fmaf(pr, er, fmaf(-pi, ei, lr_)), wi = fmaf(pr, ei, fmaf(pi, er, li_));
                    xr[(2 * i) << lv] = wr; xi[(2 * i) << lv] = wi;
                }
            }
            { const float nr = fmaf(l32r, hr, fmaf(-l32i, hi, xr[0])), ni = fmaf(l32r, hi, fmaf(l32i, hr, xi[0])); hr = nr; hi = ni; }
        } else {
#pragma unroll
        for (int tt = 0; tt < 32; ++tt) {
            const int t = DIR == 0 ? tt : 31 - tt;
            const float tr_ = fmaf(-ai, hi, xr[t]), ti_ = fmaf(ai, hr, xi[t]);
            hr = fmaf(ar, hr, tr_); hi = fmaf(ar, hi, ti_);
            *(LAS unsigned*)(hl + t * S5_HST + 4 * lane) = pk2(hr, hi);
        }
        }
        if (PASS == 2) {
#pragma unroll
            for (int sub = 0; sub < 2; ++sub) {
                float* ys = yscr + (size_t)(tile * 2 + sub) * 256 + 4 * lane;
                f32x4 y = {0.f, 0.f, 0.f, 0.f};
                if (DIR == 1) y = ysv[sub];
#pragma unroll
                for (int ks = 0; ks < 4; ++ks) { const bf16x8 hf = *(const LAS bf16x8*)(hl + (sub * 16 + (lane & 15)) * S5_HST + 64 * ks + 16 * (lane >> 4)); y = MFMA16(hf, cf[ks], y); }
                if (DIR == 0) *(f32x4*)ys = y;
                else {
                    const bf16x8 uf = *(const LAS bf16x8*)(ul + (tile * 32 + sub * 16 + (lane & 15)) * S5_UST + (g & 7) * 32 + 16 * ((lane >> 4) & 1));
                    y = MFMA16(uf, dfrag, y);
                    bf16* yo = (bf16*)(ws + WS_YG) + (rowbase + tile * 32 + sub * 16 + 4 * (lane >> 4)) * 512 + g * 16 + (lane & 15);
#pragma unroll
                    for (int r = 0; r < 4; ++r) yo[(size_t)r * 512] = (bf16)f2bf(gelu_tanh(y[r]));
                }
            }
        }
    }
    if (PASS == 1) { f32x2 e; e.x = hr; e.y = hi; *(f32x2*)(Ec + (size_t)c * 128) = e; }
}
template <int PASS>
__device__ __forceinline__ void s5_phase(unsigned char* ws, const float* s5d, LAS unsigned char* lds, int bid, int G, int tid, int wave, int lane) {
    LAS unsigned char* hl = lds + wave * (32 * S5_HST); LAS unsigned char* ul = lds + S5_UOFF;
    float* yscr = (float*)(ws + WS_YSCR) + (size_t)(bid * NWAVES + wave) * 4096;
    const bf16* h0 = (const bf16*)(ws + WS_H0);
    for (int it = bid; it < NB * S5NCH * 4; it += G) {
        const int go = it & 3, c = (it >> 2) % S5NCH, b = it / (4 * S5NCH), g = go * 8 + wave;
        { const bf16* src = h0 + ((size_t)b * SEQ + (size_t)c * S5CH) * H0P + OFF_U + go * 128;
          u32x4 v[8];
#pragma unroll
          for (int i = 0; i < 8; ++i) { const int p = i * NTHR + tid; v[i] = *(const u32x4*)(src + (size_t)(p >> 4) * H0P + 8 * (p & 15)); }
          __syncthreads();
#pragma unroll
          for (int i = 0; i < 8; ++i) { const int p = i * NTHR + tid; *(LAS u32x4*)(ul + (p >> 4) * S5_UST + 16 * (p & 15)) = v[i]; }
          __syncthreads(); }
        s5_dir<PASS, 0>(ws, s5d, b, g, c, hl, ul, yscr, lane);
        s5_dir<PASS, 1>(ws, s5d, b, g, c, hl, ul, yscr, lane);
    }
}
constexpr int G_ST = 144;
constexpr int GL_QD = 0, GL_KD = GL_QD + 64 * G_ST, GL_KCT = GL_KD + 64 * G_ST, GL_VT = GL_KCT + 64 * G_ST,
              GL_S = GL_VT + 128 * G_ST, GL_ST = GL_S + 64 * G_ST, GL_END = GL_ST + 2 * 128 * G_ST;
static_assert(GL_END <= RING_BYTES, "GLA LDS");
__device__ __forceinline__ bf16x8 ldfrag32(const LAS unsigned char* base, int row0, int ks, int lane) {
    return *(const LAS bf16x8*)(base + (row0 + (lane & 31)) * G_ST + 32 * ks + 16 * (lane >> 5));
}
__device__ __forceinline__ void gate_tail(float* bcg, const float* gate_w, const float* gate_b, const LAS float* lrs, size_t row0, int tid) {
    const int dir = tid >> 8;
    float gw[16];
#pragma unroll
    for (int r = 0; r < 16; ++r) gw[r] = gate_w[(size_t)(dir * 16 + r) * 256 + (tid & 255)];
    const float gb = gate_b[tid];
    float run = 0.f;
#pragma unroll 4
    for (int i = 0; i < 128; ++i) {
        const int t = dir ? 127 - i : i;
        if ((i & 63) == 0) run = 0.f;
        const LAS f32x4* lp = (const LAS f32x4*)(lrs + t * 32 + dir * 16);
        const f32x4 l0 = lp[0], l1 = lp[1], l2 = lp[2], l3 = lp[3];
        float z = gb + l0.x * gw[0] + l0.y * gw[1] + l0.z * gw[2] + l0.w * gw[3] + l1.x * gw[4] + l1.y * gw[5] + l1.z * gw[6] + l1.w * gw[7]
                     + l2.x * gw[8] + l2.y * gw[9] + l2.z * gw[10] + l2.w * gw[11] + l3.x * gw[12] + l3.y * gw[13] + l3.z * gw[14] + l3.w * gw[15];
        const float ls = fminf(z, 0.f) - __logf(1.f + __expf(-fabsf(z)));
        run += ls * (1.0f / 16.0f);
        bcg[(row0 + t) * 512 + tid] = run;
    }
}
__device__ __forceinline__ size_t gla_tok(int b, int dir, int chunk, int s) { const int pos = chunk * GCH + s; return (size_t)b * SEQ + (dir ? (SEQ - 1 - pos) : pos); }
template <int PASS>
__device__ __forceinline__ void gla_item(unsigned char* ws, const float* bcg, int item, LAS unsigned char* lds, int tid, int wave, int lane) {
    const int sc = item % GNSC, dir = (item / GNSC) & 1, h = (item / (GNSC * 2)) & 3, b = item / (GNSC * 8);
    const bf16* h0 = (const bf16*)(ws + WS_H0);
    LAS unsigned char* QD = lds + GL_QD; LAS unsigned char* KD = lds + GL_KD; LAS unsigned char* KCT = lds + GL_KCT; LAS unsigned char* VT = lds + GL_VT; LAS unsigned char* SS = lds + GL_S; LAS unsigned char* STT = lds + GL_ST;
    const int me = wave >> 1, nd = wave & 1;
    f32x16 st;
#pragma unroll
    for (int r = 0; r < 16; ++r) st[r] = 0.f;
    float dtot = 1.f;
    float* GS = (float*)(ws + WS_GS); float* GD = (float*)(ws + WS_GD);
    const int ibase = item - sc;
    if (PASS == 2) {
        for (int j0 = 0; j0 < sc; j0 += 4) {
            float dj[4], gv[4][16];
#pragma unroll
            for (int q = 0; q < 4; ++q) { const int j = (j0 + q) < sc ? (j0 + q) : (sc - 1);
                dj[q] = GD[(size_t)(ibase + j) * 64 + nd * 32 + (lane & 31)];
                const float* gs = GS + (size_t)(ibase + j) * 8192 + nd * 32 + (lane & 31);
#pragma unroll
                for (int r = 0; r < 16; ++r) gv[q][r] = gs[(size_t)(me * 32 + crow(r, lane >> 5)) * 64]; }
#pragma unroll
            for (int q = 0; q < 4; ++q) if (j0 + q < sc) {
#pragma unroll
                for (int r = 0; r < 16; ++r) st[r] = st[r] * dj[q] + gv[q][r]; }
        }
#pragma unroll
        for (int r = 0; r < 16; ++r) *(LAS bf16*)(STT + (me * 32 + crow(r, lane >> 5)) * G_ST + (nd * 32 + (lane & 31)) * 2) = (bf16)f2bf(st[r]);
    }
    const float qscale = 0.125f;
    const int s_l = lane;
    const int gcol = dir * 256 + h * 64;
    u32x4 pq, pk, pv0, pv1; f32x4 pb0, pb1, pl0, pl1; float pdec;
#define GLA_LOAD(n) do { const int ch_ = sc * GSC + (n); const size_t tk = gla_tok(b, dir, ch_, s_l), tl = gla_tok(b, dir, ch_, 63); const bf16* rp = h0 + tk * H0P; \
        if (PASS == 2) pq = *(const u32x4*)(rp + OFF_Q + h * 64 + 8 * wave); \
        pk = *(const u32x4*)(rp + OFF_K + h * 64 + 8 * wave); pv0 = *(const u32x4*)(rp + OFF_V + h * 128 + 16 * wave); pv1 = *(const u32x4*)(rp + OFF_V + h * 128 + 16 * wave + 8); \
        pb0 = *(const f32x4*)(bcg + tk * 512 + gcol + 8 * wave); pb1 = *(const f32x4*)(bcg + tk * 512 + gcol + 8 * wave + 4); \
        pl0 = *(const f32x4*)(bcg + tl * 512 + gcol + 8 * wave); pl1 = *(const f32x4*)(bcg + tl * 512 + gcol + 8 * wave + 4); \
        pdec = bcg[tl * 512 + gcol + nd * 32 + (lane & 31)]; } while (0)
    GLA_LOAD(0);
    __syncthreads();
#pragma unroll 1
    for (int n = 0; n < GSC; ++n) {
        LAS unsigned char* STc = STT + (n & 1) * (128 * G_ST); LAS unsigned char* STn = STT + ((n + 1) & 1) * (128 * G_ST);
        { const float bc[8] = {pb0.x, pb0.y, pb0.z, pb0.w, pb1.x, pb1.y, pb1.z, pb1.w}, bl[8] = {pl0.x, pl0.y, pl0.z, pl0.w, pl1.x, pl1.y, pl1.z, pl1.w};
          const float kv[8] = {bflo(pk.x), bfhi(pk.x), bflo(pk.y), bfhi(pk.y), bflo(pk.z), bfhi(pk.z), bflo(pk.w), bfhi(pk.w)};
          if (PASS == 2) {
              const float qv[8] = {bflo(pq.x), bfhi(pq.x), bflo(pq.y), bfhi(pq.y), bflo(pq.z), bfhi(pq.z), bflo(pq.w), bfhi(pq.w)};
              float qd[8], kd[8];
#pragma unroll
              for (int i = 0; i < 8; ++i) { qd[i] = qv[i] * qscale * __expf(bc[i]); kd[i] = kv[i] * __expf(-bc[i]); }
              u32x4 w; w.x = pk2(qd[0], qd[1]); w.y = pk2(qd[2], qd[3]); w.z = pk2(qd[4], qd[5]); w.w = pk2(qd[6], qd[7]);
              *(LAS u32x4*)(QD + s_l * G_ST + 16 * wave) = w;
              w.x = pk2(kd[0], kd[1]); w.y = pk2(kd[2], kd[3]); w.z = pk2(kd[4], kd[5]); w.w = pk2(kd[6], kd[7]);
              *(LAS u32x4*)(KD + s_l * G_ST + 16 * wave) = w;
          }
#pragma unroll
          for (int i = 0; i < 8; ++i) *(LAS bf16*)(KCT + (8 * wave + i) * G_ST + 2 * s_l) = (bf16)f2bf(kv[i] * __expf(bl[i] - bc[i]));
          const unsigned vv[8] = {pv0.x, pv0.y, pv0.z, pv0.w, pv1.x, pv1.y, pv1.z, pv1.w};
#pragma unroll
          for (int i = 0; i < 8; ++i) { *(LAS bf16*)(VT + (16 * wave + 2 * i) * G_ST + 2 * s_l) = (bf16)(vv[i] & 0xffffu); *(LAS bf16*)(VT + (16 * wave + 2 * i + 1) * G_ST + 2 * s_l) = (bf16)(vv[i] >> 16); }
        }
        const float dec = __expf(pdec);
        if (n + 1 < GSC) GLA_LOAD(n + 1);
        LDS_BARRIER();
        if (PASS == 2 && wave < 4) {
            const int ms = wave >> 1, ns = wave & 1;
            f32x16 sa;
#pragma unroll
            for (int r = 0; r < 16; ++r) sa[r] = 0.f;
            if (ns <= ms) {
#pragma unroll
                for (int ks = 0; ks < 4; ++ks) sa = MFMA32(ldfrag32(QD, ms * 32, ks, lane), ldfrag32(KD, ns * 32, ks, lane), sa);
            }
#pragma unroll
            for (int r = 0; r < 16; ++r) { const int s = ms * 32 + crow(r, lane >> 5), s2 = ns * 32 + (lane & 31);
                const bool keep = dir ? (s2 < s) : (s2 <= s);
                *(LAS bf16*)(SS + s * G_ST + 2 * s2) = (bf16)f2bf(keep ? sa[r] : 0.f); }
        }
#pragma unroll
        for (int r = 0; r < 16; ++r) st[r] *= dec;
        dtot *= dec;
#pragma unroll
        for (int ks = 0; ks < 4; ++ks) st = MFMA32(ldfrag32(VT, me * 32, ks, lane), ldfrag32(KCT, nd * 32, ks, lane), st);
        if (PASS == 2 && n + 1 < GSC) {
#pragma unroll
            for (int r = 0; r < 16; ++r) *(LAS bf16*)(STn + (me * 32 + crow(r, lane >> 5)) * G_ST + (nd * 32 + (lane & 31)) * 2) = (bf16)f2bf(st[r]);
        }
        LDS_BARRIER();
        if (PASS == 2) {
            const int ms = wave >> 2, ne = wave & 3;
            f32x16 oa;
#pragma unroll
            for (int r = 0; r < 16; ++r) oa[r] = 0.f;
#pragma unroll
            for (int ks = 0; ks < 4; ++ks) oa = MFMA32(ldfrag32(SS, ms * 32, ks, lane), ldfrag32(VT, ne * 32, ks, lane), oa);
#pragma unroll
            for (int ks = 0; ks < 4; ++ks) oa = MFMA32(ldfrag32(QD, ms * 32, ks, lane), ldfrag32(STc, ne * 32, ks, lane), oa);
            bf16* op = (bf16*)(ws + (dir ? WS_OB : WS_OF)) + h * 128 + ne * 32 + (lane & 31);
#pragma unroll
            for (int r = 0; r < 16; ++r) op[gla_tok(b, dir, sc * GSC + n, ms * 32 + crow(r, lane >> 5)) * 512] = (bf16)f2bf(oa[r]);
            LDS_BARRIER();
        }
    }
    if (PASS == 1) {
        float* gs = GS + (size_t)item * 8192 + nd * 32 + (lane & 31);
#pragma unroll
        for (int r = 0; r < 16; ++r) gs[(size_t)(me * 32 + crow(r, lane >> 5)) * 64] = st[r];
        if (me == 0 && lane < 32) GD[(size_t)item * 64 + nd * 32 + lane] = dtot;
    }
    __syncthreads();
#undef GLA_LOAD
}
constexpr int AT_KST = 144, AT_VST = 664, AT_K = 0, AT_V = 320 * AT_KST, AT_BT = AT_V + 64 * AT_VST, AT_END = AT_BT + 4 * 260 * 4;
static_assert(AT_END <= RING_BYTES && AT_V % 16 == 0 && AT_BT % 16 == 0, "attention LDS");
__device__ __forceinline__ void attn_phase(unsigned char* ws, const float* sink, LAS unsigned char* lds, int bid, int G, int tid, int wave, int lane) {
    const bf16* qkv = (const bf16*)(ws + WS_QKV); bf16* ao = (bf16*)(ws + WS_AO); const float* btab = (const float*)(ws + WS_BTAB);
    LAS unsigned char* KS = lds + AT_K; LAS unsigned char* VT = lds + AT_V; LAS float* BT = (LAS float*)(lds + AT_BT);
    const float sc2 = 0.125f * LOG2E;
    u32x4 kreg[5], vreg[5];
#define AT_LOAD(u_) do { const int qb_ = (u_) % (SEQ / 64), kvh_ = ((u_) / (SEQ / 64)) & 3, b_ = (u_) / (4 * (SEQ / 64)), kb_ = qb_ * 64 - 128; \
        _Pragma("unroll") for (int it = 0; it < 5; ++it) { const int p = it * NTHR + tid; int key = kb_ + (p >> 3); key = key < 0 ? 0 : (key > SEQ - 1 ? SEQ - 1 : key); \
            const bf16* rp = qkv + ((size_t)b_ * SEQ + key) * CN + kvh_ * 64 + 8 * (p & 7); kreg[it] = *(const u32x4*)(rp + 1024); vreg[it] = *(const u32x4*)(rp + 1280); } } while (0)
    if (bid < NB * 4 * (SEQ / 64)) AT_LOAD(bid);
    for (int u = bid; u < NB * 4 * (SEQ / 64); u += G) {
        const int qb = u % (SEQ / 64), kvh = (u / (SEQ / 64)) & 3, b = u / (4 * (SEQ / 64)), q0 = qb * 64;
#pragma unroll
        for (int it = 0; it < 5; ++it) { const int p = it * NTHR + tid, i = p >> 3, ch = p & 7;
            *(LAS u32x4*)(KS + i * AT_KST + 16 * ch) = kreg[it];
            const unsigned vv[4] = {vreg[it].x, vreg[it].y, vreg[it].z, vreg[it].w};
#pragma unroll
            for (int j = 0; j < 4; ++j) { *(LAS bf16*)(VT + (8 * ch + 2 * j) * AT_VST + 2 * i) = (bf16)(vv[j] & 0xffffu); *(LAS bf16*)(VT + (8 * ch + 2 * j + 1) * AT_VST + 2 * i) = (bf16)(vv[j] >> 16); } }
        for (int p = tid; p < 4 * 260; p += NTHR) BT[p] = btab[(kvh * 4) * 260 + p];
        if (u + G < NB * 4 * (SEQ / 64)) AT_LOAD(u + G);
        LDS_BARRIER();
        const int hl = wave >> 1, hq = kvh * 4 + hl, qw = q0 + 32 * (wave & 1), qi = qw + (lane & 31), hh = lane >> 5;
        bf16x8 qf[4];
        { const bf16* qp = qkv + ((size_t)b * SEQ + qi) * CN + hq * 64 + 8 * hh;
#pragma unroll
          for (int ks = 0; ks < 4; ++ks) qf[ks] = *(const bf16x8*)(qp + 16 * ks); }
        float m = sink[hq] * LOG2E, l = hh == 0 ? 1.f : 0.f;
        f32x16 o0, o1;
#pragma unroll
        for (int r = 0; r < 16; ++r) { o0[r] = 0.f; o1[r] = 0.f; }
        const LAS float* btc = BT + hl * 260 + 128;
#pragma unroll 1
        for (int j = 0; j < 9; ++j) {
            const int i0 = 32 * (wave & 1) + 32 * j;
            f32x16 sa;
#pragma unroll
            for (int r = 0; r < 16; ++r) sa[r] = 0.f;
#pragma unroll
            for (int ks = 0; ks < 4; ++ks) { const bf16x8 kf = *(const LAS bf16x8*)(KS + (i0 + (lane & 31)) * AT_KST + 32 * ks + 16 * hh); sa = MFMA32(kf, qf[ks], sa); }
            float mx = -3.0e38f;
#pragma unroll
            for (int r = 0; r < 16; ++r) {
                const int kk = 32 * j - 128 + crow(r, hh);
                const int rel = kk - (lane & 31), key = qw + kk;
                const bool ok = ((unsigned)(rel + 128) <= 256u) && ((unsigned)key < (unsigned)SEQ);
                int rc = rel < -128 ? -128 : rel; rc = rc > 128 ? 128 : rc;
                const float bsv = btc[rc];
                const float s = ok ? (sa[r] * sc2 + bsv) : -3.0e38f;
                sa[r] = s; mx = fmaxf(mx, s);
            }
            mx = fmaxf(mx, __shfl_xor(mx, 32));
            if (!__all(mx <= m)) {
                const float mn = fmaxf(m, mx), alpha = __builtin_amdgcn_exp2f(m - mn); m = mn; l *= alpha;
#pragma unroll
                for (int r = 0; r < 16; ++r) { o0[r] *= alpha; o1[r] *= alpha; }
            }
            float ps = 0.f;
#pragma unroll
            for (int r = 0; r < 16; ++r) { const float p = __builtin_amdgcn_exp2f(sa[r] - m); sa[r] = p; ps += p; }
            l += ps;
#pragma unroll
            for (int s = 0; s < 2; ++s) {
                u32x4 pw; pw.x = pk2(sa[8 * s], sa[8 * s + 1]); pw.y = pk2(sa[8 * s + 2], sa[8 * s + 3]); pw.z = pk2(sa[8 * s + 4], sa[8 * s + 5]); pw.w = pk2(sa[8 * s + 6], sa[8 * s + 7]);
                const bf16x8 pf = __builtin_bit_cast(bf16x8, pw);
#pragma unroll
                for (int dt = 0; dt < 2; ++dt) {
                    const LAS unsigned char* vp = VT + (dt * 32 + (lane & 31)) * AT_VST + 2 * (i0 + 16 * s + 4 * hh);
                    const bf16x4 va = *(const LAS bf16x4*)vp, vb = *(const LAS bf16x4*)(vp + 16);
                    const bf16x8 vf = __builtin_shufflevector(va, vb, 0, 1, 2, 3, 4, 5, 6, 7);
                    if (dt == 0) o0 = MFMA32(vf, pf, o0); else o1 = MFMA32(vf, pf, o1);
                }
            }
        }
        l += __shfl_xor(l, 32);
        const float inv = __builtin_amdgcn_rcpf(l);
        bf16* op = ao + ((size_t)b * SEQ + qi) * D + hq * 64 + 4 * hh;
#pragma unroll
        for (int g = 0; g < 4; ++g) {
            u32x2 w0, w1; w0.x = pk2(o0[4 * g] * inv, o0[4 * g + 1] * inv); w0.y = pk2(o0[4 * g + 2] * inv, o0[4 * g + 3] * inv);
            w1.x = pk2(o1[4 * g] * inv, o1[4 * g + 1] * inv); w1.y = pk2(o1[4 * g + 2] * inv, o1[4 * g + 3] * inv);
            *(u32x2*)(op + 8 * g) = w0; *(u32x2*)(op + 32 + 8 * g) = w1;
        }
        LDS_BARRIER();
    }
#undef AT_LOAD
}
#ifndef MK_N_LAUNCHES
#define MK_N_LAUNCHES 1
#endif
constexpr int N_PHASES = 19;
#ifndef PH_MASK
#define PH_MASK 0xFFFFFFFFu
#endif
#define ON(k) (((PH_MASK) >> (k)) & 1u)
#ifndef REP_MASK
#define REP_MASK 0u
#endif
#define NREP(k) ((((REP_MASK) >> (k)) & 1u) ? 2 : 1)

template <int LAYER>
__device__ __forceinline__ void common_phases(unsigned char* ws, LAS unsigned char* lds, float* dout, const XcdBarrier& bar, int lo, int hi, int bid, int G, int tid, int wave, int lane) {
    constexpr int pb = LAYER == 0 ? 5 : 13;
    const int gw = bid * NWAVES + wave, NGW = G * NWAVES;
#define IN(k) (lo <= (k) && (k) < hi)
#define SEAM(k) do { if (IN(k) && IN((k) + 1)) xcd_barrier(bar); } while (0)
    if (ON(5) && IN(pb)) {
        pg8::Gemm g{(const bf16*)(ws + (LAYER == 0 ? WS_X64 : WS_AO)), (const bf16*)(ws + (LAYER == 0 ? WS_WOUT : WS_COUT)), T, D, D, 0, nullptr}; pg8::StaticOrder S; S.init(T, D, G, bid);
        pg8::EpiBf16 E{(bf16*)(ws + WS_Z), D};
        pg8::gemm_phase<pg8::EpiBf16, pg8::StaticOrder, false>(lds, g, S, E);
    }
    SEAM(pb);
    if (ON(6) && IN(pb + 1)) { ln_router(ws, LAYER == 0 ? inp(lds, I_X) : (const float*)(ws + WS_H1), inp(lds, I_LNMG) + LAYER * D, inp(lds, I_LNMB) + LAYER * D, inp(lds, I_BGRP) + LAYER * 4, inp(lds, I_BRT) + LAYER * 32, LAYER, lds, bid, G, tid, wave, lane); __syncthreads(); }
    SEAM(pb + 1);
    if (ON(7) && IN(pb + 2)) { moe_sort(ws, lds, bid, G, tid); __syncthreads(); }
    SEAM(pb + 2);
    if (ON(8) && IN(pb + 3)) {
        const int* tile = (const int*)(ws + WS_TILE); const int ntiles = __builtin_amdgcn_readfirstlane(tile[511]);
        pg8::Gemm g{(const bf16*)(ws + WS_X64), LAYER == 0 ? (const bf16*)(ws + WS_W13) : (const bf16*)dout, 0, D, D, (size_t)D * D * 2, (const int*)(ws + WS_SLOTT)};
        pg8::GroupOrder S{tile, ntiles, D / 256, G, bid};
        pg8::EpiSwiglu E{(bf16*)(ws + WS_HID), DEXP};
        pg8::gemm_phase<pg8::EpiSwiglu, pg8::GroupOrder, true>(lds, g, S, E);
        if (LAYER == 0) idle_convert(0, ws, lds, dout, ntiles, bid, G, wave, lane);
    }
    SEAM(pb + 3);
    if (ON(9) && IN(pb + 4)) {
        const int* tile = (const int*)(ws + WS_TILE); const int ntiles = __builtin_amdgcn_readfirstlane(tile[511]);
        pg8::Gemm g{(const bf16*)(ws + WS_HID), LAYER == 0 ? (const bf16*)(ws + WS_W2) : (const bf16*)dout + (size_t)NEXP * D * D, 0, D, DEXP, (size_t)D * DEXP * 2, nullptr};
        pg8::GroupOrder S{tile, ntiles, D / 256, G, bid};
        pg8::EpiBf16 E{(bf16*)(ws + WS_Y2), D};
        pg8::gemm_phase<pg8::EpiBf16, pg8::GroupOrder, false>(lds, g, S, E);
        if (LAYER == 0) idle_convert(1, ws, lds, dout, ntiles, bid, G, wave, lane);
    }
    SEAM(pb + 4);
    if (ON(10) && IN(pb + 5)) {
        if (LAYER == 0) {
            combine_ln<false>(ws, inp(lds, I_LNFG), inp(lds, I_LNFB), nullptr, gw, NGW, lane);
            { const int done = idle_done(__builtin_amdgcn_readfirstlane(((const int*)(ws + WS_TILE))[511]), G);
              moe_convert(inp(lds, I_W1) + (size_t)NEXP * D * DEXP, inp(lds, I_W3) + (size_t)NEXP * D * DEXP, inp(lds, I_W2) + (size_t)NEXP * DEXP * D, (bf16*)dout, (bf16*)dout + (size_t)NEXP * D * D, (LAS float*)(lds + wave * 16384), done, MOE_ITEMS, gw, NGW, lane); }
            __syncthreads();
        } else combine_ln<true>(ws, inp(lds, I_LNFG) + D, inp(lds, I_LNFB) + D, dout, gw, NGW, lane);
    }
    if (LAYER == 0) SEAM(10);
#undef IN
#undef SEAM
}

struct Args { const float* in[N_IN]; float* out; unsigned char* ws; int ph_lo, ph_hi; };
static_assert(sizeof(Args) == N_IN * 8 + 8 + 8 + 8, "no padding holes in Args");

__global__ void __launch_bounds__(NTHR, 2) fwd_kernel(Args args) {
    extern __shared__ __attribute__((aligned(16))) unsigned char lds_raw[];
    LAS unsigned char* lds = (LAS unsigned char*)lds_raw;
    volatile LAS unsigned* MISC = (volatile LAS unsigned*)(lds + MISC_OFF);
    const int tid = threadIdx.x, lane = tid & 63, wave = __builtin_amdgcn_readfirstlane(tid >> 6), G = gridDim.x, bid = blockIdx.x;
    unsigned char* ws = args.ws;
    for (int u = tid; u < 64; u += NTHR) MISC[u] = 0u;
    if (tid < N_IN) *(LAS unsigned long long*)(lds + PTR_OFF + 8 * tid) = (unsigned long long)args.in[tid];
    __syncthreads();
    const int lo = args.ph_lo, hi = args.ph_hi;
    const bool use_bar = (hi - lo) > 1;
    XcdBarrier bar; bar.bar = (unsigned*)(ws + WS_CTL) + CW_BAR; bar.x = 0; bar.st = nullptr;
    if (use_bar) bar = xcd_barrier_post((unsigned*)(ws + WS_CTL) + CW_BAR, MISC + 8);
#define IN(k) (lo <= (k) && (k) < hi)
#define SEAM(k) do { if (IN(k) && IN((k) + 1)) xcd_barrier(bar); } while (0)
    const int gw = bid * NWAVES + wave, NGW = G * NWAVES;

    if (ON(0) && IN(0)) { p0_prologue(ws, lds, bid, G, tid, wave, lane); __syncthreads(); }
    SEAM(0);
    if (ON(1) && IN(1)) {
        pg8::Gemm g{(const bf16*)(ws + WS_X64), (const bf16*)(ws + WS_WIN), T, ABN, D, 0, nullptr}; pg8::SplitOrder S; S.init(T, ABN, 2, G, bid);
        pg8::EpiBf16 E{(bf16*)(ws + WS_H0), H0P};
        pg8::gemm_phase<pg8::EpiBf16, pg8::SplitOrder, false>(lds, g, S, E);
        lr_tail(ws, args.out, inp(lds, I_GATEW), inp(lds, I_GATEB), lds, bid, G, tid, wave, lane);
#ifdef TAIL_TWICE
        lr_tail(ws, args.out, inp(lds, I_GATEW), inp(lds, I_GATEB), lds, bid, G, tid, wave, lane);
#endif
    }
    SEAM(1);
    if (ON(2) && IN(2)) {
        s5_phase<1>(ws, inp(lds, I_S5D), lds, bid, G, tid, wave, lane);
#ifdef S5_TWICE
        __syncthreads(); s5_phase<1>(ws, inp(lds, I_S5D), lds, bid, G, tid, wave, lane);
#endif
        __syncthreads();
        for (int it = bid; it < 256; it += G) gla_item<1>(ws, args.out, it, lds, tid, wave, lane);
#ifdef GLA_TWICE
        for (int it = bid; it < 256; it += G) gla_item<1>(ws, args.out, it, lds, tid, wave, lane);
#endif
    }
    SEAM(2);
    if (ON(3) && IN(3)) {
        s5_phase<2>(ws, inp(lds, I_S5D), lds, bid, G, tid, wave, lane);
#ifdef S5_TWICE
        __syncthreads(); s5_phase<2>(ws, inp(lds, I_S5D), lds, bid, G, tid, wave, lane);
#endif
        __syncthreads();
        for (int it = bid; it < 256; it += G) gla_item<2>(ws, args.out, it, lds, tid, wave, lane);
#ifdef GLA_TWICE
        for (int it = bid; it < 256; it += G) gla_item<2>(ws, args.out, it, lds, tid, wave, lane);
#endif
    }
    SEAM(3);
    if (ON(4) && IN(4)) {
        gla_finalize(ws, inp(lds, I_NORMG), gw, NGW, lane);
        pg8::Gemm g{(const bf16*)(ws + WS_YG), (const bf16*)(ws + WS_WGLU), T, 512, 512, 0, nullptr}; pg8::StaticOrder S; S.init(T, 512, G, bid);
        pg8::EpiGlu E{(const bf16*)(ws + WS_YG), 512, (bf16*)(ws + WS_X64), D, inp(lds, I_GLUB)};
        pg8::gemm_phase<pg8::EpiGlu, pg8::StaticOrder, false>(lds, g, S, E);
    }
    SEAM(4);
    common_phases<0>(ws, lds, args.out, bar, lo, hi, bid, G, tid, wave, lane);
    if (ON(11) && IN(11)) {
        pg8::Gemm g{(const bf16*)(ws + WS_H2B), (const bf16*)(ws + WS_CIN), T, CN, D, 0, nullptr}; pg8::StaticOrder S; S.init(T, CN, G, bid);
        pg8::EpiBf16 E{(bf16*)(ws + WS_QKV), CN};
        pg8::gemm_phase<pg8::EpiBf16, pg8::StaticOrder, false>(lds, g, S, E);
    }
    SEAM(11);
    if (ON(12) && IN(12)) attn_phase(ws, inp(lds, I_SINK), lds, bid, G, tid, wave, lane);
    SEAM(12);
    common_phases<1>(ws, lds, args.out, bar, lo, hi, bid, G, tid, wave, lane);
#undef IN
#undef SEAM
}

extern "C" void kernel_launch(void* const* d_in, const int* in_sizes, int n_in, void* d_out, int out_size, void* d_ws, size_t ws_size, hipStream_t stream) {
    static int grid = 0;
    if (grid == 0) {
        if (n_in != N_IN || in_sizes[0] != T * D || out_size != T * D || ws_size < WS_END) { fprintf(stderr, "kernel_launch: unexpected shapes (n_in %d, in0 %d, out %d, ws %zu < %zu)\n", n_in, n_in > 0 ? in_sizes[0] : -1, out_size, ws_size, (size_t)WS_END); grid = -1; return; }
        int dev = 0, cus = 0, per_cu = 0;
        if (hipGetDevice(&dev) != hipSuccess || hipDeviceGetAttribute(&cus, hipDeviceAttributeMultiprocessorCount, dev) != hipSuccess) { grid = -1; return; }
        if (hipFuncSetAttribute((const void*)fwd_kernel, hipFuncAttributeMaxDynamicSharedMemorySize, LDS_BYTES) != hipSuccess) { fprintf(stderr, "kernel_launch: hipFuncSetAttribute failed\n"); grid = -1; return; }
        if (hipOccupancyMaxActiveBlocksPerMultiprocessor(&per_cu, (const void*)fwd_kernel, NTHR, LDS_BYTES) != hipSuccess || per_cu < 1) fprintf(stderr, "kernel_launch: occupancy query reports %d\n", per_cu);
        (void)hipGetLastError();
        grid = cus;
    }
    if (grid < 0) return;
    if (hipMemsetAsync((char*)d_ws + WS_CTL, 0, CTL_ZERO_BYTES, stream) != hipSuccess) return;
    Args a{};
    for (int i = 0; i < N_IN; ++i) a.in[i] = (const float*)d_in[i];
    a.out = (float*)d_out; a.ws = (unsigned char*)d_ws;
    for (int li = 0; li < MK_N_LAUNCHES; ++li) {
        a.ph_lo = (MK_N_LAUNCHES == 1) ? 0 : li; a.ph_hi = (MK_N_LAUNCHES == 1) ? N_PHASES : li + 1;
        for (int rep = 0; rep < ((MK_N_LAUNCHES > 1 && ((REP_MASK >> li) & 1u)) ? 2 : 1); ++rep)
            hipLaunchKernelGGL(fwd_kernel, dim3(grid), dim3(NTHR), LDS_BYTES, stream, a);
    }
}
```

```cpp
#include <hip/hip_runtime.h>
#include <cstdio>
#include <cstdint>
#include <cmath>
namespace pg8 {
#define PG8_LAS __attribute__((address_space(3)))
typedef unsigned short bf16_t;
typedef short bf16x8 __attribute__((ext_vector_type(8)));
typedef float f32x4 __attribute__((ext_vector_type(4)));
typedef float f32x2 __attribute__((ext_vector_type(2)));
typedef unsigned u32x4 __attribute__((ext_vector_type(4)));
typedef unsigned u32x2 __attribute__((ext_vector_type(2)));
constexpr int BM = 256, BK = 64, HALF = 128, HTB = HALF * BK * 2  , STAGE_BYTES = 8 * HTB, NXCD = 8, WGM = 8;

__host__ __device__ __forceinline__ int lds_byte(int r, int c) { const int st = (r >> 4) * 2 + (c >> 5), rr = r & 15, cc = c & 31, ob = rr * 64 + cc * 2; return st * 1024 + (ob ^ (((ob >> 9) & 1) << 5)); }
__host__ __device__ __forceinline__ void stage_rc(int b, int& R, int& C) { const int st = b / 1024, sb = b % 1024, swz = sb ^ (((sb >> 9) & 1) << 5); R = (st >> 1) * 16 + swz / 64; C = (st & 1) * 32 + (swz % 64) / 2; }
__host__ __device__ __forceinline__ int perm32(int rho) { const int n = rho >> 4, i = rho & 15; return 8 * (i >> 2) + 4 * n + (i & 3); }

struct Unit { int pm, pn, e, ui; };
struct Gemm { const bf16_t* A; const bf16_t* Bt; int M, N, K; size_t bstride; const int* rowmap; };

struct StaticOrder {
    int nM, nN, nwg, G, c;
    __host__ __device__ void init(int M, int N, int G_, int c_) { nM = M / BM; nN = N / BM; nwg = nM * nN; G = G_; c = c_; }
    __host__ __device__ bool next(int i, Unit& u) const {
        const long L = (long)i * G + c; if (L >= nwg) return false;
        int wgid = (int)L; { const int q = nwg / NXCD, r = nwg % NXCD, xcd = wgid % NXCD, off = wgid / NXCD; wgid = (xcd < r ? xcd * (q + 1) : r * (q + 1) + (xcd - r) * q) + off; }
        const int nig = WGM * nN, gid = wgid / nig, fm = gid * WGM, gsz = (nM - fm) < WGM ? (nM - fm) : WGM;
        u.pm = fm + ((wgid % nig) % gsz); u.pn = (wgid % nig) / gsz; u.e = 0; u.ui = i; return true;
    }
};
struct SplitOrder {
    int nM, nNs, nwgs, nsp, G, c;
    __host__ __device__ void init(int M, int N, int nsp_, int G_, int c_) { nM = M / BM; nNs = N / BM / nsp_; nwgs = nM * nNs; nsp = nsp_; G = G_; c = c_; }
    __host__ __device__ bool next(int i, Unit& u) const {
        const long L = (long)i * G + c; if (L >= (long)nwgs * nsp) return false;
        const int slab = (int)(L / nwgs); int wgid = (int)(L % nwgs);
        { const int q = nwgs / NXCD, r = nwgs % NXCD, xcd = wgid % NXCD, off = wgid / NXCD; wgid = (xcd < r ? xcd * (q + 1) : r * (q + 1) + (xcd - r) * q) + off; }
        const int nig = WGM * nNs, gid = wgid / nig, fm = gid * WGM, gsz = (nM - fm) < WGM ? (nM - fm) : WGM;
        u.pm = fm + ((wgid % nig) % gsz); u.pn = slab * nNs + (wgid % nig) / gsz; u.e = 0; u.ui = i; return true;
    }
};
struct GroupOrder {
    const int* tile_e; int ntiles, nN, G, c;
    __device__ bool next(int i, Unit& u) const {
        const int L = i * G + c; if (L >= ntiles * nN) return false;
        u.pm = L / nN; u.pn = L % nN; u.e = __builtin_amdgcn_readfirstlane(tile_e[u.pm]); u.ui = i; return true;
    }
};

typedef __bf16 bf16x2_t __attribute__((ext_vector_type(2)));
__device__ __forceinline__ unsigned cvt_pk_bf16(float lo, float hi) { f32x2 v = {lo, hi}; return __builtin_bit_cast(unsigned, __builtin_convertvector(v, bf16x2_t)); }
__device__ __forceinline__ float bf_lo(unsigned w) { return __uint_as_float(w << 16); }
__device__ __forceinline__ float bf_hi(unsigned w) { return __uint_as_float(w & 0xffff0000u); }

struct EpiBf16 {
    static constexpr bool PERM = true;
    bf16_t* O; int ldc;
    __device__ __forceinline__ void operator()(const f32x4 (&acc)[2][2][4][2], const Unit& u, int wr, int wc, int fr, int fq) const {
        const int row0 = u.pm * BM + wr * 64 + fr; const int col0 = u.pn * BM + wc * 32 + 8 * fq;
#pragma unroll
        for (int ai = 0; ai < 2; ++ai)
#pragma unroll
            for (int m = 0; m < 4; ++m) { bf16_t* rowp = O + (size_t)(row0 + ai * HALF + m * 16) * ldc + col0;
#pragma unroll
                for (int bj = 0; bj < 2; ++bj) { const f32x4 v0 = acc[ai][bj][m][0], v1 = acc[ai][bj][m][1];
                    u32x4 w; w.x = cvt_pk_bf16(v0[0], v0[1]); w.y = cvt_pk_bf16(v0[2], v0[3]); w.z = cvt_pk_bf16(v1[0], v1[1]); w.w = cvt_pk_bf16(v1[2], v1[3]);
                    *(u32x4*)(rowp + bj * HALF) = w; } }
    }
};
struct EpiGlu {
    static constexpr bool PERM = true;
    const bf16_t* Y; int ldy; bf16_t* O; int ldc; const float* bias;
    __device__ __forceinline__ void operator()(const f32x4 (&acc)[2][2][4][2], const Unit& u, int wr, int wc, int fr, int fq) const {
        const int row0 = u.pm * BM + wr * 64 + fr; const int col0 = u.pn * BM + wc * 32 + 8 * fq;
        f32x4 bv[2][2];
#pragma unroll
        for (int bj = 0; bj < 2; ++bj)
#pragma unroll
            for (int n = 0; n < 2; ++n) bv[bj][n] = *(const f32x4*)(bias + col0 + bj * HALF + 4 * n);
#pragma unroll
        for (int ai = 0; ai < 2; ++ai) {
            u32x4 yq[4][2];
#pragma unroll
            for (int m = 0; m < 4; ++m)
#pragma unroll
                for (int bj = 0; bj < 2; ++bj) yq[m][bj] = *(const u32x4*)(Y + (size_t)(row0 + ai * HALF + m * 16) * ldy + col0 + bj * HALF);
            asm volatile("" ::: "memory");
#pragma unroll
            for (int m = 0; m < 4; ++m) { const size_t r = (size_t)(row0 + ai * HALF + m * 16);
#pragma unroll
                for (int bj = 0; bj < 2; ++bj) { const f32x4 v0 = acc[ai][bj][m][0] + bv[bj][0], v1 = acc[ai][bj][m][1] + bv[bj][1];
                    const u32x4 y = yq[m][bj];
                    float o[8]; const float yv[8] = {bf_lo(y.x), bf_hi(y.x), bf_lo(y.y), bf_hi(y.y), bf_lo(y.z), bf_hi(y.z), bf_lo(y.w), bf_hi(y.w)};
#pragma unroll
                    for (int i = 0; i < 4; ++i) { o[i] = yv[i] * __builtin_amdgcn_rcpf(1.f + __expf(-v0[i])); o[4 + i] = yv[4 + i] * __builtin_amdgcn_rcpf(1.f + __expf(-v1[i])); }
                    u32x4 w; w.x = cvt_pk_bf16(o[0], o[1]); w.y = cvt_pk_bf16(o[2], o[3]); w.z = cvt_pk_bf16(o[4], o[5]); w.w = cvt_pk_bf16(o[6], o[7]);
                    *(u32x4*)(O + r * ldc + col0 + bj * HALF) = w; } }
            asm volatile("" ::: "memory");
        }
    }
};
struct EpiResid {
    static constexpr bool PERM = false;
    const float* resid; float* out; int ldc; float alpha;
    __device__ __forceinline__ void operator()(const f32x4 (&acc)[2][2][4][2], const Unit& u, int wr, int wc, int fr, int fq) const {
        const int col0 = u.pn * BM + wc * 32 + 4 * fq;
#pragma unroll
        for (int ai = 0; ai < 2; ++ai) {
            f32x4 bs[4][2][2];
#pragma unroll
            for (int m = 0; m < 4; ++m) { const size_t off = (size_t)(u.pm * BM + ai * HALF + wr * 64 + m * 16 + fr) * ldc + col0;
#pragma unroll
                for (int bj = 0; bj < 2; ++bj)
#pragma unroll
                    for (int n = 0; n < 2; ++n) bs[m][bj][n] = *(const f32x4*)(resid + off + bj * HALF + n * 16); }
            asm volatile("" ::: "memory");
#pragma unroll
            for (int m = 0; m < 4; ++m) { const size_t off = (size_t)(u.pm * BM + ai * HALF + wr * 64 + m * 16 + fr) * ldc + col0;
#pragma unroll
                for (int bj = 0; bj < 2; ++bj)
#pragma unroll
                    for (int n = 0; n < 2; ++n) *(f32x4*)(out + off + bj * HALF + n * 16) = bs[m][bj][n] * alpha + acc[ai][bj][m][n]; }
            asm volatile("" ::: "memory");
        }
    }
};
struct EpiSwiglu {
    static constexpr bool PERM = true;
    bf16_t* O; int ldc;
    __device__ __forceinline__ void operator()(const f32x4 (&acc)[2][2][4][2], const Unit& u, int wr, int wc, int fr, int fq) const {
        const int row0 = u.pm * BM + wr * 64 + fr; const int col0 = (u.pn * BM + wc * 32 + 8 * fq) >> 1;
#pragma unroll
        for (int ai = 0; ai < 2; ++ai)
#pragma unroll
            for (int m = 0; m < 4; ++m) { bf16_t* rowp = O + (size_t)(row0 + ai * HALF + m * 16) * ldc + col0;
#pragma unroll
                for (int bj = 0; bj < 2; ++bj) { const f32x4 g = acc[ai][bj][m][0], up = acc[ai][bj][m][1]; float o[4];
#pragma unroll
                    for (int i = 0; i < 4; ++i) o[i] = g[i] * __builtin_amdgcn_rcpf(1.f + __expf(-g[i])) * up[i];
                    u32x2 w; w.x = cvt_pk_bf16(o[0], o[1]); w.y = cvt_pk_bf16(o[2], o[3]);
                    *(u32x2*)(rowp + bj * (HALF / 2)) = w; } }
    }
};
struct EpiScale {
    static constexpr bool PERM = true;
    bf16_t* O; int ldc; const float* rw;
    __device__ __forceinline__ void operator()(const f32x4 (&acc)[2][2][4][2], const Unit& u, int wr, int wc, int fr, int fq) const {
        const int row0 = u.pm * BM + wr * 64 + fr; const int col0 = u.pn * BM + wc * 32 + 8 * fq;
        float sw[2][4];
#pragma unroll
        for (int ai = 0; ai < 2; ++ai)
#pragma unroll
            for (int m = 0; m < 4; ++m) sw[ai][m] = rw[row0 + ai * HALF + m * 16];
        asm volatile("" ::: "memory");
#pragma unroll
        for (int ai = 0; ai < 2; ++ai)
#pragma unroll
            for (int m = 0; m < 4; ++m) { const int r = row0 + ai * HALF + m * 16; const float s = sw[ai][m]; bf16_t* rowp = O + (size_t)r * ldc + col0;
#pragma unroll
                for (int bj = 0; bj < 2; ++bj) { const f32x4 v0 = acc[ai][bj][m][0] * s, v1 = acc[ai][bj][m][1] * s;
                    u32x4 w; w.x = cvt_pk_bf16(v0[0], v0[1]); w.y = cvt_pk_bf16(v0[2], v0[3]); w.z = cvt_pk_bf16(v1[0], v1[1]); w.w = cvt_pk_bf16(v1[2], v1[3]);
                    *(u32x4*)(rowp + bj * HALF) = w; } }
    }
};

template <class Epi, class Sched, bool GATHER>
__device__ __forceinline__ void gemm_phase(PG8_LAS unsigned char* lds, const Gemm g, const Sched& S, const Epi& E) {
    const int tid = threadIdx.x, wid = __builtin_amdgcn_readfirstlane(tid >> 6), lane = tid & 63, wr = wid >> 2, wc = wid & 3, fr = lane & 15, fq = lane >> 4;
    const int K = g.K, nt = K / BK;
    unsigned voffA[2], voffB[2]; int RA[2], CA[2];
#pragma unroll
    for (int i = 0; i < 2; ++i) { int R, C; stage_rc(tid * 16 + i * 8192, R, C); const int Rb = Epi::PERM ? ((R & ~31) + perm32(R & 31)) : R;
        voffA[i] = (unsigned)(R * K + C) * 2u; voffB[i] = (unsigned)(Rb * K + C) * 2u; RA[i] = R; CA[i] = C; }
    const size_t kstep = (size_t)(BK * 2);
    const size_t hstep = (size_t)HALF * K * 2;
    const size_t tstep = 2 * hstep;
    const unsigned ldsw = (unsigned)wid * 1024u;
    const int aoff = lds_byte(wr * 64 + fr, fq * 8), boff = lds_byte(wc * 32 + fr, fq * 8);
#define PG8_SA(b, h) (((b) * 2 + (h)) * HTB)
#define PG8_SB(b, h) ((4 + (b) * 2 + (h)) * HTB)
#define PG8_STAGE(bufoff, gbase, voff) do { _Pragma("unroll") for (int _i = 0; _i < 2; ++_i) \
        __builtin_amdgcn_global_load_lds((const unsigned*)((const char*)(gbase) + (voff)[_i]), (PG8_LAS unsigned*)(lds + (bufoff) + ldsw + _i * 8192), 16, 0, 0); } while (0)
#define PG8_LDA(dst, b, h) do { _Pragma("unroll") for (int m = 0; m < 4; ++m) _Pragma("unroll") for (int k = 0; k < 2; ++k) dst[m][k] = *(const PG8_LAS bf16x8*)(lds + PG8_SA(b, h) + aoff + m * 2048 + k * 1024); } while (0)
#define PG8_LDB(dst, b, h) do { _Pragma("unroll") for (int n = 0; n < 2; ++n) _Pragma("unroll") for (int k = 0; k < 2; ++k) dst[n][k] = *(const PG8_LAS bf16x8*)(lds + PG8_SB(b, h) + boff + n * 2048 + k * 1024); } while (0)
#define PG8_MMA(ai, bj, At, Bt) do { __builtin_amdgcn_s_setprio(1); _Pragma("unroll") for (int m = 0; m < 4; ++m) _Pragma("unroll") for (int n = 0; n < 2; ++n) _Pragma("unroll") for (int k = 0; k < 2; ++k) \
        acc[ai][bj][m][n] = __builtin_amdgcn_mfma_f32_16x16x32_bf16(Bt[n][k], At[m][k], acc[ai][bj][m][n], 0, 0, 0); __builtin_amdgcn_s_setprio(0); } while (0)
#define PG8_WAIT_V(n) asm volatile("s_waitcnt vmcnt(" #n ")" ::: "memory")
#define PG8_WAIT_L(n) asm volatile("s_waitcnt lgkmcnt(" #n ")" ::: "memory")
#define PG8_BAR __builtin_amdgcn_s_barrier()
#define PG8_SCHED __builtin_amdgcn_sched_barrier(0)
    Unit cur, nxt; int ui = 0;
    const PG8_LAS int* rmap = (const PG8_LAS int*)(lds + STAGE_BYTES);
    if (GATHER) { Unit t_; for (int i_ = 0; S.next(i_, t_) && i_ < 16; ++i_) { if (tid < BM) ((PG8_LAS int*)(lds + STAGE_BYTES))[i_ * BM + tid] = g.rowmap[t_.pm * BM + tid]; }
        asm volatile("s_waitcnt vmcnt(0) lgkmcnt(0)" ::: "memory"); __builtin_amdgcn_s_barrier(); asm volatile("" ::: "memory"); }
    if (!S.next(0, cur)) return;
    f32x4 acc[2][2][4][2];
#pragma unroll
    for (int a = 0; a < 2; ++a)
#pragma unroll
        for (int b = 0; b < 2; ++b)
#pragma unroll
            for (int m = 0; m < 4; ++m)
#pragma unroll
                for (int n = 0; n < 2; ++n) acc[a][b][m][n] = (f32x4){0.f, 0.f, 0.f, 0.f};
    bf16x8 At[4][2], B0[2][2], B1[2][2];
    unsigned cG[2][2], nG[2][2];
#define PG8_LOAD_ROWS(u_, G2_) do { _Pragma("unroll") for (int h_ = 0; h_ < 2; ++h_) _Pragma("unroll") for (int i_ = 0; i_ < 2; ++i_) \
        G2_[h_][i_] = GATHER ? ((unsigned)rmap[(u_).ui * BM + h_ * HALF + RA[i_]] * (unsigned)K + (unsigned)CA[i_]) * 2u : voffA[i_]; } while (0)
    const char* cA = GATHER ? (const char*)g.A : (const char*)g.A + (size_t)cur.pm * tstep;
    const size_t hA = GATHER ? 0 : hstep;
    const char* cB = (const char*)g.Bt + (size_t)cur.e * g.bstride + (size_t)cur.pn * tstep;
    PG8_LOAD_ROWS(cur, cG);
    PG8_STAGE(PG8_SB(0, 0), cB, voffB); PG8_STAGE(PG8_SB(0, 1), cB + hstep, voffB); PG8_STAGE(PG8_SA(0, 0), cA, cG[0]); PG8_STAGE(PG8_SA(0, 1), cA + hA, cG[1]);
    if (wr == 1) PG8_BAR;
    PG8_WAIT_V(2); PG8_BAR;
    PG8_STAGE(PG8_SB(1, 0), cB + kstep, voffB); PG8_STAGE(PG8_SA(1, 0), cA + kstep, cG[0]); PG8_STAGE(PG8_SB(1, 1), cB + hstep + kstep, voffB);
    PG8_WAIT_V(6); PG8_BAR;
    for (;;) {
        const bool has_next = S.next(ui + 1, nxt);
        const char* nA = GATHER ? (const char*)g.A : (has_next ? (const char*)g.A + (size_t)nxt.pm * tstep : cA);
        const char* nB = has_next ? (const char*)g.Bt + (size_t)nxt.e * g.bstride + (size_t)nxt.pn * tstep : cB;
        if (has_next) PG8_LOAD_ROWS(nxt, nG); else {
#pragma unroll
            for (int h = 0; h < 2; ++h) { nG[h][0] = cG[h][0]; nG[h][1] = cG[h][1]; } }
        for (int t = 0; t < nt; t += 2) {
            const bool last = (t == nt - 2);
            const char* a1 = cA + (size_t)(t + 1) * kstep;
            const char* a2 = last ? nA : cA + (size_t)(t + 2) * kstep; const char* b2 = last ? nB : cB + (size_t)(t + 2) * kstep;
            const char* a3 = a2 + kstep; const char* b3 = b2 + kstep;
            unsigned sG[2][2];
#pragma unroll
            for (int h = 0; h < 2; ++h) { sG[h][0] = (GATHER && last) ? nG[h][0] : cG[h][0]; sG[h][1] = (GATHER && last) ? nG[h][1] : cG[h][1]; }
            PG8_LDB(B0, 0, 0); PG8_LDB(B1, 0, 1); PG8_SCHED; PG8_LDA(At, 0, 0); PG8_STAGE(PG8_SA(1, 1), a1 + hA, cG[1]);
            PG8_WAIT_V(8); PG8_WAIT_L(0); PG8_BAR; PG8_MMA(0, 0, At, B0); PG8_MMA(0, 1, At, B1); PG8_BAR; PG8_SCHED;
            PG8_LDA(At, 0, 1); PG8_STAGE(PG8_SB(0, 0), b2, voffB); PG8_STAGE(PG8_SB(0, 1), b2 + hstep, voffB); PG8_STAGE(PG8_SA(0, 0), a2, sG[0]);
            PG8_WAIT_V(8); PG8_WAIT_L(0); PG8_BAR; PG8_MMA(1, 0, At, B0); PG8_MMA(1, 1, At, B1); PG8_BAR; PG8_SCHED;
            PG8_LDB(B0, 1, 0); PG8_LDB(B1, 1, 1); PG8_SCHED; PG8_LDA(At, 1, 0); PG8_STAGE(PG8_SA(0, 1), a2 + hA, sG[1]);
            PG8_WAIT_V(8); PG8_WAIT_L(0); PG8_BAR; PG8_MMA(0, 0, At, B0); PG8_MMA(0, 1, At, B1); PG8_BAR; PG8_SCHED;
            PG8_LDA(At, 1, 1); PG8_STAGE(PG8_SB(1, 0), b3, voffB); PG8_STAGE(PG8_SB(1, 1), b3 + hstep, voffB); PG8_STAGE(PG8_SA(1, 0), a3, sG[0]);
            PG8_WAIT_V(8); PG8_WAIT_L(0); PG8_BAR; PG8_MMA(1, 0, At, B0); PG8_MMA(1, 1, At, B1); PG8_BAR; PG8_SCHED;
        }
        if (wr == 0) PG8_BAR;
        E(acc, cur, wr, wc, fr, fq);
        if (!has_next) break;
#pragma unroll
        for (int a = 0; a < 2; ++a)
#pragma unroll
            for (int b = 0; b < 2; ++b)
#pragma unroll
                for (int m = 0; m < 4; ++m)
#pragma unroll
                    for (int n = 0; n < 2; ++n) acc[a][b][m][n] = (f32x4){0.f, 0.f, 0.f, 0.f};
        cur = nxt; cA = nA; cB = nB; ++ui;
#pragma unroll
        for (int h = 0; h < 2; ++h) { cG[h][0] = nG[h][0]; cG[h][1] = nG[h][1]; }
        if (wr == 1) PG8_BAR;
    }
    PG8_WAIT_V(0);
    PG8_BAR;
#undef PG8_LOAD_ROWS
#undef PG8_SA
#undef PG8_SB
#undef PG8_STAGE
#undef PG8_LDA
#undef PG8_LDB
#undef PG8_MMA
#undef PG8_WAIT_V
#undef PG8_WAIT_L
#undef PG8_BAR
#undef PG8_SCHED
}
}
constexpr int NB = 2, SEQ = 16384, T = NB * SEQ, D = 1024;
constexpr int H0P = 2112;
constexpr int ABN = 2048, OFF_U = 0, OFF_Q = 512, OFF_K = 768, OFF_V = 1024, OFF_GO = 1536, AB_IN = 2080;
constexpr int CN = 1536;
constexpr int NEXP = 32, DEXP = 512, CAP = 2 * T + NEXP * 256, MAXTILES = CAP / 256;
constexpr int S5CH = 256, S5NCH = SEQ / S5CH;
constexpr int GSC = 16, GCH = 64, GNSC = SEQ / (GSC * GCH);
constexpr float ALPHA = 1.41421356237309515f;
constexpr float LN_EPS = 1e-5f, RMS_EPS = 1e-6f, LOG2E = 1.44269504088896341f;
constexpr int NWAVES = 8, NTHR = 512;

constexpr size_t MiB = 1u << 20, KiB = 1u << 10;
constexpr size_t WS_CTL = 0, CTL_ZERO_BYTES = 64 * KiB;
constexpr int CW_BAR = 4096;
constexpr size_t WS_LR = 1 * MiB;
constexpr size_t WS_S5E = 5 * MiB;
constexpr size_t WS_GS = 9 * MiB;
constexpr size_t WS_GD = 17 * MiB;
constexpr size_t WS_S5L = WS_GD + 64 * KiB;
constexpr size_t WS_S5B = WS_S5L + 64 * KiB;
constexpr size_t WS_S5C = WS_S5B + 256 * KiB;
constexpr size_t WS_BTAB = WS_S5C + 256 * KiB;
constexpr size_t WS_WR = WS_BTAB + 32 * KiB;
constexpr size_t WS_TOKE = WS_WR + 384 * KiB;
constexpr size_t WS_TOKW = WS_TOKE + 256 * KiB;
constexpr size_t WS_TOKS = WS_TOKW + 256 * KiB;
constexpr size_t WS_SLOTT = WS_TOKS + 256 * KiB;
constexpr size_t WS_SLOTW = WS_SLOTT + 288 * KiB;
constexpr size_t WS_BLKC = WS_SLOTW + 288 * KiB;
constexpr size_t WS_TILE = WS_BLKC + 32 * KiB;
static_assert(WS_TILE + 4 * KiB <= 32 * MiB, "param region");
constexpr size_t WS_WIN = 32 * MiB, WS_WLR = 36 * MiB, WS_WGLU = 37 * MiB, WS_WOUT = 38 * MiB, WS_CIN = 40 * MiB, WS_COUT = 43 * MiB;
constexpr size_t WS_W13 = 48 * MiB, WS_W2 = 112 * MiB;
constexpr size_t A0 = 144 * MiB;
constexpr size_t WS_H1 = A0, WS_H0 = A0;
constexpr size_t WS_Z = A0 + 128 * MiB;
constexpr size_t WS_YG = A0 + 136 * MiB, WS_OF = A0 + 168 * MiB, WS_OB = A0 + 320 * MiB;
constexpr size_t WS_YSCR = A0 + 232 * MiB;
constexpr size_t WS_X64 = A0 + 256 * MiB;
constexpr size_t WS_HID = A0 + 128 * MiB;
constexpr size_t WS_Y2 = A0 + 200 * MiB;
constexpr size_t WS_H2B = A0 + 128 * MiB;
constexpr size_t WS_QKV = A0 + 192 * MiB;
constexpr size_t WS_AO = A0 + 288 * MiB;
constexpr size_t WS_END = A0 + 384 * MiB;
static_assert((size_t)T * H0P * 2 <= 136 * MiB && WS_Y2 + (size_t)CAP * D * 2 <= WS_END && WS_OB + (size_t)T * 512 * 4 <= WS_END && WS_HID + (size_t)CAP * 512 * 2 <= WS_Y2, "act map");

constexpr int RING_BYTES = 131072;
constexpr int MISC_OFF = 163840 - 1024;
constexpr int PTR_OFF = MISC_OFF + 256;
constexpr int LDS_BYTES = 163840;

#define GAS __attribute__((address_space(1)))
#define LAS __attribute__((address_space(3)))
typedef unsigned short bf16;
typedef float f32x4 __attribute__((ext_vector_type(4)));
typedef float f32x2 __attribute__((ext_vector_type(2)));
typedef float f32x16 __attribute__((ext_vector_type(16)));
typedef short bf16x8 __attribute__((ext_vector_type(8)));
typedef short bf16x4 __attribute__((ext_vector_type(4)));
typedef unsigned u32x4 __attribute__((ext_vector_type(4)));
typedef unsigned u32x2 __attribute__((ext_vector_type(2)));
#define LDS_WAIT() asm volatile("s_waitcnt lgkmcnt(0)" ::: "memory")
#define VM_WAIT() asm volatile("s_waitcnt vmcnt(0)" ::: "memory")
#define LDS_BARRIER() do { asm volatile("s_waitcnt lgkmcnt(0)" ::: "memory"); __builtin_amdgcn_s_barrier(); asm volatile("" ::: "memory"); } while (0)
typedef __bf16 bf16x2_t __attribute__((ext_vector_type(2)));
__device__ __forceinline__ unsigned pk2(float lo, float hi) { f32x2 v = {lo, hi}; return __builtin_bit_cast(unsigned, __builtin_convertvector(v, bf16x2_t)); }
__device__ __forceinline__ unsigned f2bf(float f) { return pk2(f, 0.f) & 0xffffu; }
__device__ __forceinline__ float bf2f(unsigned short b) { return __uint_as_float((unsigned)b << 16); }
__device__ __forceinline__ float bflo(unsigned w) { return __uint_as_float(w << 16); }
__device__ __forceinline__ float bfhi(unsigned w) { return __uint_as_float(w & 0xffff0000u); }
__device__ __forceinline__ float wave_sum(float v) {
#pragma unroll
    for (int o = 1; o < 64; o <<= 1) v += __shfl_xor(v, o);
    return v;
}
__device__ __forceinline__ int crow(int r, int hi) { return (r & 3) + 8 * (r >> 2) + 4 * hi; }

#define XB_TMO      128
#define XB_XCNT(j)  (256  + 64 * (j))
#define XB_XSUB(j)  (1280 + 64 * (j))
#define XB_XGEN(j)  (2304 + 64 * (j))
#define XB_TOP      3328
#define XB_TOPGEN   3392
#define XCD_BAR_WORDS 3456
#define XB_SPIN_CAP (1u << 18)
__device__ __forceinline__ unsigned xb_ld(unsigned* p)              { return __hip_atomic_load(p, __ATOMIC_RELAXED, __HIP_MEMORY_SCOPE_AGENT); }
__device__ __forceinline__ unsigned xb_add(unsigned* p, unsigned v) { return __hip_atomic_fetch_add(p, v, __ATOMIC_RELAXED, __HIP_MEMORY_SCOPE_AGENT); }
__device__ __forceinline__ unsigned xb_xcc_id() { return (unsigned)__builtin_amdgcn_s_getreg((3 << 11) | 20) & 0xFu; }
#define XB_SPIN(cond, bar) do { unsigned _sp = 0; while (cond) { __builtin_amdgcn_s_sleep(1); \
    if ((++_sp & 255u) == 0u) { if (xb_ld(&(bar)[XB_TMO])) break; if (_sp > XB_SPIN_CAP) { atomicAdd(&(bar)[XB_TMO], 1u); break; } } } } while (0)
struct XcdBarrier { unsigned* bar; unsigned x; volatile LAS unsigned* st; };
__device__ __forceinline__ XcdBarrier xcd_barrier_post(unsigned* bar, volatile LAS unsigned* st) {
    XcdBarrier b; b.bar = bar; b.x = xb_xcc_id(); b.st = st;
    if (threadIdx.x == 0) (void)xb_add(&bar[XB_XCNT(b.x)], 1u);
    return b;
}
__device__ __forceinline__ void xcd_barrier_complete(unsigned* bar, unsigned x, unsigned& nloc, unsigned& nx) {
    const unsigned G = gridDim.x * gridDim.y * gridDim.z;
    unsigned sum, cnt, mine, sp = 0u;
    for (;;) {
        sum = 0u; cnt = 0u; mine = 0u;
#pragma unroll
        for (unsigned j = 0; j < 16; ++j) { const unsigned c = xb_ld(&bar[XB_XCNT(j)]); sum += c; cnt += (c > 0u) ? 1u : 0u; mine = (j == x) ? c : mine; }
        if (sum == G) break;
        __builtin_amdgcn_s_sleep(1);
        if ((++sp & 255u) == 0u) { if (xb_ld(&bar[XB_TMO])) break; if (sp > XB_SPIN_CAP) { atomicAdd(&bar[XB_TMO], 1u); break; } }
    }
    nloc = mine > 0u ? mine : 1u; nx = cnt > 0u ? cnt : 1u;
}
__device__ __forceinline__ void xcd_barrier(const XcdBarrier& b) {
    asm volatile("s_waitcnt vmcnt(0)" ::: "memory");
    __syncthreads();
    if (threadIdx.x == 0) {
        unsigned* bar = b.bar;
        __builtin_amdgcn_s_waitcnt(0);
        unsigned nloc = b.st[0], nx = b.st[1];
        if (nloc == 0u) { xcd_barrier_complete(bar, b.x, nloc, nx); b.st[0] = nloc; b.st[1] = nx; }
        const unsigned old = xb_add(&bar[XB_XSUB(b.x)], 1u);
        const unsigned gen = old / nloc;
        if (old + 1u == (gen + 1u) * nloc) {
            __builtin_amdgcn_fence(__ATOMIC_RELEASE, "agent");
            asm volatile("s_waitcnt vmcnt(0)" ::: "memory");
            const unsigned og = xb_add(&bar[XB_TOP], 1u);
            const unsigned tg = og / nx;
            if (og + 1u == (tg + 1u) * nx) xb_add(&bar[XB_TOPGEN], 1u);
            else XB_SPIN(xb_ld(&bar[XB_TOPGEN]) == tg, bar);
            __builtin_amdgcn_fence(__ATOMIC_ACQUIRE, "agent");
            xb_add(&bar[XB_XGEN(b.x)], 1u);
            asm volatile("s_waitcnt vmcnt(0)" ::: "memory");
        } else {
            XB_SPIN(xb_ld(&bar[XB_XGEN(b.x)]) == gen, bar);
            __builtin_amdgcn_fence(__ATOMIC_ACQUIRE, "agent");
            asm volatile("s_waitcnt vmcnt(0)" ::: "memory");
        }
    }
    __syncthreads();
}

struct Frame {
    LAS unsigned char* lds;
    int tid, lane, wave, G, bid;
    unsigned char* ws;
    const float* const* in;
};
enum InIdx { I_X = 0, I_LNMG, I_LNMB, I_LNFG, I_LNFB, I_ABWIN, I_LAMRE, I_LAMIM, I_LOGDT, I_BRE, I_BIM, I_CRE, I_CIM, I_S5D, I_GLUW, I_GLUB,
             I_GATEW, I_GATEB, I_NORMG, I_ABWOUT, I_CWIN, I_SINK, I_CWOUT, I_RELB, I_WGRP, I_BGRP, I_WRT, I_BRT, I_W1, I_W3, I_W2, N_IN };

__device__ __forceinline__ const float* inp(LAS unsigned char* lds, int k) {
    const LAS unsigned* p = (const LAS unsigned*)(lds + PTR_OFF) + 2 * k;
    const unsigned lo = __builtin_amdgcn_readfirstlane(p[0]), hi = __builtin_amdgcn_readfirstlane(p[1]);
    return (const float*)(const GAS float*)(((unsigned long long)hi << 32) | (unsigned long long)lo);
}
__device__ __forceinline__ void tr_item(const float* W, int ldw, bf16* WT, int ldt, int rowmode, LAS float* scr, int item, int nblk, int lane) {
    const int kb = item / nblk, nb = item % nblk, k0 = 64 * kb, n0 = 32 * nb;
    float tv[32];
    const float* wp = W + (size_t)(k0 + (lane >> 5)) * ldw + n0 + (lane & 31);
#pragma unroll
    for (int i = 0; i < 32; ++i) tv[i] = wp[(size_t)(2 * i) * ldw];
#pragma unroll
    for (int i = 0; i < 32; ++i) scr[(2 * i + (lane >> 5)) * 33 + (lane & 31)] = tv[i];
    LDS_WAIT(); asm volatile("" ::: "memory");
    const int c = lane & 7;
#pragma unroll
    for (int j = 0; j < 4; ++j) { const int n = (lane >> 3) + 8 * j; const LAS float* s = scr + (8 * c) * 33 + n;
        u32x4 o; o.x = pk2(s[0 * 33], s[1 * 33]); o.y = pk2(s[2 * 33], s[3 * 33]); o.z = pk2(s[4 * 33], s[5 * 33]); o.w = pk2(s[6 * 33], s[7 * 33]);
        const int ng = n0 + n; const int dr = rowmode == 0 ? ng : (8 * (ng >> 2) + (ng & 3) + (rowmode == 2 ? 4 : 0));
        *(GAS u32x4*)(WT + (size_t)dr * ldt + k0 + 8 * c) = o; }
    LDS_WAIT(); asm volatile("" ::: "memory");
}
__device__ __forceinline__ void moe_convert(const float* w1, const float* w3, const float* w2, bf16* W13, bf16* W2T, LAS float* scr, int it0, int it1, int gw, int NGW, int lane) {
    constexpr int PER_E = 768;
    for (int it = it0 + gw; it < it1; it += NGW) {
        const int e = it / PER_E; int r = it % PER_E;
        if (r < 256) tr_item(w1 + (size_t)e * D * DEXP, DEXP, W13 + (size_t)e * D * D, D, 1, scr, r, DEXP / 32, lane);
        else if (r < 512) tr_item(w3 + (size_t)e * D * DEXP, DEXP, W13 + (size_t)e * D * D, D, 2, scr, r - 256, DEXP / 32, lane);
        else tr_item(w2 + (size_t)e * DEXP * D, D, W2T + (size_t)e * D * DEXP, DEXP, 0, scr, r - 512, D / 32, lane);
    }
}
constexpr int MOE_ITEMS = NEXP * 768, IDLE_Q8 = 88, IDLE_Q9 = 56;
__device__ __forceinline__ void idle_convert(int which, unsigned char* ws, LAS unsigned char* lds, float* dout, int ntiles, int bid, int G, int wave, int lane) {
    const int U = ntiles * (D / 256), rem = U % G; if (rem == 0 || bid < rem) return;
    const int n_idle = G - rem, rank = bid - rem;
    int q8 = n_idle * IDLE_Q8; q8 = q8 < MOE_ITEMS ? q8 : MOE_ITEMS; int q9 = n_idle * IDLE_Q9; q9 = (q8 + q9) < MOE_ITEMS ? q9 : (MOE_ITEMS - q8);
    const int per = which == 0 ? IDLE_Q8 : IDLE_Q9, base = which == 0 ? 0 : q8, lim = which == 0 ? q8 : q8 + q9;
    int lo = base + rank * per, hi = lo + per; hi = hi < lim ? hi : lim;
    moe_convert(inp(lds, I_W1) + (size_t)NEXP * D * DEXP, inp(lds, I_W3) + (size_t)NEXP * D * DEXP, inp(lds, I_W2) + (size_t)NEXP * DEXP * D,
                (bf16*)dout, (bf16*)dout + (size_t)NEXP * D * D, (LAS float*)(lds + wave * 16384), lo, hi, wave, NWAVES, lane);
}
__device__ __forceinline__ int idle_done(int ntiles, int G) {
    const int U = ntiles * (D / 256), rem = U % G; if (rem == 0) return 0;
    const int n_idle = G - rem; int q = n_idle * (IDLE_Q8 + IDLE_Q9); return q < MOE_ITEMS ? q : MOE_ITEMS;
}
__device__ __forceinline__ int t5_bucket(int rel) {
    const int nb = 16, max_exact = 8; int ret = rel > 0 ? nb : 0; const int n = rel < 0 ? -rel : rel;
    const float lg = logf((float)(n < 1 ? 1 : n) / 8.0f) / 2.7725887f * 8.0f;
    int large = max_exact + (int)lg; large = large < nb - 1 ? large : nb - 1;
    return ret + (n < max_exact ? n : large);
}
__device__ __forceinline__ void p0_prologue(unsigned char* ws, LAS unsigned char* lds, int bid, int G, int tid, int wave, int lane) {
    LAS float* scr = (LAS float*)(lds + wave * 16384);
    const int gw = bid * NWAVES + wave, NGW = G * NWAVES;
    constexpr int I0 = 16 * 64, I1 = 16, I2 = 8 * 16, I3 = 16 * 32, I4 = 16 * 48, I5 = 16 * 32, NIT = I0 + I1 + I2 + I3 + I4 + I5;
    for (int it = gw; it < NIT; it += NGW) {
        int r = it;
        if (r < I0) { tr_item(inp(lds, I_ABWIN), AB_IN, (bf16*)(ws + WS_WIN), D, 0, scr, r, 64, lane); continue; } r -= I0;
        if (r < I1) { tr_item(inp(lds, I_ABWIN) + 2048, AB_IN, (bf16*)(ws + WS_WLR), D, 0, scr, r, 1, lane); continue; } r -= I1;
        if (r < I2) { tr_item(inp(lds, I_GLUW), 512, (bf16*)(ws + WS_WGLU), 512, 0, scr, r, 16, lane); continue; } r -= I2;
        if (r < I3) { tr_item(inp(lds, I_ABWOUT), D, (bf16*)(ws + WS_WOUT), D, 0, scr, r, 32, lane); continue; } r -= I3;
        if (r < I4) { tr_item(inp(lds, I_CWIN), CN, (bf16*)(ws + WS_CIN), D, 0, scr, r, 48, lane); continue; } r -= I4;
        tr_item(inp(lds, I_CWOUT), D, (bf16*)(ws + WS_COUT), D, 0, scr, r, 32, lane);
    }
    moe_convert(inp(lds, I_W1), inp(lds, I_W3), inp(lds, I_W2), (bf16*)(ws + WS_W13), (bf16*)(ws + WS_W2), scr, 0, MOE_ITEMS, gw, NGW, lane);
    { const float* x = inp(lds, I_X); bf16* xb = (bf16*)(ws + WS_X64);
      for (int m = gw; m < T; m += 2 * NGW) { const int m2 = m + NGW;
          const GAS f32x4* xr = (const GAS f32x4*)(x + (size_t)m * D) + lane; GAS u32x2* o = (GAS u32x2*)(xb + (size_t)m * D) + lane;
          const GAS f32x4* xr2 = (const GAS f32x4*)(x + (size_t)m2 * D) + lane; GAS u32x2* o2 = (GAS u32x2*)(xb + (size_t)m2 * D) + lane;
          f32x4 v[4], v2[4];
#pragma unroll
          for (int j = 0; j < 4; ++j) { v[j] = xr[64 * j]; if (m2 < T) v2[j] = xr2[64 * j]; }
#pragma unroll
          for (int j = 0; j < 4; ++j) { u32x2 w; w.x = pk2(v[j].x, v[j].y); w.y = pk2(v[j].z, v[j].w); o[64 * j] = w;
              if (m2 < T) { u32x2 w2; w2.x = pk2(v2[j].x, v2[j].y); w2.y = pk2(v2[j].z, v2[j].w); o2[64 * j] = w2; } } } }
    const int gt = bid * NTHR + tid, NGT = G * NTHR;
    { const float* lamre = inp(lds, I_LAMRE); const float* lamim = inp(lds, I_LAMIM); const float* logdt = inp(lds, I_LOGDT); const float* bre = inp(lds, I_BRE); const float* bim = inp(lds, I_BIM);
    for (int i = tid * G + bid; i < 2 * 32 * 64; i += NTHR * G) {
        const int p = i & 63, g = (i >> 6) & 31, dir = i >> 11;
        const double lr = fmin((double)lamre[i], -1e-4), li = (double)lamim[i], dt = exp((double)logdt[dir * 32 + g]);
        const double mag = exp(lr * dt), ar = mag * cos(li * dt), ai = mag * sin(li * dt), den = lr * lr + li * li, nr = ar - 1.0;
        const double cr = (nr * lr + ai * li) / den, ci = (ai * lr - nr * li) / den;
        double qr = ar, qi = ai;
#pragma unroll 1
        for (int s = 1; s < S5CH; s <<= 1) { const double t = qr * qr - qi * qi; qi = 2.0 * qr * qi; qr = t; }
        float* L4 = (float*)(ws + WS_S5L) + (size_t)i * 4; L4[0] = (float)ar; L4[1] = (float)ai; L4[2] = (float)qr; L4[3] = (float)qi;
        bf16* Bb = (bf16*)(ws + WS_S5B) + (size_t)(dir * 32 + g) * 2048;
#pragma unroll 4
        for (int c = 0; c < 16; ++c) { const double br = bre[(size_t)i * 16 + c], bi = bim[(size_t)i * 16 + c];
            Bb[p * 16 + c] = (bf16)f2bf((float)(cr * br - ci * bi)); Bb[1024 + p * 16 + c] = (bf16)f2bf((float)(cr * bi + ci * br)); }
    } }
    { const float* cre = inp(lds, I_CRE); const float* cim = inp(lds, I_CIM);
    for (int i = gt; i < 2 * 32 * 16 * 64; i += NGT) {
        const int p = i & 63, c = (i >> 6) & 15, dg = i >> 10;
        bf16* Cm = (bf16*)(ws + WS_S5C) + (size_t)dg * 2048 + c * 128 + 2 * p;
        Cm[0] = (bf16)f2bf(cre[i]); Cm[1] = (bf16)f2bf(-cim[i]);
    } }
    { const float* relb = inp(lds, I_RELB);
    for (int i = gt; i < 16 * 257; i += NGT) { const int h = i / 257, r = i % 257; ((float*)(ws + WS_BTAB))[h * 260 + r] = relb[t5_bucket(r - 128) * 16 + h] * LOG2E; } }
    { const float* wgrp = inp(lds, I_WGRP); const float* wrt = inp(lds, I_WRT);
    for (int i = gt; i < 2 * 48 * 1024; i += NGT) {
        const int k = i & 1023, n = (i >> 10) % 48, l = i / (48 * 1024);
        const float w = n < 4 ? wgrp[(size_t)l * D * 4 + k * 4 + n] : (n < 36 ? wrt[(size_t)l * D * 32 + k * 32 + (n - 4)] : 0.f);
        const unsigned hi = f2bf(w); const float lo = w - __uint_as_float(hi << 16);
        bf16* Wr = (bf16*)(ws + WS_WR) + (size_t)l * 2 * 48 * 1024; Wr[n * 1024 + k] = (bf16)hi; Wr[48 * 1024 + n * 1024 + k] = (bf16)f2bf(lo);
    } }
}

__device__ __forceinline__ void gate_tail(float* bcg, const float* gate_w, const float* gate_b, const LAS float* lrs, size_t row0, int tid);
__device__ __forceinline__ void lr_tail(unsigned char* ws, float* bcg, const float* gate_w, const float* gate_b, LAS unsigned char* lds, int bid, int G, int tid, int wave, int lane) {
    const bf16* xb = (const bf16*)(ws + WS_X64); const bf16* wl = (const bf16*)(ws + WS_WLR); LAS float* lrs = (LAS float*)lds;
    for (int rt = bid; rt < T / 128; rt += G) {
        const int r0 = rt * 128 + wave * 16;
        f32x4 acc0 = {0.f, 0.f, 0.f, 0.f}, acc1 = {0.f, 0.f, 0.f, 0.f};
        const bf16* ap = xb + (size_t)(r0 + (lane & 15)) * D + 8 * (lane >> 4);
        const bf16* bp = wl + (size_t)(lane & 15) * D + 8 * (lane >> 4);
#pragma unroll 8
        for (int ks = 0; ks < 32; ++ks) {
            const bf16x8 a = *(const bf16x8*)(ap + ks * 32), b0 = *(const bf16x8*)(bp + ks * 32), b1 = *(const bf16x8*)(bp + 16 * D + ks * 32);
            acc0 = __builtin_amdgcn_mfma_f32_16x16x32_bf16(a, b0, acc0, 0, 0, 0); acc1 = __builtin_amdgcn_mfma_f32_16x16x32_bf16(a, b1, acc1, 0, 0, 0);
        }
        __syncthreads();
#pragma unroll
        for (int r = 0; r < 4; ++r) { LAS float* o = lrs + (wave * 16 + 4 * (lane >> 4) + r) * 32 + (lane & 15); o[0] = acc0[r]; o[16] = acc1[r]; }
        __syncthreads();
        gate_tail(bcg, gate_w, gate_b, lrs, (size_t)rt * 128, tid);
    }
    __syncthreads();
}

__device__ __forceinline__ void gla_finalize(unsigned char* ws, const float* norm_g, int gw, int NGW, int lane) {
    const bf16* of = (const bf16*)(ws + WS_OF); const bf16* ob = (const bf16*)(ws + WS_OB); const bf16* h0 = (const bf16*)(ws + WS_H0); bf16* cc = (bf16*)(ws + WS_X64);
    const f32x4 g0 = *(const f32x4*)(norm_g + 8 * lane), g1 = *(const f32x4*)(norm_g + 8 * lane + 4);
    for (int m0 = gw; m0 < T; m0 += 4 * NGW) {
        u32x4 a[4], b[4], gq[4];
#pragma unroll
        for (int q = 0; q < 4; ++q) { const size_t m = (size_t)m0 + (size_t)q * NGW;
            a[q] = *(const u32x4*)(of + m * 512 + 8 * lane); b[q] = *(const u32x4*)(ob + m * 512 + 8 * lane); gq[q] = *(const u32x4*)(h0 + m * H0P + OFF_GO + 8 * lane); }
#pragma unroll
        for (int q = 0; q < 4; ++q) { const size_t m = (size_t)m0 + (size_t)q * NGW;
            f32x4 v0, v1;
            v0.x = bflo(a[q].x) + bflo(b[q].x); v0.y = bfhi(a[q].x) + bfhi(b[q].x); v0.z = bflo(a[q].y) + bflo(b[q].y); v0.w = bfhi(a[q].y) + bfhi(b[q].y);
            v1.x = bflo(a[q].z) + bflo(b[q].z); v1.y = bfhi(a[q].z) + bfhi(b[q].z); v1.z = bflo(a[q].w) + bflo(b[q].w); v1.w = bfhi(a[q].w) + bfhi(b[q].w);
            float ss = (v0.x * v0.x + v0.y * v0.y) + (v0.z * v0.z + v0.w * v0.w) + (v1.x * v1.x + v1.y * v1.y) + (v1.z * v1.z + v1.w * v1.w);
            ss += __shfl_xor(ss, 1); ss += __shfl_xor(ss, 2); ss += __shfl_xor(ss, 4); ss += __shfl_xor(ss, 8);
            const float rs = __builtin_amdgcn_rsqf(ss * (1.0f / 128.0f) + RMS_EPS);
            const float gv[8] = {bflo(gq[q].x), bfhi(gq[q].x), bflo(gq[q].y), bfhi(gq[q].y), bflo(gq[q].z), bfhi(gq[q].z), bflo(gq[q].w), bfhi(gq[q].w)};
            const float ov[8] = {v0.x * g0.x, v0.y * g0.y, v0.z * g0.z, v0.w * g0.w, v1.x * g1.x, v1.y * g1.y, v1.z * g1.z, v1.w * g1.w};
            float r[8];
#pragma unroll
            for (int i = 0; i < 8; ++i) r[i] = ov[i] * rs * (gv[i] * __builtin_amdgcn_rcpf(1.f + __expf(-gv[i])));
            u32x4 w; w.x = pk2(r[0], r[1]); w.y = pk2(r[2], r[3]); w.z = pk2(r[4], r[5]); w.w = pk2(r[6], r[7]);
            *(u32x4*)(cc + m * D + 512 + 8 * lane) = w; }
    }
}

constexpr int RT_AST = 2064;
__device__ __forceinline__ void ln_router(unsigned char* ws, const float* resid, const float* lng, const float* lnb, const float* bgrp, const float* brt, int layer, LAS unsigned char* lds, int bid, int G, int tid, int wave, int lane) {
    const bf16* yb = (const bf16*)(ws + WS_Z); float* h1 = (float*)(ws + WS_H1); bf16* hb = (bf16*)(ws + WS_X64);
    int* tok_e = (int*)(ws + WS_TOKE); float* tok_w = (float*)(ws + WS_TOKW);
    LAS unsigned char* Ahi = lds; LAS unsigned char* Alo = lds + 16 * RT_AST; LAS float* part = (LAS float*)(lds + 32 * RT_AST);
    LAS int* hist = (LAS int*)(lds + 32 * RT_AST + 8 * 16 * 48 * 4); LAS float* lgt = (LAS float*)(lds + 32 * RT_AST + 8 * 16 * 48 * 4 + 256);
    if (tid < 32) hist[tid] = 0;
    const bf16* Wr = (const bf16*)(ws + WS_WR) + (size_t)layer * 2 * 48 * 1024;
    bf16x8 Bh[3][4], Bl[3][4];
#pragma unroll
    for (int nt = 0; nt < 3; ++nt)
#pragma unroll
        for (int ks = 0; ks < 4; ++ks) { const size_t o = (size_t)(nt * 16 + (lane & 15)) * 1024 + wave * 128 + ks * 32 + 8 * (lane >> 4);
            Bh[nt][ks] = *(const bf16x8*)(Wr + o); Bl[nt][ks] = *(const bf16x8*)(Wr + 48 * 1024 + o); }
    f32x4 gv[4], bv[4];
#pragma unroll
    for (int j = 0; j < 4; ++j) { gv[j] = *(const f32x4*)(lng + 4 * lane + 256 * j); bv[j] = *(const f32x4*)(lnb + 4 * lane + 256 * j); }
    __syncthreads();
    for (int grp = bid; grp < T / 16; grp += G) {
#pragma unroll
        for (int rr = 0; rr < 2; ++rr) {
            const int row = 2 * wave + rr; const size_t m = (size_t)grp * 16 + row;
            const GAS f32x4* xr = (const GAS f32x4*)(resid + m * D) + lane; const GAS u32x2* yr = (const GAS u32x2*)(yb + m * D) + lane;
            f32x4 v[4]; float s = 0.f;
#pragma unroll
            for (int j = 0; j < 4; ++j) { const f32x4 x4 = xr[64 * j]; const u32x2 y2 = yr[64 * j];
                v[j].x = x4.x * ALPHA + bflo(y2.x); v[j].y = x4.y * ALPHA + bfhi(y2.x); v[j].z = x4.z * ALPHA + bflo(y2.y); v[j].w = x4.w * ALPHA + bfhi(y2.y);
                s += (v[j].x + v[j].y) + (v[j].z + v[j].w); }
            const float mean = wave_sum(s) * (1.f / D); float s2 = 0.f;
#pragma unroll
            for (int j = 0; j < 4; ++j) { v[j] = v[j] - mean; s2 += (v[j].x * v[j].x + v[j].y * v[j].y) + (v[j].z * v[j].z + v[j].w * v[j].w); }
            const float rstd = 1.f / sqrtf(wave_sum(s2) * (1.f / D) + LN_EPS);
#pragma unroll
            for (int j = 0; j < 4; ++j) {
                const f32x4 h = v[j] * rstd * gv[j] + bv[j];
                ((GAS f32x4*)(h1 + m * D) + lane)[64 * j] = h;
                const unsigned h0 = pk2(h.x, h.y), h1w = pk2(h.z, h.w);
                u32x2 w; w.x = h0; w.y = h1w; ((GAS u32x2*)(hb + m * D) + lane)[64 * j] = w;
                u32x2 lo; lo.x = pk2(h.x - bflo(h0), h.y - bfhi(h0)); lo.y = pk2(h.z - bflo(h1w), h.w - bfhi(h1w));
                *(LAS u32x2*)(Ahi + row * RT_AST + (4 * lane + 256 * j) * 2) = w; *(LAS u32x2*)(Alo + row * RT_AST + (4 * lane + 256 * j) * 2) = lo;
            }
        }
        LDS_BARRIER();
        f32x4 acc[3] = {{0.f, 0.f, 0.f, 0.f}, {0.f, 0.f, 0.f, 0.f}, {0.f, 0.f, 0.f, 0.f}};
#pragma unroll
        for (int ks = 0; ks < 4; ++ks) {
            const int bo = (lane & 15) * RT_AST + (wave * 128 + ks * 32 + 8 * (lane >> 4)) * 2;
            const bf16x8 ah = *(const LAS bf16x8*)(Ahi + bo), al = *(const LAS bf16x8*)(Alo + bo);
#pragma unroll
            for (int nt = 0; nt < 3; ++nt) {
                acc[nt] = __builtin_amdgcn_mfma_f32_16x16x32_bf16(ah, Bh[nt][ks], acc[nt], 0, 0, 0);
                acc[nt] = __builtin_amdgcn_mfma_f32_16x16x32_bf16(ah, Bl[nt][ks], acc[nt], 0, 0, 0);
                acc[nt] = __builtin_amdgcn_mfma_f32_16x16x32_bf16(al, Bh[nt][ks], acc[nt], 0, 0, 0);
            }
        }
#pragma unroll
        for (int nt = 0; nt < 3; ++nt)
#pragma unroll
            for (int r = 0; r < 4; ++r) part[(wave * 16 + 4 * (lane >> 4) + r) * 48 + nt * 16 + (lane & 15)] = acc[nt][r];
        LDS_BARRIER();
        { const int itn = (grp - bid) / G;
          for (int idx = tid; idx < 16 * 36; idx += NTHR) { const int tk = idx / 36, n = idx % 36; float s = 0.f;
#pragma unroll
            for (int w = 0; w < 8; ++w) s += part[(w * 16 + tk) * 48 + n];
            lgt[(itn * 16 + tk) * 36 + n] = s + (n < 4 ? bgrp[n] : brt[n - 4]); } }
    }
    LDS_BARRIER();
    for (int tk = tid; tk < 16 * ((T / 16 - bid + G - 1) / G); tk += NTHR) {
        const size_t m = ((size_t)bid + (size_t)(tk >> 4) * G) * 16 + (tk & 15);
        const LAS float* lg = lgt + tk * 36;
        int gi = 0; float gm = lg[0];
#pragma unroll
        for (int n = 1; n < 4; ++n) if (lg[n] > gm) { gm = lg[n]; gi = n; }
        float gs = 0.f;
#pragma unroll
        for (int n = 0; n < 4; ++n) gs += __expf(lg[n] - gm);
        const float pg = 1.f / gs;
        float el[8];
#pragma unroll
        for (int i = 0; i < 8; ++i) el[i] = lg[4 + gi * 8 + i];
        int i1 = 0; float m1 = el[0];
#pragma unroll
        for (int i = 1; i < 8; ++i) if (el[i] > m1) { m1 = el[i]; i1 = i; }
        int i2 = -1; float m2 = -3.0e38f;
#pragma unroll
        for (int i = 0; i < 8; ++i) if (i != i1 && el[i] > m2) { m2 = el[i]; i2 = i; }
        const float e2 = __expf(m2 - m1), inv = 1.f / (1.f + e2);
        const int ea = gi * 8 + i1, eb = gi * 8 + i2;
        tok_e[m * 2] = ea; tok_e[m * 2 + 1] = eb; tok_w[m * 2] = pg * inv; tok_w[m * 2 + 1] = pg * e2 * inv;
        atomicAdd((int*)&hist[ea], 1); atomicAdd((int*)&hist[eb], 1);
    }
    LDS_BARRIER();
    if (tid < 32) ((int*)(ws + WS_BLKC))[bid * 32 + tid] = hist[tid];
}

__device__ __forceinline__ void moe_sort(unsigned char* ws, LAS unsigned char* lds, int bid, int G, int tid) {
    const int* blkc = (const int*)(ws + WS_BLKC); const int* tok_e = (const int*)(ws + WS_TOKE); const float* tok_w = (const float*)(ws + WS_TOKW);
    int* tok_s = (int*)(ws + WS_TOKS); int* slot_t = (int*)(ws + WS_SLOTT); float* slot_w = (float*)(ws + WS_SLOTW); int* tile = (int*)(ws + WS_TILE);
    LAS int* ptot = (LAS int*)lds; LAS int* pbase = ptot + 512; LAS int* tot = pbase + 512; LAS int* base = tot + 32; LAS int* pstart = base + 32; LAS int* lcur = pstart + 33;
    { const int e = tid & 31, part = tid >> 5; int st = 0, sb = 0;
      for (int b = part; b < G; b += 16) { const int c = blkc[b * 32 + e]; st += c; sb += (b < bid) ? c : 0; }
      ptot[part * 32 + e] = st; pbase[part * 32 + e] = sb; }
    __syncthreads();
    if (tid < 32) { int st = 0, sb = 0;
#pragma unroll
        for (int p = 0; p < 16; ++p) { st += ptot[p * 32 + tid]; sb += pbase[p * 32 + tid]; }
        tot[tid] = st; base[tid] = sb; lcur[tid] = 0; }
    __syncthreads();
    if (tid == 0) { int acc = 0; for (int e = 0; e < 32; ++e) { pstart[e] = acc; acc += (tot[e] + 255) & ~255; } pstart[32] = acc; }
    __syncthreads();
    if (bid == 0) {
        const int nt = pstart[32] >> 8;
        if (tid == 0) tile[511] = nt;
        for (int t = tid; t < nt; t += NTHR) { int e = 0; for (int q = 1; q < 32; ++q) if ((t << 8) >= pstart[q]) e = q; tile[t] = e; }
    }
    for (int e = bid; e < 32; e += G)
        for (int s = pstart[e] + tot[e] + tid; s < pstart[e + 1]; s += NTHR) { slot_t[s] = 0; slot_w[s] = 0.f; }
    for (int grp = bid; grp < T / 16; grp += G) {
        if (tid < 32) { const size_t a = (size_t)grp * 32 + tid; const int e = tok_e[a]; const int rank = atomicAdd((int*)&lcur[e], 1);
            const int s = pstart[e] + base[e] + rank; slot_t[s] = (int)(a >> 1); slot_w[s] = tok_w[a]; tok_s[a] = s; }
    }
}

template <bool FINAL>
__device__ __forceinline__ void combine_ln(unsigned char* ws, const float* lng, const float* lnb, float* dout, int gw, int NGW, int lane) {
    float* h1 = (float*)(ws + WS_H1); const bf16* y2 = (const bf16*)(ws + WS_Y2); const int* tok_s = (const int*)(ws + WS_TOKS); const float* tok_w = (const float*)(ws + WS_TOKW); bf16* h2b = (bf16*)(ws + WS_H2B);
    f32x4 gv[4], bv[4];
#pragma unroll
    for (int j = 0; j < 4; ++j) { gv[j] = *(const f32x4*)(lng + 4 * lane + 256 * j); bv[j] = *(const f32x4*)(lnb + 4 * lane + 256 * j); }
    for (int m = gw; m < T; m += NGW) {
        const int s0 = tok_s[(size_t)m * 2], s1 = tok_s[(size_t)m * 2 + 1]; const float w0 = tok_w[(size_t)m * 2], w1 = tok_w[(size_t)m * 2 + 1];
        const GAS f32x4* hr = (const GAS f32x4*)(h1 + (size_t)m * D) + lane;
        const GAS u32x2* ya = (const GAS u32x2*)(y2 + (size_t)s0 * D) + lane; const GAS u32x2* yb = (const GAS u32x2*)(y2 + (size_t)s1 * D) + lane;
        f32x4 v[4]; float s = 0.f;
#pragma unroll
        for (int j = 0; j < 4; ++j) { const f32x4 h = hr[64 * j]; const u32x2 a = ya[64 * j], b = yb[64 * j];
            v[j].x = h.x * ALPHA + (w0 * bflo(a.x) + w1 * bflo(b.x)); v[j].y = h.y * ALPHA + (w0 * bfhi(a.x) + w1 * bfhi(b.x)); v[j].z = h.z * ALPHA + (w0 * bflo(a.y) + w1 * bflo(b.y)); v[j].w = h.w * ALPHA + (w0 * bfhi(a.y) + w1 * bfhi(b.y));
            s += (v[j].x + v[j].y) + (v[j].z + v[j].w); }
        const float mean = wave_sum(s) * (1.f / D); float s2 = 0.f;
#pragma unroll
        for (int j = 0; j < 4; ++j) { v[j] = v[j] - mean; s2 += (v[j].x * v[j].x + v[j].y * v[j].y) + (v[j].z * v[j].z + v[j].w * v[j].w); }
        const float rstd = 1.f / sqrtf(wave_sum(s2) * (1.f / D) + LN_EPS);
#pragma unroll
        for (int j = 0; j < 4; ++j) { const f32x4 h = v[j] * rstd * gv[j] + bv[j];
            if (FINAL) ((GAS f32x4*)(dout + (size_t)m * D) + lane)[64 * j] = h;
            else { ((GAS f32x4*)(h1 + (size_t)m * D) + lane)[64 * j] = h; u32x2 w; w.x = pk2(h.x, h.y); w.y = pk2(h.z, h.w); ((GAS u32x2*)(h2b + (size_t)m * D) + lane)[64 * j] = w; } }
    }
}
constexpr int S5_HST = 272, S5_UST = 272, S5_UOFF = 8 * 32 * S5_HST;
#define MFMA32(a, b, c) __builtin_amdgcn_mfma_f32_32x32x16_bf16((a), (b), (c), 0, 0, 0)
#define MFMA16(a, b, c) __builtin_amdgcn_mfma_f32_16x16x32_bf16((a), (b), (c), 0, 0, 0)
__device__ __forceinline__ float gelu_tanh(float x) {
    const float u = 0.7978845608028654f * (x + 0.044715f * x * x * x);
    const float e = __expf(2.f * u); const float th = 1.f - 2.f * __builtin_amdgcn_rcpf(e + 1.f);
    return 0.5f * x * (1.f + th);
}
__device__ __forceinline__ f32x4 ld_ys(const float* p) {
    f32x4 v;
    v.x = __hip_atomic_load(p, __ATOMIC_RELAXED, __HIP_MEMORY_SCOPE_AGENT); v.y = __hip_atomic_load(p + 1, __ATOMIC_RELAXED, __HIP_MEMORY_SCOPE_AGENT);
    v.z = __hip_atomic_load(p + 2, __ATOMIC_RELAXED, __HIP_MEMORY_SCOPE_AGENT); v.w = __hip_atomic_load(p + 3, __ATOMIC_RELAXED, __HIP_MEMORY_SCOPE_AGENT);
    return v;
}
template <int PASS, int DIR>
__device__ __forceinline__ void s5_dir(unsigned char* ws, const float* s5d, int b, int g, int c, LAS unsigned char* hl, const LAS unsigned char* ul, float* yscr, int lane) {
    const bf16* h0 = (const bf16*)(ws + WS_H0);
    const int dg = DIR * 32 + g;
    const f32x4 L4 = *(const f32x4*)((const float*)(ws + WS_S5L) + (size_t)(dg * 64 + lane) * 4);
    const float ar = L4.x, ai = L4.y, qr = L4.z, qi = L4.w;
    const float l2r = ar * ar - ai * ai, l2i = 2.f * ar * ai, l4r = l2r * l2r - l2i * l2i, l4i = 2.f * l2r * l2i, l8r = l4r * l4r - l4i * l4i, l8i = 2.f * l4r * l4i;
    const float l16r = l8r * l8r - l8i * l8i, l16i = 2.f * l8r * l8i, l32r = l16r * l16r - l16i * l16i, l32i = 2.f * l16r * l16i;
    const bf16* Bb = (const bf16*)(ws + WS_S5B) + (size_t)dg * 2048 + (lane & 31) * 16 + 8 * (lane >> 5);
    const bf16x8 bre0 = *(const bf16x8*)Bb, bre1 = *(const bf16x8*)(Bb + 512), bim0 = *(const bf16x8*)(Bb + 1024), bim1 = *(const bf16x8*)(Bb + 1536);
    bf16x8 cf[4]; bf16x8 dfrag;
    if (PASS == 2) {
        const bf16* Cm = (const bf16*)(ws + WS_S5C) + (size_t)dg * 2048 + (lane & 15) * 128 + 8 * (lane >> 4);
#pragma unroll
        for (int ks = 0; ks < 4; ++ks) cf[ks] = *(const bf16x8*)(Cm + 32 * ks);
        if (DIR == 1) {
            const int cc = lane & 15, kq = lane >> 4; const float d = s5d[g * 16 + cc]; const unsigned dh = f2bf(d); const unsigned dl = f2bf(d - __uint_as_float(dh << 16));
#pragma unroll
            for (int j = 0; j < 8; ++j) { const int k = 8 * (kq & 1) + j; dfrag[j] = (short)((k == cc) ? (kq < 2 ? dh : dl) : 0u); }
        }
    }
    float hr = 0.f, hi = 0.f;
    float* Ec = (float*)(ws + WS_S5E) + ((size_t)((DIR * NB + b) * 32 + g) * S5NCH) * 128 + 2 * lane;
    if (PASS == 2) {
        const int nj = DIR == 0 ? c : (S5NCH - 1 - c);
        for (int j0 = 0; j0 < nj; j0 += 32) {
            f32x2 e[32];
#pragma unroll
            for (int q = 0; q < 32; ++q) { const int j = (j0 + q) < nj ? (j0 + q) : (nj - 1); const int jj = DIR == 0 ? j : (S5NCH - 1 - j); e[q] = *(const f32x2*)(Ec + (size_t)jj * 128); }
#pragma unroll
            for (int q = 0; q < 32; ++q) if (j0 + q < nj) { const float nr = qr * hr - qi * hi + e[q].x; hi = qr * hi + qi * hr + e[q].y; hr = nr; }
        }
    }
    const size_t rowbase = (size_t)b * SEQ + (size_t)c * S5CH;
    const LAS unsigned char* up = ul + (lane & 31) * S5_UST + (g & 7) * 32 + 16 * (lane >> 5);
    const f32x16 zero16 = {0.f, 0.f, 0.f, 0.f, 0.f, 0.f, 0.f, 0.f, 0.f, 0.f, 0.f, 0.f, 0.f, 0.f, 0.f, 0.f};
#pragma unroll 1
    for (int ti = 0; ti < S5CH / 32; ++ti) {
        const int tile = DIR == 0 ? ti : (S5CH / 32 - 1 - ti);
        const bf16x8 a = *(const LAS bf16x8*)(up + tile * 32 * S5_UST);
        f32x4 ysv[2] = {{0.f, 0.f, 0.f, 0.f}, {0.f, 0.f, 0.f, 0.f}};
        if (PASS == 2 && DIR == 1) { ysv[0] = ld_ys(yscr + (size_t)(tile * 2) * 256 + 4 * lane); ysv[1] = ld_ys(yscr + (size_t)(tile * 2 + 1) * 256 + 4 * lane); }
        f32x16 xr0 = MFMA32(a, bre0, zero16), xr1 = MFMA32(a, bre1, zero16), xi0 = MFMA32(a, bim0, zero16), xi1 = MFMA32(a, bim1, zero16);
        __builtin_amdgcn_sched_barrier(0);
        asm volatile("s_nop 15\n\ts_nop 15\n\ts_nop 15\n\ts_nop 15\n\ts_nop 15\n\ts_nop 15" ::: "memory");
        __builtin_amdgcn_sched_barrier(0);
        float xr[32], xi[32];
#pragma unroll
        for (int r = 0; r < 16; ++r) {
            auto s = __builtin_amdgcn_permlane32_swap(__float_as_uint(xr0[r]), __float_as_uint(xr1[r]), false, false);
            xr[crow(r, 0)] = __uint_as_float(s[0]); xr[crow(r, 1)] = __uint_as_float(s[1]);
            auto q = __builtin_amdgcn_permlane32_swap(__float_as_uint(xi0[r]), __float_as_uint(xi1[r]), false, false);
            xi[crow(r, 0)] = __uint_as_float(q[0]); xi[crow(r, 1)] = __uint_as_float(q[1]);
        }
        if (PASS == 1) {
#pragma unroll
            for (int lv = 0; lv < 5; ++lv) {
                const float pr = lv == 0 ? ar : lv == 1 ? l2r : lv == 2 ? l4r : lv == 3 ? l8r : l16r, pi = lv == 0 ? ai : lv == 1 ? l2i : lv == 2 ? l4i : lv == 3 ? l8i : l16i;
#pragma unroll
                for (int i = 0; i < (16 >> lv); ++i) {
                    const int e = DIR == 0 ? 2 * i : 2 * i + 1, l = DIR == 0 ? 2 * i + 1 : 2 * i;
                    const float er = xr[e << lv], ei = xi[e << lv], lr_ = xr[l << lv], li_ = xi[l << lv];
                    const float wr = fmaf(pr, er, fmaf(-pi, ei, lr_)), wi = fmaf(pr, ei, fmaf(pi, er, li_));
                    xr[(2 * i) << lv] = wr; xi[(2 * i) << lv] = wi;
                }
            }
            { const float nr = fmaf(l32r, hr, fmaf(-l32i, hi, xr[0])), ni = fmaf(l32r, hi, fmaf(l32i, hr, xi[0])); hr = nr; hi = ni; }
        } else {
#pragma unroll
        for (int tt = 0; tt < 32; ++tt) {
            const int t = DIR == 0 ? tt : 31 - tt;
            const float tr_ = fmaf(-ai, hi, xr[t]), ti_ = fmaf(ai, hr, xi[t]);
            hr = fmaf(ar, hr, tr_); hi = fmaf(ar, hi, ti_);
            *(LAS unsigned*)(hl + t * S5_HST + 4 * lane) = pk2(hr, hi);
        }
        }
        if (PASS == 2) {
#pragma unroll
            for (int sub = 0; sub < 2; ++sub) {
                float* ys = yscr + (size_t)(tile * 2 + sub) * 256 + 4 * lane;
                f32x4 y = {0.f, 0.f, 0.f, 0.f};
                if (DIR == 1) y = ysv[sub];
#pragma unroll
                for (int ks = 0; ks < 4; ++ks) { const bf16x8 hf = *(const LAS bf16x8*)(hl + (sub * 16 + (lane & 15)) * S5_HST + 64 * ks + 16 * (lane >> 4)); y = MFMA16(hf, cf[ks], y); }
                if (DIR == 0) *(f32x4*)ys = y;
                else {
                    const bf16x8 uf = *(const LAS bf16x8*)(ul + (tile * 32 + sub * 16 + (lane & 15)) * S5_UST + (g & 7) * 32 + 16 * ((lane >> 4) & 1));
                    y = MFMA16(uf, dfrag, y);
                    bf16* yo = (bf16*)(ws + WS_YG) + (rowbase + tile * 32 + sub * 16 + 4 * (lane >> 4)) * 512 + g * 16 + (lane & 15);
#pragma unroll
                    for (int r = 0; r < 4; ++r) yo[(size_t)r * 512] = (bf16)f2bf(gelu_tanh(y[r]));
                }
            }
        }
    }
    if (PASS == 1) { f32x2 e; e.x = hr; e.y = hi; *(f32x2*)(Ec + (size_t)c * 128) = e; }
}
template <int PASS>
__device__ __forceinline__ void s5_phase(unsigned char* ws, const float* s5d, LAS unsigned char* lds, int bid, int G, int tid, int wave, int lane) {
    LAS unsigned char* hl = lds + wave * (32 * S5_HST); LAS unsigned char* ul = lds + S5_UOFF;
    float* yscr = (float*)(ws + WS_YSCR) + (size_t)(bid * NWAVES + wave) * 4096;
    const bf16* h0 = (const bf16*)(ws + WS_H0);
    for (int it = bid; it < NB * S5NCH * 4; it += G) {
        const int go = it & 3, c = (it >> 2) % S5NCH, b = it / (4 * S5NCH), g = go * 8 + wave;
        { const bf16* src = h0 + ((size_t)b * SEQ + (size_t)c * S5CH) * H0P + OFF_U + go * 128;
          u32x4 v[8];
#pragma unroll
          for (int i = 0; i < 8; ++i) { const int p = i * NTHR + tid; v[i] = *(const u32x4*)(src + (size_t)(p >> 4) * H0P + 8 * (p & 15)); }
          __syncthreads();
#pragma unroll
          for (int i = 0; i < 8; ++i) { const int p = i * NTHR + tid; *(LAS u32x4*)(ul + (p >> 4) * S5_UST + 16 * (p & 15)) = v[i]; }
          __syncthreads(); }
        s5_dir<PASS, 0>(ws, s5d, b, g, c, hl, ul, yscr, lane);
        s5_dir<PASS, 1>(ws, s5d, b, g, c, hl, ul, yscr, lane);
    }
}
constexpr int G_ST = 144;
constexpr int GL_QD = 0, GL_KD = GL_QD + 64 * G_ST, GL_KCT = GL_KD + 64 * G_ST, GL_VT = GL_KCT + 64 * G_ST,
              GL_S = GL_VT + 128 * G_ST, GL_ST = GL_S + 64 * G_ST, GL_END = GL_ST + 2 * 128 * G_ST;
static_assert(GL_END <= RING_BYTES, "GLA LDS");
__device__ __forceinline__ bf16x8 ldfrag32(const LAS unsigned char* base, int row0, int ks, int lane) {
    return *(const LAS bf16x8*)(base + (row0 + (lane & 31)) * G_ST + 32 * ks + 16 * (lane >> 5));
}
__device__ __forceinline__ void gate_tail(float* bcg, const float* gate_w, const float* gate_b, const LAS float* lrs, size_t row0, int tid) {
    const int dir = tid >> 8;
    float gw[16];
#pragma unroll
    for (int r = 0; r < 16; ++r) gw[r] = gate_w[(size_t)(dir * 16 + r) * 256 + (tid & 255)];
    const float gb = gate_b[tid];
    float run = 0.f;
#pragma unroll 4
    for (int i = 0; i < 128; ++i) {
        const int t = dir ? 127 - i : i;
        if ((i & 63) == 0) run = 0.f;
        const LAS f32x4* lp = (const LAS f32x4*)(lrs + t * 32 + dir * 16);
        const f32x4 l0 = lp[0], l1 = lp[1], l2 = lp[2], l3 = lp[3];
        float z = gb + l0.x * gw[0] + l0.y * gw[1] + l0.z * gw[2] + l0.w * gw[3] + l1.x * gw[4] + l1.y * gw[5] + l1.z * gw[6] + l1.w * gw[7]
                     + l2.x * gw[8] + l2.y * gw[9] + l2.z * gw[10] + l2.w * gw[11] + l3.x * gw[12] + l3.y * gw[13] + l3.z * gw[14] + l3.w * gw[15];
        const float ls = fminf(z, 0.f) - __logf(1.f + __expf(-fabsf(z)));
        run += ls * (1.0f / 16.0f);
        bcg[(row0 + t) * 512 + tid] = run;
    }
}
__device__ __forceinline__ size_t gla_tok(int b, int dir, int chunk, int s) { const int pos = chunk * GCH + s; return (size_t)b * SEQ + (dir ? (SEQ - 1 - pos) : pos); }
template <int PASS>
__device__ __forceinline__ void gla_item(unsigned char* ws, const float* bcg, int item, LAS unsigned char* lds, int tid, int wave, int lane) {
    const int sc = item % GNSC, dir = (item / GNSC) & 1, h = (item / (GNSC * 2)) & 3, b = item / (GNSC * 8);
    const bf16* h0 = (const bf16*)(ws + WS_H0);
    LAS unsigned char* QD = lds + GL_QD; LAS unsigned char* KD = lds + GL_KD; LAS unsigned char* KCT = lds + GL_KCT; LAS unsigned char* VT = lds + GL_VT; LAS unsigned char* SS = lds + GL_S; LAS unsigned char* STT = lds + GL_ST;
    const int me = wave >> 1, nd = wave & 1;
    f32x16 st;
#pragma unroll
    for (int r = 0; r < 16; ++r) st[r] = 0.f;
    float dtot = 1.f;
    float* GS = (float*)(ws + WS_GS); float* GD = (float*)(ws + WS_GD);
    const int ibase = item - sc;
    if (PASS == 2) {
        for (int j0 = 0; j0 < sc; j0 += 4) {
            float dj[4], gv[4][16];
#pragma unroll
            for (int q = 0; q < 4; ++q) { const int j = (j0 + q) < sc ? (j0 + q) : (sc - 1);
                dj[q] = GD[(size_t)(ibase + j) * 64 + nd * 32 + (lane & 31)];
                const float* gs = GS + (size_t)(ibase + j) * 8192 + nd * 32 + (lane & 31);
#pragma unroll
                for (int r = 0; r < 16; ++r) gv[q][r] = gs[(size_t)(me * 32 + crow(r, lane >> 5)) * 64]; }
#pragma unroll
            for (int q = 0; q < 4; ++q) if (j0 + q < sc) {
#pragma unroll
                for (int r = 0; r < 16; ++r) st[r] = st[r] * dj[q] + gv[q][r]; }
        }
#pragma unroll
        for (int r = 0; r < 16; ++r) *(LAS bf16*)(STT + (me * 32 + crow(r, lane >> 5)) * G_ST + (nd * 32 + (lane & 31)) * 2) = (bf16)f2bf(st[r]);
    }
    const float qscale = 0.125f;
    const int s_l = lane;
    const int gcol = dir * 256 + h * 64;
    u32x4 pq, pk, pv0, pv1; f32x4 pb0, pb1, pl0, pl1; float pdec;
#define GLA_LOAD(n) do { const int ch_ = sc * GSC + (n); const size_t tk = gla_tok(b, dir, ch_, s_l), tl = gla_tok(b, dir, ch_, 63); const bf16* rp = h0 + tk * H0P; \
        if (PASS == 2) pq = *(const u32x4*)(rp + OFF_Q + h * 64 + 8 * wave); \
        pk = *(const u32x4*)(rp + OFF_K + h * 64 + 8 * wave); pv0 = *(const u32x4*)(rp + OFF_V + h * 128 + 16 * wave); pv1 = *(const u32x4*)(rp + OFF_V + h * 128 + 16 * wave + 8); \
        pb0 = *(const f32x4*)(bcg + tk * 512 + gcol + 8 * wave); pb1 = *(const f32x4*)(bcg + tk * 512 + gcol + 8 * wave + 4); \
        pl0 = *(const f32x4*)(bcg + tl * 512 + gcol + 8 * wave); pl1 = *(const f32x4*)(bcg + tl * 512 + gcol + 8 * wave + 4); \
        pdec = bcg[tl * 512 + gcol + nd * 32 + (lane & 31)]; } while (0)
    GLA_LOAD(0);
    __syncthreads();
#pragma unroll 1
    for (int n = 0; n < GSC; ++n) {
        LAS unsigned char* STc = STT + (n & 1) * (128 * G_ST); LAS unsigned char* STn = STT + ((n + 1) & 1) * (128 * G_ST);
        { const float bc[8] = {pb0.x, pb0.y, pb0.z, pb0.w, pb1.x, pb1.y, pb1.z, pb1.w}, bl[8] = {pl0.x, pl0.y, pl0.z, pl0.w, pl1.x, pl1.y, pl1.z, pl1.w};
          const float kv[8] = {bflo(pk.x), bfhi(pk.x), bflo(pk.y), bfhi(pk.y), bflo(pk.z), bfhi(pk.z), bflo(pk.w), bfhi(pk.w)};
          if (PASS == 2) {
              const float qv[8] = {bflo(pq.x), bfhi(pq.x), bflo(pq.y), bfhi(pq.y), bflo(pq.z), bfhi(pq.z), bflo(pq.w), bfhi(pq.w)};
              float qd[8], kd[8];
#pragma unroll
              for (int i = 0; i < 8; ++i) { qd[i] = qv[i] * qscale * __expf(bc[i]); kd[i] = kv[i] * __expf(-bc[i]); }
              u32x4 w; w.x = pk2(qd[0], qd[1]); w.y = pk2(qd[2], qd[3]); w.z = pk2(qd[4], qd[5]); w.w = pk2(qd[6], qd[7]);
              *(LAS u32x4*)(QD + s_l * G_ST + 16 * wave) = w;
              w.x = pk2(kd[0], kd[1]); w.y = pk2(kd[2], kd[3]); w.z = pk2(kd[4], kd[5]); w.w = pk2(kd[6], kd[7]);
              *(LAS u32x4*)(KD + s_l * G_ST + 16 * wave) = w;
          }
#pragma unroll
          for (int i = 0; i < 8; ++i) *(LAS bf16*)(KCT + (8 * wave + i) * G_ST + 2 * s_l) = (bf16)f2bf(kv[i] * __expf(bl[i] - bc[i]));
          const unsigned vv[8] = {pv0.x, pv0.y, pv0.z, pv0.w, pv1.x, pv1.y, pv1.z, pv1.w};
#pragma unroll
          for (int i = 0; i < 8; ++i) { *(LAS bf16*)(VT + (16 * wave + 2 * i) * G_ST + 2 * s_l) = (bf16)(vv[i] & 0xffffu); *(LAS bf16*)(VT + (16 * wave + 2 * i + 1) * G_ST + 2 * s_l) = (bf16)(vv[i] >> 16); }
        }
        const float dec = __expf(pdec);
        if (n + 1 < GSC) GLA_LOAD(n + 1);
        LDS_BARRIER();
        if (PASS == 2 && wave < 4) {
            const int ms = wave >> 1, ns = wave & 1;
            f32x16 sa;
#pragma unroll
            for (int r = 0; r < 16; ++r) sa[r] = 0.f;
            if (ns <= ms) {
#pragma unroll
                for (int ks = 0; ks < 4; ++ks) sa = MFMA32(ldfrag32(QD, ms * 32, ks, lane), ldfrag32(KD, ns * 32, ks, lane), sa);
            }
#pragma unroll
            for (int r = 0; r < 16; ++r) { const int s = ms * 32 + crow(r, lane >> 5), s2 = ns * 32 + (lane & 31);
                const bool keep = dir ? (s2 < s) : (s2 <= s);
                *(LAS bf16*)(SS + s * G_ST + 2 * s2) = (bf16)f2bf(keep ? sa[r] : 0.f); }
        }
#pragma unroll
        for (int r = 0; r < 16; ++r) st[r] *= dec;
        dtot *= dec;
#pragma unroll
        for (int ks = 0; ks < 4; ++ks) st = MFMA32(ldfrag32(VT, me * 32, ks, lane), ldfrag32(KCT, nd * 32, ks, lane), st);
        if (PASS == 2 && n + 1 < GSC) {
#pragma unroll
            for (int r = 0; r < 16; ++r) *(LAS bf16*)(STn + (me * 32 + crow(r, lane >> 5)) * G_ST + (nd * 32 + (lane & 31)) * 2) = (bf16)f2bf(st[r]);
        }
        LDS_BARRIER();
        if (PASS == 2) {
            const int ms = wave >> 2, ne = wave & 3;
            f32x16 oa;
#pragma unroll
            for (int r = 0; r < 16; ++r) oa[r] = 0.f;
#pragma unroll
            for (int ks = 0; ks < 4; ++ks) oa = MFMA32(ldfrag32(SS, ms * 32, ks, lane), ldfrag32(VT, ne * 32, ks, lane), oa);
#pragma unroll
            for (int ks = 0; ks < 4; ++ks) oa = MFMA32(ldfrag32(QD, ms * 32, ks, lane), ldfrag32(STc, ne * 32, ks, lane), oa);
            bf16* op = (bf16*)(ws + (dir ? WS_OB : WS_OF)) + h * 128 + ne * 32 + (lane & 31);
#pragma unroll
            for (int r = 0; r < 16; ++r) op[gla_tok(b, dir, sc * GSC + n, ms * 32 + crow(r, lane >> 5)) * 512] = (bf16)f2bf(oa[r]);
            LDS_BARRIER();
        }
    }
    if (PASS == 1) {
        float* gs = GS + (size_t)item * 8192 + nd * 32 + (lane & 31);
#pragma unroll
        for (int r = 0; r < 16; ++r) gs[(size_t)(me * 32 + crow(r, lane >> 5)) * 64] = st[r];
        if (me == 0 && lane < 32) GD[(size_t)item * 64 + nd * 32 + lane] = dtot;
    }
    __syncthreads();
#undef GLA_LOAD
}
constexpr int AT_KST = 144, AT_VST = 664, AT_K = 0, AT_V = 320 * AT_KST, AT_BT = AT_V + 64 * AT_VST, AT_END = AT_BT + 4 * 260 * 4;
static_assert(AT_END <= RING_BYTES && AT_V % 16 == 0 && AT_BT % 16 == 0, "attention LDS");
__device__ __forceinline__ void attn_phase(unsigned char* ws, const float* sink, LAS unsigned char* lds, int bid, int G, int tid, int wave, int lane) {
    const bf16* qkv = (const bf16*)(ws + WS_QKV); bf16* ao = (bf16*)(ws + WS_AO); const float* btab = (const float*)(ws + WS_BTAB);
    LAS unsigned char* KS = lds + AT_K; LAS unsigned char* VT = lds + AT_V; LAS float* BT = (LAS float*)(lds + AT_BT);
    const float sc2 = 0.125f * LOG2E;
    u32x4 kreg[5], vreg[5];
#define AT_LOAD(u_) do { const int qb_ = (u_) % (SEQ / 64), kvh_ = ((u_) / (SEQ / 64)) & 3, b_ = (u_) / (4 * (SEQ / 64)), kb_ = qb_ * 64 - 128; \
        _Pragma("unroll") for (int it = 0; it < 5; ++it) { const int p = it * NTHR + tid; int key = kb_ + (p >> 3); key = key < 0 ? 0 : (key > SEQ - 1 ? SEQ - 1 : key); \
            const bf16* rp = qkv + ((size_t)b_ * SEQ + key) * CN + kvh_ * 64 + 8 * (p & 7); kreg[it] = *(const u32x4*)(rp + 1024); vreg[it] = *(const u32x4*)(rp + 1280); } } while (0)
    if (bid < NB * 4 * (SEQ / 64)) AT_LOAD(bid);
    for (int u = bid; u < NB * 4 * (SEQ / 64); u += G) {
        const int qb = u % (SEQ / 64), kvh = (u / (SEQ / 64)) & 3, b = u / (4 * (SEQ / 64)), q0 = qb * 64;
#pragma unroll
        for (int it = 0; it < 5; ++it) { const int p = it * NTHR + tid, i = p >> 3, ch = p & 7;
            *(LAS u32x4*)(KS + i * AT_KST + 16 * ch) = kreg[it];
            const unsigned vv[4] = {vreg[it].x, vreg[it].y, vreg[it].z, vreg[it].w};
#pragma unroll
            for (int j = 0; j < 4; ++j) { *(LAS bf16*)(VT + (8 * ch + 2 * j) * AT_VST + 2 * i) = (bf16)(vv[j] & 0xffffu); *(LAS bf16*)(VT + (8 * ch + 2 * j + 1) * AT_VST + 2 * i) = (bf16)(vv[j] >> 16); } }
        for (int p = tid; p < 4 * 260; p += NTHR) BT[p] = btab[(kvh * 4) * 260 + p];
        if (u + G < NB * 4 * (SEQ / 64)) AT_LOAD(u + G);
        LDS_BARRIER();
        const int hl = wave >> 1, hq = kvh * 4 + hl, qw = q0 + 32 * (wave & 1), qi = qw + (lane & 31), hh = lane >> 5;
        bf16x8 qf[4];
        { const bf16* qp = qkv + ((size_t)b * SEQ + qi) * CN + hq * 64 + 8 * hh;
#pragma unroll
          for (int ks = 0; ks < 4; ++ks) qf[ks] = *(const bf16x8*)(qp + 16 * ks); }
        float m = sink[hq] * LOG2E, l = hh == 0 ? 1.f : 0.f;
        f32x16 o0, o1;
#pragma unroll
        for (int r = 0; r < 16; ++r) { o0[r] = 0.f; o1[r] = 0.f; }
        const LAS float* btl = BT + hl * 260 + 128 - (lane & 31);
        const bool edge = (q0 < 128) || (q0 + 192 > SEQ);
#pragma unroll 1
        for (int j = 0; j < 9; ++j) {
            const int i0 = 32 * (wave & 1) + 32 * j;
            f32x16 sa;
#pragma unroll
            for (int r = 0; r < 16; ++r) sa[r] = 0.f;
#pragma unroll
            for (int ks = 0; ks < 4; ++ks) { const bf16x8 kf = *(const LAS bf16x8*)(KS + (i0 + (lane & 31)) * AT_KST + 32 * ks + 16 * hh); sa = MFMA32(kf, qf[ks], sa); }
            float mx = -3.0e38f;
#pragma unroll
            for (int r = 0; r < 16; ++r) {
                const int kk = 32 * j - 128 + crow(r, hh);
                sa[r] = sa[r] * sc2 + btl[kk];
            }
            if (edge || j == 0 || j == 8) {
#pragma unroll
                for (int r = 0; r < 16; ++r) {
                    const int kk = 32 * j - 128 + crow(r, hh), rel = kk - (lane & 31), key = qw + kk;
                    const bool ok = ((unsigned)(rel + 128) <= 256u) && ((unsigned)key < (unsigned)SEQ);
                    sa[r] = ok ? sa[r] : -3.0e38f;
                }
            }
#pragma unroll
            for (int r = 0; r < 16; ++r) mx = fmaxf(mx, sa[r]);
            mx = fmaxf(mx, __shfl_xor(mx, 32));
            if (!__all(mx <= m)) {
                const float mn = fmaxf(m, mx), alpha = __builtin_amdgcn_exp2f(m - mn); m = mn; l *= alpha;
#pragma unroll
                for (int r = 0; r < 16; ++r) { o0[r] *= alpha; o1[r] *= alpha; }
            }
            float ps = 0.f;
#pragma unroll
            for (int r = 0; r < 16; ++r) { const float p = __builtin_amdgcn_exp2f(sa[r] - m); sa[r] = p; ps += p; }
            l += ps;
#pragma unroll
            for (int s = 0; s < 2; ++s) {
                u32x4 pw; pw.x = pk2(sa[8 * s], sa[8 * s + 1]); pw.y = pk2(sa[8 * s + 2], sa[8 * s + 3]); pw.z = pk2(sa[8 * s + 4], sa[8 * s + 5]); pw.w = pk2(sa[8 * s + 6], sa[8 * s + 7]);
                const bf16x8 pf = __builtin_bit_cast(bf16x8, pw);
#pragma unroll
                for (int dt = 0; dt < 2; ++dt) {
                    const LAS unsigned char* vp = VT + (dt * 32 + (lane & 31)) * AT_VST + 2 * (i0 + 16 * s + 4 * hh);
                    const bf16x4 va = *(const LAS bf16x4*)vp, vb = *(const LAS bf16x4*)(vp + 16);
                    const bf16x8 vf = __builtin_shufflevector(va, vb, 0, 1, 2, 3, 4, 5, 6, 7);
                    if (dt == 0) o0 = MFMA32(vf, pf, o0); else o1 = MFMA32(vf, pf, o1);
                }
            }
        }
        l += __shfl_xor(l, 32);
        const float inv = __builtin_amdgcn_rcpf(l);
        bf16* op = ao + ((size_t)b * SEQ + qi) * D + hq * 64 + 4 * hh;
#pragma unroll
        for (int g = 0; g < 4; ++g) {
            u32x2 w0, w1; w0.x = pk2(o0[4 * g] * inv, o0[4 * g + 1] * inv); w0.y = pk2(o0[4 * g + 2] * inv, o0[4 * g + 3] * inv);
            w1.x = pk2(o1[4 * g] * inv, o1[4 * g + 1] * inv); w1.y = pk2(o1[4 * g + 2] * inv, o1[4 * g + 3] * inv);
            *(u32x2*)(op + 8 * g) = w0; *(u32x2*)(op + 32 + 8 * g) = w1;
        }
        LDS_BARRIER();
    }
#undef AT_LOAD
}
#ifndef MK_N_LAUNCHES
#define MK_N_LAUNCHES 1
#endif
constexpr int N_PHASES = 19;
#ifndef PH_MASK
#define PH_MASK 0xFFFFFFFFu
#endif
#define ON(k) (((PH_MASK) >> (k)) & 1u)
#ifndef REP_MASK
#define REP_MASK 0u
#endif
#define NREP(k) ((((REP_MASK) >> (k)) & 1u) ? 2 : 1)

template <int LAYER>
__device__ __forceinline__ void common_phases(unsigned char* ws, LAS unsigned char* lds, float* dout, const XcdBarrier& bar, int lo, int hi, int bid, int G, int tid, int wave, int lane) {
    constexpr int pb = LAYER == 0 ? 5 : 13;
    const int gw = bid * NWAVES + wave, NGW = G * NWAVES;
#define IN(k) (lo <= (k) && (k) < hi)
#define SEAM(k) do { if (IN(k) && IN((k) + 1)) xcd_barrier(bar); } while (0)
    if (ON(5) && IN(pb)) {
        pg8::Gemm g{(const bf16*)(ws + (LAYER == 0 ? WS_X64 : WS_AO)), (const bf16*)(ws + (LAYER == 0 ? WS_WOUT : WS_COUT)), T, D, D, 0, nullptr}; pg8::StaticOrder S; S.init(T, D, G, bid);
        pg8::EpiBf16 E{(bf16*)(ws + WS_Z), D};
        pg8::gemm_phase<pg8::EpiBf16, pg8::StaticOrder, false>(lds, g, S, E);
    }
    SEAM(pb);
    if (ON(6) && IN(pb + 1)) { ln_router(ws, LAYER == 0 ? inp(lds, I_X) : (const float*)(ws + WS_H1), inp(lds, I_LNMG) + LAYER * D, inp(lds, I_LNMB) + LAYER * D, inp(lds, I_BGRP) + LAYER * 4, inp(lds, I_BRT) + LAYER * 32, LAYER, lds, bid, G, tid, wave, lane); __syncthreads(); }
    SEAM(pb + 1);
    if (ON(7) && IN(pb + 2)) { moe_sort(ws, lds, bid, G, tid); __syncthreads(); }
    SEAM(pb + 2);
    if (ON(8) && IN(pb + 3)) {
        const int* tile = (const int*)(ws + WS_TILE); const int ntiles = __builtin_amdgcn_readfirstlane(tile[511]);
        pg8::Gemm g{(const bf16*)(ws + WS_X64), LAYER == 0 ? (const bf16*)(ws + WS_W13) : (const bf16*)dout, 0, D, D, (size_t)D * D * 2, (const int*)(ws + WS_SLOTT)};
        pg8::GroupOrder S{tile, ntiles, D / 256, G, bid};
        pg8::EpiSwiglu E{(bf16*)(ws + WS_HID), DEXP};
        pg8::gemm_phase<pg8::EpiSwiglu, pg8::GroupOrder, true>(lds, g, S, E);
        if (LAYER == 0) idle_convert(0, ws, lds, dout, ntiles, bid, G, wave, lane);
    }
    SEAM(pb + 3);
    if (ON(9) && IN(pb + 4)) {
        const int* tile = (const int*)(ws + WS_TILE); const int ntiles = __builtin_amdgcn_readfirstlane(tile[511]);
        pg8::Gemm g{(const bf16*)(ws + WS_HID), LAYER == 0 ? (const bf16*)(ws + WS_W2) : (const bf16*)dout + (size_t)NEXP * D * D, 0, D, DEXP, (size_t)D * DEXP * 2, nullptr};
        pg8::GroupOrder S{tile, ntiles, D / 256, G, bid};
        pg8::EpiBf16 E{(bf16*)(ws + WS_Y2), D};
        pg8::gemm_phase<pg8::EpiBf16, pg8::GroupOrder, false>(lds, g, S, E);
        if (LAYER == 0) idle_convert(1, ws, lds, dout, ntiles, bid, G, wave, lane);
    }
    SEAM(pb + 4);
    if (ON(10) && IN(pb + 5)) {
        if (LAYER == 0) {
            combine_ln<false>(ws, inp(lds, I_LNFG), inp(lds, I_LNFB), nullptr, gw, NGW, lane);
            { const int done = idle_done(__builtin_amdgcn_readfirstlane(((const int*)(ws + WS_TILE))[511]), G);
              moe_convert(inp(lds, I_W1) + (size_t)NEXP * D * DEXP, inp(lds, I_W3) + (size_t)NEXP * D * DEXP, inp(lds, I_W2) + (size_t)NEXP * DEXP * D, (bf16*)dout, (bf16*)dout + (size_t)NEXP * D * D, (LAS float*)(lds + wave * 16384), done, MOE_ITEMS, gw, NGW, lane); }
            __syncthreads();
        } else combine_ln<true>(ws, inp(lds, I_LNFG) + D, inp(lds, I_LNFB) + D, dout, gw, NGW, lane);
    }
    if (LAYER == 0) SEAM(10);
#undef IN
#undef SEAM
}

struct Args { const float* in[N_IN]; float* out; unsigned char* ws; int ph_lo, ph_hi; };
static_assert(sizeof(Args) == N_IN * 8 + 8 + 8 + 8, "no padding holes in Args");

__global__ void __launch_bounds__(NTHR, 2) fwd_kernel(Args args) {
    extern __shared__ __attribute__((aligned(16))) unsigned char lds_raw[];
    LAS unsigned char* lds = (LAS unsigned char*)lds_raw;
    volatile LAS unsigned* MISC = (volatile LAS unsigned*)(lds + MISC_OFF);
    const int tid = threadIdx.x, lane = tid & 63, wave = __builtin_amdgcn_readfirstlane(tid >> 6), G = gridDim.x, bid = blockIdx.x;
    unsigned char* ws = args.ws;
    for (int u = tid; u < 64; u += NTHR) MISC[u] = 0u;
    if (tid < N_IN) *(LAS unsigned long long*)(lds + PTR_OFF + 8 * tid) = (unsigned long long)args.in[tid];
    __syncthreads();
    const int lo = args.ph_lo, hi = args.ph_hi;
    const bool use_bar = (hi - lo) > 1;
    XcdBarrier bar; bar.bar = (unsigned*)(ws + WS_CTL) + CW_BAR; bar.x = 0; bar.st = nullptr;
    if (use_bar) bar = xcd_barrier_post((unsigned*)(ws + WS_CTL) + CW_BAR, MISC + 8);
#define IN(k) (lo <= (k) && (k) < hi)
#define SEAM(k) do { if (IN(k) && IN((k) + 1)) xcd_barrier(bar); } while (0)
    const int gw = bid * NWAVES + wave, NGW = G * NWAVES;

    if (ON(0) && IN(0)) { p0_prologue(ws, lds, bid, G, tid, wave, lane); __syncthreads(); }
    SEAM(0);
    if (ON(1) && IN(1)) {
        pg8::Gemm g{(const bf16*)(ws + WS_X64), (const bf16*)(ws + WS_WIN), T, ABN, D, 0, nullptr}; pg8::SplitOrder S; S.init(T, ABN, 2, G, bid);
        pg8::EpiBf16 E{(bf16*)(ws + WS_H0), H0P};
        pg8::gemm_phase<pg8::EpiBf16, pg8::SplitOrder, false>(lds, g, S, E);
        lr_tail(ws, args.out, inp(lds, I_GATEW), inp(lds, I_GATEB), lds, bid, G, tid, wave, lane);
#ifdef TAIL_TWICE
        lr_tail(ws, args.out, inp(lds, I_GATEW), inp(lds, I_GATEB), lds, bid, G, tid, wave, lane);
#endif
    }
    SEAM(1);
    if (ON(2) && IN(2)) {
        s5_phase<1>(ws, inp(lds, I_S5D), lds, bid, G, tid, wave, lane);
#ifdef S5_TWICE
        __syncthreads(); s5_phase<1>(ws, inp(lds, I_S5D), lds, bid, G, tid, wave, lane);
#endif
        __syncthreads();
        for (int it = bid; it < 256; it += G) gla_item<1>(ws, args.out, it, lds, tid, wave, lane);
#ifdef GLA_TWICE
        for (int it = bid; it < 256; it += G) gla_item<1>(ws, args.out, it, lds, tid, wave, lane);
#endif
    }
    SEAM(2);
    if (ON(3) && IN(3)) {
        s5_phase<2>(ws, inp(lds, I_S5D), lds, bid, G, tid, wave, lane);
#ifdef S5_TWICE
        __syncthreads(); s5_phase<2>(ws, inp(lds, I_S5D), lds, bid, G, tid, wave, lane);
#endif
        __syncthreads();
        for (int it = bid; it < 256; it += G) gla_item<2>(ws, args.out, it, lds, tid, wave, lane);
#ifdef GLA_TWICE
        for (int it = bid; it < 256; it += G) gla_item<2>(ws, args.out, it, lds, tid, wave, lane);
#endif
    }
    SEAM(3);
    if (ON(4) && IN(4)) {
        gla_finalize(ws, inp(lds, I_NORMG), gw, NGW, lane);
        pg8::Gemm g{(const bf16*)(ws + WS_YG), (const bf16*)(ws + WS_WGLU), T, 512, 512, 0, nullptr}; pg8::StaticOrder S; S.init(T, 512, G, bid);
        pg8::EpiGlu E{(const bf16*)(ws + WS_YG), 512, (bf16*)(ws + WS_X64), D, inp(lds, I_GLUB)};
        pg8::gemm_phase<pg8::EpiGlu, pg8::StaticOrder, false>(lds, g, S, E);
    }
    SEAM(4);
    common_phases<0>(ws, lds, args.out, bar, lo, hi, bid, G, tid, wave, lane);
    if (ON(11) && IN(11)) {
        pg8::Gemm g{(const bf16*)(ws + WS_H2B), (const bf16*)(ws + WS_CIN), T, CN, D, 0, nullptr}; pg8::StaticOrder S; S.init(T, CN, G, bid);
        pg8::EpiBf16 E{(bf16*)(ws + WS_QKV), CN};
        pg8::gemm_phase<pg8::EpiBf16, pg8::StaticOrder, false>(lds, g, S, E);
    }
    SEAM(11);
    if (ON(12) && IN(12)) attn_phase(ws, inp(lds, I_SINK), lds, bid, G, tid, wave, lane);
    SEAM(12);
    common_phases<1>(ws, lds, args.out, bar, lo, hi, bid, G, tid, wave, lane);
#undef IN
#undef SEAM
}

extern "C" void kernel_launch(void* const* d_in, const int* in_sizes, int n_in, void* d_out, int out_size, void* d_ws, size_t ws_size, hipStream_t stream) {
    static int grid = 0;
    if (grid == 0) {
        if (n_in != N_IN || in_sizes[0] != T * D || out_size != T * D || ws_size < WS_END) { fprintf(stderr, "kernel_launch: unexpected shapes (n_in %d, in0 %d, out %d, ws %zu < %zu)\n", n_in, n_in > 0 ? in_sizes[0] : -1, out_size, ws_size, (size_t)WS_END); grid = -1; return; }
        int dev = 0, cus = 0, per_cu = 0;
        if (hipGetDevice(&dev) != hipSuccess || hipDeviceGetAttribute(&cus, hipDeviceAttributeMultiprocessorCount, dev) != hipSuccess) { grid = -1; return; }
        if (hipFuncSetAttribute((const void*)fwd_kernel, hipFuncAttributeMaxDynamicSharedMemorySize, LDS_BYTES) != hipSuccess) { fprintf(stderr, "kernel_launch: hipFuncSetAttribute failed\n"); grid = -1; return; }
        if (hipOccupancyMaxActiveBlocksPerMultiprocessor(&per_cu, (const void*)fwd_kernel, NTHR, LDS_BYTES) != hipSuccess || per_cu < 1) fprintf(stderr, "kernel_launch: occupancy query reports %d\n", per_cu);
        (void)hipGetLastError();
        grid = cus;
    }
    if (grid < 0) return;
    if (hipMemsetAsync((char*)d_ws + WS_CTL, 0, CTL_ZERO_BYTES, stream) != hipSuccess) return;
    Args a{};
    for (int i = 0; i < N_IN; ++i) a.in[i] = (const float*)d_in[i];
    a.out = (float*)d_out; a.ws = (unsigned char*)d_ws;
    for (int li = 0; li < MK_N_LAUNCHES; ++li) {
        a.ph_lo = (MK_N_LAUNCHES == 1) ? 0 : li; a.ph_hi = (MK_N_LAUNCHES == 1) ? N_PHASES : li + 1;
        for (int rep = 0; rep < ((MK_N_LAUNCHES > 1 && ((REP_MASK >> li) & 1u)) ? 2 : 1); ++rep)
            hipLaunchKernelGGL(fwd_kernel, dim3(grid), dim3(NTHR), LDS_BYTES, stream, a);
    }
}
```

```cpp
#include <hip/hip_runtime.h>
#include <cstdio>
#include <cstdint>
#include <cmath>
namespace pg8 {
#define PG8_LAS __attribute__((address_space(3)))
typedef unsigned short bf16_t;
typedef short bf16x8 __attribute__((ext_vector_type(8)));
typedef float f32x4 __attribute__((ext_vector_type(4)));
typedef float f32x2 __attribute__((ext_vector_type(2)));
typedef unsigned u32x4 __attribute__((ext_vector_type(4)));
typedef unsigned u32x2 __attribute__((ext_vector_type(2)));
constexpr int BM = 256, BK = 64, HALF = 128, HTB = HALF * BK * 2  , STAGE_BYTES = 8 * HTB, NXCD = 8, WGM = 8;

__host__ __device__ __forceinline__ int lds_byte(int r, int c) { const int st = (r >> 4) * 2 + (c >> 5), rr = r & 15, cc = c & 31, ob = rr * 64 + cc * 2; return st * 1024 + (ob ^ (((ob >> 9) & 1) << 5)); }
__host__ __device__ __forceinline__ void stage_rc(int b, int& R, int& C) { const int st = b / 1024, sb = b % 1024, swz = sb ^ (((sb >> 9) & 1) << 5); R = (st >> 1) * 16 + swz / 64; C = (st & 1) * 32 + (swz % 64) / 2; }
__host__ __device__ __forceinline__ int perm32(int rho) { const int n = rho >> 4, i = rho & 15; return 8 * (i >> 2) + 4 * n + (i & 3); }

struct Unit { int pm, pn, e, ui; };
struct Gemm { const bf16_t* A; const bf16_t* Bt; int M, N, K; size_t bstride; const int* rowmap; };

struct StaticOrder {
    int nM, nN, nwg, G, c;
    __host__ __device__ void init(int M, int N, int G_, int c_) { nM = M / BM; nN = N / BM; nwg = nM * nN; G = G_; c = c_; }
    __host__ __device__ bool next(int i, Unit& u) const {
        const long L = (long)i * G + c; if (L >= nwg) return false;
        int wgid = (int)L; { const int q = nwg / NXCD, r = nwg % NXCD, xcd = wgid % NXCD, off = wgid / NXCD; wgid = (xcd < r ? xcd * (q + 1) : r * (q + 1) + (xcd - r) * q) + off; }
        const int nig = WGM * nN, gid = wgid / nig, fm = gid * WGM, gsz = (nM - fm) < WGM ? (nM - fm) : WGM;
        u.pm = fm + ((wgid % nig) % gsz); u.pn = (wgid % nig) / gsz; u.e = 0; u.ui = i; return true;
    }
};
struct SplitOrder {
    int nM, nNs, nwgs, nsp, G, c;
    __host__ __device__ void init(int M, int N, int nsp_, int G_, int c_) { nM = M / BM; nNs = N / BM / nsp_; nwgs = nM * nNs; nsp = nsp_; G = G_; c = c_; }
    __host__ __device__ bool next(int i, Unit& u) const {
        const long L = (long)i * G + c; if (L >= (long)nwgs * nsp) return false;
        const int slab = (int)(L / nwgs); int wgid = (int)(L % nwgs);
        { const int q = nwgs / NXCD, r = nwgs % NXCD, xcd = wgid % NXCD, off = wgid / NXCD; wgid = (xcd < r ? xcd * (q + 1) : r * (q + 1) + (xcd - r) * q) + off; }
        const int nig = WGM * nNs, gid = wgid / nig, fm = gid * WGM, gsz = (nM - fm) < WGM ? (nM - fm) : WGM;
        u.pm = fm + ((wgid % nig) % gsz); u.pn = slab * nNs + (wgid % nig) / gsz; u.e = 0; u.ui = i; return true;
    }
};
struct GroupOrder {
    const int* tile_e; int ntiles, nN, G, c;
    __device__ bool next(int i, Unit& u) const {
        const int L = i * G + c; if (L >= ntiles * nN) return false;
        u.pm = L / nN; u.pn = L % nN; u.e = __builtin_amdgcn_readfirstlane(tile_e[u.pm]); u.ui = i; return true;
    }
};

typedef __bf16 bf16x2_t __attribute__((ext_vector_type(2)));
__device__ __forceinline__ unsigned cvt_pk_bf16(float lo, float hi) { f32x2 v = {lo, hi}; return __builtin_bit_cast(unsigned, __builtin_convertvector(v, bf16x2_t)); }
__device__ __forceinline__ float bf_lo(unsigned w) { return __uint_as_float(w << 16); }
__device__ __forceinline__ float bf_hi(unsigned w) { return __uint_as_float(w & 0xffff0000u); }

struct EpiBf16 {
    static constexpr bool PERM = true;
    bf16_t* O; int ldc;
    __device__ __forceinline__ void operator()(const f32x4 (&acc)[2][2][4][2], const Unit& u, int wr, int wc, int fr, int fq) const {
        const int row0 = u.pm * BM + wr * 64 + fr; const int col0 = u.pn * BM + wc * 32 + 8 * fq;
#pragma unroll
        for (int ai = 0; ai < 2; ++ai)
#pragma unroll
            for (int m = 0; m < 4; ++m) { bf16_t* rowp = O + (size_t)(row0 + ai * HALF + m * 16) * ldc + col0;
#pragma unroll
                for (int bj = 0; bj < 2; ++bj) { const f32x4 v0 = acc[ai][bj][m][0], v1 = acc[ai][bj][m][1];
                    u32x4 w; w.x = cvt_pk_bf16(v0[0], v0[1]); w.y = cvt_pk_bf16(v0[2], v0[3]); w.z = cvt_pk_bf16(v1[0], v1[1]); w.w = cvt_pk_bf16(v1[2], v1[3]);
                    *(u32x4*)(rowp + bj * HALF) = w; } }
    }
};
struct EpiGlu {
    static constexpr bool PERM = true;
    const bf16_t* Y; int ldy; bf16_t* O; int ldc; const float* bias;
    __device__ __forceinline__ void operator()(const f32x4 (&acc)[2][2][4][2], const Unit& u, int wr, int wc, int fr, int fq) const {
        const int row0 = u.pm * BM + wr * 64 + fr; const int col0 = u.pn * BM + wc * 32 + 8 * fq;
        f32x4 bv[2][2];
#pragma unroll
        for (int bj = 0; bj < 2; ++bj)
#pragma unroll
            for (int n = 0; n < 2; ++n) bv[bj][n] = *(const f32x4*)(bias + col0 + bj * HALF + 4 * n);
#pragma unroll
        for (int ai = 0; ai < 2; ++ai) {
            u32x4 yq[4][2];
#pragma unroll
            for (int m = 0; m < 4; ++m)
#pragma unroll
                for (int bj = 0; bj < 2; ++bj) yq[m][bj] = *(const u32x4*)(Y + (size_t)(row0 + ai * HALF + m * 16) * ldy + col0 + bj * HALF);
            asm volatile("" ::: "memory");
#pragma unroll
            for (int m = 0; m < 4; ++m) { const size_t r = (size_t)(row0 + ai * HALF + m * 16);
#pragma unroll
                for (int bj = 0; bj < 2; ++bj) { const f32x4 v0 = acc[ai][bj][m][0] + bv[bj][0], v1 = acc[ai][bj][m][1] + bv[bj][1];
                    const u32x4 y = yq[m][bj];
                    float o[8]; const float yv[8] = {bf_lo(y.x), bf_hi(y.x), bf_lo(y.y), bf_hi(y.y), bf_lo(y.z), bf_hi(y.z), bf_lo(y.w), bf_hi(y.w)};
#pragma unroll
                    for (int i = 0; i < 4; ++i) { o[i] = yv[i] * __builtin_amdgcn_rcpf(1.f + __expf(-v0[i])); o[4 + i] = yv[4 + i] * __builtin_amdgcn_rcpf(1.f + __expf(-v1[i])); }
                    u32x4 w; w.x = cvt_pk_bf16(o[0], o[1]); w.y = cvt_pk_bf16(o[2], o[3]); w.z = cvt_pk_bf16(o[4], o[5]); w.w = cvt_pk_bf16(o[6], o[7]);
                    *(u32x4*)(O + r * ldc + col0 + bj * HALF) = w; } }
            asm volatile("" ::: "memory");
        }
    }
};
struct EpiResid {
    static constexpr bool PERM = false;
    const float* resid; float* out; int ldc; float alpha;
    __device__ __forceinline__ void operator()(const f32x4 (&acc)[2][2][4][2], const Unit& u, int wr, int wc, int fr, int fq) const {
        const int col0 = u.pn * BM + wc * 32 + 4 * fq;
#pragma unroll
        for (int ai = 0; ai < 2; ++ai) {
            f32x4 bs[4][2][2];
#pragma unroll
            for (int m = 0; m < 4; ++m) { const size_t off = (size_t)(u.pm * BM + ai * HALF + wr * 64 + m * 16 + fr) * ldc + col0;
#pragma unroll
                for (int bj = 0; bj < 2; ++bj)
#pragma unroll
                    for (int n = 0; n < 2; ++n) bs[m][bj][n] = *(const f32x4*)(resid + off + bj * HALF + n * 16); }
            asm volatile("" ::: "memory");
#pragma unroll
            for (int m = 0; m < 4; ++m) { const size_t off = (size_t)(u.pm * BM + ai * HALF + wr * 64 + m * 16 + fr) * ldc + col0;
#pragma unroll
                for (int bj = 0; bj < 2; ++bj)
#pragma unroll
                    for (int n = 0; n < 2; ++n) *(f32x4*)(out + off + bj * HALF + n * 16) = bs[m][bj][n] * alpha + acc[ai][bj][m][n]; }
            asm volatile("" ::: "memory");
        }
    }
};
struct EpiSwiglu {
    static constexpr bool PERM = true;
    bf16_t* O; int ldc;
    __device__ __forceinline__ void operator()(const f32x4 (&acc)[2][2][4][2], const Unit& u, int wr, int wc, int fr, int fq) const {
        const int row0 = u.pm * BM + wr * 64 + fr; const int col0 = (u.pn * BM + wc * 32 + 8 * fq) >> 1;
#pragma unroll
        for (int ai = 0; ai < 2; ++ai)
#pragma unroll
            for (int m = 0; m < 4; ++m) { bf16_t* rowp = O + (size_t)(row0 + ai * HALF + m * 16) * ldc + col0;
#pragma unroll
                for (int bj = 0; bj < 2; ++bj) { const f32x4 g = acc[ai][bj][m][0], up = acc[ai][bj][m][1]; float o[4];
#pragma unroll
                    for (int i = 0; i < 4; ++i) o[i] = g[i] * __builtin_amdgcn_rcpf(1.f + __expf(-g[i])) * up[i];
                    u32x2 w; w.x = cvt_pk_bf16(o[0], o[1]); w.y = cvt_pk_bf16(o[2], o[3]);
                    *(u32x2*)(rowp + bj * (HALF / 2)) = w; } }
    }
};
struct EpiScale {
    static constexpr bool PERM = true;
    bf16_t* O; int ldc; const float* rw;
    __device__ __forceinline__ void operator()(const f32x4 (&acc)[2][2][4][2], const Unit& u, int wr, int wc, int fr, int fq) const {
        const int row0 = u.pm * BM + wr * 64 + fr; const int col0 = u.pn * BM + wc * 32 + 8 * fq;
        float sw[2][4];
#pragma unroll
        for (int ai = 0; ai < 2; ++ai)
#pragma unroll
            for (int m = 0; m < 4; ++m) sw[ai][m] = rw[row0 + ai * HALF + m * 16];
        asm volatile("" ::: "memory");
#pragma unroll
        for (int ai = 0; ai < 2; ++ai)
#pragma unroll
            for (int m = 0; m < 4; ++m) { const int r = row0 + ai * HALF + m * 16; const float s = sw[ai][m]; bf16_t* rowp = O + (size_t)r * ldc + col0;
#pragma unroll
                for (int bj = 0; bj < 2; ++bj) { const f32x4 v0 = acc[ai][bj][m][0] * s, v1 = acc[ai][bj][m][1] * s;
                    u32x4 w; w.x = cvt_pk_bf16(v0[0], v0[1]); w.y = cvt_pk_bf16(v0[2], v0[3]); w.z = cvt_pk_bf16(v1[0], v1[1]); w.w = cvt_pk_bf16(v1[2], v1[3]);
                    *(u32x4*)(rowp + bj * HALF) = w; } }
    }
};

template <class Epi, class Sched, bool GATHER>
__device__ __forceinline__ void gemm_phase(PG8_LAS unsigned char* lds, const Gemm g, const Sched& S, const Epi& E) {
    const int tid = threadIdx.x, wid = __builtin_amdgcn_readfirstlane(tid >> 6), lane = tid & 63, wr = wid >> 2, wc = wid & 3, fr = lane & 15, fq = lane >> 4;
    const int K = g.K, nt = K / BK;
    unsigned voffA[2], voffB[2]; int RA[2], CA[2];
#pragma unroll
    for (int i = 0; i < 2; ++i) { int R, C; stage_rc(tid * 16 + i * 8192, R, C); const int Rb = Epi::PERM ? ((R & ~31) + perm32(R & 31)) : R;
        voffA[i] = (unsigned)(R * K + C) * 2u; voffB[i] = (unsigned)(Rb * K + C) * 2u; RA[i] = R; CA[i] = C; }
    const size_t kstep = (size_t)(BK * 2);
    const size_t hstep = (size_t)HALF * K * 2;
    const size_t tstep = 2 * hstep;
    const unsigned ldsw = (unsigned)wid * 1024u;
    const int aoff = lds_byte(wr * 64 + fr, fq * 8), boff = lds_byte(wc * 32 + fr, fq * 8);
#define PG8_SA(b, h) (((b) * 2 + (h)) * HTB)
#define PG8_SB(b, h) ((4 + (b) * 2 + (h)) * HTB)
#define PG8_STAGE(bufoff, gbase, voff) do { _Pragma("unroll") for (int _i = 0; _i < 2; ++_i) \
        __builtin_amdgcn_global_load_lds((const unsigned*)((const char*)(gbase) + (voff)[_i]), (PG8_LAS unsigned*)(lds + (bufoff) + ldsw + _i * 8192), 16, 0, 0); } while (0)
#define PG8_LDA(dst, b, h) do { _Pragma("unroll") for (int m = 0; m < 4; ++m) _Pragma("unroll") for (int k = 0; k < 2; ++k) dst[m][k] = *(const PG8_LAS bf16x8*)(lds + PG8_SA(b, h) + aoff + m * 2048 + k * 1024); } while (0)
#define PG8_LDB(dst, b, h) do { _Pragma("unroll") for (int n = 0; n < 2; ++n) _Pragma("unroll") for (int k = 0; k < 2; ++k) dst[n][k] = *(const PG8_LAS bf16x8*)(lds + PG8_SB(b, h) + boff + n * 2048 + k * 1024); } while (0)
#define PG8_MMA(ai, bj, At, Bt) do { __builtin_amdgcn_s_setprio(1); _Pragma("unroll") for (int m = 0; m < 4; ++m) _Pragma("unroll") for (int n = 0; n < 2; ++n) _Pragma("unroll") for (int k = 0; k < 2; ++k) \
        acc[ai][bj][m][n] = __builtin_amdgcn_mfma_f32_16x16x32_bf16(Bt[n][k], At[m][k], acc[ai][bj][m][n], 0, 0, 0); __builtin_amdgcn_s_setprio(0); } while (0)
#define PG8_WAIT_V(n) asm volatile("s_waitcnt vmcnt(" #n ")" ::: "memory")
#define PG8_WAIT_L(n) asm volatile("s_waitcnt lgkmcnt(" #n ")" ::: "memory")
#define PG8_BAR __builtin_amdgcn_s_barrier()
#define PG8_SCHED __builtin_amdgcn_sched_barrier(0)
    Unit cur, nxt; int ui = 0;
    const PG8_LAS int* rmap = (const PG8_LAS int*)(lds + STAGE_BYTES);
    if (GATHER) { Unit t_; for (int i_ = 0; S.next(i_, t_) && i_ < 16; ++i_) { if (tid < BM) ((PG8_LAS int*)(lds + STAGE_BYTES))[i_ * BM + tid] = g.rowmap[t_.pm * BM + tid]; }
        asm volatile("s_waitcnt vmcnt(0) lgkmcnt(0)" ::: "memory"); __builtin_amdgcn_s_barrier(); asm volatile("" ::: "memory"); }
    if (!S.next(0, cur)) return;
    f32x4 acc[2][2][4][2];
#pragma unroll
    for (int a = 0; a < 2; ++a)
#pragma unroll
        for (int b = 0; b < 2; ++b)
#pragma unroll
            for (int m = 0; m < 4; ++m)
#pragma unroll
                for (int n = 0; n < 2; ++n) acc[a][b][m][n] = (f32x4){0.f, 0.f, 0.f, 0.f};
    bf16x8 At[4][2], B0[2][2], B1[2][2];
    unsigned cG[2][2], nG[2][2];
#define PG8_LOAD_ROWS(u_, G2_) do { _Pragma("unroll") for (int h_ = 0; h_ < 2; ++h_) _Pragma("unroll") for (int i_ = 0; i_ < 2; ++i_) \
        G2_[h_][i_] = GATHER ? ((unsigned)rmap[(u_).ui * BM + h_ * HALF + RA[i_]] * (unsigned)K + (unsigned)CA[i_]) * 2u : voffA[i_]; } while (0)
    const char* cA = GATHER ? (const char*)g.A : (const char*)g.A + (size_t)cur.pm * tstep;
    const size_t hA = GATHER ? 0 : hstep;
    const char* cB = (const char*)g.Bt + (size_t)cur.e * g.bstride + (size_t)cur.pn * tstep;
    PG8_LOAD_ROWS(cur, cG);
    PG8_STAGE(PG8_SB(0, 0), cB, voffB); PG8_STAGE(PG8_SB(0, 1), cB + hstep, voffB); PG8_STAGE(PG8_SA(0, 0), cA, cG[0]); PG8_STAGE(PG8_SA(0, 1), cA + hA, cG[1]);
    if (wr == 1) PG8_BAR;
    PG8_WAIT_V(2); PG8_BAR;
    PG8_STAGE(PG8_SB(1, 0), cB + kstep, voffB); PG8_STAGE(PG8_SA(1, 0), cA + kstep, cG[0]); PG8_STAGE(PG8_SB(1, 1), cB + hstep + kstep, voffB);
    PG8_WAIT_V(6); PG8_BAR;
    for (;;) {
        const bool has_next = S.next(ui + 1, nxt);
        const char* nA = GATHER ? (const char*)g.A : (has_next ? (const char*)g.A + (size_t)nxt.pm * tstep : cA);
        const char* nB = has_next ? (const char*)g.Bt + (size_t)nxt.e * g.bstride + (size_t)nxt.pn * tstep : cB;
        if (has_next) PG8_LOAD_ROWS(nxt, nG); else {
#pragma unroll
            for (int h = 0; h < 2; ++h) { nG[h][0] = cG[h][0]; nG[h][1] = cG[h][1]; } }
        for (int t = 0; t < nt; t += 2) {
            const bool last = (t == nt - 2);
            const char* a1 = cA + (size_t)(t + 1) * kstep;
            const char* a2 = last ? nA : cA + (size_t)(t + 2) * kstep; const char* b2 = last ? nB : cB + (size_t)(t + 2) * kstep;
            const char* a3 = a2 + kstep; const char* b3 = b2 + kstep;
            unsigned sG[2][2];
#pragma unroll
            for (int h = 0; h < 2; ++h) { sG[h][0] = (GATHER && last) ? nG[h][0] : cG[h][0]; sG[h][1] = (GATHER && last) ? nG[h][1] : cG[h][1]; }
            PG8_LDB(B0, 0, 0); PG8_LDB(B1, 0, 1); PG8_SCHED; PG8_LDA(At, 0, 0); PG8_STAGE(PG8_SA(1, 1), a1 + hA, cG[1]);
            PG8_WAIT_V(8); PG8_WAIT_L(0); PG8_BAR; PG8_MMA(0, 0, At, B0); PG8_MMA(0, 1, At, B1); PG8_BAR; PG8_SCHED;
            PG8_LDA(At, 0, 1); PG8_STAGE(PG8_SB(0, 0), b2, voffB); PG8_STAGE(PG8_SB(0, 1), b2 + hstep, voffB); PG8_STAGE(PG8_SA(0, 0), a2, sG[0]);
            PG8_WAIT_V(8); PG8_WAIT_L(0); PG8_BAR; PG8_MMA(1, 0, At, B0); PG8_MMA(1, 1, At, B1); PG8_BAR; PG8_SCHED;
            PG8_LDB(B0, 1, 0); PG8_LDB(B1, 1, 1); PG8_SCHED; PG8_LDA(At, 1, 0); PG8_STAGE(PG8_SA(0, 1), a2 + hA, sG[1]);
            PG8_WAIT_V(8); PG8_WAIT_L(0); PG8_BAR; PG8_MMA(0, 0, At, B0); PG8_MMA(0, 1, At, B1); PG8_BAR; PG8_SCHED;
            PG8_LDA(At, 1, 1); PG8_STAGE(PG8_SB(1, 0), b3, voffB); PG8_STAGE(PG8_SB(1, 1), b3 + hstep, voffB); PG8_STAGE(PG8_SA(1, 0), a3, sG[0]);
            PG8_WAIT_V(8); PG8_WAIT_L(0); PG8_BAR; PG8_MMA(1, 0, At, B0); PG8_MMA(1, 1, At, B1); PG8_BAR; PG8_SCHED;
        }
        if (wr == 0) PG8_BAR;
        E(acc, cur, wr, wc, fr, fq);
        if (!has_next) break;
#pragma unroll
        for (int a = 0; a < 2; ++a)
#pragma unroll
            for (int b = 0; b < 2; ++b)
#pragma unroll
                for (int m = 0; m < 4; ++m)
#pragma unroll
                    for (int n = 0; n < 2; ++n) acc[a][b][m][n] = (f32x4){0.f, 0.f, 0.f, 0.f};
        cur = nxt; cA = nA; cB = nB; ++ui;
#pragma unroll
        for (int h = 0; h < 2; ++h) { cG[h][0] = nG[h][0]; cG[h][1] = nG[h][1]; }
        if (wr == 1) PG8_BAR;
    }
    PG8_WAIT_V(0);
    PG8_BAR;
#undef PG8_LOAD_ROWS
#undef PG8_SA
#undef PG8_SB
#undef PG8_STAGE
#undef PG8_LDA
#undef PG8_LDB
#undef PG8_MMA
#undef PG8_WAIT_V
#undef PG8_WAIT_L
#undef PG8_BAR
#undef PG8_SCHED
}
}
constexpr int NB = 2, SEQ = 16384, T = NB * SEQ, D = 1024;
constexpr int H0P = 2112;
constexpr int ABN = 2048, OFF_U = 0, OFF_Q = 512, OFF_K = 768, OFF_V = 1024, OFF_GO = 1536, AB_IN = 2080;
constexpr int CN = 1536;
constexpr int NEXP = 32, DEXP = 512, CAP = 2 * T + NEXP * 256, MAXTILES = CAP / 256;
constexpr int S5CH = 256, S5NCH = SEQ / S5CH;
constexpr int GSC = 16, GCH = 64, GNSC = SEQ / (GSC * GCH);
constexpr float ALPHA = 1.41421356237309515f;
constexpr float LN_EPS = 1e-5f, RMS_EPS = 1e-6f, LOG2E = 1.44269504088896341f;
constexpr int NWAVES = 8, NTHR = 512;

constexpr size_t MiB = 1u << 20, KiB = 1u << 10;
constexpr size_t WS_CTL = 0, CTL_ZERO_BYTES = 64 * KiB;
constexpr int CW_BAR = 4096;
constexpr size_t WS_LR = 1 * MiB;
constexpr size_t WS_S5E = 5 * MiB;
constexpr size_t WS_GS = 9 * MiB;
constexpr size_t WS_GD = 17 * MiB;
constexpr size_t WS_S5L = WS_GD + 64 * KiB;
constexpr size_t WS_S5B = WS_S5L + 64 * KiB;
constexpr size_t WS_S5C = WS_S5B + 256 * KiB;
constexpr size_t WS_BTAB = WS_S5C + 256 * KiB;
constexpr size_t WS_WR = WS_BTAB + 32 * KiB;
constexpr size_t WS_TOKE = WS_WR + 384 * KiB;
constexpr size_t WS_TOKW = WS_TOKE + 256 * KiB;
constexpr size_t WS_TOKS = WS_TOKW + 256 * KiB;
constexpr size_t WS_SLOTT = WS_TOKS + 256 * KiB;
constexpr size_t WS_SLOTW = WS_SLOTT + 288 * KiB;
constexpr size_t WS_BLKC = WS_SLOTW + 288 * KiB;
constexpr size_t WS_TILE = WS_BLKC + 32 * KiB;
static_assert(WS_TILE + 4 * KiB <= 32 * MiB, "param region");
constexpr size_t WS_WIN = 32 * MiB, WS_WLR = 36 * MiB, WS_WGLU = 37 * MiB, WS_WOUT = 38 * MiB, WS_CIN = 40 * MiB, WS_COUT = 43 * MiB;
constexpr size_t WS_W13 = 48 * MiB, WS_W2 = 112 * MiB;
constexpr size_t A0 = 144 * MiB;
constexpr size_t WS_H1 = A0, WS_H0 = A0;
constexpr size_t WS_Z = A0 + 128 * MiB;
constexpr size_t WS_YG = A0 + 136 * MiB, WS_OF = A0 + 168 * MiB, WS_OB = A0 + 320 * MiB;
constexpr size_t WS_YSCR = A0 + 232 * MiB;
constexpr size_t WS_X64 = A0 + 256 * MiB;
constexpr size_t WS_HID = A0 + 128 * MiB;
constexpr size_t WS_Y2 = A0 + 200 * MiB;
constexpr size_t WS_H2B = A0 + 128 * MiB;
constexpr size_t WS_QKV = A0 + 192 * MiB;
constexpr size_t WS_AO = A0 + 288 * MiB;
constexpr size_t WS_END = A0 + 384 * MiB;
static_assert((size_t)T * H0P * 2 <= 136 * MiB && WS_Y2 + (size_t)CAP * D * 2 <= WS_END && WS_OB + (size_t)T * 512 * 4 <= WS_END && WS_HID + (size_t)CAP * 512 * 2 <= WS_Y2, "act map");

constexpr int RING_BYTES = 131072;
constexpr int MISC_OFF = 163840 - 1024;
constexpr int PTR_OFF = MISC_OFF + 256;
constexpr int LDS_BYTES = 163840;

#define GAS __attribute__((address_space(1)))
#define LAS __attribute__((address_space(3)))
typedef unsigned short bf16;
typedef float f32x4 __attribute__((ext_vector_type(4)));
typedef float f32x2 __attribute__((ext_vector_type(2)));
typedef float f32x16 __attribute__((ext_vector_type(16)));
typedef short bf16x8 __attribute__((ext_vector_type(8)));
typedef short bf16x4 __attribute__((ext_vector_type(4)));
typedef unsigned u32x4 __attribute__((ext_vector_type(4)));
typedef unsigned u32x2 __attribute__((ext_vector_type(2)));
#define LDS_WAIT() asm volatile("s_waitcnt lgkmcnt(0)" ::: "memory")
#define VM_WAIT() asm volatile("s_waitcnt vmcnt(0)" ::: "memory")
#define LDS_BARRIER() do { asm volatile("s_waitcnt lgkmcnt(0)" ::: "memory"); __builtin_amdgcn_s_barrier(); asm volatile("" ::: "memory"); } while (0)
typedef __bf16 bf16x2_t __attribute__((ext_vector_type(2)));
__device__ __forceinline__ unsigned pk2(float lo, float hi) { f32x2 v = {lo, hi}; return __builtin_bit_cast(unsigned, __builtin_convertvector(v, bf16x2_t)); }
__device__ __forceinline__ unsigned f2bf(float f) { return pk2(f, 0.f) & 0xffffu; }
__device__ __forceinline__ float bf2f(unsigned short b) { return __uint_as_float((unsigned)b << 16); }
__device__ __forceinline__ float bflo(unsigned w) { return __uint_as_float(w << 16); }
__device__ __forceinline__ float bfhi(unsigned w) { return __uint_as_float(w & 0xffff0000u); }
__device__ __forceinline__ float wave_sum(float v) {
#pragma unroll
    for (int o = 1; o < 64; o <<= 1) v += __shfl_xor(v, o);
    return v;
}
__device__ __forceinline__ int crow(int r, int hi) { return (r & 3) + 8 * (r >> 2) + 4 * hi; }

#define XB_TMO      128
#define XB_XCNT(j)  (256  + 64 * (j))
#define XB_XSUB(j)  (1280 + 64 * (j))
#define XB_XGEN(j)  (2304 + 64 * (j))
#define XB_TOP      3328
#define XB_TOPGEN   3392
#define XCD_BAR_WORDS 3456
#define XB_SPIN_CAP (1u << 18)
__device__ __forceinline__ unsigned xb_ld(unsigned* p)              { return __hip_atomic_load(p, __ATOMIC_RELAXED, __HIP_MEMORY_SCOPE_AGENT); }
__device__ __forceinline__ unsigned xb_add(unsigned* p, unsigned v) { return __hip_atomic_fetch_add(p, v, __ATOMIC_RELAXED, __HIP_MEMORY_SCOPE_AGENT); }
__device__ __forceinline__ unsigned xb_xcc_id() { return (unsigned)__builtin_amdgcn_s_getreg((3 << 11) | 20) & 0xFu; }
#define XB_SPIN(cond, bar) do { unsigned _sp = 0; while (cond) { __builtin_amdgcn_s_sleep(1); \
    if ((++_sp & 255u) == 0u) { if (xb_ld(&(bar)[XB_TMO])) break; if (_sp > XB_SPIN_CAP) { atomicAdd(&(bar)[XB_TMO], 1u); break; } } } } while (0)
struct XcdBarrier { unsigned* bar; unsigned x; volatile LAS unsigned* st; };
__device__ __forceinline__ XcdBarrier xcd_barrier_post(unsigned* bar, volatile LAS unsigned* st) {
    XcdBarrier b; b.bar = bar; b.x = xb_xcc_id(); b.st = st;
    if (threadIdx.x == 0) (void)xb_add(&bar[XB_XCNT(b.x)], 1u);
    return b;
}
__device__ __forceinline__ void xcd_barrier_complete(unsigned* bar, unsigned x, unsigned& nloc, unsigned& nx) {
    const unsigned G = gridDim.x * gridDim.y * gridDim.z;
    unsigned sum, cnt, mine, sp = 0u;
    for (;;) {
        sum = 0u; cnt = 0u; mine = 0u;
#pragma unroll
        for (unsigned j = 0; j < 16; ++j) { const unsigned c = xb_ld(&bar[XB_XCNT(j)]); sum += c; cnt += (c > 0u) ? 1u : 0u; mine = (j == x) ? c : mine; }
        if (sum == G) break;
        __builtin_amdgcn_s_sleep(1);
        if ((++sp & 255u) == 0u) { if (xb_ld(&bar[XB_TMO])) break; if (sp > XB_SPIN_CAP) { atomicAdd(&bar[XB_TMO], 1u); break; } }
    }
    nloc = mine > 0u ? mine : 1u; nx = cnt > 0u ? cnt : 1u;
}
__device__ __forceinline__ void xcd_barrier(const XcdBarrier& b) {
    asm volatile("s_waitcnt vmcnt(0)" ::: "memory");
    __syncthreads();
    if (threadIdx.x == 0) {
        unsigned* bar = b.bar;
        __builtin_amdgcn_s_waitcnt(0);
        unsigned nloc = b.st[0], nx = b.st[1];
        if (nloc == 0u) { xcd_barrier_complete(bar, b.x, nloc, nx); b.st[0] = nloc; b.st[1] = nx; }
        const unsigned old = xb_add(&bar[XB_XSUB(b.x)], 1u);
        const unsigned gen = old / nloc;
        if (old + 1u == (gen + 1u) * nloc) {
            __builtin_amdgcn_fence(__ATOMIC_RELEASE, "agent");
            asm volatile("s_waitcnt vmcnt(0)" ::: "memory");
            const unsigned og = xb_add(&bar[XB_TOP], 1u);
            const unsigned tg = og / nx;
            if (og + 1u == (tg + 1u) * nx) xb_add(&bar[XB_TOPGEN], 1u);
            else XB_SPIN(xb_ld(&bar[XB_TOPGEN]) == tg, bar);
            __builtin_amdgcn_fence(__ATOMIC_ACQUIRE, "agent");
            xb_add(&bar[XB_XGEN(b.x)], 1u);
            asm volatile("s_waitcnt vmcnt(0)" ::: "memory");
        } else {
            XB_SPIN(xb_ld(&bar[XB_XGEN(b.x)]) == gen, bar);
            __builtin_amdgcn_fence(__ATOMIC_ACQUIRE, "agent");
            asm volatile("s_waitcnt vmcnt(0)" ::: "memory");
        }
    }
    __syncthreads();
}

struct Frame {
    LAS unsigned char* lds;
    int tid, lane, wave, G, bid;
    unsigned char* ws;
    const float* const* in;
};
enum InIdx { I_X = 0, I_LNMG, I_LNMB, I_LNFG, I_LNFB, I_ABWIN, I_LAMRE, I_LAMIM, I_LOGDT, I_BRE, I_BIM, I_CRE, I_CIM, I_S5D, I_GLUW, I_GLUB,
             I_GATEW, I_GATEB, I_NORMG, I_ABWOUT, I_CWIN, I_SINK, I_CWOUT, I_RELB, I_WGRP, I_BGRP, I_WRT, I_BRT, I_W1, I_W3, I_W2, N_IN };

__device__ __forceinline__ const float* inp(LAS unsigned char* lds, int k) {
    const LAS unsigned* p = (const LAS unsigned*)(lds + PTR_OFF) + 2 * k;
    const unsigned lo = __builtin_amdgcn_readfirstlane(p[0]), hi = __builtin_amdgcn_readfirstlane(p[1]);
    return (const float*)(const GAS float*)(((unsigned long long)hi << 32) | (unsigned long long)lo);
}
__device__ __forceinline__ void tr_item(const float* W, int ldw, bf16* WT, int ldt, int rowmode, LAS float* scr, int item, int nblk, int lane) {
    const int kb = item / nblk, nb = item % nblk, k0 = 64 * kb, n0 = 32 * nb;
    float tv[32];
    const float* wp = W + (size_t)(k0 + (lane >> 5)) * ldw + n0 + (lane & 31);
#pragma unroll
    for (int i = 0; i < 32; ++i) tv[i] = wp[(size_t)(2 * i) * ldw];
#pragma unroll
    for (int i = 0; i < 32; ++i) scr[(2 * i + (lane >> 5)) * 33 + (lane & 31)] = tv[i];
    LDS_WAIT(); asm volatile("" ::: "memory");
    const int c = lane & 7;
#pragma unroll
    for (int j = 0; j < 4; ++j) { const int n = (lane >> 3) + 8 * j; const LAS float* s = scr + (8 * c) * 33 + n;
        u32x4 o; o.x = pk2(s[0 * 33], s[1 * 33]); o.y = pk2(s[2 * 33], s[3 * 33]); o.z = pk2(s[4 * 33], s[5 * 33]); o.w = pk2(s[6 * 33], s[7 * 33]);
        const int ng = n0 + n; const int dr = rowmode == 0 ? ng : (8 * (ng >> 2) + (ng & 3) + (rowmode == 2 ? 4 : 0));
        *(GAS u32x4*)(WT + (size_t)dr * ldt + k0 + 8 * c) = o; }
    LDS_WAIT(); asm volatile("" ::: "memory");
}
__device__ __forceinline__ void moe_convert(const float* w1, const float* w3, const float* w2, bf16* W13, bf16* W2T, LAS float* scr, int it0, int it1, int gw, int NGW, int lane) {
    constexpr int PER_E = 768;
    for (int it = it0 + gw; it < it1; it += NGW) {
        const int e = it / PER_E; int r = it % PER_E;
        if (r < 256) tr_item(w1 + (size_t)e * D * DEXP, DEXP, W13 + (size_t)e * D * D, D, 1, scr, r, DEXP / 32, lane);
        else if (r < 512) tr_item(w3 + (size_t)e * D * DEXP, DEXP, W13 + (size_t)e * D * D, D, 2, scr, r - 256, DEXP / 32, lane);
        else tr_item(w2 + (size_t)e * DEXP * D, D, W2T + (size_t)e * D * DEXP, DEXP, 0, scr, r - 512, D / 32, lane);
    }
}
constexpr int MOE_ITEMS = NEXP * 768, IDLE_Q8 = 88, IDLE_Q9 = 56;
__device__ __forceinline__ void idle_convert(int which, unsigned char* ws, LAS unsigned char* lds, float* dout, int ntiles, int bid, int G, int wave, int lane) {
    const int U = ntiles * (D / 256), rem = U % G; if (rem == 0 || bid < rem) return;
    const int n_idle = G - rem, rank = bid - rem;
    int q8 = n_idle * IDLE_Q8; q8 = q8 < MOE_ITEMS ? q8 : MOE_ITEMS; int q9 = n_idle * IDLE_Q9; q9 = (q8 + q9) < MOE_ITEMS ? q9 : (MOE_ITEMS - q8);
    const int per = which == 0 ? IDLE_Q8 : IDLE_Q9, base = which == 0 ? 0 : q8, lim = which == 0 ? q8 : q8 + q9;
    int lo = base + rank * per, hi = lo + per; hi = hi < lim ? hi : lim;
    moe_convert(inp(lds, I_W1) + (size_t)NEXP * D * DEXP, inp(lds, I_W3) + (size_t)NEXP * D * DEXP, inp(lds, I_W2) + (size_t)NEXP * DEXP * D,
                (bf16*)dout, (bf16*)dout + (size_t)NEXP * D * D, (LAS float*)(lds + wave * 16384), lo, hi, wave, NWAVES, lane);
}
__device__ __forceinline__ int idle_done(int ntiles, int G) {
    const int U = ntiles * (D / 256), rem = U % G; if (rem == 0) return 0;
    const int n_idle = G - rem; int q = n_idle * (IDLE_Q8 + IDLE_Q9); return q < MOE_ITEMS ? q : MOE_ITEMS;
}
__device__ __forceinline__ int t5_bucket(int rel) {
    const int nb = 16, max_exact = 8; int ret = rel > 0 ? nb : 0; const int n = rel < 0 ? -rel : rel;
    const float lg = logf((float)(n < 1 ? 1 : n) / 8.0f) / 2.7725887f * 8.0f;
    int large = max_exact + (int)lg; large = large < nb - 1 ? large : nb - 1;
    return ret + (n < max_exact ? n : large);
}
__device__ __forceinline__ void p0_prologue(unsigned char* ws, LAS unsigned char* lds, int bid, int G, int tid, int wave, int lane) {
    LAS float* scr = (LAS float*)(lds + wave * 16384);
    const int gw = bid * NWAVES + wave, NGW = G * NWAVES;
    constexpr int I0 = 16 * 64, I1 = 16, I2 = 8 * 16, I3 = 16 * 32, I4 = 16 * 48, I5 = 16 * 32, NIT = I0 + I1 + I2 + I3 + I4 + I5;
    for (int it = gw; it < NIT; it += NGW) {
        int r = it;
        if (r < I0) { tr_item(inp(lds, I_ABWIN), AB_IN, (bf16*)(ws + WS_WIN), D, 0, scr, r, 64, lane); continue; } r -= I0;
        if (r < I1) { tr_item(inp(lds, I_ABWIN) + 2048, AB_IN, (bf16*)(ws + WS_WLR), D, 0, scr, r, 1, lane); continue; } r -= I1;
        if (r < I2) { tr_item(inp(lds, I_GLUW), 512, (bf16*)(ws + WS_WGLU), 512, 0, scr, r, 16, lane); continue; } r -= I2;
        if (r < I3) { tr_item(inp(lds, I_ABWOUT), D, (bf16*)(ws + WS_WOUT), D, 0, scr, r, 32, lane); continue; } r -= I3;
        if (r < I4) { tr_item(inp(lds, I_CWIN), CN, (bf16*)(ws + WS_CIN), D, 0, scr, r, 48, lane); continue; } r -= I4;
        tr_item(inp(lds, I_CWOUT), D, (bf16*)(ws + WS_COUT), D, 0, scr, r, 32, lane);
    }
    moe_convert(inp(lds, I_W1), inp(lds, I_W3), inp(lds, I_W2), (bf16*)(ws + WS_W13), (bf16*)(ws + WS_W2), scr, 0, MOE_ITEMS, gw, NGW, lane);
    { const float* x = inp(lds, I_X); bf16* xb = (bf16*)(ws + WS_X64);
      for (int m = gw; m < T; m += 2 * NGW) { const int m2 = m + NGW;
          const GAS f32x4* xr = (const GAS f32x4*)(x + (size_t)m * D) + lane; GAS u32x2* o = (GAS u32x2*)(xb + (size_t)m * D) + lane;
          const GAS f32x4* xr2 = (const GAS f32x4*)(x + (size_t)m2 * D) + lane; GAS u32x2* o2 = (GAS u32x2*)(xb + (size_t)m2 * D) + lane;
          f32x4 v[4], v2[4];
#pragma unroll
          for (int j = 0; j < 4; ++j) { v[j] = xr[64 * j]; if (m2 < T) v2[j] = xr2[64 * j]; }
#pragma unroll
          for (int j = 0; j < 4; ++j) { u32x2 w; w.x = pk2(v[j].x, v[j].y); w.y = pk2(v[j].z, v[j].w); o[64 * j] = w;
              if (m2 < T) { u32x2 w2; w2.x = pk2(v2[j].x, v2[j].y); w2.y = pk2(v2[j].z, v2[j].w); o2[64 * j] = w2; } } } }
    const int gt = bid * NTHR + tid, NGT = G * NTHR;
    { const float* lamre = inp(lds, I_LAMRE); const float* lamim = inp(lds, I_LAMIM); const float* logdt = inp(lds, I_LOGDT); const float* bre = inp(lds, I_BRE); const float* bim = inp(lds, I_BIM);
    for (int i = tid * G + bid; i < 2 * 32 * 64; i += NTHR * G) {
        const int p = i & 63, g = (i >> 6) & 31, dir = i >> 11;
        const double lr = fmin((double)lamre[i], -1e-4), li = (double)lamim[i], dt = exp((double)logdt[dir * 32 + g]);
        const double mag = exp(lr * dt), ar = mag * cos(li * dt), ai = mag * sin(li * dt), den = lr * lr + li * li, nr = ar - 1.0;
        const double cr = (nr * lr + ai * li) / den, ci = (ai * lr - nr * li) / den;
        double qr = ar, qi = ai;
#pragma unroll 1
        for (int s = 1; s < S5CH; s <<= 1) { const double t = qr * qr - qi * qi; qi = 2.0 * qr * qi; qr = t; }
        float* L4 = (float*)(ws + WS_S5L) + (size_t)i * 4; L4[0] = (float)ar; L4[1] = (float)ai; L4[2] = (float)qr; L4[3] = (float)qi;
        bf16* Bb = (bf16*)(ws + WS_S5B) + (size_t)(dir * 32 + g) * 2048;
#pragma unroll 4
        for (int c = 0; c < 16; ++c) { const double br = bre[(size_t)i * 16 + c], bi = bim[(size_t)i * 16 + c];
            Bb[p * 16 + c] = (bf16)f2bf((float)(cr * br - ci * bi)); Bb[1024 + p * 16 + c] = (bf16)f2bf((float)(cr * bi + ci * br)); }
    } }
    { const float* cre = inp(lds, I_CRE); const float* cim = inp(lds, I_CIM);
    for (int i = gt; i < 2 * 32 * 16 * 64; i += NGT) {
        const int p = i & 63, c = (i >> 6) & 15, dg = i >> 10;
        bf16* Cm = (bf16*)(ws + WS_S5C) + (size_t)dg * 2048 + c * 128 + 2 * p;
        Cm[0] = (bf16)f2bf(cre[i]); Cm[1] = (bf16)f2bf(-cim[i]);
    } }
    { const float* relb = inp(lds, I_RELB);
    for (int i = gt; i < 16 * 257; i += NGT) { const int h = i / 257, r = i % 257; ((float*)(ws + WS_BTAB))[h * 260 + r] = relb[t5_bucket(r - 128) * 16 + h] * LOG2E; } }
    { const float* wgrp = inp(lds, I_WGRP); const float* wrt = inp(lds, I_WRT);
    for (int i = gt; i < 2 * 48 * 1024; i += NGT) {
        const int k = i & 1023, n = (i >> 10) % 48, l = i / (48 * 1024);
        const float w = n < 4 ? wgrp[(size_t)l * D * 4 + k * 4 + n] : (n < 36 ? wrt[(size_t)l * D * 32 + k * 32 + (n - 4)] : 0.f);
        const unsigned hi = f2bf(w); const float lo = w - __uint_as_float(hi << 16);
        bf16* Wr = (bf16*)(ws + WS_WR) + (size_t)l * 2 * 48 * 1024; Wr[n * 1024 + k] = (bf16)hi; Wr[48 * 1024 + n * 1024 + k] = (bf16)f2bf(lo);
    } }
}

__device__ __forceinline__ void gate_tail(float* bcg, const float* gate_w, const float* gate_b, const LAS float* lrs, size_t row0, int tid);
__device__ __forceinline__ void lr_tail(unsigned char* ws, float* bcg, const float* gate_w, const float* gate_b, LAS unsigned char* lds, int bid, int G, int tid, int wave, int lane) {
    const bf16* xb = (const bf16*)(ws + WS_X64); const bf16* wl = (const bf16*)(ws + WS_WLR); LAS float* lrs = (LAS float*)lds;
    for (int rt = bid; rt < T / 128; rt += G) {
        const int r0 = rt * 128 + wave * 16;
        f32x4 acc0 = {0.f, 0.f, 0.f, 0.f}, acc1 = {0.f, 0.f, 0.f, 0.f};
        const bf16* ap = xb + (size_t)(r0 + (lane & 15)) * D + 8 * (lane >> 4);
        const bf16* bp = wl + (size_t)(lane & 15) * D + 8 * (lane >> 4);
#pragma unroll 8
        for (int ks = 0; ks < 32; ++ks) {
            const bf16x8 a = *(const bf16x8*)(ap + ks * 32), b0 = *(const bf16x8*)(bp + ks * 32), b1 = *(const bf16x8*)(bp + 16 * D + ks * 32);
            acc0 = __builtin_amdgcn_mfma_f32_16x16x32_bf16(a, b0, acc0, 0, 0, 0); acc1 = __builtin_amdgcn_mfma_f32_16x16x32_bf16(a, b1, acc1, 0, 0, 0);
        }
        __syncthreads();
#pragma unroll
        for (int r = 0; r < 4; ++r) { LAS float* o = lrs + (wave * 16 + 4 * (lane >> 4) + r) * 32 + (lane & 15); o[0] = acc0[r]; o[16] = acc1[r]; }
        __syncthreads();
        gate_tail(bcg, gate_w, gate_b, lrs, (size_t)rt * 128, tid);
    }
    __syncthreads();
}

__device__ __forceinline__ void gla_finalize(unsigned char* ws, const float* norm_g, int gw, int NGW, int lane) {
    const bf16* of = (const bf16*)(ws + WS_OF); const bf16* ob = (const bf16*)(ws + WS_OB); const bf16* h0 = (const bf16*)(ws + WS_H0); bf16* cc = (bf16*)(ws + WS_X64);
    const f32x4 g0 = *(const f32x4*)(norm_g + 8 * lane), g1 = *(const f32x4*)(norm_g + 8 * lane + 4);
    for (int m0 = gw; m0 < T; m0 += 4 * NGW) {
        u32x4 a[4], b[4], gq[4];
#pragma unroll
        for (int q = 0; q < 4; ++q) { const size_t m = (size_t)m0 + (size_t)q * NGW;
            a[q] = *(const u32x4*)(of + m * 512 + 8 * lane); b[q] = *(const u32x4*)(ob + m * 512 + 8 * lane); gq[q] = *(const u32x4*)(h0 + m * H0P + OFF_GO + 8 * lane); }
#pragma unroll
        for (int q = 0; q < 4; ++q) { const size_t m = (size_t)m0 + (size_t)q * NGW;
            f32x4 v0, v1;
            v0.x = bflo(a[q].x) + bflo(b[q].x); v0.y = bfhi(a[q].x) + bfhi(b[q].x); v0.z = bflo(a[q].y) + bflo(b[q].y); v0.w = bfhi(a[q].y) + bfhi(b[q].y);
            v1.x = bflo(a[q].z) + bflo(b[q].z); v1.y = bfhi(a[q].z) + bfhi(b[q].z); v1.z = bflo(a[q].w) + bflo(b[q].w); v1.w = bfhi(a[q].w) + bfhi(b[q].w);
            float ss = (v0.x * v0.x + v0.y * v0.y) + (v0.z * v0.z + v0.w * v0.w) + (v1.x * v1.x + v1.y * v1.y) + (v1.z * v1.z + v1.w * v1.w);
            ss += __shfl_xor(ss, 1); ss += __shfl_xor(ss, 2); ss += __shfl_xor(ss, 4); ss += __shfl_xor(ss, 8);
            const float rs = __builtin_amdgcn_rsqf(ss * (1.0f / 128.0f) + RMS_EPS);
            const float gv[8] = {bflo(gq[q].x), bfhi(gq[q].x), bflo(gq[q].y), bfhi(gq[q].y), bflo(gq[q].z), bfhi(gq[q].z), bflo(gq[q].w), bfhi(gq[q].w)};
            const float ov[8] = {v0.x * g0.x, v0.y * g0.y, v0.z * g0.z, v0.w * g0.w, v1.x * g1.x, v1.y * g1.y, v1.z * g1.z, v1.w * g1.w};
            float r[8];
#pragma unroll
            for (int i = 0; i < 8; ++i) r[i] = ov[i] * rs * (gv[i] * __builtin_amdgcn_rcpf(1.f + __expf(-gv[i])));
            u32x4 w; w.x = pk2(r[0], r[1]); w.y = pk2(r[2], r[3]); w.z = pk2(r[4], r[5]); w.w = pk2(r[6], r[7]);
            *(u32x4*)(cc + m * D + 512 + 8 * lane) = w; }
    }
}

constexpr int RT_AST = 2064;
__device__ __forceinline__ void ln_router(unsigned char* ws, const float* resid, const float* lng, const float* lnb, const float* bgrp, const float* brt, int layer, LAS unsigned char* lds, int bid, int G, int tid, int wave, int lane) {
    const bf16* yb = (const bf16*)(ws + WS_Z); float* h1 = (float*)(ws + WS_H1); bf16* hb = (bf16*)(ws + WS_X64);
    int* tok_e = (int*)(ws + WS_TOKE); float* tok_w = (float*)(ws + WS_TOKW);
    LAS unsigned char* Ahi = lds; LAS unsigned char* Alo = lds + 16 * RT_AST; LAS float* part = (LAS float*)(lds + 32 * RT_AST);
    LAS int* hist = (LAS int*)(lds + 32 * RT_AST + 8 * 16 * 48 * 4); LAS float* lgt = (LAS float*)(lds + 32 * RT_AST + 8 * 16 * 48 * 4 + 256);
    if (tid < 32) hist[tid] = 0;
    const bf16* Wr = (const bf16*)(ws + WS_WR) + (size_t)layer * 2 * 48 * 1024;
    bf16x8 Bh[3][4], Bl[3][4];
#pragma unroll
    for (int nt = 0; nt < 3; ++nt)
#pragma unroll
        for (int ks = 0; ks < 4; ++ks) { const size_t o = (size_t)(nt * 16 + (lane & 15)) * 1024 + wave * 128 + ks * 32 + 8 * (lane >> 4);
            Bh[nt][ks] = *(const bf16x8*)(Wr + o); Bl[nt][ks] = *(const bf16x8*)(Wr + 48 * 1024 + o); }
    f32x4 gv[4], bv[4];
#pragma unroll
    for (int j = 0; j < 4; ++j) { gv[j] = *(const f32x4*)(lng + 4 * lane + 256 * j); bv[j] = *(const f32x4*)(lnb + 4 * lane + 256 * j); }
    __syncthreads();
    for (int grp = bid; grp < T / 16; grp += G) {
#pragma unroll
        for (int rr = 0; rr < 2; ++rr) {
            const int row = 2 * wave + rr; const size_t m = (size_t)grp * 16 + row;
            const GAS f32x4* xr = (const GAS f32x4*)(resid + m * D) + lane; const GAS u32x2* yr = (const GAS u32x2*)(yb + m * D) + lane;
            f32x4 v[4]; float s = 0.f;
#pragma unroll
            for (int j = 0; j < 4; ++j) { const f32x4 x4 = xr[64 * j]; const u32x2 y2 = yr[64 * j];
                v[j].x = x4.x * ALPHA + bflo(y2.x); v[j].y = x4.y * ALPHA + bfhi(y2.x); v[j].z = x4.z * ALPHA + bflo(y2.y); v[j].w = x4.w * ALPHA + bfhi(y2.y);
                s += (v[j].x + v[j].y) + (v[j].z + v[j].w); }
            const float mean = wave_sum(s) * (1.f / D); float s2 = 0.f;
#pragma unroll
            for (int j = 0; j < 4; ++j) { v[j] = v[j] - mean; s2 += (v[j].x * v[j].x + v[j].y * v[j].y) + (v[j].z * v[j].z + v[j].w * v[j].w); }
            const float rstd = 1.f / sqrtf(wave_sum(s2) * (1.f / D) + LN_EPS);
#pragma unroll
            for (int j = 0; j < 4; ++j) {
                const f32x4 h = v[j] * rstd * gv[j] + bv[j];
                ((GAS f32x4*)(h1 + m * D) + lane)[64 * j] = h;
                const unsigned h0 = pk2(h.x, h.y), h1w = pk2(h.z, h.w);
                u32x2 w; w.x = h0; w.y = h1w; ((GAS u32x2*)(hb + m * D) + lane)[64 * j] = w;
                u32x2 lo; lo.x = pk2(h.x - bflo(h0), h.y - bfhi(h0)); lo.y = pk2(h.z - bflo(h1w), h.w - bfhi(h1w));
                *(LAS u32x2*)(Ahi + row * RT_AST + (4 * lane + 256 * j) * 2) = w; *(LAS u32x2*)(Alo + row * RT_AST + (4 * lane + 256 * j) * 2) = lo;
            }
        }
        LDS_BARRIER();
        f32x4 acc[3] = {{0.f, 0.f, 0.f, 0.f}, {0.f, 0.f, 0.f, 0.f}, {0.f, 0.f, 0.f, 0.f}};
#pragma unroll
        for (int ks = 0; ks < 4; ++ks) {
            const int bo = (lane & 15) * RT_AST + (wave * 128 + ks * 32 + 8 * (lane >> 4)) * 2;
            const bf16x8 ah = *(const LAS bf16x8*)(Ahi + bo), al = *(const LAS bf16x8*)(Alo + bo);
#pragma unroll
            for (int nt = 0; nt < 3; ++nt) {
                acc[nt] = __builtin_amdgcn_mfma_f32_16x16x32_bf16(ah, Bh[nt][ks], acc[nt], 0, 0, 0);
                acc[nt] = __builtin_amdgcn_mfma_f32_16x16x32_bf16(ah, Bl[nt][ks], acc[nt], 0, 0, 0);
                acc[nt] = __builtin_amdgcn_mfma_f32_16x16x32_bf16(al, Bh[nt][ks], acc[nt], 0, 0, 0);
            }
        }
#pragma unroll
        for (int nt = 0; nt < 3; ++nt)
#pragma unroll
            for (int r = 0; r < 4; ++r) part[(wave * 16 + 4 * (lane >> 4) + r) * 48 + nt * 16 + (lane & 15)] = acc[nt][r];
        LDS_BARRIER();
        { const int itn = (grp - bid) / G;
          for (int idx = tid; idx < 16 * 36; idx += NTHR) { const int tk = idx / 36, n = idx % 36; float s = 0.f;
#pragma unroll
            for (int w = 0; w < 8; ++w) s += part[(w * 16 + tk) * 48 + n];
            lgt[(itn * 16 + tk) * 36 + n] = s + (n < 4 ? bgrp[n] : brt[n - 4]); } }
    }
    LDS_BARRIER();
    for (int tk = tid; tk < 16 * ((T / 16 - bid + G - 1) / G); tk += NTHR) {
        const size_t m = ((size_t)bid + (size_t)(tk >> 4) * G) * 16 + (tk & 15);
        const LAS float* lg = lgt + tk * 36;
        int gi = 0; float gm = lg[0];
#pragma unroll
        for (int n = 1; n < 4; ++n) if (lg[n] > gm) { gm = lg[n]; gi = n; }
        float gs = 0.f;
#pragma unroll
        for (int n = 0; n < 4; ++n) gs += __expf(lg[n] - gm);
        const float pg = 1.f / gs;
        float el[8];
#pragma unroll
        for (int i = 0; i < 8; ++i) el[i] = lg[4 + gi * 8 + i];
        int i1 = 0; float m1 = el[0];
#pragma unroll
        for (int i = 1; i < 8; ++i) if (el[i] > m1) { m1 = el[i]; i1 = i; }
        int i2 = -1; float m2 = -3.0e38f;
#pragma unroll
        for (int i = 0; i < 8; ++i) if (i != i1 && el[i] > m2) { m2 = el[i]; i2 = i; }
        const float e2 = __expf(m2 - m1), inv = 1.f / (1.f + e2);
        const int ea = gi * 8 + i1, eb = gi * 8 + i2;
        tok_e[m * 2] = ea; tok_e[m * 2 + 1] = eb; tok_w[m * 2] = pg * inv; tok_w[m * 2 + 1] = pg * e2 * inv;
        atomicAdd((int*)&hist[ea], 1); atomicAdd((int*)&hist[eb], 1);
    }
    LDS_BARRIER();
    if (tid < 32) ((int*)(ws + WS_BLKC))[bid * 32 + tid] = hist[tid];
}

__device__ __forceinline__ void moe_sort(unsigned char* ws, LAS unsigned char* lds, int bid, int G, int tid) {
    const int* blkc = (const int*)(ws + WS_BLKC); const int* tok_e = (const int*)(ws + WS_TOKE); const float* tok_w = (const float*)(ws + WS_TOKW);
    int* tok_s = (int*)(ws + WS_TOKS); int* slot_t = (int*)(ws + WS_SLOTT); float* slot_w = (float*)(ws + WS_SLOTW); int* tile = (int*)(ws + WS_TILE);
    LAS int* ptot = (LAS int*)lds; LAS int* pbase = ptot + 512; LAS int* tot = pbase + 512; LAS int* base = tot + 32; LAS int* pstart = base + 32; LAS int* lcur = pstart + 33;
    { const int e = tid & 31, part = tid >> 5; int st = 0, sb = 0;
      for (int b = part; b < G; b += 16) { const int c = blkc[b * 32 + e]; st += c; sb += (b < bid) ? c : 0; }
      ptot[part * 32 + e] = st; pbase[part * 32 + e] = sb; }
    __syncthreads();
    if (tid < 32) { int st = 0, sb = 0;
#pragma unroll
        for (int p = 0; p < 16; ++p) { st += ptot[p * 32 + tid]; sb += pbase[p * 32 + tid]; }
        tot[tid] = st; base[tid] = sb; lcur[tid] = 0; }
    __syncthreads();
    if (tid == 0) { int acc = 0; for (int e = 0; e < 32; ++e) { pstart[e] = acc; acc += (tot[e] + 255) & ~255; } pstart[32] = acc; }
    __syncthreads();
    if (bid == 0) {
        const int nt = pstart[32] >> 8;
        if (tid == 0) tile[511] = nt;
        for (int t = tid; t < nt; t += NTHR) { int e = 0; for (int q = 1; q < 32; ++q) if ((t << 8) >= pstart[q]) e = q; tile[t] = e; }
    }
    for (int e = bid; e < 32; e += G)
        for (int s = pstart[e] + tot[e] + tid; s < pstart[e + 1]; s += NTHR) { slot_t[s] = 0; slot_w[s] = 0.f; }
    for (int grp = bid; grp < T / 16; grp += G) {
        if (tid < 32) { const size_t a = (size_t)grp * 32 + tid; const int e = tok_e[a]; const int rank = atomicAdd((int*)&lcur[e], 1);
            const int s = pstart[e] + base[e] + rank; slot_t[s] = (int)(a >> 1); slot_w[s] = tok_w[a]; tok_s[a] = s; }
    }
}

template <bool FINAL>
__device__ __forceinline__ void combine_ln(unsigned char* ws, const float* lng, const float* lnb, float* dout, int gw, int NGW, int lane) {
    float* h1 = (float*)(ws + WS_H1); const bf16* y2 = (const bf16*)(ws + WS_Y2); const int* tok_s = (const int*)(ws + WS_TOKS); const float* tok_w = (const float*)(ws + WS_TOKW); bf16* h2b = (bf16*)(ws + WS_H2B);
    f32x4 gv[4], bv[4];
#pragma unroll
    for (int j = 0; j < 4; ++j) { gv[j] = *(const f32x4*)(lng + 4 * lane + 256 * j); bv[j] = *(const f32x4*)(lnb + 4 * lane + 256 * j); }
    for (int m = gw; m < T; m += NGW) {
        const int s0 = tok_s[(size_t)m * 2], s1 = tok_s[(size_t)m * 2 + 1]; const float w0 = tok_w[(size_t)m * 2], w1 = tok_w[(size_t)m * 2 + 1];
        const GAS f32x4* hr = (const GAS f32x4*)(h1 + (size_t)m * D) + lane;
        const GAS u32x2* ya = (const GAS u32x2*)(y2 + (size_t)s0 * D) + lane; const GAS u32x2* yb = (const GAS u32x2*)(y2 + (size_t)s1 * D) + lane;
        f32x4 v[4]; float s = 0.f;
#pragma unroll
        for (int j = 0; j < 4; ++j) { const f32x4 h = hr[64 * j]; const u32x2 a = ya[64 * j], b = yb[64 * j];
            v[j].x = h.x * ALPHA + (w0 * bflo(a.x) + w1 * bflo(b.x)); v[j].y = h.y * ALPHA + (w0 * bfhi(a.x) + w1 * bfhi(b.x)); v[j].z = h.z * ALPHA + (w0 * bflo(a.y) + w1 * bflo(b.y)); v[j].w = h.w * ALPHA + (w0 * bfhi(a.y) + w1 * bfhi(b.y));
            s += (v[j].x + v[j].y) + (v[j].z + v[j].w); }
        const float mean = wave_sum(s) * (1.f / D); float s2 = 0.f;
#pragma unroll
        for (int j = 0; j < 4; ++j) { v[j] = v[j] - mean; s2 += (v[j].x * v[j].x + v[j].y * v[j].y) + (v[j].z * v[j].z + v[j].w * v[j].w); }
        const float rstd = 1.f / sqrtf(wave_sum(s2) * (1.f / D) + LN_EPS);
#pragma unroll
        for (int j = 0; j < 4; ++j) { const f32x4 h = v[j] * rstd * gv[j] + bv[j];
            if (FINAL) ((GAS f32x4*)(dout + (size_t)m * D) + lane)[64 * j] = h;
            else { ((GAS f32x4*)(h1 + (size_t)m * D) + lane)[64 * j] = h; u32x2 w; w.x = pk2(h.x, h.y); w.y = pk2(h.z, h.w); ((GAS u32x2*)(h2b + (size_t)m * D) + lane)[64 * j] = w; } }
    }
}
constexpr int S5_HST = 272, S5_UST = 272, S5_UOFF = 8 * 32 * S5_HST;
#define MFMA32(a, b, c) __builtin_amdgcn_mfma_f32_32x32x16_bf16((a), (b), (c), 0, 0, 0)
#define MFMA16(a, b, c) __builtin_amdgcn_mfma_f32_16x16x32_bf16((a), (b), (c), 0, 0, 0)
__device__ __forceinline__ float gelu_tanh(float x) {
    const float u = 0.7978845608028654f * (x + 0.044715f * x * x * x);
    const float e = __expf(2.f * u); const float th = 1.f - 2.f * __builtin_amdgcn_rcpf(e + 1.f);
    return 0.5f * x * (1.f + th);
}
__device__ __forceinline__ f32x4 ld_ys(const float* p) {
    f32x4 v;
    v.x = __hip_atomic_load(p, __ATOMIC_RELAXED, __HIP_MEMORY_SCOPE_AGENT); v.y = __hip_atomic_load(p + 1, __ATOMIC_RELAXED, __HIP_MEMORY_SCOPE_AGENT);
    v.z = __hip_atomic_load(p + 2, __ATOMIC_RELAXED, __HIP_MEMORY_SCOPE_AGENT); v.w = __hip_atomic_load(p + 3, __ATOMIC_RELAXED, __HIP_MEMORY_SCOPE_AGENT);
    return v;
}
template <int PASS, int DIR>
__device__ __forceinline__ void s5_dir(unsigned char* ws, const float* s5d, int b, int g, int c, LAS unsigned char* hl, const LAS unsigned char* ul, float* yscr, int lane) {
    const bf16* h0 = (const bf16*)(ws + WS_H0);
    const int dg = DIR * 32 + g;
    const f32x4 L4 = *(const f32x4*)((const float*)(ws + WS_S5L) + (size_t)(dg * 64 + lane) * 4);
    const float ar = L4.x, ai = L4.y, qr = L4.z, qi = L4.w;
    const float l2r = ar * ar - ai * ai, l2i = 2.f * ar * ai, l4r = l2r * l2r - l2i * l2i, l4i = 2.f * l2r * l2i, l8r = l4r * l4r - l4i * l4i, l8i = 2.f * l4r * l4i;
    const float l16r = l8r * l8r - l8i * l8i, l16i = 2.f * l8r * l8i, l32r = l16r * l16r - l16i * l16i, l32i = 2.f * l16r * l16i;
    const bf16* Bb = (const bf16*)(ws + WS_S5B) + (size_t)dg * 2048 + (lane & 31) * 16 + 8 * (lane >> 5);
    const bf16x8 bre0 = *(const bf16x8*)Bb, bre1 = *(const bf16x8*)(Bb + 512), bim0 = *(const bf16x8*)(Bb + 1024), bim1 = *(const bf16x8*)(Bb + 1536);
    bf16x8 cf[4]; bf16x8 dfrag;
    if (PASS == 2) {
        const bf16* Cm = (const bf16*)(ws + WS_S5C) + (size_t)dg * 2048 + (lane & 15) * 128 + 8 * (lane >> 4);
#pragma unroll
        for (int ks = 0; ks < 4; ++ks) cf[ks] = *(const bf16x8*)(Cm + 32 * ks);
        if (DIR == 1) {
            const int cc = lane & 15, kq = lane >> 4; const float d = s5d[g * 16 + cc]; const unsigned dh = f2bf(d); const unsigned dl = f2bf(d - __uint_as_float(dh << 16));
#pragma unroll
            for (int j = 0; j < 8; ++j) { const int k = 8 * (kq & 1) + j; dfrag[j] = (short)((k == cc) ? (kq < 2 ? dh : dl) : 0u); }
        }
    }
    float hr = 0.f, hi = 0.f;
    float* Ec = (float*)(ws + WS_S5E) + ((size_t)((DIR * NB + b) * 32 + g) * S5NCH) * 128 + 2 * lane;
    if (PASS == 2) {
        const int nj = DIR == 0 ? c : (S5NCH - 1 - c);
        for (int j0 = 0; j0 < nj; j0 += 32) {
            f32x2 e[32];
#pragma unroll
            for (int q = 0; q < 32; ++q) { const int j = (j0 + q) < nj ? (j0 + q) : (nj - 1); const int jj = DIR == 0 ? j : (S5NCH - 1 - j); e[q] = *(const f32x2*)(Ec + (size_t)jj * 128); }
#pragma unroll
            for (int q = 0; q < 32; ++q) if (j0 + q < nj) { const float nr = qr * hr - qi * hi + e[q].x; hi = qr * hi + qi * hr + e[q].y; hr = nr; }
        }
    }
    const size_t rowbase = (size_t)b * SEQ + (size_t)c * S5CH;
    const LAS unsigned char* up = ul + (lane & 31) * S5_UST + (g & 7) * 32 + 16 * (lane >> 5);
    const f32x16 zero16 = {0.f, 0.f, 0.f, 0.f, 0.f, 0.f, 0.f, 0.f, 0.f, 0.f, 0.f, 0.f, 0.f, 0.f, 0.f, 0.f};
#pragma unroll 1
    for (int ti = 0; ti < S5CH / 32; ++ti) {
        const int tile = DIR == 0 ? ti : (S5CH / 32 - 1 - ti);
        const bf16x8 a = *(const LAS bf16x8*)(up + tile * 32 * S5_UST);
        f32x4 ysv[2] = {{0.f, 0.f, 0.f, 0.f}, {0.f, 0.f, 0.f, 0.f}};
        if (PASS == 2 && DIR == 1) { ysv[0] = ld_ys(yscr + (size_t)(tile * 2) * 256 + 4 * lane); ysv[1] = ld_ys(yscr + (size_t)(tile * 2 + 1) * 256 + 4 * lane); }
        f32x16 xr0 = MFMA32(a, bre0, zero16), xr1 = MFMA32(a, bre1, zero16), xi0 = MFMA32(a, bim0, zero16), xi1 = MFMA32(a, bim1, zero16);
        __builtin_amdgcn_sched_barrier(0);
        asm volatile("s_nop 15\n\ts_nop 15\n\ts_nop 15\n\ts_nop 15\n\ts_nop 15\n\ts_nop 15" ::: "memory");
        __builtin_amdgcn_sched_barrier(0);
        float xr[32], xi[32];
#pragma unroll
        for (int r = 0; r < 16; ++r) {
            auto s = __builtin_amdgcn_permlane32_swap(__float_as_uint(xr0[r]), __float_as_uint(xr1[r]), false, false);
            xr[crow(r, 0)] = __uint_as_float(s[0]); xr[crow(r, 1)] = __uint_as_float(s[1]);
            auto q = __builtin_amdgcn_permlane32_swap(__float_as_uint(xi0[r]), __float_as_uint(xi1[r]), false, false);
            xi[crow(r, 0)] = __uint_as_float(q[0]); xi[crow(r, 1)] = __uint_as_float(q[1]);
        }
        if (PASS == 1) {
#pragma unroll
            for (int lv = 0; lv < 5; ++lv) {
                const float pr = lv == 0 ? ar : lv == 1 ? l2r : lv == 2 ? l4r : lv == 3 ? l8r : l16r, pi = lv == 0 ? ai : lv == 1 ? l2i : lv == 2 ? l4i : lv == 3 ? l8i : l16i;
#pragma unroll
                for (int i = 0; i < (16 >> lv); ++i) {
                    const int e = DIR == 0 ? 2 * i : 2 * i + 1, l = DIR == 0 ? 2 * i + 1 : 2 * i;
                    const float er = xr[e << lv], ei = xi[e << lv], lr_ = xr[l << lv], li_ = xi[l << lv];
                    const float wr = fmaf(pr, er, fmaf(-pi, ei, lr_)), wi = fmaf(pr, ei, fmaf(pi, er, li_));
                    xr[(2 * i) << lv] = wr; xi[(2 * i) << lv] = wi;
                }
            }
            { const float nr = fmaf(l32r, hr, fmaf(-l32i, hi, xr[0])), ni = fmaf(l32r, hi, fmaf(l32i, hr, xi[0])); hr = nr; hi = ni; }
        } else {
#pragma unroll
        for (int tt = 0; tt < 32; ++tt) {
            const int t = DIR == 0 ? tt : 31 - tt;
            const float tr_ = fmaf(-ai, hi, xr[t]), ti_ = fmaf(ai, hr, xi[t]);
            hr = fmaf(ar, hr, tr_); hi = fmaf(ar, hi, ti_);
            *(LAS unsigned*)(hl + t * S5_HST + 4 * lane) = pk2(hr, hi);
        }
        }
        if (PASS == 2) {
#pragma unroll
            for (int sub = 0; sub < 2; ++sub) {
                float* ys = yscr + (size_t)(tile * 2 + sub) * 256 + 4 * lane;
                f32x4 y = {0.f, 0.f, 0.f, 0.f};
                if (DIR == 1) y = ysv[sub];
#pragma unroll
                for (int ks = 0; ks < 4; ++ks) { const bf16x8 hf = *(const LAS bf16x8*)(hl + (sub * 16 + (lane & 15)) * S5_HST + 64 * ks + 16 * (lane >> 4)); y = MFMA16(hf, cf[ks], y); }
                if (DIR == 0) *(f32x4*)ys = y;
                else {
                    const bf16x8 uf = *(const LAS bf16x8*)(ul + (tile * 32 + sub * 16 + (lane & 15)) * S5_UST + (g & 7) * 32 + 16 * ((lane >> 4) & 1));
                    y = MFMA16(uf, dfrag, y);
                    bf16* yo = (bf16*)(ws + WS_YG) + (rowbase + tile * 32 + sub * 16 + 4 * (lane >> 4)) * 512 + g * 16 + (lane & 15);
#pragma unroll
                    for (int r = 0; r < 4; ++r) yo[(size_t)r * 512] = (bf16)f2bf(gelu_tanh(y[r]));
                }
            }
        }
    }
    if (PASS == 1) { f32x2 e; e.x = hr; e.y = hi; *(f32x2*)(Ec + (size_t)c * 128) = e; }
}
template <int PASS>
__device__ __forceinline__ void s5_phase(unsigned char* ws, const float* s5d, LAS unsigned char* lds, int bid, int G, int tid, int wave, int lane) {
    LAS unsigned char* hl = lds + wave * (32 * S5_HST); LAS unsigned char* ul = lds + S5_UOFF;
    float* yscr = (float*)(ws + WS_YSCR) + (size_t)(bid * NWAVES + wave) * 4096;
    const bf16* h0 = (const bf16*)(ws + WS_H0);
    for (int it = bid; it < NB * S5NCH * 4; it += G) {
        const int go = it & 3, c = (it >> 2) % S5NCH, b = it / (4 * S5NCH), g = go * 8 + wave;
        { const bf16* src = h0 + ((size_t)b * SEQ + (size_t)c * S5CH) * H0P + OFF_U + go * 128;
          u32x4 v[8];
#pragma unroll
          for (int i = 0; i < 8; ++i) { const int p = i * NTHR + tid; v[i] = *(const u32x4*)(src + (size_t)(p >> 4) * H0P + 8 * (p & 15)); }
          __syncthreads();
#pragma unroll
          for (int i = 0; i < 8; ++i) { const int p = i * NTHR + tid; *(LAS u32x4*)(ul + (p >> 4) * S5_UST + 16 * (p & 15)) = v[i]; }
          __syncthreads(); }
        s5_dir<PASS, 0>(ws, s5d, b, g, c, hl, ul, yscr, lane);
        s5_dir<PASS, 1>(ws, s5d, b, g, c, hl, ul, yscr, lane);
    }
}
constexpr int G_ST = 144;
constexpr int GL_QD = 0, GL_KD = GL_QD + 64 * G_ST, GL_KCT = GL_KD + 64 * G_ST, GL_VT = GL_KCT + 64 * G_ST, GL_IMG = GL_VT + 128 * G_ST,
              GL_S = 2 * GL_IMG, GL_ST = GL_S + 64 * G_ST, GL_END = GL_ST + 2 * 128 * G_ST;
static_assert(GL_END <= MISC_OFF, "GLA LDS");
__device__ __forceinline__ bf16x8 ldfrag32(const LAS unsigned char* base, int row0, int ks, int lane) {
    return *(const LAS bf16x8*)(base + (row0 + (lane & 31)) * G_ST + 32 * ks + 16 * (lane >> 5));
}
__device__ __forceinline__ void gate_tail(float* bcg, const float* gate_w, const float* gate_b, const LAS float* lrs, size_t row0, int tid) {
    const int dir = tid >> 8;
    float gw[16];
#pragma unroll
    for (int r = 0; r < 16; ++r) gw[r] = gate_w[(size_t)(dir * 16 + r) * 256 + (tid & 255)];
    const float gb = gate_b[tid];
    float run = 0.f;
#pragma unroll 4
    for (int i = 0; i < 128; ++i) {
        const int t = dir ? 127 - i : i;
        if ((i & 63) == 0) run = 0.f;
        const LAS f32x4* lp = (const LAS f32x4*)(lrs + t * 32 + dir * 16);
        const f32x4 l0 = lp[0], l1 = lp[1], l2 = lp[2], l3 = lp[3];
        float z = gb + l0.x * gw[0] + l0.y * gw[1] + l0.z * gw[2] + l0.w * gw[3] + l1.x * gw[4] + l1.y * gw[5] + l1.z * gw[6] + l1.w * gw[7]
                     + l2.x * gw[8] + l2.y * gw[9] + l2.z * gw[10] + l2.w * gw[11] + l3.x * gw[12] + l3.y * gw[13] + l3.z * gw[14] + l3.w * gw[15];
        const float ls = fminf(z, 0.f) - __logf(1.f + __expf(-fabsf(z)));
        run += ls * (1.0f / 16.0f);
        bcg[(row0 + t) * 512 + tid] = run;
    }
}
__device__ __forceinline__ size_t gla_tok(int b, int dir, int chunk, int s) { const int pos = chunk * GCH + s; return (size_t)b * SEQ + (dir ? (SEQ - 1 - pos) : pos); }
template <int PASS>
__device__ __forceinline__ void gla_item(unsigned char* ws, const float* bcg, int item, LAS unsigned char* lds, int tid, int wave, int lane) {
    const int sc = item % GNSC, dir = (item / GNSC) & 1, h = (item / (GNSC * 2)) & 3, b = item / (GNSC * 8);
    const bf16* h0 = (const bf16*)(ws + WS_H0);
    LAS unsigned char* QD = lds + GL_QD; LAS unsigned char* KD = lds + GL_KD; LAS unsigned char* KCT = lds + GL_KCT; LAS unsigned char* VT = lds + GL_VT; LAS unsigned char* SS = lds + GL_S; LAS unsigned char* STT = lds + GL_ST;
    const int me = wave >> 1, nd = wave & 1;
    f32x16 st;
#pragma unroll
    for (int r = 0; r < 16; ++r) st[r] = 0.f;
    float dtot = 1.f;
    float* GS = (float*)(ws + WS_GS); float* GD = (float*)(ws + WS_GD);
    const int ibase = item - sc;
    if (PASS == 2) {
        for (int j0 = 0; j0 < sc; j0 += 4) {
            float dj[4], gv[4][16];
#pragma unroll
            for (int q = 0; q < 4; ++q) { const int j = (j0 + q) < sc ? (j0 + q) : (sc - 1);
                dj[q] = GD[(size_t)(ibase + j) * 64 + nd * 32 + (lane & 31)];
                const float* gs = GS + (size_t)(ibase + j) * 8192 + nd * 32 + (lane & 31);
#pragma unroll
                for (int r = 0; r < 16; ++r) gv[q][r] = gs[(size_t)(me * 32 + crow(r, lane >> 5)) * 64]; }
#pragma unroll
            for (int q = 0; q < 4; ++q) if (j0 + q < sc) {
#pragma unroll
                for (int r = 0; r < 16; ++r) st[r] = st[r] * dj[q] + gv[q][r]; }
        }
#pragma unroll
        for (int r = 0; r < 16; ++r) *(LAS bf16*)(STT + (me * 32 + crow(r, lane >> 5)) * G_ST + (nd * 32 + (lane & 31)) * 2) = (bf16)f2bf(st[r]);
    }
    const float qscale = 0.125f;
    const int s_l = lane;
    const int gcol = dir * 256 + h * 64;
    u32x4 pq, pk, pv0, pv1; f32x4 pb0, pb1, pl0, pl1; float pdec;
#define GLA_LOAD(n) do { const int ch_ = sc * GSC + (n); const size_t tk = gla_tok(b, dir, ch_, s_l), tl = gla_tok(b, dir, ch_, 63); const bf16* rp = h0 + tk * H0P; \
        if (PASS == 2) pq = *(const u32x4*)(rp + OFF_Q + h * 64 + 8 * wave); \
        pk = *(const u32x4*)(rp + OFF_K + h * 64 + 8 * wave); pv0 = *(const u32x4*)(rp + OFF_V + h * 128 + 16 * wave); pv1 = *(const u32x4*)(rp + OFF_V + h * 128 + 16 * wave + 8); \
        pb0 = *(const f32x4*)(bcg + tk * 512 + gcol + 8 * wave); pb1 = *(const f32x4*)(bcg + tk * 512 + gcol + 8 * wave + 4); \
        pl0 = *(const f32x4*)(bcg + tl * 512 + gcol + 8 * wave); pl1 = *(const f32x4*)(bcg + tl * 512 + gcol + 8 * wave + 4); \
        pdec = bcg[tl * 512 + gcol + nd * 32 + (lane & 31)]; } while (0)
#define GLA_STEP_A(IMG) do { LAS unsigned char* QD_ = (IMG) + GL_QD; LAS unsigned char* KD_ = (IMG) + GL_KD; LAS unsigned char* KCT_ = (IMG) + GL_KCT; LAS unsigned char* VT_ = (IMG) + GL_VT; \
        const float bc[8] = {pb0.x, pb0.y, pb0.z, pb0.w, pb1.x, pb1.y, pb1.z, pb1.w}, bl[8] = {pl0.x, pl0.y, pl0.z, pl0.w, pl1.x, pl1.y, pl1.z, pl1.w}; \
        const float kv[8] = {bflo(pk.x), bfhi(pk.x), bflo(pk.y), bfhi(pk.y), bflo(pk.z), bfhi(pk.z), bflo(pk.w), bfhi(pk.w)}; \
        if (PASS == 2) { const float qv[8] = {bflo(pq.x), bfhi(pq.x), bflo(pq.y), bfhi(pq.y), bflo(pq.z), bfhi(pq.z), bflo(pq.w), bfhi(pq.w)}; float qd[8], kd[8]; \
            _Pragma("unroll") for (int i = 0; i < 8; ++i) { qd[i] = qv[i] * qscale * __expf(bc[i]); kd[i] = kv[i] * __expf(-bc[i]); } \
            u32x4 w; w.x = pk2(qd[0], qd[1]); w.y = pk2(qd[2], qd[3]); w.z = pk2(qd[4], qd[5]); w.w = pk2(qd[6], qd[7]); *(LAS u32x4*)(QD_ + s_l * G_ST + 16 * wave) = w; \
            w.x = pk2(kd[0], kd[1]); w.y = pk2(kd[2], kd[3]); w.z = pk2(kd[4], kd[5]); w.w = pk2(kd[6], kd[7]); *(LAS u32x4*)(KD_ + s_l * G_ST + 16 * wave) = w; } \
        _Pragma("unroll") for (int i = 0; i < 8; ++i) *(LAS bf16*)(KCT_ + (8 * wave + i) * G_ST + 2 * s_l) = (bf16)f2bf(kv[i] * __expf(bl[i] - bc[i])); \
        const unsigned vv[8] = {pv0.x, pv0.y, pv0.z, pv0.w, pv1.x, pv1.y, pv1.z, pv1.w}; \
        _Pragma("unroll") for (int i = 0; i < 8; ++i) { *(LAS bf16*)(VT_ + (16 * wave + 2 * i) * G_ST + 2 * s_l) = (bf16)(vv[i] & 0xffffu); *(LAS bf16*)(VT_ + (16 * wave + 2 * i + 1) * G_ST + 2 * s_l) = (bf16)(vv[i] >> 16); } \
        dec_n = __expf(pdec); } while (0)
#define GLA_STEP_B(IMG, STW, WRITE_ST) do { LAS unsigned char* QD_ = (IMG) + GL_QD; LAS unsigned char* KD_ = (IMG) + GL_KD; LAS unsigned char* KCT_ = (IMG) + GL_KCT; LAS unsigned char* VT_ = (IMG) + GL_VT; \
        if (PASS == 2 && wave < 4) { const int ms = wave >> 1, ns = wave & 1; f32x16 sa; \
            _Pragma("unroll") for (int r = 0; r < 16; ++r) sa[r] = 0.f; \
            if (ns <= ms) { _Pragma("unroll") for (int ks = 0; ks < 4; ++ks) sa = MFMA32(ldfrag32(QD_, ms * 32, ks, lane), ldfrag32(KD_, ns * 32, ks, lane), sa); } \
            _Pragma("unroll") for (int r = 0; r < 16; ++r) { const int s = ms * 32 + crow(r, lane >> 5), s2 = ns * 32 + (lane & 31); const bool keep = dir ? (s2 < s) : (s2 <= s); \
                *(LAS bf16*)(SS + s * G_ST + 2 * s2) = (bf16)f2bf(keep ? sa[r] : 0.f); } } \
        _Pragma("unroll") for (int r = 0; r < 16; ++r) st[r] *= dec_c; \
        dtot *= dec_c; \
        _Pragma("unroll") for (int ks = 0; ks < 4; ++ks) st = MFMA32(ldfrag32(VT_, me * 32, ks, lane), ldfrag32(KCT_, nd * 32, ks, lane), st); \
        if (PASS == 2 && (WRITE_ST)) { _Pragma("unroll") for (int r = 0; r < 16; ++r) *(LAS bf16*)((STW) + (me * 32 + crow(r, lane >> 5)) * G_ST + (nd * 32 + (lane & 31)) * 2) = (bf16)f2bf(st[r]); } } while (0)
    float dec_n = 1.f, dec_c = 1.f;
    LAS unsigned char* IMG0 = lds; LAS unsigned char* IMG1 = lds + GL_IMG;
    GLA_LOAD(0);
    __syncthreads();
    GLA_STEP_A(IMG0); dec_c = dec_n;
    if (1 < GSC) GLA_LOAD(1);
    LDS_BARRIER();
    if (PASS == 2) { GLA_STEP_B(IMG0, STT + 128 * G_ST, true); LDS_BARRIER(); }
#pragma unroll 1
    for (int n = 0; n < GSC; ++n) {
        LAS unsigned char* Ic = (n & 1) ? IMG1 : IMG0; LAS unsigned char* In = (n & 1) ? IMG0 : IMG1;
        LAS unsigned char* STc = STT + (n & 1) * (128 * G_ST);
        if (PASS == 2) {
            const int ms = wave >> 2, ne = wave & 3;
            f32x16 oa;
#pragma unroll
            for (int r = 0; r < 16; ++r) oa[r] = 0.f;
#pragma unroll
            for (int ks = 0; ks < 4; ++ks) oa = MFMA32(ldfrag32(SS, ms * 32, ks, lane), ldfrag32(Ic + GL_VT, ne * 32, ks, lane), oa);
#pragma unroll
            for (int ks = 0; ks < 4; ++ks) oa = MFMA32(ldfrag32(Ic + GL_QD, ms * 32, ks, lane), ldfrag32(STc, ne * 32, ks, lane), oa);
            bf16* op = (bf16*)(ws + (dir ? WS_OB : WS_OF)) + h * 128 + ne * 32 + (lane & 31);
#pragma unroll
            for (int r = 0; r < 16; ++r) op[gla_tok(b, dir, sc * GSC + n, ms * 32 + crow(r, lane >> 5)) * 512] = (bf16)f2bf(oa[r]);
        } else {
            GLA_STEP_B(Ic, STT, false);
        }
        if (n + 1 < GSC) { GLA_STEP_A(In); if (n + 2 < GSC) GLA_LOAD(n + 2); }
        LDS_BARRIER();
        if (PASS == 2 && n + 1 < GSC) { dec_c = dec_n; GLA_STEP_B(In, STT + (n & 1) * (128 * G_ST), n + 2 < GSC); LDS_BARRIER(); }
        if (PASS == 1) dec_c = dec_n;
    }
#undef GLA_STEP_A
#undef GLA_STEP_B
    if (PASS == 1) {
        float* gs = GS + (size_t)item * 8192 + nd * 32 + (lane & 31);
#pragma unroll
        for (int r = 0; r < 16; ++r) gs[(size_t)(me * 32 + crow(r, lane >> 5)) * 64] = st[r];
        if (me == 0 && lane < 32) GD[(size_t)item * 64 + nd * 32 + lane] = dtot;
    }
    __syncthreads();
#undef GLA_LOAD
}
constexpr int AT_KST = 144, AT_VST = 664, AT_K = 0, AT_V = 320 * AT_KST, AT_BT = AT_V + 64 * AT_VST, AT_END = AT_BT + 16 * 260 * 4;
static_assert(AT_END <= RING_BYTES && AT_V % 16 == 0 && AT_BT % 16 == 0, "attention LDS");
__device__ __forceinline__ void attn_phase(unsigned char* ws, const float* sink, LAS unsigned char* lds, int bid, int G, int tid, int wave, int lane) {
    const bf16* qkv = (const bf16*)(ws + WS_QKV); bf16* ao = (bf16*)(ws + WS_AO); const float* btab = (const float*)(ws + WS_BTAB);
    LAS unsigned char* KS = lds + AT_K; LAS unsigned char* VT = lds + AT_V; LAS float* BT = (LAS float*)(lds + AT_BT);
    const float sc2 = 0.125f * LOG2E;
    u32x4 kreg[5], vreg[5]; bf16x8 qreg[4]; float sreg;
    for (int p = tid; p < 16 * 260; p += NTHR) BT[p] = btab[p];
#define AT_LOAD(u_) do { const int qb_ = (u_) % (SEQ / 64), kvh_ = ((u_) / (SEQ / 64)) & 3, b_ = (u_) / (4 * (SEQ / 64)), kb_ = qb_ * 64 - 128; \
        _Pragma("unroll") for (int it = 0; it < 5; ++it) { const int p = it * NTHR + tid; int key = kb_ + (p >> 3); key = key < 0 ? 0 : (key > SEQ - 1 ? SEQ - 1 : key); \
            const bf16* rp = qkv + ((size_t)b_ * SEQ + key) * CN + kvh_ * 64 + 8 * (p & 7); kreg[it] = *(const u32x4*)(rp + 1024); vreg[it] = *(const u32x4*)(rp + 1280); } \
        { const int hq_ = kvh_ * 4 + (wave >> 1); const bf16* qp_ = qkv + ((size_t)b_ * SEQ + qb_ * 64 + 32 * (wave & 1) + (lane & 31)) * CN + hq_ * 64 + 8 * (lane >> 5); \
          _Pragma("unroll") for (int ks = 0; ks < 4; ++ks) qreg[ks] = *(const bf16x8*)(qp_ + 16 * ks); sreg = sink[hq_]; } } while (0)
    if (bid < NB * 4 * (SEQ / 64)) AT_LOAD(bid);
    for (int u = bid; u < NB * 4 * (SEQ / 64); u += G) {
        const int qb = u % (SEQ / 64), kvh = (u / (SEQ / 64)) & 3, b = u / (4 * (SEQ / 64)), q0 = qb * 64;
#pragma unroll
        for (int it = 0; it < 5; ++it) { const int p = it * NTHR + tid, i = p >> 3, ch = p & 7;
            *(LAS u32x4*)(KS + i * AT_KST + 16 * ch) = kreg[it];
            const unsigned vv[4] = {vreg[it].x, vreg[it].y, vreg[it].z, vreg[it].w};
#pragma unroll
            for (int j = 0; j < 4; ++j) { *(LAS bf16*)(VT + (8 * ch + 2 * j) * AT_VST + 2 * i) = (bf16)(vv[j] & 0xffffu); *(LAS bf16*)(VT + (8 * ch + 2 * j + 1) * AT_VST + 2 * i) = (bf16)(vv[j] >> 16); } }
        const bf16x8 qf[4] = {qreg[0], qreg[1], qreg[2], qreg[3]}; const float m0 = sreg * LOG2E;
        if (u + G < NB * 4 * (SEQ / 64)) AT_LOAD(u + G);
        LDS_BARRIER();
        const int hl = wave >> 1, hq = kvh * 4 + hl, qw = q0 + 32 * (wave & 1), qi = qw + (lane & 31), hh = lane >> 5;
        float m = m0, l = hh == 0 ? 1.f : 0.f;
        f32x16 o0, o1;
#pragma unroll
        for (int r = 0; r < 16; ++r) { o0[r] = 0.f; o1[r] = 0.f; }
        const LAS float* btl = BT + hq * 260 + 128 - (lane & 31);
        const bool edge = (q0 < 128) || (q0 + 192 > SEQ);
#pragma unroll 1
        for (int j = 0; j < 9; ++j) {
            const int i0 = 32 * (wave & 1) + 32 * j;
            f32x16 sa;
#pragma unroll
            for (int r = 0; r < 16; ++r) sa[r] = 0.f;
#pragma unroll
            for (int ks = 0; ks < 4; ++ks) { const bf16x8 kf = *(const LAS bf16x8*)(KS + (i0 + (lane & 31)) * AT_KST + 32 * ks + 16 * hh); sa = MFMA32(kf, qf[ks], sa); }
            float mx = -3.0e38f;
#pragma unroll
            for (int r = 0; r < 16; ++r) {
                const int kk = 32 * j - 128 + crow(r, hh);
                sa[r] = sa[r] * sc2 + btl[kk];
            }
            if (edge || j == 0 || j == 8) {
#pragma unroll
                for (int r = 0; r < 16; ++r) {
                    const int kk = 32 * j - 128 + crow(r, hh), rel = kk - (lane & 31), key = qw + kk;
                    const bool ok = ((unsigned)(rel + 128) <= 256u) && ((unsigned)key < (unsigned)SEQ);
                    sa[r] = ok ? sa[r] : -3.0e38f;
                }
            }
#pragma unroll
            for (int r = 0; r < 16; ++r) mx = fmaxf(mx, sa[r]);
            mx = fmaxf(mx, __shfl_xor(mx, 32));
            if (!__all(mx <= m)) {
                const float mn = fmaxf(m, mx), alpha = __builtin_amdgcn_exp2f(m - mn); m = mn; l *= alpha;
#pragma unroll
                for (int r = 0; r < 16; ++r) { o0[r] *= alpha; o1[r] *= alpha; }
            }
            float ps = 0.f;
#pragma unroll
            for (int r = 0; r < 16; ++r) { const float p = __builtin_amdgcn_exp2f(sa[r] - m); sa[r] = p; ps += p; }
            l += ps;
#pragma unroll
            for (int s = 0; s < 2; ++s) {
                u32x4 pw; pw.x = pk2(sa[8 * s], sa[8 * s + 1]); pw.y = pk2(sa[8 * s + 2], sa[8 * s + 3]); pw.z = pk2(sa[8 * s + 4], sa[8 * s + 5]); pw.w = pk2(sa[8 * s + 6], sa[8 * s + 7]);
                const bf16x8 pf = __builtin_bit_cast(bf16x8, pw);
#pragma unroll
                for (int dt = 0; dt < 2; ++dt) {
                    const LAS unsigned char* vp = VT + (dt * 32 + (lane & 31)) * AT_VST + 2 * (i0 + 16 * s + 4 * hh);
                    const bf16x4 va = *(const LAS bf16x4*)vp, vb = *(const LAS bf16x4*)(vp + 16);
                    const bf16x8 vf = __builtin_shufflevector(va, vb, 0, 1, 2, 3, 4, 5, 6, 7);
                    if (dt == 0) o0 = MFMA32(vf, pf, o0); else o1 = MFMA32(vf, pf, o1);
                }
            }
        }
        l += __shfl_xor(l, 32);
        const float inv = __builtin_amdgcn_rcpf(l);
        bf16* op = ao + ((size_t)b * SEQ + qi) * D + hq * 64 + 4 * hh;
#pragma unroll
        for (int g = 0; g < 4; ++g) {
            u32x2 w0, w1; w0.x = pk2(o0[4 * g] * inv, o0[4 * g + 1] * inv); w0.y = pk2(o0[4 * g + 2] * inv, o0[4 * g + 3] * inv);
            w1.x = pk2(o1[4 * g] * inv, o1[4 * g + 1] * inv); w1.y = pk2(o1[4 * g + 2] * inv, o1[4 * g + 3] * inv);
            *(u32x2*)(op + 8 * g) = w0; *(u32x2*)(op + 32 + 8 * g) = w1;
        }
        LDS_BARRIER();
    }
#undef AT_LOAD
}
#ifndef MK_N_LAUNCHES
#define MK_N_LAUNCHES 1
#endif
constexpr int N_PHASES = 19;
#ifndef PH_MASK
#define PH_MASK 0xFFFFFFFFu
#endif
#define ON(k) (((PH_MASK) >> (k)) & 1u)
#ifndef REP_MASK
#define REP_MASK 0u
#endif
#define NREP(k) ((((REP_MASK) >> (k)) & 1u) ? 2 : 1)

template <int LAYER>
__device__ __forceinline__ void common_phases(unsigned char* ws, LAS unsigned char* lds, float* dout, const XcdBarrier& bar, int lo, int hi, int bid, int G, int tid, int wave, int lane) {
    constexpr int pb = LAYER == 0 ? 5 : 13;
    const int gw = bid * NWAVES + wave, NGW = G * NWAVES;
#define IN(k) (lo <= (k) && (k) < hi)
#define SEAM(k) do { if (IN(k) && IN((k) + 1)) xcd_barrier(bar); } while (0)
    if (ON(5) && IN(pb)) {
        pg8::Gemm g{(const bf16*)(ws + (LAYER == 0 ? WS_X64 : WS_AO)), (const bf16*)(ws + (LAYER == 0 ? WS_WOUT : WS_COUT)), T, D, D, 0, nullptr}; pg8::StaticOrder S; S.init(T, D, G, bid);
        pg8::EpiBf16 E{(bf16*)(ws + WS_Z), D};
        pg8::gemm_phase<pg8::EpiBf16, pg8::StaticOrder, false>(lds, g, S, E);
    }
    SEAM(pb);
    if (ON(6) && IN(pb + 1)) { ln_router(ws, LAYER == 0 ? inp(lds, I_X) : (const float*)(ws + WS_H1), inp(lds, I_LNMG) + LAYER * D, inp(lds, I_LNMB) + LAYER * D, inp(lds, I_BGRP) + LAYER * 4, inp(lds, I_BRT) + LAYER * 32, LAYER, lds, bid, G, tid, wave, lane); __syncthreads(); }
    SEAM(pb + 1);
    if (ON(7) && IN(pb + 2)) { moe_sort(ws, lds, bid, G, tid); __syncthreads(); }
    SEAM(pb + 2);
    if (ON(8) && IN(pb + 3)) {
        const int* tile = (const int*)(ws + WS_TILE); const int ntiles = __builtin_amdgcn_readfirstlane(tile[511]);
        pg8::Gemm g{(const bf16*)(ws + WS_X64), LAYER == 0 ? (const bf16*)(ws + WS_W13) : (const bf16*)dout, 0, D, D, (size_t)D * D * 2, (const int*)(ws + WS_SLOTT)};
        pg8::GroupOrder S{tile, ntiles, D / 256, G, bid};
        pg8::EpiSwiglu E{(bf16*)(ws + WS_HID), DEXP};
        pg8::gemm_phase<pg8::EpiSwiglu, pg8::GroupOrder, true>(lds, g, S, E);
        if (LAYER == 0) idle_convert(0, ws, lds, dout, ntiles, bid, G, wave, lane);
    }
    SEAM(pb + 3);
    if (ON(9) && IN(pb + 4)) {
        const int* tile = (const int*)(ws + WS_TILE); const int ntiles = __builtin_amdgcn_readfirstlane(tile[511]);
        pg8::Gemm g{(const bf16*)(ws + WS_HID), LAYER == 0 ? (const bf16*)(ws + WS_W2) : (const bf16*)dout + (size_t)NEXP * D * D, 0, D, DEXP, (size_t)D * DEXP * 2, nullptr};
        pg8::GroupOrder S{tile, ntiles, D / 256, G, bid};
        pg8::EpiBf16 E{(bf16*)(ws + WS_Y2), D};
        pg8::gemm_phase<pg8::EpiBf16, pg8::GroupOrder, false>(lds, g, S, E);
        if (LAYER == 0) idle_convert(1, ws, lds, dout, ntiles, bid, G, wave, lane);
    }
    SEAM(pb + 4);
    if (ON(10) && IN(pb + 5)) {
        if (LAYER == 0) {
            combine_ln<false>(ws, inp(lds, I_LNFG), inp(lds, I_LNFB), nullptr, gw, NGW, lane);
            { const int done = idle_done(__builtin_amdgcn_readfirstlane(((const int*)(ws + WS_TILE))[511]), G);
              moe_convert(inp(lds, I_W1) + (size_t)NEXP * D * DEXP, inp(lds, I_W3) + (size_t)NEXP * D * DEXP, inp(lds, I_W2) + (size_t)NEXP * DEXP * D, (bf16*)dout, (bf16*)dout + (size_t)NEXP * D * D, (LAS float*)(lds + wave * 16384), done, MOE_ITEMS, gw, NGW, lane); }
            __syncthreads();
        } else combine_ln<true>(ws, inp(lds, I_LNFG) + D, inp(lds, I_LNFB) + D, dout, gw, NGW, lane);
    }
    if (LAYER == 0) SEAM(10);
#undef IN
#undef SEAM
}

struct Args { const float* in[N_IN]; float* out; unsigned char* ws; int ph_lo, ph_hi; };
static_assert(sizeof(Args) == N_IN * 8 + 8 + 8 + 8, "no padding holes in Args");

__global__ void __launch_bounds__(NTHR, 2) fwd_kernel(Args args) {
    extern __shared__ __attribute__((aligned(16))) unsigned char lds_raw[];
    LAS unsigned char* lds = (LAS unsigned char*)lds_raw;
    volatile LAS unsigned* MISC = (volatile LAS unsigned*)(lds + MISC_OFF);
    const int tid = threadIdx.x, lane = tid & 63, wave = __builtin_amdgcn_readfirstlane(tid >> 6), G = gridDim.x, bid = blockIdx.x;
    unsigned char* ws = args.ws;
    for (int u = tid; u < 64; u += NTHR) MISC[u] = 0u;
    if (tid < N_IN) *(LAS unsigned long long*)(lds + PTR_OFF + 8 * tid) = (unsigned long long)args.in[tid];
    __syncthreads();
    const int lo = args.ph_lo, hi = args.ph_hi;
    const bool use_bar = (hi - lo) > 1;
    XcdBarrier bar; bar.bar = (unsigned*)(ws + WS_CTL) + CW_BAR; bar.x = 0; bar.st = nullptr;
    if (use_bar) bar = xcd_barrier_post((unsigned*)(ws + WS_CTL) + CW_BAR, MISC + 8);
#define IN(k) (lo <= (k) && (k) < hi)
#define SEAM(k) do { if (IN(k) && IN((k) + 1)) xcd_barrier(bar); } while (0)
    const int gw = bid * NWAVES + wave, NGW = G * NWAVES;

    if (ON(0) && IN(0)) { p0_prologue(ws, lds, bid, G, tid, wave, lane); __syncthreads(); }
    SEAM(0);
    if (ON(1) && IN(1)) {
        pg8::Gemm g{(const bf16*)(ws + WS_X64), (const bf16*)(ws + WS_WIN), T, ABN, D, 0, nullptr}; pg8::SplitOrder S; S.init(T, ABN, 2, G, bid);
        pg8::EpiBf16 E{(bf16*)(ws + WS_H0), H0P};
        pg8::gemm_phase<pg8::EpiBf16, pg8::SplitOrder, false>(lds, g, S, E);
        lr_tail(ws, args.out, inp(lds, I_GATEW), inp(lds, I_GATEB), lds, bid, G, tid, wave, lane);
#ifdef TAIL_TWICE
        lr_tail(ws, args.out, inp(lds, I_GATEW), inp(lds, I_GATEB), lds, bid, G, tid, wave, lane);
#endif
    }
    SEAM(1);
    if (ON(2) && IN(2)) {
        s5_phase<1>(ws, inp(lds, I_S5D), lds, bid, G, tid, wave, lane);
#ifdef S5_TWICE
        __syncthreads(); s5_phase<1>(ws, inp(lds, I_S5D), lds, bid, G, tid, wave, lane);
#endif
        __syncthreads();
        for (int it = bid; it < 256; it += G) gla_item<1>(ws, args.out, it, lds, tid, wave, lane);
#ifdef GLA_TWICE
        for (int it = bid; it < 256; it += G) gla_item<1>(ws, args.out, it, lds, tid, wave, lane);
#endif
    }
    SEAM(2);
    if (ON(3) && IN(3)) {
        s5_phase<2>(ws, inp(lds, I_S5D), lds, bid, G, tid, wave, lane);
#ifdef S5_TWICE
        __syncthreads(); s5_phase<2>(ws, inp(lds, I_S5D), lds, bid, G, tid, wave, lane);
#endif
        __syncthreads();
        for (int it = bid; it < 256; it += G) gla_item<2>(ws, args.out, it, lds, tid, wave, lane);
#ifdef GLA_TWICE
        for (int it = bid; it < 256; it += G) gla_item<2>(ws, args.out, it, lds, tid, wave, lane);
#endif
    }
    SEAM(3);
    if (ON(4) && IN(4)) {
        gla_finalize(ws, inp(lds, I_NORMG), gw, NGW, lane);
        pg8::Gemm g{(const bf16*)(ws + WS_YG), (const bf16*)(ws + WS_WGLU), T, 512, 512, 0, nullptr}; pg8::StaticOrder S; S.init(T, 512, G, bid);
        pg8::EpiGlu E{(const bf16*)(ws + WS_YG), 512, (bf16*)(ws + WS_X64), D, inp(lds, I_GLUB)};
        pg8::gemm_phase<pg8::EpiGlu, pg8::StaticOrder, false>(lds, g, S, E);
    }
    SEAM(4);
    common_phases<0>(ws, lds, args.out, bar, lo, hi, bid, G, tid, wave, lane);
    if (ON(11) && IN(11)) {
        pg8::Gemm g{(const bf16*)(ws + WS_H2B), (const bf16*)(ws + WS_CIN), T, CN, D, 0, nullptr}; pg8::StaticOrder S; S.init(T, CN, G, bid);
        pg8::EpiBf16 E{(bf16*)(ws + WS_QKV), CN};
        pg8::gemm_phase<pg8::EpiBf16, pg8::StaticOrder, false>(lds, g, S, E);
    }
    SEAM(11);
    if (ON(12) && IN(12)) attn_phase(ws, inp(lds, I_SINK), lds, bid, G, tid, wave, lane);
    SEAM(12);
    common_phases<1>(ws, lds, args.out, bar, lo, hi, bid, G, tid, wave, lane);
#undef IN
#undef SEAM
}

extern "C" void kernel_launch(void* const* d_in, const int* in_sizes, int n_in, void* d_out, int out_size, void* d_ws, size_t ws_size, hipStream_t stream) {
    static int grid = 0;
    if (grid == 0) {
        if (n_in != N_IN || in_sizes[0] != T * D || out_size != T * D || ws_size < WS_END) { fprintf(stderr, "kernel_launch: unexpected shapes (n_in %d, in0 %d, out %d, ws %zu < %zu)\n", n_in, n_in > 0 ? in_sizes[0] : -1, out_size, ws_size, (size_t)WS_END); grid = -1; return; }
        int dev = 0, cus = 0, per_cu = 0;
        if (hipGetDevice(&dev) != hipSuccess || hipDeviceGetAttribute(&cus, hipDeviceAttributeMultiprocessorCount, dev) != hipSuccess) { grid = -1; return; }
        if (hipFuncSetAttribute((const void*)fwd_kernel, hipFuncAttributeMaxDynamicSharedMemorySize, LDS_BYTES) != hipSuccess) { fprintf(stderr, "kernel_launch: hipFuncSetAttribute failed\n"); grid = -1; return; }
        if (hipOccupancyMaxActiveBlocksPerMultiprocessor(&per_cu, (const void*)fwd_kernel, NTHR, LDS_BYTES) != hipSuccess || per_cu < 1) fprintf(stderr, "kernel_launch: occupancy query reports %d\n", per_cu);
        (void)hipGetLastError();
        grid = cus;
    }
    if (grid < 0) return;
    if (hipMemsetAsync((char*)d_ws + WS_CTL, 0, CTL_ZERO_BYTES, stream) != hipSuccess) return;
    Args a{};
    for (int i = 0; i < N_IN; ++i) a.in[i] = (const float*)d_in[i];
    a.out = (float*)d_out; a.ws = (unsigned char*)d_ws;
    for (int li = 0; li < MK_N_LAUNCHES; ++li) {
        a.ph_lo = (MK_N_LAUNCHES == 1) ? 0 : li; a.ph_hi = (MK_N_LAUNCHES == 1) ? N_PHASES : li + 1;
        for (int rep = 0; rep < ((MK_N_LAUNCHES > 1 && ((REP_MASK >> li) & 1u)) ? 2 : 1); ++rep)
            hipLaunchKernelGGL(fwd_kernel, dim3(grid), dim3(NTHR), LDS_BYTES, stream, a);
    }
}
```

```cpp
#include <hip/hip_runtime.h>
#include <cstdio>
#include <cstdint>
#include <cmath>
namespace pg8 {
#define PG8_LAS __attribute__((address_space(3)))
typedef unsigned short bf16_t;
typedef short bf16x8 __attribute__((ext_vector_type(8)));
typedef float f32x4 __attribute__((ext_vector_type(4)));
typedef float f32x2 __attribute__((ext_vector_type(2)));
typedef unsigned u32x4 __attribute__((ext_vector_type(4)));
typedef unsigned u32x2 __attribute__((ext_vector_type(2)));
constexpr int BM = 256, BK = 64, HALF = 128, HTB = HALF * BK * 2  , STAGE_BYTES = 8 * HTB, NXCD = 8, WGM = 8;

__host__ __device__ __forceinline__ int lds_byte(int r, int c) { const int st = (r >> 4) * 2 + (c >> 5), rr = r & 15, cc = c & 31, ob = rr * 64 + cc * 2; return st * 1024 + (ob ^ (((ob >> 9) & 1) << 5)); }
__host__ __device__ __forceinline__ void stage_rc(int b, int& R, int& C) { const int st = b / 1024, sb = b % 1024, swz = sb ^ (((sb >> 9) & 1) << 5); R = (st >> 1) * 16 + swz / 64; C = (st & 1) * 32 + (swz % 64) / 2; }
__host__ __device__ __forceinline__ int perm32(int rho) { const int n = rho >> 4, i = rho & 15; return 8 * (i >> 2) + 4 * n + (i & 3); }

struct Unit { int pm, pn, e, ui; };
struct Gemm { const bf16_t* A; const bf16_t* Bt; int M, N, K; size_t bstride; const int* rowmap; };

struct StaticOrder {
    int nM, nN, nwg, G, c;
    __host__ __device__ void init(int M, int N, int G_, int c_) { nM = M / BM; nN = N / BM; nwg = nM * nN; G = G_; c = c_; }
    __host__ __device__ bool next(int i, Unit& u) const {
        const long L = (long)i * G + c; if (L >= nwg) return false;
        int wgid = (int)L; { const int q = nwg / NXCD, r = nwg % NXCD, xcd = wgid % NXCD, off = wgid / NXCD; wgid = (xcd < r ? xcd * (q + 1) : r * (q + 1) + (xcd - r) * q) + off; }
        const int nig = WGM * nN, gid = wgid / nig, fm = gid * WGM, gsz = (nM - fm) < WGM ? (nM - fm) : WGM;
        u.pm = fm + ((wgid % nig) % gsz); u.pn = (wgid % nig) / gsz; u.e = 0; u.ui = i; return true;
    }
};
struct SplitOrder {
    int nM, nNs, nwgs, nsp, G, c;
    __host__ __device__ void init(int M, int N, int nsp_, int G_, int c_) { nM = M / BM; nNs = N / BM / nsp_; nwgs = nM * nNs; nsp = nsp_; G = G_; c = c_; }
    __host__ __device__ bool next(int i, Unit& u) const {
        const long L = (long)i * G + c; if (L >= (long)nwgs * nsp) return false;
        const int slab = (int)(L / nwgs); int wgid = (int)(L % nwgs);
        { const int q = nwgs / NXCD, r = nwgs % NXCD, xcd = wgid % NXCD, off = wgid / NXCD; wgid = (xcd < r ? xcd * (q + 1) : r * (q + 1) + (xcd - r) * q) + off; }
        const int nig = WGM * nNs, gid = wgid / nig, fm = gid * WGM, gsz = (nM - fm) < WGM ? (nM - fm) : WGM;
        u.pm = fm + ((wgid % nig) % gsz); u.pn = slab * nNs + (wgid % nig) / gsz; u.e = 0; u.ui = i; return true;
    }
};
struct GroupOrder {
    const int* tile_e; int ntiles, nN, G, c;
    __device__ bool next(int i, Unit& u) const {
        const int L = i * G + c; if (L >= ntiles * nN) return false;
        u.pm = L / nN; u.pn = L % nN; u.e = __builtin_amdgcn_readfirstlane(tile_e[u.pm]); u.ui = i; return true;
    }
};

typedef __bf16 bf16x2_t __attribute__((ext_vector_type(2)));
__device__ __forceinline__ unsigned cvt_pk_bf16(float lo, float hi) { f32x2 v = {lo, hi}; return __builtin_bit_cast(unsigned, __builtin_convertvector(v, bf16x2_t)); }
__device__ __forceinline__ float bf_lo(unsigned w) { return __uint_as_float(w << 16); }
__device__ __forceinline__ float bf_hi(unsigned w) { return __uint_as_float(w & 0xffff0000u); }

struct EpiBf16 {
    static constexpr bool PERM = true;
    bf16_t* O; int ldc;
    __device__ __forceinline__ void operator()(const f32x4 (&acc)[2][2][4][2], const Unit& u, int wr, int wc, int fr, int fq) const {
        const int row0 = u.pm * BM + wr * 64 + fr; const int col0 = u.pn * BM + wc * 32 + 8 * fq;
#pragma unroll
        for (int ai = 0; ai < 2; ++ai)
#pragma unroll
            for (int m = 0; m < 4; ++m) { bf16_t* rowp = O + (size_t)(row0 + ai * HALF + m * 16) * ldc + col0;
#pragma unroll
                for (int bj = 0; bj < 2; ++bj) { const f32x4 v0 = acc[ai][bj][m][0], v1 = acc[ai][bj][m][1];
                    u32x4 w; w.x = cvt_pk_bf16(v0[0], v0[1]); w.y = cvt_pk_bf16(v0[2], v0[3]); w.z = cvt_pk_bf16(v1[0], v1[1]); w.w = cvt_pk_bf16(v1[2], v1[3]);
                    *(u32x4*)(rowp + bj * HALF) = w; } }
    }
};
struct EpiGlu {
    static constexpr bool PERM = true;
    const bf16_t* Y; int ldy; bf16_t* O; int ldc; const float* bias;
    __device__ __forceinline__ void operator()(const f32x4 (&acc)[2][2][4][2], const Unit& u, int wr, int wc, int fr, int fq) const {
        const int row0 = u.pm * BM + wr * 64 + fr; const int col0 = u.pn * BM + wc * 32 + 8 * fq;
        f32x4 bv[2][2];
#pragma unroll
        for (int bj = 0; bj < 2; ++bj)
#pragma unroll
            for (int n = 0; n < 2; ++n) bv[bj][n] = *(const f32x4*)(bias + col0 + bj * HALF + 4 * n);
#pragma unroll
        for (int ai = 0; ai < 2; ++ai) {
            u32x4 yq[4][2];
#pragma unroll
            for (int m = 0; m < 4; ++m)
#pragma unroll
                for (int bj = 0; bj < 2; ++bj) yq[m][bj] = *(const u32x4*)(Y + (size_t)(row0 + ai * HALF + m * 16) * ldy + col0 + bj * HALF);
            asm volatile("" ::: "memory");
#pragma unroll
            for (int m = 0; m < 4; ++m) { const size_t r = (size_t)(row0 + ai * HALF + m * 16);
#pragma unroll
                for (int bj = 0; bj < 2; ++bj) { const f32x4 v0 = acc[ai][bj][m][0] + bv[bj][0], v1 = acc[ai][bj][m][1] + bv[bj][1];
                    const u32x4 y = yq[m][bj];
                    float o[8]; const float yv[8] = {bf_lo(y.x), bf_hi(y.x), bf_lo(y.y), bf_hi(y.y), bf_lo(y.z), bf_hi(y.z), bf_lo(y.w), bf_hi(y.w)};
#pragma unroll
                    for (int i = 0; i < 4; ++i) { o[i] = yv[i] * __builtin_amdgcn_rcpf(1.f + __expf(-v0[i])); o[4 + i] = yv[4 + i] * __builtin_amdgcn_rcpf(1.f + __expf(-v1[i])); }
                    u32x4 w; w.x = cvt_pk_bf16(o[0], o[1]); w.y = cvt_pk_bf16(o[2], o[3]); w.z = cvt_pk_bf16(o[4], o[5]); w.w = cvt_pk_bf16(o[6], o[7]);
                    *(u32x4*)(O + r * ldc + col0 + bj * HALF) = w; } }
            asm volatile("" ::: "memory");
        }
    }
};
struct EpiResid {
    static constexpr bool PERM = false;
    const float* resid; float* out; int ldc; float alpha;
    __device__ __forceinline__ void operator()(const f32x4 (&acc)[2][2][4][2], const Unit& u, int wr, int wc, int fr, int fq) const {
        const int col0 = u.pn * BM + wc * 32 + 4 * fq;
#pragma unroll
        for (int ai = 0; ai < 2; ++ai) {
            f32x4 bs[4][2][2];
#pragma unroll
            for (int m = 0; m < 4; ++m) { const size_t off = (size_t)(u.pm * BM + ai * HALF + wr * 64 + m * 16 + fr) * ldc + col0;
#pragma unroll
                for (int bj = 0; bj < 2; ++bj)
#pragma unroll
                    for (int n = 0; n < 2; ++n) bs[m][bj][n] = *(const f32x4*)(resid + off + bj * HALF + n * 16); }
            asm volatile("" ::: "memory");
#pragma unroll
            for (int m = 0; m < 4; ++m) { const size_t off = (size_t)(u.pm * BM + ai * HALF + wr * 64 + m * 16 + fr) * ldc + col0;
#pragma unroll
                for (int bj = 0; bj < 2; ++bj)
#pragma unroll
                    for (int n = 0; n < 2; ++n) *(f32x4*)(out + off + bj * HALF + n * 16) = bs[m][bj][n] * alpha + acc[ai][bj][m][n]; }
            asm volatile("" ::: "memory");
        }
    }
};
struct EpiSwiglu {
    static constexpr bool PERM = true;
    bf16_t* O; int ldc;
    __device__ __forceinline__ void operator()(const f32x4 (&acc)[2][2][4][2], const Unit& u, int wr, int wc, int fr, int fq) const {
        const int row0 = u.pm * BM + wr * 64 + fr; const int col0 = (u.pn * BM + wc * 32 + 8 * fq) >> 1;
#pragma unroll
        for (int ai = 0; ai < 2; ++ai)
#pragma unroll
            for (int m = 0; m < 4; ++m) { bf16_t* rowp = O + (size_t)(row0 + ai * HALF + m * 16) * ldc + col0;
#pragma unroll
                for (int bj = 0; bj < 2; ++bj) { const f32x4 g = acc[ai][bj][m][0], up = acc[ai][bj][m][1]; float o[4];
#pragma unroll
                    for (int i = 0; i < 4; ++i) o[i] = g[i] * __builtin_amdgcn_rcpf(1.f + __expf(-g[i])) * up[i];
                    u32x2 w; w.x = cvt_pk_bf16(o[0], o[1]); w.y = cvt_pk_bf16(o[2], o[3]);
                    *(u32x2*)(rowp + bj * (HALF / 2)) = w; } }
    }
};
struct EpiScale {
    static constexpr bool PERM = true;
    bf16_t* O; int ldc; const float* rw;
    __device__ __forceinline__ void operator()(const f32x4 (&acc)[2][2][4][2], const Unit& u, int wr, int wc, int fr, int fq) const {
        const int row0 = u.pm * BM + wr * 64 + fr; const int col0 = u.pn * BM + wc * 32 + 8 * fq;
        float sw[2][4];
#pragma unroll
        for (int ai = 0; ai < 2; ++ai)
#pragma unroll
            for (int m = 0; m < 4; ++m) sw[ai][m] = rw[row0 + ai * HALF + m * 16];
        asm volatile("" ::: "memory");
#pragma unroll
        for (int ai = 0; ai < 2; ++ai)
#pragma unroll
            for (int m = 0; m < 4; ++m) { const int r = row0 + ai * HALF + m * 16; const float s = sw[ai][m]; bf16_t* rowp = O + (size_t)r * ldc + col0;
#pragma unroll
                for (int bj = 0; bj < 2; ++bj) { const f32x4 v0 = acc[ai][bj][m][0] * s, v1 = acc[ai][bj][m][1] * s;
                    u32x4 w; w.x = cvt_pk_bf16(v0[0], v0[1]); w.y = cvt_pk_bf16(v0[2], v0[3]); w.z = cvt_pk_bf16(v1[0], v1[1]); w.w = cvt_pk_bf16(v1[2], v1[3]);
                    *(u32x4*)(rowp + bj * HALF) = w; } }
    }
};

template <class Epi, class Sched, bool GATHER>
__device__ __forceinline__ void gemm_phase(PG8_LAS unsigned char* lds, const Gemm g, const Sched& S, const Epi& E) {
    const int tid = threadIdx.x, wid = __builtin_amdgcn_readfirstlane(tid >> 6), lane = tid & 63, wr = wid >> 2, wc = wid & 3, fr = lane & 15, fq = lane >> 4;
    const int K = g.K, nt = K / BK;
    unsigned voffA[2], voffB[2]; int RA[2], CA[2];
#pragma unroll
    for (int i = 0; i < 2; ++i) { int R, C; stage_rc(tid * 16 + i * 8192, R, C); const int Rb = Epi::PERM ? ((R & ~31) + perm32(R & 31)) : R;
        voffA[i] = (unsigned)(R * K + C) * 2u; voffB[i] = (unsigned)(Rb * K + C) * 2u; RA[i] = R; CA[i] = C; }
    const size_t kstep = (size_t)(BK * 2);
    const size_t hstep = (size_t)HALF * K * 2;
    const size_t tstep = 2 * hstep;
    const unsigned ldsw = (unsigned)wid * 1024u;
    const int aoff = lds_byte(wr * 64 + fr, fq * 8), boff = lds_byte(wc * 32 + fr, fq * 8);
#define PG8_SA(b, h) (((b) * 2 + (h)) * HTB)
#define PG8_SB(b, h) ((4 + (b) * 2 + (h)) * HTB)
#define PG8_STAGE(bufoff, gbase, voff) do { _Pragma("unroll") for (int _i = 0; _i < 2; ++_i) \
        __builtin_amdgcn_global_load_lds((const unsigned*)((const char*)(gbase) + (voff)[_i]), (PG8_LAS unsigned*)(lds + (bufoff) + ldsw + _i * 8192), 16, 0, 0); } while (0)
#define PG8_LDA(dst, b, h) do { _Pragma("unroll") for (int m = 0; m < 4; ++m) _Pragma("unroll") for (int k = 0; k < 2; ++k) dst[m][k] = *(const PG8_LAS bf16x8*)(lds + PG8_SA(b, h) + aoff + m * 2048 + k * 1024); } while (0)
#define PG8_LDB(dst, b, h) do { _Pragma("unroll") for (int n = 0; n < 2; ++n) _Pragma("unroll") for (int k = 0; k < 2; ++k) dst[n][k] = *(const PG8_LAS bf16x8*)(lds + PG8_SB(b, h) + boff + n * 2048 + k * 1024); } while (0)
#define PG8_MMA(ai, bj, At, Bt) do { __builtin_amdgcn_s_setprio(1); _Pragma("unroll") for (int m = 0; m < 4; ++m) _Pragma("unroll") for (int n = 0; n < 2; ++n) _Pragma("unroll") for (int k = 0; k < 2; ++k) \
        acc[ai][bj][m][n] = __builtin_amdgcn_mfma_f32_16x16x32_bf16(Bt[n][k], At[m][k], acc[ai][bj][m][n], 0, 0, 0); __builtin_amdgcn_s_setprio(0); } while (0)
#define PG8_WAIT_V(n) asm volatile("s_waitcnt vmcnt(" #n ")" ::: "memory")
#define PG8_WAIT_L(n) asm volatile("s_waitcnt lgkmcnt(" #n ")" ::: "memory")
#define PG8_BAR __builtin_amdgcn_s_barrier()
#define PG8_SCHED __builtin_amdgcn_sched_barrier(0)
    Unit cur, nxt; int ui = 0;
    const PG8_LAS int* rmap = (const PG8_LAS int*)(lds + STAGE_BYTES);
    if (GATHER) { Unit t_; for (int i_ = 0; S.next(i_, t_) && i_ < 16; ++i_) { if (tid < BM) ((PG8_LAS int*)(lds + STAGE_BYTES))[i_ * BM + tid] = g.rowmap[t_.pm * BM + tid]; }
        asm volatile("s_waitcnt vmcnt(0) lgkmcnt(0)" ::: "memory"); __builtin_amdgcn_s_barrier(); asm volatile("" ::: "memory"); }
    if (!S.next(0, cur)) return;
    f32x4 acc[2][2][4][2];
#pragma unroll
    for (int a = 0; a < 2; ++a)
#pragma unroll
        for (int b = 0; b < 2; ++b)
#pragma unroll
            for (int m = 0; m < 4; ++m)
#pragma unroll
                for (int n = 0; n < 2; ++n) acc[a][b][m][n] = (f32x4){0.f, 0.f, 0.f, 0.f};
    bf16x8 At[4][2], B0[2][2], B1[2][2];
    unsigned cG[2][2], nG[2][2];
#define PG8_LOAD_ROWS(u_, G2_) do { _Pragma("unroll") for (int h_ = 0; h_ < 2; ++h_) _Pragma("unroll") for (int i_ = 0; i_ < 2; ++i_) \
        G2_[h_][i_] = GATHER ? ((unsigned)rmap[(u_).ui * BM + h_ * HALF + RA[i_]] * (unsigned)K + (unsigned)CA[i_]) * 2u : voffA[i_]; } while (0)
    const char* cA = GATHER ? (const char*)g.A : (const char*)g.A + (size_t)cur.pm * tstep;
    const size_t hA = GATHER ? 0 : hstep;
    const char* cB = (const char*)g.Bt + (size_t)cur.e * g.bstride + (size_t)cur.pn * tstep;
    PG8_LOAD_ROWS(cur, cG);
    PG8_STAGE(PG8_SB(0, 0), cB, voffB); PG8_STAGE(PG8_SB(0, 1), cB + hstep, voffB); PG8_STAGE(PG8_SA(0, 0), cA, cG[0]); PG8_STAGE(PG8_SA(0, 1), cA + hA, cG[1]);
    if (wr == 1) PG8_BAR;
    PG8_WAIT_V(2); PG8_BAR;
    PG8_STAGE(PG8_SB(1, 0), cB + kstep, voffB); PG8_STAGE(PG8_SA(1, 0), cA + kstep, cG[0]); PG8_STAGE(PG8_SB(1, 1), cB + hstep + kstep, voffB);
    PG8_WAIT_V(6); PG8_BAR;
    for (;;) {
        const bool has_next = S.next(ui + 1, nxt);
        const char* nA = GATHER ? (const char*)g.A : (has_next ? (const char*)g.A + (size_t)nxt.pm * tstep : cA);
        const char* nB = has_next ? (const char*)g.Bt + (size_t)nxt.e * g.bstride + (size_t)nxt.pn * tstep : cB;
        if (has_next) PG8_LOAD_ROWS(nxt, nG); else {
#pragma unroll
            for (int h = 0; h < 2; ++h) { nG[h][0] = cG[h][0]; nG[h][1] = cG[h][1]; } }
        for (int t = 0; t < nt; t += 2) {
            const bool last = (t == nt - 2);
            const char* a1 = cA + (size_t)(t + 1) * kstep;
            const char* a2 = last ? nA : cA + (size_t)(t + 2) * kstep; const char* b2 = last ? nB : cB + (size_t)(t + 2) * kstep;
            const char* a3 = a2 + kstep; const char* b3 = b2 + kstep;
            unsigned sG[2][2];
#pragma unroll
            for (int h = 0; h < 2; ++h) { sG[h][0] = (GATHER && last) ? nG[h][0] : cG[h][0]; sG[h][1] = (GATHER && last) ? nG[h][1] : cG[h][1]; }
            PG8_LDB(B0, 0, 0); PG8_LDB(B1, 0, 1); PG8_SCHED; PG8_LDA(At, 0, 0); PG8_STAGE(PG8_SA(1, 1), a1 + hA, cG[1]);
            PG8_WAIT_V(8); PG8_WAIT_L(0); PG8_BAR; PG8_MMA(0, 0, At, B0); PG8_MMA(0, 1, At, B1); PG8_BAR; PG8_SCHED;
            PG8_LDA(At, 0, 1); PG8_STAGE(PG8_SB(0, 0), b2, voffB); PG8_STAGE(PG8_SB(0, 1), b2 + hstep, voffB); PG8_STAGE(PG8_SA(0, 0), a2, sG[0]);
            PG8_WAIT_V(8); PG8_WAIT_L(0); PG8_BAR; PG8_MMA(1, 0, At, B0); PG8_MMA(1, 1, At, B1); PG8_BAR; PG8_SCHED;
            PG8_LDB(B0, 1, 0); PG8_LDB(B1, 1, 1); PG8_SCHED; PG8_LDA(At, 1, 0); PG8_STAGE(PG8_SA(0, 1), a2 + hA, sG[1]);
            PG8_WAIT_V(8); PG8_WAIT_L(0); PG8_BAR; PG8_MMA(0, 0, At, B0); PG8_MMA(0, 1, At, B1); PG8_BAR; PG8_SCHED;
            PG8_LDA(At, 1, 1); PG8_STAGE(PG8_SB(1, 0), b3, voffB); PG8_STAGE(PG8_SB(1, 1), b3 + hstep, voffB); PG8_STAGE(PG8_SA(1, 0), a3, sG[0]);
            PG8_WAIT_V(8); PG8_WAIT_L(0); PG8_BAR; PG8_MMA(1, 0, At, B0); PG8_MMA(1, 1, At, B1); PG8_BAR; PG8_SCHED;
        }
        if (wr == 0) PG8_BAR;
        E(acc, cur, wr, wc, fr, fq);
        if (!has_next) break;
#pragma unroll
        for (int a = 0; a < 2; ++a)
#pragma unroll
            for (int b = 0; b < 2; ++b)
#pragma unroll
                for (int m = 0; m < 4; ++m)
#pragma unroll
                    for (int n = 0; n < 2; ++n) acc[a][b][m][n] = (f32x4){0.f, 0.f, 0.f, 0.f};
        cur = nxt; cA = nA; cB = nB; ++ui;
#pragma unroll
        for (int h = 0; h < 2; ++h) { cG[h][0] = nG[h][0]; cG[h][1] = nG[h][1]; }
        if (wr == 1) PG8_BAR;
    }
    PG8_WAIT_V(0);
    PG8_BAR;
#undef PG8_LOAD_ROWS
#undef PG8_SA
#undef PG8_SB
#undef PG8_STAGE
#undef PG8_LDA
#undef PG8_LDB
#undef PG8_MMA
#undef PG8_WAIT_V
#undef PG8_WAIT_L
#undef PG8_BAR
#undef PG8_SCHED
}
}
constexpr int NB = 2, SEQ = 16384, T = NB * SEQ, D = 1024;
constexpr int H0P = 2112;
constexpr int ABN = 2048, OFF_U = 0, OFF_Q = 512, OFF_K = 768, OFF_V = 1024, OFF_GO = 1536, AB_IN = 2080;
constexpr int CN = 1536;
constexpr int NEXP = 32, DEXP = 512, CAP = 2 * T + NEXP * 256, MAXTILES = CAP / 256;
constexpr int S5CH = 256, S5NCH = SEQ / S5CH;
constexpr int GSC = 16, GCH = 64, GNSC = SEQ / (GSC * GCH);
constexpr float ALPHA = 1.41421356237309515f;
constexpr float LN_EPS = 1e-5f, RMS_EPS = 1e-6f, LOG2E = 1.44269504088896341f;
constexpr int NWAVES = 8, NTHR = 512;

constexpr size_t MiB = 1u << 20, KiB = 1u << 10;
constexpr size_t WS_CTL = 0, CTL_ZERO_BYTES = 64 * KiB;
constexpr int CW_BAR = 4096;
constexpr size_t WS_LR = 1 * MiB;
constexpr size_t WS_S5E = 5 * MiB;
constexpr size_t WS_GS = 9 * MiB;
constexpr size_t WS_GD = 17 * MiB;
constexpr size_t WS_S5L = WS_GD + 64 * KiB;
constexpr size_t WS_S5B = WS_S5L + 64 * KiB;
constexpr size_t WS_S5C = WS_S5B + 256 * KiB;
constexpr size_t WS_BTAB = WS_S5C + 256 * KiB;
constexpr size_t WS_WR = WS_BTAB + 32 * KiB;
constexpr size_t WS_TOKE = WS_WR + 384 * KiB;
constexpr size_t WS_TOKW = WS_TOKE + 256 * KiB;
constexpr size_t WS_TOKS = WS_TOKW + 256 * KiB;
constexpr size_t WS_SLOTT = WS_TOKS + 256 * KiB;
constexpr size_t WS_SLOTW = WS_SLOTT + 288 * KiB;
constexpr size_t WS_BLKC = WS_SLOTW + 288 * KiB;
constexpr size_t WS_TILE = WS_BLKC + 32 * KiB;
static_assert(WS_TILE + 4 * KiB <= 32 * MiB, "param region");
constexpr size_t WS_WIN = 32 * MiB, WS_WLR = 36 * MiB, WS_WGLU = 37 * MiB, WS_WOUT = 38 * MiB, WS_CIN = 40 * MiB, WS_COUT = 43 * MiB;
constexpr size_t WS_W13 = 48 * MiB, WS_W2 = 112 * MiB;
constexpr size_t A0 = 144 * MiB;
constexpr size_t WS_H1 = A0, WS_HLO = A0, WS_HHI = A0 + 64 * MiB, WS_H0 = A0;
constexpr size_t WS_Z = A0 + 128 * MiB;
constexpr size_t WS_YG = A0 + 136 * MiB, WS_OF = A0 + 168 * MiB, WS_OB = A0 + 320 * MiB;
constexpr size_t WS_YSCR = A0 + 232 * MiB;
constexpr size_t WS_X64 = A0 + 256 * MiB;
constexpr size_t WS_HID = A0 + 128 * MiB;
constexpr size_t WS_Y2 = A0 + 200 * MiB;
constexpr size_t WS_H2B = WS_HHI;
constexpr size_t WS_QKV = A0 + 192 * MiB;
constexpr size_t WS_AO = A0 + 288 * MiB;
constexpr size_t WS_END = A0 + 384 * MiB;
static_assert((size_t)T * H0P * 2 <= 136 * MiB && WS_Y2 + (size_t)CAP * D * 2 <= WS_END && WS_OB + (size_t)T * 512 * 4 <= WS_END && WS_HID + (size_t)CAP * 512 * 2 <= WS_Y2, "act map");

constexpr int RING_BYTES = 131072;
constexpr int MISC_OFF = 163840 - 1024;
constexpr int PTR_OFF = MISC_OFF + 256;
constexpr int LDS_BYTES = 163840;

#define GAS __attribute__((address_space(1)))
#define LAS __attribute__((address_space(3)))
typedef unsigned short bf16;
typedef float f32x4 __attribute__((ext_vector_type(4)));
typedef float f32x2 __attribute__((ext_vector_type(2)));
typedef float f32x16 __attribute__((ext_vector_type(16)));
typedef short bf16x8 __attribute__((ext_vector_type(8)));
typedef short bf16x4 __attribute__((ext_vector_type(4)));
typedef unsigned u32x4 __attribute__((ext_vector_type(4)));
typedef unsigned u32x2 __attribute__((ext_vector_type(2)));
#define LDS_WAIT() asm volatile("s_waitcnt lgkmcnt(0)" ::: "memory")
#define VM_WAIT() asm volatile("s_waitcnt vmcnt(0)" ::: "memory")
#define LDS_BARRIER() do { asm volatile("s_waitcnt lgkmcnt(0)" ::: "memory"); __builtin_amdgcn_s_barrier(); asm volatile("" ::: "memory"); } while (0)
typedef __bf16 bf16x2_t __attribute__((ext_vector_type(2)));
__device__ __forceinline__ unsigned pk2(float lo, float hi) { f32x2 v = {lo, hi}; return __builtin_bit_cast(unsigned, __builtin_convertvector(v, bf16x2_t)); }
__device__ __forceinline__ unsigned f2bf(float f) { return pk2(f, 0.f) & 0xffffu; }
__device__ __forceinline__ float bf2f(unsigned short b) { return __uint_as_float((unsigned)b << 16); }
__device__ __forceinline__ float bflo(unsigned w) { return __uint_as_float(w << 16); }
__device__ __forceinline__ float bfhi(unsigned w) { return __uint_as_float(w & 0xffff0000u); }
__device__ __forceinline__ float wave_sum(float v) {
#pragma unroll
    for (int o = 1; o < 64; o <<= 1) v += __shfl_xor(v, o);
    return v;
}
__device__ __forceinline__ int crow(int r, int hi) { return (r & 3) + 8 * (r >> 2) + 4 * hi; }

#define XB_TMO      128
#define XB_XCNT(j)  (256  + 64 * (j))
#define XB_XSUB(j)  (1280 + 64 * (j))
#define XB_XGEN(j)  (2304 + 64 * (j))
#define XB_TOP      3328
#define XB_TOPGEN   3392
#define XCD_BAR_WORDS 3456
#define XB_SPIN_CAP (1u << 18)
__device__ __forceinline__ unsigned xb_ld(unsigned* p)              { return __hip_atomic_load(p, __ATOMIC_RELAXED, __HIP_MEMORY_SCOPE_AGENT); }
__device__ __forceinline__ unsigned xb_add(unsigned* p, unsigned v) { return __hip_atomic_fetch_add(p, v, __ATOMIC_RELAXED, __HIP_MEMORY_SCOPE_AGENT); }
__device__ __forceinline__ unsigned xb_xcc_id() { return (unsigned)__builtin_amdgcn_s_getreg((3 << 11) | 20) & 0xFu; }
#define XB_SPIN(cond, bar) do { unsigned _sp = 0; while (cond) { __builtin_amdgcn_s_sleep(1); \
    if ((++_sp & 255u) == 0u) { if (xb_ld(&(bar)[XB_TMO])) break; if (_sp > XB_SPIN_CAP) { atomicAdd(&(bar)[XB_TMO], 1u); break; } } } } while (0)
struct XcdBarrier { unsigned* bar; unsigned x; volatile LAS unsigned* st; };
__device__ __forceinline__ XcdBarrier xcd_barrier_post(unsigned* bar, volatile LAS unsigned* st) {
    XcdBarrier b; b.bar = bar; b.x = xb_xcc_id(); b.st = st;
    if (threadIdx.x == 0) (void)xb_add(&bar[XB_XCNT(b.x)], 1u);
    return b;
}
__device__ __forceinline__ void xcd_barrier_complete(unsigned* bar, unsigned x, unsigned& nloc, unsigned& nx) {
    const unsigned G = gridDim.x * gridDim.y * gridDim.z;
    unsigned sum, cnt, mine, sp = 0u;
    for (;;) {
        sum = 0u; cnt = 0u; mine = 0u;
#pragma unroll
        for (unsigned j = 0; j < 16; ++j) { const unsigned c = xb_ld(&bar[XB_XCNT(j)]); sum += c; cnt += (c > 0u) ? 1u : 0u; mine = (j == x) ? c : mine; }
        if (sum == G) break;
        __builtin_amdgcn_s_sleep(1);
        if ((++sp & 255u) == 0u) { if (xb_ld(&bar[XB_TMO])) break; if (sp > XB_SPIN_CAP) { atomicAdd(&bar[XB_TMO], 1u); break; } }
    }
    nloc = mine > 0u ? mine : 1u; nx = cnt > 0u ? cnt : 1u;
}
__device__ __forceinline__ void xcd_barrier(const XcdBarrier& b) {
    asm volatile("s_waitcnt vmcnt(0)" ::: "memory");
    __syncthreads();
    if (threadIdx.x == 0) {
        unsigned* bar = b.bar;
        __builtin_amdgcn_s_waitcnt(0);
        unsigned nloc = b.st[0], nx = b.st[1];
        if (nloc == 0u) { xcd_barrier_complete(bar, b.x, nloc, nx); b.st[0] = nloc; b.st[1] = nx; }
        const unsigned old = xb_add(&bar[XB_XSUB(b.x)], 1u);
        const unsigned gen = old / nloc;
        if (old + 1u == (gen + 1u) * nloc) {
            __builtin_amdgcn_fence(__ATOMIC_RELEASE, "agent");
            asm volatile("s_waitcnt vmcnt(0)" ::: "memory");
            const unsigned og = xb_add(&bar[XB_TOP], 1u);
            const unsigned tg = og / nx;
            if (og + 1u == (tg + 1u) * nx) xb_add(&bar[XB_TOPGEN], 1u);
            else XB_SPIN(xb_ld(&bar[XB_TOPGEN]) == tg, bar);
            __builtin_amdgcn_fence(__ATOMIC_ACQUIRE, "agent");
            xb_add(&bar[XB_XGEN(b.x)], 1u);
            asm volatile("s_waitcnt vmcnt(0)" ::: "memory");
        } else {
            XB_SPIN(xb_ld(&bar[XB_XGEN(b.x)]) == gen, bar);
            __builtin_amdgcn_fence(__ATOMIC_ACQUIRE, "agent");
            asm volatile("s_waitcnt vmcnt(0)" ::: "memory");
        }
    }
    __syncthreads();
}

struct Frame {
    LAS unsigned char* lds;
    int tid, lane, wave, G, bid;
    unsigned char* ws;
    const float* const* in;
};
enum InIdx { I_X = 0, I_LNMG, I_LNMB, I_LNFG, I_LNFB, I_ABWIN, I_LAMRE, I_LAMIM, I_LOGDT, I_BRE, I_BIM, I_CRE, I_CIM, I_S5D, I_GLUW, I_GLUB,
             I_GATEW, I_GATEB, I_NORMG, I_ABWOUT, I_CWIN, I_SINK, I_CWOUT, I_RELB, I_WGRP, I_BGRP, I_WRT, I_BRT, I_W1, I_W3, I_W2, N_IN };

__device__ __forceinline__ const float* inp(LAS unsigned char* lds, int k) {
    const LAS unsigned* p = (const LAS unsigned*)(lds + PTR_OFF) + 2 * k;
    const unsigned lo = __builtin_amdgcn_readfirstlane(p[0]), hi = __builtin_amdgcn_readfirstlane(p[1]);
    return (const float*)(const GAS float*)(((unsigned long long)hi << 32) | (unsigned long long)lo);
}
__device__ __forceinline__ void tr_item(const float* W, int ldw, bf16* WT, int ldt, int rowmode, LAS float* scr, int item, int nblk, int lane) {
    const int kb = item / nblk, nb = item % nblk, k0 = 64 * kb, n0 = 32 * nb;
    float tv[32];
    const float* wp = W + (size_t)(k0 + (lane >> 5)) * ldw + n0 + (lane & 31);
#pragma unroll
    for (int i = 0; i < 32; ++i) tv[i] = wp[(size_t)(2 * i) * ldw];
#pragma unroll
    for (int i = 0; i < 32; ++i) scr[(2 * i + (lane >> 5)) * 33 + (lane & 31)] = tv[i];
    LDS_WAIT(); asm volatile("" ::: "memory");
    const int c = lane & 7;
#pragma unroll
    for (int j = 0; j < 4; ++j) { const int n = (lane >> 3) + 8 * j; const LAS float* s = scr + (8 * c) * 33 + n;
        u32x4 o; o.x = pk2(s[0 * 33], s[1 * 33]); o.y = pk2(s[2 * 33], s[3 * 33]); o.z = pk2(s[4 * 33], s[5 * 33]); o.w = pk2(s[6 * 33], s[7 * 33]);
        const int ng = n0 + n; const int dr = rowmode == 0 ? ng : (8 * (ng >> 2) + (ng & 3) + (rowmode == 2 ? 4 : 0));
        *(GAS u32x4*)(WT + (size_t)dr * ldt + k0 + 8 * c) = o; }
    LDS_WAIT(); asm volatile("" ::: "memory");
}
__device__ __forceinline__ void moe_convert(const float* w1, const float* w3, const float* w2, bf16* W13, bf16* W2T, LAS float* scr, int it0, int it1, int gw, int NGW, int lane) {
    constexpr int PER_E = 768;
    for (int it = it0 + gw; it < it1; it += NGW) {
        const int e = it / PER_E; int r = it % PER_E;
        if (r < 256) tr_item(w1 + (size_t)e * D * DEXP, DEXP, W13 + (size_t)e * D * D, D, 1, scr, r, DEXP / 32, lane);
        else if (r < 512) tr_item(w3 + (size_t)e * D * DEXP, DEXP, W13 + (size_t)e * D * D, D, 2, scr, r - 256, DEXP / 32, lane);
        else tr_item(w2 + (size_t)e * DEXP * D, D, W2T + (size_t)e * D * DEXP, DEXP, 0, scr, r - 512, D / 32, lane);
    }
}
constexpr int MOE_ITEMS = NEXP * 768, IDLE_Q8 = 88, IDLE_Q9 = 56;
__device__ __forceinline__ void idle_convert(int which, unsigned char* ws, LAS unsigned char* lds, float* dout, int ntiles, int bid, int G, int wave, int lane) {
    const int U = ntiles * (D / 256), rem = U % G; if (rem == 0 || bid < rem) return;
    const int n_idle = G - rem, rank = bid - rem;
    int q8 = n_idle * IDLE_Q8; q8 = q8 < MOE_ITEMS ? q8 : MOE_ITEMS; int q9 = n_idle * IDLE_Q9; q9 = (q8 + q9) < MOE_ITEMS ? q9 : (MOE_ITEMS - q8);
    const int per = which == 0 ? IDLE_Q8 : IDLE_Q9, base = which == 0 ? 0 : q8, lim = which == 0 ? q8 : q8 + q9;
    int lo = base + rank * per, hi = lo + per; hi = hi < lim ? hi : lim;
    moe_convert(inp(lds, I_W1) + (size_t)NEXP * D * DEXP, inp(lds, I_W3) + (size_t)NEXP * D * DEXP, inp(lds, I_W2) + (size_t)NEXP * DEXP * D,
                (bf16*)dout, (bf16*)dout + (size_t)NEXP * D * D, (LAS float*)(lds + wave * 16384), lo, hi, wave, NWAVES, lane);
}
__device__ __forceinline__ int idle_done(int ntiles, int G) {
    const int U = ntiles * (D / 256), rem = U % G; if (rem == 0) return 0;
    const int n_idle = G - rem; int q = n_idle * (IDLE_Q8 + IDLE_Q9); return q < MOE_ITEMS ? q : MOE_ITEMS;
}
__device__ __forceinline__ int t5_bucket(int rel) {
    const int nb = 16, max_exact = 8; int ret = rel > 0 ? nb : 0; const int n = rel < 0 ? -rel : rel;
    const float lg = logf((float)(n < 1 ? 1 : n) / 8.0f) / 2.7725887f * 8.0f;
    int large = max_exact + (int)lg; large = large < nb - 1 ? large : nb - 1;
    return ret + (n < max_exact ? n : large);
}
__device__ __forceinline__ void p0_prologue(unsigned char* ws, LAS unsigned char* lds, int bid, int G, int tid, int wave, int lane) {
    LAS float* scr = (LAS float*)(lds + wave * 16384);
    const int gw = bid * NWAVES + wave, NGW = G * NWAVES;
    constexpr int I0 = 16 * 64, I1 = 16, I2 = 8 * 16, I3 = 16 * 32, I4 = 16 * 48, I5 = 16 * 32, NIT = I0 + I1 + I2 + I3 + I4 + I5;
    for (int it = gw; it < NIT; it += NGW) {
        int r = it;
        if (r < I0) { tr_item(inp(lds, I_ABWIN), AB_IN, (bf16*)(ws + WS_WIN), D, 0, scr, r, 64, lane); continue; } r -= I0;
        if (r < I1) { tr_item(inp(lds, I_ABWIN) + 2048, AB_IN, (bf16*)(ws + WS_WLR), D, 0, scr, r, 1, lane); continue; } r -= I1;
        if (r < I2) { tr_item(inp(lds, I_GLUW), 512, (bf16*)(ws + WS_WGLU), 512, 0, scr, r, 16, lane); continue; } r -= I2;
        if (r < I3) { tr_item(inp(lds, I_ABWOUT), D, (bf16*)(ws + WS_WOUT), D, 0, scr, r, 32, lane); continue; } r -= I3;
        if (r < I4) { tr_item(inp(lds, I_CWIN), CN, (bf16*)(ws + WS_CIN), D, 0, scr, r, 48, lane); continue; } r -= I4;
        tr_item(inp(lds, I_CWOUT), D, (bf16*)(ws + WS_COUT), D, 0, scr, r, 32, lane);
    }
    moe_convert(inp(lds, I_W1), inp(lds, I_W3), inp(lds, I_W2), (bf16*)(ws + WS_W13), (bf16*)(ws + WS_W2), scr, 0, MOE_ITEMS, gw, NGW, lane);
    { const float* x = inp(lds, I_X); bf16* xb = (bf16*)(ws + WS_X64);
      for (int m = gw; m < T; m += 2 * NGW) { const int m2 = m + NGW;
          const GAS f32x4* xr = (const GAS f32x4*)(x + (size_t)m * D) + lane; GAS u32x2* o = (GAS u32x2*)(xb + (size_t)m * D) + lane;
          const GAS f32x4* xr2 = (const GAS f32x4*)(x + (size_t)m2 * D) + lane; GAS u32x2* o2 = (GAS u32x2*)(xb + (size_t)m2 * D) + lane;
          f32x4 v[4], v2[4];
#pragma unroll
          for (int j = 0; j < 4; ++j) { v[j] = xr[64 * j]; if (m2 < T) v2[j] = xr2[64 * j]; }
#pragma unroll
          for (int j = 0; j < 4; ++j) { u32x2 w; w.x = pk2(v[j].x, v[j].y); w.y = pk2(v[j].z, v[j].w); o[64 * j] = w;
              if (m2 < T) { u32x2 w2; w2.x = pk2(v2[j].x, v2[j].y); w2.y = pk2(v2[j].z, v2[j].w); o2[64 * j] = w2; } } } }
    const int gt = bid * NTHR + tid, NGT = G * NTHR;
    { const float* lamre = inp(lds, I_LAMRE); const float* lamim = inp(lds, I_LAMIM); const float* logdt = inp(lds, I_LOGDT); const float* bre = inp(lds, I_BRE); const float* bim = inp(lds, I_BIM);
    for (int i = tid * G + bid; i < 2 * 32 * 64; i += NTHR * G) {
        const int p = i & 63, g = (i >> 6) & 31, dir = i >> 11;
        const double lr = fmin((double)lamre[i], -1e-4), li = (double)lamim[i], dt = exp((double)logdt[dir * 32 + g]);
        const double mag = exp(lr * dt), ar = mag * cos(li * dt), ai = mag * sin(li * dt), den = lr * lr + li * li, nr = ar - 1.0;
        const double cr = (nr * lr + ai * li) / den, ci = (ai * lr - nr * li) / den;
        double qr = ar, qi = ai;
#pragma unroll 1
        for (int s = 1; s < S5CH; s <<= 1) { const double t = qr * qr - qi * qi; qi = 2.0 * qr * qi; qr = t; }
        float* L4 = (float*)(ws + WS_S5L) + (size_t)i * 4; L4[0] = (float)ar; L4[1] = (float)ai; L4[2] = (float)qr; L4[3] = (float)qi;
        bf16* Bb = (bf16*)(ws + WS_S5B) + (size_t)(dir * 32 + g) * 2048;
#pragma unroll 4
        for (int c = 0; c < 16; ++c) { const double br = bre[(size_t)i * 16 + c], bi = bim[(size_t)i * 16 + c];
            Bb[p * 16 + c] = (bf16)f2bf((float)(cr * br - ci * bi)); Bb[1024 + p * 16 + c] = (bf16)f2bf((float)(cr * bi + ci * br)); }
    } }
    { const float* cre = inp(lds, I_CRE); const float* cim = inp(lds, I_CIM);
    for (int i = gt; i < 2 * 32 * 16 * 64; i += NGT) {
        const int p = i & 63, c = (i >> 6) & 15, dg = i >> 10;
        bf16* Cm = (bf16*)(ws + WS_S5C) + (size_t)dg * 2048 + c * 128 + 2 * p;
        Cm[0] = (bf16)f2bf(cre[i]); Cm[1] = (bf16)f2bf(-cim[i]);
    } }
    { const float* relb = inp(lds, I_RELB);
    for (int i = gt; i < 16 * 257; i += NGT) { const int h = i / 257, r = i % 257; ((float*)(ws + WS_BTAB))[h * 260 + r] = relb[t5_bucket(r - 128) * 16 + h] * LOG2E; } }
    { const float* wgrp = inp(lds, I_WGRP); const float* wrt = inp(lds, I_WRT);
    for (int i = gt; i < 2 * 48 * 1024; i += NGT) {
        const int k = i & 1023, n = (i >> 10) % 48, l = i / (48 * 1024);
        const float w = n < 4 ? wgrp[(size_t)l * D * 4 + k * 4 + n] : (n < 36 ? wrt[(size_t)l * D * 32 + k * 32 + (n - 4)] : 0.f);
        const unsigned hi = f2bf(w); const float lo = w - __uint_as_float(hi << 16);
        bf16* Wr = (bf16*)(ws + WS_WR) + (size_t)l * 2 * 48 * 1024; Wr[n * 1024 + k] = (bf16)hi; Wr[48 * 1024 + n * 1024 + k] = (bf16)f2bf(lo);
    } }
}

__device__ __forceinline__ void gate_tail(float* bcg, const float* gate_w, const float* gate_b, const LAS float* lrs, size_t row0, int tid);
__device__ __forceinline__ void lr_tail(unsigned char* ws, float* bcg, const float* gate_w, const float* gate_b, LAS unsigned char* lds, int bid, int G, int tid, int wave, int lane) {
    const bf16* xb = (const bf16*)(ws + WS_X64); const bf16* wl = (const bf16*)(ws + WS_WLR); LAS float* lrs = (LAS float*)lds;
    for (int rt = bid; rt < T / 128; rt += G) {
        const int r0 = rt * 128 + wave * 16;
        f32x4 acc0 = {0.f, 0.f, 0.f, 0.f}, acc1 = {0.f, 0.f, 0.f, 0.f};
        const bf16* ap = xb + (size_t)(r0 + (lane & 15)) * D + 8 * (lane >> 4);
        const bf16* bp = wl + (size_t)(lane & 15) * D + 8 * (lane >> 4);
#pragma unroll 8
        for (int ks = 0; ks < 32; ++ks) {
            const bf16x8 a = *(const bf16x8*)(ap + ks * 32), b0 = *(const bf16x8*)(bp + ks * 32), b1 = *(const bf16x8*)(bp + 16 * D + ks * 32);
            acc0 = __builtin_amdgcn_mfma_f32_16x16x32_bf16(a, b0, acc0, 0, 0, 0); acc1 = __builtin_amdgcn_mfma_f32_16x16x32_bf16(a, b1, acc1, 0, 0, 0);
        }
        __syncthreads();
#pragma unroll
        for (int r = 0; r < 4; ++r) { LAS float* o = lrs + (wave * 16 + 4 * (lane >> 4) + r) * 32 + (lane & 15); o[0] = acc0[r]; o[16] = acc1[r]; }
        __syncthreads();
        gate_tail(bcg, gate_w, gate_b, lrs, (size_t)rt * 128, tid);
    }
    __syncthreads();
}

__device__ __forceinline__ void gla_finalize(unsigned char* ws, const float* norm_g, int gw, int NGW, int lane) {
    const bf16* of = (const bf16*)(ws + WS_OF); const bf16* ob = (const bf16*)(ws + WS_OB); const bf16* h0 = (const bf16*)(ws + WS_H0); bf16* cc = (bf16*)(ws + WS_X64);
    const f32x4 g0 = *(const f32x4*)(norm_g + 8 * lane), g1 = *(const f32x4*)(norm_g + 8 * lane + 4);
    for (int m0 = gw; m0 < T; m0 += 4 * NGW) {
        u32x4 a[4], b[4], gq[4];
#pragma unroll
        for (int q = 0; q < 4; ++q) { const size_t m = (size_t)m0 + (size_t)q * NGW;
            a[q] = *(const u32x4*)(of + m * 512 + 8 * lane); b[q] = *(const u32x4*)(ob + m * 512 + 8 * lane); gq[q] = *(const u32x4*)(h0 + m * H0P + OFF_GO + 8 * lane); }
#pragma unroll
        for (int q = 0; q < 4; ++q) { const size_t m = (size_t)m0 + (size_t)q * NGW;
            f32x4 v0, v1;
            v0.x = bflo(a[q].x) + bflo(b[q].x); v0.y = bfhi(a[q].x) + bfhi(b[q].x); v0.z = bflo(a[q].y) + bflo(b[q].y); v0.w = bfhi(a[q].y) + bfhi(b[q].y);
            v1.x = bflo(a[q].z) + bflo(b[q].z); v1.y = bfhi(a[q].z) + bfhi(b[q].z); v1.z = bflo(a[q].w) + bflo(b[q].w); v1.w = bfhi(a[q].w) + bfhi(b[q].w);
            float ss = (v0.x * v0.x + v0.y * v0.y) + (v0.z * v0.z + v0.w * v0.w) + (v1.x * v1.x + v1.y * v1.y) + (v1.z * v1.z + v1.w * v1.w);
            ss += __shfl_xor(ss, 1); ss += __shfl_xor(ss, 2); ss += __shfl_xor(ss, 4); ss += __shfl_xor(ss, 8);
            const float rs = __builtin_amdgcn_rsqf(ss * (1.0f / 128.0f) + RMS_EPS);
            const float gv[8] = {bflo(gq[q].x), bfhi(gq[q].x), bflo(gq[q].y), bfhi(gq[q].y), bflo(gq[q].z), bfhi(gq[q].z), bflo(gq[q].w), bfhi(gq[q].w)};
            const float ov[8] = {v0.x * g0.x, v0.y * g0.y, v0.z * g0.z, v0.w * g0.w, v1.x * g1.x, v1.y * g1.y, v1.z * g1.z, v1.w * g1.w};
            float r[8];
#pragma unroll
            for (int i = 0; i < 8; ++i) r[i] = ov[i] * rs * (gv[i] * __builtin_amdgcn_rcpf(1.f + __expf(-gv[i])));
            u32x4 w; w.x = pk2(r[0], r[1]); w.y = pk2(r[2], r[3]); w.z = pk2(r[4], r[5]); w.w = pk2(r[6], r[7]);
            *(u32x4*)(cc + m * D + 512 + 8 * lane) = w; }
    }
}

constexpr int RT_AST = 2064;
template <bool RESID_F32>
__device__ __forceinline__ void ln_router(unsigned char* ws, const float* resid, const float* lng, const float* lnb, const float* bgrp, const float* brt, int layer, LAS unsigned char* lds, int bid, int G, int tid, int wave, int lane) {
    const bf16* yb = (const bf16*)(ws + WS_Z); bf16* hlo = (bf16*)(ws + WS_HLO); bf16* hb = (bf16*)(ws + WS_HHI);
    int* tok_e = (int*)(ws + WS_TOKE); float* tok_w = (float*)(ws + WS_TOKW);
    LAS unsigned char* Ahi = lds; LAS unsigned char* Alo = lds + 16 * RT_AST; LAS float* part = (LAS float*)(lds + 32 * RT_AST);
    LAS int* hist = (LAS int*)(lds + 32 * RT_AST + 8 * 16 * 48 * 4); LAS float* lgt = (LAS float*)(lds + 32 * RT_AST + 8 * 16 * 48 * 4 + 256);
    if (tid < 32) hist[tid] = 0;
    const bf16* Wr = (const bf16*)(ws + WS_WR) + (size_t)layer * 2 * 48 * 1024;
    bf16x8 Bh[3][4], Bl[3][4];
#pragma unroll
    for (int nt = 0; nt < 3; ++nt)
#pragma unroll
        for (int ks = 0; ks < 4; ++ks) { const size_t o = (size_t)(nt * 16 + (lane & 15)) * 1024 + wave * 128 + ks * 32 + 8 * (lane >> 4);
            Bh[nt][ks] = *(const bf16x8*)(Wr + o); Bl[nt][ks] = *(const bf16x8*)(Wr + 48 * 1024 + o); }
    f32x4 gv[4], bv[4];
#pragma unroll
    for (int j = 0; j < 4; ++j) { gv[j] = *(const f32x4*)(lng + 4 * lane + 256 * j); bv[j] = *(const f32x4*)(lnb + 4 * lane + 256 * j); }
    __syncthreads();
    for (int grp = bid; grp < T / 16; grp += G) {
#pragma unroll
        for (int rr = 0; rr < 2; ++rr) {
            const int row = 2 * wave + rr; const size_t m = (size_t)grp * 16 + row;
            const GAS f32x4* xr = (const GAS f32x4*)(resid + m * D) + lane; const GAS u32x2* yr = (const GAS u32x2*)(yb + m * D) + lane;
            const GAS u32x2* hr_ = (const GAS u32x2*)(hb + m * D) + lane; const GAS u32x2* lr_ = (const GAS u32x2*)(hlo + m * D) + lane;
            f32x4 v[4]; float s = 0.f;
#pragma unroll
            for (int j = 0; j < 4; ++j) { f32x4 x4; const u32x2 y2 = yr[64 * j];
                if (RESID_F32) x4 = xr[64 * j]; else { const u32x2 a = hr_[64 * j], b = lr_[64 * j]; x4.x = bflo(a.x) + bflo(b.x); x4.y = bfhi(a.x) + bfhi(b.x); x4.z = bflo(a.y) + bflo(b.y); x4.w = bfhi(a.y) + bfhi(b.y); }
                v[j].x = x4.x * ALPHA + bflo(y2.x); v[j].y = x4.y * ALPHA + bfhi(y2.x); v[j].z = x4.z * ALPHA + bflo(y2.y); v[j].w = x4.w * ALPHA + bfhi(y2.y);
                s += (v[j].x + v[j].y) + (v[j].z + v[j].w); }
            const float mean = wave_sum(s) * (1.f / D); float s2 = 0.f;
#pragma unroll
            for (int j = 0; j < 4; ++j) { v[j] = v[j] - mean; s2 += (v[j].x * v[j].x + v[j].y * v[j].y) + (v[j].z * v[j].z + v[j].w * v[j].w); }
            const float rstd = 1.f / sqrtf(wave_sum(s2) * (1.f / D) + LN_EPS);
#pragma unroll
            for (int j = 0; j < 4; ++j) {
                const f32x4 h = v[j] * rstd * gv[j] + bv[j];
                const unsigned h0 = pk2(h.x, h.y), h1w = pk2(h.z, h.w);
                u32x2 w; w.x = h0; w.y = h1w; ((GAS u32x2*)(hb + m * D) + lane)[64 * j] = w;
                u32x2 lo; lo.x = pk2(h.x - bflo(h0), h.y - bfhi(h0)); lo.y = pk2(h.z - bflo(h1w), h.w - bfhi(h1w));
                ((GAS u32x2*)(hlo + m * D) + lane)[64 * j] = lo;
                *(LAS u32x2*)(Ahi + row * RT_AST + (4 * lane + 256 * j) * 2) = w; *(LAS u32x2*)(Alo + row * RT_AST + (4 * lane + 256 * j) * 2) = lo;
            }
        }
        LDS_BARRIER();
        f32x4 acc[3] = {{0.f, 0.f, 0.f, 0.f}, {0.f, 0.f, 0.f, 0.f}, {0.f, 0.f, 0.f, 0.f}};
#pragma unroll
        for (int ks = 0; ks < 4; ++ks) {
            const int bo = (lane & 15) * RT_AST + (wave * 128 + ks * 32 + 8 * (lane >> 4)) * 2;
            const bf16x8 ah = *(const LAS bf16x8*)(Ahi + bo), al = *(const LAS bf16x8*)(Alo + bo);
#pragma unroll
            for (int nt = 0; nt < 3; ++nt) {
                acc[nt] = __builtin_amdgcn_mfma_f32_16x16x32_bf16(ah, Bh[nt][ks], acc[nt], 0, 0, 0);
                acc[nt] = __builtin_amdgcn_mfma_f32_16x16x32_bf16(ah, Bl[nt][ks], acc[nt], 0, 0, 0);
                acc[nt] = __builtin_amdgcn_mfma_f32_16x16x32_bf16(al, Bh[nt][ks], acc[nt], 0, 0, 0);
            }
        }
#pragma unroll
        for (int nt = 0; nt < 3; ++nt)
#pragma unroll
            for (int r = 0; r < 4; ++r) part[(wave * 16 + 4 * (lane >> 4) + r) * 48 + nt * 16 + (lane & 15)] = acc[nt][r];
        LDS_BARRIER();
        { const int itn = (grp - bid) / G;
          for (int idx = tid; idx < 16 * 36; idx += NTHR) { const int tk = idx / 36, n = idx % 36; float s = 0.f;
#pragma unroll
            for (int w = 0; w < 8; ++w) s += part[(w * 16 + tk) * 48 + n];
            lgt[(itn * 16 + tk) * 36 + n] = s + (n < 4 ? bgrp[n] : brt[n - 4]); } }
    }
    LDS_BARRIER();
    for (int tk = tid; tk < 16 * ((T / 16 - bid + G - 1) / G); tk += NTHR) {
        const size_t m = ((size_t)bid + (size_t)(tk >> 4) * G) * 16 + (tk & 15);
        const LAS float* lg = lgt + tk * 36;
        int gi = 0; float gm = lg[0];
#pragma unroll
        for (int n = 1; n < 4; ++n) if (lg[n] > gm) { gm = lg[n]; gi = n; }
        float gs = 0.f;
#pragma unroll
        for (int n = 0; n < 4; ++n) gs += __expf(lg[n] - gm);
        const float pg = 1.f / gs;
        float el[8];
#pragma unroll
        for (int i = 0; i < 8; ++i) el[i] = lg[4 + gi * 8 + i];
        int i1 = 0; float m1 = el[0];
#pragma unroll
        for (int i = 1; i < 8; ++i) if (el[i] > m1) { m1 = el[i]; i1 = i; }
        int i2 = -1; float m2 = -3.0e38f;
#pragma unroll
        for (int i = 0; i < 8; ++i) if (i != i1 && el[i] > m2) { m2 = el[i]; i2 = i; }
        const float e2 = __expf(m2 - m1), inv = 1.f / (1.f + e2);
        const int ea = gi * 8 + i1, eb = gi * 8 + i2;
        tok_e[m * 2] = ea; tok_e[m * 2 + 1] = eb; tok_w[m * 2] = pg * inv; tok_w[m * 2 + 1] = pg * e2 * inv;
        atomicAdd((int*)&hist[ea], 1); atomicAdd((int*)&hist[eb], 1);
    }
    LDS_BARRIER();
    if (tid < 32) ((int*)(ws + WS_BLKC))[bid * 32 + tid] = hist[tid];
}

__device__ __forceinline__ void moe_sort(unsigned char* ws, LAS unsigned char* lds, int bid, int G, int tid) {
    const int* blkc = (const int*)(ws + WS_BLKC); const int* tok_e = (const int*)(ws + WS_TOKE); const float* tok_w = (const float*)(ws + WS_TOKW);
    int* tok_s = (int*)(ws + WS_TOKS); int* slot_t = (int*)(ws + WS_SLOTT); float* slot_w = (float*)(ws + WS_SLOTW); int* tile = (int*)(ws + WS_TILE);
    LAS int* ptot = (LAS int*)lds; LAS int* pbase = ptot + 512; LAS int* tot = pbase + 512; LAS int* base = tot + 32; LAS int* pstart = base + 32; LAS int* lcur = pstart + 33;
    { const int e = tid & 31, part = tid >> 5; int st = 0, sb = 0;
      for (int b = part; b < G; b += 16) { const int c = blkc[b * 32 + e]; st += c; sb += (b < bid) ? c : 0; }
      ptot[part * 32 + e] = st; pbase[part * 32 + e] = sb; }
    __syncthreads();
    if (tid < 32) { int st = 0, sb = 0;
#pragma unroll
        for (int p = 0; p < 16; ++p) { st += ptot[p * 32 + tid]; sb += pbase[p * 32 + tid]; }
        tot[tid] = st; base[tid] = sb; lcur[tid] = 0; }
    __syncthreads();
    if (tid == 0) { int acc = 0; for (int e = 0; e < 32; ++e) { pstart[e] = acc; acc += (tot[e] + 255) & ~255; } pstart[32] = acc; }
    __syncthreads();
    if (bid == 0) {
        const int nt = pstart[32] >> 8;
        if (tid == 0) tile[511] = nt;
        for (int t = tid; t < nt; t += NTHR) { int e = 0; for (int q = 1; q < 32; ++q) if ((t << 8) >= pstart[q]) e = q; tile[t] = e; }
    }
    for (int e = bid; e < 32; e += G)
        for (int s = pstart[e] + tot[e] + tid; s < pstart[e + 1]; s += NTHR) { slot_t[s] = 0; slot_w[s] = 0.f; }
    for (int grp = bid; grp < T / 16; grp += G) {
        if (tid < 32) { const size_t a = (size_t)grp * 32 + tid; const int e = tok_e[a]; const int rank = atomicAdd((int*)&lcur[e], 1);
            const int s = pstart[e] + base[e] + rank; slot_t[s] = (int)(a >> 1); slot_w[s] = tok_w[a]; tok_s[a] = s; }
    }
}

template <bool FINAL>
__device__ __forceinline__ void combine_ln(unsigned char* ws, const float* lng, const float* lnb, float* dout, int gw, int NGW, int lane) {
    bf16* hlo = (bf16*)(ws + WS_HLO); bf16* hhi = (bf16*)(ws + WS_HHI); const bf16* y2 = (const bf16*)(ws + WS_Y2); const int* tok_s = (const int*)(ws + WS_TOKS); const float* tok_w = (const float*)(ws + WS_TOKW);
    f32x4 gv[4], bv[4];
#pragma unroll
    for (int j = 0; j < 4; ++j) { gv[j] = *(const f32x4*)(lng + 4 * lane + 256 * j); bv[j] = *(const f32x4*)(lnb + 4 * lane + 256 * j); }
    for (int m = gw; m < T; m += NGW) {
        const int s0 = tok_s[(size_t)m * 2], s1 = tok_s[(size_t)m * 2 + 1]; const float w0 = tok_w[(size_t)m * 2], w1 = tok_w[(size_t)m * 2 + 1];
        GAS u32x2* hr = (GAS u32x2*)(hhi + (size_t)m * D) + lane; GAS u32x2* lr = (GAS u32x2*)(hlo + (size_t)m * D) + lane;
        const GAS u32x2* ya = (const GAS u32x2*)(y2 + (size_t)s0 * D) + lane; const GAS u32x2* yb = (const GAS u32x2*)(y2 + (size_t)s1 * D) + lane;
        f32x4 v[4]; float s = 0.f;
#pragma unroll
        for (int j = 0; j < 4; ++j) { const u32x2 hh_ = hr[64 * j], hl_ = lr[64 * j]; f32x4 h; h.x = bflo(hh_.x) + bflo(hl_.x); h.y = bfhi(hh_.x) + bfhi(hl_.x); h.z = bflo(hh_.y) + bflo(hl_.y); h.w = bfhi(hh_.y) + bfhi(hl_.y);
            const u32x2 a = ya[64 * j], b = yb[64 * j];
            v[j].x = h.x * ALPHA + (w0 * bflo(a.x) + w1 * bflo(b.x)); v[j].y = h.y * ALPHA + (w0 * bfhi(a.x) + w1 * bfhi(b.x)); v[j].z = h.z * ALPHA + (w0 * bflo(a.y) + w1 * bflo(b.y)); v[j].w = h.w * ALPHA + (w0 * bfhi(a.y) + w1 * bfhi(b.y));
            s += (v[j].x + v[j].y) + (v[j].z + v[j].w); }
        const float mean = wave_sum(s) * (1.f / D); float s2 = 0.f;
#pragma unroll
        for (int j = 0; j < 4; ++j) { v[j] = v[j] - mean; s2 += (v[j].x * v[j].x + v[j].y * v[j].y) + (v[j].z * v[j].z + v[j].w * v[j].w); }
        const float rstd = 1.f / sqrtf(wave_sum(s2) * (1.f / D) + LN_EPS);
#pragma unroll
        for (int j = 0; j < 4; ++j) { const f32x4 h = v[j] * rstd * gv[j] + bv[j];
            if (FINAL) ((GAS f32x4*)(dout + (size_t)m * D) + lane)[64 * j] = h;
            else { u32x2 w; w.x = pk2(h.x, h.y); w.y = pk2(h.z, h.w); hr[64 * j] = w;
                   u32x2 lo; lo.x = pk2(h.x - bflo(w.x), h.y - bfhi(w.x)); lo.y = pk2(h.z - bflo(w.y), h.w - bfhi(w.y)); lr[64 * j] = lo; } }
    }
}
constexpr int S5_HST = 272, S5_UST = 272, S5_UOFF = 8 * 32 * S5_HST;
#define MFMA32(a, b, c) __builtin_amdgcn_mfma_f32_32x32x16_bf16((a), (b), (c), 0, 0, 0)
#define MFMA16(a, b, c) __builtin_amdgcn_mfma_f32_16x16x32_bf16((a), (b), (c), 0, 0, 0)
__device__ __forceinline__ float gelu_tanh(float x) {
    const float u = 0.7978845608028654f * (x + 0.044715f * x * x * x);
    const float e = __expf(2.f * u); const float th = 1.f - 2.f * __builtin_amdgcn_rcpf(e + 1.f);
    return 0.5f * x * (1.f + th);
}
__device__ __forceinline__ f32x4 ld_ys(const float* p) {
    f32x4 v;
    v.x = __hip_atomic_load(p, __ATOMIC_RELAXED, __HIP_MEMORY_SCOPE_AGENT); v.y = __hip_atomic_load(p + 1, __ATOMIC_RELAXED, __HIP_MEMORY_SCOPE_AGENT);
    v.z = __hip_atomic_load(p + 2, __ATOMIC_RELAXED, __HIP_MEMORY_SCOPE_AGENT); v.w = __hip_atomic_load(p + 3, __ATOMIC_RELAXED, __HIP_MEMORY_SCOPE_AGENT);
    return v;
}
template <int PASS, int DIR>
__device__ __forceinline__ void s5_dir(unsigned char* ws, const float* s5d, int b, int g, int c, LAS unsigned char* hl, const LAS unsigned char* ul, float* yscr, int lane) {
    const bf16* h0 = (const bf16*)(ws + WS_H0);
    const int dg = DIR * 32 + g;
    const f32x4 L4 = *(const f32x4*)((const float*)(ws + WS_S5L) + (size_t)(dg * 64 + lane) * 4);
    const float ar = L4.x, ai = L4.y, qr = L4.z, qi = L4.w;
    const float l2r = ar * ar - ai * ai, l2i = 2.f * ar * ai, l4r = l2r * l2r - l2i * l2i, l4i = 2.f * l2r * l2i, l8r = l4r * l4r - l4i * l4i, l8i = 2.f * l4r * l4i;
    const float l16r = l8r * l8r - l8i * l8i, l16i = 2.f * l8r * l8i, l32r = l16r * l16r - l16i * l16i, l32i = 2.f * l16r * l16i;
    const bf16* Bb = (const bf16*)(ws + WS_S5B) + (size_t)dg * 2048 + (lane & 31) * 16 + 8 * (lane >> 5);
    const bf16x8 bre0 = *(const bf16x8*)Bb, bre1 = *(const bf16x8*)(Bb + 512), bim0 = *(const bf16x8*)(Bb + 1024), bim1 = *(const bf16x8*)(Bb + 1536);
    bf16x8 cf[4]; bf16x8 dfrag;
    if (PASS == 2) {
        const bf16* Cm = (const bf16*)(ws + WS_S5C) + (size_t)dg * 2048 + (lane & 15) * 128 + 8 * (lane >> 4);
#pragma unroll
        for (int ks = 0; ks < 4; ++ks) cf[ks] = *(const bf16x8*)(Cm + 32 * ks);
        if (DIR == 1) {
            const int cc = lane & 15, kq = lane >> 4; const float d = s5d[g * 16 + cc]; const unsigned dh = f2bf(d); const unsigned dl = f2bf(d - __uint_as_float(dh << 16));
#pragma unroll
            for (int j = 0; j < 8; ++j) { const int k = 8 * (kq & 1) + j; dfrag[j] = (short)((k == cc) ? (kq < 2 ? dh : dl) : 0u); }
        }
    }
    float hr = 0.f, hi = 0.f;
    float* Ec = (float*)(ws + WS_S5E) + ((size_t)((DIR * NB + b) * 32 + g) * S5NCH) * 128 + 2 * lane;
    if (PASS == 2) {
        const int nj = DIR == 0 ? c : (S5NCH - 1 - c);
        for (int j0 = 0; j0 < nj; j0 += 32) {
            f32x2 e[32];
#pragma unroll
            for (int q = 0; q < 32; ++q) { const int j = (j0 + q) < nj ? (j0 + q) : (nj - 1); const int jj = DIR == 0 ? j : (S5NCH - 1 - j); e[q] = *(const f32x2*)(Ec + (size_t)jj * 128); }
#pragma unroll
            for (int q = 0; q < 32; ++q) if (j0 + q < nj) { const float nr = qr * hr - qi * hi + e[q].x; hi = qr * hi + qi * hr + e[q].y; hr = nr; }
        }
    }
    const size_t rowbase = (size_t)b * SEQ + (size_t)c * S5CH;
    const LAS unsigned char* up = ul + (lane & 31) * S5_UST + (g & 7) * 32 + 16 * (lane >> 5);
    const f32x16 zero16 = {0.f, 0.f, 0.f, 0.f, 0.f, 0.f, 0.f, 0.f, 0.f, 0.f, 0.f, 0.f, 0.f, 0.f, 0.f, 0.f};
#pragma unroll 1
    for (int ti = 0; ti < S5CH / 32; ++ti) {
        const int tile = DIR == 0 ? ti : (S5CH / 32 - 1 - ti);
        const bf16x8 a = *(const LAS bf16x8*)(up + tile * 32 * S5_UST);
        f32x4 ysv[2] = {{0.f, 0.f, 0.f, 0.f}, {0.f, 0.f, 0.f, 0.f}};
        if (PASS == 2 && DIR == 1) { ysv[0] = ld_ys(yscr + (size_t)(tile * 2) * 256 + 4 * lane); ysv[1] = ld_ys(yscr + (size_t)(tile * 2 + 1) * 256 + 4 * lane); }
        f32x16 xr0 = MFMA32(a, bre0, zero16), xr1 = MFMA32(a, bre1, zero16), xi0 = MFMA32(a, bim0, zero16), xi1 = MFMA32(a, bim1, zero16);
        __builtin_amdgcn_sched_barrier(0);
        asm volatile("s_nop 15\n\ts_nop 15\n\ts_nop 15\n\ts_nop 15\n\ts_nop 15\n\ts_nop 15" ::: "memory");
        __builtin_amdgcn_sched_barrier(0);
        float xr[32], xi[32];
#pragma unroll
        for (int r = 0; r < 16; ++r) {
            auto s = __builtin_amdgcn_permlane32_swap(__float_as_uint(xr0[r]), __float_as_uint(xr1[r]), false, false);
            xr[crow(r, 0)] = __uint_as_float(s[0]); xr[crow(r, 1)] = __uint_as_float(s[1]);
            auto q = __builtin_amdgcn_permlane32_swap(__float_as_uint(xi0[r]), __float_as_uint(xi1[r]), false, false);
            xi[crow(r, 0)] = __uint_as_float(q[0]); xi[crow(r, 1)] = __uint_as_float(q[1]);
        }
        if (PASS == 1) {
#pragma unroll
            for (int lv = 0; lv < 5; ++lv) {
                const float pr = lv == 0 ? ar : lv == 1 ? l2r : lv == 2 ? l4r : lv == 3 ? l8r : l16r, pi = lv == 0 ? ai : lv == 1 ? l2i : lv == 2 ? l4i : lv == 3 ? l8i : l16i;
#pragma unroll
                for (int i = 0; i < (16 >> lv); ++i) {
                    const int e = DIR == 0 ? 2 * i : 2 * i + 1, l = DIR == 0 ? 2 * i + 1 : 2 * i;
                    const float er = xr[e << lv], ei = xi[e << lv], lr_ = xr[l << lv], li_ = xi[l << lv];
                    const float wr = fmaf(pr, er, fmaf(-pi, ei, lr_)), wi = fmaf(pr, ei, fmaf(pi, er, li_));
                    xr[(2 * i) << lv] = wr; xi[(2 * i) << lv] = wi;
                }
            }
            { const float nr = fmaf(l32r, hr, fmaf(-l32i, hi, xr[0])), ni = fmaf(l32r, hi, fmaf(l32i, hr, xi[0])); hr = nr; hi = ni; }
        } else {
#pragma unroll
        for (int tt = 0; tt < 32; ++tt) {
            const int t = DIR == 0 ? tt : 31 - tt;
            const float tr_ = fmaf(-ai, hi, xr[t]), ti_ = fmaf(ai, hr, xi[t]);
            hr = fmaf(ar, hr, tr_); hi = fmaf(ar, hi, ti_);
            *(LAS unsigned*)(hl + t * S5_HST + 4 * lane) = pk2(hr, hi);
        }
        }
        if (PASS == 2) {
#pragma unroll
            for (int sub = 0; sub < 2; ++sub) {
                float* ys = yscr + (size_t)(tile * 2 + sub) * 256 + 4 * lane;
                f32x4 y = {0.f, 0.f, 0.f, 0.f};
                if (DIR == 1) y = ysv[sub];
#pragma unroll
                for (int ks = 0; ks < 4; ++ks) { const bf16x8 hf = *(const LAS bf16x8*)(hl + (sub * 16 + (lane & 15)) * S5_HST + 64 * ks + 16 * (lane >> 4)); y = MFMA16(hf, cf[ks], y); }
                if (DIR == 0) *(f32x4*)ys = y;
                else {
                    const bf16x8 uf = *(const LAS bf16x8*)(ul + (tile * 32 + sub * 16 + (lane & 15)) * S5_UST + (g & 7) * 32 + 16 * ((lane >> 4) & 1));
                    y = MFMA16(uf, dfrag, y);
                    bf16* yo = (bf16*)(ws + WS_YG) + (rowbase + tile * 32 + sub * 16 + 4 * (lane >> 4)) * 512 + g * 16 + (lane & 15);
#pragma unroll
                    for (int r = 0; r < 4; ++r) yo[(size_t)r * 512] = (bf16)f2bf(gelu_tanh(y[r]));
                }
            }
        }
    }
    if (PASS == 1) { f32x2 e; e.x = hr; e.y = hi; *(f32x2*)(Ec + (size_t)c * 128) = e; }
}
template <int PASS>
__device__ __forceinline__ void s5_phase(unsigned char* ws, const float* s5d, LAS unsigned char* lds, int bid, int G, int tid, int wave, int lane) {
    LAS unsigned char* hl = lds + wave * (32 * S5_HST); LAS unsigned char* ul = lds + S5_UOFF;
    float* yscr = (float*)(ws + WS_YSCR) + (size_t)(bid * NWAVES + wave) * 4096;
    const bf16* h0 = (const bf16*)(ws + WS_H0);
    for (int it = bid; it < NB * S5NCH * 4; it += G) {
        const int go = it & 3, c = (it >> 2) % S5NCH, b = it / (4 * S5NCH), g = go * 8 + wave;
        { const bf16* src = h0 + ((size_t)b * SEQ + (size_t)c * S5CH) * H0P + OFF_U + go * 128;
          u32x4 v[8];
#pragma unroll
          for (int i = 0; i < 8; ++i) { const int p = i * NTHR + tid; v[i] = *(const u32x4*)(src + (size_t)(p >> 4) * H0P + 8 * (p & 15)); }
          __syncthreads();
#pragma unroll
          for (int i = 0; i < 8; ++i) { const int p = i * NTHR + tid; *(LAS u32x4*)(ul + (p >> 4) * S5_UST + 16 * (p & 15)) = v[i]; }
          __syncthreads(); }
        s5_dir<PASS, 0>(ws, s5d, b, g, c, hl, ul, yscr, lane);
        s5_dir<PASS, 1>(ws, s5d, b, g, c, hl, ul, yscr, lane);
    }
}
constexpr int G_ST = 144;
constexpr int GL_QD = 0, GL_KD = GL_QD + 64 * G_ST, GL_KCT = GL_KD + 64 * G_ST, GL_VT = GL_KCT + 64 * G_ST, GL_IMG = GL_VT + 128 * G_ST,
              GL_S = 2 * GL_IMG, GL_ST = GL_S + 64 * G_ST, GL_END = GL_ST + 2 * 128 * G_ST;
static_assert(GL_END <= MISC_OFF, "GLA LDS");
__device__ __forceinline__ bf16x8 ldfrag32(const LAS unsigned char* base, int row0, int ks, int lane) {
    return *(const LAS bf16x8*)(base + (row0 + (lane & 31)) * G_ST + 32 * ks + 16 * (lane >> 5));
}
__device__ __forceinline__ void gate_tail(float* bcg, const float* gate_w, const float* gate_b, const LAS float* lrs, size_t row0, int tid) {
    const int dir = tid >> 8;
    float gw[16];
#pragma unroll
    for (int r = 0; r < 16; ++r) gw[r] = gate_w[(size_t)(dir * 16 + r) * 256 + (tid & 255)];
    const float gb = gate_b[tid];
    float run = 0.f;
#pragma unroll 4
    for (int i = 0; i < 128; ++i) {
        const int t = dir ? 127 - i : i;
        if ((i & 63) == 0) run = 0.f;
        const LAS f32x4* lp = (const LAS f32x4*)(lrs + t * 32 + dir * 16);
        const f32x4 l0 = lp[0], l1 = lp[1], l2 = lp[2], l3 = lp[3];
        float z = gb + l0.x * gw[0] + l0.y * gw[1] + l0.z * gw[2] + l0.w * gw[3] + l1.x * gw[4] + l1.y * gw[5] + l1.z * gw[6] + l1.w * gw[7]
                     + l2.x * gw[8] + l2.y * gw[9] + l2.z * gw[10] + l2.w * gw[11] + l3.x * gw[12] + l3.y * gw[13] + l3.z * gw[14] + l3.w * gw[15];
        const float ls = fminf(z, 0.f) - __logf(1.f + __expf(-fabsf(z)));
        run += ls * (1.0f / 16.0f);
        bcg[(row0 + t) * 512 + tid] = run;
    }
}
__device__ __forceinline__ size_t gla_tok(int b, int dir, int chunk, int s) { const int pos = chunk * GCH + s; return (size_t)b * SEQ + (dir ? (SEQ - 1 - pos) : pos); }
template <int PASS>
__device__ __forceinline__ void gla_item(unsigned char* ws, const float* bcg, int item, LAS unsigned char* lds, int tid, int wave, int lane) {
    const int sc = item % GNSC, dir = (item / GNSC) & 1, h = (item / (GNSC * 2)) & 3, b = item / (GNSC * 8);
    const bf16* h0 = (const bf16*)(ws + WS_H0);
    LAS unsigned char* QD = lds + GL_QD; LAS unsigned char* KD = lds + GL_KD; LAS unsigned char* KCT = lds + GL_KCT; LAS unsigned char* VT = lds + GL_VT; LAS unsigned char* SS = lds + GL_S; LAS unsigned char* STT = lds + GL_ST;
    const int me = wave >> 1, nd = wave & 1;
    f32x16 st;
#pragma unroll
    for (int r = 0; r < 16; ++r) st[r] = 0.f;
    float dtot = 1.f;
    float* GS = (float*)(ws + WS_GS); float* GD = (float*)(ws + WS_GD);
    const int ibase = item - sc;
    if (PASS == 2) {
        for (int j0 = 0; j0 < sc; j0 += 4) {
            float dj[4], gv[4][16];
#pragma unroll
            for (int q = 0; q < 4; ++q) { const int j = (j0 + q) < sc ? (j0 + q) : (sc - 1);
                dj[q] = GD[(size_t)(ibase + j) * 64 + nd * 32 + (lane & 31)];
                const float* gs = GS + (size_t)(ibase + j) * 8192 + nd * 32 + (lane & 31);
#pragma unroll
                for (int r = 0; r < 16; ++r) gv[q][r] = gs[(size_t)(me * 32 + crow(r, lane >> 5)) * 64]; }
#pragma unroll
            for (int q = 0; q < 4; ++q) if (j0 + q < sc) {
#pragma unroll
                for (int r = 0; r < 16; ++r) st[r] = st[r] * dj[q] + gv[q][r]; }
        }
#pragma unroll
        for (int r = 0; r < 16; ++r) *(LAS bf16*)(STT + (me * 32 + crow(r, lane >> 5)) * G_ST + (nd * 32 + (lane & 31)) * 2) = (bf16)f2bf(st[r]);
    }
    const float qscale = 0.125f;
    const int s_l = lane;
    const int gcol = dir * 256 + h * 64;
    u32x4 pq, pk, pv0, pv1; f32x4 pb0, pb1, pl0, pl1; float pdec;
#define GLA_LOAD(n) do { const int ch_ = sc * GSC + (n); const size_t tk = gla_tok(b, dir, ch_, s_l), tl = gla_tok(b, dir, ch_, 63); const bf16* rp = h0 + tk * H0P; \
        if (PASS == 2) pq = *(const u32x4*)(rp + OFF_Q + h * 64 + 8 * wave); \
        pk = *(const u32x4*)(rp + OFF_K + h * 64 + 8 * wave); pv0 = *(const u32x4*)(rp + OFF_V + h * 128 + 16 * wave); pv1 = *(const u32x4*)(rp + OFF_V + h * 128 + 16 * wave + 8); \
        pb0 = *(const f32x4*)(bcg + tk * 512 + gcol + 8 * wave); pb1 = *(const f32x4*)(bcg + tk * 512 + gcol + 8 * wave + 4); \
        pl0 = *(const f32x4*)(bcg + tl * 512 + gcol + 8 * wave); pl1 = *(const f32x4*)(bcg + tl * 512 + gcol + 8 * wave + 4); \
        pdec = bcg[tl * 512 + gcol + nd * 32 + (lane & 31)]; } while (0)
#define GLA_STEP_A(IMG) do { LAS unsigned char* QD_ = (IMG) + GL_QD; LAS unsigned char* KD_ = (IMG) + GL_KD; LAS unsigned char* KCT_ = (IMG) + GL_KCT; LAS unsigned char* VT_ = (IMG) + GL_VT; \
        const float bc[8] = {pb0.x, pb0.y, pb0.z, pb0.w, pb1.x, pb1.y, pb1.z, pb1.w}, bl[8] = {pl0.x, pl0.y, pl0.z, pl0.w, pl1.x, pl1.y, pl1.z, pl1.w}; \
        const float kv[8] = {bflo(pk.x), bfhi(pk.x), bflo(pk.y), bfhi(pk.y), bflo(pk.z), bfhi(pk.z), bflo(pk.w), bfhi(pk.w)}; \
        if (PASS == 2) { const float qv[8] = {bflo(pq.x), bfhi(pq.x), bflo(pq.y), bfhi(pq.y), bflo(pq.z), bfhi(pq.z), bflo(pq.w), bfhi(pq.w)}; float qd[8], kd[8]; \
            _Pragma("unroll") for (int i = 0; i < 8; ++i) { qd[i] = qv[i] * qscale * __expf(bc[i]); kd[i] = kv[i] * __expf(-bc[i]); } \
            u32x4 w; w.x = pk2(qd[0], qd[1]); w.y = pk2(qd[2], qd[3]); w.z = pk2(qd[4], qd[5]); w.w = pk2(qd[6], qd[7]); *(LAS u32x4*)(QD_ + s_l * G_ST + 16 * wave) = w; \
            w.x = pk2(kd[0], kd[1]); w.y = pk2(kd[2], kd[3]); w.z = pk2(kd[4], kd[5]); w.w = pk2(kd[6], kd[7]); *(LAS u32x4*)(KD_ + s_l * G_ST + 16 * wave) = w; } \
        _Pragma("unroll") for (int i = 0; i < 8; ++i) *(LAS bf16*)(KCT_ + (8 * wave + i) * G_ST + 2 * s_l) = (bf16)f2bf(kv[i] * __expf(bl[i] - bc[i])); \
        const unsigned vv[8] = {pv0.x, pv0.y, pv0.z, pv0.w, pv1.x, pv1.y, pv1.z, pv1.w}; \
        _Pragma("unroll") for (int i = 0; i < 8; ++i) { *(LAS bf16*)(VT_ + (16 * wave + 2 * i) * G_ST + 2 * s_l) = (bf16)(vv[i] & 0xffffu); *(LAS bf16*)(VT_ + (16 * wave + 2 * i + 1) * G_ST + 2 * s_l) = (bf16)(vv[i] >> 16); } \
        dec_n = __expf(pdec); } while (0)
#define GLA_STEP_B(IMG, STW, WRITE_ST) do { LAS unsigned char* QD_ = (IMG) + GL_QD; LAS unsigned char* KD_ = (IMG) + GL_KD; LAS unsigned char* KCT_ = (IMG) + GL_KCT; LAS unsigned char* VT_ = (IMG) + GL_VT; \
        if (PASS == 2 && wave < 4) { const int ms = wave >> 1, ns = wave & 1; f32x16 sa; \
            _Pragma("unroll") for (int r = 0; r < 16; ++r) sa[r] = 0.f; \
            if (ns <= ms) { _Pragma("unroll") for (int ks = 0; ks < 4; ++ks) sa = MFMA32(ldfrag32(QD_, ms * 32, ks, lane), ldfrag32(KD_, ns * 32, ks, lane), sa); } \
            _Pragma("unroll") for (int r = 0; r < 16; ++r) { const int s = ms * 32 + crow(r, lane >> 5), s2 = ns * 32 + (lane & 31); const bool keep = dir ? (s2 < s) : (s2 <= s); \
                *(LAS bf16*)(SS + s * G_ST + 2 * s2) = (bf16)f2bf(keep ? sa[r] : 0.f); } } \
        _Pragma("unroll") for (int r = 0; r < 16; ++r) st[r] *= dec_c; \
        dtot *= dec_c; \
        _Pragma("unroll") for (int ks = 0; ks < 4; ++ks) st = MFMA32(ldfrag32(VT_, me * 32, ks, lane), ldfrag32(KCT_, nd * 32, ks, lane), st); \
        if (PASS == 2 && (WRITE_ST)) { _Pragma("unroll") for (int r = 0; r < 16; ++r) *(LAS bf16*)((STW) + (me * 32 + crow(r, lane >> 5)) * G_ST + (nd * 32 + (lane & 31)) * 2) = (bf16)f2bf(st[r]); } } while (0)
    float dec_n = 1.f, dec_c = 1.f;
    LAS unsigned char* IMG0 = lds; LAS unsigned char* IMG1 = lds + GL_IMG;
    GLA_LOAD(0);
    __syncthreads();
    GLA_STEP_A(IMG0); dec_c = dec_n;
    if (1 < GSC) GLA_LOAD(1);
    LDS_BARRIER();
    if (PASS == 2) { GLA_STEP_B(IMG0, STT + 128 * G_ST, true); LDS_BARRIER(); }
#pragma unroll 1
    for (int n = 0; n < GSC; ++n) {
        LAS unsigned char* Ic = (n & 1) ? IMG1 : IMG0; LAS unsigned char* In = (n & 1) ? IMG0 : IMG1;
        LAS unsigned char* STc = STT + (n & 1) * (128 * G_ST);
        if (PASS == 2) {
            const int ms = wave >> 2, ne = wave & 3;
            f32x16 oa;
#pragma unroll
            for (int r = 0; r < 16; ++r) oa[r] = 0.f;
#pragma unroll
            for (int ks = 0; ks < 4; ++ks) oa = MFMA32(ldfrag32(SS, ms * 32, ks, lane), ldfrag32(Ic + GL_VT, ne * 32, ks, lane), oa);
#pragma unroll
            for (int ks = 0; ks < 4; ++ks) oa = MFMA32(ldfrag32(Ic + GL_QD, ms * 32, ks, lane), ldfrag32(STc, ne * 32, ks, lane), oa);
            bf16* op = (bf16*)(ws + (dir ? WS_OB : WS_OF)) + h * 128 + ne * 32 + (lane & 31);
#pragma unroll
            for (int r = 0; r < 16; ++r) op[gla_tok(b, dir, sc * GSC + n, ms * 32 + crow(r, lane >> 5)) * 512] = (bf16)f2bf(oa[r]);
        } else {
            GLA_STEP_B(Ic, STT, false);
        }
        if (n + 1 < GSC) { GLA_STEP_A(In); if (n + 2 < GSC) GLA_LOAD(n + 2); }
        LDS_BARRIER();
        if (PASS == 2 && n + 1 < GSC) { dec_c = dec_n; GLA_STEP_B(In, STT + (n & 1) * (128 * G_ST), n + 2 < GSC); LDS_BARRIER(); }
        if (PASS == 1) dec_c = dec_n;
    }
#undef GLA_STEP_A
#undef GLA_STEP_B
    if (PASS == 1) {
        float* gs = GS + (size_t)item * 8192 + nd * 32 + (lane & 31);
#pragma unroll
        for (int r = 0; r < 16; ++r) gs[(size_t)(me * 32 + crow(r, lane >> 5)) * 64] = st[r];
        if (me == 0 && lane < 32) GD[(size_t)item * 64 + nd * 32 + lane] = dtot;
    }
    __syncthreads();
#undef GLA_LOAD
}
constexpr int AT_KST = 144, AT_VST = 664, AT_K = 0, AT_V = 320 * AT_KST, AT_BT = AT_V + 64 * AT_VST, AT_END = AT_BT + 16 * 260 * 4;
static_assert(AT_END <= RING_BYTES && AT_V % 16 == 0 && AT_BT % 16 == 0, "attention LDS");
__device__ __forceinline__ void attn_phase(unsigned char* ws, const float* sink, LAS unsigned char* lds, int bid, int G, int tid, int wave, int lane) {
    const bf16* qkv = (const bf16*)(ws + WS_QKV); bf16* ao = (bf16*)(ws + WS_AO); const float* btab = (const float*)(ws + WS_BTAB);
    LAS unsigned char* KS = lds + AT_K; LAS unsigned char* VT = lds + AT_V; LAS float* BT = (LAS float*)(lds + AT_BT);
    const float sc2 = 0.125f * LOG2E;
    u32x4 kreg[5], vreg[5]; bf16x8 qreg[4]; float sreg;
    for (int p = tid; p < 16 * 260; p += NTHR) BT[p] = btab[p];
#define AT_LOAD(u_) do { const int qb_ = (u_) % (SEQ / 64), kvh_ = ((u_) / (SEQ / 64)) & 3, b_ = (u_) / (4 * (SEQ / 64)), kb_ = qb_ * 64 - 128; \
        _Pragma("unroll") for (int it = 0; it < 5; ++it) { const int p = it * NTHR + tid; int key = kb_ + (p >> 3); key = key < 0 ? 0 : (key > SEQ - 1 ? SEQ - 1 : key); \
            const bf16* rp = qkv + ((size_t)b_ * SEQ + key) * CN + kvh_ * 64 + 8 * (p & 7); kreg[it] = *(const u32x4*)(rp + 1024); vreg[it] = *(const u32x4*)(rp + 1280); } \
        { const int hq_ = kvh_ * 4 + (wave >> 1); const bf16* qp_ = qkv + ((size_t)b_ * SEQ + qb_ * 64 + 32 * (wave & 1) + (lane & 31)) * CN + hq_ * 64 + 8 * (lane >> 5); \
          _Pragma("unroll") for (int ks = 0; ks < 4; ++ks) qreg[ks] = *(const bf16x8*)(qp_ + 16 * ks); sreg = sink[hq_]; } } while (0)
    if (bid < NB * 4 * (SEQ / 64)) AT_LOAD(bid);
    for (int u = bid; u < NB * 4 * (SEQ / 64); u += G) {
        const int qb = u % (SEQ / 64), kvh = (u / (SEQ / 64)) & 3, b = u / (4 * (SEQ / 64)), q0 = qb * 64;
#pragma unroll
        for (int it = 0; it < 5; ++it) { const int p = it * NTHR + tid, i = p >> 3, ch = p & 7;
            *(LAS u32x4*)(KS + i * AT_KST + 16 * ch) = kreg[it];
            const unsigned vv[4] = {vreg[it].x, vreg[it].y, vreg[it].z, vreg[it].w};
#pragma unroll
            for (int j = 0; j < 4; ++j) { *(LAS bf16*)(VT + (8 * ch + 2 * j) * AT_VST + 2 * i) = (bf16)(vv[j] & 0xffffu); *(LAS bf16*)(VT + (8 * ch + 2 * j + 1) * AT_VST + 2 * i) = (bf16)(vv[j] >> 16); } }
        const bf16x8 qf[4] = {qreg[0], qreg[1], qreg[2], qreg[3]}; const float m0 = sreg * LOG2E;
        if (u + G < NB * 4 * (SEQ / 64)) AT_LOAD(u + G);
        LDS_BARRIER();
        const int hl = wave >> 1, hq = kvh * 4 + hl, qw = q0 + 32 * (wave & 1), qi = qw + (lane & 31), hh = lane >> 5;
        float m = m0, l = hh == 0 ? 1.f : 0.f;
        f32x16 o0, o1;
#pragma unroll
        for (int r = 0; r < 16; ++r) { o0[r] = 0.f; o1[r] = 0.f; }
        const LAS float* btl = BT + hq * 260 + 128 - (lane & 31);
        const bool edge = (q0 < 128) || (q0 + 192 > SEQ);
#pragma unroll 1
        for (int j = 0; j < 9; ++j) {
            const int i0 = 32 * (wave & 1) + 32 * j;
            f32x16 sa;
#pragma unroll
            for (int r = 0; r < 16; ++r) sa[r] = 0.f;
#pragma unroll
            for (int ks = 0; ks < 4; ++ks) { const bf16x8 kf = *(const LAS bf16x8*)(KS + (i0 + (lane & 31)) * AT_KST + 32 * ks + 16 * hh); sa = MFMA32(kf, qf[ks], sa); }
            float mx = -3.0e38f;
#pragma unroll
            for (int r = 0; r < 16; ++r) {
                const int kk = 32 * j - 128 + crow(r, hh);
                sa[r] = sa[r] * sc2 + btl[kk];
            }
            if (edge || j == 0 || j == 8) {
#pragma unroll
                for (int r = 0; r < 16; ++r) {
                    const int kk = 32 * j - 128 + crow(r, hh), rel = kk - (lane & 31), key = qw + kk;
                    const bool ok = ((unsigned)(rel + 128) <= 256u) && ((unsigned)key < (unsigned)SEQ);
                    sa[r] = ok ? sa[r] : -3.0e38f;
                }
            }
#pragma unroll
            for (int r = 0; r < 16; ++r) mx = fmaxf(mx, sa[r]);
            mx = fmaxf(mx, __shfl_xor(mx, 32));
            if (!__all(mx <= m)) {
                const float mn = fmaxf(m, mx), alpha = __builtin_amdgcn_exp2f(m - mn); m = mn; l *= alpha;
#pragma unroll
                for (int r = 0; r < 16; ++r) { o0[r] *= alpha; o1[r] *= alpha; }
            }
            float ps = 0.f;
#pragma unroll
            for (int r = 0; r < 16; ++r) { const float p = __builtin_amdgcn_exp2f(sa[r] - m); sa[r] = p; ps += p; }
            l += ps;
#pragma unroll
            for (int s = 0; s < 2; ++s) {
                u32x4 pw; pw.x = pk2(sa[8 * s], sa[8 * s + 1]); pw.y = pk2(sa[8 * s + 2], sa[8 * s + 3]); pw.z = pk2(sa[8 * s + 4], sa[8 * s + 5]); pw.w = pk2(sa[8 * s + 6], sa[8 * s + 7]);
                const bf16x8 pf = __builtin_bit_cast(bf16x8, pw);
#pragma unroll
                for (int dt = 0; dt < 2; ++dt) {
                    const LAS unsigned char* vp = VT + (dt * 32 + (lane & 31)) * AT_VST + 2 * (i0 + 16 * s + 4 * hh);
                    const bf16x4 va = *(const LAS bf16x4*)vp, vb = *(const LAS bf16x4*)(vp + 16);
                    const bf16x8 vf = __builtin_shufflevector(va, vb, 0, 1, 2, 3, 4, 5, 6, 7);
                    if (dt == 0) o0 = MFMA32(vf, pf, o0); else o1 = MFMA32(vf, pf, o1);
                }
            }
        }
        l += __shfl_xor(l, 32);
        const float inv = __builtin_amdgcn_rcpf(l);
        bf16* op = ao + ((size_t)b * SEQ + qi) * D + hq * 64 + 4 * hh;
#pragma unroll
        for (int g = 0; g < 4; ++g) {
            u32x2 w0, w1; w0.x = pk2(o0[4 * g] * inv, o0[4 * g + 1] * inv); w0.y = pk2(o0[4 * g + 2] * inv, o0[4 * g + 3] * inv);
            w1.x = pk2(o1[4 * g] * inv, o1[4 * g + 1] * inv); w1.y = pk2(o1[4 * g + 2] * inv, o1[4 * g + 3] * inv);
            *(u32x2*)(op + 8 * g) = w0; *(u32x2*)(op + 32 + 8 * g) = w1;
        }
        LDS_BARRIER();
    }
#undef AT_LOAD
}
#ifndef MK_N_LAUNCHES
#define MK_N_LAUNCHES 1
#endif
constexpr int N_PHASES = 19;
#ifndef PH_MASK
#define PH_MASK 0xFFFFFFFFu
#endif
#define ON(k) (((PH_MASK) >> (k)) & 1u)
#ifndef REP_MASK
#define REP_MASK 0u
#endif
#define NREP(k) ((((REP_MASK) >> (k)) & 1u) ? 2 : 1)

template <int LAYER>
__device__ __forceinline__ void common_phases(unsigned char* ws, LAS unsigned char* lds, float* dout, const XcdBarrier& bar, int lo, int hi, int bid, int G, int tid, int wave, int lane) {
    constexpr int pb = LAYER == 0 ? 5 : 13;
    const int gw = bid * NWAVES + wave, NGW = G * NWAVES;
#define IN(k) (lo <= (k) && (k) < hi)
#define SEAM(k) do { if (IN(k) && IN((k) + 1)) xcd_barrier(bar); } while (0)
    if (ON(5) && IN(pb)) {
        pg8::Gemm g{(const bf16*)(ws + (LAYER == 0 ? WS_X64 : WS_AO)), (const bf16*)(ws + (LAYER == 0 ? WS_WOUT : WS_COUT)), T, D, D, 0, nullptr}; pg8::StaticOrder S; S.init(T, D, G, bid);
        pg8::EpiBf16 E{(bf16*)(ws + WS_Z), D};
        pg8::gemm_phase<pg8::EpiBf16, pg8::StaticOrder, false>(lds, g, S, E);
    }
    SEAM(pb);
    if (ON(6) && IN(pb + 1)) { ln_router<LAYER == 0>(ws, inp(lds, I_X), inp(lds, I_LNMG) + LAYER * D, inp(lds, I_LNMB) + LAYER * D, inp(lds, I_BGRP) + LAYER * 4, inp(lds, I_BRT) + LAYER * 32, LAYER, lds, bid, G, tid, wave, lane); __syncthreads(); }
    SEAM(pb + 1);
    if (ON(7) && IN(pb + 2)) { moe_sort(ws, lds, bid, G, tid); __syncthreads(); }
    SEAM(pb + 2);
    if (ON(8) && IN(pb + 3)) {
        const int* tile = (const int*)(ws + WS_TILE); const int ntiles = __builtin_amdgcn_readfirstlane(tile[511]);
        pg8::Gemm g{(const bf16*)(ws + WS_HHI), LAYER == 0 ? (const bf16*)(ws + WS_W13) : (const bf16*)dout, 0, D, D, (size_t)D * D * 2, (const int*)(ws + WS_SLOTT)};
        pg8::GroupOrder S{tile, ntiles, D / 256, G, bid};
        pg8::EpiSwiglu E{(bf16*)(ws + WS_HID), DEXP};
        pg8::gemm_phase<pg8::EpiSwiglu, pg8::GroupOrder, true>(lds, g, S, E);
        if (LAYER == 0) idle_convert(0, ws, lds, dout, ntiles, bid, G, wave, lane);
    }
    SEAM(pb + 3);
    if (ON(9) && IN(pb + 4)) {
        const int* tile = (const int*)(ws + WS_TILE); const int ntiles = __builtin_amdgcn_readfirstlane(tile[511]);
        pg8::Gemm g{(const bf16*)(ws + WS_HID), LAYER == 0 ? (const bf16*)(ws + WS_W2) : (const bf16*)dout + (size_t)NEXP * D * D, 0, D, DEXP, (size_t)D * DEXP * 2, nullptr};
        pg8::GroupOrder S{tile, ntiles, D / 256, G, bid};
        pg8::EpiBf16 E{(bf16*)(ws + WS_Y2), D};
        pg8::gemm_phase<pg8::EpiBf16, pg8::GroupOrder, false>(lds, g, S, E);
        if (LAYER == 0) idle_convert(1, ws, lds, dout, ntiles, bid, G, wave, lane);
    }
    SEAM(pb + 4);
    if (ON(10) && IN(pb + 5)) {
        if (LAYER == 0) {
            combine_ln<false>(ws, inp(lds, I_LNFG), inp(lds, I_LNFB), nullptr, gw, NGW, lane);
            { const int done = idle_done(__builtin_amdgcn_readfirstlane(((const int*)(ws + WS_TILE))[511]), G);
              moe_convert(inp(lds, I_W1) + (size_t)NEXP * D * DEXP, inp(lds, I_W3) + (size_t)NEXP * D * DEXP, inp(lds, I_W2) + (size_t)NEXP * DEXP * D, (bf16*)dout, (bf16*)dout + (size_t)NEXP * D * D, (LAS float*)(lds + wave * 16384), done, MOE_ITEMS, gw, NGW, lane); }
            __syncthreads();
        } else combine_ln<true>(ws, inp(lds, I_LNFG) + D, inp(lds, I_LNFB) + D, dout, gw, NGW, lane);
    }
    if (LAYER == 0) SEAM(10);
#undef IN
#undef SEAM
}

struct Args { const float* in[N_IN]; float* out; unsigned char* ws; int ph_lo, ph_hi; };
static_assert(sizeof(Args) == N_IN * 8 + 8 + 8 + 8, "no padding holes in Args");

__global__ void __launch_bounds__(NTHR, 2) fwd_kernel(Args args) {
    extern __shared__ __attribute__((aligned(16))) unsigned char lds_raw[];
    LAS unsigned char* lds = (LAS unsigned char*)lds_raw;
    volatile LAS unsigned* MISC = (volatile LAS unsigned*)(lds + MISC_OFF);
    const int tid = threadIdx.x, lane = tid & 63, wave = __builtin_amdgcn_readfirstlane(tid >> 6), G = gridDim.x, bid = blockIdx.x;
    unsigned char* ws = args.ws;
    for (int u = tid; u < 64; u += NTHR) MISC[u] = 0u;
    if (tid < N_IN) *(LAS unsigned long long*)(lds + PTR_OFF + 8 * tid) = (unsigned long long)args.in[tid];
    __syncthreads();
    const int lo = args.ph_lo, hi = args.ph_hi;
    const bool use_bar = (hi - lo) > 1;
    XcdBarrier bar; bar.bar = (unsigned*)(ws + WS_CTL) + CW_BAR; bar.x = 0; bar.st = nullptr;
    if (use_bar) bar = xcd_barrier_post((unsigned*)(ws + WS_CTL) + CW_BAR, MISC + 8);
#define IN(k) (lo <= (k) && (k) < hi)
#define SEAM(k) do { if (IN(k) && IN((k) + 1)) xcd_barrier(bar); } while (0)
    const int gw = bid * NWAVES + wave, NGW = G * NWAVES;

    if (ON(0) && IN(0)) { p0_prologue(ws, lds, bid, G, tid, wave, lane); __syncthreads(); }
    SEAM(0);
    if (ON(1) && IN(1)) {
        pg8::Gemm g{(const bf16*)(ws + WS_X64), (const bf16*)(ws + WS_WIN), T, ABN, D, 0, nullptr}; pg8::SplitOrder S; S.init(T, ABN, 2, G, bid);
        pg8::EpiBf16 E{(bf16*)(ws + WS_H0), H0P};
        pg8::gemm_phase<pg8::EpiBf16, pg8::SplitOrder, false>(lds, g, S, E);
        lr_tail(ws, args.out, inp(lds, I_GATEW), inp(lds, I_GATEB), lds, bid, G, tid, wave, lane);
#ifdef TAIL_TWICE
        lr_tail(ws, args.out, inp(lds, I_GATEW), inp(lds, I_GATEB), lds, bid, G, tid, wave, lane);
#endif
    }
    SEAM(1);
    if (ON(2) && IN(2)) {
        s5_phase<1>(ws, inp(lds, I_S5D), lds, bid, G, tid, wave, lane);
#ifdef S5_TWICE
        __syncthreads(); s5_phase<1>(ws, inp(lds, I_S5D), lds, bid, G, tid, wave, lane);
#endif
        __syncthreads();
        for (int it = bid; it < 256; it += G) gla_item<1>(ws, args.out, it, lds, tid, wave, lane);
#ifdef GLA_TWICE
        for (int it = bid; it < 256; it += G) gla_item<1>(ws, args.out, it, lds, tid, wave, lane);
#endif
    }
    SEAM(2);
    if (ON(3) && IN(3)) {
        s5_phase<2>(ws, inp(lds, I_S5D), lds, bid, G, tid, wave, lane);
#ifdef S5_TWICE
        __syncthreads(); s5_phase<2>(ws, inp(lds, I_S5D), lds, bid, G, tid, wave, lane);
#endif
        __syncthreads();
        for (int it = bid; it < 256; it += G) gla_item<2>(ws, args.out, it, lds, tid, wave, lane);
#ifdef GLA_TWICE
        for (int it = bid; it < 256; it += G) gla_item<2>(ws, args.out, it, lds, tid, wave, lane);
#endif
    }
    SEAM(3);
    if (ON(4) && IN(4)) {
        gla_finalize(ws, inp(lds, I_NORMG), gw, NGW, lane);
        pg8::Gemm g{(const bf16*)(ws + WS_YG), (const bf16*)(ws + WS_WGLU), T, 512, 512, 0, nullptr}; pg8::StaticOrder S; S.init(T, 512, G, bid);
        pg8::EpiGlu E{(const bf16*)(ws + WS_YG), 512, (bf16*)(ws + WS_X64), D, inp(lds, I_GLUB)};
        pg8::gemm_phase<pg8::EpiGlu, pg8::StaticOrder, false>(lds, g, S, E);
    }
    SEAM(4);
    common_phases<0>(ws, lds, args.out, bar, lo, hi, bid, G, tid, wave, lane);
    if (ON(11) && IN(11)) {
        pg8::Gemm g{(const bf16*)(ws + WS_H2B), (const bf16*)(ws + WS_CIN), T, CN, D, 0, nullptr}; pg8::StaticOrder S; S.init(T, CN, G, bid);
        pg8::EpiBf16 E{(bf16*)(ws + WS_QKV), CN};
        pg8::gemm_phase<pg8::EpiBf16, pg8::StaticOrder, false>(lds, g, S, E);
    }
    SEAM(11);
    if (ON(12) && IN(12)) attn_phase(ws, inp(lds, I_SINK), lds, bid, G, tid, wave, lane);
    SEAM(12);
    common_phases<1>(ws, lds, args.out, bar, lo, hi, bid, G, tid, wave, lane);
#undef IN
#undef SEAM
}

extern "C" void kernel_launch(void* const* d_in, const int* in_sizes, int n_in, void* d_out, int out_size, void* d_ws, size_t ws_size, hipStream_t stream) {
    static int grid = 0;
    if (grid == 0) {
        if (n_in != N_IN || in_sizes[0] != T * D || out_size != T * D || ws_size < WS_END) { fprintf(stderr, "kernel_launch: unexpected shapes (n_in %d, in0 %d, out %d, ws %zu < %zu)\n", n_in, n_in > 0 ? in_sizes[0] : -1, out_size, ws_size, (size_t)WS_END); grid = -1; return; }
        int dev = 0, cus = 0, per_cu = 0;
        if (hipGetDevice(&dev) != hipSuccess || hipDeviceGetAttribute(&cus, hipDeviceAttributeMultiprocessorCount, dev) != hipSuccess) { grid = -1; return; }
        if (hipFuncSetAttribute((const void*)fwd_kernel, hipFuncAttributeMaxDynamicSharedMemorySize, LDS_BYTES) != hipSuccess) { fprintf(stderr, "kernel_launch: hipFuncSetAttribute failed\n"); grid = -1; return; }
        if (hipOccupancyMaxActiveBlocksPerMultiprocessor(&per_cu, (const void*)fwd_kernel, NTHR, LDS_BYTES) != hipSuccess || per_cu < 1) fprintf(stderr, "kernel_launch: occupancy query reports %d\n", per_cu);
        (void)hipGetLastError();
        grid = cus;
    }
    if (grid < 0) return;
    if (hipMemsetAsync((char*)d_ws + WS_CTL, 0, CTL_ZERO_BYTES, stream) != hipSuccess) return;
    Args a{};
    for (int i = 0; i < N_IN; ++i) a.in[i] = (const float*)d_in[i];
    a.out = (float*)d_out; a.ws = (unsigned char*)d_ws;
    for (int li = 0; li < MK_N_LAUNCHES; ++li) {
        a.ph_lo = (MK_N_LAUNCHES == 1) ? 0 : li; a.ph_hi = (MK_N_LAUNCHES == 1) ? N_PHASES : li + 1;
        for (int rep = 0; rep < ((MK_N_LAUNCHES > 1 && ((REP_MASK >> li) & 1u)) ? 2 : 1); ++rep)
            hipLaunchKernelGGL(fwd_kernel, dim3(grid), dim3(NTHR), LDS_BYTES, stream, a);
    }
}
```

```cpp
#include <hip/hip_runtime.h>
#include <cstdio>
#include <cstdint>
#include <cmath>
namespace pg8 {
#define PG8_LAS __attribute__((address_space(3)))
typedef unsigned short bf16_t;
typedef short bf16x8 __attribute__((ext_vector_type(8)));
typedef float f32x4 __attribute__((ext_vector_type(4)));
typedef float f32x2 __attribute__((ext_vector_type(2)));
typedef unsigned u32x4 __attribute__((ext_vector_type(4)));
typedef unsigned u32x2 __attribute__((ext_vector_type(2)));
constexpr int BM = 256, BK = 64, HALF = 128, HTB = HALF * BK * 2  , STAGE_BYTES = 8 * HTB, NXCD = 8, WGM = 8;

__host__ __device__ __forceinline__ int lds_byte(int r, int c) { const int st = (r >> 4) * 2 + (c >> 5), rr = r & 15, cc = c & 31, ob = rr * 64 + cc * 2; return st * 1024 + (ob ^ (((ob >> 9) & 1) << 5)); }
__host__ __device__ __forceinline__ void stage_rc(int b, int& R, int& C) { const int st = b / 1024, sb = b % 1024, swz = sb ^ (((sb >> 9) & 1) << 5); R = (st >> 1) * 16 + swz / 64; C = (st & 1) * 32 + (swz % 64) / 2; }
__host__ __device__ __forceinline__ int perm32(int rho) { const int n = rho >> 4, i = rho & 15; return 8 * (i >> 2) + 4 * n + (i & 3); }

struct Unit { int pm, pn, e, ui; };
struct Gemm { const bf16_t* A; const bf16_t* Bt; int M, N, K; size_t bstride; const int* rowmap; };

struct StaticOrder {
    int nM, nN, nwg, G, c;
    __host__ __device__ void init(int M, int N, int G_, int c_) { nM = M / BM; nN = N / BM; nwg = nM * nN; G = G_; c = c_; }
    __host__ __device__ bool next(int i, Unit& u) const {
        const long L = (long)i * G + c; if (L >= nwg) return false;
        int wgid = (int)L; { const int q = nwg / NXCD, r = nwg % NXCD, xcd = wgid % NXCD, off = wgid / NXCD; wgid = (xcd < r ? xcd * (q + 1) : r * (q + 1) + (xcd - r) * q) + off; }
        const int nig = WGM * nN, gid = wgid / nig, fm = gid * WGM, gsz = (nM - fm) < WGM ? (nM - fm) : WGM;
        u.pm = fm + ((wgid % nig) % gsz); u.pn = (wgid % nig) / gsz; u.e = 0; u.ui = i; return true;
    }
};
struct SplitOrder {
    int nM, nNs, nwgs, nsp, G, c;
    __host__ __device__ void init(int M, int N, int nsp_, int G_, int c_) { nM = M / BM; nNs = N / BM / nsp_; nwgs = nM * nNs; nsp = nsp_; G = G_; c = c_; }
    __host__ __device__ bool next(int i, Unit& u) const {
        const long L = (long)i * G + c; if (L >= (long)nwgs * nsp) return false;
        const int slab = (int)(L / nwgs); int wgid = (int)(L % nwgs);
        { const int q = nwgs / NXCD, r = nwgs % NXCD, xcd = wgid % NXCD, off = wgid / NXCD; wgid = (xcd < r ? xcd * (q + 1) : r * (q + 1) + (xcd - r) * q) + off; }
        const int nig = WGM * nNs, gid = wgid / nig, fm = gid * WGM, gsz = (nM - fm) < WGM ? (nM - fm) : WGM;
        u.pm = fm + ((wgid % nig) % gsz); u.pn = slab * nNs + (wgid % nig) / gsz; u.e = 0; u.ui = i; return true;
    }
};
struct GroupOrder {
    const int* tile_e; int ntiles, nN, G, c;
    __device__ bool next(int i, Unit& u) const {
        const int L = i * G + c; if (L >= ntiles * nN) return false;
        u.pm = L / nN; u.pn = L % nN; u.e = __builtin_amdgcn_readfirstlane(tile_e[u.pm]); u.ui = i; return true;
    }
};

typedef __bf16 bf16x2_t __attribute__((ext_vector_type(2)));
__device__ __forceinline__ unsigned cvt_pk_bf16(float lo, float hi) { f32x2 v = {lo, hi}; return __builtin_bit_cast(unsigned, __builtin_convertvector(v, bf16x2_t)); }
__device__ __forceinline__ float bf_lo(unsigned w) { return __uint_as_float(w << 16); }
__device__ __forceinline__ float bf_hi(unsigned w) { return __uint_as_float(w & 0xffff0000u); }

struct EpiBf16 {
    static constexpr bool PERM = true;
    bf16_t* O; int ldc;
    __device__ __forceinline__ void operator()(const f32x4 (&acc)[2][2][4][2], const Unit& u, int wr, int wc, int fr, int fq) const {
        const int row0 = u.pm * BM + wr * 64 + fr; const int col0 = u.pn * BM + wc * 32 + 8 * fq;
#pragma unroll
        for (int ai = 0; ai < 2; ++ai)
#pragma unroll
            for (int m = 0; m < 4; ++m) { bf16_t* rowp = O + (size_t)(row0 + ai * HALF + m * 16) * ldc + col0;
#pragma unroll
                for (int bj = 0; bj < 2; ++bj) { const f32x4 v0 = acc[ai][bj][m][0], v1 = acc[ai][bj][m][1];
                    u32x4 w; w.x = cvt_pk_bf16(v0[0], v0[1]); w.y = cvt_pk_bf16(v0[2], v0[3]); w.z = cvt_pk_bf16(v1[0], v1[1]); w.w = cvt_pk_bf16(v1[2], v1[3]);
                    *(u32x4*)(rowp + bj * HALF) = w; } }
    }
};
struct EpiGlu {
    static constexpr bool PERM = true;
    const bf16_t* Y; int ldy; bf16_t* O; int ldc; const float* bias;
    __device__ __forceinline__ void operator()(const f32x4 (&acc)[2][2][4][2], const Unit& u, int wr, int wc, int fr, int fq) const {
        const int row0 = u.pm * BM + wr * 64 + fr; const int col0 = u.pn * BM + wc * 32 + 8 * fq;
        f32x4 bv[2][2];
#pragma unroll
        for (int bj = 0; bj < 2; ++bj)
#pragma unroll
            for (int n = 0; n < 2; ++n) bv[bj][n] = *(const f32x4*)(bias + col0 + bj * HALF + 4 * n);
#pragma unroll
        for (int ai = 0; ai < 2; ++ai) {
            u32x4 yq[4][2];
#pragma unroll
            for (int m = 0; m < 4; ++m)
#pragma unroll
                for (int bj = 0; bj < 2; ++bj) yq[m][bj] = *(const u32x4*)(Y + (size_t)(row0 + ai * HALF + m * 16) * ldy + col0 + bj * HALF);
            asm volatile("" ::: "memory");
#pragma unroll
            for (int m = 0; m < 4; ++m) { const size_t r = (size_t)(row0 + ai * HALF + m * 16);
#pragma unroll
                for (int bj = 0; bj < 2; ++bj) { const f32x4 v0 = acc[ai][bj][m][0] + bv[bj][0], v1 = acc[ai][bj][m][1] + bv[bj][1];
                    const u32x4 y = yq[m][bj];
                    float o[8]; const float yv[8] = {bf_lo(y.x), bf_hi(y.x), bf_lo(y.y), bf_hi(y.y), bf_lo(y.z), bf_hi(y.z), bf_lo(y.w), bf_hi(y.w)};
#pragma unroll
                    for (int i = 0; i < 4; ++i) { o[i] = yv[i] * __builtin_amdgcn_rcpf(1.f + __expf(-v0[i])); o[4 + i] = yv[4 + i] * __builtin_amdgcn_rcpf(1.f + __expf(-v1[i])); }
                    u32x4 w; w.x = cvt_pk_bf16(o[0], o[1]); w.y = cvt_pk_bf16(o[2], o[3]); w.z = cvt_pk_bf16(o[4], o[5]); w.w = cvt_pk_bf16(o[6], o[7]);
                    *(u32x4*)(O + r * ldc + col0 + bj * HALF) = w; } }
            asm volatile("" ::: "memory");
        }
    }
};
struct EpiResid {
    static constexpr bool PERM = false;
    const float* resid; float* out; int ldc; float alpha;
    __device__ __forceinline__ void operator()(const f32x4 (&acc)[2][2][4][2], const Unit& u, int wr, int wc, int fr, int fq) const {
        const int col0 = u.pn * BM + wc * 32 + 4 * fq;
#pragma unroll
        for (int ai = 0; ai < 2; ++ai) {
            f32x4 bs[4][2][2];
#pragma unroll
            for (int m = 0; m < 4; ++m) { const size_t off = (size_t)(u.pm * BM + ai * HALF + wr * 64 + m * 16 + fr) * ldc + col0;
#pragma unroll
                for (int bj = 0; bj < 2; ++bj)
#pragma unroll
                    for (int n = 0; n < 2; ++n) bs[m][bj][n] = *(const f32x4*)(resid + off + bj * HALF + n * 16); }
            asm volatile("" ::: "memory");
#pragma unroll
            for (int m = 0; m < 4; ++m) { const size_t off = (size_t)(u.pm * BM + ai * HALF + wr * 64 + m * 16 + fr) * ldc + col0;
#pragma unroll
                for (int bj = 0; bj < 2; ++bj)
#pragma unroll
                    for (int n = 0; n < 2; ++n) *(f32x4*)(out + off + bj * HALF + n * 16) = bs[m][bj][n] * alpha + acc[ai][bj][m][n]; }
            asm volatile("" ::: "memory");
        }
    }
};
struct EpiSwiglu {
    static constexpr bool PERM = true;
    bf16_t* O; int ldc;
    __device__ __forceinline__ void operator()(const f32x4 (&acc)[2][2][4][2], const Unit& u, int wr, int wc, int fr, int fq) const {
        const int row0 = u.pm * BM + wr * 64 + fr; const int col0 = (u.pn * BM + wc * 32 + 8 * fq) >> 1;
#pragma unroll
        for (int ai = 0; ai < 2; ++ai)
#pragma unroll
            for (int m = 0; m < 4; ++m) { bf16_t* rowp = O + (size_t)(row0 + ai * HALF + m * 16) * ldc + col0;
#pragma unroll
                for (int bj = 0; bj < 2; ++bj) { const f32x4 g = acc[ai][bj][m][0], up = acc[ai][bj][m][1]; float o[4];
#pragma unroll
                    for (int i = 0; i < 4; ++i) o[i] = g[i] * __builtin_amdgcn_rcpf(1.f + __expf(-g[i])) * up[i];
                    u32x2 w; w.x = cvt_pk_bf16(o[0], o[1]); w.y = cvt_pk_bf16(o[2], o[3]);
                    *(u32x2*)(rowp + bj * (HALF / 2)) = w; } }
    }
};
struct EpiScale {
    static constexpr bool PERM = true;
    bf16_t* O; int ldc; const float* rw;
    __device__ __forceinline__ void operator()(const f32x4 (&acc)[2][2][4][2], const Unit& u, int wr, int wc, int fr, int fq) const {
        const int row0 = u.pm * BM + wr * 64 + fr; const int col0 = u.pn * BM + wc * 32 + 8 * fq;
        float sw[2][4];
#pragma unroll
        for (int ai = 0; ai < 2; ++ai)
#pragma unroll
            for (int m = 0; m < 4; ++m) sw[ai][m] = rw[row0 + ai * HALF + m * 16];
        asm volatile("" ::: "memory");
#pragma unroll
        for (int ai = 0; ai < 2; ++ai)
#pragma unroll
            for (int m = 0; m < 4; ++m) { const int r = row0 + ai * HALF + m * 16; const float s = sw[ai][m]; bf16_t* rowp = O + (size_t)r * ldc + col0;
#pragma unroll
                for (int bj = 0; bj < 2; ++bj) { const f32x4 v0 = acc[ai][bj][m][0] * s, v1 = acc[ai][bj][m][1] * s;
                    u32x4 w; w.x = cvt_pk_bf16(v0[0], v0[1]); w.y = cvt_pk_bf16(v0[2], v0[3]); w.z = cvt_pk_bf16(v1[0], v1[1]); w.w = cvt_pk_bf16(v1[2], v1[3]);
                    *(u32x4*)(rowp + bj * HALF) = w; } }
    }
};

template <class Epi, class Sched, bool GATHER>
__device__ __forceinline__ void gemm_phase(PG8_LAS unsigned char* lds, const Gemm g, const Sched& S, const Epi& E) {
    const int tid = threadIdx.x, wid = __builtin_amdgcn_readfirstlane(tid >> 6), lane = tid & 63, wr = wid >> 2, wc = wid & 3, fr = lane & 15, fq = lane >> 4;
    const int K = g.K, nt = K / BK;
    unsigned voffA[2], voffB[2]; int RA[2], CA[2];
#pragma unroll
    for (int i = 0; i < 2; ++i) { int R, C; stage_rc(tid * 16 + i * 8192, R, C); const int Rb = Epi::PERM ? ((R & ~31) + perm32(R & 31)) : R;
        voffA[i] = (unsigned)(R * K + C) * 2u; voffB[i] = (unsigned)(Rb * K + C) * 2u; RA[i] = R; CA[i] = C; }
    const size_t kstep = (size_t)(BK * 2);
    const size_t hstep = (size_t)HALF * K * 2;
    const size_t tstep = 2 * hstep;
    const unsigned ldsw = (unsigned)wid * 1024u;
    const int aoff = lds_byte(wr * 64 + fr, fq * 8), boff = lds_byte(wc * 32 + fr, fq * 8);
#define PG8_SA(b, h) (((b) * 2 + (h)) * HTB)
#define PG8_SB(b, h) ((4 + (b) * 2 + (h)) * HTB)
#define PG8_STAGE(bufoff, gbase, voff) do { _Pragma("unroll") for (int _i = 0; _i < 2; ++_i) \
        __builtin_amdgcn_global_load_lds((const unsigned*)((const char*)(gbase) + (voff)[_i]), (PG8_LAS unsigned*)(lds + (bufoff) + ldsw + _i * 8192), 16, 0, 0); } while (0)
#define PG8_LDA(dst, b, h) do { _Pragma("unroll") for (int m = 0; m < 4; ++m) _Pragma("unroll") for (int k = 0; k < 2; ++k) dst[m][k] = *(const PG8_LAS bf16x8*)(lds + PG8_SA(b, h) + aoff + m * 2048 + k * 1024); } while (0)
#define PG8_LDB(dst, b, h) do { _Pragma("unroll") for (int n = 0; n < 2; ++n) _Pragma("unroll") for (int k = 0; k < 2; ++k) dst[n][k] = *(const PG8_LAS bf16x8*)(lds + PG8_SB(b, h) + boff + n * 2048 + k * 1024); } while (0)
#define PG8_MMA(ai, bj, At, Bt) do { __builtin_amdgcn_s_setprio(1); _Pragma("unroll") for (int m = 0; m < 4; ++m) _Pragma("unroll") for (int n = 0; n < 2; ++n) _Pragma("unroll") for (int k = 0; k < 2; ++k) \
        acc[ai][bj][m][n] = __builtin_amdgcn_mfma_f32_16x16x32_bf16(Bt[n][k], At[m][k], acc[ai][bj][m][n], 0, 0, 0); __builtin_amdgcn_s_setprio(0); } while (0)
#define PG8_WAIT_V(n) asm volatile("s_waitcnt vmcnt(" #n ")" ::: "memory")
#define PG8_WAIT_L(n) asm volatile("s_waitcnt lgkmcnt(" #n ")" ::: "memory")
#define PG8_BAR __builtin_amdgcn_s_barrier()
#define PG8_SCHED __builtin_amdgcn_sched_barrier(0)
    Unit cur, nxt; int ui = 0;
    const PG8_LAS int* rmap = (const PG8_LAS int*)(lds + STAGE_BYTES);
    if (GATHER) { Unit t_; for (int i_ = 0; S.next(i_, t_) && i_ < 16; ++i_) { if (tid < BM) ((PG8_LAS int*)(lds + STAGE_BYTES))[i_ * BM + tid] = g.rowmap[t_.pm * BM + tid]; }
        asm volatile("s_waitcnt vmcnt(0) lgkmcnt(0)" ::: "memory"); __builtin_amdgcn_s_barrier(); asm volatile("" ::: "memory"); }
    if (!S.next(0, cur)) return;
    f32x4 acc[2][2][4][2];
#pragma unroll
    for (int a = 0; a < 2; ++a)
#pragma unroll
        for (int b = 0; b < 2; ++b)
#pragma unroll
            for (int m = 0; m < 4; ++m)
#pragma unroll
                for (int n = 0; n < 2; ++n) acc[a][b][m][n] = (f32x4){0.f, 0.f, 0.f, 0.f};
    bf16x8 At[4][2], B0[2][2], B1[2][2];
    unsigned cG[2][2], nG[2][2];
#define PG8_LOAD_ROWS(u_, G2_) do { _Pragma("unroll") for (int h_ = 0; h_ < 2; ++h_) _Pragma("unroll") for (int i_ = 0; i_ < 2; ++i_) \
        G2_[h_][i_] = GATHER ? ((unsigned)rmap[(u_).ui * BM + h_ * HALF + RA[i_]] * (unsigned)K + (unsigned)CA[i_]) * 2u : voffA[i_]; } while (0)
    const char* cA = GATHER ? (const char*)g.A : (const char*)g.A + (size_t)cur.pm * tstep;
    const size_t hA = GATHER ? 0 : hstep;
    const char* cB = (const char*)g.Bt + (size_t)cur.e * g.bstride + (size_t)cur.pn * tstep;
    PG8_LOAD_ROWS(cur, cG);
    PG8_STAGE(PG8_SB(0, 0), cB, voffB); PG8_STAGE(PG8_SB(0, 1), cB + hstep, voffB); PG8_STAGE(PG8_SA(0, 0), cA, cG[0]); PG8_STAGE(PG8_SA(0, 1), cA + hA, cG[1]);
    if (wr == 1) PG8_BAR;
    PG8_WAIT_V(2); PG8_BAR;
    PG8_STAGE(PG8_SB(1, 0), cB + kstep, voffB); PG8_STAGE(PG8_SA(1, 0), cA + kstep, cG[0]); PG8_STAGE(PG8_SB(1, 1), cB + hstep + kstep, voffB);
    PG8_WAIT_V(6); PG8_BAR;
    for (;;) {
        const bool has_next = S.next(ui + 1, nxt);
        const char* nA = GATHER ? (const char*)g.A : (has_next ? (const char*)g.A + (size_t)nxt.pm * tstep : cA);
        const char* nB = has_next ? (const char*)g.Bt + (size_t)nxt.e * g.bstride + (size_t)nxt.pn * tstep : cB;
        if (has_next) PG8_LOAD_ROWS(nxt, nG); else {
#pragma unroll
            for (int h = 0; h < 2; ++h) { nG[h][0] = cG[h][0]; nG[h][1] = cG[h][1]; } }
        for (int t = 0; t < nt; t += 2) {
            const bool last = (t == nt - 2);
            const char* a1 = cA + (size_t)(t + 1) * kstep;
            const char* a2 = last ? nA : cA + (size_t)(t + 2) * kstep; const char* b2 = last ? nB : cB + (size_t)(t + 2) * kstep;
            const char* a3 = a2 + kstep; const char* b3 = b2 + kstep;
            unsigned sG[2][2];
#pragma unroll
            for (int h = 0; h < 2; ++h) { sG[h][0] = (GATHER && last) ? nG[h][0] : cG[h][0]; sG[h][1] = (GATHER && last) ? nG[h][1] : cG[h][1]; }
            PG8_LDB(B0, 0, 0); PG8_LDB(B1, 0, 1); PG8_SCHED; PG8_LDA(At, 0, 0); PG8_STAGE(PG8_SA(1, 1), a1 + hA, cG[1]);
            PG8_WAIT_V(8); PG8_WAIT_L(0); PG8_BAR; PG8_MMA(0, 0, At, B0); PG8_MMA(0, 1, At, B1); PG8_BAR; PG8_SCHED;
            PG8_LDA(At, 0, 1); PG8_STAGE(PG8_SB(0, 0), b2, voffB); PG8_STAGE(PG8_SB(0, 1), b2 + hstep, voffB); PG8_STAGE(PG8_SA(0, 0), a2, sG[0]);
            PG8_WAIT_V(8); PG8_WAIT_L(0); PG8_BAR; PG8_MMA(1, 0, At, B0); PG8_MMA(1, 1, At, B1); PG8_BAR; PG8_SCHED;
            PG8_LDB(B0, 1, 0); PG8_LDB(B1, 1, 1); PG8_SCHED; PG8_LDA(At, 1, 0); PG8_STAGE(PG8_SA(0, 1), a2 + hA, sG[1]);
            PG8_WAIT_V(8); PG8_WAIT_L(0); PG8_BAR; PG8_MMA(0, 0, At, B0); PG8_MMA(0, 1, At, B1); PG8_BAR; PG8_SCHED;
            PG8_LDA(At, 1, 1); PG8_STAGE(PG8_SB(1, 0), b3, voffB); PG8_STAGE(PG8_SB(1, 1), b3 + hstep, voffB); PG8_STAGE(PG8_SA(1, 0), a3, sG[0]);
            PG8_WAIT_V(8); PG8_WAIT_L(0); PG8_BAR; PG8_MMA(1, 0, At, B0); PG8_MMA(1, 1, At, B1); PG8_BAR; PG8_SCHED;
        }
        if (wr == 0) PG8_BAR;
        E(acc, cur, wr, wc, fr, fq);
        if (!has_next) break;
#pragma unroll
        for (int a = 0; a < 2; ++a)
#pragma unroll
            for (int b = 0; b < 2; ++b)
#pragma unroll
                for (int m = 0; m < 4; ++m)
#pragma unroll
                    for (int n = 0; n < 2; ++n) acc[a][b][m][n] = (f32x4){0.f, 0.f, 0.f, 0.f};
        cur = nxt; cA = nA; cB = nB; ++ui;
#pragma unroll
        for (int h = 0; h < 2; ++h) { cG[h][0] = nG[h][0]; cG[h][1] = nG[h][1]; }
        if (wr == 1) PG8_BAR;
    }
    PG8_WAIT_V(0);
    PG8_BAR;
#undef PG8_LOAD_ROWS
#undef PG8_SA
#undef PG8_SB
#undef PG8_STAGE
#undef PG8_LDA
#undef PG8_LDB
#undef PG8_MMA
#undef PG8_WAIT_V
#undef PG8_WAIT_L
#undef PG8_BAR
#undef PG8_SCHED
}
}
constexpr int NB = 2, SEQ = 16384, T = NB * SEQ, D = 1024;
constexpr int H0P = 2112;
constexpr int ABN = 2048, OFF_U = 0, OFF_Q = 512, OFF_K = 768, OFF_V = 1024, OFF_GO = 1536, AB_IN = 2080;
constexpr int CN = 1536;
constexpr int NEXP = 32, DEXP = 512, CAP = 2 * T + NEXP * 256, MAXTILES = CAP / 256;
constexpr int S5CH = 256, S5NCH = SEQ / S5CH;
constexpr int GSC = 16, GCH = 64, GNSC = SEQ / (GSC * GCH);
constexpr float ALPHA = 1.41421356237309515f;
constexpr float LN_EPS = 1e-5f, RMS_EPS = 1e-6f, LOG2E = 1.44269504088896341f;
constexpr int NWAVES = 8, NTHR = 512;

constexpr size_t MiB = 1u << 20, KiB = 1u << 10;
constexpr size_t WS_CTL = 0, CTL_ZERO_BYTES = 64 * KiB;
constexpr int CW_BAR = 4096;
constexpr size_t WS_LR = 1 * MiB;
constexpr size_t WS_S5E = 5 * MiB;
constexpr size_t WS_GS = 9 * MiB;
constexpr size_t WS_GD = 17 * MiB;
constexpr size_t WS_S5L = WS_GD + 64 * KiB;
constexpr size_t WS_S5B = WS_S5L + 64 * KiB;
constexpr size_t WS_S5C = WS_S5B + 256 * KiB;
constexpr size_t WS_BTAB = WS_S5C + 256 * KiB;
constexpr size_t WS_WR = WS_BTAB + 32 * KiB;
constexpr size_t WS_TOKE = WS_WR + 384 * KiB;
constexpr size_t WS_TOKW = WS_TOKE + 256 * KiB;
constexpr size_t WS_TOKS = WS_TOKW + 256 * KiB;
constexpr size_t WS_SLOTT = WS_TOKS + 256 * KiB;
constexpr size_t WS_SLOTW = WS_SLOTT + 288 * KiB;
constexpr size_t WS_BLKC = WS_SLOTW + 288 * KiB;
constexpr size_t WS_TILE = WS_BLKC + 32 * KiB;
static_assert(WS_TILE + 4 * KiB <= 32 * MiB, "param region");
constexpr size_t WS_WIN = 32 * MiB, WS_WLR = 36 * MiB, WS_WGLU = 37 * MiB, WS_WOUT = 38 * MiB, WS_CIN = 40 * MiB, WS_COUT = 43 * MiB;
constexpr size_t WS_W13 = 48 * MiB, WS_W2 = 112 * MiB;
constexpr size_t A0 = 144 * MiB;
constexpr size_t WS_H1 = A0, WS_HLO = A0, WS_HHI = A0 + 64 * MiB, WS_H0 = A0;
constexpr size_t WS_Z = A0 + 128 * MiB;
constexpr size_t WS_YG = A0 + 136 * MiB, WS_OF = A0 + 168 * MiB, WS_OB = A0 + 320 * MiB;
constexpr size_t WS_YSCR = A0 + 232 * MiB;
constexpr size_t WS_X64 = A0 + 256 * MiB;
constexpr size_t WS_HID = A0 + 128 * MiB;
constexpr size_t WS_Y2 = A0 + 200 * MiB;
constexpr size_t WS_H2B = WS_HHI;
constexpr size_t WS_QKV = A0 + 192 * MiB;
constexpr size_t WS_AO = A0 + 288 * MiB;
constexpr size_t WS_END = A0 + 384 * MiB;
static_assert((size_t)T * H0P * 2 <= 136 * MiB && WS_Y2 + (size_t)CAP * D * 2 <= WS_END && WS_OB + (size_t)T * 512 * 4 <= WS_END && WS_HID + (size_t)CAP * 512 * 2 <= WS_Y2, "act map");

constexpr int RING_BYTES = 131072;
constexpr int MISC_OFF = 163840 - 1024;
constexpr int PTR_OFF = MISC_OFF + 256;
constexpr int LDS_BYTES = 163840;

#define GAS __attribute__((address_space(1)))
#define LAS __attribute__((address_space(3)))
typedef unsigned short bf16;
typedef float f32x4 __attribute__((ext_vector_type(4)));
typedef float f32x2 __attribute__((ext_vector_type(2)));
typedef float f32x16 __attribute__((ext_vector_type(16)));
typedef short bf16x8 __attribute__((ext_vector_type(8)));
typedef short bf16x4 __attribute__((ext_vector_type(4)));
typedef unsigned u32x4 __attribute__((ext_vector_type(4)));
typedef unsigned u32x2 __attribute__((ext_vector_type(2)));
#define LDS_WAIT() asm volatile("s_waitcnt lgkmcnt(0)" ::: "memory")
#define VM_WAIT() asm volatile("s_waitcnt vmcnt(0)" ::: "memory")
#define LDS_BARRIER() do { asm volatile("s_waitcnt lgkmcnt(0)" ::: "memory"); __builtin_amdgcn_s_barrier(); asm volatile("" ::: "memory"); } while (0)
typedef __bf16 bf16x2_t __attribute__((ext_vector_type(2)));
__device__ __forceinline__ unsigned pk2(float lo, float hi) { f32x2 v = {lo, hi}; return __builtin_bit_cast(unsigned, __builtin_convertvector(v, bf16x2_t)); }
__device__ __forceinline__ unsigned f2bf(float f) { return pk2(f, 0.f) & 0xffffu; }
__device__ __forceinline__ float bf2f(unsigned short b) { return __uint_as_float((unsigned)b << 16); }
__device__ __forceinline__ float bflo(unsigned w) { return __uint_as_float(w << 16); }
__device__ __forceinline__ float bfhi(unsigned w) { return __uint_as_float(w & 0xffff0000u); }
__device__ __forceinline__ float wave_sum(float v) {
#pragma unroll
    for (int o = 1; o < 64; o <<= 1) v += __shfl_xor(v, o);
    return v;
}
__device__ __forceinline__ int crow(int r, int hi) { return (r & 3) + 8 * (r >> 2) + 4 * hi; }

#define XB_TMO      128
#define XB_XCNT(j)  (256  + 64 * (j))
#define XB_XSUB(j)  (1280 + 64 * (j))
#define XB_XGEN(j)  (2304 + 64 * (j))
#define XB_TOP      3328
#define XB_TOPGEN   3392
#define XCD_BAR_WORDS 3456
#define XB_SPIN_CAP (1u << 18)
__device__ __forceinline__ unsigned xb_ld(unsigned* p)              { return __hip_atomic_load(p, __ATOMIC_RELAXED, __HIP_MEMORY_SCOPE_AGENT); }
__device__ __forceinline__ unsigned xb_add(unsigned* p, unsigned v) { return __hip_atomic_fetch_add(p, v, __ATOMIC_RELAXED, __HIP_MEMORY_SCOPE_AGENT); }
__device__ __forceinline__ unsigned xb_xcc_id() { return (unsigned)__builtin_amdgcn_s_getreg((3 << 11) | 20) & 0xFu; }
#define XB_SPIN(cond, bar) do { unsigned _sp = 0; while (cond) { __builtin_amdgcn_s_sleep(1); \
    if ((++_sp & 255u) == 0u) { if (xb_ld(&(bar)[XB_TMO])) break; if (_sp > XB_SPIN_CAP) { atomicAdd(&(bar)[XB_TMO], 1u); break; } } } } while (0)
struct XcdBarrier { unsigned* bar; unsigned x; volatile LAS unsigned* st; };
__device__ __forceinline__ XcdBarrier xcd_barrier_post(unsigned* bar, volatile LAS unsigned* st) {
    XcdBarrier b; b.bar = bar; b.x = xb_xcc_id(); b.st = st;
    if (threadIdx.x == 0) (void)xb_add(&bar[XB_XCNT(b.x)], 1u);
    return b;
}
__device__ __forceinline__ void xcd_barrier_complete(unsigned* bar, unsigned x, unsigned& nloc, unsigned& nx) {
    const unsigned G = gridDim.x * gridDim.y * gridDim.z;
    unsigned sum, cnt, mine, sp = 0u;
    for (;;) {
        sum = 0u; cnt = 0u; mine = 0u;
#pragma unroll
        for (unsigned j = 0; j < 16; ++j) { const unsigned c = xb_ld(&bar[XB_XCNT(j)]); sum += c; cnt += (c > 0u) ? 1u : 0u; mine = (j == x) ? c : mine; }
        if (sum == G) break;
        __builtin_amdgcn_s_sleep(1);
        if ((++sp & 255u) == 0u) { if (xb_ld(&bar[XB_TMO])) break; if (sp > XB_SPIN_CAP) { atomicAdd(&bar[XB_TMO], 1u); break; } }
    }
    nloc = mine > 0u ? mine : 1u; nx = cnt > 0u ? cnt : 1u;
}
__device__ __forceinline__ void xcd_barrier(const XcdBarrier& b) {
    asm volatile("s_waitcnt vmcnt(0)" ::: "memory");
    __syncthreads();
    if (threadIdx.x == 0) {
        unsigned* bar = b.bar;
        __builtin_amdgcn_s_waitcnt(0);
        unsigned nloc = b.st[0], nx = b.st[1];
        if (nloc == 0u) { xcd_barrier_complete(bar, b.x, nloc, nx); b.st[0] = nloc; b.st[1] = nx; }
        const unsigned old = xb_add(&bar[XB_XSUB(b.x)], 1u);
        const unsigned gen = old / nloc;
        if (old + 1u == (gen + 1u) * nloc) {
            __builtin_amdgcn_fence(__ATOMIC_RELEASE, "agent");
            asm volatile("s_waitcnt vmcnt(0)" ::: "memory");
            const unsigned og = xb_add(&bar[XB_TOP], 1u);
            const unsigned tg = og / nx;
            if (og + 1u == (tg + 1u) * nx) xb_add(&bar[XB_TOPGEN], 1u);
            else XB_SPIN(xb_ld(&bar[XB_TOPGEN]) == tg, bar);
            __builtin_amdgcn_fence(__ATOMIC_ACQUIRE, "agent");
            xb_add(&bar[XB_XGEN(b.x)], 1u);
            asm volatile("s_waitcnt vmcnt(0)" ::: "memory");
        } else {
            XB_SPIN(xb_ld(&bar[XB_XGEN(b.x)]) == gen, bar);
            __builtin_amdgcn_fence(__ATOMIC_ACQUIRE, "agent");
            asm volatile("s_waitcnt vmcnt(0)" ::: "memory");
        }
    }
    __syncthreads();
}

struct Frame {
    LAS unsigned char* lds;
    int tid, lane, wave, G, bid;
    unsigned char* ws;
    const float* const* in;
};
enum InIdx { I_X = 0, I_LNMG, I_LNMB, I_LNFG, I_LNFB, I_ABWIN, I_LAMRE, I_LAMIM, I_LOGDT, I_BRE, I_BIM, I_CRE, I_CIM, I_S5D, I_GLUW, I_GLUB,
             I_GATEW, I_GATEB, I_NORMG, I_ABWOUT, I_CWIN, I_SINK, I_CWOUT, I_RELB, I_WGRP, I_BGRP, I_WRT, I_BRT, I_W1, I_W3, I_W2, N_IN };

__device__ __forceinline__ const float* inp(LAS unsigned char* lds, int k) {
    const LAS unsigned* p = (const LAS unsigned*)(lds + PTR_OFF) + 2 * k;
    const unsigned lo = __builtin_amdgcn_readfirstlane(p[0]), hi = __builtin_amdgcn_readfirstlane(p[1]);
    return (const float*)(const GAS float*)(((unsigned long long)hi << 32) | (unsigned long long)lo);
}
struct TrItem { const float* W; bf16* WT; int ldw, ldt, rowmode, k0, n0; };
__device__ __forceinline__ void tr_load(const TrItem& q, float (&tv)[32], int lane) {
    const float* wp = q.W + (size_t)(q.k0 + (lane >> 5)) * q.ldw + q.n0 + (lane & 31);
#pragma unroll
    for (int i = 0; i < 32; ++i) tv[i] = wp[(size_t)(2 * i) * q.ldw];
}
__device__ __forceinline__ void tr_store(const TrItem& q, const float (&tv)[32], LAS float* scr, int lane) {
#pragma unroll
    for (int i = 0; i < 32; ++i) scr[(2 * i + (lane >> 5)) * 33 + (lane & 31)] = tv[i];
    LDS_WAIT(); asm volatile("" ::: "memory");
    const int c = lane & 7;
#pragma unroll
    for (int j = 0; j < 4; ++j) { const int n = (lane >> 3) + 8 * j; const LAS float* s = scr + (8 * c) * 33 + n;
        u32x4 o; o.x = pk2(s[0 * 33], s[1 * 33]); o.y = pk2(s[2 * 33], s[3 * 33]); o.z = pk2(s[4 * 33], s[5 * 33]); o.w = pk2(s[6 * 33], s[7 * 33]);
        const int ng = q.n0 + n; const int dr = q.rowmode == 0 ? ng : (8 * (ng >> 2) + (ng & 3) + (q.rowmode == 2 ? 4 : 0));
        *(GAS u32x4*)(q.WT + (size_t)dr * q.ldt + q.k0 + 8 * c) = o; }
    LDS_WAIT(); asm volatile("" ::: "memory");
}
__device__ __forceinline__ void tr_item(const float* W, int ldw, bf16* WT, int ldt, int rowmode, LAS float* scr, int item, int nblk, int lane) {
    TrItem q{W, WT, ldw, ldt, rowmode, 64 * (item / nblk), 32 * (item % nblk)}; float tv[32]; tr_load(q, tv, lane); tr_store(q, tv, scr, lane);
}
__device__ __forceinline__ TrItem moe_item(const float* w1, const float* w3, const float* w2, bf16* W13, bf16* W2T, int it) {
    constexpr int PER_E = 768; const int e = it / PER_E, r = it % PER_E;
    if (r < 256) return TrItem{w1 + (size_t)e * D * DEXP, W13 + (size_t)e * D * D, DEXP, D, 1, 64 * (r / 16), 32 * (r % 16)};
    if (r < 512) return TrItem{w3 + (size_t)e * D * DEXP, W13 + (size_t)e * D * D, DEXP, D, 2, 64 * ((r - 256) / 16), 32 * ((r - 256) % 16)};
    return TrItem{w2 + (size_t)e * DEXP * D, W2T + (size_t)e * D * DEXP, D, DEXP, 0, 64 * ((r - 512) / 32), 32 * ((r - 512) % 32)};
}
__device__ __forceinline__ void moe_convert(const float* w1, const float* w3, const float* w2, bf16* W13, bf16* W2T, LAS float* scr, int it0, int it1, int gw, int NGW, int lane) {
    for (int it = it0 + gw; it < it1; it += 2 * NGW) {
        const int it2 = it + NGW; const bool two = it2 < it1;
        const TrItem qa = moe_item(w1, w3, w2, W13, W2T, it), qb = moe_item(w1, w3, w2, W13, W2T, two ? it2 : it);
        float ta[32], tb[32];
        tr_load(qa, ta, lane); tr_load(qb, tb, lane);
        tr_store(qa, ta, scr, lane); if (two) tr_store(qb, tb, scr, lane);
    }
}
constexpr int MOE_ITEMS = NEXP * 768, IDLE_Q8 = 88, IDLE_Q9 = 56;
__device__ __forceinline__ void idle_convert(int which, unsigned char* ws, LAS unsigned char* lds, float* dout, int ntiles, int bid, int G, int wave, int lane) {
    const int U = ntiles * (D / 256), rem = U % G; if (rem == 0 || bid < rem) return;
    const int n_idle = G - rem, rank = bid - rem;
    int q8 = n_idle * IDLE_Q8; q8 = q8 < MOE_ITEMS ? q8 : MOE_ITEMS; int q9 = n_idle * IDLE_Q9; q9 = (q8 + q9) < MOE_ITEMS ? q9 : (MOE_ITEMS - q8);
    const int per = which == 0 ? IDLE_Q8 : IDLE_Q9, base = which == 0 ? 0 : q8, lim = which == 0 ? q8 : q8 + q9;
    int lo = base + rank * per, hi = lo + per; hi = hi < lim ? hi : lim;
    moe_convert(inp(lds, I_W1) + (size_t)NEXP * D * DEXP, inp(lds, I_W3) + (size_t)NEXP * D * DEXP, inp(lds, I_W2) + (size_t)NEXP * DEXP * D,
                (bf16*)dout, (bf16*)dout + (size_t)NEXP * D * D, (LAS float*)(lds + wave * 16384), lo, hi, wave, NWAVES, lane);
}
__device__ __forceinline__ int idle_done(int ntiles, int G) {
    const int U = ntiles * (D / 256), rem = U % G; if (rem == 0) return 0;
    const int n_idle = G - rem; int q = n_idle * (IDLE_Q8 + IDLE_Q9); return q < MOE_ITEMS ? q : MOE_ITEMS;
}
__device__ __forceinline__ int t5_bucket(int rel) {
    const int nb = 16, max_exact = 8; int ret = rel > 0 ? nb : 0; const int n = rel < 0 ? -rel : rel;
    const float lg = logf((float)(n < 1 ? 1 : n) / 8.0f) / 2.7725887f * 8.0f;
    int large = max_exact + (int)lg; large = large < nb - 1 ? large : nb - 1;
    return ret + (n < max_exact ? n : large);
}
__device__ __forceinline__ void p0_prologue(unsigned char* ws, LAS unsigned char* lds, int bid, int G, int tid, int wave, int lane) {
    LAS float* scr = (LAS float*)(lds + wave * 16384);
    const int gw = bid * NWAVES + wave, NGW = G * NWAVES;
    constexpr int I0 = 16 * 64, I1 = 16, I2 = 8 * 16, I3 = 16 * 32, I4 = 16 * 48, I5 = 16 * 32, NIT = I0 + I1 + I2 + I3 + I4 + I5;
    for (int it = gw; it < NIT; it += NGW) {
        int r = it;
        if (r < I0) { tr_item(inp(lds, I_ABWIN), AB_IN, (bf16*)(ws + WS_WIN), D, 0, scr, r, 64, lane); continue; } r -= I0;
        if (r < I1) { tr_item(inp(lds, I_ABWIN) + 2048, AB_IN, (bf16*)(ws + WS_WLR), D, 0, scr, r, 1, lane); continue; } r -= I1;
        if (r < I2) { tr_item(inp(lds, I_GLUW), 512, (bf16*)(ws + WS_WGLU), 512, 0, scr, r, 16, lane); continue; } r -= I2;
        if (r < I3) { tr_item(inp(lds, I_ABWOUT), D, (bf16*)(ws + WS_WOUT), D, 0, scr, r, 32, lane); continue; } r -= I3;
        if (r < I4) { tr_item(inp(lds, I_CWIN), CN, (bf16*)(ws + WS_CIN), D, 0, scr, r, 48, lane); continue; } r -= I4;
        tr_item(inp(lds, I_CWOUT), D, (bf16*)(ws + WS_COUT), D, 0, scr, r, 32, lane);
    }
    moe_convert(inp(lds, I_W1), inp(lds, I_W3), inp(lds, I_W2), (bf16*)(ws + WS_W13), (bf16*)(ws + WS_W2), scr, 0, MOE_ITEMS, gw, NGW, lane);
    { const float* x = inp(lds, I_X); bf16* xb = (bf16*)(ws + WS_X64);
      for (int m = gw; m < T; m += 2 * NGW) { const int m2 = m + NGW;
          const GAS f32x4* xr = (const GAS f32x4*)(x + (size_t)m * D) + lane; GAS u32x2* o = (GAS u32x2*)(xb + (size_t)m * D) + lane;
          const GAS f32x4* xr2 = (const GAS f32x4*)(x + (size_t)m2 * D) + lane; GAS u32x2* o2 = (GAS u32x2*)(xb + (size_t)m2 * D) + lane;
          f32x4 v[4], v2[4];
#pragma unroll
          for (int j = 0; j < 4; ++j) { v[j] = xr[64 * j]; if (m2 < T) v2[j] = xr2[64 * j]; }
#pragma unroll
          for (int j = 0; j < 4; ++j) { u32x2 w; w.x = pk2(v[j].x, v[j].y); w.y = pk2(v[j].z, v[j].w); o[64 * j] = w;
              if (m2 < T) { u32x2 w2; w2.x = pk2(v2[j].x, v2[j].y); w2.y = pk2(v2[j].z, v2[j].w); o2[64 * j] = w2; } } } }
    const int gt = bid * NTHR + tid, NGT = G * NTHR;
    { const float* lamre = inp(lds, I_LAMRE); const float* lamim = inp(lds, I_LAMIM); const float* logdt = inp(lds, I_LOGDT); const float* bre = inp(lds, I_BRE); const float* bim = inp(lds, I_BIM);
    for (int i = tid * G + bid; i < 2 * 32 * 64; i += NTHR * G) {
        const int p = i & 63, g = (i >> 6) & 31, dir = i >> 11;
        const double lr = fmin((double)lamre[i], -1e-4), li = (double)lamim[i], dt = exp((double)logdt[dir * 32 + g]);
        const double mag = exp(lr * dt), ar = mag * cos(li * dt), ai = mag * sin(li * dt), den = lr * lr + li * li, nr = ar - 1.0;
        const double cr = (nr * lr + ai * li) / den, ci = (ai * lr - nr * li) / den;
        double qr = ar, qi = ai;
#pragma unroll 1
        for (int s = 1; s < S5CH; s <<= 1) { const double t = qr * qr - qi * qi; qi = 2.0 * qr * qi; qr = t; }
        float* L4 = (float*)(ws + WS_S5L) + (size_t)i * 4; L4[0] = (float)ar; L4[1] = (float)ai; L4[2] = (float)qr; L4[3] = (float)qi;
        bf16* Bb = (bf16*)(ws + WS_S5B) + (size_t)(dir * 32 + g) * 2048;
#pragma unroll 4
        for (int c = 0; c < 16; ++c) { const double br = bre[(size_t)i * 16 + c], bi = bim[(size_t)i * 16 + c];
            Bb[p * 16 + c] = (bf16)f2bf((float)(cr * br - ci * bi)); Bb[1024 + p * 16 + c] = (bf16)f2bf((float)(cr * bi + ci * br)); }
    } }
    { const float* cre = inp(lds, I_CRE); const float* cim = inp(lds, I_CIM);
    for (int i = gt; i < 2 * 32 * 16 * 64; i += NGT) {
        const int p = i & 63, c = (i >> 6) & 15, dg = i >> 10;
        bf16* Cm = (bf16*)(ws + WS_S5C) + (size_t)dg * 2048 + c * 128 + 2 * p;
        Cm[0] = (bf16)f2bf(cre[i]); Cm[1] = (bf16)f2bf(-cim[i]);
    } }
    { const float* relb = inp(lds, I_RELB);
    for (int i = gt; i < 16 * 257; i += NGT) { const int h = i / 257, r = i % 257; ((float*)(ws + WS_BTAB))[h * 260 + r] = relb[t5_bucket(r - 128) * 16 + h] * LOG2E; } }
    { const float* wgrp = inp(lds, I_WGRP); const float* wrt = inp(lds, I_WRT);
    for (int i = gt; i < 2 * 48 * 1024; i += NGT) {
        const int k = i & 1023, n = (i >> 10) % 48, l = i / (48 * 1024);
        const float w = n < 4 ? wgrp[(size_t)l * D * 4 + k * 4 + n] : (n < 36 ? wrt[(size_t)l * D * 32 + k * 32 + (n - 4)] : 0.f);
        const unsigned hi = f2bf(w); const float lo = w - __uint_as_float(hi << 16);
        bf16* Wr = (bf16*)(ws + WS_WR) + (size_t)l * 2 * 48 * 1024; Wr[n * 1024 + k] = (bf16)hi; Wr[48 * 1024 + n * 1024 + k] = (bf16)f2bf(lo);
    } }
}

__device__ __forceinline__ void gate_tail(float* bcg, const float* gate_w, const float* gate_b, const LAS float* lrs, size_t row0, int tid);
__device__ __forceinline__ void lr_tail(unsigned char* ws, float* bcg, const float* gate_w, const float* gate_b, LAS unsigned char* lds, int bid, int G, int tid, int wave, int lane) {
    const bf16* xb = (const bf16*)(ws + WS_X64); const bf16* wl = (const bf16*)(ws + WS_WLR); LAS float* lrs = (LAS float*)lds;
    for (int rt = bid; rt < T / 128; rt += G) {
        const int r0 = rt * 128 + wave * 16;
        f32x4 acc0 = {0.f, 0.f, 0.f, 0.f}, acc1 = {0.f, 0.f, 0.f, 0.f};
        const bf16* ap = xb + (size_t)(r0 + (lane & 15)) * D + 8 * (lane >> 4);
        const bf16* bp = wl + (size_t)(lane & 15) * D + 8 * (lane >> 4);
#pragma unroll 8
        for (int ks = 0; ks < 32; ++ks) {
            const bf16x8 a = *(const bf16x8*)(ap + ks * 32), b0 = *(const bf16x8*)(bp + ks * 32), b1 = *(const bf16x8*)(bp + 16 * D + ks * 32);
            acc0 = __builtin_amdgcn_mfma_f32_16x16x32_bf16(a, b0, acc0, 0, 0, 0); acc1 = __builtin_amdgcn_mfma_f32_16x16x32_bf16(a, b1, acc1, 0, 0, 0);
        }
        __syncthreads();
#pragma unroll
        for (int r = 0; r < 4; ++r) { LAS float* o = lrs + (wave * 16 + 4 * (lane >> 4) + r) * 32 + (lane & 15); o[0] = acc0[r]; o[16] = acc1[r]; }
        __syncthreads();
        gate_tail(bcg, gate_w, gate_b, lrs, (size_t)rt * 128, tid);
    }
    __syncthreads();
}

__device__ __forceinline__ void gla_finalize(unsigned char* ws, const float* norm_g, int gw, int NGW, int lane) {
    const bf16* of = (const bf16*)(ws + WS_OF); const bf16* ob = (const bf16*)(ws + WS_OB); const bf16* h0 = (const bf16*)(ws + WS_H0); bf16* cc = (bf16*)(ws + WS_X64);
    const f32x4 g0 = *(const f32x4*)(norm_g + 8 * lane), g1 = *(const f32x4*)(norm_g + 8 * lane + 4);
    for (int m0 = gw; m0 < T; m0 += 4 * NGW) {
        u32x4 a[4], b[4], gq[4];
#pragma unroll
        for (int q = 0; q < 4; ++q) { const size_t m = (size_t)m0 + (size_t)q * NGW;
            a[q] = *(const u32x4*)(of + m * 512 + 8 * lane); b[q] = *(const u32x4*)(ob + m * 512 + 8 * lane); gq[q] = *(const u32x4*)(h0 + m * H0P + OFF_GO + 8 * lane); }
#pragma unroll
        for (int q = 0; q < 4; ++q) { const size_t m = (size_t)m0 + (size_t)q * NGW;
            f32x4 v0, v1;
            v0.x = bflo(a[q].x) + bflo(b[q].x); v0.y = bfhi(a[q].x) + bfhi(b[q].x); v0.z = bflo(a[q].y) + bflo(b[q].y); v0.w = bfhi(a[q].y) + bfhi(b[q].y);
            v1.x = bflo(a[q].z) + bflo(b[q].z); v1.y = bfhi(a[q].z) + bfhi(b[q].z); v1.z = bflo(a[q].w) + bflo(b[q].w); v1.w = bfhi(a[q].w) + bfhi(b[q].w);
            float ss = (v0.x * v0.x + v0.y * v0.y) + (v0.z * v0.z + v0.w * v0.w) + (v1.x * v1.x + v1.y * v1.y) + (v1.z * v1.z + v1.w * v1.w);
            ss += __shfl_xor(ss, 1); ss += __shfl_xor(ss, 2); ss += __shfl_xor(ss, 4); ss += __shfl_xor(ss, 8);
            const float rs = __builtin_amdgcn_rsqf(ss * (1.0f / 128.0f) + RMS_EPS);
            const float gv[8] = {bflo(gq[q].x), bfhi(gq[q].x), bflo(gq[q].y), bfhi(gq[q].y), bflo(gq[q].z), bfhi(gq[q].z), bflo(gq[q].w), bfhi(gq[q].w)};
            const float ov[8] = {v0.x * g0.x, v0.y * g0.y, v0.z * g0.z, v0.w * g0.w, v1.x * g1.x, v1.y * g1.y, v1.z * g1.z, v1.w * g1.w};
            float r[8];
#pragma unroll
            for (int i = 0; i < 8; ++i) r[i] = ov[i] * rs * (gv[i] * __builtin_amdgcn_rcpf(1.f + __expf(-gv[i])));
            u32x4 w; w.x = pk2(r[0], r[1]); w.y = pk2(r[2], r[3]); w.z = pk2(r[4], r[5]); w.w = pk2(r[6], r[7]);
            *(u32x4*)(cc + m * D + 512 + 8 * lane) = w; }
    }
}

constexpr int RT_AST = 2064;
template <bool RESID_F32>
__device__ __forceinline__ void ln_router(unsigned char* ws, const float* resid, const float* lng, const float* lnb, const float* bgrp, const float* brt, int layer, LAS unsigned char* lds, int bid, int G, int tid, int wave, int lane) {
    const bf16* yb = (const bf16*)(ws + WS_Z); bf16* hlo = (bf16*)(ws + WS_HLO); bf16* hb = (bf16*)(ws + WS_HHI);
    int* tok_e = (int*)(ws + WS_TOKE); float* tok_w = (float*)(ws + WS_TOKW);
    LAS unsigned char* Ahi = lds; LAS unsigned char* Alo = lds + 16 * RT_AST; LAS float* part = (LAS float*)(lds + 32 * RT_AST);
    LAS int* hist = (LAS int*)(lds + 32 * RT_AST + 8 * 16 * 48 * 4); LAS float* lgt = (LAS float*)(lds + 32 * RT_AST + 8 * 16 * 48 * 4 + 256);
    if (tid < 32) hist[tid] = 0;
    const bf16* Wr = (const bf16*)(ws + WS_WR) + (size_t)layer * 2 * 48 * 1024;
    bf16x8 Bh[3][4], Bl[3][4];
#pragma unroll
    for (int nt = 0; nt < 3; ++nt)
#pragma unroll
        for (int ks = 0; ks < 4; ++ks) { const size_t o = (size_t)(nt * 16 + (lane & 15)) * 1024 + wave * 128 + ks * 32 + 8 * (lane >> 4);
            Bh[nt][ks] = *(const bf16x8*)(Wr + o); Bl[nt][ks] = *(const bf16x8*)(Wr + 48 * 1024 + o); }
    f32x4 gv[4], bv[4];
#pragma unroll
    for (int j = 0; j < 4; ++j) { gv[j] = *(const f32x4*)(lng + 4 * lane + 256 * j); bv[j] = *(const f32x4*)(lnb + 4 * lane + 256 * j); }
    __syncthreads();
    for (int grp = bid; grp < T / 16; grp += G) {
#pragma unroll
        for (int rr = 0; rr < 2; ++rr) {
            const int row = 2 * wave + rr; const size_t m = (size_t)grp * 16 + row;
            const GAS f32x4* xr = (const GAS f32x4*)(resid + m * D) + lane; const GAS u32x2* yr = (const GAS u32x2*)(yb + m * D) + lane;
            const GAS u32x2* hr_ = (const GAS u32x2*)(hb + m * D) + lane; const GAS u32x2* lr_ = (const GAS u32x2*)(hlo + m * D) + lane;
            f32x4 v[4]; float s = 0.f;
#pragma unroll
            for (int j = 0; j < 4; ++j) { f32x4 x4; const u32x2 y2 = yr[64 * j];
                if (RESID_F32) x4 = xr[64 * j]; else { const u32x2 a = hr_[64 * j], b = lr_[64 * j]; x4.x = bflo(a.x) + bflo(b.x); x4.y = bfhi(a.x) + bfhi(b.x); x4.z = bflo(a.y) + bflo(b.y); x4.w = bfhi(a.y) + bfhi(b.y); }
                v[j].x = x4.x * ALPHA + bflo(y2.x); v[j].y = x4.y * ALPHA + bfhi(y2.x); v[j].z = x4.z * ALPHA + bflo(y2.y); v[j].w = x4.w * ALPHA + bfhi(y2.y);
                s += (v[j].x + v[j].y) + (v[j].z + v[j].w); }
            const float mean = wave_sum(s) * (1.f / D); float s2 = 0.f;
#pragma unroll
            for (int j = 0; j < 4; ++j) { v[j] = v[j] - mean; s2 += (v[j].x * v[j].x + v[j].y * v[j].y) + (v[j].z * v[j].z + v[j].w * v[j].w); }
            const float rstd = 1.f / sqrtf(wave_sum(s2) * (1.f / D) + LN_EPS);
#pragma unroll
            for (int j = 0; j < 4; ++j) {
                const f32x4 h = v[j] * rstd * gv[j] + bv[j];
                const unsigned h0 = pk2(h.x, h.y), h1w = pk2(h.z, h.w);
                u32x2 w; w.x = h0; w.y = h1w; ((GAS u32x2*)(hb + m * D) + lane)[64 * j] = w;
                u32x2 lo; lo.x = pk2(h.x - bflo(h0), h.y - bfhi(h0)); lo.y = pk2(h.z - bflo(h1w), h.w - bfhi(h1w));
                ((GAS u32x2*)(hlo + m * D) + lane)[64 * j] = lo;
                *(LAS u32x2*)(Ahi + row * RT_AST + (4 * lane + 256 * j) * 2) = w; *(LAS u32x2*)(Alo + row * RT_AST + (4 * lane + 256 * j) * 2) = lo;
            }
        }
        LDS_BARRIER();
        f32x4 acc[3] = {{0.f, 0.f, 0.f, 0.f}, {0.f, 0.f, 0.f, 0.f}, {0.f, 0.f, 0.f, 0.f}};
#pragma unroll
        for (int ks = 0; ks < 4; ++ks) {
            const int bo = (lane & 15) * RT_AST + (wave * 128 + ks * 32 + 8 * (lane >> 4)) * 2;
            const bf16x8 ah = *(const LAS bf16x8*)(Ahi + bo), al = *(const LAS bf16x8*)(Alo + bo);
#pragma unroll
            for (int nt = 0; nt < 3; ++nt) {
                acc[nt] = __builtin_amdgcn_mfma_f32_16x16x32_bf16(ah, Bh[nt][ks], acc[nt], 0, 0, 0);
                acc[nt] = __builtin_amdgcn_mfma_f32_16x16x32_bf16(ah, Bl[nt][ks], acc[nt], 0, 0, 0);
                acc[nt] = __builtin_amdgcn_mfma_f32_16x16x32_bf16(al, Bh[nt][ks], acc[nt], 0, 0, 0);
            }
        }
#pragma unroll
        for (int nt = 0; nt < 3; ++nt)
#pragma unroll
            for (int r = 0; r < 4; ++r) part[(wave * 16 + 4 * (lane >> 4) + r) * 48 + nt * 16 + (lane & 15)] = acc[nt][r];
        LDS_BARRIER();
        { const int itn = (grp - bid) / G;
          for (int idx = tid; idx < 16 * 36; idx += NTHR) { const int tk = idx / 36, n = idx % 36; float s = 0.f;
#pragma unroll
            for (int w = 0; w < 8; ++w) s += part[(w * 16 + tk) * 48 + n];
            lgt[(itn * 16 + tk) * 36 + n] = s + (n < 4 ? bgrp[n] : brt[n - 4]); } }
    }
    LDS_BARRIER();
    for (int tk = tid; tk < 16 * ((T / 16 - bid + G - 1) / G); tk += NTHR) {
        const size_t m = ((size_t)bid + (size_t)(tk >> 4) * G) * 16 + (tk & 15);
        const LAS float* lg = lgt + tk * 36;
        int gi = 0; float gm = lg[0];
#pragma unroll
        for (int n = 1; n < 4; ++n) if (lg[n] > gm) { gm = lg[n]; gi = n; }
        float gs = 0.f;
#pragma unroll
        for (int n = 0; n < 4; ++n) gs += __expf(lg[n] - gm);
        const float pg = 1.f / gs;
        float el[8];
#pragma unroll
        for (int i = 0; i < 8; ++i) el[i] = lg[4 + gi * 8 + i];
        int i1 = 0; float m1 = el[0];
#pragma unroll
        for (int i = 1; i < 8; ++i) if (el[i] > m1) { m1 = el[i]; i1 = i; }
        int i2 = -1; float m2 = -3.0e38f;
#pragma unroll
        for (int i = 0; i < 8; ++i) if (i != i1 && el[i] > m2) { m2 = el[i]; i2 = i; }
        const float e2 = __expf(m2 - m1), inv = 1.f / (1.f + e2);
        const int ea = gi * 8 + i1, eb = gi * 8 + i2;
        tok_e[m * 2] = ea; tok_e[m * 2 + 1] = eb; tok_w[m * 2] = pg * inv; tok_w[m * 2 + 1] = pg * e2 * inv;
        atomicAdd((int*)&hist[ea], 1); atomicAdd((int*)&hist[eb], 1);
    }
    LDS_BARRIER();
    if (tid < 32) ((int*)(ws + WS_BLKC))[bid * 32 + tid] = hist[tid];
}

__device__ __forceinline__ void moe_sort(unsigned char* ws, LAS unsigned char* lds, int bid, int G, int tid) {
    const int* blkc = (const int*)(ws + WS_BLKC); const int* tok_e = (const int*)(ws + WS_TOKE); const float* tok_w = (const float*)(ws + WS_TOKW);
    int* tok_s = (int*)(ws + WS_TOKS); int* slot_t = (int*)(ws + WS_SLOTT); float* slot_w = (float*)(ws + WS_SLOTW); int* tile = (int*)(ws + WS_TILE);
    LAS int* ptot = (LAS int*)lds; LAS int* pbase = ptot + 512; LAS int* tot = pbase + 512; LAS int* base = tot + 32; LAS int* pstart = base + 32; LAS int* lcur = pstart + 33;
    { const int e = tid & 31, part = tid >> 5; int st = 0, sb = 0;
      for (int b = part; b < G; b += 16) { const int c = blkc[b * 32 + e]; st += c; sb += (b < bid) ? c : 0; }
      ptot[part * 32 + e] = st; pbase[part * 32 + e] = sb; }
    __syncthreads();
    if (tid < 32) { int st = 0, sb = 0;
#pragma unroll
        for (int p = 0; p < 16; ++p) { st += ptot[p * 32 + tid]; sb += pbase[p * 32 + tid]; }
        tot[tid] = st; base[tid] = sb; lcur[tid] = 0; }
    __syncthreads();
    if (tid == 0) { int acc = 0; for (int e = 0; e < 32; ++e) { pstart[e] = acc; acc += (tot[e] + 255) & ~255; } pstart[32] = acc; }
    __syncthreads();
    if (bid == 0) {
        const int nt = pstart[32] >> 8;
        if (tid == 0) tile[511] = nt;
        for (int t = tid; t < nt; t += NTHR) { int e = 0; for (int q = 1; q < 32; ++q) if ((t << 8) >= pstart[q]) e = q; tile[t] = e; }
    }
    for (int e = bid; e < 32; e += G)
        for (int s = pstart[e] + tot[e] + tid; s < pstart[e + 1]; s += NTHR) { slot_t[s] = 0; slot_w[s] = 0.f; }
    for (int grp = bid; grp < T / 16; grp += G) {
        if (tid < 32) { const size_t a = (size_t)grp * 32 + tid; const int e = tok_e[a]; const int rank = atomicAdd((int*)&lcur[e], 1);
            const int s = pstart[e] + base[e] + rank; slot_t[s] = (int)(a >> 1); slot_w[s] = tok_w[a]; tok_s[a] = s; }
    }
}

template <bool FINAL>
__device__ __forceinline__ void combine_ln(unsigned char* ws, const float* lng, const float* lnb, float* dout, int gw, int NGW, int lane) {
    bf16* hlo = (bf16*)(ws + WS_HLO); bf16* hhi = (bf16*)(ws + WS_HHI); const bf16* y2 = (const bf16*)(ws + WS_Y2); const int* tok_s = (const int*)(ws + WS_TOKS); const float* tok_w = (const float*)(ws + WS_TOKW);
    f32x4 gv[4], bv[4];
#pragma unroll
    for (int j = 0; j < 4; ++j) { gv[j] = *(const f32x4*)(lng + 4 * lane + 256 * j); bv[j] = *(const f32x4*)(lnb + 4 * lane + 256 * j); }
    for (int m = gw; m < T; m += NGW) {
        const int s0 = tok_s[(size_t)m * 2], s1 = tok_s[(size_t)m * 2 + 1]; const float w0 = tok_w[(size_t)m * 2], w1 = tok_w[(size_t)m * 2 + 1];
        GAS u32x2* hr = (GAS u32x2*)(hhi + (size_t)m * D) + lane; GAS u32x2* lr = (GAS u32x2*)(hlo + (size_t)m * D) + lane;
        const GAS u32x2* ya = (const GAS u32x2*)(y2 + (size_t)s0 * D) + lane; const GAS u32x2* yb = (const GAS u32x2*)(y2 + (size_t)s1 * D) + lane;
        f32x4 v[4]; float s = 0.f;
#pragma unroll
        for (int j = 0; j < 4; ++j) { const u32x2 hh_ = hr[64 * j], hl_ = lr[64 * j]; f32x4 h; h.x = bflo(hh_.x) + bflo(hl_.x); h.y = bfhi(hh_.x) + bfhi(hl_.x); h.z = bflo(hh_.y) + bflo(hl_.y); h.w = bfhi(hh_.y) + bfhi(hl_.y);
            const u32x2 a = ya[64 * j], b = yb[64 * j];
            v[j].x = h.x * ALPHA + (w0 * bflo(a.x) + w1 * bflo(b.x)); v[j].y = h.y * ALPHA + (w0 * bfhi(a.x) + w1 * bfhi(b.x)); v[j].z = h.z * ALPHA + (w0 * bflo(a.y) + w1 * bflo(b.y)); v[j].w = h.w * ALPHA + (w0 * bfhi(a.y) + w1 * bfhi(b.y));
            s += (v[j].x + v[j].y) + (v[j].z + v[j].w); }
        const float mean = wave_sum(s) * (1.f / D); float s2 = 0.f;
#pragma unroll
        for (int j = 0; j < 4; ++j) { v[j] = v[j] - mean; s2 += (v[j].x * v[j].x + v[j].y * v[j].y) + (v[j].z * v[j].z + v[j].w * v[j].w); }
        const float rstd = 1.f / sqrtf(wave_sum(s2) * (1.f / D) + LN_EPS);
#pragma unroll
        for (int j = 0; j < 4; ++j) { const f32x4 h = v[j] * rstd * gv[j] + bv[j];
            if (FINAL) ((GAS f32x4*)(dout + (size_t)m * D) + lane)[64 * j] = h;
            else { u32x2 w; w.x = pk2(h.x, h.y); w.y = pk2(h.z, h.w); hr[64 * j] = w;
                   u32x2 lo; lo.x = pk2(h.x - bflo(w.x), h.y - bfhi(w.x)); lo.y = pk2(h.z - bflo(w.y), h.w - bfhi(w.y)); lr[64 * j] = lo; } }
    }
}
constexpr int S5_HST = 272, S5_UST = 272, S5_UOFF = 8 * 32 * S5_HST;
#define MFMA32(a, b, c) __builtin_amdgcn_mfma_f32_32x32x16_bf16((a), (b), (c), 0, 0, 0)
#define MFMA16(a, b, c) __builtin_amdgcn_mfma_f32_16x16x32_bf16((a), (b), (c), 0, 0, 0)
__device__ __forceinline__ float gelu_tanh(float x) {
    const float u = 0.7978845608028654f * (x + 0.044715f * x * x * x);
    const float e = __expf(2.f * u); const float th = 1.f - 2.f * __builtin_amdgcn_rcpf(e + 1.f);
    return 0.5f * x * (1.f + th);
}
__device__ __forceinline__ f32x4 ld_ys(const float* p) {
    f32x4 v;
    v.x = __hip_atomic_load(p, __ATOMIC_RELAXED, __HIP_MEMORY_SCOPE_AGENT); v.y = __hip_atomic_load(p + 1, __ATOMIC_RELAXED, __HIP_MEMORY_SCOPE_AGENT);
    v.z = __hip_atomic_load(p + 2, __ATOMIC_RELAXED, __HIP_MEMORY_SCOPE_AGENT); v.w = __hip_atomic_load(p + 3, __ATOMIC_RELAXED, __HIP_MEMORY_SCOPE_AGENT);
    return v;
}
template <int PASS, int DIR>
__device__ __forceinline__ void s5_dir(unsigned char* ws, const float* s5d, int b, int g, int c, LAS unsigned char* hl, const LAS unsigned char* ul, float* yscr, int lane) {
    const bf16* h0 = (const bf16*)(ws + WS_H0);
    const int dg = DIR * 32 + g;
    const f32x4 L4 = *(const f32x4*)((const float*)(ws + WS_S5L) + (size_t)(dg * 64 + lane) * 4);
    const float ar = L4.x, ai = L4.y, qr = L4.z, qi = L4.w;
    const float l2r = ar * ar - ai * ai, l2i = 2.f * ar * ai, l4r = l2r * l2r - l2i * l2i, l4i = 2.f * l2r * l2i, l8r = l4r * l4r - l4i * l4i, l8i = 2.f * l4r * l4i;
    const float l16r = l8r * l8r - l8i * l8i, l16i = 2.f * l8r * l8i, l32r = l16r * l16r - l16i * l16i, l32i = 2.f * l16r * l16i;
    const bf16* Bb = (const bf16*)(ws + WS_S5B) + (size_t)dg * 2048 + (lane & 31) * 16 + 8 * (lane >> 5);
    const bf16x8 bre0 = *(const bf16x8*)Bb, bre1 = *(const bf16x8*)(Bb + 512), bim0 = *(const bf16x8*)(Bb + 1024), bim1 = *(const bf16x8*)(Bb + 1536);
    bf16x8 cf[4]; bf16x8 dfrag;
    if (PASS == 2) {
        const bf16* Cm = (const bf16*)(ws + WS_S5C) + (size_t)dg * 2048 + (lane & 15) * 128 + 8 * (lane >> 4);
#pragma unroll
        for (int ks = 0; ks < 4; ++ks) cf[ks] = *(const bf16x8*)(Cm + 32 * ks);
        if (DIR == 1) {
            const int cc = lane & 15, kq = lane >> 4; const float d = s5d[g * 16 + cc]; const unsigned dh = f2bf(d); const unsigned dl = f2bf(d - __uint_as_float(dh << 16));
#pragma unroll
            for (int j = 0; j < 8; ++j) { const int k = 8 * (kq & 1) + j; dfrag[j] = (short)((k == cc) ? (kq < 2 ? dh : dl) : 0u); }
        }
    }
    float hr = 0.f, hi = 0.f;
    float* Ec = (float*)(ws + WS_S5E) + ((size_t)((DIR * NB + b) * 32 + g) * S5NCH) * 128 + 2 * lane;
    if (PASS == 2) {
        const int nj = DIR == 0 ? c : (S5NCH - 1 - c);
        for (int j0 = 0; j0 < nj; j0 += 32) {
            f32x2 e[32];
#pragma unroll
            for (int q = 0; q < 32; ++q) { const int j = (j0 + q) < nj ? (j0 + q) : (nj - 1); const int jj = DIR == 0 ? j : (S5NCH - 1 - j); e[q] = *(const f32x2*)(Ec + (size_t)jj * 128); }
#pragma unroll
            for (int q = 0; q < 32; ++q) if (j0 + q < nj) { const float nr = qr * hr - qi * hi + e[q].x; hi = qr * hi + qi * hr + e[q].y; hr = nr; }
        }
    }
    const size_t rowbase = (size_t)b * SEQ + (size_t)c * S5CH;
    const LAS unsigned char* up = ul + (lane & 31) * S5_UST + (g & 7) * 32 + 16 * (lane >> 5);
    const f32x16 zero16 = {0.f, 0.f, 0.f, 0.f, 0.f, 0.f, 0.f, 0.f, 0.f, 0.f, 0.f, 0.f, 0.f, 0.f, 0.f, 0.f};
#pragma unroll 1
    for (int ti = 0; ti < S5CH / 32; ++ti) {
        const int tile = DIR == 0 ? ti : (S5CH / 32 - 1 - ti);
        const bf16x8 a = *(const LAS bf16x8*)(up + tile * 32 * S5_UST);
        f32x4 ysv[2] = {{0.f, 0.f, 0.f, 0.f}, {0.f, 0.f, 0.f, 0.f}};
        if (PASS == 2 && DIR == 1) { ysv[0] = ld_ys(yscr + (size_t)(tile * 2) * 256 + 4 * lane); ysv[1] = ld_ys(yscr + (size_t)(tile * 2 + 1) * 256 + 4 * lane); }
        f32x16 xr0 = MFMA32(a, bre0, zero16), xr1 = MFMA32(a, bre1, zero16), xi0 = MFMA32(a, bim0, zero16), xi1 = MFMA32(a, bim1, zero16);
        __builtin_amdgcn_sched_barrier(0);
        asm volatile("s_nop 15\n\ts_nop 15\n\ts_nop 15\n\ts_nop 15\n\ts_nop 15\n\ts_nop 15" ::: "memory");
        __builtin_amdgcn_sched_barrier(0);
        float xr[32], xi[32];
#pragma unroll
        for (int r = 0; r < 16; ++r) {
            auto s = __builtin_amdgcn_permlane32_swap(__float_as_uint(xr0[r]), __float_as_uint(xr1[r]), false, false);
            xr[crow(r, 0)] = __uint_as_float(s[0]); xr[crow(r, 1)] = __uint_as_float(s[1]);
            auto q = __builtin_amdgcn_permlane32_swap(__float_as_uint(xi0[r]), __float_as_uint(xi1[r]), false, false);
            xi[crow(r, 0)] = __uint_as_float(q[0]); xi[crow(r, 1)] = __uint_as_float(q[1]);
        }
        if (PASS == 1) {
#pragma unroll
            for (int lv = 0; lv < 5; ++lv) {
                const float pr = lv == 0 ? ar : lv == 1 ? l2r : lv == 2 ? l4r : lv == 3 ? l8r : l16r, pi = lv == 0 ? ai : lv == 1 ? l2i : lv == 2 ? l4i : lv == 3 ? l8i : l16i;
#pragma unroll
                for (int i = 0; i < (16 >> lv); ++i) {
                    const int e = DIR == 0 ? 2 * i : 2 * i + 1, l = DIR == 0 ? 2 * i + 1 : 2 * i;
                    const float er = xr[e << lv], ei = xi[e << lv], lr_ = xr[l << lv], li_ = xi[l << lv];
                    const float wr = fmaf(pr, er, fmaf(-pi, ei, lr_)), wi = fmaf(pr, ei, fmaf(pi, er, li_));
                    xr[(2 * i) << lv] = wr; xi[(2 * i) << lv] = wi;
                }
            }
            { const float nr = fmaf(l32r, hr, fmaf(-l32i, hi, xr[0])), ni = fmaf(l32r, hi, fmaf(l32i, hr, xi[0])); hr = nr; hi = ni; }
        } else {
#pragma unroll
        for (int tt = 0; tt < 32; ++tt) {
            const int t = DIR == 0 ? tt : 31 - tt;
            const float tr_ = fmaf(-ai, hi, xr[t]), ti_ = fmaf(ai, hr, xi[t]);
            hr = fmaf(ar, hr, tr_); hi = fmaf(ar, hi, ti_);
            *(LAS unsigned*)(hl + t * S5_HST + 4 * lane) = pk2(hr, hi);
        }
        }
        if (PASS == 2) {
#pragma unroll
            for (int sub = 0; sub < 2; ++sub) {
                float* ys = yscr + (size_t)(tile * 2 + sub) * 256 + 4 * lane;
                f32x4 y = {0.f, 0.f, 0.f, 0.f};
                if (DIR == 1) y = ysv[sub];
#pragma unroll
                for (int ks = 0; ks < 4; ++ks) { const bf16x8 hf = *(const LAS bf16x8*)(hl + (sub * 16 + (lane & 15)) * S5_HST + 64 * ks + 16 * (lane >> 4)); y = MFMA16(hf, cf[ks], y); }
                if (DIR == 0) *(f32x4*)ys = y;
                else {
                    const bf16x8 uf = *(const LAS bf16x8*)(ul + (tile * 32 + sub * 16 + (lane & 15)) * S5_UST + (g & 7) * 32 + 16 * ((lane >> 4) & 1));
                    y = MFMA16(uf, dfrag, y);
                    bf16* yo = (bf16*)(ws + WS_YG) + (rowbase + tile * 32 + sub * 16 + 4 * (lane >> 4)) * 512 + g * 16 + (lane & 15);
#pragma unroll
                    for (int r = 0; r < 4; ++r) yo[(size_t)r * 512] = (bf16)f2bf(gelu_tanh(y[r]));
                }
            }
        }
    }
    if (PASS == 1) { f32x2 e; e.x = hr; e.y = hi; *(f32x2*)(Ec + (size_t)c * 128) = e; }
}
template <int PASS>
__device__ __forceinline__ void s5_phase(unsigned char* ws, const float* s5d, LAS unsigned char* lds, int bid, int G, int tid, int wave, int lane) {
    LAS unsigned char* hl = lds + wave * (32 * S5_HST); LAS unsigned char* ul = lds + S5_UOFF;
    float* yscr = (float*)(ws + WS_YSCR) + (size_t)(bid * NWAVES + wave) * 4096;
    const bf16* h0 = (const bf16*)(ws + WS_H0);
    for (int it = bid; it < NB * S5NCH * 4; it += G) {
        const int go = it & 3, c = (it >> 2) % S5NCH, b = it / (4 * S5NCH), g = go * 8 + wave;
        { const bf16* src = h0 + ((size_t)b * SEQ + (size_t)c * S5CH) * H0P + OFF_U + go * 128;
          u32x4 v[8];
#pragma unroll
          for (int i = 0; i < 8; ++i) { const int p = i * NTHR + tid; v[i] = *(const u32x4*)(src + (size_t)(p >> 4) * H0P + 8 * (p & 15)); }
          __syncthreads();
#pragma unroll
          for (int i = 0; i < 8; ++i) { const int p = i * NTHR + tid; *(LAS u32x4*)(ul + (p >> 4) * S5_UST + 16 * (p & 15)) = v[i]; }
          __syncthreads(); }
        s5_dir<PASS, 0>(ws, s5d, b, g, c, hl, ul, yscr, lane);
        s5_dir<PASS, 1>(ws, s5d, b, g, c, hl, ul, yscr, lane);
    }
}
constexpr int G_ST = 144;
constexpr int GL_QD = 0, GL_KD = GL_QD + 64 * G_ST, GL_KCT = GL_KD + 64 * G_ST, GL_VT = GL_KCT + 64 * G_ST, GL_IMG = GL_VT + 128 * G_ST,
              GL_S = 2 * GL_IMG, GL_ST = GL_S + 64 * G_ST, GL_END = GL_ST + 2 * 128 * G_ST;
static_assert(GL_END <= MISC_OFF, "GLA LDS");
__device__ __forceinline__ bf16x8 ldfrag32(const LAS unsigned char* base, int row0, int ks, int lane) {
    return *(const LAS bf16x8*)(base + (row0 + (lane & 31)) * G_ST + 32 * ks + 16 * (lane >> 5));
}
__device__ __forceinline__ void gate_tail(float* bcg, const float* gate_w, const float* gate_b, const LAS float* lrs, size_t row0, int tid) {
    const int dir = tid >> 8;
    float gw[16];
#pragma unroll
    for (int r = 0; r < 16; ++r) gw[r] = gate_w[(size_t)(dir * 16 + r) * 256 + (tid & 255)];
    const float gb = gate_b[tid];
    float run = 0.f;
#pragma unroll 4
    for (int i = 0; i < 128; ++i) {
        const int t = dir ? 127 - i : i;
        if ((i & 63) == 0) run = 0.f;
        const LAS f32x4* lp = (const LAS f32x4*)(lrs + t * 32 + dir * 16);
        const f32x4 l0 = lp[0], l1 = lp[1], l2 = lp[2], l3 = lp[3];
        float z = gb + l0.x * gw[0] + l0.y * gw[1] + l0.z * gw[2] + l0.w * gw[3] + l1.x * gw[4] + l1.y * gw[5] + l1.z * gw[6] + l1.w * gw[7]
                     + l2.x * gw[8] + l2.y * gw[9] + l2.z * gw[10] + l2.w * gw[11] + l3.x * gw[12] + l3.y * gw[13] + l3.z * gw[14] + l3.w * gw[15];
        const float ls = fminf(z, 0.f) - __logf(1.f + __expf(-fabsf(z)));
        run += ls * (1.0f / 16.0f);
        bcg[(row0 + t) * 512 + tid] = run;
    }
}
__device__ __forceinline__ size_t gla_tok(int b, int dir, int chunk, int s) { const int pos = chunk * GCH + s; return (size_t)b * SEQ + (dir ? (SEQ - 1 - pos) : pos); }
template <int PASS>
__device__ __forceinline__ void gla_item(unsigned char* ws, const float* bcg, int item, LAS unsigned char* lds, int tid, int wave, int lane) {
    const int sc = item % GNSC, dir = (item / GNSC) & 1, h = (item / (GNSC * 2)) & 3, b = item / (GNSC * 8);
    const bf16* h0 = (const bf16*)(ws + WS_H0);
    LAS unsigned char* QD = lds + GL_QD; LAS unsigned char* KD = lds + GL_KD; LAS unsigned char* KCT = lds + GL_KCT; LAS unsigned char* VT = lds + GL_VT; LAS unsigned char* SS = lds + GL_S; LAS unsigned char* STT = lds + GL_ST;
    const int me = wave >> 1, nd = wave & 1;
    f32x16 st;
#pragma unroll
    for (int r = 0; r < 16; ++r) st[r] = 0.f;
    float dtot = 1.f;
    float* GS = (float*)(ws + WS_GS); float* GD = (float*)(ws + WS_GD);
    const int ibase = item - sc;
    if (PASS == 2) {
        for (int j0 = 0; j0 < sc; j0 += 4) {
            float dj[4], gv[4][16];
#pragma unroll
            for (int q = 0; q < 4; ++q) { const int j = (j0 + q) < sc ? (j0 + q) : (sc - 1);
                dj[q] = GD[(size_t)(ibase + j) * 64 + nd * 32 + (lane & 31)];
                const float* gs = GS + (size_t)(ibase + j) * 8192 + nd * 32 + (lane & 31);
#pragma unroll
                for (int r = 0; r < 16; ++r) gv[q][r] = gs[(size_t)(me * 32 + crow(r, lane >> 5)) * 64]; }
#pragma unroll
            for (int q = 0; q < 4; ++q) if (j0 + q < sc) {
#pragma unroll
                for (int r = 0; r < 16; ++r) st[r] = st[r] * dj[q] + gv[q][r]; }
        }
#pragma unroll
        for (int r = 0; r < 16; ++r) *(LAS bf16*)(STT + (me * 32 + crow(r, lane >> 5)) * G_ST + (nd * 32 + (lane & 31)) * 2) = (bf16)f2bf(st[r]);
    }
    const float qscale = 0.125f;
    const int s_l = lane;
    const int gcol = dir * 256 + h * 64;
    u32x4 pq, pk, pv0, pv1; f32x4 pb0, pb1, pl0, pl1; float pdec;
#define GLA_LOAD(n) do { const int ch_ = sc * GSC + (n); const size_t tk = gla_tok(b, dir, ch_, s_l), tl = gla_tok(b, dir, ch_, 63); const bf16* rp = h0 + tk * H0P; \
        if (PASS == 2) pq = *(const u32x4*)(rp + OFF_Q + h * 64 + 8 * wave); \
        pk = *(const u32x4*)(rp + OFF_K + h * 64 + 8 * wave); pv0 = *(const u32x4*)(rp + OFF_V + h * 128 + 16 * wave); pv1 = *(const u32x4*)(rp + OFF_V + h * 128 + 16 * wave + 8); \
        pb0 = *(const f32x4*)(bcg + tk * 512 + gcol + 8 * wave); pb1 = *(const f32x4*)(bcg + tk * 512 + gcol + 8 * wave + 4); \
        pl0 = *(const f32x4*)(bcg + tl * 512 + gcol + 8 * wave); pl1 = *(const f32x4*)(bcg + tl * 512 + gcol + 8 * wave + 4); \
        pdec = bcg[tl * 512 + gcol + nd * 32 + (lane & 31)]; } while (0)
#define GLA_STEP_A(IMG) do { LAS unsigned char* QD_ = (IMG) + GL_QD; LAS unsigned char* KD_ = (IMG) + GL_KD; LAS unsigned char* KCT_ = (IMG) + GL_KCT; LAS unsigned char* VT_ = (IMG) + GL_VT; \
        const float bc[8] = {pb0.x, pb0.y, pb0.z, pb0.w, pb1.x, pb1.y, pb1.z, pb1.w}, bl[8] = {pl0.x, pl0.y, pl0.z, pl0.w, pl1.x, pl1.y, pl1.z, pl1.w}; \
        const float kv[8] = {bflo(pk.x), bfhi(pk.x), bflo(pk.y), bfhi(pk.y), bflo(pk.z), bfhi(pk.z), bflo(pk.w), bfhi(pk.w)}; \
        if (PASS == 2) { const float qv[8] = {bflo(pq.x), bfhi(pq.x), bflo(pq.y), bfhi(pq.y), bflo(pq.z), bfhi(pq.z), bflo(pq.w), bfhi(pq.w)}; float qd[8], kd[8]; \
            _Pragma("unroll") for (int i = 0; i < 8; ++i) { qd[i] = qv[i] * qscale * __expf(bc[i]); kd[i] = kv[i] * __expf(-bc[i]); } \
            u32x4 w; w.x = pk2(qd[0], qd[1]); w.y = pk2(qd[2], qd[3]); w.z = pk2(qd[4], qd[5]); w.w = pk2(qd[6], qd[7]); *(LAS u32x4*)(QD_ + s_l * G_ST + 16 * wave) = w; \
            w.x = pk2(kd[0], kd[1]); w.y = pk2(kd[2], kd[3]); w.z = pk2(kd[4], kd[5]); w.w = pk2(kd[6], kd[7]); *(LAS u32x4*)(KD_ + s_l * G_ST + 16 * wave) = w; } \
        _Pragma("unroll") for (int i = 0; i < 8; ++i) *(LAS bf16*)(KCT_ + (8 * wave + i) * G_ST + 2 * s_l) = (bf16)f2bf(kv[i] * __expf(bl[i] - bc[i])); \
        const unsigned vv[8] = {pv0.x, pv0.y, pv0.z, pv0.w, pv1.x, pv1.y, pv1.z, pv1.w}; \
        _Pragma("unroll") for (int i = 0; i < 8; ++i) { *(LAS bf16*)(VT_ + (16 * wave + 2 * i) * G_ST + 2 * s_l) = (bf16)(vv[i] & 0xffffu); *(LAS bf16*)(VT_ + (16 * wave + 2 * i + 1) * G_ST + 2 * s_l) = (bf16)(vv[i] >> 16); } \
        dec_n = __expf(pdec); } while (0)
#define GLA_STEP_B(IMG, STW, WRITE_ST) do { LAS unsigned char* QD_ = (IMG) + GL_QD; LAS unsigned char* KD_ = (IMG) + GL_KD; LAS unsigned char* KCT_ = (IMG) + GL_KCT; LAS unsigned char* VT_ = (IMG) + GL_VT; \
        if (PASS == 2 && wave < 4) { const int ms = wave >> 1, ns = wave & 1; f32x16 sa; \
            _Pragma("unroll") for (int r = 0; r < 16; ++r) sa[r] = 0.f; \
            if (ns <= ms) { _Pragma("unroll") for (int ks = 0; ks < 4; ++ks) sa = MFMA32(ldfrag32(QD_, ms * 32, ks, lane), ldfrag32(KD_, ns * 32, ks, lane), sa); } \
            _Pragma("unroll") for (int r = 0; r < 16; ++r) { const int s = ms * 32 + crow(r, lane >> 5), s2 = ns * 32 + (lane & 31); const bool keep = dir ? (s2 < s) : (s2 <= s); \
                *(LAS bf16*)(SS + s * G_ST + 2 * s2) = (bf16)f2bf(keep ? sa[r] : 0.f); } } \
        _Pragma("unroll") for (int r = 0; r < 16; ++r) st[r] *= dec_c; \
        dtot *= dec_c; \
        _Pragma("unroll") for (int ks = 0; ks < 4; ++ks) st = MFMA32(ldfrag32(VT_, me * 32, ks, lane), ldfrag32(KCT_, nd * 32, ks, lane), st); \
        if (PASS == 2 && (WRITE_ST)) { _Pragma("unroll") for (int r = 0; r < 16; ++r) *(LAS bf16*)((STW) + (me * 32 + crow(r, lane >> 5)) * G_ST + (nd * 32 + (lane & 31)) * 2) = (bf16)f2bf(st[r]); } } while (0)
    float dec_n = 1.f, dec_c = 1.f;
    LAS unsigned char* IMG0 = lds; LAS unsigned char* IMG1 = lds + GL_IMG;
    GLA_LOAD(0);
    __syncthreads();
    GLA_STEP_A(IMG0); dec_c = dec_n;
    if (1 < GSC) GLA_LOAD(1);
    LDS_BARRIER();
    if (PASS == 2) { GLA_STEP_B(IMG0, STT + 128 * G_ST, true); LDS_BARRIER(); }
#pragma unroll 1
    for (int n = 0; n < GSC; ++n) {
        LAS unsigned char* Ic = (n & 1) ? IMG1 : IMG0; LAS unsigned char* In = (n & 1) ? IMG0 : IMG1;
        LAS unsigned char* STc = STT + (n & 1) * (128 * G_ST);
        if (PASS == 2) {
            const int ms = wave >> 2, ne = wave & 3;
            f32x16 oa;
#pragma unroll
            for (int r = 0; r < 16; ++r) oa[r] = 0.f;
#pragma unroll
            for (int ks = 0; ks < 4; ++ks) oa = MFMA32(ldfrag32(SS, ms * 32, ks, lane), ldfrag32(Ic + GL_VT, ne * 32, ks, lane), oa);
#pragma unroll
            for (int ks = 0; ks < 4; ++ks) oa = MFMA32(ldfrag32(Ic + GL_QD, ms * 32, ks, lane), ldfrag32(STc, ne * 32, ks, lane), oa);
            bf16* op = (bf16*)(ws + (dir ? WS_OB : WS_OF)) + h * 128 + ne * 32 + (lane & 31);
#pragma unroll
            for (int r = 0; r < 16; ++r) op[gla_tok(b, dir, sc * GSC + n, ms * 32 + crow(r, lane >> 5)) * 512] = (bf16)f2bf(oa[r]);
        } else {
            GLA_STEP_B(Ic, STT, false);
        }
        if (n + 1 < GSC) { GLA_STEP_A(In); if (n + 2 < GSC) GLA_LOAD(n + 2); }
        LDS_BARRIER();
        if (PASS == 2 && n + 1 < GSC) { dec_c = dec_n; GLA_STEP_B(In, STT + (n & 1) * (128 * G_ST), n + 2 < GSC); LDS_BARRIER(); }
        if (PASS == 1) dec_c = dec_n;
    }
#undef GLA_STEP_A
#undef GLA_STEP_B
    if (PASS == 1) {
        float* gs = GS + (size_t)item * 8192 + nd * 32 + (lane & 31);
#pragma unroll
        for (int r = 0; r < 16; ++r) gs[(size_t)(me * 32 + crow(r, lane >> 5)) * 64] = st[r];
        if (me == 0 && lane < 32) GD[(size_t)item * 64 + nd * 32 + lane] = dtot;
    }
    __syncthreads();
#undef GLA_LOAD
}
constexpr int AT_KST = 144, AT_VST = 664, AT_K = 0, AT_V = 320 * AT_KST, AT_BT = AT_V + 64 * AT_VST, AT_END = AT_BT + 16 * 260 * 4;
static_assert(AT_END <= RING_BYTES && AT_V % 16 == 0 && AT_BT % 16 == 0, "attention LDS");
__device__ __forceinline__ void attn_phase(unsigned char* ws, const float* sink, LAS unsigned char* lds, int bid, int G, int tid, int wave, int lane) {
    const bf16* qkv = (const bf16*)(ws + WS_QKV); bf16* ao = (bf16*)(ws + WS_AO); const float* btab = (const float*)(ws + WS_BTAB);
    LAS unsigned char* KS = lds + AT_K; LAS unsigned char* VT = lds + AT_V; LAS float* BT = (LAS float*)(lds + AT_BT);
    const float sc2 = 0.125f * LOG2E;
    u32x4 kreg[5], vreg[5]; bf16x8 qreg[4]; float sreg;
    for (int p = tid; p < 16 * 260; p += NTHR) BT[p] = btab[p];
#define AT_LOAD(u_) do { const int qb_ = (u_) % (SEQ / 64), kvh_ = ((u_) / (SEQ / 64)) & 3, b_ = (u_) / (4 * (SEQ / 64)), kb_ = qb_ * 64 - 128; \
        _Pragma("unroll") for (int it = 0; it < 5; ++it) { const int p = it * NTHR + tid; int key = kb_ + (p >> 3); key = key < 0 ? 0 : (key > SEQ - 1 ? SEQ - 1 : key); \
            const bf16* rp = qkv + ((size_t)b_ * SEQ + key) * CN + kvh_ * 64 + 8 * (p & 7); kreg[it] = *(const u32x4*)(rp + 1024); vreg[it] = *(const u32x4*)(rp + 1280); } \
        { const int hq_ = kvh_ * 4 + (wave >> 1); const bf16* qp_ = qkv + ((size_t)b_ * SEQ + qb_ * 64 + 32 * (wave & 1) + (lane & 31)) * CN + hq_ * 64 + 8 * (lane >> 5); \
          _Pragma("unroll") for (int ks = 0; ks < 4; ++ks) qreg[ks] = *(const bf16x8*)(qp_ + 16 * ks); sreg = sink[hq_]; } } while (0)
    if (bid < NB * 4 * (SEQ / 64)) AT_LOAD(bid);
    for (int u = bid; u < NB * 4 * (SEQ / 64); u += G) {
        const int qb = u % (SEQ / 64), kvh = (u / (SEQ / 64)) & 3, b = u / (4 * (SEQ / 64)), q0 = qb * 64;
#pragma unroll
        for (int it = 0; it < 5; ++it) { const int p = it * NTHR + tid, i = p >> 3, ch = p & 7;
            *(LAS u32x4*)(KS + i * AT_KST + 16 * ch) = kreg[it];
            const unsigned vv[4] = {vreg[it].x, vreg[it].y, vreg[it].z, vreg[it].w};
#pragma unroll
            for (int j = 0; j < 4; ++j) { *(LAS bf16*)(VT + (8 * ch + 2 * j) * AT_VST + 2 * i) = (bf16)(vv[j] & 0xffffu); *(LAS bf16*)(VT + (8 * ch + 2 * j + 1) * AT_VST + 2 * i) = (bf16)(vv[j] >> 16); } }
        const bf16x8 qf[4] = {qreg[0], qreg[1], qreg[2], qreg[3]}; const float m0 = sreg * LOG2E;
        if (u + G < NB * 4 * (SEQ / 64)) AT_LOAD(u + G);
        LDS_BARRIER();
        const int hl = wave >> 1, hq = kvh * 4 + hl, qw = q0 + 32 * (wave & 1), qi = qw + (lane & 31), hh = lane >> 5;
        float m = m0, l = hh == 0 ? 1.f : 0.f;
        f32x16 o0, o1;
#pragma unroll
        for (int r = 0; r < 16; ++r) { o0[r] = 0.f; o1[r] = 0.f; }
        const LAS float* btl = BT + hq * 260 + 128 - (lane & 31);
        const bool edge = (q0 < 128) || (q0 + 192 > SEQ);
#pragma unroll 1
        for (int j = 0; j < 9; ++j) {
            const int i0 = 32 * (wave & 1) + 32 * j;
            f32x16 sa;
#pragma unroll
            for (int r = 0; r < 16; ++r) sa[r] = 0.f;
#pragma unroll
            for (int ks = 0; ks < 4; ++ks) { const bf16x8 kf = *(const LAS bf16x8*)(KS + (i0 + (lane & 31)) * AT_KST + 32 * ks + 16 * hh); sa = MFMA32(kf, qf[ks], sa); }
            float mx = -3.0e38f;
#pragma unroll
            for (int r = 0; r < 16; ++r) {
                const int kk = 32 * j - 128 + crow(r, hh);
                sa[r] = sa[r] * sc2 + btl[kk];
            }
            if (edge || j == 0 || j == 8) {
#pragma unroll
                for (int r = 0; r < 16; ++r) {
                    const int kk = 32 * j - 128 + crow(r, hh), rel = kk - (lane & 31), key = qw + kk;
                    const bool ok = ((unsigned)(rel + 128) <= 256u) && ((unsigned)key < (unsigned)SEQ);
                    sa[r] = ok ? sa[r] : -3.0e38f;
                }
            }
#pragma unroll
            for (int r = 0; r < 16; ++r) mx = fmaxf(mx, sa[r]);
            mx = fmaxf(mx, __shfl_xor(mx, 32));
            if (!__all(mx <= m)) {
                const float mn = fmaxf(m, mx), alpha = __builtin_amdgcn_exp2f(m - mn); m = mn; l *= alpha;
#pragma unroll
                for (int r = 0; r < 16; ++r) { o0[r] *= alpha; o1[r] *= alpha; }
            }
            float ps = 0.f;
#pragma unroll
            for (int r = 0; r < 16; ++r) { const float p = __builtin_amdgcn_exp2f(sa[r] - m); sa[r] = p; ps += p; }
            l += ps;
#pragma unroll
            for (int s = 0; s < 2; ++s) {
                u32x4 pw; pw.x = pk2(sa[8 * s], sa[8 * s + 1]); pw.y = pk2(sa[8 * s + 2], sa[8 * s + 3]); pw.z = pk2(sa[8 * s + 4], sa[8 * s + 5]); pw.w = pk2(sa[8 * s + 6], sa[8 * s + 7]);
                const bf16x8 pf = __builtin_bit_cast(bf16x8, pw);
#pragma unroll
                for (int dt = 0; dt < 2; ++dt) {
                    const LAS unsigned char* vp = VT + (dt * 32 + (lane & 31)) * AT_VST + 2 * (i0 + 16 * s + 4 * hh);
                    const bf16x4 va = *(const LAS bf16x4*)vp, vb = *(const LAS bf16x4*)(vp + 16);
                    const bf16x8 vf = __builtin_shufflevector(va, vb, 0, 1, 2, 3, 4, 5, 6, 7);
                    if (dt == 0) o0 = MFMA32(vf, pf, o0); else o1 = MFMA32(vf, pf, o1);
                }
            }
        }
        l += __shfl_xor(l, 32);
        const float inv = __builtin_amdgcn_rcpf(l);
        bf16* op = ao + ((size_t)b * SEQ + qi) * D + hq * 64 + 4 * hh;
#pragma unroll
        for (int g = 0; g < 4; ++g) {
            u32x2 w0, w1; w0.x = pk2(o0[4 * g] * inv, o0[4 * g + 1] * inv); w0.y = pk2(o0[4 * g + 2] * inv, o0[4 * g + 3] * inv);
            w1.x = pk2(o1[4 * g] * inv, o1[4 * g + 1] * inv); w1.y = pk2(o1[4 * g + 2] * inv, o1[4 * g + 3] * inv);
            *(u32x2*)(op + 8 * g) = w0; *(u32x2*)(op + 32 + 8 * g) = w1;
        }
        LDS_BARRIER();
    }
#undef AT_LOAD
}
#ifndef MK_N_LAUNCHES
#define MK_N_LAUNCHES 1
#endif
constexpr int N_PHASES = 19;
#ifndef PH_MASK
#define PH_MASK 0xFFFFFFFFu
#endif
#define ON(k) (((PH_MASK) >> (k)) & 1u)
#ifndef REP_MASK
#define REP_MASK 0u
#endif
#define NREP(k) ((((REP_MASK) >> (k)) & 1u) ? 2 : 1)

template <int LAYER>
__device__ __forceinline__ void common_phases(unsigned char* ws, LAS unsigned char* lds, float* dout, const XcdBarrier& bar, int lo, int hi, int bid, int G, int tid, int wave, int lane) {
    constexpr int pb = LAYER == 0 ? 5 : 13;
    const int gw = bid * NWAVES + wave, NGW = G * NWAVES;
#define IN(k) (lo <= (k) && (k) < hi)
#define SEAM(k) do { if (IN(k) && IN((k) + 1)) xcd_barrier(bar); } while (0)
    if (ON(5) && IN(pb)) {
        pg8::Gemm g{(const bf16*)(ws + (LAYER == 0 ? WS_X64 : WS_AO)), (const bf16*)(ws + (LAYER == 0 ? WS_WOUT : WS_COUT)), T, D, D, 0, nullptr}; pg8::StaticOrder S; S.init(T, D, G, bid);
        pg8::EpiBf16 E{(bf16*)(ws + WS_Z), D};
        pg8::gemm_phase<pg8::EpiBf16, pg8::StaticOrder, false>(lds, g, S, E);
    }
    SEAM(pb);
    if (ON(6) && IN(pb + 1)) { ln_router<LAYER == 0>(ws, inp(lds, I_X), inp(lds, I_LNMG) + LAYER * D, inp(lds, I_LNMB) + LAYER * D, inp(lds, I_BGRP) + LAYER * 4, inp(lds, I_BRT) + LAYER * 32, LAYER, lds, bid, G, tid, wave, lane); __syncthreads(); }
    SEAM(pb + 1);
    if (ON(7) && IN(pb + 2)) { moe_sort(ws, lds, bid, G, tid); __syncthreads(); }
    SEAM(pb + 2);
    if (ON(8) && IN(pb + 3)) {
        const int* tile = (const int*)(ws + WS_TILE); const int ntiles = __builtin_amdgcn_readfirstlane(tile[511]);
        pg8::Gemm g{(const bf16*)(ws + WS_HHI), LAYER == 0 ? (const bf16*)(ws + WS_W13) : (const bf16*)dout, 0, D, D, (size_t)D * D * 2, (const int*)(ws + WS_SLOTT)};
        pg8::GroupOrder S{tile, ntiles, D / 256, G, bid};
        pg8::EpiSwiglu E{(bf16*)(ws + WS_HID), DEXP};
        pg8::gemm_phase<pg8::EpiSwiglu, pg8::GroupOrder, true>(lds, g, S, E);
        if (LAYER == 0) idle_convert(0, ws, lds, dout, ntiles, bid, G, wave, lane);
    }
    SEAM(pb + 3);
    if (ON(9) && IN(pb + 4)) {
        const int* tile = (const int*)(ws + WS_TILE); const int ntiles = __builtin_amdgcn_readfirstlane(tile[511]);
        pg8::Gemm g{(const bf16*)(ws + WS_HID), LAYER == 0 ? (const bf16*)(ws + WS_W2) : (const bf16*)dout + (size_t)NEXP * D * D, 0, D, DEXP, (size_t)D * DEXP * 2, nullptr};
        pg8::GroupOrder S{tile, ntiles, D / 256, G, bid};
        pg8::EpiBf16 E{(bf16*)(ws + WS_Y2), D};
        pg8::gemm_phase<pg8::EpiBf16, pg8::GroupOrder, false>(lds, g, S, E);
        if (LAYER == 0) idle_convert(1, ws, lds, dout, ntiles, bid, G, wave, lane);
    }
    SEAM(pb + 4);
    if (ON(10) && IN(pb + 5)) {
        if (LAYER == 0) {
            combine_ln<false>(ws, inp(lds, I_LNFG), inp(lds, I_LNFB), nullptr, gw, NGW, lane);
            { const int done = idle_done(__builtin_amdgcn_readfirstlane(((const int*)(ws + WS_TILE))[511]), G);
              moe_convert(inp(lds, I_W1) + (size_t)NEXP * D * DEXP, inp(lds, I_W3) + (size_t)NEXP * D * DEXP, inp(lds, I_W2) + (size_t)NEXP * DEXP * D, (bf16*)dout, (bf16*)dout + (size_t)NEXP * D * D, (LAS float*)(lds + wave * 16384), done, MOE_ITEMS, gw, NGW, lane); }
            __syncthreads();
        } else combine_ln<true>(ws, inp(lds, I_LNFG) + D, inp(lds, I_LNFB) + D, dout, gw, NGW, lane);
    }
    if (LAYER == 0) SEAM(10);
#undef IN
#undef SEAM
}

struct Args { const float* in[N_IN]; float* out; unsigned char* ws; int ph_lo, ph_hi; };
static_assert(sizeof(Args) == N_IN * 8 + 8 + 8 + 8, "no padding holes in Args");

__global__ void __launch_bounds__(NTHR, 2) fwd_kernel(Args args) {
    extern __shared__ __attribute__((aligned(16))) unsigned char lds_raw[];
    LAS unsigned char* lds = (LAS unsigned char*)lds_raw;
    volatile LAS unsigned* MISC = (volatile LAS unsigned*)(lds + MISC_OFF);
    const int tid = threadIdx.x, lane = tid & 63, wave = __builtin_amdgcn_readfirstlane(tid >> 6), G = gridDim.x, bid = blockIdx.x;
    unsigned char* ws = args.ws;
    for (int u = tid; u < 64; u += NTHR) MISC[u] = 0u;
    if (tid < N_IN) *(LAS unsigned long long*)(lds + PTR_OFF + 8 * tid) = (unsigned long long)args.in[tid];
    __syncthreads();
    const int lo = args.ph_lo, hi = args.ph_hi;
    const bool use_bar = (hi - lo) > 1;
    XcdBarrier bar; bar.bar = (unsigned*)(ws + WS_CTL) + CW_BAR; bar.x = 0; bar.st = nullptr;
    if (use_bar) bar = xcd_barrier_post((unsigned*)(ws + WS_CTL) + CW_BAR, MISC + 8);
#define IN(k) (lo <= (k) && (k) < hi)
#define SEAM(k) do { if (IN(k) && IN((k) + 1)) xcd_barrier(bar); } while (0)
    const int gw = bid * NWAVES + wave, NGW = G * NWAVES;

    if (ON(0) && IN(0)) { p0_prologue(ws, lds, bid, G, tid, wave, lane); __syncthreads(); }
    SEAM(0);
    if (ON(1) && IN(1)) {
        pg8::Gemm g{(const bf16*)(ws + WS_X64), (const bf16*)(ws + WS_WIN), T, ABN, D, 0, nullptr}; pg8::SplitOrder S; S.init(T, ABN, 2, G, bid);
        pg8::EpiBf16 E{(bf16*)(ws + WS_H0), H0P};
        pg8::gemm_phase<pg8::EpiBf16, pg8::SplitOrder, false>(lds, g, S, E);
        lr_tail(ws, args.out, inp(lds, I_GATEW), inp(lds, I_GATEB), lds, bid, G, tid, wave, lane);
#ifdef TAIL_TWICE
        lr_tail(ws, args.out, inp(lds, I_GATEW), inp(lds, I_GATEB), lds, bid, G, tid, wave, lane);
#endif
    }
    SEAM(1);
    if (ON(2) && IN(2)) {
        s5_phase<1>(ws, inp(lds, I_S5D), lds, bid, G, tid, wave, lane);
#ifdef S5_TWICE
        __syncthreads(); s5_phase<1>(ws, inp(lds, I_S5D), lds, bid, G, tid, wave, lane);
#endif
        __syncthreads();
        for (int it = bid; it < 256; it += G) gla_item<1>(ws, args.out, it, lds, tid, wave, lane);
#ifdef GLA_TWICE
        for (int it = bid; it < 256; it += G) gla_item<1>(ws, args.out, it, lds, tid, wave, lane);
#endif
    }
    SEAM(2);
    if (ON(3) && IN(3)) {
        s5_phase<2>(ws, inp(lds, I_S5D), lds, bid, G, tid, wave, lane);
#ifdef S5_TWICE
        __syncthreads(); s5_phase<2>(ws, inp(lds, I_S5D), lds, bid, G, tid, wave, lane);
#endif
        __syncthreads();
        for (int it = bid; it < 256; it += G) gla_item<2>(ws, args.out, it, lds, tid, wave, lane);
#ifdef GLA_TWICE
        for (int it = bid; it < 256; it += G) gla_item<2>(ws, args.out, it, lds, tid, wave, lane);
#endif
    }
    SEAM(3);
    if (ON(4) && IN(4)) {
        gla_finalize(ws, inp(lds, I_NORMG), gw, NGW, lane);
        pg8::Gemm g{(const bf16*)(ws + WS_YG), (const bf16*)(ws + WS_WGLU), T, 512, 512, 0, nullptr}; pg8::StaticOrder S; S.init(T, 512, G, bid);
        pg8::EpiGlu E{(const bf16*)(ws + WS_YG), 512, (bf16*)(ws + WS_X64), D, inp(lds, I_GLUB)};
        pg8::gemm_phase<pg8::EpiGlu, pg8::StaticOrder, false>(lds, g, S, E);
    }
    SEAM(4);
    common_phases<0>(ws, lds, args.out, bar, lo, hi, bid, G, tid, wave, lane);
    if (ON(11) && IN(11)) {
        pg8::Gemm g{(const bf16*)(ws + WS_H2B), (const bf16*)(ws + WS_CIN), T, CN, D, 0, nullptr}; pg8::StaticOrder S; S.init(T, CN, G, bid);
        pg8::EpiBf16 E{(bf16*)(ws + WS_QKV), CN};
        pg8::gemm_phase<pg8::EpiBf16, pg8::StaticOrder, false>(lds, g, S, E);
    }
    SEAM(11);
    if (ON(12) && IN(12)) attn_phase(ws, inp(lds, I_SINK), lds, bid, G, tid, wave, lane);
    SEAM(12);
    common_phases<1>(ws, lds, args.out, bar, lo, hi, bid, G, tid, wave, lane);
#undef IN
#undef SEAM
}

extern "C" void kernel_launch(void* const* d_in, const int* in_sizes, int n_in, void* d_out, int out_size, void* d_ws, size_t ws_size, hipStream_t stream) {
    static int grid = 0;
    if (grid == 0) {
        if (n_in != N_IN || in_sizes[0] != T * D || out_size != T * D || ws_size < WS_END) { fprintf(stderr, "kernel_launch: unexpected shapes (n_in %d, in0 %d, out %d, ws %zu < %zu)\n", n_in, n_in > 0 ? in_sizes[0] : -1, out_size, ws_size, (size_t)WS_END); grid = -1; return; }
        int dev = 0, cus = 0, per_cu = 0;
        if (hipGetDevice(&dev) != hipSuccess || hipDeviceGetAttribute(&cus, hipDeviceAttributeMultiprocessorCount, dev) != hipSuccess) { grid = -1; return; }
        if (hipFuncSetAttribute((const void*)fwd_kernel, hipFuncAttributeMaxDynamicSharedMemorySize, LDS_BYTES) != hipSuccess) { fprintf(stderr, "kernel_launch: hipFuncSetAttribute failed\n"); grid = -1; return; }
        if (hipOccupancyMaxActiveBlocksPerMultiprocessor(&per_cu, (const void*)fwd_kernel, NTHR, LDS_BYTES) != hipSuccess || per_cu < 1) fprintf(stderr, "kernel_launch: occupancy query reports %d\n", per_cu);
        (void)hipGetLastError();
        grid = cus;
    }
    if (grid < 0) return;
    if (hipMemsetAsync((char*)d_ws + WS_CTL, 0, CTL_ZERO_BYTES, stream) != hipSuccess) return;
    Args a{};
    for (int i = 0; i < N_IN; ++i) a.in[i] = (const float*)d_in[i];
    a.out = (float*)d_out; a.ws = (unsigned char*)d_ws;
    for (int li = 0; li < MK_N_LAUNCHES; ++li) {
        a.ph_lo = (MK_N_LAUNCHES == 1) ? 0 : li; a.ph_hi = (MK_N_LAUNCHES == 1) ? N_PHASES : li + 1;
        for (int rep = 0; rep < ((MK_N_LAUNCHES > 1 && ((REP_MASK >> li) & 1u)) ? 2 : 1); ++rep)
            hipLaunchKernelGGL(fwd_kernel, dim3(grid), dim3(NTHR), LDS_BYTES, stream, a);
    }
}
```

```cpp
#include <hip/hip_runtime.h>
#include <cstdio>
#include <cstdint>
#include <cmath>
namespace pg8 {
#define PG8_LAS __attribute__((address_space(3)))
typedef unsigned short bf16_t;
typedef short bf16x8 __attribute__((ext_vector_type(8)));
typedef float f32x4 __attribute__((ext_vector_type(4)));
typedef float f32x2 __attribute__((ext_vector_type(2)));
typedef unsigned u32x4 __attribute__((ext_vector_type(4)));
typedef unsigned u32x2 __attribute__((ext_vector_type(2)));
constexpr int BM = 256, BK = 64, HALF = 128, HTB = HALF * BK * 2  , STAGE_BYTES = 8 * HTB, NXCD = 8, WGM = 8;

__host__ __device__ __forceinline__ int lds_byte(int r, int c) { const int st = (r >> 4) * 2 + (c >> 5), rr = r & 15, cc = c & 31, ob = rr * 64 + cc * 2; return st * 1024 + (ob ^ (((ob >> 9) & 1) << 5)); }
__host__ __device__ __forceinline__ void stage_rc(int b, int& R, int& C) { const int st = b / 1024, sb = b % 1024, swz = sb ^ (((sb >> 9) & 1) << 5); R = (st >> 1) * 16 + swz / 64; C = (st & 1) * 32 + (swz % 64) / 2; }
__host__ __device__ __forceinline__ int perm32(int rho) { const int n = rho >> 4, i = rho & 15; return 8 * (i >> 2) + 4 * n + (i & 3); }

struct Unit { int pm, pn, e, ui; };
struct Gemm { const bf16_t* A; const bf16_t* Bt; int M, N, K; size_t bstride; const int* rowmap; };

struct StaticOrder {
    int nM, nN, nwg, G, c;
    __host__ __device__ void init(int M, int N, int G_, int c_) { nM = M / BM; nN = N / BM; nwg = nM * nN; G = G_; c = c_; }
    __host__ __device__ bool next(int i, Unit& u) const {
        const long L = (long)i * G + c; if (L >= nwg) return false;
        int wgid = (int)L; { const int q = nwg / NXCD, r = nwg % NXCD, xcd = wgid % NXCD, off = wgid / NXCD; wgid = (xcd < r ? xcd * (q + 1) : r * (q + 1) + (xcd - r) * q) + off; }
        const int nig = WGM * nN, gid = wgid / nig, fm = gid * WGM, gsz = (nM - fm) < WGM ? (nM - fm) : WGM;
        u.pm = fm + ((wgid % nig) % gsz); u.pn = (wgid % nig) / gsz; u.e = 0; u.ui = i; return true;
    }
};
struct SplitOrder {
    int nM, nNs, nwgs, nsp, G, c;
    __host__ __device__ void init(int M, int N, int nsp_, int G_, int c_) { nM = M / BM; nNs = N / BM / nsp_; nwgs = nM * nNs; nsp = nsp_; G = G_; c = c_; }
    __host__ __device__ bool next(int i, Unit& u) const {
        const long L = (long)i * G + c; if (L >= (long)nwgs * nsp) return false;
        const int slab = (int)(L / nwgs); int wgid = (int)(L % nwgs);
        { const int q = nwgs / NXCD, r = nwgs % NXCD, xcd = wgid % NXCD, off = wgid / NXCD; wgid = (xcd < r ? xcd * (q + 1) : r * (q + 1) + (xcd - r) * q) + off; }
        const int nig = WGM * nNs, gid = wgid / nig, fm = gid * WGM, gsz = (nM - fm) < WGM ? (nM - fm) : WGM;
        u.pm = fm + ((wgid % nig) % gsz); u.pn = slab * nNs + (wgid % nig) / gsz; u.e = 0; u.ui = i; return true;
    }
};
struct GroupOrder {
    const int* tile_e; int ntiles, nN, G, c;
    __device__ bool next(int i, Unit& u) const {
        const int L = i * G + c; if (L >= ntiles * nN) return false;
        u.pm = L / nN; u.pn = L % nN; u.e = __builtin_amdgcn_readfirstlane(tile_e[u.pm]); u.ui = i; return true;
    }
};

typedef __bf16 bf16x2_t __attribute__((ext_vector_type(2)));
__device__ __forceinline__ unsigned cvt_pk_bf16(float lo, float hi) { f32x2 v = {lo, hi}; return __builtin_bit_cast(unsigned, __builtin_convertvector(v, bf16x2_t)); }
__device__ __forceinline__ float bf_lo(unsigned w) { return __uint_as_float(w << 16); }
__device__ __forceinline__ float bf_hi(unsigned w) { return __uint_as_float(w & 0xffff0000u); }

struct EpiBf16 {
    static constexpr bool PERM = true;
    bf16_t* O; int ldc;
    __device__ __forceinline__ void operator()(const f32x4 (&acc)[2][2][4][2], const Unit& u, int wr, int wc, int fr, int fq) const {
        const int row0 = u.pm * BM + wr * 64 + fr; const int col0 = u.pn * BM + wc * 32 + 8 * fq;
#pragma unroll
        for (int ai = 0; ai < 2; ++ai)
#pragma unroll
            for (int m = 0; m < 4; ++m) { bf16_t* rowp = O + (size_t)(row0 + ai * HALF + m * 16) * ldc + col0;
#pragma unroll
                for (int bj = 0; bj < 2; ++bj) { const f32x4 v0 = acc[ai][bj][m][0], v1 = acc[ai][bj][m][1];
                    u32x4 w; w.x = cvt_pk_bf16(v0[0], v0[1]); w.y = cvt_pk_bf16(v0[2], v0[3]); w.z = cvt_pk_bf16(v1[0], v1[1]); w.w = cvt_pk_bf16(v1[2], v1[3]);
                    *(u32x4*)(rowp + bj * HALF) = w; } }
    }
};
struct EpiGlu {
    static constexpr bool PERM = true;
    const bf16_t* Y; int ldy; bf16_t* O; int ldc; const float* bias;
    __device__ __forceinline__ void operator()(const f32x4 (&acc)[2][2][4][2], const Unit& u, int wr, int wc, int fr, int fq) const {
        const int row0 = u.pm * BM + wr * 64 + fr; const int col0 = u.pn * BM + wc * 32 + 8 * fq;
        f32x4 bv[2][2];
#pragma unroll
        for (int bj = 0; bj < 2; ++bj)
#pragma unroll
            for (int n = 0; n < 2; ++n) bv[bj][n] = *(const f32x4*)(bias + col0 + bj * HALF + 4 * n);
#pragma unroll
        for (int ai = 0; ai < 2; ++ai) {
            u32x4 yq[4][2];
#pragma unroll
            for (int m = 0; m < 4; ++m)
#pragma unroll
                for (int bj = 0; bj < 2; ++bj) yq[m][bj] = *(const u32x4*)(Y + (size_t)(row0 + ai * HALF + m * 16) * ldy + col0 + bj * HALF);
            asm volatile("" ::: "memory");
#pragma unroll
            for (int m = 0; m < 4; ++m) { const size_t r = (size_t)(row0 + ai * HALF + m * 16);
#pragma unroll
                for (int bj = 0; bj < 2; ++bj) { const f32x4 v0 = acc[ai][bj][m][0] + bv[bj][0], v1 = acc[ai][bj][m][1] + bv[bj][1];
                    const u32x4 y = yq[m][bj];
                    float o[8]; const float yv[8] = {bf_lo(y.x), bf_hi(y.x), bf_lo(y.y), bf_hi(y.y), bf_lo(y.z), bf_hi(y.z), bf_lo(y.w), bf_hi(y.w)};
#pragma unroll
                    for (int i = 0; i < 4; ++i) { o[i] = yv[i] * __builtin_amdgcn_rcpf(1.f + __expf(-v0[i])); o[4 + i] = yv[4 + i] * __builtin_amdgcn_rcpf(1.f + __expf(-v1[i])); }
                    u32x4 w; w.x = cvt_pk_bf16(o[0], o[1]); w.y = cvt_pk_bf16(o[2], o[3]); w.z = cvt_pk_bf16(o[4], o[5]); w.w = cvt_pk_bf16(o[6], o[7]);
                    *(u32x4*)(O + r * ldc + col0 + bj * HALF) = w; } }
            asm volatile("" ::: "memory");
        }
    }
};
struct EpiResid {
    static constexpr bool PERM = false;
    const float* resid; float* out; int ldc; float alpha;
    __device__ __forceinline__ void operator()(const f32x4 (&acc)[2][2][4][2], const Unit& u, int wr, int wc, int fr, int fq) const {
        const int col0 = u.pn * BM + wc * 32 + 4 * fq;
#pragma unroll
        for (int ai = 0; ai < 2; ++ai) {
            f32x4 bs[4][2][2];
#pragma unroll
            for (int m = 0; m < 4; ++m) { const size_t off = (size_t)(u.pm * BM + ai * HALF + wr * 64 + m * 16 + fr) * ldc + col0;
#pragma unroll
                for (int bj = 0; bj < 2; ++bj)
#pragma unroll
                    for (int n = 0; n < 2; ++n) bs[m][bj][n] = *(const f32x4*)(resid + off + bj * HALF + n * 16); }
            asm volatile("" ::: "memory");
#pragma unroll
            for (int m = 0; m < 4; ++m) { const size_t off = (size_t)(u.pm * BM + ai * HALF + wr * 64 + m * 16 + fr) * ldc + col0;
#pragma unroll
                for (int bj = 0; bj < 2; ++bj)
#pragma unroll
                    for (int n = 0; n < 2; ++n) *(f32x4*)(out + off + bj * HALF + n * 16) = bs[m][bj][n] * alpha + acc[ai][bj][m][n]; }
            asm volatile("" ::: "memory");
        }
    }
};
struct EpiSwiglu {
    static constexpr bool PERM = true;
    bf16_t* O; int ldc;
    __device__ __forceinline__ void operator()(const f32x4 (&acc)[2][2][4][2], const Unit& u, int wr, int wc, int fr, int fq) const {
        const int row0 = u.pm * BM + wr * 64 + fr; const int col0 = (u.pn * BM + wc * 32 + 8 * fq) >> 1;
#pragma unroll
        for (int ai = 0; ai < 2; ++ai)
#pragma unroll
            for (int m = 0; m < 4; ++m) { bf16_t* rowp = O + (size_t)(row0 + ai * HALF + m * 16) * ldc + col0;
#pragma unroll
                for (int bj = 0; bj < 2; ++bj) { const f32x4 g = acc[ai][bj][m][0], up = acc[ai][bj][m][1]; float o[4];
#pragma unroll
                    for (int i = 0; i < 4; ++i) o[i] = g[i] * __builtin_amdgcn_rcpf(1.f + __expf(-g[i])) * up[i];
                    u32x2 w; w.x = cvt_pk_bf16(o[0], o[1]); w.y = cvt_pk_bf16(o[2], o[3]);
                    *(u32x2*)(rowp + bj * (HALF / 2)) = w; } }
    }
};
struct EpiScale {
    static constexpr bool PERM = true;
    bf16_t* O; int ldc; const float* rw;
    __device__ __forceinline__ void operator()(const f32x4 (&acc)[2][2][4][2], const Unit& u, int wr, int wc, int fr, int fq) const {
        const int row0 = u.pm * BM + wr * 64 + fr; const int col0 = u.pn * BM + wc * 32 + 8 * fq;
        float sw[2][4];
#pragma unroll
        for (int ai = 0; ai < 2; ++ai)
#pragma unroll
            for (int m = 0; m < 4; ++m) sw[ai][m] = rw[row0 + ai * HALF + m * 16];
        asm volatile("" ::: "memory");
#pragma unroll
        for (int ai = 0; ai < 2; ++ai)
#pragma unroll
            for (int m = 0; m < 4; ++m) { const int r = row0 + ai * HALF + m * 16; const float s = sw[ai][m]; bf16_t* rowp = O + (size_t)r * ldc + col0;
#pragma unroll
                for (int bj = 0; bj < 2; ++bj) { const f32x4 v0 = acc[ai][bj][m][0] * s, v1 = acc[ai][bj][m][1] * s;
                    u32x4 w; w.x = cvt_pk_bf16(v0[0], v0[1]); w.y = cvt_pk_bf16(v0[2], v0[3]); w.z = cvt_pk_bf16(v1[0], v1[1]); w.w = cvt_pk_bf16(v1[2], v1[3]);
                    *(u32x4*)(rowp + bj * HALF) = w; } }
    }
};

template <class Epi, class Sched, bool GATHER>
__device__ __forceinline__ void gemm_phase(PG8_LAS unsigned char* lds, const Gemm g, const Sched& S, const Epi& E) {
    const int tid = threadIdx.x, wid = __builtin_amdgcn_readfirstlane(tid >> 6), lane = tid & 63, wr = wid >> 2, wc = wid & 3, fr = lane & 15, fq = lane >> 4;
    const int K = g.K, nt = K / BK;
    unsigned voffA[2], voffB[2]; int RA[2], CA[2];
#pragma unroll
    for (int i = 0; i < 2; ++i) { int R, C; stage_rc(tid * 16 + i * 8192, R, C); const int Rb = Epi::PERM ? ((R & ~31) + perm32(R & 31)) : R;
        voffA[i] = (unsigned)(R * K + C) * 2u; voffB[i] = (unsigned)(Rb * K + C) * 2u; RA[i] = R; CA[i] = C; }
    const size_t kstep = (size_t)(BK * 2);
    const size_t hstep = (size_t)HALF * K * 2;
    const size_t tstep = 2 * hstep;
    const unsigned ldsw = (unsigned)wid * 1024u;
    const int aoff = lds_byte(wr * 64 + fr, fq * 8), boff = lds_byte(wc * 32 + fr, fq * 8);
#define PG8_SA(b, h) (((b) * 2 + (h)) * HTB)
#define PG8_SB(b, h) ((4 + (b) * 2 + (h)) * HTB)
#define PG8_STAGE(bufoff, gbase, voff) do { _Pragma("unroll") for (int _i = 0; _i < 2; ++_i) \
        __builtin_amdgcn_global_load_lds((const unsigned*)((const char*)(gbase) + (voff)[_i]), (PG8_LAS unsigned*)(lds + (bufoff) + ldsw + _i * 8192), 16, 0, 0); } while (0)
#define PG8_LDA(dst, b, h) do { _Pragma("unroll") for (int m = 0; m < 4; ++m) _Pragma("unroll") for (int k = 0; k < 2; ++k) dst[m][k] = *(const PG8_LAS bf16x8*)(lds + PG8_SA(b, h) + aoff + m * 2048 + k * 1024); } while (0)
#define PG8_LDB(dst, b, h) do { _Pragma("unroll") for (int n = 0; n < 2; ++n) _Pragma("unroll") for (int k = 0; k < 2; ++k) dst[n][k] = *(const PG8_LAS bf16x8*)(lds + PG8_SB(b, h) + boff + n * 2048 + k * 1024); } while (0)
#define PG8_MMA(ai, bj, At, Bt) do { __builtin_amdgcn_s_setprio(1); _Pragma("unroll") for (int m = 0; m < 4; ++m) _Pragma("unroll") for (int n = 0; n < 2; ++n) _Pragma("unroll") for (int k = 0; k < 2; ++k) \
        acc[ai][bj][m][n] = __builtin_amdgcn_mfma_f32_16x16x32_bf16(Bt[n][k], At[m][k], acc[ai][bj][m][n], 0, 0, 0); __builtin_amdgcn_s_setprio(0); } while (0)
#define PG8_WAIT_V(n) asm volatile("s_waitcnt vmcnt(" #n ")" ::: "memory")
#define PG8_WAIT_L(n) asm volatile("s_waitcnt lgkmcnt(" #n ")" ::: "memory")
#define PG8_BAR __builtin_amdgcn_s_barrier()
#define PG8_SCHED __builtin_amdgcn_sched_barrier(0)
    Unit cur, nxt; int ui = 0;
    const PG8_LAS int* rmap = (const PG8_LAS int*)(lds + STAGE_BYTES);
    if (GATHER) { Unit t_; for (int i_ = 0; S.next(i_, t_) && i_ < 16; ++i_) { if (tid < BM) ((PG8_LAS int*)(lds + STAGE_BYTES))[i_ * BM + tid] = g.rowmap[t_.pm * BM + tid]; }
        asm volatile("s_waitcnt vmcnt(0) lgkmcnt(0)" ::: "memory"); __builtin_amdgcn_s_barrier(); asm volatile("" ::: "memory"); }
    if (!S.next(0, cur)) return;
    f32x4 acc[2][2][4][2];
#pragma unroll
    for (int a = 0; a < 2; ++a)
#pragma unroll
        for (int b = 0; b < 2; ++b)
#pragma unroll
            for (int m = 0; m < 4; ++m)
#pragma unroll
                for (int n = 0; n < 2; ++n) acc[a][b][m][n] = (f32x4){0.f, 0.f, 0.f, 0.f};
    bf16x8 At[4][2], B0[2][2], B1[2][2];
    unsigned cG[2][2], nG[2][2];
#define PG8_LOAD_ROWS(u_, G2_) do { _Pragma("unroll") for (int h_ = 0; h_ < 2; ++h_) _Pragma("unroll") for (int i_ = 0; i_ < 2; ++i_) \
        G2_[h_][i_] = GATHER ? ((unsigned)rmap[(u_).ui * BM + h_ * HALF + RA[i_]] * (unsigned)K + (unsigned)CA[i_]) * 2u : voffA[i_]; } while (0)
    const char* cA = GATHER ? (const char*)g.A : (const char*)g.A + (size_t)cur.pm * tstep;
    const size_t hA = GATHER ? 0 : hstep;
    const char* cB = (const char*)g.Bt + (size_t)cur.e * g.bstride + (size_t)cur.pn * tstep;
    PG8_LOAD_ROWS(cur, cG);
    PG8_STAGE(PG8_SB(0, 0), cB, voffB); PG8_STAGE(PG8_SB(0, 1), cB + hstep, voffB); PG8_STAGE(PG8_SA(0, 0), cA, cG[0]); PG8_STAGE(PG8_SA(0, 1), cA + hA, cG[1]);
    if (wr == 1) PG8_BAR;
    PG8_WAIT_V(2); PG8_BAR;
    PG8_STAGE(PG8_SB(1, 0), cB + kstep, voffB); PG8_STAGE(PG8_SA(1, 0), cA + kstep, cG[0]); PG8_STAGE(PG8_SB(1, 1), cB + hstep + kstep, voffB);
    PG8_WAIT_V(6); PG8_BAR;
    for (;;) {
        const bool has_next = S.next(ui + 1, nxt);
        const char* nA = GATHER ? (const char*)g.A : (has_next ? (const char*)g.A + (size_t)nxt.pm * tstep : cA);
        const char* nB = has_next ? (const char*)g.Bt + (size_t)nxt.e * g.bstride + (size_t)nxt.pn * tstep : cB;
        if (has_next) PG8_LOAD_ROWS(nxt, nG); else {
#pragma unroll
            for (int h = 0; h < 2; ++h) { nG[h][0] = cG[h][0]; nG[h][1] = cG[h][1]; } }
        for (int t = 0; t < nt; t += 2) {
            const bool last = (t == nt - 2);
            const char* a1 = cA + (size_t)(t + 1) * kstep;
            const char* a2 = last ? nA : cA + (size_t)(t + 2) * kstep; const char* b2 = last ? nB : cB + (size_t)(t + 2) * kstep;
            const char* a3 = a2 + kstep; const char* b3 = b2 + kstep;
            unsigned sG[2][2];
#pragma unroll
            for (int h = 0; h < 2; ++h) { sG[h][0] = (GATHER && last) ? nG[h][0] : cG[h][0]; sG[h][1] = (GATHER && last) ? nG[h][1] : cG[h][1]; }
            PG8_LDB(B0, 0, 0); PG8_LDB(B1, 0, 1); PG8_SCHED; PG8_LDA(At, 0, 0); PG8_STAGE(PG8_SA(1, 1), a1 + hA, cG[1]);
            PG8_WAIT_V(8); PG8_WAIT_L(0); PG8_BAR; PG8_MMA(0, 0, At, B0); PG8_MMA(0, 1, At, B1); PG8_BAR; PG8_SCHED;
            PG8_LDA(At, 0, 1); PG8_STAGE(PG8_SB(0, 0), b2, voffB); PG8_STAGE(PG8_SB(0, 1), b2 + hstep, voffB); PG8_STAGE(PG8_SA(0, 0), a2, sG[0]);
            PG8_WAIT_V(8); PG8_WAIT_L(0); PG8_BAR; PG8_MMA(1, 0, At, B0); PG8_MMA(1, 1, At, B1); PG8_BAR; PG8_SCHED;
            PG8_LDB(B0, 1, 0); PG8_LDB(B1, 1, 1); PG8_SCHED; PG8_LDA(At, 1, 0); PG8_STAGE(PG8_SA(0, 1), a2 + hA, sG[1]);
            PG8_WAIT_V(8); PG8_WAIT_L(0); PG8_BAR; PG8_MMA(0, 0, At, B0); PG8_MMA(0, 1, At, B1); PG8_BAR; PG8_SCHED;
            PG8_LDA(At, 1, 1); PG8_STAGE(PG8_SB(1, 0), b3, voffB); PG8_STAGE(PG8_SB(1, 1), b3 + hstep, voffB); PG8_STAGE(PG8_SA(1, 0), a3, sG[0]);
            PG8_WAIT_V(8); PG8_WAIT_L(0); PG8_BAR; PG8_MMA(1, 0, At, B0); PG8_MMA(1, 1, At, B1); PG8_BAR; PG8_SCHED;
        }
        if (wr == 0) PG8_BAR;
        E(acc, cur, wr, wc, fr, fq);
        if (!has_next) break;
#pragma unroll
        for (int a = 0; a < 2; ++a)
#pragma unroll
            for (int b = 0; b < 2; ++b)
#pragma unroll
                for (int m = 0; m < 4; ++m)
#pragma unroll
                    for (int n = 0; n < 2; ++n) acc[a][b][m][n] = (f32x4){0.f, 0.f, 0.f, 0.f};
        cur = nxt; cA = nA; cB = nB; ++ui;
#pragma unroll
        for (int h = 0; h < 2; ++h) { cG[h][0] = nG[h][0]; cG[h][1] = nG[h][1]; }
        if (wr == 1) PG8_BAR;
    }
    PG8_WAIT_V(0);
    PG8_BAR;
#undef PG8_LOAD_ROWS
#undef PG8_SA
#undef PG8_SB
#undef PG8_STAGE
#undef PG8_LDA
#undef PG8_LDB
#undef PG8_MMA
#undef PG8_WAIT_V
#undef PG8_WAIT_L
#undef PG8_BAR
#undef PG8_SCHED
}
}
constexpr int NB = 2, SEQ = 16384, T = NB * SEQ, D = 1024;
constexpr int H0P = 2112;
constexpr int ABN = 2048, OFF_U = 0, OFF_Q = 512, OFF_K = 768, OFF_V = 1024, OFF_GO = 1536, AB_IN = 2080;
constexpr int CN = 1536;
constexpr int NEXP = 32, DEXP = 512, CAP = 2 * T + NEXP * 256, MAXTILES = CAP / 256;
constexpr int S5CH = 256, S5NCH = SEQ / S5CH;
constexpr int GSC = 16, GCH = 64, GNSC = SEQ / (GSC * GCH);
constexpr float ALPHA = 1.41421356237309515f;
constexpr float LN_EPS = 1e-5f, RMS_EPS = 1e-6f, LOG2E = 1.44269504088896341f;
constexpr int NWAVES = 8, NTHR = 512;

constexpr size_t MiB = 1u << 20, KiB = 1u << 10;
constexpr size_t WS_CTL = 0, CTL_ZERO_BYTES = 64 * KiB;
constexpr int CW_BAR = 4096;
constexpr size_t WS_LR = 1 * MiB;
constexpr size_t WS_S5E = 5 * MiB;
constexpr size_t WS_GS = 9 * MiB;
constexpr size_t WS_GD = 17 * MiB;
constexpr size_t WS_S5L = WS_GD + 64 * KiB;
constexpr size_t WS_S5B = WS_S5L + 64 * KiB;
constexpr size_t WS_S5C = WS_S5B + 256 * KiB;
constexpr size_t WS_BTAB = WS_S5C + 256 * KiB;
constexpr size_t WS_WR = WS_BTAB + 32 * KiB;
constexpr size_t WS_TOKE = WS_WR + 384 * KiB;
constexpr size_t WS_TOKW = WS_TOKE + 256 * KiB;
constexpr size_t WS_TOKS = WS_TOKW + 256 * KiB;
constexpr size_t WS_SLOTT = WS_TOKS + 256 * KiB;
constexpr size_t WS_SLOTW = WS_SLOTT + 288 * KiB;
constexpr size_t WS_BLKC = WS_SLOTW + 288 * KiB;
constexpr size_t WS_TILE = WS_BLKC + 32 * KiB;
static_assert(WS_TILE + 4 * KiB <= 32 * MiB, "param region");
constexpr size_t WS_WIN = 32 * MiB, WS_WLR = 36 * MiB, WS_WGLU = 37 * MiB, WS_WOUT = 38 * MiB, WS_CIN = 40 * MiB, WS_COUT = 43 * MiB;
constexpr size_t WS_W13 = 48 * MiB, WS_W2 = 112 * MiB;
constexpr size_t A0 = 144 * MiB;
constexpr size_t WS_H1 = A0, WS_HLO = A0, WS_HHI = A0 + 64 * MiB, WS_H0 = A0;
constexpr size_t WS_Z = A0 + 128 * MiB;
constexpr size_t WS_YG = A0 + 136 * MiB, WS_OF = A0 + 168 * MiB, WS_OB = A0 + 320 * MiB;
constexpr size_t WS_YSCR = A0 + 232 * MiB;
constexpr size_t WS_X64 = A0 + 256 * MiB;
constexpr size_t WS_HID = A0 + 128 * MiB;
constexpr size_t WS_Y2 = A0 + 200 * MiB;
constexpr size_t WS_H2B = WS_HHI;
constexpr size_t WS_QKV = A0 + 192 * MiB;
constexpr size_t WS_AO = A0 + 288 * MiB;
constexpr size_t WS_END = A0 + 384 * MiB;
static_assert((size_t)T * H0P * 2 <= 136 * MiB && WS_Y2 + (size_t)CAP * D * 2 <= WS_END && WS_OB + (size_t)T * 512 * 4 <= WS_END && WS_HID + (size_t)CAP * 512 * 2 <= WS_Y2, "act map");

constexpr int RING_BYTES = 131072;
constexpr int MISC_OFF = 163840 - 1024;
constexpr int PTR_OFF = MISC_OFF + 256;
constexpr int LDS_BYTES = 163840;

#define GAS __attribute__((address_space(1)))
#define LAS __attribute__((address_space(3)))
typedef unsigned short bf16;
typedef float f32x4 __attribute__((ext_vector_type(4)));
typedef float f32x2 __attribute__((ext_vector_type(2)));
typedef float f32x16 __attribute__((ext_vector_type(16)));
typedef short bf16x8 __attribute__((ext_vector_type(8)));
typedef short bf16x4 __attribute__((ext_vector_type(4)));
typedef unsigned u32x4 __attribute__((ext_vector_type(4)));
typedef unsigned u32x2 __attribute__((ext_vector_type(2)));
#define LDS_WAIT() asm volatile("s_waitcnt lgkmcnt(0)" ::: "memory")
#define VM_WAIT() asm volatile("s_waitcnt vmcnt(0)" ::: "memory")
#define LDS_BARRIER() do { asm volatile("s_waitcnt lgkmcnt(0)" ::: "memory"); __builtin_amdgcn_s_barrier(); asm volatile("" ::: "memory"); } while (0)
typedef __bf16 bf16x2_t __attribute__((ext_vector_type(2)));
__device__ __forceinline__ unsigned pk2(float lo, float hi) { f32x2 v = {lo, hi}; return __builtin_bit_cast(unsigned, __builtin_convertvector(v, bf16x2_t)); }
__device__ __forceinline__ unsigned f2bf(float f) { return pk2(f, 0.f) & 0xffffu; }
__device__ __forceinline__ float bf2f(unsigned short b) { return __uint_as_float((unsigned)b << 16); }
__device__ __forceinline__ float bflo(unsigned w) { return __uint_as_float(w << 16); }
__device__ __forceinline__ float bfhi(unsigned w) { return __uint_as_float(w & 0xffff0000u); }
__device__ __forceinline__ float wave_sum(float v) {
#pragma unroll
    for (int o = 1; o < 64; o <<= 1) v += __shfl_xor(v, o);
    return v;
}
__device__ __forceinline__ int crow(int r, int hi) { return (r & 3) + 8 * (r >> 2) + 4 * hi; }

#define XB_TMO      128
#define XB_XCNT(j)  (256  + 64 * (j))
#define XB_XSUB(j)  (1280 + 64 * (j))
#define XB_XGEN(j)  (2304 + 64 * (j))
#define XB_TOP      3328
#define XB_TOPGEN   3392
#define XCD_BAR_WORDS 3456
#define XB_SPIN_CAP (1u << 18)
__device__ __forceinline__ unsigned xb_ld(unsigned* p)              { return __hip_atomic_load(p, __ATOMIC_RELAXED, __HIP_MEMORY_SCOPE_AGENT); }
__device__ __forceinline__ unsigned xb_add(unsigned* p, unsigned v) { return __hip_atomic_fetch_add(p, v, __ATOMIC_RELAXED, __HIP_MEMORY_SCOPE_AGENT); }
__device__ __forceinline__ unsigned xb_xcc_id() { return (unsigned)__builtin_amdgcn_s_getreg((3 << 11) | 20) & 0xFu; }
#define XB_SPIN(cond, bar) do { unsigned _sp = 0; while (cond) { __builtin_amdgcn_s_sleep(1); \
    if ((++_sp & 255u) == 0u) { if (xb_ld(&(bar)[XB_TMO])) break; if (_sp > XB_SPIN_CAP) { atomicAdd(&(bar)[XB_TMO], 1u); break; } } } } while (0)
struct XcdBarrier { unsigned* bar; unsigned x; volatile LAS unsigned* st; };
__device__ __forceinline__ XcdBarrier xcd_barrier_post(unsigned* bar, volatile LAS unsigned* st) {
    XcdBarrier b; b.bar = bar; b.x = xb_xcc_id(); b.st = st;
    if (threadIdx.x == 0) (void)xb_add(&bar[XB_XCNT(b.x)], 1u);
    return b;
}
__device__ __forceinline__ void xcd_barrier_complete(unsigned* bar, unsigned x, unsigned& nloc, unsigned& nx) {
    const unsigned G = gridDim.x * gridDim.y * gridDim.z;
    unsigned sum, cnt, mine, sp = 0u;
    for (;;) {
        sum = 0u; cnt = 0u; mine = 0u;
#pragma unroll
        for (unsigned j = 0; j < 16; ++j) { const unsigned c = xb_ld(&bar[XB_XCNT(j)]); sum += c; cnt += (c > 0u) ? 1u : 0u; mine = (j == x) ? c : mine; }
        if (sum == G) break;
        __builtin_amdgcn_s_sleep(1);
        if ((++sp & 255u) == 0u) { if (xb_ld(&bar[XB_TMO])) break; if (sp > XB_SPIN_CAP) { atomicAdd(&bar[XB_TMO], 1u); break; } }
    }
    nloc = mine > 0u ? mine : 1u; nx = cnt > 0u ? cnt : 1u;
}
__device__ __forceinline__ void xcd_barrier(const XcdBarrier& b) {
    asm volatile("s_waitcnt vmcnt(0)" ::: "memory");
    __syncthreads();
    if (threadIdx.x == 0) {
        unsigned* bar = b.bar;
        __builtin_amdgcn_s_waitcnt(0);
        unsigned nloc = b.st[0], nx = b.st[1];
        if (nloc == 0u) { xcd_barrier_complete(bar, b.x, nloc, nx); b.st[0] = nloc; b.st[1] = nx; }
        const unsigned old = xb_add(&bar[XB_XSUB(b.x)], 1u);
        const unsigned gen = old / nloc;
        if (old + 1u == (gen + 1u) * nloc) {
            __builtin_amdgcn_fence(__ATOMIC_RELEASE, "agent");
            asm volatile("s_waitcnt vmcnt(0)" ::: "memory");
            const unsigned og = xb_add(&bar[XB_TOP], 1u);
            const unsigned tg = og / nx;
            if (og + 1u == (tg + 1u) * nx) xb_add(&bar[XB_TOPGEN], 1u);
            else XB_SPIN(xb_ld(&bar[XB_TOPGEN]) == tg, bar);
            __builtin_amdgcn_fence(__ATOMIC_ACQUIRE, "agent");
            xb_add(&bar[XB_XGEN(b.x)], 1u);
            asm volatile("s_waitcnt vmcnt(0)" ::: "memory");
        } else {
            XB_SPIN(xb_ld(&bar[XB_XGEN(b.x)]) == gen, bar);
            __builtin_amdgcn_fence(__ATOMIC_ACQUIRE, "agent");
            asm volatile("s_waitcnt vmcnt(0)" ::: "memory");
        }
    }
    __syncthreads();
}

struct Frame {
    LAS unsigned char* lds;
    int tid, lane, wave, G, bid;
    unsigned char* ws;
    const float* const* in;
};
enum InIdx { I_X = 0, I_LNMG, I_LNMB, I_LNFG, I_LNFB, I_ABWIN, I_LAMRE, I_LAMIM, I_LOGDT, I_BRE, I_BIM, I_CRE, I_CIM, I_S5D, I_GLUW, I_GLUB,
             I_GATEW, I_GATEB, I_NORMG, I_ABWOUT, I_CWIN, I_SINK, I_CWOUT, I_RELB, I_WGRP, I_BGRP, I_WRT, I_BRT, I_W1, I_W3, I_W2, N_IN };

__device__ __forceinline__ const float* inp(LAS unsigned char* lds, int k) {
    const LAS unsigned* p = (const LAS unsigned*)(lds + PTR_OFF) + 2 * k;
    const unsigned lo = __builtin_amdgcn_readfirstlane(p[0]), hi = __builtin_amdgcn_readfirstlane(p[1]);
    return (const float*)(const GAS float*)(((unsigned long long)hi << 32) | (unsigned long long)lo);
}
struct TrItem { const float* W; bf16* WT; int ldw, ldt, rowmode, k0, n0; };
__device__ __forceinline__ void tr_load(const TrItem& q, float (&tv)[32], int lane) {
    const float* wp = q.W + (size_t)(q.k0 + (lane >> 5)) * q.ldw + q.n0 + (lane & 31);
#pragma unroll
    for (int i = 0; i < 32; ++i) tv[i] = wp[(size_t)(2 * i) * q.ldw];
}
__device__ __forceinline__ void tr_store(const TrItem& q, const float (&tv)[32], LAS float* scr, int lane) {
#pragma unroll
    for (int i = 0; i < 32; ++i) scr[(2 * i + (lane >> 5)) * 33 + (lane & 31)] = tv[i];
    LDS_WAIT(); asm volatile("" ::: "memory");
    const int c = lane & 7;
#pragma unroll
    for (int j = 0; j < 4; ++j) { const int n = (lane >> 3) + 8 * j; const LAS float* s = scr + (8 * c) * 33 + n;
        u32x4 o; o.x = pk2(s[0 * 33], s[1 * 33]); o.y = pk2(s[2 * 33], s[3 * 33]); o.z = pk2(s[4 * 33], s[5 * 33]); o.w = pk2(s[6 * 33], s[7 * 33]);
        const int ng = q.n0 + n; const int dr = q.rowmode == 0 ? ng : (8 * (ng >> 2) + (ng & 3) + (q.rowmode == 2 ? 4 : 0));
        *(GAS u32x4*)(q.WT + (size_t)dr * q.ldt + q.k0 + 8 * c) = o; }
    LDS_WAIT(); asm volatile("" ::: "memory");
}
__device__ __forceinline__ void tr_item(const float* W, int ldw, bf16* WT, int ldt, int rowmode, LAS float* scr, int item, int nblk, int lane) {
    TrItem q{W, WT, ldw, ldt, rowmode, 64 * (item / nblk), 32 * (item % nblk)}; float tv[32]; tr_load(q, tv, lane); tr_store(q, tv, scr, lane);
}
__device__ __forceinline__ TrItem moe_item(const float* w1, const float* w3, const float* w2, bf16* W13, bf16* W2T, int it) {
    constexpr int PER_E = 768; const int e = it / PER_E, r = it % PER_E;
    if (r < 256) return TrItem{w1 + (size_t)e * D * DEXP, W13 + (size_t)e * D * D, DEXP, D, 1, 64 * (r / 16), 32 * (r % 16)};
    if (r < 512) return TrItem{w3 + (size_t)e * D * DEXP, W13 + (size_t)e * D * D, DEXP, D, 2, 64 * ((r - 256) / 16), 32 * ((r - 256) % 16)};
    return TrItem{w2 + (size_t)e * DEXP * D, W2T + (size_t)e * D * DEXP, D, DEXP, 0, 64 * ((r - 512) / 32), 32 * ((r - 512) % 32)};
}
__device__ __forceinline__ void moe_convert(const float* w1, const float* w3, const float* w2, bf16* W13, bf16* W2T, LAS float* scr, int it0, int it1, int gw, int NGW, int lane) {
    for (int it = it0 + gw; it < it1; it += 2 * NGW) {
        const int it2 = it + NGW; const bool two = it2 < it1;
        const TrItem qa = moe_item(w1, w3, w2, W13, W2T, it), qb = moe_item(w1, w3, w2, W13, W2T, two ? it2 : it);
        float ta[32], tb[32];
        tr_load(qa, ta, lane); tr_load(qb, tb, lane);
        tr_store(qa, ta, scr, lane); if (two) tr_store(qb, tb, scr, lane);
    }
}
constexpr int MOE_ITEMS = NEXP * 768, IDLE_Q8 = 88, IDLE_Q9 = 56;
__device__ __forceinline__ void idle_convert(int which, unsigned char* ws, LAS unsigned char* lds, float* dout, int ntiles, int bid, int G, int wave, int lane) {
    const int U = ntiles * (D / 256), rem = U % G; if (rem == 0 || bid < rem) return;
    const int n_idle = G - rem, rank = bid - rem;
    int q8 = n_idle * IDLE_Q8; q8 = q8 < MOE_ITEMS ? q8 : MOE_ITEMS; int q9 = n_idle * IDLE_Q9; q9 = (q8 + q9) < MOE_ITEMS ? q9 : (MOE_ITEMS - q8);
    const int per = which == 0 ? IDLE_Q8 : IDLE_Q9, base = which == 0 ? 0 : q8, lim = which == 0 ? q8 : q8 + q9;
    int lo = base + rank * per, hi = lo + per; hi = hi < lim ? hi : lim;
    moe_convert(inp(lds, I_W1) + (size_t)NEXP * D * DEXP, inp(lds, I_W3) + (size_t)NEXP * D * DEXP, inp(lds, I_W2) + (size_t)NEXP * DEXP * D,
                (bf16*)dout, (bf16*)dout + (size_t)NEXP * D * D, (LAS float*)(lds + wave * 16384), lo, hi, wave, NWAVES, lane);
}
__device__ __forceinline__ int idle_done(int ntiles, int G) {
    const int U = ntiles * (D / 256), rem = U % G; if (rem == 0) return 0;
    const int n_idle = G - rem; int q = n_idle * (IDLE_Q8 + IDLE_Q9); return q < MOE_ITEMS ? q : MOE_ITEMS;
}
__device__ __forceinline__ int t5_bucket(int rel) {
    const int nb = 16, max_exact = 8; int ret = rel > 0 ? nb : 0; const int n = rel < 0 ? -rel : rel;
    const float lg = logf((float)(n < 1 ? 1 : n) / 8.0f) / 2.7725887f * 8.0f;
    int large = max_exact + (int)lg; large = large < nb - 1 ? large : nb - 1;
    return ret + (n < max_exact ? n : large);
}
__device__ __forceinline__ void p0_prologue(unsigned char* ws, LAS unsigned char* lds, int bid, int G, int tid, int wave, int lane) {
    LAS float* scr = (LAS float*)(lds + wave * 16384);
    const int gw = bid * NWAVES + wave, NGW = G * NWAVES;
    constexpr int I0 = 16 * 64, I1 = 16, I2 = 8 * 16, I3 = 16 * 32, I4 = 16 * 48, I5 = 16 * 32, NIT = I0 + I1 + I2 + I3 + I4 + I5;
    for (int it = gw; it < NIT; it += NGW) {
        int r = it;
        if (r < I0) { tr_item(inp(lds, I_ABWIN), AB_IN, (bf16*)(ws + WS_WIN), D, 0, scr, r, 64, lane); continue; } r -= I0;
        if (r < I1) { tr_item(inp(lds, I_ABWIN) + 2048, AB_IN, (bf16*)(ws + WS_WLR), D, 0, scr, r, 1, lane); continue; } r -= I1;
        if (r < I2) { tr_item(inp(lds, I_GLUW), 512, (bf16*)(ws + WS_WGLU), 512, 0, scr, r, 16, lane); continue; } r -= I2;
        if (r < I3) { tr_item(inp(lds, I_ABWOUT), D, (bf16*)(ws + WS_WOUT), D, 0, scr, r, 32, lane); continue; } r -= I3;
        if (r < I4) { tr_item(inp(lds, I_CWIN), CN, (bf16*)(ws + WS_CIN), D, 0, scr, r, 48, lane); continue; } r -= I4;
        tr_item(inp(lds, I_CWOUT), D, (bf16*)(ws + WS_COUT), D, 0, scr, r, 32, lane);
    }
    moe_convert(inp(lds, I_W1), inp(lds, I_W3), inp(lds, I_W2), (bf16*)(ws + WS_W13), (bf16*)(ws + WS_W2), scr, 0, MOE_ITEMS, gw, NGW, lane);
    { const float* x = inp(lds, I_X); bf16* xb = (bf16*)(ws + WS_X64);
      for (int m = gw; m < T; m += 2 * NGW) { const int m2 = m + NGW;
          const GAS f32x4* xr = (const GAS f32x4*)(x + (size_t)m * D) + lane; GAS u32x2* o = (GAS u32x2*)(xb + (size_t)m * D) + lane;
          const GAS f32x4* xr2 = (const GAS f32x4*)(x + (size_t)m2 * D) + lane; GAS u32x2* o2 = (GAS u32x2*)(xb + (size_t)m2 * D) + lane;
          f32x4 v[4], v2[4];
#pragma unroll
          for (int j = 0; j < 4; ++j) { v[j] = xr[64 * j]; if (m2 < T) v2[j] = xr2[64 * j]; }
#pragma unroll
          for (int j = 0; j < 4; ++j) { u32x2 w; w.x = pk2(v[j].x, v[j].y); w.y = pk2(v[j].z, v[j].w); o[64 * j] = w;
              if (m2 < T) { u32x2 w2; w2.x = pk2(v2[j].x, v2[j].y); w2.y = pk2(v2[j].z, v2[j].w); o2[64 * j] = w2; } } } }
    const int gt = bid * NTHR + tid, NGT = G * NTHR;
    { const float* lamre = inp(lds, I_LAMRE); const float* lamim = inp(lds, I_LAMIM); const float* logdt = inp(lds, I_LOGDT); const float* bre = inp(lds, I_BRE); const float* bim = inp(lds, I_BIM);
    for (int i = tid * G + bid; i < 2 * 32 * 64; i += NTHR * G) {
        const int p = i & 63, g = (i >> 6) & 31, dir = i >> 11;
        const double lr = fmin((double)lamre[i], -1e-4), li = (double)lamim[i], dt = exp((double)logdt[dir * 32 + g]);
        const double mag = exp(lr * dt), ar = mag * cos(li * dt), ai = mag * sin(li * dt), den = lr * lr + li * li, nr = ar - 1.0;
        const double cr = (nr * lr + ai * li) / den, ci = (ai * lr - nr * li) / den;
        double qr = ar, qi = ai;
#pragma unroll 1
        for (int s = 1; s < S5CH; s <<= 1) { const double t = qr * qr - qi * qi; qi = 2.0 * qr * qi; qr = t; }
        float* L4 = (float*)(ws + WS_S5L) + (size_t)i * 4; L4[0] = (float)ar; L4[1] = (float)ai; L4[2] = (float)qr; L4[3] = (float)qi;
        bf16* Bb = (bf16*)(ws + WS_S5B) + (size_t)(dir * 32 + g) * 2048;
#pragma unroll 4
        for (int c = 0; c < 16; ++c) { const double br = bre[(size_t)i * 16 + c], bi = bim[(size_t)i * 16 + c];
            Bb[p * 16 + c] = (bf16)f2bf((float)(cr * br - ci * bi)); Bb[1024 + p * 16 + c] = (bf16)f2bf((float)(cr * bi + ci * br)); }
    } }
    { const float* cre = inp(lds, I_CRE); const float* cim = inp(lds, I_CIM);
    for (int i = gt; i < 2 * 32 * 16 * 64; i += NGT) {
        const int p = i & 63, c = (i >> 6) & 15, dg = i >> 10;
        bf16* Cm = (bf16*)(ws + WS_S5C) + (size_t)dg * 2048 + c * 128 + 2 * p;
        Cm[0] = (bf16)f2bf(cre[i]); Cm[1] = (bf16)f2bf(-cim[i]);
    } }
    { const float* relb = inp(lds, I_RELB);
    for (int i = gt; i < 16 * 257; i += NGT) { const int h = i / 257, r = i % 257; ((float*)(ws + WS_BTAB))[h * 260 + r] = relb[t5_bucket(r - 128) * 16 + h] * LOG2E; } }
    { const float* wgrp = inp(lds, I_WGRP); const float* wrt = inp(lds, I_WRT);
    for (int i = gt; i < 2 * 48 * 1024; i += NGT) {
        const int k = i & 1023, n = (i >> 10) % 48, l = i / (48 * 1024);
        const float w = n < 4 ? wgrp[(size_t)l * D * 4 + k * 4 + n] : (n < 36 ? wrt[(size_t)l * D * 32 + k * 32 + (n - 4)] : 0.f);
        const unsigned hi = f2bf(w); const float lo = w - __uint_as_float(hi << 16);
        bf16* Wr = (bf16*)(ws + WS_WR) + (size_t)l * 2 * 48 * 1024; Wr[n * 1024 + k] = (bf16)hi; Wr[48 * 1024 + n * 1024 + k] = (bf16)f2bf(lo);
    } }
}

__device__ __forceinline__ void gate_tail(float* bcg, const float* gate_w, const float* gate_b, const LAS float* lrs, size_t row0, int tid);
__device__ __forceinline__ void lr_tail(unsigned char* ws, float* bcg, const float* gate_w, const float* gate_b, LAS unsigned char* lds, int bid, int G, int tid, int wave, int lane) {
    const bf16* xb = (const bf16*)(ws + WS_X64); const bf16* wl = (const bf16*)(ws + WS_WLR); LAS float* lrs = (LAS float*)lds;
    for (int rt = bid; rt < T / 128; rt += G) {
        const int r0 = rt * 128 + wave * 16;
        f32x4 acc0 = {0.f, 0.f, 0.f, 0.f}, acc1 = {0.f, 0.f, 0.f, 0.f};
        const bf16* ap = xb + (size_t)(r0 + (lane & 15)) * D + 8 * (lane >> 4);
        const bf16* bp = wl + (size_t)(lane & 15) * D + 8 * (lane >> 4);
#pragma unroll 8
        for (int ks = 0; ks < 32; ++ks) {
            const bf16x8 a = *(const bf16x8*)(ap + ks * 32), b0 = *(const bf16x8*)(bp + ks * 32), b1 = *(const bf16x8*)(bp + 16 * D + ks * 32);
            acc0 = __builtin_amdgcn_mfma_f32_16x16x32_bf16(a, b0, acc0, 0, 0, 0); acc1 = __builtin_amdgcn_mfma_f32_16x16x32_bf16(a, b1, acc1, 0, 0, 0);
        }
        __syncthreads();
#pragma unroll
        for (int r = 0; r < 4; ++r) { LAS float* o = lrs + (wave * 16 + 4 * (lane >> 4) + r) * 32 + (lane & 15); o[0] = acc0[r]; o[16] = acc1[r]; }
        __syncthreads();
        gate_tail(bcg, gate_w, gate_b, lrs, (size_t)rt * 128, tid);
    }
    __syncthreads();
}

__device__ __forceinline__ void gla_finalize(unsigned char* ws, const float* norm_g, int gw, int NGW, int lane) {
    const bf16* of = (const bf16*)(ws + WS_OF); const bf16* ob = (const bf16*)(ws + WS_OB); const bf16* h0 = (const bf16*)(ws + WS_H0); bf16* cc = (bf16*)(ws + WS_X64);
    const f32x4 g0 = *(const f32x4*)(norm_g + 8 * lane), g1 = *(const f32x4*)(norm_g + 8 * lane + 4);
    for (int m0 = gw; m0 < T; m0 += 4 * NGW) {
        u32x4 a[4], b[4], gq[4];
#pragma unroll
        for (int q = 0; q < 4; ++q) { const size_t m = (size_t)m0 + (size_t)q * NGW;
            a[q] = *(const u32x4*)(of + m * 512 + 8 * lane); b[q] = *(const u32x4*)(ob + m * 512 + 8 * lane); gq[q] = *(const u32x4*)(h0 + m * H0P + OFF_GO + 8 * lane); }
#pragma unroll
        for (int q = 0; q < 4; ++q) { const size_t m = (size_t)m0 + (size_t)q * NGW;
            f32x4 v0, v1;
            v0.x = bflo(a[q].x) + bflo(b[q].x); v0.y = bfhi(a[q].x) + bfhi(b[q].x); v0.z = bflo(a[q].y) + bflo(b[q].y); v0.w = bfhi(a[q].y) + bfhi(b[q].y);
            v1.x = bflo(a[q].z) + bflo(b[q].z); v1.y = bfhi(a[q].z) + bfhi(b[q].z); v1.z = bflo(a[q].w) + bflo(b[q].w); v1.w = bfhi(a[q].w) + bfhi(b[q].w);
            float ss = (v0.x * v0.x + v0.y * v0.y) + (v0.z * v0.z + v0.w * v0.w) + (v1.x * v1.x + v1.y * v1.y) + (v1.z * v1.z + v1.w * v1.w);
            ss += __shfl_xor(ss, 1); ss += __shfl_xor(ss, 2); ss += __shfl_xor(ss, 4); ss += __shfl_xor(ss, 8);
            const float rs = __builtin_amdgcn_rsqf(ss * (1.0f / 128.0f) + RMS_EPS);
            const float gv[8] = {bflo(gq[q].x), bfhi(gq[q].x), bflo(gq[q].y), bfhi(gq[q].y), bflo(gq[q].z), bfhi(gq[q].z), bflo(gq[q].w), bfhi(gq[q].w)};
            const float ov[8] = {v0.x * g0.x, v0.y * g0.y, v0.z * g0.z, v0.w * g0.w, v1.x * g1.x, v1.y * g1.y, v1.z * g1.z, v1.w * g1.w};
            float r[8];
#pragma unroll
            for (int i = 0; i < 8; ++i) r[i] = ov[i] * rs * (gv[i] * __builtin_amdgcn_rcpf(1.f + __expf(-gv[i])));
            u32x4 w; w.x = pk2(r[0], r[1]); w.y = pk2(r[2], r[3]); w.z = pk2(r[4], r[5]); w.w = pk2(r[6], r[7]);
            *(u32x4*)(cc + m * D + 512 + 8 * lane) = w; }
    }
}

constexpr int RT_AST = 2064;
template <bool RESID_F32, bool RD_LO, bool WR_LO>
__device__ __forceinline__ void ln_router(unsigned char* ws, const float* resid, const float* lng, const float* lnb, const float* bgrp, const float* brt, int layer, LAS unsigned char* lds, int bid, int G, int tid, int wave, int lane) {
    const bf16* yb = (const bf16*)(ws + WS_Z); bf16* hlo = (bf16*)(ws + WS_HLO); bf16* hb = (bf16*)(ws + WS_HHI);
    int* tok_e = (int*)(ws + WS_TOKE); float* tok_w = (float*)(ws + WS_TOKW);
    LAS unsigned char* Ahi = lds; LAS unsigned char* Alo = lds + 16 * RT_AST; LAS float* part = (LAS float*)(lds + 32 * RT_AST);
    LAS int* hist = (LAS int*)(lds + 32 * RT_AST + 8 * 16 * 48 * 4); LAS float* lgt = (LAS float*)(lds + 32 * RT_AST + 8 * 16 * 48 * 4 + 256);
    if (tid < 32) hist[tid] = 0;
    const bf16* Wr = (const bf16*)(ws + WS_WR) + (size_t)layer * 2 * 48 * 1024;
    bf16x8 Bh[3][4], Bl[3][4];
#pragma unroll
    for (int nt = 0; nt < 3; ++nt)
#pragma unroll
        for (int ks = 0; ks < 4; ++ks) { const size_t o = (size_t)(nt * 16 + (lane & 15)) * 1024 + wave * 128 + ks * 32 + 8 * (lane >> 4);
            Bh[nt][ks] = *(const bf16x8*)(Wr + o); Bl[nt][ks] = *(const bf16x8*)(Wr + 48 * 1024 + o); }
    f32x4 gv[4], bv[4];
#pragma unroll
    for (int j = 0; j < 4; ++j) { gv[j] = *(const f32x4*)(lng + 4 * lane + 256 * j); bv[j] = *(const f32x4*)(lnb + 4 * lane + 256 * j); }
    __syncthreads();
    for (int grp = bid; grp < T / 16; grp += G) {
#pragma unroll
        for (int rr = 0; rr < 2; ++rr) {
            const int row = 2 * wave + rr; const size_t m = (size_t)grp * 16 + row;
            const GAS f32x4* xr = (const GAS f32x4*)(resid + m * D) + lane; const GAS u32x2* yr = (const GAS u32x2*)(yb + m * D) + lane;
            const GAS u32x2* hr_ = (const GAS u32x2*)(hb + m * D) + lane; const GAS u32x2* lr_ = (const GAS u32x2*)(hlo + m * D) + lane;
            f32x4 v[4]; float s = 0.f;
#pragma unroll
            for (int j = 0; j < 4; ++j) { f32x4 x4; const u32x2 y2 = yr[64 * j];
                if (RESID_F32) x4 = xr[64 * j]; else if (RD_LO) { const u32x2 a = hr_[64 * j], b = lr_[64 * j]; x4.x = bflo(a.x) + bflo(b.x); x4.y = bfhi(a.x) + bfhi(b.x); x4.z = bflo(a.y) + bflo(b.y); x4.w = bfhi(a.y) + bfhi(b.y); }
                else { const u32x2 a = hr_[64 * j]; x4.x = bflo(a.x); x4.y = bfhi(a.x); x4.z = bflo(a.y); x4.w = bfhi(a.y); }
                v[j].x = x4.x * ALPHA + bflo(y2.x); v[j].y = x4.y * ALPHA + bfhi(y2.x); v[j].z = x4.z * ALPHA + bflo(y2.y); v[j].w = x4.w * ALPHA + bfhi(y2.y);
                s += (v[j].x + v[j].y) + (v[j].z + v[j].w); }
            const float mean = wave_sum(s) * (1.f / D); float s2 = 0.f;
#pragma unroll
            for (int j = 0; j < 4; ++j) { v[j] = v[j] - mean; s2 += (v[j].x * v[j].x + v[j].y * v[j].y) + (v[j].z * v[j].z + v[j].w * v[j].w); }
            const float rstd = 1.f / sqrtf(wave_sum(s2) * (1.f / D) + LN_EPS);
#pragma unroll
            for (int j = 0; j < 4; ++j) {
                const f32x4 h = v[j] * rstd * gv[j] + bv[j];
                const unsigned h0 = pk2(h.x, h.y), h1w = pk2(h.z, h.w);
                u32x2 w; w.x = h0; w.y = h1w; ((GAS u32x2*)(hb + m * D) + lane)[64 * j] = w;
                u32x2 lo; lo.x = pk2(h.x - bflo(h0), h.y - bfhi(h0)); lo.y = pk2(h.z - bflo(h1w), h.w - bfhi(h1w));
                if (WR_LO) ((GAS u32x2*)(hlo + m * D) + lane)[64 * j] = lo;
                *(LAS u32x2*)(Ahi + row * RT_AST + (4 * lane + 256 * j) * 2) = w; *(LAS u32x2*)(Alo + row * RT_AST + (4 * lane + 256 * j) * 2) = lo;
            }
        }
        LDS_BARRIER();
        f32x4 acc[3] = {{0.f, 0.f, 0.f, 0.f}, {0.f, 0.f, 0.f, 0.f}, {0.f, 0.f, 0.f, 0.f}};
#pragma unroll
        for (int ks = 0; ks < 4; ++ks) {
            const int bo = (lane & 15) * RT_AST + (wave * 128 + ks * 32 + 8 * (lane >> 4)) * 2;
            const bf16x8 ah = *(const LAS bf16x8*)(Ahi + bo), al = *(const LAS bf16x8*)(Alo + bo);
#pragma unroll
            for (int nt = 0; nt < 3; ++nt) {
                acc[nt] = __builtin_amdgcn_mfma_f32_16x16x32_bf16(ah, Bh[nt][ks], acc[nt], 0, 0, 0);
                acc[nt] = __builtin_amdgcn_mfma_f32_16x16x32_bf16(ah, Bl[nt][ks], acc[nt], 0, 0, 0);
                acc[nt] = __builtin_amdgcn_mfma_f32_16x16x32_bf16(al, Bh[nt][ks], acc[nt], 0, 0, 0);
            }
        }
#pragma unroll
        for (int nt = 0; nt < 3; ++nt)
#pragma unroll
            for (int r = 0; r < 4; ++r) part[(wave * 16 + 4 * (lane >> 4) + r) * 48 + nt * 16 + (lane & 15)] = acc[nt][r];
        LDS_BARRIER();
        { const int itn = (grp - bid) / G;
          for (int idx = tid; idx < 16 * 36; idx += NTHR) { const int tk = idx / 36, n = idx % 36; float s = 0.f;
#pragma unroll
            for (int w = 0; w < 8; ++w) s += part[(w * 16 + tk) * 48 + n];
            lgt[(itn * 16 + tk) * 36 + n] = s + (n < 4 ? bgrp[n] : brt[n - 4]); } }
    }
    LDS_BARRIER();
    for (int tk = tid; tk < 16 * ((T / 16 - bid + G - 1) / G); tk += NTHR) {
        const size_t m = ((size_t)bid + (size_t)(tk >> 4) * G) * 16 + (tk & 15);
        const LAS float* lg = lgt + tk * 36;
        int gi = 0; float gm = lg[0];
#pragma unroll
        for (int n = 1; n < 4; ++n) if (lg[n] > gm) { gm = lg[n]; gi = n; }
        float gs = 0.f;
#pragma unroll
        for (int n = 0; n < 4; ++n) gs += __expf(lg[n] - gm);
        const float pg = 1.f / gs;
        float el[8];
#pragma unroll
        for (int i = 0; i < 8; ++i) el[i] = lg[4 + gi * 8 + i];
        int i1 = 0; float m1 = el[0];
#pragma unroll
        for (int i = 1; i < 8; ++i) if (el[i] > m1) { m1 = el[i]; i1 = i; }
        int i2 = -1; float m2 = -3.0e38f;
#pragma unroll
        for (int i = 0; i < 8; ++i) if (i != i1 && el[i] > m2) { m2 = el[i]; i2 = i; }
        const float e2 = __expf(m2 - m1), inv = 1.f / (1.f + e2);
        const int ea = gi * 8 + i1, eb = gi * 8 + i2;
        tok_e[m * 2] = ea; tok_e[m * 2 + 1] = eb; tok_w[m * 2] = pg * inv; tok_w[m * 2 + 1] = pg * e2 * inv;
        atomicAdd((int*)&hist[ea], 1); atomicAdd((int*)&hist[eb], 1);
    }
    LDS_BARRIER();
    if (tid < 32) ((int*)(ws + WS_BLKC))[bid * 32 + tid] = hist[tid];
}

__device__ __forceinline__ void moe_sort(unsigned char* ws, LAS unsigned char* lds, int bid, int G, int tid) {
    const int* blkc = (const int*)(ws + WS_BLKC); const int* tok_e = (const int*)(ws + WS_TOKE); const float* tok_w = (const float*)(ws + WS_TOKW);
    int* tok_s = (int*)(ws + WS_TOKS); int* slot_t = (int*)(ws + WS_SLOTT); float* slot_w = (float*)(ws + WS_SLOTW); int* tile = (int*)(ws + WS_TILE);
    LAS int* ptot = (LAS int*)lds; LAS int* pbase = ptot + 512; LAS int* tot = pbase + 512; LAS int* base = tot + 32; LAS int* pstart = base + 32; LAS int* lcur = pstart + 33;
    { const int e = tid & 31, part = tid >> 5; int st = 0, sb = 0;
      for (int b = part; b < G; b += 16) { const int c = blkc[b * 32 + e]; st += c; sb += (b < bid) ? c : 0; }
      ptot[part * 32 + e] = st; pbase[part * 32 + e] = sb; }
    __syncthreads();
    if (tid < 32) { int st = 0, sb = 0;
#pragma unroll
        for (int p = 0; p < 16; ++p) { st += ptot[p * 32 + tid]; sb += pbase[p * 32 + tid]; }
        tot[tid] = st; base[tid] = sb; lcur[tid] = 0; }
    __syncthreads();
    if (tid == 0) { int acc = 0; for (int e = 0; e < 32; ++e) { pstart[e] = acc; acc += (tot[e] + 255) & ~255; } pstart[32] = acc; }
    __syncthreads();
    if (bid == 0) {
        const int nt = pstart[32] >> 8;
        if (tid == 0) tile[511] = nt;
        for (int t = tid; t < nt; t += NTHR) { int e = 0; for (int q = 1; q < 32; ++q) if ((t << 8) >= pstart[q]) e = q; tile[t] = e; }
    }
    for (int e = bid; e < 32; e += G)
        for (int s = pstart[e] + tot[e] + tid; s < pstart[e + 1]; s += NTHR) { slot_t[s] = 0; slot_w[s] = 0.f; }
    for (int grp = bid; grp < T / 16; grp += G) {
        if (tid < 32) { const size_t a = (size_t)grp * 32 + tid; const int e = tok_e[a]; const int rank = atomicAdd((int*)&lcur[e], 1);
            const int s = pstart[e] + base[e] + rank; slot_t[s] = (int)(a >> 1); slot_w[s] = tok_w[a]; tok_s[a] = s; }
    }
}

template <bool FINAL, bool RD_LO, bool WR_LO>
__device__ __forceinline__ void combine_ln(unsigned char* ws, const float* lng, const float* lnb, float* dout, int gw, int NGW, int lane) {
    bf16* hlo = (bf16*)(ws + WS_HLO); bf16* hhi = (bf16*)(ws + WS_HHI); const bf16* y2 = (const bf16*)(ws + WS_Y2); const int* tok_s = (const int*)(ws + WS_TOKS); const float* tok_w = (const float*)(ws + WS_TOKW);
    f32x4 gv[4], bv[4];
#pragma unroll
    for (int j = 0; j < 4; ++j) { gv[j] = *(const f32x4*)(lng + 4 * lane + 256 * j); bv[j] = *(const f32x4*)(lnb + 4 * lane + 256 * j); }
    for (int m = gw; m < T; m += NGW) {
        const int s0 = tok_s[(size_t)m * 2], s1 = tok_s[(size_t)m * 2 + 1]; const float w0 = tok_w[(size_t)m * 2], w1 = tok_w[(size_t)m * 2 + 1];
        GAS u32x2* hr = (GAS u32x2*)(hhi + (size_t)m * D) + lane; GAS u32x2* lr = (GAS u32x2*)(hlo + (size_t)m * D) + lane;
        const GAS u32x2* ya = (const GAS u32x2*)(y2 + (size_t)s0 * D) + lane; const GAS u32x2* yb = (const GAS u32x2*)(y2 + (size_t)s1 * D) + lane;
        f32x4 v[4]; float s = 0.f;
#pragma unroll
        for (int j = 0; j < 4; ++j) { const u32x2 hh_ = hr[64 * j]; f32x4 h; h.x = bflo(hh_.x); h.y = bfhi(hh_.x); h.z = bflo(hh_.y); h.w = bfhi(hh_.y);
            if (RD_LO) { const u32x2 hl_ = lr[64 * j]; h.x += bflo(hl_.x); h.y += bfhi(hl_.x); h.z += bflo(hl_.y); h.w += bfhi(hl_.y); }
            const u32x2 a = ya[64 * j], b = yb[64 * j];
            v[j].x = h.x * ALPHA + (w0 * bflo(a.x) + w1 * bflo(b.x)); v[j].y = h.y * ALPHA + (w0 * bfhi(a.x) + w1 * bfhi(b.x)); v[j].z = h.z * ALPHA + (w0 * bflo(a.y) + w1 * bflo(b.y)); v[j].w = h.w * ALPHA + (w0 * bfhi(a.y) + w1 * bfhi(b.y));
            s += (v[j].x + v[j].y) + (v[j].z + v[j].w); }
        const float mean = wave_sum(s) * (1.f / D); float s2 = 0.f;
#pragma unroll
        for (int j = 0; j < 4; ++j) { v[j] = v[j] - mean; s2 += (v[j].x * v[j].x + v[j].y * v[j].y) + (v[j].z * v[j].z + v[j].w * v[j].w); }
        const float rstd = 1.f / sqrtf(wave_sum(s2) * (1.f / D) + LN_EPS);
#pragma unroll
        for (int j = 0; j < 4; ++j) { const f32x4 h = v[j] * rstd * gv[j] + bv[j];
            if (FINAL) ((GAS f32x4*)(dout + (size_t)m * D) + lane)[64 * j] = h;
            else { u32x2 w; w.x = pk2(h.x, h.y); w.y = pk2(h.z, h.w); hr[64 * j] = w;
                   if (WR_LO) { u32x2 lo; lo.x = pk2(h.x - bflo(w.x), h.y - bfhi(w.x)); lo.y = pk2(h.z - bflo(w.y), h.w - bfhi(w.y)); lr[64 * j] = lo; } } }
    }
}
constexpr int S5_HST = 272, S5_UST = 272, S5_UOFF = 8 * 32 * S5_HST;
#define MFMA32(a, b, c) __builtin_amdgcn_mfma_f32_32x32x16_bf16((a), (b), (c), 0, 0, 0)
#define MFMA16(a, b, c) __builtin_amdgcn_mfma_f32_16x16x32_bf16((a), (b), (c), 0, 0, 0)
__device__ __forceinline__ float gelu_tanh(float x) {
    const float u = 0.7978845608028654f * (x + 0.044715f * x * x * x);
    const float e = __expf(2.f * u); const float th = 1.f - 2.f * __builtin_amdgcn_rcpf(e + 1.f);
    return 0.5f * x * (1.f + th);
}
__device__ __forceinline__ f32x4 ld_ys(const float* p) {
    f32x4 v;
    v.x = __hip_atomic_load(p, __ATOMIC_RELAXED, __HIP_MEMORY_SCOPE_AGENT); v.y = __hip_atomic_load(p + 1, __ATOMIC_RELAXED, __HIP_MEMORY_SCOPE_AGENT);
    v.z = __hip_atomic_load(p + 2, __ATOMIC_RELAXED, __HIP_MEMORY_SCOPE_AGENT); v.w = __hip_atomic_load(p + 3, __ATOMIC_RELAXED, __HIP_MEMORY_SCOPE_AGENT);
    return v;
}
template <int PASS, int DIR>
__device__ __forceinline__ void s5_dir(unsigned char* ws, const float* s5d, int b, int g, int c, LAS unsigned char* hl, const LAS unsigned char* ul, float* yscr, int lane) {
    const bf16* h0 = (const bf16*)(ws + WS_H0);
    const int dg = DIR * 32 + g;
    const f32x4 L4 = *(const f32x4*)((const float*)(ws + WS_S5L) + (size_t)(dg * 64 + lane) * 4);
    const float ar = L4.x, ai = L4.y, qr = L4.z, qi = L4.w;
    const float l2r = ar * ar - ai * ai, l2i = 2.f * ar * ai, l4r = l2r * l2r - l2i * l2i, l4i = 2.f * l2r * l2i, l8r = l4r * l4r - l4i * l4i, l8i = 2.f * l4r * l4i;
    const float l16r = l8r * l8r - l8i * l8i, l16i = 2.f * l8r * l8i, l32r = l16r * l16r - l16i * l16i, l32i = 2.f * l16r * l16i;
    const bf16* Bb = (const bf16*)(ws + WS_S5B) + (size_t)dg * 2048 + (lane & 31) * 16 + 8 * (lane >> 5);
    const bf16x8 bre0 = *(const bf16x8*)Bb, bre1 = *(const bf16x8*)(Bb + 512), bim0 = *(const bf16x8*)(Bb + 1024), bim1 = *(const bf16x8*)(Bb + 1536);
    bf16x8 cf[4]; bf16x8 dfrag;
    if (PASS == 2) {
        const bf16* Cm = (const bf16*)(ws + WS_S5C) + (size_t)dg * 2048 + (lane & 15) * 128 + 8 * (lane >> 4);
#pragma unroll
        for (int ks = 0; ks < 4; ++ks) cf[ks] = *(const bf16x8*)(Cm + 32 * ks);
        if (DIR == 1) {
            const int cc = lane & 15, kq = lane >> 4; const float d = s5d[g * 16 + cc]; const unsigned dh = f2bf(d); const unsigned dl = f2bf(d - __uint_as_float(dh << 16));
#pragma unroll
            for (int j = 0; j < 8; ++j) { const int k = 8 * (kq & 1) + j; dfrag[j] = (short)((k == cc) ? (kq < 2 ? dh : dl) : 0u); }
        }
    }
    float hr = 0.f, hi = 0.f;
    float* Ec = (float*)(ws + WS_S5E) + ((size_t)((DIR * NB + b) * 32 + g) * S5NCH) * 128 + 2 * lane;
    if (PASS == 2) {
        const int nj = DIR == 0 ? c : (S5NCH - 1 - c);
        for (int j0 = 0; j0 < nj; j0 += 32) {
            f32x2 e[32];
#pragma unroll
            for (int q = 0; q < 32; ++q) { const int j = (j0 + q) < nj ? (j0 + q) : (nj - 1); const int jj = DIR == 0 ? j : (S5NCH - 1 - j); e[q] = *(const f32x2*)(Ec + (size_t)jj * 128); }
#pragma unroll
            for (int q = 0; q < 32; ++q) if (j0 + q < nj) { const float nr = qr * hr - qi * hi + e[q].x; hi = qr * hi + qi * hr + e[q].y; hr = nr; }
        }
    }
    const size_t rowbase = (size_t)b * SEQ + (size_t)c * S5CH;
    const LAS unsigned char* up = ul + (lane & 31) * S5_UST + (g & 7) * 32 + 16 * (lane >> 5);
    const f32x16 zero16 = {0.f, 0.f, 0.f, 0.f, 0.f, 0.f, 0.f, 0.f, 0.f, 0.f, 0.f, 0.f, 0.f, 0.f, 0.f, 0.f};
#pragma unroll 1
    for (int ti = 0; ti < S5CH / 32; ++ti) {
        const int tile = DIR == 0 ? ti : (S5CH / 32 - 1 - ti);
        const bf16x8 a = *(const LAS bf16x8*)(up + tile * 32 * S5_UST);
        f32x4 ysv[2] = {{0.f, 0.f, 0.f, 0.f}, {0.f, 0.f, 0.f, 0.f}};
        if (PASS == 2 && DIR == 1) { ysv[0] = ld_ys(yscr + (size_t)(tile * 2) * 256 + 4 * lane); ysv[1] = ld_ys(yscr + (size_t)(tile * 2 + 1) * 256 + 4 * lane); }
        f32x16 xr0 = MFMA32(a, bre0, zero16), xr1 = MFMA32(a, bre1, zero16), xi0 = MFMA32(a, bim0, zero16), xi1 = MFMA32(a, bim1, zero16);
        __builtin_amdgcn_sched_barrier(0);
        asm volatile("s_nop 15\n\ts_nop 15\n\ts_nop 15\n\ts_nop 15\n\ts_nop 15\n\ts_nop 15" ::: "memory");
        __builtin_amdgcn_sched_barrier(0);
        float xr[32], xi[32];
#pragma unroll
        for (int r = 0; r < 16; ++r) {
            auto s = __builtin_amdgcn_permlane32_swap(__float_as_uint(xr0[r]), __float_as_uint(xr1[r]), false, false);
            xr[crow(r, 0)] = __uint_as_float(s[0]); xr[crow(r, 1)] = __uint_as_float(s[1]);
            auto q = __builtin_amdgcn_permlane32_swap(__float_as_uint(xi0[r]), __float_as_uint(xi1[r]), false, false);
            xi[crow(r, 0)] = __uint_as_float(q[0]); xi[crow(r, 1)] = __uint_as_float(q[1]);
        }
        if (PASS == 1) {
#pragma unroll
            for (int lv = 0; lv < 5; ++lv) {
                const float pr = lv == 0 ? ar : lv == 1 ? l2r : lv == 2 ? l4r : lv == 3 ? l8r : l16r, pi = lv == 0 ? ai : lv == 1 ? l2i : lv == 2 ? l4i : lv == 3 ? l8i : l16i;
#pragma unroll
                for (int i = 0; i < (16 >> lv); ++i) {
                    const int e = DIR == 0 ? 2 * i : 2 * i + 1, l = DIR == 0 ? 2 * i + 1 : 2 * i;
                    const float er = xr[e << lv], ei = xi[e << lv], lr_ = xr[l << lv], li_ = xi[l << lv];
                    const float wr = fmaf(pr, er, fmaf(-pi, ei, lr_)), wi = fmaf(pr, ei, fmaf(pi, er, li_));
                    xr[(2 * i) << lv] = wr; xi[(2 * i) << lv] = wi;
                }
            }
            { const float nr = fmaf(l32r, hr, fmaf(-l32i, hi, xr[0])), ni = fmaf(l32r, hi, fmaf(l32i, hr, xi[0])); hr = nr; hi = ni; }
        } else {
#pragma unroll
        for (int tt = 0; tt < 32; ++tt) {
            const int t = DIR == 0 ? tt : 31 - tt;
            const float tr_ = fmaf(-ai, hi, xr[t]), ti_ = fmaf(ai, hr, xi[t]);
            hr = fmaf(ar, hr, tr_); hi = fmaf(ar, hi, ti_);
            *(LAS unsigned*)(hl + t * S5_HST + 4 * lane) = pk2(hr, hi);
        }
        }
        if (PASS == 2) {
#pragma unroll
            for (int sub = 0; sub < 2; ++sub) {
                float* ys = yscr + (size_t)(tile * 2 + sub) * 256 + 4 * lane;
                f32x4 y = {0.f, 0.f, 0.f, 0.f};
                if (DIR == 1) y = ysv[sub];
#pragma unroll
                for (int ks = 0; ks < 4; ++ks) { const bf16x8 hf = *(const LAS bf16x8*)(hl + (sub * 16 + (lane & 15)) * S5_HST + 64 * ks + 16 * (lane >> 4)); y = MFMA16(hf, cf[ks], y); }
                if (DIR == 0) *(f32x4*)ys = y;
                else {
                    const bf16x8 uf = *(const LAS bf16x8*)(ul + (tile * 32 + sub * 16 + (lane & 15)) * S5_UST + (g & 7) * 32 + 16 * ((lane >> 4) & 1));
                    y = MFMA16(uf, dfrag, y);
                    bf16* yo = (bf16*)(ws + WS_YG) + (rowbase + tile * 32 + sub * 16 + 4 * (lane >> 4)) * 512 + g * 16 + (lane & 15);
#pragma unroll
                    for (int r = 0; r < 4; ++r) yo[(size_t)r * 512] = (bf16)f2bf(gelu_tanh(y[r]));
                }
            }
        }
    }
    if (PASS == 1) { f32x2 e; e.x = hr; e.y = hi; *(f32x2*)(Ec + (size_t)c * 128) = e; }
}
template <int PASS>
__device__ __forceinline__ void s5_phase(unsigned char* ws, const float* s5d, LAS unsigned char* lds, int bid, int G, int tid, int wave, int lane) {
    LAS unsigned char* hl = lds + wave * (32 * S5_HST); LAS unsigned char* ul = lds + S5_UOFF;
    float* yscr = (float*)(ws + WS_YSCR) + (size_t)(bid * NWAVES + wave) * 4096;
    const bf16* h0 = (const bf16*)(ws + WS_H0);
    for (int it = bid; it < NB * S5NCH * 4; it += G) {
        const int go = it & 3, c = (it >> 2) % S5NCH, b = it / (4 * S5NCH), g = go * 8 + wave;
        { const bf16* src = h0 + ((size_t)b * SEQ + (size_t)c * S5CH) * H0P + OFF_U + go * 128;
          u32x4 v[8];
#pragma unroll
          for (int i = 0; i < 8; ++i) { const int p = i * NTHR + tid; v[i] = *(const u32x4*)(src + (size_t)(p >> 4) * H0P + 8 * (p & 15)); }
          __syncthreads();
#pragma unroll
          for (int i = 0; i < 8; ++i) { const int p = i * NTHR + tid; *(LAS u32x4*)(ul + (p >> 4) * S5_UST + 16 * (p & 15)) = v[i]; }
          __syncthreads(); }
        s5_dir<PASS, 0>(ws, s5d, b, g, c, hl, ul, yscr, lane);
        s5_dir<PASS, 1>(ws, s5d, b, g, c, hl, ul, yscr, lane);
    }
}
constexpr int G_ST = 144;
constexpr int GL_QD = 0, GL_KD = GL_QD + 64 * G_ST, GL_KCT = GL_KD + 64 * G_ST, GL_VT = GL_KCT + 64 * G_ST, GL_IMG = GL_VT + 128 * G_ST,
              GL_S = 2 * GL_IMG, GL_ST = GL_S + 64 * G_ST, GL_END = GL_ST + 2 * 128 * G_ST;
static_assert(GL_END <= MISC_OFF, "GLA LDS");
__device__ __forceinline__ bf16x8 ldfrag32(const LAS unsigned char* base, int row0, int ks, int lane) {
    return *(const LAS bf16x8*)(base + (row0 + (lane & 31)) * G_ST + 32 * ks + 16 * (lane >> 5));
}
__device__ __forceinline__ void gate_tail(float* bcg, const float* gate_w, const float* gate_b, const LAS float* lrs, size_t row0, int tid) {
    const int dir = tid >> 8;
    float gw[16];
#pragma unroll
    for (int r = 0; r < 16; ++r) gw[r] = gate_w[(size_t)(dir * 16 + r) * 256 + (tid & 255)];
    const float gb = gate_b[tid];
    float run = 0.f;
#pragma unroll 4
    for (int i = 0; i < 128; ++i) {
        const int t = dir ? 127 - i : i;
        if ((i & 63) == 0) run = 0.f;
        const LAS f32x4* lp = (const LAS f32x4*)(lrs + t * 32 + dir * 16);
        const f32x4 l0 = lp[0], l1 = lp[1], l2 = lp[2], l3 = lp[3];
        float z = gb + l0.x * gw[0] + l0.y * gw[1] + l0.z * gw[2] + l0.w * gw[3] + l1.x * gw[4] + l1.y * gw[5] + l1.z * gw[6] + l1.w * gw[7]
                     + l2.x * gw[8] + l2.y * gw[9] + l2.z * gw[10] + l2.w * gw[11] + l3.x * gw[12] + l3.y * gw[13] + l3.z * gw[14] + l3.w * gw[15];
        const float ls = fminf(z, 0.f) - __logf(1.f + __expf(-fabsf(z)));
        run += ls * (1.0f / 16.0f);
        bcg[(row0 + t) * 512 + tid] = run;
    }
}
__device__ __forceinline__ size_t gla_tok(int b, int dir, int chunk, int s) { const int pos = chunk * GCH + s; return (size_t)b * SEQ + (dir ? (SEQ - 1 - pos) : pos); }
template <int PASS>
__device__ __forceinline__ void gla_item(unsigned char* ws, const float* bcg, int item, LAS unsigned char* lds, int tid, int wave, int lane) {
    const int sc = item % GNSC, dir = (item / GNSC) & 1, h = (item / (GNSC * 2)) & 3, b = item / (GNSC * 8);
    const bf16* h0 = (const bf16*)(ws + WS_H0);
    LAS unsigned char* QD = lds + GL_QD; LAS unsigned char* KD = lds + GL_KD; LAS unsigned char* KCT = lds + GL_KCT; LAS unsigned char* VT = lds + GL_VT; LAS unsigned char* SS = lds + GL_S; LAS unsigned char* STT = lds + GL_ST;
    const int me = wave >> 1, nd = wave & 1;
    f32x16 st;
#pragma unroll
    for (int r = 0; r < 16; ++r) st[r] = 0.f;
    float dtot = 1.f;
    float* GS = (float*)(ws + WS_GS); float* GD = (float*)(ws + WS_GD);
    const int ibase = item - sc;
    if (PASS == 2) {
        for (int j0 = 0; j0 < sc; j0 += 4) {
            float dj[4], gv[4][16];
#pragma unroll
            for (int q = 0; q < 4; ++q) { const int j = (j0 + q) < sc ? (j0 + q) : (sc - 1);
                dj[q] = GD[(size_t)(ibase + j) * 64 + nd * 32 + (lane & 31)];
                const float* gs = GS + (size_t)(ibase + j) * 8192 + nd * 32 + (lane & 31);
#pragma unroll
                for (int r = 0; r < 16; ++r) gv[q][r] = gs[(size_t)(me * 32 + crow(r, lane >> 5)) * 64]; }
#pragma unroll
            for (int q = 0; q < 4; ++q) if (j0 + q < sc) {
#pragma unroll
                for (int r = 0; r < 16; ++r) st[r] = st[r] * dj[q] + gv[q][r]; }
        }
#pragma unroll
        for (int r = 0; r < 16; ++r) *(LAS bf16*)(STT + (me * 32 + crow(r, lane >> 5)) * G_ST + (nd * 32 + (lane & 31)) * 2) = (bf16)f2bf(st[r]);
    }
    const float qscale = 0.125f;
    const int s_l = lane;
    const int gcol = dir * 256 + h * 64;
    u32x4 pq, pk, pv0, pv1; f32x4 pb0, pb1, pl0, pl1; float pdec;
#define GLA_LOAD(n) do { const int ch_ = sc * GSC + (n); const size_t tk = gla_tok(b, dir, ch_, s_l), tl = gla_tok(b, dir, ch_, 63); const bf16* rp = h0 + tk * H0P; \
        if (PASS == 2) pq = *(const u32x4*)(rp + OFF_Q + h * 64 + 8 * wave); \
        pk = *(const u32x4*)(rp + OFF_K + h * 64 + 8 * wave); pv0 = *(const u32x4*)(rp + OFF_V + h * 128 + 16 * wave); pv1 = *(const u32x4*)(rp + OFF_V + h * 128 + 16 * wave + 8); \
        pb0 = *(const f32x4*)(bcg + tk * 512 + gcol + 8 * wave); pb1 = *(const f32x4*)(bcg + tk * 512 + gcol + 8 * wave + 4); \
        pl0 = *(const f32x4*)(bcg + tl * 512 + gcol + 8 * wave); pl1 = *(const f32x4*)(bcg + tl * 512 + gcol + 8 * wave + 4); \
        pdec = bcg[tl * 512 + gcol + nd * 32 + (lane & 31)]; } while (0)
#define GLA_STEP_A(IMG) do { LAS unsigned char* QD_ = (IMG) + GL_QD; LAS unsigned char* KD_ = (IMG) + GL_KD; LAS unsigned char* KCT_ = (IMG) + GL_KCT; LAS unsigned char* VT_ = (IMG) + GL_VT; \
        const float bc[8] = {pb0.x, pb0.y, pb0.z, pb0.w, pb1.x, pb1.y, pb1.z, pb1.w}, bl[8] = {pl0.x, pl0.y, pl0.z, pl0.w, pl1.x, pl1.y, pl1.z, pl1.w}; \
        const float kv[8] = {bflo(pk.x), bfhi(pk.x), bflo(pk.y), bfhi(pk.y), bflo(pk.z), bfhi(pk.z), bflo(pk.w), bfhi(pk.w)}; \
        if (PASS == 2) { const float qv[8] = {bflo(pq.x), bfhi(pq.x), bflo(pq.y), bfhi(pq.y), bflo(pq.z), bfhi(pq.z), bflo(pq.w), bfhi(pq.w)}; float qd[8], kd[8]; \
            _Pragma("unroll") for (int i = 0; i < 8; ++i) { qd[i] = qv[i] * qscale * __expf(bc[i]); kd[i] = kv[i] * __expf(-bc[i]); } \
            u32x4 w; w.x = pk2(qd[0], qd[1]); w.y = pk2(qd[2], qd[3]); w.z = pk2(qd[4], qd[5]); w.w = pk2(qd[6], qd[7]); *(LAS u32x4*)(QD_ + s_l * G_ST + 16 * wave) = w; \
            w.x = pk2(kd[0], kd[1]); w.y = pk2(kd[2], kd[3]); w.z = pk2(kd[4], kd[5]); w.w = pk2(kd[6], kd[7]); *(LAS u32x4*)(KD_ + s_l * G_ST + 16 * wave) = w; } \
        _Pragma("unroll") for (int i = 0; i < 8; ++i) *(LAS bf16*)(KCT_ + (8 * wave + i) * G_ST + 2 * s_l) = (bf16)f2bf(kv[i] * __expf(bl[i] - bc[i])); \
        const unsigned vv[8] = {pv0.x, pv0.y, pv0.z, pv0.w, pv1.x, pv1.y, pv1.z, pv1.w}; \
        _Pragma("unroll") for (int i = 0; i < 8; ++i) { *(LAS bf16*)(VT_ + (16 * wave + 2 * i) * G_ST + 2 * s_l) = (bf16)(vv[i] & 0xffffu); *(LAS bf16*)(VT_ + (16 * wave + 2 * i + 1) * G_ST + 2 * s_l) = (bf16)(vv[i] >> 16); } \
        dec_n = __expf(pdec); } while (0)
#define GLA_STEP_B(IMG, STW, WRITE_ST) do { LAS unsigned char* QD_ = (IMG) + GL_QD; LAS unsigned char* KD_ = (IMG) + GL_KD; LAS unsigned char* KCT_ = (IMG) + GL_KCT; LAS unsigned char* VT_ = (IMG) + GL_VT; \
        if (PASS == 2 && wave < 4) { const int ms = wave >> 1, ns = wave & 1; f32x16 sa; \
            _Pragma("unroll") for (int r = 0; r < 16; ++r) sa[r] = 0.f; \
            if (ns <= ms) { _Pragma("unroll") for (int ks = 0; ks < 4; ++ks) sa = MFMA32(ldfrag32(QD_, ms * 32, ks, lane), ldfrag32(KD_, ns * 32, ks, lane), sa); } \
            _Pragma("unroll") for (int r = 0; r < 16; ++r) { const int s = ms * 32 + crow(r, lane >> 5), s2 = ns * 32 + (lane & 31); const bool keep = dir ? (s2 < s) : (s2 <= s); \
                *(LAS bf16*)(SS + s * G_ST + 2 * s2) = (bf16)f2bf(keep ? sa[r] : 0.f); } } \
        _Pragma("unroll") for (int r = 0; r < 16; ++r) st[r] *= dec_c; \
        dtot *= dec_c; \
        _Pragma("unroll") for (int ks = 0; ks < 4; ++ks) st = MFMA32(ldfrag32(VT_, me * 32, ks, lane), ldfrag32(KCT_, nd * 32, ks, lane), st); \
        if (PASS == 2 && (WRITE_ST)) { _Pragma("unroll") for (int r = 0; r < 16; ++r) *(LAS bf16*)((STW) + (me * 32 + crow(r, lane >> 5)) * G_ST + (nd * 32 + (lane & 31)) * 2) = (bf16)f2bf(st[r]); } } while (0)
    float dec_n = 1.f, dec_c = 1.f;
    LAS unsigned char* IMG0 = lds; LAS unsigned char* IMG1 = lds + GL_IMG;
    GLA_LOAD(0);
    __syncthreads();
    GLA_STEP_A(IMG0); dec_c = dec_n;
    if (1 < GSC) GLA_LOAD(1);
    LDS_BARRIER();
    if (PASS == 2) { GLA_STEP_B(IMG0, STT + 128 * G_ST, true); LDS_BARRIER(); }
#pragma unroll 1
    for (int n = 0; n < GSC; ++n) {
        LAS unsigned char* Ic = (n & 1) ? IMG1 : IMG0; LAS unsigned char* In = (n & 1) ? IMG0 : IMG1;
        LAS unsigned char* STc = STT + (n & 1) * (128 * G_ST);
        if (PASS == 2) {
            const int ms = wave >> 2, ne = wave & 3;
            f32x16 oa;
#pragma unroll
            for (int r = 0; r < 16; ++r) oa[r] = 0.f;
#pragma unroll
            for (int ks = 0; ks < 4; ++ks) oa = MFMA32(ldfrag32(SS, ms * 32, ks, lane), ldfrag32(Ic + GL_VT, ne * 32, ks, lane), oa);
#pragma unroll
            for (int ks = 0; ks < 4; ++ks) oa = MFMA32(ldfrag32(Ic + GL_QD, ms * 32, ks, lane), ldfrag32(STc, ne * 32, ks, lane), oa);
            bf16* op = (bf16*)(ws + (dir ? WS_OB : WS_OF)) + h * 128 + ne * 32 + (lane & 31);
#pragma unroll
            for (int r = 0; r < 16; ++r) op[gla_tok(b, dir, sc * GSC + n, ms * 32 + crow(r, lane >> 5)) * 512] = (bf16)f2bf(oa[r]);
        } else {
            GLA_STEP_B(Ic, STT, false);
        }
        if (n + 1 < GSC) { GLA_STEP_A(In); if (n + 2 < GSC) GLA_LOAD(n + 2); }
        LDS_BARRIER();
        if (PASS == 2 && n + 1 < GSC) { dec_c = dec_n; GLA_STEP_B(In, STT + (n & 1) * (128 * G_ST), n + 2 < GSC); LDS_BARRIER(); }
        if (PASS == 1) dec_c = dec_n;
    }
#undef GLA_STEP_A
#undef GLA_STEP_B
    if (PASS == 1) {
        float* gs = GS + (size_t)item * 8192 + nd * 32 + (lane & 31);
#pragma unroll
        for (int r = 0; r < 16; ++r) gs[(size_t)(me * 32 + crow(r, lane >> 5)) * 64] = st[r];
        if (me == 0 && lane < 32) GD[(size_t)item * 64 + nd * 32 + lane] = dtot;
    }
    __syncthreads();
#undef GLA_LOAD
}
constexpr int AT_KST = 144, AT_VST = 664, AT_K = 0, AT_V = 320 * AT_KST, AT_BT = AT_V + 64 * AT_VST, AT_END = AT_BT + 16 * 260 * 4;
static_assert(AT_END <= RING_BYTES && AT_V % 16 == 0 && AT_BT % 16 == 0, "attention LDS");
__device__ __forceinline__ void attn_phase(unsigned char* ws, const float* sink, LAS unsigned char* lds, int bid, int G, int tid, int wave, int lane) {
    const bf16* qkv = (const bf16*)(ws + WS_QKV); bf16* ao = (bf16*)(ws + WS_AO); const float* btab = (const float*)(ws + WS_BTAB);
    LAS unsigned char* KS = lds + AT_K; LAS unsigned char* VT = lds + AT_V; LAS float* BT = (LAS float*)(lds + AT_BT);
    const float sc2 = 0.125f * LOG2E;
    u32x4 kreg[5], vreg[5]; bf16x8 qreg[4]; float sreg;
    for (int p = tid; p < 16 * 260; p += NTHR) BT[p] = btab[p];
#define AT_LOAD(u_) do { const int qb_ = (u_) % (SEQ / 64), kvh_ = ((u_) / (SEQ / 64)) & 3, b_ = (u_) / (4 * (SEQ / 64)), kb_ = qb_ * 64 - 128; \
        _Pragma("unroll") for (int it = 0; it < 5; ++it) { const int p = it * NTHR + tid; int key = kb_ + (p >> 3); key = key < 0 ? 0 : (key > SEQ - 1 ? SEQ - 1 : key); \
            const bf16* rp = qkv + ((size_t)b_ * SEQ + key) * CN + kvh_ * 64 + 8 * (p & 7); kreg[it] = *(const u32x4*)(rp + 1024); vreg[it] = *(const u32x4*)(rp + 1280); } \
        { const int hq_ = kvh_ * 4 + (wave >> 1); const bf16* qp_ = qkv + ((size_t)b_ * SEQ + qb_ * 64 + 32 * (wave & 1) + (lane & 31)) * CN + hq_ * 64 + 8 * (lane >> 5); \
          _Pragma("unroll") for (int ks = 0; ks < 4; ++ks) qreg[ks] = *(const bf16x8*)(qp_ + 16 * ks); sreg = sink[hq_]; } } while (0)
    if (bid < NB * 4 * (SEQ / 64)) AT_LOAD(bid);
    for (int u = bid; u < NB * 4 * (SEQ / 64); u += G) {
        const int qb = u % (SEQ / 64), kvh = (u / (SEQ / 64)) & 3, b = u / (4 * (SEQ / 64)), q0 = qb * 64;
#pragma unroll
        for (int it = 0; it < 5; ++it) { const int p = it * NTHR + tid, i = p >> 3, ch = p & 7;
            *(LAS u32x4*)(KS + i * AT_KST + 16 * ch) = kreg[it];
            const unsigned vv[4] = {vreg[it].x, vreg[it].y, vreg[it].z, vreg[it].w};
#pragma unroll
            for (int j = 0; j < 4; ++j) { *(LAS bf16*)(VT + (8 * ch + 2 * j) * AT_VST + 2 * i) = (bf16)(vv[j] & 0xffffu); *(LAS bf16*)(VT + (8 * ch + 2 * j + 1) * AT_VST + 2 * i) = (bf16)(vv[j] >> 16); } }
        const bf16x8 qf[4] = {qreg[0], qreg[1], qreg[2], qreg[3]}; const float m0 = sreg * LOG2E;
        if (u + G < NB * 4 * (SEQ / 64)) AT_LOAD(u + G);
        LDS_BARRIER();
        const int hl = wave >> 1, hq = kvh * 4 + hl, qw = q0 + 32 * (wave & 1), qi = qw + (lane & 31), hh = lane >> 5;
        float m = m0, l = hh == 0 ? 1.f : 0.f;
        f32x16 o0, o1;
#pragma unroll
        for (int r = 0; r < 16; ++r) { o0[r] = 0.f; o1[r] = 0.f; }
        const LAS float* btl = BT + hq * 260 + 128 - (lane & 31);
        const bool edge = (q0 < 128) || (q0 + 192 > SEQ);
#pragma unroll 1
        for (int j = 0; j < 9; ++j) {
            const int i0 = 32 * (wave & 1) + 32 * j;
            f32x16 sa;
#pragma unroll
            for (int r = 0; r < 16; ++r) sa[r] = 0.f;
#pragma unroll
            for (int ks = 0; ks < 4; ++ks) { const bf16x8 kf = *(const LAS bf16x8*)(KS + (i0 + (lane & 31)) * AT_KST + 32 * ks + 16 * hh); sa = MFMA32(kf, qf[ks], sa); }
            float mx = -3.0e38f;
#pragma unroll
            for (int r = 0; r < 16; ++r) {
                const int kk = 32 * j - 128 + crow(r, hh);
                sa[r] = sa[r] * sc2 + btl[kk];
            }
            if (edge || j == 0 || j == 8) {
#pragma unroll
                for (int r = 0; r < 16; ++r) {
                    const int kk = 32 * j - 128 + crow(r, hh), rel = kk - (lane & 31), key = qw + kk;
                    const bool ok = ((unsigned)(rel + 128) <= 256u) && ((unsigned)key < (unsigned)SEQ);
                    sa[r] = ok ? sa[r] : -3.0e38f;
                }
            }
#pragma unroll
            for (int r = 0; r < 16; ++r) mx = fmaxf(mx, sa[r]);
            mx = fmaxf(mx, __shfl_xor(mx, 32));
            if (!__all(mx <= m)) {
                const float mn = fmaxf(m, mx), alpha = __builtin_amdgcn_exp2f(m - mn); m = mn; l *= alpha;
#pragma unroll
                for (int r = 0; r < 16; ++r) { o0[r] *= alpha; o1[r] *= alpha; }
            }
            float ps = 0.f;
#pragma unroll
            for (int r = 0; r < 16; ++r) { const float p = __builtin_amdgcn_exp2f(sa[r] - m); sa[r] = p; ps += p; }
            l += ps;
#pragma unroll
            for (int s = 0; s < 2; ++s) {
                u32x4 pw; pw.x = pk2(sa[8 * s], sa[8 * s + 1]); pw.y = pk2(sa[8 * s + 2], sa[8 * s + 3]); pw.z = pk2(sa[8 * s + 4], sa[8 * s + 5]); pw.w = pk2(sa[8 * s + 6], sa[8 * s + 7]);
                const bf16x8 pf = __builtin_bit_cast(bf16x8, pw);
#pragma unroll
                for (int dt = 0; dt < 2; ++dt) {
                    const LAS unsigned char* vp = VT + (dt * 32 + (lane & 31)) * AT_VST + 2 * (i0 + 16 * s + 4 * hh);
                    const bf16x4 va = *(const LAS bf16x4*)vp, vb = *(const LAS bf16x4*)(vp + 16);
                    const bf16x8 vf = __builtin_shufflevector(va, vb, 0, 1, 2, 3, 4, 5, 6, 7);
                    if (dt == 0) o0 = MFMA32(vf, pf, o0); else o1 = MFMA32(vf, pf, o1);
                }
            }
        }
        l += __shfl_xor(l, 32);
        const float inv = __builtin_amdgcn_rcpf(l);
        bf16* op = ao + ((size_t)b * SEQ + qi) * D + hq * 64 + 4 * hh;
#pragma unroll
        for (int g = 0; g < 4; ++g) {
            u32x2 w0, w1; w0.x = pk2(o0[4 * g] * inv, o0[4 * g + 1] * inv); w0.y = pk2(o0[4 * g + 2] * inv, o0[4 * g + 3] * inv);
            w1.x = pk2(o1[4 * g] * inv, o1[4 * g + 1] * inv); w1.y = pk2(o1[4 * g + 2] * inv, o1[4 * g + 3] * inv);
            *(u32x2*)(op + 8 * g) = w0; *(u32x2*)(op + 32 + 8 * g) = w1;
        }
        LDS_BARRIER();
    }
#undef AT_LOAD
}
#ifndef MK_N_LAUNCHES
#define MK_N_LAUNCHES 1
#endif
constexpr int N_PHASES = 19;
#ifndef KEEP_LO1
#define KEEP_LO1 false
#endif
#ifndef KEEP_LO2
#define KEEP_LO2 false
#endif
#ifndef KEEP_LO3
#define KEEP_LO3 false
#endif
#ifndef PH_MASK
#define PH_MASK 0xFFFFFFFFu
#endif
#define ON(k) (((PH_MASK) >> (k)) & 1u)
#ifndef REP_MASK
#define REP_MASK 0u
#endif
#define NREP(k) ((((REP_MASK) >> (k)) & 1u) ? 2 : 1)

template <int LAYER>
__device__ __forceinline__ void common_phases(unsigned char* ws, LAS unsigned char* lds, float* dout, const XcdBarrier& bar, int lo, int hi, int bid, int G, int tid, int wave, int lane) {
    constexpr int pb = LAYER == 0 ? 5 : 13;
    const int gw = bid * NWAVES + wave, NGW = G * NWAVES;
#define IN(k) (lo <= (k) && (k) < hi)
#define SEAM(k) do { if (IN(k) && IN((k) + 1)) xcd_barrier(bar); } while (0)
    if (ON(5) && IN(pb)) {
        pg8::Gemm g{(const bf16*)(ws + (LAYER == 0 ? WS_X64 : WS_AO)), (const bf16*)(ws + (LAYER == 0 ? WS_WOUT : WS_COUT)), T, D, D, 0, nullptr}; pg8::StaticOrder S; S.init(T, D, G, bid);
        pg8::EpiBf16 E{(bf16*)(ws + WS_Z), D};
        pg8::gemm_phase<pg8::EpiBf16, pg8::StaticOrder, false>(lds, g, S, E);
    }
    SEAM(pb);
    if (ON(6) && IN(pb + 1)) { ln_router<LAYER == 0, KEEP_LO2, (LAYER == 0 ? KEEP_LO1 : KEEP_LO3)>(ws, inp(lds, I_X), inp(lds, I_LNMG) + LAYER * D, inp(lds, I_LNMB) + LAYER * D, inp(lds, I_BGRP) + LAYER * 4, inp(lds, I_BRT) + LAYER * 32, LAYER, lds, bid, G, tid, wave, lane); __syncthreads(); }
    SEAM(pb + 1);
    if (ON(7) && IN(pb + 2)) { moe_sort(ws, lds, bid, G, tid); __syncthreads(); }
    SEAM(pb + 2);
    if (ON(8) && IN(pb + 3)) {
        const int* tile = (const int*)(ws + WS_TILE); const int ntiles = __builtin_amdgcn_readfirstlane(tile[511]);
        pg8::Gemm g{(const bf16*)(ws + WS_HHI), LAYER == 0 ? (const bf16*)(ws + WS_W13) : (const bf16*)dout, 0, D, D, (size_t)D * D * 2, (const int*)(ws + WS_SLOTT)};
        pg8::GroupOrder S{tile, ntiles, D / 256, G, bid};
        pg8::EpiSwiglu E{(bf16*)(ws + WS_HID), DEXP};
        pg8::gemm_phase<pg8::EpiSwiglu, pg8::GroupOrder, true>(lds, g, S, E);
        if (LAYER == 0) idle_convert(0, ws, lds, dout, ntiles, bid, G, wave, lane);
    }
    SEAM(pb + 3);
    if (ON(9) && IN(pb + 4)) {
        const int* tile = (const int*)(ws + WS_TILE); const int ntiles = __builtin_amdgcn_readfirstlane(tile[511]);
        pg8::Gemm g{(const bf16*)(ws + WS_HID), LAYER == 0 ? (const bf16*)(ws + WS_W2) : (const bf16*)dout + (size_t)NEXP * D * D, 0, D, DEXP, (size_t)D * DEXP * 2, nullptr};
        pg8::GroupOrder S{tile, ntiles, D / 256, G, bid};
        pg8::EpiBf16 E{(bf16*)(ws + WS_Y2), D};
        pg8::gemm_phase<pg8::EpiBf16, pg8::GroupOrder, false>(lds, g, S, E);
        if (LAYER == 0) idle_convert(1, ws, lds, dout, ntiles, bid, G, wave, lane);
    }
    SEAM(pb + 4);
    if (ON(10) && IN(pb + 5)) {
        if (LAYER == 0) {
            combine_ln<false, KEEP_LO1, KEEP_LO2>(ws, inp(lds, I_LNFG), inp(lds, I_LNFB), nullptr, gw, NGW, lane);
            { const int done = idle_done(__builtin_amdgcn_readfirstlane(((const int*)(ws + WS_TILE))[511]), G);
              moe_convert(inp(lds, I_W1) + (size_t)NEXP * D * DEXP, inp(lds, I_W3) + (size_t)NEXP * D * DEXP, inp(lds, I_W2) + (size_t)NEXP * DEXP * D, (bf16*)dout, (bf16*)dout + (size_t)NEXP * D * D, (LAS float*)(lds + wave * 16384), done, MOE_ITEMS, gw, NGW, lane); }
            __syncthreads();
        } else combine_ln<true, KEEP_LO3, false>(ws, inp(lds, I_LNFG) + D, inp(lds, I_LNFB) + D, dout, gw, NGW, lane);
    }
    if (LAYER == 0) SEAM(10);
#undef IN
#undef SEAM
}

struct Args { const float* in[N_IN]; float* out; unsigned char* ws; int ph_lo, ph_hi; };
static_assert(sizeof(Args) == N_IN * 8 + 8 + 8 + 8, "no padding holes in Args");

__global__ void __launch_bounds__(NTHR, 2) fwd_kernel(Args args) {
    extern __shared__ __attribute__((aligned(16))) unsigned char lds_raw[];
    LAS unsigned char* lds = (LAS unsigned char*)lds_raw;
    volatile LAS unsigned* MISC = (volatile LAS unsigned*)(lds + MISC_OFF);
    const int tid = threadIdx.x, lane = tid & 63, wave = __builtin_amdgcn_readfirstlane(tid >> 6), G = gridDim.x, bid = blockIdx.x;
    unsigned char* ws = args.ws;
    for (int u = tid; u < 64; u += NTHR) MISC[u] = 0u;
    if (tid < N_IN) *(LAS unsigned long long*)(lds + PTR_OFF + 8 * tid) = (unsigned long long)args.in[tid];
    __syncthreads();
    const int lo = args.ph_lo, hi = args.ph_hi;
    const bool use_bar = (hi - lo) > 1;
    XcdBarrier bar; bar.bar = (unsigned*)(ws + WS_CTL) + CW_BAR; bar.x = 0; bar.st = nullptr;
    if (use_bar) bar = xcd_barrier_post((unsigned*)(ws + WS_CTL) + CW_BAR, MISC + 8);
#define IN(k) (lo <= (k) && (k) < hi)
#define SEAM(k) do { if (IN(k) && IN((k) + 1)) xcd_barrier(bar); } while (0)
    const int gw = bid * NWAVES + wave, NGW = G * NWAVES;

    if (ON(0) && IN(0)) { p0_prologue(ws, lds, bid, G, tid, wave, lane); __syncthreads(); }
    SEAM(0);
    if (ON(1) && IN(1)) {
        pg8::Gemm g{(const bf16*)(ws + WS_X64), (const bf16*)(ws + WS_WIN), T, ABN, D, 0, nullptr}; pg8::SplitOrder S; S.init(T, ABN, 2, G, bid);
        pg8::EpiBf16 E{(bf16*)(ws + WS_H0), H0P};
        pg8::gemm_phase<pg8::EpiBf16, pg8::SplitOrder, false>(lds, g, S, E);
        lr_tail(ws, args.out, inp(lds, I_GATEW), inp(lds, I_GATEB), lds, bid, G, tid, wave, lane);
#ifdef TAIL_TWICE
        lr_tail(ws, args.out, inp(lds, I_GATEW), inp(lds, I_GATEB), lds, bid, G, tid, wave, lane);
#endif
    }
    SEAM(1);
    if (ON(2) && IN(2)) {
        s5_phase<1>(ws, inp(lds, I_S5D), lds, bid, G, tid, wave, lane);
#ifdef S5_TWICE
        __syncthreads(); s5_phase<1>(ws, inp(lds, I_S5D), lds, bid, G, tid, wave, lane);
#endif
        __syncthreads();
        for (int it = bid; it < 256; it += G) gla_item<1>(ws, args.out, it, lds, tid, wave, lane);
#ifdef GLA_TWICE
        for (int it = bid; it < 256; it += G) gla_item<1>(ws, args.out, it, lds, tid, wave, lane);
#endif
    }
    SEAM(2);
    if (ON(3) && IN(3)) {
        s5_phase<2>(ws, inp(lds, I_S5D), lds, bid, G, tid, wave, lane);
#ifdef S5_TWICE
        __syncthreads(); s5_phase<2>(ws, inp(lds, I_S5D), lds, bid, G, tid, wave, lane);
#endif
        __syncthreads();
        for (int it = bid; it < 256; it += G) gla_item<2>(ws, args.out, it, lds, tid, wave, lane);
#ifdef GLA_TWICE
        for (int it = bid; it < 256; it += G) gla_item<2>(ws, args.out, it, lds, tid, wave, lane);
#endif
    }
    SEAM(3);
    if (ON(4) && IN(4)) {
        gla_finalize(ws, inp(lds, I_NORMG), gw, NGW, lane);
        pg8::Gemm g{(const bf16*)(ws + WS_YG), (const bf16*)(ws + WS_WGLU), T, 512, 512, 0, nullptr}; pg8::StaticOrder S; S.init(T, 512, G, bid);
        pg8::EpiGlu E{(const bf16*)(ws + WS_YG), 512, (bf16*)(ws + WS_X64), D, inp(lds, I_GLUB)};
        pg8::gemm_phase<pg8::EpiGlu, pg8::StaticOrder, false>(lds, g, S, E);
    }
    SEAM(4);
    common_phases<0>(ws, lds, args.out, bar, lo, hi, bid, G, tid, wave, lane);
    if (ON(11) && IN(11)) {
        pg8::Gemm g{(const bf16*)(ws + WS_H2B), (const bf16*)(ws + WS_CIN), T, CN, D, 0, nullptr}; pg8::StaticOrder S; S.init(T, CN, G, bid);
        pg8::EpiBf16 E{(bf16*)(ws + WS_QKV), CN};
        pg8::gemm_phase<pg8::EpiBf16, pg8::StaticOrder, false>(lds, g, S, E);
    }
    SEAM(11);
    if (ON(12) && IN(12)) attn_phase(ws, inp(lds, I_SINK), lds, bid, G, tid, wave, lane);
    SEAM(12);
    common_phases<1>(ws, lds, args.out, bar, lo, hi, bid, G, tid, wave, lane);
#undef IN
#undef SEAM
}

extern "C" void kernel_launch(void* const* d_in, const int* in_sizes, int n_in, void* d_out, int out_size, void* d_ws, size_t ws_size, hipStream_t stream) {
    static int grid = 0;
    if (grid == 0) {
        if (n_in != N_IN || in_sizes[0] != T * D || out_size != T * D || ws_size < WS_END) { fprintf(stderr, "kernel_launch: unexpected shapes (n_in %d, in0 %d, out %d, ws %zu < %zu)\n", n_in, n_in > 0 ? in_sizes[0] : -1, out_size, ws_size, (size_t)WS_END); grid = -1; return; }
        int dev = 0, cus = 0, per_cu = 0;
        if (hipGetDevice(&dev) != hipSuccess || hipDeviceGetAttribute(&cus, hipDeviceAttributeMultiprocessorCount, dev) != hipSuccess) { grid = -1; return; }
        if (hipFuncSetAttribute((const void*)fwd_kernel, hipFuncAttributeMaxDynamicSharedMemorySize, LDS_BYTES) != hipSuccess) { fprintf(stderr, "kernel_launch: hipFuncSetAttribute failed\n"); grid = -1; return; }
        if (hipOccupancyMaxActiveBlocksPerMultiprocessor(&per_cu, (const void*)fwd_kernel, NTHR, LDS_BYTES) != hipSuccess || per_cu < 1) fprintf(stderr, "kernel_launch: occupancy query reports %d\n", per_cu);
        (void)hipGetLastError();
        grid = cus;
    }
    if (grid < 0) return;
    if (hipMemsetAsync((char*)d_ws + WS_CTL, 0, CTL_ZERO_BYTES, stream) != hipSuccess) return;
    Args a{};
    for (int i = 0; i < N_IN; ++i) a.in[i] = (const float*)d_in[i];
    a.out = (float*)d_out; a.ws = (unsigned char*)d_ws;
    for (int li = 0; li < MK_N_LAUNCHES; ++li) {
        a.ph_lo = (MK_N_LAUNCHES == 1) ? 0 : li; a.ph_hi = (MK_N_LAUNCHES == 1) ? N_PHASES : li + 1;
        for (int rep = 0; rep < ((MK_N_LAUNCHES > 1 && ((REP_MASK >> li) & 1u)) ? 2 : 1); ++rep)
            hipLaunchKernelGGL(fwd_kernel, dim3(grid), dim3(NTHR), LDS_BYTES, stream, a);
    }
}
```

```cpp
#include <hip/hip_runtime.h>
#include <cstdio>
#include <cstdint>
#include <cmath>
namespace pg8 {
#define PG8_LAS __attribute__((address_space(3)))
typedef unsigned short bf16_t;
typedef short bf16x8 __attribute__((ext_vector_type(8)));
typedef float f32x4 __attribute__((ext_vector_type(4)));
typedef float f32x2 __attribute__((ext_vector_type(2)));
typedef unsigned u32x4 __attribute__((ext_vector_type(4)));
typedef unsigned u32x2 __attribute__((ext_vector_type(2)));
constexpr int BM = 256, BK = 64, HALF = 128, HTB = HALF * BK * 2  , STAGE_BYTES = 8 * HTB, NXCD = 8, WGM = 8;

__host__ __device__ __forceinline__ int lds_byte(int r, int c) { const int st = (r >> 4) * 2 + (c >> 5), rr = r & 15, cc = c & 31, ob = rr * 64 + cc * 2; return st * 1024 + (ob ^ (((ob >> 9) & 1) << 5)); }
__host__ __device__ __forceinline__ void stage_rc(int b, int& R, int& C) { const int st = b / 1024, sb = b % 1024, swz = sb ^ (((sb >> 9) & 1) << 5); R = (st >> 1) * 16 + swz / 64; C = (st & 1) * 32 + (swz % 64) / 2; }
__host__ __device__ __forceinline__ int perm32(int rho) { const int n = rho >> 4, i = rho & 15; return 8 * (i >> 2) + 4 * n + (i & 3); }

struct Unit { int pm, pn, e, ui; };
struct Gemm { const bf16_t* A; const bf16_t* Bt; int M, N, K; size_t bstride; const int* rowmap; };

struct StaticOrder {
    int nM, nN, nwg, G, c;
    __host__ __device__ void init(int M, int N, int G_, int c_) { nM = M / BM; nN = N / BM; nwg = nM * nN; G = G_; c = c_; }
    __host__ __device__ bool next(int i, Unit& u) const {
        const long L = (long)i * G + c; if (L >= nwg) return false;
        int wgid = (int)L; { const int q = nwg / NXCD, r = nwg % NXCD, xcd = wgid % NXCD, off = wgid / NXCD; wgid = (xcd < r ? xcd * (q + 1) : r * (q + 1) + (xcd - r) * q) + off; }
        const int nig = WGM * nN, gid = wgid / nig, fm = gid * WGM, gsz = (nM - fm) < WGM ? (nM - fm) : WGM;
        u.pm = fm + ((wgid % nig) % gsz); u.pn = (wgid % nig) / gsz; u.e = 0; u.ui = i; return true;
    }
};
struct SplitOrder {
    int nM, nNs, nwgs, nsp, G, c;
    __host__ __device__ void init(int M, int N, int nsp_, int G_, int c_) { nM = M / BM; nNs = N / BM / nsp_; nwgs = nM * nNs; nsp = nsp_; G = G_; c = c_; }
    __host__ __device__ bool next(int i, Unit& u) const {
        const long L = (long)i * G + c; if (L >= (long)nwgs * nsp) return false;
        const int slab = (int)(L / nwgs); int wgid = (int)(L % nwgs);
        { const int q = nwgs / NXCD, r = nwgs % NXCD, xcd = wgid % NXCD, off = wgid / NXCD; wgid = (xcd < r ? xcd * (q + 1) : r * (q + 1) + (xcd - r) * q) + off; }
        const int nig = WGM * nNs, gid = wgid / nig, fm = gid * WGM, gsz = (nM - fm) < WGM ? (nM - fm) : WGM;
        u.pm = fm + ((wgid % nig) % gsz); u.pn = slab * nNs + (wgid % nig) / gsz; u.e = 0; u.ui = i; return true;
    }
};
struct GroupOrder {
    const int* tile_e; int ntiles, nN, G, c;
    __device__ bool next(int i, Unit& u) const {
        const int L = i * G + c; if (L >= ntiles * nN) return false;
        u.pm = L / nN; u.pn = L % nN; u.e = __builtin_amdgcn_readfirstlane(tile_e[u.pm]); u.ui = i; return true;
    }
};

typedef __bf16 bf16x2_t __attribute__((ext_vector_type(2)));
__device__ __forceinline__ unsigned cvt_pk_bf16(float lo, float hi) { f32x2 v = {lo, hi}; return __builtin_bit_cast(unsigned, __builtin_convertvector(v, bf16x2_t)); }
__device__ __forceinline__ float bf_lo(unsigned w) { return __uint_as_float(w << 16); }
__device__ __forceinline__ float bf_hi(unsigned w) { return __uint_as_float(w & 0xffff0000u); }

struct EpiBf16 {
    static constexpr bool PERM = true;
    bf16_t* O; int ldc;
    __device__ __forceinline__ void operator()(const f32x4 (&acc)[2][2][4][2], const Unit& u, int wr, int wc, int fr, int fq) const {
        const int row0 = u.pm * BM + wr * 64 + fr; const int col0 = u.pn * BM + wc * 32 + 8 * fq;
#pragma unroll
        for (int ai = 0; ai < 2; ++ai)
#pragma unroll
            for (int m = 0; m < 4; ++m) { bf16_t* rowp = O + (size_t)(row0 + ai * HALF + m * 16) * ldc + col0;
#pragma unroll
                for (int bj = 0; bj < 2; ++bj) { const f32x4 v0 = acc[ai][bj][m][0], v1 = acc[ai][bj][m][1];
                    u32x4 w; w.x = cvt_pk_bf16(v0[0], v0[1]); w.y = cvt_pk_bf16(v0[2], v0[3]); w.z = cvt_pk_bf16(v1[0], v1[1]); w.w = cvt_pk_bf16(v1[2], v1[3]);
                    *(u32x4*)(rowp + bj * HALF) = w; } }
    }
};
struct EpiGlu {
    static constexpr bool PERM = true;
    const bf16_t* Y; int ldy; bf16_t* O; int ldc; const float* bias;
    __device__ __forceinline__ void operator()(const f32x4 (&acc)[2][2][4][2], const Unit& u, int wr, int wc, int fr, int fq) const {
        const int row0 = u.pm * BM + wr * 64 + fr; const int col0 = u.pn * BM + wc * 32 + 8 * fq;
        f32x4 bv[2][2];
#pragma unroll
        for (int bj = 0; bj < 2; ++bj)
#pragma unroll
            for (int n = 0; n < 2; ++n) bv[bj][n] = *(const f32x4*)(bias + col0 + bj * HALF + 4 * n);
#pragma unroll
        for (int ai = 0; ai < 2; ++ai) {
            u32x4 yq[4][2];
#pragma unroll
            for (int m = 0; m < 4; ++m)
#pragma unroll
                for (int bj = 0; bj < 2; ++bj) yq[m][bj] = *(const u32x4*)(Y + (size_t)(row0 + ai * HALF + m * 16) * ldy + col0 + bj * HALF);
            asm volatile("" ::: "memory");
#pragma unroll
            for (int m = 0; m < 4; ++m) { const size_t r = (size_t)(row0 + ai * HALF + m * 16);
#pragma unroll
                for (int bj = 0; bj < 2; ++bj) { const f32x4 v0 = acc[ai][bj][m][0] + bv[bj][0], v1 = acc[ai][bj][m][1] + bv[bj][1];
                    const u32x4 y = yq[m][bj];
                    float o[8]; const float yv[8] = {bf_lo(y.x), bf_hi(y.x), bf_lo(y.y), bf_hi(y.y), bf_lo(y.z), bf_hi(y.z), bf_lo(y.w), bf_hi(y.w)};
#pragma unroll
                    for (int i = 0; i < 4; ++i) { o[i] = yv[i] * __builtin_amdgcn_rcpf(1.f + __expf(-v0[i])); o[4 + i] = yv[4 + i] * __builtin_amdgcn_rcpf(1.f + __expf(-v1[i])); }
                    u32x4 w; w.x = cvt_pk_bf16(o[0], o[1]); w.y = cvt_pk_bf16(o[2], o[3]); w.z = cvt_pk_bf16(o[4], o[5]); w.w = cvt_pk_bf16(o[6], o[7]);
                    *(u32x4*)(O + r * ldc + col0 + bj * HALF) = w; } }
            asm volatile("" ::: "memory");
        }
    }
};
struct EpiResid {
    static constexpr bool PERM = false;
    const float* resid; float* out; int ldc; float alpha;
    __device__ __forceinline__ void operator()(const f32x4 (&acc)[2][2][4][2], const Unit& u, int wr, int wc, int fr, int fq) const {
        const int col0 = u.pn * BM + wc * 32 + 4 * fq;
#pragma unroll
        for (int ai = 0; ai < 2; ++ai) {
            f32x4 bs[4][2][2];
#pragma unroll
            for (int m = 0; m < 4; ++m) { const size_t off = (size_t)(u.pm * BM + ai * HALF + wr * 64 + m * 16 + fr) * ldc + col0;
#pragma unroll
                for (int bj = 0; bj < 2; ++bj)
#pragma unroll
                    for (int n = 0; n < 2; ++n) bs[m][bj][n] = *(const f32x4*)(resid + off + bj * HALF + n * 16); }
            asm volatile("" ::: "memory");
#pragma unroll
            for (int m = 0; m < 4; ++m) { const size_t off = (size_t)(u.pm * BM + ai * HALF + wr * 64 + m * 16 + fr) * ldc + col0;
#pragma unroll
                for (int bj = 0; bj < 2; ++bj)
#pragma unroll
                    for (int n = 0; n < 2; ++n) *(f32x4*)(out + off + bj * HALF + n * 16) = bs[m][bj][n] * alpha + acc[ai][bj][m][n]; }
            asm volatile("" ::: "memory");
        }
    }
};
struct EpiSwiglu {
    static constexpr bool PERM = true;
    bf16_t* O; int ldc;
    __device__ __forceinline__ void operator()(const f32x4 (&acc)[2][2][4][2], const Unit& u, int wr, int wc, int fr, int fq) const {
        const int row0 = u.pm * BM + wr * 64 + fr; const int col0 = (u.pn * BM + wc * 32 + 8 * fq) >> 1;
#pragma unroll
        for (int ai = 0; ai < 2; ++ai)
#pragma unroll
            for (int m = 0; m < 4; ++m) { bf16_t* rowp = O + (size_t)(row0 + ai * HALF + m * 16) * ldc + col0;
#pragma unroll
                for (int bj = 0; bj < 2; ++bj) { const f32x4 g = acc[ai][bj][m][0], up = acc[ai][bj][m][1]; float o[4];
#pragma unroll
                    for (int i = 0; i < 4; ++i) o[i] = g[i] * __builtin_amdgcn_rcpf(1.f + __expf(-g[i])) * up[i];
                    u32x2 w; w.x = cvt_pk_bf16(o[0], o[1]); w.y = cvt_pk_bf16(o[2], o[3]);
                    *(u32x2*)(rowp + bj * (HALF / 2)) = w; } }
    }
};
struct EpiScale {
    static constexpr bool PERM = true;
    bf16_t* O; int ldc; const float* rw;
    __device__ __forceinline__ void operator()(const f32x4 (&acc)[2][2][4][2], const Unit& u, int wr, int wc, int fr, int fq) const {
        const int row0 = u.pm * BM + wr * 64 + fr; const int col0 = u.pn * BM + wc * 32 + 8 * fq;
        float sw[2][4];
#pragma unroll
        for (int ai = 0; ai < 2; ++ai)
#pragma unroll
            for (int m = 0; m < 4; ++m) sw[ai][m] = rw[row0 + ai * HALF + m * 16];
        asm volatile("" ::: "memory");
#pragma unroll
        for (int ai = 0; ai < 2; ++ai)
#pragma unroll
            for (int m = 0; m < 4; ++m) { const int r = row0 + ai * HALF + m * 16; const float s = sw[ai][m]; bf16_t* rowp = O + (size_t)r * ldc + col0;
#pragma unroll
                for (int bj = 0; bj < 2; ++bj) { const f32x4 v0 = acc[ai][bj][m][0] * s, v1 = acc[ai][bj][m][1] * s;
                    u32x4 w; w.x = cvt_pk_bf16(v0[0], v0[1]); w.y = cvt_pk_bf16(v0[2], v0[3]); w.z = cvt_pk_bf16(v1[0], v1[1]); w.w = cvt_pk_bf16(v1[2], v1[3]);
                    *(u32x4*)(rowp + bj * HALF) = w; } }
    }
};

template <class Epi, class Sched, bool GATHER>
__device__ __forceinline__ void gemm_phase(PG8_LAS unsigned char* lds, const Gemm g, const Sched& S, const Epi& E) {
    const int tid = threadIdx.x, wid = __builtin_amdgcn_readfirstlane(tid >> 6), lane = tid & 63, wr = wid >> 2, wc = wid & 3, fr = lane & 15, fq = lane >> 4;
    const int K = g.K, nt = K / BK;
    unsigned voffA[2], voffB[2]; int RA[2], CA[2];
#pragma unroll
    for (int i = 0; i < 2; ++i) { int R, C; stage_rc(tid * 16 + i * 8192, R, C); const int Rb = Epi::PERM ? ((R & ~31) + perm32(R & 31)) : R;
        voffA[i] = (unsigned)(R * K + C) * 2u; voffB[i] = (unsigned)(Rb * K + C) * 2u; RA[i] = R; CA[i] = C; }
    const size_t kstep = (size_t)(BK * 2);
    const size_t hstep = (size_t)HALF * K * 2;
    const size_t tstep = 2 * hstep;
    const unsigned ldsw = (unsigned)wid * 1024u;
    const int aoff = lds_byte(wr * 64 + fr, fq * 8), boff = lds_byte(wc * 32 + fr, fq * 8);
#define PG8_SA(b, h) (((b) * 2 + (h)) * HTB)
#define PG8_SB(b, h) ((4 + (b) * 2 + (h)) * HTB)
#define PG8_STAGE(bufoff, gbase, voff) do { _Pragma("unroll") for (int _i = 0; _i < 2; ++_i) \
        __builtin_amdgcn_global_load_lds((const unsigned*)((const char*)(gbase) + (voff)[_i]), (PG8_LAS unsigned*)(lds + (bufoff) + ldsw + _i * 8192), 16, 0, 0); } while (0)
#define PG8_LDA(dst, b, h) do { _Pragma("unroll") for (int m = 0; m < 4; ++m) _Pragma("unroll") for (int k = 0; k < 2; ++k) dst[m][k] = *(const PG8_LAS bf16x8*)(lds + PG8_SA(b, h) + aoff + m * 2048 + k * 1024); } while (0)
#define PG8_LDB(dst, b, h) do { _Pragma("unroll") for (int n = 0; n < 2; ++n) _Pragma("unroll") for (int k = 0; k < 2; ++k) dst[n][k] = *(const PG8_LAS bf16x8*)(lds + PG8_SB(b, h) + boff + n * 2048 + k * 1024); } while (0)
#define PG8_MMA(ai, bj, At, Bt) do { __builtin_amdgcn_s_setprio(1); _Pragma("unroll") for (int m = 0; m < 4; ++m) _Pragma("unroll") for (int n = 0; n < 2; ++n) _Pragma("unroll") for (int k = 0; k < 2; ++k) \
        acc[ai][bj][m][n] = __builtin_amdgcn_mfma_f32_16x16x32_bf16(Bt[n][k], At[m][k], acc[ai][bj][m][n], 0, 0, 0); __builtin_amdgcn_s_setprio(0); } while (0)
#define PG8_WAIT_V(n) asm volatile("s_waitcnt vmcnt(" #n ")" ::: "memory")
#define PG8_WAIT_L(n) asm volatile("s_waitcnt lgkmcnt(" #n ")" ::: "memory")
#define PG8_BAR __builtin_amdgcn_s_barrier()
#define PG8_SCHED __builtin_amdgcn_sched_barrier(0)
    Unit cur, nxt; int ui = 0;
    const PG8_LAS int* rmap = (const PG8_LAS int*)(lds + STAGE_BYTES);
    if (GATHER) { Unit t_; for (int i_ = 0; S.next(i_, t_) && i_ < 16; ++i_) { if (tid < BM) ((PG8_LAS int*)(lds + STAGE_BYTES))[i_ * BM + tid] = g.rowmap[t_.pm * BM + tid]; }
        asm volatile("s_waitcnt vmcnt(0) lgkmcnt(0)" ::: "memory"); __builtin_amdgcn_s_barrier(); asm volatile("" ::: "memory"); }
    if (!S.next(0, cur)) return;
    f32x4 acc[2][2][4][2];
#pragma unroll
    for (int a = 0; a < 2; ++a)
#pragma unroll
        for (int b = 0; b < 2; ++b)
#pragma unroll
            for (int m = 0; m < 4; ++m)
#pragma unroll
                for (int n = 0; n < 2; ++n) acc[a][b][m][n] = (f32x4){0.f, 0.f, 0.f, 0.f};
    bf16x8 At[4][2], B0[2][2], B1[2][2];
    unsigned cG[2][2], nG[2][2];
#define PG8_LOAD_ROWS(u_, G2_) do { _Pragma("unroll") for (int h_ = 0; h_ < 2; ++h_) _Pragma("unroll") for (int i_ = 0; i_ < 2; ++i_) \
        G2_[h_][i_] = GATHER ? ((unsigned)rmap[(u_).ui * BM + h_ * HALF + RA[i_]] * (unsigned)K + (unsigned)CA[i_]) * 2u : voffA[i_]; } while (0)
    const char* cA = GATHER ? (const char*)g.A : (const char*)g.A + (size_t)cur.pm * tstep;
    const size_t hA = GATHER ? 0 : hstep;
    const char* cB = (const char*)g.Bt + (size_t)cur.e * g.bstride + (size_t)cur.pn * tstep;
    PG8_LOAD_ROWS(cur, cG);
    PG8_STAGE(PG8_SB(0, 0), cB, voffB); PG8_STAGE(PG8_SB(0, 1), cB + hstep, voffB); PG8_STAGE(PG8_SA(0, 0), cA, cG[0]); PG8_STAGE(PG8_SA(0, 1), cA + hA, cG[1]);
    if (wr == 1) PG8_BAR;
    PG8_WAIT_V(2); PG8_BAR;
    PG8_STAGE(PG8_SB(1, 0), cB + kstep, voffB); PG8_STAGE(PG8_SA(1, 0), cA + kstep, cG[0]); PG8_STAGE(PG8_SB(1, 1), cB + hstep + kstep, voffB);
    PG8_WAIT_V(6); PG8_BAR;
    for (;;) {
        const bool has_next = S.next(ui + 1, nxt);
        const char* nA = GATHER ? (const char*)g.A : (has_next ? (const char*)g.A + (size_t)nxt.pm * tstep : cA);
        const char* nB = has_next ? (const char*)g.Bt + (size_t)nxt.e * g.bstride + (size_t)nxt.pn * tstep : cB;
        if (has_next) PG8_LOAD_ROWS(nxt, nG); else {
#pragma unroll
            for (int h = 0; h < 2; ++h) { nG[h][0] = cG[h][0]; nG[h][1] = cG[h][1]; } }
        for (int t = 0; t < nt; t += 2) {
            const bool last = (t == nt - 2);
            const char* a1 = cA + (size_t)(t + 1) * kstep;
            const char* a2 = last ? nA : cA + (size_t)(t + 2) * kstep; const char* b2 = last ? nB : cB + (size_t)(t + 2) * kstep;
            const char* a3 = a2 + kstep; const char* b3 = b2 + kstep;
            unsigned sG[2][2];
#pragma unroll
            for (int h = 0; h < 2; ++h) { sG[h][0] = (GATHER && last) ? nG[h][0] : cG[h][0]; sG[h][1] = (GATHER && last) ? nG[h][1] : cG[h][1]; }
            PG8_LDB(B0, 0, 0); PG8_LDB(B1, 0, 1); PG8_SCHED; PG8_LDA(At, 0, 0); PG8_STAGE(PG8_SA(1, 1), a1 + hA, cG[1]);
            PG8_WAIT_V(8); PG8_WAIT_L(0); PG8_BAR; PG8_MMA(0, 0, At, B0); PG8_MMA(0, 1, At, B1); PG8_BAR; PG8_SCHED;
            PG8_LDA(At, 0, 1); PG8_STAGE(PG8_SB(0, 0), b2, voffB); PG8_STAGE(PG8_SB(0, 1), b2 + hstep, voffB); PG8_STAGE(PG8_SA(0, 0), a2, sG[0]);
            PG8_WAIT_V(8); PG8_WAIT_L(0); PG8_BAR; PG8_MMA(1, 0, At, B0); PG8_MMA(1, 1, At, B1); PG8_BAR; PG8_SCHED;
            PG8_LDB(B0, 1, 0); PG8_LDB(B1, 1, 1); PG8_SCHED; PG8_LDA(At, 1, 0); PG8_STAGE(PG8_SA(0, 1), a2 + hA, sG[1]);
            PG8_WAIT_V(8); PG8_WAIT_L(0); PG8_BAR; PG8_MMA(0, 0, At, B0); PG8_MMA(0, 1, At, B1); PG8_BAR; PG8_SCHED;
            PG8_LDA(At, 1, 1); PG8_STAGE(PG8_SB(1, 0), b3, voffB); PG8_STAGE(PG8_SB(1, 1), b3 + hstep, voffB); PG8_STAGE(PG8_SA(1, 0), a3, sG[0]);
            PG8_WAIT_V(8); PG8_WAIT_L(0); PG8_BAR; PG8_MMA(1, 0, At, B0); PG8_MMA(1, 1, At, B1); PG8_BAR; PG8_SCHED;
        }
        if (wr == 0) PG8_BAR;
        E(acc, cur, wr, wc, fr, fq);
        if (!has_next) break;
#pragma unroll
        for (int a = 0; a < 2; ++a)
#pragma unroll
            for (int b = 0; b < 2; ++b)
#pragma unroll
                for (int m = 0; m < 4; ++m)
#pragma unroll
                    for (int n = 0; n < 2; ++n) acc[a][b][m][n] = (f32x4){0.f, 0.f, 0.f, 0.f};
        cur = nxt; cA = nA; cB = nB; ++ui;
#pragma unroll
        for (int h = 0; h < 2; ++h) { cG[h][0] = nG[h][0]; cG[h][1] = nG[h][1]; }
        if (wr == 1) PG8_BAR;
    }
    PG8_WAIT_V(0);
    PG8_BAR;
#undef PG8_LOAD_ROWS
#undef PG8_SA
#undef PG8_SB
#undef PG8_STAGE
#undef PG8_LDA
#undef PG8_LDB
#undef PG8_MMA
#undef PG8_WAIT_V
#undef PG8_WAIT_L
#undef PG8_BAR
#undef PG8_SCHED
}
}
constexpr int NB = 2, SEQ = 16384, T = NB * SEQ, D = 1024;
constexpr int H0P = 2112;
constexpr int ABN = 2048, OFF_U = 0, OFF_Q = 512, OFF_K = 768, OFF_V = 1024, OFF_GO = 1536, AB_IN = 2080;
constexpr int CN = 1536;
constexpr int NEXP = 32, DEXP = 512, CAP = 2 * T + NEXP * 256, MAXTILES = CAP / 256;
constexpr int S5CH = 256, S5NCH = SEQ / S5CH;
constexpr int GSC = 16, GCH = 64, GNSC = SEQ / (GSC * GCH);
constexpr float ALPHA = 1.41421356237309515f;
constexpr float LN_EPS = 1e-5f, RMS_EPS = 1e-6f, LOG2E = 1.44269504088896341f;
constexpr int NWAVES = 8, NTHR = 512;

constexpr size_t MiB = 1u << 20, KiB = 1u << 10;
constexpr size_t WS_CTL = 0, CTL_ZERO_BYTES = 64 * KiB;
constexpr int CW_BAR = 4096;
constexpr size_t WS_LR = 1 * MiB;
constexpr size_t WS_S5E = 5 * MiB;
constexpr size_t WS_GS = 9 * MiB;
constexpr size_t WS_GD = 17 * MiB;
constexpr size_t WS_S5L = WS_GD + 64 * KiB;
constexpr size_t WS_S5B = WS_S5L + 64 * KiB;
constexpr size_t WS_S5C = WS_S5B + 256 * KiB;
constexpr size_t WS_BTAB = WS_S5C + 256 * KiB;
constexpr size_t WS_WR = WS_BTAB + 32 * KiB;
constexpr size_t WS_TOKE = WS_WR + 384 * KiB;
constexpr size_t WS_TOKW = WS_TOKE + 256 * KiB;
constexpr size_t WS_TOKS = WS_TOKW + 256 * KiB;
constexpr size_t WS_SLOTT = WS_TOKS + 256 * KiB;
constexpr size_t WS_SLOTW = WS_SLOTT + 288 * KiB;
constexpr size_t WS_BLKC = WS_SLOTW + 288 * KiB;
constexpr size_t WS_TILE = WS_BLKC + 32 * KiB;
static_assert(WS_TILE + 4 * KiB <= 32 * MiB, "param region");
constexpr size_t WS_WIN = 32 * MiB, WS_WLR = 36 * MiB, WS_WGLU = 37 * MiB, WS_WOUT = 38 * MiB, WS_CIN = 40 * MiB, WS_COUT = 43 * MiB;
constexpr size_t WS_W13 = 48 * MiB, WS_W2 = 112 * MiB;
constexpr size_t A0 = 144 * MiB;
constexpr size_t WS_H1 = A0, WS_HLO = A0, WS_HHI = A0 + 64 * MiB, WS_H0 = A0;
constexpr size_t WS_Z = A0 + 128 * MiB;
constexpr size_t WS_YG = A0 + 136 * MiB, WS_OF = A0 + 168 * MiB, WS_OB = A0 + 320 * MiB;
constexpr size_t WS_YSCR = A0 + 232 * MiB;
constexpr size_t WS_X64 = A0 + 256 * MiB;
constexpr size_t WS_HID = A0 + 128 * MiB;
constexpr size_t WS_Y2 = A0 + 200 * MiB;
constexpr size_t WS_H2B = WS_HHI;
constexpr size_t WS_QKV = A0 + 192 * MiB;
constexpr size_t WS_AO = A0 + 288 * MiB;
constexpr size_t WS_END = A0 + 384 * MiB;
static_assert((size_t)T * H0P * 2 <= 136 * MiB && WS_Y2 + (size_t)CAP * D * 2 <= WS_END && WS_OB + (size_t)T * 512 * 4 <= WS_END && WS_HID + (size_t)CAP * 512 * 2 <= WS_Y2, "act map");

constexpr int RING_BYTES = 131072;
constexpr int MISC_OFF = 163840 - 1024;
constexpr int PTR_OFF = MISC_OFF + 256;
constexpr int LDS_BYTES = 163840;

#define GAS __attribute__((address_space(1)))
#define LAS __attribute__((address_space(3)))
typedef unsigned short bf16;
typedef float f32x4 __attribute__((ext_vector_type(4)));
typedef float f32x2 __attribute__((ext_vector_type(2)));
typedef float f32x16 __attribute__((ext_vector_type(16)));
typedef short bf16x8 __attribute__((ext_vector_type(8)));
typedef short bf16x4 __attribute__((ext_vector_type(4)));
typedef unsigned u32x4 __attribute__((ext_vector_type(4)));
typedef unsigned u32x2 __attribute__((ext_vector_type(2)));
#define LDS_WAIT() asm volatile("s_waitcnt lgkmcnt(0)" ::: "memory")
#define VM_WAIT() asm volatile("s_waitcnt vmcnt(0)" ::: "memory")
#define LDS_BARRIER() do { asm volatile("s_waitcnt lgkmcnt(0)" ::: "memory"); __builtin_amdgcn_s_barrier(); asm volatile("" ::: "memory"); } while (0)
typedef __bf16 bf16x2_t __attribute__((ext_vector_type(2)));
__device__ __forceinline__ unsigned pk2(float lo, float hi) { f32x2 v = {lo, hi}; return __builtin_bit_cast(unsigned, __builtin_convertvector(v, bf16x2_t)); }
__device__ __forceinline__ unsigned f2bf(float f) { return pk2(f, 0.f) & 0xffffu; }
__device__ __forceinline__ float bf2f(unsigned short b) { return __uint_as_float((unsigned)b << 16); }
__device__ __forceinline__ float bflo(unsigned w) { return __uint_as_float(w << 16); }
__device__ __forceinline__ float bfhi(unsigned w) { return __uint_as_float(w & 0xffff0000u); }
__device__ __forceinline__ float wave_sum(float v) {
#pragma unroll
    for (int o = 1; o < 64; o <<= 1) v += __shfl_xor(v, o);
    return v;
}
__device__ __forceinline__ int crow(int r, int hi) { return (r & 3) + 8 * (r >> 2) + 4 * hi; }

#define XB_TMO      128
#define XB_XCNT(j)  (256  + 64 * (j))
#define XB_XSUB(j)  (1280 + 64 * (j))
#define XB_XGEN(j)  (2304 + 64 * (j))
#define XB_TOP      3328
#define XB_TOPGEN   3392
#define XCD_BAR_WORDS 3456
#define XB_SPIN_CAP (1u << 18)
__device__ __forceinline__ unsigned xb_ld(unsigned* p)              { return __hip_atomic_load(p, __ATOMIC_RELAXED, __HIP_MEMORY_SCOPE_AGENT); }
__device__ __forceinline__ unsigned xb_add(unsigned* p, unsigned v) { return __hip_atomic_fetch_add(p, v, __ATOMIC_RELAXED, __HIP_MEMORY_SCOPE_AGENT); }
__device__ __forceinline__ unsigned xb_xcc_id() { return (unsigned)__builtin_amdgcn_s_getreg((3 << 11) | 20) & 0xFu; }
#define XB_SPIN(cond, bar) do { unsigned _sp = 0; while (cond) { __builtin_amdgcn_s_sleep(1); \
    if ((++_sp & 255u) == 0u) { if (xb_ld(&(bar)[XB_TMO])) break; if (_sp > XB_SPIN_CAP) { atomicAdd(&(bar)[XB_TMO], 1u); break; } } } } while (0)
struct XcdBarrier { unsigned* bar; unsigned x; volatile LAS unsigned* st; };
__device__ __forceinline__ XcdBarrier xcd_barrier_post(unsigned* bar, volatile LAS unsigned* st) {
    XcdBarrier b; b.bar = bar; b.x = xb_xcc_id(); b.st = st;
    if (threadIdx.x == 0) (void)xb_add(&bar[XB_XCNT(b.x)], 1u);
    return b;
}
__device__ __forceinline__ void xcd_barrier_complete(unsigned* bar, unsigned x, unsigned& nloc, unsigned& nx) {
    const unsigned G = gridDim.x * gridDim.y * gridDim.z;
    unsigned sum, cnt, mine, sp = 0u;
    for (;;) {
        sum = 0u; cnt = 0u; mine = 0u;
#pragma unroll
        for (unsigned j = 0; j < 16; ++j) { const unsigned c = xb_ld(&bar[XB_XCNT(j)]); sum += c; cnt += (c > 0u) ? 1u : 0u; mine = (j == x) ? c : mine; }
        if (sum == G) break;
        __builtin_amdgcn_s_sleep(1);
        if ((++sp & 255u) == 0u) { if (xb_ld(&bar[XB_TMO])) break; if (sp > XB_SPIN_CAP) { atomicAdd(&bar[XB_TMO], 1u); break; } }
    }
    nloc = mine > 0u ? mine : 1u; nx = cnt > 0u ? cnt : 1u;
}
__device__ __forceinline__ void xcd_barrier(const XcdBarrier& b) {
    asm volatile("s_waitcnt vmcnt(0)" ::: "memory");
    __syncthreads();
    if (threadIdx.x == 0) {
        unsigned* bar = b.bar;
        __builtin_amdgcn_s_waitcnt(0);
        unsigned nloc = b.st[0], nx = b.st[1];
        if (nloc == 0u) { xcd_barrier_complete(bar, b.x, nloc, nx); b.st[0] = nloc; b.st[1] = nx; }
        const unsigned old = xb_add(&bar[XB_XSUB(b.x)], 1u);
        const unsigned gen = old / nloc;
        if (old + 1u == (gen + 1u) * nloc) {
            __builtin_amdgcn_fence(__ATOMIC_RELEASE, "agent");
            asm volatile("s_waitcnt vmcnt(0)" ::: "memory");
            const unsigned og = xb_add(&bar[XB_TOP], 1u);
            const unsigned tg = og / nx;
            if (og + 1u == (tg + 1u) * nx) xb_add(&bar[XB_TOPGEN], 1u);
            else XB_SPIN(xb_ld(&bar[XB_TOPGEN]) == tg, bar);
            __builtin_amdgcn_fence(__ATOMIC_ACQUIRE, "agent");
            xb_add(&bar[XB_XGEN(b.x)], 1u);
            asm volatile("s_waitcnt vmcnt(0)" ::: "memory");
        } else {
            XB_SPIN(xb_ld(&bar[XB_XGEN(b.x)]) == gen, bar);
            __builtin_amdgcn_fence(__ATOMIC_ACQUIRE, "agent");
            asm volatile("s_waitcnt vmcnt(0)" ::: "memory");
        }
    }
    __syncthreads();
}

struct Frame {
    LAS unsigned char* lds;
    int tid, lane, wave, G, bid;
    unsigned char* ws;
    const float* const* in;
};
enum InIdx { I_X = 0, I_LNMG, I_LNMB, I_LNFG, I_LNFB, I_ABWIN, I_LAMRE, I_LAMIM, I_LOGDT, I_BRE, I_BIM, I_CRE, I_CIM, I_S5D, I_GLUW, I_GLUB,
             I_GATEW, I_GATEB, I_NORMG, I_ABWOUT, I_CWIN, I_SINK, I_CWOUT, I_RELB, I_WGRP, I_BGRP, I_WRT, I_BRT, I_W1, I_W3, I_W2, N_IN };

__device__ __forceinline__ const float* inp(LAS unsigned char* lds, int k) {
    const LAS unsigned* p = (const LAS unsigned*)(lds + PTR_OFF) + 2 * k;
    const unsigned lo = __builtin_amdgcn_readfirstlane(p[0]), hi = __builtin_amdgcn_readfirstlane(p[1]);
    return (const float*)(const GAS float*)(((unsigned long long)hi << 32) | (unsigned long long)lo);
}
struct TrItem { const float* W; bf16* WT; int ldw, ldt, rowmode, k0, n0; };
__device__ __forceinline__ void tr_load(const TrItem& q, float (&tv)[32], int lane) {
    const float* wp = q.W + (size_t)(q.k0 + (lane >> 5)) * q.ldw + q.n0 + (lane & 31);
#pragma unroll
    for (int i = 0; i < 32; ++i) tv[i] = wp[(size_t)(2 * i) * q.ldw];
}
__device__ __forceinline__ void tr_store(const TrItem& q, const float (&tv)[32], LAS float* scr, int lane) {
#pragma unroll
    for (int i = 0; i < 32; ++i) scr[(2 * i + (lane >> 5)) * 33 + (lane & 31)] = tv[i];
    LDS_WAIT(); asm volatile("" ::: "memory");
    const int c = lane & 7;
#pragma unroll
    for (int j = 0; j < 4; ++j) { const int n = (lane >> 3) + 8 * j; const LAS float* s = scr + (8 * c) * 33 + n;
        u32x4 o; o.x = pk2(s[0 * 33], s[1 * 33]); o.y = pk2(s[2 * 33], s[3 * 33]); o.z = pk2(s[4 * 33], s[5 * 33]); o.w = pk2(s[6 * 33], s[7 * 33]);
        const int ng = q.n0 + n; const int dr = q.rowmode == 0 ? ng : (8 * (ng >> 2) + (ng & 3) + (q.rowmode == 2 ? 4 : 0));
        *(GAS u32x4*)(q.WT + (size_t)dr * q.ldt + q.k0 + 8 * c) = o; }
    LDS_WAIT(); asm volatile("" ::: "memory");
}
__device__ __forceinline__ void tr_item(const float* W, int ldw, bf16* WT, int ldt, int rowmode, LAS float* scr, int item, int nblk, int lane) {
    TrItem q{W, WT, ldw, ldt, rowmode, 64 * (item / nblk), 32 * (item % nblk)}; float tv[32]; tr_load(q, tv, lane); tr_store(q, tv, scr, lane);
}
__device__ __forceinline__ TrItem moe_item(const float* w1, const float* w3, const float* w2, bf16* W13, bf16* W2T, int it) {
    constexpr int PER_E = 768; const int e = it / PER_E, r = it % PER_E;
    if (r < 256) return TrItem{w1 + (size_t)e * D * DEXP, W13 + (size_t)e * D * D, DEXP, D, 1, 64 * (r / 16), 32 * (r % 16)};
    if (r < 512) return TrItem{w3 + (size_t)e * D * DEXP, W13 + (size_t)e * D * D, DEXP, D, 2, 64 * ((r - 256) / 16), 32 * ((r - 256) % 16)};
    return TrItem{w2 + (size_t)e * DEXP * D, W2T + (size_t)e * D * DEXP, D, DEXP, 0, 64 * ((r - 512) / 32), 32 * ((r - 512) % 32)};
}
__device__ __forceinline__ void moe_convert(const float* w1, const float* w3, const float* w2, bf16* W13, bf16* W2T, LAS float* scr, int it0, int it1, int gw, int NGW, int lane) {
    for (int it = it0 + gw; it < it1; it += 2 * NGW) {
        const int it2 = it + NGW; const bool two = it2 < it1;
        const TrItem qa = moe_item(w1, w3, w2, W13, W2T, it), qb = moe_item(w1, w3, w2, W13, W2T, two ? it2 : it);
        float ta[32], tb[32];
        tr_load(qa, ta, lane); tr_load(qb, tb, lane);
        tr_store(qa, ta, scr, lane); if (two) tr_store(qb, tb, scr, lane);
    }
}
constexpr int MOE_ITEMS = NEXP * 768, IDLE_Q8 = 88, IDLE_Q9 = 56;
__device__ __forceinline__ void idle_convert(int which, unsigned char* ws, LAS unsigned char* lds, float* dout, int ntiles, int bid, int G, int wave, int lane) {
    const int U = ntiles * (D / 256), rem = U % G; if (rem == 0 || bid < rem) return;
    const int n_idle = G - rem, rank = bid - rem;
    int q8 = n_idle * IDLE_Q8; q8 = q8 < MOE_ITEMS ? q8 : MOE_ITEMS; int q9 = n_idle * IDLE_Q9; q9 = (q8 + q9) < MOE_ITEMS ? q9 : (MOE_ITEMS - q8);
    const int per = which == 0 ? IDLE_Q8 : IDLE_Q9, base = which == 0 ? 0 : q8, lim = which == 0 ? q8 : q8 + q9;
    int lo = base + rank * per, hi = lo + per; hi = hi < lim ? hi : lim;
    moe_convert(inp(lds, I_W1) + (size_t)NEXP * D * DEXP, inp(lds, I_W3) + (size_t)NEXP * D * DEXP, inp(lds, I_W2) + (size_t)NEXP * DEXP * D,
                (bf16*)dout, (bf16*)dout + (size_t)NEXP * D * D, (LAS float*)(lds + wave * 16384), lo, hi, wave, NWAVES, lane);
}
__device__ __forceinline__ int idle_done(int ntiles, int G) {
    const int U = ntiles * (D / 256), rem = U % G; if (rem == 0) return 0;
    const int n_idle = G - rem; int q = n_idle * (IDLE_Q8 + IDLE_Q9); return q < MOE_ITEMS ? q : MOE_ITEMS;
}
__device__ __forceinline__ int t5_bucket(int rel) {
    const int nb = 16, max_exact = 8; int ret = rel > 0 ? nb : 0; const int n = rel < 0 ? -rel : rel;
    const float lg = logf((float)(n < 1 ? 1 : n) / 8.0f) / 2.7725887f * 8.0f;
    int large = max_exact + (int)lg; large = large < nb - 1 ? large : nb - 1;
    return ret + (n < max_exact ? n : large);
}
__device__ __forceinline__ void p0_prologue(unsigned char* ws, LAS unsigned char* lds, int bid, int G, int tid, int wave, int lane) {
    LAS float* scr = (LAS float*)(lds + wave * 16384);
    const int gw = bid * NWAVES + wave, NGW = G * NWAVES;
    constexpr int I0 = 16 * 64, I1 = 16, I2 = 8 * 16, I3 = 16 * 32, I4 = 16 * 48, I5 = 16 * 32, NIT = I0 + I1 + I2 + I3 + I4 + I5;
    for (int it = gw; it < NIT; it += NGW) {
        int r = it;
        if (r < I0) { tr_item(inp(lds, I_ABWIN), AB_IN, (bf16*)(ws + WS_WIN), D, 0, scr, r, 64, lane); continue; } r -= I0;
        if (r < I1) { tr_item(inp(lds, I_ABWIN) + 2048, AB_IN, (bf16*)(ws + WS_WLR), D, 0, scr, r, 1, lane); continue; } r -= I1;
        if (r < I2) { tr_item(inp(lds, I_GLUW), 512, (bf16*)(ws + WS_WGLU), 512, 0, scr, r, 16, lane); continue; } r -= I2;
        if (r < I3) { tr_item(inp(lds, I_ABWOUT), D, (bf16*)(ws + WS_WOUT), D, 0, scr, r, 32, lane); continue; } r -= I3;
        if (r < I4) { tr_item(inp(lds, I_CWIN), CN, (bf16*)(ws + WS_CIN), D, 0, scr, r, 48, lane); continue; } r -= I4;
        tr_item(inp(lds, I_CWOUT), D, (bf16*)(ws + WS_COUT), D, 0, scr, r, 32, lane);
    }
    moe_convert(inp(lds, I_W1), inp(lds, I_W3), inp(lds, I_W2), (bf16*)(ws + WS_W13), (bf16*)(ws + WS_W2), scr, 0, MOE_ITEMS, gw, NGW, lane);
    { const float* x = inp(lds, I_X); bf16* xb = (bf16*)(ws + WS_X64);
      for (int m = gw; m < T; m += 2 * NGW) { const int m2 = m + NGW;
          const GAS f32x4* xr = (const GAS f32x4*)(x + (size_t)m * D) + lane; GAS u32x2* o = (GAS u32x2*)(xb + (size_t)m * D) + lane;
          const GAS f32x4* xr2 = (const GAS f32x4*)(x + (size_t)m2 * D) + lane; GAS u32x2* o2 = (GAS u32x2*)(xb + (size_t)m2 * D) + lane;
          f32x4 v[4], v2[4];
#pragma unroll
          for (int j = 0; j < 4; ++j) { v[j] = xr[64 * j]; if (m2 < T) v2[j] = xr2[64 * j]; }
#pragma unroll
          for (int j = 0; j < 4; ++j) { u32x2 w; w.x = pk2(v[j].x, v[j].y); w.y = pk2(v[j].z, v[j].w); o[64 * j] = w;
              if (m2 < T) { u32x2 w2; w2.x = pk2(v2[j].x, v2[j].y); w2.y = pk2(v2[j].z, v2[j].w); o2[64 * j] = w2; } } } }
    const int gt = bid * NTHR + tid, NGT = G * NTHR;
    { const float* lamre = inp(lds, I_LAMRE); const float* lamim = inp(lds, I_LAMIM); const float* logdt = inp(lds, I_LOGDT); const float* bre = inp(lds, I_BRE); const float* bim = inp(lds, I_BIM);
    for (int i = tid * G + bid; i < 2 * 32 * 64; i += NTHR * G) {
        const int p = i & 63, g = (i >> 6) & 31, dir = i >> 11;
        const double lr = fmin((double)lamre[i], -1e-4), li = (double)lamim[i], dt = exp((double)logdt[dir * 32 + g]);
        const double mag = exp(lr * dt), ar = mag * cos(li * dt), ai = mag * sin(li * dt), den = lr * lr + li * li, nr = ar - 1.0;
        const double cr = (nr * lr + ai * li) / den, ci = (ai * lr - nr * li) / den;
        double qr = ar, qi = ai;
#pragma unroll 1
        for (int s = 1; s < S5CH; s <<= 1) { const double t = qr * qr - qi * qi; qi = 2.0 * qr * qi; qr = t; }
        float* L4 = (float*)(ws + WS_S5L) + (size_t)i * 4; L4[0] = (float)ar; L4[1] = (float)ai; L4[2] = (float)qr; L4[3] = (float)qi;
        bf16* Bb = (bf16*)(ws + WS_S5B) + (size_t)(dir * 32 + g) * 2048;
#pragma unroll 4
        for (int c = 0; c < 16; ++c) { const double br = bre[(size_t)i * 16 + c], bi = bim[(size_t)i * 16 + c];
            Bb[p * 16 + c] = (bf16)f2bf((float)(cr * br - ci * bi)); Bb[1024 + p * 16 + c] = (bf16)f2bf((float)(cr * bi + ci * br)); }
    } }
    { const float* cre = inp(lds, I_CRE); const float* cim = inp(lds, I_CIM);
    for (int i = gt; i < 2 * 32 * 16 * 64; i += NGT) {
        const int p = i & 63, c = (i >> 6) & 15, dg = i >> 10;
        bf16* Cm = (bf16*)(ws + WS_S5C) + (size_t)dg * 2048 + c * 128 + 2 * p;
        Cm[0] = (bf16)f2bf(cre[i]); Cm[1] = (bf16)f2bf(-cim[i]);
    } }
    { const float* relb = inp(lds, I_RELB);
    for (int i = gt; i < 16 * 257; i += NGT) { const int h = i / 257, r = i % 257; ((float*)(ws + WS_BTAB))[h * 260 + r] = relb[t5_bucket(r - 128) * 16 + h] * LOG2E; } }
    { const float* wgrp = inp(lds, I_WGRP); const float* wrt = inp(lds, I_WRT);
    for (int i = gt; i < 2 * 48 * 1024; i += NGT) {
        const int k = i & 1023, n = (i >> 10) % 48, l = i / (48 * 1024);
        const float w = n < 4 ? wgrp[(size_t)l * D * 4 + k * 4 + n] : (n < 36 ? wrt[(size_t)l * D * 32 + k * 32 + (n - 4)] : 0.f);
        const unsigned hi = f2bf(w); const float lo = w - __uint_as_float(hi << 16);
        bf16* Wr = (bf16*)(ws + WS_WR) + (size_t)l * 2 * 48 * 1024; Wr[n * 1024 + k] = (bf16)hi; Wr[48 * 1024 + n * 1024 + k] = (bf16)f2bf(lo);
    } }
}

__device__ __forceinline__ void gate_tail(float* bcg, const float* gate_w, const float* gate_b, const LAS float* lrs, size_t row0, int tid);
__device__ __forceinline__ void lr_tail(unsigned char* ws, float* bcg, const float* gate_w, const float* gate_b, LAS unsigned char* lds, int bid, int G, int tid, int wave, int lane) {
    const bf16* xb = (const bf16*)(ws + WS_X64); const bf16* wl = (const bf16*)(ws + WS_WLR); LAS float* lrs = (LAS float*)lds;
    for (int rt = bid; rt < T / 128; rt += G) {
        const int r0 = rt * 128 + wave * 16;
        f32x4 acc0 = {0.f, 0.f, 0.f, 0.f}, acc1 = {0.f, 0.f, 0.f, 0.f};
        const bf16* ap = xb + (size_t)(r0 + (lane & 15)) * D + 8 * (lane >> 4);
        const bf16* bp = wl + (size_t)(lane & 15) * D + 8 * (lane >> 4);
#pragma unroll 8
        for (int ks = 0; ks < 32; ++ks) {
            const bf16x8 a = *(const bf16x8*)(ap + ks * 32), b0 = *(const bf16x8*)(bp + ks * 32), b1 = *(const bf16x8*)(bp + 16 * D + ks * 32);
            acc0 = __builtin_amdgcn_mfma_f32_16x16x32_bf16(a, b0, acc0, 0, 0, 0); acc1 = __builtin_amdgcn_mfma_f32_16x16x32_bf16(a, b1, acc1, 0, 0, 0);
        }
        __syncthreads();
#pragma unroll
        for (int r = 0; r < 4; ++r) { LAS float* o = lrs + (wave * 16 + 4 * (lane >> 4) + r) * 32 + (lane & 15); o[0] = acc0[r]; o[16] = acc1[r]; }
        __syncthreads();
        gate_tail(bcg, gate_w, gate_b, lrs, (size_t)rt * 128, tid);
    }
    __syncthreads();
}

__device__ __forceinline__ void gla_finalize(unsigned char* ws, const float* norm_g, int gw, int NGW, int lane) {
    const bf16* of = (const bf16*)(ws + WS_OF); const bf16* ob = (const bf16*)(ws + WS_OB); const bf16* h0 = (const bf16*)(ws + WS_H0); bf16* cc = (bf16*)(ws + WS_X64);
    const f32x4 g0 = *(const f32x4*)(norm_g + 8 * lane), g1 = *(const f32x4*)(norm_g + 8 * lane + 4);
    for (int m0 = gw; m0 < T; m0 += 4 * NGW) {
        u32x4 a[4], b[4], gq[4];
#pragma unroll
        for (int q = 0; q < 4; ++q) { const size_t m = (size_t)m0 + (size_t)q * NGW;
            a[q] = *(const u32x4*)(of + m * 512 + 8 * lane); b[q] = *(const u32x4*)(ob + m * 512 + 8 * lane); gq[q] = *(const u32x4*)(h0 + m * H0P + OFF_GO + 8 * lane); }
#pragma unroll
        for (int q = 0; q < 4; ++q) { const size_t m = (size_t)m0 + (size_t)q * NGW;
            f32x4 v0, v1;
            v0.x = bflo(a[q].x) + bflo(b[q].x); v0.y = bfhi(a[q].x) + bfhi(b[q].x); v0.z = bflo(a[q].y) + bflo(b[q].y); v0.w = bfhi(a[q].y) + bfhi(b[q].y);
            v1.x = bflo(a[q].z) + bflo(b[q].z); v1.y = bfhi(a[q].z) + bfhi(b[q].z); v1.z = bflo(a[q].w) + bflo(b[q].w); v1.w = bfhi(a[q].w) + bfhi(b[q].w);
            float ss = (v0.x * v0.x + v0.y * v0.y) + (v0.z * v0.z + v0.w * v0.w) + (v1.x * v1.x + v1.y * v1.y) + (v1.z * v1.z + v1.w * v1.w);
            ss += __shfl_xor(ss, 1); ss += __shfl_xor(ss, 2); ss += __shfl_xor(ss, 4); ss += __shfl_xor(ss, 8);
            const float rs = __builtin_amdgcn_rsqf(ss * (1.0f / 128.0f) + RMS_EPS);
            const float gv[8] = {bflo(gq[q].x), bfhi(gq[q].x), bflo(gq[q].y), bfhi(gq[q].y), bflo(gq[q].z), bfhi(gq[q].z), bflo(gq[q].w), bfhi(gq[q].w)};
            const float ov[8] = {v0.x * g0.x, v0.y * g0.y, v0.z * g0.z, v0.w * g0.w, v1.x * g1.x, v1.y * g1.y, v1.z * g1.z, v1.w * g1.w};
            float r[8];
#pragma unroll
            for (int i = 0; i < 8; ++i) r[i] = ov[i] * rs * (gv[i] * __builtin_amdgcn_rcpf(1.f + __expf(-gv[i])));
            u32x4 w; w.x = pk2(r[0], r[1]); w.y = pk2(r[2], r[3]); w.z = pk2(r[4], r[5]); w.w = pk2(r[6], r[7]);
            *(u32x4*)(cc + m * D + 512 + 8 * lane) = w; }
    }
}

constexpr int RT_AST = 2064;
template <bool RESID_F32, bool RD_LO, bool WR_LO>
__device__ __forceinline__ void ln_router(unsigned char* ws, const float* resid, const float* lng, const float* lnb, const float* bgrp, const float* brt, int layer, LAS unsigned char* lds, int bid, int G, int tid, int wave, int lane) {
    const bf16* yb = (const bf16*)(ws + WS_Z); bf16* hlo = (bf16*)(ws + WS_HLO); bf16* hb = (bf16*)(ws + WS_HHI);
    int* tok_e = (int*)(ws + WS_TOKE); float* tok_w = (float*)(ws + WS_TOKW);
    LAS unsigned char* Ahi = lds; LAS unsigned char* Alo = lds + 16 * RT_AST; LAS float* part = (LAS float*)(lds + 32 * RT_AST);
    LAS int* hist = (LAS int*)(lds + 32 * RT_AST + 8 * 16 * 48 * 4); LAS float* lgt = (LAS float*)(lds + 32 * RT_AST + 8 * 16 * 48 * 4 + 256);
    if (tid < 32) hist[tid] = 0;
    const bf16* Wr = (const bf16*)(ws + WS_WR) + (size_t)layer * 2 * 48 * 1024;
    bf16x8 Bh[3][4], Bl[3][4];
#pragma unroll
    for (int nt = 0; nt < 3; ++nt)
#pragma unroll
        for (int ks = 0; ks < 4; ++ks) { const size_t o = (size_t)(nt * 16 + (lane & 15)) * 1024 + wave * 128 + ks * 32 + 8 * (lane >> 4);
            Bh[nt][ks] = *(const bf16x8*)(Wr + o); Bl[nt][ks] = *(const bf16x8*)(Wr + 48 * 1024 + o); }
    f32x4 gv[4], bv[4];
#pragma unroll
    for (int j = 0; j < 4; ++j) { gv[j] = *(const f32x4*)(lng + 4 * lane + 256 * j); bv[j] = *(const f32x4*)(lnb + 4 * lane + 256 * j); }
    __syncthreads();
    for (int grp = bid; grp < T / 16; grp += G) {
#pragma unroll
        for (int rr = 0; rr < 2; ++rr) {
            const int row = 2 * wave + rr; const size_t m = (size_t)grp * 16 + row;
            const GAS f32x4* xr = (const GAS f32x4*)(resid + m * D) + lane; const GAS u32x2* yr = (const GAS u32x2*)(yb + m * D) + lane;
            const GAS u32x2* hr_ = (const GAS u32x2*)(hb + m * D) + lane; const GAS u32x2* lr_ = (const GAS u32x2*)(hlo + m * D) + lane;
            f32x4 v[4]; float s = 0.f;
#pragma unroll
            for (int j = 0; j < 4; ++j) { f32x4 x4; const u32x2 y2 = yr[64 * j];
                if (RESID_F32) x4 = xr[64 * j]; else if (RD_LO) { const u32x2 a = hr_[64 * j], b = lr_[64 * j]; x4.x = bflo(a.x) + bflo(b.x); x4.y = bfhi(a.x) + bfhi(b.x); x4.z = bflo(a.y) + bflo(b.y); x4.w = bfhi(a.y) + bfhi(b.y); }
                else { const u32x2 a = hr_[64 * j]; x4.x = bflo(a.x); x4.y = bfhi(a.x); x4.z = bflo(a.y); x4.w = bfhi(a.y); }
                v[j].x = x4.x * ALPHA + bflo(y2.x); v[j].y = x4.y * ALPHA + bfhi(y2.x); v[j].z = x4.z * ALPHA + bflo(y2.y); v[j].w = x4.w * ALPHA + bfhi(y2.y);
                s += (v[j].x + v[j].y) + (v[j].z + v[j].w); }
            const float mean = wave_sum(s) * (1.f / D); float s2 = 0.f;
#pragma unroll
            for (int j = 0; j < 4; ++j) { v[j] = v[j] - mean; s2 += (v[j].x * v[j].x + v[j].y * v[j].y) + (v[j].z * v[j].z + v[j].w * v[j].w); }
            const float rstd = 1.f / sqrtf(wave_sum(s2) * (1.f / D) + LN_EPS);
#pragma unroll
            for (int j = 0; j < 4; ++j) {
                const f32x4 h = v[j] * rstd * gv[j] + bv[j];
                const unsigned h0 = pk2(h.x, h.y), h1w = pk2(h.z, h.w);
                u32x2 w; w.x = h0; w.y = h1w; ((GAS u32x2*)(hb + m * D) + lane)[64 * j] = w;
                u32x2 lo; lo.x = pk2(h.x - bflo(h0), h.y - bfhi(h0)); lo.y = pk2(h.z - bflo(h1w), h.w - bfhi(h1w));
                if (WR_LO) ((GAS u32x2*)(hlo + m * D) + lane)[64 * j] = lo;
                *(LAS u32x2*)(Ahi + row * RT_AST + (4 * lane + 256 * j) * 2) = w; *(LAS u32x2*)(Alo + row * RT_AST + (4 * lane + 256 * j) * 2) = lo;
            }
        }
        LDS_BARRIER();
        f32x4 acc[3] = {{0.f, 0.f, 0.f, 0.f}, {0.f, 0.f, 0.f, 0.f}, {0.f, 0.f, 0.f, 0.f}};
#pragma unroll
        for (int ks = 0; ks < 4; ++ks) {
            const int bo = (lane & 15) * RT_AST + (wave * 128 + ks * 32 + 8 * (lane >> 4)) * 2;
            const bf16x8 ah = *(const LAS bf16x8*)(Ahi + bo), al = *(const LAS bf16x8*)(Alo + bo);
#pragma unroll
            for (int nt = 0; nt < 3; ++nt) {
                acc[nt] = __builtin_amdgcn_mfma_f32_16x16x32_bf16(ah, Bh[nt][ks], acc[nt], 0, 0, 0);
                acc[nt] = __builtin_amdgcn_mfma_f32_16x16x32_bf16(ah, Bl[nt][ks], acc[nt], 0, 0, 0);
                acc[nt] = __builtin_amdgcn_mfma_f32_16x16x32_bf16(al, Bh[nt][ks], acc[nt], 0, 0, 0);
            }
        }
#pragma unroll
        for (int nt = 0; nt < 3; ++nt)
#pragma unroll
            for (int r = 0; r < 4; ++r) part[(wave * 16 + 4 * (lane >> 4) + r) * 48 + nt * 16 + (lane & 15)] = acc[nt][r];
        LDS_BARRIER();
        { const int itn = (grp - bid) / G;
          for (int idx = tid; idx < 16 * 36; idx += NTHR) { const int tk = idx / 36, n = idx % 36; float s = 0.f;
#pragma unroll
            for (int w = 0; w < 8; ++w) s += part[(w * 16 + tk) * 48 + n];
            lgt[(itn * 16 + tk) * 36 + n] = s + (n < 4 ? bgrp[n] : brt[n - 4]); } }
    }
    LDS_BARRIER();
    for (int tk = tid; tk < 16 * ((T / 16 - bid + G - 1) / G); tk += NTHR) {
        const size_t m = ((size_t)bid + (size_t)(tk >> 4) * G) * 16 + (tk & 15);
        const LAS float* lg = lgt + tk * 36;
        int gi = 0; float gm = lg[0];
#pragma unroll
        for (int n = 1; n < 4; ++n) if (lg[n] > gm) { gm = lg[n]; gi = n; }
        float gs = 0.f;
#pragma unroll
        for (int n = 0; n < 4; ++n) gs += __expf(lg[n] - gm);
        const float pg = 1.f / gs;
        float el[8];
#pragma unroll
        for (int i = 0; i < 8; ++i) el[i] = lg[4 + gi * 8 + i];
        int i1 = 0; float m1 = el[0];
#pragma unroll
        for (int i = 1; i < 8; ++i) if (el[i] > m1) { m1 = el[i]; i1 = i; }
        int i2 = -1; float m2 = -3.0e38f;
#pragma unroll
        for (int i = 0; i < 8; ++i) if (i != i1 && el[i] > m2) { m2 = el[i]; i2 = i; }
        const float e2 = __expf(m2 - m1), inv = 1.f / (1.f + e2);
        const int ea = gi * 8 + i1, eb = gi * 8 + i2;
        tok_e[m * 2] = ea; tok_e[m * 2 + 1] = eb; tok_w[m * 2] = pg * inv; tok_w[m * 2 + 1] = pg * e2 * inv;
        atomicAdd((int*)&hist[ea], 1); atomicAdd((int*)&hist[eb], 1);
    }
    LDS_BARRIER();
    if (tid < 32) ((int*)(ws + WS_BLKC))[bid * 32 + tid] = hist[tid];
}

__device__ __forceinline__ void moe_sort(unsigned char* ws, LAS unsigned char* lds, int bid, int G, int tid) {
    const int* blkc = (const int*)(ws + WS_BLKC); const int* tok_e = (const int*)(ws + WS_TOKE); const float* tok_w = (const float*)(ws + WS_TOKW);
    int* tok_s = (int*)(ws + WS_TOKS); int* slot_t = (int*)(ws + WS_SLOTT); float* slot_w = (float*)(ws + WS_SLOTW); int* tile = (int*)(ws + WS_TILE);
    LAS int* ptot = (LAS int*)lds; LAS int* pbase = ptot + 512; LAS int* tot = pbase + 512; LAS int* base = tot + 32; LAS int* pstart = base + 32; LAS int* lcur = pstart + 33;
    { const int e = tid & 31, part = tid >> 5; int st = 0, sb = 0;
      for (int b = part; b < G; b += 16) { const int c = blkc[b * 32 + e]; st += c; sb += (b < bid) ? c : 0; }
      ptot[part * 32 + e] = st; pbase[part * 32 + e] = sb; }
    __syncthreads();
    if (tid < 32) { int st = 0, sb = 0;
#pragma unroll
        for (int p = 0; p < 16; ++p) { st += ptot[p * 32 + tid]; sb += pbase[p * 32 + tid]; }
        tot[tid] = st; base[tid] = sb; lcur[tid] = 0; }
    __syncthreads();
    if (tid == 0) { int acc = 0; for (int e = 0; e < 32; ++e) { pstart[e] = acc; acc += (tot[e] + 255) & ~255; } pstart[32] = acc; }
    __syncthreads();
    if (bid == 0) {
        const int nt = pstart[32] >> 8;
        if (tid == 0) tile[511] = nt;
        for (int t = tid; t < nt; t += NTHR) { int e = 0; for (int q = 1; q < 32; ++q) if ((t << 8) >= pstart[q]) e = q; tile[t] = e; }
    }
    for (int e = bid; e < 32; e += G)
        for (int s = pstart[e] + tot[e] + tid; s < pstart[e + 1]; s += NTHR) { slot_t[s] = 0; slot_w[s] = 0.f; }
    for (int grp = bid; grp < T / 16; grp += G) {
        if (tid < 32) { const size_t a = (size_t)grp * 32 + tid; const int e = tok_e[a]; const int rank = atomicAdd((int*)&lcur[e], 1);
            const int s = pstart[e] + base[e] + rank; slot_t[s] = (int)(a >> 1); slot_w[s] = tok_w[a]; tok_s[a] = s; }
    }
}

template <bool FINAL, bool RD_LO, bool WR_LO>
__device__ __forceinline__ void combine_ln(unsigned char* ws, const float* lng, const float* lnb, float* dout, int gw, int NGW, int lane) {
    bf16* hlo = (bf16*)(ws + WS_HLO); bf16* hhi = (bf16*)(ws + WS_HHI); const bf16* y2 = (const bf16*)(ws + WS_Y2); const int* tok_s = (const int*)(ws + WS_TOKS); const float* tok_w = (const float*)(ws + WS_TOKW);
    f32x4 gv[4], bv[4];
#pragma unroll
    for (int j = 0; j < 4; ++j) { gv[j] = *(const f32x4*)(lng + 4 * lane + 256 * j); bv[j] = *(const f32x4*)(lnb + 4 * lane + 256 * j); }
    for (int m = gw; m < T; m += NGW) {
        const int s0 = tok_s[(size_t)m * 2], s1 = tok_s[(size_t)m * 2 + 1]; const float w0 = tok_w[(size_t)m * 2], w1 = tok_w[(size_t)m * 2 + 1];
        GAS u32x2* hr = (GAS u32x2*)(hhi + (size_t)m * D) + lane; GAS u32x2* lr = (GAS u32x2*)(hlo + (size_t)m * D) + lane;
        const GAS u32x2* ya = (const GAS u32x2*)(y2 + (size_t)s0 * D) + lane; const GAS u32x2* yb = (const GAS u32x2*)(y2 + (size_t)s1 * D) + lane;
        f32x4 v[4]; float s = 0.f;
#pragma unroll
        for (int j = 0; j < 4; ++j) { const u32x2 hh_ = hr[64 * j]; f32x4 h; h.x = bflo(hh_.x); h.y = bfhi(hh_.x); h.z = bflo(hh_.y); h.w = bfhi(hh_.y);
            if (RD_LO) { const u32x2 hl_ = lr[64 * j]; h.x += bflo(hl_.x); h.y += bfhi(hl_.x); h.z += bflo(hl_.y); h.w += bfhi(hl_.y); }
            const u32x2 a = ya[64 * j], b = yb[64 * j];
            v[j].x = h.x * ALPHA + (w0 * bflo(a.x) + w1 * bflo(b.x)); v[j].y = h.y * ALPHA + (w0 * bfhi(a.x) + w1 * bfhi(b.x)); v[j].z = h.z * ALPHA + (w0 * bflo(a.y) + w1 * bflo(b.y)); v[j].w = h.w * ALPHA + (w0 * bfhi(a.y) + w1 * bfhi(b.y));
            s += (v[j].x + v[j].y) + (v[j].z + v[j].w); }
        const float mean = wave_sum(s) * (1.f / D); float s2 = 0.f;
#pragma unroll
        for (int j = 0; j < 4; ++j) { v[j] = v[j] - mean; s2 += (v[j].x * v[j].x + v[j].y * v[j].y) + (v[j].z * v[j].z + v[j].w * v[j].w); }
        const float rstd = 1.f / sqrtf(wave_sum(s2) * (1.f / D) + LN_EPS);
#pragma unroll
        for (int j = 0; j < 4; ++j) { const f32x4 h = v[j] * rstd * gv[j] + bv[j];
            if (FINAL) ((GAS f32x4*)(dout + (size_t)m * D) + lane)[64 * j] = h;
            else { u32x2 w; w.x = pk2(h.x, h.y); w.y = pk2(h.z, h.w); hr[64 * j] = w;
                   if (WR_LO) { u32x2 lo; lo.x = pk2(h.x - bflo(w.x), h.y - bfhi(w.x)); lo.y = pk2(h.z - bflo(w.y), h.w - bfhi(w.y)); lr[64 * j] = lo; } } }
    }
}
constexpr int S5_HST = 272, S5_UST = 272, S5_UOFF = 8 * 32 * S5_HST;
#define MFMA32(a, b, c) __builtin_amdgcn_mfma_f32_32x32x16_bf16((a), (b), (c), 0, 0, 0)
#define MFMA16(a, b, c) __builtin_amdgcn_mfma_f32_16x16x32_bf16((a), (b), (c), 0, 0, 0)
__device__ __forceinline__ float gelu_tanh(float x) {
    const float u = 0.7978845608028654f * (x + 0.044715f * x * x * x);
    const float e = __expf(2.f * u); const float th = 1.f - 2.f * __builtin_amdgcn_rcpf(e + 1.f);
    return 0.5f * x * (1.f + th);
}
#define S5_SCALAR_FMA 1
#define S5_PERMLANE 1
#define S5_NO_NOPS 1
#ifdef S5_SCALAR_FMA
__device__ __forceinline__ float sfma(float a, float b, float c) { float d; asm("v_fma_f32 %0, %1, %2, %3" : "=v"(d) : "v"(a), "v"(b), "v"(c)); return d; }
#define FMAF(a, b, c) sfma((a), (b), (c))
#else
#define FMAF(a, b, c) fmaf((a), (b), (c))
#endif
__device__ __forceinline__ f32x4 ld_ys(const float* p) {
    f32x4 v;
    v.x = __hip_atomic_load(p, __ATOMIC_RELAXED, __HIP_MEMORY_SCOPE_AGENT); v.y = __hip_atomic_load(p + 1, __ATOMIC_RELAXED, __HIP_MEMORY_SCOPE_AGENT);
    v.z = __hip_atomic_load(p + 2, __ATOMIC_RELAXED, __HIP_MEMORY_SCOPE_AGENT); v.w = __hip_atomic_load(p + 3, __ATOMIC_RELAXED, __HIP_MEMORY_SCOPE_AGENT);
    return v;
}
constexpr int CW_CHKA = 64, CW_CHKB = 65, CW_CHKC = 66, CW_CHKD = 67;
template <int PASS, int DIR, bool CHK = false>
__device__ __forceinline__ void s5_dir(unsigned char* ws, const float* s5d, int b, int g, int c, LAS unsigned char* hl, const LAS unsigned char* ul, float* yscr, int lane) {
    const bf16* h0 = (const bf16*)(ws + WS_H0);
    const int dg = DIR * 32 + g;
    const f32x4 L4 = *(const f32x4*)((const float*)(ws + WS_S5L) + (size_t)(dg * 64 + lane) * 4);
    const float ar = L4.x, ai = L4.y, qr = L4.z, qi = L4.w;
    const float l2r = ar * ar - ai * ai, l2i = 2.f * ar * ai, l4r = l2r * l2r - l2i * l2i, l4i = 2.f * l2r * l2i, l8r = l4r * l4r - l4i * l4i, l8i = 2.f * l4r * l4i;
    const float l16r = l8r * l8r - l8i * l8i, l16i = 2.f * l8r * l8i, l32r = l16r * l16r - l16i * l16i, l32i = 2.f * l16r * l16i;
    const bf16* Bb = (const bf16*)(ws + WS_S5B) + (size_t)dg * 2048 + (lane & 31) * 16 + 8 * (lane >> 5);
    const bf16x8 bre0 = *(const bf16x8*)Bb, bre1 = *(const bf16x8*)(Bb + 512), bim0 = *(const bf16x8*)(Bb + 1024), bim1 = *(const bf16x8*)(Bb + 1536);
    bf16x8 cf[4]; bf16x8 dfrag;
    if (PASS == 2) {
        const bf16* Cm = (const bf16*)(ws + WS_S5C) + (size_t)dg * 2048 + (lane & 15) * 128 + 8 * (lane >> 4);
#pragma unroll
        for (int ks = 0; ks < 4; ++ks) cf[ks] = *(const bf16x8*)(Cm + 32 * ks);
        if (DIR == 1) {
            const int cc = lane & 15, kq = lane >> 4; const float d = s5d[g * 16 + cc]; const unsigned dh = f2bf(d); const unsigned dl = f2bf(d - __uint_as_float(dh << 16));
#pragma unroll
            for (int j = 0; j < 8; ++j) { const int k = 8 * (kq & 1) + j; dfrag[j] = (short)((k == cc) ? (kq < 2 ? dh : dl) : 0u); }
        }
    }
    float hr = 0.f, hi = 0.f;
    float* Ec = (float*)(ws + WS_S5E) + ((size_t)((DIR * NB + b) * 32 + g) * S5NCH) * 128 + 2 * lane;
    if (PASS == 2) {
        const int nj = DIR == 0 ? c : (S5NCH - 1 - c);
        for (int j0 = 0; j0 < nj; j0 += 32) {
            f32x2 e[32];
#pragma unroll
            for (int q = 0; q < 32; ++q) { const int j = (j0 + q) < nj ? (j0 + q) : (nj - 1); const int jj = DIR == 0 ? j : (S5NCH - 1 - j); e[q] = *(const f32x2*)(Ec + (size_t)jj * 128); }
#pragma unroll
            for (int q = 0; q < 32; ++q) if (j0 + q < nj) { const float nr = FMAF(qr, hr, FMAF(-qi, hi, e[q].x)); hi = FMAF(qr, hi, FMAF(qi, hr, e[q].y)); hr = nr; }
        }
    }
    const size_t rowbase = (size_t)b * SEQ + (size_t)c * S5CH;
    const LAS unsigned char* up = ul + (lane & 31) * S5_UST + (g & 7) * 32 + 16 * (lane >> 5);
    const f32x16 zero16 = {0.f, 0.f, 0.f, 0.f, 0.f, 0.f, 0.f, 0.f, 0.f, 0.f, 0.f, 0.f, 0.f, 0.f, 0.f, 0.f};
#pragma unroll 1
    for (int ti = 0; ti < S5CH / 32; ++ti) {
        const int tile = DIR == 0 ? ti : (S5CH / 32 - 1 - ti);
        const bf16x8 a = *(const LAS bf16x8*)(up + tile * 32 * S5_UST);
        f32x4 ysv[2] = {{0.f, 0.f, 0.f, 0.f}, {0.f, 0.f, 0.f, 0.f}};
        if (PASS == 2 && DIR == 1) { ysv[0] = ld_ys(yscr + (size_t)(tile * 2) * 256 + 4 * lane); ysv[1] = ld_ys(yscr + (size_t)(tile * 2 + 1) * 256 + 4 * lane); }
        f32x16 xr0 = MFMA32(a, bre0, zero16), xr1 = MFMA32(a, bre1, zero16), xi0 = MFMA32(a, bim0, zero16), xi1 = MFMA32(a, bim1, zero16);
        asm volatile("" : "+v"(xr0), "+v"(xr1), "+v"(xi0), "+v"(xi1) : "v"(a));
#define S5_KEEP_A 1
#ifdef S5_SLEEP
        __builtin_amdgcn_sched_barrier(0); __builtin_amdgcn_s_sleep(16); __builtin_amdgcn_sched_barrier(0);
#endif
#if (defined(S5_PERMLANE) && !defined(S5_NO_NOPS)) || defined(S5_NOPS)
        __builtin_amdgcn_sched_barrier(0);
        asm volatile("s_nop 15\n\ts_nop 15\n\ts_nop 15\n\ts_nop 15\n\ts_nop 15\n\ts_nop 15" ::: "memory");
        __builtin_amdgcn_sched_barrier(0);
#endif
        float xr[32], xi[32];
#pragma unroll
        for (int r = 0; r < 16; ++r) {
#ifdef S5_PERMLANE
            auto s = __builtin_amdgcn_permlane32_swap(__float_as_uint(xr0[r]), __float_as_uint(xr1[r]), false, false);
            xr[crow(r, 0)] = __uint_as_float(s[0]); xr[crow(r, 1)] = __uint_as_float(s[1]);
            auto q = __builtin_amdgcn_permlane32_swap(__float_as_uint(xi0[r]), __float_as_uint(xi1[r]), false, false);
            xi[crow(r, 0)] = __uint_as_float(q[0]); xi[crow(r, 1)] = __uint_as_float(q[1]);
#else
            const bool up = lane >= 32; const int pa = (lane ^ 32) << 2;
            { const float sr = up ? xr0[r] : xr1[r], rr_ = __int_as_float(__builtin_amdgcn_ds_bpermute(pa, __float_as_int(sr)));
              xr[crow(r, 0)] = up ? rr_ : xr0[r]; xr[crow(r, 1)] = up ? xr1[r] : rr_; }
            { const float si = up ? xi0[r] : xi1[r], ri_ = __int_as_float(__builtin_amdgcn_ds_bpermute(pa, __float_as_int(si)));
              xi[crow(r, 0)] = up ? ri_ : xi0[r]; xi[crow(r, 1)] = up ? xi1[r] : ri_; }
#endif
        }
#ifdef S5_CHECK_X
        if (PASS == 1) { unsigned cs = 0u;
#pragma unroll
            for (int t = 0; t < 32; ++t) cs ^= (__float_as_uint(xr[t]) * (2u * t + 1u)) ^ (__float_as_uint(xi[t]) * (2u * t + 65u));
            unsigned* cw = (unsigned*)(ws + WS_OF) + ((size_t)((b * S5NCH + c) * 32 + g) * 2 + DIR) * 512 + tile * 64 + lane;
            if (CHK) { if (*cw != cs) atomicAdd((unsigned*)(ws + WS_CTL) + CW_CHKD, 1u); } else *cw = cs; }
#endif
#ifdef S5_KEEP_A
        asm volatile("" : "+v"(xi[31]), "+v"(xr[31]) : "v"(a));
#endif
        if (PASS == 1) {
#pragma unroll
            for (int lv = 0; lv < 5; ++lv) {
                const float pr = lv == 0 ? ar : lv == 1 ? l2r : lv == 2 ? l4r : lv == 3 ? l8r : l16r, pi = lv == 0 ? ai : lv == 1 ? l2i : lv == 2 ? l4i : lv == 3 ? l8i : l16i;
#pragma unroll
                for (int i = 0; i < (16 >> lv); ++i) {
                    const int e = DIR == 0 ? 2 * i : 2 * i + 1, l = DIR == 0 ? 2 * i + 1 : 2 * i;
                    const float er = xr[e << lv], ei = xi[e << lv], lr_ = xr[l << lv], li_ = xi[l << lv];
                    const float wr = FMAF(pr, er, FMAF(-pi, ei, lr_)), wi = FMAF(pr, ei, FMAF(pi, er, li_));
                    xr[(2 * i) << lv] = wr; xi[(2 * i) << lv] = wi;
                }
            }
            { const float nr = FMAF(l32r, hr, FMAF(-l32i, hi, xr[0])), ni = FMAF(l32r, hi, FMAF(l32i, hr, xi[0])); hr = nr; hi = ni; }
        } else {
#pragma unroll
        for (int tt = 0; tt < 32; ++tt) {
            const int t = DIR == 0 ? tt : 31 - tt;
            const float tr_ = FMAF(-ai, hi, xr[t]), ti_ = FMAF(ai, hr, xi[t]);
            hr = FMAF(ar, hr, tr_); hi = FMAF(ar, hi, ti_);
            *(LAS unsigned*)(hl + t * S5_HST + 4 * lane) = pk2(hr, hi);
        }
        }
        if (PASS == 2) {
#pragma unroll
            for (int sub = 0; sub < 2; ++sub) {
                float* ys = yscr + (size_t)(tile * 2 + sub) * 256 + 4 * lane;
                f32x4 y = {0.f, 0.f, 0.f, 0.f};
                if (DIR == 1) y = ysv[sub];
                bf16x8 hf[4];
#pragma unroll
                for (int ks = 0; ks < 4; ++ks) hf[ks] = *(const LAS bf16x8*)(hl + (sub * 16 + (lane & 15)) * S5_HST + 64 * ks + 16 * (lane >> 4));
#pragma unroll
                for (int ks = 0; ks < 4; ++ks) y = MFMA16(hf[ks], cf[ks], y);
                if (DIR == 0) { *(f32x4*)ys = y; __builtin_amdgcn_sched_barrier(0); asm volatile("" :: "v"(hf[0]), "v"(hf[1]), "v"(hf[2]), "v"(hf[3])); }
                else {
                    const bf16x8 uf = *(const LAS bf16x8*)(ul + (tile * 32 + sub * 16 + (lane & 15)) * S5_UST + (g & 7) * 32 + 16 * ((lane >> 4) & 1));
                    y = MFMA16(uf, dfrag, y);
                    bf16* yo = (bf16*)(ws + WS_YG) + (rowbase + tile * 32 + sub * 16 + 4 * (lane >> 4)) * 512 + g * 16 + (lane & 15);
#pragma unroll
                    for (int r = 0; r < 4; ++r) { const bf16 nv = (bf16)f2bf(gelu_tanh(y[r]));
                        if (CHK) { if (yo[(size_t)r * 512] != nv) atomicAdd((unsigned*)(ws + WS_CTL) + CW_CHKB, 1u); } else yo[(size_t)r * 512] = nv; }
                    __builtin_amdgcn_sched_barrier(0); asm volatile("" :: "v"(hf[0]), "v"(hf[1]), "v"(hf[2]), "v"(hf[3]), "v"(uf));
                }
            }
        }
    }
    if (PASS == 1) { f32x2 e; e.x = hr; e.y = hi;
        if (CHK) { const f32x2 o = *(const f32x2*)(Ec + (size_t)c * 128);
#ifndef S5_NO_EC
            if (__float_as_uint(o.x) != __float_as_uint(e.x) || __float_as_uint(o.y) != __float_as_uint(e.y)) {
                const float dn = fabsf(o.x - e.x) + fabsf(o.y - e.y), mg = fabsf(o.x) + fabsf(o.y) + fabsf(e.x) + fabsf(e.y);
                atomicAdd((unsigned*)(ws + WS_CTL) + (dn > 1e-3f * mg ? CW_CHKD : CW_CHKA), 1u); }
#endif
        }
        else *(f32x2*)(Ec + (size_t)c * 128) = e; }
}
template <int PASS, bool CHK = false>
__device__ __forceinline__ void s5_phase(unsigned char* ws, const float* s5d, LAS unsigned char* lds, int bid, int G, int tid, int wave, int lane) {
    LAS unsigned char* hl = lds + wave * (32 * S5_HST); LAS unsigned char* ul = lds + S5_UOFF;
    float* yscr = (float*)(ws + WS_YSCR) + (size_t)(bid * NWAVES + wave) * 4096;
    const bf16* h0 = (const bf16*)(ws + WS_H0);
    for (int it = bid; it < NB * S5NCH * 4; it += G) {
        const int go = it & 3, c = (it >> 2) % S5NCH, b = it / (4 * S5NCH), g = go * 8 + wave;
        { const bf16* src = h0 + ((size_t)b * SEQ + (size_t)c * S5CH) * H0P + OFF_U + go * 128;
          u32x4 v[8];
#pragma unroll
          for (int i = 0; i < 8; ++i) { const int p = i * NTHR + tid; v[i] = *(const u32x4*)(src + (size_t)(p >> 4) * H0P + 8 * (p & 15)); }
#ifdef S5_CHECK_IN
          { unsigned cs = 0u;
#pragma unroll
            for (int i = 0; i < 8; ++i) cs ^= v[i].x ^ (v[i].y * 3u) ^ (v[i].z * 5u) ^ (v[i].w * 7u);
            unsigned* cw = (unsigned*)(ws + WS_LR) + (size_t)(PASS - 1) * 512 * 512 + (size_t)it * 512 + tid;
            if (CHK) { if (*cw != cs) atomicAdd((unsigned*)(ws + WS_CTL) + CW_CHKC, 1u); } else *cw = cs; }
#endif
          __syncthreads();
#pragma unroll
          for (int i = 0; i < 8; ++i) { const int p = i * NTHR + tid; *(LAS u32x4*)(ul + (p >> 4) * S5_UST + 16 * (p & 15)) = v[i]; }
          __syncthreads(); }
#ifdef S5_SERIAL
        if (wave < 4) { s5_dir<PASS, 0, CHK>(ws, s5d, b, g, c, hl, ul, yscr, lane); s5_dir<PASS, 1, CHK>(ws, s5d, b, g, c, hl, ul, yscr, lane); }
        LDS_BARRIER();
        if (wave >= 4) { s5_dir<PASS, 0, CHK>(ws, s5d, b, g, c, hl, ul, yscr, lane); s5_dir<PASS, 1, CHK>(ws, s5d, b, g, c, hl, ul, yscr, lane); }
#else
        s5_dir<PASS, 0, CHK>(ws, s5d, b, g, c, hl, ul, yscr, lane);
        s5_dir<PASS, 1, CHK>(ws, s5d, b, g, c, hl, ul, yscr, lane);
#endif
    }
}
constexpr int G_ST = 144;
constexpr int GL_QD = 0, GL_KD = GL_QD + 64 * G_ST, GL_KCT = GL_KD + 64 * G_ST, GL_VT = GL_KCT + 64 * G_ST, GL_IMG = GL_VT + 128 * G_ST,
              GL_S = 2 * GL_IMG, GL_ST = GL_S + 64 * G_ST, GL_END = GL_ST + 2 * 128 * G_ST;
static_assert(GL_END <= MISC_OFF, "GLA LDS");
__device__ __forceinline__ bf16x8 ldfrag32(const LAS unsigned char* base, int row0, int ks, int lane) {
    return *(const LAS bf16x8*)(base + (row0 + (lane & 31)) * G_ST + 32 * ks + 16 * (lane >> 5));
}
__device__ __forceinline__ void gate_tail(float* bcg, const float* gate_w, const float* gate_b, const LAS float* lrs, size_t row0, int tid) {
    const int dir = tid >> 8;
    float gw[16];
#pragma unroll
    for (int r = 0; r < 16; ++r) gw[r] = gate_w[(size_t)(dir * 16 + r) * 256 + (tid & 255)];
    const float gb = gate_b[tid];
    float run = 0.f;
#pragma unroll 4
    for (int i = 0; i < 128; ++i) {
        const int t = dir ? 127 - i : i;
        if ((i & 63) == 0) run = 0.f;
        const LAS f32x4* lp = (const LAS f32x4*)(lrs + t * 32 + dir * 16);
        const f32x4 l0 = lp[0], l1 = lp[1], l2 = lp[2], l3 = lp[3];
        float z = gb + l0.x * gw[0] + l0.y * gw[1] + l0.z * gw[2] + l0.w * gw[3] + l1.x * gw[4] + l1.y * gw[5] + l1.z * gw[6] + l1.w * gw[7]
                     + l2.x * gw[8] + l2.y * gw[9] + l2.z * gw[10] + l2.w * gw[11] + l3.x * gw[12] + l3.y * gw[13] + l3.z * gw[14] + l3.w * gw[15];
        const float ls = fminf(z, 0.f) - __logf(1.f + __expf(-fabsf(z)));
        run += ls * (1.0f / 16.0f);
        bcg[(row0 + t) * 512 + tid] = run;
    }
}
__device__ __forceinline__ size_t gla_tok(int b, int dir, int chunk, int s) { const int pos = chunk * GCH + s; return (size_t)b * SEQ + (dir ? (SEQ - 1 - pos) : pos); }
template <int PASS>
__device__ __forceinline__ void gla_item(unsigned char* ws, const float* bcg, int item, LAS unsigned char* lds, int tid, int wave, int lane) {
    const int sc = item % GNSC, dir = (item / GNSC) & 1, h = (item / (GNSC * 2)) & 3, b = item / (GNSC * 8);
    const bf16* h0 = (const bf16*)(ws + WS_H0);
    LAS unsigned char* QD = lds + GL_QD; LAS unsigned char* KD = lds + GL_KD; LAS unsigned char* KCT = lds + GL_KCT; LAS unsigned char* VT = lds + GL_VT; LAS unsigned char* SS = lds + GL_S; LAS unsigned char* STT = lds + GL_ST;
    const int me = wave >> 1, nd = wave & 1;
    f32x16 st;
#pragma unroll
    for (int r = 0; r < 16; ++r) st[r] = 0.f;
    float dtot = 1.f;
    float* GS = (float*)(ws + WS_GS); float* GD = (float*)(ws + WS_GD);
    const int ibase = item - sc;
    if (PASS == 2) {
        for (int j0 = 0; j0 < sc; j0 += 4) {
            float dj[4], gv[4][16];
#pragma unroll
            for (int q = 0; q < 4; ++q) { const int j = (j0 + q) < sc ? (j0 + q) : (sc - 1);
                dj[q] = GD[(size_t)(ibase + j) * 64 + nd * 32 + (lane & 31)];
                const float* gs = GS + (size_t)(ibase + j) * 8192 + nd * 32 + (lane & 31);
#pragma unroll
                for (int r = 0; r < 16; ++r) gv[q][r] = gs[(size_t)(me * 32 + crow(r, lane >> 5)) * 64]; }
#pragma unroll
            for (int q = 0; q < 4; ++q) if (j0 + q < sc) {
#pragma unroll
                for (int r = 0; r < 16; ++r) st[r] = st[r] * dj[q] + gv[q][r]; }
        }
#pragma unroll
        for (int r = 0; r < 16; ++r) *(LAS bf16*)(STT + (me * 32 + crow(r, lane >> 5)) * G_ST + (nd * 32 + (lane & 31)) * 2) = (bf16)f2bf(st[r]);
    }
    const float qscale = 0.125f;
    const int s_l = lane;
    const int gcol = dir * 256 + h * 64;
    u32x4 pq, pk, pv0, pv1; f32x4 pb0, pb1, pl0, pl1; float pdec;
#define GLA_LOAD(n) do { const int ch_ = sc * GSC + (n); const size_t tk = gla_tok(b, dir, ch_, s_l), tl = gla_tok(b, dir, ch_, 63); const bf16* rp = h0 + tk * H0P; \
        if (PASS == 2) pq = *(const u32x4*)(rp + OFF_Q + h * 64 + 8 * wave); \
        pk = *(const u32x4*)(rp + OFF_K + h * 64 + 8 * wave); pv0 = *(const u32x4*)(rp + OFF_V + h * 128 + 16 * wave); pv1 = *(const u32x4*)(rp + OFF_V + h * 128 + 16 * wave + 8); \
        pb0 = *(const f32x4*)(bcg + tk * 512 + gcol + 8 * wave); pb1 = *(const f32x4*)(bcg + tk * 512 + gcol + 8 * wave + 4); \
        pl0 = *(const f32x4*)(bcg + tl * 512 + gcol + 8 * wave); pl1 = *(const f32x4*)(bcg + tl * 512 + gcol + 8 * wave + 4); \
        pdec = bcg[tl * 512 + gcol + nd * 32 + (lane & 31)]; } while (0)
#define GLA_STEP_A(IMG) do { LAS unsigned char* QD_ = (IMG) + GL_QD; LAS unsigned char* KD_ = (IMG) + GL_KD; LAS unsigned char* KCT_ = (IMG) + GL_KCT; LAS unsigned char* VT_ = (IMG) + GL_VT; \
        const float bc[8] = {pb0.x, pb0.y, pb0.z, pb0.w, pb1.x, pb1.y, pb1.z, pb1.w}, bl[8] = {pl0.x, pl0.y, pl0.z, pl0.w, pl1.x, pl1.y, pl1.z, pl1.w}; \
        const float kv[8] = {bflo(pk.x), bfhi(pk.x), bflo(pk.y), bfhi(pk.y), bflo(pk.z), bfhi(pk.z), bflo(pk.w), bfhi(pk.w)}; \
        if (PASS == 2) { const float qv[8] = {bflo(pq.x), bfhi(pq.x), bflo(pq.y), bfhi(pq.y), bflo(pq.z), bfhi(pq.z), bflo(pq.w), bfhi(pq.w)}; float qd[8], kd[8]; \
            _Pragma("unroll") for (int i = 0; i < 8; ++i) { qd[i] = qv[i] * qscale * __expf(bc[i]); kd[i] = kv[i] * __expf(-bc[i]); } \
            u32x4 w; w.x = pk2(qd[0], qd[1]); w.y = pk2(qd[2], qd[3]); w.z = pk2(qd[4], qd[5]); w.w = pk2(qd[6], qd[7]); *(LAS u32x4*)(QD_ + s_l * G_ST + 16 * wave) = w; \
            w.x = pk2(kd[0], kd[1]); w.y = pk2(kd[2], kd[3]); w.z = pk2(kd[4], kd[5]); w.w = pk2(kd[6], kd[7]); *(LAS u32x4*)(KD_ + s_l * G_ST + 16 * wave) = w; } \
        _Pragma("unroll") for (int i = 0; i < 8; ++i) *(LAS bf16*)(KCT_ + (8 * wave + i) * G_ST + 2 * s_l) = (bf16)f2bf(kv[i] * __expf(bl[i] - bc[i])); \
        const unsigned vv[8] = {pv0.x, pv0.y, pv0.z, pv0.w, pv1.x, pv1.y, pv1.z, pv1.w}; \
        _Pragma("unroll") for (int i = 0; i < 8; ++i) { *(LAS bf16*)(VT_ + (16 * wave + 2 * i) * G_ST + 2 * s_l) = (bf16)(vv[i] & 0xffffu); *(LAS bf16*)(VT_ + (16 * wave + 2 * i + 1) * G_ST + 2 * s_l) = (bf16)(vv[i] >> 16); } \
        dec_n = __expf(pdec); } while (0)
#define GLA_STEP_B(IMG, STW, WRITE_ST) do { LAS unsigned char* QD_ = (IMG) + GL_QD; LAS unsigned char* KD_ = (IMG) + GL_KD; LAS unsigned char* KCT_ = (IMG) + GL_KCT; LAS unsigned char* VT_ = (IMG) + GL_VT; \
        if (PASS == 2 && wave < 4) { const int ms = wave >> 1, ns = wave & 1; f32x16 sa; \
            _Pragma("unroll") for (int r = 0; r < 16; ++r) sa[r] = 0.f; \
            if (ns <= ms) { _Pragma("unroll") for (int ks = 0; ks < 4; ++ks) sa = MFMA32(ldfrag32(QD_, ms * 32, ks, lane), ldfrag32(KD_, ns * 32, ks, lane), sa); } \
            _Pragma("unroll") for (int r = 0; r < 16; ++r) { const int s = ms * 32 + crow(r, lane >> 5), s2 = ns * 32 + (lane & 31); const bool keep = dir ? (s2 < s) : (s2 <= s); \
                *(LAS bf16*)(SS + s * G_ST + 2 * s2) = (bf16)f2bf(keep ? sa[r] : 0.f); } } \
        _Pragma("unroll") for (int r = 0; r < 16; ++r) st[r] *= dec_c; \
        dtot *= dec_c; \
        _Pragma("unroll") for (int ks = 0; ks < 4; ++ks) st = MFMA32(ldfrag32(VT_, me * 32, ks, lane), ldfrag32(KCT_, nd * 32, ks, lane), st); \
        if (PASS == 2 && (WRITE_ST)) { _Pragma("unroll") for (int r = 0; r < 16; ++r) *(LAS bf16*)((STW) + (me * 32 + crow(r, lane >> 5)) * G_ST + (nd * 32 + (lane & 31)) * 2) = (bf16)f2bf(st[r]); } } while (0)
    float dec_n = 1.f, dec_c = 1.f;
    LAS unsigned char* IMG0 = lds; LAS unsigned char* IMG1 = lds + GL_IMG;
    GLA_LOAD(0);
    __syncthreads();
    GLA_STEP_A(IMG0); dec_c = dec_n;
    if (1 < GSC) GLA_LOAD(1);
    LDS_BARRIER();
    if (PASS == 2) { GLA_STEP_B(IMG0, STT + 128 * G_ST, true); LDS_BARRIER(); }
#pragma unroll 1
    for (int n = 0; n < GSC; ++n) {
        LAS unsigned char* Ic = (n & 1) ? IMG1 : IMG0; LAS unsigned char* In = (n & 1) ? IMG0 : IMG1;
        LAS unsigned char* STc = STT + (n & 1) * (128 * G_ST);
        if (PASS == 2) {
            const int ms = wave >> 2, ne = wave & 3;
            f32x16 oa;
#pragma unroll
            for (int r = 0; r < 16; ++r) oa[r] = 0.f;
#pragma unroll
            for (int ks = 0; ks < 4; ++ks) oa = MFMA32(ldfrag32(SS, ms * 32, ks, lane), ldfrag32(Ic + GL_VT, ne * 32, ks, lane), oa);
#pragma unroll
            for (int ks = 0; ks < 4; ++ks) oa = MFMA32(ldfrag32(Ic + GL_QD, ms * 32, ks, lane), ldfrag32(STc, ne * 32, ks, lane), oa);
            bf16* op = (bf16*)(ws + (dir ? WS_OB : WS_OF)) + h * 128 + ne * 32 + (lane & 31);
#pragma unroll
            for (int r = 0; r < 16; ++r) op[gla_tok(b, dir, sc * GSC + n, ms * 32 + crow(r, lane >> 5)) * 512] = (bf16)f2bf(oa[r]);
        } else {
            GLA_STEP_B(Ic, STT, false);
        }
        if (n + 1 < GSC) { GLA_STEP_A(In); if (n + 2 < GSC) GLA_LOAD(n + 2); }
        LDS_BARRIER();
        if (PASS == 2 && n + 1 < GSC) { dec_c = dec_n; GLA_STEP_B(In, STT + (n & 1) * (128 * G_ST), n + 2 < GSC); LDS_BARRIER(); }
        if (PASS == 1) dec_c = dec_n;
    }
#undef GLA_STEP_A
#undef GLA_STEP_B
    if (PASS == 1) {
        float* gs = GS + (size_t)item * 8192 + nd * 32 + (lane & 31);
#pragma unroll
        for (int r = 0; r < 16; ++r) gs[(size_t)(me * 32 + crow(r, lane >> 5)) * 64] = st[r];
        if (me == 0 && lane < 32) GD[(size_t)item * 64 + nd * 32 + lane] = dtot;
    }
    __syncthreads();
#undef GLA_LOAD
}
constexpr int AT_KST = 144, AT_VST = 664, AT_K = 0, AT_V = 320 * AT_KST, AT_BT = AT_V + 64 * AT_VST, AT_END = AT_BT + 16 * 260 * 4;
static_assert(AT_END <= RING_BYTES && AT_V % 16 == 0 && AT_BT % 16 == 0, "attention LDS");
__device__ __forceinline__ void attn_phase(unsigned char* ws, const float* sink, LAS unsigned char* lds, int bid, int G, int tid, int wave, int lane) {
    const bf16* qkv = (const bf16*)(ws + WS_QKV); bf16* ao = (bf16*)(ws + WS_AO); const float* btab = (const float*)(ws + WS_BTAB);
    LAS unsigned char* KS = lds + AT_K; LAS unsigned char* VT = lds + AT_V; LAS float* BT = (LAS float*)(lds + AT_BT);
    const float sc2 = 0.125f * LOG2E;
    u32x4 kreg[5], vreg[5]; bf16x8 qreg[4]; float sreg;
    for (int p = tid; p < 16 * 260; p += NTHR) BT[p] = btab[p];
#define AT_LOAD(u_) do { const int qb_ = (u_) % (SEQ / 64), kvh_ = ((u_) / (SEQ / 64)) & 3, b_ = (u_) / (4 * (SEQ / 64)), kb_ = qb_ * 64 - 128; \
        _Pragma("unroll") for (int it = 0; it < 5; ++it) { const int p = it * NTHR + tid; int key = kb_ + (p >> 3); key = key < 0 ? 0 : (key > SEQ - 1 ? SEQ - 1 : key); \
            const bf16* rp = qkv + ((size_t)b_ * SEQ + key) * CN + kvh_ * 64 + 8 * (p & 7); kreg[it] = *(const u32x4*)(rp + 1024); vreg[it] = *(const u32x4*)(rp + 1280); } \
        { const int hq_ = kvh_ * 4 + (wave >> 1); const bf16* qp_ = qkv + ((size_t)b_ * SEQ + qb_ * 64 + 32 * (wave & 1) + (lane & 31)) * CN + hq_ * 64 + 8 * (lane >> 5); \
          _Pragma("unroll") for (int ks = 0; ks < 4; ++ks) qreg[ks] = *(const bf16x8*)(qp_ + 16 * ks); sreg = sink[hq_]; } } while (0)
    if (bid < NB * 4 * (SEQ / 64)) AT_LOAD(bid);
    for (int u = bid; u < NB * 4 * (SEQ / 64); u += G) {
        const int qb = u % (SEQ / 64), kvh = (u / (SEQ / 64)) & 3, b = u / (4 * (SEQ / 64)), q0 = qb * 64;
#pragma unroll
        for (int it = 0; it < 5; ++it) { const int p = it * NTHR + tid, i = p >> 3, ch = p & 7;
            *(LAS u32x4*)(KS + i * AT_KST + 16 * ch) = kreg[it];
            const unsigned vv[4] = {vreg[it].x, vreg[it].y, vreg[it].z, vreg[it].w};
#pragma unroll
            for (int j = 0; j < 4; ++j) { *(LAS bf16*)(VT + (8 * ch + 2 * j) * AT_VST + 2 * i) = (bf16)(vv[j] & 0xffffu); *(LAS bf16*)(VT + (8 * ch + 2 * j + 1) * AT_VST + 2 * i) = (bf16)(vv[j] >> 16); } }
        const bf16x8 qf[4] = {qreg[0], qreg[1], qreg[2], qreg[3]}; const float m0 = sreg * LOG2E;
        if (u + G < NB * 4 * (SEQ / 64)) AT_LOAD(u + G);
        LDS_BARRIER();
        const int hl = wave >> 1, hq = kvh * 4 + hl, qw = q0 + 32 * (wave & 1), qi = qw + (lane & 31), hh = lane >> 5;
        float m = m0, l = hh == 0 ? 1.f : 0.f;
        f32x16 o0, o1;
#pragma unroll
        for (int r = 0; r < 16; ++r) { o0[r] = 0.f; o1[r] = 0.f; }
        const LAS float* btl = BT + hq * 260 + 128 - (lane & 31);
        const bool edge = (q0 < 128) || (q0 + 192 > SEQ);
#pragma unroll 1
        for (int j = 0; j < 9; ++j) {
            const int i0 = 32 * (wave & 1) + 32 * j;
            f32x16 sa;
#pragma unroll
            for (int r = 0; r < 16; ++r) sa[r] = 0.f;
#pragma unroll
            for (int ks = 0; ks < 4; ++ks) { const bf16x8 kf = *(const LAS bf16x8*)(KS + (i0 + (lane & 31)) * AT_KST + 32 * ks + 16 * hh); sa = MFMA32(kf, qf[ks], sa); }
            float mx = -3.0e38f;
#pragma unroll
            for (int r = 0; r < 16; ++r) {
                const int kk = 32 * j - 128 + crow(r, hh);
                sa[r] = sa[r] * sc2 + btl[kk];
            }
            if (edge || j == 0 || j == 8) {
#pragma unroll
                for (int r = 0; r < 16; ++r) {
                    const int kk = 32 * j - 128 + crow(r, hh), rel = kk - (lane & 31), key = qw + kk;
                    const bool ok = ((unsigned)(rel + 128) <= 256u) && ((unsigned)key < (unsigned)SEQ);
                    sa[r] = ok ? sa[r] : -3.0e38f;
                }
            }
#pragma unroll
            for (int r = 0; r < 16; ++r) mx = fmaxf(mx, sa[r]);
            mx = fmaxf(mx, __shfl_xor(mx, 32));
            if (!__all(mx <= m)) {
                const float mn = fmaxf(m, mx), alpha = __builtin_amdgcn_exp2f(m - mn); m = mn; l *= alpha;
#pragma unroll
                for (int r = 0; r < 16; ++r) { o0[r] *= alpha; o1[r] *= alpha; }
            }
            float ps = 0.f;
#pragma unroll
            for (int r = 0; r < 16; ++r) { const float p = __builtin_amdgcn_exp2f(sa[r] - m); sa[r] = p; ps += p; }
            l += ps;
#pragma unroll
            for (int s = 0; s < 2; ++s) {
                u32x4 pw; pw.x = pk2(sa[8 * s], sa[8 * s + 1]); pw.y = pk2(sa[8 * s + 2], sa[8 * s + 3]); pw.z = pk2(sa[8 * s + 4], sa[8 * s + 5]); pw.w = pk2(sa[8 * s + 6], sa[8 * s + 7]);
                const bf16x8 pf = __builtin_bit_cast(bf16x8, pw);
#pragma unroll
                for (int dt = 0; dt < 2; ++dt) {
                    const LAS unsigned char* vp = VT + (dt * 32 + (lane & 31)) * AT_VST + 2 * (i0 + 16 * s + 4 * hh);
                    const bf16x4 va = *(const LAS bf16x4*)vp, vb = *(const LAS bf16x4*)(vp + 16);
                    const bf16x8 vf = __builtin_shufflevector(va, vb, 0, 1, 2, 3, 4, 5, 6, 7);
                    if (dt == 0) o0 = MFMA32(vf, pf, o0); else o1 = MFMA32(vf, pf, o1);
                }
            }
        }
        l += __shfl_xor(l, 32);
        const float inv = __builtin_amdgcn_rcpf(l);
        bf16* op = ao + ((size_t)b * SEQ + qi) * D + hq * 64 + 4 * hh;
#pragma unroll
        for (int g = 0; g < 4; ++g) {
            u32x2 w0, w1; w0.x = pk2(o0[4 * g] * inv, o0[4 * g + 1] * inv); w0.y = pk2(o0[4 * g + 2] * inv, o0[4 * g + 3] * inv);
            w1.x = pk2(o1[4 * g] * inv, o1[4 * g + 1] * inv); w1.y = pk2(o1[4 * g + 2] * inv, o1[4 * g + 3] * inv);
            *(u32x2*)(op + 8 * g) = w0; *(u32x2*)(op + 32 + 8 * g) = w1;
        }
        LDS_BARRIER();
    }
#undef AT_LOAD
}
#ifndef MK_N_LAUNCHES
#define MK_N_LAUNCHES 1
#endif
constexpr int N_PHASES = 19;
#ifndef KEEP_LO1
#define KEEP_LO1 false
#endif
#ifndef KEEP_LO2
#define KEEP_LO2 false
#endif
#ifndef KEEP_LO3
#define KEEP_LO3 false
#endif
#ifndef PH_MASK
#define PH_MASK 0xFFFFFFFFu
#endif
#define ON(k) (((PH_MASK) >> (k)) & 1u)
#ifndef REP_MASK
#define REP_MASK 0u
#endif
#define NREP(k) ((((REP_MASK) >> (k)) & 1u) ? 2 : 1)

template <int LAYER>
__device__ __forceinline__ void common_phases(unsigned char* ws, LAS unsigned char* lds, float* dout, const XcdBarrier& bar, int lo, int hi, int bid, int G, int tid, int wave, int lane) {
    constexpr int pb = LAYER == 0 ? 5 : 13;
    const int gw = bid * NWAVES + wave, NGW = G * NWAVES;
#define IN(k) (lo <= (k) && (k) < hi)
#define SEAM(k) do { if (IN(k) && IN((k) + 1)) xcd_barrier(bar); } while (0)
    if (ON(5) && IN(pb)) {
        pg8::Gemm g{(const bf16*)(ws + (LAYER == 0 ? WS_X64 : WS_AO)), (const bf16*)(ws + (LAYER == 0 ? WS_WOUT : WS_COUT)), T, D, D, 0, nullptr}; pg8::StaticOrder S; S.init(T, D, G, bid);
        pg8::EpiBf16 E{(bf16*)(ws + WS_Z), D};
        pg8::gemm_phase<pg8::EpiBf16, pg8::StaticOrder, false>(lds, g, S, E);
    }
    SEAM(pb);
    if (ON(6) && IN(pb + 1)) { ln_router<LAYER == 0, KEEP_LO2, (LAYER == 0 ? KEEP_LO1 : KEEP_LO3)>(ws, inp(lds, I_X), inp(lds, I_LNMG) + LAYER * D, inp(lds, I_LNMB) + LAYER * D, inp(lds, I_BGRP) + LAYER * 4, inp(lds, I_BRT) + LAYER * 32, LAYER, lds, bid, G, tid, wave, lane); __syncthreads(); }
    SEAM(pb + 1);
    if (ON(7) && IN(pb + 2)) { moe_sort(ws, lds, bid, G, tid); __syncthreads(); }
    SEAM(pb + 2);
    if (ON(8) && IN(pb + 3)) {
        const int* tile = (const int*)(ws + WS_TILE); const int ntiles = __builtin_amdgcn_readfirstlane(tile[511]);
        pg8::Gemm g{(const bf16*)(ws + WS_HHI), LAYER == 0 ? (const bf16*)(ws + WS_W13) : (const bf16*)dout, 0, D, D, (size_t)D * D * 2, (const int*)(ws + WS_SLOTT)};
        pg8::GroupOrder S{tile, ntiles, D / 256, G, bid};
        pg8::EpiSwiglu E{(bf16*)(ws + WS_HID), DEXP};
        pg8::gemm_phase<pg8::EpiSwiglu, pg8::GroupOrder, true>(lds, g, S, E);
        if (LAYER == 0) idle_convert(0, ws, lds, dout, ntiles, bid, G, wave, lane);
    }
    SEAM(pb + 3);
    if (ON(9) && IN(pb + 4)) {
        const int* tile = (const int*)(ws + WS_TILE); const int ntiles = __builtin_amdgcn_readfirstlane(tile[511]);
        pg8::Gemm g{(const bf16*)(ws + WS_HID), LAYER == 0 ? (const bf16*)(ws + WS_W2) : (const bf16*)dout + (size_t)NEXP * D * D, 0, D, DEXP, (size_t)D * DEXP * 2, nullptr};
        pg8::GroupOrder S{tile, ntiles, D / 256, G, bid};
        pg8::EpiBf16 E{(bf16*)(ws + WS_Y2), D};
        pg8::gemm_phase<pg8::EpiBf16, pg8::GroupOrder, false>(lds, g, S, E);
        if (LAYER == 0) idle_convert(1, ws, lds, dout, ntiles, bid, G, wave, lane);
    }
    SEAM(pb + 4);
    if (ON(10) && IN(pb + 5)) {
        if (LAYER == 0) {
            combine_ln<false, KEEP_LO1, KEEP_LO2>(ws, inp(lds, I_LNFG), inp(lds, I_LNFB), nullptr, gw, NGW, lane);
            { const int done = idle_done(__builtin_amdgcn_readfirstlane(((const int*)(ws + WS_TILE))[511]), G);
              moe_convert(inp(lds, I_W1) + (size_t)NEXP * D * DEXP, inp(lds, I_W3) + (size_t)NEXP * D * DEXP, inp(lds, I_W2) + (size_t)NEXP * DEXP * D, (bf16*)dout, (bf16*)dout + (size_t)NEXP * D * D, (LAS float*)(lds + wave * 16384), done, MOE_ITEMS, gw, NGW, lane); }
            __syncthreads();
        } else combine_ln<true, KEEP_LO3, false>(ws, inp(lds, I_LNFG) + D, inp(lds, I_LNFB) + D, dout, gw, NGW, lane);
    }
    if (LAYER == 0) SEAM(10);
#undef IN
#undef SEAM
}

struct Args { const float* in[N_IN]; float* out; unsigned char* ws; int ph_lo, ph_hi; };
static_assert(sizeof(Args) == N_IN * 8 + 8 + 8 + 8, "no padding holes in Args");

__global__ void __launch_bounds__(NTHR, 2) fwd_kernel(Args args) {
    extern __shared__ __attribute__((aligned(16))) unsigned char lds_raw[];
    LAS unsigned char* lds = (LAS unsigned char*)lds_raw;
    volatile LAS unsigned* MISC = (volatile LAS unsigned*)(lds + MISC_OFF);
    const int tid = threadIdx.x, lane = tid & 63, wave = __builtin_amdgcn_readfirstlane(tid >> 6), G = gridDim.x, bid = blockIdx.x;
    unsigned char* ws = args.ws;
    for (int u = tid; u < 64; u += NTHR) MISC[u] = 0u;
    if (tid < N_IN) *(LAS unsigned long long*)(lds + PTR_OFF + 8 * tid) = (unsigned long long)args.in[tid];
    __syncthreads();
    const int lo = args.ph_lo, hi = args.ph_hi;
    const bool use_bar = (hi - lo) > 1;
    XcdBarrier bar; bar.bar = (unsigned*)(ws + WS_CTL) + CW_BAR; bar.x = 0; bar.st = nullptr;
    if (use_bar) bar = xcd_barrier_post((unsigned*)(ws + WS_CTL) + CW_BAR, MISC + 8);
#define IN(k) (lo <= (k) && (k) < hi)
#define SEAM(k) do { if (IN(k) && IN((k) + 1)) xcd_barrier(bar); } while (0)
    const int gw = bid * NWAVES + wave, NGW = G * NWAVES;

    if (ON(0) && IN(0)) { p0_prologue(ws, lds, bid, G, tid, wave, lane); __syncthreads(); }
    SEAM(0);
    if (ON(1) && IN(1)) {
        pg8::Gemm g{(const bf16*)(ws + WS_X64), (const bf16*)(ws + WS_WIN), T, ABN, D, 0, nullptr}; pg8::SplitOrder S; S.init(T, ABN, 2, G, bid);
        pg8::EpiBf16 E{(bf16*)(ws + WS_H0), H0P};
        pg8::gemm_phase<pg8::EpiBf16, pg8::SplitOrder, false>(lds, g, S, E);
        lr_tail(ws, args.out, inp(lds, I_GATEW), inp(lds, I_GATEB), lds, bid, G, tid, wave, lane);
#ifdef TAIL_TWICE
        lr_tail(ws, args.out, inp(lds, I_GATEW), inp(lds, I_GATEB), lds, bid, G, tid, wave, lane);
#endif
    }
    SEAM(1);
    if (ON(2) && IN(2)) {
        s5_phase<1>(ws, inp(lds, I_S5D), lds, bid, G, tid, wave, lane);
#ifdef S5_TWICE
        __syncthreads(); s5_phase<1>(ws, inp(lds, I_S5D), lds, bid, G, tid, wave, lane);
#endif
#ifdef S5_CHECK
        VM_WAIT(); __syncthreads(); s5_phase<1, true>(ws, inp(lds, I_S5D), lds, bid, G, tid, wave, lane);
#endif
        __syncthreads();
        for (int it = bid; it < 256; it += G) gla_item<1>(ws, args.out, it, lds, tid, wave, lane);
#ifdef GLA_TWICE
        for (int it = bid; it < 256; it += G) gla_item<1>(ws, args.out, it, lds, tid, wave, lane);
#endif
    }
    SEAM(2);
    if (ON(3) && IN(3)) {
        s5_phase<2>(ws, inp(lds, I_S5D), lds, bid, G, tid, wave, lane);
#ifdef S5_TWICE
        __syncthreads(); s5_phase<2>(ws, inp(lds, I_S5D), lds, bid, G, tid, wave, lane);
#endif
#ifdef S5_CHECK2
        VM_WAIT(); __syncthreads(); s5_phase<2, true>(ws, inp(lds, I_S5D), lds, bid, G, tid, wave, lane);
#endif
        __syncthreads();
        for (int it = bid; it < 256; it += G) gla_item<2>(ws, args.out, it, lds, tid, wave, lane);
#ifdef GLA_TWICE
        for (int it = bid; it < 256; it += G) gla_item<2>(ws, args.out, it, lds, tid, wave, lane);
#endif
    }
    SEAM(3);
    if (ON(4) && IN(4)) {
        gla_finalize(ws, inp(lds, I_NORMG), gw, NGW, lane);
        pg8::Gemm g{(const bf16*)(ws + WS_YG), (const bf16*)(ws + WS_WGLU), T, 512, 512, 0, nullptr}; pg8::StaticOrder S; S.init(T, 512, G, bid);
        pg8::EpiGlu E{(const bf16*)(ws + WS_YG), 512, (bf16*)(ws + WS_X64), D, inp(lds, I_GLUB)};
        pg8::gemm_phase<pg8::EpiGlu, pg8::StaticOrder, false>(lds, g, S, E);
    }
    SEAM(4);
    common_phases<0>(ws, lds, args.out, bar, lo, hi, bid, G, tid, wave, lane);
    if (ON(11) && IN(11)) {
        pg8::Gemm g{(const bf16*)(ws + WS_H2B), (const bf16*)(ws + WS_CIN), T, CN, D, 0, nullptr}; pg8::StaticOrder S; S.init(T, CN, G, bid);
        pg8::EpiBf16 E{(bf16*)(ws + WS_QKV), CN};
        pg8::gemm_phase<pg8::EpiBf16, pg8::StaticOrder, false>(lds, g, S, E);
    }
    SEAM(11);
    if (ON(12) && IN(12)) attn_phase(ws, inp(lds, I_SINK), lds, bid, G, tid, wave, lane);
    SEAM(12);
    common_phases<1>(ws, lds, args.out, bar, lo, hi, bid, G, tid, wave, lane);
#if defined(S5_CHECK) || defined(S5_CHECK2) || defined(GLA_CHECK) || defined(ATT_CHECK)
    if (IN(18)) { VM_WAIT(); __syncthreads();
        if (bid == 0 && tid == 0) { unsigned* cw = (unsigned*)(ws + WS_CTL);
            const unsigned ca = __hip_atomic_load(cw + CW_CHKA, __ATOMIC_RELAXED, __HIP_MEMORY_SCOPE_AGENT), cb = __hip_atomic_load(cw + CW_CHKB, __ATOMIC_RELAXED, __HIP_MEMORY_SCOPE_AGENT);
            const unsigned cc = __hip_atomic_load(cw + CW_CHKC, __ATOMIC_RELAXED, __HIP_MEMORY_SCOPE_AGENT), cd = __hip_atomic_load(cw + CW_CHKD, __ATOMIC_RELAXED, __HIP_MEMORY_SCOPE_AGENT);
            if (ca) args.out[0] = 600.f; if (cb) args.out[1] = 60000.f;
            if (cc) args.out[2] = 1.0e36f; if (cd) args.out[3] = 6000.f; } }
#endif
#undef IN
#undef SEAM
}

#ifdef DET_PROBE
__global__ void cs_kernel(const unsigned char* base, int nrows, int rowbytes, size_t pitch, const int* ntile_ptr, unsigned* acc) {
    if (ntile_ptr) { const int r = ntile_ptr[511] * 256; nrows = r < nrows ? r : nrows; }
    unsigned s = 0u; const int wpr = rowbytes >> 2;
    for (int r = blockIdx.x; r < nrows; r += gridDim.x) { const unsigned* row = (const unsigned*)(base + (size_t)r * pitch);
        for (int c = threadIdx.x; c < wpr; c += blockDim.x) s += row[c] * (2u * (unsigned)(r * 131 + c) + 1u); }
    for (int o = 1; o < 64; o <<= 1) s += __shfl_xor(s, o);
    if ((threadIdx.x & 63) == 0) atomicAdd(acc, s);
}
__global__ void flag_kernel(const unsigned* acc, float* out) {
    const int k = threadIdx.x; if (k >= 19) return;
    const float ex[19] = {0.f, 0.f, 1600.f, 400.f, 0.f, 0.f, 0.f, 3200.f, 0.f, 0.f, 800.f, 0.f, 0.f, 0.f, 0.f, 0.f, 0.f, 0.f, 0.f};
    if (ex[k] > 0.f && acc[2 * k] != acc[2 * k + 1]) out[k] = ex[k];
}
#endif
extern "C" void kernel_launch(void* const* d_in, const int* in_sizes, int n_in, void* d_out, int out_size, void* d_ws, size_t ws_size, hipStream_t stream) {
    static int grid = 0;
    if (grid == 0) {
        if (n_in != N_IN || in_sizes[0] != T * D || out_size != T * D || ws_size < WS_END) { fprintf(stderr, "kernel_launch: unexpected shapes (n_in %d, in0 %d, out %d, ws %zu < %zu)\n", n_in, n_in > 0 ? in_sizes[0] : -1, out_size, ws_size, (size_t)WS_END); grid = -1; return; }
        int dev = 0, cus = 0, per_cu = 0;
        if (hipGetDevice(&dev) != hipSuccess || hipDeviceGetAttribute(&cus, hipDeviceAttributeMultiprocessorCount, dev) != hipSuccess) { grid = -1; return; }
        if (hipFuncSetAttribute((const void*)fwd_kernel, hipFuncAttributeMaxDynamicSharedMemorySize, LDS_BYTES) != hipSuccess) { fprintf(stderr, "kernel_launch: hipFuncSetAttribute failed\n"); grid = -1; return; }
        if (hipOccupancyMaxActiveBlocksPerMultiprocessor(&per_cu, (const void*)fwd_kernel, NTHR, LDS_BYTES) != hipSuccess || per_cu < 1) fprintf(stderr, "kernel_launch: occupancy query reports %d\n", per_cu);
        (void)hipGetLastError();
        grid = cus;
    }
    if (grid < 0) return;
    if (hipMemsetAsync((char*)d_ws + WS_CTL, 0, CTL_ZERO_BYTES, stream) != hipSuccess) return;
    Args a{};
    for (int i = 0; i < N_IN; ++i) a.in[i] = (const float*)d_in[i];
    a.out = (float*)d_out; a.ws = (unsigned char*)d_ws;
#ifdef DET_PROBE
    { unsigned char* ws = (unsigned char*)d_ws; unsigned* accb = (unsigned*)(ws + WS_CTL) + 128; const int* tl = (const int*)(ws + WS_TILE);
      auto CS = [&](int k, int rep, const void* b, int nrows, int rowbytes, size_t pitch, const int* ntp) { hipLaunchKernelGGL(cs_kernel, dim3(1024), dim3(256), 0, stream, (const unsigned char*)b, nrows, rowbytes, pitch, ntp, accb + 2 * k + rep); };
      for (int li = 0; li < N_PHASES; ++li) {
        a.ph_lo = li; a.ph_hi = li + 1;
        const bool probe = (li >= 1 && li <= 6) || li == 8 || li == 9 || li == 11 || li == 12 || li == 13 || li == 16 || li == 17 || li == 18;
        for (int rep = 0; rep < (probe ? 2 : 1); ++rep) {
            hipLaunchKernelGGL(fwd_kernel, dim3(grid), dim3(NTHR), LDS_BYTES, stream, a);
            if (!probe) continue;
            switch (li) {
            case 1: CS(li, rep, ws + WS_H0, T, 4096, (size_t)H0P * 2, nullptr); CS(li, rep, d_out, T, 2048, 2048, nullptr); break;
            case 2: CS(li, rep, ws + WS_S5E, 4096, 1024, 1024, nullptr); CS(10, rep, ws + WS_OF, 16384, 1024, 1024, nullptr); CS(7, rep, ws + WS_GS, 8192, 1024, 1024, nullptr); CS(7, rep, ws + WS_GD, 64, 1024, 1024, nullptr); break;
            case 3: CS(li, rep, ws + WS_YG, T, 1024, 1024, nullptr); break;
            case 4: CS(li, rep, ws + WS_X64, T, 2048, 2048, nullptr); break;
            case 5: case 13: CS(li, rep, ws + WS_Z, T, 2048, 2048, nullptr); break;
            case 6: CS(li, rep, ws + WS_HHI, T, 2048, 2048, nullptr); CS(li, rep, ws + WS_TOKE, 256, 1024, 1024, nullptr); CS(li, rep, ws + WS_TOKW, 256, 1024, 1024, nullptr); break;
            case 8: case 16: CS(li, rep, ws + WS_HID, CAP, 1024, 1024, tl); break;
            case 9: case 17: CS(li, rep, ws + WS_Y2, CAP, 2048, 2048, tl); break;
            case 11: CS(li, rep, ws + WS_QKV, T, 3072, 3072, nullptr); break;
            case 12: CS(li, rep, ws + WS_AO, T, 2048, 2048, nullptr); break;
            case 18: CS(li, rep, d_out, T, 4096, 4096, nullptr); break;
            } } }
      hipLaunchKernelGGL(flag_kernel, dim3(1), dim3(64), 0, stream, (const unsigned*)accb, (float*)d_out);
      return; }
#endif
    for (int li = 0; li < MK_N_LAUNCHES; ++li) {
        a.ph_lo = (MK_N_LAUNCHES == 1) ? 0 : li; a.ph_hi = (MK_N_LAUNCHES == 1) ? N_PHASES : li + 1;
        for (int rep = 0; rep < ((MK_N_LAUNCHES > 1 && ((REP_MASK >> li) & 1u)) ? 2 : 1); ++rep)
            hipLaunchKernelGGL(fwd_kernel, dim3(grid), dim3(NTHR), LDS_BYTES, stream, a);
    }
}
```

```cpp
#include <hip/hip_runtime.h>
#include <cstdio>
#include <cstdint>
#include <cmath>
namespace pg8 {
#define PG8_LAS __attribute__((address_space(3)))
typedef unsigned short bf16_t;
typedef short bf16x8 __attribute__((ext_vector_type(8)));
typedef float f32x4 __attribute__((ext_vector_type(4)));
typedef float f32x2 __attribute__((ext_vector_type(2)));
typedef unsigned u32x4 __attribute__((ext_vector_type(4)));
typedef unsigned u32x2 __attribute__((ext_vector_type(2)));
constexpr int BM = 256, BK = 64, HALF = 128, HTB = HALF * BK * 2  , STAGE_BYTES = 8 * HTB, NXCD = 8, WGM = 8;

__host__ __device__ __forceinline__ int lds_byte(int r, int c) { const int st = (r >> 4) * 2 + (c >> 5), rr = r & 15, cc = c & 31, ob = rr * 64 + cc * 2; return st * 1024 + (ob ^ (((ob >> 9) & 1) << 5)); }
__host__ __device__ __forceinline__ void stage_rc(int b, int& R, int& C) { const int st = b / 1024, sb = b % 1024, swz = sb ^ (((sb >> 9) & 1) << 5); R = (st >> 1) * 16 + swz / 64; C = (st & 1) * 32 + (swz % 64) / 2; }
__host__ __device__ __forceinline__ int perm32(int rho) { const int n = rho >> 4, i = rho & 15; return 8 * (i >> 2) + 4 * n + (i & 3); }

struct Unit { int pm, pn, e, ui; };
struct Gemm { const bf16_t* A; const bf16_t* Bt; int M, N, K; size_t bstride; const int* rowmap; };

struct StaticOrder {
    int nM, nN, nwg, G, c;
    __host__ __device__ void init(int M, int N, int G_, int c_) { nM = M / BM; nN = N / BM; nwg = nM * nN; G = G_; c = c_; }
    __host__ __device__ bool next(int i, Unit& u) const {
        const long L = (long)i * G + c; if (L >= nwg) return false;
        int wgid = (int)L; { const int q = nwg / NXCD, r = nwg % NXCD, xcd = wgid % NXCD, off = wgid / NXCD; wgid = (xcd < r ? xcd * (q + 1) : r * (q + 1) + (xcd - r) * q) + off; }
        const int nig = WGM * nN, gid = wgid / nig, fm = gid * WGM, gsz = (nM - fm) < WGM ? (nM - fm) : WGM;
        u.pm = fm + ((wgid % nig) % gsz); u.pn = (wgid % nig) / gsz; u.e = 0; u.ui = i; return true;
    }
};
struct SplitOrder {
    int nM, nNs, nwgs, nsp, G, c;
    __host__ __device__ void init(int M, int N, int nsp_, int G_, int c_) { nM = M / BM; nNs = N / BM / nsp_; nwgs = nM * nNs; nsp = nsp_; G = G_; c = c_; }
    __host__ __device__ bool next(int i, Unit& u) const {
        const long L = (long)i * G + c; if (L >= (long)nwgs * nsp) return false;
        const int slab = (int)(L / nwgs); int wgid = (int)(L % nwgs);
        { const int q = nwgs / NXCD, r = nwgs % NXCD, xcd = wgid % NXCD, off = wgid / NXCD; wgid = (xcd < r ? xcd * (q + 1) : r * (q + 1) + (xcd - r) * q) + off; }
        const int nig = WGM * nNs, gid = wgid / nig, fm = gid * WGM, gsz = (nM - fm) < WGM ? (nM - fm) : WGM;
        u.pm = fm + ((wgid % nig) % gsz); u.pn = slab * nNs + (wgid % nig) / gsz; u.e = 0; u.ui = i; return true;
    }
};
struct GroupOrder {
    const int* tile_e; int ntiles, nN, G, c;
    __device__ bool next(int i, Unit& u) const {
        const int L = i * G + c; if (L >= ntiles * nN) return false;
        u.pm = L / nN; u.pn = L % nN; u.e = __builtin_amdgcn_readfirstlane(tile_e[u.pm]); u.ui = i; return true;
    }
};

typedef __bf16 bf16x2_t __attribute__((ext_vector_type(2)));
__device__ __forceinline__ unsigned cvt_pk_bf16(float lo, float hi) { f32x2 v = {lo, hi}; return __builtin_bit_cast(unsigned, __builtin_convertvector(v, bf16x2_t)); }
__device__ __forceinline__ float bf_lo(unsigned w) { return __uint_as_float(w << 16); }
__device__ __forceinline__ float bf_hi(unsigned w) { return __uint_as_float(w & 0xffff0000u); }

struct EpiBf16 {
    static constexpr bool PERM = true;
    bf16_t* O; int ldc;
    __device__ __forceinline__ void operator()(const f32x4 (&acc)[2][2][4][2], const Unit& u, int wr, int wc, int fr, int fq) const {
        const int row0 = u.pm * BM + wr * 64 + fr; const int col0 = u.pn * BM + wc * 32 + 8 * fq;
#pragma unroll
        for (int ai = 0; ai < 2; ++ai)
#pragma unroll
            for (int m = 0; m < 4; ++m) { bf16_t* rowp = O + (size_t)(row0 + ai * HALF + m * 16) * ldc + col0;
#pragma unroll
                for (int bj = 0; bj < 2; ++bj) { const f32x4 v0 = acc[ai][bj][m][0], v1 = acc[ai][bj][m][1];
                    u32x4 w; w.x = cvt_pk_bf16(v0[0], v0[1]); w.y = cvt_pk_bf16(v0[2], v0[3]); w.z = cvt_pk_bf16(v1[0], v1[1]); w.w = cvt_pk_bf16(v1[2], v1[3]);
                    *(u32x4*)(rowp + bj * HALF) = w; } }
    }
};
struct EpiGlu {
    static constexpr bool PERM = true;
    const bf16_t* Y; int ldy; bf16_t* O; int ldc; const float* bias;
    __device__ __forceinline__ void operator()(const f32x4 (&acc)[2][2][4][2], const Unit& u, int wr, int wc, int fr, int fq) const {
        const int row0 = u.pm * BM + wr * 64 + fr; const int col0 = u.pn * BM + wc * 32 + 8 * fq;
        f32x4 bv[2][2];
#pragma unroll
        for (int bj = 0; bj < 2; ++bj)
#pragma unroll
            for (int n = 0; n < 2; ++n) bv[bj][n] = *(const f32x4*)(bias + col0 + bj * HALF + 4 * n);
#pragma unroll
        for (int ai = 0; ai < 2; ++ai) {
            u32x4 yq[4][2];
#pragma unroll
            for (int m = 0; m < 4; ++m)
#pragma unroll
                for (int bj = 0; bj < 2; ++bj) yq[m][bj] = *(const u32x4*)(Y + (size_t)(row0 + ai * HALF + m * 16) * ldy + col0 + bj * HALF);
            asm volatile("" ::: "memory");
#pragma unroll
            for (int m = 0; m < 4; ++m) { const size_t r = (size_t)(row0 + ai * HALF + m * 16);
#pragma unroll
                for (int bj = 0; bj < 2; ++bj) { const f32x4 v0 = acc[ai][bj][m][0] + bv[bj][0], v1 = acc[ai][bj][m][1] + bv[bj][1];
                    const u32x4 y = yq[m][bj];
                    float o[8]; const float yv[8] = {bf_lo(y.x), bf_hi(y.x), bf_lo(y.y), bf_hi(y.y), bf_lo(y.z), bf_hi(y.z), bf_lo(y.w), bf_hi(y.w)};
#pragma unroll
                    for (int i = 0; i < 4; ++i) { o[i] = yv[i] * __builtin_amdgcn_rcpf(1.f + __expf(-v0[i])); o[4 + i] = yv[4 + i] * __builtin_amdgcn_rcpf(1.f + __expf(-v1[i])); }
                    u32x4 w; w.x = cvt_pk_bf16(o[0], o[1]); w.y = cvt_pk_bf16(o[2], o[3]); w.z = cvt_pk_bf16(o[4], o[5]); w.w = cvt_pk_bf16(o[6], o[7]);
                    *(u32x4*)(O + r * ldc + col0 + bj * HALF) = w; } }
            asm volatile("" ::: "memory");
        }
    }
};
struct EpiResid {
    static constexpr bool PERM = false;
    const float* resid; float* out; int ldc; float alpha;
    __device__ __forceinline__ void operator()(const f32x4 (&acc)[2][2][4][2], const Unit& u, int wr, int wc, int fr, int fq) const {
        const int col0 = u.pn * BM + wc * 32 + 4 * fq;
#pragma unroll
        for (int ai = 0; ai < 2; ++ai) {
            f32x4 bs[4][2][2];
#pragma unroll
            for (int m = 0; m < 4; ++m) { const size_t off = (size_t)(u.pm * BM + ai * HALF + wr * 64 + m * 16 + fr) * ldc + col0;
#pragma unroll
                for (int bj = 0; bj < 2; ++bj)
#pragma unroll
                    for (int n = 0; n < 2; ++n) bs[m][bj][n] = *(const f32x4*)(resid + off + bj * HALF + n * 16); }
            asm volatile("" ::: "memory");
#pragma unroll
            for (int m = 0; m < 4; ++m) { const size_t off = (size_t)(u.pm * BM + ai * HALF + wr * 64 + m * 16 + fr) * ldc + col0;
#pragma unroll
                for (int bj = 0; bj < 2; ++bj)
#pragma unroll
                    for (int n = 0; n < 2; ++n) *(f32x4*)(out + off + bj * HALF + n * 16) = bs[m][bj][n] * alpha + acc[ai][bj][m][n]; }
            asm volatile("" ::: "memory");
        }
    }
};
struct EpiSwiglu {
    static constexpr bool PERM = true;
    bf16_t* O; int ldc;
    __device__ __forceinline__ void operator()(const f32x4 (&acc)[2][2][4][2], const Unit& u, int wr, int wc, int fr, int fq) const {
        const int row0 = u.pm * BM + wr * 64 + fr; const int col0 = (u.pn * BM + wc * 32 + 8 * fq) >> 1;
#pragma unroll
        for (int ai = 0; ai < 2; ++ai)
#pragma unroll
            for (int m = 0; m < 4; ++m) { bf16_t* rowp = O + (size_t)(row0 + ai * HALF + m * 16) * ldc + col0;
#pragma unroll
                for (int bj = 0; bj < 2; ++bj) { const f32x4 g = acc[ai][bj][m][0], up = acc[ai][bj][m][1]; float o[4];
#pragma unroll
                    for (int i = 0; i < 4; ++i) o[i] = g[i] * __builtin_amdgcn_rcpf(1.f + __expf(-g[i])) * up[i];
                    u32x2 w; w.x = cvt_pk_bf16(o[0], o[1]); w.y = cvt_pk_bf16(o[2], o[3]);
                    *(u32x2*)(rowp + bj * (HALF / 2)) = w; } }
    }
};
struct EpiScale {
    static constexpr bool PERM = true;
    bf16_t* O; int ldc; const float* rw;
    __device__ __forceinline__ void operator()(const f32x4 (&acc)[2][2][4][2], const Unit& u, int wr, int wc, int fr, int fq) const {
        const int row0 = u.pm * BM + wr * 64 + fr; const int col0 = u.pn * BM + wc * 32 + 8 * fq;
        float sw[2][4];
#pragma unroll
        for (int ai = 0; ai < 2; ++ai)
#pragma unroll
            for (int m = 0; m < 4; ++m) sw[ai][m] = rw[row0 + ai * HALF + m * 16];
        asm volatile("" ::: "memory");
#pragma unroll
        for (int ai = 0; ai < 2; ++ai)
#pragma unroll
            for (int m = 0; m < 4; ++m) { const int r = row0 + ai * HALF + m * 16; const float s = sw[ai][m]; bf16_t* rowp = O + (size_t)r * ldc + col0;
#pragma unroll
                for (int bj = 0; bj < 2; ++bj) { const f32x4 v0 = acc[ai][bj][m][0] * s, v1 = acc[ai][bj][m][1] * s;
                    u32x4 w; w.x = cvt_pk_bf16(v0[0], v0[1]); w.y = cvt_pk_bf16(v0[2], v0[3]); w.z = cvt_pk_bf16(v1[0], v1[1]); w.w = cvt_pk_bf16(v1[2], v1[3]);
                    *(u32x4*)(rowp + bj * HALF) = w; } }
    }
};

template <class Epi, class Sched, bool GATHER>
__device__ __forceinline__ void gemm_phase(PG8_LAS unsigned char* lds, const Gemm g, const Sched& S, const Epi& E) {
    const int tid = threadIdx.x, wid = __builtin_amdgcn_readfirstlane(tid >> 6), lane = tid & 63, wr = wid >> 2, wc = wid & 3, fr = lane & 15, fq = lane >> 4;
    const int K = g.K, nt = K / BK;
    unsigned voffA[2], voffB[2]; int RA[2], CA[2];
#pragma unroll
    for (int i = 0; i < 2; ++i) { int R, C; stage_rc(tid * 16 + i * 8192, R, C); const int Rb = Epi::PERM ? ((R & ~31) + perm32(R & 31)) : R;
        voffA[i] = (unsigned)(R * K + C) * 2u; voffB[i] = (unsigned)(Rb * K + C) * 2u; RA[i] = R; CA[i] = C; }
    const size_t kstep = (size_t)(BK * 2);
    const size_t hstep = (size_t)HALF * K * 2;
    const size_t tstep = 2 * hstep;
    const unsigned ldsw = (unsigned)wid * 1024u;
    const int aoff = lds_byte(wr * 64 + fr, fq * 8), boff = lds_byte(wc * 32 + fr, fq * 8);
#define PG8_SA(b, h) (((b) * 2 + (h)) * HTB)
#define PG8_SB(b, h) ((4 + (b) * 2 + (h)) * HTB)
#define PG8_STAGE(bufoff, gbase, voff) do { _Pragma("unroll") for (int _i = 0; _i < 2; ++_i) \
        __builtin_amdgcn_global_load_lds((const unsigned*)((const char*)(gbase) + (voff)[_i]), (PG8_LAS unsigned*)(lds + (bufoff) + ldsw + _i * 8192), 16, 0, 0); } while (0)
#define PG8_LDA(dst, b, h) do { _Pragma("unroll") for (int m = 0; m < 4; ++m) _Pragma("unroll") for (int k = 0; k < 2; ++k) dst[m][k] = *(const PG8_LAS bf16x8*)(lds + PG8_SA(b, h) + aoff + m * 2048 + k * 1024); } while (0)
#define PG8_LDB(dst, b, h) do { _Pragma("unroll") for (int n = 0; n < 2; ++n) _Pragma("unroll") for (int k = 0; k < 2; ++k) dst[n][k] = *(const PG8_LAS bf16x8*)(lds + PG8_SB(b, h) + boff + n * 2048 + k * 1024); } while (0)
#define PG8_MMA(ai, bj, At, Bt) do { __builtin_amdgcn_s_setprio(1); _Pragma("unroll") for (int m = 0; m < 4; ++m) _Pragma("unroll") for (int n = 0; n < 2; ++n) _Pragma("unroll") for (int k = 0; k < 2; ++k) \
        acc[ai][bj][m][n] = __builtin_amdgcn_mfma_f32_16x16x32_bf16(Bt[n][k], At[m][k], acc[ai][bj][m][n], 0, 0, 0); __builtin_amdgcn_s_setprio(0); } while (0)
#define PG8_WAIT_V(n) asm volatile("s_waitcnt vmcnt(" #n ")" ::: "memory")
#define PG8_WAIT_L(n) asm volatile("s_waitcnt lgkmcnt(" #n ")" ::: "memory")
#define PG8_BAR __builtin_amdgcn_s_barrier()
#define PG8_SCHED __builtin_amdgcn_sched_barrier(0)
    Unit cur, nxt; int ui = 0;
    const PG8_LAS int* rmap = (const PG8_LAS int*)(lds + STAGE_BYTES);
    if (GATHER) { Unit t_; for (int i_ = 0; S.next(i_, t_) && i_ < 16; ++i_) { if (tid < BM) ((PG8_LAS int*)(lds + STAGE_BYTES))[i_ * BM + tid] = g.rowmap[t_.pm * BM + tid]; }
        asm volatile("s_waitcnt vmcnt(0) lgkmcnt(0)" ::: "memory"); __builtin_amdgcn_s_barrier(); asm volatile("" ::: "memory"); }
    if (!S.next(0, cur)) return;
    f32x4 acc[2][2][4][2];
#pragma unroll
    for (int a = 0; a < 2; ++a)
#pragma unroll
        for (int b = 0; b < 2; ++b)
#pragma unroll
            for (int m = 0; m < 4; ++m)
#pragma unroll
                for (int n = 0; n < 2; ++n) acc[a][b][m][n] = (f32x4){0.f, 0.f, 0.f, 0.f};
    bf16x8 At[4][2], B0[2][2], B1[2][2];
    unsigned cG[2][2], nG[2][2];
#define PG8_LOAD_ROWS(u_, G2_) do { _Pragma("unroll") for (int h_ = 0; h_ < 2; ++h_) _Pragma("unroll") for (int i_ = 0; i_ < 2; ++i_) \
        G2_[h_][i_] = GATHER ? ((unsigned)rmap[(u_).ui * BM + h_ * HALF + RA[i_]] * (unsigned)K + (unsigned)CA[i_]) * 2u : voffA[i_]; } while (0)
    const char* cA = GATHER ? (const char*)g.A : (const char*)g.A + (size_t)cur.pm * tstep;
    const size_t hA = GATHER ? 0 : hstep;
    const char* cB = (const char*)g.Bt + (size_t)cur.e * g.bstride + (size_t)cur.pn * tstep;
    PG8_LOAD_ROWS(cur, cG);
    PG8_STAGE(PG8_SB(0, 0), cB, voffB); PG8_STAGE(PG8_SB(0, 1), cB + hstep, voffB); PG8_STAGE(PG8_SA(0, 0), cA, cG[0]); PG8_STAGE(PG8_SA(0, 1), cA + hA, cG[1]);
    if (wr == 1) PG8_BAR;
    PG8_WAIT_V(2); PG8_BAR;
    PG8_STAGE(PG8_SB(1, 0), cB + kstep, voffB); PG8_STAGE(PG8_SA(1, 0), cA + kstep, cG[0]); PG8_STAGE(PG8_SB(1, 1), cB + hstep + kstep, voffB);
    PG8_WAIT_V(6); PG8_BAR;
    for (;;) {
        const bool has_next = S.next(ui + 1, nxt);
        const char* nA = GATHER ? (const char*)g.A : (has_next ? (const char*)g.A + (size_t)nxt.pm * tstep : cA);
        const char* nB = has_next ? (const char*)g.Bt + (size_t)nxt.e * g.bstride + (size_t)nxt.pn * tstep : cB;
        if (has_next) PG8_LOAD_ROWS(nxt, nG); else {
#pragma unroll
            for (int h = 0; h < 2; ++h) { nG[h][0] = cG[h][0]; nG[h][1] = cG[h][1]; } }
        for (int t = 0; t < nt; t += 2) {
            const bool last = (t == nt - 2);
            const char* a1 = cA + (size_t)(t + 1) * kstep;
            const char* a2 = last ? nA : cA + (size_t)(t + 2) * kstep; const char* b2 = last ? nB : cB + (size_t)(t + 2) * kstep;
            const char* a3 = a2 + kstep; const char* b3 = b2 + kstep;
            unsigned sG[2][2];
#pragma unroll
            for (int h = 0; h < 2; ++h) { sG[h][0] = (GATHER && last) ? nG[h][0] : cG[h][0]; sG[h][1] = (GATHER && last) ? nG[h][1] : cG[h][1]; }
            PG8_LDB(B0, 0, 0); PG8_LDB(B1, 0, 1); PG8_SCHED; PG8_LDA(At, 0, 0); PG8_STAGE(PG8_SA(1, 1), a1 + hA, cG[1]);
            PG8_WAIT_V(8); PG8_WAIT_L(0); PG8_BAR; PG8_MMA(0, 0, At, B0); PG8_MMA(0, 1, At, B1); PG8_BAR; PG8_SCHED;
            PG8_LDA(At, 0, 1); PG8_STAGE(PG8_SB(0, 0), b2, voffB); PG8_STAGE(PG8_SB(0, 1), b2 + hstep, voffB); PG8_STAGE(PG8_SA(0, 0), a2, sG[0]);
            PG8_WAIT_V(8); PG8_WAIT_L(0); PG8_BAR; PG8_MMA(1, 0, At, B0); PG8_MMA(1, 1, At, B1); PG8_BAR; PG8_SCHED;
            PG8_LDB(B0, 1, 0); PG8_LDB(B1, 1, 1); PG8_SCHED; PG8_LDA(At, 1, 0); PG8_STAGE(PG8_SA(0, 1), a2 + hA, sG[1]);
            PG8_WAIT_V(8); PG8_WAIT_L(0); PG8_BAR; PG8_MMA(0, 0, At, B0); PG8_MMA(0, 1, At, B1); PG8_BAR; PG8_SCHED;
            PG8_LDA(At, 1, 1); PG8_STAGE(PG8_SB(1, 0), b3, voffB); PG8_STAGE(PG8_SB(1, 1), b3 + hstep, voffB); PG8_STAGE(PG8_SA(1, 0), a3, sG[0]);
            PG8_WAIT_V(8); PG8_WAIT_L(0); PG8_BAR; PG8_MMA(1, 0, At, B0); PG8_MMA(1, 1, At, B1); PG8_BAR; PG8_SCHED;
        }
        if (wr == 0) PG8_BAR;
        E(acc, cur, wr, wc, fr, fq);
        if (!has_next) break;
#pragma unroll
        for (int a = 0; a < 2; ++a)
#pragma unroll
            for (int b = 0; b < 2; ++b)
#pragma unroll
                for (int m = 0; m < 4; ++m)
#pragma unroll
                    for (int n = 0; n < 2; ++n) acc[a][b][m][n] = (f32x4){0.f, 0.f, 0.f, 0.f};
        cur = nxt; cA = nA; cB = nB; ++ui;
#pragma unroll
        for (int h = 0; h < 2; ++h) { cG[h][0] = nG[h][0]; cG[h][1] = nG[h][1]; }
        if (wr == 1) PG8_BAR;
    }
    PG8_WAIT_V(0);
    PG8_BAR;
#undef PG8_LOAD_ROWS
#undef PG8_SA
#undef PG8_SB
#undef PG8_STAGE
#undef PG8_LDA
#undef PG8_LDB
#undef PG8_MMA
#undef PG8_WAIT_V
#undef PG8_WAIT_L
#undef PG8_BAR
#undef PG8_SCHED
}
}
#define S5_OLD_PASS1 1
#define NO_W32 1
constexpr int NB = 2, SEQ = 16384, T = NB * SEQ, D = 1024;
constexpr int H0P = 2112;
constexpr int ABN = 2048, OFF_U = 0, OFF_Q = 512, OFF_K = 768, OFF_V = 1024, OFF_GO = 1536, AB_IN = 2080;
constexpr int CN = 1536;
constexpr int NEXP = 32, DEXP = 512, CAP = 2 * T + NEXP * 256, MAXTILES = CAP / 256;
constexpr int S5CH = 256, S5NCH = SEQ / S5CH;
constexpr int GSC = 16, GCH = 64, GNSC = SEQ / (GSC * GCH);
constexpr float ALPHA = 1.41421356237309515f;
constexpr float LN_EPS = 1e-5f, RMS_EPS = 1e-6f, LOG2E = 1.44269504088896341f;
constexpr int NWAVES = 8, NTHR = 512;

constexpr size_t MiB = 1u << 20, KiB = 1u << 10;
constexpr size_t WS_CTL = 0, CTL_ZERO_BYTES = 64 * KiB;
constexpr int CW_BAR = 4096;
constexpr size_t WS_LR = 1 * MiB;
constexpr size_t WS_S5E = 5 * MiB;
constexpr size_t WS_GS = 9 * MiB;
constexpr size_t WS_GD = 17 * MiB;
constexpr size_t WS_S5L = WS_GD + 64 * KiB;
constexpr size_t WS_S5B = WS_S5L + 64 * KiB;
constexpr size_t WS_S5C = WS_S5B + 256 * KiB;
constexpr size_t WS_BTAB = WS_S5C + 256 * KiB;
constexpr size_t WS_WR = WS_BTAB + 32 * KiB;
constexpr size_t WS_TOKE = WS_WR + 384 * KiB;
constexpr size_t WS_TOKW = WS_TOKE + 256 * KiB;
constexpr size_t WS_TOKS = WS_TOKW + 256 * KiB;
constexpr size_t WS_SLOTT = WS_TOKS + 256 * KiB;
constexpr size_t WS_SLOTW = WS_SLOTT + 288 * KiB;
constexpr size_t WS_BLKC = WS_SLOTW + 288 * KiB;
constexpr size_t WS_TILE = WS_BLKC + 32 * KiB;
constexpr size_t WS_W32 = 20 * MiB;
static_assert(WS_TILE + 4 * KiB <= WS_W32 && WS_W32 + 8 * MiB <= 32 * MiB, "param region");
constexpr size_t WS_WIN = 32 * MiB, WS_WLR = 36 * MiB, WS_WGLU = 37 * MiB, WS_WOUT = 38 * MiB, WS_CIN = 40 * MiB, WS_COUT = 43 * MiB;
constexpr size_t WS_W13 = 48 * MiB, WS_W2 = 112 * MiB;
constexpr size_t A0 = 144 * MiB;
constexpr size_t WS_H1 = A0, WS_HLO = A0, WS_HHI = A0 + 64 * MiB, WS_H0 = A0;
constexpr size_t WS_Z = A0 + 128 * MiB;
constexpr size_t WS_YG = A0 + 136 * MiB, WS_OF = A0 + 168 * MiB, WS_OB = A0 + 320 * MiB;
constexpr size_t WS_YSCR = A0 + 232 * MiB;
constexpr size_t WS_X64 = A0 + 256 * MiB;
constexpr size_t WS_HID = A0 + 128 * MiB;
constexpr size_t WS_Y2 = A0 + 200 * MiB;
constexpr size_t WS_H2B = WS_HHI;
constexpr size_t WS_QKV = A0 + 192 * MiB;
constexpr size_t WS_AO = A0 + 288 * MiB;
constexpr size_t WS_END = A0 + 384 * MiB;
static_assert((size_t)T * H0P * 2 <= 136 * MiB && WS_Y2 + (size_t)CAP * D * 2 <= WS_END && WS_OB + (size_t)T * 512 * 4 <= WS_END && WS_HID + (size_t)CAP * 512 * 2 <= WS_Y2, "act map");

constexpr int RING_BYTES = 131072;
constexpr int MISC_OFF = 163840 - 1024;
constexpr int PTR_OFF = MISC_OFF + 256;
constexpr int LDS_BYTES = 163840;

#define GAS __attribute__((address_space(1)))
#define LAS __attribute__((address_space(3)))
typedef unsigned short bf16;
typedef float f32x4 __attribute__((ext_vector_type(4)));
typedef float f32x2 __attribute__((ext_vector_type(2)));
typedef float f32x16 __attribute__((ext_vector_type(16)));
typedef short bf16x8 __attribute__((ext_vector_type(8)));
typedef short bf16x4 __attribute__((ext_vector_type(4)));
typedef unsigned u32x4 __attribute__((ext_vector_type(4)));
typedef unsigned u32x2 __attribute__((ext_vector_type(2)));
#define LDS_WAIT() asm volatile("s_waitcnt lgkmcnt(0)" ::: "memory")
#define VM_WAIT() asm volatile("s_waitcnt vmcnt(0)" ::: "memory")
#define LDS_BARRIER() do { asm volatile("s_waitcnt lgkmcnt(0)" ::: "memory"); __builtin_amdgcn_s_barrier(); asm volatile("" ::: "memory"); } while (0)
typedef __bf16 bf16x2_t __attribute__((ext_vector_type(2)));
__device__ __forceinline__ unsigned pk2(float lo, float hi) { f32x2 v = {lo, hi}; return __builtin_bit_cast(unsigned, __builtin_convertvector(v, bf16x2_t)); }
__device__ __forceinline__ unsigned f2bf(float f) { return pk2(f, 0.f) & 0xffffu; }
__device__ __forceinline__ float bf2f(unsigned short b) { return __uint_as_float((unsigned)b << 16); }
__device__ __forceinline__ float bflo(unsigned w) { return __uint_as_float(w << 16); }
__device__ __forceinline__ float bfhi(unsigned w) { return __uint_as_float(w & 0xffff0000u); }
__device__ __forceinline__ float sadd(float a, float b) { float d; asm("v_add_f32 %0, %1, %2" : "=v"(d) : "v"(a), "v"(b)); return d; }
__device__ __forceinline__ float sfma1(float a, float b, float c) { float d; asm("v_fma_f32 %0, %1, %2, %3" : "=v"(d) : "v"(a), "v"(b), "v"(c)); return d; }
__device__ __forceinline__ float wave_sum(float v) {
#pragma unroll
    for (int o = 1; o < 64; o <<= 1) v += __shfl_xor(v, o);
    return v;
}
__device__ __forceinline__ int crow(int r, int hi) { return (r & 3) + 8 * (r >> 2) + 4 * hi; }

#define XB_TMO      128
#define XB_XCNT(j)  (256  + 64 * (j))
#define XB_XSUB(j)  (1280 + 64 * (j))
#define XB_XGEN(j)  (2304 + 64 * (j))
#define XB_TOP      3328
#define XB_TOPGEN   3392
#define XCD_BAR_WORDS 3456
#define XB_SPIN_CAP (1u << 18)
__device__ __forceinline__ unsigned xb_ld(unsigned* p)              { return __hip_atomic_load(p, __ATOMIC_RELAXED, __HIP_MEMORY_SCOPE_AGENT); }
__device__ __forceinline__ unsigned xb_add(unsigned* p, unsigned v) { return __hip_atomic_fetch_add(p, v, __ATOMIC_RELAXED, __HIP_MEMORY_SCOPE_AGENT); }
__device__ __forceinline__ unsigned xb_xcc_id() { return (unsigned)__builtin_amdgcn_s_getreg((3 << 11) | 20) & 0xFu; }
#define XB_SPIN(cond, bar) do { unsigned _sp = 0; while (cond) { __builtin_amdgcn_s_sleep(1); \
    if ((++_sp & 255u) == 0u) { if (xb_ld(&(bar)[XB_TMO])) break; if (_sp > XB_SPIN_CAP) { atomicAdd(&(bar)[XB_TMO], 1u); break; } } } } while (0)
struct XcdBarrier { unsigned* bar; unsigned x; volatile LAS unsigned* st; };
__device__ __forceinline__ XcdBarrier xcd_barrier_post(unsigned* bar, volatile LAS unsigned* st) {
    XcdBarrier b; b.bar = bar; b.x = xb_xcc_id(); b.st = st;
    if (threadIdx.x == 0) (void)xb_add(&bar[XB_XCNT(b.x)], 1u);
    return b;
}
__device__ __forceinline__ void xcd_barrier_complete(unsigned* bar, unsigned x, unsigned& nloc, unsigned& nx) {
    const unsigned G = gridDim.x * gridDim.y * gridDim.z;
    unsigned sum, cnt, mine, sp = 0u;
    for (;;) {
        sum = 0u; cnt = 0u; mine = 0u;
#pragma unroll
        for (unsigned j = 0; j < 16; ++j) { const unsigned c = xb_ld(&bar[XB_XCNT(j)]); sum += c; cnt += (c > 0u) ? 1u : 0u; mine = (j == x) ? c : mine; }
        if (sum == G) break;
        __builtin_amdgcn_s_sleep(1);
        if ((++sp & 255u) == 0u) { if (xb_ld(&bar[XB_TMO])) break; if (sp > XB_SPIN_CAP) { atomicAdd(&bar[XB_TMO], 1u); break; } }
    }
    nloc = mine > 0u ? mine : 1u; nx = cnt > 0u ? cnt : 1u;
}
__device__ __forceinline__ void xcd_barrier(const XcdBarrier& b) {
    asm volatile("s_waitcnt vmcnt(0)" ::: "memory");
    __syncthreads();
    if (threadIdx.x == 0) {
        unsigned* bar = b.bar;
        __builtin_amdgcn_s_waitcnt(0);
        unsigned nloc = b.st[0], nx = b.st[1];
        if (nloc == 0u) { xcd_barrier_complete(bar, b.x, nloc, nx); b.st[0] = nloc; b.st[1] = nx; }
        const unsigned old = xb_add(&bar[XB_XSUB(b.x)], 1u);
        const unsigned gen = old / nloc;
        if (old + 1u == (gen + 1u) * nloc) {
            __builtin_amdgcn_fence(__ATOMIC_RELEASE, "agent");
            asm volatile("s_waitcnt vmcnt(0)" ::: "memory");
            const unsigned og = xb_add(&bar[XB_TOP], 1u);
            const unsigned tg = og / nx;
            if (og + 1u == (tg + 1u) * nx) xb_add(&bar[XB_TOPGEN], 1u);
            else XB_SPIN(xb_ld(&bar[XB_TOPGEN]) == tg, bar);
            __builtin_amdgcn_fence(__ATOMIC_ACQUIRE, "agent");
            xb_add(&bar[XB_XGEN(b.x)], 1u);
            asm volatile("s_waitcnt vmcnt(0)" ::: "memory");
        } else {
            XB_SPIN(xb_ld(&bar[XB_XGEN(b.x)]) == gen, bar);
            __builtin_amdgcn_fence(__ATOMIC_ACQUIRE, "agent");
            asm volatile("s_waitcnt vmcnt(0)" ::: "memory");
        }
    }
    __syncthreads();
}

struct Frame {
    LAS unsigned char* lds;
    int tid, lane, wave, G, bid;
    unsigned char* ws;
    const float* const* in;
};
enum InIdx { I_X = 0, I_LNMG, I_LNMB, I_LNFG, I_LNFB, I_ABWIN, I_LAMRE, I_LAMIM, I_LOGDT, I_BRE, I_BIM, I_CRE, I_CIM, I_S5D, I_GLUW, I_GLUB,
             I_GATEW, I_GATEB, I_NORMG, I_ABWOUT, I_CWIN, I_SINK, I_CWOUT, I_RELB, I_WGRP, I_BGRP, I_WRT, I_BRT, I_W1, I_W3, I_W2, N_IN };

__device__ __forceinline__ const float* inp(LAS unsigned char* lds, int k) {
    const LAS unsigned* p = (const LAS unsigned*)(lds + PTR_OFF) + 2 * k;
    const unsigned lo = __builtin_amdgcn_readfirstlane(p[0]), hi = __builtin_amdgcn_readfirstlane(p[1]);
    return (const float*)(const GAS float*)(((unsigned long long)hi << 32) | (unsigned long long)lo);
}
struct TrItem { const float* W; bf16* WT; int ldw, ldt, rowmode, k0, n0; };
__device__ __forceinline__ void tr_load(const TrItem& q, float (&tv)[32], int lane) {
    const float* wp = q.W + (size_t)(q.k0 + (lane >> 5)) * q.ldw + q.n0 + (lane & 31);
#pragma unroll
    for (int i = 0; i < 32; ++i) tv[i] = wp[(size_t)(2 * i) * q.ldw];
}
__device__ __forceinline__ void tr_store(const TrItem& q, const float (&tv)[32], LAS float* scr, int lane) {
#pragma unroll
    for (int i = 0; i < 32; ++i) scr[(2 * i + (lane >> 5)) * 33 + (lane & 31)] = tv[i];
    LDS_WAIT(); asm volatile("" ::: "memory");
    const int c = lane & 7;
#pragma unroll
    for (int j = 0; j < 4; ++j) { const int n = (lane >> 3) + 8 * j; const LAS float* s = scr + (8 * c) * 33 + n;
        u32x4 o; o.x = pk2(s[0 * 33], s[1 * 33]); o.y = pk2(s[2 * 33], s[3 * 33]); o.z = pk2(s[4 * 33], s[5 * 33]); o.w = pk2(s[6 * 33], s[7 * 33]);
        const int ng = q.n0 + n; const int dr = q.rowmode == 0 ? ng : (8 * (ng >> 2) + (ng & 3) + (q.rowmode == 2 ? 4 : 0));
        *(GAS u32x4*)(q.WT + (size_t)dr * q.ldt + q.k0 + 8 * c) = o; }
    LDS_WAIT(); asm volatile("" ::: "memory");
}
__device__ __forceinline__ void tr_item(const float* W, int ldw, bf16* WT, int ldt, int rowmode, LAS float* scr, int item, int nblk, int lane) {
    TrItem q{W, WT, ldw, ldt, rowmode, 64 * (item / nblk), 32 * (item % nblk)}; float tv[32]; tr_load(q, tv, lane); tr_store(q, tv, scr, lane);
}
__device__ __forceinline__ TrItem moe_item(const float* w1, const float* w3, const float* w2, bf16* W13, bf16* W2T, int it) {
    constexpr int PER_E = 768; const int e = it / PER_E, r = it % PER_E;
    if (r < 256) return TrItem{w1 + (size_t)e * D * DEXP, W13 + (size_t)e * D * D, DEXP, D, 1, 64 * (r / 16), 32 * (r % 16)};
    if (r < 512) return TrItem{w3 + (size_t)e * D * DEXP, W13 + (size_t)e * D * D, DEXP, D, 2, 64 * ((r - 256) / 16), 32 * ((r - 256) % 16)};
    return TrItem{w2 + (size_t)e * DEXP * D, W2T + (size_t)e * D * DEXP, D, DEXP, 0, 64 * ((r - 512) / 32), 32 * ((r - 512) % 32)};
}
__device__ __forceinline__ void moe_convert(const float* w1, const float* w3, const float* w2, bf16* W13, bf16* W2T, LAS float* scr, int it0, int it1, int gw, int NGW, int lane) {
    for (int it = it0 + gw; it < it1; it += 2 * NGW) {
        const int it2 = it + NGW; const bool two = it2 < it1;
        const TrItem qa = moe_item(w1, w3, w2, W13, W2T, it), qb = moe_item(w1, w3, w2, W13, W2T, two ? it2 : it);
        float ta[32], tb[32];
        tr_load(qa, ta, lane); tr_load(qb, tb, lane);
        tr_store(qa, ta, scr, lane); if (two) tr_store(qb, tb, scr, lane);
    }
}
constexpr int MOE_ITEMS = NEXP * 768, IDLE_Q8 = 88, IDLE_Q9 = 56;
__device__ __forceinline__ void idle_convert(int which, unsigned char* ws, LAS unsigned char* lds, float* dout, int ntiles, int bid, int G, int wave, int lane) {
    const int U = ntiles * (D / 256), rem = U % G; if (rem == 0 || bid < rem) return;
    const int n_idle = G - rem, rank = bid - rem;
    int q8 = n_idle * IDLE_Q8; q8 = q8 < MOE_ITEMS ? q8 : MOE_ITEMS; int q9 = n_idle * IDLE_Q9; q9 = (q8 + q9) < MOE_ITEMS ? q9 : (MOE_ITEMS - q8);
    const int per = which == 0 ? IDLE_Q8 : IDLE_Q9, base = which == 0 ? 0 : q8, lim = which == 0 ? q8 : q8 + q9;
    int lo = base + rank * per, hi = lo + per; hi = hi < lim ? hi : lim;
    moe_convert(inp(lds, I_W1) + (size_t)NEXP * D * DEXP, inp(lds, I_W3) + (size_t)NEXP * D * DEXP, inp(lds, I_W2) + (size_t)NEXP * DEXP * D,
                (bf16*)dout, (bf16*)dout + (size_t)NEXP * D * D, (LAS float*)(lds + wave * 16384), lo, hi, wave, NWAVES, lane);
}
__device__ __forceinline__ int idle_done(int ntiles, int G) {
    const int U = ntiles * (D / 256), rem = U % G; if (rem == 0) return 0;
    const int n_idle = G - rem; int q = n_idle * (IDLE_Q8 + IDLE_Q9); return q < MOE_ITEMS ? q : MOE_ITEMS;
}
__device__ __forceinline__ void half_convert(int layer, int second, unsigned char* ws, LAS unsigned char* lds, float* dout, int bid, int G, int wave, int lane) {
    const int h = G / 2; if ((bid >= h) != (second != 0)) return;
    const int rank = second ? bid - h : bid, nb = second ? G - h : h;
    const int lo = second ? MOE_ITEMS / 2 : 0, hi = second ? MOE_ITEMS : MOE_ITEMS / 2;
    const size_t lof = (size_t)layer * NEXP * D * DEXP;
    bf16* W13 = layer == 0 ? (bf16*)(ws + WS_W13) : (bf16*)dout; bf16* W2T = layer == 0 ? (bf16*)(ws + WS_W2) : (bf16*)dout + (size_t)NEXP * D * D;
    moe_convert(inp(lds, I_W1) + lof, inp(lds, I_W3) + lof, inp(lds, I_W2) + lof, W13, W2T, (LAS float*)(lds + wave * 16384), lo, hi, rank * NWAVES + wave, nb * NWAVES, lane);
}
__device__ __forceinline__ int t5_bucket(int rel) {
    const int nb = 16, max_exact = 8; int ret = rel > 0 ? nb : 0; const int n = rel < 0 ? -rel : rel;
    const float lg = logf((float)(n < 1 ? 1 : n) / 8.0f) / 2.7725887f * 8.0f;
    int large = max_exact + (int)lg; large = large < nb - 1 ? large : nb - 1;
    return ret + (n < max_exact ? n : large);
}
__device__ __forceinline__ void p0_prologue(unsigned char* ws, LAS unsigned char* lds, int bid, int G, int tid, int wave, int lane) {
    LAS float* scr = (LAS float*)(lds + wave * 16384);
    const int gw = bid * NWAVES + wave, NGW = G * NWAVES;
    constexpr int I0 = 16 * 64, I1 = 16, I2 = 8 * 16, I3 = 16 * 32, I4 = 16 * 48, I5 = 16 * 32, NIT = I0 + I1 + I2 + I3 + I4 + I5;
    for (int it = gw; it < NIT; it += NGW) {
        int r = it;
        if (r < I0) { tr_item(inp(lds, I_ABWIN), AB_IN, (bf16*)(ws + WS_WIN), D, 0, scr, r, 64, lane); continue; } r -= I0;
        if (r < I1) { tr_item(inp(lds, I_ABWIN) + 2048, AB_IN, (bf16*)(ws + WS_WLR), D, 0, scr, r, 1, lane); continue; } r -= I1;
        if (r < I2) { tr_item(inp(lds, I_GLUW), 512, (bf16*)(ws + WS_WGLU), 512, 0, scr, r, 16, lane); continue; } r -= I2;
        if (r < I3) { tr_item(inp(lds, I_ABWOUT), D, (bf16*)(ws + WS_WOUT), D, 0, scr, r, 32, lane); continue; } r -= I3;
        if (r < I4) { tr_item(inp(lds, I_CWIN), CN, (bf16*)(ws + WS_CIN), D, 0, scr, r, 48, lane); continue; } r -= I4;
        tr_item(inp(lds, I_CWOUT), D, (bf16*)(ws + WS_COUT), D, 0, scr, r, 32, lane);
    }
#ifndef CONV_OVERLAP
    moe_convert(inp(lds, I_W1), inp(lds, I_W3), inp(lds, I_W2), (bf16*)(ws + WS_W13), (bf16*)(ws + WS_W2), scr, 0, MOE_ITEMS, gw, NGW, lane);
#endif
    { const float* x = inp(lds, I_X); bf16* xb = (bf16*)(ws + WS_X64);
      for (int m = gw; m < T; m += 2 * NGW) { const int m2 = m + NGW;
          const GAS f32x4* xr = (const GAS f32x4*)(x + (size_t)m * D) + lane; GAS u32x2* o = (GAS u32x2*)(xb + (size_t)m * D) + lane;
          const GAS f32x4* xr2 = (const GAS f32x4*)(x + (size_t)m2 * D) + lane; GAS u32x2* o2 = (GAS u32x2*)(xb + (size_t)m2 * D) + lane;
          f32x4 v[4], v2[4];
#pragma unroll
          for (int j = 0; j < 4; ++j) { v[j] = xr[64 * j]; if (m2 < T) v2[j] = xr2[64 * j]; }
#pragma unroll
          for (int j = 0; j < 4; ++j) { u32x2 w; w.x = pk2(v[j].x, v[j].y); w.y = pk2(v[j].z, v[j].w); o[64 * j] = w;
              if (m2 < T) { u32x2 w2; w2.x = pk2(v2[j].x, v2[j].y); w2.y = pk2(v2[j].z, v2[j].w); o2[64 * j] = w2; } } } }
    const int gt = bid * NTHR + tid, NGT = G * NTHR;
    { const float* lamre = inp(lds, I_LAMRE); const float* lamim = inp(lds, I_LAMIM); const float* logdt = inp(lds, I_LOGDT); const float* bre = inp(lds, I_BRE); const float* bim = inp(lds, I_BIM);
    for (int i = tid * G + bid; i < 2 * 32 * 64; i += NTHR * G) {
        const int p = i & 63, g = (i >> 6) & 31, dir = i >> 11;
        const double lr = fmin((double)lamre[i], -1e-4), li = (double)lamim[i], dt = exp((double)logdt[dir * 32 + g]);
        const double mag = exp(lr * dt), ar = mag * cos(li * dt), ai = mag * sin(li * dt), den = lr * lr + li * li, nr = ar - 1.0;
        const double cr = (nr * lr + ai * li) / den, ci = (ai * lr - nr * li) / den;
        double qr = ar, qi = ai;
#pragma unroll 1
        for (int s = 1; s < S5CH; s <<= 1) { const double t = qr * qr - qi * qi; qi = 2.0 * qr * qi; qr = t; }
        float* L4 = (float*)(ws + WS_S5L) + (size_t)i * 4; L4[0] = (float)ar; L4[1] = (float)ai; L4[2] = (float)qr; L4[3] = (float)qi;
        bf16* Bb = (bf16*)(ws + WS_S5B) + (size_t)(dir * 32 + g) * 2048;
#pragma unroll 4
        for (int c = 0; c < 16; ++c) { const double br = bre[(size_t)i * 16 + c], bi = bim[(size_t)i * 16 + c];
            Bb[p * 16 + c] = (bf16)f2bf((float)(cr * br - ci * bi)); Bb[1024 + p * 16 + c] = (bf16)f2bf((float)(cr * bi + ci * br)); } }
#ifndef NO_W32
    for (int idx = gt; idx < 2 * 32 * 64 * 32; idx += NGT) {
        const int i = idx & 31, p = (idx >> 5) & 63, dg = idx >> 11, q = dg * 64 + p, dir = dg >> 5;
        const float lr = fminf(lamre[q], -1e-4f), li = lamim[q], dt = expf(logdt[dg]);
        const float mag = expf(lr * dt), ar = mag * cosf(li * dt), ai = mag * sinf(li * dt), den = lr * lr + li * li, nr = ar - 1.0f;
        const float cr = (nr * lr + ai * li) / den, ci = (ai * lr - nr * li) / den;
        const float kk = (float)(dir ? i : 31 - i), pm = expf(kk * lr * dt), pr = pm * cosf(kk * li * dt), pi_ = pm * sinf(kk * li * dt);
        const float wr = pr * cr - pi_ * ci, wi = pr * ci + pi_ * cr;
        float o0[16], o1[16];
#pragma unroll
        for (int c = 0; c < 16; ++c) { const float br = bre[(size_t)q * 16 + c], bi = bim[(size_t)q * 16 + c]; o0[c] = wr * br - wi * bi; o1[c] = wr * bi + wi * br; }
        bf16* W = (bf16*)(ws + WS_W32);
        u32x4* d0 = (u32x4*)(W + ((size_t)(dg * 2 + 0) * 64 + p) * 512 + i * 16); u32x4* d1 = (u32x4*)(W + ((size_t)(dg * 2 + 1) * 64 + p) * 512 + i * 16);
        u32x4 w;
        w.x = pk2(o0[0], o0[1]); w.y = pk2(o0[2], o0[3]); w.z = pk2(o0[4], o0[5]); w.w = pk2(o0[6], o0[7]); d0[0] = w;
        w.x = pk2(o0[8], o0[9]); w.y = pk2(o0[10], o0[11]); w.z = pk2(o0[12], o0[13]); w.w = pk2(o0[14], o0[15]); d0[1] = w;
        w.x = pk2(o1[0], o1[1]); w.y = pk2(o1[2], o1[3]); w.z = pk2(o1[4], o1[5]); w.w = pk2(o1[6], o1[7]); d1[0] = w;
        w.x = pk2(o1[8], o1[9]); w.y = pk2(o1[10], o1[11]); w.z = pk2(o1[12], o1[13]); w.w = pk2(o1[14], o1[15]); d1[1] = w;
    }
#endif
    }
    { const float* cre = inp(lds, I_CRE); const float* cim = inp(lds, I_CIM);
    for (int i = gt; i < 2 * 32 * 16 * 64; i += NGT) {
        const int p = i & 63, c = (i >> 6) & 15, dg = i >> 10;
        bf16* Cm = (bf16*)(ws + WS_S5C) + (size_t)dg * 2048 + c * 128 + 2 * p;
        Cm[0] = (bf16)f2bf(cre[i]); Cm[1] = (bf16)f2bf(-cim[i]);
    } }
    { const float* relb = inp(lds, I_RELB);
    for (int i = gt; i < 16 * 257; i += NGT) { const int h = i / 257, r = i % 257; ((float*)(ws + WS_BTAB))[h * 260 + r] = relb[t5_bucket(r - 128) * 16 + h] * LOG2E; } }
    { const float* wgrp = inp(lds, I_WGRP); const float* wrt = inp(lds, I_WRT);
    for (int i = gt; i < 2 * 48 * 1024; i += NGT) {
        const int k = i & 1023, n = (i >> 10) % 48, l = i / (48 * 1024);
        const float w = n < 4 ? wgrp[(size_t)l * D * 4 + k * 4 + n] : (n < 36 ? wrt[(size_t)l * D * 32 + k * 32 + (n - 4)] : 0.f);
        const unsigned hi = f2bf(w); const float lo = w - __uint_as_float(hi << 16);
        bf16* Wr = (bf16*)(ws + WS_WR) + (size_t)l * 2 * 48 * 1024; Wr[n * 1024 + k] = (bf16)hi; Wr[48 * 1024 + n * 1024 + k] = (bf16)f2bf(lo);
    } }
}

__device__ __forceinline__ void gate_tail(float* bcg, const float* gate_w, const float* gate_b, const LAS float* lrs, size_t row0, int tid);
__device__ __forceinline__ void lr_tail(unsigned char* ws, float* bcg, const float* gate_w, const float* gate_b, LAS unsigned char* lds, int bid, int G, int tid, int wave, int lane) {
    const bf16* xb = (const bf16*)(ws + WS_X64); const bf16* wl = (const bf16*)(ws + WS_WLR); LAS float* lrs = (LAS float*)lds;
    for (int rt = bid; rt < T / 128; rt += G) {
        const int r0 = rt * 128 + wave * 16;
        f32x4 acc0 = {0.f, 0.f, 0.f, 0.f}, acc1 = {0.f, 0.f, 0.f, 0.f};
        const bf16* ap = xb + (size_t)(r0 + (lane & 15)) * D + 8 * (lane >> 4);
        const bf16* bp = wl + (size_t)(lane & 15) * D + 8 * (lane >> 4);
#pragma unroll 8
        for (int ks = 0; ks < 32; ++ks) {
            const bf16x8 a = *(const bf16x8*)(ap + ks * 32), b0 = *(const bf16x8*)(bp + ks * 32), b1 = *(const bf16x8*)(bp + 16 * D + ks * 32);
            acc0 = __builtin_amdgcn_mfma_f32_16x16x32_bf16(a, b0, acc0, 0, 0, 0); acc1 = __builtin_amdgcn_mfma_f32_16x16x32_bf16(a, b1, acc1, 0, 0, 0);
        }
        __syncthreads();
#pragma unroll
        for (int r = 0; r < 4; ++r) { LAS float* o = lrs + (wave * 16 + 4 * (lane >> 4) + r) * 32 + (lane & 15); o[0] = acc0[r]; o[16] = acc1[r]; }
        __syncthreads();
        gate_tail(bcg, gate_w, gate_b, lrs, (size_t)rt * 128, tid);
    }
    __syncthreads();
}

__device__ __forceinline__ void gla_finalize(unsigned char* ws, const float* norm_g, int gw, int NGW, int lane) {
    const bf16* of = (const bf16*)(ws + WS_OF); const bf16* ob = (const bf16*)(ws + WS_OB); const bf16* h0 = (const bf16*)(ws + WS_H0); bf16* cc = (bf16*)(ws + WS_X64);
    const f32x4 g0 = *(const f32x4*)(norm_g + 8 * lane), g1 = *(const f32x4*)(norm_g + 8 * lane + 4);
    for (int m0 = gw; m0 < T; m0 += 4 * NGW) {
        u32x4 a[4], b[4], gq[4];
#pragma unroll
        for (int q = 0; q < 4; ++q) { const size_t m = (size_t)m0 + (size_t)q * NGW;
            a[q] = *(const u32x4*)(of + m * 512 + 8 * lane); b[q] = *(const u32x4*)(ob + m * 512 + 8 * lane); gq[q] = *(const u32x4*)(h0 + m * H0P + OFF_GO + 8 * lane); }
#pragma unroll
        for (int q = 0; q < 4; ++q) { const size_t m = (size_t)m0 + (size_t)q * NGW;
            f32x4 v0, v1;
            v0.x = bflo(a[q].x) + bflo(b[q].x); v0.y = bfhi(a[q].x) + bfhi(b[q].x); v0.z = bflo(a[q].y) + bflo(b[q].y); v0.w = bfhi(a[q].y) + bfhi(b[q].y);
            v1.x = bflo(a[q].z) + bflo(b[q].z); v1.y = bfhi(a[q].z) + bfhi(b[q].z); v1.z = bflo(a[q].w) + bflo(b[q].w); v1.w = bfhi(a[q].w) + bfhi(b[q].w);
            float ss = (v0.x * v0.x + v0.y * v0.y) + (v0.z * v0.z + v0.w * v0.w) + (v1.x * v1.x + v1.y * v1.y) + (v1.z * v1.z + v1.w * v1.w);
            ss += __shfl_xor(ss, 1); ss += __shfl_xor(ss, 2); ss += __shfl_xor(ss, 4); ss += __shfl_xor(ss, 8);
            const float rs = __builtin_amdgcn_rsqf(ss * (1.0f / 128.0f) + RMS_EPS);
            const float gv[8] = {bflo(gq[q].x), bfhi(gq[q].x), bflo(gq[q].y), bfhi(gq[q].y), bflo(gq[q].z), bfhi(gq[q].z), bflo(gq[q].w), bfhi(gq[q].w)};
            const float ov[8] = {v0.x * g0.x, v0.y * g0.y, v0.z * g0.z, v0.w * g0.w, v1.x * g1.x, v1.y * g1.y, v1.z * g1.z, v1.w * g1.w};
            float r[8];
#pragma unroll
            for (int i = 0; i < 8; ++i) r[i] = ov[i] * rs * (gv[i] * __builtin_amdgcn_rcpf(1.f + __expf(-gv[i])));
            u32x4 w; w.x = pk2(r[0], r[1]); w.y = pk2(r[2], r[3]); w.z = pk2(r[4], r[5]); w.w = pk2(r[6], r[7]);
            *(u32x4*)(cc + m * D + 512 + 8 * lane) = w; }
    }
}

constexpr int RT_AST = 2064;
template <bool RESID_F32, bool RD_LO, bool WR_LO>
__device__ __forceinline__ void ln_router(unsigned char* ws, const float* resid, const float* lng, const float* lnb, const float* bgrp, const float* brt, int layer, LAS unsigned char* lds, int bid, int G, int tid, int wave, int lane) {
    const bf16* yb = (const bf16*)(ws + WS_Z); bf16* hlo = (bf16*)(ws + WS_HLO); bf16* hb = (bf16*)(ws + WS_HHI);
    int* tok_e = (int*)(ws + WS_TOKE); float* tok_w = (float*)(ws + WS_TOKW);
    LAS unsigned char* Ahi = lds; LAS unsigned char* Alo = lds + 16 * RT_AST; LAS float* part = (LAS float*)(lds + 32 * RT_AST);
    LAS int* hist = (LAS int*)(lds + 32 * RT_AST + 8 * 16 * 48 * 4); LAS float* lgt = (LAS float*)(lds + 32 * RT_AST + 8 * 16 * 48 * 4 + 256);
    if (tid < 32) hist[tid] = 0;
    const bf16* Wr = (const bf16*)(ws + WS_WR) + (size_t)layer * 2 * 48 * 1024;
    bf16x8 Bh[3][4], Bl[3][4];
#pragma unroll
    for (int nt = 0; nt < 3; ++nt)
#pragma unroll
        for (int ks = 0; ks < 4; ++ks) { const size_t o = (size_t)(nt * 16 + (lane & 15)) * 1024 + wave * 128 + ks * 32 + 8 * (lane >> 4);
            Bh[nt][ks] = *(const bf16x8*)(Wr + o); Bl[nt][ks] = *(const bf16x8*)(Wr + 48 * 1024 + o); }
    f32x4 gv[4], bv[4];
#pragma unroll
    for (int j = 0; j < 4; ++j) { gv[j] = *(const f32x4*)(lng + 4 * lane + 256 * j); bv[j] = *(const f32x4*)(lnb + 4 * lane + 256 * j); }
    __syncthreads();
    for (int grp = bid; grp < T / 16; grp += G) {
#pragma unroll
        for (int rr = 0; rr < 2; ++rr) {
            const int row = 2 * wave + rr; const size_t m = (size_t)grp * 16 + row;
            const GAS f32x4* xr = (const GAS f32x4*)(resid + m * D) + lane; const GAS u32x2* yr = (const GAS u32x2*)(yb + m * D) + lane;
            const GAS u32x2* hr_ = (const GAS u32x2*)(hb + m * D) + lane; const GAS u32x2* lr_ = (const GAS u32x2*)(hlo + m * D) + lane;
            f32x4 v[4]; float s = 0.f;
#pragma unroll
            for (int j = 0; j < 4; ++j) { f32x4 x4; const u32x2 y2 = yr[64 * j];
                if (RESID_F32) x4 = xr[64 * j]; else if (RD_LO) { const u32x2 a = hr_[64 * j], b = lr_[64 * j]; x4.x = bflo(a.x) + bflo(b.x); x4.y = bfhi(a.x) + bfhi(b.x); x4.z = bflo(a.y) + bflo(b.y); x4.w = bfhi(a.y) + bfhi(b.y); }
                else { const u32x2 a = hr_[64 * j]; x4.x = bflo(a.x); x4.y = bfhi(a.x); x4.z = bflo(a.y); x4.w = bfhi(a.y); }
                v[j].x = x4.x * ALPHA + bflo(y2.x); v[j].y = x4.y * ALPHA + bfhi(y2.x); v[j].z = x4.z * ALPHA + bflo(y2.y); v[j].w = x4.w * ALPHA + bfhi(y2.y);
                s += sadd(sadd(v[j].x, v[j].y), sadd(v[j].z, v[j].w)); }
            const float mean = wave_sum(s) * (1.f / D); float s2 = 0.f;
#pragma unroll
            for (int j = 0; j < 4; ++j) { v[j] = v[j] - mean; s2 += (v[j].x * v[j].x + v[j].y * v[j].y) + (v[j].z * v[j].z + v[j].w * v[j].w); }
            const float rstd = 1.f / sqrtf(wave_sum(s2) * (1.f / D) + LN_EPS);
#pragma unroll
            for (int j = 0; j < 4; ++j) {
                const f32x4 h = v[j] * rstd * gv[j] + bv[j];
                const unsigned h0 = pk2(h.x, h.y), h1w = pk2(h.z, h.w);
                u32x2 w; w.x = h0; w.y = h1w; ((GAS u32x2*)(hb + m * D) + lane)[64 * j] = w;
                u32x2 lo; lo.x = pk2(h.x - bflo(h0), h.y - bfhi(h0)); lo.y = pk2(h.z - bflo(h1w), h.w - bfhi(h1w));
                if (WR_LO) ((GAS u32x2*)(hlo + m * D) + lane)[64 * j] = lo;
                *(LAS u32x2*)(Ahi + row * RT_AST + (4 * lane + 256 * j) * 2) = w; *(LAS u32x2*)(Alo + row * RT_AST + (4 * lane + 256 * j) * 2) = lo;
            }
        }
        LDS_BARRIER();
        f32x4 acc[3] = {{0.f, 0.f, 0.f, 0.f}, {0.f, 0.f, 0.f, 0.f}, {0.f, 0.f, 0.f, 0.f}};
#pragma unroll
        for (int ks = 0; ks < 4; ++ks) {
            const int bo = (lane & 15) * RT_AST + (wave * 128 + ks * 32 + 8 * (lane >> 4)) * 2;
            const bf16x8 ah = *(const LAS bf16x8*)(Ahi + bo), al = *(const LAS bf16x8*)(Alo + bo);
#pragma unroll
            for (int nt = 0; nt < 3; ++nt) {
                acc[nt] = __builtin_amdgcn_mfma_f32_16x16x32_bf16(ah, Bh[nt][ks], acc[nt], 0, 0, 0);
                acc[nt] = __builtin_amdgcn_mfma_f32_16x16x32_bf16(ah, Bl[nt][ks], acc[nt], 0, 0, 0);
                acc[nt] = __builtin_amdgcn_mfma_f32_16x16x32_bf16(al, Bh[nt][ks], acc[nt], 0, 0, 0);
            }
        }
#pragma unroll
        for (int nt = 0; nt < 3; ++nt)
#pragma unroll
            for (int r = 0; r < 4; ++r) part[(wave * 16 + 4 * (lane >> 4) + r) * 48 + nt * 16 + (lane & 15)] = acc[nt][r];
        LDS_BARRIER();
        { const int itn = (grp - bid) / G;
          for (int idx = tid; idx < 16 * 36; idx += NTHR) { const int tk = idx / 36, n = idx % 36; float s = 0.f;
#pragma unroll
            for (int w = 0; w < 8; ++w) s += part[(w * 16 + tk) * 48 + n];
            lgt[(itn * 16 + tk) * 36 + n] = s + (n < 4 ? bgrp[n] : brt[n - 4]); } }
    }
    LDS_BARRIER();
    for (int tk = tid; tk < 16 * ((T / 16 - bid + G - 1) / G); tk += NTHR) {
        const size_t m = ((size_t)bid + (size_t)(tk >> 4) * G) * 16 + (tk & 15);
        const LAS float* lg = lgt + tk * 36;
        int gi = 0; float gm = lg[0];
#pragma unroll
        for (int n = 1; n < 4; ++n) if (lg[n] > gm) { gm = lg[n]; gi = n; }
        float gs = 0.f;
#pragma unroll
        for (int n = 0; n < 4; ++n) gs += __expf(lg[n] - gm);
        const float pg = 1.f / gs;
        float el[8];
#pragma unroll
        for (int i = 0; i < 8; ++i) el[i] = lg[4 + gi * 8 + i];
        int i1 = 0; float m1 = el[0];
#pragma unroll
        for (int i = 1; i < 8; ++i) if (el[i] > m1) { m1 = el[i]; i1 = i; }
        int i2 = -1; float m2 = -3.0e38f;
#pragma unroll
        for (int i = 0; i < 8; ++i) if (i != i1 && el[i] > m2) { m2 = el[i]; i2 = i; }
        const float e2 = __expf(m2 - m1), inv = 1.f / (1.f + e2);
        const int ea = gi * 8 + i1, eb = gi * 8 + i2;
        tok_e[m * 2] = ea; tok_e[m * 2 + 1] = eb; tok_w[m * 2] = pg * inv; tok_w[m * 2 + 1] = pg * e2 * inv;
        atomicAdd((int*)&hist[ea], 1); atomicAdd((int*)&hist[eb], 1);
    }
    LDS_BARRIER();
    if (tid < 32) ((int*)(ws + WS_BLKC))[bid * 32 + tid] = hist[tid];
}

__device__ __forceinline__ void moe_sort(unsigned char* ws, LAS unsigned char* lds, int bid, int G, int tid) {
    const int* blkc = (const int*)(ws + WS_BLKC); const int* tok_e = (const int*)(ws + WS_TOKE); const float* tok_w = (const float*)(ws + WS_TOKW);
    int* tok_s = (int*)(ws + WS_TOKS); int* slot_t = (int*)(ws + WS_SLOTT); float* slot_w = (float*)(ws + WS_SLOTW); int* tile = (int*)(ws + WS_TILE);
    LAS int* ptot = (LAS int*)lds; LAS int* pbase = ptot + 512; LAS int* tot = pbase + 512; LAS int* base = tot + 32; LAS int* pstart = base + 32; LAS int* lcur = pstart + 33;
    { const int e = tid & 31, part = tid >> 5; int st = 0, sb = 0;
      for (int b = part; b < G; b += 16) { const int c = blkc[b * 32 + e]; st += c; sb += (b < bid) ? c : 0; }
      ptot[part * 32 + e] = st; pbase[part * 32 + e] = sb; }
    __syncthreads();
    if (tid < 32) { int st = 0, sb = 0;
#pragma unroll
        for (int p = 0; p < 16; ++p) { st += ptot[p * 32 + tid]; sb += pbase[p * 32 + tid]; }
        tot[tid] = st; base[tid] = sb; lcur[tid] = 0; }
    __syncthreads();
    if (tid == 0) { int acc = 0; for (int e = 0; e < 32; ++e) { pstart[e] = acc; acc += (tot[e] + 255) & ~255; } pstart[32] = acc; }
    __syncthreads();
    if (bid == 0) {
        const int nt = pstart[32] >> 8;
        if (tid == 0) tile[511] = nt;
        for (int t = tid; t < nt; t += NTHR) { int e = 0; for (int q = 1; q < 32; ++q) if ((t << 8) >= pstart[q]) e = q; tile[t] = e; }
    }
    for (int e = bid; e < 32; e += G)
        for (int s = pstart[e] + tot[e] + tid; s < pstart[e + 1]; s += NTHR) { slot_t[s] = 0; slot_w[s] = 0.f; }
    for (int grp = bid; grp < T / 16; grp += G) {
        if (tid < 32) { const size_t a = (size_t)grp * 32 + tid; const int e = tok_e[a]; const int rank = atomicAdd((int*)&lcur[e], 1);
            const int s = pstart[e] + base[e] + rank; slot_t[s] = (int)(a >> 1); slot_w[s] = tok_w[a]; tok_s[a] = s; }
    }
}

template <bool FINAL, bool RD_LO, bool WR_LO>
__device__ __forceinline__ void combine_ln(unsigned char* ws, const float* lng, const float* lnb, float* dout, int gw, int NGW, int lane) {
    bf16* hlo = (bf16*)(ws + WS_HLO); bf16* hhi = (bf16*)(ws + WS_HHI); const bf16* y2 = (const bf16*)(ws + WS_Y2); const int* tok_s = (const int*)(ws + WS_TOKS); const float* tok_w = (const float*)(ws + WS_TOKW);
    f32x4 gv[4], bv[4];
#pragma unroll
    for (int j = 0; j < 4; ++j) { gv[j] = *(const f32x4*)(lng + 4 * lane + 256 * j); bv[j] = *(const f32x4*)(lnb + 4 * lane + 256 * j); }
    for (int m = gw; m < T; m += NGW) {
        const int s0 = tok_s[(size_t)m * 2], s1 = tok_s[(size_t)m * 2 + 1]; const float w0 = tok_w[(size_t)m * 2], w1 = tok_w[(size_t)m * 2 + 1];
        GAS u32x2* hr = (GAS u32x2*)(hhi + (size_t)m * D) + lane; GAS u32x2* lr = (GAS u32x2*)(hlo + (size_t)m * D) + lane;
        const GAS u32x2* ya = (const GAS u32x2*)(y2 + (size_t)s0 * D) + lane; const GAS u32x2* yb = (const GAS u32x2*)(y2 + (size_t)s1 * D) + lane;
        f32x4 v[4]; float s = 0.f;
#pragma unroll
        for (int j = 0; j < 4; ++j) { const u32x2 hh_ = hr[64 * j]; f32x4 h; h.x = bflo(hh_.x); h.y = bfhi(hh_.x); h.z = bflo(hh_.y); h.w = bfhi(hh_.y);
            if (RD_LO) { const u32x2 hl_ = lr[64 * j]; h.x += bflo(hl_.x); h.y += bfhi(hl_.x); h.z += bflo(hl_.y); h.w += bfhi(hl_.y); }
            const u32x2 a = ya[64 * j], b = yb[64 * j];
            v[j].x = sfma1(h.x, ALPHA, sfma1(w0, bflo(a.x), w1 * bflo(b.x))); v[j].y = sfma1(h.y, ALPHA, sfma1(w0, bfhi(a.x), w1 * bfhi(b.x))); v[j].z = sfma1(h.z, ALPHA, sfma1(w0, bflo(a.y), w1 * bflo(b.y))); v[j].w = sfma1(h.w, ALPHA, sfma1(w0, bfhi(a.y), w1 * bfhi(b.y)));
            s += sadd(sadd(v[j].x, v[j].y), sadd(v[j].z, v[j].w)); }
        const float mean = wave_sum(s) * (1.f / D); float s2 = 0.f;
#pragma unroll
        for (int j = 0; j < 4; ++j) { v[j] = v[j] - mean; s2 += (v[j].x * v[j].x + v[j].y * v[j].y) + (v[j].z * v[j].z + v[j].w * v[j].w); }
        const float rstd = 1.f / sqrtf(wave_sum(s2) * (1.f / D) + LN_EPS);
#pragma unroll
        for (int j = 0; j < 4; ++j) { const f32x4 h = v[j] * rstd * gv[j] + bv[j];
            if (FINAL) ((GAS f32x4*)(dout + (size_t)m * D) + lane)[64 * j] = h;
            else { u32x2 w; w.x = pk2(h.x, h.y); w.y = pk2(h.z, h.w); hr[64 * j] = w;
                   if (WR_LO) { u32x2 lo; lo.x = pk2(h.x - bflo(w.x), h.y - bfhi(w.x)); lo.y = pk2(h.z - bflo(w.y), h.w - bfhi(w.y)); lr[64 * j] = lo; } } }
    }
}
constexpr int S5_HST = 272, S5_UST = 272, S5_UOFF = 8 * 32 * S5_HST;
#define MFMA32(a, b, c) __builtin_amdgcn_mfma_f32_32x32x16_bf16((a), (b), (c), 0, 0, 0)
#define MFMA16(a, b, c) __builtin_amdgcn_mfma_f32_16x16x32_bf16((a), (b), (c), 0, 0, 0)
__device__ __forceinline__ float gelu_tanh(float x) {
    const float u = 0.7978845608028654f * (x + 0.044715f * x * x * x);
    const float e = __expf(2.f * u); const float th = 1.f - 2.f * __builtin_amdgcn_rcpf(e + 1.f);
    return 0.5f * x * (1.f + th);
}
#define S5_SCALAR_FMA 1
#define S5_PERMLANE 1
#define S5_NO_NOPS 1
#ifdef S5_SCALAR_FMA
__device__ __forceinline__ float sfma(float a, float b, float c) { float d; asm("v_fma_f32 %0, %1, %2, %3" : "=v"(d) : "v"(a), "v"(b), "v"(c)); return d; }
#define FMAF(a, b, c) sfma((a), (b), (c))
#else
#define FMAF(a, b, c) fmaf((a), (b), (c))
#endif
__device__ __forceinline__ f32x4 ld_ys(const float* p) {
    f32x4 v;
    v.x = __hip_atomic_load(p, __ATOMIC_RELAXED, __HIP_MEMORY_SCOPE_AGENT); v.y = __hip_atomic_load(p + 1, __ATOMIC_RELAXED, __HIP_MEMORY_SCOPE_AGENT);
    v.z = __hip_atomic_load(p + 2, __ATOMIC_RELAXED, __HIP_MEMORY_SCOPE_AGENT); v.w = __hip_atomic_load(p + 3, __ATOMIC_RELAXED, __HIP_MEMORY_SCOPE_AGENT);
    return v;
}
constexpr int CW_CHKA = 64, CW_CHKB = 65, CW_CHKC = 66, CW_CHKD = 67;
template <int PASS, int DIR, bool CHK = false>
__device__ __forceinline__ void s5_dir(unsigned char* ws, const float* s5d, int b, int g, int c, LAS unsigned char* hl, const LAS unsigned char* ul, float* yscr, int lane) {
    const bf16* h0 = (const bf16*)(ws + WS_H0);
    const int dg = DIR * 32 + g;
    const f32x4 L4 = *(const f32x4*)((const float*)(ws + WS_S5L) + (size_t)(dg * 64 + lane) * 4);
    const float ar = L4.x, ai = L4.y, qr = L4.z, qi = L4.w;
    const float l2r = ar * ar - ai * ai, l2i = 2.f * ar * ai, l4r = l2r * l2r - l2i * l2i, l4i = 2.f * l2r * l2i, l8r = l4r * l4r - l4i * l4i, l8i = 2.f * l4r * l4i;
    const float l16r = l8r * l8r - l8i * l8i, l16i = 2.f * l8r * l8i, l32r = l16r * l16r - l16i * l16i, l32i = 2.f * l16r * l16i;
    const bf16* Bb = (const bf16*)(ws + WS_S5B) + (size_t)dg * 2048 + (lane & 31) * 16 + 8 * (lane >> 5);
    const bf16x8 bre0 = *(const bf16x8*)Bb, bre1 = *(const bf16x8*)(Bb + 512), bim0 = *(const bf16x8*)(Bb + 1024), bim1 = *(const bf16x8*)(Bb + 1536);
    bf16x8 cf[4]; bf16x8 dfrag;
    if (PASS == 2) {
        const bf16* Cm = (const bf16*)(ws + WS_S5C) + (size_t)dg * 2048 + (lane & 15) * 128 + 8 * (lane >> 4);
#pragma unroll
        for (int ks = 0; ks < 4; ++ks) cf[ks] = *(const bf16x8*)(Cm + 32 * ks);
        if (DIR == 1) {
            const int cc = lane & 15, kq = lane >> 4; const float d = s5d[g * 16 + cc]; const unsigned dh = f2bf(d); const unsigned dl = f2bf(d - __uint_as_float(dh << 16));
#pragma unroll
            for (int j = 0; j < 8; ++j) { const int k = 8 * (kq & 1) + j; dfrag[j] = (short)((k == cc) ? (kq < 2 ? dh : dl) : 0u); }
        }
    }
    float hr = 0.f, hi = 0.f;
    float* Ec = (float*)(ws + WS_S5E) + ((size_t)((DIR * NB + b) * 32 + g) * S5NCH) * 128 + 2 * lane;
    if (PASS == 2) {
        const int nj = DIR == 0 ? c : (S5NCH - 1 - c);
        for (int j0 = 0; j0 < nj; j0 += 32) {
            f32x2 e[32];
#pragma unroll
            for (int q = 0; q < 32; ++q) { const int j = (j0 + q) < nj ? (j0 + q) : (nj - 1); const int jj = DIR == 0 ? j : (S5NCH - 1 - j); e[q] = *(const f32x2*)(Ec + (size_t)jj * 128); }
#pragma unroll
            for (int q = 0; q < 32; ++q) if (j0 + q < nj) { const float nr = FMAF(qr, hr, FMAF(-qi, hi, e[q].x)); hi = FMAF(qr, hi, FMAF(qi, hr, e[q].y)); hr = nr; }
        }
    }
    const size_t rowbase = (size_t)b * SEQ + (size_t)c * S5CH;
    const LAS unsigned char* up = ul + (lane & 31) * S5_UST + (g & 7) * 32 + 16 * (lane >> 5);
#ifdef S5_GLOBAL_U
    const bf16* ug = h0 + (rowbase + (lane & 31)) * H0P + OFF_U + g * 16 + 8 * (lane >> 5);
    bf16x8 a_next = *(const bf16x8*)(ug + (size_t)(DIR == 0 ? 0 : S5CH / 32 - 1) * 32 * H0P);
#endif
    const f32x16 zero16 = {0.f, 0.f, 0.f, 0.f, 0.f, 0.f, 0.f, 0.f, 0.f, 0.f, 0.f, 0.f, 0.f, 0.f, 0.f, 0.f};
#pragma unroll 1
    for (int ti = 0; ti < S5CH / 32; ++ti) {
        const int tile = DIR == 0 ? ti : (S5CH / 32 - 1 - ti);
#ifdef S5_GLOBAL_U
        const bf16x8 a = a_next;
        if (ti + 1 < S5CH / 32) a_next = *(const bf16x8*)(ug + (size_t)(DIR == 0 ? ti + 1 : S5CH / 32 - 2 - ti) * 32 * H0P);
        bf16x8 ufg[2];
        if (PASS == 2 && DIR == 1) {
#pragma unroll
            for (int sub = 0; sub < 2; ++sub) ufg[sub] = *(const bf16x8*)(h0 + (rowbase + tile * 32 + sub * 16 + (lane & 15)) * H0P + OFF_U + g * 16 + 8 * ((lane >> 4) & 1)); }
#else
        const bf16x8 a = *(const LAS bf16x8*)(up + tile * 32 * S5_UST);
#endif
        f32x4 ysv[2] = {{0.f, 0.f, 0.f, 0.f}, {0.f, 0.f, 0.f, 0.f}};
        if (PASS == 2 && DIR == 1) { ysv[0] = ld_ys(yscr + (size_t)(tile * 2) * 256 + 4 * lane); ysv[1] = ld_ys(yscr + (size_t)(tile * 2 + 1) * 256 + 4 * lane); }
        f32x16 xr0 = MFMA32(a, bre0, zero16), xr1 = MFMA32(a, bre1, zero16), xi0 = MFMA32(a, bim0, zero16), xi1 = MFMA32(a, bim1, zero16);
        asm volatile("" : "+v"(xr0), "+v"(xr1), "+v"(xi0), "+v"(xi1) : "v"(a));
#define S5_KEEP_A 1
#ifdef S5_SLEEP
        __builtin_amdgcn_sched_barrier(0); __builtin_amdgcn_s_sleep(16); __builtin_amdgcn_sched_barrier(0);
#endif
#if (defined(S5_PERMLANE) && !defined(S5_NO_NOPS)) || defined(S5_NOPS)
        __builtin_amdgcn_sched_barrier(0);
        asm volatile("s_nop 15\n\ts_nop 15\n\ts_nop 15\n\ts_nop 15\n\ts_nop 15\n\ts_nop 15" ::: "memory");
        __builtin_amdgcn_sched_barrier(0);
#endif
        float xr[32], xi[32];
#pragma unroll
        for (int r = 0; r < 16; ++r) {
#ifdef S5_PERMLANE
            auto s = __builtin_amdgcn_permlane32_swap(__float_as_uint(xr0[r]), __float_as_uint(xr1[r]), false, false);
            xr[crow(r, 0)] = __uint_as_float(s[0]); xr[crow(r, 1)] = __uint_as_float(s[1]);
            auto q = __builtin_amdgcn_permlane32_swap(__float_as_uint(xi0[r]), __float_as_uint(xi1[r]), false, false);
            xi[crow(r, 0)] = __uint_as_float(q[0]); xi[crow(r, 1)] = __uint_as_float(q[1]);
#else
            const bool up = lane >= 32; const int pa = (lane ^ 32) << 2;
            { const float sr = up ? xr0[r] : xr1[r], rr_ = __int_as_float(__builtin_amdgcn_ds_bpermute(pa, __float_as_int(sr)));
              xr[crow(r, 0)] = up ? rr_ : xr0[r]; xr[crow(r, 1)] = up ? xr1[r] : rr_; }
            { const float si = up ? xi0[r] : xi1[r], ri_ = __int_as_float(__builtin_amdgcn_ds_bpermute(pa, __float_as_int(si)));
              xi[crow(r, 0)] = up ? ri_ : xi0[r]; xi[crow(r, 1)] = up ? xi1[r] : ri_; }
#endif
        }
#ifdef S5_CHECK_X
        if (PASS == 1) { unsigned cs = 0u;
#pragma unroll
            for (int t = 0; t < 32; ++t) cs ^= (__float_as_uint(xr[t]) * (2u * t + 1u)) ^ (__float_as_uint(xi[t]) * (2u * t + 65u));
            unsigned* cw = (unsigned*)(ws + WS_OF) + ((size_t)((b * S5NCH + c) * 32 + g) * 2 + DIR) * 512 + tile * 64 + lane;
            if (CHK) { if (*cw != cs) atomicAdd((unsigned*)(ws + WS_CTL) + CW_CHKD, 1u); } else *cw = cs; }
#endif
#ifdef S5_KEEP_A
        asm volatile("" : "+v"(xi[31]), "+v"(xr[31]) : "v"(a));
#endif
        if (PASS == 1) {
#pragma unroll
            for (int lv = 0; lv < 5; ++lv) {
                const float pr = lv == 0 ? ar : lv == 1 ? l2r : lv == 2 ? l4r : lv == 3 ? l8r : l16r, pi = lv == 0 ? ai : lv == 1 ? l2i : lv == 2 ? l4i : lv == 3 ? l8i : l16i;
#pragma unroll
                for (int i = 0; i < (16 >> lv); ++i) {
                    const int e = DIR == 0 ? 2 * i : 2 * i + 1, l = DIR == 0 ? 2 * i + 1 : 2 * i;
                    const float er = xr[e << lv], ei = xi[e << lv], lr_ = xr[l << lv], li_ = xi[l << lv];
                    const float wr = FMAF(pr, er, FMAF(-pi, ei, lr_)), wi = FMAF(pr, ei, FMAF(pi, er, li_));
                    xr[(2 * i) << lv] = wr; xi[(2 * i) << lv] = wi;
                }
            }
            { const float nr = FMAF(l32r, hr, FMAF(-l32i, hi, xr[0])), ni = FMAF(l32r, hi, FMAF(l32i, hr, xi[0])); hr = nr; hi = ni; }
        } else {
#pragma unroll
        for (int tt = 0; tt < 32; ++tt) {
            const int t = DIR == 0 ? tt : 31 - tt;
            const float tr_ = FMAF(-ai, hi, xr[t]), ti_ = FMAF(ai, hr, xi[t]);
            hr = FMAF(ar, hr, tr_); hi = FMAF(ar, hi, ti_);
            *(LAS unsigned*)(hl + t * S5_HST + 4 * lane) = pk2(hr, hi);
        }
        }
        if (PASS == 2) {
#pragma unroll
            for (int sub = 0; sub < 2; ++sub) {
                float* ys = yscr + (size_t)(tile * 2 + sub) * 256 + 4 * lane;
                f32x4 y = {0.f, 0.f, 0.f, 0.f};
                if (DIR == 1) y = ysv[sub];
                bf16x8 hf[4];
#pragma unroll
                for (int ks = 0; ks < 4; ++ks) hf[ks] = *(const LAS bf16x8*)(hl + (sub * 16 + (lane & 15)) * S5_HST + 64 * ks + 16 * (lane >> 4));
#pragma unroll
                for (int ks = 0; ks < 4; ++ks) y = MFMA16(hf[ks], cf[ks], y);
                if (DIR == 0) *(f32x4*)ys = y;
                else {
#ifdef S5_GLOBAL_U
                    const bf16x8 uf = ufg[sub];
#else
                    const bf16x8 uf = *(const LAS bf16x8*)(ul + (tile * 32 + sub * 16 + (lane & 15)) * S5_UST + (g & 7) * 32 + 16 * ((lane >> 4) & 1));
#endif
                    y = MFMA16(uf, dfrag, y);
                    bf16* yo = (bf16*)(ws + WS_YG) + (rowbase + tile * 32 + sub * 16 + 4 * (lane >> 4)) * 512 + g * 16 + (lane & 15);
#pragma unroll
                    for (int r = 0; r < 4; ++r) { const bf16 nv = (bf16)f2bf(gelu_tanh(y[r]));
                        if (CHK) { if (yo[(size_t)r * 512] != nv) atomicAdd((unsigned*)(ws + WS_CTL) + CW_CHKB, 1u); } else yo[(size_t)r * 512] = nv; }

                }
            }
        }
    }
    if (PASS == 1) { f32x2 e; e.x = hr; e.y = hi;
        if (CHK) { const f32x2 o = *(const f32x2*)(Ec + (size_t)c * 128);
#ifndef S5_NO_EC
            if (__float_as_uint(o.x) != __float_as_uint(e.x) || __float_as_uint(o.y) != __float_as_uint(e.y)) {
                const float dn = fabsf(o.x - e.x) + fabsf(o.y - e.y), mg = fabsf(o.x) + fabsf(o.y) + fabsf(e.x) + fabsf(e.y);
                atomicAdd((unsigned*)(ws + WS_CTL) + (dn > 1e-3f * mg ? CW_CHKD : CW_CHKA), 1u); }
#endif
        }
        else *(f32x2*)(Ec + (size_t)c * 128) = e; }
}
constexpr int S5G_TP = 1040;
template <bool CHK = false>
__device__ __forceinline__ void s5_pass1_gemm(unsigned char* ws, LAS unsigned char* lds, int bid, int G, int tid, int wave, int lane) {
    const bf16* h0 = (const bf16*)(ws + WS_H0); const bf16* W32 = (const bf16*)(ws + WS_W32);
    for (int it = bid; it < 256; it += G) {
        const int g = it >> 3, cgi = it & 7, b = cgi >> 2, c0 = (cgi & 3) * 16;
        const size_t tok0 = (size_t)b * SEQ + (size_t)c0 * S5CH;
        { u32x4 v[16];
#pragma unroll
          for (int k = 0; k < 16; ++k) { const int idx = k * NTHR + tid, tk = idx >> 1, hf = idx & 1; v[k] = *(const u32x4*)(h0 + (tok0 + tk) * H0P + OFF_U + g * 16 + 8 * hf); }
          __syncthreads();
#pragma unroll
          for (int k = 0; k < 16; ++k) { const int idx = k * NTHR + tid, tk = idx >> 1, hf = idx & 1; *(LAS u32x4*)(lds + (tk >> 5) * S5G_TP + (tk & 31) * 32 + hf * 16) = v[k]; }
          __syncthreads(); }
        const int sg = wave & 3, dir = wave >> 2, dg = dir * 32 + g, p = 16 * sg + (lane & 15);
        const bf16* Wr = W32 + ((size_t)(dg * 2 + 0) * 64 + p) * 512 + 8 * (lane >> 4); const bf16* Wi = Wr + (size_t)64 * 512;
        f32x4 ar_[8], ai_[8];
#pragma unroll
        for (int m = 0; m < 8; ++m) { ar_[m] = f32x4{0.f, 0.f, 0.f, 0.f}; ai_[m] = f32x4{0.f, 0.f, 0.f, 0.f}; }
        const LAS unsigned char* ap = lds + (lane & 15) * S5G_TP + (lane >> 5) * 32 + ((lane >> 4) & 1) * 16;
#pragma unroll 4
        for (int q = 0; q < 16; ++q) {
            const bf16x8 br = *(const bf16x8*)(Wr + 32 * q), bi = *(const bf16x8*)(Wi + 32 * q);
#pragma unroll
            for (int m = 0; m < 8; ++m) { const bf16x8 a = *(const LAS bf16x8*)(ap + m * 16 * S5G_TP + q * 64); ar_[m] = MFMA16(a, br, ar_[m]); ai_[m] = MFMA16(a, bi, ai_[m]); }
        }
        const f32x4 L4 = *(const f32x4*)((const float*)(ws + WS_S5L) + (size_t)(dg * 64 + p) * 4);
        float pr = L4.x, pi = L4.y;
#pragma unroll
        for (int k = 0; k < 5; ++k) { const float t = pr * pr - pi * pi; pi = 2.f * pr * pi; pr = t; }
        const float l32r = pr, l32i = pi;
#pragma unroll
        for (int k = 0; k < 2; ++k) { const float t = pr * pr - pi * pi; pi = 2.f * pr * pi; pr = t; }
        const float l128r = pr, l128i = pi;
        const int lg = lane >> 4, half = lg & 1, chh = lg >> 1;
        float* Ec = (float*)(ws + (CHK ? WS_OF : WS_S5E)) + ((size_t)((dir * NB + b) * 32 + g) * S5NCH) * 128 + 2 * p;
#pragma unroll
        for (int m = 0; m < 8; ++m) {
            float er, ei;
            if (dir == 0) { er = ar_[m][0]; ei = ai_[m][0];
#pragma unroll
                for (int r = 1; r < 4; ++r) { const float nr = FMAF(l32r, er, FMAF(-l32i, ei, ar_[m][r])), ni = FMAF(l32r, ei, FMAF(l32i, er, ai_[m][r])); er = nr; ei = ni; } }
            else { er = ar_[m][3]; ei = ai_[m][3];
#pragma unroll
                for (int r = 2; r >= 0; --r) { const float nr = FMAF(l32r, er, FMAF(-l32i, ei, ar_[m][r])), ni = FMAF(l32r, ei, FMAF(l32i, er, ai_[m][r])); er = nr; ei = ni; } }
            const int pa = (lane ^ 16) << 2;
            const float qr_ = __int_as_float(__builtin_amdgcn_ds_bpermute(pa, __float_as_int(er))), qi_ = __int_as_float(__builtin_amdgcn_ds_bpermute(pa, __float_as_int(ei)));
            const float Er = FMAF(l128r, qr_, FMAF(-l128i, qi_, er)), Ei = FMAF(l128r, qi_, FMAF(l128i, qr_, ei));
            if (half == (dir == 0 ? 1 : 0)) { f32x2 e; e.x = Er; e.y = Ei; *(f32x2*)(Ec + (size_t)(c0 + 2 * m + chh) * 128) = e; }
        }
    }
}
struct S5Dir { float ar, ai, hr, hi; bf16x8 bre0, bre1, bim0, bim1, cf0, cf1, cf2, cf3, a_next; const bf16* ug; };
template <int DIR>
__device__ __forceinline__ void s5il_init(S5Dir& S, unsigned char* ws, int b, int g, int c, int lane) {
    const bf16* h0 = (const bf16*)(ws + WS_H0);
    const int dg = DIR * 32 + g;
    const f32x4 L4 = *(const f32x4*)((const float*)(ws + WS_S5L) + (size_t)(dg * 64 + lane) * 4);
    S.ar = L4.x; S.ai = L4.y; const float qr = L4.z, qi = L4.w;
    const bf16* Bb = (const bf16*)(ws + WS_S5B) + (size_t)dg * 2048 + (lane & 31) * 16 + 8 * (lane >> 5);
    S.bre0 = *(const bf16x8*)Bb; S.bre1 = *(const bf16x8*)(Bb + 512); S.bim0 = *(const bf16x8*)(Bb + 1024); S.bim1 = *(const bf16x8*)(Bb + 1536);
    const bf16* Cm = (const bf16*)(ws + WS_S5C) + (size_t)dg * 2048 + (lane & 15) * 128 + 8 * (lane >> 4);
    S.cf0 = *(const bf16x8*)(Cm); S.cf1 = *(const bf16x8*)(Cm + 32); S.cf2 = *(const bf16x8*)(Cm + 64); S.cf3 = *(const bf16x8*)(Cm + 96);
    float hr = 0.f, hi = 0.f;
    const float* Ec = (const float*)(ws + WS_S5E) + ((size_t)((DIR * NB + b) * 32 + g) * S5NCH) * 128 + 2 * lane;
    const int nj = DIR == 0 ? c : (S5NCH - 1 - c);
    for (int j0 = 0; j0 < nj; j0 += 32) {
        f32x2 e[32];
#pragma unroll
        for (int q = 0; q < 32; ++q) { const int j = (j0 + q) < nj ? (j0 + q) : (nj - 1); const int jj = DIR == 0 ? j : (S5NCH - 1 - j); e[q] = *(const f32x2*)(Ec + (size_t)jj * 128); }
#pragma unroll
        for (int q = 0; q < 32; ++q) if (j0 + q < nj) { const float nr = FMAF(qr, hr, FMAF(-qi, hi, e[q].x)); hi = FMAF(qr, hi, FMAF(qi, hr, e[q].y)); hr = nr; }
    }
    S.hr = hr; S.hi = hi;
    const size_t rowbase = (size_t)b * SEQ + (size_t)c * S5CH;
    S.ug = h0 + (rowbase + (lane & 31)) * H0P + OFF_U + g * 16 + 8 * (lane >> 5);
    S.a_next = *(const bf16x8*)(S.ug + (size_t)(DIR == 0 ? 0 : S5CH / 32 - 1) * 32 * H0P);
}
template <int DIR, bool FIN>
__device__ __forceinline__ void s5il_tile(S5Dir& S, unsigned char* ws, int tile, int next_tile, const bf16x8& dfrag, size_t rowbase, int g, LAS unsigned char* hl, float* yscr, int lane) {
    const bf16* h0 = (const bf16*)(ws + WS_H0);
    const bf16x8 a = S.a_next;
    if (next_tile >= 0) S.a_next = *(const bf16x8*)(S.ug + (size_t)next_tile * 32 * H0P);
    f32x4 ysv[2] = {{0.f, 0.f, 0.f, 0.f}, {0.f, 0.f, 0.f, 0.f}}; bf16x8 ufg[2];
    if (FIN) {
#pragma unroll
        for (int sub = 0; sub < 2; ++sub) { ysv[sub] = ld_ys(yscr + (size_t)(tile * 2 + sub) * 256 + 4 * lane);
            ufg[sub] = *(const bf16x8*)(h0 + (rowbase + tile * 32 + sub * 16 + (lane & 15)) * H0P + OFF_U + g * 16 + 8 * ((lane >> 4) & 1)); } }
    const f32x16 zero16 = {0.f, 0.f, 0.f, 0.f, 0.f, 0.f, 0.f, 0.f, 0.f, 0.f, 0.f, 0.f, 0.f, 0.f, 0.f, 0.f};
    f32x16 xr0 = MFMA32(a, S.bre0, zero16), xr1 = MFMA32(a, S.bre1, zero16), xi0 = MFMA32(a, S.bim0, zero16), xi1 = MFMA32(a, S.bim1, zero16);
    float xr[32], xi[32];
#pragma unroll
    for (int r = 0; r < 16; ++r) {
        auto s = __builtin_amdgcn_permlane32_swap(__float_as_uint(xr0[r]), __float_as_uint(xr1[r]), false, false);
        xr[crow(r, 0)] = __uint_as_float(s[0]); xr[crow(r, 1)] = __uint_as_float(s[1]);
        auto q = __builtin_amdgcn_permlane32_swap(__float_as_uint(xi0[r]), __float_as_uint(xi1[r]), false, false);
        xi[crow(r, 0)] = __uint_as_float(q[0]); xi[crow(r, 1)] = __uint_as_float(q[1]);
    }
    float hr = S.hr, hi = S.hi; const float ar = S.ar, ai = S.ai;
#pragma unroll
    for (int tt = 0; tt < 32; ++tt) {
        const int t = DIR == 0 ? tt : 31 - tt;
        const float tr_ = FMAF(-ai, hi, xr[t]), ti_ = FMAF(ai, hr, xi[t]);
        hr = FMAF(ar, hr, tr_); hi = FMAF(ar, hi, ti_);
        *(LAS unsigned*)(hl + t * S5_HST + 4 * lane) = pk2(hr, hi);
    }
    S.hr = hr; S.hi = hi;
#pragma unroll
    for (int sub = 0; sub < 2; ++sub) {
        f32x4 y = ysv[sub];
        const LAS unsigned char* hp = hl + (sub * 16 + (lane & 15)) * S5_HST + 16 * (lane >> 4);
        const bf16x8 hf0 = *(const LAS bf16x8*)(hp), hf1 = *(const LAS bf16x8*)(hp + 64), hf2 = *(const LAS bf16x8*)(hp + 128), hf3 = *(const LAS bf16x8*)(hp + 192);
        y = MFMA16(hf0, S.cf0, y); y = MFMA16(hf1, S.cf1, y); y = MFMA16(hf2, S.cf2, y); y = MFMA16(hf3, S.cf3, y);
        if (!FIN) *(f32x4*)(yscr + (size_t)(tile * 2 + sub) * 256 + 4 * lane) = y;
        else {
            y = MFMA16(ufg[sub], dfrag, y);
            bf16* yo = (bf16*)(ws + WS_YG) + (rowbase + tile * 32 + sub * 16 + 4 * (lane >> 4)) * 512 + g * 16 + (lane & 15);
#pragma unroll
            for (int r = 0; r < 4; ++r) yo[(size_t)r * 512] = (bf16)f2bf(gelu_tanh(y[r]));
        }
    }
}
__device__ __forceinline__ void s5_pass2_il(unsigned char* ws, const float* s5d, int b, int g, int c, LAS unsigned char* hl0, LAS unsigned char* hl1, float* yscr, int lane) {
    bf16x8 dfrag;
    { const int cc = lane & 15, kq = lane >> 4; const float d = s5d[g * 16 + cc]; const unsigned dh = f2bf(d); const unsigned dl = f2bf(d - __uint_as_float(dh << 16));
#pragma unroll
      for (int j = 0; j < 8; ++j) { const int k = 8 * (kq & 1) + j; dfrag[j] = (short)((k == cc) ? (kq < 2 ? dh : dl) : 0u); } }
    const size_t rowbase = (size_t)b * SEQ + (size_t)c * S5CH;
    S5Dir F, B;
    s5il_init<0>(F, ws, b, g, c, lane); s5il_init<1>(B, ws, b, g, c, lane);
#pragma unroll 1
    for (int k = 0; k < 4; ++k) {
        s5il_tile<0, false>(F, ws, k, k + 1, dfrag, rowbase, g, hl0, yscr, lane);
        s5il_tile<1, false>(B, ws, 7 - k, 6 - k, dfrag, rowbase, g, hl1, yscr, lane);
    }
    VM_WAIT();
#pragma unroll 1
    for (int k = 4; k < 8; ++k) {
        s5il_tile<0, true>(F, ws, k, k + 1 < 8 ? k + 1 : -1, dfrag, rowbase, g, hl0, yscr, lane);
        s5il_tile<1, true>(B, ws, 7 - k, 6 - k, dfrag, rowbase, g, hl1, yscr, lane);
    }
}
template <int PASS, bool CHK = false>
__device__ __forceinline__ void s5_phase(unsigned char* ws, const float* s5d, LAS unsigned char* lds, int bid, int G, int tid, int wave, int lane) {
    LAS unsigned char* hl = lds + wave * (32 * S5_HST); LAS unsigned char* ul = lds + S5_UOFF;
    float* yscr = (float*)(ws + WS_YSCR) + (size_t)(bid * NWAVES + wave) * 4096;
    const bf16* h0 = (const bf16*)(ws + WS_H0);
#ifdef S5_IL
    if (PASS == 2 && !CHK) {
        LAS unsigned char* hl0 = lds + wave * (64 * S5_HST); LAS unsigned char* hl1 = hl0 + 32 * S5_HST;
        for (int it = bid; it < NB * S5NCH * 4; it += G) {
            const int go = it & 3, c = (it >> 2) % S5NCH, b = it / (4 * S5NCH), g = go * 8 + wave;
            s5_pass2_il(ws, s5d, b, g, c, hl0, hl1, yscr, lane);
        }
        return;
    }
#endif
    for (int it = bid; it < NB * S5NCH * 4; it += G) {
        const int go = it & 3, c = (it >> 2) % S5NCH, b = it / (4 * S5NCH), g = go * 8 + wave;
#ifndef S5_GLOBAL_U
        { const bf16* src = h0 + ((size_t)b * SEQ + (size_t)c * S5CH) * H0P + OFF_U + go * 128;
          u32x4 v[8];
#pragma unroll
          for (int i = 0; i < 8; ++i) { const int p = i * NTHR + tid; v[i] = *(const u32x4*)(src + (size_t)(p >> 4) * H0P + 8 * (p & 15)); }
#ifdef S5_CHECK_IN
          { unsigned cs = 0u;
#pragma unroll
            for (int i = 0; i < 8; ++i) cs ^= v[i].x ^ (v[i].y * 3u) ^ (v[i].z * 5u) ^ (v[i].w * 7u);
            unsigned* cw = (unsigned*)(ws + WS_LR) + (size_t)(PASS - 1) * 512 * 512 + (size_t)it * 512 + tid;
            if (CHK) { if (*cw != cs) atomicAdd((unsigned*)(ws + WS_CTL) + CW_CHKC, 1u); } else *cw = cs; }
#endif
          __syncthreads();
#pragma unroll
          for (int i = 0; i < 8; ++i) { const int p = i * NTHR + tid; *(LAS u32x4*)(ul + (p >> 4) * S5_UST + 16 * (p & 15)) = v[i]; }
          __syncthreads(); }
#endif
#ifdef S5_SERIAL
        if (wave < 4) { s5_dir<PASS, 0, CHK>(ws, s5d, b, g, c, hl, ul, yscr, lane); s5_dir<PASS, 1, CHK>(ws, s5d, b, g, c, hl, ul, yscr, lane); }
        LDS_BARRIER();
        if (wave >= 4) { s5_dir<PASS, 0, CHK>(ws, s5d, b, g, c, hl, ul, yscr, lane); s5_dir<PASS, 1, CHK>(ws, s5d, b, g, c, hl, ul, yscr, lane); }
#else
        s5_dir<PASS, 0, CHK>(ws, s5d, b, g, c, hl, ul, yscr, lane);
        s5_dir<PASS, 1, CHK>(ws, s5d, b, g, c, hl, ul, yscr, lane);
#endif
    }
}
constexpr int G_ST = 144;
constexpr int GL_QD = 0, GL_KD = GL_QD + 64 * G_ST, GL_KCT = GL_KD + 64 * G_ST, GL_VT = GL_KCT + 64 * G_ST, GL_IMG = GL_VT + 128 * G_ST,
              GL_S = 2 * GL_IMG, GL_ST = GL_S + 64 * G_ST, GL_END = GL_ST + 2 * 128 * G_ST;
static_assert(GL_END <= MISC_OFF, "GLA LDS");
__device__ __forceinline__ bf16x8 ldfrag32(const LAS unsigned char* base, int row0, int ks, int lane) {
    return *(const LAS bf16x8*)(base + (row0 + (lane & 31)) * G_ST + 32 * ks + 16 * (lane >> 5));
}
__device__ __forceinline__ void gate_tail(float* bcg, const float* gate_w, const float* gate_b, const LAS float* lrs, size_t row0, int tid) {
    const int dir = tid >> 8;
    float gw[16];
#pragma unroll
    for (int r = 0; r < 16; ++r) gw[r] = gate_w[(size_t)(dir * 16 + r) * 256 + (tid & 255)];
    const float gb = gate_b[tid];
    float run = 0.f;
#pragma unroll 4
    for (int i = 0; i < 128; ++i) {
        const int t = dir ? 127 - i : i;
        if ((i & 63) == 0) run = 0.f;
        const LAS f32x4* lp = (const LAS f32x4*)(lrs + t * 32 + dir * 16);
        const f32x4 l0 = lp[0], l1 = lp[1], l2 = lp[2], l3 = lp[3];
        float z = gb + l0.x * gw[0] + l0.y * gw[1] + l0.z * gw[2] + l0.w * gw[3] + l1.x * gw[4] + l1.y * gw[5] + l1.z * gw[6] + l1.w * gw[7]
                     + l2.x * gw[8] + l2.y * gw[9] + l2.z * gw[10] + l2.w * gw[11] + l3.x * gw[12] + l3.y * gw[13] + l3.z * gw[14] + l3.w * gw[15];
        const float ls = fminf(z, 0.f) - __logf(1.f + __expf(-fabsf(z)));
        run += ls * (1.0f / 16.0f);
        bcg[(row0 + t) * 512 + tid] = run;
    }
}
__device__ __forceinline__ size_t gla_tok(int b, int dir, int chunk, int s) { const int pos = chunk * GCH + s; return (size_t)b * SEQ + (dir ? (SEQ - 1 - pos) : pos); }
template <int PASS>
__device__ __forceinline__ void gla_item(unsigned char* ws, const float* bcg, int item, LAS unsigned char* lds, int tid, int wave, int lane) {
    const int sc = item % GNSC, dir = (item / GNSC) & 1, h = (item / (GNSC * 2)) & 3, b = item / (GNSC * 8);
    const bf16* h0 = (const bf16*)(ws + WS_H0);
    LAS unsigned char* QD = lds + GL_QD; LAS unsigned char* KD = lds + GL_KD; LAS unsigned char* KCT = lds + GL_KCT; LAS unsigned char* VT = lds + GL_VT; LAS unsigned char* SS = lds + GL_S; LAS unsigned char* STT = lds + GL_ST;
    const int me = wave >> 1, nd = wave & 1;
    f32x16 st;
#pragma unroll
    for (int r = 0; r < 16; ++r) st[r] = 0.f;
    float dtot = 1.f;
    float* GS = (float*)(ws + WS_GS); float* GD = (float*)(ws + WS_GD);
    const int ibase = item - sc;
    if (PASS == 2) {
        for (int j0 = 0; j0 < sc; j0 += 4) {
            float dj[4], gv[4][16];
#pragma unroll
            for (int q = 0; q < 4; ++q) { const int j = (j0 + q) < sc ? (j0 + q) : (sc - 1);
                dj[q] = GD[(size_t)(ibase + j) * 64 + nd * 32 + (lane & 31)];
                const float* gs = GS + (size_t)(ibase + j) * 8192 + nd * 32 + (lane & 31);
#pragma unroll
                for (int r = 0; r < 16; ++r) gv[q][r] = gs[(size_t)(me * 32 + crow(r, lane >> 5)) * 64]; }
#pragma unroll
            for (int q = 0; q < 4; ++q) if (j0 + q < sc) {
#pragma unroll
                for (int r = 0; r < 16; ++r) st[r] = st[r] * dj[q] + gv[q][r]; }
        }
#pragma unroll
        for (int r = 0; r < 16; ++r) *(LAS bf16*)(STT + (me * 32 + crow(r, lane >> 5)) * G_ST + (nd * 32 + (lane & 31)) * 2) = (bf16)f2bf(st[r]);
    }
    const float qscale = 0.125f;
    const int s_l = lane;
    const int gcol = dir * 256 + h * 64;
    u32x4 pq, pk, pv0, pv1; f32x4 pb0, pb1, pl0, pl1; float pdec;
#define GLA_LOAD(n) do { const int ch_ = sc * GSC + (n); const size_t tk = gla_tok(b, dir, ch_, s_l), tl = gla_tok(b, dir, ch_, 63); const bf16* rp = h0 + tk * H0P; \
        if (PASS == 2) pq = *(const u32x4*)(rp + OFF_Q + h * 64 + 8 * wave); \
        pk = *(const u32x4*)(rp + OFF_K + h * 64 + 8 * wave); pv0 = *(const u32x4*)(rp + OFF_V + h * 128 + 16 * wave); pv1 = *(const u32x4*)(rp + OFF_V + h * 128 + 16 * wave + 8); \
        pb0 = *(const f32x4*)(bcg + tk * 512 + gcol + 8 * wave); pb1 = *(const f32x4*)(bcg + tk * 512 + gcol + 8 * wave + 4); \
        pl0 = *(const f32x4*)(bcg + tl * 512 + gcol + 8 * wave); pl1 = *(const f32x4*)(bcg + tl * 512 + gcol + 8 * wave + 4); \
        pdec = bcg[tl * 512 + gcol + nd * 32 + (lane & 31)]; } while (0)
#define GLA_STEP_A(IMG) do { LAS unsigned char* QD_ = (IMG) + GL_QD; LAS unsigned char* KD_ = (IMG) + GL_KD; LAS unsigned char* KCT_ = (IMG) + GL_KCT; LAS unsigned char* VT_ = (IMG) + GL_VT; \
        const float bc[8] = {pb0.x, pb0.y, pb0.z, pb0.w, pb1.x, pb1.y, pb1.z, pb1.w}, bl[8] = {pl0.x, pl0.y, pl0.z, pl0.w, pl1.x, pl1.y, pl1.z, pl1.w}; \
        const float kv[8] = {bflo(pk.x), bfhi(pk.x), bflo(pk.y), bfhi(pk.y), bflo(pk.z), bfhi(pk.z), bflo(pk.w), bfhi(pk.w)}; \
        if (PASS == 2) { const float qv[8] = {bflo(pq.x), bfhi(pq.x), bflo(pq.y), bfhi(pq.y), bflo(pq.z), bfhi(pq.z), bflo(pq.w), bfhi(pq.w)}; float qd[8], kd[8]; \
            _Pragma("unroll") for (int i = 0; i < 8; ++i) { qd[i] = qv[i] * qscale * __expf(bc[i]); kd[i] = kv[i] * __expf(-bc[i]); } \
            u32x4 w; w.x = pk2(qd[0], qd[1]); w.y = pk2(qd[2], qd[3]); w.z = pk2(qd[4], qd[5]); w.w = pk2(qd[6], qd[7]); *(LAS u32x4*)(QD_ + s_l * G_ST + 16 * wave) = w; \
            w.x = pk2(kd[0], kd[1]); w.y = pk2(kd[2], kd[3]); w.z = pk2(kd[4], kd[5]); w.w = pk2(kd[6], kd[7]); *(LAS u32x4*)(KD_ + s_l * G_ST + 16 * wave) = w; } \
        _Pragma("unroll") for (int i = 0; i < 8; ++i) *(LAS bf16*)(KCT_ + (8 * wave + i) * G_ST + 2 * s_l) = (bf16)f2bf(kv[i] * __expf(bl[i] - bc[i])); \
        const unsigned vv[8] = {pv0.x, pv0.y, pv0.z, pv0.w, pv1.x, pv1.y, pv1.z, pv1.w}; \
        _Pragma("unroll") for (int i = 0; i < 8; ++i) { *(LAS bf16*)(VT_ + (16 * wave + 2 * i) * G_ST + 2 * s_l) = (bf16)(vv[i] & 0xffffu); *(LAS bf16*)(VT_ + (16 * wave + 2 * i + 1) * G_ST + 2 * s_l) = (bf16)(vv[i] >> 16); } \
        dec_n = __expf(pdec); } while (0)
#define GLA_STEP_B(IMG, STW, WRITE_ST) do { LAS unsigned char* QD_ = (IMG) + GL_QD; LAS unsigned char* KD_ = (IMG) + GL_KD; LAS unsigned char* KCT_ = (IMG) + GL_KCT; LAS unsigned char* VT_ = (IMG) + GL_VT; \
        if (PASS == 2 && wave < 4) { const int ms = wave >> 1, ns = wave & 1; f32x16 sa; \
            _Pragma("unroll") for (int r = 0; r < 16; ++r) sa[r] = 0.f; \
            if (ns <= ms) { _Pragma("unroll") for (int ks = 0; ks < 4; ++ks) sa = MFMA32(ldfrag32(QD_, ms * 32, ks, lane), ldfrag32(KD_, ns * 32, ks, lane), sa); } \
            _Pragma("unroll") for (int r = 0; r < 16; ++r) { const int s = ms * 32 + crow(r, lane >> 5), s2 = ns * 32 + (lane & 31); const bool keep = dir ? (s2 < s) : (s2 <= s); \
                *(LAS bf16*)(SS + s * G_ST + 2 * s2) = (bf16)f2bf(keep ? sa[r] : 0.f); } } \
        _Pragma("unroll") for (int r = 0; r < 16; ++r) st[r] *= dec_c; \
        dtot *= dec_c; \
        _Pragma("unroll") for (int ks = 0; ks < 4; ++ks) st = MFMA32(ldfrag32(VT_, me * 32, ks, lane), ldfrag32(KCT_, nd * 32, ks, lane), st); \
        if (PASS == 2 && (WRITE_ST)) { _Pragma("unroll") for (int r = 0; r < 16; ++r) *(LAS bf16*)((STW) + (me * 32 + crow(r, lane >> 5)) * G_ST + (nd * 32 + (lane & 31)) * 2) = (bf16)f2bf(st[r]); } } while (0)
    float dec_n = 1.f, dec_c = 1.f;
    LAS unsigned char* IMG0 = lds; LAS unsigned char* IMG1 = lds + GL_IMG;
    GLA_LOAD(0);
    __syncthreads();
    GLA_STEP_A(IMG0); dec_c = dec_n;
    if (1 < GSC) GLA_LOAD(1);
    LDS_BARRIER();
    if (PASS == 2) { GLA_STEP_B(IMG0, STT + 128 * G_ST, true); LDS_BARRIER(); }
#pragma unroll 1
    for (int n = 0; n < GSC; ++n) {
        LAS unsigned char* Ic = (n & 1) ? IMG1 : IMG0; LAS unsigned char* In = (n & 1) ? IMG0 : IMG1;
        LAS unsigned char* STc = STT + (n & 1) * (128 * G_ST);
        if (PASS == 2) {
            const int ms = wave >> 2, ne = wave & 3;
            f32x16 oa;
#pragma unroll
            for (int r = 0; r < 16; ++r) oa[r] = 0.f;
#pragma unroll
            for (int ks = 0; ks < 4; ++ks) oa = MFMA32(ldfrag32(SS, ms * 32, ks, lane), ldfrag32(Ic + GL_VT, ne * 32, ks, lane), oa);
#pragma unroll
            for (int ks = 0; ks < 4; ++ks) oa = MFMA32(ldfrag32(Ic + GL_QD, ms * 32, ks, lane), ldfrag32(STc, ne * 32, ks, lane), oa);
            bf16* op = (bf16*)(ws + (dir ? WS_OB : WS_OF)) + h * 128 + ne * 32 + (lane & 31);
#pragma unroll
            for (int r = 0; r < 16; ++r) op[gla_tok(b, dir, sc * GSC + n, ms * 32 + crow(r, lane >> 5)) * 512] = (bf16)f2bf(oa[r]);
        } else {
            GLA_STEP_B(Ic, STT, false);
        }
        if (n + 1 < GSC) { GLA_STEP_A(In); if (n + 2 < GSC) GLA_LOAD(n + 2); }
        LDS_BARRIER();
        if (PASS == 2 && n + 1 < GSC) { dec_c = dec_n; GLA_STEP_B(In, STT + (n & 1) * (128 * G_ST), n + 2 < GSC); LDS_BARRIER(); }
        if (PASS == 1) dec_c = dec_n;
    }
#undef GLA_STEP_A
#undef GLA_STEP_B
    if (PASS == 1) {
        float* gs = GS + (size_t)item * 8192 + nd * 32 + (lane & 31);
#pragma unroll
        for (int r = 0; r < 16; ++r) gs[(size_t)(me * 32 + crow(r, lane >> 5)) * 64] = st[r];
        if (me == 0 && lane < 32) GD[(size_t)item * 64 + nd * 32 + lane] = dtot;
    }
    __syncthreads();
#undef GLA_LOAD
}
constexpr int AT_KST = 144, AT_VST = 664, AT_K = 0, AT_V = 320 * AT_KST, AT_BT = AT_V + 64 * AT_VST, AT_END = AT_BT + 16 * 260 * 4;
static_assert(AT_END <= RING_BYTES && AT_V % 16 == 0 && AT_BT % 16 == 0, "attention LDS");
__device__ __forceinline__ void attn_phase(unsigned char* ws, const float* sink, LAS unsigned char* lds, int bid, int G, int tid, int wave, int lane) {
    const bf16* qkv = (const bf16*)(ws + WS_QKV); bf16* ao = (bf16*)(ws + WS_AO); const float* btab = (const float*)(ws + WS_BTAB);
    LAS unsigned char* KS = lds + AT_K; LAS unsigned char* VT = lds + AT_V; LAS float* BT = (LAS float*)(lds + AT_BT);
    const float sc2 = 0.125f * LOG2E;
    u32x4 kreg[5], vreg[5]; bf16x8 qreg[4]; float sreg;
    for (int p = tid; p < 16 * 260; p += NTHR) BT[p] = btab[p];
#define AT_LOAD(u_) do { const int qb_ = (u_) % (SEQ / 64), kvh_ = ((u_) / (SEQ / 64)) & 3, b_ = (u_) / (4 * (SEQ / 64)), kb_ = qb_ * 64 - 128; \
        _Pragma("unroll") for (int it = 0; it < 5; ++it) { const int p = it * NTHR + tid; int key = kb_ + (p >> 3); key = key < 0 ? 0 : (key > SEQ - 1 ? SEQ - 1 : key); \
            const bf16* rp = qkv + ((size_t)b_ * SEQ + key) * CN + kvh_ * 64 + 8 * (p & 7); kreg[it] = *(const u32x4*)(rp + 1024); vreg[it] = *(const u32x4*)(rp + 1280); } \
        { const int hq_ = kvh_ * 4 + (wave >> 1); const bf16* qp_ = qkv + ((size_t)b_ * SEQ + qb_ * 64 + 32 * (wave & 1) + (lane & 31)) * CN + hq_ * 64 + 8 * (lane >> 5); \
          _Pragma("unroll") for (int ks = 0; ks < 4; ++ks) qreg[ks] = *(const bf16x8*)(qp_ + 16 * ks); sreg = sink[hq_]; } } while (0)
    if (bid < NB * 4 * (SEQ / 64)) AT_LOAD(bid);
    for (int u = bid; u < NB * 4 * (SEQ / 64); u += G) {
        const int qb = u % (SEQ / 64), kvh = (u / (SEQ / 64)) & 3, b = u / (4 * (SEQ / 64)), q0 = qb * 64;
#pragma unroll
        for (int it = 0; it < 5; ++it) { const int p = it * NTHR + tid, i = p >> 3, ch = p & 7;
            *(LAS u32x4*)(KS + i * AT_KST + 16 * ch) = kreg[it];
            const unsigned vv[4] = {vreg[it].x, vreg[it].y, vreg[it].z, vreg[it].w};
#pragma unroll
            for (int j = 0; j < 4; ++j) { *(LAS bf16*)(VT + (8 * ch + 2 * j) * AT_VST + 2 * i) = (bf16)(vv[j] & 0xffffu); *(LAS bf16*)(VT + (8 * ch + 2 * j + 1) * AT_VST + 2 * i) = (bf16)(vv[j] >> 16); } }
        const bf16x8 qf[4] = {qreg[0], qreg[1], qreg[2], qreg[3]}; const float m0 = sreg * LOG2E;
        if (u + G < NB * 4 * (SEQ / 64)) AT_LOAD(u + G);
        LDS_BARRIER();
        const int hl = wave >> 1, hq = kvh * 4 + hl, qw = q0 + 32 * (wave & 1), qi = qw + (lane & 31), hh = lane >> 5;
        float m = m0, l = hh == 0 ? 1.f : 0.f;
        f32x16 o0, o1;
#pragma unroll
        for (int r = 0; r < 16; ++r) { o0[r] = 0.f; o1[r] = 0.f; }
        const LAS float* btl = BT + hq * 260 + 128 - (lane & 31);
        const bool edge = (q0 < 128) || (q0 + 192 > SEQ);
#pragma unroll 1
        for (int j = 0; j < 9; ++j) {
            const int i0 = 32 * (wave & 1) + 32 * j;
            f32x16 sa;
#pragma unroll
            for (int r = 0; r < 16; ++r) sa[r] = 0.f;
#pragma unroll
            for (int ks = 0; ks < 4; ++ks) { const bf16x8 kf = *(const LAS bf16x8*)(KS + (i0 + (lane & 31)) * AT_KST + 32 * ks + 16 * hh); sa = MFMA32(kf, qf[ks], sa); }
            float mx = -3.0e38f;
#pragma unroll
            for (int r = 0; r < 16; ++r) {
                const int kk = 32 * j - 128 + crow(r, hh);
                sa[r] = sa[r] * sc2 + btl[kk];
            }
            if (edge || j == 0 || j == 8) {
#pragma unroll
                for (int r = 0; r < 16; ++r) {
                    const int kk = 32 * j - 128 + crow(r, hh), rel = kk - (lane & 31), key = qw + kk;
                    const bool ok = ((unsigned)(rel + 128) <= 256u) && ((unsigned)key < (unsigned)SEQ);
                    sa[r] = ok ? sa[r] : -3.0e38f;
                }
            }
#pragma unroll
            for (int r = 0; r < 16; ++r) mx = fmaxf(mx, sa[r]);
            mx = fmaxf(mx, __shfl_xor(mx, 32));
            if (!__all(mx <= m)) {
                const float mn = fmaxf(m, mx), alpha = __builtin_amdgcn_exp2f(m - mn); m = mn; l *= alpha;
#pragma unroll
                for (int r = 0; r < 16; ++r) { o0[r] *= alpha; o1[r] *= alpha; }
            }
            float ps = 0.f;
#pragma unroll
            for (int r = 0; r < 16; ++r) { const float p = __builtin_amdgcn_exp2f(sa[r] - m); sa[r] = p; ps += p; }
            l += ps;
#pragma unroll
            for (int s = 0; s < 2; ++s) {
                u32x4 pw; pw.x = pk2(sa[8 * s], sa[8 * s + 1]); pw.y = pk2(sa[8 * s + 2], sa[8 * s + 3]); pw.z = pk2(sa[8 * s + 4], sa[8 * s + 5]); pw.w = pk2(sa[8 * s + 6], sa[8 * s + 7]);
                const bf16x8 pf = __builtin_bit_cast(bf16x8, pw);
#pragma unroll
                for (int dt = 0; dt < 2; ++dt) {
                    const LAS unsigned char* vp = VT + (dt * 32 + (lane & 31)) * AT_VST + 2 * (i0 + 16 * s + 4 * hh);
                    const bf16x4 va = *(const LAS bf16x4*)vp, vb = *(const LAS bf16x4*)(vp + 16);
                    const bf16x8 vf = __builtin_shufflevector(va, vb, 0, 1, 2, 3, 4, 5, 6, 7);
                    if (dt == 0) o0 = MFMA32(vf, pf, o0); else o1 = MFMA32(vf, pf, o1);
                }
            }
        }
        l += __shfl_xor(l, 32);
        const float inv = __builtin_amdgcn_rcpf(l);
        bf16* op = ao + ((size_t)b * SEQ + qi) * D + hq * 64 + 4 * hh;
#pragma unroll
        for (int g = 0; g < 4; ++g) {
            u32x2 w0, w1; w0.x = pk2(o0[4 * g] * inv, o0[4 * g + 1] * inv); w0.y = pk2(o0[4 * g + 2] * inv, o0[4 * g + 3] * inv);
            w1.x = pk2(o1[4 * g] * inv, o1[4 * g + 1] * inv); w1.y = pk2(o1[4 * g + 2] * inv, o1[4 * g + 3] * inv);
            *(u32x2*)(op + 8 * g) = w0; *(u32x2*)(op + 32 + 8 * g) = w1;
        }
        LDS_BARRIER();
    }
#undef AT_LOAD
}
#ifndef MK_N_LAUNCHES
#define MK_N_LAUNCHES 1
#endif
constexpr int N_PHASES = 19;

#ifndef KEEP_LO1
#define KEEP_LO1 false
#endif
#ifndef KEEP_LO2
#define KEEP_LO2 false
#endif
#ifndef KEEP_LO3
#define KEEP_LO3 false
#endif
#ifndef PH_MASK
#define PH_MASK 0xFFFFFFFFu
#endif
#define ON(k) (((PH_MASK) >> (k)) & 1u)
#ifndef REP_MASK
#define REP_MASK 0u
#endif
#ifndef REP_N
#define REP_N 2
#endif
#define NREP(k) ((((REP_MASK) >> (k)) & 1u) ? 2 : 1)

template <int LAYER>
__device__ __forceinline__ void common_phases(unsigned char* ws, LAS unsigned char* lds, float* dout, const XcdBarrier& bar, int lo, int hi, int bid, int G, int tid, int wave, int lane) {
    constexpr int pb = LAYER == 0 ? 5 : 13;
    const int gw = bid * NWAVES + wave, NGW = G * NWAVES;
#define IN(k) (lo <= (k) && (k) < hi)
#define SEAM(k) do { if (IN(k) && IN((k) + 1)) xcd_barrier(bar); } while (0)
    if (ON(5) && IN(pb)) {
        pg8::Gemm g{(const bf16*)(ws + (LAYER == 0 ? WS_X64 : WS_AO)), (const bf16*)(ws + (LAYER == 0 ? WS_WOUT : WS_COUT)), T, D, D, 0, nullptr}; pg8::StaticOrder S; S.init(T, D, G, bid);
        pg8::EpiBf16 E{(bf16*)(ws + WS_Z), D};
        pg8::gemm_phase<pg8::EpiBf16, pg8::StaticOrder, false>(lds, g, S, E);
    }
    SEAM(pb);
    if (ON(6) && IN(pb + 1)) { ln_router<LAYER == 0, KEEP_LO2, (LAYER == 0 ? KEEP_LO1 : KEEP_LO3)>(ws, inp(lds, I_X), inp(lds, I_LNMG) + LAYER * D, inp(lds, I_LNMB) + LAYER * D, inp(lds, I_BGRP) + LAYER * 4, inp(lds, I_BRT) + LAYER * 32, LAYER, lds, bid, G, tid, wave, lane); __syncthreads(); }
    SEAM(pb + 1);
    if (ON(7) && IN(pb + 2)) { moe_sort(ws, lds, bid, G, tid); __syncthreads(); }
    SEAM(pb + 2);
    if (ON(8) && IN(pb + 3)) {
        const int* tile = (const int*)(ws + WS_TILE); const int ntiles = __builtin_amdgcn_readfirstlane(tile[511]);
        pg8::Gemm g{(const bf16*)(ws + WS_HHI), LAYER == 0 ? (const bf16*)(ws + WS_W13) : (const bf16*)dout, 0, D, D, (size_t)D * D * 2, (const int*)(ws + WS_SLOTT)};
        pg8::GroupOrder S{tile, ntiles, D / 256, G, bid};
        pg8::EpiSwiglu E{(bf16*)(ws + WS_HID), DEXP};
        pg8::gemm_phase<pg8::EpiSwiglu, pg8::GroupOrder, true>(lds, g, S, E);
#ifndef CONV_OVERLAP
        if (LAYER == 0) idle_convert(0, ws, lds, dout, ntiles, bid, G, wave, lane);
#endif
    }
    SEAM(pb + 3);
    if (ON(9) && IN(pb + 4)) {
        const int* tile = (const int*)(ws + WS_TILE); const int ntiles = __builtin_amdgcn_readfirstlane(tile[511]);
        pg8::Gemm g{(const bf16*)(ws + WS_HID), LAYER == 0 ? (const bf16*)(ws + WS_W2) : (const bf16*)dout + (size_t)NEXP * D * D, 0, D, DEXP, (size_t)D * DEXP * 2, nullptr};
        pg8::GroupOrder S{tile, ntiles, D / 256, G, bid};
        pg8::EpiBf16 E{(bf16*)(ws + WS_Y2), D};
        pg8::gemm_phase<pg8::EpiBf16, pg8::GroupOrder, false>(lds, g, S, E);
#ifndef CONV_OVERLAP
        if (LAYER == 0) idle_convert(1, ws, lds, dout, ntiles, bid, G, wave, lane);
#endif
    }
    SEAM(pb + 4);
    if (ON(10) && IN(pb + 5)) {
        if (LAYER == 0) {
            combine_ln<false, KEEP_LO1, KEEP_LO2>(ws, inp(lds, I_LNFG), inp(lds, I_LNFB), nullptr, gw, NGW, lane);
#ifndef CONV_OVERLAP
            { const int done = idle_done(__builtin_amdgcn_readfirstlane(((const int*)(ws + WS_TILE))[511]), G);
              moe_convert(inp(lds, I_W1) + (size_t)NEXP * D * DEXP, inp(lds, I_W3) + (size_t)NEXP * D * DEXP, inp(lds, I_W2) + (size_t)NEXP * DEXP * D, (bf16*)dout, (bf16*)dout + (size_t)NEXP * D * D, (LAS float*)(lds + wave * 16384), done, MOE_ITEMS, gw, NGW, lane); }
#endif
            __syncthreads();
        } else combine_ln<true, KEEP_LO3, false>(ws, inp(lds, I_LNFG) + D, inp(lds, I_LNFB) + D, dout, gw, NGW, lane);
    }
    if (LAYER == 0) SEAM(10);
#undef IN
#undef SEAM
}

struct Args { const float* in[N_IN]; float* out; unsigned char* ws; int ph_lo, ph_hi; };
static_assert(sizeof(Args) == N_IN * 8 + 8 + 8 + 8, "no padding holes in Args");

__global__ void __launch_bounds__(NTHR, 2) fwd_kernel(Args args) {
    extern __shared__ __attribute__((aligned(16))) unsigned char lds_raw[];
    LAS unsigned char* lds = (LAS unsigned char*)lds_raw;
    volatile LAS unsigned* MISC = (volatile LAS unsigned*)(lds + MISC_OFF);
    const int tid = threadIdx.x, lane = tid & 63, wave = __builtin_amdgcn_readfirstlane(tid >> 6), G = gridDim.x, bid = blockIdx.x;
    unsigned char* ws = args.ws;
    for (int u = tid; u < 64; u += NTHR) MISC[u] = 0u;
    if (tid < N_IN) *(LAS unsigned long long*)(lds + PTR_OFF + 8 * tid) = (unsigned long long)args.in[tid];
    __syncthreads();
    const int lo = args.ph_lo, hi = args.ph_hi;
    const bool use_bar = (hi - lo) > 1;
    XcdBarrier bar; bar.bar = (unsigned*)(ws + WS_CTL) + CW_BAR; bar.x = 0; bar.st = nullptr;
    if (use_bar) bar = xcd_barrier_post((unsigned*)(ws + WS_CTL) + CW_BAR, MISC + 8);
#define IN(k) (lo <= (k) && (k) < hi)
#define SEAM(k) do { if (IN(k) && IN((k) + 1)) xcd_barrier(bar); } while (0)
    const int gw = bid * NWAVES + wave, NGW = G * NWAVES;

    if (ON(0) && IN(0)) { p0_prologue(ws, lds, bid, G, tid, wave, lane); __syncthreads(); }
    SEAM(0);
    if (ON(1) && IN(1)) {
#ifdef CONV_OVERLAP
        half_convert(0, 0, ws, lds, args.out, bid, G, wave, lane); __syncthreads();
#endif
        pg8::Gemm g{(const bf16*)(ws + WS_X64), (const bf16*)(ws + WS_WIN), T, ABN, D, 0, nullptr}; pg8::SplitOrder S; S.init(T, ABN, 2, G, bid);
        pg8::EpiBf16 E{(bf16*)(ws + WS_H0), H0P};
        pg8::gemm_phase<pg8::EpiBf16, pg8::SplitOrder, false>(lds, g, S, E);
        lr_tail(ws, args.out, inp(lds, I_GATEW), inp(lds, I_GATEB), lds, bid, G, tid, wave, lane);
#ifdef TAIL_TWICE
        lr_tail(ws, args.out, inp(lds, I_GATEW), inp(lds, I_GATEB), lds, bid, G, tid, wave, lane);
#endif
#ifdef CONV_OVERLAP
        __syncthreads(); half_convert(0, 1, ws, lds, args.out, bid, G, wave, lane);
#endif
    }
    SEAM(1);
    if (ON(2) && IN(2)) {
#ifdef S5_OLD_PASS1
        s5_phase<1>(ws, inp(lds, I_S5D), lds, bid, G, tid, wave, lane);
#else
        s5_pass1_gemm<false>(ws, lds, bid, G, tid, wave, lane);
#ifdef S5A_TWICE
        __syncthreads(); s5_pass1_gemm<false>(ws, lds, bid, G, tid, wave, lane); __syncthreads(); s5_pass1_gemm<false>(ws, lds, bid, G, tid, wave, lane);
#endif
#endif
#ifdef S5A_CHECK
        VM_WAIT(); __syncthreads(); s5_pass1_gemm<true>(ws, lds, bid, G, tid, wave, lane); VM_WAIT(); __syncthreads();
#endif
#ifdef S5_TWICE
        __syncthreads(); s5_phase<1>(ws, inp(lds, I_S5D), lds, bid, G, tid, wave, lane);
#endif
#ifdef S5_CHECK
        VM_WAIT(); __syncthreads(); s5_phase<1, true>(ws, inp(lds, I_S5D), lds, bid, G, tid, wave, lane);
#endif
        __syncthreads();
        for (int it = bid; it < 256; it += G) gla_item<1>(ws, args.out, it, lds, tid, wave, lane);
#ifdef GLA_TWICE
        for (int it = bid; it < 256; it += G) gla_item<1>(ws, args.out, it, lds, tid, wave, lane);
#endif
    }
    SEAM(2);
    if (ON(3) && IN(3)) {
#ifdef S5A_CHECK
        { const float* ea = (const float*)(ws + WS_S5E); const float* eb = (const float*)(ws + WS_OF); float num = 0.f, den = 0.f;
          for (int i = bid * NTHR + tid; i < 2 * NB * 32 * S5NCH * 128; i += G * NTHR) { const float a = ea[i], d = a - eb[i]; num += d * d; den += a * a; }
          num = wave_sum(num); den = wave_sum(den);
          if (lane == 0) { atomicAdd((float*)(ws + WS_CTL) + 70, num); atomicAdd((float*)(ws + WS_CTL) + 71, den); } }
#endif
        s5_phase<2>(ws, inp(lds, I_S5D), lds, bid, G, tid, wave, lane);
#ifdef S5_TWICE
        __syncthreads(); s5_phase<2>(ws, inp(lds, I_S5D), lds, bid, G, tid, wave, lane);
#endif
#ifdef S5_CHECK2
        VM_WAIT(); __syncthreads(); s5_phase<2, true>(ws, inp(lds, I_S5D), lds, bid, G, tid, wave, lane);
#endif
        __syncthreads();
        for (int it = bid; it < 256; it += G) gla_item<2>(ws, args.out, it, lds, tid, wave, lane);
#ifdef GLA_TWICE
        for (int it = bid; it < 256; it += G) gla_item<2>(ws, args.out, it, lds, tid, wave, lane);
#endif
    }
    SEAM(3);
    if (ON(4) && IN(4)) {
        gla_finalize(ws, inp(lds, I_NORMG), gw, NGW, lane);
        pg8::Gemm g{(const bf16*)(ws + WS_YG), (const bf16*)(ws + WS_WGLU), T, 512, 512, 0, nullptr}; pg8::StaticOrder S; S.init(T, 512, G, bid);
        pg8::EpiGlu E{(const bf16*)(ws + WS_YG), 512, (bf16*)(ws + WS_X64), D, inp(lds, I_GLUB)};
        pg8::gemm_phase<pg8::EpiGlu, pg8::StaticOrder, false>(lds, g, S, E);
    }
    SEAM(4);
    common_phases<0>(ws, lds, args.out, bar, lo, hi, bid, G, tid, wave, lane);
    if (ON(11) && IN(11)) {
#ifdef CONV_OVERLAP
        half_convert(1, 0, ws, lds, args.out, bid, G, wave, lane); __syncthreads();
#endif
        pg8::Gemm g{(const bf16*)(ws + WS_H2B), (const bf16*)(ws + WS_CIN), T, CN, D, 0, nullptr}; pg8::StaticOrder S; S.init(T, CN, G, bid);
        pg8::EpiBf16 E{(bf16*)(ws + WS_QKV), CN};
        pg8::gemm_phase<pg8::EpiBf16, pg8::StaticOrder, false>(lds, g, S, E);
#ifdef CONV_OVERLAP
        VM_WAIT(); __syncthreads(); half_convert(1, 1, ws, lds, args.out, bid, G, wave, lane);
#endif
    }
    SEAM(11);
    if (ON(12) && IN(12)) attn_phase(ws, inp(lds, I_SINK), lds, bid, G, tid, wave, lane);
    SEAM(12);
    common_phases<1>(ws, lds, args.out, bar, lo, hi, bid, G, tid, wave, lane);
#ifdef S5A_CHECK
    if (IN(18)) { VM_WAIT(); __syncthreads();
        if (bid == 0 && tid == 0) { const float num = __hip_atomic_load((float*)(ws + WS_CTL) + 70, __ATOMIC_RELAXED, __HIP_MEMORY_SCOPE_AGENT), den = __hip_atomic_load((float*)(ws + WS_CTL) + 71, __ATOMIC_RELAXED, __HIP_MEMORY_SCOPE_AGENT);
            const float ratio = num / fmaxf(den, 1e-30f);
            if (!(ratio <= 1e-3f)) args.out[3] = 6000.f; else if (ratio > 1e-4f) args.out[3] = 600.f; else if (ratio > 1e-5f) args.out[3] = 200.f; } }
#endif
#if defined(S5_CHECK) || defined(S5_CHECK2) || defined(GLA_CHECK) || defined(ATT_CHECK)
    if (IN(18)) { VM_WAIT(); __syncthreads();
        if (bid == 0 && tid == 0) { unsigned* cw = (unsigned*)(ws + WS_CTL);
            const unsigned ca = __hip_atomic_load(cw + CW_CHKA, __ATOMIC_RELAXED, __HIP_MEMORY_SCOPE_AGENT), cb = __hip_atomic_load(cw + CW_CHKB, __ATOMIC_RELAXED, __HIP_MEMORY_SCOPE_AGENT);
            const unsigned cc = __hip_atomic_load(cw + CW_CHKC, __ATOMIC_RELAXED, __HIP_MEMORY_SCOPE_AGENT), cd = __hip_atomic_load(cw + CW_CHKD, __ATOMIC_RELAXED, __HIP_MEMORY_SCOPE_AGENT);
            if (ca) args.out[0] = 600.f; if (cb) args.out[1] = 60000.f;
            if (cc) args.out[2] = 1.0e36f; if (cd) args.out[3] = 6000.f; } }
#endif
#undef IN
#undef SEAM
}

#ifdef DET_PROBE
__global__ void cs_kernel(const unsigned char* base, int nrows, int rowbytes, size_t pitch, const int* ntile_ptr, unsigned* acc) {
    if (ntile_ptr) { const int r = ntile_ptr[511] * 256; nrows = r < nrows ? r : nrows; }
    unsigned s = 0u; const int wpr = rowbytes >> 2;
    for (int r = blockIdx.x; r < nrows; r += gridDim.x) { const unsigned* row = (const unsigned*)(base + (size_t)r * pitch);
        for (int c = threadIdx.x; c < wpr; c += blockDim.x) s += row[c] * (2u * (unsigned)(r * 131 + c) + 1u); }
    for (int o = 1; o < 64; o <<= 1) s += __shfl_xor(s, o);
    if ((threadIdx.x & 63) == 0) atomicAdd(acc, s);
}
__global__ void flag_kernel(const unsigned* acc, float* out) {
    const int k = threadIdx.x; if (k >= 19) return;
    const float ex[19] = {0.f, 2000.f, 2000.f, 2000.f, 2000.f, 2000.f, 2000.f, 2000.f, 2000.f, 2000.f, 2000.f, 2000.f, 2000.f, 2000.f, 0.f, 0.f, 2000.f, 2000.f, 2000.f};
    if (ex[k] > 0.f && acc[2 * k] != acc[2 * k + 1]) out[k] = ex[k];
}
#endif
extern "C" void kernel_launch(void* const* d_in, const int* in_sizes, int n_in, void* d_out, int out_size, void* d_ws, size_t ws_size, hipStream_t stream) {
    static int grid = 0;
    if (grid == 0) {
        if (n_in != N_IN || in_sizes[0] != T * D || out_size != T * D || ws_size < WS_END) { fprintf(stderr, "kernel_launch: unexpected shapes (n_in %d, in0 %d, out %d, ws %zu < %zu)\n", n_in, n_in > 0 ? in_sizes[0] : -1, out_size, ws_size, (size_t)WS_END); grid = -1; return; }
        int dev = 0, cus = 0, per_cu = 0;
        if (hipGetDevice(&dev) != hipSuccess || hipDeviceGetAttribute(&cus, hipDeviceAttributeMultiprocessorCount, dev) != hipSuccess) { grid = -1; return; }
        if (hipFuncSetAttribute((const void*)fwd_kernel, hipFuncAttributeMaxDynamicSharedMemorySize, LDS_BYTES) != hipSuccess) { fprintf(stderr, "kernel_launch: hipFuncSetAttribute failed\n"); grid = -1; return; }
        if (hipOccupancyMaxActiveBlocksPerMultiprocessor(&per_cu, (const void*)fwd_kernel, NTHR, LDS_BYTES) != hipSuccess || per_cu < 1) fprintf(stderr, "kernel_launch: occupancy query reports %d\n", per_cu);
        (void)hipGetLastError();
        grid = cus;
    }
    if (grid < 0) return;
    if (hipMemsetAsync((char*)d_ws + WS_CTL, 0, CTL_ZERO_BYTES, stream) != hipSuccess) return;
    Args a{};
    for (int i = 0; i < N_IN; ++i) a.in[i] = (const float*)d_in[i];
    a.out = (float*)d_out; a.ws = (unsigned char*)d_ws;
#ifdef DET_PROBE
    { unsigned char* ws = (unsigned char*)d_ws; unsigned* accb = (unsigned*)(ws + WS_CTL) + 128; const int* tl = (const int*)(ws + WS_TILE);
      auto CS = [&](int k, int rep, const void* b, int nrows, int rowbytes, size_t pitch, const int* ntp) { hipLaunchKernelGGL(cs_kernel, dim3(1024), dim3(256), 0, stream, (const unsigned char*)b, nrows, rowbytes, pitch, ntp, accb + 2 * k + rep); };
      for (int li = 0; li < N_PHASES; ++li) {
        a.ph_lo = li; a.ph_hi = li + 1;
        const bool probe = (li >= 1 && li <= 6) || li == 8 || li == 9 || li == 11 || li == 12 || li == 13 || li == 16 || li == 17 || li == 18;
        for (int rep = 0; rep < (probe ? 2 : 1); ++rep) {
            hipLaunchKernelGGL(fwd_kernel, dim3(grid), dim3(NTHR), LDS_BYTES, stream, a);
            if (!probe) continue;
            switch (li) {
            case 1: CS(li, rep, ws + WS_H0, T, 4096, (size_t)H0P * 2, nullptr); CS(li, rep, d_out, T, 2048, 2048, nullptr); break;
            case 2: CS(li, rep, ws + WS_S5E, 4096, 1024, 1024, nullptr); CS(7, rep, ws + WS_GS, 8192, 1024, 1024, nullptr); CS(7, rep, ws + WS_GD, 64, 1024, 1024, nullptr); break;
            case 3: CS(li, rep, ws + WS_YG, T, 1024, 1024, nullptr); CS(10, rep, ws + WS_OF, T, 1024, 1024, nullptr); CS(10, rep, ws + WS_OB, T, 1024, 1024, nullptr); break;
            case 4: CS(li, rep, ws + WS_X64, T, 2048, 2048, nullptr); break;
            case 5: case 13: CS(li, rep, ws + WS_Z, T, 2048, 2048, nullptr); break;
            case 6: CS(li, rep, ws + WS_HHI, T, 2048, 2048, nullptr); CS(li, rep, ws + WS_TOKE, 256, 1024, 1024, nullptr); CS(li, rep, ws + WS_TOKW, 256, 1024, 1024, nullptr); break;
            case 8: case 16: CS(li, rep, ws + WS_HID, CAP, 1024, 1024, tl); break;
            case 9: case 17: CS(li, rep, ws + WS_Y2, CAP, 2048, 2048, tl); break;
            case 11: CS(li, rep, ws + WS_QKV, T, 3072, 3072, nullptr); break;
            case 12: CS(li, rep, ws + WS_AO, T, 2048, 2048, nullptr); break;
            case 18: CS(li, rep, d_out, T, 4096, 4096, nullptr); break;
            } } }
      hipLaunchKernelGGL(flag_kernel, dim3(1), dim3(64), 0, stream, (const unsigned*)accb, (float*)d_out);
      return; }
#endif
    for (int li = 0; li < MK_N_LAUNCHES; ++li) {
        a.ph_lo = (MK_N_LAUNCHES == 1) ? 0 : li; a.ph_hi = (MK_N_LAUNCHES == 1) ? N_PHASES : li + 1;
        for (int rep = 0; rep < ((MK_N_LAUNCHES > 1 && ((REP_MASK >> li) & 1u)) ? REP_N : 1); ++rep)
            hipLaunchKernelGGL(fwd_kernel, dim3(grid), dim3(NTHR), LDS_BYTES, stream, a);
    }
}
```

```cpp
#include <hip/hip_runtime.h>
#include <cstdio>
#include <cstdint>
#include <cmath>
#define GROUP_XCD 1
namespace pg8 {
#define PG8_LAS __attribute__((address_space(3)))
typedef unsigned short bf16_t;
typedef short bf16x8 __attribute__((ext_vector_type(8)));
typedef float f32x4 __attribute__((ext_vector_type(4)));
typedef float f32x2 __attribute__((ext_vector_type(2)));
typedef unsigned u32x4 __attribute__((ext_vector_type(4)));
typedef unsigned u32x2 __attribute__((ext_vector_type(2)));
constexpr int BM = 256, BK = 64, HALF = 128, HTB = HALF * BK * 2  , STAGE_BYTES = 8 * HTB, NXCD = 8, WGM = 8;

__host__ __device__ __forceinline__ int lds_byte(int r, int c) { const int st = (r >> 4) * 2 + (c >> 5), rr = r & 15, cc = c & 31, ob = rr * 64 + cc * 2; return st * 1024 + (ob ^ (((ob >> 9) & 1) << 5)); }
__host__ __device__ __forceinline__ void stage_rc(int b, int& R, int& C) { const int st = b / 1024, sb = b % 1024, swz = sb ^ (((sb >> 9) & 1) << 5); R = (st >> 1) * 16 + swz / 64; C = (st & 1) * 32 + (swz % 64) / 2; }
__host__ __device__ __forceinline__ int perm32(int rho) { const int n = rho >> 4, i = rho & 15; return 8 * (i >> 2) + 4 * n + (i & 3); }

struct Unit { int pm, pn, e, ui; };
struct Gemm { const bf16_t* A; const bf16_t* Bt; int M, N, K; size_t bstride; const int* rowmap; };

struct StaticOrder {
    int nM, nN, nwg, G, c;
    __host__ __device__ void init(int M, int N, int G_, int c_) { nM = M / BM; nN = N / BM; nwg = nM * nN; G = G_; c = c_; }
    __host__ __device__ bool next(int i, Unit& u) const {
        const long L = (long)i * G + c; if (L >= nwg) return false;
        int wgid = (int)L; { const int q = nwg / NXCD, r = nwg % NXCD, xcd = wgid % NXCD, off = wgid / NXCD; wgid = (xcd < r ? xcd * (q + 1) : r * (q + 1) + (xcd - r) * q) + off; }
        const int nig = WGM * nN, gid = wgid / nig, fm = gid * WGM, gsz = (nM - fm) < WGM ? (nM - fm) : WGM;
        u.pm = fm + ((wgid % nig) % gsz); u.pn = (wgid % nig) / gsz; u.e = 0; u.ui = i; return true;
    }
};
struct SplitOrder {
    int nM, nNs, nwgs, nsp, G, c;
    __host__ __device__ void init(int M, int N, int nsp_, int G_, int c_) { nM = M / BM; nNs = N / BM / nsp_; nwgs = nM * nNs; nsp = nsp_; G = G_; c = c_; }
    __host__ __device__ bool next(int i, Unit& u) const {
        const long L = (long)i * G + c; if (L >= (long)nwgs * nsp) return false;
        const int slab = (int)(L / nwgs); int wgid = (int)(L % nwgs);
        { const int q = nwgs / NXCD, r = nwgs % NXCD, xcd = wgid % NXCD, off = wgid / NXCD; wgid = (xcd < r ? xcd * (q + 1) : r * (q + 1) + (xcd - r) * q) + off; }
        const int nig = WGM * nNs, gid = wgid / nig, fm = gid * WGM, gsz = (nM - fm) < WGM ? (nM - fm) : WGM;
        u.pm = fm + ((wgid % nig) % gsz); u.pn = slab * nNs + (wgid % nig) / gsz; u.e = 0; u.ui = i; return true;
    }
};
struct GroupOrder {
    const int* tile_e; int ntiles, nN, G, c;
#ifdef GROUP_XCD
    __device__ bool next(int i, Unit& u) const {
        const int x = c & 7, r = c >> 3, W = G >> 3, t0 = (x * ntiles) >> 3, t1 = ((x + 1) * ntiles) >> 3, Lx = i * W + r;
        if (Lx >= (t1 - t0) * nN) return false;
        u.pm = t0 + Lx / nN; u.pn = Lx % nN; u.e = __builtin_amdgcn_readfirstlane(tile_e[u.pm]); u.ui = i; return true;
    }
    __device__ int pm_of(int i) const { const int x = c & 7, r = c >> 3, W = G >> 3, t0 = (x * ntiles) >> 3, t1 = ((x + 1) * ntiles) >> 3, Lx = i * W + r; return Lx < (t1 - t0) * nN ? t0 + Lx / nN : -1; }
    __device__ int units(int x) const { return ((((x + 1) * ntiles) >> 3) - ((x * ntiles) >> 3)) * nN; }
    __device__ int maxcount() const { int m = 0; const int W = G >> 3; for (int x = 0; x < 8; ++x) { const int k = (units(x) + W - 1) / W; m = k > m ? k : m; } return m; }
    __device__ int thr(int x, int mx) const { const int W = G >> 3, n = units(x); if ((n + W - 1) / W < mx) return 0; const int t = n - (mx - 1) * W; return t < W ? t : W; }
#else
    __device__ bool next(int i, Unit& u) const {
        const int L = i * G + c; if (L >= ntiles * nN) return false;
        u.pm = L / nN; u.pn = L % nN; u.e = __builtin_amdgcn_readfirstlane(tile_e[u.pm]); u.ui = i; return true;
    }
#endif
};

typedef __bf16 bf16x2_t __attribute__((ext_vector_type(2)));
__device__ __forceinline__ unsigned cvt_pk_bf16(float lo, float hi) { f32x2 v = {lo, hi}; return __builtin_bit_cast(unsigned, __builtin_convertvector(v, bf16x2_t)); }
__device__ __forceinline__ float bf_lo(unsigned w) { return __uint_as_float(w << 16); }
__device__ __forceinline__ float bf_hi(unsigned w) { return __uint_as_float(w & 0xffff0000u); }

struct EpiBf16 {
    static constexpr bool PERM = true;
    bf16_t* O; int ldc;
    __device__ __forceinline__ void operator()(const f32x4 (&acc)[2][2][4][2], const Unit& u, int wr, int wc, int fr, int fq) const {
        const int row0 = u.pm * BM + wr * 64 + fr; const int col0 = u.pn * BM + wc * 32 + 8 * fq;
#pragma unroll
        for (int ai = 0; ai < 2; ++ai)
#pragma unroll
            for (int m = 0; m < 4; ++m) { bf16_t* rowp = O + (size_t)(row0 + ai * HALF + m * 16) * ldc + col0;
#pragma unroll
                for (int bj = 0; bj < 2; ++bj) { const f32x4 v0 = acc[ai][bj][m][0], v1 = acc[ai][bj][m][1];
                    u32x4 w; w.x = cvt_pk_bf16(v0[0], v0[1]); w.y = cvt_pk_bf16(v0[2], v0[3]); w.z = cvt_pk_bf16(v1[0], v1[1]); w.w = cvt_pk_bf16(v1[2], v1[3]);
                    *(u32x4*)(rowp + bj * HALF) = w; } }
    }
};
struct EpiGlu {
    static constexpr bool PERM = true;
    const bf16_t* Y; int ldy; bf16_t* O; int ldc; const float* bias;
    __device__ __forceinline__ void operator()(const f32x4 (&acc)[2][2][4][2], const Unit& u, int wr, int wc, int fr, int fq) const {
        const int row0 = u.pm * BM + wr * 64 + fr; const int col0 = u.pn * BM + wc * 32 + 8 * fq;
        f32x4 bv[2][2];
#pragma unroll
        for (int bj = 0; bj < 2; ++bj)
#pragma unroll
            for (int n = 0; n < 2; ++n) bv[bj][n] = *(const f32x4*)(bias + col0 + bj * HALF + 4 * n);
#pragma unroll
        for (int ai = 0; ai < 2; ++ai) {
            u32x4 yq[4][2];
#pragma unroll
            for (int m = 0; m < 4; ++m)
#pragma unroll
                for (int bj = 0; bj < 2; ++bj) yq[m][bj] = *(const u32x4*)(Y + (size_t)(row0 + ai * HALF + m * 16) * ldy + col0 + bj * HALF);
            asm volatile("" ::: "memory");
#pragma unroll
            for (int m = 0; m < 4; ++m) { const size_t r = (size_t)(row0 + ai * HALF + m * 16);
#pragma unroll
                for (int bj = 0; bj < 2; ++bj) { const f32x4 v0 = acc[ai][bj][m][0] + bv[bj][0], v1 = acc[ai][bj][m][1] + bv[bj][1];
                    const u32x4 y = yq[m][bj];
                    float o[8]; const float yv[8] = {bf_lo(y.x), bf_hi(y.x), bf_lo(y.y), bf_hi(y.y), bf_lo(y.z), bf_hi(y.z), bf_lo(y.w), bf_hi(y.w)};
#pragma unroll
                    for (int i = 0; i < 4; ++i) { o[i] = yv[i] * __builtin_amdgcn_rcpf(1.f + __expf(-v0[i])); o[4 + i] = yv[4 + i] * __builtin_amdgcn_rcpf(1.f + __expf(-v1[i])); }
                    u32x4 w; w.x = cvt_pk_bf16(o[0], o[1]); w.y = cvt_pk_bf16(o[2], o[3]); w.z = cvt_pk_bf16(o[4], o[5]); w.w = cvt_pk_bf16(o[6], o[7]);
                    *(u32x4*)(O + r * ldc + col0 + bj * HALF) = w; } }
            asm volatile("" ::: "memory");
        }
    }
};
struct EpiResid {
    static constexpr bool PERM = false;
    const float* resid; float* out; int ldc; float alpha;
    __device__ __forceinline__ void operator()(const f32x4 (&acc)[2][2][4][2], const Unit& u, int wr, int wc, int fr, int fq) const {
        const int col0 = u.pn * BM + wc * 32 + 4 * fq;
#pragma unroll
        for (int ai = 0; ai < 2; ++ai) {
            f32x4 bs[4][2][2];
#pragma unroll
            for (int m = 0; m < 4; ++m) { const size_t off = (size_t)(u.pm * BM + ai * HALF + wr * 64 + m * 16 + fr) * ldc + col0;
#pragma unroll
                for (int bj = 0; bj < 2; ++bj)
#pragma unroll
                    for (int n = 0; n < 2; ++n) bs[m][bj][n] = *(const f32x4*)(resid + off + bj * HALF + n * 16); }
            asm volatile("" ::: "memory");
#pragma unroll
            for (int m = 0; m < 4; ++m) { const size_t off = (size_t)(u.pm * BM + ai * HALF + wr * 64 + m * 16 + fr) * ldc + col0;
#pragma unroll
                for (int bj = 0; bj < 2; ++bj)
#pragma unroll
                    for (int n = 0; n < 2; ++n) *(f32x4*)(out + off + bj * HALF + n * 16) = bs[m][bj][n] * alpha + acc[ai][bj][m][n]; }
            asm volatile("" ::: "memory");
        }
    }
};
struct EpiSwiglu {
    static constexpr bool PERM = true;
    bf16_t* O; int ldc;
    __device__ __forceinline__ void operator()(const f32x4 (&acc)[2][2][4][2], const Unit& u, int wr, int wc, int fr, int fq) const {
        const int row0 = u.pm * BM + wr * 64 + fr; const int col0 = (u.pn * BM + wc * 32 + 8 * fq) >> 1;
#pragma unroll
        for (int ai = 0; ai < 2; ++ai)
#pragma unroll
            for (int m = 0; m < 4; ++m) { bf16_t* rowp = O + (size_t)(row0 + ai * HALF + m * 16) * ldc + col0;
#pragma unroll
                for (int bj = 0; bj < 2; ++bj) { const f32x4 g = acc[ai][bj][m][0], up = acc[ai][bj][m][1]; float o[4];
#pragma unroll
                    for (int i = 0; i < 4; ++i) o[i] = g[i] * __builtin_amdgcn_rcpf(1.f + __expf(-g[i])) * up[i];
                    u32x2 w; w.x = cvt_pk_bf16(o[0], o[1]); w.y = cvt_pk_bf16(o[2], o[3]);
                    *(u32x2*)(rowp + bj * (HALF / 2)) = w; } }
    }
};
struct EpiScale {
    static constexpr bool PERM = true;
    bf16_t* O; int ldc; const float* rw;
    __device__ __forceinline__ void operator()(const f32x4 (&acc)[2][2][4][2], const Unit& u, int wr, int wc, int fr, int fq) const {
        const int row0 = u.pm * BM + wr * 64 + fr; const int col0 = u.pn * BM + wc * 32 + 8 * fq;
        float sw[2][4];
#pragma unroll
        for (int ai = 0; ai < 2; ++ai)
#pragma unroll
            for (int m = 0; m < 4; ++m) sw[ai][m] = rw[row0 + ai * HALF + m * 16];
        asm volatile("" ::: "memory");
#pragma unroll
        for (int ai = 0; ai < 2; ++ai)
#pragma unroll
            for (int m = 0; m < 4; ++m) { const int r = row0 + ai * HALF + m * 16; const float s = sw[ai][m]; bf16_t* rowp = O + (size_t)r * ldc + col0;
#pragma unroll
                for (int bj = 0; bj < 2; ++bj) { const f32x4 v0 = acc[ai][bj][m][0] * s, v1 = acc[ai][bj][m][1] * s;
                    u32x4 w; w.x = cvt_pk_bf16(v0[0], v0[1]); w.y = cvt_pk_bf16(v0[2], v0[3]); w.z = cvt_pk_bf16(v1[0], v1[1]); w.w = cvt_pk_bf16(v1[2], v1[3]);
                    *(u32x4*)(rowp + bj * HALF) = w; } }
    }
};

template <class Epi, class Sched, bool GATHER>
__device__ __forceinline__ void gemm_phase(PG8_LAS unsigned char* lds, const Gemm g, const Sched& S, const Epi& E) {
    const int tid = threadIdx.x, wid = __builtin_amdgcn_readfirstlane(tid >> 6), lane = tid & 63, wr = wid >> 2, wc = wid & 3, fr = lane & 15, fq = lane >> 4;
    const int K = g.K, nt = K / BK;
    unsigned voffA[2], voffB[2]; int RA[2], CA[2];
#pragma unroll
    for (int i = 0; i < 2; ++i) { int R, C; stage_rc(tid * 16 + i * 8192, R, C); const int Rb = Epi::PERM ? ((R & ~31) + perm32(R & 31)) : R;
        voffA[i] = (unsigned)(R * K + C) * 2u; voffB[i] = (unsigned)(Rb * K + C) * 2u; RA[i] = R; CA[i] = C; }
    const size_t kstep = (size_t)(BK * 2);
    const size_t hstep = (size_t)HALF * K * 2;
    const size_t tstep = 2 * hstep;
    const unsigned ldsw = (unsigned)wid * 1024u;
    const int aoff = lds_byte(wr * 64 + fr, fq * 8), boff = lds_byte(wc * 32 + fr, fq * 8);
#define PG8_SA(b, h) (((b) * 2 + (h)) * HTB)
#define PG8_SB(b, h) ((4 + (b) * 2 + (h)) * HTB)
#define PG8_STAGE(bufoff, gbase, voff) do { _Pragma("unroll") for (int _i = 0; _i < 2; ++_i) \
        __builtin_amdgcn_global_load_lds((const unsigned*)((const char*)(gbase) + (voff)[_i]), (PG8_LAS unsigned*)(lds + (bufoff) + ldsw + _i * 8192), 16, 0, 0); } while (0)
#define PG8_LDA(dst, b, h) do { _Pragma("unroll") for (int m = 0; m < 4; ++m) _Pragma("unroll") for (int k = 0; k < 2; ++k) dst[m][k] = *(const PG8_LAS bf16x8*)(lds + PG8_SA(b, h) + aoff + m * 2048 + k * 1024); } while (0)
#define PG8_LDB(dst, b, h) do { _Pragma("unroll") for (int n = 0; n < 2; ++n) _Pragma("unroll") for (int k = 0; k < 2; ++k) dst[n][k] = *(const PG8_LAS bf16x8*)(lds + PG8_SB(b, h) + boff + n * 2048 + k * 1024); } while (0)
#define PG8_MMA(ai, bj, At, Bt) do { __builtin_amdgcn_s_setprio(1); _Pragma("unroll") for (int m = 0; m < 4; ++m) _Pragma("unroll") for (int n = 0; n < 2; ++n) _Pragma("unroll") for (int k = 0; k < 2; ++k) \
        acc[ai][bj][m][n] = __builtin_amdgcn_mfma_f32_16x16x32_bf16(Bt[n][k], At[m][k], acc[ai][bj][m][n], 0, 0, 0); __builtin_amdgcn_s_setprio(0); } while (0)
#define PG8_WAIT_V(n) asm volatile("s_waitcnt vmcnt(" #n ")" ::: "memory")
#define PG8_WAIT_L(n) asm volatile("s_waitcnt lgkmcnt(" #n ")" ::: "memory")
#define PG8_BAR __builtin_amdgcn_s_barrier()
#define PG8_SCHED __builtin_amdgcn_sched_barrier(0)
    Unit cur, nxt; int ui = 0;
    const PG8_LAS int* rmap = (const PG8_LAS int*)(lds + STAGE_BYTES);
    if constexpr (GATHER) {
#ifdef GROUP_XCD
        int pmv[8], rv[8];
#pragma unroll
        for (int i_ = 0; i_ < 8; ++i_) pmv[i_] = S.pm_of(i_);
#pragma unroll
        for (int i_ = 0; i_ < 8; ++i_) rv[i_] = (pmv[i_] >= 0 && tid < BM) ? g.rowmap[pmv[i_] * BM + tid] : 0;
#pragma unroll
        for (int i_ = 0; i_ < 8; ++i_) if (pmv[i_] >= 0 && tid < BM) ((PG8_LAS int*)(lds + STAGE_BYTES))[i_ * BM + tid] = rv[i_];
        for (int i_ = 8; i_ < 16 && S.pm_of(i_) >= 0; ++i_) { if (tid < BM) ((PG8_LAS int*)(lds + STAGE_BYTES))[i_ * BM + tid] = g.rowmap[S.pm_of(i_) * BM + tid]; }
#else
        Unit t_; for (int i_ = 0; S.next(i_, t_) && i_ < 16; ++i_) { if (tid < BM) ((PG8_LAS int*)(lds + STAGE_BYTES))[i_ * BM + tid] = g.rowmap[t_.pm * BM + tid]; }
#endif
        asm volatile("s_waitcnt vmcnt(0) lgkmcnt(0)" ::: "memory"); __builtin_amdgcn_s_barrier(); asm volatile("" ::: "memory"); }
    if (!S.next(0, cur)) return;
    f32x4 acc[2][2][4][2];
#pragma unroll
    for (int a = 0; a < 2; ++a)
#pragma unroll
        for (int b = 0; b < 2; ++b)
#pragma unroll
            for (int m = 0; m < 4; ++m)
#pragma unroll
                for (int n = 0; n < 2; ++n) acc[a][b][m][n] = (f32x4){0.f, 0.f, 0.f, 0.f};
    bf16x8 At[4][2], B0[2][2], B1[2][2];
    unsigned cG[2][2], nG[2][2];
#define PG8_LOAD_ROWS(u_, G2_) do { _Pragma("unroll") for (int h_ = 0; h_ < 2; ++h_) _Pragma("unroll") for (int i_ = 0; i_ < 2; ++i_) \
        G2_[h_][i_] = GATHER ? ((unsigned)rmap[(u_).ui * BM + h_ * HALF + RA[i_]] * (unsigned)K + (unsigned)CA[i_]) * 2u : voffA[i_]; } while (0)
    const char* cA = GATHER ? (const char*)g.A : (const char*)g.A + (size_t)cur.pm * tstep;
    const size_t hA = GATHER ? 0 : hstep;
    const char* cB = (const char*)g.Bt + (size_t)cur.e * g.bstride + (size_t)cur.pn * tstep;
    PG8_LOAD_ROWS(cur, cG);
    PG8_STAGE(PG8_SB(0, 0), cB, voffB); PG8_STAGE(PG8_SB(0, 1), cB + hstep, voffB); PG8_STAGE(PG8_SA(0, 0), cA, cG[0]); PG8_STAGE(PG8_SA(0, 1), cA + hA, cG[1]);
    if (wr == 1) PG8_BAR;
    PG8_WAIT_V(2); PG8_BAR;
    PG8_STAGE(PG8_SB(1, 0), cB + kstep, voffB); PG8_STAGE(PG8_SA(1, 0), cA + kstep, cG[0]); PG8_STAGE(PG8_SB(1, 1), cB + hstep + kstep, voffB);
    PG8_WAIT_V(6); PG8_BAR;
    for (;;) {
        const bool has_next = S.next(ui + 1, nxt);
        const char* nA = GATHER ? (const char*)g.A : (has_next ? (const char*)g.A + (size_t)nxt.pm * tstep : cA);
        const char* nB = has_next ? (const char*)g.Bt + (size_t)nxt.e * g.bstride + (size_t)nxt.pn * tstep : cB;
        if (has_next) PG8_LOAD_ROWS(nxt, nG); else {
#pragma unroll
            for (int h = 0; h < 2; ++h) { nG[h][0] = cG[h][0]; nG[h][1] = cG[h][1]; } }
        for (int t = 0; t < nt; t += 2) {
            const bool last = (t == nt - 2);
            const char* a1 = cA + (size_t)(t + 1) * kstep;
            const char* a2 = last ? nA : cA + (size_t)(t + 2) * kstep; const char* b2 = last ? nB : cB + (size_t)(t + 2) * kstep;
            const char* a3 = a2 + kstep; const char* b3 = b2 + kstep;
            unsigned sG[2][2];
#pragma unroll
            for (int h = 0; h < 2; ++h) { sG[h][0] = (GATHER && last) ? nG[h][0] : cG[h][0]; sG[h][1] = (GATHER && last) ? nG[h][1] : cG[h][1]; }
            PG8_LDB(B0, 0, 0); PG8_LDB(B1, 0, 1); PG8_SCHED; PG8_LDA(At, 0, 0); PG8_STAGE(PG8_SA(1, 1), a1 + hA, cG[1]);
            PG8_WAIT_V(8); PG8_WAIT_L(0); PG8_BAR; PG8_MMA(0, 0, At, B0); PG8_MMA(0, 1, At, B1); PG8_BAR; PG8_SCHED;
            PG8_LDA(At, 0, 1); PG8_STAGE(PG8_SB(0, 0), b2, voffB); PG8_STAGE(PG8_SB(0, 1), b2 + hstep, voffB); PG8_STAGE(PG8_SA(0, 0), a2, sG[0]);
            PG8_WAIT_V(8); PG8_WAIT_L(0); PG8_BAR; PG8_MMA(1, 0, At, B0); PG8_MMA(1, 1, At, B1); PG8_BAR; PG8_SCHED;
            PG8_LDB(B0, 1, 0); PG8_LDB(B1, 1, 1); PG8_SCHED; PG8_LDA(At, 1, 0); PG8_STAGE(PG8_SA(0, 1), a2 + hA, sG[1]);
            PG8_WAIT_V(8); PG8_WAIT_L(0); PG8_BAR; PG8_MMA(0, 0, At, B0); PG8_MMA(0, 1, At, B1); PG8_BAR; PG8_SCHED;
            PG8_LDA(At, 1, 1); PG8_STAGE(PG8_SB(1, 0), b3, voffB); PG8_STAGE(PG8_SB(1, 1), b3 + hstep, voffB); PG8_STAGE(PG8_SA(1, 0), a3, sG[0]);
            PG8_WAIT_V(8); PG8_WAIT_L(0); PG8_BAR; PG8_MMA(1, 0, At, B0); PG8_MMA(1, 1, At, B1); PG8_BAR; PG8_SCHED;
        }
        if (wr == 0) PG8_BAR;
        E(acc, cur, wr, wc, fr, fq);
        if (!has_next) break;
#pragma unroll
        for (int a = 0; a < 2; ++a)
#pragma unroll
            for (int b = 0; b < 2; ++b)
#pragma unroll
                for (int m = 0; m < 4; ++m)
#pragma unroll
                    for (int n = 0; n < 2; ++n) acc[a][b][m][n] = (f32x4){0.f, 0.f, 0.f, 0.f};
        cur = nxt; cA = nA; cB = nB; ++ui;
#pragma unroll
        for (int h = 0; h < 2; ++h) { cG[h][0] = nG[h][0]; cG[h][1] = nG[h][1]; }
        if (wr == 1) PG8_BAR;
    }
    PG8_WAIT_V(0);
    PG8_BAR;
#undef PG8_LOAD_ROWS
#undef PG8_SA
#undef PG8_SB
#undef PG8_STAGE
#undef PG8_LDA
#undef PG8_LDB
#undef PG8_MMA
#undef PG8_WAIT_V
#undef PG8_WAIT_L
#undef PG8_BAR
#undef PG8_SCHED
}
}
#ifndef S5_NEW_PASS1
#define S5_OLD_PASS1 1
#define NO_W32 1
#endif
#define S5_YREG 1
#define GLA_UNROLL2 1
#define ATT_UNROLL3 1
#define GLA_OSTAGE 1
constexpr int NB = 2, SEQ = 16384, T = NB * SEQ, D = 1024;
constexpr int H0P = 2112;
constexpr int ABN = 2048, OFF_U = 0, OFF_Q = 512, OFF_K = 768, OFF_V = 1024, OFF_GO = 1536, AB_IN = 2080;
constexpr int CN = 1536;
constexpr int NEXP = 32, DEXP = 512, CAP = 2 * T + NEXP * 256, MAXTILES = CAP / 256;
constexpr int S5CH = 256, S5NCH = SEQ / S5CH;
constexpr int GSC = 16, GCH = 64, GNSC = SEQ / (GSC * GCH);
constexpr float ALPHA = 1.41421356237309515f;
constexpr float LN_EPS = 1e-5f, RMS_EPS = 1e-6f, LOG2E = 1.44269504088896341f;
constexpr int NWAVES = 8, NTHR = 512;

constexpr size_t MiB = 1u << 20, KiB = 1u << 10;
constexpr size_t WS_CTL = 0, CTL_ZERO_BYTES = 64 * KiB;
constexpr int CW_BAR = 4096;
constexpr size_t WS_LR = 1 * MiB;
constexpr size_t WS_S5E = 5 * MiB;
constexpr size_t WS_GS = 9 * MiB;
constexpr size_t WS_GD = 17 * MiB;
constexpr size_t WS_S5L = WS_GD + 64 * KiB;
constexpr size_t WS_S5B = WS_S5L + 64 * KiB;
constexpr size_t WS_S5C = WS_S5B + 256 * KiB;
constexpr size_t WS_BTAB = WS_S5C + 256 * KiB;
constexpr size_t WS_WR = WS_BTAB + 32 * KiB;
constexpr size_t WS_TOKE = WS_WR + 384 * KiB;
constexpr size_t WS_TOKW = WS_TOKE + 256 * KiB;
constexpr size_t WS_TOKS = WS_TOKW + 256 * KiB;
constexpr size_t WS_SLOTT = WS_TOKS + 256 * KiB;
constexpr size_t WS_SLOTW = WS_SLOTT + 288 * KiB;
constexpr size_t WS_BLKC = WS_SLOTW + 288 * KiB;
constexpr size_t WS_TILE = WS_BLKC + 32 * KiB;
constexpr size_t WS_W32 = 20 * MiB;
static_assert(WS_TILE + 4 * KiB <= WS_W32 && WS_W32 + 8 * MiB <= 32 * MiB, "param region");
constexpr size_t WS_WIN = 32 * MiB, WS_WLR = 36 * MiB, WS_WGLU = 37 * MiB, WS_WOUT = 38 * MiB, WS_CIN = 40 * MiB, WS_COUT = 43 * MiB;
constexpr size_t WS_W13 = 48 * MiB, WS_W2 = 112 * MiB;
constexpr size_t A0 = 144 * MiB;
constexpr size_t WS_H1 = A0, WS_HLO = A0, WS_HHI = A0 + 64 * MiB, WS_H0 = A0;
constexpr size_t WS_Z = A0 + 128 * MiB;
constexpr size_t WS_YG = A0 + 136 * MiB, WS_OF = A0 + 168 * MiB, WS_OB = A0 + 320 * MiB;
constexpr size_t WS_YSCR = A0 + 232 * MiB;
constexpr size_t WS_X64 = A0 + 256 * MiB;
constexpr size_t WS_HID = A0 + 128 * MiB;
constexpr size_t WS_Y2 = A0 + 200 * MiB;
constexpr size_t WS_H2B = WS_HHI;
constexpr size_t WS_QKV = A0 + 192 * MiB;
constexpr size_t WS_AO = A0 + 288 * MiB;
constexpr size_t WS_END = A0 + 384 * MiB;
static_assert((size_t)T * H0P * 2 <= 136 * MiB && WS_Y2 + (size_t)CAP * D * 2 <= WS_END && WS_OB + (size_t)T * 512 * 4 <= WS_END && WS_HID + (size_t)CAP * 512 * 2 <= WS_Y2, "act map");

constexpr int RING_BYTES = 131072;
constexpr int MISC_OFF = 163840 - 1024;
constexpr int PTR_OFF = MISC_OFF + 256;
constexpr int LDS_BYTES = 163840;

#define GAS __attribute__((address_space(1)))
#define LAS __attribute__((address_space(3)))
typedef unsigned short bf16;
typedef float f32x4 __attribute__((ext_vector_type(4)));
typedef float f32x2 __attribute__((ext_vector_type(2)));
typedef float f32x16 __attribute__((ext_vector_type(16)));
typedef short bf16x8 __attribute__((ext_vector_type(8)));
typedef short bf16x4 __attribute__((ext_vector_type(4)));
typedef unsigned u32x4 __attribute__((ext_vector_type(4)));
typedef unsigned u32x2 __attribute__((ext_vector_type(2)));
#define LDS_WAIT() asm volatile("s_waitcnt lgkmcnt(0)" ::: "memory")
#define VM_WAIT() asm volatile("s_waitcnt vmcnt(0)" ::: "memory")
#define LDS_BARRIER() do { asm volatile("s_waitcnt lgkmcnt(0)" ::: "memory"); __builtin_amdgcn_s_barrier(); asm volatile("" ::: "memory"); } while (0)
typedef __bf16 bf16x2_t __attribute__((ext_vector_type(2)));
__device__ __forceinline__ unsigned pk2(float lo, float hi) { f32x2 v = {lo, hi}; return __builtin_bit_cast(unsigned, __builtin_convertvector(v, bf16x2_t)); }
__device__ __forceinline__ unsigned f2bf(float f) { return pk2(f, 0.f) & 0xffffu; }
__device__ __forceinline__ float bf2f(unsigned short b) { return __uint_as_float((unsigned)b << 16); }
__device__ __forceinline__ float bflo(unsigned w) { return __uint_as_float(w << 16); }
__device__ __forceinline__ float bfhi(unsigned w) { return __uint_as_float(w & 0xffff0000u); }
__device__ __forceinline__ float sadd(float a, float b) { float d; asm("v_add_f32 %0, %1, %2" : "=v"(d) : "v"(a), "v"(b)); return d; }
__device__ __forceinline__ float sfma1(float a, float b, float c) { float d; asm("v_fma_f32 %0, %1, %2, %3" : "=v"(d) : "v"(a), "v"(b), "v"(c)); return d; }
__device__ __forceinline__ float wave_sum(float v) {
#pragma unroll
    for (int o = 1; o < 64; o <<= 1) v += __shfl_xor(v, o);
    return v;
}
__device__ __forceinline__ int crow(int r, int hi) { return (r & 3) + 8 * (r >> 2) + 4 * hi; }

#define XB_TMO      128
#define XB_XCNT(j)  (256  + 64 * (j))
#define XB_XSUB(j)  (1280 + 64 * (j))
#define XB_XGEN(j)  (2304 + 64 * (j))
#define XB_TOP      3328
#define XB_TOPGEN   3392
#define XCD_BAR_WORDS 3456
#define XB_SPIN_CAP (1u << 18)
__device__ __forceinline__ unsigned xb_ld(unsigned* p)              { return __hip_atomic_load(p, __ATOMIC_RELAXED, __HIP_MEMORY_SCOPE_AGENT); }
__device__ __forceinline__ unsigned xb_add(unsigned* p, unsigned v) { return __hip_atomic_fetch_add(p, v, __ATOMIC_RELAXED, __HIP_MEMORY_SCOPE_AGENT); }
__device__ __forceinline__ unsigned xb_xcc_id() { return (unsigned)__builtin_amdgcn_s_getreg((3 << 11) | 20) & 0xFu; }
#define XB_SPIN(cond, bar) do { unsigned _sp = 0; while (cond) { __builtin_amdgcn_s_sleep(1); \
    if ((++_sp & 255u) == 0u) { if (xb_ld(&(bar)[XB_TMO])) break; if (_sp > XB_SPIN_CAP) { atomicAdd(&(bar)[XB_TMO], 1u); break; } } } } while (0)
struct XcdBarrier { unsigned* bar; unsigned x; volatile LAS unsigned* st; };
__device__ __forceinline__ XcdBarrier xcd_barrier_post(unsigned* bar, volatile LAS unsigned* st) {
    XcdBarrier b; b.bar = bar; b.x = xb_xcc_id(); b.st = st;
    if (threadIdx.x == 0) (void)xb_add(&bar[XB_XCNT(b.x)], 1u);
    return b;
}
__device__ __forceinline__ void xcd_barrier_complete(unsigned* bar, unsigned x, unsigned& nloc, unsigned& nx) {
    const unsigned G = gridDim.x * gridDim.y * gridDim.z;
    unsigned sum, cnt, mine, sp = 0u;
    for (;;) {
        sum = 0u; cnt = 0u; mine = 0u;
#pragma unroll
        for (unsigned j = 0; j < 16; ++j) { const unsigned c = xb_ld(&bar[XB_XCNT(j)]); sum += c; cnt += (c > 0u) ? 1u : 0u; mine = (j == x) ? c : mine; }
        if (sum == G) break;
        __builtin_amdgcn_s_sleep(1);
        if ((++sp & 255u) == 0u) { if (xb_ld(&bar[XB_TMO])) break; if (sp > XB_SPIN_CAP) { atomicAdd(&bar[XB_TMO], 1u); break; } }
    }
    nloc = mine > 0u ? mine : 1u; nx = cnt > 0u ? cnt : 1u;
}
__device__ __forceinline__ void xcd_barrier(const XcdBarrier& b) {
    asm volatile("s_waitcnt vmcnt(0)" ::: "memory");
    __syncthreads();
    if (threadIdx.x == 0) {
        unsigned* bar = b.bar;
        __builtin_amdgcn_s_waitcnt(0);
        unsigned nloc = b.st[0], nx = b.st[1];
        if (nloc == 0u) { xcd_barrier_complete(bar, b.x, nloc, nx); b.st[0] = nloc; b.st[1] = nx; }
        const unsigned old = xb_add(&bar[XB_XSUB(b.x)], 1u);
        const unsigned gen = old / nloc;
        if (old + 1u == (gen + 1u) * nloc) {
            __builtin_amdgcn_fence(__ATOMIC_RELEASE, "agent");
            asm volatile("s_waitcnt vmcnt(0)" ::: "memory");
            const unsigned og = xb_add(&bar[XB_TOP], 1u);
            const unsigned tg = og / nx;
            if (og + 1u == (tg + 1u) * nx) xb_add(&bar[XB_TOPGEN], 1u);
            else XB_SPIN(xb_ld(&bar[XB_TOPGEN]) == tg, bar);
            __builtin_amdgcn_fence(__ATOMIC_ACQUIRE, "agent");
            xb_add(&bar[XB_XGEN(b.x)], 1u);
            asm volatile("s_waitcnt vmcnt(0)" ::: "memory");
        } else {
            XB_SPIN(xb_ld(&bar[XB_XGEN(b.x)]) == gen, bar);
            __builtin_amdgcn_fence(__ATOMIC_ACQUIRE, "agent");
            asm volatile("s_waitcnt vmcnt(0)" ::: "memory");
        }
    }
    __syncthreads();
}

struct Frame {
    LAS unsigned char* lds;
    int tid, lane, wave, G, bid;
    unsigned char* ws;
    const float* const* in;
};
enum InIdx { I_X = 0, I_LNMG, I_LNMB, I_LNFG, I_LNFB, I_ABWIN, I_LAMRE, I_LAMIM, I_LOGDT, I_BRE, I_BIM, I_CRE, I_CIM, I_S5D, I_GLUW, I_GLUB,
             I_GATEW, I_GATEB, I_NORMG, I_ABWOUT, I_CWIN, I_SINK, I_CWOUT, I_RELB, I_WGRP, I_BGRP, I_WRT, I_BRT, I_W1, I_W3, I_W2, N_IN };

__device__ __forceinline__ const float* inp(LAS unsigned char* lds, int k) {
    const LAS unsigned* p = (const LAS unsigned*)(lds + PTR_OFF) + 2 * k;
    const unsigned lo = __builtin_amdgcn_readfirstlane(p[0]), hi = __builtin_amdgcn_readfirstlane(p[1]);
    return (const float*)(const GAS float*)(((unsigned long long)hi << 32) | (unsigned long long)lo);
}
struct TrItem { const float* W; bf16* WT; int ldw, ldt, rowmode, k0, n0; };
__device__ __forceinline__ void tr_load(const TrItem& q, float (&tv)[32], int lane) {
    const float* wp = q.W + (size_t)(q.k0 + (lane >> 5)) * q.ldw + q.n0 + (lane & 31);
#pragma unroll
    for (int i = 0; i < 32; ++i) tv[i] = wp[(size_t)(2 * i) * q.ldw];
}
__device__ __forceinline__ void tr_store(const TrItem& q, const float (&tv)[32], LAS float* scr, int lane) {
#pragma unroll
    for (int i = 0; i < 32; ++i) scr[(2 * i + (lane >> 5)) * 33 + (lane & 31)] = tv[i];
    LDS_WAIT(); asm volatile("" ::: "memory");
    const int c = lane & 7;
#pragma unroll
    for (int j = 0; j < 4; ++j) { const int n = (lane >> 3) + 8 * j; const LAS float* s = scr + (8 * c) * 33 + n;
        u32x4 o; o.x = pk2(s[0 * 33], s[1 * 33]); o.y = pk2(s[2 * 33], s[3 * 33]); o.z = pk2(s[4 * 33], s[5 * 33]); o.w = pk2(s[6 * 33], s[7 * 33]);
        const int ng = q.n0 + n; const int dr = q.rowmode == 0 ? ng : (8 * (ng >> 2) + (ng & 3) + (q.rowmode == 2 ? 4 : 0));
        *(GAS u32x4*)(q.WT + (size_t)dr * q.ldt + q.k0 + 8 * c) = o; }
    LDS_WAIT(); asm volatile("" ::: "memory");
}
__device__ __forceinline__ void tr_item(const float* W, int ldw, bf16* WT, int ldt, int rowmode, LAS float* scr, int item, int nblk, int lane) {
    TrItem q{W, WT, ldw, ldt, rowmode, 64 * (item / nblk), 32 * (item % nblk)}; float tv[32]; tr_load(q, tv, lane); tr_store(q, tv, scr, lane);
}
__device__ __forceinline__ TrItem moe_item(const float* w1, const float* w3, const float* w2, bf16* W13, bf16* W2T, int it) {
    constexpr int PER_E = 768; const int e = it / PER_E, r = it % PER_E;
    if (r < 256) return TrItem{w1 + (size_t)e * D * DEXP, W13 + (size_t)e * D * D, DEXP, D, 1, 64 * (r / 16), 32 * (r % 16)};
    if (r < 512) return TrItem{w3 + (size_t)e * D * DEXP, W13 + (size_t)e * D * D, DEXP, D, 2, 64 * ((r - 256) / 16), 32 * ((r - 256) % 16)};
    return TrItem{w2 + (size_t)e * DEXP * D, W2T + (size_t)e * D * DEXP, D, DEXP, 0, 64 * ((r - 512) / 32), 32 * ((r - 512) % 32)};
}
__device__ __forceinline__ void moe_convert(const float* w1, const float* w3, const float* w2, bf16* W13, bf16* W2T, LAS float* scr, int it0, int it1, int gw, int NGW, int lane) {
    for (int it = it0 + gw; it < it1; it += 2 * NGW) {
        const int it2 = it + NGW; const bool two = it2 < it1;
        const TrItem qa = moe_item(w1, w3, w2, W13, W2T, it), qb = moe_item(w1, w3, w2, W13, W2T, two ? it2 : it);
        float ta[32], tb[32];
        tr_load(qa, ta, lane); tr_load(qb, tb, lane);
        tr_store(qa, ta, scr, lane); if (two) tr_store(qb, tb, scr, lane);
    }
}
constexpr int MOE_ITEMS = NEXP * 768, IDLE_Q8 = 88, IDLE_Q9 = 56;
#ifdef GROUP_XCD
__device__ __forceinline__ void idle_rank(int ntiles, int G, int bid, int& n_idle, int& rank, bool& idle) {
    pg8::GroupOrder S{nullptr, ntiles, D / 256, G, 0}; const int mx = S.maxcount(), W = G >> 3; n_idle = 0; rank = 0;
    for (int x = 0; x < 8; ++x) { const int t = S.thr(x, mx); n_idle += W - t; int R = (bid - x + 7) >> 3; R = R < 0 ? 0 : R; rank += R > t ? R - t : 0; }
    idle = (bid >> 3) >= S.thr(bid & 7, mx);
}
#endif
__device__ __forceinline__ void idle_convert(int which, unsigned char* ws, LAS unsigned char* lds, float* dout, int ntiles, int bid, int G, int wave, int lane) {
#ifdef GROUP_XCD
    int n_idle, rank; bool idle; idle_rank(ntiles, G, bid, n_idle, rank, idle); if (!idle || n_idle == G) return;
#else
    const int U = ntiles * (D / 256), rem = U % G; if (rem == 0 || bid < rem) return;
    const int n_idle = G - rem, rank = bid - rem;
#endif
    int q8 = n_idle * IDLE_Q8; q8 = q8 < MOE_ITEMS ? q8 : MOE_ITEMS; int q9 = n_idle * IDLE_Q9; q9 = (q8 + q9) < MOE_ITEMS ? q9 : (MOE_ITEMS - q8);
    const int per = which == 0 ? IDLE_Q8 : IDLE_Q9, base = which == 0 ? 0 : q8, lim = which == 0 ? q8 : q8 + q9;
    int lo = base + rank * per, hi = lo + per; hi = hi < lim ? hi : lim;
    moe_convert(inp(lds, I_W1) + (size_t)NEXP * D * DEXP, inp(lds, I_W3) + (size_t)NEXP * D * DEXP, inp(lds, I_W2) + (size_t)NEXP * DEXP * D,
                (bf16*)dout, (bf16*)dout + (size_t)NEXP * D * D, (LAS float*)(lds + wave * 16384), lo, hi, wave, NWAVES, lane);
}
__device__ __forceinline__ int idle_done(int ntiles, int G) {
#ifdef GROUP_XCD
    int n_idle, rank; bool idle; idle_rank(ntiles, G, 0, n_idle, rank, idle); if (n_idle == G) return 0;
#else
    const int U = ntiles * (D / 256), rem = U % G; if (rem == 0) return 0;
    const int n_idle = G - rem;
#endif
    int q = n_idle * (IDLE_Q8 + IDLE_Q9); return q < MOE_ITEMS ? q : MOE_ITEMS;
}
__device__ __forceinline__ void half_convert(int layer, int second, unsigned char* ws, LAS unsigned char* lds, float* dout, int bid, int G, int wave, int lane) {
    const int h = G / 2; if ((bid >= h) != (second != 0)) return;
    const int rank = second ? bid - h : bid, nb = second ? G - h : h;
    const int lo = second ? MOE_ITEMS / 2 : 0, hi = second ? MOE_ITEMS : MOE_ITEMS / 2;
    const size_t lof = (size_t)layer * NEXP * D * DEXP;
    bf16* W13 = layer == 0 ? (bf16*)(ws + WS_W13) : (bf16*)dout; bf16* W2T = layer == 0 ? (bf16*)(ws + WS_W2) : (bf16*)dout + (size_t)NEXP * D * D;
    moe_convert(inp(lds, I_W1) + lof, inp(lds, I_W3) + lof, inp(lds, I_W2) + lof, W13, W2T, (LAS float*)(lds + wave * 16384), lo, hi, rank * NWAVES + wave, nb * NWAVES, lane);
}
__device__ __forceinline__ int t5_bucket(int rel) {
    const int nb = 16, max_exact = 8; int ret = rel > 0 ? nb : 0; const int n = rel < 0 ? -rel : rel;
    const float lg = logf((float)(n < 1 ? 1 : n) / 8.0f) / 2.7725887f * 8.0f;
    int large = max_exact + (int)lg; large = large < nb - 1 ? large : nb - 1;
    return ret + (n < max_exact ? n : large);
}
__device__ __forceinline__ void p0_prologue(unsigned char* ws, LAS unsigned char* lds, int bid, int G, int tid, int wave, int lane) {
    LAS float* scr = (LAS float*)(lds + wave * 16384);
    const int gw = bid * NWAVES + wave, NGW = G * NWAVES;
    constexpr int I0 = 16 * 64, I1 = 16, I2 = 8 * 16, I3 = 16 * 32, I4 = 16 * 48, I5 = 16 * 32, NIT = I0 + I1 + I2 + I3 + I4 + I5;
    for (int it = gw; it < NIT; it += NGW) {
        int r = it;
        if (r < I0) { tr_item(inp(lds, I_ABWIN), AB_IN, (bf16*)(ws + WS_WIN), D, 0, scr, r, 64, lane); continue; } r -= I0;
        if (r < I1) { tr_item(inp(lds, I_ABWIN) + 2048, AB_IN, (bf16*)(ws + WS_WLR), D, 0, scr, r, 1, lane); continue; } r -= I1;
        if (r < I2) { tr_item(inp(lds, I_GLUW), 512, (bf16*)(ws + WS_WGLU), 512, 0, scr, r, 16, lane); continue; } r -= I2;
        if (r < I3) { tr_item(inp(lds, I_ABWOUT), D, (bf16*)(ws + WS_WOUT), D, 0, scr, r, 32, lane); continue; } r -= I3;
        if (r < I4) { tr_item(inp(lds, I_CWIN), CN, (bf16*)(ws + WS_CIN), D, 0, scr, r, 48, lane); continue; } r -= I4;
        tr_item(inp(lds, I_CWOUT), D, (bf16*)(ws + WS_COUT), D, 0, scr, r, 32, lane);
    }
#ifndef CONV_OVERLAP
    moe_convert(inp(lds, I_W1), inp(lds, I_W3), inp(lds, I_W2), (bf16*)(ws + WS_W13), (bf16*)(ws + WS_W2), scr, 0, MOE_ITEMS, gw, NGW, lane);
#endif
    { const float* x = inp(lds, I_X); bf16* xb = (bf16*)(ws + WS_X64);
      for (int m = gw; m < T; m += 2 * NGW) { const int m2 = m + NGW;
          const GAS f32x4* xr = (const GAS f32x4*)(x + (size_t)m * D) + lane; GAS u32x2* o = (GAS u32x2*)(xb + (size_t)m * D) + lane;
          const GAS f32x4* xr2 = (const GAS f32x4*)(x + (size_t)m2 * D) + lane; GAS u32x2* o2 = (GAS u32x2*)(xb + (size_t)m2 * D) + lane;
          f32x4 v[4], v2[4];
#pragma unroll
          for (int j = 0; j < 4; ++j) { v[j] = xr[64 * j]; if (m2 < T) v2[j] = xr2[64 * j]; }
#pragma unroll
          for (int j = 0; j < 4; ++j) { u32x2 w; w.x = pk2(v[j].x, v[j].y); w.y = pk2(v[j].z, v[j].w); o[64 * j] = w;
              if (m2 < T) { u32x2 w2; w2.x = pk2(v2[j].x, v2[j].y); w2.y = pk2(v2[j].z, v2[j].w); o2[64 * j] = w2; } } } }
    const int gt = bid * NTHR + tid, NGT = G * NTHR;
    { const float* lamre = inp(lds, I_LAMRE); const float* lamim = inp(lds, I_LAMIM); const float* logdt = inp(lds, I_LOGDT); const float* bre = inp(lds, I_BRE); const float* bim = inp(lds, I_BIM);
    for (int i = tid * G + bid; i < 2 * 32 * 64; i += NTHR * G) {
        const int p = i & 63, g = (i >> 6) & 31, dir = i >> 11;
        const double lr = fmin((double)lamre[i], -1e-4), li = (double)lamim[i], dt = exp((double)logdt[dir * 32 + g]);
        const double mag = exp(lr * dt), ar = mag * cos(li * dt), ai = mag * sin(li * dt), den = lr * lr + li * li, nr = ar - 1.0;
        const double cr = (nr * lr + ai * li) / den, ci = (ai * lr - nr * li) / den;
        double qr = ar, qi = ai;
#pragma unroll 1
        for (int s = 1; s < S5CH; s <<= 1) { const double t = qr * qr - qi * qi; qi = 2.0 * qr * qi; qr = t; }
        float* L4 = (float*)(ws + WS_S5L) + (size_t)i * 4; L4[0] = (float)ar; L4[1] = (float)ai; L4[2] = (float)qr; L4[3] = (float)qi;
        bf16* Bb = (bf16*)(ws + WS_S5B) + (size_t)(dir * 32 + g) * 2048;
#pragma unroll 4
        for (int c = 0; c < 16; ++c) { const double br = bre[(size_t)i * 16 + c], bi = bim[(size_t)i * 16 + c];
            Bb[p * 16 + c] = (bf16)f2bf((float)(cr * br - ci * bi)); Bb[1024 + p * 16 + c] = (bf16)f2bf((float)(cr * bi + ci * br)); } }
#ifndef NO_W32
    for (int idx = gt; idx < 2 * 32 * 64 * 32; idx += NGT) {
        const int i = idx & 31, p = (idx >> 5) & 63, dg = idx >> 11, q = dg * 64 + p, dir = dg >> 5;
        const float lr = fminf(lamre[q], -1e-4f), li = lamim[q], dt = expf(logdt[dg]);
        const float mag = expf(lr * dt), ar = mag * cosf(li * dt), ai = mag * sinf(li * dt), den = lr * lr + li * li, nr = ar - 1.0f;
        const float cr = (nr * lr + ai * li) / den, ci = (ai * lr - nr * li) / den;
        const float kk = (float)(dir ? i : 31 - i), pm = expf(kk * lr * dt), pr = pm * cosf(kk * li * dt), pi_ = pm * sinf(kk * li * dt);
        const float wr = pr * cr - pi_ * ci, wi = pr * ci + pi_ * cr;
        float o0[16], o1[16];
#pragma unroll
        for (int c = 0; c < 16; ++c) { const float br = bre[(size_t)q * 16 + c], bi = bim[(size_t)q * 16 + c]; o0[c] = wr * br - wi * bi; o1[c] = wr * bi + wi * br; }
        bf16* W = (bf16*)(ws + WS_W32);
        u32x4* d0 = (u32x4*)(W + ((size_t)(dg * 2 + 0) * 64 + p) * 512 + i * 16); u32x4* d1 = (u32x4*)(W + ((size_t)(dg * 2 + 1) * 64 + p) * 512 + i * 16);
        u32x4 w;
        w.x = pk2(o0[0], o0[1]); w.y = pk2(o0[2], o0[3]); w.z = pk2(o0[4], o0[5]); w.w = pk2(o0[6], o0[7]); d0[0] = w;
        w.x = pk2(o0[8], o0[9]); w.y = pk2(o0[10], o0[11]); w.z = pk2(o0[12], o0[13]); w.w = pk2(o0[14], o0[15]); d0[1] = w;
        w.x = pk2(o1[0], o1[1]); w.y = pk2(o1[2], o1[3]); w.z = pk2(o1[4], o1[5]); w.w = pk2(o1[6], o1[7]); d1[0] = w;
        w.x = pk2(o1[8], o1[9]); w.y = pk2(o1[10], o1[11]); w.z = pk2(o1[12], o1[13]); w.w = pk2(o1[14], o1[15]); d1[1] = w;
    }
#endif
    }
    { const float* cre = inp(lds, I_CRE); const float* cim = inp(lds, I_CIM);
    for (int i = gt; i < 2 * 32 * 16 * 64; i += NGT) {
        const int p = i & 63, c = (i >> 6) & 15, dg = i >> 10;
        bf16* Cm = (bf16*)(ws + WS_S5C) + (size_t)dg * 2048 + c * 128 + 2 * p;
        Cm[0] = (bf16)f2bf(cre[i]); Cm[1] = (bf16)f2bf(-cim[i]);
    } }
    { const float* relb = inp(lds, I_RELB);
    for (int i = gt; i < 16 * 257; i += NGT) { const int h = i / 257, r = i % 257; ((float*)(ws + WS_BTAB))[h * 260 + r] = relb[t5_bucket(r - 128) * 16 + h] * LOG2E; } }
    { const float* wgrp = inp(lds, I_WGRP); const float* wrt = inp(lds, I_WRT);
    for (int i = gt; i < 2 * 48 * 1024; i += NGT) {
        const int k = i & 1023, n = (i >> 10) % 48, l = i / (48 * 1024);
        const float w = n < 4 ? wgrp[(size_t)l * D * 4 + k * 4 + n] : (n < 36 ? wrt[(size_t)l * D * 32 + k * 32 + (n - 4)] : 0.f);
        const unsigned hi = f2bf(w); const float lo = w - __uint_as_float(hi << 16);
        bf16* Wr = (bf16*)(ws + WS_WR) + (size_t)l * 2 * 48 * 1024; Wr[n * 1024 + k] = (bf16)hi; Wr[48 * 1024 + n * 1024 + k] = (bf16)f2bf(lo);
    } }
}

__device__ __forceinline__ void gate_tail(float* bcg, const float* gate_w, const float* gate_b, const LAS float* lrs, size_t row0, int tid);
template <int DIRC> __device__ __forceinline__ void gate_tail_w(float* bcg, const float* gate_w, const float* gate_b, const LAS float* lrs, size_t row0, int wave, int lane);
template <int ABL = 0>
__device__ __forceinline__ void lr_tail(unsigned char* ws, float* bcg, const float* gate_w, const float* gate_b, LAS unsigned char* lds, int bid, int G, int tid, int wave, int lane) {
    const bf16* xb = (const bf16*)(ws + WS_X64); const bf16* wl = (const bf16*)(ws + WS_WLR); LAS float* lrs = (LAS float*)lds;
    constexpr int WL_OFF = 16384, WL_ST = 2064;
    VM_WAIT(); __syncthreads();
    for (int p = tid; p < 32 * 128; p += NTHR) *(LAS u32x4*)(lds + WL_OFF + (p >> 7) * WL_ST + 16 * (p & 127)) = *(const u32x4*)(wl + (size_t)(p >> 7) * D + 8 * (p & 127));
    __syncthreads();
    for (int rt = bid; rt < T / 128; rt += G) {
        const int r0 = rt * 128 + wave * 16;
        f32x4 acc0 = {0.f, 0.f, 0.f, 0.f}, acc1 = {0.f, 0.f, 0.f, 0.f};
        const bf16* ap = xb + (size_t)(r0 + (lane & 15)) * D + 8 * (lane >> 4);
        const LAS unsigned char* bp = lds + WL_OFF + (lane & 15) * WL_ST + 16 * (lane >> 4);
        bf16x8 a[32];
#pragma unroll
        for (int ks = 0; ks < 32; ++ks) a[ks] = *(const bf16x8*)(ap + ks * 32);
#pragma unroll
        for (int ks = 0; ks < 32; ++ks) {
            const bf16x8 b0 = *(const LAS bf16x8*)(bp + ks * 64), b1 = *(const LAS bf16x8*)(bp + 16 * WL_ST + ks * 64);
            acc0 = __builtin_amdgcn_mfma_f32_16x16x32_bf16(a[ks], b0, acc0, 0, 0, 0); acc1 = __builtin_amdgcn_mfma_f32_16x16x32_bf16(a[ks], b1, acc1, 0, 0, 0);
        }
        __syncthreads();
#pragma unroll
        for (int r = 0; r < 4; ++r) { LAS float* o = lrs + (wave * 16 + 4 * (lane >> 4) + r) * 32 + (lane & 15); o[0] = acc0[r]; o[16] = acc1[r]; }
        __syncthreads();
#ifdef GATE_MFMA
        if (!(ABL & 1)) { if (wave < 4) gate_tail_w<0>(bcg, gate_w, gate_b, lrs, (size_t)rt * 128, wave, lane); else gate_tail_w<1>(bcg, gate_w, gate_b, lrs, (size_t)rt * 128, wave, lane); }
#else
        if (!(ABL & 1)) gate_tail(bcg, gate_w, gate_b, lrs, (size_t)rt * 128, tid);
#endif
    }
    __syncthreads();
}

__device__ __forceinline__ void gla_finalize(unsigned char* ws, const float* norm_g, int gw, int NGW, int lane) {
    const bf16* of = (const bf16*)(ws + WS_OF); const bf16* ob = (const bf16*)(ws + WS_OB); const bf16* h0 = (const bf16*)(ws + WS_H0); bf16* cc = (bf16*)(ws + WS_X64);
    const f32x4 g0 = *(const f32x4*)(norm_g + 8 * lane), g1 = *(const f32x4*)(norm_g + 8 * lane + 4);
    for (int m0 = gw; m0 < T; m0 += 4 * NGW) {
        u32x4 a[4], b[4], gq[4];
#pragma unroll
        for (int q = 0; q < 4; ++q) { const size_t m = (size_t)m0 + (size_t)q * NGW;
            a[q] = *(const u32x4*)(of + m * 512 + 8 * lane); b[q] = *(const u32x4*)(ob + m * 512 + 8 * lane); gq[q] = *(const u32x4*)(h0 + m * H0P + OFF_GO + 8 * lane); }
#pragma unroll
        for (int q = 0; q < 4; ++q) { const size_t m = (size_t)m0 + (size_t)q * NGW;
            f32x4 v0, v1;
            v0.x = bflo(a[q].x) + bflo(b[q].x); v0.y = bfhi(a[q].x) + bfhi(b[q].x); v0.z = bflo(a[q].y) + bflo(b[q].y); v0.w = bfhi(a[q].y) + bfhi(b[q].y);
            v1.x = bflo(a[q].z) + bflo(b[q].z); v1.y = bfhi(a[q].z) + bfhi(b[q].z); v1.z = bflo(a[q].w) + bflo(b[q].w); v1.w = bfhi(a[q].w) + bfhi(b[q].w);
            float ss = (v0.x * v0.x + v0.y * v0.y) + (v0.z * v0.z + v0.w * v0.w) + (v1.x * v1.x + v1.y * v1.y) + (v1.z * v1.z + v1.w * v1.w);
            ss += __shfl_xor(ss, 1); ss += __shfl_xor(ss, 2); ss += __shfl_xor(ss, 4); ss += __shfl_xor(ss, 8);
            const float rs = __builtin_amdgcn_rsqf(ss * (1.0f / 128.0f) + RMS_EPS);
            const float gv[8] = {bflo(gq[q].x), bfhi(gq[q].x), bflo(gq[q].y), bfhi(gq[q].y), bflo(gq[q].z), bfhi(gq[q].z), bflo(gq[q].w), bfhi(gq[q].w)};
            const float ov[8] = {v0.x * g0.x, v0.y * g0.y, v0.z * g0.z, v0.w * g0.w, v1.x * g1.x, v1.y * g1.y, v1.z * g1.z, v1.w * g1.w};
            float r[8];
#pragma unroll
            for (int i = 0; i < 8; ++i) r[i] = ov[i] * rs * (gv[i] * __builtin_amdgcn_rcpf(1.f + __expf(-gv[i])));
            u32x4 w; w.x = pk2(r[0], r[1]); w.y = pk2(r[2], r[3]); w.z = pk2(r[4], r[5]); w.w = pk2(r[6], r[7]);
            *(u32x4*)(cc + m * D + 512 + 8 * lane) = w; }
    }
}

constexpr int RT_AST = 2064;
template <bool RESID_F32, bool RD_LO, bool WR_LO>
__device__ __forceinline__ void ln_router(unsigned char* ws, const float* resid, const float* lng, const float* lnb, const float* bgrp, const float* brt, int layer, LAS unsigned char* lds, int bid, int G, int tid, int wave, int lane) {
    const bf16* yb = (const bf16*)(ws + WS_Z); bf16* hlo = (bf16*)(ws + WS_HLO); bf16* hb = (bf16*)(ws + WS_HHI);
    int* tok_e = (int*)(ws + WS_TOKE); float* tok_w = (float*)(ws + WS_TOKW);
    LAS unsigned char* Ahi = lds; LAS unsigned char* Alo = lds + 16 * RT_AST; LAS float* part = (LAS float*)(lds + 32 * RT_AST);
    LAS int* hist = (LAS int*)(lds + 32 * RT_AST + 8 * 16 * 48 * 4); LAS float* lgt = (LAS float*)(lds + 32 * RT_AST + 8 * 16 * 48 * 4 + 256);
    if (tid < 32) hist[tid] = 0;
    const bf16* Wr = (const bf16*)(ws + WS_WR) + (size_t)layer * 2 * 48 * 1024;
    bf16x8 Bh[3][4], Bl[3][4];
#pragma unroll
    for (int nt = 0; nt < 3; ++nt)
#pragma unroll
        for (int ks = 0; ks < 4; ++ks) { const size_t o = (size_t)(nt * 16 + (lane & 15)) * 1024 + wave * 128 + ks * 32 + 8 * (lane >> 4);
            Bh[nt][ks] = *(const bf16x8*)(Wr + o); Bl[nt][ks] = *(const bf16x8*)(Wr + 48 * 1024 + o); }
    f32x4 gv[4], bv[4];
#pragma unroll
    for (int j = 0; j < 4; ++j) { gv[j] = *(const f32x4*)(lng + 4 * lane + 256 * j); bv[j] = *(const f32x4*)(lnb + 4 * lane + 256 * j); }
    __syncthreads();
    for (int grp = bid; grp < T / 16; grp += G) {
#pragma unroll
        for (int rr = 0; rr < 2; ++rr) {
            const int row = 2 * wave + rr; const size_t m = (size_t)grp * 16 + row;
            const GAS f32x4* xr = (const GAS f32x4*)(resid + m * D) + lane; const GAS u32x2* yr = (const GAS u32x2*)(yb + m * D) + lane;
            const GAS u32x2* hr_ = (const GAS u32x2*)(hb + m * D) + lane; const GAS u32x2* lr_ = (const GAS u32x2*)(hlo + m * D) + lane;
            f32x4 v[4]; float s = 0.f;
#pragma unroll
            for (int j = 0; j < 4; ++j) { f32x4 x4; const u32x2 y2 = yr[64 * j];
                if (RESID_F32) x4 = xr[64 * j]; else if (RD_LO) { const u32x2 a = hr_[64 * j], b = lr_[64 * j]; x4.x = bflo(a.x) + bflo(b.x); x4.y = bfhi(a.x) + bfhi(b.x); x4.z = bflo(a.y) + bflo(b.y); x4.w = bfhi(a.y) + bfhi(b.y); }
                else { const u32x2 a = hr_[64 * j]; x4.x = bflo(a.x); x4.y = bfhi(a.x); x4.z = bflo(a.y); x4.w = bfhi(a.y); }
                v[j].x = x4.x * ALPHA + bflo(y2.x); v[j].y = x4.y * ALPHA + bfhi(y2.x); v[j].z = x4.z * ALPHA + bflo(y2.y); v[j].w = x4.w * ALPHA + bfhi(y2.y);
                s += (v[j].x + v[j].y) + (v[j].z + v[j].w); }
            const float mean = wave_sum(s) * (1.f / D); float s2 = 0.f;
#pragma unroll
            for (int j = 0; j < 4; ++j) { v[j] = v[j] - mean; s2 += (v[j].x * v[j].x + v[j].y * v[j].y) + (v[j].z * v[j].z + v[j].w * v[j].w); }
            const float rstd = 1.f / sqrtf(wave_sum(s2) * (1.f / D) + LN_EPS);
#pragma unroll
            for (int j = 0; j < 4; ++j) {
                const f32x4 h = v[j] * rstd * gv[j] + bv[j];
                const unsigned h0 = pk2(h.x, h.y), h1w = pk2(h.z, h.w);
                u32x2 w; w.x = h0; w.y = h1w; ((GAS u32x2*)(hb + m * D) + lane)[64 * j] = w;
                u32x2 lo; lo.x = pk2(h.x - bflo(h0), h.y - bfhi(h0)); lo.y = pk2(h.z - bflo(h1w), h.w - bfhi(h1w));
                if (WR_LO) ((GAS u32x2*)(hlo + m * D) + lane)[64 * j] = lo;
                *(LAS u32x2*)(Ahi + row * RT_AST + (4 * lane + 256 * j) * 2) = w; *(LAS u32x2*)(Alo + row * RT_AST + (4 * lane + 256 * j) * 2) = lo;
            }
        }
        LDS_BARRIER();
        f32x4 acc[3] = {{0.f, 0.f, 0.f, 0.f}, {0.f, 0.f, 0.f, 0.f}, {0.f, 0.f, 0.f, 0.f}};
#pragma unroll
        for (int ks = 0; ks < 4; ++ks) {
            const int bo = (lane & 15) * RT_AST + (wave * 128 + ks * 32 + 8 * (lane >> 4)) * 2;
            const bf16x8 ah = *(const LAS bf16x8*)(Ahi + bo), al = *(const LAS bf16x8*)(Alo + bo);
#pragma unroll
            for (int nt = 0; nt < 3; ++nt) {
                acc[nt] = __builtin_amdgcn_mfma_f32_16x16x32_bf16(ah, Bh[nt][ks], acc[nt], 0, 0, 0);
                acc[nt] = __builtin_amdgcn_mfma_f32_16x16x32_bf16(ah, Bl[nt][ks], acc[nt], 0, 0, 0);
                acc[nt] = __builtin_amdgcn_mfma_f32_16x16x32_bf16(al, Bh[nt][ks], acc[nt], 0, 0, 0);
            }
        }
#pragma unroll
        for (int nt = 0; nt < 3; ++nt)
#pragma unroll
            for (int r = 0; r < 4; ++r) part[(wave * 16 + 4 * (lane >> 4) + r) * 48 + nt * 16 + (lane & 15)] = acc[nt][r];
        LDS_BARRIER();
        { const int itn = (grp - bid) / G;
          for (int idx = tid; idx < 16 * 36; idx += NTHR) { const int tk = idx / 36, n = idx % 36; float s = 0.f;
#pragma unroll
            for (int w = 0; w < 8; ++w) s += part[(w * 16 + tk) * 48 + n];
            lgt[(itn * 16 + tk) * 36 + n] = s + (n < 4 ? bgrp[n] : brt[n - 4]); } }
    }
    LDS_BARRIER();
    for (int tk = tid; tk < 16 * ((T / 16 - bid + G - 1) / G); tk += NTHR) {
        const size_t m = ((size_t)bid + (size_t)(tk >> 4) * G) * 16 + (tk & 15);
        const LAS float* lg = lgt + tk * 36;
        int gi = 0; float gm = lg[0];
#pragma unroll
        for (int n = 1; n < 4; ++n) if (lg[n] > gm) { gm = lg[n]; gi = n; }
        float gs = 0.f;
#pragma unroll
        for (int n = 0; n < 4; ++n) gs += __expf(lg[n] - gm);
        const float pg = 1.f / gs;
        float el[8];
#pragma unroll
        for (int i = 0; i < 8; ++i) el[i] = lg[4 + gi * 8 + i];
        int i1 = 0; float m1 = el[0];
#pragma unroll
        for (int i = 1; i < 8; ++i) if (el[i] > m1) { m1 = el[i]; i1 = i; }
        int i2 = -1; float m2 = -3.0e38f;
#pragma unroll
        for (int i = 0; i < 8; ++i) if (i != i1 && el[i] > m2) { m2 = el[i]; i2 = i; }
        const float e2 = __expf(m2 - m1), inv = 1.f / (1.f + e2);
        const int ea = gi * 8 + i1, eb = gi * 8 + i2;
        tok_e[m * 2] = ea; tok_e[m * 2 + 1] = eb; tok_w[m * 2] = pg * inv; tok_w[m * 2 + 1] = pg * e2 * inv;
        atomicAdd((int*)&hist[ea], 1); atomicAdd((int*)&hist[eb], 1);
    }
    LDS_BARRIER();
    if (tid < 32) ((int*)(ws + WS_BLKC))[bid * 32 + tid] = hist[tid];
}

__device__ __forceinline__ void moe_sort(unsigned char* ws, LAS unsigned char* lds, int bid, int G, int tid) {
    const int* blkc = (const int*)(ws + WS_BLKC); const int* tok_e = (const int*)(ws + WS_TOKE); const float* tok_w = (const float*)(ws + WS_TOKW);
    int* tok_s = (int*)(ws + WS_TOKS); int* slot_t = (int*)(ws + WS_SLOTT); float* slot_w = (float*)(ws + WS_SLOTW); int* tile = (int*)(ws + WS_TILE);
    LAS int* ptot = (LAS int*)lds; LAS int* pbase = ptot + 512; LAS int* tot = pbase + 512; LAS int* base = tot + 32; LAS int* pstart = base + 32; LAS int* lcur = pstart + 33;
    { const int e = tid & 31, part = tid >> 5; int st = 0, sb = 0;
#pragma unroll 16
      for (int b = part; b < G; b += 16) { const int c = blkc[b * 32 + e]; st += c; sb += (b < bid) ? c : 0; }
      ptot[part * 32 + e] = st; pbase[part * 32 + e] = sb; }
    __syncthreads();
    if (tid < 32) { int st = 0, sb = 0;
#pragma unroll
        for (int p = 0; p < 16; ++p) { st += ptot[p * 32 + tid]; sb += pbase[p * 32 + tid]; }
        tot[tid] = st; base[tid] = sb; lcur[tid] = 0; }
    __syncthreads();
    if (tid == 0) { int acc = 0; for (int e = 0; e < 32; ++e) { pstart[e] = acc; acc += (tot[e] + 255) & ~255; } pstart[32] = acc; }
    __syncthreads();
    if (bid == 0) {
        const int nt = pstart[32] >> 8;
        if (tid == 0) tile[511] = nt;
        for (int t = tid; t < nt; t += NTHR) { int e = 0; for (int q = 1; q < 32; ++q) if ((t << 8) >= pstart[q]) e = q; tile[t] = e; }
    }
    for (int e = bid; e < 32; e += G)
        for (int s = pstart[e] + tot[e] + tid; s < pstart[e + 1]; s += NTHR) { slot_t[s] = 0; slot_w[s] = 0.f; }
    LAS int* gcnt = lcur + 32;
    const int wave_ = tid >> 6, lane_ = tid & 63;
    for (int g0 = 0; bid + g0 * G < T / 16; g0 += 8) {
        if (tid < 256) gcnt[tid] = 0;
        __syncthreads();
        const int grp = bid + (g0 + wave_) * G; const bool act = lane_ < 32 && grp < T / 16;
        size_t a = 0; int e = 0, rin = 0; float w = 0.f;
        if (act) { a = (size_t)grp * 32 + lane_; e = tok_e[a]; w = tok_w[a]; rin = atomicAdd((int*)&gcnt[wave_ * 32 + e], 1); }
        __syncthreads();
        if (act) { int off = lcur[e];
            for (int w2 = 0; w2 < wave_; ++w2) off += gcnt[w2 * 32 + e];
            const int sl = pstart[e] + base[e] + off + rin; slot_t[sl] = (int)(a >> 1); slot_w[sl] = w; tok_s[a] = sl; }
        __syncthreads();
        if (tid < 32) { int t = lcur[tid];
#pragma unroll
            for (int w2 = 0; w2 < 8; ++w2) t += gcnt[w2 * 32 + tid];
            lcur[tid] = t; }
        __syncthreads();
    }
}

template <bool FINAL, bool RD_LO, bool WR_LO>
__device__ __forceinline__ void combine_ln(unsigned char* ws, const float* lng, const float* lnb, float* dout, int gw, int NGW, int lane) {
    bf16* hlo = (bf16*)(ws + WS_HLO); bf16* hhi = (bf16*)(ws + WS_HHI); const bf16* y2 = (const bf16*)(ws + WS_Y2); const int* tok_s = (const int*)(ws + WS_TOKS); const float* tok_w = (const float*)(ws + WS_TOKW);
    f32x4 gv[4], bv[4];
#pragma unroll
    for (int j = 0; j < 4; ++j) { gv[j] = *(const f32x4*)(lng + 4 * lane + 256 * j); bv[j] = *(const f32x4*)(lnb + 4 * lane + 256 * j); }
    for (int m = gw; m < T; m += NGW) {
        const int s0 = tok_s[(size_t)m * 2], s1 = tok_s[(size_t)m * 2 + 1]; const float w0 = tok_w[(size_t)m * 2], w1 = tok_w[(size_t)m * 2 + 1];
        GAS u32x2* hr = (GAS u32x2*)(hhi + (size_t)m * D) + lane; GAS u32x2* lr = (GAS u32x2*)(hlo + (size_t)m * D) + lane;
        const GAS u32x2* ya = (const GAS u32x2*)(y2 + (size_t)s0 * D) + lane; const GAS u32x2* yb = (const GAS u32x2*)(y2 + (size_t)s1 * D) + lane;
        f32x4 v[4]; float s = 0.f;
#pragma unroll
        for (int j = 0; j < 4; ++j) { const u32x2 hh_ = hr[64 * j]; f32x4 h; h.x = bflo(hh_.x); h.y = bfhi(hh_.x); h.z = bflo(hh_.y); h.w = bfhi(hh_.y);
            if (RD_LO) { const u32x2 hl_ = lr[64 * j]; h.x += bflo(hl_.x); h.y += bfhi(hl_.x); h.z += bflo(hl_.y); h.w += bfhi(hl_.y); }
            const u32x2 a = ya[64 * j], b = yb[64 * j];
            v[j].x = h.x * ALPHA + (w0 * bflo(a.x) + w1 * bflo(b.x)); v[j].y = h.y * ALPHA + (w0 * bfhi(a.x) + w1 * bfhi(b.x)); v[j].z = h.z * ALPHA + (w0 * bflo(a.y) + w1 * bflo(b.y)); v[j].w = h.w * ALPHA + (w0 * bfhi(a.y) + w1 * bfhi(b.y));
            s += (v[j].x + v[j].y) + (v[j].z + v[j].w); }
        const float mean = wave_sum(s) * (1.f / D); float s2 = 0.f;
#pragma unroll
        for (int j = 0; j < 4; ++j) { v[j] = v[j] - mean; s2 += (v[j].x * v[j].x + v[j].y * v[j].y) + (v[j].z * v[j].z + v[j].w * v[j].w); }
        const float rstd = 1.f / sqrtf(wave_sum(s2) * (1.f / D) + LN_EPS);
#pragma unroll
        for (int j = 0; j < 4; ++j) { const f32x4 h = v[j] * rstd * gv[j] + bv[j];
            if (FINAL) ((GAS f32x4*)(dout + (size_t)m * D) + lane)[64 * j] = h;
            else { u32x2 w; w.x = pk2(h.x, h.y); w.y = pk2(h.z, h.w); hr[64 * j] = w;
                   if (WR_LO) { u32x2 lo; lo.x = pk2(h.x - bflo(w.x), h.y - bfhi(w.x)); lo.y = pk2(h.z - bflo(w.y), h.w - bfhi(w.y)); lr[64 * j] = lo; } } }
    }
}
constexpr int S5_HST = 272, S5_UST = 272, S5_UOFF = 8 * 32 * S5_HST;
#define MFMA32(a, b, c) __builtin_amdgcn_mfma_f32_32x32x16_bf16((a), (b), (c), 0, 0, 0)
#define MFMA16(a, b, c) __builtin_amdgcn_mfma_f32_16x16x32_bf16((a), (b), (c), 0, 0, 0)
__device__ __forceinline__ float gelu_tanh(float x) {
    const float u = 0.7978845608028654f * (x + 0.044715f * x * x * x);
    const float e = __expf(2.f * u); const float th = 1.f - 2.f * __builtin_amdgcn_rcpf(e + 1.f);
    return 0.5f * x * (1.f + th);
}
#define S5_SCALAR_FMA 1
#define S5_PERMLANE 1
#define S5_NO_NOPS 1
#ifdef S5_SCALAR_FMA
__device__ __forceinline__ float sfma(float a, float b, float c) { float d; asm("v_fma_f32 %0, %1, %2, %3" : "=v"(d) : "v"(a), "v"(b), "v"(c)); return d; }
#define FMAF(a, b, c) sfma((a), (b), (c))
#else
#define FMAF(a, b, c) fmaf((a), (b), (c))
#endif
__device__ __forceinline__ f32x4 ld_ys(const float* p) {
    f32x4 v;
    v.x = __hip_atomic_load(p, __ATOMIC_RELAXED, __HIP_MEMORY_SCOPE_AGENT); v.y = __hip_atomic_load(p + 1, __ATOMIC_RELAXED, __HIP_MEMORY_SCOPE_AGENT);
    v.z = __hip_atomic_load(p + 2, __ATOMIC_RELAXED, __HIP_MEMORY_SCOPE_AGENT); v.w = __hip_atomic_load(p + 3, __ATOMIC_RELAXED, __HIP_MEMORY_SCOPE_AGENT);
    return v;
}
constexpr int CW_CHKA = 64, CW_CHKB = 65, CW_CHKC = 66, CW_CHKD = 67;
__device__ __forceinline__ void s5_carry2(unsigned char* ws, int b, int g, int c, int lane, float (&h0_)[2], float (&h1_)[2]) {
    const float* E0 = (const float*)(ws + WS_S5E) + ((size_t)((0 * NB + b) * 32 + g) * S5NCH) * 128 + 2 * lane;
    const float* E1 = (const float*)(ws + WS_S5E) + ((size_t)((1 * NB + b) * 32 + g) * S5NCH) * 128 + 2 * lane;
    const f32x4 La = *(const f32x4*)((const float*)(ws + WS_S5L) + (size_t)((0 * 32 + g) * 64 + lane) * 4), Lb = *(const f32x4*)((const float*)(ws + WS_S5L) + (size_t)((1 * 32 + g) * 64 + lane) * 4);
    const float q0r = La.z, q0i = La.w, q1r = Lb.z, q1i = Lb.w;
    float ar = 0.f, ai = 0.f, br = 0.f, bi = 0.f;
    const int n0 = c, n1 = S5NCH - 1 - c, nm = n0 > n1 ? n0 : n1;
    for (int j0 = 0; j0 < nm; j0 += 16) {
        f32x2 e0[16], e1[16];
#pragma unroll
        for (int q = 0; q < 16; ++q) { int j = j0 + q; const int ja = j < n0 ? j : (n0 > 0 ? n0 - 1 : 0), jb = j < n1 ? j : (n1 > 0 ? n1 - 1 : 0);
            e0[q] = *(const f32x2*)(E0 + (size_t)ja * 128); e1[q] = *(const f32x2*)(E1 + (size_t)(S5NCH - 1 - jb) * 128); }
#pragma unroll
        for (int q = 0; q < 16; ++q) {
            if (j0 + q < n0) { const float nr = FMAF(q0r, ar, FMAF(-q0i, ai, e0[q].x)); ai = FMAF(q0r, ai, FMAF(q0i, ar, e0[q].y)); ar = nr; }
            if (j0 + q < n1) { const float nr = FMAF(q1r, br, FMAF(-q1i, bi, e1[q].x)); bi = FMAF(q1r, bi, FMAF(q1i, br, e1[q].y)); br = nr; }
        }
    }
    h0_[0] = ar; h0_[1] = ai; h1_[0] = br; h1_[1] = bi;
}
template <int PASS, int DIR, bool CHK = false>
__device__ __forceinline__ void s5_dir(unsigned char* ws, const float* s5d, int b, int g, int c, LAS unsigned char* hl, const LAS unsigned char* ul, float* yscr, int lane, f32x4 (&ysr)[16], const float (&hin)[2]) {
    const bf16* h0 = (const bf16*)(ws + WS_H0);
    const int dg = DIR * 32 + g;
    const f32x4 L4 = *(const f32x4*)((const float*)(ws + WS_S5L) + (size_t)(dg * 64 + lane) * 4);
    const float ar = L4.x, ai = L4.y, qr = L4.z, qi = L4.w;
    const float l2r = ar * ar - ai * ai, l2i = 2.f * ar * ai, l4r = l2r * l2r - l2i * l2i, l4i = 2.f * l2r * l2i, l8r = l4r * l4r - l4i * l4i, l8i = 2.f * l4r * l4i;
    const float l16r = l8r * l8r - l8i * l8i, l16i = 2.f * l8r * l8i, l32r = l16r * l16r - l16i * l16i, l32i = 2.f * l16r * l16i;
    const bf16* Bb = (const bf16*)(ws + WS_S5B) + (size_t)dg * 2048 + (lane & 31) * 16 + 8 * (lane >> 5);
    const bf16x8 bre0 = *(const bf16x8*)Bb, bre1 = *(const bf16x8*)(Bb + 512), bim0 = *(const bf16x8*)(Bb + 1024), bim1 = *(const bf16x8*)(Bb + 1536);
    bf16x8 cf[4]; bf16x8 dfrag;
    if (PASS == 2) {
        const bf16* Cm = (const bf16*)(ws + WS_S5C) + (size_t)dg * 2048 + (lane & 15) * 128 + 8 * (lane >> 4);
#pragma unroll
        for (int ks = 0; ks < 4; ++ks) cf[ks] = *(const bf16x8*)(Cm + 32 * ks);
        if (DIR == 1) {
            const int cc = lane & 15, kq = lane >> 4; const float d = s5d[g * 16 + cc]; const unsigned dh = f2bf(d); const unsigned dl = f2bf(d - __uint_as_float(dh << 16));
#pragma unroll
            for (int j = 0; j < 8; ++j) { const int k = 8 * (kq & 1) + j; dfrag[j] = (short)((k == cc) ? (kq < 2 ? dh : dl) : 0u); }
        }
    }
    float hr = 0.f, hi = 0.f;
    float* Ec = (float*)(ws + WS_S5E) + ((size_t)((DIR * NB + b) * 32 + g) * S5NCH) * 128 + 2 * lane;
#ifdef S5_CARRY2
    if (PASS == 2) { hr = hin[0]; hi = hin[1]; }
    if (false) {
#else
    if (PASS == 2) {
#endif
        const int nj = DIR == 0 ? c : (S5NCH - 1 - c);
        for (int j0 = 0; j0 < nj; j0 += 32) {
            f32x2 e[32];
#pragma unroll
            for (int q = 0; q < 32; ++q) { const int j = (j0 + q) < nj ? (j0 + q) : (nj - 1); const int jj = DIR == 0 ? j : (S5NCH - 1 - j); e[q] = *(const f32x2*)(Ec + (size_t)jj * 128); }
#pragma unroll
            for (int q = 0; q < 32; ++q) if (j0 + q < nj) { const float nr = FMAF(qr, hr, FMAF(-qi, hi, e[q].x)); hi = FMAF(qr, hi, FMAF(qi, hr, e[q].y)); hr = nr; }
        }
    }
    const size_t rowbase = (size_t)b * SEQ + (size_t)c * S5CH;
    const LAS unsigned char* up = ul + (lane & 31) * S5_UST + (g & 7) * 32 + 16 * (lane >> 5);
#ifdef S5_GLOBAL_U
    const bf16* ug = h0 + (rowbase + (lane & 31)) * H0P + OFF_U + g * 16 + 8 * (lane >> 5);
    bf16x8 a_next = *(const bf16x8*)(ug + (size_t)(DIR == 0 ? 0 : S5CH / 32 - 1) * 32 * H0P);
#endif
    const f32x16 zero16 = {0.f, 0.f, 0.f, 0.f, 0.f, 0.f, 0.f, 0.f, 0.f, 0.f, 0.f, 0.f, 0.f, 0.f, 0.f, 0.f};
#if defined(S5_YREG) && defined(S5_P1_ROLLED)
#pragma unroll (PASS == 2 ? 8 : 1)
#elif defined(S5_YREG)
#pragma unroll
#else
#pragma unroll 1
#endif
    for (int ti = 0; ti < S5CH / 32; ++ti) {
        const int tile = DIR == 0 ? ti : (S5CH / 32 - 1 - ti);
#ifdef S5_GLOBAL_U
        const bf16x8 a = a_next;
        if (ti + 1 < S5CH / 32) a_next = *(const bf16x8*)(ug + (size_t)(DIR == 0 ? ti + 1 : S5CH / 32 - 2 - ti) * 32 * H0P);
        bf16x8 ufg[2];
        if (PASS == 2 && DIR == 1) {
#pragma unroll
            for (int sub = 0; sub < 2; ++sub) ufg[sub] = *(const bf16x8*)(h0 + (rowbase + tile * 32 + sub * 16 + (lane & 15)) * H0P + OFF_U + g * 16 + 8 * ((lane >> 4) & 1)); }
#else
        const bf16x8 a = *(const LAS bf16x8*)(up + tile * 32 * S5_UST);
#endif
        f32x4 ysv[2] = {{0.f, 0.f, 0.f, 0.f}, {0.f, 0.f, 0.f, 0.f}};
#ifdef S5_ABL
        if (PASS == 2 && DIR == 1 && !(CHK && (S5_ABL & 4))) { ysv[0] = ld_ys(yscr + (size_t)(tile * 2) * 256 + 4 * lane); ysv[1] = ld_ys(yscr + (size_t)(tile * 2 + 1) * 256 + 4 * lane); }
#elif defined(S5_YREG)
        if (PASS == 2 && DIR == 1) { ysv[0] = ysr[tile * 2]; ysv[1] = ysr[tile * 2 + 1]; }
#else
        if (PASS == 2 && DIR == 1) { ysv[0] = ld_ys(yscr + (size_t)(tile * 2) * 256 + 4 * lane); ysv[1] = ld_ys(yscr + (size_t)(tile * 2 + 1) * 256 + 4 * lane); }
#endif
        f32x16 xr0 = MFMA32(a, bre0, zero16), xr1 = MFMA32(a, bre1, zero16), xi0 = MFMA32(a, bim0, zero16), xi1 = MFMA32(a, bim1, zero16);
        asm volatile("" : "+v"(xr0), "+v"(xr1), "+v"(xi0), "+v"(xi1) : "v"(a));
#define S5_KEEP_A 1
#ifdef S5_SLEEP
        __builtin_amdgcn_sched_barrier(0); __builtin_amdgcn_s_sleep(16); __builtin_amdgcn_sched_barrier(0);
#endif
#if (defined(S5_PERMLANE) && !defined(S5_NO_NOPS)) || defined(S5_NOPS)
        __builtin_amdgcn_sched_barrier(0);
        asm volatile("s_nop 15\n\ts_nop 15\n\ts_nop 15\n\ts_nop 15\n\ts_nop 15\n\ts_nop 15" ::: "memory");
        __builtin_amdgcn_sched_barrier(0);
#endif
        float xr[32], xi[32];
#pragma unroll
        for (int r = 0; r < 16; ++r) {
#ifdef S5_PERMLANE
            auto s = __builtin_amdgcn_permlane32_swap(__float_as_uint(xr0[r]), __float_as_uint(xr1[r]), false, false);
            xr[crow(r, 0)] = __uint_as_float(s[0]); xr[crow(r, 1)] = __uint_as_float(s[1]);
            auto q = __builtin_amdgcn_permlane32_swap(__float_as_uint(xi0[r]), __float_as_uint(xi1[r]), false, false);
            xi[crow(r, 0)] = __uint_as_float(q[0]); xi[crow(r, 1)] = __uint_as_float(q[1]);
#else
            const bool up = lane >= 32; const int pa = (lane ^ 32) << 2;
            { const float sr = up ? xr0[r] : xr1[r], rr_ = __int_as_float(__builtin_amdgcn_ds_bpermute(pa, __float_as_int(sr)));
              xr[crow(r, 0)] = up ? rr_ : xr0[r]; xr[crow(r, 1)] = up ? xr1[r] : rr_; }
            { const float si = up ? xi0[r] : xi1[r], ri_ = __int_as_float(__builtin_amdgcn_ds_bpermute(pa, __float_as_int(si)));
              xi[crow(r, 0)] = up ? ri_ : xi0[r]; xi[crow(r, 1)] = up ? xi1[r] : ri_; }
#endif
        }
#ifdef S5_CHECK_X
        if (PASS == 1) { unsigned cs = 0u;
#pragma unroll
            for (int t = 0; t < 32; ++t) cs ^= (__float_as_uint(xr[t]) * (2u * t + 1u)) ^ (__float_as_uint(xi[t]) * (2u * t + 65u));
            unsigned* cw = (unsigned*)(ws + WS_OF) + ((size_t)((b * S5NCH + c) * 32 + g) * 2 + DIR) * 512 + tile * 64 + lane;
            if (CHK) { if (*cw != cs) atomicAdd((unsigned*)(ws + WS_CTL) + CW_CHKD, 1u); } else *cw = cs; }
#endif
#ifdef S5_KEEP_A
        asm volatile("" : "+v"(xi[31]), "+v"(xr[31]) : "v"(a));
#endif
        if (PASS == 1) {
#pragma unroll
            for (int lv = 0; lv < 5; ++lv) {
                const float pr = lv == 0 ? ar : lv == 1 ? l2r : lv == 2 ? l4r : lv == 3 ? l8r : l16r, pi = lv == 0 ? ai : lv == 1 ? l2i : lv == 2 ? l4i : lv == 3 ? l8i : l16i;
#pragma unroll
                for (int i = 0; i < (16 >> lv); ++i) {
                    const int e = DIR == 0 ? 2 * i : 2 * i + 1, l = DIR == 0 ? 2 * i + 1 : 2 * i;
                    const float er = xr[e << lv], ei = xi[e << lv], lr_ = xr[l << lv], li_ = xi[l << lv];
                    const float wr = FMAF(pr, er, FMAF(-pi, ei, lr_)), wi = FMAF(pr, ei, FMAF(pi, er, li_));
                    xr[(2 * i) << lv] = wr; xi[(2 * i) << lv] = wi;
                }
            }
            { const float nr = FMAF(l32r, hr, FMAF(-l32i, hi, xr[0])), ni = FMAF(l32r, hi, FMAF(l32i, hr, xi[0])); hr = nr; hi = ni; }
        }
#ifdef S5_ABL
        else if (CHK && (S5_ABL & 2)) { float acc_ = 0.f;
#pragma unroll
            for (int t = 0; t < 32; ++t) acc_ += xr[t] + xi[t];
            if (acc_ == 1.2345e33f) *(LAS unsigned*)(hl + 4 * lane) = 0u; }
#endif
        else {
#pragma unroll
        for (int tt = 0; tt < 32; ++tt) {
            const int t = DIR == 0 ? tt : 31 - tt;
            const float tr_ = FMAF(-ai, hi, xr[t]), ti_ = FMAF(ai, hr, xi[t]);
            hr = FMAF(ar, hr, tr_); hi = FMAF(ar, hi, ti_);
            *(LAS unsigned*)(hl + t * S5_HST + 4 * lane) = pk2(hr, hi);
        }
        }
#ifdef S5_ABL
        if (PASS == 2 && !(CHK && (S5_ABL & 1))) {
#else
        if (PASS == 2) {
#endif
#pragma unroll
            for (int sub = 0; sub < 2; ++sub) {
                float* ys = yscr + (size_t)(tile * 2 + sub) * 256 + 4 * lane;
                f32x4 y = {0.f, 0.f, 0.f, 0.f};
                if (DIR == 1) y = ysv[sub];
                bf16x8 hf[4];
#pragma unroll
                for (int ks = 0; ks < 4; ++ks) hf[ks] = *(const LAS bf16x8*)(hl + (sub * 16 + (lane & 15)) * S5_HST + 64 * ks + 16 * (lane >> 4));
#pragma unroll
                for (int ks = 0; ks < 4; ++ks) y = MFMA16(hf[ks], cf[ks], y);
#ifdef S5_ABL
                if (CHK && (S5_ABL & 4)) { if (y[0] == 1.2345e33f && y[3] == 2.f) *(LAS unsigned*)(hl + 4 * lane) = 0u; if (DIR == 0) continue; }
#endif
#ifdef S5_YREG
                if (DIR == 0) ysr[tile * 2 + sub] = y;
#else
                if (DIR == 0) { *(f32x4*)ys = y; __builtin_amdgcn_sched_barrier(0); asm volatile("" :: "v"(hf[0]), "v"(hf[1]), "v"(hf[2]), "v"(hf[3])); }
#endif
                else {
#ifdef S5_GLOBAL_U
                    const bf16x8 uf = ufg[sub];
#else
                    const bf16x8 uf = *(const LAS bf16x8*)(ul + (tile * 32 + sub * 16 + (lane & 15)) * S5_UST + (g & 7) * 32 + 16 * ((lane >> 4) & 1));
#endif
                    y = MFMA16(uf, dfrag, y);
#if defined(S5_YLDS) && !defined(S5_GLOBAL_U)
                    LAS bf16* yl = (LAS bf16*)(const_cast<LAS unsigned char*>(ul) + (tile * 32 + sub * 16 + 4 * (lane >> 4)) * S5_UST + (g & 7) * 32 + 2 * (lane & 15));
#pragma unroll
                    for (int r = 0; r < 4; ++r) yl[r * (S5_UST / 2)] = (bf16)f2bf(gelu_tanh(y[r]));
#elif defined(S5_YPAIR)
                    { unsigned nv[4], ov[4];
#pragma unroll
                      for (int r = 0; r < 4; ++r) { nv[r] = f2bf(gelu_tanh(y[r])); ov[r] = (unsigned)__shfl_xor((int)nv[r], 1); }
                      const int odd = lane & 1;
                      unsigned* yo2 = (unsigned*)((bf16*)(ws + WS_YG) + (rowbase + tile * 32 + sub * 16 + 4 * (lane >> 4) + 2 * odd) * 512 + g * 16 + ((lane & 15) & ~1));
                      const unsigned w0 = odd ? (ov[2] | (nv[2] << 16)) : (nv[0] | (ov[0] << 16)), w1 = odd ? (ov[3] | (nv[3] << 16)) : (nv[1] | (ov[1] << 16));
                      yo2[0] = w0; yo2[256] = w1; }
#else
                    bf16* yo = (bf16*)(ws + WS_YG) + (rowbase + tile * 32 + sub * 16 + 4 * (lane >> 4)) * 512 + g * 16 + (lane & 15);
#pragma unroll
                    for (int r = 0; r < 4; ++r) { const bf16 nv = (bf16)f2bf(gelu_tanh(y[r]));
#ifdef S5_ABL
                        if (CHK && (S5_ABL & (4 | 8))) { if (nv == 0x7fc1) *(LAS unsigned*)(hl + 4 * lane) = 1u; continue; }
#endif
                        if (CHK) { if (yo[(size_t)r * 512] != nv) atomicAdd((unsigned*)(ws + WS_CTL) + CW_CHKB, 1u); } else yo[(size_t)r * 512] = nv; }
#endif
                    __builtin_amdgcn_sched_barrier(0); asm volatile("" :: "v"(hf[0]), "v"(hf[1]), "v"(hf[2]), "v"(hf[3]), "v"(uf));

                }
            }
        }
    }
    if (PASS == 1) { f32x2 e; e.x = hr; e.y = hi;
        if (CHK) { const f32x2 o = *(const f32x2*)(Ec + (size_t)c * 128);
#ifndef S5_NO_EC
            if (__float_as_uint(o.x) != __float_as_uint(e.x) || __float_as_uint(o.y) != __float_as_uint(e.y)) {
                const float dn = fabsf(o.x - e.x) + fabsf(o.y - e.y), mg = fabsf(o.x) + fabsf(o.y) + fabsf(e.x) + fabsf(e.y);
                atomicAdd((unsigned*)(ws + WS_CTL) + (dn > 1e-3f * mg ? CW_CHKD : CW_CHKA), 1u); }
#endif
        }
        else *(f32x2*)(Ec + (size_t)c * 128) = e; }
}
constexpr int S5G_TP = 1040;
template <bool CHK = false>
__device__ __forceinline__ void s5_pass1_gemm(unsigned char* ws, LAS unsigned char* lds, int bid, int G, int tid, int wave, int lane) {
    const bf16* h0 = (const bf16*)(ws + WS_H0); const bf16* W32 = (const bf16*)(ws + WS_W32);
    for (int it = bid; it < 256; it += G) {
        const int g = it >> 3, cgi = it & 7, b = cgi >> 2, c0 = (cgi & 3) * 16;
        const size_t tok0 = (size_t)b * SEQ + (size_t)c0 * S5CH;
        { u32x4 v[16];
#pragma unroll
          for (int k = 0; k < 16; ++k) { const int idx = k * NTHR + tid, tk = idx >> 1, hf = idx & 1; v[k] = *(const u32x4*)(h0 + (tok0 + tk) * H0P + OFF_U + g * 16 + 8 * hf); }
          __syncthreads();
#pragma unroll
          for (int k = 0; k < 16; ++k) { const int idx = k * NTHR + tid, tk = idx >> 1, hf = idx & 1; *(LAS u32x4*)(lds + (tk >> 5) * S5G_TP + (tk & 31) * 32 + hf * 16) = v[k]; }
          __syncthreads(); }
        const int sg = wave & 3, dir = wave >> 2, dg = dir * 32 + g, p = 16 * sg + (lane & 15);
        const bf16* Wr = W32 + ((size_t)(dg * 2 + 0) * 64 + p) * 512 + 8 * (lane >> 4); const bf16* Wi = Wr + (size_t)64 * 512;
        f32x4 ar_[8], ai_[8];
#pragma unroll
        for (int m = 0; m < 8; ++m) { ar_[m] = f32x4{0.f, 0.f, 0.f, 0.f}; ai_[m] = f32x4{0.f, 0.f, 0.f, 0.f}; }
        const LAS unsigned char* ap = lds + (lane & 15) * S5G_TP + (lane >> 5) * 32 + ((lane >> 4) & 1) * 16;
#pragma unroll 4
        for (int q = 0; q < 16; ++q) {
            const bf16x8 br = *(const bf16x8*)(Wr + 32 * q), bi = *(const bf16x8*)(Wi + 32 * q);
#pragma unroll
            for (int m = 0; m < 8; ++m) { const bf16x8 a = *(const LAS bf16x8*)(ap + m * 16 * S5G_TP + q * 64); ar_[m] = MFMA16(a, br, ar_[m]); ai_[m] = MFMA16(a, bi, ai_[m]); }
        }
        const f32x4 L4 = *(const f32x4*)((const float*)(ws + WS_S5L) + (size_t)(dg * 64 + p) * 4);
        float pr = L4.x, pi = L4.y;
#pragma unroll
        for (int k = 0; k < 5; ++k) { const float t = pr * pr - pi * pi; pi = 2.f * pr * pi; pr = t; }
        const float l32r = pr, l32i = pi;
#pragma unroll
        for (int k = 0; k < 2; ++k) { const float t = pr * pr - pi * pi; pi = 2.f * pr * pi; pr = t; }
        const float l128r = pr, l128i = pi;
        const int lg = lane >> 4, half = lg & 1, chh = lg >> 1;
        float* Ec = (float*)(ws + (CHK ? WS_OF : WS_S5E)) + ((size_t)((dir * NB + b) * 32 + g) * S5NCH) * 128 + 2 * p;
#pragma unroll
        for (int m = 0; m < 8; ++m) {
            float er, ei;
            if (dir == 0) { er = ar_[m][0]; ei = ai_[m][0];
#pragma unroll
                for (int r = 1; r < 4; ++r) { const float nr = FMAF(l32r, er, FMAF(-l32i, ei, ar_[m][r])), ni = FMAF(l32r, ei, FMAF(l32i, er, ai_[m][r])); er = nr; ei = ni; } }
            else { er = ar_[m][3]; ei = ai_[m][3];
#pragma unroll
                for (int r = 2; r >= 0; --r) { const float nr = FMAF(l32r, er, FMAF(-l32i, ei, ar_[m][r])), ni = FMAF(l32r, ei, FMAF(l32i, er, ai_[m][r])); er = nr; ei = ni; } }
            const int pa = (lane ^ 16) << 2;
            const float qr_ = __int_as_float(__builtin_amdgcn_ds_bpermute(pa, __float_as_int(er))), qi_ = __int_as_float(__builtin_amdgcn_ds_bpermute(pa, __float_as_int(ei)));
            const float Er = FMAF(l128r, qr_, FMAF(-l128i, qi_, er)), Ei = FMAF(l128r, qi_, FMAF(l128i, qr_, ei));
            if (half == (dir == 0 ? 1 : 0)) { f32x2 e; e.x = Er; e.y = Ei; *(f32x2*)(Ec + (size_t)(c0 + 2 * m + chh) * 128) = e; }
        }
    }
}
struct S5Dir { float ar, ai, hr, hi; bf16x8 bre0, bre1, bim0, bim1, cf0, cf1, cf2, cf3, a_next; const bf16* ug; };
template <int DIR>
__device__ __forceinline__ void s5il_init(S5Dir& S, unsigned char* ws, int b, int g, int c, int lane) {
    const bf16* h0 = (const bf16*)(ws + WS_H0);
    const int dg = DIR * 32 + g;
    const f32x4 L4 = *(const f32x4*)((const float*)(ws + WS_S5L) + (size_t)(dg * 64 + lane) * 4);
    S.ar = L4.x; S.ai = L4.y; const float qr = L4.z, qi = L4.w;
    const bf16* Bb = (const bf16*)(ws + WS_S5B) + (size_t)dg * 2048 + (lane & 31) * 16 + 8 * (lane >> 5);
    S.bre0 = *(const bf16x8*)Bb; S.bre1 = *(const bf16x8*)(Bb + 512); S.bim0 = *(const bf16x8*)(Bb + 1024); S.bim1 = *(const bf16x8*)(Bb + 1536);
    const bf16* Cm = (const bf16*)(ws + WS_S5C) + (size_t)dg * 2048 + (lane & 15) * 128 + 8 * (lane >> 4);
    S.cf0 = *(const bf16x8*)(Cm); S.cf1 = *(const bf16x8*)(Cm + 32); S.cf2 = *(const bf16x8*)(Cm + 64); S.cf3 = *(const bf16x8*)(Cm + 96);
    float hr = 0.f, hi = 0.f;
    const float* Ec = (const float*)(ws + WS_S5E) + ((size_t)((DIR * NB + b) * 32 + g) * S5NCH) * 128 + 2 * lane;
    const int nj = DIR == 0 ? c : (S5NCH - 1 - c);
    for (int j0 = 0; j0 < nj; j0 += 32) {
        f32x2 e[32];
#pragma unroll
        for (int q = 0; q < 32; ++q) { const int j = (j0 + q) < nj ? (j0 + q) : (nj - 1); const int jj = DIR == 0 ? j : (S5NCH - 1 - j); e[q] = *(const f32x2*)(Ec + (size_t)jj * 128); }
#pragma unroll
        for (int q = 0; q < 32; ++q) if (j0 + q < nj) { const float nr = FMAF(qr, hr, FMAF(-qi, hi, e[q].x)); hi = FMAF(qr, hi, FMAF(qi, hr, e[q].y)); hr = nr; }
    }
    S.hr = hr; S.hi = hi;
    const size_t rowbase = (size_t)b * SEQ + (size_t)c * S5CH;
    S.ug = h0 + (rowbase + (lane & 31)) * H0P + OFF_U + g * 16 + 8 * (lane >> 5);
    S.a_next = *(const bf16x8*)(S.ug + (size_t)(DIR == 0 ? 0 : S5CH / 32 - 1) * 32 * H0P);
}
template <int DIR, bool FIN>
__device__ __forceinline__ void s5il_tile(S5Dir& S, unsigned char* ws, int tile, int next_tile, const bf16x8& dfrag, size_t rowbase, int g, LAS unsigned char* hl, float* yscr, int lane) {
    const bf16* h0 = (const bf16*)(ws + WS_H0);
    const bf16x8 a = S.a_next;
    if (next_tile >= 0) S.a_next = *(const bf16x8*)(S.ug + (size_t)next_tile * 32 * H0P);
    f32x4 ysv[2] = {{0.f, 0.f, 0.f, 0.f}, {0.f, 0.f, 0.f, 0.f}}; bf16x8 ufg[2];
    if (FIN) {
#pragma unroll
        for (int sub = 0; sub < 2; ++sub) { ysv[sub] = ld_ys(yscr + (size_t)(tile * 2 + sub) * 256 + 4 * lane);
            ufg[sub] = *(const bf16x8*)(h0 + (rowbase + tile * 32 + sub * 16 + (lane & 15)) * H0P + OFF_U + g * 16 + 8 * ((lane >> 4) & 1)); } }
    const f32x16 zero16 = {0.f, 0.f, 0.f, 0.f, 0.f, 0.f, 0.f, 0.f, 0.f, 0.f, 0.f, 0.f, 0.f, 0.f, 0.f, 0.f};
    f32x16 xr0 = MFMA32(a, S.bre0, zero16), xr1 = MFMA32(a, S.bre1, zero16), xi0 = MFMA32(a, S.bim0, zero16), xi1 = MFMA32(a, S.bim1, zero16);
    float xr[32], xi[32];
#pragma unroll
    for (int r = 0; r < 16; ++r) {
        auto s = __builtin_amdgcn_permlane32_swap(__float_as_uint(xr0[r]), __float_as_uint(xr1[r]), false, false);
        xr[crow(r, 0)] = __uint_as_float(s[0]); xr[crow(r, 1)] = __uint_as_float(s[1]);
        auto q = __builtin_amdgcn_permlane32_swap(__float_as_uint(xi0[r]), __float_as_uint(xi1[r]), false, false);
        xi[crow(r, 0)] = __uint_as_float(q[0]); xi[crow(r, 1)] = __uint_as_float(q[1]);
    }
    float hr = S.hr, hi = S.hi; const float ar = S.ar, ai = S.ai;
#pragma unroll
    for (int tt = 0; tt < 32; ++tt) {
        const int t = DIR == 0 ? tt : 31 - tt;
        const float tr_ = FMAF(-ai, hi, xr[t]), ti_ = FMAF(ai, hr, xi[t]);
        hr = FMAF(ar, hr, tr_); hi = FMAF(ar, hi, ti_);
        *(LAS unsigned*)(hl + t * S5_HST + 4 * lane) = pk2(hr, hi);
    }
    S.hr = hr; S.hi = hi;
#pragma unroll
    for (int sub = 0; sub < 2; ++sub) {
        f32x4 y = ysv[sub];
        const LAS unsigned char* hp = hl + (sub * 16 + (lane & 15)) * S5_HST + 16 * (lane >> 4);
        const bf16x8 hf0 = *(const LAS bf16x8*)(hp), hf1 = *(const LAS bf16x8*)(hp + 64), hf2 = *(const LAS bf16x8*)(hp + 128), hf3 = *(const LAS bf16x8*)(hp + 192);
        y = MFMA16(hf0, S.cf0, y); y = MFMA16(hf1, S.cf1, y); y = MFMA16(hf2, S.cf2, y); y = MFMA16(hf3, S.cf3, y);
        if (!FIN) *(f32x4*)(yscr + (size_t)(tile * 2 + sub) * 256 + 4 * lane) = y;
        else {
            y = MFMA16(ufg[sub], dfrag, y);
            bf16* yo = (bf16*)(ws + WS_YG) + (rowbase + tile * 32 + sub * 16 + 4 * (lane >> 4)) * 512 + g * 16 + (lane & 15);
#pragma unroll
            for (int r = 0; r < 4; ++r) yo[(size_t)r * 512] = (bf16)f2bf(gelu_tanh(y[r]));
        }
    }
}
__device__ __forceinline__ void s5_pass2_il(unsigned char* ws, const float* s5d, int b, int g, int c, LAS unsigned char* hl0, LAS unsigned char* hl1, float* yscr, int lane) {
    bf16x8 dfrag;
    { const int cc = lane & 15, kq = lane >> 4; const float d = s5d[g * 16 + cc]; const unsigned dh = f2bf(d); const unsigned dl = f2bf(d - __uint_as_float(dh << 16));
#pragma unroll
      for (int j = 0; j < 8; ++j) { const int k = 8 * (kq & 1) + j; dfrag[j] = (short)((k == cc) ? (kq < 2 ? dh : dl) : 0u); } }
    const size_t rowbase = (size_t)b * SEQ + (size_t)c * S5CH;
    S5Dir F, B;
    s5il_init<0>(F, ws, b, g, c, lane); s5il_init<1>(B, ws, b, g, c, lane);
#pragma unroll 1
    for (int k = 0; k < 4; ++k) {
        s5il_tile<0, false>(F, ws, k, k + 1, dfrag, rowbase, g, hl0, yscr, lane);
        s5il_tile<1, false>(B, ws, 7 - k, 6 - k, dfrag, rowbase, g, hl1, yscr, lane);
    }
    VM_WAIT();
#pragma unroll 1
    for (int k = 4; k < 8; ++k) {
        s5il_tile<0, true>(F, ws, k, k + 1 < 8 ? k + 1 : -1, dfrag, rowbase, g, hl0, yscr, lane);
        s5il_tile<1, true>(B, ws, 7 - k, 6 - k, dfrag, rowbase, g, hl1, yscr, lane);
    }
}
template <int DIR>
__device__ __forceinline__ void s5_dir2p(unsigned char* ws, const float* s5d, int b, int g, int c, LAS unsigned char* hl, const LAS unsigned char* ul, float* yscr, int lane) {
    const int dg = DIR * 32 + g;
    const f32x4 L4 = *(const f32x4*)((const float*)(ws + WS_S5L) + (size_t)(dg * 64 + lane) * 4);
    const float ar = L4.x, ai = L4.y, qr = L4.z, qi = L4.w;
    const bf16* Bb = (const bf16*)(ws + WS_S5B) + (size_t)dg * 2048 + (lane & 31) * 16 + 8 * (lane >> 5);
    const bf16x8 bre0 = *(const bf16x8*)Bb, bre1 = *(const bf16x8*)(Bb + 512), bim0 = *(const bf16x8*)(Bb + 1024), bim1 = *(const bf16x8*)(Bb + 1536);
    bf16x8 cf[4]; bf16x8 dfrag;
    { const bf16* Cm = (const bf16*)(ws + WS_S5C) + (size_t)dg * 2048 + (lane & 15) * 128 + 8 * (lane >> 4);
#pragma unroll
      for (int ks = 0; ks < 4; ++ks) cf[ks] = *(const bf16x8*)(Cm + 32 * ks);
      if (DIR == 1) { const int cc = lane & 15, kq = lane >> 4; const float d = s5d[g * 16 + cc]; const unsigned dh = f2bf(d); const unsigned dl = f2bf(d - __uint_as_float(dh << 16));
#pragma unroll
          for (int j = 0; j < 8; ++j) { const int k = 8 * (kq & 1) + j; dfrag[j] = (short)((k == cc) ? (kq < 2 ? dh : dl) : 0u); } } }
    float hr = 0.f, hi = 0.f;
    { const float* Ec = (const float*)(ws + WS_S5E) + ((size_t)((DIR * NB + b) * 32 + g) * S5NCH) * 128 + 2 * lane;
      const int nj = DIR == 0 ? c : (S5NCH - 1 - c);
      for (int j0 = 0; j0 < nj; j0 += 32) {
          f32x2 e[32];
#pragma unroll
          for (int q = 0; q < 32; ++q) { const int j = (j0 + q) < nj ? (j0 + q) : (nj - 1); const int jj = DIR == 0 ? j : (S5NCH - 1 - j); e[q] = *(const f32x2*)(Ec + (size_t)jj * 128); }
#pragma unroll
          for (int q = 0; q < 32; ++q) if (j0 + q < nj) { const float nr = FMAF(qr, hr, FMAF(-qi, hi, e[q].x)); hi = FMAF(qr, hi, FMAF(qi, hr, e[q].y)); hr = nr; }
      } }
    const size_t rowbase = (size_t)b * SEQ + (size_t)c * S5CH;
    const LAS unsigned char* up = ul + (lane & 31) * S5_UST + (g & 7) * 32 + 16 * (lane >> 5);
    const f32x16 zero16 = {0.f, 0.f, 0.f, 0.f, 0.f, 0.f, 0.f, 0.f, 0.f, 0.f, 0.f, 0.f, 0.f, 0.f, 0.f, 0.f};
    float xr[32], xi[32];
    auto doX = [&](int tile) {
        const bf16x8 a = *(const LAS bf16x8*)(up + tile * 32 * S5_UST);
        f32x16 xr0 = MFMA32(a, bre0, zero16), xr1 = MFMA32(a, bre1, zero16), xi0 = MFMA32(a, bim0, zero16), xi1 = MFMA32(a, bim1, zero16);
#pragma unroll
        for (int r = 0; r < 16; ++r) {
            auto s_ = __builtin_amdgcn_permlane32_swap(__float_as_uint(xr0[r]), __float_as_uint(xr1[r]), false, false);
            xr[crow(r, 0)] = __uint_as_float(s_[0]); xr[crow(r, 1)] = __uint_as_float(s_[1]);
            auto q_ = __builtin_amdgcn_permlane32_swap(__float_as_uint(xi0[r]), __float_as_uint(xi1[r]), false, false);
            xi[crow(r, 0)] = __uint_as_float(q_[0]); xi[crow(r, 1)] = __uint_as_float(q_[1]);
        } };
    auto doS = [&]() {
#pragma unroll
        for (int tt = 0; tt < 32; ++tt) {
            const int t = DIR == 0 ? tt : 31 - tt;
            const float tr_ = FMAF(-ai, hi, xr[t]), ti_ = FMAF(ai, hr, xi[t]);
            hr = FMAF(ar, hr, tr_); hi = FMAF(ar, hi, ti_);
            *(LAS unsigned*)(hl + t * S5_HST + 4 * lane) = pk2(hr, hi);
        } };
    doX(DIR == 0 ? 0 : S5CH / 32 - 1); doS();
#pragma unroll 1
    for (int ti = 0; ti < S5CH / 32; ++ti) {
        const int tile = DIR == 0 ? ti : (S5CH / 32 - 1 - ti);
        f32x4 ysv[2] = {{0.f, 0.f, 0.f, 0.f}, {0.f, 0.f, 0.f, 0.f}};
        if (DIR == 1) { ysv[0] = ld_ys(yscr + (size_t)(tile * 2) * 256 + 4 * lane); ysv[1] = ld_ys(yscr + (size_t)(tile * 2 + 1) * 256 + 4 * lane); }
        if (ti + 1 < S5CH / 32) doX(DIR == 0 ? ti + 1 : S5CH / 32 - 2 - ti);
#pragma unroll
        for (int sub = 0; sub < 2; ++sub) {
            f32x4 y = ysv[sub];
            bf16x8 hf[4];
#pragma unroll
            for (int ks = 0; ks < 4; ++ks) hf[ks] = *(const LAS bf16x8*)(hl + (sub * 16 + (lane & 15)) * S5_HST + 64 * ks + 16 * (lane >> 4));
#pragma unroll
            for (int ks = 0; ks < 4; ++ks) y = MFMA16(hf[ks], cf[ks], y);
            if (DIR == 0) *(f32x4*)(yscr + (size_t)(tile * 2 + sub) * 256 + 4 * lane) = y;
            else {
                const bf16x8 uf = *(const LAS bf16x8*)(ul + (tile * 32 + sub * 16 + (lane & 15)) * S5_UST + (g & 7) * 32 + 16 * ((lane >> 4) & 1));
                y = MFMA16(uf, dfrag, y);
                bf16* yo = (bf16*)(ws + WS_YG) + (rowbase + tile * 32 + sub * 16 + 4 * (lane >> 4)) * 512 + g * 16 + (lane & 15);
#pragma unroll
                for (int r = 0; r < 4; ++r) yo[(size_t)r * 512] = (bf16)f2bf(gelu_tanh(y[r]));
            }
        }
        if (ti + 1 < S5CH / 32) { LDS_WAIT(); doS(); }
    }
}
template <int PASS, bool CHK = false>
__device__ __forceinline__ void s5_phase(unsigned char* ws, const float* s5d, LAS unsigned char* lds, int bid, int G, int tid, int wave, int lane) {
    LAS unsigned char* hl = lds + wave * (32 * S5_HST); LAS unsigned char* ul = lds + S5_UOFF;
    float* yscr = (float*)(ws + WS_YSCR) + (size_t)(bid * NWAVES + wave) * 4096;
    const bf16* h0 = (const bf16*)(ws + WS_H0);
#ifdef S5_IL
    if (PASS == 2 && !CHK) {
        LAS unsigned char* hl0 = lds + wave * (64 * S5_HST); LAS unsigned char* hl1 = hl0 + 32 * S5_HST;
        for (int it = bid; it < NB * S5NCH * 4; it += G) {
            const int go = it & 3, c = (it >> 2) % S5NCH, b = it / (4 * S5NCH), g = go * 8 + wave;
            s5_pass2_il(ws, s5d, b, g, c, hl0, hl1, yscr, lane);
        }
        return;
    }
#endif
    for (int it = bid; it < NB * S5NCH * 4; it += G) {
        const int go = it & 3, c = (it >> 2) % S5NCH, b = it / (4 * S5NCH), g = go * 8 + wave;
        f32x4 ysr_[16]; float hin0_[2] = {0.f, 0.f}, hin1_[2] = {0.f, 0.f};
#ifdef S5_CARRY2
        if (PASS == 2) s5_carry2(ws, b, g, c, lane, hin0_, hin1_);
#endif
#ifndef S5_GLOBAL_U
        { const bf16* src = h0 + ((size_t)b * SEQ + (size_t)c * S5CH) * H0P + OFF_U + go * 128;
          u32x4 v[8];
#pragma unroll
          for (int i = 0; i < 8; ++i) { const int p = i * NTHR + tid; v[i] = *(const u32x4*)(src + (size_t)(p >> 4) * H0P + 8 * (p & 15)); }
#ifdef S5_CHECK_IN
          { unsigned cs = 0u;
#pragma unroll
            for (int i = 0; i < 8; ++i) cs ^= v[i].x ^ (v[i].y * 3u) ^ (v[i].z * 5u) ^ (v[i].w * 7u);
            unsigned* cw = (unsigned*)(ws + WS_LR) + (size_t)(PASS - 1) * 512 * 512 + (size_t)it * 512 + tid;
            if (CHK) { if (*cw != cs) atomicAdd((unsigned*)(ws + WS_CTL) + CW_CHKC, 1u); } else *cw = cs; }
#endif
          __syncthreads();
#pragma unroll
          for (int i = 0; i < 8; ++i) { const int p = i * NTHR + tid; *(LAS u32x4*)(ul + (p >> 4) * S5_UST + 16 * (p & 15)) = v[i]; }
          __syncthreads(); }
#endif
#ifdef S5_SERIAL
        if (wave < 4) { s5_dir<PASS, 0, CHK>(ws, s5d, b, g, c, hl, ul, yscr, lane, ysr_, hin0_); s5_dir<PASS, 1, CHK>(ws, s5d, b, g, c, hl, ul, yscr, lane, ysr_, hin1_); }
        LDS_BARRIER();
        if (wave >= 4) { s5_dir<PASS, 0, CHK>(ws, s5d, b, g, c, hl, ul, yscr, lane, ysr_, hin0_); s5_dir<PASS, 1, CHK>(ws, s5d, b, g, c, hl, ul, yscr, lane, ysr_, hin1_); }
#else
#ifdef S5_PIPE
        if (PASS == 2 && !CHK) { s5_dir2p<0>(ws, s5d, b, g, c, hl, ul, yscr, lane); s5_dir2p<1>(ws, s5d, b, g, c, hl, ul, yscr, lane); }
        else
#endif
        { s5_dir<PASS, 0, CHK>(ws, s5d, b, g, c, hl, ul, yscr, lane, ysr_, hin0_);
        s5_dir<PASS, 1, CHK>(ws, s5d, b, g, c, hl, ul, yscr, lane, ysr_, hin1_); }
#endif
#if defined(S5_YLDS) && !defined(S5_GLOBAL_U)
        if (PASS == 2) { __syncthreads();
            bf16* dst = (bf16*)(ws + WS_YG) + ((size_t)b * SEQ + (size_t)c * S5CH) * 512 + go * 128;
#pragma unroll
            for (int i = 0; i < 8; ++i) { const int p = i * NTHR + tid; *(u32x4*)(dst + (size_t)(p >> 4) * 512 + 8 * (p & 15)) = *(const LAS u32x4*)(ul + (p >> 4) * S5_UST + 16 * (p & 15)); } }
#endif
    }
}
#ifndef GLA_S16
#define GLA_S16 0
#endif
constexpr int G_ST = 144;
constexpr int GL_QD = 0, GL_KD = GL_QD + 64 * G_ST, GL_KCT = GL_KD + 64 * G_ST, GL_VT = GL_KCT + 64 * G_ST, GL_IMG = GL_VT + 128 * G_ST,
              GL_S = 2 * GL_IMG, GL_ST = GL_S + 64 * G_ST, GL_OS = GL_ST + 2 * 128 * G_ST, GL_OST = 272, GL_END = GL_OS + 64 * GL_OST;
static_assert(GL_END <= MISC_OFF, "GLA LDS");
__device__ __forceinline__ bf16x8 ldfrag32(const LAS unsigned char* base, int row0, int ks, int lane) {
    return *(const LAS bf16x8*)(base + (row0 + (lane & 31)) * G_ST + 32 * ks + 16 * (lane >> 5));
}
template <int SH>
__device__ __forceinline__ bf16x8 ldfrag32s(const LAS unsigned char* base, int row0, int ks, int lane) {
    const int row = row0 + (lane & 31);
    return *(const LAS bf16x8*)(base + row * G_ST + 16 * ((2 * ks + (lane >> 5)) ^ ((row >> SH) & 7)));
}
__device__ __forceinline__ void gate_tail(float* bcg, const float* gate_w, const float* gate_b, const LAS float* lrs, size_t row0, int tid) {
    const int dir = tid >> 8;
    float gw[16];
#pragma unroll
    for (int r = 0; r < 16; ++r) gw[r] = gate_w[(size_t)(dir * 16 + r) * 256 + (tid & 255)];
    const float gb = gate_b[tid];
    float run = 0.f;
#pragma unroll 8
    for (int i = 0; i < 128; ++i) {
        const int t = dir ? 127 - i : i;
        if ((i & 63) == 0) run = 0.f;
        const LAS f32x4* lp = (const LAS f32x4*)(lrs + t * 32 + dir * 16);
        const f32x4 l0 = lp[0], l1 = lp[1], l2 = lp[2], l3 = lp[3];
        float z = gb + l0.x * gw[0] + l0.y * gw[1] + l0.z * gw[2] + l0.w * gw[3] + l1.x * gw[4] + l1.y * gw[5] + l1.z * gw[6] + l1.w * gw[7]
                     + l2.x * gw[8] + l2.y * gw[9] + l2.z * gw[10] + l2.w * gw[11] + l3.x * gw[12] + l3.y * gw[13] + l3.z * gw[14] + l3.w * gw[15];
        const float ls = fminf(z, 0.f) - __logf(1.f + __expf(-fabsf(z)));
        run += ls * (1.0f / 16.0f);
        bcg[(row0 + t) * 512 + tid] = run;
    }
}
__device__ __forceinline__ size_t gla_tok(int b, int dir, int chunk, int s) { const int pos = chunk * GCH + s; return (size_t)b * SEQ + (dir ? (SEQ - 1 - pos) : pos); }
template <int PASS, int ABL = 0>
__device__ __forceinline__ void gla_item(unsigned char* ws, const float* bcg, int item, LAS unsigned char* lds, int tid, int wave, int lane) {
    const int sc = item % GNSC, dir = (item / GNSC) & 1, h = (item / (GNSC * 2)) & 3, b = item / (GNSC * 8);
    const bf16* h0 = (const bf16*)(ws + WS_H0);
    LAS unsigned char* QD = lds + GL_QD; LAS unsigned char* KD = lds + GL_KD; LAS unsigned char* KCT = lds + GL_KCT; LAS unsigned char* VT = lds + GL_VT; LAS unsigned char* SS = lds + GL_S; LAS unsigned char* STT = lds + GL_ST;
    const int me = wave >> 1, nd = wave & 1;
    f32x16 st;
#pragma unroll
    for (int r = 0; r < 16; ++r) st[r] = 0.f;
    float dtot = 1.f;
    float* GS = (float*)(ws + WS_GS); float* GD = (float*)(ws + WS_GD);
    const int ibase = item - sc;
    if (PASS == 2) {
        for (int j0 = 0; j0 < sc; j0 += 4) {
            float dj[4], gv[4][16];
#pragma unroll
            for (int q = 0; q < 4; ++q) { const int j = (j0 + q) < sc ? (j0 + q) : (sc - 1);
                dj[q] = GD[(size_t)(ibase + j) * 64 + nd * 32 + (lane & 31)];
                const float* gs = GS + (size_t)(ibase + j) * 8192 + nd * 32 + (lane & 31);
#pragma unroll
                for (int r = 0; r < 16; ++r) gv[q][r] = gs[(size_t)(me * 32 + crow(r, lane >> 5)) * 64]; }
#pragma unroll
            for (int q = 0; q < 4; ++q) if (j0 + q < sc) {
#pragma unroll
                for (int r = 0; r < 16; ++r) st[r] = st[r] * dj[q] + gv[q][r]; }
        }
#pragma unroll
        for (int r = 0; r < 16; ++r) *(LAS bf16*)(STT + (me * 32 + crow(r, lane >> 5)) * G_ST + (nd * 32 + (lane & 31)) * 2) = (bf16)f2bf(st[r]);
    }
    const float qscale = 0.125f;
    const int s_l = tid >> 3, cw = tid & 7;
    const int gcol = dir * 256 + h * 64;
    u32x4 pq, pk, pv0, pv1; f32x4 pb0, pb1, pl0, pl1; float pdec;
#define GLA_LOAD(n) do { if (ABL & 8) break; const int ch_ = sc * GSC + (n); const size_t tk = gla_tok(b, dir, ch_, s_l), tl = gla_tok(b, dir, ch_, 63); const bf16* rp = h0 + tk * H0P; \
        if (PASS == 2) pq = *(const u32x4*)(rp + OFF_Q + h * 64 + 8 * cw); \
        pk = *(const u32x4*)(rp + OFF_K + h * 64 + 8 * cw); pv0 = *(const u32x4*)(rp + OFF_V + h * 128 + 16 * cw); pv1 = *(const u32x4*)(rp + OFF_V + h * 128 + 16 * cw + 8); \
        pb0 = *(const f32x4*)(bcg + tk * 512 + gcol + 8 * cw); pb1 = *(const f32x4*)(bcg + tk * 512 + gcol + 8 * cw + 4); \
        pl0 = *(const f32x4*)(bcg + tl * 512 + gcol + 8 * cw); pl1 = *(const f32x4*)(bcg + tl * 512 + gcol + 8 * cw + 4); \
        pdec = bcg[tl * 512 + gcol + nd * 32 + (lane & 31)]; } while (0)
#define GLA_STEP_A(IMG) do { LAS unsigned char* QD_ = (IMG) + GL_QD; LAS unsigned char* KD_ = (IMG) + GL_KD; LAS unsigned char* KCT_ = (IMG) + GL_KCT; LAS unsigned char* VT_ = (IMG) + GL_VT; \
        const float bc[8] = {pb0.x, pb0.y, pb0.z, pb0.w, pb1.x, pb1.y, pb1.z, pb1.w}, bl[8] = {pl0.x, pl0.y, pl0.z, pl0.w, pl1.x, pl1.y, pl1.z, pl1.w}; \
        const float kv[8] = {bflo(pk.x), bfhi(pk.x), bflo(pk.y), bfhi(pk.y), bflo(pk.z), bfhi(pk.z), bflo(pk.w), bfhi(pk.w)}; \
        if (PASS == 2) { const float qv[8] = {bflo(pq.x), bfhi(pq.x), bflo(pq.y), bfhi(pq.y), bflo(pq.z), bfhi(pq.z), bflo(pq.w), bfhi(pq.w)}; float qd[8], kd[8]; \
            _Pragma("unroll") for (int i = 0; i < 8; ++i) { qd[i] = qv[i] * qscale * ((ABL & 2) ? (1.f + bc[i]) : __expf(bc[i])); kd[i] = kv[i] * ((ABL & 2) ? (1.f - bc[i]) : __expf(-bc[i])); } \
            u32x4 w; w.x = pk2(qd[0], qd[1]); w.y = pk2(qd[2], qd[3]); w.z = pk2(qd[4], qd[5]); w.w = pk2(qd[6], qd[7]); *(LAS u32x4*)(QD_ + s_l * G_ST + 16 * cw) = w; \
            w.x = pk2(kd[0], kd[1]); w.y = pk2(kd[2], kd[3]); w.z = pk2(kd[4], kd[5]); w.w = pk2(kd[6], kd[7]); *(LAS u32x4*)(KD_ + s_l * G_ST + 16 * cw) = w; } \
        if (!(ABL & 16)) _Pragma("unroll") for (int i = 0; i < 8; ++i) *(LAS bf16*)(KCT_ + (8 * cw + i) * G_ST + 16 * ((s_l >> 3) ^ cw) + 2 * (s_l & 7)) = (bf16)f2bf(kv[i] * ((ABL & 2) ? (1.f + bl[i] - bc[i]) : __expf(bl[i] - bc[i]))); \
        const unsigned vv[8] = {pv0.x, pv0.y, pv0.z, pv0.w, pv1.x, pv1.y, pv1.z, pv1.w}; \
        if (!(ABL & 16)) _Pragma("unroll") for (int i = 0; i < 8; ++i) { *(LAS bf16*)(VT_ + (16 * cw + 2 * i) * G_ST + 16 * ((s_l >> 3) ^ cw) + 2 * (s_l & 7)) = (bf16)(vv[i] & 0xffffu); *(LAS bf16*)(VT_ + (16 * cw + 2 * i + 1) * G_ST + 16 * ((s_l >> 3) ^ cw) + 2 * (s_l & 7)) = (bf16)(vv[i] >> 16); } \
        dec_n = __expf(pdec); } while (0)
#define GLA_STEP_B(IMG, STW, WRITE_ST) do { LAS unsigned char* QD_ = (IMG) + GL_QD; LAS unsigned char* KD_ = (IMG) + GL_KD; LAS unsigned char* KCT_ = (IMG) + GL_KCT; LAS unsigned char* VT_ = (IMG) + GL_VT; \
        if (PASS == 2 && GLA_S16 && !(ABL & 4)) {   \
            _Pragma("unroll") for (int tq = 0; tq < 2; ++tq) { const int m16 = wave >> 1, n16 = 2 * (wave & 1) + tq; f32x4 sa = {0.f, 0.f, 0.f, 0.f}; \
                if (n16 <= m16) { _Pragma("unroll") for (int ks = 0; ks < 2; ++ks) { \
                    const bf16x8 qa = *(const LAS bf16x8*)(QD_ + (16 * m16 + (lane & 15)) * G_ST + 64 * ks + 16 * (lane >> 4)), kb = *(const LAS bf16x8*)(KD_ + (16 * n16 + (lane & 15)) * G_ST + 64 * ks + 16 * (lane >> 4)); \
                    sa = MFMA16(qa, kb, sa); } } \
                _Pragma("unroll") for (int r = 0; r < 4; ++r) { const int s = 16 * m16 + 4 * (lane >> 4) + r, s2 = 16 * n16 + (lane & 15); const bool keep = dir ? (s2 < s) : (s2 <= s); \
                    *(LAS bf16*)(SS + s * G_ST + 2 * s2) = (bf16)f2bf(keep ? sa[r] : 0.f); } } } \
        if (PASS == 2 && !GLA_S16 && wave < 4 && !(ABL & 4)) { const int ms = wave >> 1, ns = wave & 1; f32x16 sa; \
            _Pragma("unroll") for (int r = 0; r < 16; ++r) sa[r] = 0.f; \
            if (ns <= ms) { _Pragma("unroll") for (int ks = 0; ks < 4; ++ks) sa = MFMA32(ldfrag32(QD_, ms * 32, ks, lane), ldfrag32(KD_, ns * 32, ks, lane), sa); } \
            _Pragma("unroll") for (int r = 0; r < 16; ++r) { const int s = ms * 32 + crow(r, lane >> 5), s2 = ns * 32 + (lane & 31); const bool keep = dir ? (s2 < s) : (s2 <= s); \
                *(LAS bf16*)(SS + s * G_ST + 2 * s2) = (bf16)f2bf(keep ? sa[r] : 0.f); } } \
        _Pragma("unroll") for (int r = 0; r < 16; ++r) st[r] *= dec_c; \
        dtot *= dec_c; \
        if (!(ABL & 32)) _Pragma("unroll") for (int ks = 0; ks < 4; ++ks) st = MFMA32(ldfrag32s<4>(VT_, me * 32, ks, lane), ldfrag32s<3>(KCT_, nd * 32, ks, lane), st); \
        if (PASS == 2 && (WRITE_ST)) { _Pragma("unroll") for (int r = 0; r < 16; ++r) *(LAS bf16*)((STW) + (me * 32 + crow(r, lane >> 5)) * G_ST + (nd * 32 + (lane & 31)) * 2) = (bf16)f2bf(st[r]); } } while (0)
    float dec_n = 1.f, dec_c = 1.f;
    LAS unsigned char* IMG0 = lds; LAS unsigned char* IMG1 = lds + GL_IMG;
    GLA_LOAD(0);
    __syncthreads();
    GLA_STEP_A(IMG0); dec_c = dec_n;
    if (1 < GSC) GLA_LOAD(1);
    LDS_BARRIER();
    if (PASS == 2) { GLA_STEP_B(IMG0, STT + 128 * G_ST, true); LDS_BARRIER(); }
#if defined(GLA_UNROLL4)
#pragma unroll 4
#elif defined(GLA_UNROLL2)
#pragma unroll 2
#else
#pragma unroll 1
#endif
    for (int n = 0; n < GSC; ++n) {
        LAS unsigned char* Ic = (n & 1) ? IMG1 : IMG0; LAS unsigned char* In = (n & 1) ? IMG0 : IMG1;
        LAS unsigned char* STc = STT + (n & 1) * (128 * G_ST);
        if (PASS == 2) {
            const int ms = wave >> 2, ne = wave & 3;
            f32x16 oa;
#pragma unroll
            for (int r = 0; r < 16; ++r) oa[r] = 0.f;
#pragma unroll
            for (int ks = 0; ks < 4; ++ks) oa = MFMA32(ldfrag32(SS, ms * 32, ks, lane), ldfrag32s<4>(Ic + GL_VT, ne * 32, ks, lane), oa);
#pragma unroll
            for (int ks = 0; ks < 4; ++ks) oa = MFMA32(ldfrag32(Ic + GL_QD, ms * 32, ks, lane), ldfrag32(STc, ne * 32, ks, lane), oa);
#ifdef GLA_OSTAGE
#pragma unroll
            for (int r = 0; r < 16; ++r) *(LAS bf16*)(lds + GL_OS + (ms * 32 + crow(r, lane >> 5)) * GL_OST + (ne * 32 + (lane & 31)) * 2) = (bf16)f2bf(oa[r]);
#else
            bf16* op = (bf16*)(ws + (dir ? WS_OB : WS_OF)) + h * 128 + ne * 32 + (lane & 31);
#pragma unroll
            for (int r = 0; r < 16; ++r) { if (ABL & 1) { if (oa[r] == 1.2345e33f) op[0] = 0; } else op[gla_tok(b, dir, sc * GSC + n, ms * 32 + crow(r, lane >> 5)) * 512] = (bf16)f2bf(oa[r]); }
#endif
        } else {
            GLA_STEP_B(Ic, STT, false);
        }
        if (n + 1 < GSC) { GLA_STEP_A(In); if (n + 2 < GSC) GLA_LOAD(n + 2); }
        LDS_BARRIER();
#ifdef GLA_OSTAGE
        if (PASS == 2) { bf16* ob_ = (bf16*)(ws + (dir ? WS_OB : WS_OF)) + h * 128;
#pragma unroll
            for (int q = 0; q < 2; ++q) { const int p_ = q * NTHR + tid, row = p_ >> 4, ch = p_ & 15;
                *(u32x4*)(ob_ + gla_tok(b, dir, sc * GSC + n, row) * 512 + 8 * ch) = *(const LAS u32x4*)(lds + GL_OS + row * GL_OST + 16 * ch); } }
#endif
        if (PASS == 2 && n + 1 < GSC) { dec_c = dec_n; GLA_STEP_B(In, STT + (n & 1) * (128 * G_ST), n + 2 < GSC); LDS_BARRIER(); }
        if (PASS == 1) dec_c = dec_n;
    }
#undef GLA_STEP_A
#undef GLA_STEP_B
    if (PASS == 1 && ABL == 0) {
        float* gs = GS + (size_t)item * 8192 + nd * 32 + (lane & 31);
#pragma unroll
        for (int r = 0; r < 16; ++r) gs[(size_t)(me * 32 + crow(r, lane >> 5)) * 64] = st[r];
        if (me == 0 && lane < 32) GD[(size_t)item * 64 + nd * 32 + lane] = dtot;
    }
    __syncthreads();
#undef GLA_LOAD
}
constexpr int AT_KST = 144, AT_VST = 664, AT_K = 0, AT_V = 320 * AT_KST, AT_BT = AT_V + 64 * AT_VST, AT_END = AT_BT + 16 * 260 * 4;
static_assert(AT_END <= RING_BYTES && AT_V % 16 == 0 && AT_BT % 16 == 0, "attention LDS");
#ifndef ATT_QCOAL
#define ATT_QCOAL 0
#endif
constexpr int AT_OS = (AT_END + 15) & ~15, AT_OST = 144;
static_assert(AT_OS + 8 * 32 * AT_OST <= MISC_OFF, "attention LDS (output staging)");
template <int ABL = 0>
__device__ __forceinline__ void attn_phase(unsigned char* ws, const float* sink, LAS unsigned char* lds, int bid, int G, int tid, int wave, int lane) {
    const bf16* qkv = (const bf16*)(ws + WS_QKV); bf16* ao = (bf16*)(ws + WS_AO); const float* btab = (const float*)(ws + WS_BTAB);
    LAS unsigned char* KS = lds + AT_K; LAS unsigned char* VT = lds + AT_V; LAS float* BT = (LAS float*)(lds + AT_BT);
    const float sc2 = 0.125f * LOG2E;
    u32x4 kreg[5], vreg[5]; bf16x8 qreg[4]; float sreg;
    for (int p = tid; p < 16 * 260; p += NTHR) BT[p] = btab[p];
#define AT_LOAD(u_) do { if (ABL & 2) break; const int qb_ = (u_) % (SEQ / 64), kvh_ = ((u_) / (SEQ / 64)) & 3, b_ = (u_) / (4 * (SEQ / 64)), kb_ = qb_ * 64 - 128; \
        _Pragma("unroll") for (int it = 0; it < 5; ++it) { const int p = it * NTHR + tid; int key = kb_ + (p >> 3); key = key < 0 ? 0 : (key > SEQ - 1 ? SEQ - 1 : key); \
            const bf16* rp = qkv + ((size_t)b_ * SEQ + key) * CN + kvh_ * 64 + 8 * (p & 7); kreg[it] = *(const u32x4*)(rp + 1024); vreg[it] = *(const u32x4*)(rp + 1280); } \
        { const int hq_ = kvh_ * 4 + (wave >> 1); const bf16* qp_ = qkv + ((size_t)b_ * SEQ + qb_ * 64 + 32 * (wave & 1) + (lane & 31)) * CN + hq_ * 64 + 8 * (lane >> 5); \
          const bf16* qc_ = qkv + ((size_t)b_ * SEQ + qb_ * 64 + 32 * (wave & 1) + (lane >> 3)) * CN + hq_ * 64 + 8 * (lane & 7); (void)qp_; (void)qc_; \
          _Pragma("unroll") for (int ks = 0; ks < 4; ++ks) qreg[ks] = ATT_QCOAL ? *(const bf16x8*)(qc_ + (size_t)ks * 8 * CN) : *(const bf16x8*)(qp_ + 16 * ks); sreg = sink[hq_]; } } while (0)
    constexpr int NU = NB * 4 * (SEQ / 64);
    const bool xmap = (G % 8 == 0) && (NU % G == 0);
    const int ustep = xmap ? G / 8 : G, ubase = xmap ? (bid & 7) * (NU / 8) + (bid >> 3) : bid, uend = xmap ? ((bid & 7) + 1) * (NU / 8) : NU;
    if (ubase < uend) AT_LOAD(ubase);
    for (int u = ubase; u < uend; u += ustep) {
        const int qb = u % (SEQ / 64), kvh = (u / (SEQ / 64)) & 3, b = u / (4 * (SEQ / 64)), q0 = qb * 64;
#pragma unroll
        for (int it = 0; it < ((ABL & 4) ? 0 : 5); ++it) { const int p = it * NTHR + tid, i = p >> 3, ch = p & 7;
            *(LAS u32x4*)(KS + i * AT_KST + 16 * ch) = kreg[it];
            const unsigned vv[4] = {vreg[it].x, vreg[it].y, vreg[it].z, vreg[it].w};
#pragma unroll
            for (int j = 0; j < 4; ++j) { *(LAS bf16*)(VT + (8 * ch + 2 * j) * AT_VST + 2 * i) = (bf16)(vv[j] & 0xffffu); *(LAS bf16*)(VT + (8 * ch + 2 * j + 1) * AT_VST + 2 * i) = (bf16)(vv[j] >> 16); } }
        bf16x8 qf[4]; const float m0 = sreg * LOG2E;
        if (ATT_QCOAL) {
            LAS unsigned char* QS = lds + AT_OS + wave * (32 * AT_OST);
#pragma unroll
            for (int ks = 0; ks < 4; ++ks) *(LAS bf16x8*)(QS + (8 * ks + (lane >> 3)) * AT_OST + 16 * (lane & 7)) = qreg[ks];
#pragma unroll
            for (int ks = 0; ks < 4; ++ks) qf[ks] = *(const LAS bf16x8*)(QS + (lane & 31) * AT_OST + 32 * ks + 16 * (lane >> 5));
        } else {
#pragma unroll
            for (int ks = 0; ks < 4; ++ks) qf[ks] = qreg[ks]; }
        if (u + ustep < uend) AT_LOAD(u + ustep);
        LDS_BARRIER();
        const int hl = wave >> 1, hq = kvh * 4 + hl, qw = q0 + 32 * (wave & 1), qi = qw + (lane & 31), hh = lane >> 5;
        float m = m0, l = hh == 0 ? 1.f : 0.f;
        f32x16 o0, o1;
#pragma unroll
        for (int r = 0; r < 16; ++r) { o0[r] = 0.f; o1[r] = 0.f; }
        const LAS float* btl = BT + hq * 260 + 128 - (lane & 31);
        const bool edge = (q0 < 128) || (q0 + 192 > SEQ);
#if defined(ATT_UNROLL9)
#pragma unroll
#elif defined(ATT_UNROLL3)
#pragma unroll 3
#else
#pragma unroll 1
#endif
        for (int j = 0; j < 9; ++j) {
            const int i0 = 32 * (wave & 1) + 32 * j;
            f32x16 sa;
#pragma unroll
            for (int r = 0; r < 16; ++r) sa[r] = 0.f;
#ifdef ATT_PRIO
            __builtin_amdgcn_s_setprio(1);
#endif
#pragma unroll
            for (int ks = 0; ks < 4; ++ks) { const bf16x8 kf = *(const LAS bf16x8*)(KS + (i0 + (lane & 31)) * AT_KST + 32 * ks + 16 * hh); sa = MFMA32(kf, qf[ks], sa); }
#ifdef ATT_PRIO
            __builtin_amdgcn_s_setprio(0);
#endif
            float mx = -3.0e38f;
#pragma unroll
            for (int r = 0; r < 16; ++r) {
                const int kk = 32 * j - 128 + crow(r, hh);
                sa[r] = sa[r] * sc2 + btl[kk];
            }
            if (edge || j == 0 || j == 8) {
#pragma unroll
                for (int r = 0; r < 16; ++r) {
                    const int kk = 32 * j - 128 + crow(r, hh), rel = kk - (lane & 31), key = qw + kk;
                    const bool ok = ((unsigned)(rel + 128) <= 256u) && ((unsigned)key < (unsigned)SEQ);
                    sa[r] = ok ? sa[r] : -3.0e38f;
                }
            }
#pragma unroll
            for (int r = 0; r < 16; ++r) mx = fmaxf(mx, sa[r]);
            mx = fmaxf(mx, __shfl_xor(mx, 32));
            if (!__all(mx <= m)) {
                const float mn = fmaxf(m, mx), alpha = __builtin_amdgcn_exp2f(m - mn); m = mn; l *= alpha;
#pragma unroll
                for (int r = 0; r < 16; ++r) { o0[r] *= alpha; o1[r] *= alpha; }
            }
            float ps = 0.f;
#pragma unroll
            for (int r = 0; r < 16; ++r) { const float p = __builtin_amdgcn_exp2f(sa[r] - m); sa[r] = p; ps += p; }
            l += ps;
#pragma unroll
            for (int s = 0; s < 2; ++s) {
                u32x4 pw; pw.x = pk2(sa[8 * s], sa[8 * s + 1]); pw.y = pk2(sa[8 * s + 2], sa[8 * s + 3]); pw.z = pk2(sa[8 * s + 4], sa[8 * s + 5]); pw.w = pk2(sa[8 * s + 6], sa[8 * s + 7]);
                const bf16x8 pf = __builtin_bit_cast(bf16x8, pw);
#pragma unroll
                for (int dt = 0; dt < 2; ++dt) {
                    const LAS unsigned char* vp = VT + (dt * 32 + (lane & 31)) * AT_VST + 2 * (i0 + 16 * s + 4 * hh);
                    const bf16x4 va = *(const LAS bf16x4*)vp, vb = *(const LAS bf16x4*)(vp + 16);
                    const bf16x8 vf = __builtin_shufflevector(va, vb, 0, 1, 2, 3, 4, 5, 6, 7);
                    if (dt == 0) o0 = MFMA32(vf, pf, o0); else o1 = MFMA32(vf, pf, o1);
                }
            }
        }
        l += __shfl_xor(l, 32);
        const float inv = __builtin_amdgcn_rcpf(l);
        LAS unsigned char* OS = lds + AT_OS + wave * (32 * AT_OST) + (lane & 31) * AT_OST + 8 * hh;
#pragma unroll
        for (int g = 0; g < 4; ++g) {
            u32x2 w0, w1; w0.x = pk2(o0[4 * g] * inv, o0[4 * g + 1] * inv); w0.y = pk2(o0[4 * g + 2] * inv, o0[4 * g + 3] * inv);
            w1.x = pk2(o1[4 * g] * inv, o1[4 * g + 1] * inv); w1.y = pk2(o1[4 * g + 2] * inv, o1[4 * g + 3] * inv);
            *(LAS u32x2*)(OS + 16 * g) = w0; *(LAS u32x2*)(OS + 64 + 16 * g) = w1;
        }
        { const LAS unsigned char* OR = lds + AT_OS + wave * (32 * AT_OST) + (lane >> 3) * AT_OST + 16 * (lane & 7);
          bf16* op = ao + ((size_t)b * SEQ + qw + (lane >> 3)) * D + hq * 64 + 8 * (lane & 7);
#pragma unroll
          for (int j = 0; j < 4; ++j) { const u32x4 v = *(const LAS u32x4*)(OR + j * 8 * AT_OST);
              if (ABL & 1) { if (v.x == 0x12345678u && v.w == 0x9abcdef0u) op[0] = 0; } else *(u32x4*)(op + (size_t)j * 8 * D) = v; } }
        LDS_BARRIER();
    }
#undef AT_LOAD
}
#ifndef MK_N_LAUNCHES
#define MK_N_LAUNCHES 1
#endif
constexpr int N_PHASES = 19;

#ifndef KEEP_LO1
#define KEEP_LO1 false
#endif
#ifndef KEEP_LO2
#define KEEP_LO2 false
#endif
#ifndef KEEP_LO3
#define KEEP_LO3 false
#endif
#ifndef PH_MASK
#define PH_MASK 0xFFFFFFFFu
#endif
#define ON(k) (((PH_MASK) >> (k)) & 1u)
#ifndef REP_MASK
#define REP_MASK 0u
#endif
#ifndef REP_N
#define REP_N 2
#endif
#define NREP(k) ((((REP_MASK) >> (k)) & 1u) ? 2 : 1)

template <int LAYER>
__device__ __forceinline__ void common_phases(unsigned char* ws, LAS unsigned char* lds, float* dout, const XcdBarrier& bar, int lo, int hi, int bid, int G, int tid, int wave, int lane) {
    constexpr int pb = LAYER == 0 ? 5 : 13;
    const int gw = bid * NWAVES + wave, NGW = G * NWAVES;
#define IN(k) (lo <= (k) && (k) < hi)
#define SEAM(k) do { if (IN(k) && IN((k) + 1)) xcd_barrier(bar); } while (0)
    if (ON(5) && IN(pb)) {
        pg8::Gemm g{(const bf16*)(ws + (LAYER == 0 ? WS_X64 : WS_AO)), (const bf16*)(ws + (LAYER == 0 ? WS_WOUT : WS_COUT)), T, D, D, 0, nullptr}; pg8::StaticOrder S; S.init(T, D, G, bid);
        pg8::EpiBf16 E{(bf16*)(ws + WS_Z), D};
        pg8::gemm_phase<pg8::EpiBf16, pg8::StaticOrder, false>(lds, g, S, E);
    }
    SEAM(pb);
    if (ON(6) && IN(pb + 1)) { ln_router<LAYER == 0, KEEP_LO2, (LAYER == 0 ? KEEP_LO1 : KEEP_LO3)>(ws, inp(lds, I_X), inp(lds, I_LNMG) + LAYER * D, inp(lds, I_LNMB) + LAYER * D, inp(lds, I_BGRP) + LAYER * 4, inp(lds, I_BRT) + LAYER * 32, LAYER, lds, bid, G, tid, wave, lane); __syncthreads(); }
    SEAM(pb + 1);
    if (ON(7) && IN(pb + 2)) { moe_sort(ws, lds, bid, G, tid); __syncthreads(); }
    SEAM(pb + 2);
    if (ON(8) && IN(pb + 3)) {
        const int* tile = (const int*)(ws + WS_TILE); const int ntiles = __builtin_amdgcn_readfirstlane(tile[511]);
        pg8::Gemm g{(const bf16*)(ws + WS_HHI), LAYER == 0 ? (const bf16*)(ws + WS_W13) : (const bf16*)dout, 0, D, D, (size_t)D * D * 2, (const int*)(ws + WS_SLOTT)};
        pg8::GroupOrder S{tile, ntiles, D / 256, G, bid};
        pg8::EpiSwiglu E{(bf16*)(ws + WS_HID), DEXP};
        pg8::gemm_phase<pg8::EpiSwiglu, pg8::GroupOrder, true>(lds, g, S, E);
#ifndef CONV_OVERLAP
        if (LAYER == 0) idle_convert(0, ws, lds, dout, ntiles, bid, G, wave, lane);
#endif
    }
    SEAM(pb + 3);
    if (ON(9) && IN(pb + 4)) {
        const int* tile = (const int*)(ws + WS_TILE); const int ntiles = __builtin_amdgcn_readfirstlane(tile[511]);
        pg8::Gemm g{(const bf16*)(ws + WS_HID), LAYER == 0 ? (const bf16*)(ws + WS_W2) : (const bf16*)dout + (size_t)NEXP * D * D, 0, D, DEXP, (size_t)D * DEXP * 2, nullptr};
        pg8::GroupOrder S{tile, ntiles, D / 256, G, bid};
        pg8::EpiBf16 E{(bf16*)(ws + WS_Y2), D};
        pg8::gemm_phase<pg8::EpiBf16, pg8::GroupOrder, false>(lds, g, S, E);
#ifndef CONV_OVERLAP
        if (LAYER == 0) idle_convert(1, ws, lds, dout, ntiles, bid, G, wave, lane);
#endif
    }
    SEAM(pb + 4);
    if (ON(10) && IN(pb + 5)) {
        if (LAYER == 0) {
            combine_ln<false, KEEP_LO1, KEEP_LO2>(ws, inp(lds, I_LNFG), inp(lds, I_LNFB), nullptr, gw, NGW, lane);
#ifndef CONV_OVERLAP
            { const int done = idle_done(__builtin_amdgcn_readfirstlane(((const int*)(ws + WS_TILE))[511]), G);
              moe_convert(inp(lds, I_W1) + (size_t)NEXP * D * DEXP, inp(lds, I_W3) + (size_t)NEXP * D * DEXP, inp(lds, I_W2) + (size_t)NEXP * DEXP * D, (bf16*)dout, (bf16*)dout + (size_t)NEXP * D * D, (LAS float*)(lds + wave * 16384), done, MOE_ITEMS, gw, NGW, lane); }
#endif
            __syncthreads();
        } else combine_ln<true, KEEP_LO3, false>(ws, inp(lds, I_LNFG) + D, inp(lds, I_LNFB) + D, dout, gw, NGW, lane);
    }
    if (LAYER == 0) SEAM(10);
#undef IN
#undef SEAM
}

struct Args { const float* in[N_IN]; float* out; unsigned char* ws; int ph_lo, ph_hi; };
static_assert(sizeof(Args) == N_IN * 8 + 8 + 8 + 8, "no padding holes in Args");

__global__ void __launch_bounds__(NTHR, 2) fwd_kernel(Args args) {
    extern __shared__ __attribute__((aligned(16))) unsigned char lds_raw[];
    LAS unsigned char* lds = (LAS unsigned char*)lds_raw;
    volatile LAS unsigned* MISC = (volatile LAS unsigned*)(lds + MISC_OFF);
    const int tid = threadIdx.x, lane = tid & 63, wave = __builtin_amdgcn_readfirstlane(tid >> 6), G = gridDim.x, bid = blockIdx.x;
    unsigned char* ws = args.ws;
    for (int u = tid; u < 64; u += NTHR) MISC[u] = 0u;
    if (tid < N_IN) *(LAS unsigned long long*)(lds + PTR_OFF + 8 * tid) = (unsigned long long)args.in[tid];
    __syncthreads();
    const int lo = args.ph_lo, hi = args.ph_hi;
    const bool use_bar = (hi - lo) > 1;
    XcdBarrier bar; bar.bar = (unsigned*)(ws + WS_CTL) + CW_BAR; bar.x = 0; bar.st = nullptr;
    if (use_bar) bar = xcd_barrier_post((unsigned*)(ws + WS_CTL) + CW_BAR, MISC + 8);
#define IN(k) (lo <= (k) && (k) < hi)
#define SEAM(k) do { if (IN(k) && IN((k) + 1)) xcd_barrier(bar); } while (0)
    const int gw = bid * NWAVES + wave, NGW = G * NWAVES;

    if (ON(0) && IN(0)) { p0_prologue(ws, lds, bid, G, tid, wave, lane); __syncthreads(); }
    SEAM(0);
    if (ON(1) && IN(1)) {
#ifdef CONV_OVERLAP
        half_convert(0, 0, ws, lds, args.out, bid, G, wave, lane); __syncthreads();
#endif
        pg8::Gemm g{(const bf16*)(ws + WS_X64), (const bf16*)(ws + WS_WIN), T, ABN, D, 0, nullptr}; pg8::SplitOrder S; S.init(T, ABN, 2, G, bid);
        pg8::EpiBf16 E{(bf16*)(ws + WS_H0), H0P};
        pg8::gemm_phase<pg8::EpiBf16, pg8::SplitOrder, false>(lds, g, S, E);
        lr_tail(ws, args.out, inp(lds, I_GATEW), inp(lds, I_GATEB), lds, bid, G, tid, wave, lane);
#ifdef TAIL_TWICE
        lr_tail<TAIL_TWICE>(ws, args.out, inp(lds, I_GATEW), inp(lds, I_GATEB), lds, bid, G, tid, wave, lane);
#endif
#ifdef CONV_OVERLAP
        __syncthreads(); half_convert(0, 1, ws, lds, args.out, bid, G, wave, lane);
#endif
    }
    SEAM(1);
    if (ON(2) && IN(2)) {
#ifdef S5_OLD_PASS1
        s5_phase<1>(ws, inp(lds, I_S5D), lds, bid, G, tid, wave, lane);
#else
        s5_pass1_gemm<false>(ws, lds, bid, G, tid, wave, lane);
#ifdef S5A_TWICE
        __syncthreads(); s5_pass1_gemm<false>(ws, lds, bid, G, tid, wave, lane); __syncthreads(); s5_pass1_gemm<false>(ws, lds, bid, G, tid, wave, lane);
#endif
#endif
#ifdef S5A_CHECK
        VM_WAIT(); __syncthreads(); s5_pass1_gemm<true>(ws, lds, bid, G, tid, wave, lane); VM_WAIT(); __syncthreads();
#endif
#ifdef S5_TWICE
        __syncthreads(); s5_phase<1>(ws, inp(lds, I_S5D), lds, bid, G, tid, wave, lane);
#endif
#ifdef S5_CHECK
        VM_WAIT(); __syncthreads(); s5_phase<1, true>(ws, inp(lds, I_S5D), lds, bid, G, tid, wave, lane);
#endif
        __syncthreads();
        for (int it = bid; it < 256; it += G) gla_item<1>(ws, args.out, it, lds, tid, wave, lane);
#ifdef GLA_TWICE
        for (int it = bid; it < 256; it += G) gla_item<1>(ws, args.out, it, lds, tid, wave, lane);
#endif
#if defined(GLA_ABL) && GLA_ABL_P == 1
        for (int it = bid; it < 256; it += G) gla_item<1, GLA_ABL>(ws, args.out, it, lds, tid, wave, lane);
#endif
    }
    SEAM(2);
    if (ON(3) && IN(3)) {
#ifdef S5A_CHECK
        { const float* ea = (const float*)(ws + WS_S5E); const float* eb = (const float*)(ws + WS_OF); float num = 0.f, den = 0.f;
          for (int i = bid * NTHR + tid; i < 2 * NB * 32 * S5NCH * 128; i += G * NTHR) { const float a = ea[i], d = a - eb[i]; num += d * d; den += a * a; }
          num = wave_sum(num); den = wave_sum(den);
          if (lane == 0) { atomicAdd((float*)(ws + WS_CTL) + 70, num); atomicAdd((float*)(ws + WS_CTL) + 71, den); } }
#endif
        s5_phase<2>(ws, inp(lds, I_S5D), lds, bid, G, tid, wave, lane);
#ifdef S5_TWICE
        __syncthreads(); s5_phase<2>(ws, inp(lds, I_S5D), lds, bid, G, tid, wave, lane);
#endif
#ifdef S5_ABL
        __syncthreads(); s5_phase<2, true>(ws, inp(lds, I_S5D), lds, bid, G, tid, wave, lane);
#endif
#ifdef S5_CHECK2
        VM_WAIT(); __syncthreads(); s5_phase<2, true>(ws, inp(lds, I_S5D), lds, bid, G, tid, wave, lane);
#endif
        __syncthreads();
        for (int it = bid; it < 256; it += G) gla_item<2>(ws, args.out, it, lds, tid, wave, lane);
#ifdef GLA_TWICE
        for (int it = bid; it < 256; it += G) gla_item<2>(ws, args.out, it, lds, tid, wave, lane);
#endif
#if defined(GLA_ABL) && GLA_ABL_P == 2
        for (int it = bid; it < 256; it += G) gla_item<2, GLA_ABL>(ws, args.out, it, lds, tid, wave, lane);
#endif
    }
    SEAM(3);
    if (ON(4) && IN(4)) {
        gla_finalize(ws, inp(lds, I_NORMG), gw, NGW, lane);
        pg8::Gemm g{(const bf16*)(ws + WS_YG), (const bf16*)(ws + WS_WGLU), T, 512, 512, 0, nullptr}; pg8::StaticOrder S; S.init(T, 512, G, bid);
        pg8::EpiGlu E{(const bf16*)(ws + WS_YG), 512, (bf16*)(ws + WS_X64), D, inp(lds, I_GLUB)};
        pg8::gemm_phase<pg8::EpiGlu, pg8::StaticOrder, false>(lds, g, S, E);
    }
    SEAM(4);
    common_phases<0>(ws, lds, args.out, bar, lo, hi, bid, G, tid, wave, lane);
    if (ON(11) && IN(11)) {
#ifdef CONV_OVERLAP
        half_convert(1, 0, ws, lds, args.out, bid, G, wave, lane); __syncthreads();
#endif
        pg8::Gemm g{(const bf16*)(ws + WS_H2B), (const bf16*)(ws + WS_CIN), T, CN, D, 0, nullptr}; pg8::StaticOrder S; S.init(T, CN, G, bid);
        pg8::EpiBf16 E{(bf16*)(ws + WS_QKV), CN};
        pg8::gemm_phase<pg8::EpiBf16, pg8::StaticOrder, false>(lds, g, S, E);
#ifdef CONV_OVERLAP
        VM_WAIT(); __syncthreads(); half_convert(1, 1, ws, lds, args.out, bid, G, wave, lane);
#endif
    }
    SEAM(11);
    if (ON(12) && IN(12)) { attn_phase<0>(ws, inp(lds, I_SINK), lds, bid, G, tid, wave, lane);
#ifdef ATT_ABL
        __syncthreads(); attn_phase<ATT_ABL>(ws, inp(lds, I_SINK), lds, bid, G, tid, wave, lane);
#endif
    }
    SEAM(12);
    common_phases<1>(ws, lds, args.out, bar, lo, hi, bid, G, tid, wave, lane);
#ifdef S5A_CHECK
    if (IN(18)) { VM_WAIT(); __syncthreads();
        if (bid == 0 && tid == 0) { const float num = __hip_atomic_load((float*)(ws + WS_CTL) + 70, __ATOMIC_RELAXED, __HIP_MEMORY_SCOPE_AGENT), den = __hip_atomic_load((float*)(ws + WS_CTL) + 71, __ATOMIC_RELAXED, __HIP_MEMORY_SCOPE_AGENT);
            const float ratio = num / fmaxf(den, 1e-30f);
            if (!(ratio <= 1e-3f)) args.out[3] = 6000.f; else if (ratio > 1e-4f) args.out[3] = 600.f; else if (ratio > 1e-5f) args.out[3] = 200.f; } }
#endif
#if defined(S5_CHECK) || defined(S5_CHECK2) || defined(GLA_CHECK) || defined(ATT_CHECK)
    if (IN(18)) { VM_WAIT(); __syncthreads();
        if (bid == 0 && tid == 0) { unsigned* cw = (unsigned*)(ws + WS_CTL);
            const unsigned ca = __hip_atomic_load(cw + CW_CHKA, __ATOMIC_RELAXED, __HIP_MEMORY_SCOPE_AGENT), cb = __hip_atomic_load(cw + CW_CHKB, __ATOMIC_RELAXED, __HIP_MEMORY_SCOPE_AGENT);
            const unsigned cc = __hip_atomic_load(cw + CW_CHKC, __ATOMIC_RELAXED, __HIP_MEMORY_SCOPE_AGENT), cd = __hip_atomic_load(cw + CW_CHKD, __ATOMIC_RELAXED, __HIP_MEMORY_SCOPE_AGENT);
            if (ca) args.out[0] = 600.f; if (cb) args.out[1] = 60000.f;
            if (cc) args.out[2] = 1.0e36f; if (cd) args.out[3] = 6000.f; } }
#endif
#undef IN
#undef SEAM
}

#ifdef DET_PROBE
__global__ void cs_kernel(const unsigned char* base, int nrows, int rowbytes, size_t pitch, const int* ntile_ptr, unsigned* acc) {
    if (ntile_ptr) { const int r = ntile_ptr[511] * 256; nrows = r < nrows ? r : nrows; }
    unsigned s = 0u; const int wpr = rowbytes >> 2;
    for (int r = blockIdx.x; r < nrows; r += gridDim.x) { const unsigned* row = (const unsigned*)(base + (size_t)r * pitch);
        for (int c = threadIdx.x; c < wpr; c += blockDim.x) s += row[c] * (2u * (unsigned)(r * 131 + c) + 1u); }
    for (int o = 1; o < 64; o <<= 1) s += __shfl_xor(s, o);
    if ((threadIdx.x & 63) == 0) atomicAdd(acc, s);
}
__global__ void flag_kernel(const unsigned* acc, float* out) {
    const int k = threadIdx.x; if (k >= 19) return;
    const float ex[19] = {0.f, 2000.f, 2000.f, 2000.f, 2000.f, 2000.f, 2000.f, 2000.f, 2000.f, 2000.f, 2000.f, 2000.f, 2000.f, 2000.f, 0.f, 0.f, 2000.f, 2000.f, 2000.f};
    if (ex[k] > 0.f && acc[2 * k] != acc[2 * k + 1]) out[k] = ex[k];
}
#endif
extern "C" void kernel_launch(void* const* d_in, const int* in_sizes, int n_in, void* d_out, int out_size, void* d_ws, size_t ws_size, hipStream_t stream) {
    static int grid = 0;
    if (grid == 0) {
        if (n_in != N_IN || in_sizes[0] != T * D || out_size != T * D || ws_size < WS_END) { fprintf(stderr, "kernel_launch: unexpected shapes (n_in %d, in0 %d, out %d, ws %zu < %zu)\n", n_in, n_in > 0 ? in_sizes[0] : -1, out_size, ws_size, (size_t)WS_END); grid = -1; return; }
        int dev = 0, cus = 0, per_cu = 0;
        if (hipGetDevice(&dev) != hipSuccess || hipDeviceGetAttribute(&cus, hipDeviceAttributeMultiprocessorCount, dev) != hipSuccess) { grid = -1; return; }
        if (hipFuncSetAttribute((const void*)fwd_kernel, hipFuncAttributeMaxDynamicSharedMemorySize, LDS_BYTES) != hipSuccess) { fprintf(stderr, "kernel_launch: hipFuncSetAttribute failed\n"); grid = -1; return; }
        if (hipOccupancyMaxActiveBlocksPerMultiprocessor(&per_cu, (const void*)fwd_kernel, NTHR, LDS_BYTES) != hipSuccess || per_cu < 1) fprintf(stderr, "kernel_launch: occupancy query reports %d\n", per_cu);
        (void)hipGetLastError();
        grid = cus;
    }
    if (grid < 0) return;
    if (hipMemsetAsync((char*)d_ws + WS_CTL, 0, CTL_ZERO_BYTES, stream) != hipSuccess) return;
    Args a{};
    for (int i = 0; i < N_IN; ++i) a.in[i] = (const float*)d_in[i];
    a.out = (float*)d_out; a.ws = (unsigned char*)d_ws;
#ifdef DET_PROBE
    { unsigned char* ws = (unsigned char*)d_ws; unsigned* accb = (unsigned*)(ws + WS_CTL) + 128; const int* tl = (const int*)(ws + WS_TILE);
      auto CS = [&](int k, int rep, const void* b, int nrows, int rowbytes, size_t pitch, const int* ntp) { hipLaunchKernelGGL(cs_kernel, dim3(1024), dim3(256), 0, stream, (const unsigned char*)b, nrows, rowbytes, pitch, ntp, accb + 2 * k + rep); };
      for (int li = 0; li < N_PHASES; ++li) {
        a.ph_lo = li; a.ph_hi = li + 1;
        const bool probe = (li >= 1 && li <= 6) || li == 8 || li == 9 || li == 11 || li == 12 || li == 13 || li == 16 || li == 17 || li == 18;
        for (int rep = 0; rep < (probe ? 2 : 1); ++rep) {
            hipLaunchKernelGGL(fwd_kernel, dim3(grid), dim3(NTHR), LDS_BYTES, stream, a);
            if (!probe) continue;
            switch (li) {
            case 1: CS(li, rep, ws + WS_H0, T, 4096, (size_t)H0P * 2, nullptr); CS(li, rep, d_out, T, 2048, 2048, nullptr); break;
            case 2: CS(li, rep, ws + WS_S5E, 4096, 1024, 1024, nullptr); CS(7, rep, ws + WS_GS, 8192, 1024, 1024, nullptr); CS(7, rep, ws + WS_GD, 64, 1024, 1024, nullptr); break;
            case 3: CS(li, rep, ws + WS_YG, T, 1024, 1024, nullptr); CS(10, rep, ws + WS_OF, T, 1024, 1024, nullptr); CS(10, rep, ws + WS_OB, T, 1024, 1024, nullptr); break;
            case 4: CS(li, rep, ws + WS_X64, T, 2048, 2048, nullptr); break;
            case 5: case 13: CS(li, rep, ws + WS_Z, T, 2048, 2048, nullptr); break;
            case 6: CS(li, rep, ws + WS_HHI, T, 2048, 2048, nullptr); CS(li, rep, ws + WS_TOKE, 256, 1024, 1024, nullptr); CS(li, rep, ws + WS_TOKW, 256, 1024, 1024, nullptr); break;
            case 8: case 16: CS(li, rep, ws + WS_HID, CAP, 1024, 1024, tl); break;
            case 9: case 17: CS(li, rep, ws + WS_Y2, CAP, 2048, 2048, tl); break;
            case 11: CS(li, rep, ws + WS_QKV, T, 3072, 3072, nullptr); break;
            case 12: CS(li, rep, ws + WS_AO, T, 2048, 2048, nullptr); break;
            case 18: CS(li, rep, d_out, T, 4096, 4096, nullptr); break;
            } } }
      hipLaunchKernelGGL(flag_kernel, dim3(1), dim3(64), 0, stream, (const unsigned*)accb, (float*)d_out);
      return; }
#endif
    for (int li = 0; li < MK_N_LAUNCHES; ++li) {
        a.ph_lo = (MK_N_LAUNCHES == 1) ? 0 : li; a.ph_hi = (MK_N_LAUNCHES == 1) ? N_PHASES : li + 1;
        for (int rep = 0; rep < ((MK_N_LAUNCHES > 1 && ((REP_MASK >> li) & 1u)) ? REP_N : 1); ++rep)
            hipLaunchKernelGGL(fwd_kernel, dim3(grid), dim3(NTHR), LDS_BYTES, stream, a);
    }
}
```
